# Optimizing an MI355X kernel written in HIP

```python
import jax, jax.numpy as jnp
from jax import lax
import numpy as np

D_MODEL = 2048
BATCH = 2
SEQ = 8192
DEPTH = 4

N_HEADS = 16
HEAD_DIM = D_MODEL // N_HEADS
N_KV_GROUPS = 4
CMP_BLOCK = 32
CMP_STRIDE = 16
SLC_BLOCK = 64
N_SELECT = 16
WINDOW = 512
Q_BLOCK = 64
PHI_HIDDEN = HEAD_DIM
FORCE_BONUS = 1.0e4
ROPE_THETA = 10000.0
CONV_DIM = D_MODEL
CONV_WIDTH = 3
D_INNER = D_MODEL
SSD_HEAD_DIM = 64
SSD_HEADS = D_INNER // SSD_HEAD_DIM
SSD_GROUPS = 4
SSD_STATE = 128
SSD_CONV = 4
SSD_CHUNK = 128
D_FF = 4 * D_MODEL
PLE_DIM = 256
N_BRANCHES = 3
EPS = 1e-6

KV_DIM = N_KV_GROUPS * HEAD_DIM
SSD_XBC = D_INNER + 2 * SSD_GROUPS * SSD_STATE
PROJ_WIDTHS = (N_HEADS * HEAD_DIM, KV_DIM, KV_DIM, KV_DIM, KV_DIM, KV_DIM, KV_DIM, N_HEADS * 3,
               CONV_DIM, CONV_DIM, CONV_DIM, D_INNER, SSD_XBC, SSD_HEADS, N_BRANCHES * D_MODEL)
PROJ_TOTAL = sum(PROJ_WIDTHS)

kernel_name = 'hybrid_nsa_shortconv_ssd_block'


def rms_norm(x, g):
    xf = x.astype(jnp.float32)
    y = xf * lax.rsqrt(jnp.mean(xf * xf, axis=-1, keepdims=True) + EPS)
    return (y * g.astype(jnp.float32)).astype(x.dtype)


def rope_tables(positions):
    inv_freq = 1.0 / (ROPE_THETA ** (jnp.arange(0, HEAD_DIM, 2, dtype=jnp.float32) / HEAD_DIM))
    ang = positions.astype(jnp.float32)[..., None] * inv_freq
    return jnp.cos(ang)[:, :, None, :], jnp.sin(ang)[:, :, None, :]


def apply_rope(x, cos, sin):
    x1, x2 = jnp.split(x.astype(jnp.float32), 2, axis=-1)
    return jnp.concatenate([x1 * cos - x2 * sin, x2 * cos + x1 * sin], axis=-1).astype(x.dtype)


def masked_softmax(s, mask):
    s = jnp.where(mask, s.astype(jnp.float32), -jnp.inf)
    m = jnp.max(s, axis=-1, keepdims=True)
    e = jnp.where(mask, jnp.exp(s - jnp.where(jnp.isfinite(m), m, 0.0)), 0.0)
    d = jnp.sum(e, axis=-1, keepdims=True)
    return e / jnp.where(d > 0, d, 1.0)


def causal_depthwise_conv(u, w):
    k, T = w.shape[0], u.shape[1]
    up = jnp.pad(u, ((0, 0), (k - 1, 0), (0, 0)))
    y = up[:, 0:T] * w[0]
    for j in range(1, k):
        y = y + up[:, j:j + T] * w[j]
    return y


def compress_blocks(k, pe, w1, b1, w2, b2):
    bsz, T, G, dk = k.shape
    n_cmp = (T - CMP_BLOCK) // CMP_STRIDE + 1
    idx = jnp.arange(n_cmp)[:, None] * CMP_STRIDE + jnp.arange(CMP_BLOCK)[None, :]
    blk = k[:, idx] + pe[:, None, :]
    blk = blk.transpose(0, 3, 1, 2, 4).reshape(bsz, G, n_cmp, CMP_BLOCK * dk)
    return jax.nn.silu(blk @ w1 + b1) @ w2 + b2


def nsa_mixer(q, k_c, v_c, k_s, v_s, k_w, v_w, gate, pe_k, pe_v,
              pk_w1, pk_b1, pk_w2, pk_b2, pv_w1, pv_b1, pv_w2, pv_b2):
    bsz, T, H, dk = q.shape
    G = k_c.shape[2]
    R = H // G
    scale = dk ** -0.5
    n_cmp = (T - CMP_BLOCK) // CMP_STRIDE + 1
    n_slc = T // SLC_BLOCK
    n_sel = min(N_SELECT, n_slc)
    kcmp = compress_blocks(k_c, pe_k, pk_w1, pk_b1, pk_w2, pk_b2)
    vcmp = compress_blocks(v_c, pe_v, pv_w1, pv_b1, pv_w2, pv_b2)
    cstart = jnp.arange(n_cmp) * CMP_STRIDE
    sstart = jnp.arange(n_slc) * SLC_BLOCK
    cend = cstart + CMP_BLOCK - 1
    overlap = ((cstart[:, None] < sstart[None, :] + SLC_BLOCK)
               & (cstart[:, None] + CMP_BLOCK > sstart[None, :])).astype(jnp.float32)
    kblk = k_s.reshape(bsz, n_slc, SLC_BLOCK, G, dk).transpose(0, 3, 1, 2, 4)
    vblk = v_s.reshape(bsz, n_slc, SLC_BLOCK, G, dk).transpose(0, 3, 1, 2, 4)
    kw_pad = jnp.pad(k_w, ((0, 0), (WINDOW, 0), (0, 0), (0, 0)))
    vw_pad = jnp.pad(v_w, ((0, 0), (WINDOW, 0), (0, 0), (0, 0)))
    b_idx = jnp.arange(bsz)[:, None, None, None]
    g_idx = jnp.arange(G)[None, :, None, None]
    blk = jnp.arange(n_slc)

    def query_block(i):
        s = i * Q_BLOCK
        t = s + jnp.arange(Q_BLOCK)
        qb = lax.dynamic_slice_in_dim(q, s, Q_BLOCK, axis=1).reshape(bsz, Q_BLOCK, G, R, dk)
        gb = lax.dynamic_slice_in_dim(gate, s, Q_BLOCK, axis=1).reshape(bsz, Q_BLOCK, G, R, 3)
        p_c = masked_softmax(jnp.einsum('bqgrd,bgnd->bgrqn', qb, kcmp) * scale,
                             cend[None, :] <= t[:, None])
        o_c = jnp.einsum('bgrqn,bgnd->bqgrd', p_c, vcmp)
        imp = jnp.einsum('bgrqn,nj->bgqj', p_c, overlap)
        valid = sstart[None, :] <= t[:, None]
        cur = (t // SLC_BLOCK)[:, None]
        forced = (blk[None, :] == 0) | (blk[None, :] == cur) | (blk[None, :] == cur - 1)
        score = jnp.where(valid, imp + jnp.where(forced, FORCE_BONUS, 0.0), -jnp.inf)
        _, sel = lax.top_k(score, n_sel)
        kg = kblk[b_idx, g_idx, sel].reshape(bsz, G, Q_BLOCK, n_sel * SLC_BLOCK, dk)
        vg = vblk[b_idx, g_idx, sel].reshape(bsz, G, Q_BLOCK, n_sel * SLC_BLOCK, dk)
        kpos = (sel[..., None] * SLC_BLOCK + jnp.arange(SLC_BLOCK)).reshape(
            bsz, G, 1, Q_BLOCK, n_sel * SLC_BLOCK)
        p_s = masked_softmax(jnp.einsum('bqgrd,bgqkd->bgrqk', qb, kg) * scale, kpos <= t[:, None])
        o_s = jnp.einsum('bgrqk,bgqkd->bqgrd', p_s, vg)
        kwb = lax.dynamic_slice_in_dim(kw_pad, s, WINDOW + Q_BLOCK, axis=1)
        vwb = lax.dynamic_slice_in_dim(vw_pad, s, WINDOW + Q_BLOCK, axis=1)
        kidx = s - WINDOW + jnp.arange(WINDOW + Q_BLOCK)
        wmask = ((kidx[None, :] <= t[:, None]) & (kidx[None, :] > t[:, None] - WINDOW)
                 & (kidx[None, :] >= 0))
        p_w = masked_softmax(jnp.einsum('bqgrd,bkgd->bgrqk', qb, kwb) * scale, wmask)
        o_w = jnp.einsum('bgrqk,bkgd->bqgrd', p_w, vwb)
        o = gb[..., 0:1] * o_c + gb[..., 1:2] * o_s + gb[..., 2:3] * o_w
        return o.reshape(bsz, Q_BLOCK, H * dk).astype(q.dtype)

    out = lax.map(query_block, jnp.arange(T // Q_BLOCK))
    return out.transpose(1, 0, 2, 3).reshape(bsz, T, H * dk)


def short_conv_mixer(gate_b, gate_c, u, w):
    return gate_b * causal_depthwise_conv(gate_c * u, w)


def ssd_mixer(z, xbc, dt_raw, conv_w, conv_b, dt_bias, a_log, d_skip, norm_g):
    f32 = jnp.float32
    bsz, T, _ = xbc.shape
    R = SSD_HEADS // SSD_GROUPS
    nc = T // SSD_CHUNK
    xbc = jax.nn.silu(causal_depthwise_conv(xbc, conv_w) + conv_b)
    xs, bm, cm = jnp.split(xbc, [D_INNER, D_INNER + SSD_GROUPS * SSD_STATE], axis=-1)
    xs = xs.reshape(bsz, T, SSD_GROUPS, R, SSD_HEAD_DIM).astype(f32)
    bm = bm.reshape(bsz, nc, SSD_CHUNK, SSD_GROUPS, SSD_STATE).astype(f32)
    cm = cm.reshape(bsz, nc, SSD_CHUNK, SSD_GROUPS, SSD_STATE).astype(f32)
    dt = jax.nn.softplus(dt_raw.astype(f32) + dt_bias.astype(f32)).reshape(bsz, T, SSD_GROUPS, R)
    a = -jnp.exp(a_log.astype(f32)).reshape(SSD_GROUPS, R)
    xdt = (xs * dt[..., None]).reshape(bsz, nc, SSD_CHUNK, SSD_GROUPS, R, SSD_HEAD_DIM)
    da = (dt * a).reshape(bsz, nc, SSD_CHUNK, SSD_GROUPS, R).transpose(0, 3, 4, 1, 2)
    acs = jnp.cumsum(da, axis=-1)
    causal = jnp.tril(jnp.ones((SSD_CHUNK, SSD_CHUNK), dtype=bool))
    seg = jnp.exp(jnp.where(causal, acs[..., :, None] - acs[..., None, :], -jnp.inf))
    cb = jnp.einsum('bclgn,bcsgn->bgcls', cm, bm)
    y_diag = jnp.einsum('bgrcls,bcsgrp->bclgrp', cb[:, :, None] * seg, xdt)
    decay_to_end = jnp.exp(acs[..., -1:] - acs)
    chunk_states = jnp.einsum('bclgn,bgrcl,bclgrp->cbgrpn', bm, decay_to_end, xdt)
    chunk_decay = jnp.exp(acs[..., -1]).transpose(3, 0, 1, 2)

    def step(h, inp):
        st, dec = inp
        return h * dec[..., None, None] + st, h

    h0 = jnp.zeros(chunk_states.shape[1:], f32)
    _, states_in = lax.scan(step, h0, (chunk_states, chunk_decay))
    y_off = jnp.einsum('bclgn,cbgrpn,bgrcl->bclgrp', cm, states_in, jnp.exp(acs))
    y = (y_diag + y_off).reshape(bsz, T, SSD_GROUPS, R, SSD_HEAD_DIM) \
        + d_skip.astype(f32).reshape(SSD_GROUPS, R, 1) * xs
    y = y.reshape(bsz, T, D_INNER) * jax.nn.silu(z.astype(f32))
    yg = y.reshape(bsz, T, SSD_GROUPS, D_INNER // SSD_GROUPS)
    yg = yg * lax.rsqrt(jnp.mean(yg * yg, axis=-1, keepdims=True) + EPS)
    return (yg.reshape(bsz, T, D_INNER) * norm_g.astype(f32)).astype(z.dtype)


def setup_inputs(seed: int = 0) -> dict:
    key = jax.random.key(seed)
    ks = jax.random.split(key, 32)
    L = DEPTH

    def nrm(k, shape, s):
        return jax.random.normal(k, shape, jnp.float32) * s

    def gain(k, n):
        return 1.0 + nrm(k, (L, n), 0.02)

    dt0 = jnp.exp(jax.random.uniform(ks[17], (L, SSD_HEADS), jnp.float32,
                                     minval=float(np.log(1e-3)), maxval=float(np.log(1e-1))))
    offs = jax.random.randint(ks[2], (BATCH, 1), 0, 2048, dtype=jnp.int32)
    return {
        'x': nrm(ks[0], (BATCH, SEQ, D_MODEL), 1.0),
        'p': nrm(ks[1], (DEPTH, BATCH, SEQ, PLE_DIM), 1.0),
        'positions': jnp.arange(SEQ, dtype=jnp.int32)[None, :] + offs,
        'g_mix': gain(ks[3], D_MODEL),
        'w_in': nrm(ks[4], (L, D_MODEL, PROJ_TOTAL), D_MODEL ** -0.5),
        'nsa_pe_k': nrm(ks[5], (L, CMP_BLOCK, HEAD_DIM), 0.1),
        'nsa_pe_v': nrm(ks[6], (L, CMP_BLOCK, HEAD_DIM), 0.1),
        'phi_k_w1': nrm(ks[7], (L, CMP_BLOCK * HEAD_DIM, PHI_HIDDEN), (CMP_BLOCK * HEAD_DIM) ** -0.5),
        'phi_k_b1': nrm(ks[8], (L, PHI_HIDDEN), 0.01),
        'phi_k_w2': nrm(ks[9], (L, PHI_HIDDEN, HEAD_DIM), PHI_HIDDEN ** -0.5),
        'phi_k_b2': nrm(ks[10], (L, HEAD_DIM), 0.01),
        'phi_v_w1': nrm(ks[11], (L, CMP_BLOCK * HEAD_DIM, PHI_HIDDEN), (CMP_BLOCK * HEAD_DIM) ** -0.5),
        'phi_v_b1': nrm(ks[12], (L, PHI_HIDDEN), 0.01),
        'phi_v_w2': nrm(ks[13], (L, PHI_HIDDEN, HEAD_DIM), PHI_HIDDEN ** -0.5),
        'phi_v_b2': nrm(ks[14], (L, HEAD_DIM), 0.01),
        'sconv_w': nrm(ks[15], (L, CONV_WIDTH, CONV_DIM), CONV_WIDTH ** -0.5),
        'ssd_conv_w': nrm(ks[16], (L, SSD_CONV, SSD_XBC), SSD_CONV ** -0.5),
        'ssd_conv_b': nrm(ks[18], (L, SSD_XBC), 0.01),
        'ssd_dt_bias': dt0 + jnp.log(-jnp.expm1(-dt0)),
        'ssd_a_log': jnp.log(jax.random.uniform(ks[19], (L, SSD_HEADS), jnp.float32, minval=1.0, maxval=16.0)),
        'ssd_d': 1.0 + nrm(ks[20], (L, SSD_HEADS), 0.1),
        'ssd_norm_g': gain(ks[21], D_INNER),
        'w_o': nrm(ks[22], (L, D_MODEL, D_MODEL), D_MODEL ** -0.5),
        'g_mlp': gain(ks[23], D_MODEL),
        'w_up': nrm(ks[24], (L, D_MODEL, D_FF), D_MODEL ** -0.5),
        'w_down': nrm(ks[25], (L, D_FF, D_MODEL), D_FF ** -0.5),
        'g_ple': gain(ks[26], D_MODEL),
        'w_ple': nrm(ks[27], (L, PLE_DIM, D_MODEL), PLE_DIM ** -0.5),
        'w_ple_gate': nrm(ks[28], (L, D_MODEL, D_MODEL), D_MODEL ** -0.5),
        'g_final': 1.0 + nrm(ks[29], (D_MODEL,), 0.02),
    }


def reference(x, p, positions, g_mix, w_in, nsa_pe_k, nsa_pe_v,
              phi_k_w1, phi_k_b1, phi_k_w2, phi_k_b2, phi_v_w1, phi_v_b1, phi_v_w2, phi_v_b2,
              sconv_w, ssd_conv_w, ssd_conv_b, ssd_dt_bias, ssd_a_log, ssd_d, ssd_norm_g,
              w_o, g_mlp, w_up, w_down, g_ple, w_ple, w_ple_gate, g_final):
    bsz, T, _ = x.shape
    cos, sin = rope_tables(positions)
    splits = [int(v) for v in np.cumsum(PROJ_WIDTHS)[:-1]]
    for i in range(DEPTH):
        h = rms_norm(x, g_mix[i])
        proj = h @ w_in[i]
        (q, k_c, v_c, k_s, v_s, k_w, v_w, g_nsa, cb_gate, cc_gate, c_u,
         s_z, s_xbc, s_dt, g_merge) = jnp.split(proj, splits, axis=-1)
        q = apply_rope(q.reshape(bsz, T, N_HEADS, HEAD_DIM), cos, sin)
        kv = lambda a: a.reshape(bsz, T, N_KV_GROUPS, HEAD_DIM)
        k_c = apply_rope(kv(k_c), cos, sin)
        k_s = apply_rope(kv(k_s), cos, sin)
        k_w = apply_rope(kv(k_w), cos, sin)
        y_a = nsa_mixer(q, k_c, kv(v_c), k_s, kv(v_s), k_w, kv(v_w),
                        jax.nn.sigmoid(g_nsa).reshape(bsz, T, N_HEADS, 3),
                        nsa_pe_k[i], nsa_pe_v[i],
                        phi_k_w1[i], phi_k_b1[i], phi_k_w2[i], phi_k_b2[i],
                        phi_v_w1[i], phi_v_b1[i], phi_v_w2[i], phi_v_b2[i]).astype(x.dtype)
        y_b = short_conv_mixer(cb_gate, cc_gate, c_u, sconv_w[i]).astype(x.dtype)
        y_c = ssd_mixer(s_z, s_xbc, s_dt, ssd_conv_w[i], ssd_conv_b[i], ssd_dt_bias[i],
                        ssd_a_log[i], ssd_d[i], ssd_norm_g[i]).astype(x.dtype)
        gm = jax.nn.sigmoid(g_merge).reshape(bsz, T, N_BRANCHES, D_MODEL)
        merged = gm[:, :, 0] * y_a + gm[:, :, 1] * y_b + gm[:, :, 2] * y_c
        x = x + (merged @ w_o[i]).astype(x.dtype)
        h = rms_norm(x, g_mlp[i])
        x = x + (jnp.square(jax.nn.relu(h @ w_up[i])) @ w_down[i]).astype(x.dtype)
        gate = jax.nn.sigmoid(rms_norm(x, g_ple[i]) @ w_ple_gate[i])
        x = x + ((p[i] @ w_ple[i]) * gate).astype(x.dtype)
    return rms_norm(x, g_final)
```

```cpp
#include <hip/hip_runtime.h>
#include <cstdio>
#include <cstdint>
namespace pg8 {
#define PG8_LAS __attribute__((address_space(3)))
typedef unsigned short bf16_t;
typedef short bf16x8 __attribute__((ext_vector_type(8)));
typedef float f32x4 __attribute__((ext_vector_type(4)));
typedef unsigned u32x4 __attribute__((ext_vector_type(4)));
constexpr int BM = 256, BK = 64, HALF = 128, HTB = HALF * BK * 2  , STAGE_BYTES = 8 * HTB, NXCD = 8, WGM = 8;

__host__ __device__ __forceinline__ int lds_byte(int r, int c) { const int st = (r >> 4) * 2 + (c >> 5), rr = r & 15, cc = c & 31, ob = rr * 64 + cc * 2; return st * 1024 + (ob ^ (((ob >> 9) & 1) << 5)); }
__host__ __device__ __forceinline__ void stage_rc(int b, int& R, int& C) { const int st = b / 1024, sb = b % 1024, swz = sb ^ (((sb >> 9) & 1) << 5); R = (st >> 1) * 16 + swz / 64; C = (st & 1) * 32 + (swz % 64) / 2; }
__host__ __device__ __forceinline__ int perm32(int rho) { const int n = rho >> 4, i = rho & 15; return 8 * (i >> 2) + 4 * n + (i & 3); }

struct Unit { int pm, pn; };
struct Gemm { const bf16_t* A; const bf16_t* Bt; int M, N, K; };

struct StaticOrder {
    int nM, nN, nwg, G, c;
    __host__ __device__ void init(int M, int N, int G_, int c_) { nM = M / BM; nN = N / BM; nwg = nM * nN; G = G_; c = c_; }
    __host__ __device__ bool next(int i, Unit& u) const {
        const long L = (long)i * G + c; if (L >= nwg) return false;
        int wgid = (int)L; { const int q = nwg / NXCD, r = nwg % NXCD, xcd = wgid % NXCD, off = wgid / NXCD; wgid = (xcd < r ? xcd * (q + 1) : r * (q + 1) + (xcd - r) * q) + off; }
        const int nig = WGM * nN, gid = wgid / nig, fm = gid * WGM, gsz = (nM - fm) < WGM ? (nM - fm) : WGM;
        u.pm = fm + ((wgid % nig) % gsz); u.pn = (wgid % nig) / gsz; return true;
    }
    __device__ __forceinline__ void a_ready(const Unit&) const {}
    __device__ __forceinline__ void done(const Unit&) const {}
};
__device__ __forceinline__ unsigned cvt_pk_bf16(float lo, float hi) { unsigned r; asm volatile("v_cvt_pk_bf16_f32 %0, %1, %2" : "=v"(r) : "v"(lo), "v"(hi)); return r; }
template <class Epi, class Sched, bool ALIGN_EPI = false, bool SP2 = false>
__device__ __forceinline__ void gemm_phase(PG8_LAS unsigned char* lds, const Gemm g, const Sched& S, const Epi& E, const int wave_idx  ) {
    int lane_l; asm volatile("v_mbcnt_lo_u32_b32 %0, -1, 0\n\tv_mbcnt_hi_u32_b32 %0, -1, %0" : "=v"(lane_l));
    const int wid = wave_idx, tid = wid * 64 + lane_l, lane = tid & 63, wr = wid >> 2, wc = wid & 3, fr = lane & 15, fq = lane >> 4;
    const int K = g.K, nt = K / BK;
    unsigned voffA[2], voffB[2];
#pragma unroll
    for (int i = 0; i < 2; ++i) { int R, C; stage_rc(tid * 16 + i * 8192, R, C); const int Rb = Epi::PERM ? ((R & ~31) + perm32(R & 31)) : R;
        voffA[i] = (unsigned)(R * K + C) * 2u; voffB[i] = (unsigned)(Rb * K + C) * 2u; }
    const size_t kstep = (size_t)(BK * 2);
    const size_t hstep = (size_t)HALF * K * 2;
    const size_t tstep = 2 * hstep;
    const unsigned ldsw = (unsigned)wid * 1024u;
    const int aoff = lds_byte(wr * 64 + fr, fq * 8), boff = lds_byte(wc * 32 + fr, fq * 8);
#define PG8_SA(b, h) (((b) * 2 + (h)) * HTB)
#define PG8_SB(b, h) ((4 + (b) * 2 + (h)) * HTB)
#define PG8_STAGE(bufoff, gbase, voff) do { _Pragma("unroll") for (int _i = 0; _i < 2; ++_i) \
        __builtin_amdgcn_global_load_lds((const unsigned*)((const char*)(gbase) + (voff)[_i]), (PG8_LAS unsigned*)(lds + (bufoff) + ldsw + _i * 8192), 16, 0, 0); } while (0)
#define PG8_LDA(dst, b, h) do { _Pragma("unroll") for (int m = 0; m < 4; ++m) _Pragma("unroll") for (int k = 0; k < 2; ++k) dst[m][k] = *(const PG8_LAS bf16x8*)(lds + PG8_SA(b, h) + aoff + m * 2048 + k * 1024); } while (0)
#define PG8_LDB(dst, b, h) do { _Pragma("unroll") for (int n = 0; n < 2; ++n) _Pragma("unroll") for (int k = 0; k < 2; ++k) dst[n][k] = *(const PG8_LAS bf16x8*)(lds + PG8_SB(b, h) + boff + n * 2048 + k * 1024); } while (0)
#define PG8_MMA(ai, bj, At, Bt) do { __builtin_amdgcn_s_setprio(1); _Pragma("unroll") for (int m = 0; m < 4; ++m) _Pragma("unroll") for (int n = 0; n < 2; ++n) _Pragma("unroll") for (int k = 0; k < 2; ++k) \
        acc[ai][bj][m][n] = __builtin_amdgcn_mfma_f32_16x16x32_bf16(Bt[n][k], At[m][k], acc[ai][bj][m][n], 0, 0, 0); __builtin_amdgcn_s_setprio(0); } while (0)
#define PG8_WAIT_V(n) asm volatile("s_waitcnt vmcnt(" #n ")" ::: "memory")
#define PG8_WAIT_L(n) asm volatile("s_waitcnt lgkmcnt(" #n ")" ::: "memory")
#define PG8_BAR __builtin_amdgcn_s_barrier()
#define PG8_SCHED __builtin_amdgcn_sched_barrier(0)
    Unit cur, nxt; int ui = 0;
    if (!S.next(0, cur)) return;
    f32x4 acc[2][2][4][2];
#pragma unroll
    for (int a = 0; a < 2; ++a)
#pragma unroll
        for (int b = 0; b < 2; ++b)
#pragma unroll
            for (int m = 0; m < 4; ++m)
#pragma unroll
                for (int n = 0; n < 2; ++n) acc[a][b][m][n] = (f32x4){0.f, 0.f, 0.f, 0.f};
    bf16x8 At[4][2], B0[2][2], B1[2][2];
    const char* cA = (const char*)g.A + (size_t)cur.pm * tstep; const char* cB = (const char*)g.Bt + (size_t)cur.pn * tstep;
    S.a_ready(cur);
    if constexpr (SP2) {
        PG8_STAGE(PG8_SB(0, 0), cB, voffB); PG8_STAGE(PG8_SB(0, 1), cB + hstep, voffB); PG8_STAGE(PG8_SA(0, 0), cA, voffA); PG8_STAGE(PG8_SA(0, 1), cA + hstep, voffA);
        if (wr == 1) PG8_BAR;
        PG8_WAIT_V(2); PG8_BAR;
        PG8_STAGE(PG8_SB(1, 0), cB + kstep, voffB); PG8_STAGE(PG8_SA(1, 0), cA + kstep, voffA); PG8_STAGE(PG8_SB(1, 1), cB + hstep + kstep, voffB);
        PG8_WAIT_V(6); PG8_BAR;
    } else {
        PG8_STAGE(PG8_SB(0, 0), cB, voffB); PG8_STAGE(PG8_SA(0, 0), cA, voffA); PG8_STAGE(PG8_SB(0, 1), cB + hstep, voffB); PG8_STAGE(PG8_SA(0, 1), cA + hstep, voffA);
        if (wr == 1) PG8_BAR;
        PG8_WAIT_V(4); PG8_BAR;
        PG8_STAGE(PG8_SB(1, 0), cB + kstep, voffB); PG8_STAGE(PG8_SA(1, 0), cA + kstep, voffA); PG8_STAGE(PG8_SB(1, 1), cB + hstep + kstep, voffB);
        PG8_WAIT_V(6); PG8_BAR;
    }
    for (;;) {
        const bool has_next = S.next(ui + 1, nxt);
        const char* nA = has_next ? (const char*)g.A + (size_t)nxt.pm * tstep : cA; const char* nB = has_next ? (const char*)g.Bt + (size_t)nxt.pn * tstep : cB;
        for (int t = 0; t < nt; t += 2) {
            const bool last = (t == nt - 2);
            const char* a1 = cA + (size_t)(t + 1) * kstep;
            const char* a2 = last ? nA : cA + (size_t)(t + 2) * kstep; const char* b2 = last ? nB : cB + (size_t)(t + 2) * kstep;
            const char* a3 = a2 + kstep; const char* b3 = b2 + kstep;
            if (last && has_next) S.a_ready(nxt);
            if constexpr (SP2) {
            PG8_LDB(B0, 0, 0); PG8_LDB(B1, 0, 1); PG8_SCHED; PG8_LDA(At, 0, 0); PG8_STAGE(PG8_SA(1, 1), a1 + hstep, voffA);
            PG8_WAIT_V(8); PG8_WAIT_L(0); PG8_BAR; PG8_MMA(0, 0, At, B0); PG8_MMA(0, 1, At, B1); PG8_BAR; PG8_SCHED;
            PG8_LDA(At, 0, 1); PG8_STAGE(PG8_SB(0, 0), b2, voffB); PG8_STAGE(PG8_SB(0, 1), b2 + hstep, voffB); PG8_STAGE(PG8_SA(0, 0), a2, voffA);
            PG8_WAIT_V(8); PG8_WAIT_L(0); PG8_BAR; PG8_MMA(1, 0, At, B0); PG8_MMA(1, 1, At, B1); PG8_BAR; PG8_SCHED;
            PG8_LDB(B0, 1, 0); PG8_LDB(B1, 1, 1); PG8_SCHED; PG8_LDA(At, 1, 0); PG8_STAGE(PG8_SA(0, 1), a2 + hstep, voffA);
            PG8_WAIT_V(8); PG8_WAIT_L(0); PG8_BAR; PG8_MMA(0, 0, At, B0); PG8_MMA(0, 1, At, B1); PG8_BAR; PG8_SCHED;
            PG8_LDA(At, 1, 1); PG8_STAGE(PG8_SB(1, 0), b3, voffB); PG8_STAGE(PG8_SB(1, 1), b3 + hstep, voffB); PG8_STAGE(PG8_SA(1, 0), a3, voffA);
            PG8_WAIT_V(8); PG8_WAIT_L(0); PG8_BAR; PG8_MMA(1, 0, At, B0); PG8_MMA(1, 1, At, B1); PG8_BAR; PG8_SCHED;
            } else {
            PG8_LDB(B0, 0, 0); PG8_SCHED; PG8_LDA(At, 0, 0); PG8_STAGE(PG8_SA(1, 1), a1 + hstep, voffA);
            PG8_WAIT_L(8); PG8_BAR; PG8_WAIT_L(0); PG8_MMA(0, 0, At, B0); PG8_BAR; PG8_SCHED;
            PG8_LDB(B1, 0, 1); PG8_STAGE(PG8_SB(0, 0), b2, voffB);
            PG8_BAR; PG8_WAIT_L(0); PG8_MMA(0, 1, At, B1); PG8_BAR;
            PG8_LDA(At, 0, 1); PG8_STAGE(PG8_SA(0, 0), a2, voffA);
            PG8_BAR; PG8_WAIT_L(0); PG8_MMA(1, 0, At, B0); PG8_BAR; PG8_SCHED;
            PG8_STAGE(PG8_SB(0, 1), b2 + hstep, voffB);
            PG8_WAIT_V(6); PG8_BAR; PG8_MMA(1, 1, At, B1); PG8_BAR;
            PG8_LDB(B0, 1, 0); PG8_SCHED; PG8_LDA(At, 1, 0); PG8_STAGE(PG8_SA(0, 1), a2 + hstep, voffA);
            PG8_WAIT_L(8); PG8_BAR; PG8_WAIT_L(0); PG8_MMA(0, 0, At, B0); PG8_BAR; PG8_SCHED;
            PG8_LDB(B1, 1, 1); PG8_STAGE(PG8_SB(1, 0), b3, voffB);
            PG8_BAR; PG8_WAIT_L(0); PG8_MMA(0, 1, At, B1); PG8_BAR;
            PG8_LDA(At, 1, 1); PG8_STAGE(PG8_SA(1, 0), a3, voffA);
            PG8_BAR; PG8_WAIT_L(0); PG8_MMA(1, 0, At, B0); PG8_BAR; PG8_SCHED;
            PG8_STAGE(PG8_SB(1, 1), b3 + hstep, voffB);
            PG8_WAIT_V(6); PG8_BAR; PG8_MMA(1, 1, At, B1); PG8_BAR;
            }
        }
        if constexpr (ALIGN_EPI) { if (wr == 0) PG8_BAR; }
        if constexpr (!Epi::AFTER_DRAIN) { E(acc, cur, wr, wc, fr, fq); S.done(cur); }
        if (!has_next) break;
#pragma unroll
        for (int a = 0; a < 2; ++a)
#pragma unroll
            for (int b = 0; b < 2; ++b)
#pragma unroll
                for (int m = 0; m < 4; ++m)
#pragma unroll
                    for (int n = 0; n < 2; ++n) acc[a][b][m][n] = (f32x4){0.f, 0.f, 0.f, 0.f};
        cur = nxt; cA = nA; cB = nB; ++ui;
        if constexpr (ALIGN_EPI) { if (wr == 1) PG8_BAR; }
    }
    PG8_WAIT_V(0);
    if constexpr (!ALIGN_EPI) { if (wr == 0) PG8_BAR; }
    PG8_BAR;
    if constexpr (Epi::AFTER_DRAIN) { E.fused(acc, cur, wr, wc, fr, fq, lds, wid, lane); S.done(cur); }
#undef PG8_SA
#undef PG8_SB
#undef PG8_STAGE
#undef PG8_LDA
#undef PG8_LDB
#undef PG8_MMA
#undef PG8_WAIT_V
#undef PG8_WAIT_L
#undef PG8_BAR
#undef PG8_SCHED
}
}

constexpr int BATCH = 2, SEQ = 8192, DM = 2048, DEPTH = 4;
constexpr int M = BATCH * SEQ;
constexpr int NH = 16, HD = 128, NG = 4, RH = 4;
constexpr int NCMP = 511, NCMP_PAD = 512, NSLC = 128, NSEL = 16, WIN = 512;
constexpr int SSD_H = 32, SSD_P = 64, SSD_N = 128, SSD_G = 4, SSD_CH = 128, SSD_NC = 64, SSD_XBC = 3072;
constexpr int DFF = 8192, PLE = 256;
constexpr float EPS = 1e-6f;
constexpr int PROJ_SRC = 22608;
constexpr int C_Q = 0, C_KC = 2048, C_VC = 2560, C_KS = 3072, C_VS = 3584, C_KW = 4096, C_VW = 4608;
constexpr int C_CB = 5120, C_CC = 7168, C_CU = 9216, C_Z = 11264, C_XBC = 13312, C_GM = 16384, C_GN = 22528, C_DT = 22592;
constexpr int LDP = 22784;
constexpr int S_GN = 5120, S_DT = 16432;

constexpr size_t MiB = 1u << 20;
constexpr size_t WS_CTL = 0, CTL_ZERO_BYTES = 1 * MiB;
constexpr size_t WS_ROPE = 1 * MiB;
constexpr size_t WS_MISC = 9 * MiB;
constexpr size_t WS_DT = 10 * MiB;
constexpr size_t WS_ACS = 12 * MiB;
constexpr size_t WS_CDEC = 14 * MiB;
constexpr size_t WS_KCMP = 15 * MiB;
constexpr size_t WS_VCMP = 16 * MiB;
constexpr size_t WS_X = 32 * MiB;
constexpr size_t WS_HB = 160 * MiB;
constexpr size_t WS_PB = 224 * MiB;
constexpr size_t WS_EB = 256 * MiB;
constexpr size_t WS_YA = 320 * MiB;
constexpr size_t WS_YC = 384 * MiB;
constexpr size_t WS_XBC = 448 * MiB;
constexpr size_t WS_ST = 544 * MiB;
constexpr size_t WS_PROJ = 672 * MiB;
constexpr size_t WS_U = WS_PROJ;
constexpr size_t WS_W = 1384 * MiB;
constexpr size_t LW_IN = 0;
constexpr size_t LW_O = 89 * MiB;
constexpr size_t LW_UP = 97 * MiB;
constexpr size_t LW_DOWN = 129 * MiB;
constexpr size_t LW_PG = 161 * MiB;
constexpr size_t LW_PLE = 169 * MiB;
constexpr size_t LW_PK1 = 170 * MiB;
constexpr size_t LW_PV1 = 171 * MiB;
constexpr size_t LW_PK2 = 172 * MiB;
constexpr size_t LW_PV2 = 172 * MiB + 64 * 1024;
constexpr size_t LW_STRIDE = 173 * MiB;
constexpr size_t WS_END = WS_W + 4 * LW_STRIDE;
static_assert((size_t)M * LDP * 2 <= 712 * MiB && (size_t)LDP * 2048 * 2 <= 89 * MiB, "ws map");

constexpr int CW_BAR = 4096;
constexpr int CW_CHK = 16384;

constexpr int RING_BYTES = 131072;
constexpr int LX_OFF = RING_BYTES;
constexpr int LX_BYTES = 8192;
constexpr int LDSCTL_OFF = LX_OFF + LX_BYTES;
constexpr int LDS_BYTES = LDSCTL_OFF + 256;
constexpr int NWAVES = 8, NTHR = 512;

#define DI __device__ __forceinline__
#define GAS __attribute__((address_space(1)))
#define LAS __attribute__((address_space(3)))
typedef unsigned short bf16;
typedef unsigned u32x4 __attribute__((ext_vector_type(4)));
typedef unsigned u32x2 __attribute__((ext_vector_type(2)));
typedef float f32x4 __attribute__((ext_vector_type(4)));
typedef float f32x2 __attribute__((ext_vector_type(2)));
typedef short bf16x8 __attribute__((ext_vector_type(8)));
typedef short s16x4 __attribute__((ext_vector_type(4)));
typedef GAS unsigned gu32;
#define RLX_AGENT __ATOMIC_RELAXED, __HIP_MEMORY_SCOPE_AGENT
#define LDS_WAIT() asm volatile("s_waitcnt lgkmcnt(0)" ::: "memory")
#define VM_WAIT() asm volatile("s_waitcnt vmcnt(0)" ::: "memory")
DI unsigned f2bf(float f) { unsigned u = __builtin_bit_cast(unsigned, f); return (u + 0x7fffu + ((u >> 16) & 1u)) >> 16; }
DI unsigned pk2(float lo, float hi) { return pg8::cvt_pk_bf16(lo, hi); }
DI float bf2f(unsigned h) { return __builtin_bit_cast(float, h << 16); }
DI float bflo(unsigned w) { return __builtin_bit_cast(float, w << 16); }
DI float bfhi(unsigned w) { return __builtin_bit_cast(float, w & 0xffff0000u); }
DI float sigmoidf_(float x) { return 1.0f / (1.0f + __expf(-x)); }
DI float siluf_(float x) { return x / (1.0f + __expf(-x)); }
DI float shfl_idx(float v, int src) { return __builtin_bit_cast(float, __builtin_amdgcn_ds_bpermute(src << 2, __builtin_bit_cast(int, v))); }
DI unsigned shfl_idx_u(unsigned v, int src) { return (unsigned)__builtin_amdgcn_ds_bpermute(src << 2, (int)v); }
DI float shx(float v, int m, int lane) { return shfl_idx(v, lane ^ m); }
DI float wave_sum(float v, int lane) {
#pragma unroll
    for (int o = 1; o < 64; o <<= 1) v += shx(v, o, lane);
    return v;
}
DI unsigned off_b(unsigned row, unsigned ch) { return 256u * row + 16u * (ch ^ (((row & 3u) << 2) | ((row >> 2) & 3u))); }
DI unsigned tr_addr(unsigned lane, unsigned r0, unsigned c, unsigned t) {
    const unsigned g = lane >> 4, q = (lane & 15u) >> 2, p = lane & 3u;
    return off_b(r0 + 8u * g + 4u * t + q, 2u * c + (p >> 1)) + 8u * (p & 1u);
}
DI s16x4 tr_read(LAS const unsigned char* p) { return __builtin_amdgcn_ds_read_tr16_b64_v4i16((LAS s16x4*)p); }
DI bf16x8 tr_read8(LAS const unsigned char* base, unsigned lane, unsigned r0, unsigned c) {
    const s16x4 lo = tr_read(base + tr_addr(lane, r0, c, 0)), hi = tr_read(base + tr_addr(lane, r0, c, 1));
    return __builtin_shufflevector(lo, hi, 0, 1, 2, 3, 4, 5, 6, 7);
}
DI bf16x8 lds_rd8(LAS const unsigned char* p) { return *(const LAS bf16x8*)p; }
DI bf16x8 as_bf16x8(u32x4 v) { return __builtin_bit_cast(bf16x8, v); }
#define MFMA16(a, b, c) __builtin_amdgcn_mfma_f32_16x16x32_bf16((a), (b), (c), 0, 0, 0)

namespace pg8 {
template <int MODE> struct EpiB {
    static constexpr bool PERM = true, AFTER_DRAIN = false;
    bf16_t* O; int ldc; const float* rope;
    __device__ __forceinline__ void operator()(const f32x4 (&acc)[2][2][4][2], const Unit& u, int wr, int wc, int fr, int fq) const {
        { int l; asm volatile("v_mbcnt_lo_u32_b32 %0, -1, 0\n\tv_mbcnt_hi_u32_b32 %0, -1, %0" : "=v"(l)); fr = l & 15; fq = l >> 4; }
        const int row0 = u.pm * BM + wr * 64 + fr;
        bool rp = false;
        if (MODE == 2) { const int pn = u.pn; rp = (pn < 10) || pn == 12 || pn == 13 || pn == 16 || pn == 17; }
        if (MODE == 2 && rp) {
            const int colb = u.pn * BM + 128 * (wc >> 1) + 32 * (wc & 1) + 8 * fq, jj0 = 32 * (wc & 1) + 8 * fq;
#pragma unroll
            for (int ai = 0; ai < 2; ++ai)
#pragma unroll
                for (int m = 0; m < 4; ++m) {
                    const int row = row0 + ai * HALF + m * 16;
                    const float* rpp = (const float*)((const char*)rope + (unsigned)(((unsigned)row * 64u + (unsigned)jj0) * 8u));
                    const f32x4 cs0 = *(const f32x4*)(rpp), cs1 = *(const f32x4*)(rpp + 4), cs2 = *(const f32x4*)(rpp + 8), cs3 = *(const f32x4*)(rpp + 12);
                    const f32x4 x1a = acc[ai][0][m][0], x1b = acc[ai][0][m][1], x2a = acc[ai][1][m][0], x2b = acc[ai][1][m][1];
                    float c[8] = {cs0[0], cs0[2], cs1[0], cs1[2], cs2[0], cs2[2], cs3[0], cs3[2]};
                    float s[8] = {cs0[1], cs0[3], cs1[1], cs1[3], cs2[1], cs2[3], cs3[1], cs3[3]};
                    float x1[8] = {x1a[0], x1a[1], x1a[2], x1a[3], x1b[0], x1b[1], x1b[2], x1b[3]};
                    float x2[8] = {x2a[0], x2a[1], x2a[2], x2a[3], x2b[0], x2b[1], x2b[2], x2b[3]};
                    float o1[8], o2[8];
#pragma unroll
                    for (int k = 0; k < 8; ++k) { o1[k] = x1[k] * c[k] - x2[k] * s[k]; o2[k] = x2[k] * c[k] + x1[k] * s[k]; }
                    u32x4 w1, w2;
                    w1.x = cvt_pk_bf16(o1[0], o1[1]); w1.y = cvt_pk_bf16(o1[2], o1[3]); w1.z = cvt_pk_bf16(o1[4], o1[5]); w1.w = cvt_pk_bf16(o1[6], o1[7]);
                    w2.x = cvt_pk_bf16(o2[0], o2[1]); w2.y = cvt_pk_bf16(o2[2], o2[3]); w2.z = cvt_pk_bf16(o2[4], o2[5]); w2.w = cvt_pk_bf16(o2[6], o2[7]);
                    bf16_t* rowp = (bf16_t*)((char*)O + (unsigned)(((unsigned)row * (unsigned)ldc + (unsigned)colb) * 2u));
                    *(u32x4*)(rowp) = w1; *(u32x4*)(rowp + 64) = w2;
                    asm volatile("" ::: "memory");
                }
        } else {
            const int col0 = u.pn * BM + wc * 32 + 8 * fq;
#pragma unroll
            for (int ai = 0; ai < 2; ++ai)
#pragma unroll
                for (int m = 0; m < 4; ++m) { bf16_t* rowp = (bf16_t*)((char*)O + (unsigned)(((unsigned)(row0 + ai * HALF + m * 16) * (unsigned)ldc + (unsigned)col0) * 2u));
#pragma unroll
                    for (int bj = 0; bj < 2; ++bj) { f32x4 v0 = acc[ai][bj][m][0], v1 = acc[ai][bj][m][1];
                        if (MODE == 1) {
#pragma unroll
                            for (int k = 0; k < 4; ++k) { const float a = fmaxf(v0[k], 0.f), b = fmaxf(v1[k], 0.f); v0[k] = a * a; v1[k] = b * b; } }
                        u32x4 w; w.x = cvt_pk_bf16(v0[0], v0[1]); w.y = cvt_pk_bf16(v0[2], v0[3]); w.z = cvt_pk_bf16(v1[0], v1[1]); w.w = cvt_pk_bf16(v1[2], v1[3]);
                        *(u32x4*)(rowp + bj * HALF) = w; } }
        }
    }
};
template <bool GATE> struct EpiRes {
    static constexpr bool PERM = false, AFTER_DRAIN = false;
    const float* xin; float* xout; int ldc; const bf16_t* e;
    __device__ __forceinline__ void operator()(const f32x4 (&acc)[2][2][4][2], const Unit& u, int wr, int wc, int fr, int fq) const {
        { int l; asm volatile("v_mbcnt_lo_u32_b32 %0, -1, 0\n\tv_mbcnt_hi_u32_b32 %0, -1, %0" : "=v"(l)); fr = l & 15; fq = l >> 4; }
        const int row0 = u.pm * BM + wr * 64 + fr, col0 = u.pn * BM + wc * 32 + 4 * fq;
#pragma unroll
        for (int ai = 0; ai < 2; ++ai)
#pragma unroll
            for (int m = 0; m < 4; ++m) { const unsigned off = (unsigned)(row0 + ai * HALF + m * 16) * (unsigned)ldc + (unsigned)col0;
#pragma unroll
                for (int bj = 0; bj < 2; ++bj)
#pragma unroll
                    for (int n = 0; n < 2; ++n) { const unsigned o = off + bj * HALF + n * 16; const f32x4 xv = *(const f32x4*)((const char*)xin + (unsigned)(o * 4u)); f32x4 a = acc[ai][bj][m][n];
                        if (GATE) { typedef unsigned u32x2v __attribute__((ext_vector_type(2))); const u32x2v ev = *(const u32x2v*)((const char*)e + (unsigned)(o * 2u));
                            const float e0 = __builtin_bit_cast(float, ev.x << 16), e1 = __builtin_bit_cast(float, ev.x & 0xffff0000u), e2 = __builtin_bit_cast(float, ev.y << 16), e3 = __builtin_bit_cast(float, ev.y & 0xffff0000u);
                            a[0] = e0 / (1.0f + __expf(-a[0])); a[1] = e1 / (1.0f + __expf(-a[1])); a[2] = e2 / (1.0f + __expf(-a[2])); a[3] = e3 / (1.0f + __expf(-a[3])); }
                        *(f32x4*)((char*)xout + (unsigned)(o * 4u)) = xv + a; }
                asm volatile("" ::: "memory"); }
    }
};
}
#define XB_TMO      128
#define XB_XCNT(j)  (256  + 64 * (j))
#define XB_XSUB(j)  (1280 + 64 * (j))
#define XB_XGEN(j)  (2304 + 64 * (j))
#define XB_TOP      3328
#define XB_TOPGEN   3392
#define XCD_BAR_WORDS 3456
#define XB_SPIN_CAP (1u << 18)

__device__ __forceinline__ unsigned xb_ld(unsigned* p)              { return __hip_atomic_load(p, __ATOMIC_RELAXED, __HIP_MEMORY_SCOPE_AGENT); }
__device__ __forceinline__ unsigned xb_add(unsigned* p, unsigned v) { return __hip_atomic_fetch_add(p, v, __ATOMIC_RELAXED, __HIP_MEMORY_SCOPE_AGENT); }
__device__ __forceinline__ unsigned xb_xcc_id() { return (unsigned)__builtin_amdgcn_s_getreg((3 << 11) | 20) & 0xFu; }
#define XB_SPIN(cond, bar) do { unsigned _sp = 0; while (cond) { __builtin_amdgcn_s_sleep(1); \
    if ((++_sp & 255u) == 0u) { if (xb_ld(&(bar)[XB_TMO])) break; if (_sp > XB_SPIN_CAP) { atomicAdd(&(bar)[XB_TMO], 1u); break; } } } } while (0)

struct XcdBarrier {
    unsigned* bar; unsigned x;
    volatile LAS unsigned* st;
};

__device__ __forceinline__ XcdBarrier xcd_barrier_post(unsigned* bar, volatile LAS unsigned* st) {
    XcdBarrier b; b.bar = bar; b.x = xb_xcc_id(); b.st = st;
    if (threadIdx.x == 0) (void)xb_add(&bar[XB_XCNT(b.x)], 1u);
    return b;
}
__device__ __forceinline__ void xcd_barrier_complete(unsigned* bar, unsigned x, unsigned& nloc, unsigned& nx) {
    const unsigned G = gridDim.x * gridDim.y * gridDim.z;
    unsigned sum, cnt, mine, sp = 0u;
    for (;;) {
        sum = 0u; cnt = 0u; mine = 0u;
#pragma unroll
        for (unsigned j = 0; j < 16; ++j) { const unsigned c = xb_ld(&bar[XB_XCNT(j)]); sum += c; cnt += (c > 0u) ? 1u : 0u; mine = (j == x) ? c : mine; }
        if (sum == G) break;
        __builtin_amdgcn_s_sleep(1);
        if ((++sp & 255u) == 0u) { if (xb_ld(&bar[XB_TMO])) break; if (sp > XB_SPIN_CAP) { atomicAdd(&bar[XB_TMO], 1u); break; } }
    }
    nloc = mine > 0u ? mine : 1u; nx = cnt > 0u ? cnt : 1u;
}

__device__ __forceinline__ void xcd_barrier(const XcdBarrier& b) {
    asm volatile("s_waitcnt vmcnt(0)" ::: "memory");
    __syncthreads();
    if (threadIdx.x == 0) {
        unsigned* bar = b.bar;
        __builtin_amdgcn_s_waitcnt(0);
        unsigned nloc = b.st[0], nx = b.st[1];
        if (nloc == 0u) { xcd_barrier_complete(bar, b.x, nloc, nx); b.st[0] = nloc; b.st[1] = nx; }
        const unsigned old = xb_add(&bar[XB_XSUB(b.x)], 1u);
        const unsigned gen = old / nloc;
        if (old + 1u == (gen + 1u) * nloc) {
            __builtin_amdgcn_fence(__ATOMIC_RELEASE, "agent");
            asm volatile("s_waitcnt vmcnt(0)" ::: "memory");
            const unsigned og = xb_add(&bar[XB_TOP], 1u);
            const unsigned tg = og / nx;
            if (og + 1u == (tg + 1u) * nx) xb_add(&bar[XB_TOPGEN], 1u);
            else XB_SPIN(xb_ld(&bar[XB_TOPGEN]) == tg, bar);
            __builtin_amdgcn_fence(__ATOMIC_ACQUIRE, "agent");
            xb_add(&bar[XB_XGEN(b.x)], 1u);
            asm volatile("s_waitcnt vmcnt(0)" ::: "memory");
        } else {
            XB_SPIN(xb_ld(&bar[XB_XGEN(b.x)]) == gen, bar);
            __builtin_amdgcn_fence(__ATOMIC_ACQUIRE, "agent");
            asm volatile("s_waitcnt vmcnt(0)" ::: "memory");
        }
    }
    __syncthreads();
}

struct Args { const void* in[30]; float* out; unsigned char* ws; int ph_lo, ph_hi; };
struct Frame {
    LAS unsigned char* lds;
    gu32* ctl;
    unsigned char* ws;
    int tid, lane, wave, G, bid;
};
DI const void* argin(const Args&, int k) {
    typedef const void* const __attribute__((address_space(4)))* kptr_t;
    kptr_t p = (kptr_t)__builtin_amdgcn_kernarg_segment_ptr(); asm volatile("" : "+s"(p));
    return (const void*)p[k]; }
DI int launder_s(int x) { asm volatile("" : "+s"(x)); return x; }
DI Frame phase_frame(const Frame& F0) { Frame F = F0;
    int l; asm volatile("v_mbcnt_lo_u32_b32 %0, -1, 0\n\tv_mbcnt_hi_u32_b32 %0, -1, %0" : "=v"(l));
    F.wave = launder_s(F0.wave); F.bid = launder_s(F0.bid); F.G = launder_s(F0.G);
    F.lane = l; F.tid = F.wave * 64 + l;
    { unsigned long long wsb = (unsigned long long)F0.ws; asm volatile("" : "+s"(wsb)); F.ws = (unsigned char*)wsb; }
    { unsigned ll = (unsigned)(size_t)F0.lds; asm volatile("" : "+s"(ll)); F.lds = (LAS unsigned char*)(size_t)ll; }
    return F; }
DI unsigned char* lw_ptr(const Frame& F, int layer, size_t off) { return F.ws + WS_W + (size_t)layer * LW_STRIDE + off; }

DI void transpose_item(const float* W, int K, int Nsrc, int nsrc0, bf16* WT, int dst_row0, int k0, LAS float* scr, int lane) {
#pragma unroll 8
    for (int i = 0; i < 32; ++i) { const int kk = 2 * i + (lane >> 5); scr[kk * 33 + (lane & 31)] = W[(size_t)(k0 + kk) * Nsrc + nsrc0 + (lane & 31)]; }
    LDS_WAIT(); asm volatile("" ::: "memory");
    const int c = lane & 7;
#pragma unroll
    for (int j = 0; j < 4; ++j) { const int n = (lane >> 3) + 8 * j; const LAS float* s = scr + (8 * c) * 33 + n;
        u32x4 o; o.x = pk2(s[0 * 33], s[1 * 33]); o.y = pk2(s[2 * 33], s[3 * 33]); o.z = pk2(s[4 * 33], s[5 * 33]); o.w = pk2(s[6 * 33], s[7 * 33]);
        *(u32x4*)(WT + (size_t)(dst_row0 + n) * K + k0 + 8 * c) = o; }
    LDS_WAIT(); asm volatile("" ::: "memory");
}
DI int proj_src_col(int d) {
    if (d < 5120) {
        const int pn = d >> 8; const bool rp = (pn < 10) || pn == 12 || pn == 13 || pn == 16 || pn == 17;
        if (!rp) return d;
        const int c = d & 255, bj = c >> 7, wc = (c >> 5) & 3;
        return (pn << 8) + 128 * (wc >> 1) + 64 * bj + 32 * (wc & 1);
    }
    if (d < 16384) return d + 48;
    if (d < 22528) return d + 80;
    if (d < 22592) return S_GN + (d - 22528);
    if (d < 22624) return S_DT + (d - 22592);
    return 0;
}
constexpr int TI_IN = 32 * 712, TI_O = 32 * 64, TI_UP = 32 * 256, TI_DOWN = 128 * 64, TI_PG = 32 * 64, TI_PLE = 4 * 64, TI_P1 = 64 * 4, TI_P2 = 2 * 4;
constexpr int TI_LAYER = TI_IN + TI_O + TI_UP + TI_DOWN + TI_PG + TI_PLE + 2 * TI_P1 + 2 * TI_P2;

DI void p0_prologue(const Frame& F0, const Args& A) {
    const Frame F = phase_frame(F0);
    LAS float* scr = (LAS float*)(F.lds + F.wave * 16384);
    const int gw = F.bid * NWAVES + F.wave, NGW = F.G * NWAVES;
    for (int it = gw; it < DEPTH * TI_LAYER; it += NGW) {
        const int layer = it / TI_LAYER; int r = it - layer * TI_LAYER;
        if (r < TI_IN) { const int kb = r / 712, nb = r - kb * 712;
            transpose_item((const float*)argin(A, 4) + (size_t)layer * DM * PROJ_SRC, DM, PROJ_SRC, proj_src_col(nb * 32), (bf16*)lw_ptr(F, layer, LW_IN), nb * 32, kb * 64, scr, F.lane); continue; } r -= TI_IN;
        if (r < TI_O) { const int kb = r / 64, nb = r % 64;
            transpose_item((const float*)argin(A, 22) + (size_t)layer * DM * DM, DM, DM, nb * 32, (bf16*)lw_ptr(F, layer, LW_O), nb * 32, kb * 64, scr, F.lane); continue; } r -= TI_O;
        if (r < TI_UP) { const int kb = r / 256, nb = r % 256;
            transpose_item((const float*)argin(A, 24) + (size_t)layer * DM * DFF, DM, DFF, nb * 32, (bf16*)lw_ptr(F, layer, LW_UP), nb * 32, kb * 64, scr, F.lane); continue; } r -= TI_UP;
        if (r < TI_DOWN) { const int kb = r / 64, nb = r % 64;
            transpose_item((const float*)argin(A, 25) + (size_t)layer * DFF * DM, DFF, DM, nb * 32, (bf16*)lw_ptr(F, layer, LW_DOWN), nb * 32, kb * 64, scr, F.lane); continue; } r -= TI_DOWN;
        if (r < TI_PG) { const int kb = r / 64, nb = r % 64;
            transpose_item((const float*)argin(A, 28) + (size_t)layer * DM * DM, DM, DM, nb * 32, (bf16*)lw_ptr(F, layer, LW_PG), nb * 32, kb * 64, scr, F.lane); continue; } r -= TI_PG;
        if (r < TI_PLE) { const int kb = r / 64, nb = r % 64;
            transpose_item((const float*)argin(A, 27) + (size_t)layer * PLE * DM, PLE, DM, nb * 32, (bf16*)lw_ptr(F, layer, LW_PLE), nb * 32, kb * 64, scr, F.lane); continue; } r -= TI_PLE;
        if (r < TI_P1) { const int kb = r / 4, nb = r % 4;
            transpose_item((const float*)argin(A, 7) + (size_t)layer * 4096 * 128, 4096, 128, nb * 32, (bf16*)lw_ptr(F, layer, LW_PK1), nb * 32, kb * 64, scr, F.lane); continue; } r -= TI_P1;
        if (r < TI_P1) { const int kb = r / 4, nb = r % 4;
            transpose_item((const float*)argin(A, 11) + (size_t)layer * 4096 * 128, 4096, 128, nb * 32, (bf16*)lw_ptr(F, layer, LW_PV1), nb * 32, kb * 64, scr, F.lane); continue; } r -= TI_P1;
        if (r < TI_P2) { const int kb = r / 4, nb = r % 4;
            transpose_item((const float*)argin(A, 9) + (size_t)layer * 128 * 128, 128, 128, nb * 32, (bf16*)lw_ptr(F, layer, LW_PK2), nb * 32, kb * 64, scr, F.lane); continue; } r -= TI_P2;
        { const int kb = r / 4, nb = r % 4;
            transpose_item((const float*)argin(A, 13) + (size_t)layer * 128 * 128, 128, 128, nb * 32, (bf16*)lw_ptr(F, layer, LW_PV2), nb * 32, kb * 64, scr, F.lane); }
    }
    const size_t gt = (size_t)F.bid * NTHR + F.tid, NGT = (size_t)F.G * NTHR;
    { const float* p = (const float*)argin(A, 1); bf16* pb = (bf16*)(F.ws + WS_PB);
      for (size_t i = gt; i < (size_t)DEPTH * M * PLE / 8; i += NGT) { const f32x4 a = *(const f32x4*)(p + i * 8), b = *(const f32x4*)(p + i * 8 + 4);
          u32x4 o; o.x = pk2(a[0], a[1]); o.y = pk2(a[2], a[3]); o.z = pk2(b[0], b[1]); o.w = pk2(b[2], b[3]); *(u32x4*)(pb + i * 8) = o; } }
    { const int* pos = (const int*)argin(A, 2); float* rope = (float*)(F.ws + WS_ROPE);
      for (size_t i = gt; i < (size_t)M * 64; i += NGT) { const int row = (int)(i >> 6), jj = (int)(i & 63);
          const float inv = 1.0f / powf(10000.0f, (float)(2 * jj) * (1.0f / 128.0f));
          const float ang = (float)pos[row] * inv;
          double a = (double)ang; a -= 6.283185307179586476925 * __builtin_rint(a * 0.15915494309189533577);
          const float ar = (float)a;
          rope[i * 2] = cosf(ar); rope[i * 2 + 1] = sinf(ar); } }
    { float* part = (float*)(F.ws + WS_MISC);
      for (size_t i = gt; i < (size_t)DEPTH * 2 * 8 * 128; i += NGT) { const int hid = (int)(i & 127), c = (int)(i >> 7) & 7, kv = (int)(i >> 10) & 1, layer = (int)(i >> 11);
          const float* pe = (const float*)(kv ? A.in[6] : A.in[5]) + (size_t)layer * 4096 + c * 512;
          const float* w1 = (const float*)(kv ? A.in[11] : A.in[7]) + (size_t)layer * 4096 * 128 + (size_t)c * 512 * 128 + hid;
          float s = 0.f;
#pragma unroll 8
          for (int kk = 0; kk < 512; ++kk) s += pe[kk] * w1[(size_t)kk * 128];
          part[i] = s; } }
}

template <bool OUTF32> DI void norm_rows(const Frame& F0, const float* x, const float* g, void* outp) {
    const Frame F = phase_frame(F0);
    const int gw = F.bid * NWAVES + F.wave, NGW = F.G * NWAVES;
    for (int m = gw; m < M; m += NGW) {
        const f32x4* xr = (const f32x4*)(x + (size_t)m * DM) + F.lane;
        f32x4 v[8]; float s = 0.f;
#pragma unroll
        for (int j = 0; j < 8; ++j) { v[j] = xr[64 * j]; s += (v[j][0] * v[j][0] + v[j][1] * v[j][1]) + (v[j][2] * v[j][2] + v[j][3] * v[j][3]); }
        const float rstd = 1.0f / sqrtf(wave_sum(s, F.lane) * (1.0f / DM) + EPS);
#pragma unroll
        for (int j = 0; j < 8; ++j) { const f32x4 gv = ((const f32x4*)g)[F.lane + 64 * j]; const f32x4 o = v[j] * rstd * gv;
            if (OUTF32) ((f32x4*)((float*)outp + (size_t)m * DM))[F.lane + 64 * j] = o;
            else { u32x2 w; w.x = pk2(o[0], o[1]); w.y = pk2(o[2], o[3]); ((u32x2*)((bf16*)outp + (size_t)m * DM))[F.lane + 64 * j] = w; } }
    }
}
DI void unpack8(u32x4 w, float (&f)[8]) { f[0] = bflo(w.x); f[1] = bfhi(w.x); f[2] = bflo(w.y); f[3] = bfhi(w.y); f[4] = bflo(w.z); f[5] = bfhi(w.z); f[6] = bflo(w.w); f[7] = bfhi(w.w); }
DI u32x4 pack8f(const float (&f)[8]) { u32x4 o; o.x = pk2(f[0], f[1]); o.y = pk2(f[2], f[3]); o.z = pk2(f[4], f[5]); o.w = pk2(f[6], f[7]); return o; }

DI void ssd_conv_pass(const Frame& F0, const Args& A, int layer) {
    const Frame F = phase_frame(F0);
    const bf16* proj = (const bf16*)(F.ws + WS_PROJ); bf16* xbc = (bf16*)(F.ws + WS_XBC);
    const float* cw = (const float*)argin(A, 16) + (size_t)layer * 4 * SSD_XBC; const float* cb = (const float*)argin(A, 17) + (size_t)layer * SSD_XBC;
    const int gt = F.bid * NTHR + F.tid, NGT = F.G * NTHR;
    for (int task = gt; task < 512 * 384; task += NGT) {
        const int run = task / 384, cg = task - run * 384, ch = cg * 8, row0 = run * 32;
        float w[4][8], bs[8], xm3[8], xm2[8], xm1[8];
#pragma unroll
        for (int j = 0; j < 4; ++j) { const f32x4 a = *(const f32x4*)(cw + j * SSD_XBC + ch), b = *(const f32x4*)(cw + j * SSD_XBC + ch + 4);
            w[j][0] = a[0]; w[j][1] = a[1]; w[j][2] = a[2]; w[j][3] = a[3]; w[j][4] = b[0]; w[j][5] = b[1]; w[j][6] = b[2]; w[j][7] = b[3]; }
        { const f32x4 a = *(const f32x4*)(cb + ch), b = *(const f32x4*)(cb + ch + 4); bs[0] = a[0]; bs[1] = a[1]; bs[2] = a[2]; bs[3] = a[3]; bs[4] = b[0]; bs[5] = b[1]; bs[6] = b[2]; bs[7] = b[3]; }
        if ((row0 & (SEQ - 1)) != 0) {
            unpack8(*(const u32x4*)(proj + (size_t)(row0 - 3) * LDP + C_XBC + ch), xm3);
            unpack8(*(const u32x4*)(proj + (size_t)(row0 - 2) * LDP + C_XBC + ch), xm2);
            unpack8(*(const u32x4*)(proj + (size_t)(row0 - 1) * LDP + C_XBC + ch), xm1);
        } else {
#pragma unroll
            for (int k = 0; k < 8; ++k) { xm3[k] = 0.f; xm2[k] = 0.f; xm1[k] = 0.f; }
        }
#pragma unroll 4
        for (int r = 0; r < 32; ++r) {
            float cur[8], y[8]; unpack8(*(const u32x4*)(proj + (size_t)(row0 + r) * LDP + C_XBC + ch), cur);
#pragma unroll
            for (int k = 0; k < 8; ++k) { const float v = w[0][k] * xm3[k] + w[1][k] * xm2[k] + w[2][k] * xm1[k] + w[3][k] * cur[k] + bs[k]; y[k] = siluf_(v); xm3[k] = xm2[k]; xm2[k] = xm1[k]; xm1[k] = cur[k]; }
            *(u32x4*)(xbc + (size_t)(row0 + r) * SSD_XBC + ch) = pack8f(y);
            asm volatile("" ::: "memory");
        }
    }
    const float* dtb = (const float*)argin(A, 18) + layer * SSD_H; float* dt = (float*)(F.ws + WS_DT);
    for (int i = gt; i < M * SSD_H; i += NGT) { const int row = i >> 5, h = i & 31;
        const float x = bf2f(proj[(size_t)row * LDP + C_DT + h]) + dtb[h];
        dt[i] = fmaxf(x, 0.f) + log1pf(__expf(-fabsf(x))); }
}

DI void merge_pass(const Frame& F0, const Args& A, int layer) {
    const Frame F = phase_frame(F0);
    const bf16* proj = (const bf16*)(F.ws + WS_PROJ); const bf16* ya = (const bf16*)(F.ws + WS_YA); const bf16* yc = (const bf16*)(F.ws + WS_YC); bf16* hb = (bf16*)(F.ws + WS_HB);
    const float* sw = (const float*)argin(A, 15) + (size_t)layer * 3 * DM;
    const int gt = F.bid * NTHR + F.tid, NGT = F.G * NTHR;
    for (int task = gt; task < 512 * 256; task += NGT) {
        const int run = task >> 8, cg = task & 255, ch = cg * 8, row0 = run * 32;
        float w[3][8], pm2[8], pm1[8];
#pragma unroll
        for (int j = 0; j < 3; ++j) { const f32x4 a = *(const f32x4*)(sw + j * DM + ch), b = *(const f32x4*)(sw + j * DM + ch + 4);
            w[j][0] = a[0]; w[j][1] = a[1]; w[j][2] = a[2]; w[j][3] = a[3]; w[j][4] = b[0]; w[j][5] = b[1]; w[j][6] = b[2]; w[j][7] = b[3]; }
        if ((row0 & (SEQ - 1)) != 0) {
            float c1[8], u1[8];
            unpack8(*(const u32x4*)(proj + (size_t)(row0 - 2) * LDP + C_CC + ch), c1); unpack8(*(const u32x4*)(proj + (size_t)(row0 - 2) * LDP + C_CU + ch), u1);
#pragma unroll
            for (int k = 0; k < 8; ++k) pm2[k] = c1[k] * u1[k];
            unpack8(*(const u32x4*)(proj + (size_t)(row0 - 1) * LDP + C_CC + ch), c1); unpack8(*(const u32x4*)(proj + (size_t)(row0 - 1) * LDP + C_CU + ch), u1);
#pragma unroll
            for (int k = 0; k < 8; ++k) pm1[k] = c1[k] * u1[k];
        } else {
#pragma unroll
            for (int k = 0; k < 8; ++k) { pm2[k] = 0.f; pm1[k] = 0.f; }
        }
#pragma unroll 2
        for (int r = 0; r < 32; ++r) {
            const size_t pr = (size_t)(row0 + r) * LDP + ch, yr = (size_t)(row0 + r) * DM + ch;
            float cc[8], cu[8], cbv[8], g0[8], g1[8], g2[8], a[8], c[8], o[8];
            unpack8(*(const u32x4*)(proj + pr + C_CC), cc); unpack8(*(const u32x4*)(proj + pr + C_CU), cu); unpack8(*(const u32x4*)(proj + pr + C_CB), cbv);
            unpack8(*(const u32x4*)(proj + pr + C_GM), g0); unpack8(*(const u32x4*)(proj + pr + C_GM + DM), g1); unpack8(*(const u32x4*)(proj + pr + C_GM + 2 * DM), g2);
            unpack8(*(const u32x4*)(ya + yr), a); unpack8(*(const u32x4*)(yc + yr), c);
#pragma unroll
            for (int k = 0; k < 8; ++k) { const float pc = cc[k] * cu[k]; const float cv = w[0][k] * pm2[k] + w[1][k] * pm1[k] + w[2][k] * pc; pm2[k] = pm1[k]; pm1[k] = pc;
                o[k] = sigmoidf_(g0[k]) * a[k] + sigmoidf_(g1[k]) * (cbv[k] * cv) + sigmoidf_(g2[k]) * c[k]; }
            *(u32x4*)(hb + yr) = pack8f(o);
            asm volatile("" ::: "memory");
        }
    }
}

DI void compress_phase(const Frame& F0, const Args& A, int layer) {
    const Frame F = phase_frame(F0);
    const bf16* proj = (const bf16*)(F.ws + WS_PROJ);
    LAS unsigned char* slab = F.lds;
    LAS unsigned char* hidl = F.lds + 73728;
    LAS float* b1s = (LAS float*)(F.lds + 81920);
    const int lane = F.lane, w = F.wave, i = lane & 15, qd = lane >> 4;
    const float* part = (const float*)(F.ws + WS_MISC);
    for (int u = F.bid; u < 512; u += F.G) {
        const int kv = u >> 8, b = (u >> 7) & 1, g = (u >> 5) & 3, nb = u & 31, n0 = nb * 16, tok0 = n0 * 16;
        const int col = (kv ? C_VC : C_KC) + g * HD;
        for (int id = F.tid; id < 272 * 16; id += NTHR) { const int row = id >> 4, ch = id & 15, t = tok0 + row;
            u32x4 v = {0u, 0u, 0u, 0u}; if (t < SEQ) v = *(const u32x4*)(proj + (size_t)(b * SEQ + t) * LDP + col + ch * 8);
            *(LAS u32x4*)(slab + off_b(row, ch)) = v; }
        if (F.tid < 128) { float s = ((const float*)argin(A, kv ? 12 : 8))[layer * 128 + F.tid];
#pragma unroll
            for (int c = 0; c < 8; ++c) s += part[(((size_t)layer * 2 + kv) * 8 + c) * 128 + F.tid];
            b1s[F.tid] = s; }
        __syncthreads();
        const bf16* w1t = (const bf16*)lw_ptr(F, layer, kv ? LW_PV1 : LW_PK1) + (size_t)(16 * w + i) * 4096 + 8 * qd;
        f32x4 acc = {0.f, 0.f, 0.f, 0.f};
#pragma unroll 8
        for (int ks = 0; ks < 128; ++ks) {
            const bf16x8 a = lds_rd8(slab + off_b(16 * i + (ks >> 2), 4 * (ks & 3) + qd));
            const bf16x8 bb = *(const bf16x8*)(w1t + 32 * ks);
            acc = MFMA16(a, bb, acc);
        }
        { const float bv = b1s[16 * w + i];
#pragma unroll
          for (int j = 0; j < 4; ++j) *(LAS bf16*)(hidl + (4 * qd + j) * 272 + (16 * w + i) * 2) = (bf16)f2bf(siluf_(acc[j] + bv)); }
        __syncthreads();
        const bf16* w2t = (const bf16*)lw_ptr(F, layer, kv ? LW_PV2 : LW_PK2) + (size_t)(16 * w + i) * 128 + 8 * qd;
        f32x4 acc2 = {0.f, 0.f, 0.f, 0.f};
#pragma unroll
        for (int s = 0; s < 4; ++s) {
            const bf16x8 a = lds_rd8(hidl + i * 272 + 64 * s + 16 * qd);
            const bf16x8 bb = *(const bf16x8*)(w2t + 32 * s);
            acc2 = MFMA16(a, bb, acc2);
        }
        const float b2 = ((const float*)argin(A, kv ? 14 : 10))[layer * 128 + 16 * w + i];
        bf16* dst = (bf16*)(F.ws + (kv ? WS_VCMP : WS_KCMP)) + ((size_t)(b * NG + g) * NCMP_PAD + n0) * HD + 16 * w + i;
#pragma unroll
        for (int j = 0; j < 4; ++j) dst[(size_t)(4 * qd + j) * HD] = (bf16)f2bf(acc2[j] + b2);
        __syncthreads();
    }
}

DI void ssd_states_phase(const Frame& F0, const Args& A, int layer) {
    const Frame F = phase_frame(F0);
    const bf16* xbc = (const bf16*)(F.ws + WS_XBC); const float* dt = (const float*)(F.ws + WS_DT);
    float* acs = (float*)(F.ws + WS_ACS); float* cdec = (float*)(F.ws + WS_CDEC); float* st = (float*)(F.ws + WS_ST);
    LAS unsigned char* Bt = F.lds; LAS unsigned char* Xt = F.lds + 32768; LAS float* sc = (LAS float*)(F.lds + 65536);
    const float* alog = (const float*)argin(A, 19) + layer * SSD_H;
    const int lane = F.lane, w = F.wave, i = lane & 15, qd = lane >> 4;
    for (int u = F.bid; u < 512; u += F.G) {
        const int b = u >> 8, c = (u >> 2) & 63, g = u & 3, row0 = b * SEQ + c * SSD_CH;
        {
            const int hh = g * 8 + w; const float a = -__expf(alog[hh]);
            const float dt0 = dt[(size_t)(row0 + 2 * lane) * SSD_H + hh], dt1 = dt[(size_t)(row0 + 2 * lane + 1) * SSD_H + hh];
            const float d0 = dt0 * a, d1 = dt1 * a, pair = d0 + d1; float s = pair;
#pragma unroll
            for (int o = 1; o < 64; o <<= 1) { const float t = shfl_idx(s, lane - o); if (lane >= o) s += t; }
            const float a0 = (s - pair) + d0, a1 = s, total = __builtin_bit_cast(float, __builtin_amdgcn_readlane(__builtin_bit_cast(int, s), 63));
            acs[(size_t)(row0 + 2 * lane) * SSD_H + hh] = a0; acs[(size_t)(row0 + 2 * lane + 1) * SSD_H + hh] = a1;
            sc[w * 128 + 2 * lane] = dt0 * __expf(total - a0); sc[w * 128 + 2 * lane + 1] = dt1 * __expf(total - a1);
            if (lane == 0) cdec[(size_t)(b * SSD_NC + c) * SSD_H + hh] = __expf(total);
        }
        for (int id = F.tid; id < 128 * 16; id += NTHR) { const int row = id >> 4, ch = id & 15;
            *(LAS u32x4*)(Bt + off_b(row, ch)) = *(const u32x4*)(xbc + (size_t)(row0 + row) * SSD_XBC + 2048 + g * 128 + ch * 8); }
        bf16x8 bfr[4];
        for (int hp = 0; hp < 4; ++hp) {
            __syncthreads();
            for (int id = F.tid; id < 128 * 16; id += NTHR) { const int row = id >> 4, ch = id & 15;
                float x[8]; unpack8(*(const u32x4*)(xbc + (size_t)(row0 + row) * SSD_XBC + g * 512 + hp * 128 + ch * 8), x);
                const float f = sc[(hp * 2 + (ch >> 3)) * 128 + row];
#pragma unroll
                for (int k = 0; k < 8; ++k) x[k] *= f;
                *(LAS u32x4*)(Xt + off_b(row, ch)) = pack8f(x); }
            __syncthreads();
            if (hp == 0) {
#pragma unroll
                for (int ks = 0; ks < 4; ++ks) bfr[ks] = tr_read8(Bt, lane, 32 * ks, w);
            }
#pragma unroll
            for (int h2 = 0; h2 < 2; ++h2) {
                const int head = g * 8 + hp * 2 + h2;
                float* dst = st + ((size_t)((b * SSD_NC + c) * SSD_H + head) * SSD_N + 16 * w + i) * SSD_P + 4 * qd;
#pragma unroll
                for (int pt = 0; pt < 4; ++pt) {
                    f32x4 acc = {0.f, 0.f, 0.f, 0.f};
#pragma unroll
                    for (int ks = 0; ks < 4; ++ks) acc = MFMA16(tr_read8(Xt, lane, 32 * ks, h2 * 4 + pt), bfr[ks], acc);
                    *(f32x4*)(dst + 16 * pt) = acc;
                }
            }
        }
        __syncthreads();
    }
}
DI void ssd_scan_phase(const Frame& F0) {
    const Frame F = phase_frame(F0);
    f32x4* st = (f32x4*)(F.ws + WS_ST); const float* cdec = (const float*)(F.ws + WS_CDEC);
    const int gt = F.bid * NTHR + F.tid, NGT = F.G * NTHR;
    for (int v = gt; v < BATCH * SSD_H * 2048; v += NGT) {
        const int b = v >> 16, h = (v >> 11) & 31, e = v & 2047;
        f32x4* base = st + ((size_t)(b * SSD_NC) * SSD_H + h) * 2048 + e;
        const float* dc = cdec + (size_t)(b * SSD_NC) * SSD_H + h;
        f32x4 hs = {0.f, 0.f, 0.f, 0.f};
        for (int c0 = 0; c0 < SSD_NC; c0 += 8) {
            f32x4 s[8]; float d[8];
#pragma unroll
            for (int k = 0; k < 8; ++k) { s[k] = base[(size_t)(c0 + k) * 65536]; d[k] = dc[(c0 + k) * SSD_H]; }
#pragma unroll
            for (int k = 0; k < 8; ++k) { base[(size_t)(c0 + k) * 65536] = hs; hs = hs * d[k] + s[k]; }
            asm volatile("" ::: "memory");
        }
    }
}
DI void ssd_out_phase(const Frame& F0, const Args& A, int layer) {
    const Frame F = phase_frame(F0);
    const bf16* xbc = (const bf16*)(F.ws + WS_XBC); const bf16* proj = (const bf16*)(F.ws + WS_PROJ);
    const float* dt = (const float*)(F.ws + WS_DT); const float* acs = (const float*)(F.ws + WS_ACS); const float* st = (const float*)(F.ws + WS_ST);
    bf16* yc = (bf16*)(F.ws + WS_YC);
    LAS unsigned char* Bt = F.lds; LAS unsigned char* Ct = F.lds + 32768; LAS unsigned char* Xt = F.lds + 65536; LAS unsigned char* Ht = F.lds + 98304;
    LAS float* acsl = (LAS float*)(F.lds + LX_OFF);
    const float* dsk = (const float*)argin(A, 20) + layer * SSD_H; const float* ng = (const float*)argin(A, 21) + (size_t)layer * DM;
    const int lane = F.lane, w = F.wave, i = lane & 15, qd = lane >> 4;
    for (int u = F.bid; u < 512; u += F.G) {
        const int b = u >> 8, c = (u >> 2) & 63, g = u & 3, row0 = b * SEQ + c * SSD_CH;
        for (int id = F.tid; id < 128 * 16; id += NTHR) { const int row = id >> 4, ch = id & 15; const bf16* src = xbc + (size_t)(row0 + row) * SSD_XBC + 2048 + g * 128 + ch * 8;
            *(LAS u32x4*)(Bt + off_b(row, ch)) = *(const u32x4*)(src); *(LAS u32x4*)(Ct + off_b(row, ch)) = *(const u32x4*)(src + 512); }
        __syncthreads();
        bf16x8 cfr[4];
#pragma unroll
        for (int ks = 0; ks < 4; ++ks) cfr[ks] = lds_rd8(Ct + off_b(16 * w + i, 4 * ks + qd));
        f32x4 cb[4][2];
#pragma unroll
        for (int k = 0; k < 4; ++k)
#pragma unroll
            for (int T = 0; T < 2; ++T) { f32x4 acc = {0.f, 0.f, 0.f, 0.f};
#pragma unroll
                for (int ks = 0; ks < 4; ++ks) acc = MFMA16(lds_rd8(Bt + off_b(32 * k + 8 * (i >> 2) + (i & 3) + 4 * T, 4 * ks + qd)), cfr[ks], acc);
                cb[k][T] = acc; }
        const int lrow = 16 * w + i, row = row0 + lrow;
        float ssq = 0.f;
        for (int hp = 0; hp < 4; ++hp) {
            __syncthreads();
            if (F.tid < 256) { const int h2 = F.tid >> 7, l = F.tid & 127; acsl[F.tid] = acs[(size_t)(row0 + l) * SSD_H + g * 8 + hp * 2 + h2]; }
            for (int id = F.tid; id < 128 * 16; id += NTHR) { const int r = id >> 4, ch = id & 15, head = g * 8 + hp * 2 + (ch >> 3);
                float x[8]; unpack8(*(const u32x4*)(xbc + (size_t)(row0 + r) * SSD_XBC + g * 512 + hp * 128 + ch * 8), x);
                const float f = dt[(size_t)(row0 + r) * SSD_H + head];
#pragma unroll
                for (int k = 0; k < 8; ++k) x[k] *= f;
                *(LAS u32x4*)(Xt + off_b(r, ch)) = pack8f(x);
                const float* hs = st + ((size_t)((b * SSD_NC + c) * SSD_H + head) * SSD_N + r) * SSD_P + (ch & 7) * 8;
                const f32x4 h0 = *(const f32x4*)hs, h1 = *(const f32x4*)(hs + 4);
                u32x4 hv; hv.x = pk2(h0[0], h0[1]); hv.y = pk2(h0[2], h0[3]); hv.z = pk2(h1[0], h1[1]); hv.w = pk2(h1[2], h1[3]);
                *(LAS u32x4*)(Ht + off_b(r, ch)) = hv; }
            __syncthreads();
#pragma unroll
            for (int h2 = 0; h2 < 2; ++h2) {
                const int head = g * 8 + hp * 2 + h2;
                const float al = acsl[h2 * 128 + lrow], ea = __expf(al), dsv = dsk[head];
                bf16x8 mfr[4];
#pragma unroll
                for (int k = 0; k < 4; ++k) {
                    const f32x4 a0 = *(const LAS f32x4*)(acsl + h2 * 128 + 32 * k + 8 * qd), a1 = *(const LAS f32x4*)(acsl + h2 * 128 + 32 * k + 8 * qd + 4);
                    float mv[8];
#pragma unroll
                    for (int j = 0; j < 4; ++j) { const int s0 = 32 * k + 8 * qd + j, s1 = s0 + 4;
                        mv[j] = (s0 <= lrow) ? cb[k][0][j] * __expf(al - a0[j]) : 0.f;
                        mv[4 + j] = (s1 <= lrow) ? cb[k][1][j] * __expf(al - a1[j]) : 0.f; }
                    mfr[k] = as_bf16x8(pack8f(mv));
                }
#pragma unroll
                for (int pt = 0; pt < 4; ++pt) {
                    f32x4 yd = {0.f, 0.f, 0.f, 0.f}, yo = {0.f, 0.f, 0.f, 0.f};
#pragma unroll
                    for (int k = 0; k < 4; ++k) yd = MFMA16(tr_read8(Xt, lane, 32 * k, h2 * 4 + pt), mfr[k], yd);
#pragma unroll
                    for (int ks = 0; ks < 4; ++ks) yo = MFMA16(tr_read8(Ht, lane, 32 * ks, h2 * 4 + pt), cfr[ks], yo);
                    const int chn = head * SSD_P + 16 * pt + 4 * qd;
                    const u32x2 xv = *(const u32x2*)(xbc + (size_t)row * SSD_XBC + chn), zv = *(const u32x2*)(proj + (size_t)row * LDP + C_Z + chn);
                    const float xs[4] = {bflo(xv.x), bfhi(xv.x), bflo(xv.y), bfhi(xv.y)}, zz[4] = {bflo(zv.x), bfhi(zv.x), bflo(zv.y), bfhi(zv.y)};
                    float gy[4];
#pragma unroll
                    for (int j = 0; j < 4; ++j) { const float y = yd[j] + ea * yo[j] + dsv * xs[j]; gy[j] = y * siluf_(zz[j]); ssq += gy[j] * gy[j]; }
                    u32x2 o; o.x = pk2(gy[0], gy[1]); o.y = pk2(gy[2], gy[3]);
                    *(u32x2*)(yc + (size_t)row * DM + chn) = o;
                }
            }
        }
        ssq += shx(ssq, 16, lane); ssq += shx(ssq, 32, lane);
        const float rstd = 1.0f / sqrtf(ssq * (1.0f / 512.0f) + EPS);
        VM_WAIT();
#pragma unroll 4
        for (int k = 0; k < 32; ++k) { const int chn = g * 512 + 16 * k + 4 * qd;
            const u32x2 v = *(const u32x2*)(yc + (size_t)row * DM + chn); const f32x4 gv = *(const f32x4*)(ng + chn);
            u32x2 o; o.x = pk2(bflo(v.x) * rstd * gv[0], bfhi(v.x) * rstd * gv[1]); o.y = pk2(bflo(v.y) * rstd * gv[2], bfhi(v.y) * rstd * gv[3]);
            *(u32x2*)(yc + (size_t)row * DM + chn) = o; }
        __syncthreads();
    }
}

constexpr int TP = 272, TILE_B = 64 * TP;
DI void tile_load(u32x4 (&kr)[2], u32x4 (&vr)[2], const bf16* kp, const bf16* vp, int pitch, int tid, bool withv) {
#pragma unroll
    for (int k = 0; k < 2; ++k) { const int id = tid + NTHR * k, row = id >> 4, ch = id & 15;
        kr[k] = *(const u32x4*)(kp + (size_t)row * pitch + ch * 8);
        if (withv) vr[k] = *(const u32x4*)(vp + (size_t)row * pitch + ch * 8); }
}
DI void tile_store(const u32x4 (&kr)[2], const u32x4 (&vr)[2], LAS unsigned char* kb, LAS unsigned char* vb, int tid, bool withv) {
#pragma unroll
    for (int k = 0; k < 2; ++k) { const int id = tid + NTHR * k, row = id >> 4, ch = id & 15;
        *(LAS u32x4*)(kb + row * TP + ch * 16) = kr[k];
        if (withv) *(LAS u32x4*)(vb + row * TP + ch * 16) = vr[k]; }
}
DI void tile_scores(LAS const unsigned char* Kt, const bf16x8 (&Qf)[4], f32x4 (&sc)[2][2]) {
#pragma unroll
    for (int kh = 0; kh < 2; ++kh)
#pragma unroll
        for (int T = 0; T < 2; ++T) { f32x4 acc = {0.f, 0.f, 0.f, 0.f};
#pragma unroll
            for (int ks = 0; ks < 4; ++ks) acc = MFMA16(lds_rd8(Kt + TP * (32 * kh + 4 * T) + 64 * ks), Qf[ks], acc);
            sc[kh][T] = acc; }
}
DI void tile_pv(LAS const unsigned char* Vt, const bf16x8 (&pf)[2], f32x4 (&O)[8]) {
#pragma unroll
    for (int kh = 0; kh < 2; ++kh)
#pragma unroll
        for (int dt = 0; dt < 8; ++dt) { const s16x4 lo = tr_read(Vt + TP * (32 * kh) + 32 * dt), hi = tr_read(Vt + TP * (32 * kh + 4) + 32 * dt);
            O[dt] = MFMA16(__builtin_shufflevector(lo, hi, 0, 1, 2, 3, 4, 5, 6, 7), pf[kh], O[dt]); }
}
template <int MODE>
DI void attn_tile(LAS const unsigned char* Kt, LAS const unsigned char* Vt, const bf16x8 (&Qf)[4], f32x4 (&O)[8], float& m, float& l, int lo, int hi, float c2, float inv_l,
                  LAS float* impA, LAS float* impB, int ql, int jb0, int lane) {
    const int qd = lane >> 4;
    f32x4 sc[2][2];
    tile_scores(Kt, Qf, sc);
    const float NEG = -__builtin_inff();
#pragma unroll
    for (int kh = 0; kh < 2; ++kh)
#pragma unroll
        for (int T = 0; T < 2; ++T)
#pragma unroll
            for (int j = 0; j < 4; ++j) { const int kk = 32 * kh + 8 * qd + 4 * T + j; if (kk < lo || kk > hi) sc[kh][T][j] = NEG; }
    float mn = m;
    if (MODE != 2) {
        float tmax = NEG;
#pragma unroll
        for (int kh = 0; kh < 2; ++kh)
#pragma unroll
            for (int T = 0; T < 2; ++T)
#pragma unroll
                for (int j = 0; j < 4; ++j) tmax = fmaxf(tmax, sc[kh][T][j]);
        tmax = fmaxf(tmax, shx(tmax, 16, lane)); tmax = fmaxf(tmax, shx(tmax, 32, lane));
        mn = fmaxf(m, tmax);
        const float alpha = __builtin_amdgcn_exp2f((m - mn) * c2);
        m = mn; l *= alpha;
        if (MODE == 1) {
#pragma unroll
            for (int dt = 0; dt < 8; ++dt) O[dt] = O[dt] * alpha;
        }
    }
    float ps = 0.f;
#pragma unroll
    for (int kh = 0; kh < 2; ++kh)
#pragma unroll
        for (int T = 0; T < 2; ++T)
#pragma unroll
            for (int j = 0; j < 4; ++j) { float p = __builtin_amdgcn_exp2f((sc[kh][T][j] - mn) * c2); if (MODE == 2) p *= inv_l; sc[kh][T][j] = p; ps += p; }
    if (MODE != 2) l += ps;
    if (MODE == 2) {
#pragma unroll
        for (int kh = 0; kh < 2; ++kh)
#pragma unroll
            for (int T = 0; T < 2; ++T) {
                float s4 = (sc[kh][T][0] + sc[kh][T][1]) + (sc[kh][T][2] + sc[kh][T][3]), cy = sc[kh][T][3];
                s4 += shx(s4, 1, lane); s4 += shx(s4, 2, lane); cy += shx(cy, 1, lane); cy += shx(cy, 2, lane);
                if ((lane & 3) == 0) { const int jb = jb0 + 8 * kh + 2 * qd + T; impA[ql * 128 + jb] = s4; if (jb + 1 < NSLC) impB[ql * 128 + jb + 1] = cy; }
            }
    }
    if (MODE != 0) {
        bf16x8 pf[2];
#pragma unroll
        for (int kh = 0; kh < 2; ++kh) { u32x4 pw; pw.x = pk2(sc[kh][0][0], sc[kh][0][1]); pw.y = pk2(sc[kh][0][2], sc[kh][0][3]); pw.z = pk2(sc[kh][1][0], sc[kh][1][1]); pw.w = pk2(sc[kh][1][2], sc[kh][1][3]); pf[kh] = as_bf16x8(pw); }
        tile_pv(Vt, pf, O);
    }
}
template <bool FIRST> DI void nsa_emit(const f32x4 (&O)[8], float scale, bf16* dst  ) {
#pragma unroll
    for (int dt = 0; dt < 8; ++dt) { f32x4 v = O[dt] * scale;
        if (!FIRST) { const u32x2 old = *(const u32x2*)(dst + 16 * dt); v[0] += bflo(old.x); v[1] += bfhi(old.x); v[2] += bflo(old.y); v[3] += bfhi(old.y); }
        u32x2 o; o.x = pk2(v[0], v[1]); o.y = pk2(v[2], v[3]); *(u32x2*)(dst + 16 * dt) = o; }
}
DI int next_bit(unsigned u0, unsigned u1, unsigned u2, unsigned u3, int from) {
    const int wd = from >> 5; const unsigned msk = ~0u << (from & 31);
    const unsigned x0 = (wd == 0) ? (u0 & msk) : 0u;
    const unsigned x1 = (wd < 1) ? u1 : ((wd == 1) ? (u1 & msk) : 0u);
    const unsigned x2 = (wd < 2) ? u2 : ((wd == 2) ? (u2 & msk) : 0u);
    const unsigned x3 = (wd < 3) ? u3 : (u3 & msk);
    if (x0) return __builtin_ctz(x0);
    if (x1) return 32 + __builtin_ctz(x1);
    if (x2) return 64 + __builtin_ctz(x2);
    if (x3) return 96 + __builtin_ctz(x3);
    return -1;
}

DI void nsa_phase(const Frame& F0, const Args& A, int layer) {
    const Frame F = phase_frame(F0);
    const bf16* proj = (const bf16*)(F.ws + WS_PROJ); const bf16* kcmp = (const bf16*)(F.ws + WS_KCMP); const bf16* vcmp = (const bf16*)(F.ws + WS_VCMP);
    bf16* ya = (bf16*)(F.ws + WS_YA);
    LAS unsigned char* const KB0 = F.lds; LAS unsigned char* const VB0 = F.lds + 2 * TILE_B;
    LAS float* impA = (LAS float*)(F.lds + 4 * TILE_B); LAS float* impB = (LAS float*)(F.lds + 4 * TILE_B + 32768);
    LAS unsigned* selm = (LAS unsigned*)(F.lds + 4 * TILE_B + 65536); LAS unsigned* uml = selm + 256;
    static_assert(4 * TILE_B + 65536 + 1024 + 16 <= LDSCTL_OFF, "nsa LDS map");
    const float c2 = 0.08838834764831845f * 1.4426950408889634f;
    for (int u = F.bid; u < 1024; u += F.G) {
        int tid_l = F.tid; asm volatile("" : "+v"(tid_l));
        const int tid = tid_l, lane = tid & 63, w = __builtin_amdgcn_readfirstlane(tid >> 6), i = lane & 15, qd = lane >> 4, hd = i & 3;
        const int klane = TP * (8 * (i >> 2) + hd) + 16 * qd, vlane = TP * (8 * qd + (i >> 2)) + 8 * hd;
        const int xg = u & 7, jj = (u >> 3) & 31, rr = u >> 8;
        const int b = xg >> 2, g = xg & 3;
        const int qt = (rr == 0) ? 127 - jj : (rr == 1) ? 64 + jj : (rr == 2) ? 63 - jj : jj;
        const int s0 = qt * 64, cur = qt, rowb = b * SEQ;
        int ql[2], trow[2]; bf16x8 Qf[2][4];
#pragma unroll
        for (int s = 0; s < 2; ++s) { ql[s] = 8 * w + 4 * s + (i >> 2); trow[s] = rowb + s0 + ql[s];
#pragma unroll
            for (int ks = 0; ks < 4; ++ks) Qf[s][ks] = *(const bf16x8*)(proj + (size_t)trow[s] * LDP + C_Q + (4 * g + hd) * HD + 32 * ks + 8 * qd); }
        for (int k = 0; k < 8; ++k) { ((LAS f32x4*)impA)[tid + NTHR * k] = (f32x4){0.f, 0.f, 0.f, 0.f}; }
        u32x4 kr[2], vr[2];
        f32x4 O[2][8]; float mrow[2], lrow[2];
        const int ntc = (4 * qt + 3 + 63) >> 6;
        const bf16* kc0 = kcmp + (size_t)(b * NG + g) * NCMP_PAD * HD; const bf16* vc0 = vcmp + (size_t)(b * NG + g) * NCMP_PAD * HD;
        int nmax[2];
#pragma unroll
        for (int s = 0; s < 2; ++s) { const int t = s0 + ql[s]; nmax[s] = (t >= 31) ? ((t - 31) >> 4) : -1; mrow[s] = -1e30f; lrow[s] = 0.f; }
        tile_load(kr, vr, kc0, vc0, HD, tid, false); tile_store(kr, vr, KB0, VB0, tid, false); __syncthreads();
        for (int tc = 0, buf = 0; tc < ntc; ++tc, buf ^= 1) {
            const bool more = tc + 1 < ntc;
            if (more) tile_load(kr, vr, kc0 + (size_t)(tc + 1) * 64 * HD, vc0, HD, tid, false);
#pragma unroll
            for (int s = 0; s < 2; ++s) attn_tile<0>(KB0 + buf * TILE_B + klane, VB0, Qf[s], O[s], mrow[s], lrow[s], 0, nmax[s] - 64 * tc, c2, 0.f, impA, impB, 0, 0, lane);
            if (more) tile_store(kr, vr, KB0 + (buf ^ 1) * TILE_B, VB0, tid, false);
            __syncthreads();
        }
        float invl[2];
#pragma unroll
        for (int s = 0; s < 2; ++s) { float lt = lrow[s]; lt += shx(lt, 16, lane); lt += shx(lt, 32, lane); invl[s] = (lt > 0.f) ? 1.0f / lt : 0.f;
#pragma unroll
            for (int dt = 0; dt < 8; ++dt) O[s][dt] = (f32x4){0.f, 0.f, 0.f, 0.f}; }
        tile_load(kr, vr, kc0, vc0, HD, tid, true); tile_store(kr, vr, KB0, VB0, tid, true); __syncthreads();
        for (int tc = 0, buf = 0; tc < ntc; ++tc, buf ^= 1) {
            const bool more = tc + 1 < ntc;
            if (more) tile_load(kr, vr, kc0 + (size_t)(tc + 1) * 64 * HD, vc0 + (size_t)(tc + 1) * 64 * HD, HD, tid, true);
#pragma unroll
            for (int s = 0; s < 2; ++s) attn_tile<2>(KB0 + buf * TILE_B + klane, VB0 + buf * TILE_B + vlane, Qf[s], O[s], mrow[s], lrow[s], 0, nmax[s] - 64 * tc, c2, invl[s], impA, impB, ql[s], 16 * tc, lane);
            if (more) tile_store(kr, vr, KB0 + (buf ^ 1) * TILE_B, VB0 + (buf ^ 1) * TILE_B, tid, true);
            __syncthreads();
        }
#pragma unroll
        for (int s = 0; s < 2; ++s) { const float gate = sigmoidf_(bf2f(proj[(size_t)trow[s] * LDP + C_GN + (4 * g + hd) * 3 + 0]));
            nsa_emit<true>(O[s], gate, ya + (size_t)trow[s] * DM + (4 * g + hd) * HD + 4 * qd); }
        {
            const int nforced = (cur == 0) ? 1 : (cur == 1) ? 2 : 3; const int nsel = (cur + 1 < NSEL) ? cur + 1 : NSEL; const int R = nsel - nforced;
            for (int q8 = 0; q8 < 8; ++q8) {
                const int q = 8 * w + q8;
                const int j0 = lane, j1 = lane + 64;
                const bool e0 = (j0 >= 1) && (j0 <= cur - 2), e1 = (j1 <= cur - 2);
                const float v0 = e0 ? impA[q * 128 + j0] + impB[q * 128 + j0] : -1.f, v1 = e1 ? impA[q * 128 + j1] + impB[q * 128 + j1] : -1.f;
                int r0 = 0, r1 = 0;
                const int cend = (cur - 2 < 127) ? cur - 2 : 127;
                for (int c = 1; c <= cend; ++c) {
                    const float vc = __builtin_bit_cast(float, (c < 64) ? __builtin_amdgcn_readlane(__builtin_bit_cast(int, v0), c) : __builtin_amdgcn_readlane(__builtin_bit_cast(int, v1), c - 64));
                    r0 += (vc > v0 || (vc == v0 && c < j0)) ? 1 : 0; r1 += (vc > v1 || (vc == v1 && c < j1)) ? 1 : 0;
                }
                const bool f0 = (j0 == 0) || (j0 == cur) || (j0 == cur - 1), f1 = (j1 == cur) || (j1 == cur - 1);
                const unsigned long long m0 = __ballot(f0 || (e0 && r0 < R)), m1 = __ballot(f1 || (e1 && r1 < R));
                if (lane == 0) { selm[q * 4 + 0] = (unsigned)m0; selm[q * 4 + 1] = (unsigned)(m0 >> 32); selm[q * 4 + 2] = (unsigned)m1; selm[q * 4 + 3] = (unsigned)(m1 >> 32); }
            }
            __syncthreads();
            if (w == 0) { unsigned x0 = selm[lane * 4 + 0], x1 = selm[lane * 4 + 1], x2 = selm[lane * 4 + 2], x3 = selm[lane * 4 + 3];
#pragma unroll
                for (int o = 1; o < 64; o <<= 1) { x0 |= shfl_idx_u(x0, lane ^ o); x1 |= shfl_idx_u(x1, lane ^ o); x2 |= shfl_idx_u(x2, lane ^ o); x3 |= shfl_idx_u(x3, lane ^ o); }
                if (lane == 0) { uml[0] = x0; uml[1] = x1; uml[2] = x2; uml[3] = x3; } }
            __syncthreads();
        }
        const unsigned um0 = __builtin_amdgcn_readfirstlane(uml[0]), um1 = __builtin_amdgcn_readfirstlane(uml[1]), um2 = __builtin_amdgcn_readfirstlane(uml[2]), um3 = __builtin_amdgcn_readfirstlane(uml[3]);
        {
            const bf16* ks0 = proj + (size_t)rowb * LDP + C_KS + g * HD; const bf16* vs0 = proj + (size_t)rowb * LDP + C_VS + g * HD;
#pragma unroll
            for (int s = 0; s < 2; ++s) { mrow[s] = -1e30f; lrow[s] = 0.f;
#pragma unroll
                for (int dt = 0; dt < 8; ++dt) O[s][dt] = (f32x4){0.f, 0.f, 0.f, 0.f}; }
            int jb = next_bit(um0, um1, um2, um3, 0), buf = 0;
            tile_load(kr, vr, ks0 + (size_t)jb * 64 * LDP, vs0 + (size_t)jb * 64 * LDP, LDP, tid, true); tile_store(kr, vr, KB0, VB0, tid, true); __syncthreads();
            while (jb >= 0) {
                const int nj = (jb + 1 < NSLC) ? next_bit(um0, um1, um2, um3, jb + 1) : -1;
                if (nj >= 0) tile_load(kr, vr, ks0 + (size_t)nj * 64 * LDP, vs0 + (size_t)nj * 64 * LDP, LDP, tid, true);
#pragma unroll
                for (int s = 0; s < 2; ++s) {
                    const bool act = (selm[ql[s] * 4 + (jb >> 5)] >> (jb & 31)) & 1u;
                    if (__ballot(act) != 0ull) {
                        const int hi = act ? ((jb < cur) ? 63 : ql[s]) : -1;
                        attn_tile<1>(KB0 + buf * TILE_B + klane, VB0 + buf * TILE_B + vlane, Qf[s], O[s], mrow[s], lrow[s], 0, hi, c2, 0.f, impA, impB, 0, 0, lane);
                    }
                }
                if (nj >= 0) tile_store(kr, vr, KB0 + (buf ^ 1) * TILE_B, VB0 + (buf ^ 1) * TILE_B, tid, true);
                __syncthreads();
                jb = nj; buf ^= 1;
            }
            VM_WAIT();
#pragma unroll
            for (int s = 0; s < 2; ++s) { float lt = lrow[s]; lt += shx(lt, 16, lane); lt += shx(lt, 32, lane);
                const float gate = sigmoidf_(bf2f(proj[(size_t)trow[s] * LDP + C_GN + (4 * g + hd) * 3 + 1]));
                nsa_emit<false>(O[s], (lt > 0.f) ? gate / lt : 0.f, ya + (size_t)trow[s] * DM + (4 * g + hd) * HD + 4 * qd); }
        }
        {
            const bf16* kw0 = proj + (size_t)rowb * LDP + C_KW + g * HD; const bf16* vw0 = proj + (size_t)rowb * LDP + C_VW + g * HD;
#pragma unroll
            for (int s = 0; s < 2; ++s) { mrow[s] = -1e30f; lrow[s] = 0.f;
#pragma unroll
                for (int dt = 0; dt < 8; ++dt) O[s][dt] = (f32x4){0.f, 0.f, 0.f, 0.f}; }
            const int tt0 = (qt >= 8) ? 0 : 8 - qt;
            { const size_t r0 = (size_t)(s0 - 512 + 64 * tt0) * LDP; tile_load(kr, vr, kw0 + r0, vw0 + r0, LDP, tid, true); tile_store(kr, vr, KB0, VB0, tid, true); __syncthreads(); }
            for (int tt = tt0, buf = 0; tt <= 8; ++tt, buf ^= 1) {
                const bool more = tt < 8;
                if (more) { const size_t r0 = (size_t)(s0 - 512 + 64 * (tt + 1)) * LDP; tile_load(kr, vr, kw0 + r0, vw0 + r0, LDP, tid, true); }
#pragma unroll
                for (int s = 0; s < 2; ++s) {
                    const int lo = (tt == 0) ? ql[s] + 1 : 0, hi = (tt == 8) ? ql[s] : 63;
                    attn_tile<1>(KB0 + buf * TILE_B + klane, VB0 + buf * TILE_B + vlane, Qf[s], O[s], mrow[s], lrow[s], lo, hi, c2, 0.f, impA, impB, 0, 0, lane);
                }
                if (more) tile_store(kr, vr, KB0 + (buf ^ 1) * TILE_B, VB0 + (buf ^ 1) * TILE_B, tid, true);
                __syncthreads();
            }
            VM_WAIT();
#pragma unroll
            for (int s = 0; s < 2; ++s) { float lt = lrow[s]; lt += shx(lt, 16, lane); lt += shx(lt, 32, lane);
                const float gate = sigmoidf_(bf2f(proj[(size_t)trow[s] * LDP + C_GN + (4 * g + hd) * 3 + 2]));
                nsa_emit<false>(O[s], (lt > 0.f) ? gate / lt : 0.f, ya + (size_t)trow[s] * DM + (4 * g + hd) * HD + 4 * qd); }
        }
        __syncthreads();
    }
}

constexpr int NPH_LAYER = 13, NPH = 2 + NPH_LAYER * DEPTH;
#ifndef PG8_SP2
#define PG8_SP2 true
#endif
#ifndef PG8_ALIGN
#define PG8_ALIGN true
#endif
#ifndef PH_MASK
#define PH_MASK 0xFFFFFFFFu
#endif
#define INK(k, kk) (((PH_MASK >> (kk)) & 1u) && lo <= (k) && (k) < hi)
#define SEAM(k) do { if (lo <= (k) && (k) + 1 < hi) { XcdBarrier b_ = bar; { unsigned long long p_ = (unsigned long long)bar.bar; asm volatile("" : "+s"(p_)); b_.bar = (unsigned*)p_; } xcd_barrier(b_); } } while (0)
template <int LAYER> DI void layer_phases(const Frame& F, const Args& args, const XcdBarrier& bar, const int lo, const int hi) {
    constexpr int layer = LAYER, layer_ = LAYER;
    float* xres = (float*)(F.ws + WS_X); bf16* hb = (bf16*)(F.ws + WS_HB); bf16* projb = (bf16*)(F.ws + WS_PROJ); bf16* ub = (bf16*)(F.ws + WS_U); bf16* eb = (bf16*)(F.ws + WS_EB);
        const int pb = 1 + NPH_LAYER * layer;
        const float* xin = (layer == 0) ? (const float*)argin(args, 0) : (const float*)xres;
        if (INK(pb + 0, 0)) norm_rows<false>(F, xin, (const float*)argin(args, 3) + (size_t)layer * DM, hb);
        SEAM(pb + 0);
        if (INK(pb + 1, 1)) {
#ifndef NO_G1
            { const Frame Fp = phase_frame(F);  pg8::Gemm g{hb, (const bf16*)lw_ptr(Fp, layer, LW_IN), M, LDP, DM}; pg8::StaticOrder S; S.init(M, LDP, Fp.G, Fp.bid);
              pg8::EpiB<2> E{projb, LDP, (const float*)(Fp.ws + WS_ROPE)};
              pg8::gemm_phase<pg8::EpiB<2>, pg8::StaticOrder, PG8_ALIGN, PG8_SP2>(Fp.lds, g, S, E, Fp.wave); }
#endif
#ifndef NO_G5
            { const Frame Fp = phase_frame(F);  pg8::Gemm g{(const bf16*)(Fp.ws + WS_PB) + (size_t)layer * M * PLE, (const bf16*)lw_ptr(Fp, layer, LW_PLE), M, DM, PLE}; pg8::StaticOrder S; S.init(M, DM, Fp.G, Fp.bid);
              pg8::EpiB<0> E{eb, DM, nullptr};
              pg8::gemm_phase<pg8::EpiB<0>, pg8::StaticOrder, PG8_ALIGN, PG8_SP2>(Fp.lds, g, S, E, Fp.wave); }
#endif
        }
        SEAM(pb + 1);
        if (INK(pb + 2, 2)) { ssd_conv_pass(F, args, layer); compress_phase(F, args, layer); }
        SEAM(pb + 2);
        if (INK(pb + 3, 3)) ssd_states_phase(F, args, layer);
        SEAM(pb + 3);
        if (INK(pb + 4, 4)) ssd_scan_phase(F);
        SEAM(pb + 4);
        if (INK(pb + 5, 5)) {
#ifndef NO_S3
            ssd_out_phase(F, args, layer);
#endif
#ifndef NO_NSA
            nsa_phase(F, args, layer);
#endif
        }
        SEAM(pb + 5);
        if (INK(pb + 6, 6)) merge_pass(F, args, layer);
        SEAM(pb + 6);
        if (INK(pb + 7, 7)) { const Frame Fp = phase_frame(F);  pg8::Gemm g{hb, (const bf16*)lw_ptr(Fp, layer, LW_O), M, DM, DM}; pg8::StaticOrder S; S.init(M, DM, Fp.G, Fp.bid);
            pg8::EpiRes<false> E{xin, xres, DM, nullptr};
            pg8::gemm_phase<pg8::EpiRes<false>, pg8::StaticOrder, PG8_ALIGN, PG8_SP2>(Fp.lds, g, S, E, Fp.wave); }
        SEAM(pb + 7);
        if (INK(pb + 8, 8)) norm_rows<false>(F, xres, (const float*)argin(args, 23) + (size_t)layer * DM, hb);
        SEAM(pb + 8);
        if (INK(pb + 9, 9)) { const Frame Fp = phase_frame(F);  pg8::Gemm g{hb, (const bf16*)lw_ptr(Fp, layer, LW_UP), M, DFF, DM}; pg8::StaticOrder S; S.init(M, DFF, Fp.G, Fp.bid);
            pg8::EpiB<1> E{ub, DFF, nullptr};
            pg8::gemm_phase<pg8::EpiB<1>, pg8::StaticOrder, PG8_ALIGN, PG8_SP2>(Fp.lds, g, S, E, Fp.wave); }
        SEAM(pb + 9);
        if (INK(pb + 10, 10)) { const Frame Fp = phase_frame(F);  pg8::Gemm g{ub, (const bf16*)lw_ptr(Fp, layer, LW_DOWN), M, DM, DFF}; pg8::StaticOrder S; S.init(M, DM, Fp.G, Fp.bid);
            pg8::EpiRes<false> E{xres, xres, DM, nullptr};
            pg8::gemm_phase<pg8::EpiRes<false>, pg8::StaticOrder, PG8_ALIGN, PG8_SP2>(Fp.lds, g, S, E, Fp.wave); }
        SEAM(pb + 10);
        if (INK(pb + 11, 11)) norm_rows<false>(F, xres, (const float*)argin(args, 26) + (size_t)layer * DM, hb);
        SEAM(pb + 11);
        if (INK(pb + 12, 12)) { const Frame Fp = phase_frame(F);  pg8::Gemm g{hb, (const bf16*)lw_ptr(Fp, layer, LW_PG), M, DM, DM}; pg8::StaticOrder S; S.init(M, DM, Fp.G, Fp.bid);
            pg8::EpiRes<true> E{xres, xres, DM, eb};
            pg8::gemm_phase<pg8::EpiRes<true>, pg8::StaticOrder, PG8_ALIGN, PG8_SP2>(Fp.lds, g, S, E, Fp.wave); }
        SEAM(pb + 12);
}
__global__ void __launch_bounds__(NTHR, 2) hyb_fwd(Args args) {
    extern __shared__ __attribute__((aligned(16))) unsigned char lds_raw[];
    Frame F;
    F.lds = (LAS unsigned char*)lds_raw; F.ws = args.ws; F.ctl = (gu32*)(args.ws + WS_CTL);
    F.tid = threadIdx.x; F.lane = F.tid & 63; F.wave = __builtin_amdgcn_readfirstlane(threadIdx.x >> 6); F.G = gridDim.x; F.bid = blockIdx.x;
    const int lo = args.ph_lo, hi = args.ph_hi;
    if (F.tid < 64) ((LAS unsigned*)(F.lds + LDSCTL_OFF))[F.tid] = 0u;
    __syncthreads();
    XcdBarrier bar; bar.bar = (unsigned*)(F.ctl + CW_BAR); bar.x = 0; bar.st = (volatile LAS unsigned*)(F.lds + LDSCTL_OFF);
    if (hi - lo > 1) bar = xcd_barrier_post((unsigned*)(F.ctl + CW_BAR), (volatile LAS unsigned*)(F.lds + LDSCTL_OFF));
    if (INK(0, 13)) p0_prologue(F, args);
    SEAM(0);
    layer_phases<0>(F, args, bar, lo, hi); layer_phases<1>(F, args, bar, lo, hi); layer_phases<2>(F, args, bar, lo, hi); layer_phases<3>(F, args, bar, lo, hi);
    float* xres = (float*)(F.ws + WS_X);
    int hi_l = hi; asm volatile("" : "+s"(hi_l));
    if (((PH_MASK >> 14) & 1u) && lo <= NPH - 1 && NPH - 1 < hi_l) norm_rows<true>(F, xres, (const float*)argin(args, 29), args.out);
#undef INK
#undef SEAM
}

#ifndef MK_ONE_LAUNCH
#define MK_ONE_LAUNCH 0
#endif
extern "C" void kernel_launch(void* const* d_in, const int* in_sizes, int n_in, void* d_out, int out_size, void* d_ws, size_t ws_size, hipStream_t stream) {
    static int grid = 0;
    if (grid == 0) {
        if (n_in != 30 || out_size != M * DM || ws_size < WS_END) { fprintf(stderr, "kernel_launch: unexpected shapes (n_in %d out %d ws %zu need %zu)\n", n_in, out_size, ws_size, (size_t)WS_END); grid = -1; return; }
        int dev = 0, cus = 0, per_cu = 0;
        if (hipGetDevice(&dev) != hipSuccess || hipDeviceGetAttribute(&cus, hipDeviceAttributeMultiprocessorCount, dev) != hipSuccess) { grid = -1; return; }
        if (hipFuncSetAttribute((const void*)hyb_fwd, hipFuncAttributeMaxDynamicSharedMemorySize, LDS_BYTES) != hipSuccess) { fprintf(stderr, "kernel_launch: hipFuncSetAttribute failed\n"); grid = -1; return; }
        if (hipOccupancyMaxActiveBlocksPerMultiprocessor(&per_cu, (const void*)hyb_fwd, NTHR, LDS_BYTES) != hipSuccess || per_cu < 1) { fprintf(stderr, "kernel_launch: occupancy query says %d\n", per_cu); }
        (void)hipGetLastError();
        grid = cus;
    }
    if (grid < 0) return;
    (void)hipMemsetAsync((char*)d_ws + WS_CTL, 0, CTL_ZERO_BYTES, stream);
    Args a{};
    for (int i = 0; i < 30; ++i) a.in[i] = d_in[i];
    a.out = (float*)d_out; a.ws = (unsigned char*)d_ws;
#if MK_ONE_LAUNCH
    a.ph_lo = 0; a.ph_hi = NPH;
    hipLaunchKernelGGL(hyb_fwd, dim3(grid), dim3(NTHR), LDS_BYTES, stream, a);
#else
    for (int ph = 0; ph < NPH; ++ph) { a.ph_lo = ph; a.ph_hi = ph + 1; hipLaunchKernelGGL(hyb_fwd, dim3(grid), dim3(NTHR), LDS_BYTES, stream, a); }
#endif
    (void)in_sizes;
}
```

```cpp
#include <hip/hip_runtime.h>
#include <cstdio>
#include <cstdint>
namespace pg8 {
#define PG8_LAS __attribute__((address_space(3)))
typedef unsigned short bf16_t;
typedef short bf16x8 __attribute__((ext_vector_type(8)));
typedef float f32x4 __attribute__((ext_vector_type(4)));
typedef unsigned u32x4 __attribute__((ext_vector_type(4)));
constexpr int BM = 256, BK = 64, HALF = 128, HTB = HALF * BK * 2  , STAGE_BYTES = 8 * HTB, NXCD = 8, WGM = 8;

__host__ __device__ __forceinline__ int lds_byte(int r, int c) { const int st = (r >> 4) * 2 + (c >> 5), rr = r & 15, cc = c & 31, ob = rr * 64 + cc * 2; return st * 1024 + (ob ^ (((ob >> 9) & 1) << 5)); }
__host__ __device__ __forceinline__ void stage_rc(int b, int& R, int& C) { const int st = b / 1024, sb = b % 1024, swz = sb ^ (((sb >> 9) & 1) << 5); R = (st >> 1) * 16 + swz / 64; C = (st & 1) * 32 + (swz % 64) / 2; }
__host__ __device__ __forceinline__ int perm32(int rho) { const int n = rho >> 4, i = rho & 15; return 8 * (i >> 2) + 4 * n + (i & 3); }

struct Unit { int pm, pn; };
struct Gemm { const bf16_t* A; const bf16_t* Bt; int M, N, K; };

struct StaticOrder {
    int nM, nN, nwg, G, c;
    __host__ __device__ void init(int M, int N, int G_, int c_) { nM = M / BM; nN = N / BM; nwg = nM * nN; G = G_; c = c_; }
    __host__ __device__ bool next(int i, Unit& u) const {
        const long L = (long)i * G + c; if (L >= nwg) return false;
        int wgid = (int)L; { const int q = nwg / NXCD, r = nwg % NXCD, xcd = wgid % NXCD, off = wgid / NXCD; wgid = (xcd < r ? xcd * (q + 1) : r * (q + 1) + (xcd - r) * q) + off; }
        const int nig = WGM * nN, gid = wgid / nig, fm = gid * WGM, gsz = (nM - fm) < WGM ? (nM - fm) : WGM;
        u.pm = fm + ((wgid % nig) % gsz); u.pn = (wgid % nig) / gsz; return true;
    }
    __device__ __forceinline__ void a_ready(const Unit&) const {}
    __device__ __forceinline__ void done(const Unit&) const {}
};
__device__ __forceinline__ unsigned cvt_pk_bf16(float lo, float hi) { unsigned r; asm volatile("v_cvt_pk_bf16_f32 %0, %1, %2" : "=v"(r) : "v"(lo), "v"(hi)); return r; }
template <class Epi, class Sched, bool ALIGN_EPI = false, bool SP2 = false>
__device__ __forceinline__ void gemm_phase(PG8_LAS unsigned char* lds, const Gemm g, const Sched& S, const Epi& E, const int wave_idx  ) {
    int lane_l; asm volatile("v_mbcnt_lo_u32_b32 %0, -1, 0\n\tv_mbcnt_hi_u32_b32 %0, -1, %0" : "=v"(lane_l));
    const int wid = wave_idx, tid = wid * 64 + lane_l, lane = tid & 63, wr = wid >> 2, wc = wid & 3, fr = lane & 15, fq = lane >> 4;
    const int K = g.K, nt = K / BK;
    unsigned voffA[2], voffB[2];
#pragma unroll
    for (int i = 0; i < 2; ++i) { int R, C; stage_rc(tid * 16 + i * 8192, R, C); const int Rb = Epi::PERM ? ((R & ~31) + perm32(R & 31)) : R;
        voffA[i] = (unsigned)(R * K + C) * 2u; voffB[i] = (unsigned)(Rb * K + C) * 2u; }
    const size_t kstep = (size_t)(BK * 2);
    const size_t hstep = (size_t)HALF * K * 2;
    const size_t tstep = 2 * hstep;
    const unsigned ldsw = (unsigned)wid * 1024u;
    const int aoff = lds_byte(wr * 64 + fr, fq * 8), boff = lds_byte(wc * 32 + fr, fq * 8);
#define PG8_SA(b, h) (((b) * 2 + (h)) * HTB)
#define PG8_SB(b, h) ((4 + (b) * 2 + (h)) * HTB)
#define PG8_STAGE(bufoff, gbase, voff) do { _Pragma("unroll") for (int _i = 0; _i < 2; ++_i) \
        __builtin_amdgcn_global_load_lds((const unsigned*)((const char*)(gbase) + (voff)[_i]), (PG8_LAS unsigned*)(lds + (bufoff) + ldsw + _i * 8192), 16, 0, 0); } while (0)
#define PG8_LDA(dst, b, h) do { _Pragma("unroll") for (int m = 0; m < 4; ++m) _Pragma("unroll") for (int k = 0; k < 2; ++k) dst[m][k] = *(const PG8_LAS bf16x8*)(lds + PG8_SA(b, h) + aoff + m * 2048 + k * 1024); } while (0)
#define PG8_LDB(dst, b, h) do { _Pragma("unroll") for (int n = 0; n < 2; ++n) _Pragma("unroll") for (int k = 0; k < 2; ++k) dst[n][k] = *(const PG8_LAS bf16x8*)(lds + PG8_SB(b, h) + boff + n * 2048 + k * 1024); } while (0)
#define PG8_MMA(ai, bj, At, Bt) do { __builtin_amdgcn_s_setprio(1); _Pragma("unroll") for (int m = 0; m < 4; ++m) _Pragma("unroll") for (int n = 0; n < 2; ++n) _Pragma("unroll") for (int k = 0; k < 2; ++k) \
        acc[ai][bj][m][n] = __builtin_amdgcn_mfma_f32_16x16x32_bf16(Bt[n][k], At[m][k], acc[ai][bj][m][n], 0, 0, 0); __builtin_amdgcn_s_setprio(0); } while (0)
#define PG8_WAIT_V(n) asm volatile("s_waitcnt vmcnt(" #n ")" ::: "memory")
#define PG8_WAIT_L(n) asm volatile("s_waitcnt lgkmcnt(" #n ")" ::: "memory")
#define PG8_BAR __builtin_amdgcn_s_barrier()
#define PG8_SCHED __builtin_amdgcn_sched_barrier(0)
    Unit cur, nxt; int ui = 0;
    if (!S.next(0, cur)) return;
    f32x4 acc[2][2][4][2];
#pragma unroll
    for (int a = 0; a < 2; ++a)
#pragma unroll
        for (int b = 0; b < 2; ++b)
#pragma unroll
            for (int m = 0; m < 4; ++m)
#pragma unroll
                for (int n = 0; n < 2; ++n) acc[a][b][m][n] = (f32x4){0.f, 0.f, 0.f, 0.f};
    bf16x8 At[4][2], B0[2][2], B1[2][2];
    const char* cA = (const char*)g.A + (size_t)cur.pm * tstep; const char* cB = (const char*)g.Bt + (size_t)cur.pn * tstep;
    S.a_ready(cur);
    if constexpr (SP2) {
        PG8_STAGE(PG8_SB(0, 0), cB, voffB); PG8_STAGE(PG8_SB(0, 1), cB + hstep, voffB); PG8_STAGE(PG8_SA(0, 0), cA, voffA); PG8_STAGE(PG8_SA(0, 1), cA + hstep, voffA);
        if (wr == 1) PG8_BAR;
        PG8_WAIT_V(2); PG8_BAR;
        PG8_STAGE(PG8_SB(1, 0), cB + kstep, voffB); PG8_STAGE(PG8_SA(1, 0), cA + kstep, voffA); PG8_STAGE(PG8_SB(1, 1), cB + hstep + kstep, voffB);
        PG8_WAIT_V(6); PG8_BAR;
    } else {
        PG8_STAGE(PG8_SB(0, 0), cB, voffB); PG8_STAGE(PG8_SA(0, 0), cA, voffA); PG8_STAGE(PG8_SB(0, 1), cB + hstep, voffB); PG8_STAGE(PG8_SA(0, 1), cA + hstep, voffA);
        if (wr == 1) PG8_BAR;
        PG8_WAIT_V(4); PG8_BAR;
        PG8_STAGE(PG8_SB(1, 0), cB + kstep, voffB); PG8_STAGE(PG8_SA(1, 0), cA + kstep, voffA); PG8_STAGE(PG8_SB(1, 1), cB + hstep + kstep, voffB);
        PG8_WAIT_V(6); PG8_BAR;
    }
    for (;;) {
        const bool has_next = S.next(ui + 1, nxt);
        const char* nA = has_next ? (const char*)g.A + (size_t)nxt.pm * tstep : cA; const char* nB = has_next ? (const char*)g.Bt + (size_t)nxt.pn * tstep : cB;
        for (int t = 0; t < nt; t += 2) {
            const bool last = (t == nt - 2);
            const char* a1 = cA + (size_t)(t + 1) * kstep;
            const char* a2 = last ? nA : cA + (size_t)(t + 2) * kstep; const char* b2 = last ? nB : cB + (size_t)(t + 2) * kstep;
            const char* a3 = a2 + kstep; const char* b3 = b2 + kstep;
            if (last && has_next) S.a_ready(nxt);
            if constexpr (SP2) {
            PG8_LDB(B0, 0, 0); PG8_LDB(B1, 0, 1); PG8_SCHED; PG8_LDA(At, 0, 0); PG8_STAGE(PG8_SA(1, 1), a1 + hstep, voffA);
            PG8_WAIT_V(8); PG8_WAIT_L(0); PG8_BAR; PG8_MMA(0, 0, At, B0); PG8_MMA(0, 1, At, B1); PG8_BAR; PG8_SCHED;
            PG8_LDA(At, 0, 1); PG8_STAGE(PG8_SB(0, 0), b2, voffB); PG8_STAGE(PG8_SB(0, 1), b2 + hstep, voffB); PG8_STAGE(PG8_SA(0, 0), a2, voffA);
            PG8_WAIT_V(8); PG8_WAIT_L(0); PG8_BAR; PG8_MMA(1, 0, At, B0); PG8_MMA(1, 1, At, B1); PG8_BAR; PG8_SCHED;
            PG8_LDB(B0, 1, 0); PG8_LDB(B1, 1, 1); PG8_SCHED; PG8_LDA(At, 1, 0); PG8_STAGE(PG8_SA(0, 1), a2 + hstep, voffA);
            PG8_WAIT_V(8); PG8_WAIT_L(0); PG8_BAR; PG8_MMA(0, 0, At, B0); PG8_MMA(0, 1, At, B1); PG8_BAR; PG8_SCHED;
            PG8_LDA(At, 1, 1); PG8_STAGE(PG8_SB(1, 0), b3, voffB); PG8_STAGE(PG8_SB(1, 1), b3 + hstep, voffB); PG8_STAGE(PG8_SA(1, 0), a3, voffA);
            PG8_WAIT_V(8); PG8_WAIT_L(0); PG8_BAR; PG8_MMA(1, 0, At, B0); PG8_MMA(1, 1, At, B1); PG8_BAR; PG8_SCHED;
            } else {
            PG8_LDB(B0, 0, 0); PG8_SCHED; PG8_LDA(At, 0, 0); PG8_STAGE(PG8_SA(1, 1), a1 + hstep, voffA);
            PG8_WAIT_L(8); PG8_BAR; PG8_WAIT_L(0); PG8_MMA(0, 0, At, B0); PG8_BAR; PG8_SCHED;
            PG8_LDB(B1, 0, 1); PG8_STAGE(PG8_SB(0, 0), b2, voffB);
            PG8_BAR; PG8_WAIT_L(0); PG8_MMA(0, 1, At, B1); PG8_BAR;
            PG8_LDA(At, 0, 1); PG8_STAGE(PG8_SA(0, 0), a2, voffA);
            PG8_BAR; PG8_WAIT_L(0); PG8_MMA(1, 0, At, B0); PG8_BAR; PG8_SCHED;
            PG8_STAGE(PG8_SB(0, 1), b2 + hstep, voffB);
            PG8_WAIT_V(6); PG8_BAR; PG8_MMA(1, 1, At, B1); PG8_BAR;
            PG8_LDB(B0, 1, 0); PG8_SCHED; PG8_LDA(At, 1, 0); PG8_STAGE(PG8_SA(0, 1), a2 + hstep, voffA);
            PG8_WAIT_L(8); PG8_BAR; PG8_WAIT_L(0); PG8_MMA(0, 0, At, B0); PG8_BAR; PG8_SCHED;
            PG8_LDB(B1, 1, 1); PG8_STAGE(PG8_SB(1, 0), b3, voffB);
            PG8_BAR; PG8_WAIT_L(0); PG8_MMA(0, 1, At, B1); PG8_BAR;
            PG8_LDA(At, 1, 1); PG8_STAGE(PG8_SA(1, 0), a3, voffA);
            PG8_BAR; PG8_WAIT_L(0); PG8_MMA(1, 0, At, B0); PG8_BAR; PG8_SCHED;
            PG8_STAGE(PG8_SB(1, 1), b3 + hstep, voffB);
            PG8_WAIT_V(6); PG8_BAR; PG8_MMA(1, 1, At, B1); PG8_BAR;
            }
        }
        if constexpr (ALIGN_EPI) { if (wr == 0) PG8_BAR; }
        if constexpr (!Epi::AFTER_DRAIN) { E(acc, cur, wr, wc, fr, fq); S.done(cur); }
        if (!has_next) break;
#pragma unroll
        for (int a = 0; a < 2; ++a)
#pragma unroll
            for (int b = 0; b < 2; ++b)
#pragma unroll
                for (int m = 0; m < 4; ++m)
#pragma unroll
                    for (int n = 0; n < 2; ++n) acc[a][b][m][n] = (f32x4){0.f, 0.f, 0.f, 0.f};
        cur = nxt; cA = nA; cB = nB; ++ui;
        if constexpr (ALIGN_EPI) { if (wr == 1) PG8_BAR; }
    }
    PG8_WAIT_V(0);
    if constexpr (!ALIGN_EPI) { if (wr == 0) PG8_BAR; }
    PG8_BAR;
    if constexpr (Epi::AFTER_DRAIN) { E.fused(acc, cur, wr, wc, fr, fq, lds, wid, lane); S.done(cur); }
#undef PG8_SA
#undef PG8_SB
#undef PG8_STAGE
#undef PG8_LDA
#undef PG8_LDB
#undef PG8_MMA
#undef PG8_WAIT_V
#undef PG8_WAIT_L
#undef PG8_BAR
#undef PG8_SCHED
}
}

constexpr int BATCH = 2, SEQ = 8192, DM = 2048, DEPTH = 4;
constexpr int M = BATCH * SEQ;
constexpr int NH = 16, HD = 128, NG = 4, RH = 4;
constexpr int NCMP = 511, NCMP_PAD = 512, NSLC = 128, NSEL = 16, WIN = 512;
constexpr int SSD_H = 32, SSD_P = 64, SSD_N = 128, SSD_G = 4, SSD_CH = 128, SSD_NC = 64, SSD_XBC = 3072;
constexpr int DFF = 8192, PLE = 256;
constexpr float EPS = 1e-6f;
constexpr int PROJ_SRC = 22608;
constexpr int C_Q = 0, C_KC = 2048, C_VC = 2560, C_KS = 3072, C_VS = 3584, C_KW = 4096, C_VW = 4608;
constexpr int C_CB = 5120, C_CC = 7168, C_CU = 9216, C_Z = 11264, C_XBC = 13312, C_GM = 16384, C_GN = 22528, C_DT = 22592;
constexpr int LDP = 22784;
constexpr int S_GN = 5120, S_DT = 16432;

constexpr size_t MiB = 1u << 20;
constexpr size_t WS_CTL = 0, CTL_ZERO_BYTES = 1 * MiB;
constexpr size_t WS_ROPE = 1 * MiB;
constexpr size_t WS_MISC = 9 * MiB;
constexpr size_t WS_DT = 10 * MiB;
constexpr size_t WS_ACS = 12 * MiB;
constexpr size_t WS_CDEC = 14 * MiB;
constexpr size_t WS_KCMP = 15 * MiB;
constexpr size_t WS_VCMP = 16 * MiB;
constexpr size_t WS_X = 32 * MiB;
constexpr size_t WS_HB = 160 * MiB;
constexpr size_t WS_PB = 224 * MiB;
constexpr size_t WS_EB = 256 * MiB;
constexpr size_t WS_YA = 320 * MiB;
constexpr size_t WS_YC = 384 * MiB;
constexpr size_t WS_XBC = 448 * MiB;
constexpr size_t WS_ST = 544 * MiB;
constexpr size_t WS_PROJ = 672 * MiB;
constexpr size_t WS_U = WS_PROJ;
constexpr size_t WS_W = 1384 * MiB;
constexpr size_t LW_IN = 0;
constexpr size_t LW_O = 89 * MiB;
constexpr size_t LW_UP = 97 * MiB;
constexpr size_t LW_DOWN = 129 * MiB;
constexpr size_t LW_PG = 161 * MiB;
constexpr size_t LW_PLE = 169 * MiB;
constexpr size_t LW_PK1 = 170 * MiB;
constexpr size_t LW_PV1 = 171 * MiB;
constexpr size_t LW_PK2 = 172 * MiB;
constexpr size_t LW_PV2 = 172 * MiB + 64 * 1024;
constexpr size_t LW_STRIDE = 173 * MiB;
constexpr size_t WS_END = WS_W + 4 * LW_STRIDE;
static_assert((size_t)M * LDP * 2 <= 712 * MiB && (size_t)LDP * 2048 * 2 <= 89 * MiB, "ws map");

constexpr int CW_BAR = 4096;
constexpr int CW_CHK = 16384;

constexpr int RING_BYTES = 131072;
constexpr int LX_OFF = RING_BYTES;
constexpr int LX_BYTES = 8192;
constexpr int LDSCTL_OFF = LX_OFF + LX_BYTES;
constexpr int LDS_BYTES = LDSCTL_OFF + 256;
constexpr int NWAVES = 8, NTHR = 512;

#define DI __device__ __forceinline__
#define GAS __attribute__((address_space(1)))
#define LAS __attribute__((address_space(3)))
typedef unsigned short bf16;
typedef unsigned u32x4 __attribute__((ext_vector_type(4)));
typedef unsigned u32x2 __attribute__((ext_vector_type(2)));
typedef float f32x4 __attribute__((ext_vector_type(4)));
typedef float f32x2 __attribute__((ext_vector_type(2)));
typedef short bf16x8 __attribute__((ext_vector_type(8)));
typedef short s16x4 __attribute__((ext_vector_type(4)));
typedef GAS unsigned gu32;
#define RLX_AGENT __ATOMIC_RELAXED, __HIP_MEMORY_SCOPE_AGENT
#define LDS_WAIT() asm volatile("s_waitcnt lgkmcnt(0)" ::: "memory")
#define VM_WAIT() asm volatile("s_waitcnt vmcnt(0)" ::: "memory")
DI unsigned f2bf(float f) { unsigned u = __builtin_bit_cast(unsigned, f); return (u + 0x7fffu + ((u >> 16) & 1u)) >> 16; }
DI unsigned pk2(float lo, float hi) { return pg8::cvt_pk_bf16(lo, hi); }
DI float bf2f(unsigned h) { return __builtin_bit_cast(float, h << 16); }
DI float bflo(unsigned w) { return __builtin_bit_cast(float, w << 16); }
DI float bfhi(unsigned w) { return __builtin_bit_cast(float, w & 0xffff0000u); }
DI float sigmoidf_(float x) { return 1.0f / (1.0f + __expf(-x)); }
DI float siluf_(float x) { return x / (1.0f + __expf(-x)); }
DI float shfl_idx(float v, int src) { return __builtin_bit_cast(float, __builtin_amdgcn_ds_bpermute(src << 2, __builtin_bit_cast(int, v))); }
DI unsigned shfl_idx_u(unsigned v, int src) { return (unsigned)__builtin_amdgcn_ds_bpermute(src << 2, (int)v); }
DI float shx(float v, int m, int lane) { return shfl_idx(v, lane ^ m); }
DI float wave_sum(float v, int lane) {
#pragma unroll
    for (int o = 1; o < 64; o <<= 1) v += shx(v, o, lane);
    return v;
}
DI unsigned off_b(unsigned row, unsigned ch) { return 256u * row + 16u * (ch ^ (((row & 3u) << 2) | ((row >> 2) & 3u))); }
DI unsigned tr_addr(unsigned lane, unsigned r0, unsigned c, unsigned t) {
    const unsigned g = lane >> 4, q = (lane & 15u) >> 2, p = lane & 3u;
    return off_b(r0 + 8u * g + 4u * t + q, 2u * c + (p >> 1)) + 8u * (p & 1u);
}
DI s16x4 tr_read(LAS const unsigned char* p) { return __builtin_amdgcn_ds_read_tr16_b64_v4i16((LAS s16x4*)p); }
DI bf16x8 tr_read8(LAS const unsigned char* base, unsigned lane, unsigned r0, unsigned c) {
    const s16x4 lo = tr_read(base + tr_addr(lane, r0, c, 0)), hi = tr_read(base + tr_addr(lane, r0, c, 1));
    return __builtin_shufflevector(lo, hi, 0, 1, 2, 3, 4, 5, 6, 7);
}
DI bf16x8 lds_rd8(LAS const unsigned char* p) { return *(const LAS bf16x8*)p; }
DI bf16x8 as_bf16x8(u32x4 v) { return __builtin_bit_cast(bf16x8, v); }
#define MFMA16(a, b, c) __builtin_amdgcn_mfma_f32_16x16x32_bf16((a), (b), (c), 0, 0, 0)

namespace pg8 {
template <int MODE> struct EpiB {
    static constexpr bool PERM = true, AFTER_DRAIN = false;
    bf16_t* O; int ldc; const float* rope;
    __device__ __forceinline__ void operator()(const f32x4 (&acc)[2][2][4][2], const Unit& u, int wr, int wc, int fr, int fq) const {
        { int l; asm volatile("v_mbcnt_lo_u32_b32 %0, -1, 0\n\tv_mbcnt_hi_u32_b32 %0, -1, %0" : "=v"(l)); fr = l & 15; fq = l >> 4; }
        const int row0 = u.pm * BM + wr * 64 + fr;
        bool rp = false;
        if (MODE == 2) { const int pn = u.pn; rp = (pn < 10) || pn == 12 || pn == 13 || pn == 16 || pn == 17; }
        if (MODE == 2 && rp) {
            const int colb = u.pn * BM + 128 * (wc >> 1) + 32 * (wc & 1) + 8 * fq, jj0 = 32 * (wc & 1) + 8 * fq;
#pragma unroll
            for (int ai = 0; ai < 2; ++ai)
#pragma unroll
                for (int m = 0; m < 4; ++m) {
                    const int row = row0 + ai * HALF + m * 16;
                    const float* rpp = (const float*)((const char*)rope + (unsigned)(((unsigned)row * 64u + (unsigned)jj0) * 8u));
                    const f32x4 cs0 = *(const f32x4*)(rpp), cs1 = *(const f32x4*)(rpp + 4), cs2 = *(const f32x4*)(rpp + 8), cs3 = *(const f32x4*)(rpp + 12);
                    const f32x4 x1a = acc[ai][0][m][0], x1b = acc[ai][0][m][1], x2a = acc[ai][1][m][0], x2b = acc[ai][1][m][1];
                    float c[8] = {cs0[0], cs0[2], cs1[0], cs1[2], cs2[0], cs2[2], cs3[0], cs3[2]};
                    float s[8] = {cs0[1], cs0[3], cs1[1], cs1[3], cs2[1], cs2[3], cs3[1], cs3[3]};
                    float x1[8] = {x1a[0], x1a[1], x1a[2], x1a[3], x1b[0], x1b[1], x1b[2], x1b[3]};
                    float x2[8] = {x2a[0], x2a[1], x2a[2], x2a[3], x2b[0], x2b[1], x2b[2], x2b[3]};
                    float o1[8], o2[8];
#pragma unroll
                    for (int k = 0; k < 8; ++k) { o1[k] = x1[k] * c[k] - x2[k] * s[k]; o2[k] = x2[k] * c[k] + x1[k] * s[k]; }
                    u32x4 w1, w2;
                    w1.x = cvt_pk_bf16(o1[0], o1[1]); w1.y = cvt_pk_bf16(o1[2], o1[3]); w1.z = cvt_pk_bf16(o1[4], o1[5]); w1.w = cvt_pk_bf16(o1[6], o1[7]);
                    w2.x = cvt_pk_bf16(o2[0], o2[1]); w2.y = cvt_pk_bf16(o2[2], o2[3]); w2.z = cvt_pk_bf16(o2[4], o2[5]); w2.w = cvt_pk_bf16(o2[6], o2[7]);
                    bf16_t* rowp = (bf16_t*)((char*)O + (unsigned)(((unsigned)row * (unsigned)ldc + (unsigned)colb) * 2u));
                    *(u32x4*)(rowp) = w1; *(u32x4*)(rowp + 64) = w2;
                    asm volatile("" ::: "memory");
                }
        } else {
            const int col0 = u.pn * BM + wc * 32 + 8 * fq;
#pragma unroll
            for (int ai = 0; ai < 2; ++ai)
#pragma unroll
                for (int m = 0; m < 4; ++m) { bf16_t* rowp = (bf16_t*)((char*)O + (unsigned)(((unsigned)(row0 + ai * HALF + m * 16) * (unsigned)ldc + (unsigned)col0) * 2u));
#pragma unroll
                    for (int bj = 0; bj < 2; ++bj) { f32x4 v0 = acc[ai][bj][m][0], v1 = acc[ai][bj][m][1];
                        if (MODE == 1) {
#pragma unroll
                            for (int k = 0; k < 4; ++k) { const float a = fmaxf(v0[k], 0.f), b = fmaxf(v1[k], 0.f); v0[k] = a * a; v1[k] = b * b; } }
                        u32x4 w; w.x = cvt_pk_bf16(v0[0], v0[1]); w.y = cvt_pk_bf16(v0[2], v0[3]); w.z = cvt_pk_bf16(v1[0], v1[1]); w.w = cvt_pk_bf16(v1[2], v1[3]);
                        *(u32x4*)(rowp + bj * HALF) = w; } }
        }
    }
};
template <bool GATE> struct EpiRes {
    static constexpr bool PERM = false, AFTER_DRAIN = false;
    const float* xin; float* xout; int ldc; const bf16_t* e;
    __device__ __forceinline__ void operator()(const f32x4 (&acc)[2][2][4][2], const Unit& u, int wr, int wc, int fr, int fq) const {
        { int l; asm volatile("v_mbcnt_lo_u32_b32 %0, -1, 0\n\tv_mbcnt_hi_u32_b32 %0, -1, %0" : "=v"(l)); fr = l & 15; fq = l >> 4; }
        const int row0 = u.pm * BM + wr * 64 + fr, col0 = u.pn * BM + wc * 32 + 4 * fq;
#pragma unroll
        for (int ai = 0; ai < 2; ++ai)
#pragma unroll
            for (int m = 0; m < 4; ++m) { const unsigned off = (unsigned)(row0 + ai * HALF + m * 16) * (unsigned)ldc + (unsigned)col0;
#pragma unroll
                for (int bj = 0; bj < 2; ++bj)
#pragma unroll
                    for (int n = 0; n < 2; ++n) { const unsigned o = off + bj * HALF + n * 16; const f32x4 xv = *(const f32x4*)((const char*)xin + (unsigned)(o * 4u)); f32x4 a = acc[ai][bj][m][n];
                        if (GATE) { typedef unsigned u32x2v __attribute__((ext_vector_type(2))); const u32x2v ev = *(const u32x2v*)((const char*)e + (unsigned)(o * 2u));
                            const float e0 = __builtin_bit_cast(float, ev.x << 16), e1 = __builtin_bit_cast(float, ev.x & 0xffff0000u), e2 = __builtin_bit_cast(float, ev.y << 16), e3 = __builtin_bit_cast(float, ev.y & 0xffff0000u);
                            a[0] = e0 / (1.0f + __expf(-a[0])); a[1] = e1 / (1.0f + __expf(-a[1])); a[2] = e2 / (1.0f + __expf(-a[2])); a[3] = e3 / (1.0f + __expf(-a[3])); }
                        *(f32x4*)((char*)xout + (unsigned)(o * 4u)) = xv + a; }
                asm volatile("" ::: "memory"); }
    }
};
}
#define XB_TMO      128
#define XB_XCNT(j)  (256  + 64 * (j))
#define XB_XSUB(j)  (1280 + 64 * (j))
#define XB_XGEN(j)  (2304 + 64 * (j))
#define XB_TOP      3328
#define XB_TOPGEN   3392
#define XCD_BAR_WORDS 3456
#define XB_SPIN_CAP (1u << 18)

__device__ __forceinline__ unsigned xb_ld(unsigned* p)              { return __hip_atomic_load(p, __ATOMIC_RELAXED, __HIP_MEMORY_SCOPE_AGENT); }
__device__ __forceinline__ unsigned xb_add(unsigned* p, unsigned v) { return __hip_atomic_fetch_add(p, v, __ATOMIC_RELAXED, __HIP_MEMORY_SCOPE_AGENT); }
__device__ __forceinline__ unsigned xb_xcc_id() { return (unsigned)__builtin_amdgcn_s_getreg((3 << 11) | 20) & 0xFu; }
#define XB_SPIN(cond, bar) do { unsigned _sp = 0; while (cond) { __builtin_amdgcn_s_sleep(1); \
    if ((++_sp & 255u) == 0u) { if (xb_ld(&(bar)[XB_TMO])) break; if (_sp > XB_SPIN_CAP) { atomicAdd(&(bar)[XB_TMO], 1u); break; } } } } while (0)

struct XcdBarrier {
    unsigned* bar; unsigned x;
    volatile LAS unsigned* st;
};

__device__ __forceinline__ XcdBarrier xcd_barrier_post(unsigned* bar, volatile LAS unsigned* st) {
    XcdBarrier b; b.bar = bar; b.x = xb_xcc_id(); b.st = st;
    if (threadIdx.x == 0) (void)xb_add(&bar[XB_XCNT(b.x)], 1u);
    return b;
}
__device__ __forceinline__ void xcd_barrier_complete(unsigned* bar, unsigned x, unsigned& nloc, unsigned& nx) {
    const unsigned G = gridDim.x * gridDim.y * gridDim.z;
    unsigned sum, cnt, mine, sp = 0u;
    for (;;) {
        sum = 0u; cnt = 0u; mine = 0u;
#pragma unroll
        for (unsigned j = 0; j < 16; ++j) { const unsigned c = xb_ld(&bar[XB_XCNT(j)]); sum += c; cnt += (c > 0u) ? 1u : 0u; mine = (j == x) ? c : mine; }
        if (sum == G) break;
        __builtin_amdgcn_s_sleep(1);
        if ((++sp & 255u) == 0u) { if (xb_ld(&bar[XB_TMO])) break; if (sp > XB_SPIN_CAP) { atomicAdd(&bar[XB_TMO], 1u); break; } }
    }
    nloc = mine > 0u ? mine : 1u; nx = cnt > 0u ? cnt : 1u;
}

__device__ __forceinline__ void xcd_barrier(const XcdBarrier& b) {
    asm volatile("s_waitcnt vmcnt(0)" ::: "memory");
    __syncthreads();
    if (threadIdx.x == 0) {
        unsigned* bar = b.bar;
        __builtin_amdgcn_s_waitcnt(0);
        unsigned nloc = b.st[0], nx = b.st[1];
        if (nloc == 0u) { xcd_barrier_complete(bar, b.x, nloc, nx); b.st[0] = nloc; b.st[1] = nx; }
        const unsigned old = xb_add(&bar[XB_XSUB(b.x)], 1u);
        const unsigned gen = old / nloc;
        if (old + 1u == (gen + 1u) * nloc) {
            __builtin_amdgcn_fence(__ATOMIC_RELEASE, "agent");
            asm volatile("s_waitcnt vmcnt(0)" ::: "memory");
            const unsigned og = xb_add(&bar[XB_TOP], 1u);
            const unsigned tg = og / nx;
            if (og + 1u == (tg + 1u) * nx) xb_add(&bar[XB_TOPGEN], 1u);
            else XB_SPIN(xb_ld(&bar[XB_TOPGEN]) == tg, bar);
            __builtin_amdgcn_fence(__ATOMIC_ACQUIRE, "agent");
            xb_add(&bar[XB_XGEN(b.x)], 1u);
            asm volatile("s_waitcnt vmcnt(0)" ::: "memory");
        } else {
            XB_SPIN(xb_ld(&bar[XB_XGEN(b.x)]) == gen, bar);
            __builtin_amdgcn_fence(__ATOMIC_ACQUIRE, "agent");
            asm volatile("s_waitcnt vmcnt(0)" ::: "memory");
        }
    }
    __syncthreads();
}

struct Args { const void* in[30]; float* out; unsigned char* ws; int ph_lo, ph_hi; };
struct Frame {
    LAS unsigned char* lds;
    gu32* ctl;
    unsigned char* ws;
    int tid, lane, wave, G, bid;
};
DI const void* argin(const Args&, int k) {
    typedef const void* const __attribute__((address_space(4)))* kptr_t;
    kptr_t p = (kptr_t)__builtin_amdgcn_kernarg_segment_ptr(); asm volatile("" : "+s"(p));
    return (const void*)p[k]; }
DI int launder_s(int x) { asm volatile("" : "+s"(x)); return x; }
DI Frame phase_frame(const Frame& F0) { Frame F = F0;
    int l; asm volatile("v_mbcnt_lo_u32_b32 %0, -1, 0\n\tv_mbcnt_hi_u32_b32 %0, -1, %0" : "=v"(l));
    F.wave = launder_s(F0.wave); F.bid = launder_s(F0.bid); F.G = launder_s(F0.G);
    F.lane = l; F.tid = F.wave * 64 + l;
    { unsigned long long wsb = (unsigned long long)F0.ws; asm volatile("" : "+s"(wsb)); F.ws = (unsigned char*)wsb; }
    { unsigned ll = (unsigned)(size_t)F0.lds; asm volatile("" : "+s"(ll)); F.lds = (LAS unsigned char*)(size_t)ll; }
    return F; }
DI unsigned char* lw_ptr(const Frame& F, int layer, size_t off) { return F.ws + WS_W + (size_t)layer * LW_STRIDE + off; }

DI void transpose_item(const float* W, int K, int Nsrc, int nsrc0, bf16* WT, int dst_row0, int k0, LAS float* scr, int lane) {
#pragma unroll 8
    for (int i = 0; i < 32; ++i) { const int kk = 2 * i + (lane >> 5); scr[kk * 33 + (lane & 31)] = W[(size_t)(k0 + kk) * Nsrc + nsrc0 + (lane & 31)]; }
    LDS_WAIT(); asm volatile("" ::: "memory");
    const int c = lane & 7;
#pragma unroll
    for (int j = 0; j < 4; ++j) { const int n = (lane >> 3) + 8 * j; const LAS float* s = scr + (8 * c) * 33 + n;
        u32x4 o; o.x = pk2(s[0 * 33], s[1 * 33]); o.y = pk2(s[2 * 33], s[3 * 33]); o.z = pk2(s[4 * 33], s[5 * 33]); o.w = pk2(s[6 * 33], s[7 * 33]);
        *(u32x4*)(WT + (size_t)(dst_row0 + n) * K + k0 + 8 * c) = o; }
    LDS_WAIT(); asm volatile("" ::: "memory");
}
DI int proj_src_col(int d) {
    if (d < 5120) {
        const int pn = d >> 8; const bool rp = (pn < 10) || pn == 12 || pn == 13 || pn == 16 || pn == 17;
        if (!rp) return d;
        const int c = d & 255, bj = c >> 7, wc = (c >> 5) & 3;
        return (pn << 8) + 128 * (wc >> 1) + 64 * bj + 32 * (wc & 1);
    }
    if (d < 16384) return d + 48;
    if (d < 22528) return d + 80;
    if (d < 22592) return S_GN + (d - 22528);
    if (d < 22624) return S_DT + (d - 22592);
    return 0;
}
constexpr int TI_IN = 32 * 712, TI_O = 32 * 64, TI_UP = 32 * 256, TI_DOWN = 128 * 64, TI_PG = 32 * 64, TI_PLE = 4 * 64, TI_P1 = 64 * 4, TI_P2 = 2 * 4;
constexpr int TI_LAYER = TI_IN + TI_O + TI_UP + TI_DOWN + TI_PG + TI_PLE + 2 * TI_P1 + 2 * TI_P2;

DI void p0_prologue(const Frame& F0, const Args& A) {
    const Frame F = phase_frame(F0);
    LAS float* scr = (LAS float*)(F.lds + F.wave * 16384);
    const int gw = F.bid * NWAVES + F.wave, NGW = F.G * NWAVES;
    for (int it = gw; it < DEPTH * TI_LAYER; it += NGW) {
        const int layer = it / TI_LAYER; int r = it - layer * TI_LAYER;
        if (r < TI_IN) { const int kb = r / 712, nb = r - kb * 712;
            transpose_item((const float*)argin(A, 4) + (size_t)layer * DM * PROJ_SRC, DM, PROJ_SRC, proj_src_col(nb * 32), (bf16*)lw_ptr(F, layer, LW_IN), nb * 32, kb * 64, scr, F.lane); continue; } r -= TI_IN;
        if (r < TI_O) { const int kb = r / 64, nb = r % 64;
            transpose_item((const float*)argin(A, 22) + (size_t)layer * DM * DM, DM, DM, nb * 32, (bf16*)lw_ptr(F, layer, LW_O), nb * 32, kb * 64, scr, F.lane); continue; } r -= TI_O;
        if (r < TI_UP) { const int kb = r / 256, nb = r % 256;
            transpose_item((const float*)argin(A, 24) + (size_t)layer * DM * DFF, DM, DFF, nb * 32, (bf16*)lw_ptr(F, layer, LW_UP), nb * 32, kb * 64, scr, F.lane); continue; } r -= TI_UP;
        if (r < TI_DOWN) { const int kb = r / 64, nb = r % 64;
            transpose_item((const float*)argin(A, 25) + (size_t)layer * DFF * DM, DFF, DM, nb * 32, (bf16*)lw_ptr(F, layer, LW_DOWN), nb * 32, kb * 64, scr, F.lane); continue; } r -= TI_DOWN;
        if (r < TI_PG) { const int kb = r / 64, nb = r % 64;
            transpose_item((const float*)argin(A, 28) + (size_t)layer * DM * DM, DM, DM, nb * 32, (bf16*)lw_ptr(F, layer, LW_PG), nb * 32, kb * 64, scr, F.lane); continue; } r -= TI_PG;
        if (r < TI_PLE) { const int kb = r / 64, nb = r % 64;
            transpose_item((const float*)argin(A, 27) + (size_t)layer * PLE * DM, PLE, DM, nb * 32, (bf16*)lw_ptr(F, layer, LW_PLE), nb * 32, kb * 64, scr, F.lane); continue; } r -= TI_PLE;
        if (r < TI_P1) { const int kb = r / 4, nb = r % 4;
            transpose_item((const float*)argin(A, 7) + (size_t)layer * 4096 * 128, 4096, 128, nb * 32, (bf16*)lw_ptr(F, layer, LW_PK1), nb * 32, kb * 64, scr, F.lane); continue; } r -= TI_P1;
        if (r < TI_P1) { const int kb = r / 4, nb = r % 4;
            transpose_item((const float*)argin(A, 11) + (size_t)layer * 4096 * 128, 4096, 128, nb * 32, (bf16*)lw_ptr(F, layer, LW_PV1), nb * 32, kb * 64, scr, F.lane); continue; } r -= TI_P1;
        if (r < TI_P2) { const int kb = r / 4, nb = r % 4;
            transpose_item((const float*)argin(A, 9) + (size_t)layer * 128 * 128, 128, 128, nb * 32, (bf16*)lw_ptr(F, layer, LW_PK2), nb * 32, kb * 64, scr, F.lane); continue; } r -= TI_P2;
        { const int kb = r / 4, nb = r % 4;
            transpose_item((const float*)argin(A, 13) + (size_t)layer * 128 * 128, 128, 128, nb * 32, (bf16*)lw_ptr(F, layer, LW_PV2), nb * 32, kb * 64, scr, F.lane); }
    }
    const size_t gt = (size_t)F.bid * NTHR + F.tid, NGT = (size_t)F.G * NTHR;
    { const float* p = (const float*)argin(A, 1); bf16* pb = (bf16*)(F.ws + WS_PB);
      for (size_t i = gt; i < (size_t)DEPTH * M * PLE / 8; i += NGT) { const f32x4 a = *(const f32x4*)(p + i * 8), b = *(const f32x4*)(p + i * 8 + 4);
          u32x4 o; o.x = pk2(a[0], a[1]); o.y = pk2(a[2], a[3]); o.z = pk2(b[0], b[1]); o.w = pk2(b[2], b[3]); *(u32x4*)(pb + i * 8) = o; } }
    { const int* pos = (const int*)argin(A, 2); float* rope = (float*)(F.ws + WS_ROPE);
      for (size_t i = gt; i < (size_t)M * 64; i += NGT) { const int row = (int)(i >> 6), jj = (int)(i & 63);
          const float inv = 1.0f / powf(10000.0f, (float)(2 * jj) * (1.0f / 128.0f));
          const float ang = (float)pos[row] * inv;
          double a = (double)ang; a -= 6.283185307179586476925 * __builtin_rint(a * 0.15915494309189533577);
          const float ar = (float)a;
          rope[i * 2] = cosf(ar); rope[i * 2 + 1] = sinf(ar); } }
    { float* part = (float*)(F.ws + WS_MISC);
      for (size_t i = gt; i < (size_t)DEPTH * 2 * 8 * 128; i += NGT) { const int hid = (int)(i & 127), c = (int)(i >> 7) & 7, kv = (int)(i >> 10) & 1, layer = (int)(i >> 11);
          const float* pe = (const float*)(kv ? A.in[6] : A.in[5]) + (size_t)layer * 4096 + c * 512;
          const float* w1 = (const float*)(kv ? A.in[11] : A.in[7]) + (size_t)layer * 4096 * 128 + (size_t)c * 512 * 128 + hid;
          float s = 0.f;
#pragma unroll 8
          for (int kk = 0; kk < 512; ++kk) s += pe[kk] * w1[(size_t)kk * 128];
          part[i] = s; } }
}

template <bool OUTF32> DI void norm_rows(const Frame& F0, const float* x, const float* g, void* outp) {
    const Frame F = phase_frame(F0);
    const int gw = F.bid * NWAVES + F.wave, NGW = F.G * NWAVES;
    for (int m = gw; m < M; m += NGW) {
        const f32x4* xr = (const f32x4*)(x + (size_t)m * DM) + F.lane;
        f32x4 v[8]; float s = 0.f;
#pragma unroll
        for (int j = 0; j < 8; ++j) { v[j] = xr[64 * j]; s += (v[j][0] * v[j][0] + v[j][1] * v[j][1]) + (v[j][2] * v[j][2] + v[j][3] * v[j][3]); }
        const float rstd = 1.0f / sqrtf(wave_sum(s, F.lane) * (1.0f / DM) + EPS);
#pragma unroll
        for (int j = 0; j < 8; ++j) { const f32x4 gv = ((const f32x4*)g)[F.lane + 64 * j]; const f32x4 o = v[j] * rstd * gv;
            if (OUTF32) ((f32x4*)((float*)outp + (size_t)m * DM))[F.lane + 64 * j] = o;
            else { u32x2 w; w.x = pk2(o[0], o[1]); w.y = pk2(o[2], o[3]); ((u32x2*)((bf16*)outp + (size_t)m * DM))[F.lane + 64 * j] = w; } }
    }
}
DI void unpack8(u32x4 w, float (&f)[8]) { f[0] = bflo(w.x); f[1] = bfhi(w.x); f[2] = bflo(w.y); f[3] = bfhi(w.y); f[4] = bflo(w.z); f[5] = bfhi(w.z); f[6] = bflo(w.w); f[7] = bfhi(w.w); }
DI u32x4 pack8f(const float (&f)[8]) { u32x4 o; o.x = pk2(f[0], f[1]); o.y = pk2(f[2], f[3]); o.z = pk2(f[4], f[5]); o.w = pk2(f[6], f[7]); return o; }

DI void ssd_conv_pass(const Frame& F0, const Args& A, int layer) {
    const Frame F = phase_frame(F0);
    const bf16* proj = (const bf16*)(F.ws + WS_PROJ); bf16* xbc = (bf16*)(F.ws + WS_XBC);
    const float* cw = (const float*)argin(A, 16) + (size_t)layer * 4 * SSD_XBC; const float* cb = (const float*)argin(A, 17) + (size_t)layer * SSD_XBC;
    const int gt = F.bid * NTHR + F.tid, NGT = F.G * NTHR;
    for (int task = gt; task < 512 * 384; task += NGT) {
        const int run = task / 384, cg = task - run * 384, ch = cg * 8, row0 = run * 32;
        float w[4][8], bs[8], xm3[8], xm2[8], xm1[8];
#pragma unroll
        for (int j = 0; j < 4; ++j) { const f32x4 a = *(const f32x4*)(cw + j * SSD_XBC + ch), b = *(const f32x4*)(cw + j * SSD_XBC + ch + 4);
            w[j][0] = a[0]; w[j][1] = a[1]; w[j][2] = a[2]; w[j][3] = a[3]; w[j][4] = b[0]; w[j][5] = b[1]; w[j][6] = b[2]; w[j][7] = b[3]; }
        { const f32x4 a = *(const f32x4*)(cb + ch), b = *(const f32x4*)(cb + ch + 4); bs[0] = a[0]; bs[1] = a[1]; bs[2] = a[2]; bs[3] = a[3]; bs[4] = b[0]; bs[5] = b[1]; bs[6] = b[2]; bs[7] = b[3]; }
        if ((row0 & (SEQ - 1)) != 0) {
            unpack8(*(const u32x4*)(proj + (size_t)(row0 - 3) * LDP + C_XBC + ch), xm3);
            unpack8(*(const u32x4*)(proj + (size_t)(row0 - 2) * LDP + C_XBC + ch), xm2);
            unpack8(*(const u32x4*)(proj + (size_t)(row0 - 1) * LDP + C_XBC + ch), xm1);
        } else {
#pragma unroll
            for (int k = 0; k < 8; ++k) { xm3[k] = 0.f; xm2[k] = 0.f; xm1[k] = 0.f; }
        }
#pragma unroll 4
        for (int r = 0; r < 32; ++r) {
            float cur[8], y[8]; unpack8(*(const u32x4*)(proj + (size_t)(row0 + r) * LDP + C_XBC + ch), cur);
#pragma unroll
            for (int k = 0; k < 8; ++k) { const float v = w[0][k] * xm3[k] + w[1][k] * xm2[k] + w[2][k] * xm1[k] + w[3][k] * cur[k] + bs[k]; y[k] = siluf_(v); xm3[k] = xm2[k]; xm2[k] = xm1[k]; xm1[k] = cur[k]; }
            *(u32x4*)(xbc + (size_t)(row0 + r) * SSD_XBC + ch) = pack8f(y);
            asm volatile("" ::: "memory");
        }
    }
    const float* dtb = (const float*)argin(A, 18) + layer * SSD_H; float* dt = (float*)(F.ws + WS_DT);
    for (int i = gt; i < M * SSD_H; i += NGT) { const int row = i >> 5, h = i & 31;
        const float x = bf2f(proj[(size_t)row * LDP + C_DT + h]) + dtb[h];
        dt[i] = fmaxf(x, 0.f) + log1pf(__expf(-fabsf(x))); }
}

DI void merge_pass(const Frame& F0, const Args& A, int layer) {
    const Frame F = phase_frame(F0);
    const bf16* proj = (const bf16*)(F.ws + WS_PROJ); const bf16* ya = (const bf16*)(F.ws + WS_YA); const bf16* yc = (const bf16*)(F.ws + WS_YC); bf16* hb = (bf16*)(F.ws + WS_HB);
    const float* sw = (const float*)argin(A, 15) + (size_t)layer * 3 * DM;
    const int gt = F.bid * NTHR + F.tid, NGT = F.G * NTHR;
    for (int task = gt; task < 512 * 256; task += NGT) {
        const int run = task >> 8, cg = task & 255, ch = cg * 8, row0 = run * 32;
        float w[3][8], pm2[8], pm1[8];
#pragma unroll
        for (int j = 0; j < 3; ++j) { const f32x4 a = *(const f32x4*)(sw + j * DM + ch), b = *(const f32x4*)(sw + j * DM + ch + 4);
            w[j][0] = a[0]; w[j][1] = a[1]; w[j][2] = a[2]; w[j][3] = a[3]; w[j][4] = b[0]; w[j][5] = b[1]; w[j][6] = b[2]; w[j][7] = b[3]; }
        if ((row0 & (SEQ - 1)) != 0) {
            float c1[8], u1[8];
            unpack8(*(const u32x4*)(proj + (size_t)(row0 - 2) * LDP + C_CC + ch), c1); unpack8(*(const u32x4*)(proj + (size_t)(row0 - 2) * LDP + C_CU + ch), u1);
#pragma unroll
            for (int k = 0; k < 8; ++k) pm2[k] = c1[k] * u1[k];
            unpack8(*(const u32x4*)(proj + (size_t)(row0 - 1) * LDP + C_CC + ch), c1); unpack8(*(const u32x4*)(proj + (size_t)(row0 - 1) * LDP + C_CU + ch), u1);
#pragma unroll
            for (int k = 0; k < 8; ++k) pm1[k] = c1[k] * u1[k];
        } else {
#pragma unroll
            for (int k = 0; k < 8; ++k) { pm2[k] = 0.f; pm1[k] = 0.f; }
        }
#pragma unroll 2
        for (int r = 0; r < 32; ++r) {
            const size_t pr = (size_t)(row0 + r) * LDP + ch, yr = (size_t)(row0 + r) * DM + ch;
            float cc[8], cu[8], cbv[8], g0[8], g1[8], g2[8], a[8], c[8], o[8];
            unpack8(*(const u32x4*)(proj + pr + C_CC), cc); unpack8(*(const u32x4*)(proj + pr + C_CU), cu); unpack8(*(const u32x4*)(proj + pr + C_CB), cbv);
            unpack8(*(const u32x4*)(proj + pr + C_GM), g0); unpack8(*(const u32x4*)(proj + pr + C_GM + DM), g1); unpack8(*(const u32x4*)(proj + pr + C_GM + 2 * DM), g2);
            unpack8(*(const u32x4*)(ya + yr), a); unpack8(*(const u32x4*)(yc + yr), c);
#pragma unroll
            for (int k = 0; k < 8; ++k) { const float pc = cc[k] * cu[k]; const float cv = w[0][k] * pm2[k] + w[1][k] * pm1[k] + w[2][k] * pc; pm2[k] = pm1[k]; pm1[k] = pc;
                o[k] = sigmoidf_(g0[k]) * a[k] + sigmoidf_(g1[k]) * (cbv[k] * cv) + sigmoidf_(g2[k]) * c[k]; }
            *(u32x4*)(hb + yr) = pack8f(o);
            asm volatile("" ::: "memory");
        }
    }
}

DI void compress_phase(const Frame& F0, const Args& A, int layer) {
    const Frame F = phase_frame(F0);
    const bf16* proj = (const bf16*)(F.ws + WS_PROJ);
    LAS unsigned char* slab = F.lds;
    LAS unsigned char* hidl = F.lds + 73728;
    LAS float* b1s = (LAS float*)(F.lds + 81920);
    const int lane = F.lane, w = F.wave, i = lane & 15, qd = lane >> 4;
    const float* part = (const float*)(F.ws + WS_MISC);
    for (int u = F.bid; u < 512; u += F.G) {
        const int kv = u >> 8, b = (u >> 7) & 1, g = (u >> 5) & 3, nb = u & 31, n0 = nb * 16, tok0 = n0 * 16;
        const int col = (kv ? C_VC : C_KC) + g * HD;
        for (int id = F.tid; id < 272 * 16; id += NTHR) { const int row = id >> 4, ch = id & 15, t = tok0 + row;
            u32x4 v = {0u, 0u, 0u, 0u}; if (t < SEQ) v = *(const u32x4*)(proj + (size_t)(b * SEQ + t) * LDP + col + ch * 8);
            *(LAS u32x4*)(slab + off_b(row, ch)) = v; }
        if (F.tid < 128) { float s = ((const float*)argin(A, kv ? 12 : 8))[layer * 128 + F.tid];
#pragma unroll
            for (int c = 0; c < 8; ++c) s += part[(((size_t)layer * 2 + kv) * 8 + c) * 128 + F.tid];
            b1s[F.tid] = s; }
        __syncthreads();
        const bf16* w1t = (const bf16*)lw_ptr(F, layer, kv ? LW_PV1 : LW_PK1) + (size_t)(16 * w + i) * 4096 + 8 * qd;
        f32x4 acc = {0.f, 0.f, 0.f, 0.f};
#pragma unroll 8
        for (int ks = 0; ks < 128; ++ks) {
            const bf16x8 a = lds_rd8(slab + off_b(16 * i + (ks >> 2), 4 * (ks & 3) + qd));
            const bf16x8 bb = *(const bf16x8*)(w1t + 32 * ks);
            acc = MFMA16(a, bb, acc);
        }
        { const float bv = b1s[16 * w + i];
#pragma unroll
          for (int j = 0; j < 4; ++j) *(LAS bf16*)(hidl + (4 * qd + j) * 272 + (16 * w + i) * 2) = (bf16)f2bf(siluf_(acc[j] + bv)); }
        __syncthreads();
        const bf16* w2t = (const bf16*)lw_ptr(F, layer, kv ? LW_PV2 : LW_PK2) + (size_t)(16 * w + i) * 128 + 8 * qd;
        f32x4 acc2 = {0.f, 0.f, 0.f, 0.f};
#pragma unroll
        for (int s = 0; s < 4; ++s) {
            const bf16x8 a = lds_rd8(hidl + i * 272 + 64 * s + 16 * qd);
            const bf16x8 bb = *(const bf16x8*)(w2t + 32 * s);
            acc2 = MFMA16(a, bb, acc2);
        }
        const float b2 = ((const float*)argin(A, kv ? 14 : 10))[layer * 128 + 16 * w + i];
        bf16* dst = (bf16*)(F.ws + (kv ? WS_VCMP : WS_KCMP)) + ((size_t)(b * NG + g) * NCMP_PAD + n0) * HD + 16 * w + i;
#pragma unroll
        for (int j = 0; j < 4; ++j) dst[(size_t)(4 * qd + j) * HD] = (bf16)f2bf(acc2[j] + b2);
        __syncthreads();
    }
}

DI void ssd_states_phase(const Frame& F0, const Args& A, int layer) {
    const Frame F = phase_frame(F0);
    const bf16* xbc = (const bf16*)(F.ws + WS_XBC); const float* dt = (const float*)(F.ws + WS_DT);
    float* acs = (float*)(F.ws + WS_ACS); float* cdec = (float*)(F.ws + WS_CDEC); float* st = (float*)(F.ws + WS_ST);
    LAS unsigned char* Bt = F.lds; LAS unsigned char* Xt = F.lds + 32768; LAS float* sc = (LAS float*)(F.lds + 65536);
    const float* alog = (const float*)argin(A, 19) + layer * SSD_H;
    const int lane = F.lane, w = F.wave, i = lane & 15, qd = lane >> 4;
    for (int u = F.bid; u < 512; u += F.G) {
        const int b = u >> 8, c = (u >> 2) & 63, g = u & 3, row0 = b * SEQ + c * SSD_CH;
        {
            const int hh = g * 8 + w; const float a = -__expf(alog[hh]);
            const float dt0 = dt[(size_t)(row0 + 2 * lane) * SSD_H + hh], dt1 = dt[(size_t)(row0 + 2 * lane + 1) * SSD_H + hh];
            const float d0 = dt0 * a, d1 = dt1 * a, pair = d0 + d1; float s = pair;
#pragma unroll
            for (int o = 1; o < 64; o <<= 1) { const float t = shfl_idx(s, lane - o); if (lane >= o) s += t; }
            const float a0 = (s - pair) + d0, a1 = s, total = __builtin_bit_cast(float, __builtin_amdgcn_readlane(__builtin_bit_cast(int, s), 63));
            acs[(size_t)(row0 + 2 * lane) * SSD_H + hh] = a0; acs[(size_t)(row0 + 2 * lane + 1) * SSD_H + hh] = a1;
            sc[w * 128 + 2 * lane] = dt0 * __expf(total - a0); sc[w * 128 + 2 * lane + 1] = dt1 * __expf(total - a1);
            if (lane == 0) cdec[(size_t)(b * SSD_NC + c) * SSD_H + hh] = __expf(total);
        }
        for (int id = F.tid; id < 128 * 16; id += NTHR) { const int row = id >> 4, ch = id & 15;
            *(LAS u32x4*)(Bt + off_b(row, ch)) = *(const u32x4*)(xbc + (size_t)(row0 + row) * SSD_XBC + 2048 + g * 128 + ch * 8); }
        bf16x8 bfr[4];
        for (int hp = 0; hp < 4; ++hp) {
            __syncthreads();
            for (int id = F.tid; id < 128 * 16; id += NTHR) { const int row = id >> 4, ch = id & 15;
                float x[8]; unpack8(*(const u32x4*)(xbc + (size_t)(row0 + row) * SSD_XBC + g * 512 + hp * 128 + ch * 8), x);
                const float f = sc[(hp * 2 + (ch >> 3)) * 128 + row];
#pragma unroll
                for (int k = 0; k < 8; ++k) x[k] *= f;
                *(LAS u32x4*)(Xt + off_b(row, ch)) = pack8f(x); }
            __syncthreads();
            if (hp == 0) {
#pragma unroll
                for (int ks = 0; ks < 4; ++ks) bfr[ks] = tr_read8(Bt, lane, 32 * ks, w);
            }
#pragma unroll
            for (int h2 = 0; h2 < 2; ++h2) {
                const int head = g * 8 + hp * 2 + h2;
                float* dst = st + ((size_t)((b * SSD_NC + c) * SSD_H + head) * SSD_N + 16 * w + i) * SSD_P + 4 * qd;
#pragma unroll
                for (int pt = 0; pt < 4; ++pt) {
                    f32x4 acc = {0.f, 0.f, 0.f, 0.f};
#pragma unroll
                    for (int ks = 0; ks < 4; ++ks) acc = MFMA16(tr_read8(Xt, lane, 32 * ks, h2 * 4 + pt), bfr[ks], acc);
                    *(f32x4*)(dst + 16 * pt) = acc;
                }
            }
        }
        __syncthreads();
    }
}
DI void ssd_scan_phase(const Frame& F0) {
    const Frame F = phase_frame(F0);
    f32x4* st = (f32x4*)(F.ws + WS_ST); const float* cdec = (const float*)(F.ws + WS_CDEC);
    const int gt = F.bid * NTHR + F.tid, NGT = F.G * NTHR;
    for (int v = gt; v < BATCH * SSD_H * 2048; v += NGT) {
        const int b = v >> 16, h = (v >> 11) & 31, e = v & 2047;
        f32x4* base = st + ((size_t)(b * SSD_NC) * SSD_H + h) * 2048 + e;
        const float* dc = cdec + (size_t)(b * SSD_NC) * SSD_H + h;
        f32x4 hs = {0.f, 0.f, 0.f, 0.f};
        for (int c0 = 0; c0 < SSD_NC; c0 += 8) {
            f32x4 s[8]; float d[8];
#pragma unroll
            for (int k = 0; k < 8; ++k) { s[k] = base[(size_t)(c0 + k) * 65536]; d[k] = dc[(c0 + k) * SSD_H]; }
#pragma unroll
            for (int k = 0; k < 8; ++k) { base[(size_t)(c0 + k) * 65536] = hs; hs = hs * d[k] + s[k]; }
            asm volatile("" ::: "memory");
        }
    }
}
DI void ssd_out_phase(const Frame& F0, const Args& A, int layer) {
    const Frame F = phase_frame(F0);
    const bf16* xbc = (const bf16*)(F.ws + WS_XBC); const bf16* proj = (const bf16*)(F.ws + WS_PROJ);
    const float* dt = (const float*)(F.ws + WS_DT); const float* acs = (const float*)(F.ws + WS_ACS); const float* st = (const float*)(F.ws + WS_ST);
    bf16* yc = (bf16*)(F.ws + WS_YC);
    LAS unsigned char* Bt = F.lds; LAS unsigned char* Ct = F.lds + 32768; LAS unsigned char* Xt = F.lds + 65536; LAS unsigned char* Ht = F.lds + 98304;
    LAS float* acsl = (LAS float*)(F.lds + LX_OFF);
    const float* dsk = (const float*)argin(A, 20) + layer * SSD_H; const float* ng = (const float*)argin(A, 21) + (size_t)layer * DM;
    const int lane = F.lane, w = F.wave, i = lane & 15, qd = lane >> 4;
    for (int u = F.bid; u < 512; u += F.G) {
        const int b = u >> 8, c = (u >> 2) & 63, g = u & 3, row0 = b * SEQ + c * SSD_CH;
        for (int id = F.tid; id < 128 * 16; id += NTHR) { const int row = id >> 4, ch = id & 15; const bf16* src = xbc + (size_t)(row0 + row) * SSD_XBC + 2048 + g * 128 + ch * 8;
            *(LAS u32x4*)(Bt + off_b(row, ch)) = *(const u32x4*)(src); *(LAS u32x4*)(Ct + off_b(row, ch)) = *(const u32x4*)(src + 512); }
        __syncthreads();
        bf16x8 cfr[4];
#pragma unroll
        for (int ks = 0; ks < 4; ++ks) cfr[ks] = lds_rd8(Ct + off_b(16 * w + i, 4 * ks + qd));
        f32x4 cb[4][2];
#pragma unroll
        for (int k = 0; k < 4; ++k)
#pragma unroll
            for (int T = 0; T < 2; ++T) { f32x4 acc = {0.f, 0.f, 0.f, 0.f};
#pragma unroll
                for (int ks = 0; ks < 4; ++ks) acc = MFMA16(lds_rd8(Bt + off_b(32 * k + 8 * (i >> 2) + (i & 3) + 4 * T, 4 * ks + qd)), cfr[ks], acc);
                cb[k][T] = acc; }
        const int lrow = 16 * w + i, row = row0 + lrow;
        float ssq = 0.f;
        for (int hp = 0; hp < 4; ++hp) {
            __syncthreads();
            if (F.tid < 256) { const int h2 = F.tid >> 7, l = F.tid & 127; acsl[F.tid] = acs[(size_t)(row0 + l) * SSD_H + g * 8 + hp * 2 + h2]; }
            for (int id = F.tid; id < 128 * 16; id += NTHR) { const int r = id >> 4, ch = id & 15, head = g * 8 + hp * 2 + (ch >> 3);
                float x[8]; unpack8(*(const u32x4*)(xbc + (size_t)(row0 + r) * SSD_XBC + g * 512 + hp * 128 + ch * 8), x);
                const float f = dt[(size_t)(row0 + r) * SSD_H + head];
#pragma unroll
                for (int k = 0; k < 8; ++k) x[k] *= f;
                *(LAS u32x4*)(Xt + off_b(r, ch)) = pack8f(x);
                const float* hs = st + ((size_t)((b * SSD_NC + c) * SSD_H + head) * SSD_N + r) * SSD_P + (ch & 7) * 8;
                const f32x4 h0 = *(const f32x4*)hs, h1 = *(const f32x4*)(hs + 4);
                u32x4 hv; hv.x = pk2(h0[0], h0[1]); hv.y = pk2(h0[2], h0[3]); hv.z = pk2(h1[0], h1[1]); hv.w = pk2(h1[2], h1[3]);
                *(LAS u32x4*)(Ht + off_b(r, ch)) = hv; }
            __syncthreads();
#pragma unroll
            for (int h2 = 0; h2 < 2; ++h2) {
                const int head = g * 8 + hp * 2 + h2;
                const float al = acsl[h2 * 128 + lrow], ea = __expf(al), dsv = dsk[head];
                bf16x8 mfr[4];
#pragma unroll
                for (int k = 0; k < 4; ++k) {
                    const f32x4 a0 = *(const LAS f32x4*)(acsl + h2 * 128 + 32 * k + 8 * qd), a1 = *(const LAS f32x4*)(acsl + h2 * 128 + 32 * k + 8 * qd + 4);
                    float mv[8];
#pragma unroll
                    for (int j = 0; j < 4; ++j) { const int s0 = 32 * k + 8 * qd + j, s1 = s0 + 4;
                        mv[j] = (s0 <= lrow) ? cb[k][0][j] * __expf(al - a0[j]) : 0.f;
                        mv[4 + j] = (s1 <= lrow) ? cb[k][1][j] * __expf(al - a1[j]) : 0.f; }
                    mfr[k] = as_bf16x8(pack8f(mv));
                }
#pragma unroll
                for (int pt = 0; pt < 4; ++pt) {
                    f32x4 yd = {0.f, 0.f, 0.f, 0.f}, yo = {0.f, 0.f, 0.f, 0.f};
#pragma unroll
                    for (int k = 0; k < 4; ++k) yd = MFMA16(tr_read8(Xt, lane, 32 * k, h2 * 4 + pt), mfr[k], yd);
#pragma unroll
                    for (int ks = 0; ks < 4; ++ks) yo = MFMA16(tr_read8(Ht, lane, 32 * ks, h2 * 4 + pt), cfr[ks], yo);
                    const int chn = head * SSD_P + 16 * pt + 4 * qd;
                    const u32x2 xv = *(const u32x2*)(xbc + (size_t)row * SSD_XBC + chn), zv = *(const u32x2*)(proj + (size_t)row * LDP + C_Z + chn);
                    const float xs[4] = {bflo(xv.x), bfhi(xv.x), bflo(xv.y), bfhi(xv.y)}, zz[4] = {bflo(zv.x), bfhi(zv.x), bflo(zv.y), bfhi(zv.y)};
                    float gy[4];
#pragma unroll
                    for (int j = 0; j < 4; ++j) { const float y = yd[j] + ea * yo[j] + dsv * xs[j]; gy[j] = y * siluf_(zz[j]); ssq += gy[j] * gy[j]; }
                    u32x2 o; o.x = pk2(gy[0], gy[1]); o.y = pk2(gy[2], gy[3]);
                    *(u32x2*)(yc + (size_t)row * DM + chn) = o;
                }
            }
        }
        ssq += shx(ssq, 16, lane); ssq += shx(ssq, 32, lane);
        const float rstd = 1.0f / sqrtf(ssq * (1.0f / 512.0f) + EPS);
        VM_WAIT();
#pragma unroll 4
        for (int k = 0; k < 32; ++k) { const int chn = g * 512 + 16 * k + 4 * qd;
            const u32x2 v = *(const u32x2*)(yc + (size_t)row * DM + chn); const f32x4 gv = *(const f32x4*)(ng + chn);
            u32x2 o; o.x = pk2(bflo(v.x) * rstd * gv[0], bfhi(v.x) * rstd * gv[1]); o.y = pk2(bflo(v.y) * rstd * gv[2], bfhi(v.y) * rstd * gv[3]);
            *(u32x2*)(yc + (size_t)row * DM + chn) = o; }
        __syncthreads();
    }
}

constexpr int TP = 272, TILE_B = 64 * TP;
DI void tile_load(u32x4 (&kr)[2], u32x4 (&vr)[2], const bf16* kp, const bf16* vp, int pitch, int tid, bool withv) {
#pragma unroll
    for (int k = 0; k < 2; ++k) { const int id = tid + NTHR * k, row = id >> 4, ch = id & 15;
        kr[k] = *(const u32x4*)(kp + (size_t)row * pitch + ch * 8);
        if (withv) vr[k] = *(const u32x4*)(vp + (size_t)row * pitch + ch * 8); }
}
DI void tile_store(const u32x4 (&kr)[2], const u32x4 (&vr)[2], LAS unsigned char* kb, LAS unsigned char* vb, int tid, bool withv) {
#pragma unroll
    for (int k = 0; k < 2; ++k) { const int id = tid + NTHR * k, row = id >> 4, ch = id & 15;
        *(LAS u32x4*)(kb + row * TP + ch * 16) = kr[k];
        if (withv) *(LAS u32x4*)(vb + row * TP + ch * 16) = vr[k]; }
}
DI void tile_scores(LAS const unsigned char* Kt, const bf16x8 (&Qf)[4], f32x4 (&sc)[2][2]) {
#pragma unroll
    for (int kh = 0; kh < 2; ++kh)
#pragma unroll
        for (int T = 0; T < 2; ++T) { f32x4 acc = {0.f, 0.f, 0.f, 0.f};
#pragma unroll
            for (int ks = 0; ks < 4; ++ks) acc = MFMA16(lds_rd8(Kt + TP * (32 * kh + 4 * T) + 64 * ks), Qf[ks], acc);
            sc[kh][T] = acc; }
}
DI void tile_pv(LAS const unsigned char* Vt, const bf16x8 (&pf)[2], f32x4 (&O)[8]) {
#pragma unroll
    for (int kh = 0; kh < 2; ++kh)
#pragma unroll
        for (int dt = 0; dt < 8; ++dt) { const s16x4 lo = tr_read(Vt + TP * (32 * kh) + 32 * dt), hi = tr_read(Vt + TP * (32 * kh + 4) + 32 * dt);
            O[dt] = MFMA16(__builtin_shufflevector(lo, hi, 0, 1, 2, 3, 4, 5, 6, 7), pf[kh], O[dt]); }
}
template <int MODE>
DI void attn_tile(LAS const unsigned char* Kt, LAS const unsigned char* Vt, const bf16x8 (&Qf)[4], f32x4 (&O)[8], float& m, float& l, int lo, int hi, float c2, float inv_l,
                  LAS float* impA, LAS float* impB, int ql, int jb0, int lane) {
    const int qd = lane >> 4;
    f32x4 sc[2][2];
    tile_scores(Kt, Qf, sc);
    const float NEG = -__builtin_inff();
#pragma unroll
    for (int kh = 0; kh < 2; ++kh)
#pragma unroll
        for (int T = 0; T < 2; ++T)
#pragma unroll
            for (int j = 0; j < 4; ++j) { const int kk = 32 * kh + 8 * qd + 4 * T + j; if (kk < lo || kk > hi) sc[kh][T][j] = NEG; }
    float mn = m;
    if (MODE != 2) {
        float tmax = NEG;
#pragma unroll
        for (int kh = 0; kh < 2; ++kh)
#pragma unroll
            for (int T = 0; T < 2; ++T)
#pragma unroll
                for (int j = 0; j < 4; ++j) tmax = fmaxf(tmax, sc[kh][T][j]);
        tmax = fmaxf(tmax, shx(tmax, 16, lane)); tmax = fmaxf(tmax, shx(tmax, 32, lane));
        mn = fmaxf(m, tmax);
        const float alpha = __builtin_amdgcn_exp2f((m - mn) * c2);
        m = mn; l *= alpha;
        if (MODE == 1) {
#pragma unroll
            for (int dt = 0; dt < 8; ++dt) O[dt] = O[dt] * alpha;
        }
    }
    float ps = 0.f;
#pragma unroll
    for (int kh = 0; kh < 2; ++kh)
#pragma unroll
        for (int T = 0; T < 2; ++T)
#pragma unroll
            for (int j = 0; j < 4; ++j) { float p = __builtin_amdgcn_exp2f((sc[kh][T][j] - mn) * c2); if (MODE == 2) p *= inv_l; sc[kh][T][j] = p; ps += p; }
    if (MODE != 2) l += ps;
    if (MODE == 2) {
#pragma unroll
        for (int kh = 0; kh < 2; ++kh)
#pragma unroll
            for (int T = 0; T < 2; ++T) {
                float s4 = (sc[kh][T][0] + sc[kh][T][1]) + (sc[kh][T][2] + sc[kh][T][3]), cy = sc[kh][T][3];
                s4 += shx(s4, 1, lane); s4 += shx(s4, 2, lane); cy += shx(cy, 1, lane); cy += shx(cy, 2, lane);
                if ((lane & 3) == 0) { const int jb = jb0 + 8 * kh + 2 * qd + T; impA[ql * 128 + jb] = s4; if (jb + 1 < NSLC) impB[ql * 128 + jb + 1] = cy; }
            }
    }
    if (MODE != 0) {
        bf16x8 pf[2];
#pragma unroll
        for (int kh = 0; kh < 2; ++kh) { u32x4 pw; pw.x = pk2(sc[kh][0][0], sc[kh][0][1]); pw.y = pk2(sc[kh][0][2], sc[kh][0][3]); pw.z = pk2(sc[kh][1][0], sc[kh][1][1]); pw.w = pk2(sc[kh][1][2], sc[kh][1][3]); pf[kh] = as_bf16x8(pw); }
        tile_pv(Vt, pf, O);
    }
}
template <bool FIRST> DI void nsa_emit(const f32x4 (&O)[8], float scale, bf16* dst  ) {
#pragma unroll
    for (int dt = 0; dt < 8; ++dt) { f32x4 v = O[dt] * scale;
        if (!FIRST) { const u32x2 old = *(const u32x2*)(dst + 16 * dt); v[0] += bflo(old.x); v[1] += bfhi(old.x); v[2] += bflo(old.y); v[3] += bfhi(old.y); }
        u32x2 o; o.x = pk2(v[0], v[1]); o.y = pk2(v[2], v[3]); *(u32x2*)(dst + 16 * dt) = o; }
}
DI int next_bit(unsigned u0, unsigned u1, unsigned u2, unsigned u3, int from) {
    const int wd = from >> 5; const unsigned msk = ~0u << (from & 31);
    const unsigned x0 = (wd == 0) ? (u0 & msk) : 0u;
    const unsigned x1 = (wd < 1) ? u1 : ((wd == 1) ? (u1 & msk) : 0u);
    const unsigned x2 = (wd < 2) ? u2 : ((wd == 2) ? (u2 & msk) : 0u);
    const unsigned x3 = (wd < 3) ? u3 : (u3 & msk);
    if (x0) return __builtin_ctz(x0);
    if (x1) return 32 + __builtin_ctz(x1);
    if (x2) return 64 + __builtin_ctz(x2);
    if (x3) return 96 + __builtin_ctz(x3);
    return -1;
}

DI void nsa_phase(const Frame& F0, const Args& A, int layer) {
    const Frame F = phase_frame(F0);
    const bf16* proj = (const bf16*)(F.ws + WS_PROJ); const bf16* kcmp = (const bf16*)(F.ws + WS_KCMP); const bf16* vcmp = (const bf16*)(F.ws + WS_VCMP);
    bf16* ya = (bf16*)(F.ws + WS_YA);
    LAS unsigned char* const KB0 = F.lds; LAS unsigned char* const VB0 = F.lds + 2 * TILE_B;
    LAS float* impA = (LAS float*)(F.lds + 4 * TILE_B); LAS float* impB = (LAS float*)(F.lds + 4 * TILE_B + 32768);
    LAS unsigned* selm = (LAS unsigned*)(F.lds + 4 * TILE_B + 65536); LAS unsigned* uml = selm + 256;
    static_assert(4 * TILE_B + 65536 + 1024 + 16 <= LDSCTL_OFF, "nsa LDS map");
    const float c2 = 0.08838834764831845f * 1.4426950408889634f;
    for (int u = F.bid; u < 1024; u += F.G) {
        int tid_l = F.tid; asm volatile("" : "+v"(tid_l));
        const int tid = tid_l, lane = tid & 63, w = __builtin_amdgcn_readfirstlane(tid >> 6), i = lane & 15, qd = lane >> 4, hd = i & 3;
        const int klane = TP * (8 * (i >> 2) + hd) + 16 * qd, vlane = TP * (8 * qd + (i >> 2)) + 8 * hd;
        const int xg = u & 7, jj = (u >> 3) & 31, rr = u >> 8;
        const int b = xg >> 2, g = xg & 3;
        const int qt = (rr == 0) ? 127 - jj : (rr == 1) ? 64 + jj : (rr == 2) ? 63 - jj : jj;
        const int s0 = qt * 64, cur = qt, rowb = b * SEQ;
        int ql[2], trow[2]; bf16x8 Qf[2][4];
#pragma unroll
        for (int s = 0; s < 2; ++s) { ql[s] = 8 * w + 4 * s + (i >> 2); trow[s] = rowb + s0 + ql[s];
#pragma unroll
            for (int ks = 0; ks < 4; ++ks) Qf[s][ks] = *(const bf16x8*)(proj + (size_t)trow[s] * LDP + C_Q + (4 * g + hd) * HD + 32 * ks + 8 * qd); }
        for (int k = 0; k < 8; ++k) { ((LAS f32x4*)impA)[tid + NTHR * k] = (f32x4){0.f, 0.f, 0.f, 0.f}; }
        u32x4 kr[2], vr[2];
        f32x4 O[2][8]; float mrow[2], lrow[2];
        const int ntc = (4 * qt + 3 + 63) >> 6;
        const bf16* kc0 = kcmp + (size_t)(b * NG + g) * NCMP_PAD * HD; const bf16* vc0 = vcmp + (size_t)(b * NG + g) * NCMP_PAD * HD;
        int nmax[2];
#pragma unroll
        for (int s = 0; s < 2; ++s) { const int t = s0 + ql[s]; nmax[s] = (t >= 31) ? ((t - 31) >> 4) : -1; mrow[s] = -1e30f; lrow[s] = 0.f; }
        tile_load(kr, vr, kc0, vc0, HD, tid, false); tile_store(kr, vr, KB0, VB0, tid, false); __syncthreads();
        for (int tc = 0, buf = 0; tc < ntc; ++tc, buf ^= 1) {
            const bool more = tc + 1 < ntc;
            if (more) tile_load(kr, vr, kc0 + (size_t)(tc + 1) * 64 * HD, vc0, HD, tid, false);
#pragma unroll
            for (int s = 0; s < 2; ++s) attn_tile<0>(KB0 + buf * TILE_B + klane, VB0, Qf[s], O[s], mrow[s], lrow[s], 0, nmax[s] - 64 * tc, c2, 0.f, impA, impB, 0, 0, lane);
            if (more) tile_store(kr, vr, KB0 + (buf ^ 1) * TILE_B, VB0, tid, false);
            __syncthreads();
        }
        float invl[2];
#pragma unroll
        for (int s = 0; s < 2; ++s) { float lt = lrow[s]; lt += shx(lt, 16, lane); lt += shx(lt, 32, lane); invl[s] = (lt > 0.f) ? 1.0f / lt : 0.f;
#pragma unroll
            for (int dt = 0; dt < 8; ++dt) O[s][dt] = (f32x4){0.f, 0.f, 0.f, 0.f}; }
        tile_load(kr, vr, kc0, vc0, HD, tid, true); tile_store(kr, vr, KB0, VB0, tid, true); __syncthreads();
        for (int tc = 0, buf = 0; tc < ntc; ++tc, buf ^= 1) {
            const bool more = tc + 1 < ntc;
            if (more) tile_load(kr, vr, kc0 + (size_t)(tc + 1) * 64 * HD, vc0 + (size_t)(tc + 1) * 64 * HD, HD, tid, true);
#pragma unroll
            for (int s = 0; s < 2; ++s) attn_tile<2>(KB0 + buf * TILE_B + klane, VB0 + buf * TILE_B + vlane, Qf[s], O[s], mrow[s], lrow[s], 0, nmax[s] - 64 * tc, c2, invl[s], impA, impB, ql[s], 16 * tc, lane);
            if (more) tile_store(kr, vr, KB0 + (buf ^ 1) * TILE_B, VB0 + (buf ^ 1) * TILE_B, tid, true);
            __syncthreads();
        }
#pragma unroll
        for (int s = 0; s < 2; ++s) { const float gate = sigmoidf_(bf2f(proj[(size_t)trow[s] * LDP + C_GN + (4 * g + hd) * 3 + 0]));
            nsa_emit<true>(O[s], gate, ya + (size_t)trow[s] * DM + (4 * g + hd) * HD + 4 * qd); }
        {
            const int nforced = (cur == 0) ? 1 : (cur == 1) ? 2 : 3; const int nsel = (cur + 1 < NSEL) ? cur + 1 : NSEL; const int R = nsel - nforced;
            for (int q8 = 0; q8 < 8; ++q8) {
                const int q = 8 * w + q8;
                const int j0 = lane, j1 = lane + 64;
                const bool e0 = (j0 >= 1) && (j0 <= cur - 2), e1 = (j1 <= cur - 2);
                const float v0 = e0 ? impA[q * 128 + j0] + impB[q * 128 + j0] : -1.f, v1 = e1 ? impA[q * 128 + j1] + impB[q * 128 + j1] : -1.f;
                int r0 = 0, r1 = 0;
                const int cend = (cur - 2 < 127) ? cur - 2 : 127;
                for (int c = 1; c <= cend; ++c) {
                    const float vc = __builtin_bit_cast(float, (c < 64) ? __builtin_amdgcn_readlane(__builtin_bit_cast(int, v0), c) : __builtin_amdgcn_readlane(__builtin_bit_cast(int, v1), c - 64));
                    r0 += (vc > v0 || (vc == v0 && c < j0)) ? 1 : 0; r1 += (vc > v1 || (vc == v1 && c < j1)) ? 1 : 0;
                }
                const bool f0 = (j0 == 0) || (j0 == cur) || (j0 == cur - 1), f1 = (j1 == cur) || (j1 == cur - 1);
                const unsigned long long m0 = __ballot(f0 || (e0 && r0 < R)), m1 = __ballot(f1 || (e1 && r1 < R));
                if (lane == 0) { selm[q * 4 + 0] = (unsigned)m0; selm[q * 4 + 1] = (unsigned)(m0 >> 32); selm[q * 4 + 2] = (unsigned)m1; selm[q * 4 + 3] = (unsigned)(m1 >> 32); }
            }
            __syncthreads();
            if (w == 0) { unsigned x0 = selm[lane * 4 + 0], x1 = selm[lane * 4 + 1], x2 = selm[lane * 4 + 2], x3 = selm[lane * 4 + 3];
#pragma unroll
                for (int o = 1; o < 64; o <<= 1) { x0 |= shfl_idx_u(x0, lane ^ o); x1 |= shfl_idx_u(x1, lane ^ o); x2 |= shfl_idx_u(x2, lane ^ o); x3 |= shfl_idx_u(x3, lane ^ o); }
                if (lane == 0) { uml[0] = x0; uml[1] = x1; uml[2] = x2; uml[3] = x3; } }
            __syncthreads();
        }
        const unsigned um0 = __builtin_amdgcn_readfirstlane(uml[0]), um1 = __builtin_amdgcn_readfirstlane(uml[1]), um2 = __builtin_amdgcn_readfirstlane(uml[2]), um3 = __builtin_amdgcn_readfirstlane(uml[3]);
        {
            const bf16* ks0 = proj + (size_t)rowb * LDP + C_KS + g * HD; const bf16* vs0 = proj + (size_t)rowb * LDP + C_VS + g * HD;
#pragma unroll
            for (int s = 0; s < 2; ++s) { mrow[s] = -1e30f; lrow[s] = 0.f;
#pragma unroll
                for (int dt = 0; dt < 8; ++dt) O[s][dt] = (f32x4){0.f, 0.f, 0.f, 0.f}; }
            int jb = next_bit(um0, um1, um2, um3, 0), buf = 0;
            tile_load(kr, vr, ks0 + (size_t)jb * 64 * LDP, vs0 + (size_t)jb * 64 * LDP, LDP, tid, true); tile_store(kr, vr, KB0, VB0, tid, true); __syncthreads();
            while (jb >= 0) {
                const int nj = (jb + 1 < NSLC) ? next_bit(um0, um1, um2, um3, jb + 1) : -1;
                if (nj >= 0) tile_load(kr, vr, ks0 + (size_t)nj * 64 * LDP, vs0 + (size_t)nj * 64 * LDP, LDP, tid, true);
#pragma unroll
                for (int s = 0; s < 2; ++s) {
                    const bool act = (selm[ql[s] * 4 + (jb >> 5)] >> (jb & 31)) & 1u;
                    if (__ballot(act) != 0ull) {
                        const int hi = act ? ((jb < cur) ? 63 : ql[s]) : -1;
                        attn_tile<1>(KB0 + buf * TILE_B + klane, VB0 + buf * TILE_B + vlane, Qf[s], O[s], mrow[s], lrow[s], 0, hi, c2, 0.f, impA, impB, 0, 0, lane);
                    }
                }
                if (nj >= 0) tile_store(kr, vr, KB0 + (buf ^ 1) * TILE_B, VB0 + (buf ^ 1) * TILE_B, tid, true);
                __syncthreads();
                jb = nj; buf ^= 1;
            }
            VM_WAIT();
#pragma unroll
            for (int s = 0; s < 2; ++s) { float lt = lrow[s]; lt += shx(lt, 16, lane); lt += shx(lt, 32, lane);
                const float gate = sigmoidf_(bf2f(proj[(size_t)trow[s] * LDP + C_GN + (4 * g + hd) * 3 + 1]));
                nsa_emit<false>(O[s], (lt > 0.f) ? gate / lt : 0.f, ya + (size_t)trow[s] * DM + (4 * g + hd) * HD + 4 * qd); }
        }
        {
            const bf16* kw0 = proj + (size_t)rowb * LDP + C_KW + g * HD; const bf16* vw0 = proj + (size_t)rowb * LDP + C_VW + g * HD;
#pragma unroll
            for (int s = 0; s < 2; ++s) { mrow[s] = -1e30f; lrow[s] = 0.f;
#pragma unroll
                for (int dt = 0; dt < 8; ++dt) O[s][dt] = (f32x4){0.f, 0.f, 0.f, 0.f}; }
            const int tt0 = (qt >= 8) ? 0 : 8 - qt;
            { const size_t r0 = (size_t)(s0 - 512 + 64 * tt0) * LDP; tile_load(kr, vr, kw0 + r0, vw0 + r0, LDP, tid, true); tile_store(kr, vr, KB0, VB0, tid, true); __syncthreads(); }
            for (int tt = tt0, buf = 0; tt <= 8; ++tt, buf ^= 1) {
                const bool more = tt < 8;
                if (more) { const size_t r0 = (size_t)(s0 - 512 + 64 * (tt + 1)) * LDP; tile_load(kr, vr, kw0 + r0, vw0 + r0, LDP, tid, true); }
#pragma unroll
                for (int s = 0; s < 2; ++s) {
                    const int lo = (tt == 0) ? ql[s] + 1 : 0, hi = (tt == 8) ? ql[s] : 63;
                    attn_tile<1>(KB0 + buf * TILE_B + klane, VB0 + buf * TILE_B + vlane, Qf[s], O[s], mrow[s], lrow[s], lo, hi, c2, 0.f, impA, impB, 0, 0, lane);
                }
                if (more) tile_store(kr, vr, KB0 + (buf ^ 1) * TILE_B, VB0 + (buf ^ 1) * TILE_B, tid, true);
                __syncthreads();
            }
            VM_WAIT();
#pragma unroll
            for (int s = 0; s < 2; ++s) { float lt = lrow[s]; lt += shx(lt, 16, lane); lt += shx(lt, 32, lane);
                const float gate = sigmoidf_(bf2f(proj[(size_t)trow[s] * LDP + C_GN + (4 * g + hd) * 3 + 2]));
                nsa_emit<false>(O[s], (lt > 0.f) ? gate / lt : 0.f, ya + (size_t)trow[s] * DM + (4 * g + hd) * HD + 4 * qd); }
        }
        __syncthreads();
    }
}

constexpr int NPH_LAYER = 13, NPH = 2 + NPH_LAYER * DEPTH;
#ifndef PG8_SP2
#define PG8_SP2 true
#endif
#ifndef PG8_ALIGN
#define PG8_ALIGN true
#endif
#ifndef PH_MASK
#define PH_MASK 0xFFFFFFFFu
#endif
#define INK(k, kk) (((PH_MASK >> (kk)) & 1u) && lo <= (k) && (k) < hi)
#define SEAM(k) do { if (lo <= (k) && (k) + 1 < hi) { XcdBarrier b_ = bar; { unsigned long long p_ = (unsigned long long)bar.bar; asm volatile("" : "+s"(p_)); b_.bar = (unsigned*)p_; } xcd_barrier(b_); } } while (0)
template <int LAYER> DI void layer_phases(const Frame& F, const Args& args, const XcdBarrier& bar, const int lo, const int hi) {
    constexpr int layer = LAYER, layer_ = LAYER;
    float* xres = (float*)(F.ws + WS_X); bf16* hb = (bf16*)(F.ws + WS_HB); bf16* projb = (bf16*)(F.ws + WS_PROJ); bf16* ub = (bf16*)(F.ws + WS_U); bf16* eb = (bf16*)(F.ws + WS_EB);
        const int pb = 1 + NPH_LAYER * layer;
        const float* xin = (layer == 0) ? (const float*)argin(args, 0) : (const float*)xres;
        if (INK(pb + 0, 0)) norm_rows<false>(F, xin, (const float*)argin(args, 3) + (size_t)layer * DM, hb);
        SEAM(pb + 0);
        if (INK(pb + 1, 1)) {
#ifndef NO_G1
            { const Frame Fp = phase_frame(F);  pg8::Gemm g{hb, (const bf16*)lw_ptr(Fp, layer, LW_IN), M, LDP, DM}; pg8::StaticOrder S; S.init(M, LDP, Fp.G, Fp.bid);
              pg8::EpiB<2> E{projb, LDP, (const float*)(Fp.ws + WS_ROPE)};
              pg8::gemm_phase<pg8::EpiB<2>, pg8::StaticOrder, PG8_ALIGN, PG8_SP2>(Fp.lds, g, S, E, Fp.wave); }
#endif
#ifndef NO_G5
            { const Frame Fp = phase_frame(F);  pg8::Gemm g{(const bf16*)(Fp.ws + WS_PB) + (size_t)layer * M * PLE, (const bf16*)lw_ptr(Fp, layer, LW_PLE), M, DM, PLE}; pg8::StaticOrder S; S.init(M, DM, Fp.G, Fp.bid);
              pg8::EpiB<0> E{eb, DM, nullptr};
              pg8::gemm_phase<pg8::EpiB<0>, pg8::StaticOrder, PG8_ALIGN, PG8_SP2>(Fp.lds, g, S, E, Fp.wave); }
#endif
        }
        SEAM(pb + 1);
        if (INK(pb + 2, 2)) { ssd_conv_pass(F, args, layer); compress_phase(F, args, layer); }
        SEAM(pb + 2);
        if (INK(pb + 3, 3)) ssd_states_phase(F, args, layer);
        SEAM(pb + 3);
        if (INK(pb + 4, 4)) ssd_scan_phase(F);
        SEAM(pb + 4);
        if (INK(pb + 5, 5)) {
#ifndef NO_S3
            ssd_out_phase(F, args, layer);
#endif
#ifndef NO_NSA
            nsa_phase(F, args, layer);
#endif
        }
        SEAM(pb + 5);
        if (INK(pb + 6, 6)) merge_pass(F, args, layer);
        SEAM(pb + 6);
        if (INK(pb + 7, 7)) { const Frame Fp = phase_frame(F);  pg8::Gemm g{hb, (const bf16*)lw_ptr(Fp, layer, LW_O), M, DM, DM}; pg8::StaticOrder S; S.init(M, DM, Fp.G, Fp.bid);
            pg8::EpiRes<false> E{xin, xres, DM, nullptr};
            pg8::gemm_phase<pg8::EpiRes<false>, pg8::StaticOrder, PG8_ALIGN, PG8_SP2>(Fp.lds, g, S, E, Fp.wave); }
        SEAM(pb + 7);
        if (INK(pb + 8, 8)) norm_rows<false>(F, xres, (const float*)argin(args, 23) + (size_t)layer * DM, hb);
        SEAM(pb + 8);
        if (INK(pb + 9, 9)) { const Frame Fp = phase_frame(F);  pg8::Gemm g{hb, (const bf16*)lw_ptr(Fp, layer, LW_UP), M, DFF, DM}; pg8::StaticOrder S; S.init(M, DFF, Fp.G, Fp.bid);
            pg8::EpiB<1> E{ub, DFF, nullptr};
            pg8::gemm_phase<pg8::EpiB<1>, pg8::StaticOrder, PG8_ALIGN, PG8_SP2>(Fp.lds, g, S, E, Fp.wave); }
        SEAM(pb + 9);
        if (INK(pb + 10, 10)) { const Frame Fp = phase_frame(F);  pg8::Gemm g{ub, (const bf16*)lw_ptr(Fp, layer, LW_DOWN), M, DM, DFF}; pg8::StaticOrder S; S.init(M, DM, Fp.G, Fp.bid);
            pg8::EpiRes<false> E{xres, xres, DM, nullptr};
            pg8::gemm_phase<pg8::EpiRes<false>, pg8::StaticOrder, PG8_ALIGN, PG8_SP2>(Fp.lds, g, S, E, Fp.wave); }
        SEAM(pb + 10);
        if (INK(pb + 11, 11)) norm_rows<false>(F, xres, (const float*)argin(args, 26) + (size_t)layer * DM, hb);
        SEAM(pb + 11);
        if (INK(pb + 12, 12)) { const Frame Fp = phase_frame(F);  pg8::Gemm g{hb, (const bf16*)lw_ptr(Fp, layer, LW_PG), M, DM, DM}; pg8::StaticOrder S; S.init(M, DM, Fp.G, Fp.bid);
            pg8::EpiRes<true> E{xres, xres, DM, eb};
            pg8::gemm_phase<pg8::EpiRes<true>, pg8::StaticOrder, PG8_ALIGN, PG8_SP2>(Fp.lds, g, S, E, Fp.wave); }
        SEAM(pb + 12);
}
__global__ void __launch_bounds__(NTHR, 2) hyb_fwd(Args args) {
    extern __shared__ __attribute__((aligned(16))) unsigned char lds_raw[];
    Frame F;
    F.lds = (LAS unsigned char*)lds_raw; F.ws = args.ws; F.ctl = (gu32*)(args.ws + WS_CTL);
    F.tid = threadIdx.x; F.lane = F.tid & 63; F.wave = __builtin_amdgcn_readfirstlane(threadIdx.x >> 6); F.G = gridDim.x; F.bid = blockIdx.x;
    const int lo = args.ph_lo, hi = args.ph_hi;
    if (F.tid < 64) ((LAS unsigned*)(F.lds + LDSCTL_OFF))[F.tid] = 0u;
    __syncthreads();
    XcdBarrier bar; bar.bar = (unsigned*)(F.ctl + CW_BAR); bar.x = 0; bar.st = (volatile LAS unsigned*)(F.lds + LDSCTL_OFF);
    if (hi - lo > 1) bar = xcd_barrier_post((unsigned*)(F.ctl + CW_BAR), (volatile LAS unsigned*)(F.lds + LDSCTL_OFF));
    if (INK(0, 13)) p0_prologue(F, args);
    SEAM(0);
    layer_phases<0>(F, args, bar, lo, hi); layer_phases<1>(F, args, bar, lo, hi); layer_phases<2>(F, args, bar, lo, hi); layer_phases<3>(F, args, bar, lo, hi);
    float* xres = (float*)(F.ws + WS_X);
    int hi_l = hi; asm volatile("" : "+s"(hi_l));
    if (((PH_MASK >> 14) & 1u) && lo <= NPH - 1 && NPH - 1 < hi_l) norm_rows<true>(F, xres, (const float*)argin(args, 29), args.out);
#undef INK
#undef SEAM
}

#ifndef MK_ONE_LAUNCH
#define MK_ONE_LAUNCH 1
#endif
extern "C" void kernel_launch(void* const* d_in, const int* in_sizes, int n_in, void* d_out, int out_size, void* d_ws, size_t ws_size, hipStream_t stream) {
    static int grid = 0;
    if (grid == 0) {
        if (n_in != 30 || out_size != M * DM || ws_size < WS_END) { fprintf(stderr, "kernel_launch: unexpected shapes (n_in %d out %d ws %zu need %zu)\n", n_in, out_size, ws_size, (size_t)WS_END); grid = -1; return; }
        int dev = 0, cus = 0, per_cu = 0;
        if (hipGetDevice(&dev) != hipSuccess || hipDeviceGetAttribute(&cus, hipDeviceAttributeMultiprocessorCount, dev) != hipSuccess) { grid = -1; return; }
        if (hipFuncSetAttribute((const void*)hyb_fwd, hipFuncAttributeMaxDynamicSharedMemorySize, LDS_BYTES) != hipSuccess) { fprintf(stderr, "kernel_launch: hipFuncSetAttribute failed\n"); grid = -1; return; }
        if (hipOccupancyMaxActiveBlocksPerMultiprocessor(&per_cu, (const void*)hyb_fwd, NTHR, LDS_BYTES) != hipSuccess || per_cu < 1) { fprintf(stderr, "kernel_launch: occupancy query says %d\n", per_cu); }
        (void)hipGetLastError();
        grid = cus;
    }
    if (grid < 0) return;
    (void)hipMemsetAsync((char*)d_ws + WS_CTL, 0, CTL_ZERO_BYTES, stream);
    Args a{};
    for (int i = 0; i < 30; ++i) a.in[i] = d_in[i];
    a.out = (float*)d_out; a.ws = (unsigned char*)d_ws;
#if MK_ONE_LAUNCH
    a.ph_lo = 0; a.ph_hi = NPH;
    hipLaunchKernelGGL(hyb_fwd, dim3(grid), dim3(NTHR), LDS_BYTES, stream, a);
#else
    for (int ph = 0; ph < NPH; ++ph) { a.ph_lo = ph; a.ph_hi = ph + 1; hipLaunchKernelGGL(hyb_fwd, dim3(grid), dim3(NTHR), LDS_BYTES, stream, a); }
#endif
    (void)in_sizes;
}
```

```cpp
#include <hip/hip_runtime.h>
#include <cstdio>
#include <cstdint>
namespace pg8 {
#define PG8_LAS __attribute__((address_space(3)))
typedef unsigned short bf16_t;
typedef short bf16x8 __attribute__((ext_vector_type(8)));
typedef float f32x4 __attribute__((ext_vector_type(4)));
typedef unsigned u32x4 __attribute__((ext_vector_type(4)));
constexpr int BM = 256, BK = 64, HALF = 128, HTB = HALF * BK * 2  , STAGE_BYTES = 8 * HTB, NXCD = 8, WGM = 8;

__host__ __device__ __forceinline__ int lds_byte(int r, int c) { const int st = (r >> 4) * 2 + (c >> 5), rr = r & 15, cc = c & 31, ob = rr * 64 + cc * 2; return st * 1024 + (ob ^ (((ob >> 9) & 1) << 5)); }
__host__ __device__ __forceinline__ void stage_rc(int b, int& R, int& C) { const int st = b / 1024, sb = b % 1024, swz = sb ^ (((sb >> 9) & 1) << 5); R = (st >> 1) * 16 + swz / 64; C = (st & 1) * 32 + (swz % 64) / 2; }
__host__ __device__ __forceinline__ int perm32(int rho) { const int n = rho >> 4, i = rho & 15; return 8 * (i >> 2) + 4 * n + (i & 3); }

struct Unit { int pm, pn; };
struct Gemm { const bf16_t* A; const bf16_t* Bt; int M, N, K; };

struct StaticOrder {
    int nM, nN, nwg, G, c;
    __host__ __device__ void init(int M, int N, int G_, int c_) { nM = M / BM; nN = N / BM; nwg = nM * nN; G = G_; c = c_; }
    __host__ __device__ bool next(int i, Unit& u) const {
        const long L = (long)i * G + c; if (L >= nwg) return false;
        int wgid = (int)L; { const int q = nwg / NXCD, r = nwg % NXCD, xcd = wgid % NXCD, off = wgid / NXCD; wgid = (xcd < r ? xcd * (q + 1) : r * (q + 1) + (xcd - r) * q) + off; }
        const int nig = WGM * nN, gid = wgid / nig, fm = gid * WGM, gsz = (nM - fm) < WGM ? (nM - fm) : WGM;
        u.pm = fm + ((wgid % nig) % gsz); u.pn = (wgid % nig) / gsz; return true;
    }
    __device__ __forceinline__ void a_ready(const Unit&) const {}
    __device__ __forceinline__ void done(const Unit&) const {}
};
__device__ __forceinline__ unsigned cvt_pk_bf16(float lo, float hi) { unsigned r; asm volatile("v_cvt_pk_bf16_f32 %0, %1, %2" : "=v"(r) : "v"(lo), "v"(hi)); return r; }
template <class Epi, class Sched, bool ALIGN_EPI = false, bool SP2 = false>
__device__ __forceinline__ void gemm_phase(PG8_LAS unsigned char* lds, const Gemm g, const Sched& S, const Epi& E, const int wave_idx  ) {
    int lane_l; asm volatile("v_mbcnt_lo_u32_b32 %0, -1, 0\n\tv_mbcnt_hi_u32_b32 %0, -1, %0" : "=v"(lane_l));
    const int wid = wave_idx, tid = wid * 64 + lane_l, lane = tid & 63, wr = wid >> 2, wc = wid & 3, fr = lane & 15, fq = lane >> 4;
    const int K = g.K, nt = K / BK;
    unsigned voffA[2], voffB[2];
#pragma unroll
    for (int i = 0; i < 2; ++i) { int R, C; stage_rc(tid * 16 + i * 8192, R, C); const int Rb = Epi::PERM ? ((R & ~31) + perm32(R & 31)) : R;
        voffA[i] = (unsigned)(R * K + C) * 2u; voffB[i] = (unsigned)(Rb * K + C) * 2u; }
    const size_t kstep = (size_t)(BK * 2);
    const size_t hstep = (size_t)HALF * K * 2;
    const size_t tstep = 2 * hstep;
    const unsigned ldsw = (unsigned)wid * 1024u;
    const int aoff = lds_byte(wr * 64 + fr, fq * 8), boff = lds_byte(wc * 32 + fr, fq * 8);
#define PG8_SA(b, h) (((b) * 2 + (h)) * HTB)
#define PG8_SB(b, h) ((4 + (b) * 2 + (h)) * HTB)
#define PG8_STAGE(bufoff, gbase, voff) do { _Pragma("unroll") for (int _i = 0; _i < 2; ++_i) \
        __builtin_amdgcn_global_load_lds((const unsigned*)((const char*)(gbase) + (voff)[_i]), (PG8_LAS unsigned*)(lds + (bufoff) + ldsw + _i * 8192), 16, 0, 0); } while (0)
#define PG8_LDA(dst, b, h) do { _Pragma("unroll") for (int m = 0; m < 4; ++m) _Pragma("unroll") for (int k = 0; k < 2; ++k) dst[m][k] = *(const PG8_LAS bf16x8*)(lds + PG8_SA(b, h) + aoff + m * 2048 + k * 1024); } while (0)
#define PG8_LDB(dst, b, h) do { _Pragma("unroll") for (int n = 0; n < 2; ++n) _Pragma("unroll") for (int k = 0; k < 2; ++k) dst[n][k] = *(const PG8_LAS bf16x8*)(lds + PG8_SB(b, h) + boff + n * 2048 + k * 1024); } while (0)
#define PG8_MMA(ai, bj, At, Bt) do { __builtin_amdgcn_s_setprio(1); _Pragma("unroll") for (int m = 0; m < 4; ++m) _Pragma("unroll") for (int n = 0; n < 2; ++n) _Pragma("unroll") for (int k = 0; k < 2; ++k) \
        acc[ai][bj][m][n] = __builtin_amdgcn_mfma_f32_16x16x32_bf16(Bt[n][k], At[m][k], acc[ai][bj][m][n], 0, 0, 0); __builtin_amdgcn_s_setprio(0); } while (0)
#define PG8_WAIT_V(n) asm volatile("s_waitcnt vmcnt(" #n ")" ::: "memory")
#define PG8_WAIT_L(n) asm volatile("s_waitcnt lgkmcnt(" #n ")" ::: "memory")
#define PG8_BAR __builtin_amdgcn_s_barrier()
#define PG8_SCHED __builtin_amdgcn_sched_barrier(0)
    Unit cur, nxt; int ui = 0;
    if (!S.next(0, cur)) return;
    f32x4 acc[2][2][4][2];
#pragma unroll
    for (int a = 0; a < 2; ++a)
#pragma unroll
        for (int b = 0; b < 2; ++b)
#pragma unroll
            for (int m = 0; m < 4; ++m)
#pragma unroll
                for (int n = 0; n < 2; ++n) acc[a][b][m][n] = (f32x4){0.f, 0.f, 0.f, 0.f};
    bf16x8 At[4][2], B0[2][2], B1[2][2];
    const char* cA = (const char*)g.A + (size_t)cur.pm * tstep; const char* cB = (const char*)g.Bt + (size_t)cur.pn * tstep;
    S.a_ready(cur);
    if constexpr (SP2) {
        PG8_STAGE(PG8_SB(0, 0), cB, voffB); PG8_STAGE(PG8_SB(0, 1), cB + hstep, voffB); PG8_STAGE(PG8_SA(0, 0), cA, voffA); PG8_STAGE(PG8_SA(0, 1), cA + hstep, voffA);
        if (wr == 1) PG8_BAR;
        PG8_WAIT_V(2); PG8_BAR;
        PG8_STAGE(PG8_SB(1, 0), cB + kstep, voffB); PG8_STAGE(PG8_SA(1, 0), cA + kstep, voffA); PG8_STAGE(PG8_SB(1, 1), cB + hstep + kstep, voffB);
        PG8_WAIT_V(6); PG8_BAR;
    } else {
        PG8_STAGE(PG8_SB(0, 0), cB, voffB); PG8_STAGE(PG8_SA(0, 0), cA, voffA); PG8_STAGE(PG8_SB(0, 1), cB + hstep, voffB); PG8_STAGE(PG8_SA(0, 1), cA + hstep, voffA);
        if (wr == 1) PG8_BAR;
        PG8_WAIT_V(4); PG8_BAR;
        PG8_STAGE(PG8_SB(1, 0), cB + kstep, voffB); PG8_STAGE(PG8_SA(1, 0), cA + kstep, voffA); PG8_STAGE(PG8_SB(1, 1), cB + hstep + kstep, voffB);
        PG8_WAIT_V(6); PG8_BAR;
    }
    for (;;) {
        const bool has_next = S.next(ui + 1, nxt);
        const char* nA = has_next ? (const char*)g.A + (size_t)nxt.pm * tstep : cA; const char* nB = has_next ? (const char*)g.Bt + (size_t)nxt.pn * tstep : cB;
        for (int t = 0; t < nt; t += 2) {
            const bool last = (t == nt - 2);
            const char* a1 = cA + (size_t)(t + 1) * kstep;
            const char* a2 = last ? nA : cA + (size_t)(t + 2) * kstep; const char* b2 = last ? nB : cB + (size_t)(t + 2) * kstep;
            const char* a3 = a2 + kstep; const char* b3 = b2 + kstep;
            if (last && has_next) S.a_ready(nxt);
            if constexpr (SP2) {
            PG8_LDB(B0, 0, 0); PG8_LDB(B1, 0, 1); PG8_SCHED; PG8_LDA(At, 0, 0); PG8_STAGE(PG8_SA(1, 1), a1 + hstep, voffA);
            PG8_WAIT_V(8); PG8_WAIT_L(0); PG8_BAR; PG8_MMA(0, 0, At, B0); PG8_MMA(0, 1, At, B1); PG8_BAR; PG8_SCHED;
            PG8_LDA(At, 0, 1); PG8_STAGE(PG8_SB(0, 0), b2, voffB); PG8_STAGE(PG8_SB(0, 1), b2 + hstep, voffB); PG8_STAGE(PG8_SA(0, 0), a2, voffA);
            PG8_WAIT_V(8); PG8_WAIT_L(0); PG8_BAR; PG8_MMA(1, 0, At, B0); PG8_MMA(1, 1, At, B1); PG8_BAR; PG8_SCHED;
            PG8_LDB(B0, 1, 0); PG8_LDB(B1, 1, 1); PG8_SCHED; PG8_LDA(At, 1, 0); PG8_STAGE(PG8_SA(0, 1), a2 + hstep, voffA);
            PG8_WAIT_V(8); PG8_WAIT_L(0); PG8_BAR; PG8_MMA(0, 0, At, B0); PG8_MMA(0, 1, At, B1); PG8_BAR; PG8_SCHED;
            PG8_LDA(At, 1, 1); PG8_STAGE(PG8_SB(1, 0), b3, voffB); PG8_STAGE(PG8_SB(1, 1), b3 + hstep, voffB); PG8_STAGE(PG8_SA(1, 0), a3, voffA);
            PG8_WAIT_V(8); PG8_WAIT_L(0); PG8_BAR; PG8_MMA(1, 0, At, B0); PG8_MMA(1, 1, At, B1); PG8_BAR; PG8_SCHED;
            } else {
            PG8_LDB(B0, 0, 0); PG8_SCHED; PG8_LDA(At, 0, 0); PG8_STAGE(PG8_SA(1, 1), a1 + hstep, voffA);
            PG8_WAIT_L(8); PG8_BAR; PG8_WAIT_L(0); PG8_MMA(0, 0, At, B0); PG8_BAR; PG8_SCHED;
            PG8_LDB(B1, 0, 1); PG8_STAGE(PG8_SB(0, 0), b2, voffB);
            PG8_BAR; PG8_WAIT_L(0); PG8_MMA(0, 1, At, B1); PG8_BAR;
            PG8_LDA(At, 0, 1); PG8_STAGE(PG8_SA(0, 0), a2, voffA);
            PG8_BAR; PG8_WAIT_L(0); PG8_MMA(1, 0, At, B0); PG8_BAR; PG8_SCHED;
            PG8_STAGE(PG8_SB(0, 1), b2 + hstep, voffB);
            PG8_WAIT_V(6); PG8_BAR; PG8_MMA(1, 1, At, B1); PG8_BAR;
            PG8_LDB(B0, 1, 0); PG8_SCHED; PG8_LDA(At, 1, 0); PG8_STAGE(PG8_SA(0, 1), a2 + hstep, voffA);
            PG8_WAIT_L(8); PG8_BAR; PG8_WAIT_L(0); PG8_MMA(0, 0, At, B0); PG8_BAR; PG8_SCHED;
            PG8_LDB(B1, 1, 1); PG8_STAGE(PG8_SB(1, 0), b3, voffB);
            PG8_BAR; PG8_WAIT_L(0); PG8_MMA(0, 1, At, B1); PG8_BAR;
            PG8_LDA(At, 1, 1); PG8_STAGE(PG8_SA(1, 0), a3, voffA);
            PG8_BAR; PG8_WAIT_L(0); PG8_MMA(1, 0, At, B0); PG8_BAR; PG8_SCHED;
            PG8_STAGE(PG8_SB(1, 1), b3 + hstep, voffB);
            PG8_WAIT_V(6); PG8_BAR; PG8_MMA(1, 1, At, B1); PG8_BAR;
            }
        }
        if constexpr (ALIGN_EPI) { if (wr == 0) PG8_BAR; }
        if constexpr (!Epi::AFTER_DRAIN) { E(acc, cur, wr, wc, fr, fq); S.done(cur); }
        if (!has_next) break;
#pragma unroll
        for (int a = 0; a < 2; ++a)
#pragma unroll
            for (int b = 0; b < 2; ++b)
#pragma unroll
                for (int m = 0; m < 4; ++m)
#pragma unroll
                    for (int n = 0; n < 2; ++n) acc[a][b][m][n] = (f32x4){0.f, 0.f, 0.f, 0.f};
        cur = nxt; cA = nA; cB = nB; ++ui;
        if constexpr (ALIGN_EPI) { if (wr == 1) PG8_BAR; }
    }
    PG8_WAIT_V(0);
    if constexpr (!ALIGN_EPI) { if (wr == 0) PG8_BAR; }
    PG8_BAR;
    if constexpr (Epi::AFTER_DRAIN) { E.fused(acc, cur, wr, wc, fr, fq, lds, wid, lane); S.done(cur); }
#undef PG8_SA
#undef PG8_SB
#undef PG8_STAGE
#undef PG8_LDA
#undef PG8_LDB
#undef PG8_MMA
#undef PG8_WAIT_V
#undef PG8_WAIT_L
#undef PG8_BAR
#undef PG8_SCHED
}
}

constexpr int BATCH = 2, SEQ = 8192, DM = 2048, DEPTH = 4;
constexpr int M = BATCH * SEQ;
constexpr int NH = 16, HD = 128, NG = 4, RH = 4;
constexpr int NCMP = 511, NCMP_PAD = 512, NSLC = 128, NSEL = 16, WIN = 512;
constexpr int SSD_H = 32, SSD_P = 64, SSD_N = 128, SSD_G = 4, SSD_CH = 128, SSD_NC = 64, SSD_XBC = 3072;
constexpr int DFF = 8192, PLE = 256;
constexpr float EPS = 1e-6f;
constexpr int PROJ_SRC = 22608;
constexpr int C_Q = 0, C_KC = 2048, C_VC = 2560, C_KS = 3072, C_VS = 3584, C_KW = 4096, C_VW = 4608;
constexpr int C_CB = 5120, C_CC = 7168, C_CU = 9216, C_Z = 11264, C_XBC = 13312, C_GM = 16384, C_GN = 22528, C_DT = 22592;
constexpr int LDP = 22784;
constexpr int S_GN = 5120, S_DT = 16432;

constexpr size_t MiB = 1u << 20;
constexpr size_t WS_CTL = 0, CTL_ZERO_BYTES = 1 * MiB;
constexpr size_t WS_ROPE = 1 * MiB;
constexpr size_t WS_MISC = 9 * MiB;
constexpr size_t WS_DT = 10 * MiB;
constexpr size_t WS_ACS = 12 * MiB;
constexpr size_t WS_CDEC = 14 * MiB;
constexpr size_t WS_KCMP = 15 * MiB;
constexpr size_t WS_VCMP = 16 * MiB;
constexpr size_t WS_X = 32 * MiB;
constexpr size_t WS_HB = 160 * MiB;
constexpr size_t WS_PB = 224 * MiB;
constexpr size_t WS_EB = 256 * MiB;
constexpr size_t WS_YA = 320 * MiB;
constexpr size_t WS_YC = 384 * MiB;
constexpr size_t WS_XBC = 448 * MiB;
constexpr size_t WS_ST = 544 * MiB;
constexpr size_t WS_PROJ = 672 * MiB;
constexpr size_t WS_U = WS_PROJ;
constexpr size_t WS_W = 1384 * MiB;
constexpr size_t LW_IN = 0;
constexpr size_t LW_O = 89 * MiB;
constexpr size_t LW_UP = 97 * MiB;
constexpr size_t LW_DOWN = 129 * MiB;
constexpr size_t LW_PG = 161 * MiB;
constexpr size_t LW_PLE = 169 * MiB;
constexpr size_t LW_PK1 = 170 * MiB;
constexpr size_t LW_PV1 = 171 * MiB;
constexpr size_t LW_PK2 = 172 * MiB;
constexpr size_t LW_PV2 = 172 * MiB + 64 * 1024;
constexpr size_t LW_STRIDE = 173 * MiB;
constexpr size_t WS_END = WS_W + 4 * LW_STRIDE;
static_assert((size_t)M * LDP * 2 <= 712 * MiB && (size_t)LDP * 2048 * 2 <= 89 * MiB, "ws map");

constexpr int CW_BAR = 4096;
constexpr int CW_CHK = 16384;
constexpr int CW_TS = 20480;

constexpr int RING_BYTES = 131072;
constexpr int LX_OFF = RING_BYTES;
constexpr int LX_BYTES = 8192;
constexpr int LDSCTL_OFF = LX_OFF + LX_BYTES;
constexpr int LDS_BYTES = LDSCTL_OFF + 256;
constexpr int NWAVES = 8, NTHR = 512;

#define DI __device__ __forceinline__
#define GAS __attribute__((address_space(1)))
#define LAS __attribute__((address_space(3)))
typedef unsigned short bf16;
typedef unsigned u32x4 __attribute__((ext_vector_type(4)));
typedef unsigned u32x2 __attribute__((ext_vector_type(2)));
typedef float f32x4 __attribute__((ext_vector_type(4)));
typedef float f32x2 __attribute__((ext_vector_type(2)));
typedef short bf16x8 __attribute__((ext_vector_type(8)));
typedef short s16x4 __attribute__((ext_vector_type(4)));
typedef GAS unsigned gu32;
#define RLX_AGENT __ATOMIC_RELAXED, __HIP_MEMORY_SCOPE_AGENT
#define LDS_WAIT() asm volatile("s_waitcnt lgkmcnt(0)" ::: "memory")
#define VM_WAIT() asm volatile("s_waitcnt vmcnt(0)" ::: "memory")
DI unsigned f2bf(float f) { unsigned u = __builtin_bit_cast(unsigned, f); return (u + 0x7fffu + ((u >> 16) & 1u)) >> 16; }
DI unsigned pk2(float lo, float hi) { unsigned r; asm("v_cvt_pk_bf16_f32 %0, %1, %2" : "=v"(r) : "v"(lo), "v"(hi)); return r; }
DI float bf2f(unsigned h) { return __builtin_bit_cast(float, h << 16); }
DI float bflo(unsigned w) { return __builtin_bit_cast(float, w << 16); }
DI float bfhi(unsigned w) { return __builtin_bit_cast(float, w & 0xffff0000u); }
DI float sigmoidf_(float x) { return 1.0f / (1.0f + __expf(-x)); }
DI float siluf_(float x) { return x / (1.0f + __expf(-x)); }
DI float shfl_idx(float v, int src) { return __builtin_bit_cast(float, __builtin_amdgcn_ds_bpermute(src << 2, __builtin_bit_cast(int, v))); }
DI unsigned shfl_idx_u(unsigned v, int src) { return (unsigned)__builtin_amdgcn_ds_bpermute(src << 2, (int)v); }
DI float shx(float v, int m, int lane) { return shfl_idx(v, lane ^ m); }
DI float wave_sum(float v, int lane) {
#pragma unroll
    for (int o = 1; o < 64; o <<= 1) v += shx(v, o, lane);
    return v;
}
DI unsigned off_b(unsigned row, unsigned ch) { return 256u * row + 16u * (ch ^ (((row & 3u) << 2) | ((row >> 2) & 3u))); }
DI unsigned tr_addr(unsigned lane, unsigned r0, unsigned c, unsigned t) {
    const unsigned g = lane >> 4, q = (lane & 15u) >> 2, p = lane & 3u;
    return off_b(r0 + 8u * g + 4u * t + q, 2u * c + (p >> 1)) + 8u * (p & 1u);
}
DI s16x4 tr_read(LAS const unsigned char* p) { return __builtin_amdgcn_ds_read_tr16_b64_v4i16((LAS s16x4*)p); }
DI bf16x8 tr_read8(LAS const unsigned char* base, unsigned lane, unsigned r0, unsigned c) {
    const s16x4 lo = tr_read(base + tr_addr(lane, r0, c, 0)), hi = tr_read(base + tr_addr(lane, r0, c, 1));
    return __builtin_shufflevector(lo, hi, 0, 1, 2, 3, 4, 5, 6, 7);
}
DI bf16x8 lds_rd8(LAS const unsigned char* p) { return *(const LAS bf16x8*)p; }
DI bf16x8 as_bf16x8(u32x4 v) { return __builtin_bit_cast(bf16x8, v); }
#define MFMA16(a, b, c) __builtin_amdgcn_mfma_f32_16x16x32_bf16((a), (b), (c), 0, 0, 0)

namespace pg8 {
template <int MODE> struct EpiB {
    static constexpr bool PERM = true, AFTER_DRAIN = false;
    bf16_t* O; int ldc; const float* rope;
    __device__ __forceinline__ void operator()(const f32x4 (&acc)[2][2][4][2], const Unit& u, int wr, int wc, int fr, int fq) const {
        { int l; asm volatile("v_mbcnt_lo_u32_b32 %0, -1, 0\n\tv_mbcnt_hi_u32_b32 %0, -1, %0" : "=v"(l)); fr = l & 15; fq = l >> 4; }
        const int row0 = u.pm * BM + wr * 64 + fr;
        bool rp = false;
        if (MODE == 2) { const int pn = u.pn; rp = (pn < 10) || pn == 12 || pn == 13 || pn == 16 || pn == 17; }
        if (MODE == 2 && rp) {
            const int colb = u.pn * BM + 128 * (wc >> 1) + 32 * (wc & 1) + 8 * fq, jj0 = 32 * (wc & 1) + 8 * fq;
#pragma unroll
            for (int ai = 0; ai < 2; ++ai)
#pragma unroll
                for (int m = 0; m < 4; ++m) {
                    const int row = row0 + ai * HALF + m * 16;
                    const float* rpp = (const float*)((const char*)rope + (unsigned)(((unsigned)row * 64u + (unsigned)jj0) * 8u));
                    const f32x4 cs0 = *(const f32x4*)(rpp), cs1 = *(const f32x4*)(rpp + 4), cs2 = *(const f32x4*)(rpp + 8), cs3 = *(const f32x4*)(rpp + 12);
                    const f32x4 x1a = acc[ai][0][m][0], x1b = acc[ai][0][m][1], x2a = acc[ai][1][m][0], x2b = acc[ai][1][m][1];
                    float c[8] = {cs0[0], cs0[2], cs1[0], cs1[2], cs2[0], cs2[2], cs3[0], cs3[2]};
                    float s[8] = {cs0[1], cs0[3], cs1[1], cs1[3], cs2[1], cs2[3], cs3[1], cs3[3]};
                    float x1[8] = {x1a[0], x1a[1], x1a[2], x1a[3], x1b[0], x1b[1], x1b[2], x1b[3]};
                    float x2[8] = {x2a[0], x2a[1], x2a[2], x2a[3], x2b[0], x2b[1], x2b[2], x2b[3]};
                    float o1[8], o2[8];
#pragma unroll
                    for (int k = 0; k < 8; ++k) { o1[k] = x1[k] * c[k] - x2[k] * s[k]; o2[k] = x2[k] * c[k] + x1[k] * s[k]; }
                    u32x4 w1, w2;
                    w1.x = cvt_pk_bf16(o1[0], o1[1]); w1.y = cvt_pk_bf16(o1[2], o1[3]); w1.z = cvt_pk_bf16(o1[4], o1[5]); w1.w = cvt_pk_bf16(o1[6], o1[7]);
                    w2.x = cvt_pk_bf16(o2[0], o2[1]); w2.y = cvt_pk_bf16(o2[2], o2[3]); w2.z = cvt_pk_bf16(o2[4], o2[5]); w2.w = cvt_pk_bf16(o2[6], o2[7]);
                    bf16_t* rowp = (bf16_t*)((char*)O + (unsigned)(((unsigned)row * (unsigned)ldc + (unsigned)colb) * 2u));
                    *(u32x4*)(rowp) = w1; *(u32x4*)(rowp + 64) = w2;
                    asm volatile("" ::: "memory");
                }
        } else {
            const int col0 = u.pn * BM + wc * 32 + 8 * fq;
#pragma unroll
            for (int ai = 0; ai < 2; ++ai)
#pragma unroll
                for (int m = 0; m < 4; ++m) { bf16_t* rowp = (bf16_t*)((char*)O + (unsigned)(((unsigned)(row0 + ai * HALF + m * 16) * (unsigned)ldc + (unsigned)col0) * 2u));
#pragma unroll
                    for (int bj = 0; bj < 2; ++bj) { f32x4 v0 = acc[ai][bj][m][0], v1 = acc[ai][bj][m][1];
                        if (MODE == 1) {
#pragma unroll
                            for (int k = 0; k < 4; ++k) { const float a = fmaxf(v0[k], 0.f), b = fmaxf(v1[k], 0.f); v0[k] = a * a; v1[k] = b * b; } }
                        u32x4 w; w.x = cvt_pk_bf16(v0[0], v0[1]); w.y = cvt_pk_bf16(v0[2], v0[3]); w.z = cvt_pk_bf16(v1[0], v1[1]); w.w = cvt_pk_bf16(v1[2], v1[3]);
                        *(u32x4*)(rowp + bj * HALF) = w; } }
        }
    }
};
template <bool GATE> struct EpiRes {
    static constexpr bool PERM = false, AFTER_DRAIN = false;
    const float* xin; float* xout; int ldc; const bf16_t* e;
    __device__ __forceinline__ void operator()(const f32x4 (&acc)[2][2][4][2], const Unit& u, int wr, int wc, int fr, int fq) const {
        { int l; asm volatile("v_mbcnt_lo_u32_b32 %0, -1, 0\n\tv_mbcnt_hi_u32_b32 %0, -1, %0" : "=v"(l)); fr = l & 15; fq = l >> 4; }
        const int row0 = u.pm * BM + wr * 64 + fr, col0 = u.pn * BM + wc * 32 + 4 * fq;
#pragma unroll
        for (int ai = 0; ai < 2; ++ai)
#pragma unroll
            for (int m = 0; m < 4; ++m) { const unsigned off = (unsigned)(row0 + ai * HALF + m * 16) * (unsigned)ldc + (unsigned)col0;
#pragma unroll
                for (int bj = 0; bj < 2; ++bj)
#pragma unroll
                    for (int n = 0; n < 2; ++n) { const unsigned o = off + bj * HALF + n * 16; const f32x4 xv = *(const f32x4*)((const char*)xin + (unsigned)(o * 4u)); f32x4 a = acc[ai][bj][m][n];
                        if (GATE) { typedef unsigned u32x2v __attribute__((ext_vector_type(2))); const u32x2v ev = *(const u32x2v*)((const char*)e + (unsigned)(o * 2u));
                            const float e0 = __builtin_bit_cast(float, ev.x << 16), e1 = __builtin_bit_cast(float, ev.x & 0xffff0000u), e2 = __builtin_bit_cast(float, ev.y << 16), e3 = __builtin_bit_cast(float, ev.y & 0xffff0000u);
                            a[0] = e0 / (1.0f + __expf(-a[0])); a[1] = e1 / (1.0f + __expf(-a[1])); a[2] = e2 / (1.0f + __expf(-a[2])); a[3] = e3 / (1.0f + __expf(-a[3])); }
                        *(f32x4*)((char*)xout + (unsigned)(o * 4u)) = xv + a; }
                asm volatile("" ::: "memory"); }
    }
};
}
#define XB_TMO      128
#define XB_XCNT(j)  (256  + 64 * (j))
#define XB_XSUB(j)  (1280 + 64 * (j))
#define XB_XGEN(j)  (2304 + 64 * (j))
#define XB_TOP      3328
#define XB_TOPGEN   3392
#define XCD_BAR_WORDS 3456
#define XB_SPIN_CAP (1u << 18)

__device__ __forceinline__ unsigned xb_ld(unsigned* p)              { return __hip_atomic_load(p, __ATOMIC_RELAXED, __HIP_MEMORY_SCOPE_AGENT); }
__device__ __forceinline__ unsigned xb_add(unsigned* p, unsigned v) { return __hip_atomic_fetch_add(p, v, __ATOMIC_RELAXED, __HIP_MEMORY_SCOPE_AGENT); }
__device__ __forceinline__ unsigned xb_xcc_id() { return (unsigned)__builtin_amdgcn_s_getreg((3 << 11) | 20) & 0xFu; }
#define XB_SPIN(cond, bar) do { unsigned _sp = 0; while (cond) { __builtin_amdgcn_s_sleep(1); \
    if ((++_sp & 255u) == 0u) { if (xb_ld(&(bar)[XB_TMO])) break; if (_sp > XB_SPIN_CAP) { atomicAdd(&(bar)[XB_TMO], 1u); break; } } } } while (0)

struct XcdBarrier {
    unsigned* bar; unsigned x;
    volatile LAS unsigned* st;
};

__device__ __forceinline__ XcdBarrier xcd_barrier_post(unsigned* bar, volatile LAS unsigned* st) {
    XcdBarrier b; b.bar = bar; b.x = xb_xcc_id(); b.st = st;
    if (threadIdx.x == 0) (void)xb_add(&bar[XB_XCNT(b.x)], 1u);
    return b;
}
__device__ __forceinline__ void xcd_barrier_complete(unsigned* bar, unsigned x, unsigned& nloc, unsigned& nx) {
    const unsigned G = gridDim.x * gridDim.y * gridDim.z;
    unsigned sum, cnt, mine, sp = 0u;
    for (;;) {
        sum = 0u; cnt = 0u; mine = 0u;
#pragma unroll
        for (unsigned j = 0; j < 16; ++j) { const unsigned c = xb_ld(&bar[XB_XCNT(j)]); sum += c; cnt += (c > 0u) ? 1u : 0u; mine = (j == x) ? c : mine; }
        if (sum == G) break;
        __builtin_amdgcn_s_sleep(1);
        if ((++sp & 255u) == 0u) { if (xb_ld(&bar[XB_TMO])) break; if (sp > XB_SPIN_CAP) { atomicAdd(&bar[XB_TMO], 1u); break; } }
    }
    nloc = mine > 0u ? mine : 1u; nx = cnt > 0u ? cnt : 1u;
}

__device__ __forceinline__ void xcd_barrier(const XcdBarrier& b) {
    asm volatile("s_waitcnt vmcnt(0)" ::: "memory");
    __syncthreads();
    if (threadIdx.x == 0) {
        unsigned* bar = b.bar;
        __builtin_amdgcn_s_waitcnt(0);
        unsigned nloc = b.st[0], nx = b.st[1];
        if (nloc == 0u) { xcd_barrier_complete(bar, b.x, nloc, nx); b.st[0] = nloc; b.st[1] = nx; }
        const unsigned old = xb_add(&bar[XB_XSUB(b.x)], 1u);
        const unsigned gen = old / nloc;
        if (old + 1u == (gen + 1u) * nloc) {
            __builtin_amdgcn_fence(__ATOMIC_RELEASE, "agent");
            asm volatile("s_waitcnt vmcnt(0)" ::: "memory");
            const unsigned og = xb_add(&bar[XB_TOP], 1u);
            const unsigned tg = og / nx;
            if (og + 1u == (tg + 1u) * nx) xb_add(&bar[XB_TOPGEN], 1u);
            else XB_SPIN(xb_ld(&bar[XB_TOPGEN]) == tg, bar);
            __builtin_amdgcn_fence(__ATOMIC_ACQUIRE, "agent");
            xb_add(&bar[XB_XGEN(b.x)], 1u);
            asm volatile("s_waitcnt vmcnt(0)" ::: "memory");
        } else {
            XB_SPIN(xb_ld(&bar[XB_XGEN(b.x)]) == gen, bar);
            __builtin_amdgcn_fence(__ATOMIC_ACQUIRE, "agent");
            asm volatile("s_waitcnt vmcnt(0)" ::: "memory");
        }
    }
    __syncthreads();
}

struct Args { const void* in[30]; float* out; unsigned char* ws; int ph_lo, ph_hi; };
struct Frame {
    LAS unsigned char* lds;
    gu32* ctl;
    unsigned char* ws;
    int tid, lane, wave, G, bid;
};
DI const void* argin(const Args&, int k) {
    typedef const void* const __attribute__((address_space(4)))* kptr_t;
    kptr_t p = (kptr_t)__builtin_amdgcn_kernarg_segment_ptr(); asm volatile("" : "+s"(p));
    return (const void*)p[k]; }
DI int launder_s(int x) { asm volatile("" : "+s"(x)); return x; }
DI Frame phase_frame(const Frame& F0) { Frame F = F0;
    int l; asm volatile("v_mbcnt_lo_u32_b32 %0, -1, 0\n\tv_mbcnt_hi_u32_b32 %0, -1, %0" : "=v"(l));
    F.wave = launder_s(F0.wave); F.bid = launder_s(F0.bid); F.G = launder_s(F0.G);
    F.lane = l; F.tid = F.wave * 64 + l;
    { unsigned long long wsb = (unsigned long long)F0.ws; asm volatile("" : "+s"(wsb)); F.ws = (unsigned char*)wsb; }
    { unsigned ll = (unsigned)(size_t)F0.lds; asm volatile("" : "+s"(ll)); F.lds = (LAS unsigned char*)(size_t)ll; }
    return F; }
DI unsigned char* lw_ptr(const Frame& F, int layer, size_t off) { return F.ws + WS_W + (size_t)layer * LW_STRIDE + off; }

DI void transpose_item(const float* W, int K, int Nsrc, int nsrc0, bf16* WT, int dst_row0, int k0, LAS float* scr, int lane) {
#pragma unroll 8
    for (int i = 0; i < 32; ++i) { const int kk = 2 * i + (lane >> 5); scr[kk * 33 + (lane & 31)] = W[(size_t)(k0 + kk) * Nsrc + nsrc0 + (lane & 31)]; }
    LDS_WAIT(); asm volatile("" ::: "memory");
    const int c = lane & 7;
#pragma unroll
    for (int j = 0; j < 4; ++j) { const int n = (lane >> 3) + 8 * j; const LAS float* s = scr + (8 * c) * 33 + n;
        u32x4 o; o.x = pk2(s[0 * 33], s[1 * 33]); o.y = pk2(s[2 * 33], s[3 * 33]); o.z = pk2(s[4 * 33], s[5 * 33]); o.w = pk2(s[6 * 33], s[7 * 33]);
        *(u32x4*)(WT + (size_t)(dst_row0 + n) * K + k0 + 8 * c) = o; }
    LDS_WAIT(); asm volatile("" ::: "memory");
}
DI int proj_src_col(int d) {
    if (d < 5120) {
        const int pn = d >> 8; const bool rp = (pn < 10) || pn == 12 || pn == 13 || pn == 16 || pn == 17;
        if (!rp) return d;
        const int c = d & 255, bj = c >> 7, wc = (c >> 5) & 3;
        return (pn << 8) + 128 * (wc >> 1) + 64 * bj + 32 * (wc & 1);
    }
    if (d < 16384) return d + 48;
    if (d < 22528) return d + 80;
    if (d < 22592) return S_GN + (d - 22528);
    if (d < 22624) return S_DT + (d - 22592);
    return 0;
}
constexpr int TI_IN = 32 * 712, TI_O = 32 * 64, TI_UP = 32 * 256, TI_DOWN = 128 * 64, TI_PG = 32 * 64, TI_PLE = 4 * 64, TI_P1 = 64 * 4, TI_P2 = 2 * 4;
constexpr int TI_LAYER = TI_IN + TI_O + TI_UP + TI_DOWN + TI_PG + TI_PLE + 2 * TI_P1 + 2 * TI_P2;

DI void p0_prologue(const Frame& F0, const Args& A) {
    const Frame F = phase_frame(F0);
    LAS float* scr = (LAS float*)(F.lds + F.wave * 16384);
    const int gw = F.bid * NWAVES + F.wave, NGW = F.G * NWAVES;
    for (int it = gw; it < DEPTH * TI_LAYER; it += NGW) {
        const int layer = it / TI_LAYER; int r = it - layer * TI_LAYER;
        if (r < TI_IN) { const int kb = r / 712, nb = r - kb * 712;
            transpose_item((const float*)argin(A, 4) + (size_t)layer * DM * PROJ_SRC, DM, PROJ_SRC, proj_src_col(nb * 32), (bf16*)lw_ptr(F, layer, LW_IN), nb * 32, kb * 64, scr, F.lane); continue; } r -= TI_IN;
        if (r < TI_O) { const int kb = r / 64, nb = r % 64;
            transpose_item((const float*)argin(A, 22) + (size_t)layer * DM * DM, DM, DM, nb * 32, (bf16*)lw_ptr(F, layer, LW_O), nb * 32, kb * 64, scr, F.lane); continue; } r -= TI_O;
        if (r < TI_UP) { const int kb = r / 256, nb = r % 256;
            transpose_item((const float*)argin(A, 24) + (size_t)layer * DM * DFF, DM, DFF, nb * 32, (bf16*)lw_ptr(F, layer, LW_UP), nb * 32, kb * 64, scr, F.lane); continue; } r -= TI_UP;
        if (r < TI_DOWN) { const int kb = r / 64, nb = r % 64;
            transpose_item((const float*)argin(A, 25) + (size_t)layer * DFF * DM, DFF, DM, nb * 32, (bf16*)lw_ptr(F, layer, LW_DOWN), nb * 32, kb * 64, scr, F.lane); continue; } r -= TI_DOWN;
        if (r < TI_PG) { const int kb = r / 64, nb = r % 64;
            transpose_item((const float*)argin(A, 28) + (size_t)layer * DM * DM, DM, DM, nb * 32, (bf16*)lw_ptr(F, layer, LW_PG), nb * 32, kb * 64, scr, F.lane); continue; } r -= TI_PG;
        if (r < TI_PLE) { const int kb = r / 64, nb = r % 64;
            transpose_item((const float*)argin(A, 27) + (size_t)layer * PLE * DM, PLE, DM, nb * 32, (bf16*)lw_ptr(F, layer, LW_PLE), nb * 32, kb * 64, scr, F.lane); continue; } r -= TI_PLE;
        if (r < TI_P1) { const int kb = r / 4, nb = r % 4;
            transpose_item((const float*)argin(A, 7) + (size_t)layer * 4096 * 128, 4096, 128, nb * 32, (bf16*)lw_ptr(F, layer, LW_PK1), nb * 32, kb * 64, scr, F.lane); continue; } r -= TI_P1;
        if (r < TI_P1) { const int kb = r / 4, nb = r % 4;
            transpose_item((const float*)argin(A, 11) + (size_t)layer * 4096 * 128, 4096, 128, nb * 32, (bf16*)lw_ptr(F, layer, LW_PV1), nb * 32, kb * 64, scr, F.lane); continue; } r -= TI_P1;
        if (r < TI_P2) { const int kb = r / 4, nb = r % 4;
            transpose_item((const float*)argin(A, 9) + (size_t)layer * 128 * 128, 128, 128, nb * 32, (bf16*)lw_ptr(F, layer, LW_PK2), nb * 32, kb * 64, scr, F.lane); continue; } r -= TI_P2;
        { const int kb = r / 4, nb = r % 4;
            transpose_item((const float*)argin(A, 13) + (size_t)layer * 128 * 128, 128, 128, nb * 32, (bf16*)lw_ptr(F, layer, LW_PV2), nb * 32, kb * 64, scr, F.lane); }
    }
    const size_t gt = (size_t)F.bid * NTHR + F.tid, NGT = (size_t)F.G * NTHR;
    { const float* p = (const float*)argin(A, 1); bf16* pb = (bf16*)(F.ws + WS_PB);
      for (size_t i = gt; i < (size_t)DEPTH * M * PLE / 8; i += NGT) { const f32x4 a = *(const f32x4*)(p + i * 8), b = *(const f32x4*)(p + i * 8 + 4);
          u32x4 o; o.x = pk2(a[0], a[1]); o.y = pk2(a[2], a[3]); o.z = pk2(b[0], b[1]); o.w = pk2(b[2], b[3]); *(u32x4*)(pb + i * 8) = o; } }
    { const int* pos = (const int*)argin(A, 2); float* rope = (float*)(F.ws + WS_ROPE);
      for (size_t i = gt; i < (size_t)M * 64; i += NGT) { const int row = (int)(i >> 6), jj = (int)(i & 63);
          const float inv = 1.0f / powf(10000.0f, (float)(2 * jj) * (1.0f / 128.0f));
          const float ang = (float)pos[row] * inv;
          double a = (double)ang; a -= 6.283185307179586476925 * __builtin_rint(a * 0.15915494309189533577);
          const float ar = (float)a;
          rope[i * 2] = cosf(ar); rope[i * 2 + 1] = sinf(ar); } }
    { float* part = (float*)(F.ws + WS_MISC);
      for (size_t i = gt; i < (size_t)DEPTH * 2 * 8 * 128; i += NGT) { const int hid = (int)(i & 127), c = (int)(i >> 7) & 7, kv = (int)(i >> 10) & 1, layer = (int)(i >> 11);
          const float* pe = (const float*)(kv ? A.in[6] : A.in[5]) + (size_t)layer * 4096 + c * 512;
          const float* w1 = (const float*)(kv ? A.in[11] : A.in[7]) + (size_t)layer * 4096 * 128 + (size_t)c * 512 * 128 + hid;
          float s = 0.f;
#pragma unroll 8
          for (int kk = 0; kk < 512; ++kk) s += pe[kk] * w1[(size_t)kk * 128];
          part[i] = s; } }
}

template <bool OUTF32> DI void norm_rows(const Frame& F0, const float* x, const float* g, void* outp) {
    const Frame F = phase_frame(F0);
    const int gw = F.bid * NWAVES + F.wave, NGW = F.G * NWAVES;
    for (int m = gw; m < M; m += NGW) {
        const f32x4* xr = (const f32x4*)(x + (size_t)m * DM) + F.lane;
        f32x4 v[8]; float s = 0.f;
#pragma unroll
        for (int j = 0; j < 8; ++j) { v[j] = xr[64 * j]; s += (v[j][0] * v[j][0] + v[j][1] * v[j][1]) + (v[j][2] * v[j][2] + v[j][3] * v[j][3]); }
        const float rstd = 1.0f / sqrtf(wave_sum(s, F.lane) * (1.0f / DM) + EPS);
#pragma unroll
        for (int j = 0; j < 8; ++j) { const f32x4 gv = ((const f32x4*)g)[F.lane + 64 * j]; const f32x4 o = v[j] * rstd * gv;
            if (OUTF32) ((f32x4*)((float*)outp + (size_t)m * DM))[F.lane + 64 * j] = o;
            else { u32x2 w; w.x = pk2(o[0], o[1]); w.y = pk2(o[2], o[3]); ((u32x2*)((bf16*)outp + (size_t)m * DM))[F.lane + 64 * j] = w; } }
    }
}
DI void unpack8(u32x4 w, float (&f)[8]) { f[0] = bflo(w.x); f[1] = bfhi(w.x); f[2] = bflo(w.y); f[3] = bfhi(w.y); f[4] = bflo(w.z); f[5] = bfhi(w.z); f[6] = bflo(w.w); f[7] = bfhi(w.w); }
DI u32x4 pack8f(const float (&f)[8]) { u32x4 o; o.x = pk2(f[0], f[1]); o.y = pk2(f[2], f[3]); o.z = pk2(f[4], f[5]); o.w = pk2(f[6], f[7]); return o; }

DI void ssd_conv_pass(const Frame& F0, const Args& A, int layer) {
    const Frame F = phase_frame(F0);
    const bf16* proj = (const bf16*)(F.ws + WS_PROJ); bf16* xbc = (bf16*)(F.ws + WS_XBC);
    const float* cw = (const float*)argin(A, 16) + (size_t)layer * 4 * SSD_XBC; const float* cb = (const float*)argin(A, 17) + (size_t)layer * SSD_XBC;
    const int gt = F.bid * NTHR + F.tid, NGT = F.G * NTHR;
    for (int task = gt; task < 512 * 384; task += NGT) {
        const int run = task / 384, cg = task - run * 384, ch = cg * 8, row0 = run * 32;
        float w[4][8], bs[8], xm3[8], xm2[8], xm1[8];
#pragma unroll
        for (int j = 0; j < 4; ++j) { const f32x4 a = *(const f32x4*)(cw + j * SSD_XBC + ch), b = *(const f32x4*)(cw + j * SSD_XBC + ch + 4);
            w[j][0] = a[0]; w[j][1] = a[1]; w[j][2] = a[2]; w[j][3] = a[3]; w[j][4] = b[0]; w[j][5] = b[1]; w[j][6] = b[2]; w[j][7] = b[3]; }
        { const f32x4 a = *(const f32x4*)(cb + ch), b = *(const f32x4*)(cb + ch + 4); bs[0] = a[0]; bs[1] = a[1]; bs[2] = a[2]; bs[3] = a[3]; bs[4] = b[0]; bs[5] = b[1]; bs[6] = b[2]; bs[7] = b[3]; }
        if ((row0 & (SEQ - 1)) != 0) {
            unpack8(*(const u32x4*)(proj + (size_t)(row0 - 3) * LDP + C_XBC + ch), xm3);
            unpack8(*(const u32x4*)(proj + (size_t)(row0 - 2) * LDP + C_XBC + ch), xm2);
            unpack8(*(const u32x4*)(proj + (size_t)(row0 - 1) * LDP + C_XBC + ch), xm1);
        } else {
#pragma unroll
            for (int k = 0; k < 8; ++k) { xm3[k] = 0.f; xm2[k] = 0.f; xm1[k] = 0.f; }
        }
#pragma unroll 4
        for (int r = 0; r < 32; ++r) {
            float cur[8], y[8]; unpack8(*(const u32x4*)(proj + (size_t)(row0 + r) * LDP + C_XBC + ch), cur);
#pragma unroll
            for (int k = 0; k < 8; ++k) { const float v = w[0][k] * xm3[k] + w[1][k] * xm2[k] + w[2][k] * xm1[k] + w[3][k] * cur[k] + bs[k]; y[k] = siluf_(v); xm3[k] = xm2[k]; xm2[k] = xm1[k]; xm1[k] = cur[k]; }
            *(u32x4*)(xbc + (size_t)(row0 + r) * SSD_XBC + ch) = pack8f(y);
            asm volatile("" ::: "memory");
        }
    }
    const float* dtb = (const float*)argin(A, 18) + layer * SSD_H; float* dt = (float*)(F.ws + WS_DT);
    for (int i = gt; i < M * SSD_H; i += NGT) { const int row = i >> 5, h = i & 31;
        const float x = bf2f(proj[(size_t)row * LDP + C_DT + h]) + dtb[h];
        dt[i] = fmaxf(x, 0.f) + log1pf(__expf(-fabsf(x))); }
}

DI void merge_pass(const Frame& F0, const Args& A, int layer) {
    const Frame F = phase_frame(F0);
    const bf16* proj = (const bf16*)(F.ws + WS_PROJ); const bf16* ya = (const bf16*)(F.ws + WS_YA); const bf16* yc = (const bf16*)(F.ws + WS_YC); bf16* hb = (bf16*)(F.ws + WS_HB);
    const float* sw = (const float*)argin(A, 15) + (size_t)layer * 3 * DM;
    const int gt = F.bid * NTHR + F.tid, NGT = F.G * NTHR;
    for (int task = gt; task < 512 * 256; task += NGT) {
        const int run = task >> 8, cg = task & 255, ch = cg * 8, row0 = run * 32;
        float w[3][8], pm2[8], pm1[8];
#pragma unroll
        for (int j = 0; j < 3; ++j) { const f32x4 a = *(const f32x4*)(sw + j * DM + ch), b = *(const f32x4*)(sw + j * DM + ch + 4);
            w[j][0] = a[0]; w[j][1] = a[1]; w[j][2] = a[2]; w[j][3] = a[3]; w[j][4] = b[0]; w[j][5] = b[1]; w[j][6] = b[2]; w[j][7] = b[3]; }
        if ((row0 & (SEQ - 1)) != 0) {
            float c1[8], u1[8];
            unpack8(*(const u32x4*)(proj + (size_t)(row0 - 2) * LDP + C_CC + ch), c1); unpack8(*(const u32x4*)(proj + (size_t)(row0 - 2) * LDP + C_CU + ch), u1);
#pragma unroll
            for (int k = 0; k < 8; ++k) pm2[k] = c1[k] * u1[k];
            unpack8(*(const u32x4*)(proj + (size_t)(row0 - 1) * LDP + C_CC + ch), c1); unpack8(*(const u32x4*)(proj + (size_t)(row0 - 1) * LDP + C_CU + ch), u1);
#pragma unroll
            for (int k = 0; k < 8; ++k) pm1[k] = c1[k] * u1[k];
        } else {
#pragma unroll
            for (int k = 0; k < 8; ++k) { pm2[k] = 0.f; pm1[k] = 0.f; }
        }
#pragma unroll 2
        for (int r = 0; r < 32; ++r) {
            const size_t pr = (size_t)(row0 + r) * LDP + ch, yr = (size_t)(row0 + r) * DM + ch;
            float cc[8], cu[8], cbv[8], g0[8], g1[8], g2[8], a[8], c[8], o[8];
            unpack8(*(const u32x4*)(proj + pr + C_CC), cc); unpack8(*(const u32x4*)(proj + pr + C_CU), cu); unpack8(*(const u32x4*)(proj + pr + C_CB), cbv);
            unpack8(*(const u32x4*)(proj + pr + C_GM), g0); unpack8(*(const u32x4*)(proj + pr + C_GM + DM), g1); unpack8(*(const u32x4*)(proj + pr + C_GM + 2 * DM), g2);
            unpack8(*(const u32x4*)(ya + yr), a); unpack8(*(const u32x4*)(yc + yr), c);
#pragma unroll
            for (int k = 0; k < 8; ++k) { const float pc = cc[k] * cu[k]; const float cv = w[0][k] * pm2[k] + w[1][k] * pm1[k] + w[2][k] * pc; pm2[k] = pm1[k]; pm1[k] = pc;
                o[k] = sigmoidf_(g0[k]) * a[k] + sigmoidf_(g1[k]) * (cbv[k] * cv) + sigmoidf_(g2[k]) * c[k]; }
            *(u32x4*)(hb + yr) = pack8f(o);
            asm volatile("" ::: "memory");
        }
    }
}

DI void compress_phase(const Frame& F0, const Args& A, int layer) {
    const Frame F = phase_frame(F0);
    const bf16* proj = (const bf16*)(F.ws + WS_PROJ);
    LAS unsigned char* slab = F.lds;
    LAS unsigned char* hidl = F.lds + 73728;
    LAS float* b1s = (LAS float*)(F.lds + 81920);
    const int lane = F.lane, w = F.wave, i = lane & 15, qd = lane >> 4;
    const float* part = (const float*)(F.ws + WS_MISC);
    for (int u = F.bid; u < 512; u += F.G) {
        const int kv = u >> 8, b = (u >> 7) & 1, g = (u >> 5) & 3, nb = u & 31, n0 = nb * 16, tok0 = n0 * 16;
        const int col = (kv ? C_VC : C_KC) + g * HD;
        for (int id = F.tid; id < 272 * 16; id += NTHR) { const int row = id >> 4, ch = id & 15, t = tok0 + row;
            u32x4 v = {0u, 0u, 0u, 0u}; if (t < SEQ) v = *(const u32x4*)(proj + (size_t)(b * SEQ + t) * LDP + col + ch * 8);
            *(LAS u32x4*)(slab + off_b(row, ch)) = v; }
        if (F.tid < 128) { float s = ((const float*)argin(A, kv ? 12 : 8))[layer * 128 + F.tid];
#pragma unroll
            for (int c = 0; c < 8; ++c) s += part[(((size_t)layer * 2 + kv) * 8 + c) * 128 + F.tid];
            b1s[F.tid] = s; }
        __syncthreads();
        const bf16* w1t = (const bf16*)lw_ptr(F, layer, kv ? LW_PV1 : LW_PK1) + (size_t)(16 * w + i) * 4096 + 8 * qd;
        f32x4 acc = {0.f, 0.f, 0.f, 0.f};
#pragma unroll 8
        for (int ks = 0; ks < 128; ++ks) {
            const bf16x8 a = lds_rd8(slab + off_b(16 * i + (ks >> 2), 4 * (ks & 3) + qd));
            const bf16x8 bb = *(const bf16x8*)(w1t + 32 * ks);
            acc = MFMA16(a, bb, acc);
        }
        { const float bv = b1s[16 * w + i];
#pragma unroll
          for (int j = 0; j < 4; ++j) *(LAS bf16*)(hidl + (4 * qd + j) * 272 + (16 * w + i) * 2) = (bf16)f2bf(siluf_(acc[j] + bv)); }
        __syncthreads();
        const bf16* w2t = (const bf16*)lw_ptr(F, layer, kv ? LW_PV2 : LW_PK2) + (size_t)(16 * w + i) * 128 + 8 * qd;
        f32x4 acc2 = {0.f, 0.f, 0.f, 0.f};
#pragma unroll
        for (int s = 0; s < 4; ++s) {
            const bf16x8 a = lds_rd8(hidl + i * 272 + 64 * s + 16 * qd);
            const bf16x8 bb = *(const bf16x8*)(w2t + 32 * s);
            acc2 = MFMA16(a, bb, acc2);
        }
        const float b2 = ((const float*)argin(A, kv ? 14 : 10))[layer * 128 + 16 * w + i];
        bf16* dst = (bf16*)(F.ws + (kv ? WS_VCMP : WS_KCMP)) + ((size_t)(b * NG + g) * NCMP_PAD + n0) * HD + 16 * w + i;
#pragma unroll
        for (int j = 0; j < 4; ++j) dst[(size_t)(4 * qd + j) * HD] = (bf16)f2bf(acc2[j] + b2);
        __syncthreads();
    }
}

DI void ssd_states_phase(const Frame& F0, const Args& A, int layer) {
    const Frame F = phase_frame(F0);
    const bf16* xbc = (const bf16*)(F.ws + WS_XBC); const float* dt = (const float*)(F.ws + WS_DT);
    float* acs = (float*)(F.ws + WS_ACS); float* cdec = (float*)(F.ws + WS_CDEC); float* st = (float*)(F.ws + WS_ST);
    LAS unsigned char* Bt = F.lds; LAS unsigned char* Xt = F.lds + 32768; LAS float* sc = (LAS float*)(F.lds + 65536);
    const float* alog = (const float*)argin(A, 19) + layer * SSD_H;
    const int lane = F.lane, w = F.wave, i = lane & 15, qd = lane >> 4;
    for (int u = F.bid; u < 512; u += F.G) {
        const int b = u >> 8, c = (u >> 2) & 63, g = u & 3, row0 = b * SEQ + c * SSD_CH;
        {
            const int hh = g * 8 + w; const float a = -__expf(alog[hh]);
            const float dt0 = dt[(size_t)(row0 + 2 * lane) * SSD_H + hh], dt1 = dt[(size_t)(row0 + 2 * lane + 1) * SSD_H + hh];
            const float d0 = dt0 * a, d1 = dt1 * a, pair = d0 + d1; float s = pair;
#pragma unroll
            for (int o = 1; o < 64; o <<= 1) { const float t = shfl_idx(s, lane - o); if (lane >= o) s += t; }
            const float a0 = (s - pair) + d0, a1 = s, total = __builtin_bit_cast(float, __builtin_amdgcn_readlane(__builtin_bit_cast(int, s), 63));
            acs[(size_t)(row0 + 2 * lane) * SSD_H + hh] = a0; acs[(size_t)(row0 + 2 * lane + 1) * SSD_H + hh] = a1;
            sc[w * 128 + 2 * lane] = dt0 * __expf(total - a0); sc[w * 128 + 2 * lane + 1] = dt1 * __expf(total - a1);
            if (lane == 0) cdec[(size_t)(b * SSD_NC + c) * SSD_H + hh] = __expf(total);
        }
        for (int id = F.tid; id < 128 * 16; id += NTHR) { const int row = id >> 4, ch = id & 15;
            *(LAS u32x4*)(Bt + off_b(row, ch)) = *(const u32x4*)(xbc + (size_t)(row0 + row) * SSD_XBC + 2048 + g * 128 + ch * 8); }
        bf16x8 bfr[4];
        for (int hp = 0; hp < 4; ++hp) {
            __syncthreads();
            for (int id = F.tid; id < 128 * 16; id += NTHR) { const int row = id >> 4, ch = id & 15;
                float x[8]; unpack8(*(const u32x4*)(xbc + (size_t)(row0 + row) * SSD_XBC + g * 512 + hp * 128 + ch * 8), x);
                const float f = sc[(hp * 2 + (ch >> 3)) * 128 + row];
#pragma unroll
                for (int k = 0; k < 8; ++k) x[k] *= f;
                *(LAS u32x4*)(Xt + off_b(row, ch)) = pack8f(x); }
            __syncthreads();
            if (hp == 0) {
#pragma unroll
                for (int ks = 0; ks < 4; ++ks) bfr[ks] = tr_read8(Bt, lane, 32 * ks, w);
            }
#pragma unroll
            for (int h2 = 0; h2 < 2; ++h2) {
                const int head = g * 8 + hp * 2 + h2;
                float* dst = st + ((size_t)((b * SSD_NC + c) * SSD_H + head) * SSD_N + 16 * w + i) * SSD_P + 4 * qd;
#pragma unroll
                for (int pt = 0; pt < 4; ++pt) {
                    f32x4 acc = {0.f, 0.f, 0.f, 0.f};
#pragma unroll
                    for (int ks = 0; ks < 4; ++ks) acc = MFMA16(tr_read8(Xt, lane, 32 * ks, h2 * 4 + pt), bfr[ks], acc);
                    *(f32x4*)(dst + 16 * pt) = acc;
                }
            }
        }
        __syncthreads();
    }
}
DI void ssd_scan_phase(const Frame& F0) {
    const Frame F = phase_frame(F0);
    f32x4* st = (f32x4*)(F.ws + WS_ST); const float* cdec = (const float*)(F.ws + WS_CDEC);
    const int gt = F.bid * NTHR + F.tid, NGT = F.G * NTHR;
    for (int v = gt; v < BATCH * SSD_H * 2048; v += NGT) {
        const int b = v >> 16, h = (v >> 11) & 31, e = v & 2047;
        f32x4* base = st + ((size_t)(b * SSD_NC) * SSD_H + h) * 2048 + e;
        const float* dc = cdec + (size_t)(b * SSD_NC) * SSD_H + h;
        f32x4 hs = {0.f, 0.f, 0.f, 0.f};
        for (int c0 = 0; c0 < SSD_NC; c0 += 8) {
            f32x4 s[8]; float d[8];
#pragma unroll
            for (int k = 0; k < 8; ++k) { s[k] = base[(size_t)(c0 + k) * 65536]; d[k] = dc[(c0 + k) * SSD_H]; }
#pragma unroll
            for (int k = 0; k < 8; ++k) { base[(size_t)(c0 + k) * 65536] = hs; hs = hs * d[k] + s[k]; }
            asm volatile("" ::: "memory");
        }
    }
}
DI void ssd_out_phase(const Frame& F0, const Args& A, int layer) {
    const Frame F = phase_frame(F0);
    const bf16* xbc = (const bf16*)(F.ws + WS_XBC); const bf16* proj = (const bf16*)(F.ws + WS_PROJ);
    const float* dt = (const float*)(F.ws + WS_DT); const float* acs = (const float*)(F.ws + WS_ACS); const float* st = (const float*)(F.ws + WS_ST);
    bf16* yc = (bf16*)(F.ws + WS_YC);
    LAS unsigned char* Bt = F.lds; LAS unsigned char* Ct = F.lds + 32768; LAS unsigned char* Xt = F.lds + 65536; LAS unsigned char* Ht = F.lds + 98304;
    LAS float* acsl = (LAS float*)(F.lds + LX_OFF);
    const float* dsk = (const float*)argin(A, 20) + layer * SSD_H; const float* ng = (const float*)argin(A, 21) + (size_t)layer * DM;
    const int lane = F.lane, w = F.wave, i = lane & 15, qd = lane >> 4;
    for (int u = F.bid; u < 512; u += F.G) {
        const int b = u >> 8, c = (u >> 2) & 63, g = u & 3, row0 = b * SEQ + c * SSD_CH;
        for (int id = F.tid; id < 128 * 16; id += NTHR) { const int row = id >> 4, ch = id & 15; const bf16* src = xbc + (size_t)(row0 + row) * SSD_XBC + 2048 + g * 128 + ch * 8;
            *(LAS u32x4*)(Bt + off_b(row, ch)) = *(const u32x4*)(src); *(LAS u32x4*)(Ct + off_b(row, ch)) = *(const u32x4*)(src + 512); }
        __syncthreads();
        bf16x8 cfr[4];
#pragma unroll
        for (int ks = 0; ks < 4; ++ks) cfr[ks] = lds_rd8(Ct + off_b(16 * w + i, 4 * ks + qd));
        f32x4 cb[4][2];
#pragma unroll
        for (int k = 0; k < 4; ++k)
#pragma unroll
            for (int T = 0; T < 2; ++T) { f32x4 acc = {0.f, 0.f, 0.f, 0.f};
#pragma unroll
                for (int ks = 0; ks < 4; ++ks) acc = MFMA16(lds_rd8(Bt + off_b(32 * k + 8 * (i >> 2) + (i & 3) + 4 * T, 4 * ks + qd)), cfr[ks], acc);
                cb[k][T] = acc; }
        const int lrow = 16 * w + i, row = row0 + lrow;
        float ssq = 0.f;
        for (int hp = 0; hp < 4; ++hp) {
            __syncthreads();
            if (F.tid < 256) { const int h2 = F.tid >> 7, l = F.tid & 127; acsl[F.tid] = acs[(size_t)(row0 + l) * SSD_H + g * 8 + hp * 2 + h2]; }
            for (int id = F.tid; id < 128 * 16; id += NTHR) { const int r = id >> 4, ch = id & 15, head = g * 8 + hp * 2 + (ch >> 3);
                float x[8]; unpack8(*(const u32x4*)(xbc + (size_t)(row0 + r) * SSD_XBC + g * 512 + hp * 128 + ch * 8), x);
                const float f = dt[(size_t)(row0 + r) * SSD_H + head];
#pragma unroll
                for (int k = 0; k < 8; ++k) x[k] *= f;
                *(LAS u32x4*)(Xt + off_b(r, ch)) = pack8f(x);
                const float* hs = st + ((size_t)((b * SSD_NC + c) * SSD_H + head) * SSD_N + r) * SSD_P + (ch & 7) * 8;
                const f32x4 h0 = *(const f32x4*)hs, h1 = *(const f32x4*)(hs + 4);
                u32x4 hv; hv.x = pk2(h0[0], h0[1]); hv.y = pk2(h0[2], h0[3]); hv.z = pk2(h1[0], h1[1]); hv.w = pk2(h1[2], h1[3]);
                *(LAS u32x4*)(Ht + off_b(r, ch)) = hv; }
            __syncthreads();
#pragma unroll
            for (int h2 = 0; h2 < 2; ++h2) {
                const int head = g * 8 + hp * 2 + h2;
                const float al = acsl[h2 * 128 + lrow], ea = __expf(al), dsv = dsk[head];
                bf16x8 mfr[4];
#pragma unroll
                for (int k = 0; k < 4; ++k) {
                    const f32x4 a0 = *(const LAS f32x4*)(acsl + h2 * 128 + 32 * k + 8 * qd), a1 = *(const LAS f32x4*)(acsl + h2 * 128 + 32 * k + 8 * qd + 4);
                    float mv[8];
#pragma unroll
                    for (int j = 0; j < 4; ++j) { const int s0 = 32 * k + 8 * qd + j, s1 = s0 + 4;
                        mv[j] = (s0 <= lrow) ? cb[k][0][j] * __expf(al - a0[j]) : 0.f;
                        mv[4 + j] = (s1 <= lrow) ? cb[k][1][j] * __expf(al - a1[j]) : 0.f; }
                    mfr[k] = as_bf16x8(pack8f(mv));
                }
#pragma unroll
                for (int pt = 0; pt < 4; ++pt) {
                    f32x4 yd = {0.f, 0.f, 0.f, 0.f}, yo = {0.f, 0.f, 0.f, 0.f};
#pragma unroll
                    for (int k = 0; k < 4; ++k) yd = MFMA16(tr_read8(Xt, lane, 32 * k, h2 * 4 + pt), mfr[k], yd);
#pragma unroll
                    for (int ks = 0; ks < 4; ++ks) yo = MFMA16(tr_read8(Ht, lane, 32 * ks, h2 * 4 + pt), cfr[ks], yo);
                    const int chn = head * SSD_P + 16 * pt + 4 * qd;
                    const u32x2 xv = *(const u32x2*)(xbc + (size_t)row * SSD_XBC + chn), zv = *(const u32x2*)(proj + (size_t)row * LDP + C_Z + chn);
                    const float xs[4] = {bflo(xv.x), bfhi(xv.x), bflo(xv.y), bfhi(xv.y)}, zz[4] = {bflo(zv.x), bfhi(zv.x), bflo(zv.y), bfhi(zv.y)};
                    float gy[4];
#pragma unroll
                    for (int j = 0; j < 4; ++j) { const float y = yd[j] + ea * yo[j] + dsv * xs[j]; gy[j] = y * siluf_(zz[j]); ssq += gy[j] * gy[j]; }
                    u32x2 o; o.x = pk2(gy[0], gy[1]); o.y = pk2(gy[2], gy[3]);
                    *(u32x2*)(yc + (size_t)row * DM + chn) = o;
                }
            }
        }
        ssq += shx(ssq, 16, lane); ssq += shx(ssq, 32, lane);
        const float rstd = 1.0f / sqrtf(ssq * (1.0f / 512.0f) + EPS);
        VM_WAIT();
#pragma unroll 4
        for (int k = 0; k < 32; ++k) { const int chn = g * 512 + 16 * k + 4 * qd;
            const u32x2 v = *(const u32x2*)(yc + (size_t)row * DM + chn); const f32x4 gv = *(const f32x4*)(ng + chn);
            u32x2 o; o.x = pk2(bflo(v.x) * rstd * gv[0], bfhi(v.x) * rstd * gv[1]); o.y = pk2(bflo(v.y) * rstd * gv[2], bfhi(v.y) * rstd * gv[3]);
            *(u32x2*)(yc + (size_t)row * DM + chn) = o; }
        __syncthreads();
    }
}

#ifndef NSA_REP_PART
#define NSA_REP_PART 0
#endif
#if NSA_REP_PART == 7
#define W7DUP(x) x
#define W7WAIT() NSA_WAITV(8)
#else
#define W7DUP(x)
#define W7WAIT() NSA_WAITV(4)
#endif
constexpr int RB = 32768, NRING = 3;
#define NSA_WAITV(n) asm volatile("s_waitcnt vmcnt(" #n ")" ::: "memory")
#define NSA_BAR() do { asm volatile("" ::: "memory"); __builtin_amdgcn_s_barrier(); asm volatile("" ::: "memory"); } while (0)
template <bool WITHV> DI void tile_dma(LAS unsigned char* buf, const bf16* kp, const bf16* vp, int pitch, int w, int lane) {
#pragma unroll
    for (int e = 0; e < 2; ++e) { const int kb = 2 * w + e, kh = kb >> 3, T = (kb >> 2) & 1, ks = kb & 3, i = lane & 15, qd = lane >> 4;
        const int key = 32 * kh + 8 * (i >> 2) + (i & 3) + 4 * T, ch = 4 * ks + qd;
        __builtin_amdgcn_global_load_lds((const unsigned*)(kp + (size_t)key * pitch + ch * 8), (LAS unsigned*)(buf + kb * 1024), 16, 0, 0); }
    if (WITHV) {
#pragma unroll
        for (int e = 0; e < 2; ++e) { const int vb = 2 * w + e, kh = vb >> 3, dt = vb & 7, t = lane >> 5, g = (lane >> 3) & 3, q = (lane >> 1) & 3, ph = lane & 1;
            const int key = 32 * kh + 8 * g + 4 * t + q, ch = 2 * dt + ph;
            __builtin_amdgcn_global_load_lds((const unsigned*)(vp + (size_t)key * pitch + ch * 8), (LAS unsigned*)(buf + 16384 + vb * 1024), 16, 0, 0); }
    }
}
#define NSA_TR8(r, addr, b) asm volatile("ds_read_b64_tr_b16 %0, %8 offset:%9\n\tds_read_b64_tr_b16 %1, %8 offset:%10\n\tds_read_b64_tr_b16 %2, %8 offset:%11\n\tds_read_b64_tr_b16 %3, %8 offset:%12\n\t" \
        "ds_read_b64_tr_b16 %4, %8 offset:%13\n\tds_read_b64_tr_b16 %5, %8 offset:%14\n\tds_read_b64_tr_b16 %6, %8 offset:%15\n\tds_read_b64_tr_b16 %7, %8 offset:%16" \
        : "=&v"(r[0]), "=&v"(r[1]), "=&v"(r[2]), "=&v"(r[3]), "=&v"(r[4]), "=&v"(r[5]), "=&v"(r[6]), "=&v"(r[7]) \
        : "v"(addr), "i"((b)), "i"((b) + 512), "i"((b) + 1024), "i"((b) + 1536), "i"((b) + 2048), "i"((b) + 2560), "i"((b) + 3072), "i"((b) + 3584) : "memory")
#define NSA_TRWAIT(r) asm volatile("s_waitcnt lgkmcnt(0)" : "+v"(r[0]), "+v"(r[1]), "+v"(r[2]), "+v"(r[3]), "+v"(r[4]), "+v"(r[5]), "+v"(r[6]), "+v"(r[7]) :: "memory")
#define NSA_SB() __builtin_amdgcn_sched_barrier(0)
#define NSA_PV4(r, kh, d0) do { _Pragma("unroll") for (int q_ = 0; q_ < 4; ++q_) { const bf16x8 vf_ = __builtin_shufflevector(r[2 * q_], r[2 * q_ + 1], 0, 1, 2, 3, 4, 5, 6, 7); \
        if (SM & 1) O[0][(d0) + q_] = MFMA16(vf_, pf[0][kh], O[0][(d0) + q_]); if (SM & 2) O[1][(d0) + q_] = MFMA16(vf_, pf[1][kh], O[1][(d0) + q_]); } } while (0)
template <int MODE, int SM>
DI void attn_tile(LAS const unsigned char* Kt, LAS const unsigned char* Vt, const bf16x8 (&Qf)[2][4], f32x4 (&O)[2][8], float (&m)[2], float (&l)[2], const int (&lo)[2], const int (&hi)[2], bool needmask,
                  float c2, const float (&inv_l)[2], LAS float* imp, const int (&ql)[2], int jb0, float (&cin)[2], int lane) {
    const int qd = lane >> 4;
    f32x4 sc[2][2][2];
#pragma unroll
    for (int kh = 0; kh < 2; ++kh)
#pragma unroll
        for (int T = 0; T < 2; ++T) { f32x4 a0 = {0.f, 0.f, 0.f, 0.f}, a1 = {0.f, 0.f, 0.f, 0.f};
#pragma unroll
            for (int ks = 0; ks < 4; ++ks) { const bf16x8 kf = lds_rd8(Kt + (kh * 8 + T * 4 + ks) * 1024);
                if (SM & 1) a0 = MFMA16(kf, Qf[0][ks], a0); if (SM & 2) a1 = MFMA16(kf, Qf[1][ks], a1); }
            sc[0][kh][T] = a0; sc[1][kh][T] = a1; }
    const float NEG = -__builtin_inff();
    bf16x8 pf[2][2];
#pragma unroll
    for (int s = 0; s < 2; ++s) if (SM & (1 << s)) {
        if (needmask) {
#pragma unroll
            for (int kh = 0; kh < 2; ++kh)
#pragma unroll
                for (int T = 0; T < 2; ++T)
#pragma unroll
                    for (int j = 0; j < 4; ++j) { const int kk = 32 * kh + 8 * qd + 4 * T + j; if (kk < lo[s] || kk > hi[s]) sc[s][kh][T][j] = NEG; }
        }
        float mn = m[s];
        if (MODE != 2) {
            float tmax = fmaxf(fmaxf(sc[s][0][0][0], sc[s][0][0][1]), fmaxf(sc[s][0][0][2], sc[s][0][0][3]));
            tmax = fmaxf(tmax, fmaxf(fmaxf(sc[s][0][1][0], sc[s][0][1][1]), fmaxf(sc[s][0][1][2], sc[s][0][1][3])));
            tmax = fmaxf(tmax, fmaxf(fmaxf(sc[s][1][0][0], sc[s][1][0][1]), fmaxf(sc[s][1][0][2], sc[s][1][0][3])));
            tmax = fmaxf(tmax, fmaxf(fmaxf(sc[s][1][1][0], sc[s][1][1][1]), fmaxf(sc[s][1][1][2], sc[s][1][1][3])));
            tmax = fmaxf(tmax, shx(tmax, 16, lane)); tmax = fmaxf(tmax, shx(tmax, 32, lane));
            mn = fmaxf(m[s], tmax);
            if (__ballot(mn != m[s]) != 0ull) {
                const float alpha = __builtin_amdgcn_exp2f((m[s] - mn) * c2);
                l[s] *= alpha;
                if (MODE == 1) {
#pragma unroll
                    for (int dt = 0; dt < 8; ++dt) O[s][dt] = O[s][dt] * alpha;
                }
                m[s] = mn;
            }
        }
        const float nmc = -mn * c2; float ps = 0.f;
#pragma unroll
        for (int kh = 0; kh < 2; ++kh)
#pragma unroll
            for (int T = 0; T < 2; ++T)
#pragma unroll
                for (int j = 0; j < 4; ++j) { float p = __builtin_amdgcn_exp2f(__builtin_fmaf(sc[s][kh][T][j], c2, nmc)); if (MODE == 2) p *= inv_l[s]; sc[s][kh][T][j] = p; ps += p; }
        if (MODE != 2) l[s] += ps;
        if (MODE == 2) {
            float s4[2][2], cy[2][2];
#pragma unroll
            for (int kh = 0; kh < 2; ++kh)
#pragma unroll
                for (int T = 0; T < 2; ++T) {
                    float a = (sc[s][kh][T][0] + sc[s][kh][T][1]) + (sc[s][kh][T][2] + sc[s][kh][T][3]), c = sc[s][kh][T][3];
                    a += shx(a, 1, lane); a += shx(a, 2, lane); c += shx(c, 1, lane); c += shx(c, 2, lane);
                    s4[kh][T] = a; cy[kh][T] = c; }
            const float x0 = shfl_idx(cy[0][1], (lane - 16) & 63), x1 = shfl_idx(cy[1][1], (lane - 16) & 63);
            const float p00 = (qd == 0) ? cin[s] : x0, p10 = (qd == 0) ? x0 : x1;
            cin[s] = x1;
            if ((lane & 3) == 0) { const int jb = jb0 + 2 * qd;
                *(LAS f32x2*)(imp + ql[s] * 128 + jb) = (f32x2){s4[0][0] + p00, s4[0][1] + cy[0][0]};
                *(LAS f32x2*)(imp + ql[s] * 128 + jb + 8) = (f32x2){s4[1][0] + p10, s4[1][1] + cy[1][0]}; }
        }
        if (MODE != 0) {
#pragma unroll
            for (int kh = 0; kh < 2; ++kh) { u32x4 pw; pw.x = pk2(sc[s][kh][0][0], sc[s][kh][0][1]); pw.y = pk2(sc[s][kh][0][2], sc[s][kh][0][3]); pw.z = pk2(sc[s][kh][1][0], sc[s][kh][1][1]); pw.w = pk2(sc[s][kh][1][2], sc[s][kh][1][3]); pf[s][kh] = as_bf16x8(pw); }
        }
    }
    if (MODE != 0) {
        const unsigned va = (unsigned)(size_t)Vt;
        s16x4 ra[8], rb[8];
        NSA_TR8(ra, va, 0);     NSA_TRWAIT(ra); NSA_SB();
        NSA_TR8(rb, va, 4096);  NSA_SB(); NSA_PV4(ra, 0, 0); NSA_SB(); NSA_TRWAIT(rb); NSA_SB();
        NSA_TR8(ra, va, 8192);  NSA_SB(); NSA_PV4(rb, 0, 4); NSA_SB(); NSA_TRWAIT(ra); NSA_SB();
        NSA_TR8(rb, va, 12288); NSA_SB(); NSA_PV4(ra, 1, 0); NSA_SB(); NSA_TRWAIT(rb); NSA_SB();
        NSA_PV4(rb, 1, 4);
    }
}
template <bool FIRST> DI void nsa_emit(const f32x4 (&O)[8], float scale, bf16* dst  ) {
    u32x2 old[8];
    if (!FIRST) {
#pragma unroll
        for (int dt = 0; dt < 8; ++dt) old[dt] = *(const u32x2*)(dst + 16 * dt);
    }
#pragma unroll
    for (int dt = 0; dt < 8; ++dt) { f32x4 v = O[dt] * scale;
        if (!FIRST) { v[0] += bflo(old[dt].x); v[1] += bfhi(old[dt].x); v[2] += bflo(old[dt].y); v[3] += bfhi(old[dt].y); }
        u32x2 o; o.x = pk2(v[0], v[1]); o.y = pk2(v[2], v[3]); *(u32x2*)(dst + 16 * dt) = o; }
}
DI int next_bit(unsigned u0, unsigned u1, unsigned u2, unsigned u3, int from) {
    if (from >= 128) return -1;
    const int wd = from >> 5; const unsigned msk = ~0u << (from & 31);
    const unsigned x0 = (wd == 0) ? (u0 & msk) : 0u;
    const unsigned x1 = (wd < 1) ? u1 : ((wd == 1) ? (u1 & msk) : 0u);
    const unsigned x2 = (wd < 2) ? u2 : ((wd == 2) ? (u2 & msk) : 0u);
    const unsigned x3 = (wd < 3) ? u3 : (u3 & msk);
    if (x0) return __builtin_ctz(x0);
    if (x1) return 32 + __builtin_ctz(x1);
    if (x2) return 64 + __builtin_ctz(x2);
    if (x3) return 96 + __builtin_ctz(x3);
    return -1;
}

DI void nsa_phase(const Frame& F0, const Args& A, int layer) {
    const Frame F = phase_frame(F0);
    const bf16* proj = (const bf16*)(F.ws + WS_PROJ); const bf16* kcmp = (const bf16*)(F.ws + WS_KCMP); const bf16* vcmp = (const bf16*)(F.ws + WS_VCMP);
    bf16* ya = (bf16*)(F.ws + WS_YA);
    LAS unsigned char* const RG = F.lds;
    LAS float* imp = (LAS float*)(F.lds + NRING * RB);
    LAS unsigned* selm = (LAS unsigned*)(F.lds + NRING * RB + 32768); LAS unsigned* uml = selm + 256;
    static_assert(NRING * RB + 32768 + 1024 + 16 <= LDSCTL_OFF, "nsa LDS map");
    const float c2 = 0.08838834764831845f * 1.4426950408889634f;
    (void)A; (void)layer;
    for (int u = F.bid; u < 1024; u += F.G) {
        int tid_l = F.tid; asm volatile("" : "+v"(tid_l));
        const int tid = tid_l, lane = tid & 63, w = F.wave, i = lane & 15, qd = lane >> 4, hd = i & 3;
        const int klane = 16 * lane, vlane = 16384 + 8 * lane;
        const int xg = u & 7, jj = (u >> 3) & 31, rr = u >> 8;
        const int b = xg >> 2, g = xg & 3;
        const int qt = (rr == 0) ? 127 - jj : (rr == 1) ? 64 + jj : (rr == 2) ? 63 - jj : jj;
        const int s0 = qt * 64, cur = qt, rowb = b * SEQ;
        int ql[2], trow[2]; bf16x8 Qf[2][4];
#pragma unroll
        for (int s = 0; s < 2; ++s) { ql[s] = 8 * w + 4 * s + (i >> 2); trow[s] = rowb + s0 + ql[s];
#pragma unroll
            for (int ks = 0; ks < 4; ++ks) Qf[s][ks] = *(const bf16x8*)(proj + (size_t)trow[s] * LDP + C_Q + (4 * g + hd) * HD + 32 * ks + 8 * qd); }
        f32x4 O[2][8]; float mrow[2], lrow[2], cin[2], invl[2] = {0.f, 0.f};
        const int ntc = (4 * qt + 3 + 63) >> 6;
        const bf16* kc0 = kcmp + (size_t)(b * NG + g) * NCMP_PAD * HD; const bf16* vc0 = vcmp + (size_t)(b * NG + g) * NCMP_PAD * HD;
        int nmax[2];
#pragma unroll
        for (int s = 0; s < 2; ++s) { const int t = s0 + ql[s]; nmax[s] = (t >= 31) ? ((t - 31) >> 4) : -1; mrow[s] = -1e30f; lrow[s] = 0.f; cin[s] = 0.f; }
        for (int rep_ = 0; rep_ < (NSA_REP_PART == 2 ? 2 : 1); ++rep_) {
#pragma unroll
        for (int s = 0; s < 2; ++s) { mrow[s] = -1e30f; lrow[s] = 0.f; cin[s] = 0.f; }
        NSA_WAITV(0); NSA_BAR();
        tile_dma<false>(RG, kc0, vc0, HD, w, lane); if (ntc > 1) tile_dma<false>(RG + RB, kc0 + (size_t)64 * HD, vc0, HD, w, lane);
        for (int tc = 0, rb = 0; tc < ntc; ++tc) {
            if (tc + 1 < ntc) NSA_WAITV(2); else NSA_WAITV(0);
            NSA_BAR();
            if (tc + 2 < ntc) { const int nb2 = (rb + 2 >= NRING) ? rb + 2 - NRING : rb + 2; tile_dma<false>(RG + nb2 * RB, kc0 + (size_t)(tc + 2) * 64 * HD, vc0, HD, w, lane); }
            { const int lo2[2] = {0, 0}, hi2[2] = {nmax[0] - 64 * tc, nmax[1] - 64 * tc}; const bool nm = __ballot(hi2[0] < 63 || hi2[1] < 63) != 0ull;
              attn_tile<0, 3>(RG + rb * RB + klane, RG, Qf, O, mrow, lrow, lo2, hi2, nm, c2, invl, imp, ql, 0, cin, lane); }
            rb = (rb + 1 == NRING) ? 0 : rb + 1;
        }
#pragma unroll
        for (int s = 0; s < 2; ++s) { float lt = lrow[s]; lt += shx(lt, 16, lane); lt += shx(lt, 32, lane); invl[s] = (lt > 0.f) ? 1.0f / lt : 0.f;
#pragma unroll
            for (int dt = 0; dt < 8; ++dt) O[s][dt] = (f32x4){0.f, 0.f, 0.f, 0.f}; }
        NSA_BAR();
        tile_dma<true>(RG, kc0, vc0, HD, w, lane); if (ntc > 1) tile_dma<true>(RG + RB, kc0 + (size_t)64 * HD, vc0 + (size_t)64 * HD, HD, w, lane);
        for (int tc = 0, rb = 0; tc < ntc; ++tc) {
            if (tc + 1 < ntc) NSA_WAITV(4); else NSA_WAITV(0);
            NSA_BAR();
            if (tc + 2 < ntc) { const int nb2 = (rb + 2 >= NRING) ? rb + 2 - NRING : rb + 2; tile_dma<true>(RG + nb2 * RB, kc0 + (size_t)(tc + 2) * 64 * HD, vc0 + (size_t)(tc + 2) * 64 * HD, HD, w, lane); }
            { const int lo2[2] = {0, 0}, hi2[2] = {nmax[0] - 64 * tc, nmax[1] - 64 * tc}; const bool nm = __ballot(hi2[0] < 63 || hi2[1] < 63) != 0ull;
              attn_tile<2, 3>(RG + rb * RB + klane, RG + rb * RB + vlane, Qf, O, mrow, lrow, lo2, hi2, nm, c2, invl, imp, ql, 16 * tc, cin, lane); }
            rb = (rb + 1 == NRING) ? 0 : rb + 1;
        }
#pragma unroll
        for (int s = 0; s < 2; ++s) { const float gate = sigmoidf_(bf2f(proj[(size_t)trow[s] * LDP + C_GN + (4 * g + hd) * 3 + 0]));
            nsa_emit<true>(O[s], gate, ya + (size_t)trow[s] * DM + (4 * g + hd) * HD + 4 * qd); }
        }
        for (int rep_ = 0; rep_ < (NSA_REP_PART == 1 ? 2 : 1); ++rep_) {
            LDS_WAIT();
            const int nforced = (cur == 0) ? 1 : (cur == 1) ? 2 : 3; const int nsel = (cur + 1 < NSEL) ? cur + 1 : NSEL; const int R = nsel - nforced;
            const int E = (cur >= 3) ? cur - 2 : 0;
            for (int q8 = 0; q8 < 8; ++q8) {
                const int q = 8 * w + q8;
                const int j0 = lane, j1 = lane + 64;
                const bool e0 = (j0 >= 1) && (j0 <= cur - 2), e1 = (j1 <= cur - 2);
                const bool f0 = (j0 == 0) || (j0 == cur) || (j0 == cur - 1), f1 = (j1 == cur) || (j1 == cur - 1);
                bool s0 = e0, s1 = e1;
                if (R < E) {
                    const unsigned k0 = e0 ? __builtin_bit_cast(unsigned, imp[q * 128 + j0]) + 1u : 0u, k1 = e1 ? __builtin_bit_cast(unsigned, imp[q * 128 + j1]) + 1u : 0u;
                    unsigned T = 0u;
#pragma unroll 1
                    for (int bit = 30; bit >= 0; --bit) { const unsigned c = T | (1u << bit);
                        const int n = __builtin_popcountll(__ballot(k0 >= c)) + __builtin_popcountll(__ballot(k1 >= c));
                        if (n >= R) T = c; }
                    const unsigned long long eq0 = __ballot(k0 == T), eq1 = __ballot(k1 == T);
                    const int G = __builtin_popcountll(__ballot(k0 > T)) + __builtin_popcountll(__ballot(k1 > T));
                    const unsigned long long lt = (1ull << lane) - 1ull;
                    const int r0 = __builtin_popcountll(eq0 & lt), r1 = __builtin_popcountll(eq0) + __builtin_popcountll(eq1 & lt);
                    s0 = (k0 > T) || (k0 == T && r0 < R - G); s1 = (k1 > T) || (k1 == T && r1 < R - G);
                }
                const unsigned long long m0 = __ballot(f0 || s0), m1 = __ballot(f1 || s1);
                if (lane == 0) { selm[q * 4 + 0] = (unsigned)m0; selm[q * 4 + 1] = (unsigned)(m0 >> 32); selm[q * 4 + 2] = (unsigned)m1; selm[q * 4 + 3] = (unsigned)(m1 >> 32); }
            }
            __syncthreads();
            if (w == 0) { unsigned x0 = selm[lane * 4 + 0], x1 = selm[lane * 4 + 1], x2 = selm[lane * 4 + 2], x3 = selm[lane * 4 + 3];
#pragma unroll
                for (int o = 1; o < 64; o <<= 1) { x0 |= shfl_idx_u(x0, lane ^ o); x1 |= shfl_idx_u(x1, lane ^ o); x2 |= shfl_idx_u(x2, lane ^ o); x3 |= shfl_idx_u(x3, lane ^ o); }
                if (lane == 0) { uml[0] = x0; uml[1] = x1; uml[2] = x2; uml[3] = x3; } }
            __syncthreads();
        }
        const unsigned um0 = __builtin_amdgcn_readfirstlane(uml[0]), um1 = __builtin_amdgcn_readfirstlane(uml[1]), um2 = __builtin_amdgcn_readfirstlane(uml[2]), um3 = __builtin_amdgcn_readfirstlane(uml[3]);
        for (int rep_ = 0; rep_ < (NSA_REP_PART == 3 ? 2 : 1); ++rep_) {
            const bf16* ks0 = proj + (size_t)rowb * LDP + C_KS + g * HD; const bf16* vs0 = proj + (size_t)rowb * LDP + C_VS + g * HD;
#pragma unroll
            for (int s = 0; s < 2; ++s) { mrow[s] = -1e30f; lrow[s] = 0.f;
#pragma unroll
                for (int dt = 0; dt < 8; ++dt) O[s][dt] = (f32x4){0.f, 0.f, 0.f, 0.f}; }
            int jb = next_bit(um0, um1, um2, um3, 0), j1 = next_bit(um0, um1, um2, um3, jb + 1), rb = 0;
            VM_WAIT(); if (NSA_REP_PART == 3) NSA_BAR();
            tile_dma<true>(RG, ks0 + (size_t)jb * 64 * LDP, vs0 + (size_t)jb * 64 * LDP, LDP, w, lane);
            if (j1 >= 0) tile_dma<true>(RG + RB, ks0 + (size_t)j1 * 64 * LDP, vs0 + (size_t)j1 * 64 * LDP, LDP, w, lane);
            while (jb >= 0) {
                const int j2 = (j1 >= 0) ? next_bit(um0, um1, um2, um3, j1 + 1) : -1;
                if (j1 >= 0) NSA_WAITV(4); else NSA_WAITV(0);
                NSA_BAR();
                if (j2 >= 0) { const int nb2 = (rb + 2 >= NRING) ? rb + 2 - NRING : rb + 2; tile_dma<true>(RG + nb2 * RB, ks0 + (size_t)j2 * 64 * LDP, vs0 + (size_t)j2 * 64 * LDP, LDP, w, lane); }
                { const bool act0 = (selm[ql[0] * 4 + (jb >> 5)] >> (jb & 31)) & 1u, act1 = (selm[ql[1] * 4 + (jb >> 5)] >> (jb & 31)) & 1u;
                  const bool any0 = __ballot(act0) != 0ull, any1 = __ballot(act1) != 0ull;
                  const int lo2[2] = {0, 0}, hi2[2] = {act0 ? ((jb < cur) ? 63 : ql[0]) : -1, act1 ? ((jb < cur) ? 63 : ql[1]) : -1};
                  LAS const unsigned char* kt = RG + rb * RB + klane; LAS const unsigned char* vt = RG + rb * RB + vlane;
                  if (any0 && any1) { const bool nm = __ballot(hi2[0] < 63 || hi2[1] < 63) != 0ull; attn_tile<1, 3>(kt, vt, Qf, O, mrow, lrow, lo2, hi2, nm, c2, invl, imp, ql, 0, cin, lane); }
                  else if (any0) { const bool nm = __ballot(hi2[0] < 63) != 0ull; attn_tile<1, 1>(kt, vt, Qf, O, mrow, lrow, lo2, hi2, nm, c2, invl, imp, ql, 0, cin, lane); }
                  else if (any1) { const bool nm = __ballot(hi2[1] < 63) != 0ull; attn_tile<1, 2>(kt, vt, Qf, O, mrow, lrow, lo2, hi2, nm, c2, invl, imp, ql, 0, cin, lane); } }
                jb = j1; j1 = j2; rb = (rb + 1 == NRING) ? 0 : rb + 1;
            }
#pragma unroll
            for (int s = 0; s < 2; ++s) { float lt = lrow[s]; lt += shx(lt, 16, lane); lt += shx(lt, 32, lane);
                const float gate = sigmoidf_(bf2f(proj[(size_t)trow[s] * LDP + C_GN + (4 * g + hd) * 3 + 1]));
                if (rep_ == 0) nsa_emit<false>(O[s], (lt > 0.f) ? gate / lt : 0.f, ya + (size_t)trow[s] * DM + (4 * g + hd) * HD + 4 * qd); }
        }
        for (int rep_ = 0; rep_ < (NSA_REP_PART == 4 ? 2 : 1); ++rep_) {
            const bf16* kw0 = proj + (size_t)rowb * LDP + C_KW + g * HD; const bf16* vw0 = proj + (size_t)rowb * LDP + C_VW + g * HD;
#pragma unroll
            for (int s = 0; s < 2; ++s) { mrow[s] = -1e30f; lrow[s] = 0.f;
#pragma unroll
                for (int dt = 0; dt < 8; ++dt) O[s][dt] = (f32x4){0.f, 0.f, 0.f, 0.f}; }
#if NSA_REP_PART == 8
            {
            const int tt0d = (qt >= 8) ? 0 : 8 - qt;
            VM_WAIT(); NSA_BAR();
            { const size_t r0 = (size_t)(s0 - 512 + 64 * tt0d) * LDP; tile_dma<true>(RG, kw0 + r0, vw0 + r0, LDP, w, lane); W7DUP(tile_dma<true>(RG, kw0 + r0, vw0 + r0, LDP, w, lane);) }
            if (tt0d < 8) { const size_t r0 = (size_t)(s0 - 512 + 64 * (tt0d + 1)) * LDP; tile_dma<true>(RG + RB, kw0 + r0, vw0 + r0, LDP, w, lane); W7DUP(tile_dma<true>(RG + RB, kw0 + r0, vw0 + r0, LDP, w, lane);) }
            for (int tt = tt0d, rb = 0; tt <= 8; ++tt) {
                if (tt < 8) { W7WAIT(); } else NSA_WAITV(0);
                NSA_BAR();
                if (tt + 2 <= 8) { const int nb2 = (rb + 2 >= NRING) ? rb + 2 - NRING : rb + 2; const size_t r0 = (size_t)(s0 - 512 + 64 * (tt + 2)) * LDP; tile_dma<true>(RG + nb2 * RB, kw0 + r0, vw0 + r0, LDP, w, lane); W7DUP(tile_dma<true>(RG + nb2 * RB, kw0 + r0, vw0 + r0, LDP, w, lane);) }
                rb = (rb + 1 == NRING) ? 0 : rb + 1;
            }
            }
#endif
            const int tt0 = (qt >= 8) ? 0 : 8 - qt;
            VM_WAIT(); NSA_BAR();
            { const size_t r0 = (size_t)(s0 - 512 + 64 * tt0) * LDP; tile_dma<true>(RG, kw0 + r0, vw0 + r0, LDP, w, lane); W7DUP(tile_dma<true>(RG, kw0 + r0, vw0 + r0, LDP, w, lane);) }
            if (tt0 < 8) { const size_t r0 = (size_t)(s0 - 512 + 64 * (tt0 + 1)) * LDP; tile_dma<true>(RG + RB, kw0 + r0, vw0 + r0, LDP, w, lane); W7DUP(tile_dma<true>(RG + RB, kw0 + r0, vw0 + r0, LDP, w, lane);) }
            for (int tt = tt0, rb = 0; tt <= 8; ++tt) {
                if (tt < 8) { W7WAIT(); } else NSA_WAITV(0);
                NSA_BAR();
                if (tt + 2 <= 8) { const int nb2 = (rb + 2 >= NRING) ? rb + 2 - NRING : rb + 2; const size_t r0 = (size_t)(s0 - 512 + 64 * (tt + 2)) * LDP; tile_dma<true>(RG + nb2 * RB, kw0 + r0, vw0 + r0, LDP, w, lane); W7DUP(tile_dma<true>(RG + nb2 * RB, kw0 + r0, vw0 + r0, LDP, w, lane);) }
                { const int lo2[2] = {(tt == 0) ? ql[0] + 1 : 0, (tt == 0) ? ql[1] + 1 : 0}, hi2[2] = {(tt == 8) ? ql[0] : 63, (tt == 8) ? ql[1] : 63};
                  attn_tile<1, 3>(RG + rb * RB + klane, RG + rb * RB + vlane, Qf, O, mrow, lrow, lo2, hi2, (tt == 0) || (tt == 8), c2, invl, imp, ql, 0, cin, lane);
#if NSA_REP_PART == 5
                  { const int him[2] = {-1, -1}; attn_tile<1, 3>(RG + rb * RB + klane, RG + rb * RB + vlane, Qf, O, mrow, lrow, lo2, him, true, c2, invl, imp, ql, 0, cin, lane); }
#endif
#if NSA_REP_PART == 6
                  NSA_BAR(); NSA_BAR(); NSA_BAR(); NSA_BAR();
#endif
                }
                rb = (rb + 1 == NRING) ? 0 : rb + 1;
            }
            VM_WAIT();
#pragma unroll
            for (int s = 0; s < 2; ++s) { float lt = lrow[s]; lt += shx(lt, 16, lane); lt += shx(lt, 32, lane);
                const float gate = sigmoidf_(bf2f(proj[(size_t)trow[s] * LDP + C_GN + (4 * g + hd) * 3 + 2]));
                if (rep_ == 0) nsa_emit<false>(O[s], (lt > 0.f) ? gate / lt : 0.f, ya + (size_t)trow[s] * DM + (4 * g + hd) * HD + 4 * qd); }
        }
        __syncthreads();
    }
}

#if defined(CHECK_BUILD) && CHECK_BUILD
DI unsigned hash_u(unsigned x) { x ^= x >> 16; x *= 0x7feb352du; x ^= x >> 15; x *= 0x846ca68bu; x ^= x >> 16; return x; }
DI float blk_sum(float v, LAS float* red, int tid, int nthr) {
    for (int o = 32; o >= 1; o >>= 1) v += __shfl_xor(v, o);
    __syncthreads(); if ((tid & 63) == 0) red[tid >> 6] = v; __syncthreads();
    float s = 0.f; for (int k = 0; k < nthr / 64; ++k) s += red[k]; __syncthreads(); return s;
}
__global__ void chk_proj(Args args) {
    const int lane = threadIdx.x & 63, smp = blockIdx.x * (blockDim.x >> 6) + (threadIdx.x >> 6);
    const bf16* hb = (const bf16*)(args.ws + WS_HB); const bf16* proj = (const bf16*)(args.ws + WS_PROJ); const float* win = (const float*)args.in[4]; const int* pos = (const int*)args.in[2];
    unsigned* res = (unsigned*)(args.ws + WS_CTL) + CW_CHK;
    const unsigned h = hash_u(smp * 2654435761u + 12345u);
    int row = h % M; if (smp < 4) row = (smp == 0) ? 0 : (smp == 1) ? 8191 : (smp == 2) ? 8192 : 16383;
    const int kind = smp % 15; const unsigned h2 = hash_u(h + 77u);
    const int srcb[15] = {0, 2048, 2560, 3072, 3584, 4096, 4608, 5120, 5168, 7216, 9264, 11312, 13360, 16432, 16464};
    const int dstb[15] = {C_Q, C_KC, C_VC, C_KS, C_VS, C_KW, C_VW, C_GN, C_CB, C_CC, C_CU, C_Z, C_XBC, C_DT, C_GM};
    const int wid[15] = {2048, 512, 512, 512, 512, 512, 512, 48, 2048, 2048, 2048, 2048, 3072, 32, 6144};
    const bool rope = (kind == 0 || kind == 1 || kind == 3 || kind == 5);
    int e = h2 % wid[kind]; if (rope) e = (e / 128) * 128 + (e % 64);
    float d0 = 0.f, d1 = 0.f;
    for (int k = lane; k < DM; k += 64) { const float a = bf2f(hb[(size_t)row * DM + k]); d0 += a * win[(size_t)k * PROJ_SRC + srcb[kind] + e]; if (rope) d1 += a * win[(size_t)k * PROJ_SRC + srcb[kind] + e + 64]; }
    for (int o = 32; o >= 1; o >>= 1) { d0 += __shfl_xor(d0, o); d1 += __shfl_xor(d1, o); }
    float e0 = d0, e1 = d1;
    if (rope) { const double inv = exp(-(double)(2 * (e % 64)) / 128.0 * 9.210340371976184); double ang = (double)pos[row] * inv; ang -= 6.283185307179586476925 * __builtin_rint(ang * 0.15915494309189533577); const float c = cosf((float)ang), s = sinf((float)ang); e0 = d0 * c - d1 * s; e1 = d1 * c + d0 * s; }
    if (lane == 0) {
        const float g0 = bf2f(proj[(size_t)row * LDP + dstb[kind] + e]); float err = fabsf(g0 - e0) / (0.03f + 0.02f * fabsf(e0));
        if (rope) { const float g1 = bf2f(proj[(size_t)row * LDP + dstb[kind] + e + 64]); err = fmaxf(err, fabsf(g1 - e1) / (0.03f + 0.02f * fabsf(e1))); }
        if (!(err <= 1.0f)) atomicAdd(res + 0, 1u);
        atomicMax(res + 1, __float_as_uint(fminf(err, 1e6f)));
    }
}
__global__ void chk_cmp(Args args) {
    __shared__ float hid[128];
    const int tid = threadIdx.x, smp = blockIdx.x;
    const unsigned h = hash_u(smp * 40503u + 99u);
    const int kv = smp & 1, b = (smp >> 1) & 1, g = (smp >> 2) & 3; int n = h % NCMP; if (smp < 8) n = (smp < 4) ? 0 : 510;
    const bf16* proj = (const bf16*)(args.ws + WS_PROJ);
    const float* pe = (const float*)args.in[kv ? 6 : 5]; const float* w1 = (const float*)args.in[kv ? 11 : 7]; const float* b1 = (const float*)args.in[kv ? 12 : 8];
    const float* w2 = (const float*)args.in[kv ? 13 : 9]; const float* b2 = (const float*)args.in[kv ? 14 : 10];
    const bf16* out = (const bf16*)(args.ws + (kv ? WS_VCMP : WS_KCMP));
    unsigned* res = (unsigned*)(args.ws + WS_CTL) + CW_CHK;
    float s = b1[tid];
    for (int l = 0; l < 32; ++l) { const bf16* kr = proj + (size_t)(b * SEQ + 16 * n + l) * LDP + (kv ? C_VC : C_KC) + g * HD;
        for (int d = 0; d < 128; ++d) s += (bf2f(kr[d]) + pe[l * 128 + d]) * w1[(size_t)(l * 128 + d) * 128 + tid]; }
    hid[tid] = s / (1.0f + expf(-s));
    __syncthreads();
    float o = b2[tid];
    for (int k = 0; k < 128; ++k) o += hid[k] * w2[k * 128 + tid];
    const float got = bf2f(out[((size_t)(b * NG + g) * NCMP_PAD + n) * HD + tid]);
    const float err = fabsf(got - o) / (0.02f + 0.02f * fabsf(o));
    if (!(err <= 1.0f)) atomicAdd(res + 2, 1u);
    atomicMax(res + 3, __float_as_uint(fminf(err, 1e6f)));
}
constexpr int CHK_NT = 24;
__global__ void __launch_bounds__(256) chk_nsa(Args args) {
    __shared__ float qf[4][128], oacc[4][128], obr[4][128], sc[4][1024], imp[128], red[8];
    __shared__ int kl[1024], seln[16], usedl[128];
    const int tlist[CHK_NT] = {0, 1, 30, 31, 47, 63, 64, 65, 127, 128, 500, 511, 512, 513, 575, 1023, 1024, 1087, 2000, 4095, 4096, 6000, 8128, 8191};
    const int tid = threadIdx.x, smp = blockIdx.x;
    const int t = tlist[smp % CHK_NT], bg = (smp / CHK_NT + smp) & 7, b = bg >> 2, g = bg & 3, row = b * SEQ + t, cur = t >> 6;
    const bf16* proj = (const bf16*)(args.ws + WS_PROJ); const bf16* kcmp = (const bf16*)(args.ws + WS_KCMP) + (size_t)(b * NG + g) * NCMP_PAD * HD; const bf16* vcmp = (const bf16*)(args.ws + WS_VCMP) + (size_t)(b * NG + g) * NCMP_PAD * HD;
    const bf16* ya = (const bf16*)(args.ws + WS_YA);
    unsigned* res = (unsigned*)(args.ws + WS_CTL) + CW_CHK;
    const float scale = 0.08838834764831845f;
    for (int k = tid; k < 512; k += 256) { const int r = k >> 7, d = k & 127; qf[r][d] = bf2f(proj[(size_t)row * LDP + C_Q + (4 * g + r) * HD + d]); oacc[r][d] = 0.f; }
    __syncthreads();
    for (int br = 0; br < 3; ++br) {
        int nk = 0;
        if (br == 0) { nk = (t >= 31) ? ((t - 31) >> 4) + 1 : 0; for (int k = tid; k < nk; k += 256) kl[k] = k; }
        else if (br == 1) {
            if (tid == 0) {
                for (int j = 0; j < 128; ++j) usedl[j] = 0;
                for (int it = 0; it < 16; ++it) { int best = -1; float bv = 0.f;
                    for (int j = 0; j < 128; ++j) { if (usedl[j]) continue; const bool valid = (64 * j <= t); const bool forced = (j == 0) || (j == cur) || (j == cur - 1);
                        const float v = valid ? imp[j] + (forced ? 1.0e4f : 0.f) : -__builtin_inff();
                        if (best < 0 || v > bv) { best = j; bv = v; } }
                    usedl[best] = 1; seln[it] = best; } }
            __syncthreads();
            for (int k = tid; k < 1024; k += 256) kl[k] = seln[k >> 6] * 64 + (k & 63);
            nk = 1024;
        } else { nk = 576; for (int k = tid; k < 576; k += 256) kl[k] = (t & ~63) - WIN + k; }
        __syncthreads();
        for (int idx = tid; idx < 4 * nk; idx += 256) { const int r = idx / nk, k = idx - r * nk, key = kl[k];
            bool ok; const bf16* kp;
            if (br == 0) { ok = true; kp = kcmp + (size_t)key * HD; }
            else if (br == 1) { ok = (key <= t); kp = proj + (size_t)(b * SEQ + key) * LDP + C_KS + g * HD; }
            else { ok = (key >= 0) && (key <= t) && (key > t - WIN); kp = proj + (size_t)(b * SEQ + (key < 0 ? 0 : key)) * LDP + C_KW + g * HD; }
            float s = 0.f; for (int d = 0; d < 128; ++d) s += qf[r][d] * bf2f(kp[d]);
            sc[r][k] = ok ? s * scale : -__builtin_inff(); }
        __syncthreads();
        if (tid < 4) { float m = -__builtin_inff(); for (int k = 0; k < nk; ++k) m = fmaxf(m, sc[tid][k]);
            const float mm = (m > -1e30f) ? m : 0.f; float l = 0.f; for (int k = 0; k < nk; ++k) { const float e = (sc[tid][k] > -1e30f) ? expf(sc[tid][k] - mm) : 0.f; sc[tid][k] = e; l += e; }
            const float il = (l > 0.f) ? 1.0f / l : 0.f; for (int k = 0; k < nk; ++k) sc[tid][k] *= il; }
        __syncthreads();
        if (br == 0) { if (tid < 128) { float s = 0.f; for (int r = 0; r < 4; ++r) for (int n = 4 * tid - 1; n <= 4 * tid + 3; ++n) if (n >= 0 && n < nk) s += sc[r][n]; imp[tid] = s; } }
        for (int o = tid; o < 512; o += 256) { const int r = o >> 7, d = o & 127; float s = 0.f;
            for (int k = 0; k < nk; ++k) { const float p = sc[r][k]; if (p == 0.f) continue; const int key = kl[k];
                const bf16* vp = (br == 0) ? vcmp + (size_t)key * HD : proj + (size_t)(b * SEQ + key) * LDP + (br == 1 ? C_VS : C_VW) + g * HD;
                s += p * bf2f(vp[d]); }
            const float gate = 1.0f / (1.0f + expf(-bf2f(proj[(size_t)row * LDP + C_GN + (4 * g + r) * 3 + br])));
            oacc[r][d] += gate * s; obr[r][d] = s; }
        __syncthreads();
    }
    float errm = 0.f;
    for (int o = tid; o < 512; o += 256) { const int r = o >> 7, d = o & 127; const float got = bf2f(ya[(size_t)row * DM + (4 * g + r) * HD + d]), ex = oacc[r][d] * (CHECK_BUILD == 2 ? ((smp & 1) ? 1.5f : 1.0f) : 1.0f);
        errm = fmaxf(errm, fabsf(got - ex) / (0.006f + 0.03f * fabsf(ex))); }
    for (int o = 32; o >= 1; o >>= 1) errm = fmaxf(errm, __shfl_xor(errm, o));
    if ((tid & 63) == 0) red[tid >> 6] = errm;
    __syncthreads();
    if (tid == 0) { const float e = fmaxf(fmaxf(red[0], red[1]), fmaxf(red[2], red[3])); if (!(e <= 1.0f)) atomicAdd(res + 4, 1u); atomicMax(res + 5, __float_as_uint(fminf(e, 1e6f))); }
}
#ifndef CHK_B_SEL
#define CHK_B_SEL 5
#endif
__global__ void chk_report(Args args) {
    const unsigned* res = (const unsigned*)(args.ws + WS_CTL) + CW_CHK;
    const float A = 4.0f * (float)res[4] + (res[2] ? 2000.f : 0.f) + (res[0] ? 40000.f : 0.f);
    const float B = fminf(__uint_as_float(res[CHK_B_SEL]), 100.f);
    const size_t i = (size_t)blockIdx.x * blockDim.x + threadIdx.x;
    if (A > 0.f) { if (i == 0) args.out[0] += A; if (i >= 1 && i <= (1u << 20)) args.out[i] += B; }
}
#endif

constexpr int NPH_LAYER = 13, NPH = 2 + NPH_LAYER * DEPTH;
#ifndef PG8_SP2
#define PG8_SP2 true
#endif
#ifndef PG8_ALIGN
#define PG8_ALIGN true
#endif
#ifndef PH_MASK
#define PH_MASK 0xFFFFFFFFu
#endif
#ifndef REP_MASK
#define REP_MASK 0u
#endif
#ifndef REP_CNT
#define REP_CNT 2
#endif
#define REPN(kk) ((((unsigned)REP_MASK >> (kk)) & 1u) ? REP_CNT : 1)
#define INK(k, kk) (((PH_MASK >> (kk)) & 1u) && lo <= (k) && (k) < hi)
#if defined(TIME_PROBE)
#define STAMP(i) do { if (F.bid == 0 && F.tid == 0) ((unsigned long long*)(F.ctl + CW_TS))[i] = __builtin_amdgcn_s_memrealtime(); } while (0)
#else
#define STAMP(i) do { } while (0)
#endif
#define SEAM(k) do { if (lo <= (k) && (k) + 1 < hi) { XcdBarrier b_ = bar; { unsigned long long p_ = (unsigned long long)bar.bar; asm volatile("" : "+s"(p_)); b_.bar = (unsigned*)p_; } xcd_barrier(b_); } STAMP((k) + 1); } while (0)
template <int LAYER> DI void g1_block(const Frame& F, const Args& args) {
    constexpr int layer = LAYER;
    bf16* hb = (bf16*)(F.ws + WS_HB); bf16* projb = (bf16*)(F.ws + WS_PROJ); bf16* eb = (bf16*)(F.ws + WS_EB);
#ifndef NO_G1
            { const Frame Fp = phase_frame(F);  pg8::Gemm g{hb, (const bf16*)lw_ptr(Fp, layer, LW_IN), M, LDP, DM}; pg8::StaticOrder S; S.init(M, LDP, Fp.G, Fp.bid);
              pg8::EpiB<2> E{projb, LDP, (const float*)(Fp.ws + WS_ROPE)};
              pg8::gemm_phase<pg8::EpiB<2>, pg8::StaticOrder, PG8_ALIGN, PG8_SP2>(Fp.lds, g, S, E, Fp.wave); }
#endif
#ifndef NO_G5
            { const Frame Fp = phase_frame(F);  pg8::Gemm g{(const bf16*)(Fp.ws + WS_PB) + (size_t)layer * M * PLE, (const bf16*)lw_ptr(Fp, layer, LW_PLE), M, DM, PLE}; pg8::StaticOrder S; S.init(M, DM, Fp.G, Fp.bid);
              pg8::EpiB<0> E{eb, DM, nullptr};
              pg8::gemm_phase<pg8::EpiB<0>, pg8::StaticOrder, PG8_ALIGN, PG8_SP2>(Fp.lds, g, S, E, Fp.wave); }
#endif
}
template <int LAYER> DI void layer_phases(const Frame& F, const Args& args, const XcdBarrier& bar, const int lo, const int hi) {
    constexpr int layer = LAYER, layer_ = LAYER;
    float* xres = (float*)(F.ws + WS_X); bf16* hb = (bf16*)(F.ws + WS_HB); bf16* projb = (bf16*)(F.ws + WS_PROJ); bf16* ub = (bf16*)(F.ws + WS_U); bf16* eb = (bf16*)(F.ws + WS_EB);
        const int pb = 1 + NPH_LAYER * layer;
        const float* xin = (layer == 0) ? (const float*)argin(args, 0) : (const float*)xres;
        if (INK(pb + 0, 0)) for (int rep = 0; rep < REPN(0); ++rep) norm_rows<false>(F, xin, (const float*)argin(args, 3) + (size_t)layer * DM, hb);
        SEAM(pb + 0);
        if (INK(pb + 1, 1)) { g1_block<LAYER>(F, args); if (REPN(1) >= 2) g1_block<LAYER>(F, args); }
        SEAM(pb + 1);
        if (INK(pb + 2, 2)) for (int rep = 0; rep < REPN(2); ++rep) { ssd_conv_pass(F, args, layer); compress_phase(F, args, layer); }
        SEAM(pb + 2);
        if (INK(pb + 3, 3)) for (int rep = 0; rep < REPN(3); ++rep) ssd_states_phase(F, args, layer);
        SEAM(pb + 3);
        if (INK(pb + 4, 4)) ssd_scan_phase(F);
        SEAM(pb + 4);
        if (INK(pb + 5, 5)) {
#ifndef NO_S3
            for (int rep = 0; rep < REPN(15); ++rep) ssd_out_phase(F, args, layer);
#endif
            STAMP(60 + layer);
#ifndef NO_NSA
            for (int rep = 0; rep < REPN(5); ++rep) nsa_phase(F, args, layer);
#endif
        }
        SEAM(pb + 5);
        if (INK(pb + 6, 6)) for (int rep = 0; rep < REPN(6); ++rep) merge_pass(F, args, layer);
        SEAM(pb + 6);
        if (INK(pb + 7, 7)) for (int rep = 0; rep < REPN(7); ++rep) { const Frame Fp = phase_frame(F);  pg8::Gemm g{hb, (const bf16*)lw_ptr(Fp, layer, LW_O), M, DM, DM}; pg8::StaticOrder S; S.init(M, DM, Fp.G, Fp.bid);
            pg8::EpiRes<false> E{xin, rep ? (float*)(Fp.ws + WS_ST) : xres, DM, nullptr};
            pg8::gemm_phase<pg8::EpiRes<false>, pg8::StaticOrder, PG8_ALIGN, PG8_SP2>(Fp.lds, g, S, E, Fp.wave); }
        SEAM(pb + 7);
        if (INK(pb + 8, 8)) for (int rep = 0; rep < REPN(8); ++rep) norm_rows<false>(F, xres, (const float*)argin(args, 23) + (size_t)layer * DM, hb);
        SEAM(pb + 8);
        if (INK(pb + 9, 9)) for (int rep = 0; rep < REPN(9); ++rep) { const Frame Fp = phase_frame(F);  pg8::Gemm g{hb, (const bf16*)lw_ptr(Fp, layer, LW_UP), M, DFF, DM}; pg8::StaticOrder S; S.init(M, DFF, Fp.G, Fp.bid);
            pg8::EpiB<1> E{ub, DFF, nullptr};
            pg8::gemm_phase<pg8::EpiB<1>, pg8::StaticOrder, PG8_ALIGN, PG8_SP2>(Fp.lds, g, S, E, Fp.wave); }
        SEAM(pb + 9);
        if (INK(pb + 10, 10)) for (int rep = 0; rep < REPN(10); ++rep) { const Frame Fp = phase_frame(F);  pg8::Gemm g{ub, (const bf16*)lw_ptr(Fp, layer, LW_DOWN), M, DM, DFF}; pg8::StaticOrder S; S.init(M, DM, Fp.G, Fp.bid);
            pg8::EpiRes<false> E{xres, rep ? (float*)(Fp.ws + WS_ST) : xres, DM, nullptr};
            pg8::gemm_phase<pg8::EpiRes<false>, pg8::StaticOrder, PG8_ALIGN, PG8_SP2>(Fp.lds, g, S, E, Fp.wave); }
        SEAM(pb + 10);
        if (INK(pb + 11, 11)) for (int rep = 0; rep < REPN(11); ++rep) norm_rows<false>(F, xres, (const float*)argin(args, 26) + (size_t)layer * DM, hb);
        SEAM(pb + 11);
        if (INK(pb + 12, 12)) for (int rep = 0; rep < REPN(12); ++rep) { const Frame Fp = phase_frame(F);  pg8::Gemm g{hb, (const bf16*)lw_ptr(Fp, layer, LW_PG), M, DM, DM}; pg8::StaticOrder S; S.init(M, DM, Fp.G, Fp.bid);
            pg8::EpiRes<true> E{xres, rep ? (float*)(Fp.ws + WS_ST) : xres, DM, eb};
            pg8::gemm_phase<pg8::EpiRes<true>, pg8::StaticOrder, PG8_ALIGN, PG8_SP2>(Fp.lds, g, S, E, Fp.wave); }
        SEAM(pb + 12);
}
__global__ void __launch_bounds__(NTHR, 2) hyb_fwd(Args args) {
    extern __shared__ __attribute__((aligned(16))) unsigned char lds_raw[];
    Frame F;
    F.lds = (LAS unsigned char*)lds_raw; F.ws = args.ws; F.ctl = (gu32*)(args.ws + WS_CTL);
    F.tid = threadIdx.x; F.lane = F.tid & 63; F.wave = __builtin_amdgcn_readfirstlane(threadIdx.x >> 6); F.G = gridDim.x; F.bid = blockIdx.x;
    const int lo = args.ph_lo, hi = args.ph_hi;
    if (F.tid < 64) ((LAS unsigned*)(F.lds + LDSCTL_OFF))[F.tid] = 0u;
    __syncthreads();
    XcdBarrier bar; bar.bar = (unsigned*)(F.ctl + CW_BAR); bar.x = 0; bar.st = (volatile LAS unsigned*)(F.lds + LDSCTL_OFF);
    if (hi - lo > 1) bar = xcd_barrier_post((unsigned*)(F.ctl + CW_BAR), (volatile LAS unsigned*)(F.lds + LDSCTL_OFF));
    STAMP(0);
    if (INK(0, 13)) for (int rep = 0; rep < REPN(13); ++rep) p0_prologue(F, args);
    SEAM(0);
    layer_phases<0>(F, args, bar, lo, hi); layer_phases<1>(F, args, bar, lo, hi); layer_phases<2>(F, args, bar, lo, hi); layer_phases<3>(F, args, bar, lo, hi);
    float* xres = (float*)(F.ws + WS_X);
    int hi_l = hi; asm volatile("" : "+s"(hi_l));
    if (((PH_MASK >> 14) & 1u) && lo <= NPH - 1 && NPH - 1 < hi_l) for (int rep = 0; rep < REPN(14); ++rep) norm_rows<true>(F, xres, (const float*)argin(args, 29), args.out);
#if defined(TIME_PROBE)
    { XcdBarrier b_ = bar; xcd_barrier(b_); STAMP(NPH);
      if (F.bid == 0) {
        LAS float* ab = (LAS float*)(F.lds);
        if (F.tid == 0) { const unsigned long long* ts = (const unsigned long long*)(F.ctl + CW_TS); float sum[17];
            float sA = 0.f, sB = 0.f;
            for (int ph = 0; ph < NPH; ++ph) { int kind = (ph == 0) ? 13 : (ph == NPH - 1) ? 14 : (ph - 1) % NPH_LAYER; float d = (float)(ts[ph + 1] - ts[ph]) * 0.01f;
                if (kind == 5) { const int L = (ph - 1) / NPH_LAYER; const float d3 = (float)(ts[60 + L] - ts[ph]) * 0.01f; if (TIME_PROBE_A == 15) sA += d3; if (TIME_PROBE_B == 15) sB += d3; d -= d3; }
                if (kind == TIME_PROBE_A || (TIME_PROBE_A == 16 && (kind == 0 || kind == 8 || kind == 11))) sA += d;
                if (kind == TIME_PROBE_B || (TIME_PROBE_B == 16 && (kind == 0 || kind == 8 || kind == 11))) sB += d; }
            ab[0] = sA; ab[1] = sB * 0.01f; (void)sum; }
        __syncthreads();
        const float A = ab[0], B = ab[1];
        if (F.tid == 0) args.out[0] += A;
        for (int j = 0; j < 2048; ++j) args.out[1 + F.tid + NTHR * j] += B;
      } }
#endif
#undef INK
#undef SEAM
}

#ifndef MK_ONE_LAUNCH
#define MK_ONE_LAUNCH 1
#endif
extern "C" void kernel_launch(void* const* d_in, const int* in_sizes, int n_in, void* d_out, int out_size, void* d_ws, size_t ws_size, hipStream_t stream) {
    static int grid = 0;
    if (grid == 0) {
        if (n_in != 30 || out_size != M * DM || ws_size < WS_END) { fprintf(stderr, "kernel_launch: unexpected shapes (n_in %d out %d ws %zu need %zu)\n", n_in, out_size, ws_size, (size_t)WS_END); grid = -1; return; }
        int dev = 0, cus = 0, per_cu = 0;
        if (hipGetDevice(&dev) != hipSuccess || hipDeviceGetAttribute(&cus, hipDeviceAttributeMultiprocessorCount, dev) != hipSuccess) { grid = -1; return; }
        if (hipFuncSetAttribute((const void*)hyb_fwd, hipFuncAttributeMaxDynamicSharedMemorySize, LDS_BYTES) != hipSuccess) { fprintf(stderr, "kernel_launch: hipFuncSetAttribute failed\n"); grid = -1; return; }
        if (hipOccupancyMaxActiveBlocksPerMultiprocessor(&per_cu, (const void*)hyb_fwd, NTHR, LDS_BYTES) != hipSuccess || per_cu < 1) { fprintf(stderr, "kernel_launch: occupancy query says %d\n", per_cu); }
        (void)hipGetLastError();
        grid = cus;
    }
    if (grid < 0) return;
    (void)hipMemsetAsync((char*)d_ws + WS_CTL, 0, CTL_ZERO_BYTES, stream);
    Args a{};
    for (int i = 0; i < 30; ++i) a.in[i] = d_in[i];
    a.out = (float*)d_out; a.ws = (unsigned char*)d_ws;
#if MK_ONE_LAUNCH
    a.ph_lo = 0; a.ph_hi = NPH;
    hipLaunchKernelGGL(hyb_fwd, dim3(grid), dim3(NTHR), LDS_BYTES, stream, a);
#else
    for (int ph = 0; ph < NPH; ++ph) { a.ph_lo = ph; a.ph_hi = ph + 1; hipLaunchKernelGGL(hyb_fwd, dim3(grid), dim3(NTHR), LDS_BYTES, stream, a);
#if defined(CHECK_BUILD) && CHECK_BUILD
        if (ph == 2) hipLaunchKernelGGL(chk_proj, dim3(1024), dim3(256), 0, stream, a);
        if (ph == 3) hipLaunchKernelGGL(chk_cmp, dim3(128), dim3(128), 0, stream, a);
        if (ph == 6) hipLaunchKernelGGL(chk_nsa, dim3(8 * CHK_NT), dim3(256), 0, stream, a);
        if (ph == NPH - 1) hipLaunchKernelGGL(chk_report, dim3(4098), dim3(256), 0, stream, a);
#endif
    }
#endif
    (void)in_sizes;
}
```

```cpp
#include <hip/hip_runtime.h>
#include <cstdio>
#include <cstdint>
namespace pg8 {
#define PG8_LAS __attribute__((address_space(3)))
typedef unsigned short bf16_t;
typedef short bf16x8 __attribute__((ext_vector_type(8)));
typedef float f32x4 __attribute__((ext_vector_type(4)));
typedef unsigned u32x4 __attribute__((ext_vector_type(4)));
constexpr int BM = 256, BK = 64, HALF = 128, HTB = HALF * BK * 2  , STAGE_BYTES = 8 * HTB, NXCD = 8, WGM = 8;

__host__ __device__ __forceinline__ int lds_byte(int r, int c) { const int st = (r >> 4) * 2 + (c >> 5), rr = r & 15, cc = c & 31, ob = rr * 64 + cc * 2; return st * 1024 + (ob ^ (((ob >> 9) & 1) << 5)); }
__host__ __device__ __forceinline__ void stage_rc(int b, int& R, int& C) { const int st = b / 1024, sb = b % 1024, swz = sb ^ (((sb >> 9) & 1) << 5); R = (st >> 1) * 16 + swz / 64; C = (st & 1) * 32 + (swz % 64) / 2; }
__host__ __device__ __forceinline__ int perm32(int rho) { const int n = rho >> 4, i = rho & 15; return 8 * (i >> 2) + 4 * n + (i & 3); }

struct Unit { int pm, pn; };
struct Gemm { const bf16_t* A; const bf16_t* Bt; int M, N, K; };

struct StaticOrder {
    int nM, nN, nwg, G, c;
    __host__ __device__ void init(int M, int N, int G_, int c_) { nM = M / BM; nN = N / BM; nwg = nM * nN; G = G_; c = c_; }
    __host__ __device__ bool next(int i, Unit& u) const {
        const long L = (long)i * G + c; if (L >= nwg) return false;
        int wgid = (int)L; { const int q = nwg / NXCD, r = nwg % NXCD, xcd = wgid % NXCD, off = wgid / NXCD; wgid = (xcd < r ? xcd * (q + 1) : r * (q + 1) + (xcd - r) * q) + off; }
        const int nig = WGM * nN, gid = wgid / nig, fm = gid * WGM, gsz = (nM - fm) < WGM ? (nM - fm) : WGM;
        u.pm = fm + ((wgid % nig) % gsz); u.pn = (wgid % nig) / gsz; return true;
    }
    __device__ __forceinline__ void a_ready(const Unit&) const {}
    __device__ __forceinline__ void done(const Unit&) const {}
};
__device__ __forceinline__ unsigned cvt_pk_bf16(float lo, float hi) { unsigned r; asm volatile("v_cvt_pk_bf16_f32 %0, %1, %2" : "=v"(r) : "v"(lo), "v"(hi)); return r; }
template <class Epi, class Sched, bool ALIGN_EPI = false, bool SP2 = false>
__device__ __forceinline__ void gemm_phase(PG8_LAS unsigned char* lds, const Gemm g, const Sched& S, const Epi& E, const int wave_idx  ) {
    int lane_l; asm volatile("v_mbcnt_lo_u32_b32 %0, -1, 0\n\tv_mbcnt_hi_u32_b32 %0, -1, %0" : "=v"(lane_l));
    const int wid = wave_idx, tid = wid * 64 + lane_l, lane = tid & 63, wr = wid >> 2, wc = wid & 3, fr = lane & 15, fq = lane >> 4;
    const int K = g.K, nt = K / BK;
    unsigned voffA[2], voffB[2];
#pragma unroll
    for (int i = 0; i < 2; ++i) { int R, C; stage_rc(tid * 16 + i * 8192, R, C); const int Rb = Epi::PERM ? ((R & ~31) + perm32(R & 31)) : R;
        voffA[i] = (unsigned)(R * K + C) * 2u; voffB[i] = (unsigned)(Rb * K + C) * 2u; }
    const size_t kstep = (size_t)(BK * 2);
    const size_t hstep = (size_t)HALF * K * 2;
    const size_t tstep = 2 * hstep;
    const unsigned ldsw = (unsigned)wid * 1024u;
    const int aoff = lds_byte(wr * 64 + fr, fq * 8), boff = lds_byte(wc * 32 + fr, fq * 8);
#define PG8_SA(b, h) (((b) * 2 + (h)) * HTB)
#define PG8_SB(b, h) ((4 + (b) * 2 + (h)) * HTB)
#define PG8_STAGE(bufoff, gbase, voff) do { _Pragma("unroll") for (int _i = 0; _i < 2; ++_i) \
        __builtin_amdgcn_global_load_lds((const unsigned*)((const char*)(gbase) + (voff)[_i]), (PG8_LAS unsigned*)(lds + (bufoff) + ldsw + _i * 8192), 16, 0, 0); } while (0)
#define PG8_LDA(dst, b, h) do { _Pragma("unroll") for (int m = 0; m < 4; ++m) _Pragma("unroll") for (int k = 0; k < 2; ++k) dst[m][k] = *(const PG8_LAS bf16x8*)(lds + PG8_SA(b, h) + aoff + m * 2048 + k * 1024); } while (0)
#define PG8_LDB(dst, b, h) do { _Pragma("unroll") for (int n = 0; n < 2; ++n) _Pragma("unroll") for (int k = 0; k < 2; ++k) dst[n][k] = *(const PG8_LAS bf16x8*)(lds + PG8_SB(b, h) + boff + n * 2048 + k * 1024); } while (0)
#define PG8_MMA(ai, bj, At, Bt) do { __builtin_amdgcn_s_setprio(1); _Pragma("unroll") for (int m = 0; m < 4; ++m) _Pragma("unroll") for (int n = 0; n < 2; ++n) _Pragma("unroll") for (int k = 0; k < 2; ++k) \
        acc[ai][bj][m][n] = __builtin_amdgcn_mfma_f32_16x16x32_bf16(Bt[n][k], At[m][k], acc[ai][bj][m][n], 0, 0, 0); __builtin_amdgcn_s_setprio(0); } while (0)
#define PG8_WAIT_V(n) asm volatile("s_waitcnt vmcnt(" #n ")" ::: "memory")
#define PG8_WAIT_L(n) asm volatile("s_waitcnt lgkmcnt(" #n ")" ::: "memory")
#define PG8_BAR __builtin_amdgcn_s_barrier()
#define PG8_SCHED __builtin_amdgcn_sched_barrier(0)
    Unit cur, nxt; int ui = 0;
    if (!S.next(0, cur)) return;
    f32x4 acc[2][2][4][2];
#pragma unroll
    for (int a = 0; a < 2; ++a)
#pragma unroll
        for (int b = 0; b < 2; ++b)
#pragma unroll
            for (int m = 0; m < 4; ++m)
#pragma unroll
                for (int n = 0; n < 2; ++n) acc[a][b][m][n] = (f32x4){0.f, 0.f, 0.f, 0.f};
    bf16x8 At[4][2], B0[2][2], B1[2][2];
    const char* cA = (const char*)g.A + (size_t)cur.pm * tstep; const char* cB = (const char*)g.Bt + (size_t)cur.pn * tstep;
    S.a_ready(cur);
    if constexpr (SP2) {
        PG8_STAGE(PG8_SB(0, 0), cB, voffB); PG8_STAGE(PG8_SB(0, 1), cB + hstep, voffB); PG8_STAGE(PG8_SA(0, 0), cA, voffA); PG8_STAGE(PG8_SA(0, 1), cA + hstep, voffA);
        if (wr == 1) PG8_BAR;
        PG8_WAIT_V(2); PG8_BAR;
        PG8_STAGE(PG8_SB(1, 0), cB + kstep, voffB); PG8_STAGE(PG8_SA(1, 0), cA + kstep, voffA); PG8_STAGE(PG8_SB(1, 1), cB + hstep + kstep, voffB);
        PG8_WAIT_V(6); PG8_BAR;
    } else {
        PG8_STAGE(PG8_SB(0, 0), cB, voffB); PG8_STAGE(PG8_SA(0, 0), cA, voffA); PG8_STAGE(PG8_SB(0, 1), cB + hstep, voffB); PG8_STAGE(PG8_SA(0, 1), cA + hstep, voffA);
        if (wr == 1) PG8_BAR;
        PG8_WAIT_V(4); PG8_BAR;
        PG8_STAGE(PG8_SB(1, 0), cB + kstep, voffB); PG8_STAGE(PG8_SA(1, 0), cA + kstep, voffA); PG8_STAGE(PG8_SB(1, 1), cB + hstep + kstep, voffB);
        PG8_WAIT_V(6); PG8_BAR;
    }
    for (;;) {
        const bool has_next = S.next(ui + 1, nxt);
        const char* nA = has_next ? (const char*)g.A + (size_t)nxt.pm * tstep : cA; const char* nB = has_next ? (const char*)g.Bt + (size_t)nxt.pn * tstep : cB;
        for (int t = 0; t < nt; t += 2) {
            const bool last = (t == nt - 2);
            const char* a1 = cA + (size_t)(t + 1) * kstep;
            const char* a2 = last ? nA : cA + (size_t)(t + 2) * kstep; const char* b2 = last ? nB : cB + (size_t)(t + 2) * kstep;
            const char* a3 = a2 + kstep; const char* b3 = b2 + kstep;
            if (last && has_next) S.a_ready(nxt);
            if constexpr (SP2) {
            PG8_LDB(B0, 0, 0); PG8_LDB(B1, 0, 1); PG8_SCHED; PG8_LDA(At, 0, 0); PG8_STAGE(PG8_SA(1, 1), a1 + hstep, voffA);
            PG8_WAIT_V(8); PG8_WAIT_L(0); PG8_BAR; PG8_MMA(0, 0, At, B0); PG8_MMA(0, 1, At, B1); PG8_BAR; PG8_SCHED;
            PG8_LDA(At, 0, 1); PG8_STAGE(PG8_SB(0, 0), b2, voffB); PG8_STAGE(PG8_SB(0, 1), b2 + hstep, voffB); PG8_STAGE(PG8_SA(0, 0), a2, voffA);
            PG8_WAIT_V(8); PG8_WAIT_L(0); PG8_BAR; PG8_MMA(1, 0, At, B0); PG8_MMA(1, 1, At, B1); PG8_BAR; PG8_SCHED;
            PG8_LDB(B0, 1, 0); PG8_LDB(B1, 1, 1); PG8_SCHED; PG8_LDA(At, 1, 0); PG8_STAGE(PG8_SA(0, 1), a2 + hstep, voffA);
            PG8_WAIT_V(8); PG8_WAIT_L(0); PG8_BAR; PG8_MMA(0, 0, At, B0); PG8_MMA(0, 1, At, B1); PG8_BAR; PG8_SCHED;
            PG8_LDA(At, 1, 1); PG8_STAGE(PG8_SB(1, 0), b3, voffB); PG8_STAGE(PG8_SB(1, 1), b3 + hstep, voffB); PG8_STAGE(PG8_SA(1, 0), a3, voffA);
            PG8_WAIT_V(8); PG8_WAIT_L(0); PG8_BAR; PG8_MMA(1, 0, At, B0); PG8_MMA(1, 1, At, B1); PG8_BAR; PG8_SCHED;
            } else {
            PG8_LDB(B0, 0, 0); PG8_SCHED; PG8_LDA(At, 0, 0); PG8_STAGE(PG8_SA(1, 1), a1 + hstep, voffA);
            PG8_WAIT_L(8); PG8_BAR; PG8_WAIT_L(0); PG8_MMA(0, 0, At, B0); PG8_BAR; PG8_SCHED;
            PG8_LDB(B1, 0, 1); PG8_STAGE(PG8_SB(0, 0), b2, voffB);
            PG8_BAR; PG8_WAIT_L(0); PG8_MMA(0, 1, At, B1); PG8_BAR;
            PG8_LDA(At, 0, 1); PG8_STAGE(PG8_SA(0, 0), a2, voffA);
            PG8_BAR; PG8_WAIT_L(0); PG8_MMA(1, 0, At, B0); PG8_BAR; PG8_SCHED;
            PG8_STAGE(PG8_SB(0, 1), b2 + hstep, voffB);
            PG8_WAIT_V(6); PG8_BAR; PG8_MMA(1, 1, At, B1); PG8_BAR;
            PG8_LDB(B0, 1, 0); PG8_SCHED; PG8_LDA(At, 1, 0); PG8_STAGE(PG8_SA(0, 1), a2 + hstep, voffA);
            PG8_WAIT_L(8); PG8_BAR; PG8_WAIT_L(0); PG8_MMA(0, 0, At, B0); PG8_BAR; PG8_SCHED;
            PG8_LDB(B1, 1, 1); PG8_STAGE(PG8_SB(1, 0), b3, voffB);
            PG8_BAR; PG8_WAIT_L(0); PG8_MMA(0, 1, At, B1); PG8_BAR;
            PG8_LDA(At, 1, 1); PG8_STAGE(PG8_SA(1, 0), a3, voffA);
            PG8_BAR; PG8_WAIT_L(0); PG8_MMA(1, 0, At, B0); PG8_BAR; PG8_SCHED;
            PG8_STAGE(PG8_SB(1, 1), b3 + hstep, voffB);
            PG8_WAIT_V(6); PG8_BAR; PG8_MMA(1, 1, At, B1); PG8_BAR;
            }
        }
        if constexpr (ALIGN_EPI) { if (wr == 0) PG8_BAR; }
        if constexpr (!Epi::AFTER_DRAIN) { E(acc, cur, wr, wc, fr, fq);
#if defined(EPI_TWICE)
            if constexpr (Epi::PERM) E(acc, cur, wr, wc, fr, fq);
#endif
            S.done(cur); }
        if (!has_next) break;
#pragma unroll
        for (int a = 0; a < 2; ++a)
#pragma unroll
            for (int b = 0; b < 2; ++b)
#pragma unroll
                for (int m = 0; m < 4; ++m)
#pragma unroll
                    for (int n = 0; n < 2; ++n) acc[a][b][m][n] = (f32x4){0.f, 0.f, 0.f, 0.f};
        cur = nxt; cA = nA; cB = nB; ++ui;
        if constexpr (ALIGN_EPI) { if (wr == 1) PG8_BAR; }
    }
    PG8_WAIT_V(0);
    if constexpr (!ALIGN_EPI) { if (wr == 0) PG8_BAR; }
    PG8_BAR;
    if constexpr (Epi::AFTER_DRAIN) { E.fused(acc, cur, wr, wc, fr, fq, lds, wid, lane); S.done(cur); }
#undef PG8_SA
#undef PG8_SB
#undef PG8_STAGE
#undef PG8_LDA
#undef PG8_LDB
#undef PG8_MMA
#undef PG8_WAIT_V
#undef PG8_WAIT_L
#undef PG8_BAR
#undef PG8_SCHED
}
}

constexpr int BATCH = 2, SEQ = 8192, DM = 2048, DEPTH = 4;
constexpr int M = BATCH * SEQ;
constexpr int NH = 16, HD = 128, NG = 4, RH = 4;
constexpr int NCMP = 511, NCMP_PAD = 512, NSLC = 128, NSEL = 16, WIN = 512;
constexpr int SSD_H = 32, SSD_P = 64, SSD_N = 128, SSD_G = 4, SSD_CH = 128, SSD_NC = 64, SSD_XBC = 3072;
constexpr int DFF = 8192, PLE = 256;
constexpr float EPS = 1e-6f;
constexpr int PROJ_SRC = 22608;
constexpr int C_Q = 0, C_KC = 2048, C_VC = 2560, C_KS = 3072, C_VS = 3584, C_KW = 4096, C_VW = 4608;
constexpr int C_CB = 5120, C_CC = 7168, C_CU = 9216, C_Z = 11264, C_XBC = 13312, C_GM = 16384, C_GN = 22528, C_DT = 22592;
constexpr int LDP = 22784;
constexpr int S_GN = 5120, S_DT = 16432;

constexpr size_t MiB = 1u << 20;
constexpr size_t WS_CTL = 0, CTL_ZERO_BYTES = 1 * MiB;
constexpr size_t WS_ROPE = 1 * MiB;
constexpr size_t WS_MISC = 9 * MiB;
constexpr size_t WS_DT = 10 * MiB;
constexpr size_t WS_ACS = 12 * MiB;
constexpr size_t WS_CDEC = 14 * MiB;
constexpr size_t WS_KCMP = 15 * MiB;
constexpr size_t WS_VCMP = 16 * MiB;
constexpr size_t WS_X = 32 * MiB;
constexpr size_t WS_HB = 160 * MiB;
constexpr size_t WS_PB = 224 * MiB;
constexpr size_t WS_EB = 256 * MiB;
constexpr size_t WS_YA = 320 * MiB;
constexpr size_t WS_YC = 384 * MiB;
constexpr size_t WS_XBC = 448 * MiB;
constexpr size_t WS_ST = 544 * MiB;
constexpr size_t WS_PROJ = 672 * MiB;
constexpr size_t WS_U = WS_PROJ;
constexpr size_t WS_W = 1384 * MiB;
constexpr size_t LW_IN = 0;
constexpr size_t LW_O = 89 * MiB;
constexpr size_t LW_UP = 97 * MiB;
constexpr size_t LW_DOWN = 129 * MiB;
constexpr size_t LW_PG = 161 * MiB;
constexpr size_t LW_PLE = 169 * MiB;
constexpr size_t LW_PK1 = 170 * MiB;
constexpr size_t LW_PV1 = 171 * MiB;
constexpr size_t LW_PK2 = 172 * MiB;
constexpr size_t LW_PV2 = 172 * MiB + 64 * 1024;
constexpr size_t LW_STRIDE = 173 * MiB;
constexpr size_t WS_HIN = WS_W + 4 * LW_STRIDE;
constexpr size_t WS_RSTD = WS_MISC + 512 * 1024;
constexpr size_t WS_END = WS_HIN + 64 * MiB;
static_assert((size_t)M * LDP * 2 <= 712 * MiB && (size_t)LDP * 2048 * 2 <= 89 * MiB, "ws map");

constexpr int CW_BAR = 4096;
constexpr int CW_CHK = 16384;
constexpr int CW_TS = 20480;

constexpr int RING_BYTES = 131072;
constexpr int LX_OFF = RING_BYTES;
constexpr int LX_BYTES = 8192;
constexpr int LDSCTL_OFF = LX_OFF + LX_BYTES;
constexpr int LDS_BYTES = LDSCTL_OFF + 256;
constexpr int NWAVES = 8, NTHR = 512;

#define DI __device__ __forceinline__
#define GAS __attribute__((address_space(1)))
#define LAS __attribute__((address_space(3)))
typedef unsigned short bf16;
typedef unsigned u32x4 __attribute__((ext_vector_type(4)));
typedef unsigned u32x2 __attribute__((ext_vector_type(2)));
typedef float f32x4 __attribute__((ext_vector_type(4)));
typedef float f32x2 __attribute__((ext_vector_type(2)));
typedef short bf16x8 __attribute__((ext_vector_type(8)));
typedef short s16x4 __attribute__((ext_vector_type(4)));
typedef GAS unsigned gu32;
#define RLX_AGENT __ATOMIC_RELAXED, __HIP_MEMORY_SCOPE_AGENT
#define LDS_WAIT() asm volatile("s_waitcnt lgkmcnt(0)" ::: "memory")
#define VM_WAIT() asm volatile("s_waitcnt vmcnt(0)" ::: "memory")
DI unsigned f2bf(float f) { unsigned u = __builtin_bit_cast(unsigned, f); return (u + 0x7fffu + ((u >> 16) & 1u)) >> 16; }
DI unsigned pk2(float lo, float hi) { unsigned r; asm("v_cvt_pk_bf16_f32 %0, %1, %2" : "=v"(r) : "v"(lo), "v"(hi)); return r; }
DI float bf2f(unsigned h) { return __builtin_bit_cast(float, h << 16); }
DI float bflo(unsigned w) { return __builtin_bit_cast(float, w << 16); }
DI float bfhi(unsigned w) { return __builtin_bit_cast(float, w & 0xffff0000u); }
DI float sigmoidf_(float x) { return 1.0f / (1.0f + __expf(-x)); }
DI float siluf_(float x) { return x / (1.0f + __expf(-x)); }
DI float shfl_idx(float v, int src) { return __builtin_bit_cast(float, __builtin_amdgcn_ds_bpermute(src << 2, __builtin_bit_cast(int, v))); }
DI unsigned shfl_idx_u(unsigned v, int src) { return (unsigned)__builtin_amdgcn_ds_bpermute(src << 2, (int)v); }
DI float shx(float v, int m, int lane) { return shfl_idx(v, lane ^ m); }
DI float xq_max(float x) {
    float a = x, b = x;
    asm("s_nop 1\n\tv_permlane32_swap_b32 %0, %1" : "+v"(a), "+v"(b)); x = fmaxf(a, b);
    a = x; b = x;
    asm("s_nop 1\n\tv_permlane16_swap_b32 %0, %1" : "+v"(a), "+v"(b)); return fmaxf(a, b);
}
DI float xq_sum(float x) {
    float a = x, b = x;
    asm("s_nop 1\n\tv_permlane32_swap_b32 %0, %1" : "+v"(a), "+v"(b)); x = a + b;
    a = x; b = x;
    asm("s_nop 1\n\tv_permlane16_swap_b32 %0, %1" : "+v"(a), "+v"(b)); return a + b;
}
DI float quad_sum(float v) {
    v += __builtin_bit_cast(float, __builtin_amdgcn_update_dpp(0, __builtin_bit_cast(int, v), 0xB1, 0xF, 0xF, true));
    v += __builtin_bit_cast(float, __builtin_amdgcn_update_dpp(0, __builtin_bit_cast(int, v), 0x4E, 0xF, 0xF, true));
    return v;
}
DI float wave_sum(float v, int lane) {
#pragma unroll
    for (int o = 1; o < 64; o <<= 1) v += shx(v, o, lane);
    return v;
}
DI unsigned off_b(unsigned row, unsigned ch) { return 256u * row + 16u * (ch ^ (((row & 3u) << 2) | ((row >> 2) & 3u))); }
DI unsigned tr_addr(unsigned lane, unsigned r0, unsigned c, unsigned t) {
    const unsigned g = lane >> 4, q = (lane & 15u) >> 2, p = lane & 3u;
    return off_b(r0 + 8u * g + 4u * t + q, 2u * c + (p >> 1)) + 8u * (p & 1u);
}
DI s16x4 tr_read(LAS const unsigned char* p) { return __builtin_amdgcn_ds_read_tr16_b64_v4i16((LAS s16x4*)p); }
DI bf16x8 tr_read8(LAS const unsigned char* base, unsigned lane, unsigned r0, unsigned c) {
    const s16x4 lo = tr_read(base + tr_addr(lane, r0, c, 0)), hi = tr_read(base + tr_addr(lane, r0, c, 1));
    return __builtin_shufflevector(lo, hi, 0, 1, 2, 3, 4, 5, 6, 7);
}
DI bf16x8 lds_rd8(LAS const unsigned char* p) { return *(const LAS bf16x8*)p; }
DI bf16x8 as_bf16x8(u32x4 v) { return __builtin_bit_cast(bf16x8, v); }
#define MFMA16(a, b, c) __builtin_amdgcn_mfma_f32_16x16x32_bf16((a), (b), (c), 0, 0, 0)

namespace pg8 {
template <int MODE> struct EpiB {
    static constexpr bool PERM = true, AFTER_DRAIN = false;
    bf16_t* O; int ldc; const float* rope;
    __device__ __forceinline__ void operator()(const f32x4 (&acc)[2][2][4][2], const Unit& u, int wr, int wc, int fr, int fq) const {
        { int l; asm volatile("v_mbcnt_lo_u32_b32 %0, -1, 0\n\tv_mbcnt_hi_u32_b32 %0, -1, %0" : "=v"(l)); fr = l & 15; fq = l >> 4; }
        const int row0 = u.pm * BM + wr * 64 + fr;
        bool rp = false;
        if (MODE == 2) { const int pn = u.pn; rp = (pn < 10) || pn == 12 || pn == 13 || pn == 16 || pn == 17; }
        if (MODE == 2 && rp) {
            const int colb = u.pn * BM + 128 * (wc >> 1) + 32 * (wc & 1) + 8 * fq, jj0 = 32 * (wc & 1) + 8 * fq;
#pragma unroll
            for (int ai = 0; ai < 2; ++ai)
#pragma unroll
                for (int m = 0; m < 4; ++m) {
                    const int row = row0 + ai * HALF + m * 16;
                    const float* rpp = (const float*)((const char*)rope + (unsigned)(((unsigned)row * 64u + (unsigned)jj0) * 8u));
                    const f32x4 cs0 = *(const f32x4*)(rpp), cs1 = *(const f32x4*)(rpp + 4), cs2 = *(const f32x4*)(rpp + 8), cs3 = *(const f32x4*)(rpp + 12);
                    const f32x4 x1a = acc[ai][0][m][0], x1b = acc[ai][0][m][1], x2a = acc[ai][1][m][0], x2b = acc[ai][1][m][1];
                    float c[8] = {cs0[0], cs0[2], cs1[0], cs1[2], cs2[0], cs2[2], cs3[0], cs3[2]};
                    float s[8] = {cs0[1], cs0[3], cs1[1], cs1[3], cs2[1], cs2[3], cs3[1], cs3[3]};
                    float x1[8] = {x1a[0], x1a[1], x1a[2], x1a[3], x1b[0], x1b[1], x1b[2], x1b[3]};
                    float x2[8] = {x2a[0], x2a[1], x2a[2], x2a[3], x2b[0], x2b[1], x2b[2], x2b[3]};
                    float o1[8], o2[8];
#pragma unroll
                    for (int k = 0; k < 8; ++k) { o1[k] = x1[k] * c[k] - x2[k] * s[k]; o2[k] = x2[k] * c[k] + x1[k] * s[k]; }
                    u32x4 w1, w2;
                    w1.x = cvt_pk_bf16(o1[0], o1[1]); w1.y = cvt_pk_bf16(o1[2], o1[3]); w1.z = cvt_pk_bf16(o1[4], o1[5]); w1.w = cvt_pk_bf16(o1[6], o1[7]);
                    w2.x = cvt_pk_bf16(o2[0], o2[1]); w2.y = cvt_pk_bf16(o2[2], o2[3]); w2.z = cvt_pk_bf16(o2[4], o2[5]); w2.w = cvt_pk_bf16(o2[6], o2[7]);
                    bf16_t* rowp = (bf16_t*)((char*)O + (unsigned)(((unsigned)row * (unsigned)ldc + (unsigned)colb) * 2u));
                    *(u32x4*)(rowp) = w1; *(u32x4*)(rowp + 64) = w2;
                    asm volatile("" ::: "memory");
                }
        } else {
            const int col0 = u.pn * BM + wc * 32 + 8 * fq;
#pragma unroll
            for (int ai = 0; ai < 2; ++ai)
#pragma unroll
                for (int m = 0; m < 4; ++m) { bf16_t* rowp = (bf16_t*)((char*)O + (unsigned)(((unsigned)(row0 + ai * HALF + m * 16) * (unsigned)ldc + (unsigned)col0) * 2u));
#pragma unroll
                    for (int bj = 0; bj < 2; ++bj) { f32x4 v0 = acc[ai][bj][m][0], v1 = acc[ai][bj][m][1];
                        if (MODE == 1) {
#pragma unroll
                            for (int k = 0; k < 4; ++k) { const float a = fmaxf(v0[k], 0.f), b = fmaxf(v1[k], 0.f); v0[k] = a * a; v1[k] = b * b; } }
                        u32x4 w; w.x = cvt_pk_bf16(v0[0], v0[1]); w.y = cvt_pk_bf16(v0[2], v0[3]); w.z = cvt_pk_bf16(v1[0], v1[1]); w.w = cvt_pk_bf16(v1[2], v1[3]);
                        *(u32x4*)(rowp + bj * HALF) = w; } }
        }
    }
};
template <bool GATE> struct EpiRes {
    static constexpr bool PERM = false, AFTER_DRAIN = false;
    const float* xin; float* xout; int ldc; const bf16_t* e;
    __device__ __forceinline__ void operator()(const f32x4 (&acc)[2][2][4][2], const Unit& u, int wr, int wc, int fr, int fq) const {
        { int l; asm volatile("v_mbcnt_lo_u32_b32 %0, -1, 0\n\tv_mbcnt_hi_u32_b32 %0, -1, %0" : "=v"(l)); fr = l & 15; fq = l >> 4; }
        const int row0 = u.pm * BM + wr * 64 + fr, col0 = u.pn * BM + wc * 32 + 4 * fq;
#pragma unroll
        for (int ai = 0; ai < 2; ++ai)
#pragma unroll
            for (int m = 0; m < 4; ++m) { const unsigned off = (unsigned)(row0 + ai * HALF + m * 16) * (unsigned)ldc + (unsigned)col0;
#pragma unroll
                for (int bj = 0; bj < 2; ++bj)
#pragma unroll
                    for (int n = 0; n < 2; ++n) { const unsigned o = off + bj * HALF + n * 16; const f32x4 xv = *(const f32x4*)((const char*)xin + (unsigned)(o * 4u)); f32x4 a = acc[ai][bj][m][n];
                        if (GATE) { typedef unsigned u32x2v __attribute__((ext_vector_type(2))); const u32x2v ev = *(const u32x2v*)((const char*)e + (unsigned)(o * 2u));
                            const float e0 = __builtin_bit_cast(float, ev.x << 16), e1 = __builtin_bit_cast(float, ev.x & 0xffff0000u), e2 = __builtin_bit_cast(float, ev.y << 16), e3 = __builtin_bit_cast(float, ev.y & 0xffff0000u);
                            a[0] = e0 / (1.0f + __expf(-a[0])); a[1] = e1 / (1.0f + __expf(-a[1])); a[2] = e2 / (1.0f + __expf(-a[2])); a[3] = e3 / (1.0f + __expf(-a[3])); }
                        *(f32x4*)((char*)xout + (unsigned)(o * 4u)) = xv + a; }
                asm volatile("" ::: "memory"); }
    }
};
}
#define XB_TMO      128
#define XB_XCNT(j)  (256  + 64 * (j))
#define XB_XSUB(j)  (1280 + 64 * (j))
#define XB_XGEN(j)  (2304 + 64 * (j))
#define XB_TOP      3328
#define XB_TOPGEN   3392
#define XCD_BAR_WORDS 3456
#define XB_SPIN_CAP (1u << 18)

__device__ __forceinline__ unsigned xb_ld(unsigned* p)              { return __hip_atomic_load(p, __ATOMIC_RELAXED, __HIP_MEMORY_SCOPE_AGENT); }
__device__ __forceinline__ unsigned xb_add(unsigned* p, unsigned v) { return __hip_atomic_fetch_add(p, v, __ATOMIC_RELAXED, __HIP_MEMORY_SCOPE_AGENT); }
__device__ __forceinline__ unsigned xb_xcc_id() { return (unsigned)__builtin_amdgcn_s_getreg((3 << 11) | 20) & 0xFu; }
#define XB_SPIN(cond, bar) do { unsigned _sp = 0; while (cond) { __builtin_amdgcn_s_sleep(1); \
    if ((++_sp & 255u) == 0u) { if (xb_ld(&(bar)[XB_TMO])) break; if (_sp > XB_SPIN_CAP) { atomicAdd(&(bar)[XB_TMO], 1u); break; } } } } while (0)

struct XcdBarrier {
    unsigned* bar; unsigned x;
    volatile LAS unsigned* st;
};

__device__ __forceinline__ XcdBarrier xcd_barrier_post(unsigned* bar, volatile LAS unsigned* st) {
    XcdBarrier b; b.bar = bar; b.x = xb_xcc_id(); b.st = st;
    if (threadIdx.x == 0) (void)xb_add(&bar[XB_XCNT(b.x)], 1u);
    return b;
}
__device__ __forceinline__ void xcd_barrier_complete(unsigned* bar, unsigned x, unsigned& nloc, unsigned& nx) {
    const unsigned G = gridDim.x * gridDim.y * gridDim.z;
    unsigned sum, cnt, mine, sp = 0u;
    for (;;) {
        sum = 0u; cnt = 0u; mine = 0u;
#pragma unroll
        for (unsigned j = 0; j < 16; ++j) { const unsigned c = xb_ld(&bar[XB_XCNT(j)]); sum += c; cnt += (c > 0u) ? 1u : 0u; mine = (j == x) ? c : mine; }
        if (sum == G) break;
        __builtin_amdgcn_s_sleep(1);
        if ((++sp & 255u) == 0u) { if (xb_ld(&bar[XB_TMO])) break; if (sp > XB_SPIN_CAP) { atomicAdd(&bar[XB_TMO], 1u); break; } }
    }
    nloc = mine > 0u ? mine : 1u; nx = cnt > 0u ? cnt : 1u;
}

__device__ __forceinline__ void xcd_barrier(const XcdBarrier& b) {
    asm volatile("s_waitcnt vmcnt(0)" ::: "memory");
    __syncthreads();
    if (threadIdx.x == 0) {
        unsigned* bar = b.bar;
        __builtin_amdgcn_s_waitcnt(0);
        unsigned nloc = b.st[0], nx = b.st[1];
        if (nloc == 0u) { xcd_barrier_complete(bar, b.x, nloc, nx); b.st[0] = nloc; b.st[1] = nx; }
        const unsigned old = xb_add(&bar[XB_XSUB(b.x)], 1u);
        const unsigned gen = old / nloc;
        if (old + 1u == (gen + 1u) * nloc) {
            __builtin_amdgcn_fence(__ATOMIC_RELEASE, "agent");
            asm volatile("s_waitcnt vmcnt(0)" ::: "memory");
            const unsigned og = xb_add(&bar[XB_TOP], 1u);
            const unsigned tg = og / nx;
            if (og + 1u == (tg + 1u) * nx) xb_add(&bar[XB_TOPGEN], 1u);
            else XB_SPIN(xb_ld(&bar[XB_TOPGEN]) == tg, bar);
            __builtin_amdgcn_fence(__ATOMIC_ACQUIRE, "agent");
            xb_add(&bar[XB_XGEN(b.x)], 1u);
            asm volatile("s_waitcnt vmcnt(0)" ::: "memory");
        } else {
            XB_SPIN(xb_ld(&bar[XB_XGEN(b.x)]) == gen, bar);
            __builtin_amdgcn_fence(__ATOMIC_ACQUIRE, "agent");
            asm volatile("s_waitcnt vmcnt(0)" ::: "memory");
        }
    }
    __syncthreads();
}

struct Args { const void* in[30]; float* out; unsigned char* ws; int ph_lo, ph_hi; };
struct Frame {
    LAS unsigned char* lds;
    gu32* ctl;
    unsigned char* ws;
    int tid, lane, wave, G, bid;
};
DI const void* argin(const Args&, int k) {
    typedef const void* const __attribute__((address_space(4)))* kptr_t;
    kptr_t p = (kptr_t)__builtin_amdgcn_kernarg_segment_ptr(); asm volatile("" : "+s"(p));
    return (const void*)p[k]; }
DI int launder_s(int x) { asm volatile("" : "+s"(x)); return x; }
DI Frame phase_frame(const Frame& F0) { Frame F = F0;
    int l; asm volatile("v_mbcnt_lo_u32_b32 %0, -1, 0\n\tv_mbcnt_hi_u32_b32 %0, -1, %0" : "=v"(l));
    F.wave = launder_s(F0.wave); F.bid = launder_s(F0.bid); F.G = launder_s(F0.G);
    F.lane = l; F.tid = F.wave * 64 + l;
    { unsigned long long wsb = (unsigned long long)F0.ws; asm volatile("" : "+s"(wsb)); F.ws = (unsigned char*)wsb; }
    { unsigned ll = (unsigned)(size_t)F0.lds; asm volatile("" : "+s"(ll)); F.lds = (LAS unsigned char*)(size_t)ll; }
    return F; }
DI unsigned char* lw_ptr(const Frame& F, int layer, size_t off) { return F.ws + WS_W + (size_t)layer * LW_STRIDE + off; }

template <bool FRAGMAJOR = false>
DI void transpose_item(const float* W, int K, int Nsrc, int nsrc0, bf16* WT, int dst_row0, int k0, LAS float* scr, int lane) {
#pragma unroll 8
    for (int i = 0; i < 32; ++i) { const int kk = 2 * i + (lane >> 5); scr[kk * 33 + (lane & 31)] = W[(size_t)(k0 + kk) * Nsrc + nsrc0 + (lane & 31)]; }
    LDS_WAIT(); asm volatile("" ::: "memory");
    const int c = lane & 7;
#pragma unroll
    for (int j = 0; j < 4; ++j) { const int n = (lane >> 3) + 8 * j; const LAS float* s = scr + (8 * c) * 33 + n;
        u32x4 o; o.x = pk2(s[0 * 33], s[1 * 33]); o.y = pk2(s[2 * 33], s[3 * 33]); o.z = pk2(s[4 * 33], s[5 * 33]); o.w = pk2(s[6 * 33], s[7 * 33]);
        if (FRAGMAJOR) { const int hid = dst_row0 + n, kk = k0 + 8 * c;
            *(u32x4*)(WT + ((size_t)((hid >> 4) * (K >> 5) + (kk >> 5)) * 64 + (((kk >> 3) & 3) * 16 + (hid & 15))) * 8) = o; }
        else *(u32x4*)(WT + (size_t)(dst_row0 + n) * K + k0 + 8 * c) = o; }
    LDS_WAIT(); asm volatile("" ::: "memory");
}
DI int proj_src_col(int d) {
    if (d < 5120) {
        const int pn = d >> 8; const bool rp = (pn < 10) || pn == 12 || pn == 13 || pn == 16 || pn == 17;
        if (!rp) return d;
        const int c = d & 255, bj = c >> 7, wc = (c >> 5) & 3;
        return (pn << 8) + 128 * (wc >> 1) + 64 * bj + 32 * (wc & 1);
    }
    if (d < 16384) return d + 48;
    if (d < 22528) return d + 80;
    if (d < 22592) return S_GN + (d - 22528);
    if (d < 22624) return S_DT + (d - 22592);
    return 0;
}
constexpr int TI_IN = 32 * 712, TI_O = 32 * 64, TI_UP = 32 * 256, TI_DOWN = 128 * 64, TI_PG = 32 * 64, TI_PLE = 4 * 64, TI_P1 = 64 * 4, TI_P2 = 2 * 4;
constexpr int TI_LAYER = TI_IN + TI_O + TI_UP + TI_DOWN + TI_PG + TI_PLE + 2 * TI_P1 + 2 * TI_P2;

DI void p0_prologue(const Frame& F0, const Args& A) {
    const Frame F = phase_frame(F0);
    LAS float* scr = (LAS float*)(F.lds + F.wave * 16384);
    const int gw = F.bid * NWAVES + F.wave, NGW = F.G * NWAVES;
    for (int it = gw; it < DEPTH * TI_LAYER; it += NGW) {
        const int layer = it / TI_LAYER; int r = it - layer * TI_LAYER;
        if (r < TI_IN) { const int kb = r / 712, nb = r - kb * 712;
            transpose_item((const float*)argin(A, 4) + (size_t)layer * DM * PROJ_SRC, DM, PROJ_SRC, proj_src_col(nb * 32), (bf16*)lw_ptr(F, layer, LW_IN), nb * 32, kb * 64, scr, F.lane); continue; } r -= TI_IN;
        if (r < TI_O) { const int kb = r / 64, nb = r % 64;
            transpose_item((const float*)argin(A, 22) + (size_t)layer * DM * DM, DM, DM, nb * 32, (bf16*)lw_ptr(F, layer, LW_O), nb * 32, kb * 64, scr, F.lane); continue; } r -= TI_O;
        if (r < TI_UP) { const int kb = r / 256, nb = r % 256;
            transpose_item((const float*)argin(A, 24) + (size_t)layer * DM * DFF, DM, DFF, nb * 32, (bf16*)lw_ptr(F, layer, LW_UP), nb * 32, kb * 64, scr, F.lane); continue; } r -= TI_UP;
        if (r < TI_DOWN) { const int kb = r / 64, nb = r % 64;
            transpose_item((const float*)argin(A, 25) + (size_t)layer * DFF * DM, DFF, DM, nb * 32, (bf16*)lw_ptr(F, layer, LW_DOWN), nb * 32, kb * 64, scr, F.lane); continue; } r -= TI_DOWN;
        if (r < TI_PG) { const int kb = r / 64, nb = r % 64;
            transpose_item((const float*)argin(A, 28) + (size_t)layer * DM * DM, DM, DM, nb * 32, (bf16*)lw_ptr(F, layer, LW_PG), nb * 32, kb * 64, scr, F.lane); continue; } r -= TI_PG;
        if (r < TI_PLE) { const int kb = r / 64, nb = r % 64;
            transpose_item((const float*)argin(A, 27) + (size_t)layer * PLE * DM, PLE, DM, nb * 32, (bf16*)lw_ptr(F, layer, LW_PLE), nb * 32, kb * 64, scr, F.lane); continue; } r -= TI_PLE;
        if (r < TI_P1) { const int kb = r / 4, nb = r % 4;
            transpose_item<true>((const float*)argin(A, 7) + (size_t)layer * 4096 * 128, 4096, 128, nb * 32, (bf16*)lw_ptr(F, layer, LW_PK1), nb * 32, kb * 64, scr, F.lane); continue; } r -= TI_P1;
        if (r < TI_P1) { const int kb = r / 4, nb = r % 4;
            transpose_item<true>((const float*)argin(A, 11) + (size_t)layer * 4096 * 128, 4096, 128, nb * 32, (bf16*)lw_ptr(F, layer, LW_PV1), nb * 32, kb * 64, scr, F.lane); continue; } r -= TI_P1;
        if (r < TI_P2) { const int kb = r / 4, nb = r % 4;
            transpose_item((const float*)argin(A, 9) + (size_t)layer * 128 * 128, 128, 128, nb * 32, (bf16*)lw_ptr(F, layer, LW_PK2), nb * 32, kb * 64, scr, F.lane); continue; } r -= TI_P2;
        { const int kb = r / 4, nb = r % 4;
            transpose_item((const float*)argin(A, 13) + (size_t)layer * 128 * 128, 128, 128, nb * 32, (bf16*)lw_ptr(F, layer, LW_PV2), nb * 32, kb * 64, scr, F.lane); }
    }
    const size_t gt = (size_t)F.bid * NTHR + F.tid, NGT = (size_t)F.G * NTHR;
    { const float* p = (const float*)argin(A, 1); bf16* pb = (bf16*)(F.ws + WS_PB);
      for (size_t i = gt; i < (size_t)DEPTH * M * PLE / 8; i += NGT) { const f32x4 a = *(const f32x4*)(p + i * 8), b = *(const f32x4*)(p + i * 8 + 4);
          u32x4 o; o.x = pk2(a[0], a[1]); o.y = pk2(a[2], a[3]); o.z = pk2(b[0], b[1]); o.w = pk2(b[2], b[3]); *(u32x4*)(pb + i * 8) = o; } }
    { const int* pos = (const int*)argin(A, 2); float* rope = (float*)(F.ws + WS_ROPE);
      for (size_t i = gt; i < (size_t)M * 64; i += NGT) { const int row = (int)(i >> 6), jj = (int)(i & 63);
          const float inv = 1.0f / powf(10000.0f, (float)(2 * jj) * (1.0f / 128.0f));
          const float ang = (float)pos[row] * inv;
          double a = (double)ang; a -= 6.283185307179586476925 * __builtin_rint(a * 0.15915494309189533577);
          const float ar = (float)a;
          rope[i * 2] = cosf(ar); rope[i * 2 + 1] = sinf(ar); } }
    { float* part = (float*)(F.ws + WS_MISC);
      for (size_t i = gt; i < (size_t)DEPTH * 2 * 8 * 128; i += NGT) { const int hid = (int)(i & 127), c = (int)(i >> 7) & 7, kv = (int)(i >> 10) & 1, layer = (int)(i >> 11);
          const float* pe = (const float*)(kv ? A.in[6] : A.in[5]) + (size_t)layer * 4096 + c * 512;
          const float* w1 = (const float*)(kv ? A.in[11] : A.in[7]) + (size_t)layer * 4096 * 128 + (size_t)c * 512 * 128 + hid;
          float s = 0.f;
#pragma unroll 8
          for (int kk = 0; kk < 512; ++kk) s += pe[kk] * w1[(size_t)kk * 128];
          part[i] = s; } }
}

template <bool OUTF32> DI void norm_rows(const Frame& F0, const float* x, const float* g, void* outp) {
    const Frame F = phase_frame(F0);
    const int gw = F.bid * NWAVES + F.wave, NGW = F.G * NWAVES;
    for (int m = gw; m < M; m += NGW) {
        const f32x4* xr = (const f32x4*)(x + (size_t)m * DM) + F.lane;
        f32x4 v[8]; float s = 0.f;
#pragma unroll
        for (int j = 0; j < 8; ++j) { v[j] = xr[64 * j]; s += (v[j][0] * v[j][0] + v[j][1] * v[j][1]) + (v[j][2] * v[j][2] + v[j][3] * v[j][3]); }
        const float rstd = 1.0f / sqrtf(wave_sum(s, F.lane) * (1.0f / DM) + EPS);
#pragma unroll
        for (int j = 0; j < 8; ++j) { const f32x4 gv = ((const f32x4*)g)[F.lane + 64 * j]; const f32x4 o = v[j] * rstd * gv;
            if (OUTF32) ((f32x4*)((float*)outp + (size_t)m * DM))[F.lane + 64 * j] = o;
            else { u32x2 w; w.x = pk2(o[0], o[1]); w.y = pk2(o[2], o[3]); ((u32x2*)((bf16*)outp + (size_t)m * DM))[F.lane + 64 * j] = w; } }
    }
}
DI void unpack8(u32x4 w, float (&f)[8]) { f[0] = bflo(w.x); f[1] = bfhi(w.x); f[2] = bflo(w.y); f[3] = bfhi(w.y); f[4] = bflo(w.z); f[5] = bfhi(w.z); f[6] = bflo(w.w); f[7] = bfhi(w.w); }
DI u32x4 pack8f(const float (&f)[8]) { u32x4 o; o.x = pk2(f[0], f[1]); o.y = pk2(f[2], f[3]); o.z = pk2(f[4], f[5]); o.w = pk2(f[6], f[7]); return o; }

DI void ssd_conv_pass(const Frame& F0, const Args& A, int layer) {
    const Frame F = phase_frame(F0);
    const bf16* proj = (const bf16*)(F.ws + WS_PROJ); bf16* xbc = (bf16*)(F.ws + WS_XBC);
    const float* cw = (const float*)argin(A, 16) + (size_t)layer * 4 * SSD_XBC; const float* cb = (const float*)argin(A, 17) + (size_t)layer * SSD_XBC;
    const int gt = F.bid * NTHR + F.tid, NGT = F.G * NTHR;
    for (int task = gt; task < 512 * 384; task += NGT) {
        const int run = task / 384, cg = task - run * 384, ch = cg * 8, row0 = run * 32;
        float w[4][8], bs[8], xm3[8], xm2[8], xm1[8];
#pragma unroll
        for (int j = 0; j < 4; ++j) { const f32x4 a = *(const f32x4*)(cw + j * SSD_XBC + ch), b = *(const f32x4*)(cw + j * SSD_XBC + ch + 4);
            w[j][0] = a[0]; w[j][1] = a[1]; w[j][2] = a[2]; w[j][3] = a[3]; w[j][4] = b[0]; w[j][5] = b[1]; w[j][6] = b[2]; w[j][7] = b[3]; }
        { const f32x4 a = *(const f32x4*)(cb + ch), b = *(const f32x4*)(cb + ch + 4); bs[0] = a[0]; bs[1] = a[1]; bs[2] = a[2]; bs[3] = a[3]; bs[4] = b[0]; bs[5] = b[1]; bs[6] = b[2]; bs[7] = b[3]; }
        if ((row0 & (SEQ - 1)) != 0) {
            unpack8(*(const u32x4*)(proj + (size_t)(row0 - 3) * LDP + C_XBC + ch), xm3);
            unpack8(*(const u32x4*)(proj + (size_t)(row0 - 2) * LDP + C_XBC + ch), xm2);
            unpack8(*(const u32x4*)(proj + (size_t)(row0 - 1) * LDP + C_XBC + ch), xm1);
        } else {
#pragma unroll
            for (int k = 0; k < 8; ++k) { xm3[k] = 0.f; xm2[k] = 0.f; xm1[k] = 0.f; }
        }
#pragma unroll 4
        for (int r = 0; r < 32; ++r) {
            float cur[8], y[8]; unpack8(*(const u32x4*)(proj + (size_t)(row0 + r) * LDP + C_XBC + ch), cur);
#pragma unroll
            for (int k = 0; k < 8; ++k) { const float v = w[0][k] * xm3[k] + w[1][k] * xm2[k] + w[2][k] * xm1[k] + w[3][k] * cur[k] + bs[k]; y[k] = siluf_(v); xm3[k] = xm2[k]; xm2[k] = xm1[k]; xm1[k] = cur[k]; }
            *(u32x4*)(xbc + (size_t)(row0 + r) * SSD_XBC + ch) = pack8f(y);
            asm volatile("" ::: "memory");
        }
    }
    const float* dtb = (const float*)argin(A, 18) + layer * SSD_H; float* dt = (float*)(F.ws + WS_DT);
    for (int i = gt; i < M * SSD_H; i += NGT) { const int row = i >> 5, h = i & 31;
        const float x = bf2f(proj[(size_t)row * LDP + C_DT + h]) + dtb[h];
        dt[i] = fmaxf(x, 0.f) + log1pf(__expf(-fabsf(x))); }
}

DI void merge_pass(const Frame& F0, const Args& A, int layer) {
    const Frame F = phase_frame(F0);
    const bf16* proj = (const bf16*)(F.ws + WS_PROJ); const bf16* ya = (const bf16*)(F.ws + WS_YA); const bf16* yc = (const bf16*)(F.ws + WS_YC); bf16* hb = (bf16*)(F.ws + WS_HB);
    const float* sw = (const float*)argin(A, 15) + (size_t)layer * 3 * DM; const float* ngp = (const float*)argin(A, 21) + (size_t)layer * DM; const float* rstdp = (const float*)(F.ws + WS_RSTD);
    const int gt = F.bid * NTHR + F.tid, NGT = F.G * NTHR;
    for (int task = gt; task < 512 * 256; task += NGT) {
        const int run = task >> 8, cg = task & 255, ch = cg * 8, row0 = run * 32;
        float w[3][8], pm2[8], pm1[8], ng8[8];
        { const f32x4 a = *(const f32x4*)(ngp + ch), b = *(const f32x4*)(ngp + ch + 4); ng8[0] = a[0]; ng8[1] = a[1]; ng8[2] = a[2]; ng8[3] = a[3]; ng8[4] = b[0]; ng8[5] = b[1]; ng8[6] = b[2]; ng8[7] = b[3]; }
#pragma unroll
        for (int j = 0; j < 3; ++j) { const f32x4 a = *(const f32x4*)(sw + j * DM + ch), b = *(const f32x4*)(sw + j * DM + ch + 4);
            w[j][0] = a[0]; w[j][1] = a[1]; w[j][2] = a[2]; w[j][3] = a[3]; w[j][4] = b[0]; w[j][5] = b[1]; w[j][6] = b[2]; w[j][7] = b[3]; }
        if ((row0 & (SEQ - 1)) != 0) {
            float c1[8], u1[8];
            unpack8(*(const u32x4*)(proj + (size_t)(row0 - 2) * LDP + C_CC + ch), c1); unpack8(*(const u32x4*)(proj + (size_t)(row0 - 2) * LDP + C_CU + ch), u1);
#pragma unroll
            for (int k = 0; k < 8; ++k) pm2[k] = c1[k] * u1[k];
            unpack8(*(const u32x4*)(proj + (size_t)(row0 - 1) * LDP + C_CC + ch), c1); unpack8(*(const u32x4*)(proj + (size_t)(row0 - 1) * LDP + C_CU + ch), u1);
#pragma unroll
            for (int k = 0; k < 8; ++k) pm1[k] = c1[k] * u1[k];
        } else {
#pragma unroll
            for (int k = 0; k < 8; ++k) { pm2[k] = 0.f; pm1[k] = 0.f; }
        }
#pragma unroll 2
        for (int r = 0; r < 32; ++r) {
            const size_t pr = (size_t)(row0 + r) * LDP + ch, yr = (size_t)(row0 + r) * DM + ch;
            float cc[8], cu[8], cbv[8], g0[8], g1[8], g2[8], a[8], c[8], o[8];
            unpack8(*(const u32x4*)(proj + pr + C_CC), cc); unpack8(*(const u32x4*)(proj + pr + C_CU), cu); unpack8(*(const u32x4*)(proj + pr + C_CB), cbv);
            unpack8(*(const u32x4*)(proj + pr + C_GM), g0); unpack8(*(const u32x4*)(proj + pr + C_GM + DM), g1); unpack8(*(const u32x4*)(proj + pr + C_GM + 2 * DM), g2);
            unpack8(*(const u32x4*)(ya + yr), a); unpack8(*(const u32x4*)(yc + yr), c);
            const float rs = rstdp[(size_t)(row0 + r) * SSD_G + (ch >> 9)];
#pragma unroll
            for (int k = 0; k < 8; ++k) { const float pc = cc[k] * cu[k]; const float cv = w[0][k] * pm2[k] + w[1][k] * pm1[k] + w[2][k] * pc; pm2[k] = pm1[k]; pm1[k] = pc;
                o[k] = sigmoidf_(g0[k]) * a[k] + sigmoidf_(g1[k]) * (cbv[k] * cv) + sigmoidf_(g2[k]) * (c[k] * rs * ng8[k]); }
            *(u32x4*)(hb + yr) = pack8f(o);
            asm volatile("" ::: "memory");
        }
    }
}

DI void compress_phase(const Frame& F0, const Args& A, int layer) {
    const Frame F = phase_frame(F0);
    const bf16* proj = (const bf16*)(F.ws + WS_PROJ);
    LAS unsigned char* slab = F.lds;
    LAS unsigned char* hidl = F.lds + 73728;
    LAS float* b1s = (LAS float*)(F.lds + 81920);
    const int lane = F.lane, w = F.wave, i = lane & 15, qd = lane >> 4;
    const float* part = (const float*)(F.ws + WS_MISC);
    for (int u = F.bid; u < 512; u += F.G) {
        const int kv = u >> 8, b = (u >> 7) & 1, g = (u >> 5) & 3, nb = u & 31, n0 = nb * 16, tok0 = n0 * 16;
        const int col = (kv ? C_VC : C_KC) + g * HD;
        for (int id = F.tid; id < 272 * 16; id += NTHR) { const int row = id >> 4, ch = id & 15, t = tok0 + row;
            u32x4 v = {0u, 0u, 0u, 0u}; if (t < SEQ) v = *(const u32x4*)(proj + (size_t)(b * SEQ + t) * LDP + col + ch * 8);
            *(LAS u32x4*)(slab + off_b(row, ch)) = v; }
        if (F.tid < 128) { float s = ((const float*)argin(A, kv ? 12 : 8))[layer * 128 + F.tid];
#pragma unroll
            for (int c = 0; c < 8; ++c) s += part[(((size_t)layer * 2 + kv) * 8 + c) * 128 + F.tid];
            b1s[F.tid] = s; }
        __syncthreads();
        const bf16* w1t = (const bf16*)lw_ptr(F, layer, kv ? LW_PV1 : LW_PK1) + ((size_t)w * 128 * 64 + lane) * 8;
        f32x4 acc = {0.f, 0.f, 0.f, 0.f};
        for (int k0 = 0; k0 < 128; k0 += 32) {
            bf16x8 bb[32];
#pragma unroll
            for (int k = 0; k < 32; ++k) bb[k] = *(const bf16x8*)(w1t + 512 * (k0 + k));
#pragma unroll
            for (int k = 0; k < 32; ++k) { const int ks = k0 + k;
                acc = MFMA16(lds_rd8(slab + off_b(16 * i + (ks >> 2), 4 * (ks & 3) + qd)), bb[k], acc); }
        }
        { const float bv = b1s[16 * w + i];
#pragma unroll
          for (int j = 0; j < 4; ++j) *(LAS bf16*)(hidl + (4 * qd + j) * 272 + (16 * w + i) * 2) = (bf16)f2bf(siluf_(acc[j] + bv)); }
        __syncthreads();
        const bf16* w2t = (const bf16*)lw_ptr(F, layer, kv ? LW_PV2 : LW_PK2) + (size_t)(16 * w + i) * 128 + 8 * qd;
        f32x4 acc2 = {0.f, 0.f, 0.f, 0.f};
#pragma unroll
        for (int s = 0; s < 4; ++s) {
            const bf16x8 a = lds_rd8(hidl + i * 272 + 64 * s + 16 * qd);
            const bf16x8 bb = *(const bf16x8*)(w2t + 32 * s);
            acc2 = MFMA16(a, bb, acc2);
        }
        const float b2 = ((const float*)argin(A, kv ? 14 : 10))[layer * 128 + 16 * w + i];
        bf16* dst = (bf16*)(F.ws + (kv ? WS_VCMP : WS_KCMP)) + ((size_t)(b * NG + g) * NCMP_PAD + n0) * HD + 16 * w + i;
#pragma unroll
        for (int j = 0; j < 4; ++j) dst[(size_t)(4 * qd + j) * HD] = (bf16)f2bf(acc2[j] + b2);
        __syncthreads();
    }
}

DI void ssd_states_phase(const Frame& F0, const Args& A, int layer) {
    const Frame F = phase_frame(F0);
    const bf16* xbc = (const bf16*)(F.ws + WS_XBC); const float* dt = (const float*)(F.ws + WS_DT);
    float* acs = (float*)(F.ws + WS_ACS); float* cdec = (float*)(F.ws + WS_CDEC); float* st = (float*)(F.ws + WS_ST);
    LAS unsigned char* Bt = F.lds; LAS unsigned char* Xt = F.lds + 32768; LAS float* sc = (LAS float*)(F.lds + 65536);
    const float* alog = (const float*)argin(A, 19) + layer * SSD_H;
    const int lane = F.lane, w = F.wave, i = lane & 15, qd = lane >> 4;
    for (int u = F.bid; u < 512; u += F.G) {
        const int b = u >> 8, c = (u >> 2) & 63, g = u & 3, row0 = b * SEQ + c * SSD_CH;
        {
            const int hh = g * 8 + w; const float a = -__expf(alog[hh]);
            const float dt0 = dt[(size_t)(row0 + 2 * lane) * SSD_H + hh], dt1 = dt[(size_t)(row0 + 2 * lane + 1) * SSD_H + hh];
            const float d0 = dt0 * a, d1 = dt1 * a, pair = d0 + d1; float s = pair;
#pragma unroll
            for (int o = 1; o < 64; o <<= 1) { const float t = shfl_idx(s, lane - o); if (lane >= o) s += t; }
            const float a0 = (s - pair) + d0, a1 = s, total = __builtin_bit_cast(float, __builtin_amdgcn_readlane(__builtin_bit_cast(int, s), 63));
            acs[(size_t)(row0 + 2 * lane) * SSD_H + hh] = a0; acs[(size_t)(row0 + 2 * lane + 1) * SSD_H + hh] = a1;
            sc[w * 128 + 2 * lane] = dt0 * __expf(total - a0); sc[w * 128 + 2 * lane + 1] = dt1 * __expf(total - a1);
            if (lane == 0) cdec[(size_t)(b * SSD_NC + c) * SSD_H + hh] = __expf(total);
        }
        for (int id = F.tid; id < 128 * 16; id += NTHR) { const int row = id >> 4, ch = id & 15;
            *(LAS u32x4*)(Bt + off_b(row, ch)) = *(const u32x4*)(xbc + (size_t)(row0 + row) * SSD_XBC + 2048 + g * 128 + ch * 8); }
        bf16x8 bfr[4];
        for (int hp = 0; hp < 4; ++hp) {
            __syncthreads();
            for (int id = F.tid; id < 128 * 16; id += NTHR) { const int row = id >> 4, ch = id & 15;
                float x[8]; unpack8(*(const u32x4*)(xbc + (size_t)(row0 + row) * SSD_XBC + g * 512 + hp * 128 + ch * 8), x);
                const float f = sc[(hp * 2 + (ch >> 3)) * 128 + row];
#pragma unroll
                for (int k = 0; k < 8; ++k) x[k] *= f;
                *(LAS u32x4*)(Xt + off_b(row, ch)) = pack8f(x); }
            __syncthreads();
            if (hp == 0) {
#pragma unroll
                for (int ks = 0; ks < 4; ++ks) bfr[ks] = tr_read8(Bt, lane, 32 * ks, w);
            }
#pragma unroll
            for (int h2 = 0; h2 < 2; ++h2) {
                const int head = g * 8 + hp * 2 + h2;
                float* dst = st + ((size_t)((b * SSD_NC + c) * SSD_H + head) * SSD_N + 16 * w + i) * SSD_P + 4 * qd;
#pragma unroll
                for (int pt = 0; pt < 4; ++pt) {
                    f32x4 acc = {0.f, 0.f, 0.f, 0.f};
#pragma unroll
                    for (int ks = 0; ks < 4; ++ks) acc = MFMA16(tr_read8(Xt, lane, 32 * ks, h2 * 4 + pt), bfr[ks], acc);
                    *(f32x4*)(dst + 16 * pt) = acc;
                }
            }
        }
        __syncthreads();
    }
}
DI void ssd_scan_phase(const Frame& F0) {
    const Frame F = phase_frame(F0);
    const f32x4* st = (const f32x4*)(F.ws + WS_ST); u32x2* hin = (u32x2*)(F.ws + WS_HIN); const float* cdec = (const float*)(F.ws + WS_CDEC);
    const int gt = F.bid * NTHR + F.tid, NGT = F.G * NTHR;
    for (int v = gt; v < BATCH * SSD_H * 2048; v += NGT) {
        const int b = v >> 16, h = (v >> 11) & 31, e = v & 2047;
        const size_t o0 = ((size_t)(b * SSD_NC) * SSD_H + h) * 2048 + e;
        const float* dc = cdec + (size_t)(b * SSD_NC) * SSD_H + h;
        f32x4 hs = {0.f, 0.f, 0.f, 0.f};
        for (int c0 = 0; c0 < SSD_NC; c0 += 8) {
            f32x4 s[8]; float d[8];
#pragma unroll
            for (int k = 0; k < 8; ++k) { s[k] = st[o0 + (size_t)(c0 + k) * 65536]; d[k] = dc[(c0 + k) * SSD_H]; }
#pragma unroll
            for (int k = 0; k < 8; ++k) { u32x2 o; o.x = pk2(hs[0], hs[1]); o.y = pk2(hs[2], hs[3]); hin[o0 + (size_t)(c0 + k) * 65536] = o; hs = hs * d[k] + s[k]; }
        }
    }
}
DI void ssd_out_phase(const Frame& F0, const Args& A, int layer) {
    const Frame F = phase_frame(F0);
    const bf16* xbc = (const bf16*)(F.ws + WS_XBC); const bf16* proj = (const bf16*)(F.ws + WS_PROJ);
    const float* dt = (const float*)(F.ws + WS_DT); const float* acs = (const float*)(F.ws + WS_ACS); const bf16* hin = (const bf16*)(F.ws + WS_HIN);
    bf16* yc = (bf16*)(F.ws + WS_YC); float* rstdp = (float*)(F.ws + WS_RSTD);
    LAS unsigned char* Bt = F.lds; LAS unsigned char* Ct = F.lds + 32768; LAS unsigned char* Xt = F.lds + 65536; LAS unsigned char* Ht = F.lds + 98304;
    LAS float* acsl = (LAS float*)(F.lds + LX_OFF);
    const float* dsk = (const float*)argin(A, 20) + layer * SSD_H;
    const int lane = F.lane, w = F.wave, i = lane & 15, qd = lane >> 4;
    for (int u = F.bid; u < 512; u += F.G) {
        const int b = u >> 8, c = (u >> 2) & 63, g = u & 3, row0 = b * SEQ + c * SSD_CH;
        for (int id = F.tid; id < 128 * 16; id += NTHR) { const int row = id >> 4, ch = id & 15; const bf16* src = xbc + (size_t)(row0 + row) * SSD_XBC + 2048 + g * 128 + ch * 8;
            *(LAS u32x4*)(Bt + off_b(row, ch)) = *(const u32x4*)(src); *(LAS u32x4*)(Ct + off_b(row, ch)) = *(const u32x4*)(src + 512); }
        __syncthreads();
        bf16x8 cfr[4];
#pragma unroll
        for (int ks = 0; ks < 4; ++ks) cfr[ks] = lds_rd8(Ct + off_b(16 * w + i, 4 * ks + qd));
        f32x4 cb[4][2];
#pragma unroll
        for (int k = 0; k < 4; ++k)
#pragma unroll
            for (int T = 0; T < 2; ++T) { f32x4 acc = {0.f, 0.f, 0.f, 0.f};
#pragma unroll
                for (int ks = 0; ks < 4; ++ks) acc = MFMA16(lds_rd8(Bt + off_b(32 * k + 8 * (i >> 2) + (i & 3) + 4 * T, 4 * ks + qd)), cfr[ks], acc);
                cb[k][T] = acc; }
        const int lrow = 16 * w + i, row = row0 + lrow;
        float ssq = 0.f;
        for (int hp = 0; hp < 4; ++hp) {
            __syncthreads();
            if (F.tid < 256) { const int h2 = F.tid >> 7, l = F.tid & 127; acsl[F.tid] = acs[(size_t)(row0 + l) * SSD_H + g * 8 + hp * 2 + h2]; }
            for (int id = F.tid; id < 128 * 16; id += NTHR) { const int r = id >> 4, ch = id & 15, head = g * 8 + hp * 2 + (ch >> 3);
                float x[8]; unpack8(*(const u32x4*)(xbc + (size_t)(row0 + r) * SSD_XBC + g * 512 + hp * 128 + ch * 8), x);
                const float f = dt[(size_t)(row0 + r) * SSD_H + head];
#pragma unroll
                for (int k = 0; k < 8; ++k) x[k] *= f;
                *(LAS u32x4*)(Xt + off_b(r, ch)) = pack8f(x);
                *(LAS u32x4*)(Ht + off_b(r, ch)) = *(const u32x4*)(hin + ((size_t)((b * SSD_NC + c) * SSD_H + head) * SSD_N + r) * SSD_P + (ch & 7) * 8); }
            __syncthreads();
#pragma unroll
            for (int h2 = 0; h2 < 2; ++h2) {
                const int head = g * 8 + hp * 2 + h2;
                const float al = acsl[h2 * 128 + lrow], ea = __expf(al), dsv = dsk[head];
                bf16x8 mfr[4];
#pragma unroll
                for (int k = 0; k < 4; ++k) {
                    const f32x4 a0 = *(const LAS f32x4*)(acsl + h2 * 128 + 32 * k + 8 * qd), a1 = *(const LAS f32x4*)(acsl + h2 * 128 + 32 * k + 8 * qd + 4);
                    float mv[8];
#pragma unroll
                    for (int j = 0; j < 4; ++j) { const int s0 = 32 * k + 8 * qd + j, s1 = s0 + 4;
                        mv[j] = (s0 <= lrow) ? cb[k][0][j] * __expf(al - a0[j]) : 0.f;
                        mv[4 + j] = (s1 <= lrow) ? cb[k][1][j] * __expf(al - a1[j]) : 0.f; }
                    mfr[k] = as_bf16x8(pack8f(mv));
                }
#pragma unroll
                for (int pt = 0; pt < 4; ++pt) {
                    f32x4 yd = {0.f, 0.f, 0.f, 0.f}, yo = {0.f, 0.f, 0.f, 0.f};
#pragma unroll
                    for (int k = 0; k < 4; ++k) yd = MFMA16(tr_read8(Xt, lane, 32 * k, h2 * 4 + pt), mfr[k], yd);
#pragma unroll
                    for (int ks = 0; ks < 4; ++ks) yo = MFMA16(tr_read8(Ht, lane, 32 * ks, h2 * 4 + pt), cfr[ks], yo);
                    const int chn = head * SSD_P + 16 * pt + 4 * qd;
                    const u32x2 xv = *(const u32x2*)(xbc + (size_t)row * SSD_XBC + chn), zv = *(const u32x2*)(proj + (size_t)row * LDP + C_Z + chn);
                    const float xs[4] = {bflo(xv.x), bfhi(xv.x), bflo(xv.y), bfhi(xv.y)}, zz[4] = {bflo(zv.x), bfhi(zv.x), bflo(zv.y), bfhi(zv.y)};
                    float gy[4];
#pragma unroll
                    for (int j = 0; j < 4; ++j) { const float y = yd[j] + ea * yo[j] + dsv * xs[j]; gy[j] = y * siluf_(zz[j]); ssq += gy[j] * gy[j]; }
                    u32x2 o; o.x = pk2(gy[0], gy[1]); o.y = pk2(gy[2], gy[3]);
                    *(u32x2*)(yc + (size_t)row * DM + chn) = o;
                }
            }
        }
        ssq += shx(ssq, 16, lane); ssq += shx(ssq, 32, lane);
        if (qd == 0) rstdp[(size_t)row * SSD_G + g] = 1.0f / sqrtf(ssq * (1.0f / 512.0f) + EPS);
        __syncthreads();
    }
}

#ifndef NSA_REP_PART
#define NSA_REP_PART 0
#endif
#if NSA_REP_PART == 7
#define W7DUP(x) x
#define W7WAIT() NSA_WAITV(8)
#else
#define W7DUP(x)
#define W7WAIT() NSA_WAITV(4)
#endif
constexpr int RB = 32768, NRING = 3;
#define NSA_WAITV(n) asm volatile("s_waitcnt vmcnt(" #n ")" ::: "memory")
#define NSA_BAR() do { asm volatile("" ::: "memory"); __builtin_amdgcn_s_barrier(); asm volatile("" ::: "memory"); } while (0)
template <bool WITHV> DI void tile_dma(LAS unsigned char* buf, const bf16* kp, const bf16* vp, int pitch, int w, int lane) {
#pragma unroll
    for (int e = 0; e < 2; ++e) { const int kb = 2 * w + e, kh = kb >> 3, T = (kb >> 2) & 1, ks = kb & 3, i = lane & 15, qd = lane >> 4;
        const int key = 32 * kh + 8 * (i >> 2) + (i & 3) + 4 * T, ch = 4 * ks + qd;
        __builtin_amdgcn_global_load_lds((const unsigned*)(kp + (size_t)key * pitch + ch * 8), (LAS unsigned*)(buf + kb * 1024), 16, 0, 0); }
    if (WITHV) {
#pragma unroll
        for (int e = 0; e < 2; ++e) { const int vb = 2 * w + e, kh = vb >> 3, dt = vb & 7, t = lane >> 5, g = (lane >> 3) & 3, q = (lane >> 1) & 3, ph = lane & 1;
            const int key = 32 * kh + 8 * g + 4 * t + q, ch = 2 * dt + ph;
            __builtin_amdgcn_global_load_lds((const unsigned*)(vp + (size_t)key * pitch + ch * 8), (LAS unsigned*)(buf + 16384 + vb * 1024), 16, 0, 0); }
    }
}
#define NSA_TR8(r, addr, b) asm volatile("ds_read_b64_tr_b16 %0, %8 offset:%9\n\tds_read_b64_tr_b16 %1, %8 offset:%10\n\tds_read_b64_tr_b16 %2, %8 offset:%11\n\tds_read_b64_tr_b16 %3, %8 offset:%12\n\t" \
        "ds_read_b64_tr_b16 %4, %8 offset:%13\n\tds_read_b64_tr_b16 %5, %8 offset:%14\n\tds_read_b64_tr_b16 %6, %8 offset:%15\n\tds_read_b64_tr_b16 %7, %8 offset:%16" \
        : "=&v"(r[0]), "=&v"(r[1]), "=&v"(r[2]), "=&v"(r[3]), "=&v"(r[4]), "=&v"(r[5]), "=&v"(r[6]), "=&v"(r[7]) \
        : "v"(addr), "i"((b)), "i"((b) + 512), "i"((b) + 1024), "i"((b) + 1536), "i"((b) + 2048), "i"((b) + 2560), "i"((b) + 3072), "i"((b) + 3584) : "memory")
#define NSA_TRWAIT(r) asm volatile("s_waitcnt lgkmcnt(0)" : "+v"(r[0]), "+v"(r[1]), "+v"(r[2]), "+v"(r[3]), "+v"(r[4]), "+v"(r[5]), "+v"(r[6]), "+v"(r[7]) :: "memory")
#define NSA_SB() __builtin_amdgcn_sched_barrier(0)
#define NSA_PV4(r, kh, d0) do { _Pragma("unroll") for (int q_ = 0; q_ < 4; ++q_) { const bf16x8 vf_ = __builtin_shufflevector(r[2 * q_], r[2 * q_ + 1], 0, 1, 2, 3, 4, 5, 6, 7); \
        if (SM & 1) O[0][(d0) + q_] = MFMA16(vf_, pf[0][kh], O[0][(d0) + q_]); if (SM & 2) O[1][(d0) + q_] = MFMA16(vf_, pf[1][kh], O[1][(d0) + q_]); } } while (0)
template <int MODE, int SM>
DI void attn_tile(LAS const unsigned char* Kt, LAS const unsigned char* Vt, const bf16x8 (&Qf)[2][4], f32x4 (&O)[2][8], float (&m)[2], float (&l)[2], const int (&lo)[2], const int (&hi)[2], bool needmask,
                  float c2, const float (&inv_l)[2], LAS float* imp, const int (&ql)[2], int jb0, float (&cin)[2], int lane) {
    const int qd = lane >> 4;
    f32x4 sc[2][2][2];
#pragma unroll
    for (int kh = 0; kh < 2; ++kh)
#pragma unroll
        for (int T = 0; T < 2; ++T) { f32x4 a0 = {0.f, 0.f, 0.f, 0.f}, a1 = {0.f, 0.f, 0.f, 0.f};
#pragma unroll
            for (int ks = 0; ks < 4; ++ks) { const bf16x8 kf = lds_rd8(Kt + (kh * 8 + T * 4 + ks) * 1024);
                if (SM & 1) a0 = MFMA16(kf, Qf[0][ks], a0); if (SM & 2) a1 = MFMA16(kf, Qf[1][ks], a1); }
            sc[0][kh][T] = a0; sc[1][kh][T] = a1; }
    const float NEG = -__builtin_inff();
    bf16x8 pf[2][2];
#pragma unroll
    for (int s = 0; s < 2; ++s) if (SM & (1 << s)) {
        if (needmask) {
#pragma unroll
            for (int kh = 0; kh < 2; ++kh)
#pragma unroll
                for (int T = 0; T < 2; ++T)
#pragma unroll
                    for (int j = 0; j < 4; ++j) { const int kk = 32 * kh + 8 * qd + 4 * T + j; if (kk < lo[s] || kk > hi[s]) sc[s][kh][T][j] = NEG; }
        }
        float mn = m[s];
        if (MODE != 2) {
            float tmax = fmaxf(fmaxf(sc[s][0][0][0], sc[s][0][0][1]), fmaxf(sc[s][0][0][2], sc[s][0][0][3]));
            tmax = fmaxf(tmax, fmaxf(fmaxf(sc[s][0][1][0], sc[s][0][1][1]), fmaxf(sc[s][0][1][2], sc[s][0][1][3])));
            tmax = fmaxf(tmax, fmaxf(fmaxf(sc[s][1][0][0], sc[s][1][0][1]), fmaxf(sc[s][1][0][2], sc[s][1][0][3])));
            tmax = fmaxf(tmax, fmaxf(fmaxf(sc[s][1][1][0], sc[s][1][1][1]), fmaxf(sc[s][1][1][2], sc[s][1][1][3])));
            tmax = xq_max(tmax);
            mn = fmaxf(m[s], tmax);
            if (__ballot(mn != m[s]) != 0ull) {
                const float alpha = __builtin_amdgcn_exp2f((m[s] - mn) * c2);
                l[s] *= alpha;
                if (MODE == 1) {
#pragma unroll
                    for (int dt = 0; dt < 8; ++dt) O[s][dt] = O[s][dt] * alpha;
                }
                m[s] = mn;
            }
        }
        const float nmc = -mn * c2; float ps = 0.f;
#pragma unroll
        for (int kh = 0; kh < 2; ++kh)
#pragma unroll
            for (int T = 0; T < 2; ++T)
#pragma unroll
                for (int j = 0; j < 4; ++j) { float p = __builtin_amdgcn_exp2f(__builtin_fmaf(sc[s][kh][T][j], c2, nmc)); if (MODE == 2) p *= inv_l[s]; sc[s][kh][T][j] = p; ps += p; }
        if (MODE != 2) l[s] += ps;
        if (MODE == 2) {
            float s4[2][2], cy[2][2];
#pragma unroll
            for (int kh = 0; kh < 2; ++kh)
#pragma unroll
                for (int T = 0; T < 2; ++T) {
                    float a = (sc[s][kh][T][0] + sc[s][kh][T][1]) + (sc[s][kh][T][2] + sc[s][kh][T][3]), c = sc[s][kh][T][3];
                    a = quad_sum(a); c = quad_sum(c);
                    s4[kh][T] = a; cy[kh][T] = c; }
            const float x0 = shfl_idx(cy[0][1], (lane - 16) & 63), x1 = shfl_idx(cy[1][1], (lane - 16) & 63);
            const float p00 = (qd == 0) ? cin[s] : x0, p10 = (qd == 0) ? x0 : x1;
            cin[s] = x1;
            if ((lane & 3) == 0) { const int jb = jb0 + 2 * qd;
                *(LAS f32x2*)(imp + ql[s] * 128 + jb) = (f32x2){s4[0][0] + p00, s4[0][1] + cy[0][0]};
                *(LAS f32x2*)(imp + ql[s] * 128 + jb + 8) = (f32x2){s4[1][0] + p10, s4[1][1] + cy[1][0]}; }
        }
        if (MODE != 0) {
#pragma unroll
            for (int kh = 0; kh < 2; ++kh) { u32x4 pw; pw.x = pk2(sc[s][kh][0][0], sc[s][kh][0][1]); pw.y = pk2(sc[s][kh][0][2], sc[s][kh][0][3]); pw.z = pk2(sc[s][kh][1][0], sc[s][kh][1][1]); pw.w = pk2(sc[s][kh][1][2], sc[s][kh][1][3]); pf[s][kh] = as_bf16x8(pw); }
        }
    }
    if (MODE != 0) {
        const unsigned va = (unsigned)(size_t)Vt;
        s16x4 ra[8], rb[8];
        NSA_TR8(ra, va, 0);     NSA_TRWAIT(ra); NSA_SB();
        NSA_TR8(rb, va, 4096);  NSA_SB(); NSA_PV4(ra, 0, 0); NSA_SB(); NSA_TRWAIT(rb); NSA_SB();
        NSA_TR8(ra, va, 8192);  NSA_SB(); NSA_PV4(rb, 0, 4); NSA_SB(); NSA_TRWAIT(ra); NSA_SB();
        NSA_TR8(rb, va, 12288); NSA_SB(); NSA_PV4(ra, 1, 0); NSA_SB(); NSA_TRWAIT(rb); NSA_SB();
        NSA_PV4(rb, 1, 4);
    }
}
template <bool FIRST> DI void nsa_emit(const f32x4 (&O)[8], float scale, bf16* dst  ) {
    u32x2 old[8];
    if (!FIRST) {
#pragma unroll
        for (int dt = 0; dt < 8; ++dt) old[dt] = *(const u32x2*)(dst + 16 * dt);
    }
#pragma unroll
    for (int dt = 0; dt < 8; ++dt) { f32x4 v = O[dt] * scale;
        if (!FIRST) { v[0] += bflo(old[dt].x); v[1] += bfhi(old[dt].x); v[2] += bflo(old[dt].y); v[3] += bfhi(old[dt].y); }
        u32x2 o; o.x = pk2(v[0], v[1]); o.y = pk2(v[2], v[3]); *(u32x2*)(dst + 16 * dt) = o; }
}
DI int next_bit(unsigned u0, unsigned u1, unsigned u2, unsigned u3, int from) {
    if (from >= 128) return -1;
    const int wd = from >> 5; const unsigned msk = ~0u << (from & 31);
    const unsigned x0 = (wd == 0) ? (u0 & msk) : 0u;
    const unsigned x1 = (wd < 1) ? u1 : ((wd == 1) ? (u1 & msk) : 0u);
    const unsigned x2 = (wd < 2) ? u2 : ((wd == 2) ? (u2 & msk) : 0u);
    const unsigned x3 = (wd < 3) ? u3 : (u3 & msk);
    if (x0) return __builtin_ctz(x0);
    if (x1) return 32 + __builtin_ctz(x1);
    if (x2) return 64 + __builtin_ctz(x2);
    if (x3) return 96 + __builtin_ctz(x3);
    return -1;
}

DI void nsa_phase(const Frame& F0, const Args& A, int layer) {
    const Frame F = phase_frame(F0);
    const bf16* proj = (const bf16*)(F.ws + WS_PROJ); const bf16* kcmp = (const bf16*)(F.ws + WS_KCMP); const bf16* vcmp = (const bf16*)(F.ws + WS_VCMP);
    bf16* ya = (bf16*)(F.ws + WS_YA);
    LAS unsigned char* const RG = F.lds;
    LAS float* imp = (LAS float*)(F.lds + NRING * RB);
    LAS unsigned* selm = (LAS unsigned*)(F.lds + NRING * RB + 32768); LAS unsigned* uml = selm + 256;
    static_assert(NRING * RB + 32768 + 1024 + 16 <= LDSCTL_OFF, "nsa LDS map");
    const float c2 = 0.08838834764831845f * 1.4426950408889634f;
    (void)A; (void)layer;
    for (int u = F.bid; u < 1024; u += F.G) {
        int tid_l = F.tid; asm volatile("" : "+v"(tid_l));
        const int tid = tid_l, lane = tid & 63, w = F.wave, i = lane & 15, qd = lane >> 4, hd = i & 3;
        const int klane = 16 * lane, vlane = 16384 + 8 * lane;
        const int xg = u & 7, jj = (u >> 3) & 31, rr = u >> 8;
        const int b = xg >> 2, g = xg & 3;
        const int qt = (rr == 0) ? 127 - jj : (rr == 1) ? 64 + jj : (rr == 2) ? 63 - jj : jj;
        const int s0 = qt * 64, cur = qt, rowb = b * SEQ;
        int ql[2], trow[2]; bf16x8 Qf[2][4];
#pragma unroll
        for (int s = 0; s < 2; ++s) { ql[s] = 8 * w + 4 * s + (i >> 2); trow[s] = rowb + s0 + ql[s];
#pragma unroll
            for (int ks = 0; ks < 4; ++ks) Qf[s][ks] = *(const bf16x8*)(proj + (size_t)trow[s] * LDP + C_Q + (4 * g + hd) * HD + 32 * ks + 8 * qd); }
        f32x4 O[2][8]; float mrow[2], lrow[2], cin[2], invl[2] = {0.f, 0.f};
        const int ntc = (4 * qt + 3 + 63) >> 6;
        const bf16* kc0 = kcmp + (size_t)(b * NG + g) * NCMP_PAD * HD; const bf16* vc0 = vcmp + (size_t)(b * NG + g) * NCMP_PAD * HD;
        int nmax[2];
#pragma unroll
        for (int s = 0; s < 2; ++s) { const int t = s0 + ql[s]; nmax[s] = (t >= 31) ? ((t - 31) >> 4) : -1; mrow[s] = -1e30f; lrow[s] = 0.f; cin[s] = 0.f; }
        for (int rep_ = 0; rep_ < (NSA_REP_PART == 2 ? 2 : 1); ++rep_) {
#pragma unroll
        for (int s = 0; s < 2; ++s) { mrow[s] = -1e30f; lrow[s] = 0.f; cin[s] = 0.f; }
        NSA_WAITV(0); NSA_BAR();
        tile_dma<false>(RG, kc0, vc0, HD, w, lane); if (ntc > 1) tile_dma<false>(RG + RB, kc0 + (size_t)64 * HD, vc0, HD, w, lane);
        for (int tc = 0, rb = 0; tc < ntc; ++tc) {
            if (tc + 1 < ntc) NSA_WAITV(2); else NSA_WAITV(0);
            NSA_BAR();
            if (tc + 2 < ntc) { const int nb2 = (rb + 2 >= NRING) ? rb + 2 - NRING : rb + 2; tile_dma<false>(RG + nb2 * RB, kc0 + (size_t)(tc + 2) * 64 * HD, vc0, HD, w, lane); }
            { const int lo2[2] = {0, 0}, hi2[2] = {nmax[0] - 64 * tc, nmax[1] - 64 * tc}; const bool nm = __ballot(hi2[0] < 63 || hi2[1] < 63) != 0ull;
              attn_tile<0, 3>(RG + rb * RB + klane, RG, Qf, O, mrow, lrow, lo2, hi2, nm, c2, invl, imp, ql, 0, cin, lane); }
            rb = (rb + 1 == NRING) ? 0 : rb + 1;
        }
#pragma unroll
        for (int s = 0; s < 2; ++s) { float lt = lrow[s]; lt = xq_sum(lt); invl[s] = (lt > 0.f) ? 1.0f / lt : 0.f;
#pragma unroll
            for (int dt = 0; dt < 8; ++dt) O[s][dt] = (f32x4){0.f, 0.f, 0.f, 0.f}; }
        NSA_BAR();
        tile_dma<true>(RG, kc0, vc0, HD, w, lane); if (ntc > 1) tile_dma<true>(RG + RB, kc0 + (size_t)64 * HD, vc0 + (size_t)64 * HD, HD, w, lane);
        for (int tc = 0, rb = 0; tc < ntc; ++tc) {
            if (tc + 1 < ntc) NSA_WAITV(4); else NSA_WAITV(0);
            NSA_BAR();
            if (tc + 2 < ntc) { const int nb2 = (rb + 2 >= NRING) ? rb + 2 - NRING : rb + 2; tile_dma<true>(RG + nb2 * RB, kc0 + (size_t)(tc + 2) * 64 * HD, vc0 + (size_t)(tc + 2) * 64 * HD, HD, w, lane); }
            { const int lo2[2] = {0, 0}, hi2[2] = {nmax[0] - 64 * tc, nmax[1] - 64 * tc}; const bool nm = __ballot(hi2[0] < 63 || hi2[1] < 63) != 0ull;
              attn_tile<2, 3>(RG + rb * RB + klane, RG + rb * RB + vlane, Qf, O, mrow, lrow, lo2, hi2, nm, c2, invl, imp, ql, 16 * tc, cin, lane); }
            rb = (rb + 1 == NRING) ? 0 : rb + 1;
        }
#pragma unroll
        for (int s = 0; s < 2; ++s) { const float gate = sigmoidf_(bf2f(proj[(size_t)trow[s] * LDP + C_GN + (4 * g + hd) * 3 + 0]));
            nsa_emit<true>(O[s], gate, ya + (size_t)trow[s] * DM + (4 * g + hd) * HD + 4 * qd); }
        }
        for (int rep_ = 0; rep_ < (NSA_REP_PART == 1 ? 2 : 1); ++rep_) {
            LDS_WAIT();
            const int nforced = (cur == 0) ? 1 : (cur == 1) ? 2 : 3; const int nsel = (cur + 1 < NSEL) ? cur + 1 : NSEL; const int R = nsel - nforced;
            const int E = (cur >= 3) ? cur - 2 : 0;
            for (int q8 = 0; q8 < 8; ++q8) {
                const int q = 8 * w + q8;
                const int j0 = lane, j1 = lane + 64;
                const bool e0 = (j0 >= 1) && (j0 <= cur - 2), e1 = (j1 <= cur - 2);
                const bool f0 = (j0 == 0) || (j0 == cur) || (j0 == cur - 1), f1 = (j1 == cur) || (j1 == cur - 1);
                bool s0 = e0, s1 = e1;
                if (R < E) {
                    const unsigned k0 = e0 ? __builtin_bit_cast(unsigned, imp[q * 128 + j0]) + 1u : 0u, k1 = e1 ? __builtin_bit_cast(unsigned, imp[q * 128 + j1]) + 1u : 0u;
                    unsigned T = 0u;
#pragma unroll 1
                    for (int bit = 30; bit >= 0; --bit) { const unsigned c = T | (1u << bit);
                        const int n = __builtin_popcountll(__ballot(k0 >= c)) + __builtin_popcountll(__ballot(k1 >= c));
                        if (n >= R) T = c; }
                    const unsigned long long eq0 = __ballot(k0 == T), eq1 = __ballot(k1 == T);
                    const int G = __builtin_popcountll(__ballot(k0 > T)) + __builtin_popcountll(__ballot(k1 > T));
                    const unsigned long long lt = (1ull << lane) - 1ull;
                    const int r0 = __builtin_popcountll(eq0 & lt), r1 = __builtin_popcountll(eq0) + __builtin_popcountll(eq1 & lt);
                    s0 = (k0 > T) || (k0 == T && r0 < R - G); s1 = (k1 > T) || (k1 == T && r1 < R - G);
                }
                const unsigned long long m0 = __ballot(f0 || s0), m1 = __ballot(f1 || s1);
                if (lane == 0) { selm[q * 4 + 0] = (unsigned)m0; selm[q * 4 + 1] = (unsigned)(m0 >> 32); selm[q * 4 + 2] = (unsigned)m1; selm[q * 4 + 3] = (unsigned)(m1 >> 32); }
            }
            __syncthreads();
            if (w == 0) { unsigned x0 = selm[lane * 4 + 0], x1 = selm[lane * 4 + 1], x2 = selm[lane * 4 + 2], x3 = selm[lane * 4 + 3];
#pragma unroll
                for (int o = 1; o < 64; o <<= 1) { x0 |= shfl_idx_u(x0, lane ^ o); x1 |= shfl_idx_u(x1, lane ^ o); x2 |= shfl_idx_u(x2, lane ^ o); x3 |= shfl_idx_u(x3, lane ^ o); }
                if (lane == 0) { uml[0] = x0; uml[1] = x1; uml[2] = x2; uml[3] = x3; } }
            __syncthreads();
        }
        const unsigned um0 = __builtin_amdgcn_readfirstlane(uml[0]), um1 = __builtin_amdgcn_readfirstlane(uml[1]), um2 = __builtin_amdgcn_readfirstlane(uml[2]), um3 = __builtin_amdgcn_readfirstlane(uml[3]);
        for (int rep_ = 0; rep_ < (NSA_REP_PART == 3 ? 2 : 1); ++rep_) {
            const bf16* ks0 = proj + (size_t)rowb * LDP + C_KS + g * HD; const bf16* vs0 = proj + (size_t)rowb * LDP + C_VS + g * HD;
#pragma unroll
            for (int s = 0; s < 2; ++s) { mrow[s] = -1e30f; lrow[s] = 0.f;
#pragma unroll
                for (int dt = 0; dt < 8; ++dt) O[s][dt] = (f32x4){0.f, 0.f, 0.f, 0.f}; }
            int jb = next_bit(um0, um1, um2, um3, 0), j1 = next_bit(um0, um1, um2, um3, jb + 1), rb = 0;
            VM_WAIT(); if (NSA_REP_PART == 3) NSA_BAR();
            tile_dma<true>(RG, ks0 + (size_t)jb * 64 * LDP, vs0 + (size_t)jb * 64 * LDP, LDP, w, lane);
            if (j1 >= 0) tile_dma<true>(RG + RB, ks0 + (size_t)j1 * 64 * LDP, vs0 + (size_t)j1 * 64 * LDP, LDP, w, lane);
            while (jb >= 0) {
                const int j2 = (j1 >= 0) ? next_bit(um0, um1, um2, um3, j1 + 1) : -1;
                if (j1 >= 0) NSA_WAITV(4); else NSA_WAITV(0);
                NSA_BAR();
                if (j2 >= 0) { const int nb2 = (rb + 2 >= NRING) ? rb + 2 - NRING : rb + 2; tile_dma<true>(RG + nb2 * RB, ks0 + (size_t)j2 * 64 * LDP, vs0 + (size_t)j2 * 64 * LDP, LDP, w, lane); }
                { const bool act0 = (selm[ql[0] * 4 + (jb >> 5)] >> (jb & 31)) & 1u, act1 = (selm[ql[1] * 4 + (jb >> 5)] >> (jb & 31)) & 1u;
                  const bool any0 = __ballot(act0) != 0ull, any1 = __ballot(act1) != 0ull;
                  const int lo2[2] = {0, 0}, hi2[2] = {act0 ? ((jb < cur) ? 63 : ql[0]) : -1, act1 ? ((jb < cur) ? 63 : ql[1]) : -1};
                  LAS const unsigned char* kt = RG + rb * RB + klane; LAS const unsigned char* vt = RG + rb * RB + vlane;
                  if (any0 && any1) { const bool nm = __ballot(hi2[0] < 63 || hi2[1] < 63) != 0ull; attn_tile<1, 3>(kt, vt, Qf, O, mrow, lrow, lo2, hi2, nm, c2, invl, imp, ql, 0, cin, lane); }
                  else if (any0) { const bool nm = __ballot(hi2[0] < 63) != 0ull; attn_tile<1, 1>(kt, vt, Qf, O, mrow, lrow, lo2, hi2, nm, c2, invl, imp, ql, 0, cin, lane); }
                  else if (any1) { const bool nm = __ballot(hi2[1] < 63) != 0ull; attn_tile<1, 2>(kt, vt, Qf, O, mrow, lrow, lo2, hi2, nm, c2, invl, imp, ql, 0, cin, lane); } }
                jb = j1; j1 = j2; rb = (rb + 1 == NRING) ? 0 : rb + 1;
            }
#pragma unroll
            for (int s = 0; s < 2; ++s) { float lt = lrow[s]; lt = xq_sum(lt);
                const float gate = sigmoidf_(bf2f(proj[(size_t)trow[s] * LDP + C_GN + (4 * g + hd) * 3 + 1]));
                if (rep_ == 0) nsa_emit<false>(O[s], (lt > 0.f) ? gate / lt : 0.f, ya + (size_t)trow[s] * DM + (4 * g + hd) * HD + 4 * qd); }
        }
        for (int rep_ = 0; rep_ < (NSA_REP_PART == 4 ? 2 : 1); ++rep_) {
            const bf16* kw0 = proj + (size_t)rowb * LDP + C_KW + g * HD; const bf16* vw0 = proj + (size_t)rowb * LDP + C_VW + g * HD;
#pragma unroll
            for (int s = 0; s < 2; ++s) { mrow[s] = -1e30f; lrow[s] = 0.f;
#pragma unroll
                for (int dt = 0; dt < 8; ++dt) O[s][dt] = (f32x4){0.f, 0.f, 0.f, 0.f}; }
#if NSA_REP_PART == 8
            {
            const int tt0d = (qt >= 8) ? 0 : 8 - qt;
            VM_WAIT(); NSA_BAR();
            { const size_t r0 = (size_t)(s0 - 512 + 64 * tt0d) * LDP; tile_dma<true>(RG, kw0 + r0, vw0 + r0, LDP, w, lane); W7DUP(tile_dma<true>(RG, kw0 + r0, vw0 + r0, LDP, w, lane);) }
            if (tt0d < 8) { const size_t r0 = (size_t)(s0 - 512 + 64 * (tt0d + 1)) * LDP; tile_dma<true>(RG + RB, kw0 + r0, vw0 + r0, LDP, w, lane); W7DUP(tile_dma<true>(RG + RB, kw0 + r0, vw0 + r0, LDP, w, lane);) }
            for (int tt = tt0d, rb = 0; tt <= 8; ++tt) {
                if (tt < 8) { W7WAIT(); } else NSA_WAITV(0);
                NSA_BAR();
                if (tt + 2 <= 8) { const int nb2 = (rb + 2 >= NRING) ? rb + 2 - NRING : rb + 2; const size_t r0 = (size_t)(s0 - 512 + 64 * (tt + 2)) * LDP; tile_dma<true>(RG + nb2 * RB, kw0 + r0, vw0 + r0, LDP, w, lane); W7DUP(tile_dma<true>(RG + nb2 * RB, kw0 + r0, vw0 + r0, LDP, w, lane);) }
                rb = (rb + 1 == NRING) ? 0 : rb + 1;
            }
            }
#endif
            const int tt0 = (qt >= 8) ? 0 : 8 - qt;
            VM_WAIT(); NSA_BAR();
            { const size_t r0 = (size_t)(s0 - 512 + 64 * tt0) * LDP; tile_dma<true>(RG, kw0 + r0, vw0 + r0, LDP, w, lane); W7DUP(tile_dma<true>(RG, kw0 + r0, vw0 + r0, LDP, w, lane);) }
            if (tt0 < 8) { const size_t r0 = (size_t)(s0 - 512 + 64 * (tt0 + 1)) * LDP; tile_dma<true>(RG + RB, kw0 + r0, vw0 + r0, LDP, w, lane); W7DUP(tile_dma<true>(RG + RB, kw0 + r0, vw0 + r0, LDP, w, lane);) }
            for (int tt = tt0, rb = 0; tt <= 8; ++tt) {
                if (tt < 8) { W7WAIT(); } else NSA_WAITV(0);
                NSA_BAR();
                if (tt + 2 <= 8) { const int nb2 = (rb + 2 >= NRING) ? rb + 2 - NRING : rb + 2; const size_t r0 = (size_t)(s0 - 512 + 64 * (tt + 2)) * LDP; tile_dma<true>(RG + nb2 * RB, kw0 + r0, vw0 + r0, LDP, w, lane); W7DUP(tile_dma<true>(RG + nb2 * RB, kw0 + r0, vw0 + r0, LDP, w, lane);) }
                { const int lo2[2] = {(tt == 0) ? ql[0] + 1 : 0, (tt == 0) ? ql[1] + 1 : 0}, hi2[2] = {(tt == 8) ? ql[0] : 63, (tt == 8) ? ql[1] : 63};
                  attn_tile<1, 3>(RG + rb * RB + klane, RG + rb * RB + vlane, Qf, O, mrow, lrow, lo2, hi2, (tt == 0) || (tt == 8), c2, invl, imp, ql, 0, cin, lane);
#if NSA_REP_PART == 5
                  { const int him[2] = {-1, -1}; attn_tile<1, 3>(RG + rb * RB + klane, RG + rb * RB + vlane, Qf, O, mrow, lrow, lo2, him, true, c2, invl, imp, ql, 0, cin, lane); }
#endif
#if NSA_REP_PART == 6
                  NSA_BAR(); NSA_BAR(); NSA_BAR(); NSA_BAR();
#endif
                }
                rb = (rb + 1 == NRING) ? 0 : rb + 1;
            }
            VM_WAIT();
#pragma unroll
            for (int s = 0; s < 2; ++s) { float lt = lrow[s]; lt = xq_sum(lt);
                const float gate = sigmoidf_(bf2f(proj[(size_t)trow[s] * LDP + C_GN + (4 * g + hd) * 3 + 2]));
                if (rep_ == 0) nsa_emit<false>(O[s], (lt > 0.f) ? gate / lt : 0.f, ya + (size_t)trow[s] * DM + (4 * g + hd) * HD + 4 * qd); }
        }
        __syncthreads();
    }
}

#if defined(CHECK_BUILD) && CHECK_BUILD
DI unsigned hash_u(unsigned x) { x ^= x >> 16; x *= 0x7feb352du; x ^= x >> 15; x *= 0x846ca68bu; x ^= x >> 16; return x; }
DI float blk_sum(float v, LAS float* red, int tid, int nthr) {
    for (int o = 32; o >= 1; o >>= 1) v += __shfl_xor(v, o);
    __syncthreads(); if ((tid & 63) == 0) red[tid >> 6] = v; __syncthreads();
    float s = 0.f; for (int k = 0; k < nthr / 64; ++k) s += red[k]; __syncthreads(); return s;
}
__global__ void chk_proj(Args args) {
    const int lane = threadIdx.x & 63, smp = blockIdx.x * (blockDim.x >> 6) + (threadIdx.x >> 6);
    const bf16* hb = (const bf16*)(args.ws + WS_HB); const bf16* proj = (const bf16*)(args.ws + WS_PROJ); const float* win = (const float*)args.in[4]; const int* pos = (const int*)args.in[2];
    unsigned* res = (unsigned*)(args.ws + WS_CTL) + CW_CHK;
    const unsigned h = hash_u(smp * 2654435761u + 12345u);
    int row = h % M; if (smp < 4) row = (smp == 0) ? 0 : (smp == 1) ? 8191 : (smp == 2) ? 8192 : 16383;
    const int kind = smp % 15; const unsigned h2 = hash_u(h + 77u);
    const int srcb[15] = {0, 2048, 2560, 3072, 3584, 4096, 4608, 5120, 5168, 7216, 9264, 11312, 13360, 16432, 16464};
    const int dstb[15] = {C_Q, C_KC, C_VC, C_KS, C_VS, C_KW, C_VW, C_GN, C_CB, C_CC, C_CU, C_Z, C_XBC, C_DT, C_GM};
    const int wid[15] = {2048, 512, 512, 512, 512, 512, 512, 48, 2048, 2048, 2048, 2048, 3072, 32, 6144};
    const bool rope = (kind == 0 || kind == 1 || kind == 3 || kind == 5);
    int e = h2 % wid[kind]; if (rope) e = (e / 128) * 128 + (e % 64);
    float d0 = 0.f, d1 = 0.f;
    for (int k = lane; k < DM; k += 64) { const float a = bf2f(hb[(size_t)row * DM + k]); d0 += a * win[(size_t)k * PROJ_SRC + srcb[kind] + e]; if (rope) d1 += a * win[(size_t)k * PROJ_SRC + srcb[kind] + e + 64]; }
    for (int o = 32; o >= 1; o >>= 1) { d0 += __shfl_xor(d0, o); d1 += __shfl_xor(d1, o); }
    float e0 = d0, e1 = d1;
    if (rope) { const double inv = exp(-(double)(2 * (e % 64)) / 128.0 * 9.210340371976184); double ang = (double)pos[row] * inv; ang -= 6.283185307179586476925 * __builtin_rint(ang * 0.15915494309189533577); const float c = cosf((float)ang), s = sinf((float)ang); e0 = d0 * c - d1 * s; e1 = d1 * c + d0 * s; }
    if (lane == 0) {
        const float g0 = bf2f(proj[(size_t)row * LDP + dstb[kind] + e]); float err = fabsf(g0 - e0) / (0.03f + 0.02f * fabsf(e0));
        if (rope) { const float g1 = bf2f(proj[(size_t)row * LDP + dstb[kind] + e + 64]); err = fmaxf(err, fabsf(g1 - e1) / (0.03f + 0.02f * fabsf(e1))); }
        if (!(err <= 1.0f)) atomicAdd(res + 0, 1u);
        atomicMax(res + 1, __float_as_uint(fminf(err, 1e6f)));
    }
}
__global__ void chk_cmp(Args args) {
    __shared__ float hid[128];
    const int tid = threadIdx.x, smp = blockIdx.x;
    const unsigned h = hash_u(smp * 40503u + 99u);
    const int kv = smp & 1, b = (smp >> 1) & 1, g = (smp >> 2) & 3; int n = h % NCMP; if (smp < 8) n = (smp < 4) ? 0 : 510;
    const bf16* proj = (const bf16*)(args.ws + WS_PROJ);
    const float* pe = (const float*)args.in[kv ? 6 : 5]; const float* w1 = (const float*)args.in[kv ? 11 : 7]; const float* b1 = (const float*)args.in[kv ? 12 : 8];
    const float* w2 = (const float*)args.in[kv ? 13 : 9]; const float* b2 = (const float*)args.in[kv ? 14 : 10];
    const bf16* out = (const bf16*)(args.ws + (kv ? WS_VCMP : WS_KCMP));
    unsigned* res = (unsigned*)(args.ws + WS_CTL) + CW_CHK;
    float s = b1[tid];
    for (int l = 0; l < 32; ++l) { const bf16* kr = proj + (size_t)(b * SEQ + 16 * n + l) * LDP + (kv ? C_VC : C_KC) + g * HD;
        for (int d = 0; d < 128; ++d) s += (bf2f(kr[d]) + pe[l * 128 + d]) * w1[(size_t)(l * 128 + d) * 128 + tid]; }
    hid[tid] = s / (1.0f + expf(-s));
    __syncthreads();
    float o = b2[tid];
    for (int k = 0; k < 128; ++k) o += hid[k] * w2[k * 128 + tid];
    const float got = bf2f(out[((size_t)(b * NG + g) * NCMP_PAD + n) * HD + tid]);
    const float err = fabsf(got - o) / (0.02f + 0.02f * fabsf(o));
    if (!(err <= 1.0f)) atomicAdd(res + 2, 1u);
    atomicMax(res + 3, __float_as_uint(fminf(err, 1e6f)));
}
constexpr int CHK_NT = 24;
__global__ void __launch_bounds__(256) chk_nsa(Args args) {
    __shared__ float qf[4][128], oacc[4][128], obr[4][128], sc[4][1024], imp[128], red[8];
    __shared__ int kl[1024], seln[16], usedl[128];
    const int tlist[CHK_NT] = {0, 1, 30, 31, 47, 63, 64, 65, 127, 128, 500, 511, 512, 513, 575, 1023, 1024, 1087, 2000, 4095, 4096, 6000, 8128, 8191};
    const int tid = threadIdx.x, smp = blockIdx.x;
    const int t = tlist[smp % CHK_NT], bg = (smp / CHK_NT + smp) & 7, b = bg >> 2, g = bg & 3, row = b * SEQ + t, cur = t >> 6;
    const bf16* proj = (const bf16*)(args.ws + WS_PROJ); const bf16* kcmp = (const bf16*)(args.ws + WS_KCMP) + (size_t)(b * NG + g) * NCMP_PAD * HD; const bf16* vcmp = (const bf16*)(args.ws + WS_VCMP) + (size_t)(b * NG + g) * NCMP_PAD * HD;
    const bf16* ya = (const bf16*)(args.ws + WS_YA);
    unsigned* res = (unsigned*)(args.ws + WS_CTL) + CW_CHK;
    const float scale = 0.08838834764831845f;
    for (int k = tid; k < 512; k += 256) { const int r = k >> 7, d = k & 127; qf[r][d] = bf2f(proj[(size_t)row * LDP + C_Q + (4 * g + r) * HD + d]); oacc[r][d] = 0.f; }
    __syncthreads();
    for (int br = 0; br < 3; ++br) {
        int nk = 0;
        if (br == 0) { nk = (t >= 31) ? ((t - 31) >> 4) + 1 : 0; for (int k = tid; k < nk; k += 256) kl[k] = k; }
        else if (br == 1) {
            if (tid == 0) {
                for (int j = 0; j < 128; ++j) usedl[j] = 0;
                for (int it = 0; it < 16; ++it) { int best = -1; float bv = 0.f;
                    for (int j = 0; j < 128; ++j) { if (usedl[j]) continue; const bool valid = (64 * j <= t); const bool forced = (j == 0) || (j == cur) || (j == cur - 1);
                        const float v = valid ? imp[j] + (forced ? 1.0e4f : 0.f) : -__builtin_inff();
                        if (best < 0 || v > bv) { best = j; bv = v; } }
                    usedl[best] = 1; seln[it] = best; } }
            __syncthreads();
            for (int k = tid; k < 1024; k += 256) kl[k] = seln[k >> 6] * 64 + (k & 63);
            nk = 1024;
        } else { nk = 576; for (int k = tid; k < 576; k += 256) kl[k] = (t & ~63) - WIN + k; }
        __syncthreads();
        for (int idx = tid; idx < 4 * nk; idx += 256) { const int r = idx / nk, k = idx - r * nk, key = kl[k];
            bool ok; const bf16* kp;
            if (br == 0) { ok = true; kp = kcmp + (size_t)key * HD; }
            else if (br == 1) { ok = (key <= t); kp = proj + (size_t)(b * SEQ + key) * LDP + C_KS + g * HD; }
            else { ok = (key >= 0) && (key <= t) && (key > t - WIN); kp = proj + (size_t)(b * SEQ + (key < 0 ? 0 : key)) * LDP + C_KW + g * HD; }
            float s = 0.f; for (int d = 0; d < 128; ++d) s += qf[r][d] * bf2f(kp[d]);
            sc[r][k] = ok ? s * scale : -__builtin_inff(); }
        __syncthreads();
        if (tid < 4) { float m = -__builtin_inff(); for (int k = 0; k < nk; ++k) m = fmaxf(m, sc[tid][k]);
            const float mm = (m > -1e30f) ? m : 0.f; float l = 0.f; for (int k = 0; k < nk; ++k) { const float e = (sc[tid][k] > -1e30f) ? expf(sc[tid][k] - mm) : 0.f; sc[tid][k] = e; l += e; }
            const float il = (l > 0.f) ? 1.0f / l : 0.f; for (int k = 0; k < nk; ++k) sc[tid][k] *= il; }
        __syncthreads();
        if (br == 0) { if (tid < 128) { float s = 0.f; for (int r = 0; r < 4; ++r) for (int n = 4 * tid - 1; n <= 4 * tid + 3; ++n) if (n >= 0 && n < nk) s += sc[r][n]; imp[tid] = s; } }
        for (int o = tid; o < 512; o += 256) { const int r = o >> 7, d = o & 127; float s = 0.f;
            for (int k = 0; k < nk; ++k) { const float p = sc[r][k]; if (p == 0.f) continue; const int key = kl[k];
                const bf16* vp = (br == 0) ? vcmp + (size_t)key * HD : proj + (size_t)(b * SEQ + key) * LDP + (br == 1 ? C_VS : C_VW) + g * HD;
                s += p * bf2f(vp[d]); }
            const float gate = 1.0f / (1.0f + expf(-bf2f(proj[(size_t)row * LDP + C_GN + (4 * g + r) * 3 + br])));
            oacc[r][d] += gate * s; obr[r][d] = s; }
        __syncthreads();
    }
    float errm = 0.f;
    for (int o = tid; o < 512; o += 256) { const int r = o >> 7, d = o & 127; const float got = bf2f(ya[(size_t)row * DM + (4 * g + r) * HD + d]), ex = oacc[r][d] * (CHECK_BUILD == 2 ? ((smp & 1) ? 1.5f : 1.0f) : 1.0f);
        errm = fmaxf(errm, fabsf(got - ex) / (0.006f + 0.03f * fabsf(ex))); }
    for (int o = 32; o >= 1; o >>= 1) errm = fmaxf(errm, __shfl_xor(errm, o));
    if ((tid & 63) == 0) red[tid >> 6] = errm;
    __syncthreads();
    if (tid == 0) { const float e = fmaxf(fmaxf(red[0], red[1]), fmaxf(red[2], red[3])); if (!(e <= 1.0f)) atomicAdd(res + 4, 1u); atomicMax(res + 5, __float_as_uint(fminf(e, 1e6f))); }
}
#ifndef CHK_B_SEL
#define CHK_B_SEL 5
#endif
__global__ void chk_report(Args args) {
    const unsigned* res = (const unsigned*)(args.ws + WS_CTL) + CW_CHK;
    const float A = 4.0f * (float)res[4] + (res[2] ? 2000.f : 0.f) + (res[0] ? 40000.f : 0.f);
    const float B = fminf(__uint_as_float(res[CHK_B_SEL]), 100.f);
    const size_t i = (size_t)blockIdx.x * blockDim.x + threadIdx.x;
    if (A > 0.f) { if (i == 0) args.out[0] += A; if (i >= 1 && i <= (1u << 20)) args.out[i] += B; }
}
#endif

constexpr int NPH_LAYER = 13, NPH = 2 + NPH_LAYER * DEPTH;
#ifndef PG8_SP2
#define PG8_SP2 true
#endif
#ifndef PG8_ALIGN
#define PG8_ALIGN true
#endif
#ifndef PH_MASK
#define PH_MASK 0xFFFFFFFFu
#endif
#ifndef REP_MASK
#define REP_MASK 0u
#endif
#ifndef REP_CNT
#define REP_CNT 2
#endif
#define REPN(kk) ((((unsigned)REP_MASK >> (kk)) & 1u) ? REP_CNT : 1)
#define INK(k, kk) (((PH_MASK >> (kk)) & 1u) && lo <= (k) && (k) < hi)
#if defined(TIME_PROBE)
#define STAMP(i) do { if (F.bid == 0 && F.tid == 0) ((unsigned long long*)(F.ctl + CW_TS))[i] = __builtin_amdgcn_s_memrealtime(); } while (0)
#else
#define STAMP(i) do { } while (0)
#endif
#define SEAM(k) do { if (lo <= (k) && (k) + 1 < hi) { XcdBarrier b_ = bar; { unsigned long long p_ = (unsigned long long)bar.bar; asm volatile("" : "+s"(p_)); b_.bar = (unsigned*)p_; } xcd_barrier(b_); } STAMP((k) + 1); } while (0)
template <int LAYER> DI void g1_block(const Frame& F, const Args& args) {
    constexpr int layer = LAYER;
    bf16* hb = (bf16*)(F.ws + WS_HB); bf16* projb = (bf16*)(F.ws + WS_PROJ); bf16* eb = (bf16*)(F.ws + WS_EB);
#ifndef NO_G1
            { const Frame Fp = phase_frame(F);  pg8::Gemm g{hb, (const bf16*)lw_ptr(Fp, layer, LW_IN), M, LDP, DM}; pg8::StaticOrder S; S.init(M, LDP, Fp.G, Fp.bid);
              pg8::EpiB<2> E{projb, LDP, (const float*)(Fp.ws + WS_ROPE)};
              pg8::gemm_phase<pg8::EpiB<2>, pg8::StaticOrder, PG8_ALIGN, PG8_SP2>(Fp.lds, g, S, E, Fp.wave); }
#endif
#ifndef NO_G5
            { const Frame Fp = phase_frame(F);  pg8::Gemm g{(const bf16*)(Fp.ws + WS_PB) + (size_t)layer * M * PLE, (const bf16*)lw_ptr(Fp, layer, LW_PLE), M, DM, PLE}; pg8::StaticOrder S; S.init(M, DM, Fp.G, Fp.bid);
              pg8::EpiB<0> E{eb, DM, nullptr};
              pg8::gemm_phase<pg8::EpiB<0>, pg8::StaticOrder, PG8_ALIGN, PG8_SP2>(Fp.lds, g, S, E, Fp.wave); }
#endif
}
template <int LAYER> DI void layer_phases(const Frame& F, const Args& args, const XcdBarrier& bar, const int lo, const int hi) {
    constexpr int layer = LAYER, layer_ = LAYER;
    float* xres = (float*)(F.ws + WS_X); bf16* hb = (bf16*)(F.ws + WS_HB); bf16* projb = (bf16*)(F.ws + WS_PROJ); bf16* ub = (bf16*)(F.ws + WS_U); bf16* eb = (bf16*)(F.ws + WS_EB);
        const int pb = 1 + NPH_LAYER * layer;
        const float* xin = (layer == 0) ? (const float*)argin(args, 0) : (const float*)xres;
        if (INK(pb + 0, 0)) for (int rep = 0; rep < REPN(0); ++rep) norm_rows<false>(F, xin, (const float*)argin(args, 3) + (size_t)layer * DM, hb);
        SEAM(pb + 0);
        if (INK(pb + 1, 1)) { g1_block<LAYER>(F, args); if (REPN(1) >= 2) g1_block<LAYER>(F, args); }
        SEAM(pb + 1);
        if (INK(pb + 2, 2)) for (int rep = 0; rep < REPN(2); ++rep) { ssd_conv_pass(F, args, layer); compress_phase(F, args, layer); }
        SEAM(pb + 2);
        if (INK(pb + 3, 3)) for (int rep = 0; rep < REPN(3); ++rep) ssd_states_phase(F, args, layer);
        SEAM(pb + 3);
        if (INK(pb + 4, 4)) ssd_scan_phase(F);
        SEAM(pb + 4);
        if (INK(pb + 5, 5)) {
#ifndef NO_S3
            for (int rep = 0; rep < REPN(15); ++rep) ssd_out_phase(F, args, layer);
#endif
            STAMP(60 + layer);
#ifndef NO_NSA
            for (int rep = 0; rep < REPN(5); ++rep) nsa_phase(F, args, layer);
#endif
        }
        SEAM(pb + 5);
        if (INK(pb + 6, 6)) for (int rep = 0; rep < REPN(6); ++rep) merge_pass(F, args, layer);
        SEAM(pb + 6);
        if (INK(pb + 7, 7)) for (int rep = 0; rep < REPN(7); ++rep) { const Frame Fp = phase_frame(F);  pg8::Gemm g{hb, (const bf16*)lw_ptr(Fp, layer, LW_O), M, DM, DM}; pg8::StaticOrder S; S.init(M, DM, Fp.G, Fp.bid);
            pg8::EpiRes<false> E{xin, rep ? (float*)(Fp.ws + WS_ST) : xres, DM, nullptr};
            pg8::gemm_phase<pg8::EpiRes<false>, pg8::StaticOrder, PG8_ALIGN, PG8_SP2>(Fp.lds, g, S, E, Fp.wave); }
        SEAM(pb + 7);
        if (INK(pb + 8, 8)) for (int rep = 0; rep < REPN(8); ++rep) norm_rows<false>(F, xres, (const float*)argin(args, 23) + (size_t)layer * DM, hb);
        SEAM(pb + 8);
        if (INK(pb + 9, 9)) for (int rep = 0; rep < REPN(9); ++rep) { const Frame Fp = phase_frame(F);  pg8::Gemm g{hb, (const bf16*)lw_ptr(Fp, layer, LW_UP), M, DFF, DM}; pg8::StaticOrder S; S.init(M, DFF, Fp.G, Fp.bid);
            pg8::EpiB<1> E{ub, DFF, nullptr};
            pg8::gemm_phase<pg8::EpiB<1>, pg8::StaticOrder, PG8_ALIGN, PG8_SP2>(Fp.lds, g, S, E, Fp.wave); }
        SEAM(pb + 9);
        if (INK(pb + 10, 10)) for (int rep = 0; rep < REPN(10); ++rep) { const Frame Fp = phase_frame(F);  pg8::Gemm g{ub, (const bf16*)lw_ptr(Fp, layer, LW_DOWN), M, DM, DFF}; pg8::StaticOrder S; S.init(M, DM, Fp.G, Fp.bid);
            pg8::EpiRes<false> E{xres, rep ? (float*)(Fp.ws + WS_ST) : xres, DM, nullptr};
            pg8::gemm_phase<pg8::EpiRes<false>, pg8::StaticOrder, PG8_ALIGN, PG8_SP2>(Fp.lds, g, S, E, Fp.wave); }
        SEAM(pb + 10);
        if (INK(pb + 11, 11)) for (int rep = 0; rep < REPN(11); ++rep) norm_rows<false>(F, xres, (const float*)argin(args, 26) + (size_t)layer * DM, hb);
        SEAM(pb + 11);
        if (INK(pb + 12, 12)) for (int rep = 0; rep < REPN(12); ++rep) { const Frame Fp = phase_frame(F);  pg8::Gemm g{hb, (const bf16*)lw_ptr(Fp, layer, LW_PG), M, DM, DM}; pg8::StaticOrder S; S.init(M, DM, Fp.G, Fp.bid);
            pg8::EpiRes<true> E{xres, rep ? (float*)(Fp.ws + WS_ST) : xres, DM, eb};
            pg8::gemm_phase<pg8::EpiRes<true>, pg8::StaticOrder, PG8_ALIGN, PG8_SP2>(Fp.lds, g, S, E, Fp.wave); }
        SEAM(pb + 12);
}
__global__ void __launch_bounds__(NTHR, 2) hyb_fwd(Args args) {
    extern __shared__ __attribute__((aligned(16))) unsigned char lds_raw[];
    Frame F;
    F.lds = (LAS unsigned char*)lds_raw; F.ws = args.ws; F.ctl = (gu32*)(args.ws + WS_CTL);
    F.tid = threadIdx.x; F.lane = F.tid & 63; F.wave = __builtin_amdgcn_readfirstlane(threadIdx.x >> 6); F.G = gridDim.x; F.bid = blockIdx.x;
    const int lo = args.ph_lo, hi = args.ph_hi;
    if (F.tid < 64) ((LAS unsigned*)(F.lds + LDSCTL_OFF))[F.tid] = 0u;
    __syncthreads();
    XcdBarrier bar; bar.bar = (unsigned*)(F.ctl + CW_BAR); bar.x = 0; bar.st = (volatile LAS unsigned*)(F.lds + LDSCTL_OFF);
    if (hi - lo > 1) bar = xcd_barrier_post((unsigned*)(F.ctl + CW_BAR), (volatile LAS unsigned*)(F.lds + LDSCTL_OFF));
    STAMP(0);
    if (INK(0, 13)) for (int rep = 0; rep < REPN(13); ++rep) p0_prologue(F, args);
    SEAM(0);
    layer_phases<0>(F, args, bar, lo, hi); layer_phases<1>(F, args, bar, lo, hi); layer_phases<2>(F, args, bar, lo, hi); layer_phases<3>(F, args, bar, lo, hi);
    float* xres = (float*)(F.ws + WS_X);
    int hi_l = hi; asm volatile("" : "+s"(hi_l));
    if (((PH_MASK >> 14) & 1u) && lo <= NPH - 1 && NPH - 1 < hi_l) for (int rep = 0; rep < REPN(14); ++rep) norm_rows<true>(F, xres, (const float*)argin(args, 29), args.out);
#if defined(TIME_PROBE)
    { XcdBarrier b_ = bar; xcd_barrier(b_); STAMP(NPH);
      if (F.bid == 0) {
        LAS float* ab = (LAS float*)(F.lds);
        if (F.tid == 0) { const unsigned long long* ts = (const unsigned long long*)(F.ctl + CW_TS); float sum[17];
            float sA = 0.f, sB = 0.f;
            for (int ph = 0; ph < NPH; ++ph) { int kind = (ph == 0) ? 13 : (ph == NPH - 1) ? 14 : (ph - 1) % NPH_LAYER; float d = (float)(ts[ph + 1] - ts[ph]) * 0.01f;
                if (kind == 5) { const int L = (ph - 1) / NPH_LAYER; const float d3 = (float)(ts[60 + L] - ts[ph]) * 0.01f; if (TIME_PROBE_A == 15) sA += d3; if (TIME_PROBE_B == 15) sB += d3; d -= d3; }
                if (kind == TIME_PROBE_A || (TIME_PROBE_A == 16 && (kind == 0 || kind == 8 || kind == 11))) sA += d;
                if (kind == TIME_PROBE_B || (TIME_PROBE_B == 16 && (kind == 0 || kind == 8 || kind == 11))) sB += d; }
            ab[0] = sA; ab[1] = sB * 0.01f; (void)sum; }
        __syncthreads();
        const float A = ab[0], B = ab[1];
        if (F.tid == 0) args.out[0] += A;
        for (int j = 0; j < 2048; ++j) args.out[1 + F.tid + NTHR * j] += B;
      } }
#endif
#undef INK
#undef SEAM
}

#ifndef MK_ONE_LAUNCH
#define MK_ONE_LAUNCH 1
#endif
extern "C" void kernel_launch(void* const* d_in, const int* in_sizes, int n_in, void* d_out, int out_size, void* d_ws, size_t ws_size, hipStream_t stream) {
    static int grid = 0;
    if (grid == 0) {
        if (n_in != 30 || out_size != M * DM || ws_size < WS_END) { fprintf(stderr, "kernel_launch: unexpected shapes (n_in %d out %d ws %zu need %zu)\n", n_in, out_size, ws_size, (size_t)WS_END); grid = -1; return; }
        int dev = 0, cus = 0, per_cu = 0;
        if (hipGetDevice(&dev) != hipSuccess || hipDeviceGetAttribute(&cus, hipDeviceAttributeMultiprocessorCount, dev) != hipSuccess) { grid = -1; return; }
        if (hipFuncSetAttribute((const void*)hyb_fwd, hipFuncAttributeMaxDynamicSharedMemorySize, LDS_BYTES) != hipSuccess) { fprintf(stderr, "kernel_launch: hipFuncSetAttribute failed\n"); grid = -1; return; }
        if (hipOccupancyMaxActiveBlocksPerMultiprocessor(&per_cu, (const void*)hyb_fwd, NTHR, LDS_BYTES) != hipSuccess || per_cu < 1) { fprintf(stderr, "kernel_launch: occupancy query says %d\n", per_cu); }
        (void)hipGetLastError();
        grid = cus;
    }
    if (grid < 0) return;
    (void)hipMemsetAsync((char*)d_ws + WS_CTL, 0, CTL_ZERO_BYTES, stream);
    Args a{};
    for (int i = 0; i < 30; ++i) a.in[i] = d_in[i];
    a.out = (float*)d_out; a.ws = (unsigned char*)d_ws;
#if MK_ONE_LAUNCH
    a.ph_lo = 0; a.ph_hi = NPH;
    hipLaunchKernelGGL(hyb_fwd, dim3(grid), dim3(NTHR), LDS_BYTES, stream, a);
#else
    for (int ph = 0; ph < NPH; ++ph) { a.ph_lo = ph; a.ph_hi = ph + 1; hipLaunchKernelGGL(hyb_fwd, dim3(grid), dim3(NTHR), LDS_BYTES, stream, a);
#if defined(CHECK_BUILD) && CHECK_BUILD
        if (ph == 2) hipLaunchKernelGGL(chk_proj, dim3(1024), dim3(256), 0, stream, a);
        if (ph == 3) hipLaunchKernelGGL(chk_cmp, dim3(128), dim3(128), 0, stream, a);
        if (ph == 6) hipLaunchKernelGGL(chk_nsa, dim3(8 * CHK_NT), dim3(256), 0, stream, a);
        if (ph == NPH - 1) hipLaunchKernelGGL(chk_report, dim3(4098), dim3(256), 0, stream, a);
#endif
    }
#endif
    (void)in_sizes;
}
```

```cpp
#include <hip/hip_runtime.h>
#include <cstdio>
#include <cstdint>
namespace pg8 {
#define PG8_LAS __attribute__((address_space(3)))
typedef unsigned short bf16_t;
typedef short bf16x8 __attribute__((ext_vector_type(8)));
typedef float f32x4 __attribute__((ext_vector_type(4)));
typedef unsigned u32x4 __attribute__((ext_vector_type(4)));
constexpr int BM = 256, BK = 64, HALF = 128, HTB = HALF * BK * 2  , STAGE_BYTES = 8 * HTB, NXCD = 8, WGM = 8;

__host__ __device__ __forceinline__ int lds_byte(int r, int c) { const int st = (r >> 4) * 2 + (c >> 5), rr = r & 15, cc = c & 31, ob = rr * 64 + cc * 2; return st * 1024 + (ob ^ (((ob >> 9) & 1) << 5)); }
__host__ __device__ __forceinline__ void stage_rc(int b, int& R, int& C) { const int st = b / 1024, sb = b % 1024, swz = sb ^ (((sb >> 9) & 1) << 5); R = (st >> 1) * 16 + swz / 64; C = (st & 1) * 32 + (swz % 64) / 2; }
__host__ __device__ __forceinline__ int perm32(int rho) { const int n = rho >> 4, i = rho & 15; return 8 * (i >> 2) + 4 * n + (i & 3); }

struct Unit { int pm, pn; };
struct Gemm { const bf16_t* A; const bf16_t* Bt; int M, N, K; };

struct StaticOrder {
    int nM, nN, nwg, G, c;
    __host__ __device__ void init(int M, int N, int G_, int c_) { nM = M / BM; nN = N / BM; nwg = nM * nN; G = G_; c = c_; }
    __host__ __device__ bool next(int i, Unit& u) const {
        const long L = (long)i * G + c; if (L >= nwg) return false;
        int wgid = (int)L; { const int q = nwg / NXCD, r = nwg % NXCD, xcd = wgid % NXCD, off = wgid / NXCD; wgid = (xcd < r ? xcd * (q + 1) : r * (q + 1) + (xcd - r) * q) + off; }
        const int nig = WGM * nN, gid = wgid / nig, fm = gid * WGM, gsz = (nM - fm) < WGM ? (nM - fm) : WGM;
        u.pm = fm + ((wgid % nig) % gsz); u.pn = (wgid % nig) / gsz; return true;
    }
    __device__ __forceinline__ void a_ready(const Unit&) const {}
    __device__ __forceinline__ void done(const Unit&) const {}
};
__device__ __forceinline__ unsigned cvt_pk_bf16(float lo, float hi) { unsigned r; asm volatile("v_cvt_pk_bf16_f32 %0, %1, %2" : "=v"(r) : "v"(lo), "v"(hi)); return r; }
template <class Epi, class Sched, bool ALIGN_EPI = false, bool SP2 = false>
__device__ __forceinline__ void gemm_phase(PG8_LAS unsigned char* lds, const Gemm g, const Sched& S, const Epi& E, const int wave_idx  ) {
    int lane_l; asm volatile("v_mbcnt_lo_u32_b32 %0, -1, 0\n\tv_mbcnt_hi_u32_b32 %0, -1, %0" : "=v"(lane_l));
    const int wid = wave_idx, tid = wid * 64 + lane_l, lane = tid & 63, wr = wid >> 2, wc = wid & 3, fr = lane & 15, fq = lane >> 4;
    const int K = g.K, nt = K / BK;
    unsigned voffA[2], voffB[2];
#pragma unroll
    for (int i = 0; i < 2; ++i) { int R, C; stage_rc(tid * 16 + i * 8192, R, C); const int Rb = Epi::PERM ? ((R & ~31) + perm32(R & 31)) : R;
        voffA[i] = (unsigned)(R * K + C) * 2u; voffB[i] = (unsigned)(Rb * K + C) * 2u; }
    const size_t kstep = (size_t)(BK * 2);
    const size_t hstep = (size_t)HALF * K * 2;
    const size_t tstep = 2 * hstep;
    const unsigned ldsw = (unsigned)wid * 1024u;
    const int aoff = lds_byte(wr * 64 + fr, fq * 8), boff = lds_byte(wc * 32 + fr, fq * 8);
#define PG8_SA(b, h) (((b) * 2 + (h)) * HTB)
#define PG8_SB(b, h) ((4 + (b) * 2 + (h)) * HTB)
#define PG8_STAGE(bufoff, gbase, voff) do { _Pragma("unroll") for (int _i = 0; _i < 2; ++_i) \
        __builtin_amdgcn_global_load_lds((const unsigned*)((const char*)(gbase) + (voff)[_i]), (PG8_LAS unsigned*)(lds + (bufoff) + ldsw + _i * 8192), 16, 0, 0); } while (0)
#define PG8_LDA(dst, b, h) do { _Pragma("unroll") for (int m = 0; m < 4; ++m) _Pragma("unroll") for (int k = 0; k < 2; ++k) dst[m][k] = *(const PG8_LAS bf16x8*)(lds + PG8_SA(b, h) + aoff + m * 2048 + k * 1024); } while (0)
#define PG8_LDB(dst, b, h) do { _Pragma("unroll") for (int n = 0; n < 2; ++n) _Pragma("unroll") for (int k = 0; k < 2; ++k) dst[n][k] = *(const PG8_LAS bf16x8*)(lds + PG8_SB(b, h) + boff + n * 2048 + k * 1024); } while (0)
#define PG8_MMA(ai, bj, At, Bt) do { __builtin_amdgcn_s_setprio(1); _Pragma("unroll") for (int m = 0; m < 4; ++m) _Pragma("unroll") for (int n = 0; n < 2; ++n) _Pragma("unroll") for (int k = 0; k < 2; ++k) \
        acc[ai][bj][m][n] = __builtin_amdgcn_mfma_f32_16x16x32_bf16(Bt[n][k], At[m][k], acc[ai][bj][m][n], 0, 0, 0); __builtin_amdgcn_s_setprio(0); } while (0)
#define PG8_WAIT_V(n) asm volatile("s_waitcnt vmcnt(" #n ")" ::: "memory")
#define PG8_WAIT_L(n) asm volatile("s_waitcnt lgkmcnt(" #n ")" ::: "memory")
#define PG8_BAR __builtin_amdgcn_s_barrier()
#define PG8_SCHED __builtin_amdgcn_sched_barrier(0)
    Unit cur, nxt; int ui = 0;
    if (!S.next(0, cur)) return;
    f32x4 acc[2][2][4][2];
#pragma unroll
    for (int a = 0; a < 2; ++a)
#pragma unroll
        for (int b = 0; b < 2; ++b)
#pragma unroll
            for (int m = 0; m < 4; ++m)
#pragma unroll
                for (int n = 0; n < 2; ++n) acc[a][b][m][n] = (f32x4){0.f, 0.f, 0.f, 0.f};
    bf16x8 At[4][2], B0[2][2], B1[2][2];
    const char* cA = (const char*)g.A + (size_t)cur.pm * tstep; const char* cB = (const char*)g.Bt + (size_t)cur.pn * tstep;
    S.a_ready(cur);
    if constexpr (SP2) {
        PG8_STAGE(PG8_SB(0, 0), cB, voffB); PG8_STAGE(PG8_SB(0, 1), cB + hstep, voffB); PG8_STAGE(PG8_SA(0, 0), cA, voffA); PG8_STAGE(PG8_SA(0, 1), cA + hstep, voffA);
        if (wr == 1) PG8_BAR;
        PG8_WAIT_V(2); PG8_BAR;
        PG8_STAGE(PG8_SB(1, 0), cB + kstep, voffB); PG8_STAGE(PG8_SA(1, 0), cA + kstep, voffA); PG8_STAGE(PG8_SB(1, 1), cB + hstep + kstep, voffB);
        PG8_WAIT_V(6); PG8_BAR;
    } else {
        PG8_STAGE(PG8_SB(0, 0), cB, voffB); PG8_STAGE(PG8_SA(0, 0), cA, voffA); PG8_STAGE(PG8_SB(0, 1), cB + hstep, voffB); PG8_STAGE(PG8_SA(0, 1), cA + hstep, voffA);
        if (wr == 1) PG8_BAR;
        PG8_WAIT_V(4); PG8_BAR;
        PG8_STAGE(PG8_SB(1, 0), cB + kstep, voffB); PG8_STAGE(PG8_SA(1, 0), cA + kstep, voffA); PG8_STAGE(PG8_SB(1, 1), cB + hstep + kstep, voffB);
        PG8_WAIT_V(6); PG8_BAR;
    }
    for (;;) {
        const bool has_next = S.next(ui + 1, nxt);
        const char* nA = has_next ? (const char*)g.A + (size_t)nxt.pm * tstep : cA; const char* nB = has_next ? (const char*)g.Bt + (size_t)nxt.pn * tstep : cB;
        for (int t = 0; t < nt; t += 2) {
            const bool last = (t == nt - 2);
            const char* a1 = cA + (size_t)(t + 1) * kstep;
            const char* a2 = last ? nA : cA + (size_t)(t + 2) * kstep; const char* b2 = last ? nB : cB + (size_t)(t + 2) * kstep;
            const char* a3 = a2 + kstep; const char* b3 = b2 + kstep;
            if (last && has_next) S.a_ready(nxt);
            if constexpr (SP2) {
            PG8_LDB(B0, 0, 0); PG8_LDB(B1, 0, 1); PG8_SCHED; PG8_LDA(At, 0, 0); PG8_STAGE(PG8_SA(1, 1), a1 + hstep, voffA);
            PG8_WAIT_V(8); PG8_WAIT_L(0); PG8_BAR; PG8_MMA(0, 0, At, B0); PG8_MMA(0, 1, At, B1); PG8_BAR; PG8_SCHED;
            PG8_LDA(At, 0, 1); PG8_STAGE(PG8_SB(0, 0), b2, voffB); PG8_STAGE(PG8_SB(0, 1), b2 + hstep, voffB); PG8_STAGE(PG8_SA(0, 0), a2, voffA);
            PG8_WAIT_V(8); PG8_WAIT_L(0); PG8_BAR; PG8_MMA(1, 0, At, B0); PG8_MMA(1, 1, At, B1); PG8_BAR; PG8_SCHED;
            PG8_LDB(B0, 1, 0); PG8_LDB(B1, 1, 1); PG8_SCHED; PG8_LDA(At, 1, 0); PG8_STAGE(PG8_SA(0, 1), a2 + hstep, voffA);
            PG8_WAIT_V(8); PG8_WAIT_L(0); PG8_BAR; PG8_MMA(0, 0, At, B0); PG8_MMA(0, 1, At, B1); PG8_BAR; PG8_SCHED;
            PG8_LDA(At, 1, 1); PG8_STAGE(PG8_SB(1, 0), b3, voffB); PG8_STAGE(PG8_SB(1, 1), b3 + hstep, voffB); PG8_STAGE(PG8_SA(1, 0), a3, voffA);
            PG8_WAIT_V(8); PG8_WAIT_L(0); PG8_BAR; PG8_MMA(1, 0, At, B0); PG8_MMA(1, 1, At, B1); PG8_BAR; PG8_SCHED;
            } else {
            PG8_LDB(B0, 0, 0); PG8_SCHED; PG8_LDA(At, 0, 0); PG8_STAGE(PG8_SA(1, 1), a1 + hstep, voffA);
            PG8_WAIT_L(8); PG8_BAR; PG8_WAIT_L(0); PG8_MMA(0, 0, At, B0); PG8_BAR; PG8_SCHED;
            PG8_LDB(B1, 0, 1); PG8_STAGE(PG8_SB(0, 0), b2, voffB);
            PG8_BAR; PG8_WAIT_L(0); PG8_MMA(0, 1, At, B1); PG8_BAR;
            PG8_LDA(At, 0, 1); PG8_STAGE(PG8_SA(0, 0), a2, voffA);
            PG8_BAR; PG8_WAIT_L(0); PG8_MMA(1, 0, At, B0); PG8_BAR; PG8_SCHED;
            PG8_STAGE(PG8_SB(0, 1), b2 + hstep, voffB);
            PG8_WAIT_V(6); PG8_BAR; PG8_MMA(1, 1, At, B1); PG8_BAR;
            PG8_LDB(B0, 1, 0); PG8_SCHED; PG8_LDA(At, 1, 0); PG8_STAGE(PG8_SA(0, 1), a2 + hstep, voffA);
            PG8_WAIT_L(8); PG8_BAR; PG8_WAIT_L(0); PG8_MMA(0, 0, At, B0); PG8_BAR; PG8_SCHED;
            PG8_LDB(B1, 1, 1); PG8_STAGE(PG8_SB(1, 0), b3, voffB);
            PG8_BAR; PG8_WAIT_L(0); PG8_MMA(0, 1, At, B1); PG8_BAR;
            PG8_LDA(At, 1, 1); PG8_STAGE(PG8_SA(1, 0), a3, voffA);
            PG8_BAR; PG8_WAIT_L(0); PG8_MMA(1, 0, At, B0); PG8_BAR; PG8_SCHED;
            PG8_STAGE(PG8_SB(1, 1), b3 + hstep, voffB);
            PG8_WAIT_V(6); PG8_BAR; PG8_MMA(1, 1, At, B1); PG8_BAR;
            }
        }
        if constexpr (ALIGN_EPI) { if (wr == 0) PG8_BAR; }
        if constexpr (!Epi::AFTER_DRAIN) { E(acc, cur, wr, wc, fr, fq);
#if defined(EPI_TWICE)
            if constexpr (Epi::PERM) E(acc, cur, wr, wc, fr, fq);
#endif
            S.done(cur); }
        if (!has_next) break;
#pragma unroll
        for (int a = 0; a < 2; ++a)
#pragma unroll
            for (int b = 0; b < 2; ++b)
#pragma unroll
                for (int m = 0; m < 4; ++m)
#pragma unroll
                    for (int n = 0; n < 2; ++n) acc[a][b][m][n] = (f32x4){0.f, 0.f, 0.f, 0.f};
        cur = nxt; cA = nA; cB = nB; ++ui;
        if constexpr (ALIGN_EPI) { if (wr == 1) PG8_BAR; }
    }
    PG8_WAIT_V(0);
    if constexpr (!ALIGN_EPI) { if (wr == 0) PG8_BAR; }
    PG8_BAR;
    if constexpr (Epi::AFTER_DRAIN) { E.fused(acc, cur, wr, wc, fr, fq, lds, wid, lane); S.done(cur); }
#undef PG8_SA
#undef PG8_SB
#undef PG8_STAGE
#undef PG8_LDA
#undef PG8_LDB
#undef PG8_MMA
#undef PG8_WAIT_V
#undef PG8_WAIT_L
#undef PG8_BAR
#undef PG8_SCHED
}
}

constexpr int BATCH = 2, SEQ = 8192, DM = 2048, DEPTH = 4;
constexpr int M = BATCH * SEQ;
constexpr int NH = 16, HD = 128, NG = 4, RH = 4;
constexpr int NCMP = 511, NCMP_PAD = 512, NSLC = 128, NSEL = 16, WIN = 512;
constexpr int SSD_H = 32, SSD_P = 64, SSD_N = 128, SSD_G = 4, SSD_CH = 128, SSD_NC = 64, SSD_XBC = 3072;
constexpr int DFF = 8192, PLE = 256;
constexpr float EPS = 1e-6f;
constexpr int PROJ_SRC = 22608;
constexpr int C_Q = 0, C_KC = 2048, C_VC = 2560, C_KS = 3072, C_VS = 3584, C_KW = 4096, C_VW = 4608;
constexpr int C_CB = 5120, C_CC = 7168, C_CU = 9216, C_Z = 11264, C_XBC = 13312, C_GM = 16384, C_GN = 22528, C_DT = 22592;
constexpr int LDP = 22784;
constexpr int S_GN = 5120, S_DT = 16432;

constexpr size_t MiB = 1u << 20;
constexpr size_t WS_CTL = 0, CTL_ZERO_BYTES = 1 * MiB;
constexpr size_t WS_ROPE = 1 * MiB;
constexpr size_t WS_MISC = 9 * MiB;
constexpr size_t WS_DT = 10 * MiB;
constexpr size_t WS_ACS = 12 * MiB;
constexpr size_t WS_CDEC = 14 * MiB;
constexpr size_t WS_KCMP = 15 * MiB;
constexpr size_t WS_VCMP = 16 * MiB;
constexpr size_t WS_X = 32 * MiB;
constexpr size_t WS_HB = 160 * MiB;
constexpr size_t WS_PB = 224 * MiB;
constexpr size_t WS_EB = 256 * MiB;
constexpr size_t WS_YA = 320 * MiB;
constexpr size_t WS_YC = 384 * MiB;
constexpr size_t WS_XBC = 448 * MiB;
constexpr size_t WS_ST = 544 * MiB;
constexpr size_t WS_PROJ = 672 * MiB;
constexpr size_t WS_U = WS_PROJ;
constexpr size_t WS_W = 1384 * MiB;
constexpr size_t LW_IN = 0;
constexpr size_t LW_O = 89 * MiB;
constexpr size_t LW_UP = 97 * MiB;
constexpr size_t LW_DOWN = 129 * MiB;
constexpr size_t LW_PG = 161 * MiB;
constexpr size_t LW_PLE = 169 * MiB;
constexpr size_t LW_PK1 = 170 * MiB;
constexpr size_t LW_PV1 = 171 * MiB;
constexpr size_t LW_PK2 = 172 * MiB;
constexpr size_t LW_PV2 = 172 * MiB + 64 * 1024;
constexpr size_t LW_STRIDE = 173 * MiB;
constexpr size_t WS_HIN = WS_W + 4 * LW_STRIDE;
constexpr size_t WS_RSTD = WS_MISC + 512 * 1024;
constexpr size_t WS_DELTA = WS_HIN + 64 * MiB;
constexpr size_t WS_END = WS_DELTA + 64 * MiB;
static_assert((size_t)M * LDP * 2 <= 712 * MiB && (size_t)LDP * 2048 * 2 <= 89 * MiB, "ws map");

constexpr int CW_BAR = 4096;
constexpr int CW_CHK = 16384;
constexpr int CW_TS = 20480;

constexpr int RING_BYTES = 131072;
constexpr int LX_OFF = RING_BYTES;
constexpr int LX_BYTES = 8192;
constexpr int LDSCTL_OFF = LX_OFF + LX_BYTES;
constexpr int LDS_BYTES = LDSCTL_OFF + 256;
constexpr int NWAVES = 8, NTHR = 512;

#define DI __device__ __forceinline__
#define GAS __attribute__((address_space(1)))
#define LAS __attribute__((address_space(3)))
typedef unsigned short bf16;
typedef unsigned u32x4 __attribute__((ext_vector_type(4)));
typedef unsigned u32x2 __attribute__((ext_vector_type(2)));
typedef float f32x4 __attribute__((ext_vector_type(4)));
typedef float f32x2 __attribute__((ext_vector_type(2)));
typedef short bf16x8 __attribute__((ext_vector_type(8)));
typedef short s16x4 __attribute__((ext_vector_type(4)));
typedef GAS unsigned gu32;
#define RLX_AGENT __ATOMIC_RELAXED, __HIP_MEMORY_SCOPE_AGENT
#define LDS_WAIT() asm volatile("s_waitcnt lgkmcnt(0)" ::: "memory")
#define VM_WAIT() asm volatile("s_waitcnt vmcnt(0)" ::: "memory")
DI unsigned f2bf(float f) { unsigned u = __builtin_bit_cast(unsigned, f); return (u + 0x7fffu + ((u >> 16) & 1u)) >> 16; }
DI unsigned pk2(float lo, float hi) { unsigned r; asm("v_cvt_pk_bf16_f32 %0, %1, %2" : "=v"(r) : "v"(lo), "v"(hi)); return r; }
DI float bf2f(unsigned h) { return __builtin_bit_cast(float, h << 16); }
DI float bflo(unsigned w) { return __builtin_bit_cast(float, w << 16); }
DI float bfhi(unsigned w) { return __builtin_bit_cast(float, w & 0xffff0000u); }
DI float sigmoidf_(float x) { return 1.0f / (1.0f + __expf(-x)); }
DI float siluf_(float x) { return x / (1.0f + __expf(-x)); }
DI float shfl_idx(float v, int src) { return __builtin_bit_cast(float, __builtin_amdgcn_ds_bpermute(src << 2, __builtin_bit_cast(int, v))); }
DI unsigned shfl_idx_u(unsigned v, int src) { return (unsigned)__builtin_amdgcn_ds_bpermute(src << 2, (int)v); }
DI float shx(float v, int m, int lane) { return shfl_idx(v, lane ^ m); }
DI float xq_max(float x) {
    float a = x, b = x;
    asm("s_nop 1\n\tv_permlane32_swap_b32 %0, %1" : "+v"(a), "+v"(b)); x = fmaxf(a, b);
    a = x; b = x;
    asm("s_nop 1\n\tv_permlane16_swap_b32 %0, %1" : "+v"(a), "+v"(b)); return fmaxf(a, b);
}
DI float xq_sum(float x) {
    float a = x, b = x;
    asm("s_nop 1\n\tv_permlane32_swap_b32 %0, %1" : "+v"(a), "+v"(b)); x = a + b;
    a = x; b = x;
    asm("s_nop 1\n\tv_permlane16_swap_b32 %0, %1" : "+v"(a), "+v"(b)); return a + b;
}
DI float quad_sum(float v) {
    v += __builtin_bit_cast(float, __builtin_amdgcn_update_dpp(0, __builtin_bit_cast(int, v), 0xB1, 0xF, 0xF, true));
    v += __builtin_bit_cast(float, __builtin_amdgcn_update_dpp(0, __builtin_bit_cast(int, v), 0x4E, 0xF, 0xF, true));
    return v;
}
DI float wave_sum(float v, int lane) {
#pragma unroll
    for (int o = 1; o < 64; o <<= 1) v += shx(v, o, lane);
    return v;
}
DI unsigned off_b(unsigned row, unsigned ch) { return 256u * row + 16u * (ch ^ (((row & 3u) << 2) | ((row >> 2) & 3u))); }
DI unsigned tr_addr(unsigned lane, unsigned r0, unsigned c, unsigned t) {
    const unsigned g = lane >> 4, q = (lane & 15u) >> 2, p = lane & 3u;
    return off_b(r0 + 8u * g + 4u * t + q, 2u * c + (p >> 1)) + 8u * (p & 1u);
}
DI s16x4 tr_read(LAS const unsigned char* p) { return __builtin_amdgcn_ds_read_tr16_b64_v4i16((LAS s16x4*)p); }
DI bf16x8 tr_read8(LAS const unsigned char* base, unsigned lane, unsigned r0, unsigned c) {
    const s16x4 lo = tr_read(base + tr_addr(lane, r0, c, 0)), hi = tr_read(base + tr_addr(lane, r0, c, 1));
    return __builtin_shufflevector(lo, hi, 0, 1, 2, 3, 4, 5, 6, 7);
}
DI bf16x8 lds_rd8(LAS const unsigned char* p) { return *(const LAS bf16x8*)p; }
DI bf16x8 as_bf16x8(u32x4 v) { return __builtin_bit_cast(bf16x8, v); }
#define MFMA16(a, b, c) __builtin_amdgcn_mfma_f32_16x16x32_bf16((a), (b), (c), 0, 0, 0)

namespace pg8 {
template <int MODE> struct EpiB {
    static constexpr bool PERM = true, AFTER_DRAIN = false;
    bf16_t* O; int ldc; const float* rope;
    __device__ __forceinline__ void operator()(const f32x4 (&acc)[2][2][4][2], const Unit& u, int wr, int wc, int fr, int fq) const {
        { int l; asm volatile("v_mbcnt_lo_u32_b32 %0, -1, 0\n\tv_mbcnt_hi_u32_b32 %0, -1, %0" : "=v"(l)); fr = l & 15; fq = l >> 4; }
        const int row0 = u.pm * BM + wr * 64 + fr;
        bool rp = false;
        if (MODE == 2) { const int pn = u.pn; rp = (pn < 10) || pn == 12 || pn == 13 || pn == 16 || pn == 17; }
        if (MODE == 2 && rp) {
            const int colb = u.pn * BM + 128 * (wc >> 1) + 32 * (wc & 1) + 8 * fq, jj0 = 32 * (wc & 1) + 8 * fq;
#pragma unroll
            for (int ai = 0; ai < 2; ++ai)
#pragma unroll
                for (int m = 0; m < 4; ++m) {
                    const int row = row0 + ai * HALF + m * 16;
                    const float* rpp = (const float*)((const char*)rope + (unsigned)(((unsigned)row * 64u + (unsigned)jj0) * 8u));
                    const f32x4 cs0 = *(const f32x4*)(rpp), cs1 = *(const f32x4*)(rpp + 4), cs2 = *(const f32x4*)(rpp + 8), cs3 = *(const f32x4*)(rpp + 12);
                    const f32x4 x1a = acc[ai][0][m][0], x1b = acc[ai][0][m][1], x2a = acc[ai][1][m][0], x2b = acc[ai][1][m][1];
                    float c[8] = {cs0[0], cs0[2], cs1[0], cs1[2], cs2[0], cs2[2], cs3[0], cs3[2]};
                    float s[8] = {cs0[1], cs0[3], cs1[1], cs1[3], cs2[1], cs2[3], cs3[1], cs3[3]};
                    float x1[8] = {x1a[0], x1a[1], x1a[2], x1a[3], x1b[0], x1b[1], x1b[2], x1b[3]};
                    float x2[8] = {x2a[0], x2a[1], x2a[2], x2a[3], x2b[0], x2b[1], x2b[2], x2b[3]};
                    float o1[8], o2[8];
#pragma unroll
                    for (int k = 0; k < 8; ++k) { o1[k] = x1[k] * c[k] - x2[k] * s[k]; o2[k] = x2[k] * c[k] + x1[k] * s[k]; }
                    u32x4 w1, w2;
                    w1.x = cvt_pk_bf16(o1[0], o1[1]); w1.y = cvt_pk_bf16(o1[2], o1[3]); w1.z = cvt_pk_bf16(o1[4], o1[5]); w1.w = cvt_pk_bf16(o1[6], o1[7]);
                    w2.x = cvt_pk_bf16(o2[0], o2[1]); w2.y = cvt_pk_bf16(o2[2], o2[3]); w2.z = cvt_pk_bf16(o2[4], o2[5]); w2.w = cvt_pk_bf16(o2[6], o2[7]);
                    bf16_t* rowp = (bf16_t*)((char*)O + (unsigned)(((unsigned)row * (unsigned)ldc + (unsigned)colb) * 2u));
                    *(u32x4*)(rowp) = w1; *(u32x4*)(rowp + 64) = w2;
                    asm volatile("" ::: "memory");
                }
        } else {
            const int col0 = u.pn * BM + wc * 32 + 8 * fq;
#pragma unroll
            for (int ai = 0; ai < 2; ++ai)
#pragma unroll
                for (int m = 0; m < 4; ++m) { bf16_t* rowp = (bf16_t*)((char*)O + (unsigned)(((unsigned)(row0 + ai * HALF + m * 16) * (unsigned)ldc + (unsigned)col0) * 2u));
#pragma unroll
                    for (int bj = 0; bj < 2; ++bj) { f32x4 v0 = acc[ai][bj][m][0], v1 = acc[ai][bj][m][1];
                        if (MODE == 1) {
#pragma unroll
                            for (int k = 0; k < 4; ++k) { const float a = fmaxf(v0[k], 0.f), b = fmaxf(v1[k], 0.f); v0[k] = a * a; v1[k] = b * b; } }
                        if (MODE == 3) { const u32x4 ev = *(const u32x4*)((const bf16_t*)rope + (rowp - O) + bj * HALF);
                            const float e[8] = {__builtin_bit_cast(float, ev.x << 16), __builtin_bit_cast(float, ev.x & 0xffff0000u), __builtin_bit_cast(float, ev.y << 16), __builtin_bit_cast(float, ev.y & 0xffff0000u),
                                                __builtin_bit_cast(float, ev.z << 16), __builtin_bit_cast(float, ev.z & 0xffff0000u), __builtin_bit_cast(float, ev.w << 16), __builtin_bit_cast(float, ev.w & 0xffff0000u)};
#pragma unroll
                            for (int k = 0; k < 4; ++k) { v0[k] = e[k] / (1.0f + __expf(-v0[k])); v1[k] = e[4 + k] / (1.0f + __expf(-v1[k])); } }
                        u32x4 w; w.x = cvt_pk_bf16(v0[0], v0[1]); w.y = cvt_pk_bf16(v0[2], v0[3]); w.z = cvt_pk_bf16(v1[0], v1[1]); w.w = cvt_pk_bf16(v1[2], v1[3]);
                        *(u32x4*)(rowp + bj * HALF) = w; } }
        }
    }
};
template <bool GATE> struct EpiRes {
    static constexpr bool PERM = false, AFTER_DRAIN = false;
    const float* xin; float* xout; int ldc; const bf16_t* e;
    __device__ __forceinline__ void operator()(const f32x4 (&acc)[2][2][4][2], const Unit& u, int wr, int wc, int fr, int fq) const {
        { int l; asm volatile("v_mbcnt_lo_u32_b32 %0, -1, 0\n\tv_mbcnt_hi_u32_b32 %0, -1, %0" : "=v"(l)); fr = l & 15; fq = l >> 4; }
        const int row0 = u.pm * BM + wr * 64 + fr, col0 = u.pn * BM + wc * 32 + 4 * fq;
#pragma unroll
        for (int ai = 0; ai < 2; ++ai)
#pragma unroll
            for (int m = 0; m < 4; ++m) { const unsigned off = (unsigned)(row0 + ai * HALF + m * 16) * (unsigned)ldc + (unsigned)col0;
#pragma unroll
                for (int bj = 0; bj < 2; ++bj)
#pragma unroll
                    for (int n = 0; n < 2; ++n) { const unsigned o = off + bj * HALF + n * 16; const f32x4 xv = *(const f32x4*)((const char*)xin + (unsigned)(o * 4u)); f32x4 a = acc[ai][bj][m][n];
                        if (GATE) { typedef unsigned u32x2v __attribute__((ext_vector_type(2))); const u32x2v ev = *(const u32x2v*)((const char*)e + (unsigned)(o * 2u));
                            const float e0 = __builtin_bit_cast(float, ev.x << 16), e1 = __builtin_bit_cast(float, ev.x & 0xffff0000u), e2 = __builtin_bit_cast(float, ev.y << 16), e3 = __builtin_bit_cast(float, ev.y & 0xffff0000u);
                            a[0] = e0 / (1.0f + __expf(-a[0])); a[1] = e1 / (1.0f + __expf(-a[1])); a[2] = e2 / (1.0f + __expf(-a[2])); a[3] = e3 / (1.0f + __expf(-a[3])); }
                        *(f32x4*)((char*)xout + (unsigned)(o * 4u)) = xv + a; }
                asm volatile("" ::: "memory"); }
    }
};
}
#define XB_TMO      128
#define XB_XCNT(j)  (256  + 64 * (j))
#define XB_XSUB(j)  (1280 + 64 * (j))
#define XB_XGEN(j)  (2304 + 64 * (j))
#define XB_TOP      3328
#define XB_TOPGEN   3392
#define XCD_BAR_WORDS 3456
#define XB_SPIN_CAP (1u << 18)

__device__ __forceinline__ unsigned xb_ld(unsigned* p)              { return __hip_atomic_load(p, __ATOMIC_RELAXED, __HIP_MEMORY_SCOPE_AGENT); }
__device__ __forceinline__ unsigned xb_add(unsigned* p, unsigned v) { return __hip_atomic_fetch_add(p, v, __ATOMIC_RELAXED, __HIP_MEMORY_SCOPE_AGENT); }
__device__ __forceinline__ unsigned xb_xcc_id() { return (unsigned)__builtin_amdgcn_s_getreg((3 << 11) | 20) & 0xFu; }
#define XB_SPIN(cond, bar) do { unsigned _sp = 0; while (cond) { __builtin_amdgcn_s_sleep(1); \
    if ((++_sp & 255u) == 0u) { if (xb_ld(&(bar)[XB_TMO])) break; if (_sp > XB_SPIN_CAP) { atomicAdd(&(bar)[XB_TMO], 1u); break; } } } } while (0)

struct XcdBarrier {
    unsigned* bar; unsigned x;
    volatile LAS unsigned* st;
};

__device__ __forceinline__ XcdBarrier xcd_barrier_post(unsigned* bar, volatile LAS unsigned* st) {
    XcdBarrier b; b.bar = bar; b.x = xb_xcc_id(); b.st = st;
    if (threadIdx.x == 0) (void)xb_add(&bar[XB_XCNT(b.x)], 1u);
    return b;
}
__device__ __forceinline__ void xcd_barrier_complete(unsigned* bar, unsigned x, unsigned& nloc, unsigned& nx) {
    const unsigned G = gridDim.x * gridDim.y * gridDim.z;
    unsigned sum, cnt, mine, sp = 0u;
    for (;;) {
        sum = 0u; cnt = 0u; mine = 0u;
#pragma unroll
        for (unsigned j = 0; j < 16; ++j) { const unsigned c = xb_ld(&bar[XB_XCNT(j)]); sum += c; cnt += (c > 0u) ? 1u : 0u; mine = (j == x) ? c : mine; }
        if (sum == G) break;
        __builtin_amdgcn_s_sleep(1);
        if ((++sp & 255u) == 0u) { if (xb_ld(&bar[XB_TMO])) break; if (sp > XB_SPIN_CAP) { atomicAdd(&bar[XB_TMO], 1u); break; } }
    }
    nloc = mine > 0u ? mine : 1u; nx = cnt > 0u ? cnt : 1u;
}

__device__ __forceinline__ void xcd_barrier(const XcdBarrier& b) {
    asm volatile("s_waitcnt vmcnt(0)" ::: "memory");
    __syncthreads();
    if (threadIdx.x == 0) {
        unsigned* bar = b.bar;
        __builtin_amdgcn_s_waitcnt(0);
        unsigned nloc = b.st[0], nx = b.st[1];
        if (nloc == 0u) { xcd_barrier_complete(bar, b.x, nloc, nx); b.st[0] = nloc; b.st[1] = nx; }
        const unsigned old = xb_add(&bar[XB_XSUB(b.x)], 1u);
        const unsigned gen = old / nloc;
        if (old + 1u == (gen + 1u) * nloc) {
            __builtin_amdgcn_fence(__ATOMIC_RELEASE, "agent");
            asm volatile("s_waitcnt vmcnt(0)" ::: "memory");
            const unsigned og = xb_add(&bar[XB_TOP], 1u);
            const unsigned tg = og / nx;
            if (og + 1u == (tg + 1u) * nx) xb_add(&bar[XB_TOPGEN], 1u);
            else XB_SPIN(xb_ld(&bar[XB_TOPGEN]) == tg, bar);
            __builtin_amdgcn_fence(__ATOMIC_ACQUIRE, "agent");
            xb_add(&bar[XB_XGEN(b.x)], 1u);
            asm volatile("s_waitcnt vmcnt(0)" ::: "memory");
        } else {
            XB_SPIN(xb_ld(&bar[XB_XGEN(b.x)]) == gen, bar);
            __builtin_amdgcn_fence(__ATOMIC_ACQUIRE, "agent");
            asm volatile("s_waitcnt vmcnt(0)" ::: "memory");
        }
    }
    __syncthreads();
}

struct Args { const void* in[30]; float* out; unsigned char* ws; int ph_lo, ph_hi; };
struct Frame {
    LAS unsigned char* lds;
    gu32* ctl;
    unsigned char* ws;
    int tid, lane, wave, G, bid;
};
DI const void* argin(const Args&, int k) {
    typedef const void* const __attribute__((address_space(4)))* kptr_t;
    kptr_t p = (kptr_t)__builtin_amdgcn_kernarg_segment_ptr(); asm volatile("" : "+s"(p));
    return (const void*)p[k]; }
DI int launder_s(int x) { asm volatile("" : "+s"(x)); return x; }
DI Frame phase_frame(const Frame& F0) { Frame F = F0;
    int l; asm volatile("v_mbcnt_lo_u32_b32 %0, -1, 0\n\tv_mbcnt_hi_u32_b32 %0, -1, %0" : "=v"(l));
    F.wave = launder_s(F0.wave); F.bid = launder_s(F0.bid); F.G = launder_s(F0.G);
    F.lane = l; F.tid = F.wave * 64 + l;
    { unsigned long long wsb = (unsigned long long)F0.ws; asm volatile("" : "+s"(wsb)); F.ws = (unsigned char*)wsb; }
    { unsigned ll = (unsigned)(size_t)F0.lds; asm volatile("" : "+s"(ll)); F.lds = (LAS unsigned char*)(size_t)ll; }
    return F; }
DI unsigned char* lw_ptr(const Frame& F, int layer, size_t off) { return F.ws + WS_W + (size_t)layer * LW_STRIDE + off; }

template <bool FRAGMAJOR = false>
DI void transpose_item(const float* W, int K, int Nsrc, int nsrc0, bf16* WT, int dst_row0, int k0, LAS float* scr, int lane) {
#pragma unroll 8
    for (int i = 0; i < 32; ++i) { const int kk = 2 * i + (lane >> 5); scr[kk * 33 + (lane & 31)] = W[(size_t)(k0 + kk) * Nsrc + nsrc0 + (lane & 31)]; }
    LDS_WAIT(); asm volatile("" ::: "memory");
    const int c = lane & 7;
#pragma unroll
    for (int j = 0; j < 4; ++j) { const int n = (lane >> 3) + 8 * j; const LAS float* s = scr + (8 * c) * 33 + n;
        u32x4 o; o.x = pk2(s[0 * 33], s[1 * 33]); o.y = pk2(s[2 * 33], s[3 * 33]); o.z = pk2(s[4 * 33], s[5 * 33]); o.w = pk2(s[6 * 33], s[7 * 33]);
        if (FRAGMAJOR) { const int hid = dst_row0 + n, kk = k0 + 8 * c;
            *(u32x4*)(WT + ((size_t)((hid >> 4) * (K >> 5) + (kk >> 5)) * 64 + (((kk >> 3) & 3) * 16 + (hid & 15))) * 8) = o; }
        else *(u32x4*)(WT + (size_t)(dst_row0 + n) * K + k0 + 8 * c) = o; }
    LDS_WAIT(); asm volatile("" ::: "memory");
}
DI int proj_src_col(int d) {
    if (d < 5120) {
        const int pn = d >> 8; const bool rp = (pn < 10) || pn == 12 || pn == 13 || pn == 16 || pn == 17;
        if (!rp) return d;
        const int c = d & 255, bj = c >> 7, wc = (c >> 5) & 3;
        return (pn << 8) + 128 * (wc >> 1) + 64 * bj + 32 * (wc & 1);
    }
    if (d < 16384) return d + 48;
    if (d < 22528) return d + 80;
    if (d < 22592) return S_GN + (d - 22528);
    if (d < 22624) return S_DT + (d - 22592);
    return 0;
}
constexpr int TI_IN = 32 * 712, TI_O = 32 * 64, TI_UP = 32 * 256, TI_DOWN = 128 * 64, TI_PG = 32 * 64, TI_PLE = 4 * 64, TI_P1 = 64 * 4, TI_P2 = 2 * 4;
constexpr int TI_LAYER = TI_IN + TI_O + TI_UP + TI_DOWN + TI_PG + TI_PLE + 2 * TI_P1 + 2 * TI_P2;

DI void p0_prologue(const Frame& F0, const Args& A) {
    const Frame F = phase_frame(F0);
    LAS float* scr = (LAS float*)(F.lds + F.wave * 16384);
    const int gw = F.bid * NWAVES + F.wave, NGW = F.G * NWAVES;
    for (int it = gw; it < DEPTH * TI_LAYER; it += NGW) {
        const int layer = it / TI_LAYER; int r = it - layer * TI_LAYER;
        if (r < TI_IN) { const int kb = r / 712, nb = r - kb * 712;
            transpose_item((const float*)argin(A, 4) + (size_t)layer * DM * PROJ_SRC, DM, PROJ_SRC, proj_src_col(nb * 32), (bf16*)lw_ptr(F, layer, LW_IN), nb * 32, kb * 64, scr, F.lane); continue; } r -= TI_IN;
        if (r < TI_O) { const int kb = r / 64, nb = r % 64;
            transpose_item((const float*)argin(A, 22) + (size_t)layer * DM * DM, DM, DM, nb * 32, (bf16*)lw_ptr(F, layer, LW_O), nb * 32, kb * 64, scr, F.lane); continue; } r -= TI_O;
        if (r < TI_UP) { const int kb = r / 256, nb = r % 256;
            transpose_item((const float*)argin(A, 24) + (size_t)layer * DM * DFF, DM, DFF, nb * 32, (bf16*)lw_ptr(F, layer, LW_UP), nb * 32, kb * 64, scr, F.lane); continue; } r -= TI_UP;
        if (r < TI_DOWN) { const int kb = r / 64, nb = r % 64;
            transpose_item((const float*)argin(A, 25) + (size_t)layer * DFF * DM, DFF, DM, nb * 32, (bf16*)lw_ptr(F, layer, LW_DOWN), nb * 32, kb * 64, scr, F.lane); continue; } r -= TI_DOWN;
        if (r < TI_PG) { const int kb = r / 64, nb = r % 64;
            transpose_item((const float*)argin(A, 28) + (size_t)layer * DM * DM, DM, DM, nb * 32, (bf16*)lw_ptr(F, layer, LW_PG), nb * 32, kb * 64, scr, F.lane); continue; } r -= TI_PG;
        if (r < TI_PLE) { const int kb = r / 64, nb = r % 64;
            transpose_item((const float*)argin(A, 27) + (size_t)layer * PLE * DM, PLE, DM, nb * 32, (bf16*)lw_ptr(F, layer, LW_PLE), nb * 32, kb * 64, scr, F.lane); continue; } r -= TI_PLE;
        if (r < TI_P1) { const int kb = r / 4, nb = r % 4;
            transpose_item<true>((const float*)argin(A, 7) + (size_t)layer * 4096 * 128, 4096, 128, nb * 32, (bf16*)lw_ptr(F, layer, LW_PK1), nb * 32, kb * 64, scr, F.lane); continue; } r -= TI_P1;
        if (r < TI_P1) { const int kb = r / 4, nb = r % 4;
            transpose_item<true>((const float*)argin(A, 11) + (size_t)layer * 4096 * 128, 4096, 128, nb * 32, (bf16*)lw_ptr(F, layer, LW_PV1), nb * 32, kb * 64, scr, F.lane); continue; } r -= TI_P1;
        if (r < TI_P2) { const int kb = r / 4, nb = r % 4;
            transpose_item((const float*)argin(A, 9) + (size_t)layer * 128 * 128, 128, 128, nb * 32, (bf16*)lw_ptr(F, layer, LW_PK2), nb * 32, kb * 64, scr, F.lane); continue; } r -= TI_P2;
        { const int kb = r / 4, nb = r % 4;
            transpose_item((const float*)argin(A, 13) + (size_t)layer * 128 * 128, 128, 128, nb * 32, (bf16*)lw_ptr(F, layer, LW_PV2), nb * 32, kb * 64, scr, F.lane); }
    }
    const size_t gt = (size_t)F.bid * NTHR + F.tid, NGT = (size_t)F.G * NTHR;
    { const float* p = (const float*)argin(A, 1); bf16* pb = (bf16*)(F.ws + WS_PB);
      for (size_t i = gt; i < (size_t)DEPTH * M * PLE / 8; i += NGT) { const f32x4 a = *(const f32x4*)(p + i * 8), b = *(const f32x4*)(p + i * 8 + 4);
          u32x4 o; o.x = pk2(a[0], a[1]); o.y = pk2(a[2], a[3]); o.z = pk2(b[0], b[1]); o.w = pk2(b[2], b[3]); *(u32x4*)(pb + i * 8) = o; } }
    { const int* pos = (const int*)argin(A, 2); float* rope = (float*)(F.ws + WS_ROPE);
      for (size_t i = gt; i < (size_t)M * 64; i += NGT) { const int row = (int)(i >> 6), jj = (int)(i & 63);
          const float inv = 1.0f / powf(10000.0f, (float)(2 * jj) * (1.0f / 128.0f));
          const float ang = (float)pos[row] * inv;
          double a = (double)ang; a -= 6.283185307179586476925 * __builtin_rint(a * 0.15915494309189533577);
          const float ar = (float)a;
          rope[i * 2] = cosf(ar); rope[i * 2 + 1] = sinf(ar); } }
    { float* part = (float*)(F.ws + WS_MISC);
      for (size_t i = gt; i < (size_t)DEPTH * 2 * 8 * 128; i += NGT) { const int hid = (int)(i & 127), c = (int)(i >> 7) & 7, kv = (int)(i >> 10) & 1, layer = (int)(i >> 11);
          const float* pe = (const float*)(kv ? A.in[6] : A.in[5]) + (size_t)layer * 4096 + c * 512;
          const float* w1 = (const float*)(kv ? A.in[11] : A.in[7]) + (size_t)layer * 4096 * 128 + (size_t)c * 512 * 128 + hid;
          float s = 0.f;
#pragma unroll 8
          for (int kk = 0; kk < 512; ++kk) s += pe[kk] * w1[(size_t)kk * 128];
          part[i] = s; } }
}

template <bool OUTF32> DI void norm_rows(const Frame& F0, const float* x, const float* g, void* outp) {
    const Frame F = phase_frame(F0);
    const int gw = F.bid * NWAVES + F.wave, NGW = F.G * NWAVES;
    for (int m = gw; m < M; m += NGW) {
        const f32x4* xr = (const f32x4*)(x + (size_t)m * DM) + F.lane;
        f32x4 v[8]; float s = 0.f;
#pragma unroll
        for (int j = 0; j < 8; ++j) { v[j] = xr[64 * j]; s += (v[j][0] * v[j][0] + v[j][1] * v[j][1]) + (v[j][2] * v[j][2] + v[j][3] * v[j][3]); }
        const float rstd = 1.0f / sqrtf(wave_sum(s, F.lane) * (1.0f / DM) + EPS);
#pragma unroll
        for (int j = 0; j < 8; ++j) { const f32x4 gv = ((const f32x4*)g)[F.lane + 64 * j]; const f32x4 o = v[j] * rstd * gv;
            if (OUTF32) ((f32x4*)((float*)outp + (size_t)m * DM))[F.lane + 64 * j] = o;
            else { u32x2 w; w.x = pk2(o[0], o[1]); w.y = pk2(o[2], o[3]); ((u32x2*)((bf16*)outp + (size_t)m * DM))[F.lane + 64 * j] = w; } }
    }
}
template <bool OUTF32> DI void addnorm_rows(const Frame& F0, const float* xin, const bf16* delta, const float* g, float* xout, void* outp) {
    const Frame F = phase_frame(F0);
    const int gw = F.bid * NWAVES + F.wave, NGW = F.G * NWAVES;
    for (int m = gw; m < M; m += NGW) {
        const f32x4* xr = (const f32x4*)(xin + (size_t)m * DM) + F.lane; const u32x2* dr = (const u32x2*)(delta + (size_t)m * DM) + F.lane;
        f32x4 v[8]; u32x2 d[8]; float s = 0.f;
#pragma unroll
        for (int j = 0; j < 8; ++j) { v[j] = xr[64 * j]; d[j] = dr[64 * j]; }
#pragma unroll
        for (int j = 0; j < 8; ++j) { v[j][0] += bflo(d[j].x); v[j][1] += bfhi(d[j].x); v[j][2] += bflo(d[j].y); v[j][3] += bfhi(d[j].y);
            s += (v[j][0] * v[j][0] + v[j][1] * v[j][1]) + (v[j][2] * v[j][2] + v[j][3] * v[j][3]);
            if (!OUTF32) ((f32x4*)(xout + (size_t)m * DM))[F.lane + 64 * j] = v[j]; }
        const float rstd = 1.0f / sqrtf(wave_sum(s, F.lane) * (1.0f / DM) + EPS);
#pragma unroll
        for (int j = 0; j < 8; ++j) { const f32x4 gv = ((const f32x4*)g)[F.lane + 64 * j]; const f32x4 o = v[j] * rstd * gv;
            if (OUTF32) ((f32x4*)((float*)outp + (size_t)m * DM))[F.lane + 64 * j] = o;
            else { u32x2 w; w.x = pk2(o[0], o[1]); w.y = pk2(o[2], o[3]); ((u32x2*)((bf16*)outp + (size_t)m * DM))[F.lane + 64 * j] = w; } }
    }
}
DI void unpack8(u32x4 w, float (&f)[8]) { f[0] = bflo(w.x); f[1] = bfhi(w.x); f[2] = bflo(w.y); f[3] = bfhi(w.y); f[4] = bflo(w.z); f[5] = bfhi(w.z); f[6] = bflo(w.w); f[7] = bfhi(w.w); }
DI u32x4 pack8f(const float (&f)[8]) { u32x4 o; o.x = pk2(f[0], f[1]); o.y = pk2(f[2], f[3]); o.z = pk2(f[4], f[5]); o.w = pk2(f[6], f[7]); return o; }

DI void ssd_conv_pass(const Frame& F0, const Args& A, int layer) {
    const Frame F = phase_frame(F0);
    const bf16* proj = (const bf16*)(F.ws + WS_PROJ); bf16* xbc = (bf16*)(F.ws + WS_XBC);
    const float* cw = (const float*)argin(A, 16) + (size_t)layer * 4 * SSD_XBC; const float* cb = (const float*)argin(A, 17) + (size_t)layer * SSD_XBC;
    const int gt = F.bid * NTHR + F.tid, NGT = F.G * NTHR;
    for (int task = gt; task < 512 * 384; task += NGT) {
        const int run = task / 384, cg = task - run * 384, ch = cg * 8, row0 = run * 32;
        float w[4][8], bs[8], xm3[8], xm2[8], xm1[8];
#pragma unroll
        for (int j = 0; j < 4; ++j) { const f32x4 a = *(const f32x4*)(cw + j * SSD_XBC + ch), b = *(const f32x4*)(cw + j * SSD_XBC + ch + 4);
            w[j][0] = a[0]; w[j][1] = a[1]; w[j][2] = a[2]; w[j][3] = a[3]; w[j][4] = b[0]; w[j][5] = b[1]; w[j][6] = b[2]; w[j][7] = b[3]; }
        { const f32x4 a = *(const f32x4*)(cb + ch), b = *(const f32x4*)(cb + ch + 4); bs[0] = a[0]; bs[1] = a[1]; bs[2] = a[2]; bs[3] = a[3]; bs[4] = b[0]; bs[5] = b[1]; bs[6] = b[2]; bs[7] = b[3]; }
        if ((row0 & (SEQ - 1)) != 0) {
            unpack8(*(const u32x4*)(proj + (size_t)(row0 - 3) * LDP + C_XBC + ch), xm3);
            unpack8(*(const u32x4*)(proj + (size_t)(row0 - 2) * LDP + C_XBC + ch), xm2);
            unpack8(*(const u32x4*)(proj + (size_t)(row0 - 1) * LDP + C_XBC + ch), xm1);
        } else {
#pragma unroll
            for (int k = 0; k < 8; ++k) { xm3[k] = 0.f; xm2[k] = 0.f; xm1[k] = 0.f; }
        }
#pragma unroll 4
        for (int r = 0; r < 32; ++r) {
            float cur[8], y[8]; unpack8(*(const u32x4*)(proj + (size_t)(row0 + r) * LDP + C_XBC + ch), cur);
#pragma unroll
            for (int k = 0; k < 8; ++k) { const float v = w[0][k] * xm3[k] + w[1][k] * xm2[k] + w[2][k] * xm1[k] + w[3][k] * cur[k] + bs[k]; y[k] = siluf_(v); xm3[k] = xm2[k]; xm2[k] = xm1[k]; xm1[k] = cur[k]; }
            *(u32x4*)(xbc + (size_t)(row0 + r) * SSD_XBC + ch) = pack8f(y);
            asm volatile("" ::: "memory");
        }
    }
    const float* dtb = (const float*)argin(A, 18) + layer * SSD_H; float* dt = (float*)(F.ws + WS_DT);
    for (int i = gt; i < M * SSD_H; i += NGT) { const int row = i >> 5, h = i & 31;
        const float x = bf2f(proj[(size_t)row * LDP + C_DT + h]) + dtb[h];
        dt[i] = fmaxf(x, 0.f) + log1pf(__expf(-fabsf(x))); }
}

DI void merge_pass(const Frame& F0, const Args& A, int layer) {
    const Frame F = phase_frame(F0);
    const bf16* proj = (const bf16*)(F.ws + WS_PROJ); const bf16* ya = (const bf16*)(F.ws + WS_YA); const bf16* yc = (const bf16*)(F.ws + WS_YC); bf16* hb = (bf16*)(F.ws + WS_HB);
    const float* sw = (const float*)argin(A, 15) + (size_t)layer * 3 * DM; const float* ngp = (const float*)argin(A, 21) + (size_t)layer * DM; const float* rstdp = (const float*)(F.ws + WS_RSTD);
    const int gt = F.bid * NTHR + F.tid, NGT = F.G * NTHR;
    for (int task = gt; task < 512 * 256; task += NGT) {
        const int run = task >> 8, cg = task & 255, ch = cg * 8, row0 = run * 32;
        float w[3][8], pm2[8], pm1[8], ng8[8];
        { const f32x4 a = *(const f32x4*)(ngp + ch), b = *(const f32x4*)(ngp + ch + 4); ng8[0] = a[0]; ng8[1] = a[1]; ng8[2] = a[2]; ng8[3] = a[3]; ng8[4] = b[0]; ng8[5] = b[1]; ng8[6] = b[2]; ng8[7] = b[3]; }
#pragma unroll
        for (int j = 0; j < 3; ++j) { const f32x4 a = *(const f32x4*)(sw + j * DM + ch), b = *(const f32x4*)(sw + j * DM + ch + 4);
            w[j][0] = a[0]; w[j][1] = a[1]; w[j][2] = a[2]; w[j][3] = a[3]; w[j][4] = b[0]; w[j][5] = b[1]; w[j][6] = b[2]; w[j][7] = b[3]; }
        if ((row0 & (SEQ - 1)) != 0) {
            float c1[8], u1[8];
            unpack8(*(const u32x4*)(proj + (size_t)(row0 - 2) * LDP + C_CC + ch), c1); unpack8(*(const u32x4*)(proj + (size_t)(row0 - 2) * LDP + C_CU + ch), u1);
#pragma unroll
            for (int k = 0; k < 8; ++k) pm2[k] = c1[k] * u1[k];
            unpack8(*(const u32x4*)(proj + (size_t)(row0 - 1) * LDP + C_CC + ch), c1); unpack8(*(const u32x4*)(proj + (size_t)(row0 - 1) * LDP + C_CU + ch), u1);
#pragma unroll
            for (int k = 0; k < 8; ++k) pm1[k] = c1[k] * u1[k];
        } else {
#pragma unroll
            for (int k = 0; k < 8; ++k) { pm2[k] = 0.f; pm1[k] = 0.f; }
        }
#pragma unroll 2
        for (int r = 0; r < 32; ++r) {
            const size_t pr = (size_t)(row0 + r) * LDP + ch, yr = (size_t)(row0 + r) * DM + ch;
            float cc[8], cu[8], cbv[8], g0[8], g1[8], g2[8], a[8], c[8], o[8];
            unpack8(*(const u32x4*)(proj + pr + C_CC), cc); unpack8(*(const u32x4*)(proj + pr + C_CU), cu); unpack8(*(const u32x4*)(proj + pr + C_CB), cbv);
            unpack8(*(const u32x4*)(proj + pr + C_GM), g0); unpack8(*(const u32x4*)(proj + pr + C_GM + DM), g1); unpack8(*(const u32x4*)(proj + pr + C_GM + 2 * DM), g2);
            unpack8(*(const u32x4*)(ya + yr), a); unpack8(*(const u32x4*)(yc + yr), c);
            const float rs = rstdp[(size_t)(row0 + r) * SSD_G + (ch >> 9)];
#pragma unroll
            for (int k = 0; k < 8; ++k) { const float pc = cc[k] * cu[k]; const float cv = w[0][k] * pm2[k] + w[1][k] * pm1[k] + w[2][k] * pc; pm2[k] = pm1[k]; pm1[k] = pc;
                o[k] = sigmoidf_(g0[k]) * a[k] + sigmoidf_(g1[k]) * (cbv[k] * cv) + sigmoidf_(g2[k]) * (c[k] * rs * ng8[k]); }
            *(u32x4*)(hb + yr) = pack8f(o);
            asm volatile("" ::: "memory");
        }
    }
}

DI void compress_phase(const Frame& F0, const Args& A, int layer) {
    const Frame F = phase_frame(F0);
    const bf16* proj = (const bf16*)(F.ws + WS_PROJ);
    LAS unsigned char* slab = F.lds;
    LAS unsigned char* hidl = F.lds + 73728;
    LAS float* b1s = (LAS float*)(F.lds + 81920);
    const int lane = F.lane, w = F.wave, i = lane & 15, qd = lane >> 4;
    const float* part = (const float*)(F.ws + WS_MISC);
    for (int u = F.bid; u < 512; u += F.G) {
        const int kv = u >> 8, b = (u >> 7) & 1, g = (u >> 5) & 3, nb = u & 31, n0 = nb * 16, tok0 = n0 * 16;
        const int col = (kv ? C_VC : C_KC) + g * HD;
        for (int id = F.tid; id < 272 * 16; id += NTHR) { const int row = id >> 4, ch = id & 15, t = tok0 + row;
            u32x4 v = {0u, 0u, 0u, 0u}; if (t < SEQ) v = *(const u32x4*)(proj + (size_t)(b * SEQ + t) * LDP + col + ch * 8);
            *(LAS u32x4*)(slab + off_b(row, ch)) = v; }
        if (F.tid < 128) { float s = ((const float*)argin(A, kv ? 12 : 8))[layer * 128 + F.tid];
#pragma unroll
            for (int c = 0; c < 8; ++c) s += part[(((size_t)layer * 2 + kv) * 8 + c) * 128 + F.tid];
            b1s[F.tid] = s; }
        __syncthreads();
        const bf16* w1t = (const bf16*)lw_ptr(F, layer, kv ? LW_PV1 : LW_PK1) + ((size_t)w * 128 * 64 + lane) * 8;
        f32x4 acc = {0.f, 0.f, 0.f, 0.f};
        for (int k0 = 0; k0 < 128; k0 += 32) {
            bf16x8 bb[32];
#pragma unroll
            for (int k = 0; k < 32; ++k) bb[k] = *(const bf16x8*)(w1t + 512 * (k0 + k));
#pragma unroll
            for (int k = 0; k < 32; ++k) { const int ks = k0 + k;
                acc = MFMA16(lds_rd8(slab + off_b(16 * i + (ks >> 2), 4 * (ks & 3) + qd)), bb[k], acc); }
        }
        { const float bv = b1s[16 * w + i];
#pragma unroll
          for (int j = 0; j < 4; ++j) *(LAS bf16*)(hidl + (4 * qd + j) * 272 + (16 * w + i) * 2) = (bf16)f2bf(siluf_(acc[j] + bv)); }
        __syncthreads();
        const bf16* w2t = (const bf16*)lw_ptr(F, layer, kv ? LW_PV2 : LW_PK2) + (size_t)(16 * w + i) * 128 + 8 * qd;
        f32x4 acc2 = {0.f, 0.f, 0.f, 0.f};
#pragma unroll
        for (int s = 0; s < 4; ++s) {
            const bf16x8 a = lds_rd8(hidl + i * 272 + 64 * s + 16 * qd);
            const bf16x8 bb = *(const bf16x8*)(w2t + 32 * s);
            acc2 = MFMA16(a, bb, acc2);
        }
        const float b2 = ((const float*)argin(A, kv ? 14 : 10))[layer * 128 + 16 * w + i];
        bf16* dst = (bf16*)(F.ws + (kv ? WS_VCMP : WS_KCMP)) + ((size_t)(b * NG + g) * NCMP_PAD + n0) * HD + 16 * w + i;
#pragma unroll
        for (int j = 0; j < 4; ++j) dst[(size_t)(4 * qd + j) * HD] = (bf16)f2bf(acc2[j] + b2);
        __syncthreads();
    }
}

DI void ssd_states_phase(const Frame& F0, const Args& A, int layer) {
    const Frame F = phase_frame(F0);
    const bf16* xbc = (const bf16*)(F.ws + WS_XBC); const float* dt = (const float*)(F.ws + WS_DT);
    float* acs = (float*)(F.ws + WS_ACS); float* cdec = (float*)(F.ws + WS_CDEC); float* st = (float*)(F.ws + WS_ST);
    LAS unsigned char* Bt = F.lds; LAS unsigned char* Xt = F.lds + 32768; LAS float* sc = (LAS float*)(F.lds + 65536);
    const float* alog = (const float*)argin(A, 19) + layer * SSD_H;
    const int lane = F.lane, w = F.wave, i = lane & 15, qd = lane >> 4;
    for (int u = F.bid; u < 512; u += F.G) {
        const int b = u >> 8, c = (u >> 2) & 63, g = u & 3, row0 = b * SEQ + c * SSD_CH;
        {
            const int hh = g * 8 + w; const float a = -__expf(alog[hh]);
            const float dt0 = dt[(size_t)(row0 + 2 * lane) * SSD_H + hh], dt1 = dt[(size_t)(row0 + 2 * lane + 1) * SSD_H + hh];
            const float d0 = dt0 * a, d1 = dt1 * a, pair = d0 + d1; float s = pair;
#pragma unroll
            for (int o = 1; o < 64; o <<= 1) { const float t = shfl_idx(s, lane - o); if (lane >= o) s += t; }
            const float a0 = (s - pair) + d0, a1 = s, total = __builtin_bit_cast(float, __builtin_amdgcn_readlane(__builtin_bit_cast(int, s), 63));
            acs[(size_t)(row0 + 2 * lane) * SSD_H + hh] = a0; acs[(size_t)(row0 + 2 * lane + 1) * SSD_H + hh] = a1;
            sc[w * 128 + 2 * lane] = dt0 * __expf(total - a0); sc[w * 128 + 2 * lane + 1] = dt1 * __expf(total - a1);
            if (lane == 0) cdec[(size_t)(b * SSD_NC + c) * SSD_H + hh] = __expf(total);
        }
        for (int id = F.tid; id < 128 * 16; id += NTHR) { const int row = id >> 4, ch = id & 15;
            *(LAS u32x4*)(Bt + off_b(row, ch)) = *(const u32x4*)(xbc + (size_t)(row0 + row) * SSD_XBC + 2048 + g * 128 + ch * 8); }
        bf16x8 bfr[4];
        for (int hp = 0; hp < 4; ++hp) {
            __syncthreads();
            for (int id = F.tid; id < 128 * 16; id += NTHR) { const int row = id >> 4, ch = id & 15;
                float x[8]; unpack8(*(const u32x4*)(xbc + (size_t)(row0 + row) * SSD_XBC + g * 512 + hp * 128 + ch * 8), x);
                const float f = sc[(hp * 2 + (ch >> 3)) * 128 + row];
#pragma unroll
                for (int k = 0; k < 8; ++k) x[k] *= f;
                *(LAS u32x4*)(Xt + off_b(row, ch)) = pack8f(x); }
            __syncthreads();
            if (hp == 0) {
#pragma unroll
                for (int ks = 0; ks < 4; ++ks) bfr[ks] = tr_read8(Bt, lane, 32 * ks, w);
            }
#pragma unroll
            for (int h2 = 0; h2 < 2; ++h2) {
                const int head = g * 8 + hp * 2 + h2;
                float* dst = st + ((size_t)((b * SSD_NC + c) * SSD_H + head) * SSD_N + 16 * w + i) * SSD_P + 4 * qd;
#pragma unroll
                for (int pt = 0; pt < 4; ++pt) {
                    f32x4 acc = {0.f, 0.f, 0.f, 0.f};
#pragma unroll
                    for (int ks = 0; ks < 4; ++ks) acc = MFMA16(tr_read8(Xt, lane, 32 * ks, h2 * 4 + pt), bfr[ks], acc);
                    *(f32x4*)(dst + 16 * pt) = acc;
                }
            }
        }
        __syncthreads();
    }
}
DI void ssd_scan_phase(const Frame& F0) {
    const Frame F = phase_frame(F0);
    const f32x4* st = (const f32x4*)(F.ws + WS_ST); u32x2* hin = (u32x2*)(F.ws + WS_HIN); const float* cdec = (const float*)(F.ws + WS_CDEC);
    const int gt = F.bid * NTHR + F.tid, NGT = F.G * NTHR;
    for (int v = gt; v < BATCH * SSD_H * 2048; v += NGT) {
        const int b = v >> 16, h = (v >> 11) & 31, e = v & 2047;
        const size_t o0 = ((size_t)(b * SSD_NC) * SSD_H + h) * 2048 + e;
        const float* dc = cdec + (size_t)(b * SSD_NC) * SSD_H + h;
        f32x4 hs = {0.f, 0.f, 0.f, 0.f};
        for (int c0 = 0; c0 < SSD_NC; c0 += 8) {
            f32x4 s[8]; float d[8];
#pragma unroll
            for (int k = 0; k < 8; ++k) { s[k] = st[o0 + (size_t)(c0 + k) * 65536]; d[k] = dc[(c0 + k) * SSD_H]; }
#pragma unroll
            for (int k = 0; k < 8; ++k) { u32x2 o; o.x = pk2(hs[0], hs[1]); o.y = pk2(hs[2], hs[3]); hin[o0 + (size_t)(c0 + k) * 65536] = o; hs = hs * d[k] + s[k]; }
        }
    }
}
DI void ssd_out_phase(const Frame& F0, const Args& A, int layer) {
    const Frame F = phase_frame(F0);
    const bf16* xbc = (const bf16*)(F.ws + WS_XBC); const bf16* proj = (const bf16*)(F.ws + WS_PROJ);
    const float* dt = (const float*)(F.ws + WS_DT); const float* acs = (const float*)(F.ws + WS_ACS); const bf16* hin = (const bf16*)(F.ws + WS_HIN);
    bf16* yc = (bf16*)(F.ws + WS_YC); float* rstdp = (float*)(F.ws + WS_RSTD);
    LAS unsigned char* Bt = F.lds; LAS unsigned char* Ct = F.lds + 32768; LAS unsigned char* Xt = F.lds + 65536; LAS unsigned char* Ht = F.lds + 98304;
    LAS float* acsl = (LAS float*)(F.lds + LX_OFF);
    const float* dsk = (const float*)argin(A, 20) + layer * SSD_H;
    const int lane = F.lane, w = F.wave, i = lane & 15, qd = lane >> 4;
    for (int u = F.bid; u < 512; u += F.G) {
        const int b = u >> 8, c = (u >> 2) & 63, g = u & 3, row0 = b * SEQ + c * SSD_CH;
        for (int id = F.tid; id < 128 * 16; id += NTHR) { const int row = id >> 4, ch = id & 15; const bf16* src = xbc + (size_t)(row0 + row) * SSD_XBC + 2048 + g * 128 + ch * 8;
            *(LAS u32x4*)(Bt + off_b(row, ch)) = *(const u32x4*)(src); *(LAS u32x4*)(Ct + off_b(row, ch)) = *(const u32x4*)(src + 512); }
        __syncthreads();
        bf16x8 cfr[4];
#pragma unroll
        for (int ks = 0; ks < 4; ++ks) cfr[ks] = lds_rd8(Ct + off_b(16 * w + i, 4 * ks + qd));
        f32x4 cb[4][2];
#pragma unroll
        for (int k = 0; k < 4; ++k)
#pragma unroll
            for (int T = 0; T < 2; ++T) { f32x4 acc = {0.f, 0.f, 0.f, 0.f};
#pragma unroll
                for (int ks = 0; ks < 4; ++ks) acc = MFMA16(lds_rd8(Bt + off_b(32 * k + 8 * (i >> 2) + (i & 3) + 4 * T, 4 * ks + qd)), cfr[ks], acc);
                cb[k][T] = acc; }
        const int lrow = 16 * w + i, row = row0 + lrow;
        float ssq = 0.f;
        for (int hp = 0; hp < 4; ++hp) {
            __syncthreads();
            if (F.tid < 256) { const int h2 = F.tid >> 7, l = F.tid & 127; acsl[F.tid] = acs[(size_t)(row0 + l) * SSD_H + g * 8 + hp * 2 + h2]; }
            for (int id = F.tid; id < 128 * 16; id += NTHR) { const int r = id >> 4, ch = id & 15, head = g * 8 + hp * 2 + (ch >> 3);
                float x[8]; unpack8(*(const u32x4*)(xbc + (size_t)(row0 + r) * SSD_XBC + g * 512 + hp * 128 + ch * 8), x);
                const float f = dt[(size_t)(row0 + r) * SSD_H + head];
#pragma unroll
                for (int k = 0; k < 8; ++k) x[k] *= f;
                *(LAS u32x4*)(Xt + off_b(r, ch)) = pack8f(x);
                *(LAS u32x4*)(Ht + off_b(r, ch)) = *(const u32x4*)(hin + ((size_t)((b * SSD_NC + c) * SSD_H + head) * SSD_N + r) * SSD_P + (ch & 7) * 8); }
            __syncthreads();
#pragma unroll
            for (int h2 = 0; h2 < 2; ++h2) {
                const int head = g * 8 + hp * 2 + h2;
                const float al = acsl[h2 * 128 + lrow], ea = __expf(al), dsv = dsk[head];
                bf16x8 mfr[4];
#pragma unroll
                for (int k = 0; k < 4; ++k) {
                    const f32x4 a0 = *(const LAS f32x4*)(acsl + h2 * 128 + 32 * k + 8 * qd), a1 = *(const LAS f32x4*)(acsl + h2 * 128 + 32 * k + 8 * qd + 4);
                    float mv[8];
#pragma unroll
                    for (int j = 0; j < 4; ++j) { const int s0 = 32 * k + 8 * qd + j, s1 = s0 + 4;
                        mv[j] = (s0 <= lrow) ? cb[k][0][j] * __expf(al - a0[j]) : 0.f;
                        mv[4 + j] = (s1 <= lrow) ? cb[k][1][j] * __expf(al - a1[j]) : 0.f; }
                    mfr[k] = as_bf16x8(pack8f(mv));
                }
#pragma unroll
                for (int pt = 0; pt < 4; ++pt) {
                    f32x4 yd = {0.f, 0.f, 0.f, 0.f}, yo = {0.f, 0.f, 0.f, 0.f};
#pragma unroll
                    for (int k = 0; k < 4; ++k) yd = MFMA16(tr_read8(Xt, lane, 32 * k, h2 * 4 + pt), mfr[k], yd);
#pragma unroll
                    for (int ks = 0; ks < 4; ++ks) yo = MFMA16(tr_read8(Ht, lane, 32 * ks, h2 * 4 + pt), cfr[ks], yo);
                    const int chn = head * SSD_P + 16 * pt + 4 * qd;
                    const u32x2 xv = *(const u32x2*)(xbc + (size_t)row * SSD_XBC + chn), zv = *(const u32x2*)(proj + (size_t)row * LDP + C_Z + chn);
                    const float xs[4] = {bflo(xv.x), bfhi(xv.x), bflo(xv.y), bfhi(xv.y)}, zz[4] = {bflo(zv.x), bfhi(zv.x), bflo(zv.y), bfhi(zv.y)};
                    float gy[4];
#pragma unroll
                    for (int j = 0; j < 4; ++j) { const float y = yd[j] + ea * yo[j] + dsv * xs[j]; gy[j] = y * siluf_(zz[j]); ssq += gy[j] * gy[j]; }
                    u32x2 o; o.x = pk2(gy[0], gy[1]); o.y = pk2(gy[2], gy[3]);
                    *(u32x2*)(yc + (size_t)row * DM + chn) = o;
                }
            }
        }
        ssq += shx(ssq, 16, lane); ssq += shx(ssq, 32, lane);
        if (qd == 0) rstdp[(size_t)row * SSD_G + g] = 1.0f / sqrtf(ssq * (1.0f / 512.0f) + EPS);
        __syncthreads();
    }
}

#ifndef NSA_REP_PART
#define NSA_REP_PART 0
#endif
#if NSA_REP_PART == 7
#define W7DUP(x) x
#define W7WAIT() NSA_WAITV(8)
#else
#define W7DUP(x)
#define W7WAIT() NSA_WAITV(4)
#endif
#if NSA_REP_PART == 10
#define SELDUP(x) x
#else
#define SELDUP(x)
#endif
constexpr int RB = 32768, NRING = 3;
#define NSA_WAITV(n) asm volatile("s_waitcnt vmcnt(" #n ")" ::: "memory")
#define NSA_BAR() do { asm volatile("" ::: "memory"); __builtin_amdgcn_s_barrier(); asm volatile("" ::: "memory"); } while (0)
template <bool WITHV> DI void tile_dma(LAS unsigned char* buf, const bf16* kp, const bf16* vp, int pitch, int w, int lane) {
#pragma unroll
    for (int e = 0; e < 2; ++e) { const int kb = 2 * w + e, kh = kb >> 3, T = (kb >> 2) & 1, ks = kb & 3, i = lane & 15, qd = lane >> 4;
        const int key = 32 * kh + 8 * (i >> 2) + (i & 3) + 4 * T, ch = 4 * ks + qd;
        __builtin_amdgcn_global_load_lds((const unsigned*)(kp + (size_t)key * pitch + ch * 8), (LAS unsigned*)(buf + kb * 1024), 16, 0, 0); }
    if (WITHV) {
#pragma unroll
        for (int e = 0; e < 2; ++e) { const int vb = 2 * w + e, kh = vb >> 3, t = (vb >> 2) & 1, dtp = vb & 3, dtl = lane >> 5, g = (lane >> 3) & 3, q = (lane >> 1) & 3, ph = lane & 1;
            const int key = 32 * kh + 8 * g + 4 * t + q, ch = 4 * dtp + 2 * dtl + ph;
            __builtin_amdgcn_global_load_lds((const unsigned*)(vp + (size_t)key * pitch + ch * 8), (LAS unsigned*)(buf + 16384 + vb * 1024), 16, 0, 0); }
    }
}
#define NSA_TR8(r, addr, b) asm volatile("ds_read_b64_tr_b16 %0, %8 offset:%9\n\tds_read_b64_tr_b16 %1, %8 offset:%10\n\tds_read_b64_tr_b16 %2, %8 offset:%11\n\tds_read_b64_tr_b16 %3, %8 offset:%12\n\t" \
        "ds_read_b64_tr_b16 %4, %8 offset:%13\n\tds_read_b64_tr_b16 %5, %8 offset:%14\n\tds_read_b64_tr_b16 %6, %8 offset:%15\n\tds_read_b64_tr_b16 %7, %8 offset:%16" \
        : "=&v"(r[0]), "=&v"(r[1]), "=&v"(r[2]), "=&v"(r[3]), "=&v"(r[4]), "=&v"(r[5]), "=&v"(r[6]), "=&v"(r[7]) \
        : "v"(addr), "i"((b)), "i"((b) + 4096), "i"((b) + 512), "i"((b) + 4608), "i"((b) + 1024), "i"((b) + 5120), "i"((b) + 1536), "i"((b) + 5632) : "memory")
#define NSA_TRWAIT(r) asm volatile("s_waitcnt lgkmcnt(0)" : "+v"(r[0]), "+v"(r[1]), "+v"(r[2]), "+v"(r[3]), "+v"(r[4]), "+v"(r[5]), "+v"(r[6]), "+v"(r[7]) :: "memory")
#define NSA_SB() __builtin_amdgcn_sched_barrier(0)
#define NSA_PV4(r, kh, d0) do { _Pragma("unroll") for (int q_ = 0; q_ < 4; ++q_) { const bf16x8 vf_ = __builtin_shufflevector(r[2 * q_], r[2 * q_ + 1], 0, 1, 2, 3, 4, 5, 6, 7); \
        if (SM & 1) O[0][(d0) + q_] = MFMA16(vf_, pf[0][kh], O[0][(d0) + q_]); if (SM & 2) O[1][(d0) + q_] = MFMA16(vf_, pf[1][kh], O[1][(d0) + q_]); } } while (0)
template <int MODE, int SM>
DI void attn_tile(LAS const unsigned char* Kt, LAS const unsigned char* Vt, const bf16x8 (&Qf)[2][4], f32x4 (&O)[2][8], float (&m)[2], float (&l)[2], const int (&lo)[2], const int (&hi)[2], bool needmask,
                  float c2, const float (&inv_l)[2], LAS float* imp, const int (&ql)[2], int jb0, float (&cin)[2], int lane) {
    const int qd = lane >> 4;
    f32x4 sc[2][2][2];
#pragma unroll
    for (int kh = 0; kh < 2; ++kh)
#pragma unroll
        for (int T = 0; T < 2; ++T) { f32x4 a0 = {0.f, 0.f, 0.f, 0.f}, a1 = {0.f, 0.f, 0.f, 0.f};
#pragma unroll
            for (int ks = 0; ks < 4; ++ks) { const bf16x8 kf = lds_rd8(Kt + (kh * 8 + T * 4 + ks) * 1024);
                if (SM & 1) a0 = MFMA16(kf, Qf[0][ks], a0); if (SM & 2) a1 = MFMA16(kf, Qf[1][ks], a1); }
            sc[0][kh][T] = a0; sc[1][kh][T] = a1; }
    const float NEG = -__builtin_inff();
    bf16x8 pf[2][2];
#pragma unroll
    for (int s = 0; s < 2; ++s) if (SM & (1 << s)) {
        if (needmask) {
#pragma unroll
            for (int kh = 0; kh < 2; ++kh)
#pragma unroll
                for (int T = 0; T < 2; ++T)
#pragma unroll
                    for (int j = 0; j < 4; ++j) { const int kk = 32 * kh + 8 * qd + 4 * T + j; if (kk < lo[s] || kk > hi[s]) sc[s][kh][T][j] = NEG; }
        }
        float mn = m[s];
        if (MODE != 2) {
            float tmax = fmaxf(fmaxf(sc[s][0][0][0], sc[s][0][0][1]), fmaxf(sc[s][0][0][2], sc[s][0][0][3]));
            tmax = fmaxf(tmax, fmaxf(fmaxf(sc[s][0][1][0], sc[s][0][1][1]), fmaxf(sc[s][0][1][2], sc[s][0][1][3])));
            tmax = fmaxf(tmax, fmaxf(fmaxf(sc[s][1][0][0], sc[s][1][0][1]), fmaxf(sc[s][1][0][2], sc[s][1][0][3])));
            tmax = fmaxf(tmax, fmaxf(fmaxf(sc[s][1][1][0], sc[s][1][1][1]), fmaxf(sc[s][1][1][2], sc[s][1][1][3])));
            tmax = xq_max(tmax);
            mn = fmaxf(m[s], tmax);
            if (__ballot(mn != m[s]) != 0ull) {
                const float alpha = __builtin_amdgcn_exp2f((m[s] - mn) * c2);
                l[s] *= alpha;
                if (MODE == 1) {
#pragma unroll
                    for (int dt = 0; dt < 8; ++dt) O[s][dt] = O[s][dt] * alpha;
                }
                m[s] = mn;
            }
        }
        const float nmc = -mn * c2; float ps = 0.f;
#pragma unroll
        for (int kh = 0; kh < 2; ++kh)
#pragma unroll
            for (int T = 0; T < 2; ++T)
#pragma unroll
                for (int j = 0; j < 4; ++j) { float p = __builtin_amdgcn_exp2f(__builtin_fmaf(sc[s][kh][T][j], c2, nmc)); if (MODE == 2) p *= inv_l[s]; sc[s][kh][T][j] = p; ps += p; }
        if (MODE != 2) l[s] += ps;
        if (MODE == 2) {
            float s4[2][2], cy[2][2];
#pragma unroll
            for (int kh = 0; kh < 2; ++kh)
#pragma unroll
                for (int T = 0; T < 2; ++T) {
                    float a = (sc[s][kh][T][0] + sc[s][kh][T][1]) + (sc[s][kh][T][2] + sc[s][kh][T][3]), c = sc[s][kh][T][3];
                    a = quad_sum(a); c = quad_sum(c);
                    s4[kh][T] = a; cy[kh][T] = c; }
            const float x0 = shfl_idx(cy[0][1], (lane - 16) & 63), x1 = shfl_idx(cy[1][1], (lane - 16) & 63);
            const float p00 = (qd == 0) ? cin[s] : x0, p10 = (qd == 0) ? x0 : x1;
            cin[s] = x1;
            if ((lane & 3) == 0) { const int jb = jb0 + 2 * qd;
                *(LAS f32x2*)(imp + ql[s] * 128 + jb) = (f32x2){s4[0][0] + p00, s4[0][1] + cy[0][0]};
                *(LAS f32x2*)(imp + ql[s] * 128 + jb + 8) = (f32x2){s4[1][0] + p10, s4[1][1] + cy[1][0]}; }
        }
        if (MODE != 0) {
#pragma unroll
            for (int kh = 0; kh < 2; ++kh) { u32x4 pw; pw.x = pk2(sc[s][kh][0][0], sc[s][kh][0][1]); pw.y = pk2(sc[s][kh][0][2], sc[s][kh][0][3]); pw.z = pk2(sc[s][kh][1][0], sc[s][kh][1][1]); pw.w = pk2(sc[s][kh][1][2], sc[s][kh][1][3]); pf[s][kh] = as_bf16x8(pw); }
        }
    }
    if (MODE != 0) {
        const unsigned va = (unsigned)(size_t)Vt;
        s16x4 ra[8], rb[8];
        NSA_TR8(ra, va, 0);     NSA_TRWAIT(ra); NSA_SB();
        NSA_TR8(rb, va, 2048);  NSA_SB(); NSA_PV4(ra, 0, 0); NSA_SB(); NSA_TRWAIT(rb); NSA_SB();
        NSA_TR8(ra, va, 8192);  NSA_SB(); NSA_PV4(rb, 0, 4); NSA_SB(); NSA_TRWAIT(ra); NSA_SB();
        NSA_TR8(rb, va, 10240); NSA_SB(); NSA_PV4(ra, 1, 0); NSA_SB(); NSA_TRWAIT(rb); NSA_SB();
        NSA_PV4(rb, 1, 4);
    }
}
template <bool FIRST> DI void nsa_emit(const f32x4 (&O)[8], float scale, bf16* dst  ) {
    u32x2 old[8];
    if (!FIRST) {
#pragma unroll
        for (int dt = 0; dt < 8; ++dt) old[dt] = *(const u32x2*)(dst + 16 * dt);
    }
#pragma unroll
    for (int dt = 0; dt < 8; ++dt) { f32x4 v = O[dt] * scale;
        if (!FIRST) { v[0] += bflo(old[dt].x); v[1] += bfhi(old[dt].x); v[2] += bflo(old[dt].y); v[3] += bfhi(old[dt].y); }
        u32x2 o; o.x = pk2(v[0], v[1]); o.y = pk2(v[2], v[3]); *(u32x2*)(dst + 16 * dt) = o; }
}
DI int next_bit(unsigned u0, unsigned u1, unsigned u2, unsigned u3, int from) {
    if (from >= 128) return -1;
    const int wd = from >> 5; const unsigned msk = ~0u << (from & 31);
    const unsigned x0 = (wd == 0) ? (u0 & msk) : 0u;
    const unsigned x1 = (wd < 1) ? u1 : ((wd == 1) ? (u1 & msk) : 0u);
    const unsigned x2 = (wd < 2) ? u2 : ((wd == 2) ? (u2 & msk) : 0u);
    const unsigned x3 = (wd < 3) ? u3 : (u3 & msk);
    if (x0) return __builtin_ctz(x0);
    if (x1) return 32 + __builtin_ctz(x1);
    if (x2) return 64 + __builtin_ctz(x2);
    if (x3) return 96 + __builtin_ctz(x3);
    return -1;
}

DI void nsa_phase(const Frame& F0, const Args& A, int layer) {
    const Frame F = phase_frame(F0);
    const bf16* proj = (const bf16*)(F.ws + WS_PROJ); const bf16* kcmp = (const bf16*)(F.ws + WS_KCMP); const bf16* vcmp = (const bf16*)(F.ws + WS_VCMP);
    bf16* ya = (bf16*)(F.ws + WS_YA);
    LAS unsigned char* const RG = F.lds;
    LAS float* imp = (LAS float*)(F.lds + NRING * RB);
    LAS unsigned* selm = (LAS unsigned*)(F.lds + NRING * RB + 32768); LAS unsigned* uml = selm + 256;
    static_assert(NRING * RB + 32768 + 1024 + 16 <= LDSCTL_OFF && NRING * RB + 32768 == 4 * RB, "nsa LDS map (the selected loop's pair buffers overlay ring + importance table)");
    const float c2 = 0.08838834764831845f * 1.4426950408889634f;
    (void)A; (void)layer;
    for (int u = F.bid; u < 1024; u += F.G) {
        int tid_l = F.tid; asm volatile("" : "+v"(tid_l));
        const int tid = tid_l, lane = tid & 63, w = F.wave, i = lane & 15, qd = lane >> 4, hd = i & 3;
        const int klane = 16 * lane, vlane = 16384 + 8 * lane;
        const int xg = u & 7, jj = (u >> 3) & 31, rr = u >> 8;
        const int b = xg >> 2, g = xg & 3;
        const int qt = (rr == 0) ? 127 - jj : (rr == 1) ? 64 + jj : (rr == 2) ? 63 - jj : jj;
        const int s0 = qt * 64, cur = qt, rowb = b * SEQ;
        int ql[2], trow[2]; bf16x8 Qf[2][4];
#pragma unroll
        for (int s = 0; s < 2; ++s) { ql[s] = 8 * w + 4 * s + (i >> 2); trow[s] = rowb + s0 + ql[s];
#pragma unroll
            for (int ks = 0; ks < 4; ++ks) Qf[s][ks] = *(const bf16x8*)(proj + (size_t)trow[s] * LDP + C_Q + (4 * g + hd) * HD + 32 * ks + 8 * qd); }
        f32x4 O[2][8]; float mrow[2], lrow[2], cin[2], invl[2] = {0.f, 0.f};
        const int ntc = (4 * qt + 3 + 63) >> 6;
        const bf16* kc0 = kcmp + (size_t)(b * NG + g) * NCMP_PAD * HD; const bf16* vc0 = vcmp + (size_t)(b * NG + g) * NCMP_PAD * HD;
        int nmax[2];
#pragma unroll
        for (int s = 0; s < 2; ++s) { const int t = s0 + ql[s]; nmax[s] = (t >= 31) ? ((t - 31) >> 4) : -1; mrow[s] = -1e30f; lrow[s] = 0.f; cin[s] = 0.f; }
        for (int rep_ = 0; rep_ < (NSA_REP_PART == 2 ? 2 : 1); ++rep_) {
#pragma unroll
        for (int s = 0; s < 2; ++s) { mrow[s] = -1e30f; lrow[s] = 0.f; cin[s] = 0.f; }
        NSA_WAITV(0); NSA_BAR();
        tile_dma<false>(RG, kc0, vc0, HD, w, lane); if (ntc > 1) tile_dma<false>(RG + RB, kc0 + (size_t)64 * HD, vc0, HD, w, lane);
        for (int tc = 0, rb = 0; tc < ntc; ++tc) {
            if (tc + 1 < ntc) NSA_WAITV(2); else NSA_WAITV(0);
            NSA_BAR();
            if (tc + 2 < ntc) { const int nb2 = (rb + 2 >= NRING) ? rb + 2 - NRING : rb + 2; tile_dma<false>(RG + nb2 * RB, kc0 + (size_t)(tc + 2) * 64 * HD, vc0, HD, w, lane); }
            { const int lo2[2] = {0, 0}, hi2[2] = {nmax[0] - 64 * tc, nmax[1] - 64 * tc}; const bool nm = __ballot(hi2[0] < 63 || hi2[1] < 63) != 0ull;
              attn_tile<0, 3>(RG + rb * RB + klane, RG, Qf, O, mrow, lrow, lo2, hi2, nm, c2, invl, imp, ql, 0, cin, lane); }
            rb = (rb + 1 == NRING) ? 0 : rb + 1;
        }
#pragma unroll
        for (int s = 0; s < 2; ++s) { float lt = lrow[s]; lt = xq_sum(lt); invl[s] = (lt > 0.f) ? 1.0f / lt : 0.f;
#pragma unroll
            for (int dt = 0; dt < 8; ++dt) O[s][dt] = (f32x4){0.f, 0.f, 0.f, 0.f}; }
        NSA_BAR();
        tile_dma<true>(RG, kc0, vc0, HD, w, lane); if (ntc > 1) tile_dma<true>(RG + RB, kc0 + (size_t)64 * HD, vc0 + (size_t)64 * HD, HD, w, lane);
        for (int tc = 0, rb = 0; tc < ntc; ++tc) {
            if (tc + 1 < ntc) NSA_WAITV(4); else NSA_WAITV(0);
            NSA_BAR();
            if (tc + 2 < ntc) { const int nb2 = (rb + 2 >= NRING) ? rb + 2 - NRING : rb + 2; tile_dma<true>(RG + nb2 * RB, kc0 + (size_t)(tc + 2) * 64 * HD, vc0 + (size_t)(tc + 2) * 64 * HD, HD, w, lane); }
            { const int lo2[2] = {0, 0}, hi2[2] = {nmax[0] - 64 * tc, nmax[1] - 64 * tc}; const bool nm = __ballot(hi2[0] < 63 || hi2[1] < 63) != 0ull;
              attn_tile<2, 3>(RG + rb * RB + klane, RG + rb * RB + vlane, Qf, O, mrow, lrow, lo2, hi2, nm, c2, invl, imp, ql, 16 * tc, cin, lane); }
            rb = (rb + 1 == NRING) ? 0 : rb + 1;
        }
#pragma unroll
        for (int s = 0; s < 2; ++s) { const float gate = sigmoidf_(bf2f(proj[(size_t)trow[s] * LDP + C_GN + (4 * g + hd) * 3 + 0]));
            nsa_emit<true>(O[s], gate, ya + (size_t)trow[s] * DM + (4 * g + hd) * HD + 4 * qd); }
        }
        for (int rep_ = 0; rep_ < (NSA_REP_PART == 1 ? 2 : 1); ++rep_) {
            LDS_WAIT();
            const int nforced = (cur == 0) ? 1 : (cur == 1) ? 2 : 3; const int nsel = (cur + 1 < NSEL) ? cur + 1 : NSEL; const int R = nsel - nforced;
            const int E = (cur >= 3) ? cur - 2 : 0;
            for (int q8 = 0; q8 < 8; ++q8) {
                const int q = 8 * w + q8;
                const int j0 = lane, j1 = lane + 64;
                const bool e0 = (j0 >= 1) && (j0 <= cur - 2), e1 = (j1 <= cur - 2);
                const bool f0 = (j0 == 0) || (j0 == cur) || (j0 == cur - 1), f1 = (j1 == cur) || (j1 == cur - 1);
                bool s0 = e0, s1 = e1;
                if (R < E) {
                    const unsigned k0 = e0 ? __builtin_bit_cast(unsigned, imp[q * 128 + j0]) + 1u : 0u, k1 = e1 ? __builtin_bit_cast(unsigned, imp[q * 128 + j1]) + 1u : 0u;
                    unsigned T = 0u;
#pragma unroll 1
                    for (int bit = 30; bit >= 0; --bit) { const unsigned c = T | (1u << bit);
                        const int n = __builtin_popcountll(__ballot(k0 >= c)) + __builtin_popcountll(__ballot(k1 >= c));
                        if (n >= R) T = c; }
                    const unsigned long long eq0 = __ballot(k0 == T), eq1 = __ballot(k1 == T);
                    const int G = __builtin_popcountll(__ballot(k0 > T)) + __builtin_popcountll(__ballot(k1 > T));
                    const unsigned long long lt = (1ull << lane) - 1ull;
                    const int r0 = __builtin_popcountll(eq0 & lt), r1 = __builtin_popcountll(eq0) + __builtin_popcountll(eq1 & lt);
                    s0 = (k0 > T) || (k0 == T && r0 < R - G); s1 = (k1 > T) || (k1 == T && r1 < R - G);
                }
                const unsigned long long m0 = __ballot(f0 || s0), m1 = __ballot(f1 || s1);
                if (lane == 0) { selm[q * 4 + 0] = (unsigned)m0; selm[q * 4 + 1] = (unsigned)(m0 >> 32); selm[q * 4 + 2] = (unsigned)m1; selm[q * 4 + 3] = (unsigned)(m1 >> 32); }
            }
            __syncthreads();
            if (w == 0) { unsigned x0 = selm[lane * 4 + 0], x1 = selm[lane * 4 + 1], x2 = selm[lane * 4 + 2], x3 = selm[lane * 4 + 3];
#pragma unroll
                for (int o = 1; o < 64; o <<= 1) { x0 |= shfl_idx_u(x0, lane ^ o); x1 |= shfl_idx_u(x1, lane ^ o); x2 |= shfl_idx_u(x2, lane ^ o); x3 |= shfl_idx_u(x3, lane ^ o); }
                if (lane == 0) { uml[0] = x0; uml[1] = x1; uml[2] = x2; uml[3] = x3; } }
            __syncthreads();
        }
        const unsigned um0 = __builtin_amdgcn_readfirstlane(uml[0]), um1 = __builtin_amdgcn_readfirstlane(uml[1]), um2 = __builtin_amdgcn_readfirstlane(uml[2]), um3 = __builtin_amdgcn_readfirstlane(uml[3]);
        for (int rep_ = 0; rep_ < (NSA_REP_PART == 3 ? 2 : 1); ++rep_) {
            const bf16* ks0 = proj + (size_t)rowb * LDP + C_KS + g * HD; const bf16* vs0 = proj + (size_t)rowb * LDP + C_VS + g * HD;
#pragma unroll
            for (int s = 0; s < 2; ++s) { mrow[s] = -1e30f; lrow[s] = 0.f;
#pragma unroll
                for (int dt = 0; dt < 8; ++dt) O[s][dt] = (f32x4){0.f, 0.f, 0.f, 0.f}; }
            int ja = next_bit(um0, um1, um2, um3, 0), jbb = next_bit(um0, um1, um2, um3, ja + 1), pbuf = 0;
            VM_WAIT(); if (NSA_REP_PART == 3) NSA_BAR();
            tile_dma<true>(RG, ks0 + (size_t)ja * 64 * LDP, vs0 + (size_t)ja * 64 * LDP, LDP, w, lane); SELDUP(tile_dma<true>(RG, ks0 + (size_t)ja * 64 * LDP, vs0 + (size_t)ja * 64 * LDP, LDP, w, lane);)
            if (jbb >= 0) tile_dma<true>(RG + RB, ks0 + (size_t)jbb * 64 * LDP, vs0 + (size_t)jbb * 64 * LDP, LDP, w, lane); SELDUP(tile_dma<true>(RG + RB, ks0 + (size_t)jbb * 64 * LDP, vs0 + (size_t)jbb * 64 * LDP, LDP, w, lane);)
            while (ja >= 0) {
                const int jc = (jbb >= 0) ? next_bit(um0, um1, um2, um3, jbb + 1) : -1, jd = (jc >= 0) ? next_bit(um0, um1, um2, um3, jc + 1) : -1;
                NSA_WAITV(0);
                NSA_BAR();
                if (jc >= 0) { LAS unsigned char* nb = RG + (pbuf ^ 1) * 2 * RB; tile_dma<true>(nb, ks0 + (size_t)jc * 64 * LDP, vs0 + (size_t)jc * 64 * LDP, LDP, w, lane); SELDUP(tile_dma<true>(nb, ks0 + (size_t)jc * 64 * LDP, vs0 + (size_t)jc * 64 * LDP, LDP, w, lane);)
                    if (jd >= 0) tile_dma<true>(nb + RB, ks0 + (size_t)jd * 64 * LDP, vs0 + (size_t)jd * 64 * LDP, LDP, w, lane); SELDUP(tile_dma<true>(nb + RB, ks0 + (size_t)jd * 64 * LDP, vs0 + (size_t)jd * 64 * LDP, LDP, w, lane);) }
#pragma unroll 1
                for (int e2 = 0; e2 < 2; ++e2) { const int jb = e2 ? jbb : ja; if (jb < 0) break;
                  const bool act0 = (selm[ql[0] * 4 + (jb >> 5)] >> (jb & 31)) & 1u, act1 = (selm[ql[1] * 4 + (jb >> 5)] >> (jb & 31)) & 1u;
                  const bool any0 = __ballot(act0) != 0ull, any1 = __ballot(act1) != 0ull;
                  const int lo2[2] = {0, 0}, hi2[2] = {act0 ? ((jb < cur) ? 63 : ql[0]) : -1, act1 ? ((jb < cur) ? 63 : ql[1]) : -1};
                  LAS const unsigned char* kt = RG + (pbuf * 2 + e2) * RB + klane; LAS const unsigned char* vt = RG + (pbuf * 2 + e2) * RB + vlane;
                  if (any0 && any1) { const bool nm = __ballot(hi2[0] < 63 || hi2[1] < 63) != 0ull; attn_tile<1, 3>(kt, vt, Qf, O, mrow, lrow, lo2, hi2, nm, c2, invl, imp, ql, 0, cin, lane); }
                  else if (any0) { const bool nm = __ballot(hi2[0] < 63) != 0ull; attn_tile<1, 1>(kt, vt, Qf, O, mrow, lrow, lo2, hi2, nm, c2, invl, imp, ql, 0, cin, lane); }
                  else if (any1) { const bool nm = __ballot(hi2[1] < 63) != 0ull; attn_tile<1, 2>(kt, vt, Qf, O, mrow, lrow, lo2, hi2, nm, c2, invl, imp, ql, 0, cin, lane); } }
                ja = jc; jbb = jd; pbuf ^= 1;
            }
            NSA_BAR();
#pragma unroll
            for (int s = 0; s < 2; ++s) { float lt = lrow[s]; lt = xq_sum(lt);
                const float gate = sigmoidf_(bf2f(proj[(size_t)trow[s] * LDP + C_GN + (4 * g + hd) * 3 + 1]));
                if (rep_ == 0) nsa_emit<false>(O[s], (lt > 0.f) ? gate / lt : 0.f, ya + (size_t)trow[s] * DM + (4 * g + hd) * HD + 4 * qd); }
        }
        for (int rep_ = 0; rep_ < (NSA_REP_PART == 4 ? 2 : 1); ++rep_) {
            const bf16* kw0 = proj + (size_t)rowb * LDP + C_KW + g * HD; const bf16* vw0 = proj + (size_t)rowb * LDP + C_VW + g * HD;
#pragma unroll
            for (int s = 0; s < 2; ++s) { mrow[s] = -1e30f; lrow[s] = 0.f;
#pragma unroll
                for (int dt = 0; dt < 8; ++dt) O[s][dt] = (f32x4){0.f, 0.f, 0.f, 0.f}; }
#if NSA_REP_PART == 8
            {
            const int tt0d = (qt >= 8) ? 0 : 8 - qt;
            VM_WAIT(); NSA_BAR();
            { const size_t r0 = (size_t)(s0 - 512 + 64 * tt0d) * LDP; tile_dma<true>(RG, kw0 + r0, vw0 + r0, LDP, w, lane); W7DUP(tile_dma<true>(RG, kw0 + r0, vw0 + r0, LDP, w, lane);) }
            if (tt0d < 8) { const size_t r0 = (size_t)(s0 - 512 + 64 * (tt0d + 1)) * LDP; tile_dma<true>(RG + RB, kw0 + r0, vw0 + r0, LDP, w, lane); W7DUP(tile_dma<true>(RG + RB, kw0 + r0, vw0 + r0, LDP, w, lane);) }
            for (int tt = tt0d, rb = 0; tt <= 8; ++tt) {
                if (tt < 8) { W7WAIT(); } else NSA_WAITV(0);
                NSA_BAR();
                if (tt + 2 <= 8) { const int nb2 = (rb + 2 >= NRING) ? rb + 2 - NRING : rb + 2; const size_t r0 = (size_t)(s0 - 512 + 64 * (tt + 2)) * LDP; tile_dma<true>(RG + nb2 * RB, kw0 + r0, vw0 + r0, LDP, w, lane); W7DUP(tile_dma<true>(RG + nb2 * RB, kw0 + r0, vw0 + r0, LDP, w, lane);) }
                rb = (rb + 1 == NRING) ? 0 : rb + 1;
            }
            }
#endif
            const int tt0 = (qt >= 8) ? 0 : 8 - qt;
            VM_WAIT(); NSA_BAR();
            { const size_t r0 = (size_t)(s0 - 512 + 64 * tt0) * LDP; tile_dma<true>(RG, kw0 + r0, vw0 + r0, LDP, w, lane); W7DUP(tile_dma<true>(RG, kw0 + r0, vw0 + r0, LDP, w, lane);) }
            if (tt0 < 8) { const size_t r0 = (size_t)(s0 - 512 + 64 * (tt0 + 1)) * LDP; tile_dma<true>(RG + RB, kw0 + r0, vw0 + r0, LDP, w, lane); W7DUP(tile_dma<true>(RG + RB, kw0 + r0, vw0 + r0, LDP, w, lane);) }
            for (int tt = tt0, rb = 0; tt <= 8; ++tt) {
                if (tt < 8) { W7WAIT(); } else NSA_WAITV(0);
                NSA_BAR();
                if (tt + 2 <= 8) { const int nb2 = (rb + 2 >= NRING) ? rb + 2 - NRING : rb + 2; const size_t r0 = (size_t)(s0 - 512 + 64 * (tt + 2)) * LDP; tile_dma<true>(RG + nb2 * RB, kw0 + r0, vw0 + r0, LDP, w, lane); W7DUP(tile_dma<true>(RG + nb2 * RB, kw0 + r0, vw0 + r0, LDP, w, lane);) }
                { const int lo2[2] = {(tt == 0) ? ql[0] + 1 : 0, (tt == 0) ? ql[1] + 1 : 0}, hi2[2] = {(tt == 8) ? ql[0] : 63, (tt == 8) ? ql[1] : 63};
                  attn_tile<1, 3>(RG + rb * RB + klane, RG + rb * RB + vlane, Qf, O, mrow, lrow, lo2, hi2, (tt == 0) || (tt == 8), c2, invl, imp, ql, 0, cin, lane);
#if NSA_REP_PART == 5
                  { const int him[2] = {-1, -1}; attn_tile<1, 3>(RG + rb * RB + klane, RG + rb * RB + vlane, Qf, O, mrow, lrow, lo2, him, true, c2, invl, imp, ql, 0, cin, lane); }
#endif
#if NSA_REP_PART == 6
                  NSA_BAR(); NSA_BAR(); NSA_BAR(); NSA_BAR();
#endif
                }
                rb = (rb + 1 == NRING) ? 0 : rb + 1;
            }
            VM_WAIT();
#pragma unroll
            for (int s = 0; s < 2; ++s) { float lt = lrow[s]; lt = xq_sum(lt);
                const float gate = sigmoidf_(bf2f(proj[(size_t)trow[s] * LDP + C_GN + (4 * g + hd) * 3 + 2]));
                if (rep_ == 0) nsa_emit<false>(O[s], (lt > 0.f) ? gate / lt : 0.f, ya + (size_t)trow[s] * DM + (4 * g + hd) * HD + 4 * qd); }
        }
        __syncthreads();
    }
}

#if defined(CHECK_BUILD) && CHECK_BUILD
DI unsigned hash_u(unsigned x) { x ^= x >> 16; x *= 0x7feb352du; x ^= x >> 15; x *= 0x846ca68bu; x ^= x >> 16; return x; }
DI float blk_sum(float v, LAS float* red, int tid, int nthr) {
    for (int o = 32; o >= 1; o >>= 1) v += __shfl_xor(v, o);
    __syncthreads(); if ((tid & 63) == 0) red[tid >> 6] = v; __syncthreads();
    float s = 0.f; for (int k = 0; k < nthr / 64; ++k) s += red[k]; __syncthreads(); return s;
}
__global__ void chk_proj(Args args) {
    const int lane = threadIdx.x & 63, smp = blockIdx.x * (blockDim.x >> 6) + (threadIdx.x >> 6);
    const bf16* hb = (const bf16*)(args.ws + WS_HB); const bf16* proj = (const bf16*)(args.ws + WS_PROJ); const float* win = (const float*)args.in[4]; const int* pos = (const int*)args.in[2];
    unsigned* res = (unsigned*)(args.ws + WS_CTL) + CW_CHK;
    const unsigned h = hash_u(smp * 2654435761u + 12345u);
    int row = h % M; if (smp < 4) row = (smp == 0) ? 0 : (smp == 1) ? 8191 : (smp == 2) ? 8192 : 16383;
    const int kind = smp % 15; const unsigned h2 = hash_u(h + 77u);
    const int srcb[15] = {0, 2048, 2560, 3072, 3584, 4096, 4608, 5120, 5168, 7216, 9264, 11312, 13360, 16432, 16464};
    const int dstb[15] = {C_Q, C_KC, C_VC, C_KS, C_VS, C_KW, C_VW, C_GN, C_CB, C_CC, C_CU, C_Z, C_XBC, C_DT, C_GM};
    const int wid[15] = {2048, 512, 512, 512, 512, 512, 512, 48, 2048, 2048, 2048, 2048, 3072, 32, 6144};
    const bool rope = (kind == 0 || kind == 1 || kind == 3 || kind == 5);
    int e = h2 % wid[kind]; if (rope) e = (e / 128) * 128 + (e % 64);
    float d0 = 0.f, d1 = 0.f;
    for (int k = lane; k < DM; k += 64) { const float a = bf2f(hb[(size_t)row * DM + k]); d0 += a * win[(size_t)k * PROJ_SRC + srcb[kind] + e]; if (rope) d1 += a * win[(size_t)k * PROJ_SRC + srcb[kind] + e + 64]; }
    for (int o = 32; o >= 1; o >>= 1) { d0 += __shfl_xor(d0, o); d1 += __shfl_xor(d1, o); }
    float e0 = d0, e1 = d1;
    if (rope) { const double inv = exp(-(double)(2 * (e % 64)) / 128.0 * 9.210340371976184); double ang = (double)pos[row] * inv; ang -= 6.283185307179586476925 * __builtin_rint(ang * 0.15915494309189533577); const float c = cosf((float)ang), s = sinf((float)ang); e0 = d0 * c - d1 * s; e1 = d1 * c + d0 * s; }
    if (lane == 0) {
        const float g0 = bf2f(proj[(size_t)row * LDP + dstb[kind] + e]); float err = fabsf(g0 - e0) / (0.03f + 0.02f * fabsf(e0));
        if (rope) { const float g1 = bf2f(proj[(size_t)row * LDP + dstb[kind] + e + 64]); err = fmaxf(err, fabsf(g1 - e1) / (0.03f + 0.02f * fabsf(e1))); }
        if (!(err <= 1.0f)) atomicAdd(res + 0, 1u);
        atomicMax(res + 1, __float_as_uint(fminf(err, 1e6f)));
    }
}
__global__ void chk_cmp(Args args) {
    __shared__ float hid[128];
    const int tid = threadIdx.x, smp = blockIdx.x;
    const unsigned h = hash_u(smp * 40503u + 99u);
    const int kv = smp & 1, b = (smp >> 1) & 1, g = (smp >> 2) & 3; int n = h % NCMP; if (smp < 8) n = (smp < 4) ? 0 : 510;
    const bf16* proj = (const bf16*)(args.ws + WS_PROJ);
    const float* pe = (const float*)args.in[kv ? 6 : 5]; const float* w1 = (const float*)args.in[kv ? 11 : 7]; const float* b1 = (const float*)args.in[kv ? 12 : 8];
    const float* w2 = (const float*)args.in[kv ? 13 : 9]; const float* b2 = (const float*)args.in[kv ? 14 : 10];
    const bf16* out = (const bf16*)(args.ws + (kv ? WS_VCMP : WS_KCMP));
    unsigned* res = (unsigned*)(args.ws + WS_CTL) + CW_CHK;
    float s = b1[tid];
    for (int l = 0; l < 32; ++l) { const bf16* kr = proj + (size_t)(b * SEQ + 16 * n + l) * LDP + (kv ? C_VC : C_KC) + g * HD;
        for (int d = 0; d < 128; ++d) s += (bf2f(kr[d]) + pe[l * 128 + d]) * w1[(size_t)(l * 128 + d) * 128 + tid]; }
    hid[tid] = s / (1.0f + expf(-s));
    __syncthreads();
    float o = b2[tid];
    for (int k = 0; k < 128; ++k) o += hid[k] * w2[k * 128 + tid];
    const float got = bf2f(out[((size_t)(b * NG + g) * NCMP_PAD + n) * HD + tid]);
    const float err = fabsf(got - o) / (0.02f + 0.02f * fabsf(o));
    if (!(err <= 1.0f)) atomicAdd(res + 2, 1u);
    atomicMax(res + 3, __float_as_uint(fminf(err, 1e6f)));
}
constexpr int CHK_NT = 24;
__global__ void __launch_bounds__(256) chk_nsa(Args args) {
    __shared__ float qf[4][128], oacc[4][128], obr[4][128], sc[4][1024], imp[128], red[8];
    __shared__ int kl[1024], seln[16], usedl[128];
    const int tlist[CHK_NT] = {0, 1, 30, 31, 47, 63, 64, 65, 127, 128, 500, 511, 512, 513, 575, 1023, 1024, 1087, 2000, 4095, 4096, 6000, 8128, 8191};
    const int tid = threadIdx.x, smp = blockIdx.x;
    const int t = tlist[smp % CHK_NT], bg = (smp / CHK_NT + smp) & 7, b = bg >> 2, g = bg & 3, row = b * SEQ + t, cur = t >> 6;
    const bf16* proj = (const bf16*)(args.ws + WS_PROJ); const bf16* kcmp = (const bf16*)(args.ws + WS_KCMP) + (size_t)(b * NG + g) * NCMP_PAD * HD; const bf16* vcmp = (const bf16*)(args.ws + WS_VCMP) + (size_t)(b * NG + g) * NCMP_PAD * HD;
    const bf16* ya = (const bf16*)(args.ws + WS_YA);
    unsigned* res = (unsigned*)(args.ws + WS_CTL) + CW_CHK;
    const float scale = 0.08838834764831845f;
    for (int k = tid; k < 512; k += 256) { const int r = k >> 7, d = k & 127; qf[r][d] = bf2f(proj[(size_t)row * LDP + C_Q + (4 * g + r) * HD + d]); oacc[r][d] = 0.f; }
    __syncthreads();
    for (int br = 0; br < 3; ++br) {
        int nk = 0;
        if (br == 0) { nk = (t >= 31) ? ((t - 31) >> 4) + 1 : 0; for (int k = tid; k < nk; k += 256) kl[k] = k; }
        else if (br == 1) {
            if (tid == 0) {
                for (int j = 0; j < 128; ++j) usedl[j] = 0;
                for (int it = 0; it < 16; ++it) { int best = -1; float bv = 0.f;
                    for (int j = 0; j < 128; ++j) { if (usedl[j]) continue; const bool valid = (64 * j <= t); const bool forced = (j == 0) || (j == cur) || (j == cur - 1);
                        const float v = valid ? imp[j] + (forced ? 1.0e4f : 0.f) : -__builtin_inff();
                        if (best < 0 || v > bv) { best = j; bv = v; } }
                    usedl[best] = 1; seln[it] = best; } }
            __syncthreads();
            for (int k = tid; k < 1024; k += 256) kl[k] = seln[k >> 6] * 64 + (k & 63);
            nk = 1024;
        } else { nk = 576; for (int k = tid; k < 576; k += 256) kl[k] = (t & ~63) - WIN + k; }
        __syncthreads();
        for (int idx = tid; idx < 4 * nk; idx += 256) { const int r = idx / nk, k = idx - r * nk, key = kl[k];
            bool ok; const bf16* kp;
            if (br == 0) { ok = true; kp = kcmp + (size_t)key * HD; }
            else if (br == 1) { ok = (key <= t); kp = proj + (size_t)(b * SEQ + key) * LDP + C_KS + g * HD; }
            else { ok = (key >= 0) && (key <= t) && (key > t - WIN); kp = proj + (size_t)(b * SEQ + (key < 0 ? 0 : key)) * LDP + C_KW + g * HD; }
            float s = 0.f; for (int d = 0; d < 128; ++d) s += qf[r][d] * bf2f(kp[d]);
            sc[r][k] = ok ? s * scale : -__builtin_inff(); }
        __syncthreads();
        if (tid < 4) { float m = -__builtin_inff(); for (int k = 0; k < nk; ++k) m = fmaxf(m, sc[tid][k]);
            const float mm = (m > -1e30f) ? m : 0.f; float l = 0.f; for (int k = 0; k < nk; ++k) { const float e = (sc[tid][k] > -1e30f) ? expf(sc[tid][k] - mm) : 0.f; sc[tid][k] = e; l += e; }
            const float il = (l > 0.f) ? 1.0f / l : 0.f; for (int k = 0; k < nk; ++k) sc[tid][k] *= il; }
        __syncthreads();
        if (br == 0) { if (tid < 128) { float s = 0.f; for (int r = 0; r < 4; ++r) for (int n = 4 * tid - 1; n <= 4 * tid + 3; ++n) if (n >= 0 && n < nk) s += sc[r][n]; imp[tid] = s; } }
        for (int o = tid; o < 512; o += 256) { const int r = o >> 7, d = o & 127; float s = 0.f;
            for (int k = 0; k < nk; ++k) { const float p = sc[r][k]; if (p == 0.f) continue; const int key = kl[k];
                const bf16* vp = (br == 0) ? vcmp + (size_t)key * HD : proj + (size_t)(b * SEQ + key) * LDP + (br == 1 ? C_VS : C_VW) + g * HD;
                s += p * bf2f(vp[d]); }
            const float gate = 1.0f / (1.0f + expf(-bf2f(proj[(size_t)row * LDP + C_GN + (4 * g + r) * 3 + br])));
            oacc[r][d] += gate * s; obr[r][d] = s; }
        __syncthreads();
    }
    float errm = 0.f;
    for (int o = tid; o < 512; o += 256) { const int r = o >> 7, d = o & 127; const float got = bf2f(ya[(size_t)row * DM + (4 * g + r) * HD + d]), ex = oacc[r][d] * (CHECK_BUILD == 2 ? ((smp & 1) ? 1.5f : 1.0f) : 1.0f);
        errm = fmaxf(errm, fabsf(got - ex) / (0.006f + 0.03f * fabsf(ex))); }
    for (int o = 32; o >= 1; o >>= 1) errm = fmaxf(errm, __shfl_xor(errm, o));
    if ((tid & 63) == 0) red[tid >> 6] = errm;
    __syncthreads();
    if (tid == 0) { const float e = fmaxf(fmaxf(red[0], red[1]), fmaxf(red[2], red[3])); if (!(e <= 1.0f)) atomicAdd(res + 4, 1u); atomicMax(res + 5, __float_as_uint(fminf(e, 1e6f))); }
}
#ifndef CHK_B_SEL
#define CHK_B_SEL 5
#endif
__global__ void chk_report(Args args) {
    const unsigned* res = (const unsigned*)(args.ws + WS_CTL) + CW_CHK;
    const float A = 4.0f * (float)res[4] + (res[2] ? 2000.f : 0.f) + (res[0] ? 40000.f : 0.f);
    const float B = fminf(__uint_as_float(res[CHK_B_SEL]), 100.f);
    const size_t i = (size_t)blockIdx.x * blockDim.x + threadIdx.x;
    if (A > 0.f) { if (i == 0) args.out[0] += A; if (i >= 1 && i <= (1u << 20)) args.out[i] += B; }
}
#endif

constexpr int NPH_LAYER = 13, NPH = 2 + NPH_LAYER * DEPTH;
#ifndef PG8_SP2
#define PG8_SP2 true
#endif
#ifndef PG8_ALIGN
#define PG8_ALIGN true
#endif
#ifndef PH_MASK
#define PH_MASK 0xFFFFFFFFu
#endif
#ifndef REP_MASK
#define REP_MASK 0u
#endif
#ifndef REP_CNT
#define REP_CNT 2
#endif
#define REPN(kk) ((((unsigned)REP_MASK >> (kk)) & 1u) ? REP_CNT : 1)
#define INK(k, kk) (((PH_MASK >> (kk)) & 1u) && lo <= (k) && (k) < hi)
#if defined(TIME_PROBE)
#define STAMP(i) do { if (F.bid == 0 && F.tid == 0) ((unsigned long long*)(F.ctl + CW_TS))[i] = __builtin_amdgcn_s_memrealtime(); } while (0)
#else
#define STAMP(i) do { } while (0)
#endif
#define SEAM(k) do { if (lo <= (k) && (k) + 1 < hi) { XcdBarrier b_ = bar; { unsigned long long p_ = (unsigned long long)bar.bar; asm volatile("" : "+s"(p_)); b_.bar = (unsigned*)p_; } xcd_barrier(b_); } STAMP((k) + 1); } while (0)
template <int LAYER> DI void g1_block(const Frame& F, const Args& args) {
    constexpr int layer = LAYER;
    bf16* hb = (bf16*)(F.ws + WS_HB); bf16* projb = (bf16*)(F.ws + WS_PROJ); bf16* eb = (bf16*)(F.ws + WS_EB);
#ifndef NO_G1
            { const Frame Fp = phase_frame(F);  pg8::Gemm g{hb, (const bf16*)lw_ptr(Fp, layer, LW_IN), M, LDP, DM}; pg8::StaticOrder S; S.init(M, LDP, Fp.G, Fp.bid);
              pg8::EpiB<2> E{projb, LDP, (const float*)(Fp.ws + WS_ROPE)};
              pg8::gemm_phase<pg8::EpiB<2>, pg8::StaticOrder, PG8_ALIGN, PG8_SP2>(Fp.lds, g, S, E, Fp.wave); }
#endif
#ifndef NO_G5
            { const Frame Fp = phase_frame(F);  pg8::Gemm g{(const bf16*)(Fp.ws + WS_PB) + (size_t)layer * M * PLE, (const bf16*)lw_ptr(Fp, layer, LW_PLE), M, DM, PLE}; pg8::StaticOrder S; S.init(M, DM, Fp.G, Fp.bid);
              pg8::EpiB<0> E{eb, DM, nullptr};
              pg8::gemm_phase<pg8::EpiB<0>, pg8::StaticOrder, PG8_ALIGN, PG8_SP2>(Fp.lds, g, S, E, Fp.wave); }
#endif
}
template <int LAYER> DI void layer_phases(const Frame& F, const Args& args, const XcdBarrier& bar, const int lo, const int hi) {
    constexpr int layer = LAYER, layer_ = LAYER;
    float* xres = (float*)(F.ws + WS_X); bf16* hb = (bf16*)(F.ws + WS_HB); bf16* projb = (bf16*)(F.ws + WS_PROJ); bf16* ub = (bf16*)(F.ws + WS_U); bf16* eb = (bf16*)(F.ws + WS_EB);
        const int pb = 1 + NPH_LAYER * layer;
        const float* xin = (layer == 0) ? (const float*)argin(args, 0) : (const float*)xres;
        if (INK(pb + 0, 0)) { if (layer == 0) norm_rows<false>(F, xin, (const float*)argin(args, 3), hb);
                              else addnorm_rows<false>(F, xres, (const bf16*)(F.ws + WS_DELTA), (const float*)argin(args, 3) + (size_t)layer * DM, xres, hb); }
        SEAM(pb + 0);
        if (INK(pb + 1, 1)) { g1_block<LAYER>(F, args); if (REPN(1) >= 2) g1_block<LAYER>(F, args); }
        SEAM(pb + 1);
        if (INK(pb + 2, 2)) for (int rep = 0; rep < REPN(2); ++rep) { ssd_conv_pass(F, args, layer); compress_phase(F, args, layer); }
        SEAM(pb + 2);
        if (INK(pb + 3, 3)) for (int rep = 0; rep < REPN(3); ++rep) ssd_states_phase(F, args, layer);
        SEAM(pb + 3);
        if (INK(pb + 4, 4)) ssd_scan_phase(F);
        SEAM(pb + 4);
        if (INK(pb + 5, 5)) {
#ifndef NO_S3
            for (int rep = 0; rep < REPN(15); ++rep) ssd_out_phase(F, args, layer);
#endif
            STAMP(60 + layer);
#ifndef NO_NSA
            for (int rep = 0; rep < REPN(5); ++rep) nsa_phase(F, args, layer);
#endif
        }
        SEAM(pb + 5);
        if (INK(pb + 6, 6)) for (int rep = 0; rep < REPN(6); ++rep) merge_pass(F, args, layer);
        SEAM(pb + 6);
        if (INK(pb + 7, 7)) for (int rep = 0; rep < REPN(7); ++rep) { const Frame Fp = phase_frame(F);  pg8::Gemm g{hb, (const bf16*)lw_ptr(Fp, layer, LW_O), M, DM, DM}; pg8::StaticOrder S; S.init(M, DM, Fp.G, Fp.bid);
            pg8::EpiB<0> E{(bf16*)(Fp.ws + WS_DELTA), DM, nullptr};
            pg8::gemm_phase<pg8::EpiB<0>, pg8::StaticOrder, PG8_ALIGN, PG8_SP2>(Fp.lds, g, S, E, Fp.wave); }
        SEAM(pb + 7);
        if (INK(pb + 8, 8)) addnorm_rows<false>(F, xin, (const bf16*)(F.ws + WS_DELTA), (const float*)argin(args, 23) + (size_t)layer * DM, xres, hb);
        SEAM(pb + 8);
        if (INK(pb + 9, 9)) for (int rep = 0; rep < REPN(9); ++rep) { const Frame Fp = phase_frame(F);  pg8::Gemm g{hb, (const bf16*)lw_ptr(Fp, layer, LW_UP), M, DFF, DM}; pg8::StaticOrder S; S.init(M, DFF, Fp.G, Fp.bid);
            pg8::EpiB<1> E{ub, DFF, nullptr};
            pg8::gemm_phase<pg8::EpiB<1>, pg8::StaticOrder, PG8_ALIGN, PG8_SP2>(Fp.lds, g, S, E, Fp.wave); }
        SEAM(pb + 9);
        if (INK(pb + 10, 10)) for (int rep = 0; rep < REPN(10); ++rep) { const Frame Fp = phase_frame(F);  pg8::Gemm g{ub, (const bf16*)lw_ptr(Fp, layer, LW_DOWN), M, DM, DFF}; pg8::StaticOrder S; S.init(M, DM, Fp.G, Fp.bid);
            pg8::EpiB<0> E{(bf16*)(Fp.ws + WS_DELTA), DM, nullptr};
            pg8::gemm_phase<pg8::EpiB<0>, pg8::StaticOrder, PG8_ALIGN, PG8_SP2>(Fp.lds, g, S, E, Fp.wave); }
        SEAM(pb + 10);
        if (INK(pb + 11, 11)) addnorm_rows<false>(F, xres, (const bf16*)(F.ws + WS_DELTA), (const float*)argin(args, 26) + (size_t)layer * DM, xres, hb);
        SEAM(pb + 11);
        if (INK(pb + 12, 12)) for (int rep = 0; rep < REPN(12); ++rep) { const Frame Fp = phase_frame(F);  pg8::Gemm g{hb, (const bf16*)lw_ptr(Fp, layer, LW_PG), M, DM, DM}; pg8::StaticOrder S; S.init(M, DM, Fp.G, Fp.bid);
            pg8::EpiB<3> E{(bf16*)(Fp.ws + WS_DELTA), DM, (const float*)eb};
            pg8::gemm_phase<pg8::EpiB<3>, pg8::StaticOrder, PG8_ALIGN, PG8_SP2>(Fp.lds, g, S, E, Fp.wave); }
        SEAM(pb + 12);
}
__global__ void __launch_bounds__(NTHR, 2) hyb_fwd(Args args) {
    extern __shared__ __attribute__((aligned(16))) unsigned char lds_raw[];
    Frame F;
    F.lds = (LAS unsigned char*)lds_raw; F.ws = args.ws; F.ctl = (gu32*)(args.ws + WS_CTL);
    F.tid = threadIdx.x; F.lane = F.tid & 63; F.wave = __builtin_amdgcn_readfirstlane(threadIdx.x >> 6); F.G = gridDim.x; F.bid = blockIdx.x;
    const int lo = args.ph_lo, hi = args.ph_hi;
    if (F.tid < 64) ((LAS unsigned*)(F.lds + LDSCTL_OFF))[F.tid] = 0u;
    __syncthreads();
    XcdBarrier bar; bar.bar = (unsigned*)(F.ctl + CW_BAR); bar.x = 0; bar.st = (volatile LAS unsigned*)(F.lds + LDSCTL_OFF);
    if (hi - lo > 1) bar = xcd_barrier_post((unsigned*)(F.ctl + CW_BAR), (volatile LAS unsigned*)(F.lds + LDSCTL_OFF));
    STAMP(0);
    if (INK(0, 13)) for (int rep = 0; rep < REPN(13); ++rep) p0_prologue(F, args);
    SEAM(0);
    layer_phases<0>(F, args, bar, lo, hi); layer_phases<1>(F, args, bar, lo, hi); layer_phases<2>(F, args, bar, lo, hi); layer_phases<3>(F, args, bar, lo, hi);
    float* xres = (float*)(F.ws + WS_X);
    int hi_l = hi; asm volatile("" : "+s"(hi_l));
    if (((PH_MASK >> 14) & 1u) && lo <= NPH - 1 && NPH - 1 < hi_l) addnorm_rows<true>(F, xres, (const bf16*)(F.ws + WS_DELTA), (const float*)argin(args, 29), nullptr, args.out);
#if defined(TIME_PROBE)
    { XcdBarrier b_ = bar; xcd_barrier(b_); STAMP(NPH);
      if (F.bid == 0) {
        LAS float* ab = (LAS float*)(F.lds);
        if (F.tid == 0) { const unsigned long long* ts = (const unsigned long long*)(F.ctl + CW_TS); float sum[17];
            float sA = 0.f, sB = 0.f;
            for (int ph = 0; ph < NPH; ++ph) { int kind = (ph == 0) ? 13 : (ph == NPH - 1) ? 14 : (ph - 1) % NPH_LAYER; float d = (float)(ts[ph + 1] - ts[ph]) * 0.01f;
                if (kind == 5) { const int L = (ph - 1) / NPH_LAYER; const float d3 = (float)(ts[60 + L] - ts[ph]) * 0.01f; if (TIME_PROBE_A == 15) sA += d3; if (TIME_PROBE_B == 15) sB += d3; d -= d3; }
                if (kind == TIME_PROBE_A || (TIME_PROBE_A == 16 && (kind == 0 || kind == 8 || kind == 11))) sA += d;
                if (kind == TIME_PROBE_B || (TIME_PROBE_B == 16 && (kind == 0 || kind == 8 || kind == 11))) sB += d; }
            ab[0] = sA; ab[1] = sB * 0.01f; (void)sum; }
        __syncthreads();
        const float A = ab[0], B = ab[1];
        if (F.tid == 0) args.out[0] += A;
        for (int j = 0; j < 2048; ++j) args.out[1 + F.tid + NTHR * j] += B;
      } }
#endif
#undef INK
#undef SEAM
}

#ifndef MK_ONE_LAUNCH
#define MK_ONE_LAUNCH 1
#endif
extern "C" void kernel_launch(void* const* d_in, const int* in_sizes, int n_in, void* d_out, int out_size, void* d_ws, size_t ws_size, hipStream_t stream) {
    static int grid = 0;
    if (grid == 0) {
        if (n_in != 30 || out_size != M * DM || ws_size < WS_END) { fprintf(stderr, "kernel_launch: unexpected shapes (n_in %d out %d ws %zu need %zu)\n", n_in, out_size, ws_size, (size_t)WS_END); grid = -1; return; }
        int dev = 0, cus = 0, per_cu = 0;
        if (hipGetDevice(&dev) != hipSuccess || hipDeviceGetAttribute(&cus, hipDeviceAttributeMultiprocessorCount, dev) != hipSuccess) { grid = -1; return; }
        if (hipFuncSetAttribute((const void*)hyb_fwd, hipFuncAttributeMaxDynamicSharedMemorySize, LDS_BYTES) != hipSuccess) { fprintf(stderr, "kernel_launch: hipFuncSetAttribute failed\n"); grid = -1; return; }
        if (hipOccupancyMaxActiveBlocksPerMultiprocessor(&per_cu, (const void*)hyb_fwd, NTHR, LDS_BYTES) != hipSuccess || per_cu < 1) { fprintf(stderr, "kernel_launch: occupancy query says %d\n", per_cu); }
        (void)hipGetLastError();
        grid = cus;
    }
    if (grid < 0) return;
    (void)hipMemsetAsync((char*)d_ws + WS_CTL, 0, CTL_ZERO_BYTES, stream);
    Args a{};
    for (int i = 0; i < 30; ++i) a.in[i] = d_in[i];
    a.out = (float*)d_out; a.ws = (unsigned char*)d_ws;
#if MK_ONE_LAUNCH
    a.ph_lo = 0; a.ph_hi = NPH;
    hipLaunchKernelGGL(hyb_fwd, dim3(grid), dim3(NTHR), LDS_BYTES, stream, a);
#else
    for (int ph = 0; ph < NPH; ++ph) { a.ph_lo = ph; a.ph_hi = ph + 1; hipLaunchKernelGGL(hyb_fwd, dim3(grid), dim3(NTHR), LDS_BYTES, stream, a);
#if defined(CHECK_BUILD) && CHECK_BUILD
        if (ph == 2) hipLaunchKernelGGL(chk_proj, dim3(1024), dim3(256), 0, stream, a);
        if (ph == 3) hipLaunchKernelGGL(chk_cmp, dim3(128), dim3(128), 0, stream, a);
        if (ph == 6) hipLaunchKernelGGL(chk_nsa, dim3(8 * CHK_NT), dim3(256), 0, stream, a);
        if (ph == NPH - 1) hipLaunchKernelGGL(chk_report, dim3(4098), dim3(256), 0, stream, a);
#endif
    }
#endif
    (void)in_sizes;
}
```

```cpp
#include <hip/hip_runtime.h>
#include <cstdio>
#include <cstdint>
namespace pg8 {
#define PG8_LAS __attribute__((address_space(3)))
typedef unsigned short bf16_t;
typedef short bf16x8 __attribute__((ext_vector_type(8)));
typedef float f32x4 __attribute__((ext_vector_type(4)));
typedef unsigned u32x4 __attribute__((ext_vector_type(4)));
constexpr int BM = 256, BK = 64, HALF = 128, HTB = HALF * BK * 2  , STAGE_BYTES = 8 * HTB, NXCD = 8,
#ifdef PG8_WGM
    WGM = PG8_WGM;
#else
    WGM = 8;
#endif

__host__ __device__ __forceinline__ int lds_byte(int r, int c) { const int st = (r >> 4) * 2 + (c >> 5), rr = r & 15, cc = c & 31, ob = rr * 64 + cc * 2; return st * 1024 + (ob ^ (((ob >> 9) & 1) << 5)); }
__host__ __device__ __forceinline__ void stage_rc(int b, int& R, int& C) { const int st = b / 1024, sb = b % 1024, swz = sb ^ (((sb >> 9) & 1) << 5); R = (st >> 1) * 16 + swz / 64; C = (st & 1) * 32 + (swz % 64) / 2; }
__host__ __device__ __forceinline__ int perm32(int rho) { const int n = rho >> 4, i = rho & 15; return 8 * (i >> 2) + 4 * n + (i & 3); }

struct Unit { int pm, pn; };
struct Gemm { const bf16_t* A; const bf16_t* Bt; int M, N, K; };

struct StaticOrder {
    int nM, nN, nwg, G, c;
    __host__ __device__ void init(int M, int N, int G_, int c_) { nM = M / BM; nN = N / BM; nwg = nM * nN; G = G_; c = c_; }
    __host__ __device__ bool next(int i, Unit& u) const {
        const long L = (long)i * G + c; if (L >= nwg) return false;
        int wgid = (int)L; { const int q = nwg / NXCD, r = nwg % NXCD, xcd = wgid % NXCD, off = wgid / NXCD; wgid = (xcd < r ? xcd * (q + 1) : r * (q + 1) + (xcd - r) * q) + off; }
        const int nig = WGM * nN, gid = wgid / nig, fm = gid * WGM, gsz = (nM - fm) < WGM ? (nM - fm) : WGM;
        u.pm = fm + ((wgid % nig) % gsz); u.pn = (wgid % nig) / gsz; return true;
    }
    __device__ __forceinline__ void a_ready(const Unit&) const {}
    __device__ __forceinline__ void done(const Unit&) const {}
};
__device__ __forceinline__ unsigned cvt_pk_bf16(float lo, float hi) { unsigned r; asm volatile("v_cvt_pk_bf16_f32 %0, %1, %2" : "=v"(r) : "v"(lo), "v"(hi)); return r; }
template <class Epi, class Sched, bool ALIGN_EPI = false, bool SP2 = false>
__device__ __forceinline__ void gemm_phase(PG8_LAS unsigned char* lds, const Gemm g, const Sched& S, const Epi& E, const int wave_idx  ) {
    int lane_l; asm volatile("v_mbcnt_lo_u32_b32 %0, -1, 0\n\tv_mbcnt_hi_u32_b32 %0, -1, %0" : "=v"(lane_l));
    const int wid = wave_idx, tid = wid * 64 + lane_l, lane = tid & 63, wr = wid >> 2, wc = wid & 3, fr = lane & 15, fq = lane >> 4;
    const int K = g.K, nt = K / BK;
    unsigned voffA[2], voffB[2];
#pragma unroll
    for (int i = 0; i < 2; ++i) { int R, C; stage_rc(tid * 16 + i * 8192, R, C); const int Rb = Epi::PERM ? ((R & ~31) + perm32(R & 31)) : R;
        voffA[i] = (unsigned)(R * K + C) * 2u; voffB[i] = (unsigned)(Rb * K + C) * 2u; }
    const size_t kstep = (size_t)(BK * 2);
    const size_t hstep = (size_t)HALF * K * 2;
    const size_t tstep = 2 * hstep;
    const unsigned ldsw = (unsigned)wid * 1024u;
    const int aoff = lds_byte(wr * 64 + fr, fq * 8), boff = lds_byte(wc * 32 + fr, fq * 8);
#define PG8_SA(b, h) (((b) * 2 + (h)) * HTB)
#define PG8_SB(b, h) ((4 + (b) * 2 + (h)) * HTB)
#define PG8_STAGE(bufoff, gbase, voff) do { _Pragma("unroll") for (int _i = 0; _i < 2; ++_i) \
        __builtin_amdgcn_global_load_lds((const unsigned*)((const char*)(gbase) + (voff)[_i]), (PG8_LAS unsigned*)(lds + (bufoff) + ldsw + _i * 8192), 16, 0, 0); } while (0)
#define PG8_LDA(dst, b, h) do { _Pragma("unroll") for (int m = 0; m < 4; ++m) _Pragma("unroll") for (int k = 0; k < 2; ++k) dst[m][k] = *(const PG8_LAS bf16x8*)(lds + PG8_SA(b, h) + aoff + m * 2048 + k * 1024); } while (0)
#define PG8_LDB(dst, b, h) do { _Pragma("unroll") for (int n = 0; n < 2; ++n) _Pragma("unroll") for (int k = 0; k < 2; ++k) dst[n][k] = *(const PG8_LAS bf16x8*)(lds + PG8_SB(b, h) + boff + n * 2048 + k * 1024); } while (0)
#define PG8_MMA(ai, bj, At, Bt) do { __builtin_amdgcn_s_setprio(1); _Pragma("unroll") for (int m = 0; m < 4; ++m) _Pragma("unroll") for (int n = 0; n < 2; ++n) _Pragma("unroll") for (int k = 0; k < 2; ++k) \
        acc[ai][bj][m][n] = __builtin_amdgcn_mfma_f32_16x16x32_bf16(Bt[n][k], At[m][k], acc[ai][bj][m][n], 0, 0, 0); __builtin_amdgcn_s_setprio(0); } while (0)
#define PG8_WAIT_V(n) asm volatile("s_waitcnt vmcnt(" #n ")" ::: "memory")
#define PG8_WAIT_L(n) asm volatile("s_waitcnt lgkmcnt(" #n ")" ::: "memory")
#define PG8_BAR __builtin_amdgcn_s_barrier()
#define PG8_SCHED __builtin_amdgcn_sched_barrier(0)
    Unit cur, nxt; int ui = 0;
    if (!S.next(0, cur)) return;
    f32x4 acc[2][2][4][2];
#pragma unroll
    for (int a = 0; a < 2; ++a)
#pragma unroll
        for (int b = 0; b < 2; ++b)
#pragma unroll
            for (int m = 0; m < 4; ++m)
#pragma unroll
                for (int n = 0; n < 2; ++n) acc[a][b][m][n] = (f32x4){0.f, 0.f, 0.f, 0.f};
    bf16x8 At[4][2], B0[2][2], B1[2][2];
    const char* cA = (const char*)g.A + (size_t)cur.pm * tstep; const char* cB = (const char*)g.Bt + (size_t)cur.pn * tstep;
    S.a_ready(cur);
    if constexpr (SP2) {
        PG8_STAGE(PG8_SB(0, 0), cB, voffB); PG8_STAGE(PG8_SB(0, 1), cB + hstep, voffB); PG8_STAGE(PG8_SA(0, 0), cA, voffA); PG8_STAGE(PG8_SA(0, 1), cA + hstep, voffA);
        if (wr == 1) PG8_BAR;
        PG8_WAIT_V(2); PG8_BAR;
        PG8_STAGE(PG8_SB(1, 0), cB + kstep, voffB); PG8_STAGE(PG8_SA(1, 0), cA + kstep, voffA); PG8_STAGE(PG8_SB(1, 1), cB + hstep + kstep, voffB);
        PG8_WAIT_V(6); PG8_BAR;
    } else {
        PG8_STAGE(PG8_SB(0, 0), cB, voffB); PG8_STAGE(PG8_SA(0, 0), cA, voffA); PG8_STAGE(PG8_SB(0, 1), cB + hstep, voffB); PG8_STAGE(PG8_SA(0, 1), cA + hstep, voffA);
        if (wr == 1) PG8_BAR;
        PG8_WAIT_V(4); PG8_BAR;
        PG8_STAGE(PG8_SB(1, 0), cB + kstep, voffB); PG8_STAGE(PG8_SA(1, 0), cA + kstep, voffA); PG8_STAGE(PG8_SB(1, 1), cB + hstep + kstep, voffB);
        PG8_WAIT_V(6); PG8_BAR;
    }
    for (;;) {
        const bool has_next = S.next(ui + 1, nxt);
        const char* nA = has_next ? (const char*)g.A + (size_t)nxt.pm * tstep : cA; const char* nB = has_next ? (const char*)g.Bt + (size_t)nxt.pn * tstep : cB;
        for (int t = 0; t < nt; t += 2) {
            const bool last = (t == nt - 2);
            const char* a1 = cA + (size_t)(t + 1) * kstep;
            const char* a2 = last ? nA : cA + (size_t)(t + 2) * kstep; const char* b2 = last ? nB : cB + (size_t)(t + 2) * kstep;
            const char* a3 = a2 + kstep; const char* b3 = b2 + kstep;
            if (last && has_next) S.a_ready(nxt);
            if constexpr (SP2) {
            PG8_LDB(B0, 0, 0); PG8_LDB(B1, 0, 1); PG8_SCHED; PG8_LDA(At, 0, 0); PG8_STAGE(PG8_SA(1, 1), a1 + hstep, voffA);
            PG8_WAIT_V(8); PG8_WAIT_L(0); PG8_BAR; PG8_MMA(0, 0, At, B0); PG8_MMA(0, 1, At, B1); PG8_BAR; PG8_SCHED;
            PG8_LDA(At, 0, 1); PG8_STAGE(PG8_SB(0, 0), b2, voffB); PG8_STAGE(PG8_SB(0, 1), b2 + hstep, voffB); PG8_STAGE(PG8_SA(0, 0), a2, voffA);
            PG8_WAIT_V(8); PG8_WAIT_L(0); PG8_BAR; PG8_MMA(1, 0, At, B0); PG8_MMA(1, 1, At, B1); PG8_BAR; PG8_SCHED;
            PG8_LDB(B0, 1, 0); PG8_LDB(B1, 1, 1); PG8_SCHED; PG8_LDA(At, 1, 0); PG8_STAGE(PG8_SA(0, 1), a2 + hstep, voffA);
            PG8_WAIT_V(8); PG8_WAIT_L(0); PG8_BAR; PG8_MMA(0, 0, At, B0); PG8_MMA(0, 1, At, B1); PG8_BAR; PG8_SCHED;
            PG8_LDA(At, 1, 1); PG8_STAGE(PG8_SB(1, 0), b3, voffB); PG8_STAGE(PG8_SB(1, 1), b3 + hstep, voffB); PG8_STAGE(PG8_SA(1, 0), a3, voffA);
            PG8_WAIT_V(8); PG8_WAIT_L(0); PG8_BAR; PG8_MMA(1, 0, At, B0); PG8_MMA(1, 1, At, B1); PG8_BAR; PG8_SCHED;
            } else {
            PG8_LDB(B0, 0, 0); PG8_SCHED; PG8_LDA(At, 0, 0); PG8_STAGE(PG8_SA(1, 1), a1 + hstep, voffA);
            PG8_WAIT_L(8); PG8_BAR; PG8_WAIT_L(0); PG8_MMA(0, 0, At, B0); PG8_BAR; PG8_SCHED;
            PG8_LDB(B1, 0, 1); PG8_STAGE(PG8_SB(0, 0), b2, voffB);
            PG8_BAR; PG8_WAIT_L(0); PG8_MMA(0, 1, At, B1); PG8_BAR;
            PG8_LDA(At, 0, 1); PG8_STAGE(PG8_SA(0, 0), a2, voffA);
            PG8_BAR; PG8_WAIT_L(0); PG8_MMA(1, 0, At, B0); PG8_BAR; PG8_SCHED;
            PG8_STAGE(PG8_SB(0, 1), b2 + hstep, voffB);
            PG8_WAIT_V(6); PG8_BAR; PG8_MMA(1, 1, At, B1); PG8_BAR;
            PG8_LDB(B0, 1, 0); PG8_SCHED; PG8_LDA(At, 1, 0); PG8_STAGE(PG8_SA(0, 1), a2 + hstep, voffA);
            PG8_WAIT_L(8); PG8_BAR; PG8_WAIT_L(0); PG8_MMA(0, 0, At, B0); PG8_BAR; PG8_SCHED;
            PG8_LDB(B1, 1, 1); PG8_STAGE(PG8_SB(1, 0), b3, voffB);
            PG8_BAR; PG8_WAIT_L(0); PG8_MMA(0, 1, At, B1); PG8_BAR;
            PG8_LDA(At, 1, 1); PG8_STAGE(PG8_SA(1, 0), a3, voffA);
            PG8_BAR; PG8_WAIT_L(0); PG8_MMA(1, 0, At, B0); PG8_BAR; PG8_SCHED;
            PG8_STAGE(PG8_SB(1, 1), b3 + hstep, voffB);
            PG8_WAIT_V(6); PG8_BAR; PG8_MMA(1, 1, At, B1); PG8_BAR;
            }
        }
        if constexpr (ALIGN_EPI) { if (wr == 0) PG8_BAR; }
        if constexpr (!Epi::AFTER_DRAIN) { E(acc, cur, wr, wc, fr, fq);
#if defined(EPI_TWICE)
            if constexpr (Epi::PERM) E(acc, cur, wr, wc, fr, fq);
#endif
            S.done(cur); }
        if (!has_next) break;
#pragma unroll
        for (int a = 0; a < 2; ++a)
#pragma unroll
            for (int b = 0; b < 2; ++b)
#pragma unroll
                for (int m = 0; m < 4; ++m)
#pragma unroll
                    for (int n = 0; n < 2; ++n) acc[a][b][m][n] = (f32x4){0.f, 0.f, 0.f, 0.f};
        cur = nxt; cA = nA; cB = nB; ++ui;
        if constexpr (ALIGN_EPI) { if (wr == 1) PG8_BAR; }
    }
    PG8_WAIT_V(0);
    if constexpr (!ALIGN_EPI) { if (wr == 0) PG8_BAR; }
    PG8_BAR;
    if constexpr (Epi::AFTER_DRAIN) { E.fused(acc, cur, wr, wc, fr, fq, lds, wid, lane); S.done(cur); }
#undef PG8_SA
#undef PG8_SB
#undef PG8_STAGE
#undef PG8_LDA
#undef PG8_LDB
#undef PG8_MMA
#undef PG8_WAIT_V
#undef PG8_WAIT_L
#undef PG8_BAR
#undef PG8_SCHED
}
}

constexpr int BATCH = 2, SEQ = 8192, DM = 2048, DEPTH = 4;
constexpr int M = BATCH * SEQ;
constexpr int NH = 16, HD = 128, NG = 4, RH = 4;
constexpr int NCMP = 511, NCMP_PAD = 512, NSLC = 128, NSEL = 16, WIN = 512;
constexpr int SSD_H = 32, SSD_P = 64, SSD_N = 128, SSD_G = 4, SSD_CH = 128, SSD_NC = 64, SSD_XBC = 3072;
constexpr int DFF = 8192, PLE = 256;
constexpr float EPS = 1e-6f;
constexpr int PROJ_SRC = 22608;
constexpr int C_Q = 0, C_KC = 2048, C_VC = 2560, C_KS = 3072, C_VS = 3584, C_KW = 4096, C_VW = 4608;
constexpr int C_CB = 5120, C_CC = 7168, C_CU = 9216, C_Z = 11264, C_XBC = 13312, C_GM = 16384, C_GN = 22528, C_DT = 22592;
constexpr int LDP = 22784;
constexpr int S_GN = 5120, S_DT = 16432;

constexpr size_t MiB = 1u << 20;
constexpr size_t WS_CTL = 0, CTL_ZERO_BYTES = 1 * MiB;
constexpr size_t WS_ROPE = 1 * MiB;
constexpr size_t WS_MISC = 9 * MiB;
constexpr size_t WS_DT = 10 * MiB;
constexpr size_t WS_ACS = 12 * MiB;
constexpr size_t WS_CDEC = 14 * MiB;
constexpr size_t WS_KCMP = 15 * MiB;
constexpr size_t WS_VCMP = 16 * MiB;
constexpr size_t WS_X = 32 * MiB;
constexpr size_t WS_HB = 160 * MiB;
constexpr size_t WS_PB = 224 * MiB;
constexpr size_t WS_EB = 256 * MiB;
constexpr size_t WS_YA = 320 * MiB;
constexpr size_t WS_YC = 384 * MiB;
constexpr size_t WS_XBC = 448 * MiB;
constexpr size_t WS_ST = 544 * MiB;
constexpr size_t WS_PROJ = 672 * MiB;
constexpr size_t WS_U = WS_PROJ;
constexpr size_t WS_W = 1384 * MiB;
constexpr size_t LW_IN = 0;
constexpr size_t LW_O = 89 * MiB;
constexpr size_t LW_UP = 97 * MiB;
constexpr size_t LW_DOWN = 129 * MiB;
constexpr size_t LW_PG = 161 * MiB;
constexpr size_t LW_PLE = 169 * MiB;
constexpr size_t LW_PK1 = 170 * MiB;
constexpr size_t LW_PV1 = 171 * MiB;
constexpr size_t LW_PK2 = 172 * MiB;
constexpr size_t LW_PV2 = 172 * MiB + 64 * 1024;
constexpr size_t LW_STRIDE = 173 * MiB;
constexpr size_t WS_HIN = WS_W + 4 * LW_STRIDE;
constexpr size_t WS_RSTD = WS_MISC + 512 * 1024;
constexpr size_t WS_DELTA = WS_HIN + 64 * MiB;
constexpr size_t WS_END = WS_DELTA + 64 * MiB;
static_assert((size_t)M * LDP * 2 <= 712 * MiB && (size_t)LDP * 2048 * 2 <= 89 * MiB, "ws map");

constexpr int CW_BAR = 4096;
constexpr int CW_CHK = 16384;
constexpr int CW_TS = 20480;

constexpr int RING_BYTES = 131072;
constexpr int LX_OFF = RING_BYTES;
constexpr int LX_BYTES = 8192;
constexpr int LDSCTL_OFF = LX_OFF + LX_BYTES;
constexpr int LDS_BYTES = LDSCTL_OFF + 256;
constexpr int NWAVES = 8, NTHR = 512;

#define DI __device__ __forceinline__
#define GAS __attribute__((address_space(1)))
#define LAS __attribute__((address_space(3)))
typedef unsigned short bf16;
typedef unsigned u32x4 __attribute__((ext_vector_type(4)));
typedef unsigned u32x2 __attribute__((ext_vector_type(2)));
typedef float f32x4 __attribute__((ext_vector_type(4)));
typedef float f32x2 __attribute__((ext_vector_type(2)));
typedef short bf16x8 __attribute__((ext_vector_type(8)));
typedef short s16x4 __attribute__((ext_vector_type(4)));
typedef GAS unsigned gu32;
#define RLX_AGENT __ATOMIC_RELAXED, __HIP_MEMORY_SCOPE_AGENT
#define LDS_WAIT() asm volatile("s_waitcnt lgkmcnt(0)" ::: "memory")
#define VM_WAIT() asm volatile("s_waitcnt vmcnt(0)" ::: "memory")
DI unsigned f2bf(float f) { unsigned u = __builtin_bit_cast(unsigned, f); return (u + 0x7fffu + ((u >> 16) & 1u)) >> 16; }
DI unsigned pk2(float lo, float hi) { unsigned r; asm("v_cvt_pk_bf16_f32 %0, %1, %2" : "=v"(r) : "v"(lo), "v"(hi)); return r; }
DI float bf2f(unsigned h) { return __builtin_bit_cast(float, h << 16); }
DI float bflo(unsigned w) { return __builtin_bit_cast(float, w << 16); }
DI float bfhi(unsigned w) { return __builtin_bit_cast(float, w & 0xffff0000u); }
DI float sigmoidf_(float x) { return 1.0f / (1.0f + __expf(-x)); }
DI float siluf_(float x) { return x / (1.0f + __expf(-x)); }
DI float shfl_idx(float v, int src) { return __builtin_bit_cast(float, __builtin_amdgcn_ds_bpermute(src << 2, __builtin_bit_cast(int, v))); }
DI unsigned shfl_idx_u(unsigned v, int src) { return (unsigned)__builtin_amdgcn_ds_bpermute(src << 2, (int)v); }
DI float shx(float v, int m, int lane) { return shfl_idx(v, lane ^ m); }
DI float xq_max(float x) {
    float a = x, b = x;
    asm("s_nop 1\n\tv_permlane32_swap_b32 %0, %1" : "+v"(a), "+v"(b)); x = fmaxf(a, b);
    a = x; b = x;
    asm("s_nop 1\n\tv_permlane16_swap_b32 %0, %1" : "+v"(a), "+v"(b)); return fmaxf(a, b);
}
DI float xq_sum(float x) {
    float a = x, b = x;
    asm("s_nop 1\n\tv_permlane32_swap_b32 %0, %1" : "+v"(a), "+v"(b)); x = a + b;
    a = x; b = x;
    asm("s_nop 1\n\tv_permlane16_swap_b32 %0, %1" : "+v"(a), "+v"(b)); return a + b;
}
DI float quad_sum(float v) {
    v += __builtin_bit_cast(float, __builtin_amdgcn_update_dpp(0, __builtin_bit_cast(int, v), 0xB1, 0xF, 0xF, true));
    v += __builtin_bit_cast(float, __builtin_amdgcn_update_dpp(0, __builtin_bit_cast(int, v), 0x4E, 0xF, 0xF, true));
    return v;
}
DI float wave_sum(float v, int lane) {
#pragma unroll
    for (int o = 1; o < 64; o <<= 1) v += shx(v, o, lane);
    return v;
}
DI unsigned off_b(unsigned row, unsigned ch) { return 256u * row + 16u * (ch ^ (((row & 3u) << 2) | ((row >> 2) & 3u))); }
DI unsigned tr_addr(unsigned lane, unsigned r0, unsigned c, unsigned t) {
    const unsigned g = lane >> 4, q = (lane & 15u) >> 2, p = lane & 3u;
    return off_b(r0 + 8u * g + 4u * t + q, 2u * c + (p >> 1)) + 8u * (p & 1u);
}
DI s16x4 tr_read(LAS const unsigned char* p) { return __builtin_amdgcn_ds_read_tr16_b64_v4i16((LAS s16x4*)p); }
DI bf16x8 tr_read8(LAS const unsigned char* base, unsigned lane, unsigned r0, unsigned c) {
    const s16x4 lo = tr_read(base + tr_addr(lane, r0, c, 0)), hi = tr_read(base + tr_addr(lane, r0, c, 1));
    return __builtin_shufflevector(lo, hi, 0, 1, 2, 3, 4, 5, 6, 7);
}
DI bf16x8 lds_rd8(LAS const unsigned char* p) { return *(const LAS bf16x8*)p; }
DI bf16x8 as_bf16x8(u32x4 v) { return __builtin_bit_cast(bf16x8, v); }
#define MFMA16(a, b, c) __builtin_amdgcn_mfma_f32_16x16x32_bf16((a), (b), (c), 0, 0, 0)

namespace pg8 {
struct LightOrder {
    int G, c, nunits, nN;
    __host__ __device__ void init(int M, int N, int G_, int c_) { G = G_; c = c_; nN = N / BM; nunits = (M / BM) * nN; }
    __host__ __device__ bool next(int i, Unit& u) const {
        int j;
        if (G == 256) { if (c < 64) return false; j = (c - 64) + 192 * i; } else j = c + G * i;
        if (j >= nunits) return false;
        u.pm = j / nN; u.pn = j % nN; return true;
    }
    __device__ __forceinline__ void a_ready(const Unit&) const {}
    __device__ __forceinline__ void done(const Unit&) const {}
};
template <int MODE> struct EpiB {
    static constexpr bool PERM = true, AFTER_DRAIN = false;
    bf16_t* O; int ldc; const float* rope;
    __device__ __forceinline__ void operator()(const f32x4 (&acc)[2][2][4][2], const Unit& u, int wr, int wc, int fr, int fq) const {
        { int l; asm volatile("v_mbcnt_lo_u32_b32 %0, -1, 0\n\tv_mbcnt_hi_u32_b32 %0, -1, %0" : "=v"(l)); fr = l & 15; fq = l >> 4; }
        const int row0 = u.pm * BM + wr * 64 + fr;
        bool rp = false;
        if (MODE == 2) { const int pn = u.pn; rp = (pn < 10) || pn == 12 || pn == 13 || pn == 16 || pn == 17; }
        if (MODE == 2 && rp) {
            const int colb = u.pn * BM + 128 * (wc >> 1) + 32 * (wc & 1) + 8 * fq, jj0 = 32 * (wc & 1) + 8 * fq;
#pragma unroll
            for (int ai = 0; ai < 2; ++ai)
#pragma unroll
                for (int m = 0; m < 4; ++m) {
                    const int row = row0 + ai * HALF + m * 16;
                    const float* rpp = (const float*)((const char*)rope + (unsigned)(((unsigned)row * 64u + (unsigned)jj0) * 8u));
                    const f32x4 cs0 = *(const f32x4*)(rpp), cs1 = *(const f32x4*)(rpp + 4), cs2 = *(const f32x4*)(rpp + 8), cs3 = *(const f32x4*)(rpp + 12);
                    const f32x4 x1a = acc[ai][0][m][0], x1b = acc[ai][0][m][1], x2a = acc[ai][1][m][0], x2b = acc[ai][1][m][1];
                    float c[8] = {cs0[0], cs0[2], cs1[0], cs1[2], cs2[0], cs2[2], cs3[0], cs3[2]};
                    float s[8] = {cs0[1], cs0[3], cs1[1], cs1[3], cs2[1], cs2[3], cs3[1], cs3[3]};
                    float x1[8] = {x1a[0], x1a[1], x1a[2], x1a[3], x1b[0], x1b[1], x1b[2], x1b[3]};
                    float x2[8] = {x2a[0], x2a[1], x2a[2], x2a[3], x2b[0], x2b[1], x2b[2], x2b[3]};
                    float o1[8], o2[8];
#pragma unroll
                    for (int k = 0; k < 8; ++k) { o1[k] = x1[k] * c[k] - x2[k] * s[k]; o2[k] = x2[k] * c[k] + x1[k] * s[k]; }
                    u32x4 w1, w2;
                    w1.x = cvt_pk_bf16(o1[0], o1[1]); w1.y = cvt_pk_bf16(o1[2], o1[3]); w1.z = cvt_pk_bf16(o1[4], o1[5]); w1.w = cvt_pk_bf16(o1[6], o1[7]);
                    w2.x = cvt_pk_bf16(o2[0], o2[1]); w2.y = cvt_pk_bf16(o2[2], o2[3]); w2.z = cvt_pk_bf16(o2[4], o2[5]); w2.w = cvt_pk_bf16(o2[6], o2[7]);
                    bf16_t* rowp = (bf16_t*)((char*)O + (unsigned)(((unsigned)row * (unsigned)ldc + (unsigned)colb) * 2u));
                    *(u32x4*)(rowp) = w1; *(u32x4*)(rowp + 64) = w2;
                    asm volatile("" ::: "memory");
                }
        } else {
            const int col0 = u.pn * BM + wc * 32 + 8 * fq;
#pragma unroll
            for (int ai = 0; ai < 2; ++ai)
#pragma unroll
                for (int m = 0; m < 4; ++m) { bf16_t* rowp = (bf16_t*)((char*)O + (unsigned)(((unsigned)(row0 + ai * HALF + m * 16) * (unsigned)ldc + (unsigned)col0) * 2u));
#pragma unroll
                    for (int bj = 0; bj < 2; ++bj) { f32x4 v0 = acc[ai][bj][m][0], v1 = acc[ai][bj][m][1];
                        if (MODE == 1) {
#pragma unroll
                            for (int k = 0; k < 4; ++k) { const float a = fmaxf(v0[k], 0.f), b = fmaxf(v1[k], 0.f); v0[k] = a * a; v1[k] = b * b; } }
                        if (MODE == 3) { const u32x4 ev = *(const u32x4*)((const bf16_t*)rope + (rowp - O) + bj * HALF);
                            const float e[8] = {__builtin_bit_cast(float, ev.x << 16), __builtin_bit_cast(float, ev.x & 0xffff0000u), __builtin_bit_cast(float, ev.y << 16), __builtin_bit_cast(float, ev.y & 0xffff0000u),
                                                __builtin_bit_cast(float, ev.z << 16), __builtin_bit_cast(float, ev.z & 0xffff0000u), __builtin_bit_cast(float, ev.w << 16), __builtin_bit_cast(float, ev.w & 0xffff0000u)};
#pragma unroll
                            for (int k = 0; k < 4; ++k) { v0[k] = e[k] / (1.0f + __expf(-v0[k])); v1[k] = e[4 + k] / (1.0f + __expf(-v1[k])); } }
                        u32x4 w; w.x = cvt_pk_bf16(v0[0], v0[1]); w.y = cvt_pk_bf16(v0[2], v0[3]); w.z = cvt_pk_bf16(v1[0], v1[1]); w.w = cvt_pk_bf16(v1[2], v1[3]);
                        *(u32x4*)(rowp + bj * HALF) = w; } }
        }
    }
};
template <bool GATE> struct EpiRes {
    static constexpr bool PERM = false, AFTER_DRAIN = false;
    const float* xin; float* xout; int ldc; const bf16_t* e;
    __device__ __forceinline__ void operator()(const f32x4 (&acc)[2][2][4][2], const Unit& u, int wr, int wc, int fr, int fq) const {
        { int l; asm volatile("v_mbcnt_lo_u32_b32 %0, -1, 0\n\tv_mbcnt_hi_u32_b32 %0, -1, %0" : "=v"(l)); fr = l & 15; fq = l >> 4; }
        const int row0 = u.pm * BM + wr * 64 + fr, col0 = u.pn * BM + wc * 32 + 4 * fq;
#pragma unroll
        for (int ai = 0; ai < 2; ++ai)
#pragma unroll
            for (int m = 0; m < 4; ++m) { const unsigned off = (unsigned)(row0 + ai * HALF + m * 16) * (unsigned)ldc + (unsigned)col0;
#pragma unroll
                for (int bj = 0; bj < 2; ++bj)
#pragma unroll
                    for (int n = 0; n < 2; ++n) { const unsigned o = off + bj * HALF + n * 16; const f32x4 xv = *(const f32x4*)((const char*)xin + (unsigned)(o * 4u)); f32x4 a = acc[ai][bj][m][n];
                        if (GATE) { typedef unsigned u32x2v __attribute__((ext_vector_type(2))); const u32x2v ev = *(const u32x2v*)((const char*)e + (unsigned)(o * 2u));
                            const float e0 = __builtin_bit_cast(float, ev.x << 16), e1 = __builtin_bit_cast(float, ev.x & 0xffff0000u), e2 = __builtin_bit_cast(float, ev.y << 16), e3 = __builtin_bit_cast(float, ev.y & 0xffff0000u);
                            a[0] = e0 / (1.0f + __expf(-a[0])); a[1] = e1 / (1.0f + __expf(-a[1])); a[2] = e2 / (1.0f + __expf(-a[2])); a[3] = e3 / (1.0f + __expf(-a[3])); }
                        *(f32x4*)((char*)xout + (unsigned)(o * 4u)) = xv + a; }
                asm volatile("" ::: "memory"); }
    }
};
}
#define XB_TMO      128
#define XB_XCNT(j)  (256  + 64 * (j))
#define XB_XSUB(j)  (1280 + 64 * (j))
#define XB_XGEN(j)  (2304 + 64 * (j))
#define XB_TOP      3328
#define XB_TOPGEN   3392
#define XCD_BAR_WORDS 3456
#define XB_SPIN_CAP (1u << 18)

__device__ __forceinline__ unsigned xb_ld(unsigned* p)              { return __hip_atomic_load(p, __ATOMIC_RELAXED, __HIP_MEMORY_SCOPE_AGENT); }
__device__ __forceinline__ unsigned xb_add(unsigned* p, unsigned v) { return __hip_atomic_fetch_add(p, v, __ATOMIC_RELAXED, __HIP_MEMORY_SCOPE_AGENT); }
__device__ __forceinline__ unsigned xb_xcc_id() { return (unsigned)__builtin_amdgcn_s_getreg((3 << 11) | 20) & 0xFu; }
#define XB_SPIN(cond, bar) do { unsigned _sp = 0; while (cond) { __builtin_amdgcn_s_sleep(1); \
    if ((++_sp & 255u) == 0u) { if (xb_ld(&(bar)[XB_TMO])) break; if (_sp > XB_SPIN_CAP) { atomicAdd(&(bar)[XB_TMO], 1u); break; } } } } while (0)

struct XcdBarrier {
    unsigned* bar; unsigned x;
    volatile LAS unsigned* st;
};

__device__ __forceinline__ XcdBarrier xcd_barrier_post(unsigned* bar, volatile LAS unsigned* st) {
    XcdBarrier b; b.bar = bar; b.x = xb_xcc_id(); b.st = st;
    if (threadIdx.x == 0) (void)xb_add(&bar[XB_XCNT(b.x)], 1u);
    return b;
}
__device__ __forceinline__ void xcd_barrier_complete(unsigned* bar, unsigned x, unsigned& nloc, unsigned& nx) {
    const unsigned G = gridDim.x * gridDim.y * gridDim.z;
    unsigned sum, cnt, mine, sp = 0u;
    for (;;) {
        sum = 0u; cnt = 0u; mine = 0u;
#pragma unroll
        for (unsigned j = 0; j < 16; ++j) { const unsigned c = xb_ld(&bar[XB_XCNT(j)]); sum += c; cnt += (c > 0u) ? 1u : 0u; mine = (j == x) ? c : mine; }
        if (sum == G) break;
        __builtin_amdgcn_s_sleep(1);
        if ((++sp & 255u) == 0u) { if (xb_ld(&bar[XB_TMO])) break; if (sp > XB_SPIN_CAP) { atomicAdd(&bar[XB_TMO], 1u); break; } }
    }
    nloc = mine > 0u ? mine : 1u; nx = cnt > 0u ? cnt : 1u;
}

__device__ __forceinline__ void xcd_barrier(const XcdBarrier& b) {
    asm volatile("s_waitcnt vmcnt(0)" ::: "memory");
    __syncthreads();
    if (threadIdx.x == 0) {
        unsigned* bar = b.bar;
        __builtin_amdgcn_s_waitcnt(0);
        unsigned nloc = b.st[0], nx = b.st[1];
        if (nloc == 0u) { xcd_barrier_complete(bar, b.x, nloc, nx); b.st[0] = nloc; b.st[1] = nx; }
        const unsigned old = xb_add(&bar[XB_XSUB(b.x)], 1u);
        const unsigned gen = old / nloc;
        if (old + 1u == (gen + 1u) * nloc) {
            __builtin_amdgcn_fence(__ATOMIC_RELEASE, "agent");
            asm volatile("s_waitcnt vmcnt(0)" ::: "memory");
            const unsigned og = xb_add(&bar[XB_TOP], 1u);
            const unsigned tg = og / nx;
            if (og + 1u == (tg + 1u) * nx) xb_add(&bar[XB_TOPGEN], 1u);
            else XB_SPIN(xb_ld(&bar[XB_TOPGEN]) == tg, bar);
            __builtin_amdgcn_fence(__ATOMIC_ACQUIRE, "agent");
            xb_add(&bar[XB_XGEN(b.x)], 1u);
            asm volatile("s_waitcnt vmcnt(0)" ::: "memory");
        } else {
            XB_SPIN(xb_ld(&bar[XB_XGEN(b.x)]) == gen, bar);
            __builtin_amdgcn_fence(__ATOMIC_ACQUIRE, "agent");
            asm volatile("s_waitcnt vmcnt(0)" ::: "memory");
        }
    }
    __syncthreads();
}

struct Args { const void* in[30]; float* out; unsigned char* ws; int ph_lo, ph_hi; };
struct Frame {
    LAS unsigned char* lds;
    gu32* ctl;
    unsigned char* ws;
    int tid, lane, wave, G, bid;
};
DI const void* argin(const Args&, int k) {
    typedef const void* const __attribute__((address_space(4)))* kptr_t;
    kptr_t p = (kptr_t)__builtin_amdgcn_kernarg_segment_ptr(); asm volatile("" : "+s"(p));
    return (const void*)p[k]; }
DI int launder_s(int x) { asm volatile("" : "+s"(x)); return x; }
DI Frame phase_frame(const Frame& F0) { Frame F = F0;
    int l; asm volatile("v_mbcnt_lo_u32_b32 %0, -1, 0\n\tv_mbcnt_hi_u32_b32 %0, -1, %0" : "=v"(l));
    F.wave = launder_s(F0.wave); F.bid = launder_s(F0.bid); F.G = launder_s(F0.G);
    F.lane = l; F.tid = F.wave * 64 + l;
    { unsigned long long wsb = (unsigned long long)F0.ws; asm volatile("" : "+s"(wsb)); F.ws = (unsigned char*)wsb; }
    { unsigned ll = (unsigned)(size_t)F0.lds; asm volatile("" : "+s"(ll)); F.lds = (LAS unsigned char*)(size_t)ll; }
    return F; }
DI unsigned char* lw_ptr(const Frame& F, int layer, size_t off) { return F.ws + WS_W + (size_t)layer * LW_STRIDE + off; }

template <bool FRAGMAJOR = false>
DI void transpose_item(const float* W, int K, int Nsrc, int nsrc0, bf16* WT, int dst_row0, int k0, LAS float* scr, int lane) {
#pragma unroll 8
    for (int i = 0; i < 32; ++i) { const int kk = 2 * i + (lane >> 5); scr[kk * 33 + (lane & 31)] = W[(size_t)(k0 + kk) * Nsrc + nsrc0 + (lane & 31)]; }
    LDS_WAIT(); asm volatile("" ::: "memory");
    const int c = lane & 7;
#pragma unroll
    for (int j = 0; j < 4; ++j) { const int n = (lane >> 3) + 8 * j; const LAS float* s = scr + (8 * c) * 33 + n;
        u32x4 o; o.x = pk2(s[0 * 33], s[1 * 33]); o.y = pk2(s[2 * 33], s[3 * 33]); o.z = pk2(s[4 * 33], s[5 * 33]); o.w = pk2(s[6 * 33], s[7 * 33]);
        if (FRAGMAJOR) { const int hid = dst_row0 + n, kk = k0 + 8 * c;
            *(u32x4*)(WT + ((size_t)((hid >> 4) * (K >> 5) + (kk >> 5)) * 64 + (((kk >> 3) & 3) * 16 + (hid & 15))) * 8) = o; }
        else *(u32x4*)(WT + (size_t)(dst_row0 + n) * K + k0 + 8 * c) = o; }
    LDS_WAIT(); asm volatile("" ::: "memory");
}
DI int proj_src_col(int d) {
    if (d < 5120) {
        const int pn = d >> 8; const bool rp = (pn < 10) || pn == 12 || pn == 13 || pn == 16 || pn == 17;
        if (!rp) return d;
        const int c = d & 255, bj = c >> 7, wc = (c >> 5) & 3;
        return (pn << 8) + 128 * (wc >> 1) + 64 * bj + 32 * (wc & 1);
    }
    if (d < 16384) return d + 48;
    if (d < 22528) return d + 80;
    if (d < 22592) return S_GN + (d - 22528);
    if (d < 22624) return S_DT + (d - 22592);
    return 0;
}
constexpr int TI_IN = 32 * 712, TI_O = 32 * 64, TI_UP = 32 * 256, TI_DOWN = 128 * 64, TI_PG = 32 * 64, TI_PLE = 4 * 64, TI_P1 = 64 * 4, TI_P2 = 2 * 4;
constexpr int TI_LAYER = TI_IN + TI_O + TI_UP + TI_DOWN + TI_PG + TI_PLE + 2 * TI_P1 + 2 * TI_P2;

DI void p0_prologue(const Frame& F0, const Args& A) {
    const Frame F = phase_frame(F0);
    LAS float* scr = (LAS float*)(F.lds + F.wave * 16384);
    const int gw = F.bid * NWAVES + F.wave, NGW = F.G * NWAVES;
    for (int it = gw; it < DEPTH * TI_LAYER; it += NGW) {
        const int layer = it / TI_LAYER; int r = it - layer * TI_LAYER;
        if (r < TI_IN) { const int kb = r / 712, nb = r - kb * 712;
            transpose_item((const float*)argin(A, 4) + (size_t)layer * DM * PROJ_SRC, DM, PROJ_SRC, proj_src_col(nb * 32), (bf16*)lw_ptr(F, layer, LW_IN), nb * 32, kb * 64, scr, F.lane); continue; } r -= TI_IN;
        if (r < TI_O) { const int kb = r / 64, nb = r % 64;
            transpose_item((const float*)argin(A, 22) + (size_t)layer * DM * DM, DM, DM, nb * 32, (bf16*)lw_ptr(F, layer, LW_O), nb * 32, kb * 64, scr, F.lane); continue; } r -= TI_O;
        if (r < TI_UP) { const int kb = r / 256, nb = r % 256;
            transpose_item((const float*)argin(A, 24) + (size_t)layer * DM * DFF, DM, DFF, nb * 32, (bf16*)lw_ptr(F, layer, LW_UP), nb * 32, kb * 64, scr, F.lane); continue; } r -= TI_UP;
        if (r < TI_DOWN) { const int kb = r / 64, nb = r % 64;
            transpose_item((const float*)argin(A, 25) + (size_t)layer * DFF * DM, DFF, DM, nb * 32, (bf16*)lw_ptr(F, layer, LW_DOWN), nb * 32, kb * 64, scr, F.lane); continue; } r -= TI_DOWN;
        if (r < TI_PG) { const int kb = r / 64, nb = r % 64;
            transpose_item((const float*)argin(A, 28) + (size_t)layer * DM * DM, DM, DM, nb * 32, (bf16*)lw_ptr(F, layer, LW_PG), nb * 32, kb * 64, scr, F.lane); continue; } r -= TI_PG;
        if (r < TI_PLE) { const int kb = r / 64, nb = r % 64;
            transpose_item((const float*)argin(A, 27) + (size_t)layer * PLE * DM, PLE, DM, nb * 32, (bf16*)lw_ptr(F, layer, LW_PLE), nb * 32, kb * 64, scr, F.lane); continue; } r -= TI_PLE;
        if (r < TI_P1) { const int kb = r / 4, nb = r % 4;
            transpose_item<true>((const float*)argin(A, 7) + (size_t)layer * 4096 * 128, 4096, 128, nb * 32, (bf16*)lw_ptr(F, layer, LW_PK1), nb * 32, kb * 64, scr, F.lane); continue; } r -= TI_P1;
        if (r < TI_P1) { const int kb = r / 4, nb = r % 4;
            transpose_item<true>((const float*)argin(A, 11) + (size_t)layer * 4096 * 128, 4096, 128, nb * 32, (bf16*)lw_ptr(F, layer, LW_PV1), nb * 32, kb * 64, scr, F.lane); continue; } r -= TI_P1;
        if (r < TI_P2) { const int kb = r / 4, nb = r % 4;
            transpose_item((const float*)argin(A, 9) + (size_t)layer * 128 * 128, 128, 128, nb * 32, (bf16*)lw_ptr(F, layer, LW_PK2), nb * 32, kb * 64, scr, F.lane); continue; } r -= TI_P2;
        { const int kb = r / 4, nb = r % 4;
            transpose_item((const float*)argin(A, 13) + (size_t)layer * 128 * 128, 128, 128, nb * 32, (bf16*)lw_ptr(F, layer, LW_PV2), nb * 32, kb * 64, scr, F.lane); }
    }
    const size_t gt = (size_t)F.bid * NTHR + F.tid, NGT = (size_t)F.G * NTHR;
    { const float* p = (const float*)argin(A, 1); bf16* pb = (bf16*)(F.ws + WS_PB);
      for (size_t i = gt; i < (size_t)DEPTH * M * PLE / 8; i += NGT) { const f32x4 a = *(const f32x4*)(p + i * 8), b = *(const f32x4*)(p + i * 8 + 4);
          u32x4 o; o.x = pk2(a[0], a[1]); o.y = pk2(a[2], a[3]); o.z = pk2(b[0], b[1]); o.w = pk2(b[2], b[3]); *(u32x4*)(pb + i * 8) = o; } }
    { const int* pos = (const int*)argin(A, 2); float* rope = (float*)(F.ws + WS_ROPE);
      for (size_t i = gt; i < (size_t)M * 64; i += NGT) { const int row = (int)(i >> 6), jj = (int)(i & 63);
          const float inv = 1.0f / powf(10000.0f, (float)(2 * jj) * (1.0f / 128.0f));
          const float ang = (float)pos[row] * inv;
          double a = (double)ang; a -= 6.283185307179586476925 * __builtin_rint(a * 0.15915494309189533577);
          const float ar = (float)a;
          rope[i * 2] = cosf(ar); rope[i * 2 + 1] = sinf(ar); } }
    { float* part = (float*)(F.ws + WS_MISC);
      for (size_t i = gt; i < (size_t)DEPTH * 2 * 8 * 128; i += NGT) { const int hid = (int)(i & 127), c = (int)(i >> 7) & 7, kv = (int)(i >> 10) & 1, layer = (int)(i >> 11);
          const float* pe = (const float*)(kv ? A.in[6] : A.in[5]) + (size_t)layer * 4096 + c * 512;
          const float* w1 = (const float*)(kv ? A.in[11] : A.in[7]) + (size_t)layer * 4096 * 128 + (size_t)c * 512 * 128 + hid;
          float s = 0.f;
#pragma unroll 8
          for (int kk = 0; kk < 512; ++kk) s += pe[kk] * w1[(size_t)kk * 128];
          part[i] = s; } }
}

template <bool OUTF32> DI void norm_rows(const Frame& F0, const float* x, const float* g, void* outp) {
    const Frame F = phase_frame(F0);
    const int gw = F.bid * NWAVES + F.wave, NGW = F.G * NWAVES;
    for (int m = gw; m < M; m += NGW) {
        const f32x4* xr = (const f32x4*)(x + (size_t)m * DM) + F.lane;
        f32x4 v[8]; float s = 0.f;
#pragma unroll
        for (int j = 0; j < 8; ++j) { v[j] = xr[64 * j]; s += (v[j][0] * v[j][0] + v[j][1] * v[j][1]) + (v[j][2] * v[j][2] + v[j][3] * v[j][3]); }
        const float rstd = 1.0f / sqrtf(wave_sum(s, F.lane) * (1.0f / DM) + EPS);
#pragma unroll
        for (int j = 0; j < 8; ++j) { const f32x4 gv = ((const f32x4*)g)[F.lane + 64 * j]; const f32x4 o = v[j] * rstd * gv;
            if (OUTF32) ((f32x4*)((float*)outp + (size_t)m * DM))[F.lane + 64 * j] = o;
            else { u32x2 w; w.x = pk2(o[0], o[1]); w.y = pk2(o[2], o[3]); ((u32x2*)((bf16*)outp + (size_t)m * DM))[F.lane + 64 * j] = w; } }
    }
}
template <bool OUTF32> DI void addnorm_rows(const Frame& F0, const float* xin, const bf16* delta, const float* g, float* xout, void* outp) {
    const Frame F = phase_frame(F0);
    const int gw = F.bid * NWAVES + F.wave, NGW = F.G * NWAVES;
    for (int m = gw; m < M; m += NGW) {
        const f32x4* xr = (const f32x4*)(xin + (size_t)m * DM) + F.lane; const u32x2* dr = (const u32x2*)(delta + (size_t)m * DM) + F.lane;
        f32x4 v[8]; u32x2 d[8]; float s = 0.f;
#pragma unroll
        for (int j = 0; j < 8; ++j) { v[j] = xr[64 * j]; d[j] = dr[64 * j]; }
#pragma unroll
        for (int j = 0; j < 8; ++j) { v[j][0] += bflo(d[j].x); v[j][1] += bfhi(d[j].x); v[j][2] += bflo(d[j].y); v[j][3] += bfhi(d[j].y);
            s += (v[j][0] * v[j][0] + v[j][1] * v[j][1]) + (v[j][2] * v[j][2] + v[j][3] * v[j][3]);
            if (!OUTF32) ((f32x4*)(xout + (size_t)m * DM))[F.lane + 64 * j] = v[j]; }
        const float rstd = 1.0f / sqrtf(wave_sum(s, F.lane) * (1.0f / DM) + EPS);
#pragma unroll
        for (int j = 0; j < 8; ++j) { const f32x4 gv = ((const f32x4*)g)[F.lane + 64 * j]; const f32x4 o = v[j] * rstd * gv;
            if (OUTF32) ((f32x4*)((float*)outp + (size_t)m * DM))[F.lane + 64 * j] = o;
            else { u32x2 w; w.x = pk2(o[0], o[1]); w.y = pk2(o[2], o[3]); ((u32x2*)((bf16*)outp + (size_t)m * DM))[F.lane + 64 * j] = w; } }
    }
}
DI void unpack8(u32x4 w, float (&f)[8]) { f[0] = bflo(w.x); f[1] = bfhi(w.x); f[2] = bflo(w.y); f[3] = bfhi(w.y); f[4] = bflo(w.z); f[5] = bfhi(w.z); f[6] = bflo(w.w); f[7] = bfhi(w.w); }
DI u32x4 pack8f(const float (&f)[8]) { u32x4 o; o.x = pk2(f[0], f[1]); o.y = pk2(f[2], f[3]); o.z = pk2(f[4], f[5]); o.w = pk2(f[6], f[7]); return o; }

DI void ssd_conv_pass(const Frame& F0, const Args& A, int layer) {
    const Frame F = phase_frame(F0);
    const bf16* proj = (const bf16*)(F.ws + WS_PROJ); bf16* xbc = (bf16*)(F.ws + WS_XBC);
    const float* cw = (const float*)argin(A, 16) + (size_t)layer * 4 * SSD_XBC; const float* cb = (const float*)argin(A, 17) + (size_t)layer * SSD_XBC;
    const int gt = F.bid * NTHR + F.tid, NGT = F.G * NTHR;
    for (int task = gt; task < 512 * 384; task += NGT) {
        const int run = task / 384, cg = task - run * 384, ch = cg * 8, row0 = run * 32;
        float w[4][8], bs[8], xm3[8], xm2[8], xm1[8];
#pragma unroll
        for (int j = 0; j < 4; ++j) { const f32x4 a = *(const f32x4*)(cw + j * SSD_XBC + ch), b = *(const f32x4*)(cw + j * SSD_XBC + ch + 4);
            w[j][0] = a[0]; w[j][1] = a[1]; w[j][2] = a[2]; w[j][3] = a[3]; w[j][4] = b[0]; w[j][5] = b[1]; w[j][6] = b[2]; w[j][7] = b[3]; }
        { const f32x4 a = *(const f32x4*)(cb + ch), b = *(const f32x4*)(cb + ch + 4); bs[0] = a[0]; bs[1] = a[1]; bs[2] = a[2]; bs[3] = a[3]; bs[4] = b[0]; bs[5] = b[1]; bs[6] = b[2]; bs[7] = b[3]; }
        if ((row0 & (SEQ - 1)) != 0) {
            unpack8(*(const u32x4*)(proj + (size_t)(row0 - 3) * LDP + C_XBC + ch), xm3);
            unpack8(*(const u32x4*)(proj + (size_t)(row0 - 2) * LDP + C_XBC + ch), xm2);
            unpack8(*(const u32x4*)(proj + (size_t)(row0 - 1) * LDP + C_XBC + ch), xm1);
        } else {
#pragma unroll
            for (int k = 0; k < 8; ++k) { xm3[k] = 0.f; xm2[k] = 0.f; xm1[k] = 0.f; }
        }
#pragma unroll 4
        for (int r = 0; r < 32; ++r) {
            float cur[8], y[8]; unpack8(*(const u32x4*)(proj + (size_t)(row0 + r) * LDP + C_XBC + ch), cur);
#pragma unroll
            for (int k = 0; k < 8; ++k) { const float v = w[0][k] * xm3[k] + w[1][k] * xm2[k] + w[2][k] * xm1[k] + w[3][k] * cur[k] + bs[k]; y[k] = siluf_(v); xm3[k] = xm2[k]; xm2[k] = xm1[k]; xm1[k] = cur[k]; }
            *(u32x4*)(xbc + (size_t)(row0 + r) * SSD_XBC + ch) = pack8f(y);
        }
    }
    const float* dtb = (const float*)argin(A, 18) + layer * SSD_H; float* dt = (float*)(F.ws + WS_DT);
    for (int i = gt; i < M * SSD_H; i += NGT) { const int row = i >> 5, h = i & 31;
        const float x = bf2f(proj[(size_t)row * LDP + C_DT + h]) + dtb[h];
        dt[i] = fmaxf(x, 0.f) + log1pf(__expf(-fabsf(x))); }
}

DI void merge_pass(const Frame& F0, const Args& A, int layer) {
    const Frame F = phase_frame(F0);
    const bf16* proj = (const bf16*)(F.ws + WS_PROJ); const bf16* ya = (const bf16*)(F.ws + WS_YA); const bf16* yc = (const bf16*)(F.ws + WS_YC); bf16* hb = (bf16*)(F.ws + WS_HB);
    const float* sw = (const float*)argin(A, 15) + (size_t)layer * 3 * DM; const float* ngp = (const float*)argin(A, 21) + (size_t)layer * DM; const float* rstdp = (const float*)(F.ws + WS_RSTD);
    const int gt = F.bid * NTHR + F.tid, NGT = F.G * NTHR;
    for (int task = gt; task < 512 * 256; task += NGT) {
        const int run = task >> 8, cg = task & 255, ch = cg * 8, row0 = run * 32;
        float w[3][8], pm2[8], pm1[8], ng8[8];
        { const f32x4 a = *(const f32x4*)(ngp + ch), b = *(const f32x4*)(ngp + ch + 4); ng8[0] = a[0]; ng8[1] = a[1]; ng8[2] = a[2]; ng8[3] = a[3]; ng8[4] = b[0]; ng8[5] = b[1]; ng8[6] = b[2]; ng8[7] = b[3]; }
#pragma unroll
        for (int j = 0; j < 3; ++j) { const f32x4 a = *(const f32x4*)(sw + j * DM + ch), b = *(const f32x4*)(sw + j * DM + ch + 4);
            w[j][0] = a[0]; w[j][1] = a[1]; w[j][2] = a[2]; w[j][3] = a[3]; w[j][4] = b[0]; w[j][5] = b[1]; w[j][6] = b[2]; w[j][7] = b[3]; }
        if ((row0 & (SEQ - 1)) != 0) {
            float c1[8], u1[8];
            unpack8(*(const u32x4*)(proj + (size_t)(row0 - 2) * LDP + C_CC + ch), c1); unpack8(*(const u32x4*)(proj + (size_t)(row0 - 2) * LDP + C_CU + ch), u1);
#pragma unroll
            for (int k = 0; k < 8; ++k) pm2[k] = c1[k] * u1[k];
            unpack8(*(const u32x4*)(proj + (size_t)(row0 - 1) * LDP + C_CC + ch), c1); unpack8(*(const u32x4*)(proj + (size_t)(row0 - 1) * LDP + C_CU + ch), u1);
#pragma unroll
            for (int k = 0; k < 8; ++k) pm1[k] = c1[k] * u1[k];
        } else {
#pragma unroll
            for (int k = 0; k < 8; ++k) { pm2[k] = 0.f; pm1[k] = 0.f; }
        }
#pragma unroll 2
        for (int r = 0; r < 32; ++r) {
            const size_t pr = (size_t)(row0 + r) * LDP + ch, yr = (size_t)(row0 + r) * DM + ch;
            float cc[8], cu[8], cbv[8], g0[8], g1[8], g2[8], a[8], c[8], o[8];
            unpack8(*(const u32x4*)(proj + pr + C_CC), cc); unpack8(*(const u32x4*)(proj + pr + C_CU), cu); unpack8(*(const u32x4*)(proj + pr + C_CB), cbv);
            unpack8(*(const u32x4*)(proj + pr + C_GM), g0); unpack8(*(const u32x4*)(proj + pr + C_GM + DM), g1); unpack8(*(const u32x4*)(proj + pr + C_GM + 2 * DM), g2);
            unpack8(*(const u32x4*)(ya + yr), a); unpack8(*(const u32x4*)(yc + yr), c);
            const float rs = rstdp[(size_t)(row0 + r) * SSD_G + (ch >> 9)];
#pragma unroll
            for (int k = 0; k < 8; ++k) { const float pc = cc[k] * cu[k]; const float cv = w[0][k] * pm2[k] + w[1][k] * pm1[k] + w[2][k] * pc; pm2[k] = pm1[k]; pm1[k] = pc;
                o[k] = sigmoidf_(g0[k]) * a[k] + sigmoidf_(g1[k]) * (cbv[k] * cv) + sigmoidf_(g2[k]) * (c[k] * rs * ng8[k]); }
            *(u32x4*)(hb + yr) = pack8f(o);
        }
    }
}

DI void compress_phase(const Frame& F0, const Args& A, int layer) {
    const Frame F = phase_frame(F0);
    const bf16* proj = (const bf16*)(F.ws + WS_PROJ);
    LAS unsigned char* slab = F.lds;
    LAS unsigned char* hidl = F.lds + 73728;
    LAS float* b1s = (LAS float*)(F.lds + 81920);
    const int lane = F.lane, w = F.wave, i = lane & 15, qd = lane >> 4;
    const float* part = (const float*)(F.ws + WS_MISC);
    for (int u = F.bid; u < 512; u += F.G) {
        const int kv = u >> 8, b = (u >> 7) & 1, g = (u >> 5) & 3, nb = u & 31, n0 = nb * 16, tok0 = n0 * 16;
        const int col = (kv ? C_VC : C_KC) + g * HD;
        for (int id = F.tid; id < 272 * 16; id += NTHR) { const int row = id >> 4, ch = id & 15, t = tok0 + row;
            u32x4 v = {0u, 0u, 0u, 0u}; if (t < SEQ) v = *(const u32x4*)(proj + (size_t)(b * SEQ + t) * LDP + col + ch * 8);
            *(LAS u32x4*)(slab + off_b(row, ch)) = v; }
        if (F.tid < 128) { float s = ((const float*)argin(A, kv ? 12 : 8))[layer * 128 + F.tid];
#pragma unroll
            for (int c = 0; c < 8; ++c) s += part[(((size_t)layer * 2 + kv) * 8 + c) * 128 + F.tid];
            b1s[F.tid] = s; }
        __syncthreads();
        const bf16* w1t = (const bf16*)lw_ptr(F, layer, kv ? LW_PV1 : LW_PK1) + ((size_t)w * 128 * 64 + lane) * 8;
        f32x4 acc = {0.f, 0.f, 0.f, 0.f};
        for (int k0 = 0; k0 < 128; k0 += 32) {
            bf16x8 bb[32];
#pragma unroll
            for (int k = 0; k < 32; ++k) bb[k] = *(const bf16x8*)(w1t + 512 * (k0 + k));
#pragma unroll
            for (int k = 0; k < 32; ++k) { const int ks = k0 + k;
                acc = MFMA16(lds_rd8(slab + off_b(16 * i + (ks >> 2), 4 * (ks & 3) + qd)), bb[k], acc); }
        }
        { const float bv = b1s[16 * w + i];
#pragma unroll
          for (int j = 0; j < 4; ++j) *(LAS bf16*)(hidl + (4 * qd + j) * 272 + (16 * w + i) * 2) = (bf16)f2bf(siluf_(acc[j] + bv)); }
        __syncthreads();
        const bf16* w2t = (const bf16*)lw_ptr(F, layer, kv ? LW_PV2 : LW_PK2) + (size_t)(16 * w + i) * 128 + 8 * qd;
        f32x4 acc2 = {0.f, 0.f, 0.f, 0.f};
#pragma unroll
        for (int s = 0; s < 4; ++s) {
            const bf16x8 a = lds_rd8(hidl + i * 272 + 64 * s + 16 * qd);
            const bf16x8 bb = *(const bf16x8*)(w2t + 32 * s);
            acc2 = MFMA16(a, bb, acc2);
        }
        const float b2 = ((const float*)argin(A, kv ? 14 : 10))[layer * 128 + 16 * w + i];
        bf16* dst = (bf16*)(F.ws + (kv ? WS_VCMP : WS_KCMP)) + ((size_t)(b * NG + g) * NCMP_PAD + n0) * HD + 16 * w + i;
#pragma unroll
        for (int j = 0; j < 4; ++j) dst[(size_t)(4 * qd + j) * HD] = (bf16)f2bf(acc2[j] + b2);
        __syncthreads();
    }
}

DI void ssd_states_phase(const Frame& F0, const Args& A, int layer) {
    const Frame F = phase_frame(F0);
    const bf16* xbc = (const bf16*)(F.ws + WS_XBC); const float* dt = (const float*)(F.ws + WS_DT);
    float* acs = (float*)(F.ws + WS_ACS); float* cdec = (float*)(F.ws + WS_CDEC); float* st = (float*)(F.ws + WS_ST);
    LAS unsigned char* Bt = F.lds; LAS unsigned char* Xt = F.lds + 32768; LAS float* sc = (LAS float*)(F.lds + 65536);
    const float* alog = (const float*)argin(A, 19) + layer * SSD_H;
    const int lane = F.lane, w = F.wave, i = lane & 15, qd = lane >> 4;
    for (int u = F.bid; u < 512; u += F.G) {
        const int b = u >> 8, c = (u >> 2) & 63, g = u & 3, row0 = b * SEQ + c * SSD_CH;
        {
            const int hh = g * 8 + w; const float a = -__expf(alog[hh]);
            const float dt0 = dt[(size_t)(row0 + 2 * lane) * SSD_H + hh], dt1 = dt[(size_t)(row0 + 2 * lane + 1) * SSD_H + hh];
            const float d0 = dt0 * a, d1 = dt1 * a, pair = d0 + d1; float s = pair;
#pragma unroll
            for (int o = 1; o < 64; o <<= 1) { const float t = shfl_idx(s, lane - o); if (lane >= o) s += t; }
            const float a0 = (s - pair) + d0, a1 = s, total = __builtin_bit_cast(float, __builtin_amdgcn_readlane(__builtin_bit_cast(int, s), 63));
            acs[(size_t)(row0 + 2 * lane) * SSD_H + hh] = a0; acs[(size_t)(row0 + 2 * lane + 1) * SSD_H + hh] = a1;
            sc[w * 128 + 2 * lane] = dt0 * __expf(total - a0); sc[w * 128 + 2 * lane + 1] = dt1 * __expf(total - a1);
            if (lane == 0) cdec[(size_t)(b * SSD_NC + c) * SSD_H + hh] = __expf(total);
        }
        for (int id = F.tid; id < 128 * 16; id += NTHR) { const int row = id >> 4, ch = id & 15;
            *(LAS u32x4*)(Bt + off_b(row, ch)) = *(const u32x4*)(xbc + (size_t)(row0 + row) * SSD_XBC + 2048 + g * 128 + ch * 8); }
        bf16x8 bfr[4];
        for (int hp = 0; hp < 4; ++hp) {
            __syncthreads();
            for (int id = F.tid; id < 128 * 16; id += NTHR) { const int row = id >> 4, ch = id & 15;
                float x[8]; unpack8(*(const u32x4*)(xbc + (size_t)(row0 + row) * SSD_XBC + g * 512 + hp * 128 + ch * 8), x);
                const float f = sc[(hp * 2 + (ch >> 3)) * 128 + row];
#pragma unroll
                for (int k = 0; k < 8; ++k) x[k] *= f;
                *(LAS u32x4*)(Xt + off_b(row, ch)) = pack8f(x); }
            __syncthreads();
            if (hp == 0) {
#pragma unroll
                for (int ks = 0; ks < 4; ++ks) bfr[ks] = tr_read8(Bt, lane, 32 * ks, w);
            }
#pragma unroll
            for (int h2 = 0; h2 < 2; ++h2) {
                const int head = g * 8 + hp * 2 + h2;
                float* dst = st + ((size_t)((b * SSD_NC + c) * SSD_H + head) * SSD_N + 16 * w + i) * SSD_P + 4 * qd;
#pragma unroll
                for (int pt = 0; pt < 4; ++pt) {
                    f32x4 acc = {0.f, 0.f, 0.f, 0.f};
#pragma unroll
                    for (int ks = 0; ks < 4; ++ks) acc = MFMA16(tr_read8(Xt, lane, 32 * ks, h2 * 4 + pt), bfr[ks], acc);
                    *(f32x4*)(dst + 16 * pt) = acc;
                }
            }
        }
        __syncthreads();
    }
}
DI void ssd_scan_phase(const Frame& F0) {
    const Frame F = phase_frame(F0);
    const f32x4* st = (const f32x4*)(F.ws + WS_ST); u32x2* hin = (u32x2*)(F.ws + WS_HIN); const float* cdec = (const float*)(F.ws + WS_CDEC);
    const int gt = F.bid * NTHR + F.tid, NGT = F.G * NTHR;
    for (int v = gt; v < BATCH * SSD_H * 2048; v += NGT) {
        const int b = v >> 16, h = (v >> 11) & 31, e = v & 2047;
        const size_t o0 = ((size_t)(b * SSD_NC) * SSD_H + h) * 2048 + e;
        const float* dc = cdec + (size_t)(b * SSD_NC) * SSD_H + h;
        f32x4 hs = {0.f, 0.f, 0.f, 0.f};
        for (int c0 = 0; c0 < SSD_NC; c0 += 8) {
            f32x4 s[8]; float d[8];
#pragma unroll
            for (int k = 0; k < 8; ++k) { s[k] = st[o0 + (size_t)(c0 + k) * 65536]; d[k] = dc[(c0 + k) * SSD_H]; }
#pragma unroll
            for (int k = 0; k < 8; ++k) { u32x2 o; o.x = pk2(hs[0], hs[1]); o.y = pk2(hs[2], hs[3]); hin[o0 + (size_t)(c0 + k) * 65536] = o; hs = hs * d[k] + s[k]; }
        }
    }
}
DI void ssd_out_phase(const Frame& F0, const Args& A, int layer) {
    const Frame F = phase_frame(F0);
    const bf16* xbc = (const bf16*)(F.ws + WS_XBC); const bf16* proj = (const bf16*)(F.ws + WS_PROJ);
    const float* dt = (const float*)(F.ws + WS_DT); const float* acs = (const float*)(F.ws + WS_ACS); const bf16* hin = (const bf16*)(F.ws + WS_HIN);
    bf16* yc = (bf16*)(F.ws + WS_YC); float* rstdp = (float*)(F.ws + WS_RSTD);
    LAS unsigned char* Bt = F.lds; LAS unsigned char* Ct = F.lds + 32768; LAS unsigned char* Xt = F.lds + 65536; LAS unsigned char* Ht = F.lds + 98304;
    LAS float* acsl = (LAS float*)(F.lds + LX_OFF);
    const float* dsk = (const float*)argin(A, 20) + layer * SSD_H;
    const int lane = F.lane, w = F.wave, i = lane & 15, qd = lane >> 4;
    for (int u = F.bid; u < 512; u += F.G) {
        const int b = u >> 8, c = (u >> 2) & 63, g = u & 3, row0 = b * SEQ + c * SSD_CH;
        for (int id = F.tid; id < 128 * 16; id += NTHR) { const int row = id >> 4, ch = id & 15; const bf16* src = xbc + (size_t)(row0 + row) * SSD_XBC + 2048 + g * 128 + ch * 8;
            *(LAS u32x4*)(Bt + off_b(row, ch)) = *(const u32x4*)(src); *(LAS u32x4*)(Ct + off_b(row, ch)) = *(const u32x4*)(src + 512); }
        __syncthreads();
        bf16x8 cfr[4];
#pragma unroll
        for (int ks = 0; ks < 4; ++ks) cfr[ks] = lds_rd8(Ct + off_b(16 * w + i, 4 * ks + qd));
        f32x4 cb[4][2];
#pragma unroll
        for (int k = 0; k < 4; ++k)
#pragma unroll
            for (int T = 0; T < 2; ++T) { f32x4 acc = {0.f, 0.f, 0.f, 0.f};
#pragma unroll
                for (int ks = 0; ks < 4; ++ks) acc = MFMA16(lds_rd8(Bt + off_b(32 * k + 8 * (i >> 2) + (i & 3) + 4 * T, 4 * ks + qd)), cfr[ks], acc);
                cb[k][T] = acc; }
        const int lrow = 16 * w + i, row = row0 + lrow;
        float ssq = 0.f;
        for (int hp = 0; hp < 4; ++hp) {
            __syncthreads();
            if (F.tid < 256) { const int h2 = F.tid >> 7, l = F.tid & 127; acsl[F.tid] = acs[(size_t)(row0 + l) * SSD_H + g * 8 + hp * 2 + h2]; }
            for (int id = F.tid; id < 128 * 16; id += NTHR) { const int r = id >> 4, ch = id & 15, head = g * 8 + hp * 2 + (ch >> 3);
                float x[8]; unpack8(*(const u32x4*)(xbc + (size_t)(row0 + r) * SSD_XBC + g * 512 + hp * 128 + ch * 8), x);
                const float f = dt[(size_t)(row0 + r) * SSD_H + head];
#pragma unroll
                for (int k = 0; k < 8; ++k) x[k] *= f;
                *(LAS u32x4*)(Xt + off_b(r, ch)) = pack8f(x);
                *(LAS u32x4*)(Ht + off_b(r, ch)) = *(const u32x4*)(hin + ((size_t)((b * SSD_NC + c) * SSD_H + head) * SSD_N + r) * SSD_P + (ch & 7) * 8); }
            __syncthreads();
#pragma unroll
            for (int h2 = 0; h2 < 2; ++h2) {
                const int head = g * 8 + hp * 2 + h2;
                const float al = acsl[h2 * 128 + lrow], ea = __expf(al), dsv = dsk[head];
                u32x2 xv4[4], zv4[4];
#pragma unroll
                for (int pt = 0; pt < 4; ++pt) { const int chn = head * SSD_P + 16 * pt + 4 * qd;
                    xv4[pt] = *(const u32x2*)(xbc + (size_t)row * SSD_XBC + chn); zv4[pt] = *(const u32x2*)(proj + (size_t)row * LDP + C_Z + chn); }
                bf16x8 mfr[4];
#pragma unroll
                for (int k = 0; k < 4; ++k) {
                    const f32x4 a0 = *(const LAS f32x4*)(acsl + h2 * 128 + 32 * k + 8 * qd), a1 = *(const LAS f32x4*)(acsl + h2 * 128 + 32 * k + 8 * qd + 4);
                    float mv[8];
#pragma unroll
                    for (int j = 0; j < 4; ++j) { const int s0 = 32 * k + 8 * qd + j, s1 = s0 + 4;
                        mv[j] = (s0 <= lrow) ? cb[k][0][j] * __expf(al - a0[j]) : 0.f;
                        mv[4 + j] = (s1 <= lrow) ? cb[k][1][j] * __expf(al - a1[j]) : 0.f; }
                    mfr[k] = as_bf16x8(pack8f(mv));
                }
#pragma unroll
                for (int pt = 0; pt < 4; ++pt) {
                    f32x4 yd = {0.f, 0.f, 0.f, 0.f}, yo = {0.f, 0.f, 0.f, 0.f};
#pragma unroll
                    for (int k = 0; k < 4; ++k) yd = MFMA16(tr_read8(Xt, lane, 32 * k, h2 * 4 + pt), mfr[k], yd);
#pragma unroll
                    for (int ks = 0; ks < 4; ++ks) yo = MFMA16(tr_read8(Ht, lane, 32 * ks, h2 * 4 + pt), cfr[ks], yo);
                    const int chn = head * SSD_P + 16 * pt + 4 * qd;
                    const u32x2 xv = xv4[pt], zv = zv4[pt];
                    const float xs[4] = {bflo(xv.x), bfhi(xv.x), bflo(xv.y), bfhi(xv.y)}, zz[4] = {bflo(zv.x), bfhi(zv.x), bflo(zv.y), bfhi(zv.y)};
                    float gy[4];
#pragma unroll
                    for (int j = 0; j < 4; ++j) { const float y = yd[j] + ea * yo[j] + dsv * xs[j]; gy[j] = y * siluf_(zz[j]); ssq += gy[j] * gy[j]; }
                    u32x2 o; o.x = pk2(gy[0], gy[1]); o.y = pk2(gy[2], gy[3]);
                    *(u32x2*)(yc + (size_t)row * DM + chn) = o;
                }
            }
        }
        ssq += shx(ssq, 16, lane); ssq += shx(ssq, 32, lane);
        if (qd == 0) rstdp[(size_t)row * SSD_G + g] = 1.0f / sqrtf(ssq * (1.0f / 512.0f) + EPS);
        __syncthreads();
    }
}

#ifndef NSA_REP_PART
#define NSA_REP_PART 0
#endif
#if NSA_REP_PART == 7
#define W7DUP(x) x
#define W7WAIT() NSA_WAITV(8)
#else
#define W7DUP(x)
#define W7WAIT() NSA_WAITV(4)
#endif
#if NSA_REP_PART == 10
#define SELDUP(x) x
#else
#define SELDUP(x)
#endif
constexpr int RB = 32768, NRING = 3;
#define NSA_WAITV(n) asm volatile("s_waitcnt vmcnt(" #n ")" ::: "memory")
#define NSA_BAR() do { asm volatile("" ::: "memory"); __builtin_amdgcn_s_barrier(); asm volatile("" ::: "memory"); } while (0)
template <bool WITHV> DI void tile_dma(LAS unsigned char* buf, const bf16* kp, const bf16* vp, int pitch, int w, int lane) {
#pragma unroll
    for (int e = 0; e < 2; ++e) { const int kb = 2 * w + e, kh = kb >> 3, T = (kb >> 2) & 1, ks = kb & 3, i = lane & 15, qd = lane >> 4;
        const int key = 32 * kh + 8 * (i >> 2) + (i & 3) + 4 * T, ch = 4 * ks + qd;
        __builtin_amdgcn_global_load_lds((const unsigned*)(kp + (size_t)key * pitch + ch * 8), (LAS unsigned*)(buf + kb * 1024), 16, 0, 0); }
    if (WITHV) {
#pragma unroll
        for (int e = 0; e < 2; ++e) { const int vb = 2 * w + e, kh = vb >> 3, t = (vb >> 2) & 1, dtp = vb & 3, dtl = lane >> 5, g = (lane >> 3) & 3, q = (lane >> 1) & 3, ph = lane & 1;
            const int key = 32 * kh + 8 * g + 4 * t + q, ch = 4 * dtp + 2 * dtl + ph;
            __builtin_amdgcn_global_load_lds((const unsigned*)(vp + (size_t)key * pitch + ch * 8), (LAS unsigned*)(buf + 16384 + vb * 1024), 16, 0, 0); }
    }
}
#define NSA_TR8(r, addr, b) asm volatile("ds_read_b64_tr_b16 %0, %8 offset:%9\n\tds_read_b64_tr_b16 %1, %8 offset:%10\n\tds_read_b64_tr_b16 %2, %8 offset:%11\n\tds_read_b64_tr_b16 %3, %8 offset:%12\n\t" \
        "ds_read_b64_tr_b16 %4, %8 offset:%13\n\tds_read_b64_tr_b16 %5, %8 offset:%14\n\tds_read_b64_tr_b16 %6, %8 offset:%15\n\tds_read_b64_tr_b16 %7, %8 offset:%16" \
        : "=&v"(r[0]), "=&v"(r[1]), "=&v"(r[2]), "=&v"(r[3]), "=&v"(r[4]), "=&v"(r[5]), "=&v"(r[6]), "=&v"(r[7]) \
        : "v"(addr), "i"((b)), "i"((b) + 4096), "i"((b) + 512), "i"((b) + 4608), "i"((b) + 1024), "i"((b) + 5120), "i"((b) + 1536), "i"((b) + 5632) : "memory")
#define NSA_TRWAIT(r) asm volatile("s_waitcnt lgkmcnt(0)" : "+v"(r[0]), "+v"(r[1]), "+v"(r[2]), "+v"(r[3]), "+v"(r[4]), "+v"(r[5]), "+v"(r[6]), "+v"(r[7]) :: "memory")
#define NSA_SB() __builtin_amdgcn_sched_barrier(0)
#define NSA_PV4(r, kh, d0) do { _Pragma("unroll") for (int q_ = 0; q_ < 4; ++q_) { const bf16x8 vf_ = __builtin_shufflevector(r[2 * q_], r[2 * q_ + 1], 0, 1, 2, 3, 4, 5, 6, 7); \
        if (SM & 1) O[0][(d0) + q_] = MFMA16(vf_, pf[0][kh], O[0][(d0) + q_]); if (SM & 2) O[1][(d0) + q_] = MFMA16(vf_, pf[1][kh], O[1][(d0) + q_]); } } while (0)
template <int MODE, int SM>
DI void attn_tile(LAS const unsigned char* Kt, LAS const unsigned char* Vt, const bf16x8 (&Qf)[2][4], f32x4 (&O)[2][8], float (&m)[2], float (&l)[2], const int (&lo)[2], const int (&hi)[2], bool needmask,
                  float c2, const float (&inv_l)[2], LAS float* imp, const int (&ql)[2], int jb0, float (&cin)[2], int lane) {
    const int qd = lane >> 4;
    f32x4 sc[2][2][2];
#pragma unroll
    for (int kh = 0; kh < 2; ++kh)
#pragma unroll
        for (int T = 0; T < 2; ++T) { f32x4 a0 = {0.f, 0.f, 0.f, 0.f}, a1 = {0.f, 0.f, 0.f, 0.f};
#pragma unroll
            for (int ks = 0; ks < 4; ++ks) { const bf16x8 kf = lds_rd8(Kt + (kh * 8 + T * 4 + ks) * 1024);
                if (SM & 1) a0 = MFMA16(kf, Qf[0][ks], a0); if (SM & 2) a1 = MFMA16(kf, Qf[1][ks], a1); }
            sc[0][kh][T] = a0; sc[1][kh][T] = a1; }
    const float NEG = -__builtin_inff();
    bf16x8 pf[2][2];
#pragma unroll
    for (int s = 0; s < 2; ++s) if (SM & (1 << s)) {
        if (needmask) {
#pragma unroll
            for (int kh = 0; kh < 2; ++kh)
#pragma unroll
                for (int T = 0; T < 2; ++T)
#pragma unroll
                    for (int j = 0; j < 4; ++j) { const int kk = 32 * kh + 8 * qd + 4 * T + j; if (kk < lo[s] || kk > hi[s]) sc[s][kh][T][j] = NEG; }
        }
        float mn = m[s];
        if (MODE != 2) {
            float tmax = fmaxf(fmaxf(sc[s][0][0][0], sc[s][0][0][1]), fmaxf(sc[s][0][0][2], sc[s][0][0][3]));
            tmax = fmaxf(tmax, fmaxf(fmaxf(sc[s][0][1][0], sc[s][0][1][1]), fmaxf(sc[s][0][1][2], sc[s][0][1][3])));
            tmax = fmaxf(tmax, fmaxf(fmaxf(sc[s][1][0][0], sc[s][1][0][1]), fmaxf(sc[s][1][0][2], sc[s][1][0][3])));
            tmax = fmaxf(tmax, fmaxf(fmaxf(sc[s][1][1][0], sc[s][1][1][1]), fmaxf(sc[s][1][1][2], sc[s][1][1][3])));
            tmax = xq_max(tmax);
            mn = fmaxf(m[s], tmax);
            if (__ballot(mn != m[s]) != 0ull) {
                const float alpha = __builtin_amdgcn_exp2f((m[s] - mn) * c2);
                l[s] *= alpha;
                if (MODE == 1) {
#pragma unroll
                    for (int dt = 0; dt < 8; ++dt) O[s][dt] = O[s][dt] * alpha;
                }
                m[s] = mn;
            }
        }
        const float nmc = -mn * c2; float ps = 0.f;
#pragma unroll
        for (int kh = 0; kh < 2; ++kh)
#pragma unroll
            for (int T = 0; T < 2; ++T)
#pragma unroll
                for (int j = 0; j < 4; ++j) { float p = __builtin_amdgcn_exp2f(__builtin_fmaf(sc[s][kh][T][j], c2, nmc)); if (MODE == 2) p *= inv_l[s]; sc[s][kh][T][j] = p; ps += p; }
        if (MODE != 2) l[s] += ps;
        if (MODE == 2) {
            float s4[2][2], cy[2][2];
#pragma unroll
            for (int kh = 0; kh < 2; ++kh)
#pragma unroll
                for (int T = 0; T < 2; ++T) {
                    float a = (sc[s][kh][T][0] + sc[s][kh][T][1]) + (sc[s][kh][T][2] + sc[s][kh][T][3]), c = sc[s][kh][T][3];
                    a = quad_sum(a); c = quad_sum(c);
                    s4[kh][T] = a; cy[kh][T] = c; }
            const float x0 = shfl_idx(cy[0][1], (lane - 16) & 63), x1 = shfl_idx(cy[1][1], (lane - 16) & 63);
            const float p00 = (qd == 0) ? cin[s] : x0, p10 = (qd == 0) ? x0 : x1;
            cin[s] = x1;
            if ((lane & 3) == 0) { const int jb = jb0 + 2 * qd;
                *(LAS f32x2*)(imp + ql[s] * 128 + jb) = (f32x2){s4[0][0] + p00, s4[0][1] + cy[0][0]};
                *(LAS f32x2*)(imp + ql[s] * 128 + jb + 8) = (f32x2){s4[1][0] + p10, s4[1][1] + cy[1][0]}; }
        }
        if (MODE != 0) {
#pragma unroll
            for (int kh = 0; kh < 2; ++kh) { u32x4 pw; pw.x = pk2(sc[s][kh][0][0], sc[s][kh][0][1]); pw.y = pk2(sc[s][kh][0][2], sc[s][kh][0][3]); pw.z = pk2(sc[s][kh][1][0], sc[s][kh][1][1]); pw.w = pk2(sc[s][kh][1][2], sc[s][kh][1][3]); pf[s][kh] = as_bf16x8(pw); }
        }
    }
    if (MODE != 0) {
        const unsigned va = (unsigned)(size_t)Vt;
        s16x4 ra[8], rb[8];
        NSA_TR8(ra, va, 0);     NSA_TRWAIT(ra); NSA_SB();
        NSA_TR8(rb, va, 2048);  NSA_SB(); NSA_PV4(ra, 0, 0); NSA_SB(); NSA_TRWAIT(rb); NSA_SB();
        NSA_TR8(ra, va, 8192);  NSA_SB(); NSA_PV4(rb, 0, 4); NSA_SB(); NSA_TRWAIT(ra); NSA_SB();
        NSA_TR8(rb, va, 10240); NSA_SB(); NSA_PV4(ra, 1, 0); NSA_SB(); NSA_TRWAIT(rb); NSA_SB();
        NSA_PV4(rb, 1, 4);
    }
}
template <bool FIRST> DI void nsa_emit(const f32x4 (&O)[8], float scale, bf16* dst  ) {
    u32x2 old[8];
    if (!FIRST) {
#pragma unroll
        for (int dt = 0; dt < 8; ++dt) old[dt] = *(const u32x2*)(dst + 16 * dt);
    }
#pragma unroll
    for (int dt = 0; dt < 8; ++dt) { f32x4 v = O[dt] * scale;
        if (!FIRST) { v[0] += bflo(old[dt].x); v[1] += bfhi(old[dt].x); v[2] += bflo(old[dt].y); v[3] += bfhi(old[dt].y); }
        u32x2 o; o.x = pk2(v[0], v[1]); o.y = pk2(v[2], v[3]); *(u32x2*)(dst + 16 * dt) = o; }
}
DI int next_bit(unsigned u0, unsigned u1, unsigned u2, unsigned u3, int from) {
    if (from >= 128) return -1;
    const int wd = from >> 5; const unsigned msk = ~0u << (from & 31);
    const unsigned x0 = (wd == 0) ? (u0 & msk) : 0u;
    const unsigned x1 = (wd < 1) ? u1 : ((wd == 1) ? (u1 & msk) : 0u);
    const unsigned x2 = (wd < 2) ? u2 : ((wd == 2) ? (u2 & msk) : 0u);
    const unsigned x3 = (wd < 3) ? u3 : (u3 & msk);
    if (x0) return __builtin_ctz(x0);
    if (x1) return 32 + __builtin_ctz(x1);
    if (x2) return 64 + __builtin_ctz(x2);
    if (x3) return 96 + __builtin_ctz(x3);
    return -1;
}

DI void nsa_phase(const Frame& F0, const Args& A, int layer) {
    const Frame F = phase_frame(F0);
    const bf16* proj = (const bf16*)(F.ws + WS_PROJ); const bf16* kcmp = (const bf16*)(F.ws + WS_KCMP); const bf16* vcmp = (const bf16*)(F.ws + WS_VCMP);
    bf16* ya = (bf16*)(F.ws + WS_YA);
    LAS unsigned char* const RG = F.lds;
    LAS float* imp = (LAS float*)(F.lds + NRING * RB);
    LAS unsigned* selm = (LAS unsigned*)(F.lds + NRING * RB + 32768); LAS unsigned* uml = selm + 256;
    static_assert(NRING * RB + 32768 + 1024 + 16 <= LDSCTL_OFF && NRING * RB + 32768 == 4 * RB, "nsa LDS map (the selected loop's pair buffers overlay ring + importance table)");
    const float c2 = 0.08838834764831845f * 1.4426950408889634f;
    (void)A; (void)layer;
#if defined(NSA_PRIO)
    if (F.wave < 4) __builtin_amdgcn_s_setprio(2); else __builtin_amdgcn_s_setprio(0);
#endif
    for (int u = F.bid; u < 1024; u += F.G) {
        int tid_l = F.tid; asm volatile("" : "+v"(tid_l));
        const int tid = tid_l, lane = tid & 63, w = F.wave, i = lane & 15, qd = lane >> 4, hd = i & 3;
        const int klane = 16 * lane, vlane = 16384 + 8 * lane;
        const int xg = u & 7, jj = (u >> 3) & 31, rr = u >> 8;
        const int b = xg >> 2, g = xg & 3;
        const int qt = (rr == 0) ? 127 - jj : (rr == 1) ? 64 + jj : (rr == 2) ? 63 - jj : jj;
        const int s0 = qt * 64, cur = qt, rowb = b * SEQ;
        int ql[2], trow[2]; bf16x8 Qf[2][4];
#pragma unroll
        for (int s = 0; s < 2; ++s) { ql[s] = 8 * w + 4 * s + (i >> 2); trow[s] = rowb + s0 + ql[s];
#pragma unroll
            for (int ks = 0; ks < 4; ++ks) Qf[s][ks] = *(const bf16x8*)(proj + (size_t)trow[s] * LDP + C_Q + (4 * g + hd) * HD + 32 * ks + 8 * qd); }
        f32x4 O[2][8]; float mrow[2], lrow[2], cin[2], invl[2] = {0.f, 0.f};
        const int ntc = (4 * qt + 3 + 63) >> 6;
        const bf16* kc0 = kcmp + (size_t)(b * NG + g) * NCMP_PAD * HD; const bf16* vc0 = vcmp + (size_t)(b * NG + g) * NCMP_PAD * HD;
        int nmax[2];
#pragma unroll
        for (int s = 0; s < 2; ++s) { const int t = s0 + ql[s]; nmax[s] = (t >= 31) ? ((t - 31) >> 4) : -1; mrow[s] = -1e30f; lrow[s] = 0.f; cin[s] = 0.f; }
        for (int rep_ = 0; rep_ < (NSA_REP_PART == 2 ? 2 : 1); ++rep_) {
#pragma unroll
        for (int s = 0; s < 2; ++s) { mrow[s] = -1e30f; lrow[s] = 0.f; cin[s] = 0.f; }
        NSA_WAITV(0); NSA_BAR();
        tile_dma<false>(RG, kc0, vc0, HD, w, lane); if (ntc > 1) tile_dma<false>(RG + RB, kc0 + (size_t)64 * HD, vc0, HD, w, lane);
        for (int tc = 0, rb = 0; tc < ntc; ++tc) {
            if (tc + 1 < ntc) NSA_WAITV(2); else NSA_WAITV(0);
            NSA_BAR();
            if (tc + 2 < ntc) { const int nb2 = (rb + 2 >= NRING) ? rb + 2 - NRING : rb + 2; tile_dma<false>(RG + nb2 * RB, kc0 + (size_t)(tc + 2) * 64 * HD, vc0, HD, w, lane); }
            { const int lo2[2] = {0, 0}, hi2[2] = {nmax[0] - 64 * tc, nmax[1] - 64 * tc}; const bool nm = __ballot(hi2[0] < 63 || hi2[1] < 63) != 0ull;
              attn_tile<0, 3>(RG + rb * RB + klane, RG, Qf, O, mrow, lrow, lo2, hi2, nm, c2, invl, imp, ql, 0, cin, lane); }
            rb = (rb + 1 == NRING) ? 0 : rb + 1;
        }
#pragma unroll
        for (int s = 0; s < 2; ++s) { float lt = lrow[s]; lt = xq_sum(lt); invl[s] = (lt > 0.f) ? 1.0f / lt : 0.f;
#pragma unroll
            for (int dt = 0; dt < 8; ++dt) O[s][dt] = (f32x4){0.f, 0.f, 0.f, 0.f}; }
        NSA_BAR();
        tile_dma<true>(RG, kc0, vc0, HD, w, lane); if (ntc > 1) tile_dma<true>(RG + RB, kc0 + (size_t)64 * HD, vc0 + (size_t)64 * HD, HD, w, lane);
        for (int tc = 0, rb = 0; tc < ntc; ++tc) {
            if (tc + 1 < ntc) NSA_WAITV(4); else NSA_WAITV(0);
            NSA_BAR();
            if (tc + 2 < ntc) { const int nb2 = (rb + 2 >= NRING) ? rb + 2 - NRING : rb + 2; tile_dma<true>(RG + nb2 * RB, kc0 + (size_t)(tc + 2) * 64 * HD, vc0 + (size_t)(tc + 2) * 64 * HD, HD, w, lane); }
            { const int lo2[2] = {0, 0}, hi2[2] = {nmax[0] - 64 * tc, nmax[1] - 64 * tc}; const bool nm = __ballot(hi2[0] < 63 || hi2[1] < 63) != 0ull;
              attn_tile<2, 3>(RG + rb * RB + klane, RG + rb * RB + vlane, Qf, O, mrow, lrow, lo2, hi2, nm, c2, invl, imp, ql, 16 * tc, cin, lane); }
            rb = (rb + 1 == NRING) ? 0 : rb + 1;
        }
#pragma unroll
        for (int s = 0; s < 2; ++s) { const float gate = sigmoidf_(bf2f(proj[(size_t)trow[s] * LDP + C_GN + (4 * g + hd) * 3 + 0]));
            nsa_emit<true>(O[s], gate, ya + (size_t)trow[s] * DM + (4 * g + hd) * HD + 4 * qd); }
        }
        for (int rep_ = 0; rep_ < (NSA_REP_PART == 1 ? 2 : 1); ++rep_) {
            LDS_WAIT();
            const int nforced = (cur == 0) ? 1 : (cur == 1) ? 2 : 3; const int nsel = (cur + 1 < NSEL) ? cur + 1 : NSEL; const int R = nsel - nforced;
            const int E = (cur >= 3) ? cur - 2 : 0;
            for (int q8 = 0; q8 < 8; ++q8) {
                const int q = 8 * w + q8;
                const int j0 = lane, j1 = lane + 64;
                const bool e0 = (j0 >= 1) && (j0 <= cur - 2), e1 = (j1 <= cur - 2);
                const bool f0 = (j0 == 0) || (j0 == cur) || (j0 == cur - 1), f1 = (j1 == cur) || (j1 == cur - 1);
                bool s0 = e0, s1 = e1;
                if (R < E) {
                    const unsigned k0 = e0 ? __builtin_bit_cast(unsigned, imp[q * 128 + j0]) + 1u : 0u, k1 = e1 ? __builtin_bit_cast(unsigned, imp[q * 128 + j1]) + 1u : 0u;
                    unsigned T = 0u;
#pragma unroll 1
                    for (int bit = 30; bit >= 0; --bit) { const unsigned c = T | (1u << bit);
                        const int n = __builtin_popcountll(__ballot(k0 >= c)) + __builtin_popcountll(__ballot(k1 >= c));
                        if (n >= R) T = c; }
                    const unsigned long long eq0 = __ballot(k0 == T), eq1 = __ballot(k1 == T);
                    const int G = __builtin_popcountll(__ballot(k0 > T)) + __builtin_popcountll(__ballot(k1 > T));
                    const unsigned long long lt = (1ull << lane) - 1ull;
                    const int r0 = __builtin_popcountll(eq0 & lt), r1 = __builtin_popcountll(eq0) + __builtin_popcountll(eq1 & lt);
                    s0 = (k0 > T) || (k0 == T && r0 < R - G); s1 = (k1 > T) || (k1 == T && r1 < R - G);
                }
                const unsigned long long m0 = __ballot(f0 || s0), m1 = __ballot(f1 || s1);
                if (lane == 0) { selm[q * 4 + 0] = (unsigned)m0; selm[q * 4 + 1] = (unsigned)(m0 >> 32); selm[q * 4 + 2] = (unsigned)m1; selm[q * 4 + 3] = (unsigned)(m1 >> 32); }
            }
            __syncthreads();
            if (w == 0) { unsigned x0 = selm[lane * 4 + 0], x1 = selm[lane * 4 + 1], x2 = selm[lane * 4 + 2], x3 = selm[lane * 4 + 3];
#pragma unroll
                for (int o = 1; o < 64; o <<= 1) { x0 |= shfl_idx_u(x0, lane ^ o); x1 |= shfl_idx_u(x1, lane ^ o); x2 |= shfl_idx_u(x2, lane ^ o); x3 |= shfl_idx_u(x3, lane ^ o); }
                if (lane == 0) { uml[0] = x0; uml[1] = x1; uml[2] = x2; uml[3] = x3; } }
            __syncthreads();
        }
        const unsigned um0 = __builtin_amdgcn_readfirstlane(uml[0]), um1 = __builtin_amdgcn_readfirstlane(uml[1]), um2 = __builtin_amdgcn_readfirstlane(uml[2]), um3 = __builtin_amdgcn_readfirstlane(uml[3]);
        for (int rep_ = 0; rep_ < (NSA_REP_PART == 3 ? 2 : 1); ++rep_) {
            const bf16* ks0 = proj + (size_t)rowb * LDP + C_KS + g * HD; const bf16* vs0 = proj + (size_t)rowb * LDP + C_VS + g * HD;
#pragma unroll
            for (int s = 0; s < 2; ++s) { mrow[s] = -1e30f; lrow[s] = 0.f;
#pragma unroll
                for (int dt = 0; dt < 8; ++dt) O[s][dt] = (f32x4){0.f, 0.f, 0.f, 0.f}; }
#if NSA_REP_PART == 11
            {
            int jaD = next_bit(um0, um1, um2, um3, 0), jbD = next_bit(um0, um1, um2, um3, jaD + 1), pbD = 0;
            VM_WAIT(); if (NSA_REP_PART == 3) NSA_BAR();
            tile_dma<true>(RG, ks0 + (size_t)jaD * 64 * LDP, vs0 + (size_t)jaD * 64 * LDP, LDP, w, lane); SELDUP(tile_dma<true>(RG, ks0 + (size_t)jaD * 64 * LDP, vs0 + (size_t)jaD * 64 * LDP, LDP, w, lane);)
            if (jbD >= 0) tile_dma<true>(RG + RB, ks0 + (size_t)jbD * 64 * LDP, vs0 + (size_t)jbD * 64 * LDP, LDP, w, lane); SELDUP(tile_dma<true>(RG + RB, ks0 + (size_t)jbD * 64 * LDP, vs0 + (size_t)jbD * 64 * LDP, LDP, w, lane);)
            while (jaD >= 0) {
                const int jcD = (jbD >= 0) ? next_bit(um0, um1, um2, um3, jbD + 1) : -1, jdD = (jcD >= 0) ? next_bit(um0, um1, um2, um3, jcD + 1) : -1;
                NSA_WAITV(0);
                NSA_BAR();
                if (jcD >= 0) { LAS unsigned char* nb = RG + (pbD ^ 1) * 2 * RB; tile_dma<true>(nb, ks0 + (size_t)jcD * 64 * LDP, vs0 + (size_t)jcD * 64 * LDP, LDP, w, lane); SELDUP(tile_dma<true>(nb, ks0 + (size_t)jcD * 64 * LDP, vs0 + (size_t)jcD * 64 * LDP, LDP, w, lane);)
                    if (jdD >= 0) tile_dma<true>(nb + RB, ks0 + (size_t)jdD * 64 * LDP, vs0 + (size_t)jdD * 64 * LDP, LDP, w, lane); SELDUP(tile_dma<true>(nb + RB, ks0 + (size_t)jdD * 64 * LDP, vs0 + (size_t)jdD * 64 * LDP, LDP, w, lane);) }
                jaD = jcD; jbD = jdD; pbD ^= 1;
            }
            NSA_BAR();
            }
#endif
            int ja = next_bit(um0, um1, um2, um3, 0), jbb = next_bit(um0, um1, um2, um3, ja + 1), pbuf = 0;
            VM_WAIT(); if (NSA_REP_PART == 3) NSA_BAR();
            tile_dma<true>(RG, ks0 + (size_t)ja * 64 * LDP, vs0 + (size_t)ja * 64 * LDP, LDP, w, lane); SELDUP(tile_dma<true>(RG, ks0 + (size_t)ja * 64 * LDP, vs0 + (size_t)ja * 64 * LDP, LDP, w, lane);)
            if (jbb >= 0) tile_dma<true>(RG + RB, ks0 + (size_t)jbb * 64 * LDP, vs0 + (size_t)jbb * 64 * LDP, LDP, w, lane); SELDUP(tile_dma<true>(RG + RB, ks0 + (size_t)jbb * 64 * LDP, vs0 + (size_t)jbb * 64 * LDP, LDP, w, lane);)
            while (ja >= 0) {
                const int jc = (jbb >= 0) ? next_bit(um0, um1, um2, um3, jbb + 1) : -1, jd = (jc >= 0) ? next_bit(um0, um1, um2, um3, jc + 1) : -1;
                NSA_WAITV(0);
                NSA_BAR();
                if (jc >= 0) { LAS unsigned char* nb = RG + (pbuf ^ 1) * 2 * RB; tile_dma<true>(nb, ks0 + (size_t)jc * 64 * LDP, vs0 + (size_t)jc * 64 * LDP, LDP, w, lane); SELDUP(tile_dma<true>(nb, ks0 + (size_t)jc * 64 * LDP, vs0 + (size_t)jc * 64 * LDP, LDP, w, lane);)
                    if (jd >= 0) tile_dma<true>(nb + RB, ks0 + (size_t)jd * 64 * LDP, vs0 + (size_t)jd * 64 * LDP, LDP, w, lane); SELDUP(tile_dma<true>(nb + RB, ks0 + (size_t)jd * 64 * LDP, vs0 + (size_t)jd * 64 * LDP, LDP, w, lane);) }
#pragma unroll 1
                for (int e2 = 0; e2 < 2; ++e2) { const int jb = e2 ? jbb : ja; if (jb < 0) break;
                  const bool act0 = (selm[ql[0] * 4 + (jb >> 5)] >> (jb & 31)) & 1u, act1 = (selm[ql[1] * 4 + (jb >> 5)] >> (jb & 31)) & 1u;
                  const bool any0 = __ballot(act0) != 0ull, any1 = __ballot(act1) != 0ull;
                  const int lo2[2] = {0, 0}, hi2[2] = {act0 ? ((jb < cur) ? 63 : ql[0]) : -1, act1 ? ((jb < cur) ? 63 : ql[1]) : -1};
                  LAS const unsigned char* kt = RG + (pbuf * 2 + e2) * RB + klane; LAS const unsigned char* vt = RG + (pbuf * 2 + e2) * RB + vlane;
                  if (any0 && any1) { const bool nm = __ballot(hi2[0] < 63 || hi2[1] < 63) != 0ull; attn_tile<1, 3>(kt, vt, Qf, O, mrow, lrow, lo2, hi2, nm, c2, invl, imp, ql, 0, cin, lane); }
                  else if (any0) { const bool nm = __ballot(hi2[0] < 63) != 0ull; attn_tile<1, 1>(kt, vt, Qf, O, mrow, lrow, lo2, hi2, nm, c2, invl, imp, ql, 0, cin, lane); }
                  else if (any1) { const bool nm = __ballot(hi2[1] < 63) != 0ull; attn_tile<1, 2>(kt, vt, Qf, O, mrow, lrow, lo2, hi2, nm, c2, invl, imp, ql, 0, cin, lane); } }
                ja = jc; jbb = jd; pbuf ^= 1;
            }
            NSA_BAR();
#pragma unroll
            for (int s = 0; s < 2; ++s) { float lt = lrow[s]; lt = xq_sum(lt);
                const float gate = sigmoidf_(bf2f(proj[(size_t)trow[s] * LDP + C_GN + (4 * g + hd) * 3 + 1]));
                if (rep_ == 0) nsa_emit<false>(O[s], (lt > 0.f) ? gate / lt : 0.f, ya + (size_t)trow[s] * DM + (4 * g + hd) * HD + 4 * qd); }
        }
        for (int rep_ = 0; rep_ < (NSA_REP_PART == 4 ? 2 : 1); ++rep_) {
            const bf16* kw0 = proj + (size_t)rowb * LDP + C_KW + g * HD; const bf16* vw0 = proj + (size_t)rowb * LDP + C_VW + g * HD;
#pragma unroll
            for (int s = 0; s < 2; ++s) { mrow[s] = -1e30f; lrow[s] = 0.f;
#pragma unroll
                for (int dt = 0; dt < 8; ++dt) O[s][dt] = (f32x4){0.f, 0.f, 0.f, 0.f}; }
#if NSA_REP_PART == 8
            {
            const int tt0d = (qt >= 8) ? 0 : 8 - qt;
            VM_WAIT(); NSA_BAR();
            { const size_t r0 = (size_t)(s0 - 512 + 64 * tt0d) * LDP; tile_dma<true>(RG, kw0 + r0, vw0 + r0, LDP, w, lane); W7DUP(tile_dma<true>(RG, kw0 + r0, vw0 + r0, LDP, w, lane);) }
            if (tt0d < 8) { const size_t r0 = (size_t)(s0 - 512 + 64 * (tt0d + 1)) * LDP; tile_dma<true>(RG + RB, kw0 + r0, vw0 + r0, LDP, w, lane); W7DUP(tile_dma<true>(RG + RB, kw0 + r0, vw0 + r0, LDP, w, lane);) }
            for (int tt = tt0d, rb = 0; tt <= 8; ++tt) {
                if (tt < 8) { W7WAIT(); } else NSA_WAITV(0);
                NSA_BAR();
                if (tt + 2 <= 8) { const int nb2 = (rb + 2 >= NRING) ? rb + 2 - NRING : rb + 2; const size_t r0 = (size_t)(s0 - 512 + 64 * (tt + 2)) * LDP; tile_dma<true>(RG + nb2 * RB, kw0 + r0, vw0 + r0, LDP, w, lane); W7DUP(tile_dma<true>(RG + nb2 * RB, kw0 + r0, vw0 + r0, LDP, w, lane);) }
                rb = (rb + 1 == NRING) ? 0 : rb + 1;
            }
            }
#endif
            const int tt0 = (qt >= 8) ? 0 : 8 - qt;
            VM_WAIT(); NSA_BAR();
            { const size_t r0 = (size_t)(s0 - 512 + 64 * tt0) * LDP; tile_dma<true>(RG, kw0 + r0, vw0 + r0, LDP, w, lane); W7DUP(tile_dma<true>(RG, kw0 + r0, vw0 + r0, LDP, w, lane);) }
            if (tt0 < 8) { const size_t r0 = (size_t)(s0 - 512 + 64 * (tt0 + 1)) * LDP; tile_dma<true>(RG + RB, kw0 + r0, vw0 + r0, LDP, w, lane); W7DUP(tile_dma<true>(RG + RB, kw0 + r0, vw0 + r0, LDP, w, lane);) }
            for (int tt = tt0, rb = 0; tt <= 8; ++tt) {
                if (tt < 8) { W7WAIT(); } else NSA_WAITV(0);
                NSA_BAR();
                if (tt + 2 <= 8) { const int nb2 = (rb + 2 >= NRING) ? rb + 2 - NRING : rb + 2; const size_t r0 = (size_t)(s0 - 512 + 64 * (tt + 2)) * LDP; tile_dma<true>(RG + nb2 * RB, kw0 + r0, vw0 + r0, LDP, w, lane); W7DUP(tile_dma<true>(RG + nb2 * RB, kw0 + r0, vw0 + r0, LDP, w, lane);) }
                { const int lo2[2] = {(tt == 0) ? ql[0] + 1 : 0, (tt == 0) ? ql[1] + 1 : 0}, hi2[2] = {(tt == 8) ? ql[0] : 63, (tt == 8) ? ql[1] : 63};
                  attn_tile<1, 3>(RG + rb * RB + klane, RG + rb * RB + vlane, Qf, O, mrow, lrow, lo2, hi2, (tt == 0) || (tt == 8), c2, invl, imp, ql, 0, cin, lane);
#if NSA_REP_PART == 5
                  { const int him[2] = {-1, -1}; attn_tile<1, 3>(RG + rb * RB + klane, RG + rb * RB + vlane, Qf, O, mrow, lrow, lo2, him, true, c2, invl, imp, ql, 0, cin, lane); }
#endif
#if NSA_REP_PART == 6
                  NSA_BAR(); NSA_BAR(); NSA_BAR(); NSA_BAR();
#endif
                }
                rb = (rb + 1 == NRING) ? 0 : rb + 1;
            }
            VM_WAIT();
#pragma unroll
            for (int s = 0; s < 2; ++s) { float lt = lrow[s]; lt = xq_sum(lt);
                const float gate = sigmoidf_(bf2f(proj[(size_t)trow[s] * LDP + C_GN + (4 * g + hd) * 3 + 2]));
                if (rep_ == 0) nsa_emit<false>(O[s], (lt > 0.f) ? gate / lt : 0.f, ya + (size_t)trow[s] * DM + (4 * g + hd) * HD + 4 * qd); }
        }
        __syncthreads();
    }
    __builtin_amdgcn_s_setprio(0);
}

#if defined(CHECK_BUILD) && CHECK_BUILD
DI unsigned hash_u(unsigned x) { x ^= x >> 16; x *= 0x7feb352du; x ^= x >> 15; x *= 0x846ca68bu; x ^= x >> 16; return x; }
DI float blk_sum(float v, LAS float* red, int tid, int nthr) {
    for (int o = 32; o >= 1; o >>= 1) v += __shfl_xor(v, o);
    __syncthreads(); if ((tid & 63) == 0) red[tid >> 6] = v; __syncthreads();
    float s = 0.f; for (int k = 0; k < nthr / 64; ++k) s += red[k]; __syncthreads(); return s;
}
__global__ void chk_proj(Args args) {
    const int lane = threadIdx.x & 63, smp = blockIdx.x * (blockDim.x >> 6) + (threadIdx.x >> 6);
    const bf16* hb = (const bf16*)(args.ws + WS_HB); const bf16* proj = (const bf16*)(args.ws + WS_PROJ); const float* win = (const float*)args.in[4]; const int* pos = (const int*)args.in[2];
    unsigned* res = (unsigned*)(args.ws + WS_CTL) + CW_CHK;
    const unsigned h = hash_u(smp * 2654435761u + 12345u);
    int row = h % M; if (smp < 4) row = (smp == 0) ? 0 : (smp == 1) ? 8191 : (smp == 2) ? 8192 : 16383;
    const int kind = smp % 15; const unsigned h2 = hash_u(h + 77u);
    const int srcb[15] = {0, 2048, 2560, 3072, 3584, 4096, 4608, 5120, 5168, 7216, 9264, 11312, 13360, 16432, 16464};
    const int dstb[15] = {C_Q, C_KC, C_VC, C_KS, C_VS, C_KW, C_VW, C_GN, C_CB, C_CC, C_CU, C_Z, C_XBC, C_DT, C_GM};
    const int wid[15] = {2048, 512, 512, 512, 512, 512, 512, 48, 2048, 2048, 2048, 2048, 3072, 32, 6144};
    const bool rope = (kind == 0 || kind == 1 || kind == 3 || kind == 5);
    int e = h2 % wid[kind]; if (rope) e = (e / 128) * 128 + (e % 64);
    float d0 = 0.f, d1 = 0.f;
    for (int k = lane; k < DM; k += 64) { const float a = bf2f(hb[(size_t)row * DM + k]); d0 += a * win[(size_t)k * PROJ_SRC + srcb[kind] + e]; if (rope) d1 += a * win[(size_t)k * PROJ_SRC + srcb[kind] + e + 64]; }
    for (int o = 32; o >= 1; o >>= 1) { d0 += __shfl_xor(d0, o); d1 += __shfl_xor(d1, o); }
    float e0 = d0, e1 = d1;
    if (rope) { const double inv = exp(-(double)(2 * (e % 64)) / 128.0 * 9.210340371976184); double ang = (double)pos[row] * inv; ang -= 6.283185307179586476925 * __builtin_rint(ang * 0.15915494309189533577); const float c = cosf((float)ang), s = sinf((float)ang); e0 = d0 * c - d1 * s; e1 = d1 * c + d0 * s; }
    if (lane == 0) {
        const float g0 = bf2f(proj[(size_t)row * LDP + dstb[kind] + e]); float err = fabsf(g0 - e0) / (0.03f + 0.02f * fabsf(e0));
        if (rope) { const float g1 = bf2f(proj[(size_t)row * LDP + dstb[kind] + e + 64]); err = fmaxf(err, fabsf(g1 - e1) / (0.03f + 0.02f * fabsf(e1))); }
        if (!(err <= 1.0f)) atomicAdd(res + 0, 1u);
        atomicMax(res + 1, __float_as_uint(fminf(err, 1e6f)));
    }
}
__global__ void chk_cmp(Args args) {
    __shared__ float hid[128];
    const int tid = threadIdx.x, smp = blockIdx.x;
    const unsigned h = hash_u(smp * 40503u + 99u);
    const int kv = smp & 1, b = (smp >> 1) & 1, g = (smp >> 2) & 3; int n = h % NCMP; if (smp < 8) n = (smp < 4) ? 0 : 510;
    const bf16* proj = (const bf16*)(args.ws + WS_PROJ);
    const float* pe = (const float*)args.in[kv ? 6 : 5]; const float* w1 = (const float*)args.in[kv ? 11 : 7]; const float* b1 = (const float*)args.in[kv ? 12 : 8];
    const float* w2 = (const float*)args.in[kv ? 13 : 9]; const float* b2 = (const float*)args.in[kv ? 14 : 10];
    const bf16* out = (const bf16*)(args.ws + (kv ? WS_VCMP : WS_KCMP));
    unsigned* res = (unsigned*)(args.ws + WS_CTL) + CW_CHK;
    float s = b1[tid];
    for (int l = 0; l < 32; ++l) { const bf16* kr = proj + (size_t)(b * SEQ + 16 * n + l) * LDP + (kv ? C_VC : C_KC) + g * HD;
        for (int d = 0; d < 128; ++d) s += (bf2f(kr[d]) + pe[l * 128 + d]) * w1[(size_t)(l * 128 + d) * 128 + tid]; }
    hid[tid] = s / (1.0f + expf(-s));
    __syncthreads();
    float o = b2[tid];
    for (int k = 0; k < 128; ++k) o += hid[k] * w2[k * 128 + tid];
    const float got = bf2f(out[((size_t)(b * NG + g) * NCMP_PAD + n) * HD + tid]);
    const float err = fabsf(got - o) / (0.02f + 0.02f * fabsf(o));
    if (!(err <= 1.0f)) atomicAdd(res + 2, 1u);
    atomicMax(res + 3, __float_as_uint(fminf(err, 1e6f)));
}
constexpr int CHK_NT = 24;
__global__ void __launch_bounds__(256) chk_nsa(Args args) {
    __shared__ float qf[4][128], oacc[4][128], obr[4][128], sc[4][1024], imp[128], red[8];
    __shared__ int kl[1024], seln[16], usedl[128];
    const int tlist[CHK_NT] = {0, 1, 30, 31, 47, 63, 64, 65, 127, 128, 500, 511, 512, 513, 575, 1023, 1024, 1087, 2000, 4095, 4096, 6000, 8128, 8191};
    const int tid = threadIdx.x, smp = blockIdx.x;
    const int t = tlist[smp % CHK_NT], bg = (smp / CHK_NT + smp) & 7, b = bg >> 2, g = bg & 3, row = b * SEQ + t, cur = t >> 6;
    const bf16* proj = (const bf16*)(args.ws + WS_PROJ); const bf16* kcmp = (const bf16*)(args.ws + WS_KCMP) + (size_t)(b * NG + g) * NCMP_PAD * HD; const bf16* vcmp = (const bf16*)(args.ws + WS_VCMP) + (size_t)(b * NG + g) * NCMP_PAD * HD;
    const bf16* ya = (const bf16*)(args.ws + WS_YA);
    unsigned* res = (unsigned*)(args.ws + WS_CTL) + CW_CHK;
    const float scale = 0.08838834764831845f;
    for (int k = tid; k < 512; k += 256) { const int r = k >> 7, d = k & 127; qf[r][d] = bf2f(proj[(size_t)row * LDP + C_Q + (4 * g + r) * HD + d]); oacc[r][d] = 0.f; }
    __syncthreads();
    for (int br = 0; br < 3; ++br) {
        int nk = 0;
        if (br == 0) { nk = (t >= 31) ? ((t - 31) >> 4) + 1 : 0; for (int k = tid; k < nk; k += 256) kl[k] = k; }
        else if (br == 1) {
            if (tid == 0) {
                for (int j = 0; j < 128; ++j) usedl[j] = 0;
                for (int it = 0; it < 16; ++it) { int best = -1; float bv = 0.f;
                    for (int j = 0; j < 128; ++j) { if (usedl[j]) continue; const bool valid = (64 * j <= t); const bool forced = (j == 0) || (j == cur) || (j == cur - 1);
                        const float v = valid ? imp[j] + (forced ? 1.0e4f : 0.f) : -__builtin_inff();
                        if (best < 0 || v > bv) { best = j; bv = v; } }
                    usedl[best] = 1; seln[it] = best; } }
            __syncthreads();
            for (int k = tid; k < 1024; k += 256) kl[k] = seln[k >> 6] * 64 + (k & 63);
            nk = 1024;
        } else { nk = 576; for (int k = tid; k < 576; k += 256) kl[k] = (t & ~63) - WIN + k; }
        __syncthreads();
        for (int idx = tid; idx < 4 * nk; idx += 256) { const int r = idx / nk, k = idx - r * nk, key = kl[k];
            bool ok; const bf16* kp;
            if (br == 0) { ok = true; kp = kcmp + (size_t)key * HD; }
            else if (br == 1) { ok = (key <= t); kp = proj + (size_t)(b * SEQ + key) * LDP + C_KS + g * HD; }
            else { ok = (key >= 0) && (key <= t) && (key > t - WIN); kp = proj + (size_t)(b * SEQ + (key < 0 ? 0 : key)) * LDP + C_KW + g * HD; }
            float s = 0.f; for (int d = 0; d < 128; ++d) s += qf[r][d] * bf2f(kp[d]);
            sc[r][k] = ok ? s * scale : -__builtin_inff(); }
        __syncthreads();
        if (tid < 4) { float m = -__builtin_inff(); for (int k = 0; k < nk; ++k) m = fmaxf(m, sc[tid][k]);
            const float mm = (m > -1e30f) ? m : 0.f; float l = 0.f; for (int k = 0; k < nk; ++k) { const float e = (sc[tid][k] > -1e30f) ? expf(sc[tid][k] - mm) : 0.f; sc[tid][k] = e; l += e; }
            const float il = (l > 0.f) ? 1.0f / l : 0.f; for (int k = 0; k < nk; ++k) sc[tid][k] *= il; }
        __syncthreads();
        if (br == 0) { if (tid < 128) { float s = 0.f; for (int r = 0; r < 4; ++r) for (int n = 4 * tid - 1; n <= 4 * tid + 3; ++n) if (n >= 0 && n < nk) s += sc[r][n]; imp[tid] = s; } }
        for (int o = tid; o < 512; o += 256) { const int r = o >> 7, d = o & 127; float s = 0.f;
            for (int k = 0; k < nk; ++k) { const float p = sc[r][k]; if (p == 0.f) continue; const int key = kl[k];
                const bf16* vp = (br == 0) ? vcmp + (size_t)key * HD : proj + (size_t)(b * SEQ + key) * LDP + (br == 1 ? C_VS : C_VW) + g * HD;
                s += p * bf2f(vp[d]); }
            const float gate = 1.0f / (1.0f + expf(-bf2f(proj[(size_t)row * LDP + C_GN + (4 * g + r) * 3 + br])));
            oacc[r][d] += gate * s; obr[r][d] = s; }
        __syncthreads();
    }
    float errm = 0.f;
    for (int o = tid; o < 512; o += 256) { const int r = o >> 7, d = o & 127; const float got = bf2f(ya[(size_t)row * DM + (4 * g + r) * HD + d]), ex = oacc[r][d] * (CHECK_BUILD == 2 ? ((smp & 1) ? 1.5f : 1.0f) : 1.0f);
        errm = fmaxf(errm, fabsf(got - ex) / (0.006f + 0.03f * fabsf(ex))); }
    for (int o = 32; o >= 1; o >>= 1) errm = fmaxf(errm, __shfl_xor(errm, o));
    if ((tid & 63) == 0) red[tid >> 6] = errm;
    __syncthreads();
    if (tid == 0) { const float e = fmaxf(fmaxf(red[0], red[1]), fmaxf(red[2], red[3])); if (!(e <= 1.0f)) atomicAdd(res + 4, 1u); atomicMax(res + 5, __float_as_uint(fminf(e, 1e6f))); }
}
#ifndef CHK_B_SEL
#define CHK_B_SEL 5
#endif
__global__ void chk_report(Args args) {
    const unsigned* res = (const unsigned*)(args.ws + WS_CTL) + CW_CHK;
    const float A = 4.0f * (float)res[4] + (res[2] ? 2000.f : 0.f) + (res[0] ? 40000.f : 0.f);
    const float B = fminf(__uint_as_float(res[CHK_B_SEL]), 100.f);
    const size_t i = (size_t)blockIdx.x * blockDim.x + threadIdx.x;
    if (A > 0.f) { if (i == 0) args.out[0] += A; if (i >= 1 && i <= (1u << 20)) args.out[i] += B; }
}
#endif

constexpr int NPH_LAYER = 13, NPH = 2 + NPH_LAYER * DEPTH;
#ifndef PG8_SP2
#define PG8_SP2 true
#endif
#ifndef PG8_ALIGN
#define PG8_ALIGN true
#endif
#ifndef PH_MASK
#define PH_MASK 0xFFFFFFFFu
#endif
#ifndef REP_MASK
#define REP_MASK 0u
#endif
#ifndef REP_CNT
#define REP_CNT 2
#endif
#define REPN(kk) ((((unsigned)REP_MASK >> (kk)) & 1u) ? REP_CNT : 1)
#define INK(k, kk) (((PH_MASK >> (kk)) & 1u) && lo <= (k) && (k) < hi)
#if defined(TIME_PROBE)
#define STAMP(i) do { if (F.bid == 0 && F.tid == 0) ((unsigned long long*)(F.ctl + CW_TS))[i] = __builtin_amdgcn_s_memrealtime(); } while (0)
#else
#define STAMP(i) do { } while (0)
#endif
#if defined(BAR_TWICE)
#define SEAM_TWICE(x) x
#else
#define SEAM_TWICE(x)
#endif
#define SEAM(k) do { if (lo <= (k) && (k) + 1 < hi) { XcdBarrier b_ = bar; { unsigned long long p_ = (unsigned long long)bar.bar; asm volatile("" : "+s"(p_)); b_.bar = (unsigned*)p_; } xcd_barrier(b_); SEAM_TWICE(xcd_barrier(b_);) } STAMP((k) + 1); } while (0)
template <int LAYER> DI void g1_block(const Frame& F, const Args& args) {
    constexpr int layer = LAYER;
    bf16* hb = (bf16*)(F.ws + WS_HB); bf16* projb = (bf16*)(F.ws + WS_PROJ); bf16* eb = (bf16*)(F.ws + WS_EB);
#ifndef NO_G1
            { const Frame Fp = phase_frame(F);  pg8::Gemm g{hb, (const bf16*)lw_ptr(Fp, layer, LW_IN), M, LDP, DM}; pg8::StaticOrder S; S.init(M, LDP, Fp.G, Fp.bid);
              pg8::EpiB<2> E{projb, LDP, (const float*)(Fp.ws + WS_ROPE)};
              pg8::gemm_phase<pg8::EpiB<2>, pg8::StaticOrder, PG8_ALIGN, PG8_SP2>(Fp.lds, g, S, E, Fp.wave); }
#endif
#ifndef NO_G5
            { const Frame Fp = phase_frame(F);  pg8::Gemm g{(const bf16*)(Fp.ws + WS_PB) + (size_t)layer * M * PLE, (const bf16*)lw_ptr(Fp, layer, LW_PLE), M, DM, PLE}; pg8::LightOrder S; S.init(M, DM, Fp.G, Fp.bid);
              pg8::EpiB<0> E{eb, DM, nullptr};
              pg8::gemm_phase<pg8::EpiB<0>, pg8::LightOrder, PG8_ALIGN, PG8_SP2>(Fp.lds, g, S, E, Fp.wave); }
#endif
}
template <int LAYER> DI void layer_phases(const Frame& F, const Args& args, const XcdBarrier& bar, const int lo, const int hi) {
    constexpr int layer = LAYER, layer_ = LAYER;
    float* xres = (float*)(F.ws + WS_X); bf16* hb = (bf16*)(F.ws + WS_HB); bf16* projb = (bf16*)(F.ws + WS_PROJ); bf16* ub = (bf16*)(F.ws + WS_U); bf16* eb = (bf16*)(F.ws + WS_EB);
        const int pb = 1 + NPH_LAYER * layer;
        const float* xin = (layer == 0) ? (const float*)argin(args, 0) : (const float*)xres;
        if (INK(pb + 0, 0)) { if (layer == 0) norm_rows<false>(F, xin, (const float*)argin(args, 3), hb);
                              else addnorm_rows<false>(F, xres, (const bf16*)(F.ws + WS_DELTA), (const float*)argin(args, 3) + (size_t)layer * DM, xres, hb); }
        SEAM(pb + 0);
        if (INK(pb + 1, 1)) { g1_block<LAYER>(F, args); if (REPN(1) >= 2) g1_block<LAYER>(F, args); }
        SEAM(pb + 1);
        if (INK(pb + 2, 2)) for (int rep = 0; rep < REPN(2); ++rep) { ssd_conv_pass(F, args, layer); compress_phase(F, args, layer); }
        SEAM(pb + 2);
        if (INK(pb + 3, 3)) for (int rep = 0; rep < REPN(3); ++rep) ssd_states_phase(F, args, layer);
        SEAM(pb + 3);
        if (INK(pb + 4, 4)) ssd_scan_phase(F);
        SEAM(pb + 4);
        if (INK(pb + 5, 5)) {
#ifndef NO_S3
            for (int rep = 0; rep < REPN(15); ++rep) ssd_out_phase(F, args, layer);
#endif
            STAMP(60 + layer);
#ifndef NO_NSA
            for (int rep = 0; rep < REPN(5); ++rep) nsa_phase(F, args, layer);
#endif
        }
        SEAM(pb + 5);
        if (INK(pb + 6, 6)) for (int rep = 0; rep < REPN(6); ++rep) merge_pass(F, args, layer);
        SEAM(pb + 6);
        if (INK(pb + 7, 7)) for (int rep = 0; rep < REPN(7); ++rep) { const Frame Fp = phase_frame(F);  pg8::Gemm g{hb, (const bf16*)lw_ptr(Fp, layer, LW_O), M, DM, DM}; pg8::StaticOrder S; S.init(M, DM, Fp.G, Fp.bid);
            pg8::EpiB<0> E{(bf16*)(Fp.ws + WS_DELTA), DM, nullptr};
            pg8::gemm_phase<pg8::EpiB<0>, pg8::StaticOrder, PG8_ALIGN, PG8_SP2>(Fp.lds, g, S, E, Fp.wave); }
        SEAM(pb + 7);
        if (INK(pb + 8, 8)) for (int rep = 0; rep < REPN(8); ++rep) addnorm_rows<false>(F, xin, (const bf16*)(F.ws + WS_DELTA), (const float*)argin(args, 23) + (size_t)layer * DM, rep ? (float*)(F.ws + WS_ST) : xres, rep ? (bf16*)(F.ws + WS_ST + 128 * MiB - 64 * MiB) : hb);
        SEAM(pb + 8);
        if (INK(pb + 9, 9)) for (int rep = 0; rep < REPN(9); ++rep) { const Frame Fp = phase_frame(F);  pg8::Gemm g{hb, (const bf16*)lw_ptr(Fp, layer, LW_UP), M, DFF, DM}; pg8::StaticOrder S; S.init(M, DFF, Fp.G, Fp.bid);
            pg8::EpiB<1> E{ub, DFF, nullptr};
            pg8::gemm_phase<pg8::EpiB<1>, pg8::StaticOrder, PG8_ALIGN, PG8_SP2>(Fp.lds, g, S, E, Fp.wave); }
        SEAM(pb + 9);
        if (INK(pb + 10, 10)) for (int rep = 0; rep < REPN(10); ++rep) { const Frame Fp = phase_frame(F);  pg8::Gemm g{ub, (const bf16*)lw_ptr(Fp, layer, LW_DOWN), M, DM, DFF}; pg8::StaticOrder S; S.init(M, DM, Fp.G, Fp.bid);
            pg8::EpiB<0> E{(bf16*)(Fp.ws + WS_DELTA), DM, nullptr};
            pg8::gemm_phase<pg8::EpiB<0>, pg8::StaticOrder, PG8_ALIGN, PG8_SP2>(Fp.lds, g, S, E, Fp.wave); }
        SEAM(pb + 10);
        if (INK(pb + 11, 11)) addnorm_rows<false>(F, xres, (const bf16*)(F.ws + WS_DELTA), (const float*)argin(args, 26) + (size_t)layer * DM, xres, hb);
        SEAM(pb + 11);
        if (INK(pb + 12, 12)) for (int rep = 0; rep < REPN(12); ++rep) { const Frame Fp = phase_frame(F);  pg8::Gemm g{hb, (const bf16*)lw_ptr(Fp, layer, LW_PG), M, DM, DM}; pg8::StaticOrder S; S.init(M, DM, Fp.G, Fp.bid);
            pg8::EpiB<3> E{(bf16*)(Fp.ws + WS_DELTA), DM, (const float*)eb};
            pg8::gemm_phase<pg8::EpiB<3>, pg8::StaticOrder, PG8_ALIGN, PG8_SP2>(Fp.lds, g, S, E, Fp.wave); }
        SEAM(pb + 12);
}
__global__ void __launch_bounds__(NTHR, 2) hyb_fwd(Args args) {
    extern __shared__ __attribute__((aligned(16))) unsigned char lds_raw[];
    Frame F;
    F.lds = (LAS unsigned char*)lds_raw; F.ws = args.ws; F.ctl = (gu32*)(args.ws + WS_CTL);
    F.tid = threadIdx.x; F.lane = F.tid & 63; F.wave = __builtin_amdgcn_readfirstlane(threadIdx.x >> 6); F.G = gridDim.x; F.bid = blockIdx.x;
    const int lo = args.ph_lo, hi = args.ph_hi;
    if (F.tid < 64) ((LAS unsigned*)(F.lds + LDSCTL_OFF))[F.tid] = 0u;
    __syncthreads();
    XcdBarrier bar; bar.bar = (unsigned*)(F.ctl + CW_BAR); bar.x = 0; bar.st = (volatile LAS unsigned*)(F.lds + LDSCTL_OFF);
    if (hi - lo > 1) bar = xcd_barrier_post((unsigned*)(F.ctl + CW_BAR), (volatile LAS unsigned*)(F.lds + LDSCTL_OFF));
    STAMP(0);
    if (INK(0, 13)) for (int rep = 0; rep < REPN(13); ++rep) p0_prologue(F, args);
    SEAM(0);
    layer_phases<0>(F, args, bar, lo, hi); layer_phases<1>(F, args, bar, lo, hi); layer_phases<2>(F, args, bar, lo, hi); layer_phases<3>(F, args, bar, lo, hi);
    float* xres = (float*)(F.ws + WS_X);
    int hi_l = hi; asm volatile("" : "+s"(hi_l));
    if (((PH_MASK >> 14) & 1u) && lo <= NPH - 1 && NPH - 1 < hi_l) addnorm_rows<true>(F, xres, (const bf16*)(F.ws + WS_DELTA), (const float*)argin(args, 29), nullptr, args.out);
#if defined(TIME_PROBE)
    { XcdBarrier b_ = bar; xcd_barrier(b_); STAMP(NPH);
      if (F.bid == 0) {
        LAS float* ab = (LAS float*)(F.lds);
        if (F.tid == 0) { const unsigned long long* ts = (const unsigned long long*)(F.ctl + CW_TS); float sum[17];
            float sA = 0.f, sB = 0.f;
            for (int ph = 0; ph < NPH; ++ph) { int kind = (ph == 0) ? 13 : (ph == NPH - 1) ? 14 : (ph - 1) % NPH_LAYER; float d = (float)(ts[ph + 1] - ts[ph]) * 0.01f;
                if (kind == 5) { const int L = (ph - 1) / NPH_LAYER; const float d3 = (float)(ts[60 + L] - ts[ph]) * 0.01f; if (TIME_PROBE_A == 15) sA += d3; if (TIME_PROBE_B == 15) sB += d3; d -= d3; }
                if (kind == TIME_PROBE_A || (TIME_PROBE_A == 16 && (kind == 0 || kind == 8 || kind == 11))) sA += d;
                if (kind == TIME_PROBE_B || (TIME_PROBE_B == 16 && (kind == 0 || kind == 8 || kind == 11))) sB += d; }
            ab[0] = sA; ab[1] = sB * 0.01f; (void)sum; }
        __syncthreads();
        const float A = ab[0], B = ab[1];
        if (F.tid == 0) args.out[0] += A;
        for (int j = 0; j < 2048; ++j) args.out[1 + F.tid + NTHR * j] += B;
      } }
#endif
#undef INK
#undef SEAM
}

#ifndef MK_ONE_LAUNCH
#define MK_ONE_LAUNCH 1
#endif
extern "C" void kernel_launch(void* const* d_in, const int* in_sizes, int n_in, void* d_out, int out_size, void* d_ws, size_t ws_size, hipStream_t stream) {
    static int grid = 0;
    if (grid == 0) {
        if (n_in != 30 || out_size != M * DM || ws_size < WS_END) { fprintf(stderr, "kernel_launch: unexpected shapes (n_in %d out %d ws %zu need %zu)\n", n_in, out_size, ws_size, (size_t)WS_END); grid = -1; return; }
        int dev = 0, cus = 0, per_cu = 0;
        if (hipGetDevice(&dev) != hipSuccess || hipDeviceGetAttribute(&cus, hipDeviceAttributeMultiprocessorCount, dev) != hipSuccess) { grid = -1; return; }
        if (hipFuncSetAttribute((const void*)hyb_fwd, hipFuncAttributeMaxDynamicSharedMemorySize, LDS_BYTES) != hipSuccess) { fprintf(stderr, "kernel_launch: hipFuncSetAttribute failed\n"); grid = -1; return; }
        if (hipOccupancyMaxActiveBlocksPerMultiprocessor(&per_cu, (const void*)hyb_fwd, NTHR, LDS_BYTES) != hipSuccess || per_cu < 1) { fprintf(stderr, "kernel_launch: occupancy query says %d\n", per_cu); }
        (void)hipGetLastError();
        grid = cus;
    }
    if (grid < 0) return;
    (void)hipMemsetAsync((char*)d_ws + WS_CTL, 0, CTL_ZERO_BYTES, stream);
    Args a{};
    for (int i = 0; i < 30; ++i) a.in[i] = d_in[i];
    a.out = (float*)d_out; a.ws = (unsigned char*)d_ws;
#if MK_ONE_LAUNCH
    a.ph_lo = 0; a.ph_hi = NPH;
    hipLaunchKernelGGL(hyb_fwd, dim3(grid), dim3(NTHR), LDS_BYTES, stream, a);
#else
    for (int ph = 0; ph < NPH; ++ph) { a.ph_lo = ph; a.ph_hi = ph + 1; hipLaunchKernelGGL(hyb_fwd, dim3(grid), dim3(NTHR), LDS_BYTES, stream, a);
#if defined(CHECK_BUILD) && CHECK_BUILD
        if (ph == 2) hipLaunchKernelGGL(chk_proj, dim3(1024), dim3(256), 0, stream, a);
        if (ph == 3) hipLaunchKernelGGL(chk_cmp, dim3(128), dim3(128), 0, stream, a);
        if (ph == 6) hipLaunchKernelGGL(chk_nsa, dim3(8 * CHK_NT), dim3(256), 0, stream, a);
        if (ph == NPH - 1) hipLaunchKernelGGL(chk_report, dim3(4098), dim3(256), 0, stream, a);
#endif
    }
#endif
    (void)in_sizes;
}
```

```cpp
#include <hip/hip_runtime.h>
#include <cstdio>
#include <cstdint>
namespace pg8 {
#define PG8_LAS __attribute__((address_space(3)))
typedef unsigned short bf16_t;
typedef short bf16x8 __attribute__((ext_vector_type(8)));
typedef float f32x4 __attribute__((ext_vector_type(4)));
typedef unsigned u32x4 __attribute__((ext_vector_type(4)));
constexpr int BM = 256, BK = 64, HALF = 128, HTB = HALF * BK * 2  , STAGE_BYTES = 8 * HTB, NXCD = 8,
#ifdef PG8_WGM
    WGM = PG8_WGM;
#else
    WGM = 8;
#endif

__host__ __device__ __forceinline__ int lds_byte(int r, int c) { const int st = (r >> 4) * 2 + (c >> 5), rr = r & 15, cc = c & 31, ob = rr * 64 + cc * 2; return st * 1024 + (ob ^ (((ob >> 9) & 1) << 5)); }
__host__ __device__ __forceinline__ void stage_rc(int b, int& R, int& C) { const int st = b / 1024, sb = b % 1024, swz = sb ^ (((sb >> 9) & 1) << 5); R = (st >> 1) * 16 + swz / 64; C = (st & 1) * 32 + (swz % 64) / 2; }
__host__ __device__ __forceinline__ int perm32(int rho) { const int n = rho >> 4, i = rho & 15; return 8 * (i >> 2) + 4 * n + (i & 3); }

struct Unit { int pm, pn; };
struct Gemm { const bf16_t* A; const bf16_t* Bt; int M, N, K; };

struct StaticOrder {
    int nM, nN, nwg, G, c;
    __host__ __device__ void init(int M, int N, int G_, int c_) { nM = M / BM; nN = N / BM; nwg = nM * nN; G = G_; c = c_; }
    __host__ __device__ bool next(int i, Unit& u) const {
        const long L = (long)i * G + c; if (L >= nwg) return false;
        int wgid = (int)L; { const int q = nwg / NXCD, r = nwg % NXCD, xcd = wgid % NXCD, off = wgid / NXCD; wgid = (xcd < r ? xcd * (q + 1) : r * (q + 1) + (xcd - r) * q) + off; }
        const int nig = WGM * nN, gid = wgid / nig, fm = gid * WGM, gsz = (nM - fm) < WGM ? (nM - fm) : WGM;
        u.pm = fm + ((wgid % nig) % gsz); u.pn = (wgid % nig) / gsz; return true;
    }
    __device__ __forceinline__ void a_ready(const Unit&) const {}
    __device__ __forceinline__ void done(const Unit&) const {}
};
__device__ __forceinline__ unsigned cvt_pk_bf16(float lo, float hi) { unsigned r; asm volatile("v_cvt_pk_bf16_f32 %0, %1, %2" : "=v"(r) : "v"(lo), "v"(hi)); return r; }
template <class Epi, class Sched, bool ALIGN_EPI = false, bool SP2 = false>
__device__ __forceinline__ void gemm_phase(PG8_LAS unsigned char* lds, const Gemm g, const Sched& S, const Epi& E, const int wave_idx  ) {
    int lane_l; asm volatile("v_mbcnt_lo_u32_b32 %0, -1, 0\n\tv_mbcnt_hi_u32_b32 %0, -1, %0" : "=v"(lane_l));
    const int wid = wave_idx, tid = wid * 64 + lane_l, lane = tid & 63, wr = wid >> 2, wc = wid & 3, fr = lane & 15, fq = lane >> 4;
    const int K = g.K, nt = K / BK;
    unsigned voffA[2], voffB[2];
#pragma unroll
    for (int i = 0; i < 2; ++i) { int R, C; stage_rc(tid * 16 + i * 8192, R, C); const int Rb = Epi::PERM ? ((R & ~31) + perm32(R & 31)) : R;
        voffA[i] = (unsigned)(R * K + C) * 2u; voffB[i] = (unsigned)(Rb * K + C) * 2u; }
    const size_t kstep = (size_t)(BK * 2);
    const size_t hstep = (size_t)HALF * K * 2;
    const size_t tstep = 2 * hstep;
    const unsigned ldsw = (unsigned)wid * 1024u;
    const int aoff = lds_byte(wr * 64 + fr, fq * 8), boff = lds_byte(wc * 32 + fr, fq * 8);
#define PG8_SA(b, h) (((b) * 2 + (h)) * HTB)
#define PG8_SB(b, h) ((4 + (b) * 2 + (h)) * HTB)
#define PG8_STAGE(bufoff, gbase, voff) do { _Pragma("unroll") for (int _i = 0; _i < 2; ++_i) \
        __builtin_amdgcn_global_load_lds((const unsigned*)((const char*)(gbase) + (voff)[_i]), (PG8_LAS unsigned*)(lds + (bufoff) + ldsw + _i * 8192), 16, 0, 0); } while (0)
#define PG8_LDA(dst, b, h) do { _Pragma("unroll") for (int m = 0; m < 4; ++m) _Pragma("unroll") for (int k = 0; k < 2; ++k) dst[m][k] = *(const PG8_LAS bf16x8*)(lds + PG8_SA(b, h) + aoff + m * 2048 + k * 1024); } while (0)
#define PG8_LDB(dst, b, h) do { _Pragma("unroll") for (int n = 0; n < 2; ++n) _Pragma("unroll") for (int k = 0; k < 2; ++k) dst[n][k] = *(const PG8_LAS bf16x8*)(lds + PG8_SB(b, h) + boff + n * 2048 + k * 1024); } while (0)
#define PG8_MMA(ai, bj, At, Bt) do { __builtin_amdgcn_s_setprio(1); _Pragma("unroll") for (int m = 0; m < 4; ++m) _Pragma("unroll") for (int n = 0; n < 2; ++n) _Pragma("unroll") for (int k = 0; k < 2; ++k) \
        acc[ai][bj][m][n] = __builtin_amdgcn_mfma_f32_16x16x32_bf16(Bt[n][k], At[m][k], acc[ai][bj][m][n], 0, 0, 0); __builtin_amdgcn_s_setprio(0); } while (0)
#define PG8_WAIT_V(n) asm volatile("s_waitcnt vmcnt(" #n ")" ::: "memory")
#define PG8_WAIT_L(n) asm volatile("s_waitcnt lgkmcnt(" #n ")" ::: "memory")
#define PG8_BAR __builtin_amdgcn_s_barrier()
#define PG8_SCHED __builtin_amdgcn_sched_barrier(0)
    Unit cur, nxt; int ui = 0;
    if (!S.next(0, cur)) return;
    f32x4 acc[2][2][4][2];
#pragma unroll
    for (int a = 0; a < 2; ++a)
#pragma unroll
        for (int b = 0; b < 2; ++b)
#pragma unroll
            for (int m = 0; m < 4; ++m)
#pragma unroll
                for (int n = 0; n < 2; ++n) acc[a][b][m][n] = (f32x4){0.f, 0.f, 0.f, 0.f};
    bf16x8 At[4][2], B0[2][2], B1[2][2];
    const char* cA = (const char*)g.A + (size_t)cur.pm * tstep; const char* cB = (const char*)g.Bt + (size_t)cur.pn * tstep;
    S.a_ready(cur);
    if constexpr (SP2) {
        PG8_STAGE(PG8_SB(0, 0), cB, voffB); PG8_STAGE(PG8_SB(0, 1), cB + hstep, voffB); PG8_STAGE(PG8_SA(0, 0), cA, voffA); PG8_STAGE(PG8_SA(0, 1), cA + hstep, voffA);
        if (wr == 1) PG8_BAR;
        PG8_WAIT_V(2); PG8_BAR;
        PG8_STAGE(PG8_SB(1, 0), cB + kstep, voffB); PG8_STAGE(PG8_SA(1, 0), cA + kstep, voffA); PG8_STAGE(PG8_SB(1, 1), cB + hstep + kstep, voffB);
        PG8_WAIT_V(6); PG8_BAR;
    } else {
        PG8_STAGE(PG8_SB(0, 0), cB, voffB); PG8_STAGE(PG8_SA(0, 0), cA, voffA); PG8_STAGE(PG8_SB(0, 1), cB + hstep, voffB); PG8_STAGE(PG8_SA(0, 1), cA + hstep, voffA);
        if (wr == 1) PG8_BAR;
        PG8_WAIT_V(4); PG8_BAR;
        PG8_STAGE(PG8_SB(1, 0), cB + kstep, voffB); PG8_STAGE(PG8_SA(1, 0), cA + kstep, voffA); PG8_STAGE(PG8_SB(1, 1), cB + hstep + kstep, voffB);
        PG8_WAIT_V(6); PG8_BAR;
    }
    for (;;) {
        const bool has_next = S.next(ui + 1, nxt);
        const char* nA = has_next ? (const char*)g.A + (size_t)nxt.pm * tstep : cA; const char* nB = has_next ? (const char*)g.Bt + (size_t)nxt.pn * tstep : cB;
        for (int t = 0; t < nt; t += 2) {
            const bool last = (t == nt - 2);
            const char* a1 = cA + (size_t)(t + 1) * kstep;
            const char* a2 = last ? nA : cA + (size_t)(t + 2) * kstep; const char* b2 = last ? nB : cB + (size_t)(t + 2) * kstep;
            const char* a3 = a2 + kstep; const char* b3 = b2 + kstep;
            if (last && has_next) S.a_ready(nxt);
            if constexpr (SP2) {
            PG8_LDB(B0, 0, 0); PG8_LDB(B1, 0, 1); PG8_SCHED; PG8_LDA(At, 0, 0); PG8_STAGE(PG8_SA(1, 1), a1 + hstep, voffA);
            PG8_WAIT_V(8); PG8_WAIT_L(0); PG8_BAR; PG8_MMA(0, 0, At, B0); PG8_MMA(0, 1, At, B1); PG8_BAR; PG8_SCHED;
            PG8_LDA(At, 0, 1); PG8_STAGE(PG8_SB(0, 0), b2, voffB); PG8_STAGE(PG8_SB(0, 1), b2 + hstep, voffB); PG8_STAGE(PG8_SA(0, 0), a2, voffA);
            PG8_WAIT_V(8); PG8_WAIT_L(0); PG8_BAR; PG8_MMA(1, 0, At, B0); PG8_MMA(1, 1, At, B1); PG8_BAR; PG8_SCHED;
            PG8_LDB(B0, 1, 0); PG8_LDB(B1, 1, 1); PG8_SCHED; PG8_LDA(At, 1, 0); PG8_STAGE(PG8_SA(0, 1), a2 + hstep, voffA);
            PG8_WAIT_V(8); PG8_WAIT_L(0); PG8_BAR; PG8_MMA(0, 0, At, B0); PG8_MMA(0, 1, At, B1); PG8_BAR; PG8_SCHED;
            PG8_LDA(At, 1, 1); PG8_STAGE(PG8_SB(1, 0), b3, voffB); PG8_STAGE(PG8_SB(1, 1), b3 + hstep, voffB); PG8_STAGE(PG8_SA(1, 0), a3, voffA);
            PG8_WAIT_V(8); PG8_WAIT_L(0); PG8_BAR; PG8_MMA(1, 0, At, B0); PG8_MMA(1, 1, At, B1); PG8_BAR; PG8_SCHED;
            } else {
            PG8_LDB(B0, 0, 0); PG8_SCHED; PG8_LDA(At, 0, 0); PG8_STAGE(PG8_SA(1, 1), a1 + hstep, voffA);
            PG8_WAIT_L(8); PG8_BAR; PG8_WAIT_L(0); PG8_MMA(0, 0, At, B0); PG8_BAR; PG8_SCHED;
            PG8_LDB(B1, 0, 1); PG8_STAGE(PG8_SB(0, 0), b2, voffB);
            PG8_BAR; PG8_WAIT_L(0); PG8_MMA(0, 1, At, B1); PG8_BAR;
            PG8_LDA(At, 0, 1); PG8_STAGE(PG8_SA(0, 0), a2, voffA);
            PG8_BAR; PG8_WAIT_L(0); PG8_MMA(1, 0, At, B0); PG8_BAR; PG8_SCHED;
            PG8_STAGE(PG8_SB(0, 1), b2 + hstep, voffB);
            PG8_WAIT_V(6); PG8_BAR; PG8_MMA(1, 1, At, B1); PG8_BAR;
            PG8_LDB(B0, 1, 0); PG8_SCHED; PG8_LDA(At, 1, 0); PG8_STAGE(PG8_SA(0, 1), a2 + hstep, voffA);
            PG8_WAIT_L(8); PG8_BAR; PG8_WAIT_L(0); PG8_MMA(0, 0, At, B0); PG8_BAR; PG8_SCHED;
            PG8_LDB(B1, 1, 1); PG8_STAGE(PG8_SB(1, 0), b3, voffB);
            PG8_BAR; PG8_WAIT_L(0); PG8_MMA(0, 1, At, B1); PG8_BAR;
            PG8_LDA(At, 1, 1); PG8_STAGE(PG8_SA(1, 0), a3, voffA);
            PG8_BAR; PG8_WAIT_L(0); PG8_MMA(1, 0, At, B0); PG8_BAR; PG8_SCHED;
            PG8_STAGE(PG8_SB(1, 1), b3 + hstep, voffB);
            PG8_WAIT_V(6); PG8_BAR; PG8_MMA(1, 1, At, B1); PG8_BAR;
            }
        }
        if constexpr (ALIGN_EPI) { if (wr == 0) PG8_BAR; }
        if constexpr (!Epi::AFTER_DRAIN) { E(acc, cur, wr, wc, fr, fq);
#if defined(EPI_TWICE)
            if constexpr (Epi::PERM) E(acc, cur, wr, wc, fr, fq);
#endif
            S.done(cur); }
        if (!has_next) break;
#pragma unroll
        for (int a = 0; a < 2; ++a)
#pragma unroll
            for (int b = 0; b < 2; ++b)
#pragma unroll
                for (int m = 0; m < 4; ++m)
#pragma unroll
                    for (int n = 0; n < 2; ++n) acc[a][b][m][n] = (f32x4){0.f, 0.f, 0.f, 0.f};
        cur = nxt; cA = nA; cB = nB; ++ui;
        if constexpr (ALIGN_EPI) { if (wr == 1) PG8_BAR; }
    }
    PG8_WAIT_V(0);
    if constexpr (!ALIGN_EPI) { if (wr == 0) PG8_BAR; }
    PG8_BAR;
    if constexpr (Epi::AFTER_DRAIN) { E.fused(acc, cur, wr, wc, fr, fq, lds, wid, lane); S.done(cur); }
#undef PG8_SA
#undef PG8_SB
#undef PG8_STAGE
#undef PG8_LDA
#undef PG8_LDB
#undef PG8_MMA
#undef PG8_WAIT_V
#undef PG8_WAIT_L
#undef PG8_BAR
#undef PG8_SCHED
}
}

constexpr int BATCH = 2, SEQ = 8192, DM = 2048, DEPTH = 4;
constexpr int M = BATCH * SEQ;
constexpr int NH = 16, HD = 128, NG = 4, RH = 4;
constexpr int NCMP = 511, NCMP_PAD = 512, NSLC = 128, NSEL = 16, WIN = 512;
constexpr int SSD_H = 32, SSD_P = 64, SSD_N = 128, SSD_G = 4, SSD_CH = 128, SSD_NC = 64, SSD_XBC = 3072;
constexpr int DFF = 8192, PLE = 256;
constexpr float EPS = 1e-6f;
constexpr int PROJ_SRC = 22608;
constexpr int C_Q = 0, C_KC = 2048, C_VC = 2560, C_KS = 3072, C_VS = 3584, C_KW = 4096, C_VW = 4608;
constexpr int C_CB = 5120, C_CC = 7168, C_CU = 9216, C_Z = 11264, C_XBC = 13312, C_GM = 16384, C_GN = 22528, C_DT = 22592;
constexpr int LDP = 22784;
constexpr int S_GN = 5120, S_DT = 16432;

constexpr size_t MiB = 1u << 20;
constexpr size_t WS_CTL = 0, CTL_ZERO_BYTES = 1 * MiB;
constexpr size_t WS_ROPE = 1 * MiB;
constexpr size_t WS_MISC = 9 * MiB;
constexpr size_t WS_DT = 10 * MiB;
constexpr size_t WS_ACS = 12 * MiB;
constexpr size_t WS_CDEC = 14 * MiB;
constexpr size_t WS_KCMP = 15 * MiB;
constexpr size_t WS_VCMP = 16 * MiB;
constexpr size_t WS_X = 32 * MiB;
constexpr size_t WS_HB = 160 * MiB;
constexpr size_t WS_PB = 224 * MiB;
constexpr size_t WS_EB = 256 * MiB;
constexpr size_t WS_YA = 320 * MiB;
constexpr size_t WS_YC = 384 * MiB;
constexpr size_t WS_XBC = 448 * MiB;
constexpr size_t WS_ST = 544 * MiB;
constexpr size_t WS_PROJ = 672 * MiB;
constexpr size_t WS_U = WS_PROJ;
constexpr size_t WS_W = 1384 * MiB;
constexpr size_t LW_IN = 0;
constexpr size_t LW_O = 89 * MiB;
constexpr size_t LW_UP = 97 * MiB;
constexpr size_t LW_DOWN = 129 * MiB;
constexpr size_t LW_PG = 161 * MiB;
constexpr size_t LW_PLE = 169 * MiB;
constexpr size_t LW_PK1 = 170 * MiB;
constexpr size_t LW_PV1 = 171 * MiB;
constexpr size_t LW_PK2 = 172 * MiB;
constexpr size_t LW_PV2 = 172 * MiB + 64 * 1024;
constexpr size_t LW_STRIDE = 173 * MiB;
constexpr size_t WS_HIN = WS_W + 4 * LW_STRIDE;
constexpr size_t WS_RSTD = WS_MISC + 512 * 1024;
constexpr size_t WS_DELTA = WS_HIN + 64 * MiB;
constexpr size_t WS_KV = WS_DELTA + 64 * MiB;
constexpr size_t WS_END = WS_KV + 96 * MiB;
static_assert((size_t)M * LDP * 2 <= 712 * MiB && (size_t)LDP * 2048 * 2 <= 89 * MiB, "ws map");

constexpr int CW_BAR = 4096;
constexpr int CW_CHK = 16384;
constexpr int CW_TS = 20480;

constexpr int RING_BYTES = 131072;
constexpr int LX_OFF = RING_BYTES;
constexpr int LX_BYTES = 8192;
constexpr int LDSCTL_OFF = LX_OFF + LX_BYTES;
constexpr int LDS_BYTES = LDSCTL_OFF + 256;
constexpr int NWAVES = 8, NTHR = 512;

#define DI __device__ __forceinline__
#define GAS __attribute__((address_space(1)))
#define LAS __attribute__((address_space(3)))
typedef unsigned short bf16;
typedef unsigned u32x4 __attribute__((ext_vector_type(4)));
typedef unsigned u32x2 __attribute__((ext_vector_type(2)));
typedef float f32x4 __attribute__((ext_vector_type(4)));
typedef float f32x2 __attribute__((ext_vector_type(2)));
typedef short bf16x8 __attribute__((ext_vector_type(8)));
typedef short s16x4 __attribute__((ext_vector_type(4)));
typedef GAS unsigned gu32;
#define RLX_AGENT __ATOMIC_RELAXED, __HIP_MEMORY_SCOPE_AGENT
#define LDS_WAIT() asm volatile("s_waitcnt lgkmcnt(0)" ::: "memory")
#define VM_WAIT() asm volatile("s_waitcnt vmcnt(0)" ::: "memory")
DI size_t kv_off(int kind, int b, int g, int t) { return ((((size_t)kind * BATCH + b) * NG + g) * SEQ + t) * HD; }
DI unsigned f2bf(float f) { unsigned u = __builtin_bit_cast(unsigned, f); return (u + 0x7fffu + ((u >> 16) & 1u)) >> 16; }
DI unsigned pk2(float lo, float hi) { unsigned r; asm("v_cvt_pk_bf16_f32 %0, %1, %2" : "=v"(r) : "v"(lo), "v"(hi)); return r; }
DI float bf2f(unsigned h) { return __builtin_bit_cast(float, h << 16); }
DI float bflo(unsigned w) { return __builtin_bit_cast(float, w << 16); }
DI float bfhi(unsigned w) { return __builtin_bit_cast(float, w & 0xffff0000u); }
DI float sigmoidf_(float x) { return 1.0f / (1.0f + __expf(-x)); }
DI float siluf_(float x) { return x / (1.0f + __expf(-x)); }
DI float shfl_idx(float v, int src) { return __builtin_bit_cast(float, __builtin_amdgcn_ds_bpermute(src << 2, __builtin_bit_cast(int, v))); }
DI unsigned shfl_idx_u(unsigned v, int src) { return (unsigned)__builtin_amdgcn_ds_bpermute(src << 2, (int)v); }
DI float shx(float v, int m, int lane) { return shfl_idx(v, lane ^ m); }
DI float xq_max(float x) {
    float a = x, b = x;
    asm("s_nop 1\n\tv_permlane32_swap_b32 %0, %1" : "+v"(a), "+v"(b)); x = fmaxf(a, b);
    a = x; b = x;
    asm("s_nop 1\n\tv_permlane16_swap_b32 %0, %1" : "+v"(a), "+v"(b)); return fmaxf(a, b);
}
DI float xq_sum(float x) {
    float a = x, b = x;
    asm("s_nop 1\n\tv_permlane32_swap_b32 %0, %1" : "+v"(a), "+v"(b)); x = a + b;
    a = x; b = x;
    asm("s_nop 1\n\tv_permlane16_swap_b32 %0, %1" : "+v"(a), "+v"(b)); return a + b;
}
DI float quad_sum(float v) {
    v += __builtin_bit_cast(float, __builtin_amdgcn_update_dpp(0, __builtin_bit_cast(int, v), 0xB1, 0xF, 0xF, true));
    v += __builtin_bit_cast(float, __builtin_amdgcn_update_dpp(0, __builtin_bit_cast(int, v), 0x4E, 0xF, 0xF, true));
    return v;
}
DI float wave_sum(float v, int lane) {
#pragma unroll
    for (int o = 1; o < 64; o <<= 1) v += shx(v, o, lane);
    return v;
}
DI unsigned off_b(unsigned row, unsigned ch) { return 256u * row + 16u * (ch ^ (((row & 3u) << 2) | ((row >> 2) & 3u))); }
DI unsigned tr_addr(unsigned lane, unsigned r0, unsigned c, unsigned t) {
    const unsigned g = lane >> 4, q = (lane & 15u) >> 2, p = lane & 3u;
    return off_b(r0 + 8u * g + 4u * t + q, 2u * c + (p >> 1)) + 8u * (p & 1u);
}
DI s16x4 tr_read(LAS const unsigned char* p) { return __builtin_amdgcn_ds_read_tr16_b64_v4i16((LAS s16x4*)p); }
DI bf16x8 tr_read8(LAS const unsigned char* base, unsigned lane, unsigned r0, unsigned c) {
    const s16x4 lo = tr_read(base + tr_addr(lane, r0, c, 0)), hi = tr_read(base + tr_addr(lane, r0, c, 1));
    return __builtin_shufflevector(lo, hi, 0, 1, 2, 3, 4, 5, 6, 7);
}
DI bf16x8 lds_rd8(LAS const unsigned char* p) { return *(const LAS bf16x8*)p; }
DI bf16x8 as_bf16x8(u32x4 v) { return __builtin_bit_cast(bf16x8, v); }
#define MFMA16(a, b, c) __builtin_amdgcn_mfma_f32_16x16x32_bf16((a), (b), (c), 0, 0, 0)

namespace pg8 {
struct LightOrder {
    int G, c, nunits, nN;
    __host__ __device__ void init(int M, int N, int G_, int c_) { G = G_; c = c_; nN = N / BM; nunits = (M / BM) * nN; }
    __host__ __device__ bool next(int i, Unit& u) const {
        int j;
        if (G == 256) { if (c < 64) return false; j = (c - 64) + 192 * i; } else j = c + G * i;
        if (j >= nunits) return false;
        u.pm = j / nN; u.pn = j % nN; return true;
    }
    __device__ __forceinline__ void a_ready(const Unit&) const {}
    __device__ __forceinline__ void done(const Unit&) const {}
};
template <int MODE> struct EpiB {
    static constexpr bool PERM = true, AFTER_DRAIN = false;
    bf16_t* O; int ldc; const float* rope;
    bf16_t* kv;
    __device__ __forceinline__ void operator()(const f32x4 (&acc)[2][2][4][2], const Unit& u, int wr, int wc, int fr, int fq) const {
        { int l; asm volatile("v_mbcnt_lo_u32_b32 %0, -1, 0\n\tv_mbcnt_hi_u32_b32 %0, -1, %0" : "=v"(l)); fr = l & 15; fq = l >> 4; }
        const int row0 = u.pm * BM + wr * 64 + fr;
        bool rp = false;
        if (MODE == 2) { const int pn = u.pn; rp = (pn < 10) || pn == 12 || pn == 13 || pn == 16 || pn == 17; }
        if (MODE == 2 && rp) {
            const int colb = u.pn * BM + 128 * (wc >> 1) + 32 * (wc & 1) + 8 * fq, jj0 = 32 * (wc & 1) + 8 * fq;
#pragma unroll
            for (int ai = 0; ai < 2; ++ai)
#pragma unroll
                for (int m = 0; m < 4; ++m) {
                    const int row = row0 + ai * HALF + m * 16;
                    const float* rpp = (const float*)((const char*)rope + (unsigned)(((unsigned)row * 64u + (unsigned)jj0) * 8u));
                    const f32x4 cs0 = *(const f32x4*)(rpp), cs1 = *(const f32x4*)(rpp + 4), cs2 = *(const f32x4*)(rpp + 8), cs3 = *(const f32x4*)(rpp + 12);
                    const f32x4 x1a = acc[ai][0][m][0], x1b = acc[ai][0][m][1], x2a = acc[ai][1][m][0], x2b = acc[ai][1][m][1];
                    float c[8] = {cs0[0], cs0[2], cs1[0], cs1[2], cs2[0], cs2[2], cs3[0], cs3[2]};
                    float s[8] = {cs0[1], cs0[3], cs1[1], cs1[3], cs2[1], cs2[3], cs3[1], cs3[3]};
                    float x1[8] = {x1a[0], x1a[1], x1a[2], x1a[3], x1b[0], x1b[1], x1b[2], x1b[3]};
                    float x2[8] = {x2a[0], x2a[1], x2a[2], x2a[3], x2b[0], x2b[1], x2b[2], x2b[3]};
                    float o1[8], o2[8];
#pragma unroll
                    for (int k = 0; k < 8; ++k) { o1[k] = x1[k] * c[k] - x2[k] * s[k]; o2[k] = x2[k] * c[k] + x1[k] * s[k]; }
                    u32x4 w1, w2;
                    w1.x = cvt_pk_bf16(o1[0], o1[1]); w1.y = cvt_pk_bf16(o1[2], o1[3]); w1.z = cvt_pk_bf16(o1[4], o1[5]); w1.w = cvt_pk_bf16(o1[6], o1[7]);
                    w2.x = cvt_pk_bf16(o2[0], o2[1]); w2.y = cvt_pk_bf16(o2[2], o2[3]); w2.z = cvt_pk_bf16(o2[4], o2[5]); w2.w = cvt_pk_bf16(o2[6], o2[7]);
                    bf16_t* rowp = (bf16_t*)((char*)O + (unsigned)(((unsigned)row * (unsigned)ldc + (unsigned)colb) * 2u));
                    if (u.pn >= 8) { const int kind = (u.pn - 8) >> 1, g = 2 * (u.pn & 1) + (wc >> 1);
                        rowp = kv + ((((size_t)kind * 2 + (row >> 13)) * 4 + g) * 8192 + (row & 8191)) * 128 + jj0; }
                    *(u32x4*)(rowp) = w1; *(u32x4*)(rowp + 64) = w2;
                    asm volatile("" ::: "memory");
                }
        } else {
            const int col0 = u.pn * BM + wc * 32 + 8 * fq;
#pragma unroll
            for (int ai = 0; ai < 2; ++ai)
#pragma unroll
                for (int m = 0; m < 4; ++m) { bf16_t* rowp = (bf16_t*)((char*)O + (unsigned)(((unsigned)(row0 + ai * HALF + m * 16) * (unsigned)ldc + (unsigned)col0) * 2u));
#pragma unroll
                    for (int bj = 0; bj < 2; ++bj) { f32x4 v0 = acc[ai][bj][m][0], v1 = acc[ai][bj][m][1];
                        if (MODE == 1) {
#pragma unroll
                            for (int k = 0; k < 4; ++k) { const float a = fmaxf(v0[k], 0.f), b = fmaxf(v1[k], 0.f); v0[k] = a * a; v1[k] = b * b; } }
                        if (MODE == 3) { const u32x4 ev = *(const u32x4*)((const bf16_t*)rope + (rowp - O) + bj * HALF);
                            const float e[8] = {__builtin_bit_cast(float, ev.x << 16), __builtin_bit_cast(float, ev.x & 0xffff0000u), __builtin_bit_cast(float, ev.y << 16), __builtin_bit_cast(float, ev.y & 0xffff0000u),
                                                __builtin_bit_cast(float, ev.z << 16), __builtin_bit_cast(float, ev.z & 0xffff0000u), __builtin_bit_cast(float, ev.w << 16), __builtin_bit_cast(float, ev.w & 0xffff0000u)};
#pragma unroll
                            for (int k = 0; k < 4; ++k) { v0[k] = e[k] / (1.0f + __expf(-v0[k])); v1[k] = e[4 + k] / (1.0f + __expf(-v1[k])); } }
                        u32x4 w; w.x = cvt_pk_bf16(v0[0], v0[1]); w.y = cvt_pk_bf16(v0[2], v0[3]); w.z = cvt_pk_bf16(v1[0], v1[1]); w.w = cvt_pk_bf16(v1[2], v1[3]);
                        if (MODE == 2 && u.pn >= 8 && u.pn < 20) { const int kind = (u.pn - 8) >> 1, g = 2 * (u.pn & 1) + bj, row = row0 + ai * HALF + m * 16;
                            *(u32x4*)(kv + ((((size_t)kind * 2 + (row >> 13)) * 4 + g) * 8192 + (row & 8191)) * 128 + wc * 32 + 8 * fq) = w; }
                        else *(u32x4*)(rowp + bj * HALF) = w; } }
        }
    }
};
template <bool GATE> struct EpiRes {
    static constexpr bool PERM = false, AFTER_DRAIN = false;
    const float* xin; float* xout; int ldc; const bf16_t* e;
    __device__ __forceinline__ void operator()(const f32x4 (&acc)[2][2][4][2], const Unit& u, int wr, int wc, int fr, int fq) const {
        { int l; asm volatile("v_mbcnt_lo_u32_b32 %0, -1, 0\n\tv_mbcnt_hi_u32_b32 %0, -1, %0" : "=v"(l)); fr = l & 15; fq = l >> 4; }
        const int row0 = u.pm * BM + wr * 64 + fr, col0 = u.pn * BM + wc * 32 + 4 * fq;
#pragma unroll
        for (int ai = 0; ai < 2; ++ai)
#pragma unroll
            for (int m = 0; m < 4; ++m) { const unsigned off = (unsigned)(row0 + ai * HALF + m * 16) * (unsigned)ldc + (unsigned)col0;
#pragma unroll
                for (int bj = 0; bj < 2; ++bj)
#pragma unroll
                    for (int n = 0; n < 2; ++n) { const unsigned o = off + bj * HALF + n * 16; const f32x4 xv = *(const f32x4*)((const char*)xin + (unsigned)(o * 4u)); f32x4 a = acc[ai][bj][m][n];
                        if (GATE) { typedef unsigned u32x2v __attribute__((ext_vector_type(2))); const u32x2v ev = *(const u32x2v*)((const char*)e + (unsigned)(o * 2u));
                            const float e0 = __builtin_bit_cast(float, ev.x << 16), e1 = __builtin_bit_cast(float, ev.x & 0xffff0000u), e2 = __builtin_bit_cast(float, ev.y << 16), e3 = __builtin_bit_cast(float, ev.y & 0xffff0000u);
                            a[0] = e0 / (1.0f + __expf(-a[0])); a[1] = e1 / (1.0f + __expf(-a[1])); a[2] = e2 / (1.0f + __expf(-a[2])); a[3] = e3 / (1.0f + __expf(-a[3])); }
                        *(f32x4*)((char*)xout + (unsigned)(o * 4u)) = xv + a; }
                asm volatile("" ::: "memory"); }
    }
};
}
#define XB_TMO      128
#define XB_XCNT(j)  (256  + 64 * (j))
#define XB_XSUB(j)  (1280 + 64 * (j))
#define XB_XGEN(j)  (2304 + 64 * (j))
#define XB_TOP      3328
#define XB_TOPGEN   3392
#define XCD_BAR_WORDS 3456
#define XB_SPIN_CAP (1u << 18)

__device__ __forceinline__ unsigned xb_ld(unsigned* p)              { return __hip_atomic_load(p, __ATOMIC_RELAXED, __HIP_MEMORY_SCOPE_AGENT); }
__device__ __forceinline__ unsigned xb_add(unsigned* p, unsigned v) { return __hip_atomic_fetch_add(p, v, __ATOMIC_RELAXED, __HIP_MEMORY_SCOPE_AGENT); }
__device__ __forceinline__ unsigned xb_xcc_id() { return (unsigned)__builtin_amdgcn_s_getreg((3 << 11) | 20) & 0xFu; }
#define XB_SPIN(cond, bar) do { unsigned _sp = 0; while (cond) { __builtin_amdgcn_s_sleep(1); \
    if ((++_sp & 255u) == 0u) { if (xb_ld(&(bar)[XB_TMO])) break; if (_sp > XB_SPIN_CAP) { atomicAdd(&(bar)[XB_TMO], 1u); break; } } } } while (0)

struct XcdBarrier {
    unsigned* bar; unsigned x;
    volatile LAS unsigned* st;
};

__device__ __forceinline__ XcdBarrier xcd_barrier_post(unsigned* bar, volatile LAS unsigned* st) {
    XcdBarrier b; b.bar = bar; b.x = xb_xcc_id(); b.st = st;
    if (threadIdx.x == 0) (void)xb_add(&bar[XB_XCNT(b.x)], 1u);
    return b;
}
__device__ __forceinline__ void xcd_barrier_complete(unsigned* bar, unsigned x, unsigned& nloc, unsigned& nx) {
    const unsigned G = gridDim.x * gridDim.y * gridDim.z;
    unsigned sum, cnt, mine, sp = 0u;
    for (;;) {
        sum = 0u; cnt = 0u; mine = 0u;
#pragma unroll
        for (unsigned j = 0; j < 16; ++j) { const unsigned c = xb_ld(&bar[XB_XCNT(j)]); sum += c; cnt += (c > 0u) ? 1u : 0u; mine = (j == x) ? c : mine; }
        if (sum == G) break;
        __builtin_amdgcn_s_sleep(1);
        if ((++sp & 255u) == 0u) { if (xb_ld(&bar[XB_TMO])) break; if (sp > XB_SPIN_CAP) { atomicAdd(&bar[XB_TMO], 1u); break; } }
    }
    nloc = mine > 0u ? mine : 1u; nx = cnt > 0u ? cnt : 1u;
}

__device__ __forceinline__ void xcd_barrier(const XcdBarrier& b) {
    asm volatile("s_waitcnt vmcnt(0)" ::: "memory");
    __syncthreads();
    if (threadIdx.x == 0) {
        unsigned* bar = b.bar;
        __builtin_amdgcn_s_waitcnt(0);
        unsigned nloc = b.st[0], nx = b.st[1];
        if (nloc == 0u) { xcd_barrier_complete(bar, b.x, nloc, nx); b.st[0] = nloc; b.st[1] = nx; }
        const unsigned old = xb_add(&bar[XB_XSUB(b.x)], 1u);
        const unsigned gen = old / nloc;
        if (old + 1u == (gen + 1u) * nloc) {
            __builtin_amdgcn_fence(__ATOMIC_RELEASE, "agent");
            asm volatile("s_waitcnt vmcnt(0)" ::: "memory");
            const unsigned og = xb_add(&bar[XB_TOP], 1u);
            const unsigned tg = og / nx;
            if (og + 1u == (tg + 1u) * nx) xb_add(&bar[XB_TOPGEN], 1u);
            else XB_SPIN(xb_ld(&bar[XB_TOPGEN]) == tg, bar);
            __builtin_amdgcn_fence(__ATOMIC_ACQUIRE, "agent");
            xb_add(&bar[XB_XGEN(b.x)], 1u);
            asm volatile("s_waitcnt vmcnt(0)" ::: "memory");
        } else {
            XB_SPIN(xb_ld(&bar[XB_XGEN(b.x)]) == gen, bar);
            __builtin_amdgcn_fence(__ATOMIC_ACQUIRE, "agent");
            asm volatile("s_waitcnt vmcnt(0)" ::: "memory");
        }
    }
    __syncthreads();
}

struct Args { const void* in[30]; float* out; unsigned char* ws; int ph_lo, ph_hi; };
struct Frame {
    LAS unsigned char* lds;
    gu32* ctl;
    unsigned char* ws;
    int tid, lane, wave, G, bid;
};
DI const void* argin(const Args&, int k) {
    typedef const void* const __attribute__((address_space(4)))* kptr_t;
    kptr_t p = (kptr_t)__builtin_amdgcn_kernarg_segment_ptr(); asm volatile("" : "+s"(p));
    return (const void*)p[k]; }
DI int launder_s(int x) { asm volatile("" : "+s"(x)); return x; }
DI Frame phase_frame(const Frame& F0) { Frame F = F0;
    int l; asm volatile("v_mbcnt_lo_u32_b32 %0, -1, 0\n\tv_mbcnt_hi_u32_b32 %0, -1, %0" : "=v"(l));
    F.wave = launder_s(F0.wave); F.bid = launder_s(F0.bid); F.G = launder_s(F0.G);
    F.lane = l; F.tid = F.wave * 64 + l;
    { unsigned long long wsb = (unsigned long long)F0.ws; asm volatile("" : "+s"(wsb)); F.ws = (unsigned char*)wsb; }
    { unsigned ll = (unsigned)(size_t)F0.lds; asm volatile("" : "+s"(ll)); F.lds = (LAS unsigned char*)(size_t)ll; }
    return F; }
DI unsigned char* lw_ptr(const Frame& F, int layer, size_t off) { return F.ws + WS_W + (size_t)layer * LW_STRIDE + off; }

template <bool FRAGMAJOR = false>
DI void transpose_item(const float* W, int K, int Nsrc, int nsrc0, bf16* WT, int dst_row0, int k0, LAS float* scr, int lane) {
#pragma unroll 8
    for (int i = 0; i < 32; ++i) { const int kk = 2 * i + (lane >> 5); scr[kk * 33 + (lane & 31)] = W[(size_t)(k0 + kk) * Nsrc + nsrc0 + (lane & 31)]; }
    LDS_WAIT(); asm volatile("" ::: "memory");
    const int c = lane & 7;
#pragma unroll
    for (int j = 0; j < 4; ++j) { const int n = (lane >> 3) + 8 * j; const LAS float* s = scr + (8 * c) * 33 + n;
        u32x4 o; o.x = pk2(s[0 * 33], s[1 * 33]); o.y = pk2(s[2 * 33], s[3 * 33]); o.z = pk2(s[4 * 33], s[5 * 33]); o.w = pk2(s[6 * 33], s[7 * 33]);
        if (FRAGMAJOR) { const int hid = dst_row0 + n, kk = k0 + 8 * c;
            *(u32x4*)(WT + ((size_t)((hid >> 4) * (K >> 5) + (kk >> 5)) * 64 + (((kk >> 3) & 3) * 16 + (hid & 15))) * 8) = o; }
        else *(u32x4*)(WT + (size_t)(dst_row0 + n) * K + k0 + 8 * c) = o; }
    LDS_WAIT(); asm volatile("" ::: "memory");
}
DI int proj_src_col(int d) {
    if (d < 5120) {
        const int pn = d >> 8; const bool rp = (pn < 10) || pn == 12 || pn == 13 || pn == 16 || pn == 17;
        if (!rp) return d;
        const int c = d & 255, bj = c >> 7, wc = (c >> 5) & 3;
        return (pn << 8) + 128 * (wc >> 1) + 64 * bj + 32 * (wc & 1);
    }
    if (d < 16384) return d + 48;
    if (d < 22528) return d + 80;
    if (d < 22592) return S_GN + (d - 22528);
    if (d < 22624) return S_DT + (d - 22592);
    return 0;
}
constexpr int TI_IN = 32 * 712, TI_O = 32 * 64, TI_UP = 32 * 256, TI_DOWN = 128 * 64, TI_PG = 32 * 64, TI_PLE = 4 * 64, TI_P1 = 64 * 4, TI_P2 = 2 * 4;
constexpr int TI_LAYER = TI_IN + TI_O + TI_UP + TI_DOWN + TI_PG + TI_PLE + 2 * TI_P1 + 2 * TI_P2;

DI void p0_prologue(const Frame& F0, const Args& A) {
    const Frame F = phase_frame(F0);
    LAS float* scr = (LAS float*)(F.lds + F.wave * 16384);
    const int gw = F.bid * NWAVES + F.wave, NGW = F.G * NWAVES;
    for (int it = gw; it < DEPTH * TI_LAYER; it += NGW) {
        const int layer = it / TI_LAYER; int r = it - layer * TI_LAYER;
        if (r < TI_IN) { const int kb = r / 712, nb = r - kb * 712;
            transpose_item((const float*)argin(A, 4) + (size_t)layer * DM * PROJ_SRC, DM, PROJ_SRC, proj_src_col(nb * 32), (bf16*)lw_ptr(F, layer, LW_IN), nb * 32, kb * 64, scr, F.lane); continue; } r -= TI_IN;
        if (r < TI_O) { const int kb = r / 64, nb = r % 64;
            transpose_item((const float*)argin(A, 22) + (size_t)layer * DM * DM, DM, DM, nb * 32, (bf16*)lw_ptr(F, layer, LW_O), nb * 32, kb * 64, scr, F.lane); continue; } r -= TI_O;
        if (r < TI_UP) { const int kb = r / 256, nb = r % 256;
            transpose_item((const float*)argin(A, 24) + (size_t)layer * DM * DFF, DM, DFF, nb * 32, (bf16*)lw_ptr(F, layer, LW_UP), nb * 32, kb * 64, scr, F.lane); continue; } r -= TI_UP;
        if (r < TI_DOWN) { const int kb = r / 64, nb = r % 64;
            transpose_item((const float*)argin(A, 25) + (size_t)layer * DFF * DM, DFF, DM, nb * 32, (bf16*)lw_ptr(F, layer, LW_DOWN), nb * 32, kb * 64, scr, F.lane); continue; } r -= TI_DOWN;
        if (r < TI_PG) { const int kb = r / 64, nb = r % 64;
            transpose_item((const float*)argin(A, 28) + (size_t)layer * DM * DM, DM, DM, nb * 32, (bf16*)lw_ptr(F, layer, LW_PG), nb * 32, kb * 64, scr, F.lane); continue; } r -= TI_PG;
        if (r < TI_PLE) { const int kb = r / 64, nb = r % 64;
            transpose_item((const float*)argin(A, 27) + (size_t)layer * PLE * DM, PLE, DM, nb * 32, (bf16*)lw_ptr(F, layer, LW_PLE), nb * 32, kb * 64, scr, F.lane); continue; } r -= TI_PLE;
        if (r < TI_P1) { const int kb = r / 4, nb = r % 4;
            transpose_item<true>((const float*)argin(A, 7) + (size_t)layer * 4096 * 128, 4096, 128, nb * 32, (bf16*)lw_ptr(F, layer, LW_PK1), nb * 32, kb * 64, scr, F.lane); continue; } r -= TI_P1;
        if (r < TI_P1) { const int kb = r / 4, nb = r % 4;
            transpose_item<true>((const float*)argin(A, 11) + (size_t)layer * 4096 * 128, 4096, 128, nb * 32, (bf16*)lw_ptr(F, layer, LW_PV1), nb * 32, kb * 64, scr, F.lane); continue; } r -= TI_P1;
        if (r < TI_P2) { const int kb = r / 4, nb = r % 4;
            transpose_item((const float*)argin(A, 9) + (size_t)layer * 128 * 128, 128, 128, nb * 32, (bf16*)lw_ptr(F, layer, LW_PK2), nb * 32, kb * 64, scr, F.lane); continue; } r -= TI_P2;
        { const int kb = r / 4, nb = r % 4;
            transpose_item((const float*)argin(A, 13) + (size_t)layer * 128 * 128, 128, 128, nb * 32, (bf16*)lw_ptr(F, layer, LW_PV2), nb * 32, kb * 64, scr, F.lane); }
    }
    const size_t gt = (size_t)F.bid * NTHR + F.tid, NGT = (size_t)F.G * NTHR;
    { const float* p = (const float*)argin(A, 1); bf16* pb = (bf16*)(F.ws + WS_PB);
      for (size_t i = gt; i < (size_t)DEPTH * M * PLE / 8; i += NGT) { const f32x4 a = *(const f32x4*)(p + i * 8), b = *(const f32x4*)(p + i * 8 + 4);
          u32x4 o; o.x = pk2(a[0], a[1]); o.y = pk2(a[2], a[3]); o.z = pk2(b[0], b[1]); o.w = pk2(b[2], b[3]); *(u32x4*)(pb + i * 8) = o; } }
    { const int* pos = (const int*)argin(A, 2); float* rope = (float*)(F.ws + WS_ROPE);
      for (size_t i = gt; i < (size_t)M * 64; i += NGT) { const int row = (int)(i >> 6), jj = (int)(i & 63);
          const float inv = 1.0f / powf(10000.0f, (float)(2 * jj) * (1.0f / 128.0f));
          const float ang = (float)pos[row] * inv;
          double a = (double)ang; a -= 6.283185307179586476925 * __builtin_rint(a * 0.15915494309189533577);
          const float ar = (float)a;
          rope[i * 2] = cosf(ar); rope[i * 2 + 1] = sinf(ar); } }
    { float* part = (float*)(F.ws + WS_MISC);
      for (size_t i = gt; i < (size_t)DEPTH * 2 * 8 * 128; i += NGT) { const int hid = (int)(i & 127), c = (int)(i >> 7) & 7, kv = (int)(i >> 10) & 1, layer = (int)(i >> 11);
          const float* pe = (const float*)(kv ? A.in[6] : A.in[5]) + (size_t)layer * 4096 + c * 512;
          const float* w1 = (const float*)(kv ? A.in[11] : A.in[7]) + (size_t)layer * 4096 * 128 + (size_t)c * 512 * 128 + hid;
          float s = 0.f;
#pragma unroll 8
          for (int kk = 0; kk < 512; ++kk) s += pe[kk] * w1[(size_t)kk * 128];
          part[i] = s; } }
}

template <bool OUTF32> DI void norm_rows(const Frame& F0, const float* x, const float* g, void* outp) {
    const Frame F = phase_frame(F0);
    const int gw = F.bid * NWAVES + F.wave, NGW = F.G * NWAVES;
    for (int m = gw; m < M; m += NGW) {
        const f32x4* xr = (const f32x4*)(x + (size_t)m * DM) + F.lane;
        f32x4 v[8]; float s = 0.f;
#pragma unroll
        for (int j = 0; j < 8; ++j) { v[j] = xr[64 * j]; s += (v[j][0] * v[j][0] + v[j][1] * v[j][1]) + (v[j][2] * v[j][2] + v[j][3] * v[j][3]); }
        const float rstd = 1.0f / sqrtf(wave_sum(s, F.lane) * (1.0f / DM) + EPS);
#pragma unroll
        for (int j = 0; j < 8; ++j) { const f32x4 gv = ((const f32x4*)g)[F.lane + 64 * j]; const f32x4 o = v[j] * rstd * gv;
            if (OUTF32) ((f32x4*)((float*)outp + (size_t)m * DM))[F.lane + 64 * j] = o;
            else { u32x2 w; w.x = pk2(o[0], o[1]); w.y = pk2(o[2], o[3]); ((u32x2*)((bf16*)outp + (size_t)m * DM))[F.lane + 64 * j] = w; } }
    }
}
template <bool OUTF32> DI void addnorm_rows(const Frame& F0, const float* xin, const bf16* delta, const float* g, float* xout, void* outp) {
    const Frame F = phase_frame(F0);
    const int gw = F.bid * NWAVES + F.wave, NGW = F.G * NWAVES;
    for (int m = gw; m < M; m += NGW) {
        const f32x4* xr = (const f32x4*)(xin + (size_t)m * DM) + F.lane; const u32x2* dr = (const u32x2*)(delta + (size_t)m * DM) + F.lane;
        f32x4 v[8]; u32x2 d[8]; float s = 0.f;
#pragma unroll
        for (int j = 0; j < 8; ++j) { v[j] = xr[64 * j]; d[j] = dr[64 * j]; }
#pragma unroll
        for (int j = 0; j < 8; ++j) { v[j][0] += bflo(d[j].x); v[j][1] += bfhi(d[j].x); v[j][2] += bflo(d[j].y); v[j][3] += bfhi(d[j].y);
            s += (v[j][0] * v[j][0] + v[j][1] * v[j][1]) + (v[j][2] * v[j][2] + v[j][3] * v[j][3]);
            if (!OUTF32) ((f32x4*)(xout + (size_t)m * DM))[F.lane + 64 * j] = v[j]; }
        const float rstd = 1.0f / sqrtf(wave_sum(s, F.lane) * (1.0f / DM) + EPS);
#pragma unroll
        for (int j = 0; j < 8; ++j) { const f32x4 gv = ((const f32x4*)g)[F.lane + 64 * j]; const f32x4 o = v[j] * rstd * gv;
            if (OUTF32) ((f32x4*)((float*)outp + (size_t)m * DM))[F.lane + 64 * j] = o;
            else { u32x2 w; w.x = pk2(o[0], o[1]); w.y = pk2(o[2], o[3]); ((u32x2*)((bf16*)outp + (size_t)m * DM))[F.lane + 64 * j] = w; } }
    }
}
DI void unpack8(u32x4 w, float (&f)[8]) { f[0] = bflo(w.x); f[1] = bfhi(w.x); f[2] = bflo(w.y); f[3] = bfhi(w.y); f[4] = bflo(w.z); f[5] = bfhi(w.z); f[6] = bflo(w.w); f[7] = bfhi(w.w); }
DI u32x4 pack8f(const float (&f)[8]) { u32x4 o; o.x = pk2(f[0], f[1]); o.y = pk2(f[2], f[3]); o.z = pk2(f[4], f[5]); o.w = pk2(f[6], f[7]); return o; }

DI void ssd_conv_pass(const Frame& F0, const Args& A, int layer) {
    const Frame F = phase_frame(F0);
    const bf16* proj = (const bf16*)(F.ws + WS_PROJ); bf16* xbc = (bf16*)(F.ws + WS_XBC);
    const float* cw = (const float*)argin(A, 16) + (size_t)layer * 4 * SSD_XBC; const float* cb = (const float*)argin(A, 17) + (size_t)layer * SSD_XBC;
    const int gt = F.bid * NTHR + F.tid, NGT = F.G * NTHR;
    for (int task = gt; task < 512 * 384; task += NGT) {
        const int run = task / 384, cg = task - run * 384, ch = cg * 8, row0 = run * 32;
        float w[4][8], bs[8], xm3[8], xm2[8], xm1[8];
#pragma unroll
        for (int j = 0; j < 4; ++j) { const f32x4 a = *(const f32x4*)(cw + j * SSD_XBC + ch), b = *(const f32x4*)(cw + j * SSD_XBC + ch + 4);
            w[j][0] = a[0]; w[j][1] = a[1]; w[j][2] = a[2]; w[j][3] = a[3]; w[j][4] = b[0]; w[j][5] = b[1]; w[j][6] = b[2]; w[j][7] = b[3]; }
        { const f32x4 a = *(const f32x4*)(cb + ch), b = *(const f32x4*)(cb + ch + 4); bs[0] = a[0]; bs[1] = a[1]; bs[2] = a[2]; bs[3] = a[3]; bs[4] = b[0]; bs[5] = b[1]; bs[6] = b[2]; bs[7] = b[3]; }
        if ((row0 & (SEQ - 1)) != 0) {
            unpack8(*(const u32x4*)(proj + (size_t)(row0 - 3) * LDP + C_XBC + ch), xm3);
            unpack8(*(const u32x4*)(proj + (size_t)(row0 - 2) * LDP + C_XBC + ch), xm2);
            unpack8(*(const u32x4*)(proj + (size_t)(row0 - 1) * LDP + C_XBC + ch), xm1);
        } else {
#pragma unroll
            for (int k = 0; k < 8; ++k) { xm3[k] = 0.f; xm2[k] = 0.f; xm1[k] = 0.f; }
        }
#pragma unroll 4
        for (int r = 0; r < 32; ++r) {
            float cur[8], y[8]; unpack8(*(const u32x4*)(proj + (size_t)(row0 + r) * LDP + C_XBC + ch), cur);
#pragma unroll
            for (int k = 0; k < 8; ++k) { const float v = w[0][k] * xm3[k] + w[1][k] * xm2[k] + w[2][k] * xm1[k] + w[3][k] * cur[k] + bs[k]; y[k] = siluf_(v); xm3[k] = xm2[k]; xm2[k] = xm1[k]; xm1[k] = cur[k]; }
            *(u32x4*)(xbc + (size_t)(row0 + r) * SSD_XBC + ch) = pack8f(y);
        }
    }
    const float* dtb = (const float*)argin(A, 18) + layer * SSD_H; float* dt = (float*)(F.ws + WS_DT);
    for (int i = gt; i < M * SSD_H; i += NGT) { const int row = i >> 5, h = i & 31;
        const float x = bf2f(proj[(size_t)row * LDP + C_DT + h]) + dtb[h];
        dt[i] = fmaxf(x, 0.f) + log1pf(__expf(-fabsf(x))); }
}

DI void merge_pass(const Frame& F0, const Args& A, int layer) {
    const Frame F = phase_frame(F0);
    const bf16* proj = (const bf16*)(F.ws + WS_PROJ); const bf16* ya = (const bf16*)(F.ws + WS_YA); const bf16* yc = (const bf16*)(F.ws + WS_YC); bf16* hb = (bf16*)(F.ws + WS_HB);
    const float* sw = (const float*)argin(A, 15) + (size_t)layer * 3 * DM; const float* ngp = (const float*)argin(A, 21) + (size_t)layer * DM; const float* rstdp = (const float*)(F.ws + WS_RSTD);
    const int gt = F.bid * NTHR + F.tid, NGT = F.G * NTHR;
    for (int task = gt; task < 512 * 256; task += NGT) {
        const int run = task >> 8, cg = task & 255, ch = cg * 8, row0 = run * 32;
        float w[3][8], pm2[8], pm1[8], ng8[8];
        { const f32x4 a = *(const f32x4*)(ngp + ch), b = *(const f32x4*)(ngp + ch + 4); ng8[0] = a[0]; ng8[1] = a[1]; ng8[2] = a[2]; ng8[3] = a[3]; ng8[4] = b[0]; ng8[5] = b[1]; ng8[6] = b[2]; ng8[7] = b[3]; }
#pragma unroll
        for (int j = 0; j < 3; ++j) { const f32x4 a = *(const f32x4*)(sw + j * DM + ch), b = *(const f32x4*)(sw + j * DM + ch + 4);
            w[j][0] = a[0]; w[j][1] = a[1]; w[j][2] = a[2]; w[j][3] = a[3]; w[j][4] = b[0]; w[j][5] = b[1]; w[j][6] = b[2]; w[j][7] = b[3]; }
        if ((row0 & (SEQ - 1)) != 0) {
            float c1[8], u1[8];
            unpack8(*(const u32x4*)(proj + (size_t)(row0 - 2) * LDP + C_CC + ch), c1); unpack8(*(const u32x4*)(proj + (size_t)(row0 - 2) * LDP + C_CU + ch), u1);
#pragma unroll
            for (int k = 0; k < 8; ++k) pm2[k] = c1[k] * u1[k];
            unpack8(*(const u32x4*)(proj + (size_t)(row0 - 1) * LDP + C_CC + ch), c1); unpack8(*(const u32x4*)(proj + (size_t)(row0 - 1) * LDP + C_CU + ch), u1);
#pragma unroll
            for (int k = 0; k < 8; ++k) pm1[k] = c1[k] * u1[k];
        } else {
#pragma unroll
            for (int k = 0; k < 8; ++k) { pm2[k] = 0.f; pm1[k] = 0.f; }
        }
#pragma unroll 2
        for (int r = 0; r < 32; ++r) {
            const size_t pr = (size_t)(row0 + r) * LDP + ch, yr = (size_t)(row0 + r) * DM + ch;
            float cc[8], cu[8], cbv[8], g0[8], g1[8], g2[8], a[8], c[8], o[8];
            unpack8(*(const u32x4*)(proj + pr + C_CC), cc); unpack8(*(const u32x4*)(proj + pr + C_CU), cu); unpack8(*(const u32x4*)(proj + pr + C_CB), cbv);
            unpack8(*(const u32x4*)(proj + pr + C_GM), g0); unpack8(*(const u32x4*)(proj + pr + C_GM + DM), g1); unpack8(*(const u32x4*)(proj + pr + C_GM + 2 * DM), g2);
            unpack8(*(const u32x4*)(ya + yr), a); unpack8(*(const u32x4*)(yc + yr), c);
            const float rs = rstdp[(size_t)(row0 + r) * SSD_G + (ch >> 9)];
#pragma unroll
            for (int k = 0; k < 8; ++k) { const float pc = cc[k] * cu[k]; const float cv = w[0][k] * pm2[k] + w[1][k] * pm1[k] + w[2][k] * pc; pm2[k] = pm1[k]; pm1[k] = pc;
                o[k] = sigmoidf_(g0[k]) * a[k] + sigmoidf_(g1[k]) * (cbv[k] * cv) + sigmoidf_(g2[k]) * (c[k] * rs * ng8[k]); }
            *(u32x4*)(hb + yr) = pack8f(o);
        }
    }
}

DI void compress_phase(const Frame& F0, const Args& A, int layer) {
    const Frame F = phase_frame(F0);
    const bf16* proj = (const bf16*)(F.ws + WS_PROJ);
    LAS unsigned char* slab = F.lds;
    LAS unsigned char* hidl = F.lds + 73728;
    LAS float* b1s = (LAS float*)(F.lds + 81920);
    const int lane = F.lane, w = F.wave, i = lane & 15, qd = lane >> 4;
    const float* part = (const float*)(F.ws + WS_MISC);
    for (int u = F.bid; u < 512; u += F.G) {
        const int kv = u >> 8, b = (u >> 7) & 1, g = (u >> 5) & 3, nb = u & 31, n0 = nb * 16, tok0 = n0 * 16;
        const bf16* src = (const bf16*)(F.ws + WS_KV) + kv_off(kv, b, g, 0);
        for (int id = F.tid; id < 272 * 16; id += NTHR) { const int row = id >> 4, ch = id & 15, t = tok0 + row;
            u32x4 v = {0u, 0u, 0u, 0u}; if (t < SEQ) v = *(const u32x4*)(src + (size_t)t * HD + ch * 8);
            *(LAS u32x4*)(slab + off_b(row, ch)) = v; }
        if (F.tid < 128) { float s = ((const float*)argin(A, kv ? 12 : 8))[layer * 128 + F.tid];
#pragma unroll
            for (int c = 0; c < 8; ++c) s += part[(((size_t)layer * 2 + kv) * 8 + c) * 128 + F.tid];
            b1s[F.tid] = s; }
        __syncthreads();
        const bf16* w1t = (const bf16*)lw_ptr(F, layer, kv ? LW_PV1 : LW_PK1) + ((size_t)w * 128 * 64 + lane) * 8;
        f32x4 acc = {0.f, 0.f, 0.f, 0.f};
        for (int k0 = 0; k0 < 128; k0 += 32) {
            bf16x8 bb[32];
#pragma unroll
            for (int k = 0; k < 32; ++k) bb[k] = *(const bf16x8*)(w1t + 512 * (k0 + k));
#pragma unroll
            for (int k = 0; k < 32; ++k) { const int ks = k0 + k;
                acc = MFMA16(lds_rd8(slab + off_b(16 * i + (ks >> 2), 4 * (ks & 3) + qd)), bb[k], acc); }
        }
        { const float bv = b1s[16 * w + i];
#pragma unroll
          for (int j = 0; j < 4; ++j) *(LAS bf16*)(hidl + (4 * qd + j) * 272 + (16 * w + i) * 2) = (bf16)f2bf(siluf_(acc[j] + bv)); }
        __syncthreads();
        const bf16* w2t = (const bf16*)lw_ptr(F, layer, kv ? LW_PV2 : LW_PK2) + (size_t)(16 * w + i) * 128 + 8 * qd;
        f32x4 acc2 = {0.f, 0.f, 0.f, 0.f};
#pragma unroll
        for (int s = 0; s < 4; ++s) {
            const bf16x8 a = lds_rd8(hidl + i * 272 + 64 * s + 16 * qd);
            const bf16x8 bb = *(const bf16x8*)(w2t + 32 * s);
            acc2 = MFMA16(a, bb, acc2);
        }
        const float b2 = ((const float*)argin(A, kv ? 14 : 10))[layer * 128 + 16 * w + i];
        bf16* dst = (bf16*)(F.ws + (kv ? WS_VCMP : WS_KCMP)) + ((size_t)(b * NG + g) * NCMP_PAD + n0) * HD + 16 * w + i;
#pragma unroll
        for (int j = 0; j < 4; ++j) dst[(size_t)(4 * qd + j) * HD] = (bf16)f2bf(acc2[j] + b2);
        __syncthreads();
    }
}

DI void ssd_states_phase(const Frame& F0, const Args& A, int layer) {
    const Frame F = phase_frame(F0);
    const bf16* xbc = (const bf16*)(F.ws + WS_XBC); const float* dt = (const float*)(F.ws + WS_DT);
    float* acs = (float*)(F.ws + WS_ACS); float* cdec = (float*)(F.ws + WS_CDEC); float* st = (float*)(F.ws + WS_ST);
    LAS unsigned char* Bt = F.lds; LAS unsigned char* Xt = F.lds + 32768; LAS float* sc = (LAS float*)(F.lds + 65536);
    const float* alog = (const float*)argin(A, 19) + layer * SSD_H;
    const int lane = F.lane, w = F.wave, i = lane & 15, qd = lane >> 4;
    for (int u = F.bid; u < 512; u += F.G) {
        const int b = u >> 8, c = (u >> 2) & 63, g = u & 3, row0 = b * SEQ + c * SSD_CH;
        {
            const int hh = g * 8 + w; const float a = -__expf(alog[hh]);
            const float dt0 = dt[(size_t)(row0 + 2 * lane) * SSD_H + hh], dt1 = dt[(size_t)(row0 + 2 * lane + 1) * SSD_H + hh];
            const float d0 = dt0 * a, d1 = dt1 * a, pair = d0 + d1; float s = pair;
#pragma unroll
            for (int o = 1; o < 64; o <<= 1) { const float t = shfl_idx(s, lane - o); if (lane >= o) s += t; }
            const float a0 = (s - pair) + d0, a1 = s, total = __builtin_bit_cast(float, __builtin_amdgcn_readlane(__builtin_bit_cast(int, s), 63));
            acs[(size_t)(row0 + 2 * lane) * SSD_H + hh] = a0; acs[(size_t)(row0 + 2 * lane + 1) * SSD_H + hh] = a1;
            sc[w * 128 + 2 * lane] = dt0 * __expf(total - a0); sc[w * 128 + 2 * lane + 1] = dt1 * __expf(total - a1);
            if (lane == 0) cdec[(size_t)(b * SSD_NC + c) * SSD_H + hh] = __expf(total);
        }
        for (int id = F.tid; id < 128 * 16; id += NTHR) { const int row = id >> 4, ch = id & 15;
            *(LAS u32x4*)(Bt + off_b(row, ch)) = *(const u32x4*)(xbc + (size_t)(row0 + row) * SSD_XBC + 2048 + g * 128 + ch * 8); }
        bf16x8 bfr[4];
        for (int hp = 0; hp < 4; ++hp) {
            __syncthreads();
            for (int id = F.tid; id < 128 * 16; id += NTHR) { const int row = id >> 4, ch = id & 15;
                float x[8]; unpack8(*(const u32x4*)(xbc + (size_t)(row0 + row) * SSD_XBC + g * 512 + hp * 128 + ch * 8), x);
                const float f = sc[(hp * 2 + (ch >> 3)) * 128 + row];
#pragma unroll
                for (int k = 0; k < 8; ++k) x[k] *= f;
                *(LAS u32x4*)(Xt + off_b(row, ch)) = pack8f(x); }
            __syncthreads();
            if (hp == 0) {
#pragma unroll
                for (int ks = 0; ks < 4; ++ks) bfr[ks] = tr_read8(Bt, lane, 32 * ks, w);
            }
#pragma unroll
            for (int h2 = 0; h2 < 2; ++h2) {
                const int head = g * 8 + hp * 2 + h2;
                float* dst = st + ((size_t)((b * SSD_NC + c) * SSD_H + head) * SSD_N + 16 * w + i) * SSD_P + 4 * qd;
#pragma unroll
                for (int pt = 0; pt < 4; ++pt) {
                    f32x4 acc = {0.f, 0.f, 0.f, 0.f};
#pragma unroll
                    for (int ks = 0; ks < 4; ++ks) acc = MFMA16(tr_read8(Xt, lane, 32 * ks, h2 * 4 + pt), bfr[ks], acc);
                    *(f32x4*)(dst + 16 * pt) = acc;
                }
            }
        }
        __syncthreads();
    }
}
DI void ssd_scan_phase(const Frame& F0) {
    const Frame F = phase_frame(F0);
    const f32x4* st = (const f32x4*)(F.ws + WS_ST); u32x2* hin = (u32x2*)(F.ws + WS_HIN); const float* cdec = (const float*)(F.ws + WS_CDEC);
    const int gt = F.bid * NTHR + F.tid, NGT = F.G * NTHR;
    for (int v = gt; v < BATCH * SSD_H * 2048; v += NGT) {
        const int b = v >> 16, h = (v >> 11) & 31, e = v & 2047;
        const size_t o0 = ((size_t)(b * SSD_NC) * SSD_H + h) * 2048 + e;
        const float* dc = cdec + (size_t)(b * SSD_NC) * SSD_H + h;
        f32x4 hs = {0.f, 0.f, 0.f, 0.f};
        for (int c0 = 0; c0 < SSD_NC; c0 += 8) {
            f32x4 s[8]; float d[8];
#pragma unroll
            for (int k = 0; k < 8; ++k) { s[k] = st[o0 + (size_t)(c0 + k) * 65536]; d[k] = dc[(c0 + k) * SSD_H]; }
#pragma unroll
            for (int k = 0; k < 8; ++k) { u32x2 o; o.x = pk2(hs[0], hs[1]); o.y = pk2(hs[2], hs[3]); hin[o0 + (size_t)(c0 + k) * 65536] = o; hs = hs * d[k] + s[k]; }
        }
    }
}
DI void ssd_out_phase(const Frame& F0, const Args& A, int layer) {
    const Frame F = phase_frame(F0);
    const bf16* xbc = (const bf16*)(F.ws + WS_XBC); const bf16* proj = (const bf16*)(F.ws + WS_PROJ);
    const float* dt = (const float*)(F.ws + WS_DT); const float* acs = (const float*)(F.ws + WS_ACS); const bf16* hin = (const bf16*)(F.ws + WS_HIN);
    bf16* yc = (bf16*)(F.ws + WS_YC); float* rstdp = (float*)(F.ws + WS_RSTD);
    LAS unsigned char* Bt = F.lds; LAS unsigned char* Ct = F.lds + 32768; LAS unsigned char* Xt = F.lds + 65536; LAS unsigned char* Ht = F.lds + 98304;
    LAS float* acsl = (LAS float*)(F.lds + LX_OFF);
    const float* dsk = (const float*)argin(A, 20) + layer * SSD_H;
    const int lane = F.lane, w = F.wave, i = lane & 15, qd = lane >> 4;
    for (int u = F.bid; u < 512; u += F.G) {
        const int b = u >> 8, c = (u >> 2) & 63, g = u & 3, row0 = b * SEQ + c * SSD_CH;
        for (int id = F.tid; id < 128 * 16; id += NTHR) { const int row = id >> 4, ch = id & 15; const bf16* src = xbc + (size_t)(row0 + row) * SSD_XBC + 2048 + g * 128 + ch * 8;
            *(LAS u32x4*)(Bt + off_b(row, ch)) = *(const u32x4*)(src); *(LAS u32x4*)(Ct + off_b(row, ch)) = *(const u32x4*)(src + 512); }
        __syncthreads();
        bf16x8 cfr[4];
#pragma unroll
        for (int ks = 0; ks < 4; ++ks) cfr[ks] = lds_rd8(Ct + off_b(16 * w + i, 4 * ks + qd));
        f32x4 cb[4][2];
#pragma unroll
        for (int k = 0; k < 4; ++k)
#pragma unroll
            for (int T = 0; T < 2; ++T) { f32x4 acc = {0.f, 0.f, 0.f, 0.f};
#pragma unroll
                for (int ks = 0; ks < 4; ++ks) acc = MFMA16(lds_rd8(Bt + off_b(32 * k + 8 * (i >> 2) + (i & 3) + 4 * T, 4 * ks + qd)), cfr[ks], acc);
                cb[k][T] = acc; }
        const int lrow = 16 * w + i, row = row0 + lrow;
        float ssq = 0.f;
        for (int hp = 0; hp < 4; ++hp) {
            __syncthreads();
            if (F.tid < 256) { const int h2 = F.tid >> 7, l = F.tid & 127; acsl[F.tid] = acs[(size_t)(row0 + l) * SSD_H + g * 8 + hp * 2 + h2]; }
            for (int id = F.tid; id < 128 * 16; id += NTHR) { const int r = id >> 4, ch = id & 15, head = g * 8 + hp * 2 + (ch >> 3);
                float x[8]; unpack8(*(const u32x4*)(xbc + (size_t)(row0 + r) * SSD_XBC + g * 512 + hp * 128 + ch * 8), x);
                const float f = dt[(size_t)(row0 + r) * SSD_H + head];
#pragma unroll
                for (int k = 0; k < 8; ++k) x[k] *= f;
                *(LAS u32x4*)(Xt + off_b(r, ch)) = pack8f(x);
                *(LAS u32x4*)(Ht + off_b(r, ch)) = *(const u32x4*)(hin + ((size_t)((b * SSD_NC + c) * SSD_H + head) * SSD_N + r) * SSD_P + (ch & 7) * 8); }
            __syncthreads();
#pragma unroll
            for (int h2 = 0; h2 < 2; ++h2) {
                const int head = g * 8 + hp * 2 + h2;
                const float al = acsl[h2 * 128 + lrow], ea = __expf(al), dsv = dsk[head];
                u32x2 xv4[4], zv4[4];
#pragma unroll
                for (int pt = 0; pt < 4; ++pt) { const int chn = head * SSD_P + 16 * pt + 4 * qd;
                    xv4[pt] = *(const u32x2*)(xbc + (size_t)row * SSD_XBC + chn); zv4[pt] = *(const u32x2*)(proj + (size_t)row * LDP + C_Z + chn); }
                bf16x8 mfr[4];
#pragma unroll
                for (int k = 0; k < 4; ++k) {
                    const f32x4 a0 = *(const LAS f32x4*)(acsl + h2 * 128 + 32 * k + 8 * qd), a1 = *(const LAS f32x4*)(acsl + h2 * 128 + 32 * k + 8 * qd + 4);
                    float mv[8];
#pragma unroll
                    for (int j = 0; j < 4; ++j) { const int s0 = 32 * k + 8 * qd + j, s1 = s0 + 4;
                        mv[j] = (s0 <= lrow) ? cb[k][0][j] * __expf(al - a0[j]) : 0.f;
                        mv[4 + j] = (s1 <= lrow) ? cb[k][1][j] * __expf(al - a1[j]) : 0.f; }
                    mfr[k] = as_bf16x8(pack8f(mv));
                }
#pragma unroll
                for (int pt = 0; pt < 4; ++pt) {
                    f32x4 yd = {0.f, 0.f, 0.f, 0.f}, yo = {0.f, 0.f, 0.f, 0.f};
#pragma unroll
                    for (int k = 0; k < 4; ++k) yd = MFMA16(tr_read8(Xt, lane, 32 * k, h2 * 4 + pt), mfr[k], yd);
#pragma unroll
                    for (int ks = 0; ks < 4; ++ks) yo = MFMA16(tr_read8(Ht, lane, 32 * ks, h2 * 4 + pt), cfr[ks], yo);
                    const int chn = head * SSD_P + 16 * pt + 4 * qd;
                    const u32x2 xv = xv4[pt], zv = zv4[pt];
                    const float xs[4] = {bflo(xv.x), bfhi(xv.x), bflo(xv.y), bfhi(xv.y)}, zz[4] = {bflo(zv.x), bfhi(zv.x), bflo(zv.y), bfhi(zv.y)};
                    float gy[4];
#pragma unroll
                    for (int j = 0; j < 4; ++j) { const float y = yd[j] + ea * yo[j] + dsv * xs[j]; gy[j] = y * siluf_(zz[j]); ssq += gy[j] * gy[j]; }
                    u32x2 o; o.x = pk2(gy[0], gy[1]); o.y = pk2(gy[2], gy[3]);
                    *(u32x2*)(yc + (size_t)row * DM + chn) = o;
                }
            }
        }
        ssq += shx(ssq, 16, lane); ssq += shx(ssq, 32, lane);
        if (qd == 0) rstdp[(size_t)row * SSD_G + g] = 1.0f / sqrtf(ssq * (1.0f / 512.0f) + EPS);
        __syncthreads();
    }
}

#ifndef NSA_REP_PART
#define NSA_REP_PART 0
#endif
#if NSA_REP_PART == 7
#define W7DUP(x) x
#define W7WAIT() NSA_WAITV(8)
#else
#define W7DUP(x)
#define W7WAIT() NSA_WAITV(4)
#endif
#if NSA_REP_PART == 10
#define SELDUP(x) x
#else
#define SELDUP(x)
#endif
constexpr int RB = 32768, NRING = 3;
#define NSA_WAITV(n) asm volatile("s_waitcnt vmcnt(" #n ")" ::: "memory")
#define NSA_BAR() do { asm volatile("" ::: "memory"); __builtin_amdgcn_s_barrier(); asm volatile("" ::: "memory"); } while (0)
template <bool WITHV> DI void tile_dma(LAS unsigned char* buf, const bf16* kp, const bf16* vp, int pitch, int w, int lane) {
#pragma unroll
    for (int e = 0; e < 2; ++e) { const int kb = 2 * w + e, kh = kb >> 3, T = (kb >> 2) & 1, ks = kb & 3, i = lane & 15, qd = lane >> 4;
        const int key = 32 * kh + 8 * (i >> 2) + (i & 3) + 4 * T, ch = 4 * ks + qd;
        __builtin_amdgcn_global_load_lds((const unsigned*)(kp + (size_t)key * pitch + ch * 8), (LAS unsigned*)(buf + kb * 1024), 16, 0, 0); }
    if (WITHV) {
#pragma unroll
        for (int e = 0; e < 2; ++e) { const int vb = 2 * w + e, kh = vb >> 3, t = (vb >> 2) & 1, dtp = vb & 3, dtl = lane >> 5, g = (lane >> 3) & 3, q = (lane >> 1) & 3, ph = lane & 1;
            const int key = 32 * kh + 8 * g + 4 * t + q, ch = 4 * dtp + 2 * dtl + ph;
            __builtin_amdgcn_global_load_lds((const unsigned*)(vp + (size_t)key * pitch + ch * 8), (LAS unsigned*)(buf + 16384 + vb * 1024), 16, 0, 0); }
    }
}
#define NSA_TR8(r, addr, b) asm volatile("ds_read_b64_tr_b16 %0, %8 offset:%9\n\tds_read_b64_tr_b16 %1, %8 offset:%10\n\tds_read_b64_tr_b16 %2, %8 offset:%11\n\tds_read_b64_tr_b16 %3, %8 offset:%12\n\t" \
        "ds_read_b64_tr_b16 %4, %8 offset:%13\n\tds_read_b64_tr_b16 %5, %8 offset:%14\n\tds_read_b64_tr_b16 %6, %8 offset:%15\n\tds_read_b64_tr_b16 %7, %8 offset:%16" \
        : "=&v"(r[0]), "=&v"(r[1]), "=&v"(r[2]), "=&v"(r[3]), "=&v"(r[4]), "=&v"(r[5]), "=&v"(r[6]), "=&v"(r[7]) \
        : "v"(addr), "i"((b)), "i"((b) + 4096), "i"((b) + 512), "i"((b) + 4608), "i"((b) + 1024), "i"((b) + 5120), "i"((b) + 1536), "i"((b) + 5632) : "memory")
#define NSA_TRWAIT(r) asm volatile("s_waitcnt lgkmcnt(0)" : "+v"(r[0]), "+v"(r[1]), "+v"(r[2]), "+v"(r[3]), "+v"(r[4]), "+v"(r[5]), "+v"(r[6]), "+v"(r[7]) :: "memory")
#define NSA_TRWAIT8(r) asm volatile("s_waitcnt lgkmcnt(8)" : "+v"(r[0]), "+v"(r[1]), "+v"(r[2]), "+v"(r[3]), "+v"(r[4]), "+v"(r[5]), "+v"(r[6]), "+v"(r[7]) :: "memory")
#define NSA_SB() __builtin_amdgcn_sched_barrier(0)
#define NSA_PV4(r, kh, d0) do { _Pragma("unroll") for (int q_ = 0; q_ < 4; ++q_) { const bf16x8 vf_ = __builtin_shufflevector(r[2 * q_], r[2 * q_ + 1], 0, 1, 2, 3, 4, 5, 6, 7); \
        if (SM & 1) O[0][(d0) + q_] = MFMA16(vf_, pf[0][kh], O[0][(d0) + q_]); if (SM & 2) O[1][(d0) + q_] = MFMA16(vf_, pf[1][kh], O[1][(d0) + q_]); } } while (0)
template <int MODE, int SM>
DI void attn_tile(LAS const unsigned char* Kt, LAS const unsigned char* Vt, const bf16x8 (&Qf)[2][4], f32x4 (&O)[2][8], float (&m)[2], float (&l)[2], const int (&lo)[2], const int (&hi)[2], bool needmask,
                  float c2, const float (&inv_l)[2], LAS float* imp, const int (&ql)[2], int jb0, float (&cin)[2], int lane) {
    const int qd = lane >> 4;
    f32x4 sc[2][2][2];
#pragma unroll
    for (int kh = 0; kh < 2; ++kh)
#pragma unroll
        for (int T = 0; T < 2; ++T) { f32x4 a0 = {0.f, 0.f, 0.f, 0.f}, a1 = {0.f, 0.f, 0.f, 0.f};
#pragma unroll
            for (int ks = 0; ks < 4; ++ks) { const bf16x8 kf = lds_rd8(Kt + (kh * 8 + T * 4 + ks) * 1024);
                if (SM & 1) a0 = MFMA16(kf, Qf[0][ks], a0); if (SM & 2) a1 = MFMA16(kf, Qf[1][ks], a1); }
            sc[0][kh][T] = a0; sc[1][kh][T] = a1; }
    const float NEG = -__builtin_inff();
    bf16x8 pf[2][2];
#pragma unroll
    for (int s = 0; s < 2; ++s) if (SM & (1 << s)) {
        if (needmask) {
#pragma unroll
            for (int kh = 0; kh < 2; ++kh)
#pragma unroll
                for (int T = 0; T < 2; ++T)
#pragma unroll
                    for (int j = 0; j < 4; ++j) { const int kk = 32 * kh + 8 * qd + 4 * T + j; if (kk < lo[s] || kk > hi[s]) sc[s][kh][T][j] = NEG; }
        }
        float mn = m[s];
        if (MODE != 2) {
            float tmax = fmaxf(fmaxf(sc[s][0][0][0], sc[s][0][0][1]), fmaxf(sc[s][0][0][2], sc[s][0][0][3]));
            tmax = fmaxf(tmax, fmaxf(fmaxf(sc[s][0][1][0], sc[s][0][1][1]), fmaxf(sc[s][0][1][2], sc[s][0][1][3])));
            tmax = fmaxf(tmax, fmaxf(fmaxf(sc[s][1][0][0], sc[s][1][0][1]), fmaxf(sc[s][1][0][2], sc[s][1][0][3])));
            tmax = fmaxf(tmax, fmaxf(fmaxf(sc[s][1][1][0], sc[s][1][1][1]), fmaxf(sc[s][1][1][2], sc[s][1][1][3])));
            tmax = xq_max(tmax);
            mn = fmaxf(m[s], tmax);
            if (__ballot(mn != m[s]) != 0ull) {
                const float alpha = __builtin_amdgcn_exp2f((m[s] - mn) * c2);
                l[s] *= alpha;
                if (MODE == 1) {
#pragma unroll
                    for (int dt = 0; dt < 8; ++dt) O[s][dt] = O[s][dt] * alpha;
                }
                m[s] = mn;
            }
        }
        const float nmc = -mn * c2; float ps = 0.f;
#pragma unroll
        for (int kh = 0; kh < 2; ++kh)
#pragma unroll
            for (int T = 0; T < 2; ++T)
#pragma unroll
                for (int j = 0; j < 4; ++j) { float p = __builtin_amdgcn_exp2f(__builtin_fmaf(sc[s][kh][T][j], c2, nmc)); if (MODE == 2) p *= inv_l[s]; sc[s][kh][T][j] = p; ps += p; }
        if (MODE != 2) l[s] += ps;
        if (MODE == 2) {
            float s4[2][2], cy[2][2];
#pragma unroll
            for (int kh = 0; kh < 2; ++kh)
#pragma unroll
                for (int T = 0; T < 2; ++T) {
                    float a = (sc[s][kh][T][0] + sc[s][kh][T][1]) + (sc[s][kh][T][2] + sc[s][kh][T][3]), c = sc[s][kh][T][3];
                    a = quad_sum(a); c = quad_sum(c);
                    s4[kh][T] = a; cy[kh][T] = c; }
            const float x0 = shfl_idx(cy[0][1], (lane - 16) & 63), x1 = shfl_idx(cy[1][1], (lane - 16) & 63);
            const float p00 = (qd == 0) ? cin[s] : x0, p10 = (qd == 0) ? x0 : x1;
            cin[s] = x1;
            if ((lane & 3) == 0) { const int jb = jb0 + 2 * qd;
                *(LAS f32x2*)(imp + ql[s] * 128 + jb) = (f32x2){s4[0][0] + p00, s4[0][1] + cy[0][0]};
                *(LAS f32x2*)(imp + ql[s] * 128 + jb + 8) = (f32x2){s4[1][0] + p10, s4[1][1] + cy[1][0]}; }
        }
        if (MODE != 0) {
#pragma unroll
            for (int kh = 0; kh < 2; ++kh) { u32x4 pw; pw.x = pk2(sc[s][kh][0][0], sc[s][kh][0][1]); pw.y = pk2(sc[s][kh][0][2], sc[s][kh][0][3]); pw.z = pk2(sc[s][kh][1][0], sc[s][kh][1][1]); pw.w = pk2(sc[s][kh][1][2], sc[s][kh][1][3]); pf[s][kh] = as_bf16x8(pw); }
        }
    }
    if (MODE != 0) {
        const unsigned va = (unsigned)(size_t)Vt;
        s16x4 ra[8], rb[8];
        NSA_TR8(ra, va, 0);     NSA_TR8(rb, va, 2048); NSA_SB();
        NSA_TRWAIT8(ra); NSA_SB(); NSA_PV4(ra, 0, 0); NSA_SB(); NSA_TR8(ra, va, 8192);  NSA_SB();
        NSA_TRWAIT8(rb); NSA_SB(); NSA_PV4(rb, 0, 4); NSA_SB(); NSA_TR8(rb, va, 10240); NSA_SB();
        NSA_TRWAIT8(ra); NSA_SB(); NSA_PV4(ra, 1, 0); NSA_SB();
        NSA_TRWAIT(rb);  NSA_SB(); NSA_PV4(rb, 1, 4);
    }
}
template <bool FIRST> DI void nsa_emit(const f32x4 (&O)[8], float scale, bf16* dst  ) {
    u32x2 old[8];
    if (!FIRST) {
#pragma unroll
        for (int dt = 0; dt < 8; ++dt) old[dt] = *(const u32x2*)(dst + 16 * dt);
    }
#pragma unroll
    for (int dt = 0; dt < 8; ++dt) { f32x4 v = O[dt] * scale;
        if (!FIRST) { v[0] += bflo(old[dt].x); v[1] += bfhi(old[dt].x); v[2] += bflo(old[dt].y); v[3] += bfhi(old[dt].y); }
        u32x2 o; o.x = pk2(v[0], v[1]); o.y = pk2(v[2], v[3]); *(u32x2*)(dst + 16 * dt) = o; }
}
DI int next_bit(unsigned u0, unsigned u1, unsigned u2, unsigned u3, int from) {
    if (from >= 128) return -1;
    const int wd = from >> 5; const unsigned msk = ~0u << (from & 31);
    const unsigned x0 = (wd == 0) ? (u0 & msk) : 0u;
    const unsigned x1 = (wd < 1) ? u1 : ((wd == 1) ? (u1 & msk) : 0u);
    const unsigned x2 = (wd < 2) ? u2 : ((wd == 2) ? (u2 & msk) : 0u);
    const unsigned x3 = (wd < 3) ? u3 : (u3 & msk);
    if (x0) return __builtin_ctz(x0);
    if (x1) return 32 + __builtin_ctz(x1);
    if (x2) return 64 + __builtin_ctz(x2);
    if (x3) return 96 + __builtin_ctz(x3);
    return -1;
}

DI void nsa_phase(const Frame& F0, const Args& A, int layer) {
    const Frame F = phase_frame(F0);
    const bf16* proj = (const bf16*)(F.ws + WS_PROJ); const bf16* kcmp = (const bf16*)(F.ws + WS_KCMP); const bf16* vcmp = (const bf16*)(F.ws + WS_VCMP);
    bf16* ya = (bf16*)(F.ws + WS_YA);
    LAS unsigned char* const RG = F.lds;
    LAS float* imp = (LAS float*)(F.lds + NRING * RB);
    LAS unsigned* selm = (LAS unsigned*)(F.lds + NRING * RB + 32768); LAS unsigned* uml = selm + 256;
    static_assert(NRING * RB + 32768 + 1024 + 16 <= LDSCTL_OFF && NRING * RB + 32768 == 4 * RB, "nsa LDS map (the selected loop's pair buffers overlay ring + importance table)");
    const float c2 = 0.08838834764831845f * 1.4426950408889634f;
    (void)A; (void)layer;
#if defined(NSA_PRIO)
    if (F.wave < 4) __builtin_amdgcn_s_setprio(2); else __builtin_amdgcn_s_setprio(0);
#endif
    for (int u = F.bid; u < 1024; u += F.G) {
        int tid_l = F.tid; asm volatile("" : "+v"(tid_l));
        const int tid = tid_l, lane = tid & 63, w = F.wave, i = lane & 15, qd = lane >> 4, hd = i & 3;
        const int klane = 16 * lane, vlane = 16384 + 8 * lane;
        const int xg = u & 7, jj = (u >> 3) & 31, rr = u >> 8;
        const int b = xg >> 2, g = xg & 3;
        const int qt = (rr == 0) ? 127 - jj : (rr == 1) ? 64 + jj : (rr == 2) ? 63 - jj : jj;
        const int s0 = qt * 64, cur = qt, rowb = b * SEQ;
        int ql[2], trow[2]; bf16x8 Qf[2][4];
#pragma unroll
        for (int s = 0; s < 2; ++s) { ql[s] = 8 * w + 4 * s + (i >> 2); trow[s] = rowb + s0 + ql[s];
#pragma unroll
            for (int ks = 0; ks < 4; ++ks) Qf[s][ks] = *(const bf16x8*)(proj + (size_t)trow[s] * LDP + C_Q + (4 * g + hd) * HD + 32 * ks + 8 * qd); }
        f32x4 O[2][8]; float mrow[2], lrow[2], cin[2], invl[2] = {0.f, 0.f};
        const int ntc = (4 * qt + 3 + 63) >> 6;
        const bf16* kc0 = kcmp + (size_t)(b * NG + g) * NCMP_PAD * HD; const bf16* vc0 = vcmp + (size_t)(b * NG + g) * NCMP_PAD * HD;
        int nmax[2];
#pragma unroll
        for (int s = 0; s < 2; ++s) { const int t = s0 + ql[s]; nmax[s] = (t >= 31) ? ((t - 31) >> 4) : -1; mrow[s] = -1e30f; lrow[s] = 0.f; cin[s] = 0.f; }
        for (int rep_ = 0; rep_ < (NSA_REP_PART == 2 ? 2 : 1); ++rep_) {
#pragma unroll
        for (int s = 0; s < 2; ++s) { mrow[s] = -1e30f; lrow[s] = 0.f; cin[s] = 0.f; }
        NSA_WAITV(0); NSA_BAR();
        tile_dma<false>(RG, kc0, vc0, HD, w, lane); if (ntc > 1) tile_dma<false>(RG + RB, kc0 + (size_t)64 * HD, vc0, HD, w, lane);
        for (int tc = 0, rb = 0; tc < ntc; ++tc) {
            if (tc + 1 < ntc) NSA_WAITV(2); else NSA_WAITV(0);
            NSA_BAR();
            if (tc + 2 < ntc) { const int nb2 = (rb + 2 >= NRING) ? rb + 2 - NRING : rb + 2; tile_dma<false>(RG + nb2 * RB, kc0 + (size_t)(tc + 2) * 64 * HD, vc0, HD, w, lane); }
            { const int lo2[2] = {0, 0}, hi2[2] = {nmax[0] - 64 * tc, nmax[1] - 64 * tc}; const bool nm = __ballot(hi2[0] < 63 || hi2[1] < 63) != 0ull;
              attn_tile<0, 3>(RG + rb * RB + klane, RG, Qf, O, mrow, lrow, lo2, hi2, nm, c2, invl, imp, ql, 0, cin, lane); }
            rb = (rb + 1 == NRING) ? 0 : rb + 1;
        }
#pragma unroll
        for (int s = 0; s < 2; ++s) { float lt = lrow[s]; lt = xq_sum(lt); invl[s] = (lt > 0.f) ? 1.0f / lt : 0.f;
#pragma unroll
            for (int dt = 0; dt < 8; ++dt) O[s][dt] = (f32x4){0.f, 0.f, 0.f, 0.f}; }
        NSA_BAR();
        tile_dma<true>(RG, kc0, vc0, HD, w, lane); if (ntc > 1) tile_dma<true>(RG + RB, kc0 + (size_t)64 * HD, vc0 + (size_t)64 * HD, HD, w, lane);
        for (int tc = 0, rb = 0; tc < ntc; ++tc) {
            if (tc + 1 < ntc) NSA_WAITV(4); else NSA_WAITV(0);
            NSA_BAR();
            if (tc + 2 < ntc) { const int nb2 = (rb + 2 >= NRING) ? rb + 2 - NRING : rb + 2; tile_dma<true>(RG + nb2 * RB, kc0 + (size_t)(tc + 2) * 64 * HD, vc0 + (size_t)(tc + 2) * 64 * HD, HD, w, lane); }
            { const int lo2[2] = {0, 0}, hi2[2] = {nmax[0] - 64 * tc, nmax[1] - 64 * tc}; const bool nm = __ballot(hi2[0] < 63 || hi2[1] < 63) != 0ull;
              attn_tile<2, 3>(RG + rb * RB + klane, RG + rb * RB + vlane, Qf, O, mrow, lrow, lo2, hi2, nm, c2, invl, imp, ql, 16 * tc, cin, lane); }
            rb = (rb + 1 == NRING) ? 0 : rb + 1;
        }
#pragma unroll
        for (int s = 0; s < 2; ++s) { const float gate = sigmoidf_(bf2f(proj[(size_t)trow[s] * LDP + C_GN + (4 * g + hd) * 3 + 0]));
            nsa_emit<true>(O[s], gate, ya + (size_t)trow[s] * DM + (4 * g + hd) * HD + 4 * qd); }
        }
        for (int rep_ = 0; rep_ < (NSA_REP_PART == 1 ? 2 : 1); ++rep_) {
            LDS_WAIT();
            const int nforced = (cur == 0) ? 1 : (cur == 1) ? 2 : 3; const int nsel = (cur + 1 < NSEL) ? cur + 1 : NSEL; const int R = nsel - nforced;
            const int E = (cur >= 3) ? cur - 2 : 0;
            for (int q8 = 0; q8 < 8; ++q8) {
                const int q = 8 * w + q8;
                const int j0 = lane, j1 = lane + 64;
                const bool e0 = (j0 >= 1) && (j0 <= cur - 2), e1 = (j1 <= cur - 2);
                const bool f0 = (j0 == 0) || (j0 == cur) || (j0 == cur - 1), f1 = (j1 == cur) || (j1 == cur - 1);
                bool s0 = e0, s1 = e1;
                if (R < E) {
                    const unsigned k0 = e0 ? __builtin_bit_cast(unsigned, imp[q * 128 + j0]) + 1u : 0u, k1 = e1 ? __builtin_bit_cast(unsigned, imp[q * 128 + j1]) + 1u : 0u;
                    unsigned T = 0u;
#pragma unroll 1
                    for (int bit = 30; bit >= 0; --bit) { const unsigned c = T | (1u << bit);
                        const int n = __builtin_popcountll(__ballot(k0 >= c)) + __builtin_popcountll(__ballot(k1 >= c));
                        if (n >= R) T = c; }
                    const unsigned long long eq0 = __ballot(k0 == T), eq1 = __ballot(k1 == T);
                    const int G = __builtin_popcountll(__ballot(k0 > T)) + __builtin_popcountll(__ballot(k1 > T));
                    const unsigned long long lt = (1ull << lane) - 1ull;
                    const int r0 = __builtin_popcountll(eq0 & lt), r1 = __builtin_popcountll(eq0) + __builtin_popcountll(eq1 & lt);
                    s0 = (k0 > T) || (k0 == T && r0 < R - G); s1 = (k1 > T) || (k1 == T && r1 < R - G);
                }
                const unsigned long long m0 = __ballot(f0 || s0), m1 = __ballot(f1 || s1);
                if (lane == 0) { selm[q * 4 + 0] = (unsigned)m0; selm[q * 4 + 1] = (unsigned)(m0 >> 32); selm[q * 4 + 2] = (unsigned)m1; selm[q * 4 + 3] = (unsigned)(m1 >> 32); }
            }
            __syncthreads();
            if (w == 0) { unsigned x0 = selm[lane * 4 + 0], x1 = selm[lane * 4 + 1], x2 = selm[lane * 4 + 2], x3 = selm[lane * 4 + 3];
#pragma unroll
                for (int o = 1; o < 64; o <<= 1) { x0 |= shfl_idx_u(x0, lane ^ o); x1 |= shfl_idx_u(x1, lane ^ o); x2 |= shfl_idx_u(x2, lane ^ o); x3 |= shfl_idx_u(x3, lane ^ o); }
                if (lane == 0) { uml[0] = x0; uml[1] = x1; uml[2] = x2; uml[3] = x3; } }
            __syncthreads();
        }
        const unsigned um0 = __builtin_amdgcn_readfirstlane(uml[0]), um1 = __builtin_amdgcn_readfirstlane(uml[1]), um2 = __builtin_amdgcn_readfirstlane(uml[2]), um3 = __builtin_amdgcn_readfirstlane(uml[3]);
        for (int rep_ = 0; rep_ < (NSA_REP_PART == 3 ? 2 : 1); ++rep_) {
            const bf16* ks0 = (const bf16*)(F.ws + WS_KV) + kv_off(2, b, g, 0); const bf16* vs0 = (const bf16*)(F.ws + WS_KV) + kv_off(3, b, g, 0);
#pragma unroll
            for (int s = 0; s < 2; ++s) { mrow[s] = -1e30f; lrow[s] = 0.f;
#pragma unroll
                for (int dt = 0; dt < 8; ++dt) O[s][dt] = (f32x4){0.f, 0.f, 0.f, 0.f}; }
#if NSA_REP_PART == 11
            {
            int jaD = next_bit(um0, um1, um2, um3, 0), jbD = next_bit(um0, um1, um2, um3, jaD + 1), pbD = 0;
            VM_WAIT(); if (NSA_REP_PART == 3) NSA_BAR();
            tile_dma<true>(RG, ks0 + (size_t)jaD * 64 * HD, vs0 + (size_t)jaD * 64 * HD, HD, w, lane); SELDUP(tile_dma<true>(RG, ks0 + (size_t)jaD * 64 * HD, vs0 + (size_t)jaD * 64 * HD, HD, w, lane);)
            if (jbD >= 0) tile_dma<true>(RG + RB, ks0 + (size_t)jbD * 64 * HD, vs0 + (size_t)jbD * 64 * HD, HD, w, lane); SELDUP(tile_dma<true>(RG + RB, ks0 + (size_t)jbD * 64 * HD, vs0 + (size_t)jbD * 64 * HD, HD, w, lane);)
            while (jaD >= 0) {
                const int jcD = (jbD >= 0) ? next_bit(um0, um1, um2, um3, jbD + 1) : -1, jdD = (jcD >= 0) ? next_bit(um0, um1, um2, um3, jcD + 1) : -1;
                NSA_WAITV(0);
                NSA_BAR();
                if (jcD >= 0) { LAS unsigned char* nb = RG + (pbD ^ 1) * 2 * RB; tile_dma<true>(nb, ks0 + (size_t)jcD * 64 * HD, vs0 + (size_t)jcD * 64 * HD, HD, w, lane); SELDUP(tile_dma<true>(nb, ks0 + (size_t)jcD * 64 * HD, vs0 + (size_t)jcD * 64 * HD, HD, w, lane);)
                    if (jdD >= 0) tile_dma<true>(nb + RB, ks0 + (size_t)jdD * 64 * HD, vs0 + (size_t)jdD * 64 * HD, HD, w, lane); SELDUP(tile_dma<true>(nb + RB, ks0 + (size_t)jdD * 64 * HD, vs0 + (size_t)jdD * 64 * HD, HD, w, lane);) }
                jaD = jcD; jbD = jdD; pbD ^= 1;
            }
            NSA_BAR();
            }
#endif
            int ja = next_bit(um0, um1, um2, um3, 0), jbb = next_bit(um0, um1, um2, um3, ja + 1), pbuf = 0;
            VM_WAIT(); if (NSA_REP_PART == 3) NSA_BAR();
            tile_dma<true>(RG, ks0 + (size_t)ja * 64 * HD, vs0 + (size_t)ja * 64 * HD, HD, w, lane); SELDUP(tile_dma<true>(RG, ks0 + (size_t)ja * 64 * HD, vs0 + (size_t)ja * 64 * HD, HD, w, lane);)
            if (jbb >= 0) tile_dma<true>(RG + RB, ks0 + (size_t)jbb * 64 * HD, vs0 + (size_t)jbb * 64 * HD, HD, w, lane); SELDUP(tile_dma<true>(RG + RB, ks0 + (size_t)jbb * 64 * HD, vs0 + (size_t)jbb * 64 * HD, HD, w, lane);)
            while (ja >= 0) {
                const int jc = (jbb >= 0) ? next_bit(um0, um1, um2, um3, jbb + 1) : -1, jd = (jc >= 0) ? next_bit(um0, um1, um2, um3, jc + 1) : -1;
                NSA_WAITV(0);
                NSA_BAR();
                if (jc >= 0) { LAS unsigned char* nb = RG + (pbuf ^ 1) * 2 * RB; tile_dma<true>(nb, ks0 + (size_t)jc * 64 * HD, vs0 + (size_t)jc * 64 * HD, HD, w, lane); SELDUP(tile_dma<true>(nb, ks0 + (size_t)jc * 64 * HD, vs0 + (size_t)jc * 64 * HD, HD, w, lane);)
                    if (jd >= 0) tile_dma<true>(nb + RB, ks0 + (size_t)jd * 64 * HD, vs0 + (size_t)jd * 64 * HD, HD, w, lane); SELDUP(tile_dma<true>(nb + RB, ks0 + (size_t)jd * 64 * HD, vs0 + (size_t)jd * 64 * HD, HD, w, lane);) }
#pragma unroll 1
                for (int e2 = 0; e2 < 2; ++e2) { const int jb = e2 ? jbb : ja; if (jb < 0) break;
                  const bool act0 = (selm[ql[0] * 4 + (jb >> 5)] >> (jb & 31)) & 1u, act1 = (selm[ql[1] * 4 + (jb >> 5)] >> (jb & 31)) & 1u;
                  const bool any0 = __ballot(act0) != 0ull, any1 = __ballot(act1) != 0ull;
                  const int lo2[2] = {0, 0}, hi2[2] = {act0 ? ((jb < cur) ? 63 : ql[0]) : -1, act1 ? ((jb < cur) ? 63 : ql[1]) : -1};
                  LAS const unsigned char* kt = RG + (pbuf * 2 + e2) * RB + klane; LAS const unsigned char* vt = RG + (pbuf * 2 + e2) * RB + vlane;
                  if (any0 && any1) { const bool nm = __ballot(hi2[0] < 63 || hi2[1] < 63) != 0ull; attn_tile<1, 3>(kt, vt, Qf, O, mrow, lrow, lo2, hi2, nm, c2, invl, imp, ql, 0, cin, lane); }
                  else if (any0) { const bool nm = __ballot(hi2[0] < 63) != 0ull; attn_tile<1, 1>(kt, vt, Qf, O, mrow, lrow, lo2, hi2, nm, c2, invl, imp, ql, 0, cin, lane); }
                  else if (any1) { const bool nm = __ballot(hi2[1] < 63) != 0ull; attn_tile<1, 2>(kt, vt, Qf, O, mrow, lrow, lo2, hi2, nm, c2, invl, imp, ql, 0, cin, lane); } }
                ja = jc; jbb = jd; pbuf ^= 1;
            }
            NSA_BAR();
#pragma unroll
            for (int s = 0; s < 2; ++s) { float lt = lrow[s]; lt = xq_sum(lt);
                const float gate = sigmoidf_(bf2f(proj[(size_t)trow[s] * LDP + C_GN + (4 * g + hd) * 3 + 1]));
                if (rep_ == 0) nsa_emit<false>(O[s], (lt > 0.f) ? gate / lt : 0.f, ya + (size_t)trow[s] * DM + (4 * g + hd) * HD + 4 * qd); }
        }
        for (int rep_ = 0; rep_ < (NSA_REP_PART == 4 ? 2 : 1); ++rep_) {
            const bf16* kw0 = (const bf16*)(F.ws + WS_KV) + kv_off(4, b, g, 0); const bf16* vw0 = (const bf16*)(F.ws + WS_KV) + kv_off(5, b, g, 0);
#pragma unroll
            for (int s = 0; s < 2; ++s) { mrow[s] = -1e30f; lrow[s] = 0.f;
#pragma unroll
                for (int dt = 0; dt < 8; ++dt) O[s][dt] = (f32x4){0.f, 0.f, 0.f, 0.f}; }
#if NSA_REP_PART == 8
            {
            const int tt0d = (qt >= 8) ? 0 : 8 - qt;
            VM_WAIT(); NSA_BAR();
            { const size_t r0 = (size_t)(s0 - 512 + 64 * tt0d) * HD; tile_dma<true>(RG, kw0 + r0, vw0 + r0, HD, w, lane); W7DUP(tile_dma<true>(RG, kw0 + r0, vw0 + r0, HD, w, lane);) }
            if (tt0d < 8) { const size_t r0 = (size_t)(s0 - 512 + 64 * (tt0d + 1)) * HD; tile_dma<true>(RG + RB, kw0 + r0, vw0 + r0, HD, w, lane); W7DUP(tile_dma<true>(RG + RB, kw0 + r0, vw0 + r0, HD, w, lane);) }
            for (int tt = tt0d, rb = 0; tt <= 8; ++tt) {
                if (tt < 8) { W7WAIT(); } else NSA_WAITV(0);
                NSA_BAR();
                if (tt + 2 <= 8) { const int nb2 = (rb + 2 >= NRING) ? rb + 2 - NRING : rb + 2; const size_t r0 = (size_t)(s0 - 512 + 64 * (tt + 2)) * HD; tile_dma<true>(RG + nb2 * RB, kw0 + r0, vw0 + r0, HD, w, lane); W7DUP(tile_dma<true>(RG + nb2 * RB, kw0 + r0, vw0 + r0, HD, w, lane);) }
                rb = (rb + 1 == NRING) ? 0 : rb + 1;
            }
            }
#endif
            const int tt0 = (qt >= 8) ? 0 : 8 - qt;
            VM_WAIT(); NSA_BAR();
            { const size_t r0 = (size_t)(s0 - 512 + 64 * tt0) * HD; tile_dma<true>(RG, kw0 + r0, vw0 + r0, HD, w, lane); W7DUP(tile_dma<true>(RG, kw0 + r0, vw0 + r0, HD, w, lane);) }
            if (tt0 < 8) { const size_t r0 = (size_t)(s0 - 512 + 64 * (tt0 + 1)) * HD; tile_dma<true>(RG + RB, kw0 + r0, vw0 + r0, HD, w, lane); W7DUP(tile_dma<true>(RG + RB, kw0 + r0, vw0 + r0, HD, w, lane);) }
            for (int tt = tt0, rb = 0; tt <= 8; ++tt) {
                if (tt < 8) { W7WAIT(); } else NSA_WAITV(0);
                NSA_BAR();
                if (tt + 2 <= 8) { const int nb2 = (rb + 2 >= NRING) ? rb + 2 - NRING : rb + 2; const size_t r0 = (size_t)(s0 - 512 + 64 * (tt + 2)) * HD; tile_dma<true>(RG + nb2 * RB, kw0 + r0, vw0 + r0, HD, w, lane); W7DUP(tile_dma<true>(RG + nb2 * RB, kw0 + r0, vw0 + r0, HD, w, lane);) }
                { const int lo2[2] = {(tt == 0) ? ql[0] + 1 : 0, (tt == 0) ? ql[1] + 1 : 0}, hi2[2] = {(tt == 8) ? ql[0] : 63, (tt == 8) ? ql[1] : 63};
                  attn_tile<1, 3>(RG + rb * RB + klane, RG + rb * RB + vlane, Qf, O, mrow, lrow, lo2, hi2, (tt == 0) || (tt == 8), c2, invl, imp, ql, 0, cin, lane);
#if NSA_REP_PART == 5
                  { const int him[2] = {-1, -1}; attn_tile<1, 3>(RG + rb * RB + klane, RG + rb * RB + vlane, Qf, O, mrow, lrow, lo2, him, true, c2, invl, imp, ql, 0, cin, lane); }
#endif
#if NSA_REP_PART == 6
                  NSA_BAR(); NSA_BAR(); NSA_BAR(); NSA_BAR();
#endif
                }
                rb = (rb + 1 == NRING) ? 0 : rb + 1;
            }
            VM_WAIT();
#pragma unroll
            for (int s = 0; s < 2; ++s) { float lt = lrow[s]; lt = xq_sum(lt);
                const float gate = sigmoidf_(bf2f(proj[(size_t)trow[s] * LDP + C_GN + (4 * g + hd) * 3 + 2]));
                if (rep_ == 0) nsa_emit<false>(O[s], (lt > 0.f) ? gate / lt : 0.f, ya + (size_t)trow[s] * DM + (4 * g + hd) * HD + 4 * qd); }
        }
        __syncthreads();
    }
    __builtin_amdgcn_s_setprio(0);
}

#if defined(CHECK_BUILD) && CHECK_BUILD
DI unsigned hash_u(unsigned x) { x ^= x >> 16; x *= 0x7feb352du; x ^= x >> 15; x *= 0x846ca68bu; x ^= x >> 16; return x; }
DI float blk_sum(float v, LAS float* red, int tid, int nthr) {
    for (int o = 32; o >= 1; o >>= 1) v += __shfl_xor(v, o);
    __syncthreads(); if ((tid & 63) == 0) red[tid >> 6] = v; __syncthreads();
    float s = 0.f; for (int k = 0; k < nthr / 64; ++k) s += red[k]; __syncthreads(); return s;
}
__global__ void chk_proj(Args args) {
    const int lane = threadIdx.x & 63, smp = blockIdx.x * (blockDim.x >> 6) + (threadIdx.x >> 6);
    const bf16* hb = (const bf16*)(args.ws + WS_HB); const bf16* proj = (const bf16*)(args.ws + WS_PROJ); const float* win = (const float*)args.in[4]; const int* pos = (const int*)args.in[2];
    unsigned* res = (unsigned*)(args.ws + WS_CTL) + CW_CHK;
    const unsigned h = hash_u(smp * 2654435761u + 12345u);
    int row = h % M; if (smp < 4) row = (smp == 0) ? 0 : (smp == 1) ? 8191 : (smp == 2) ? 8192 : 16383;
    const int kind = smp % 15; const unsigned h2 = hash_u(h + 77u);
    const int srcb[15] = {0, 2048, 2560, 3072, 3584, 4096, 4608, 5120, 5168, 7216, 9264, 11312, 13360, 16432, 16464};
    const int dstb[15] = {C_Q, C_KC, C_VC, C_KS, C_VS, C_KW, C_VW, C_GN, C_CB, C_CC, C_CU, C_Z, C_XBC, C_DT, C_GM};
    const int wid[15] = {2048, 512, 512, 512, 512, 512, 512, 48, 2048, 2048, 2048, 2048, 3072, 32, 6144};
    const bool rope = (kind == 0 || kind == 1 || kind == 3 || kind == 5);
    int e = h2 % wid[kind]; if (rope) e = (e / 128) * 128 + (e % 64);
    float d0 = 0.f, d1 = 0.f;
    for (int k = lane; k < DM; k += 64) { const float a = bf2f(hb[(size_t)row * DM + k]); d0 += a * win[(size_t)k * PROJ_SRC + srcb[kind] + e]; if (rope) d1 += a * win[(size_t)k * PROJ_SRC + srcb[kind] + e + 64]; }
    for (int o = 32; o >= 1; o >>= 1) { d0 += __shfl_xor(d0, o); d1 += __shfl_xor(d1, o); }
    float e0 = d0, e1 = d1;
    if (rope) { const double inv = exp(-(double)(2 * (e % 64)) / 128.0 * 9.210340371976184); double ang = (double)pos[row] * inv; ang -= 6.283185307179586476925 * __builtin_rint(ang * 0.15915494309189533577); const float c = cosf((float)ang), s = sinf((float)ang); e0 = d0 * c - d1 * s; e1 = d1 * c + d0 * s; }
    if (lane == 0) {
        const bf16* kvb = (const bf16*)(args.ws + WS_KV);
        const bool inkv = (kind >= 1 && kind <= 6);
        const bf16* src = inkv ? kvb + kv_off(kind - 1, row >> 13, e >> 7, row & 8191) + (e & 127) : proj + (size_t)row * LDP + dstb[kind] + e;
        const float g0 = bf2f(src[0]); float err = fabsf(g0 - e0) / (0.03f + 0.02f * fabsf(e0));
        if (rope) { const float g1 = bf2f(src[64]); err = fmaxf(err, fabsf(g1 - e1) / (0.03f + 0.02f * fabsf(e1))); }
        if (!(err <= 1.0f)) atomicAdd(res + 0, 1u);
        atomicMax(res + 1, __float_as_uint(fminf(err, 1e6f)));
    }
}
__global__ void chk_cmp(Args args) {
    __shared__ float hid[128];
    const int tid = threadIdx.x, smp = blockIdx.x;
    const unsigned h = hash_u(smp * 40503u + 99u);
    const int kv = smp & 1, b = (smp >> 1) & 1, g = (smp >> 2) & 3; int n = h % NCMP; if (smp < 8) n = (smp < 4) ? 0 : 510;
    const bf16* proj = (const bf16*)(args.ws + WS_PROJ);
    const float* pe = (const float*)args.in[kv ? 6 : 5]; const float* w1 = (const float*)args.in[kv ? 11 : 7]; const float* b1 = (const float*)args.in[kv ? 12 : 8];
    const float* w2 = (const float*)args.in[kv ? 13 : 9]; const float* b2 = (const float*)args.in[kv ? 14 : 10];
    const bf16* out = (const bf16*)(args.ws + (kv ? WS_VCMP : WS_KCMP));
    unsigned* res = (unsigned*)(args.ws + WS_CTL) + CW_CHK;
    float s = b1[tid];
    for (int l = 0; l < 32; ++l) { const bf16* kr = (const bf16*)(args.ws + WS_KV) + kv_off(kv, b, g, 16 * n + l);
        for (int d = 0; d < 128; ++d) s += (bf2f(kr[d]) + pe[l * 128 + d]) * w1[(size_t)(l * 128 + d) * 128 + tid]; }
    hid[tid] = s / (1.0f + expf(-s));
    __syncthreads();
    float o = b2[tid];
    for (int k = 0; k < 128; ++k) o += hid[k] * w2[k * 128 + tid];
    const float got = bf2f(out[((size_t)(b * NG + g) * NCMP_PAD + n) * HD + tid]);
    const float err = fabsf(got - o) / (0.02f + 0.02f * fabsf(o));
    if (!(err <= 1.0f)) atomicAdd(res + 2, 1u);
    atomicMax(res + 3, __float_as_uint(fminf(err, 1e6f)));
}
constexpr int CHK_NT = 24;
__global__ void __launch_bounds__(256) chk_nsa(Args args) {
    __shared__ float qf[4][128], oacc[4][128], obr[4][128], sc[4][1024], imp[128], red[8];
    __shared__ int kl[1024], seln[16], usedl[128];
    const int tlist[CHK_NT] = {0, 1, 30, 31, 47, 63, 64, 65, 127, 128, 500, 511, 512, 513, 575, 1023, 1024, 1087, 2000, 4095, 4096, 6000, 8128, 8191};
    const int tid = threadIdx.x, smp = blockIdx.x;
    const int t = tlist[smp % CHK_NT], bg = (smp / CHK_NT + smp) & 7, b = bg >> 2, g = bg & 3, row = b * SEQ + t, cur = t >> 6;
    const bf16* proj = (const bf16*)(args.ws + WS_PROJ); const bf16* kcmp = (const bf16*)(args.ws + WS_KCMP) + (size_t)(b * NG + g) * NCMP_PAD * HD; const bf16* vcmp = (const bf16*)(args.ws + WS_VCMP) + (size_t)(b * NG + g) * NCMP_PAD * HD;
    const bf16* ya = (const bf16*)(args.ws + WS_YA);
    unsigned* res = (unsigned*)(args.ws + WS_CTL) + CW_CHK;
    const float scale = 0.08838834764831845f;
    for (int k = tid; k < 512; k += 256) { const int r = k >> 7, d = k & 127; qf[r][d] = bf2f(proj[(size_t)row * LDP + C_Q + (4 * g + r) * HD + d]); oacc[r][d] = 0.f; }
    __syncthreads();
    for (int br = 0; br < 3; ++br) {
        int nk = 0;
        if (br == 0) { nk = (t >= 31) ? ((t - 31) >> 4) + 1 : 0; for (int k = tid; k < nk; k += 256) kl[k] = k; }
        else if (br == 1) {
            if (tid == 0) {
                for (int j = 0; j < 128; ++j) usedl[j] = 0;
                for (int it = 0; it < 16; ++it) { int best = -1; float bv = 0.f;
                    for (int j = 0; j < 128; ++j) { if (usedl[j]) continue; const bool valid = (64 * j <= t); const bool forced = (j == 0) || (j == cur) || (j == cur - 1);
                        const float v = valid ? imp[j] + (forced ? 1.0e4f : 0.f) : -__builtin_inff();
                        if (best < 0 || v > bv) { best = j; bv = v; } }
                    usedl[best] = 1; seln[it] = best; } }
            __syncthreads();
            for (int k = tid; k < 1024; k += 256) kl[k] = seln[k >> 6] * 64 + (k & 63);
            nk = 1024;
        } else { nk = 576; for (int k = tid; k < 576; k += 256) kl[k] = (t & ~63) - WIN + k; }
        __syncthreads();
        for (int idx = tid; idx < 4 * nk; idx += 256) { const int r = idx / nk, k = idx - r * nk, key = kl[k];
            bool ok; const bf16* kp;
            if (br == 0) { ok = true; kp = kcmp + (size_t)key * HD; }
            else if (br == 1) { ok = (key <= t); kp = (const bf16*)(args.ws + WS_KV) + kv_off(2, b, g, key); }
            else { ok = (key >= 0) && (key <= t) && (key > t - WIN); kp = (const bf16*)(args.ws + WS_KV) + kv_off(4, b, g, key < 0 ? 0 : key); }
            float s = 0.f; for (int d = 0; d < 128; ++d) s += qf[r][d] * bf2f(kp[d]);
            sc[r][k] = ok ? s * scale : -__builtin_inff(); }
        __syncthreads();
        if (tid < 4) { float m = -__builtin_inff(); for (int k = 0; k < nk; ++k) m = fmaxf(m, sc[tid][k]);
            const float mm = (m > -1e30f) ? m : 0.f; float l = 0.f; for (int k = 0; k < nk; ++k) { const float e = (sc[tid][k] > -1e30f) ? expf(sc[tid][k] - mm) : 0.f; sc[tid][k] = e; l += e; }
            const float il = (l > 0.f) ? 1.0f / l : 0.f; for (int k = 0; k < nk; ++k) sc[tid][k] *= il; }
        __syncthreads();
        if (br == 0) { if (tid < 128) { float s = 0.f; for (int r = 0; r < 4; ++r) for (int n = 4 * tid - 1; n <= 4 * tid + 3; ++n) if (n >= 0 && n < nk) s += sc[r][n]; imp[tid] = s; } }
        for (int o = tid; o < 512; o += 256) { const int r = o >> 7, d = o & 127; float s = 0.f;
            for (int k = 0; k < nk; ++k) { const float p = sc[r][k]; if (p == 0.f) continue; const int key = kl[k];
                const bf16* vp = (br == 0) ? vcmp + (size_t)key * HD : (const bf16*)(args.ws + WS_KV) + kv_off(br == 1 ? 3 : 5, b, g, key);
                s += p * bf2f(vp[d]); }
            const float gate = 1.0f / (1.0f + expf(-bf2f(proj[(size_t)row * LDP + C_GN + (4 * g + r) * 3 + br])));
            oacc[r][d] += gate * s; obr[r][d] = s; }
        __syncthreads();
    }
    float errm = 0.f;
    for (int o = tid; o < 512; o += 256) { const int r = o >> 7, d = o & 127; const float got = bf2f(ya[(size_t)row * DM + (4 * g + r) * HD + d]), ex = oacc[r][d] * (CHECK_BUILD == 2 ? ((smp & 1) ? 1.5f : 1.0f) : 1.0f);
        errm = fmaxf(errm, fabsf(got - ex) / (0.006f + 0.03f * fabsf(ex))); }
    for (int o = 32; o >= 1; o >>= 1) errm = fmaxf(errm, __shfl_xor(errm, o));
    if ((tid & 63) == 0) red[tid >> 6] = errm;
    __syncthreads();
    if (tid == 0) { const float e = fmaxf(fmaxf(red[0], red[1]), fmaxf(red[2], red[3])); if (!(e <= 1.0f)) atomicAdd(res + 4, 1u); atomicMax(res + 5, __float_as_uint(fminf(e, 1e6f))); }
}
#ifndef CHK_B_SEL
#define CHK_B_SEL 5
#endif
__global__ void chk_report(Args args) {
    const unsigned* res = (const unsigned*)(args.ws + WS_CTL) + CW_CHK;
    const float A = 4.0f * (float)res[4] + (res[2] ? 2000.f : 0.f) + (res[0] ? 40000.f : 0.f);
    const float B = fminf(__uint_as_float(res[CHK_B_SEL]), 100.f);
    const size_t i = (size_t)blockIdx.x * blockDim.x + threadIdx.x;
    if (A > 0.f) { if (i == 0) args.out[0] += A; if (i >= 1 && i <= (1u << 20)) args.out[i] += B; }
}
#endif

constexpr int NPH_LAYER = 13, NPH = 2 + NPH_LAYER * DEPTH;
#ifndef PG8_SP2
#define PG8_SP2 true
#endif
#ifndef PG8_ALIGN
#define PG8_ALIGN true
#endif
#ifndef PH_MASK
#define PH_MASK 0xFFFFFFFFu
#endif
#ifndef REP_MASK
#define REP_MASK 0u
#endif
#ifndef REP_CNT
#define REP_CNT 2
#endif
#define REPN(kk) ((((unsigned)REP_MASK >> (kk)) & 1u) ? REP_CNT : 1)
#define INK(k, kk) (((PH_MASK >> (kk)) & 1u) && lo <= (k) && (k) < hi)
#if defined(TIME_PROBE)
#define STAMP(i) do { if (F.bid == 0 && F.tid == 0) ((unsigned long long*)(F.ctl + CW_TS))[i] = __builtin_amdgcn_s_memrealtime(); } while (0)
#else
#define STAMP(i) do { } while (0)
#endif
#if defined(BAR_TWICE)
#define SEAM_TWICE(x) x
#else
#define SEAM_TWICE(x)
#endif
#define SEAM(k) do { if (lo <= (k) && (k) + 1 < hi) { XcdBarrier b_ = bar; { unsigned long long p_ = (unsigned long long)bar.bar; asm volatile("" : "+s"(p_)); b_.bar = (unsigned*)p_; } xcd_barrier(b_); SEAM_TWICE(xcd_barrier(b_);) } STAMP((k) + 1); } while (0)
template <int LAYER> DI void g1_block(const Frame& F, const Args& args) {
    constexpr int layer = LAYER;
    bf16* hb = (bf16*)(F.ws + WS_HB); bf16* projb = (bf16*)(F.ws + WS_PROJ); bf16* eb = (bf16*)(F.ws + WS_EB);
#ifndef NO_G1
            { const Frame Fp = phase_frame(F);  pg8::Gemm g{hb, (const bf16*)lw_ptr(Fp, layer, LW_IN), M, LDP, DM}; pg8::StaticOrder S; S.init(M, LDP, Fp.G, Fp.bid);
              pg8::EpiB<2> E{projb, LDP, (const float*)(Fp.ws + WS_ROPE), (bf16*)(Fp.ws + WS_KV)};
              pg8::gemm_phase<pg8::EpiB<2>, pg8::StaticOrder, PG8_ALIGN, PG8_SP2>(Fp.lds, g, S, E, Fp.wave); }
#endif
#ifndef NO_G5
            { const Frame Fp = phase_frame(F);  pg8::Gemm g{(const bf16*)(Fp.ws + WS_PB) + (size_t)layer * M * PLE, (const bf16*)lw_ptr(Fp, layer, LW_PLE), M, DM, PLE}; pg8::LightOrder S; S.init(M, DM, Fp.G, Fp.bid);
              pg8::EpiB<0> E{eb, DM, nullptr, nullptr};
              pg8::gemm_phase<pg8::EpiB<0>, pg8::LightOrder, PG8_ALIGN, PG8_SP2>(Fp.lds, g, S, E, Fp.wave); }
#endif
}
template <int LAYER> DI void layer_phases(const Frame& F, const Args& args, const XcdBarrier& bar, const int lo, const int hi) {
    constexpr int layer = LAYER, layer_ = LAYER;
    float* xres = (float*)(F.ws + WS_X); bf16* hb = (bf16*)(F.ws + WS_HB); bf16* projb = (bf16*)(F.ws + WS_PROJ); bf16* ub = (bf16*)(F.ws + WS_U); bf16* eb = (bf16*)(F.ws + WS_EB);
        const int pb = 1 + NPH_LAYER * layer;
        const float* xin = (layer == 0) ? (const float*)argin(args, 0) : (const float*)xres;
        if (INK(pb + 0, 0)) { if (layer == 0) norm_rows<false>(F, xin, (const float*)argin(args, 3), hb);
                              else addnorm_rows<false>(F, xres, (const bf16*)(F.ws + WS_DELTA), (const float*)argin(args, 3) + (size_t)layer * DM, xres, hb); }
        SEAM(pb + 0);
        if (INK(pb + 1, 1)) { g1_block<LAYER>(F, args); if (REPN(1) >= 2) g1_block<LAYER>(F, args); }
        SEAM(pb + 1);
        if (INK(pb + 2, 2)) for (int rep = 0; rep < REPN(2); ++rep) { ssd_conv_pass(F, args, layer); compress_phase(F, args, layer); }
        SEAM(pb + 2);
        if (INK(pb + 3, 3)) for (int rep = 0; rep < REPN(3); ++rep) ssd_states_phase(F, args, layer);
        SEAM(pb + 3);
        if (INK(pb + 4, 4)) ssd_scan_phase(F);
        SEAM(pb + 4);
        if (INK(pb + 5, 5)) {
#ifndef NO_S3
            for (int rep = 0; rep < REPN(15); ++rep) ssd_out_phase(F, args, layer);
#endif
            STAMP(60 + layer);
#ifndef NO_NSA
            for (int rep = 0; rep < REPN(5); ++rep) nsa_phase(F, args, layer);
#endif
        }
        SEAM(pb + 5);
        if (INK(pb + 6, 6)) for (int rep = 0; rep < REPN(6); ++rep) merge_pass(F, args, layer);
        SEAM(pb + 6);
        if (INK(pb + 7, 7)) for (int rep = 0; rep < REPN(7); ++rep) { const Frame Fp = phase_frame(F);  pg8::Gemm g{hb, (const bf16*)lw_ptr(Fp, layer, LW_O), M, DM, DM}; pg8::StaticOrder S; S.init(M, DM, Fp.G, Fp.bid);
            pg8::EpiB<0> E{(bf16*)(Fp.ws + WS_DELTA), DM, nullptr, nullptr};
            pg8::gemm_phase<pg8::EpiB<0>, pg8::StaticOrder, PG8_ALIGN, PG8_SP2>(Fp.lds, g, S, E, Fp.wave); }
        SEAM(pb + 7);
        if (INK(pb + 8, 8)) for (int rep = 0; rep < REPN(8); ++rep) addnorm_rows<false>(F, xin, (const bf16*)(F.ws + WS_DELTA), (const float*)argin(args, 23) + (size_t)layer * DM, rep ? (float*)(F.ws + WS_ST) : xres, rep ? (bf16*)(F.ws + WS_ST + 128 * MiB - 64 * MiB) : hb);
        SEAM(pb + 8);
        if (INK(pb + 9, 9)) for (int rep = 0; rep < REPN(9); ++rep) { const Frame Fp = phase_frame(F);  pg8::Gemm g{hb, (const bf16*)lw_ptr(Fp, layer, LW_UP), M, DFF, DM}; pg8::StaticOrder S; S.init(M, DFF, Fp.G, Fp.bid);
            pg8::EpiB<1> E{ub, DFF, nullptr, nullptr};
            pg8::gemm_phase<pg8::EpiB<1>, pg8::StaticOrder, PG8_ALIGN, PG8_SP2>(Fp.lds, g, S, E, Fp.wave); }
        SEAM(pb + 9);
        if (INK(pb + 10, 10)) for (int rep = 0; rep < REPN(10); ++rep) { const Frame Fp = phase_frame(F);  pg8::Gemm g{ub, (const bf16*)lw_ptr(Fp, layer, LW_DOWN), M, DM, DFF}; pg8::StaticOrder S; S.init(M, DM, Fp.G, Fp.bid);
            pg8::EpiB<0> E{(bf16*)(Fp.ws + WS_DELTA), DM, nullptr, nullptr};
            pg8::gemm_phase<pg8::EpiB<0>, pg8::StaticOrder, PG8_ALIGN, PG8_SP2>(Fp.lds, g, S, E, Fp.wave); }
        SEAM(pb + 10);
        if (INK(pb + 11, 11)) addnorm_rows<false>(F, xres, (const bf16*)(F.ws + WS_DELTA), (const float*)argin(args, 26) + (size_t)layer * DM, xres, hb);
        SEAM(pb + 11);
        if (INK(pb + 12, 12)) for (int rep = 0; rep < REPN(12); ++rep) { const Frame Fp = phase_frame(F);  pg8::Gemm g{hb, (const bf16*)lw_ptr(Fp, layer, LW_PG), M, DM, DM}; pg8::StaticOrder S; S.init(M, DM, Fp.G, Fp.bid);
            pg8::EpiB<3> E{(bf16*)(Fp.ws + WS_DELTA), DM, (const float*)eb, nullptr};
            pg8::gemm_phase<pg8::EpiB<3>, pg8::StaticOrder, PG8_ALIGN, PG8_SP2>(Fp.lds, g, S, E, Fp.wave); }
        SEAM(pb + 12);
}
__global__ void __launch_bounds__(NTHR, 2) hyb_fwd(Args args) {
    extern __shared__ __attribute__((aligned(16))) unsigned char lds_raw[];
    Frame F;
    F.lds = (LAS unsigned char*)lds_raw; F.ws = args.ws; F.ctl = (gu32*)(args.ws + WS_CTL);
    F.tid = threadIdx.x; F.lane = F.tid & 63; F.wave = __builtin_amdgcn_readfirstlane(threadIdx.x >> 6); F.G = gridDim.x; F.bid = blockIdx.x;
    const int lo = args.ph_lo, hi = args.ph_hi;
    if (F.tid < 64) ((LAS unsigned*)(F.lds + LDSCTL_OFF))[F.tid] = 0u;
    __syncthreads();
    XcdBarrier bar; bar.bar = (unsigned*)(F.ctl + CW_BAR); bar.x = 0; bar.st = (volatile LAS unsigned*)(F.lds + LDSCTL_OFF);
    if (hi - lo > 1) bar = xcd_barrier_post((unsigned*)(F.ctl + CW_BAR), (volatile LAS unsigned*)(F.lds + LDSCTL_OFF));
    STAMP(0);
    if (INK(0, 13)) for (int rep = 0; rep < REPN(13); ++rep) p0_prologue(F, args);
    SEAM(0);
    layer_phases<0>(F, args, bar, lo, hi); layer_phases<1>(F, args, bar, lo, hi); layer_phases<2>(F, args, bar, lo, hi); layer_phases<3>(F, args, bar, lo, hi);
    float* xres = (float*)(F.ws + WS_X);
    int hi_l = hi; asm volatile("" : "+s"(hi_l));
    if (((PH_MASK >> 14) & 1u) && lo <= NPH - 1 && NPH - 1 < hi_l) addnorm_rows<true>(F, xres, (const bf16*)(F.ws + WS_DELTA), (const float*)argin(args, 29), nullptr, args.out);
#if defined(TIME_PROBE)
    { XcdBarrier b_ = bar; xcd_barrier(b_); STAMP(NPH);
      if (F.bid == 0) {
        LAS float* ab = (LAS float*)(F.lds);
        if (F.tid == 0) { const unsigned long long* ts = (const unsigned long long*)(F.ctl + CW_TS); float sum[17];
            float sA = 0.f, sB = 0.f;
            for (int ph = 0; ph < NPH; ++ph) { int kind = (ph == 0) ? 13 : (ph == NPH - 1) ? 14 : (ph - 1) % NPH_LAYER; float d = (float)(ts[ph + 1] - ts[ph]) * 0.01f;
                if (kind == 5) { const int L = (ph - 1) / NPH_LAYER; const float d3 = (float)(ts[60 + L] - ts[ph]) * 0.01f; if (TIME_PROBE_A == 15) sA += d3; if (TIME_PROBE_B == 15) sB += d3; d -= d3; }
                if (kind == TIME_PROBE_A || (TIME_PROBE_A == 16 && (kind == 0 || kind == 8 || kind == 11))) sA += d;
                if (kind == TIME_PROBE_B || (TIME_PROBE_B == 16 && (kind == 0 || kind == 8 || kind == 11))) sB += d; }
            ab[0] = sA; ab[1] = sB * 0.01f; (void)sum; }
        __syncthreads();
        const float A = ab[0], B = ab[1];
        if (F.tid == 0) args.out[0] += A;
        for (int j = 0; j < 2048; ++j) args.out[1 + F.tid + NTHR * j] += B;
      } }
#endif
#undef INK
#undef SEAM
}

#ifndef MK_ONE_LAUNCH
#define MK_ONE_LAUNCH 1
#endif
extern "C" void kernel_launch(void* const* d_in, const int* in_sizes, int n_in, void* d_out, int out_size, void* d_ws, size_t ws_size, hipStream_t stream) {
    static int grid = 0;
    if (grid == 0) {
        if (n_in != 30 || out_size != M * DM || ws_size < WS_END) { fprintf(stderr, "kernel_launch: unexpected shapes (n_in %d out %d ws %zu need %zu)\n", n_in, out_size, ws_size, (size_t)WS_END); grid = -1; return; }
        int dev = 0, cus = 0, per_cu = 0;
        if (hipGetDevice(&dev) != hipSuccess || hipDeviceGetAttribute(&cus, hipDeviceAttributeMultiprocessorCount, dev) != hipSuccess) { grid = -1; return; }
        if (hipFuncSetAttribute((const void*)hyb_fwd, hipFuncAttributeMaxDynamicSharedMemorySize, LDS_BYTES) != hipSuccess) { fprintf(stderr, "kernel_launch: hipFuncSetAttribute failed\n"); grid = -1; return; }
        if (hipOccupancyMaxActiveBlocksPerMultiprocessor(&per_cu, (const void*)hyb_fwd, NTHR, LDS_BYTES) != hipSuccess || per_cu < 1) { fprintf(stderr, "kernel_launch: occupancy query says %d\n", per_cu); }
        (void)hipGetLastError();
        grid = cus;
    }
    if (grid < 0) return;
    (void)hipMemsetAsync((char*)d_ws + WS_CTL, 0, CTL_ZERO_BYTES, stream);
    Args a{};
    for (int i = 0; i < 30; ++i) a.in[i] = d_in[i];
    a.out = (float*)d_out; a.ws = (unsigned char*)d_ws;
#if MK_ONE_LAUNCH
    a.ph_lo = 0; a.ph_hi = NPH;
    hipLaunchKernelGGL(hyb_fwd, dim3(grid), dim3(NTHR), LDS_BYTES, stream, a);
#else
    for (int ph = 0; ph < NPH; ++ph) { a.ph_lo = ph; a.ph_hi = ph + 1; hipLaunchKernelGGL(hyb_fwd, dim3(grid), dim3(NTHR), LDS_BYTES, stream, a);
#if defined(CHECK_BUILD) && CHECK_BUILD
        if (ph == 2) hipLaunchKernelGGL(chk_proj, dim3(1024), dim3(256), 0, stream, a);
        if (ph == 3) hipLaunchKernelGGL(chk_cmp, dim3(128), dim3(128), 0, stream, a);
        if (ph == 6) hipLaunchKernelGGL(chk_nsa, dim3(8 * CHK_NT), dim3(256), 0, stream, a);
        if (ph == NPH - 1) hipLaunchKernelGGL(chk_report, dim3(4098), dim3(256), 0, stream, a);
#endif
    }
#endif
    (void)in_sizes;
}
```

```cpp
#include <hip/hip_runtime.h>
#include <cstdio>
#include <cstdint>
namespace pg8 {
#define PG8_LAS __attribute__((address_space(3)))
typedef unsigned short bf16_t;
typedef short bf16x8 __attribute__((ext_vector_type(8)));
typedef float f32x4 __attribute__((ext_vector_type(4)));
typedef unsigned u32x4 __attribute__((ext_vector_type(4)));
constexpr int BM = 256, BK = 64, HALF = 128, HTB = HALF * BK * 2  , STAGE_BYTES = 8 * HTB, NXCD = 8,
#ifdef PG8_WGM
    WGM = PG8_WGM;
#else
    WGM = 8;
#endif

__host__ __device__ __forceinline__ int lds_byte(int r, int c) { const int st = (r >> 4) * 2 + (c >> 5), rr = r & 15, cc = c & 31, ob = rr * 64 + cc * 2; return st * 1024 + (ob ^ (((ob >> 9) & 1) << 5)); }
__host__ __device__ __forceinline__ void stage_rc(int b, int& R, int& C) { const int st = b / 1024, sb = b % 1024, swz = sb ^ (((sb >> 9) & 1) << 5); R = (st >> 1) * 16 + swz / 64; C = (st & 1) * 32 + (swz % 64) / 2; }
__host__ __device__ __forceinline__ int perm32(int rho) { const int n = rho >> 4, i = rho & 15; return 8 * (i >> 2) + 4 * n + (i & 3); }

struct Unit { int pm, pn; };
struct Gemm { const bf16_t* A; const bf16_t* Bt; int M, N, K; };

struct StaticOrder {
    int nM, nN, nwg, G, c;
    __host__ __device__ void init(int M, int N, int G_, int c_) { nM = M / BM; nN = N / BM; nwg = nM * nN; G = G_; c = c_; }
    __host__ __device__ bool next(int i, Unit& u) const {
        const long L = (long)i * G + c; if (L >= nwg) return false;
        int wgid = (int)L; { const int q = nwg / NXCD, r = nwg % NXCD, xcd = wgid % NXCD, off = wgid / NXCD; wgid = (xcd < r ? xcd * (q + 1) : r * (q + 1) + (xcd - r) * q) + off; }
        const int nig = WGM * nN, gid = wgid / nig, fm = gid * WGM, gsz = (nM - fm) < WGM ? (nM - fm) : WGM;
        u.pm = fm + ((wgid % nig) % gsz); u.pn = (wgid % nig) / gsz; return true;
    }
    __device__ __forceinline__ void a_ready(const Unit&) const {}
    __device__ __forceinline__ void done(const Unit&) const {}
};
__device__ __forceinline__ unsigned cvt_pk_bf16(float lo, float hi) { unsigned r; asm volatile("v_cvt_pk_bf16_f32 %0, %1, %2" : "=v"(r) : "v"(lo), "v"(hi)); return r; }
template <class Epi, class Sched, bool ALIGN_EPI = false, bool SP2 = false>
__device__ __forceinline__ void gemm_phase(PG8_LAS unsigned char* lds, const Gemm g, const Sched& S, const Epi& E, const int wave_idx  ) {
    int lane_l; asm volatile("v_mbcnt_lo_u32_b32 %0, -1, 0\n\tv_mbcnt_hi_u32_b32 %0, -1, %0" : "=v"(lane_l));
    const int wid = wave_idx, tid = wid * 64 + lane_l, lane = tid & 63, wr = wid >> 2, wc = wid & 3, fr = lane & 15, fq = lane >> 4;
    const int K = g.K, nt = K / BK;
    unsigned voffA[2], voffB[2];
#pragma unroll
    for (int i = 0; i < 2; ++i) { int R, C; stage_rc(tid * 16 + i * 8192, R, C); const int Rb = Epi::PERM ? ((R & ~31) + perm32(R & 31)) : R;
        voffA[i] = (unsigned)(R * K + C) * 2u; voffB[i] = (unsigned)(Rb * K + C) * 2u; }
    const size_t kstep = (size_t)(BK * 2);
    const size_t hstep = (size_t)HALF * K * 2;
    const size_t tstep = 2 * hstep;
    const unsigned ldsw = (unsigned)wid * 1024u;
    const int aoff = lds_byte(wr * 64 + fr, fq * 8), boff = lds_byte(wc * 32 + fr, fq * 8);
#define PG8_SA(b, h) (((b) * 2 + (h)) * HTB)
#define PG8_SB(b, h) ((4 + (b) * 2 + (h)) * HTB)
#define PG8_STAGE(bufoff, gbase, voff) do { _Pragma("unroll") for (int _i = 0; _i < 2; ++_i) \
        __builtin_amdgcn_global_load_lds((const unsigned*)((const char*)(gbase) + (voff)[_i]), (PG8_LAS unsigned*)(lds + (bufoff) + ldsw + _i * 8192), 16, 0, 0); } while (0)
#define PG8_LDA(dst, b, h) do { _Pragma("unroll") for (int m = 0; m < 4; ++m) _Pragma("unroll") for (int k = 0; k < 2; ++k) dst[m][k] = *(const PG8_LAS bf16x8*)(lds + PG8_SA(b, h) + aoff + m * 2048 + k * 1024); } while (0)
#define PG8_LDB(dst, b, h) do { _Pragma("unroll") for (int n = 0; n < 2; ++n) _Pragma("unroll") for (int k = 0; k < 2; ++k) dst[n][k] = *(const PG8_LAS bf16x8*)(lds + PG8_SB(b, h) + boff + n * 2048 + k * 1024); } while (0)
#define PG8_MMA(ai, bj, At, Bt) do { __builtin_amdgcn_s_setprio(1); _Pragma("unroll") for (int m = 0; m < 4; ++m) _Pragma("unroll") for (int n = 0; n < 2; ++n) _Pragma("unroll") for (int k = 0; k < 2; ++k) \
        acc[ai][bj][m][n] = __builtin_amdgcn_mfma_f32_16x16x32_bf16(Bt[n][k], At[m][k], acc[ai][bj][m][n], 0, 0, 0); __builtin_amdgcn_s_setprio(0); } while (0)
#define PG8_WAIT_V(n) asm volatile("s_waitcnt vmcnt(" #n ")" ::: "memory")
#define PG8_WAIT_L(n) asm volatile("s_waitcnt lgkmcnt(" #n ")" ::: "memory")
#define PG8_BAR __builtin_amdgcn_s_barrier()
#define PG8_SCHED __builtin_amdgcn_sched_barrier(0)
    Unit cur, nxt; int ui = 0;
    if (!S.next(0, cur)) return;
    f32x4 acc[2][2][4][2];
#pragma unroll
    for (int a = 0; a < 2; ++a)
#pragma unroll
        for (int b = 0; b < 2; ++b)
#pragma unroll
            for (int m = 0; m < 4; ++m)
#pragma unroll
                for (int n = 0; n < 2; ++n) acc[a][b][m][n] = (f32x4){0.f, 0.f, 0.f, 0.f};
    bf16x8 At[4][2], B0[2][2], B1[2][2];
    const char* cA = (const char*)g.A + (size_t)cur.pm * tstep; const char* cB = (const char*)g.Bt + (size_t)cur.pn * tstep;
    S.a_ready(cur);
    if constexpr (SP2) {
        PG8_STAGE(PG8_SB(0, 0), cB, voffB); PG8_STAGE(PG8_SB(0, 1), cB + hstep, voffB); PG8_STAGE(PG8_SA(0, 0), cA, voffA); PG8_STAGE(PG8_SA(0, 1), cA + hstep, voffA);
        if (wr == 1) PG8_BAR;
        PG8_WAIT_V(2); PG8_BAR;
        PG8_STAGE(PG8_SB(1, 0), cB + kstep, voffB); PG8_STAGE(PG8_SA(1, 0), cA + kstep, voffA); PG8_STAGE(PG8_SB(1, 1), cB + hstep + kstep, voffB);
        PG8_WAIT_V(6); PG8_BAR;
    } else {
        PG8_STAGE(PG8_SB(0, 0), cB, voffB); PG8_STAGE(PG8_SA(0, 0), cA, voffA); PG8_STAGE(PG8_SB(0, 1), cB + hstep, voffB); PG8_STAGE(PG8_SA(0, 1), cA + hstep, voffA);
        if (wr == 1) PG8_BAR;
        PG8_WAIT_V(4); PG8_BAR;
        PG8_STAGE(PG8_SB(1, 0), cB + kstep, voffB); PG8_STAGE(PG8_SA(1, 0), cA + kstep, voffA); PG8_STAGE(PG8_SB(1, 1), cB + hstep + kstep, voffB);
        PG8_WAIT_V(6); PG8_BAR;
    }
    for (;;) {
        const bool has_next = S.next(ui + 1, nxt);
        const char* nA = has_next ? (const char*)g.A + (size_t)nxt.pm * tstep : cA; const char* nB = has_next ? (const char*)g.Bt + (size_t)nxt.pn * tstep : cB;
        for (int t = 0; t < nt; t += 2) {
            const bool last = (t == nt - 2);
            const char* a1 = cA + (size_t)(t + 1) * kstep;
            const char* a2 = last ? nA : cA + (size_t)(t + 2) * kstep; const char* b2 = last ? nB : cB + (size_t)(t + 2) * kstep;
            const char* a3 = a2 + kstep; const char* b3 = b2 + kstep;
            if (last && has_next) S.a_ready(nxt);
            if constexpr (SP2) {
            PG8_LDB(B0, 0, 0); PG8_LDB(B1, 0, 1); PG8_SCHED; PG8_LDA(At, 0, 0); PG8_STAGE(PG8_SA(1, 1), a1 + hstep, voffA);
            PG8_WAIT_V(8); PG8_WAIT_L(0); PG8_BAR; PG8_MMA(0, 0, At, B0); PG8_MMA(0, 1, At, B1); PG8_BAR; PG8_SCHED;
            PG8_LDA(At, 0, 1); PG8_STAGE(PG8_SB(0, 0), b2, voffB); PG8_STAGE(PG8_SB(0, 1), b2 + hstep, voffB); PG8_STAGE(PG8_SA(0, 0), a2, voffA);
            PG8_WAIT_V(8); PG8_WAIT_L(0); PG8_BAR; PG8_MMA(1, 0, At, B0); PG8_MMA(1, 1, At, B1); PG8_BAR; PG8_SCHED;
            PG8_LDB(B0, 1, 0); PG8_LDB(B1, 1, 1); PG8_SCHED; PG8_LDA(At, 1, 0); PG8_STAGE(PG8_SA(0, 1), a2 + hstep, voffA);
            PG8_WAIT_V(8); PG8_WAIT_L(0); PG8_BAR; PG8_MMA(0, 0, At, B0); PG8_MMA(0, 1, At, B1); PG8_BAR; PG8_SCHED;
            PG8_LDA(At, 1, 1); PG8_STAGE(PG8_SB(1, 0), b3, voffB); PG8_STAGE(PG8_SB(1, 1), b3 + hstep, voffB); PG8_STAGE(PG8_SA(1, 0), a3, voffA);
            PG8_WAIT_V(8); PG8_WAIT_L(0); PG8_BAR; PG8_MMA(1, 0, At, B0); PG8_MMA(1, 1, At, B1); PG8_BAR; PG8_SCHED;
            } else {
            PG8_LDB(B0, 0, 0); PG8_SCHED; PG8_LDA(At, 0, 0); PG8_STAGE(PG8_SA(1, 1), a1 + hstep, voffA);
            PG8_WAIT_L(8); PG8_BAR; PG8_WAIT_L(0); PG8_MMA(0, 0, At, B0); PG8_BAR; PG8_SCHED;
            PG8_LDB(B1, 0, 1); PG8_STAGE(PG8_SB(0, 0), b2, voffB);
            PG8_BAR; PG8_WAIT_L(0); PG8_MMA(0, 1, At, B1); PG8_BAR;
            PG8_LDA(At, 0, 1); PG8_STAGE(PG8_SA(0, 0), a2, voffA);
            PG8_BAR; PG8_WAIT_L(0); PG8_MMA(1, 0, At, B0); PG8_BAR; PG8_SCHED;
            PG8_STAGE(PG8_SB(0, 1), b2 + hstep, voffB);
            PG8_WAIT_V(6); PG8_BAR; PG8_MMA(1, 1, At, B1); PG8_BAR;
            PG8_LDB(B0, 1, 0); PG8_SCHED; PG8_LDA(At, 1, 0); PG8_STAGE(PG8_SA(0, 1), a2 + hstep, voffA);
            PG8_WAIT_L(8); PG8_BAR; PG8_WAIT_L(0); PG8_MMA(0, 0, At, B0); PG8_BAR; PG8_SCHED;
            PG8_LDB(B1, 1, 1); PG8_STAGE(PG8_SB(1, 0), b3, voffB);
            PG8_BAR; PG8_WAIT_L(0); PG8_MMA(0, 1, At, B1); PG8_BAR;
            PG8_LDA(At, 1, 1); PG8_STAGE(PG8_SA(1, 0), a3, voffA);
            PG8_BAR; PG8_WAIT_L(0); PG8_MMA(1, 0, At, B0); PG8_BAR; PG8_SCHED;
            PG8_STAGE(PG8_SB(1, 1), b3 + hstep, voffB);
            PG8_WAIT_V(6); PG8_BAR; PG8_MMA(1, 1, At, B1); PG8_BAR;
            }
        }
        if constexpr (ALIGN_EPI) { if (wr == 0) PG8_BAR; }
        if constexpr (!Epi::AFTER_DRAIN) { E(acc, cur, wr, wc, fr, fq);
#if defined(EPI_TWICE)
            if constexpr (Epi::PERM) E(acc, cur, wr, wc, fr, fq);
#endif
            S.done(cur); }
        if (!has_next) break;
#pragma unroll
        for (int a = 0; a < 2; ++a)
#pragma unroll
            for (int b = 0; b < 2; ++b)
#pragma unroll
                for (int m = 0; m < 4; ++m)
#pragma unroll
                    for (int n = 0; n < 2; ++n) acc[a][b][m][n] = (f32x4){0.f, 0.f, 0.f, 0.f};
        cur = nxt; cA = nA; cB = nB; ++ui;
        if constexpr (ALIGN_EPI) { if (wr == 1) PG8_BAR; }
    }
    PG8_WAIT_V(0);
    if constexpr (!ALIGN_EPI) { if (wr == 0) PG8_BAR; }
    PG8_BAR;
    if constexpr (Epi::AFTER_DRAIN) { E.fused(acc, cur, wr, wc, fr, fq, lds, wid, lane); S.done(cur); }
#undef PG8_SA
#undef PG8_SB
#undef PG8_STAGE
#undef PG8_LDA
#undef PG8_LDB
#undef PG8_MMA
#undef PG8_WAIT_V
#undef PG8_WAIT_L
#undef PG8_BAR
#undef PG8_SCHED
}
}

constexpr int BATCH = 2, SEQ = 8192, DM = 2048, DEPTH = 4;
constexpr int M = BATCH * SEQ;
constexpr int NH = 16, HD = 128, NG = 4, RH = 4;
constexpr int NCMP = 511, NCMP_PAD = 512, NSLC = 128, NSEL = 16, WIN = 512;
constexpr int SSD_H = 32, SSD_P = 64, SSD_N = 128, SSD_G = 4, SSD_CH = 128, SSD_NC = 64, SSD_XBC = 3072;
constexpr int DFF = 8192, PLE = 256;
constexpr float EPS = 1e-6f;
constexpr int PROJ_SRC = 22608;
constexpr int C_Q = 0, C_KC = 2048, C_VC = 2560, C_KS = 3072, C_VS = 3584, C_KW = 4096, C_VW = 4608;
constexpr int C_CB = 5120, C_CC = 7168, C_CU = 9216, C_Z = 11264, C_XBC = 13312, C_GM = 16384, C_GN = 22528, C_DT = 22592;
constexpr int LDP = 22784;
constexpr int S_GN = 5120, S_DT = 16432;

constexpr size_t MiB = 1u << 20;
constexpr size_t WS_CTL = 0, CTL_ZERO_BYTES = 1 * MiB;
constexpr size_t WS_ROPE = 1 * MiB;
constexpr size_t WS_MISC = 9 * MiB;
constexpr size_t WS_DT = 10 * MiB;
constexpr size_t WS_ACS = 12 * MiB;
constexpr size_t WS_CDEC = 14 * MiB;
constexpr size_t WS_KCMP = 15 * MiB;
constexpr size_t WS_VCMP = 16 * MiB;
constexpr size_t WS_X = 32 * MiB;
constexpr size_t WS_HB = 160 * MiB;
constexpr size_t WS_PB = 224 * MiB;
constexpr size_t WS_EB = 256 * MiB;
constexpr size_t WS_YA = 320 * MiB;
constexpr size_t WS_YC = 384 * MiB;
constexpr size_t WS_XBC = 448 * MiB;
constexpr size_t WS_ST = 544 * MiB;
constexpr size_t WS_PROJ = 672 * MiB;
constexpr size_t WS_U = WS_PROJ;
constexpr size_t WS_W = 1384 * MiB;
constexpr size_t LW_IN = 0;
constexpr size_t LW_O = 89 * MiB;
constexpr size_t LW_UP = 97 * MiB;
constexpr size_t LW_DOWN = 129 * MiB;
constexpr size_t LW_PG = 161 * MiB;
constexpr size_t LW_PLE = 169 * MiB;
constexpr size_t LW_PK1 = 170 * MiB;
constexpr size_t LW_PV1 = 171 * MiB;
constexpr size_t LW_PK2 = 172 * MiB;
constexpr size_t LW_PV2 = 172 * MiB + 64 * 1024;
constexpr size_t LW_STRIDE = 173 * MiB;
constexpr size_t WS_HIN = WS_W + 4 * LW_STRIDE;
constexpr size_t WS_RSTD = WS_MISC + 512 * 1024;
constexpr size_t WS_DELTA = WS_HIN + 64 * MiB;
constexpr size_t WS_KV = WS_DELTA + 64 * MiB;
constexpr size_t WS_END = WS_KV + 96 * MiB;
static_assert((size_t)M * LDP * 2 <= 712 * MiB && (size_t)LDP * 2048 * 2 <= 89 * MiB, "ws map");

constexpr int CW_BAR = 4096;
constexpr int CW_CHK = 16384;
constexpr int CW_TS = 20480;

constexpr int RING_BYTES = 131072;
constexpr int LX_OFF = RING_BYTES;
constexpr int LX_BYTES = 8192;
constexpr int LDSCTL_OFF = LX_OFF + LX_BYTES;
constexpr int LDS_BYTES = LDSCTL_OFF + 256;
constexpr int NWAVES = 8, NTHR = 512;

#define DI __device__ __forceinline__
#define GAS __attribute__((address_space(1)))
#define LAS __attribute__((address_space(3)))
typedef unsigned short bf16;
typedef unsigned u32x4 __attribute__((ext_vector_type(4)));
typedef unsigned u32x2 __attribute__((ext_vector_type(2)));
typedef float f32x4 __attribute__((ext_vector_type(4)));
typedef float f32x2 __attribute__((ext_vector_type(2)));
typedef short bf16x8 __attribute__((ext_vector_type(8)));
typedef short s16x4 __attribute__((ext_vector_type(4)));
typedef GAS unsigned gu32;
#define RLX_AGENT __ATOMIC_RELAXED, __HIP_MEMORY_SCOPE_AGENT
#define LDS_WAIT() asm volatile("s_waitcnt lgkmcnt(0)" ::: "memory")
#define VM_WAIT() asm volatile("s_waitcnt vmcnt(0)" ::: "memory")
DI size_t kv_off(int kind, int b, int g, int t) { return ((((size_t)kind * BATCH + b) * NG + g) * SEQ + t) * HD; }
DI unsigned f2bf(float f) { unsigned u = __builtin_bit_cast(unsigned, f); return (u + 0x7fffu + ((u >> 16) & 1u)) >> 16; }
DI unsigned pk2(float lo, float hi) { unsigned r; asm("v_cvt_pk_bf16_f32 %0, %1, %2" : "=v"(r) : "v"(lo), "v"(hi)); return r; }
DI float bf2f(unsigned h) { return __builtin_bit_cast(float, h << 16); }
DI float bflo(unsigned w) { return __builtin_bit_cast(float, w << 16); }
DI float bfhi(unsigned w) { return __builtin_bit_cast(float, w & 0xffff0000u); }
DI float sigmoidf_(float x) { return 1.0f / (1.0f + __expf(-x)); }
DI float siluf_(float x) { return x / (1.0f + __expf(-x)); }
DI float shfl_idx(float v, int src) { return __builtin_bit_cast(float, __builtin_amdgcn_ds_bpermute(src << 2, __builtin_bit_cast(int, v))); }
DI unsigned shfl_idx_u(unsigned v, int src) { return (unsigned)__builtin_amdgcn_ds_bpermute(src << 2, (int)v); }
DI float shx(float v, int m, int lane) { return shfl_idx(v, lane ^ m); }
DI float xq_max(float x) {
    float a = x, b = x;
    asm("s_nop 1\n\tv_permlane32_swap_b32 %0, %1" : "+v"(a), "+v"(b)); x = fmaxf(a, b);
    a = x; b = x;
    asm("s_nop 1\n\tv_permlane16_swap_b32 %0, %1" : "+v"(a), "+v"(b)); return fmaxf(a, b);
}
DI float xq_sum(float x) {
    float a = x, b = x;
    asm("s_nop 1\n\tv_permlane32_swap_b32 %0, %1" : "+v"(a), "+v"(b)); x = a + b;
    a = x; b = x;
    asm("s_nop 1\n\tv_permlane16_swap_b32 %0, %1" : "+v"(a), "+v"(b)); return a + b;
}
DI float quad_sum(float v) {
    v += __builtin_bit_cast(float, __builtin_amdgcn_update_dpp(0, __builtin_bit_cast(int, v), 0xB1, 0xF, 0xF, true));
    v += __builtin_bit_cast(float, __builtin_amdgcn_update_dpp(0, __builtin_bit_cast(int, v), 0x4E, 0xF, 0xF, true));
    return v;
}
DI float wave_sum(float v, int lane) {
#pragma unroll
    for (int o = 1; o < 64; o <<= 1) v += shx(v, o, lane);
    return v;
}
DI unsigned off_b(unsigned row, unsigned ch) { return 256u * row + 16u * (ch ^ (((row & 3u) << 2) | ((row >> 2) & 3u))); }
DI unsigned tr_addr(unsigned lane, unsigned r0, unsigned c, unsigned t) {
    const unsigned g = lane >> 4, q = (lane & 15u) >> 2, p = lane & 3u;
    return off_b(r0 + 8u * g + 4u * t + q, 2u * c + (p >> 1)) + 8u * (p & 1u);
}
DI s16x4 tr_read(LAS const unsigned char* p) { return __builtin_amdgcn_ds_read_tr16_b64_v4i16((LAS s16x4*)p); }
DI bf16x8 tr_read8(LAS const unsigned char* base, unsigned lane, unsigned r0, unsigned c) {
    const s16x4 lo = tr_read(base + tr_addr(lane, r0, c, 0)), hi = tr_read(base + tr_addr(lane, r0, c, 1));
    return __builtin_shufflevector(lo, hi, 0, 1, 2, 3, 4, 5, 6, 7);
}
DI bf16x8 lds_rd8(LAS const unsigned char* p) { return *(const LAS bf16x8*)p; }
DI bf16x8 as_bf16x8(u32x4 v) { return __builtin_bit_cast(bf16x8, v); }
#define MFMA16(a, b, c) __builtin_amdgcn_mfma_f32_16x16x32_bf16((a), (b), (c), 0, 0, 0)

namespace pg8 {
struct LightOrder {
    int G, c, nunits, nN;
    __host__ __device__ void init(int M, int N, int G_, int c_) { G = G_; c = c_; nN = N / BM; nunits = (M / BM) * nN; }
    __host__ __device__ bool next(int i, Unit& u) const {
        int j;
        if (G == 256) { if (c < 64) return false; j = (c - 64) + 192 * i; } else j = c + G * i;
        if (j >= nunits) return false;
        u.pm = j / nN; u.pn = j % nN; return true;
    }
    __device__ __forceinline__ void a_ready(const Unit&) const {}
    __device__ __forceinline__ void done(const Unit&) const {}
};
template <int MODE> struct EpiB {
    static constexpr bool PERM = true, AFTER_DRAIN = false;
    bf16_t* O; int ldc; const float* rope;
    bf16_t* kv;
    __device__ __forceinline__ void operator()(const f32x4 (&acc)[2][2][4][2], const Unit& u, int wr, int wc, int fr, int fq) const {
        { int l; asm volatile("v_mbcnt_lo_u32_b32 %0, -1, 0\n\tv_mbcnt_hi_u32_b32 %0, -1, %0" : "=v"(l)); fr = l & 15; fq = l >> 4; }
        const int row0 = u.pm * BM + wr * 64 + fr;
        bool rp = false;
        if (MODE == 2) { const int pn = u.pn; rp = (pn < 10) || pn == 12 || pn == 13 || pn == 16 || pn == 17; }
        if (MODE == 2 && rp) {
            const int colb = u.pn * BM + 128 * (wc >> 1) + 32 * (wc & 1) + 8 * fq, jj0 = 32 * (wc & 1) + 8 * fq;
#pragma unroll
            for (int ai = 0; ai < 2; ++ai)
#pragma unroll
                for (int m = 0; m < 4; ++m) {
                    const int row = row0 + ai * HALF + m * 16;
                    const float* rpp = (const float*)((const char*)rope + (unsigned)(((unsigned)row * 64u + (unsigned)jj0) * 8u));
                    const f32x4 cs0 = *(const f32x4*)(rpp), cs1 = *(const f32x4*)(rpp + 4), cs2 = *(const f32x4*)(rpp + 8), cs3 = *(const f32x4*)(rpp + 12);
                    const f32x4 x1a = acc[ai][0][m][0], x1b = acc[ai][0][m][1], x2a = acc[ai][1][m][0], x2b = acc[ai][1][m][1];
                    float c[8] = {cs0[0], cs0[2], cs1[0], cs1[2], cs2[0], cs2[2], cs3[0], cs3[2]};
                    float s[8] = {cs0[1], cs0[3], cs1[1], cs1[3], cs2[1], cs2[3], cs3[1], cs3[3]};
                    float x1[8] = {x1a[0], x1a[1], x1a[2], x1a[3], x1b[0], x1b[1], x1b[2], x1b[3]};
                    float x2[8] = {x2a[0], x2a[1], x2a[2], x2a[3], x2b[0], x2b[1], x2b[2], x2b[3]};
                    float o1[8], o2[8];
#pragma unroll
                    for (int k = 0; k < 8; ++k) { o1[k] = x1[k] * c[k] - x2[k] * s[k]; o2[k] = x2[k] * c[k] + x1[k] * s[k]; }
                    u32x4 w1, w2;
                    w1.x = cvt_pk_bf16(o1[0], o1[1]); w1.y = cvt_pk_bf16(o1[2], o1[3]); w1.z = cvt_pk_bf16(o1[4], o1[5]); w1.w = cvt_pk_bf16(o1[6], o1[7]);
                    w2.x = cvt_pk_bf16(o2[0], o2[1]); w2.y = cvt_pk_bf16(o2[2], o2[3]); w2.z = cvt_pk_bf16(o2[4], o2[5]); w2.w = cvt_pk_bf16(o2[6], o2[7]);
                    bf16_t* rowp = (bf16_t*)((char*)O + (unsigned)(((unsigned)row * (unsigned)ldc + (unsigned)colb) * 2u));
                    if (u.pn >= 8) { const int kind = (u.pn - 8) >> 1, g = 2 * (u.pn & 1) + (wc >> 1);
                        rowp = kv + ((((size_t)kind * 2 + (row >> 13)) * 4 + g) * 8192 + (row & 8191)) * 128 + jj0; }
                    *(u32x4*)(rowp) = w1; *(u32x4*)(rowp + 64) = w2;
                    asm volatile("" ::: "memory");
                }
        } else {
            const int col0 = u.pn * BM + wc * 32 + 8 * fq;
#pragma unroll
            for (int ai = 0; ai < 2; ++ai)
#pragma unroll
                for (int m = 0; m < 4; ++m) { bf16_t* rowp = (bf16_t*)((char*)O + (unsigned)(((unsigned)(row0 + ai * HALF + m * 16) * (unsigned)ldc + (unsigned)col0) * 2u));
#pragma unroll
                    for (int bj = 0; bj < 2; ++bj) { f32x4 v0 = acc[ai][bj][m][0], v1 = acc[ai][bj][m][1];
                        if (MODE == 1) {
#pragma unroll
                            for (int k = 0; k < 4; ++k) { const float a = fmaxf(v0[k], 0.f), b = fmaxf(v1[k], 0.f); v0[k] = a * a; v1[k] = b * b; } }
                        if (MODE == 3) { const u32x4 ev = *(const u32x4*)((const bf16_t*)rope + (rowp - O) + bj * HALF);
                            const float e[8] = {__builtin_bit_cast(float, ev.x << 16), __builtin_bit_cast(float, ev.x & 0xffff0000u), __builtin_bit_cast(float, ev.y << 16), __builtin_bit_cast(float, ev.y & 0xffff0000u),
                                                __builtin_bit_cast(float, ev.z << 16), __builtin_bit_cast(float, ev.z & 0xffff0000u), __builtin_bit_cast(float, ev.w << 16), __builtin_bit_cast(float, ev.w & 0xffff0000u)};
#pragma unroll
                            for (int k = 0; k < 4; ++k) { v0[k] = e[k] / (1.0f + __expf(-v0[k])); v1[k] = e[4 + k] / (1.0f + __expf(-v1[k])); } }
                        u32x4 w; w.x = cvt_pk_bf16(v0[0], v0[1]); w.y = cvt_pk_bf16(v0[2], v0[3]); w.z = cvt_pk_bf16(v1[0], v1[1]); w.w = cvt_pk_bf16(v1[2], v1[3]);
                        if (MODE == 2 && u.pn >= 8 && u.pn < 20) { const int kind = (u.pn - 8) >> 1, g = 2 * (u.pn & 1) + bj, row = row0 + ai * HALF + m * 16;
                            *(u32x4*)(kv + ((((size_t)kind * 2 + (row >> 13)) * 4 + g) * 8192 + (row & 8191)) * 128 + wc * 32 + 8 * fq) = w; }
                        else *(u32x4*)(rowp + bj * HALF) = w; } }
        }
    }
};
template <bool GATE> struct EpiRes {
    static constexpr bool PERM = false, AFTER_DRAIN = false;
    const float* xin; float* xout; int ldc; const bf16_t* e;
    __device__ __forceinline__ void operator()(const f32x4 (&acc)[2][2][4][2], const Unit& u, int wr, int wc, int fr, int fq) const {
        { int l; asm volatile("v_mbcnt_lo_u32_b32 %0, -1, 0\n\tv_mbcnt_hi_u32_b32 %0, -1, %0" : "=v"(l)); fr = l & 15; fq = l >> 4; }
        const int row0 = u.pm * BM + wr * 64 + fr, col0 = u.pn * BM + wc * 32 + 4 * fq;
#pragma unroll
        for (int ai = 0; ai < 2; ++ai)
#pragma unroll
            for (int m = 0; m < 4; ++m) { const unsigned off = (unsigned)(row0 + ai * HALF + m * 16) * (unsigned)ldc + (unsigned)col0;
#pragma unroll
                for (int bj = 0; bj < 2; ++bj)
#pragma unroll
                    for (int n = 0; n < 2; ++n) { const unsigned o = off + bj * HALF + n * 16; const f32x4 xv = *(const f32x4*)((const char*)xin + (unsigned)(o * 4u)); f32x4 a = acc[ai][bj][m][n];
                        if (GATE) { typedef unsigned u32x2v __attribute__((ext_vector_type(2))); const u32x2v ev = *(const u32x2v*)((const char*)e + (unsigned)(o * 2u));
                            const float e0 = __builtin_bit_cast(float, ev.x << 16), e1 = __builtin_bit_cast(float, ev.x & 0xffff0000u), e2 = __builtin_bit_cast(float, ev.y << 16), e3 = __builtin_bit_cast(float, ev.y & 0xffff0000u);
                            a[0] = e0 / (1.0f + __expf(-a[0])); a[1] = e1 / (1.0f + __expf(-a[1])); a[2] = e2 / (1.0f + __expf(-a[2])); a[3] = e3 / (1.0f + __expf(-a[3])); }
                        *(f32x4*)((char*)xout + (unsigned)(o * 4u)) = xv + a; }
                asm volatile("" ::: "memory"); }
    }
};
}
#define XB_TMO      128
#define XB_XCNT(j)  (256  + 64 * (j))
#define XB_XSUB(j)  (1280 + 64 * (j))
#define XB_XGEN(j)  (2304 + 64 * (j))
#define XB_TOP      3328
#define XB_TOPGEN   3392
#define XCD_BAR_WORDS 3456
#define XB_SPIN_CAP (1u << 18)

__device__ __forceinline__ unsigned xb_ld(unsigned* p)              { return __hip_atomic_load(p, __ATOMIC_RELAXED, __HIP_MEMORY_SCOPE_AGENT); }
__device__ __forceinline__ unsigned xb_add(unsigned* p, unsigned v) { return __hip_atomic_fetch_add(p, v, __ATOMIC_RELAXED, __HIP_MEMORY_SCOPE_AGENT); }
__device__ __forceinline__ unsigned xb_xcc_id() { return (unsigned)__builtin_amdgcn_s_getreg((3 << 11) | 20) & 0xFu; }
#define XB_SPIN(cond, bar) do { unsigned _sp = 0; while (cond) { __builtin_amdgcn_s_sleep(1); \
    if ((++_sp & 255u) == 0u) { if (xb_ld(&(bar)[XB_TMO])) break; if (_sp > XB_SPIN_CAP) { atomicAdd(&(bar)[XB_TMO], 1u); break; } } } } while (0)

struct XcdBarrier {
    unsigned* bar; unsigned x;
    volatile LAS unsigned* st;
};

__device__ __forceinline__ XcdBarrier xcd_barrier_post(unsigned* bar, volatile LAS unsigned* st) {
    XcdBarrier b; b.bar = bar; b.x = xb_xcc_id(); b.st = st;
    if (threadIdx.x == 0) (void)xb_add(&bar[XB_XCNT(b.x)], 1u);
    return b;
}
__device__ __forceinline__ void xcd_barrier_complete(unsigned* bar, unsigned x, unsigned& nloc, unsigned& nx) {
    const unsigned G = gridDim.x * gridDim.y * gridDim.z;
    unsigned sum, cnt, mine, sp = 0u;
    for (;;) {
        sum = 0u; cnt = 0u; mine = 0u;
#pragma unroll
        for (unsigned j = 0; j < 16; ++j) { const unsigned c = xb_ld(&bar[XB_XCNT(j)]); sum += c; cnt += (c > 0u) ? 1u : 0u; mine = (j == x) ? c : mine; }
        if (sum == G) break;
        __builtin_amdgcn_s_sleep(1);
        if ((++sp & 255u) == 0u) { if (xb_ld(&bar[XB_TMO])) break; if (sp > XB_SPIN_CAP) { atomicAdd(&bar[XB_TMO], 1u); break; } }
    }
    nloc = mine > 0u ? mine : 1u; nx = cnt > 0u ? cnt : 1u;
}

__device__ __forceinline__ void xcd_barrier(const XcdBarrier& b) {
    asm volatile("s_waitcnt vmcnt(0)" ::: "memory");
    __syncthreads();
    if (threadIdx.x == 0) {
        unsigned* bar = b.bar;
        __builtin_amdgcn_s_waitcnt(0);
        unsigned nloc = b.st[0], nx = b.st[1];
        if (nloc == 0u) { xcd_barrier_complete(bar, b.x, nloc, nx); b.st[0] = nloc; b.st[1] = nx; }
        const unsigned old = xb_add(&bar[XB_XSUB(b.x)], 1u);
        const unsigned gen = old / nloc;
        if (old + 1u == (gen + 1u) * nloc) {
            __builtin_amdgcn_fence(__ATOMIC_RELEASE, "agent");
            asm volatile("s_waitcnt vmcnt(0)" ::: "memory");
            const unsigned og = xb_add(&bar[XB_TOP], 1u);
            const unsigned tg = og / nx;
            if (og + 1u == (tg + 1u) * nx) xb_add(&bar[XB_TOPGEN], 1u);
            else XB_SPIN(xb_ld(&bar[XB_TOPGEN]) == tg, bar);
            __builtin_amdgcn_fence(__ATOMIC_ACQUIRE, "agent");
            xb_add(&bar[XB_XGEN(b.x)], 1u);
            asm volatile("s_waitcnt vmcnt(0)" ::: "memory");
        } else {
            XB_SPIN(xb_ld(&bar[XB_XGEN(b.x)]) == gen, bar);
            __builtin_amdgcn_fence(__ATOMIC_ACQUIRE, "agent");
            asm volatile("s_waitcnt vmcnt(0)" ::: "memory");
        }
    }
    __syncthreads();
}

struct Args { const void* in[30]; float* out; unsigned char* ws; int ph_lo, ph_hi; };
struct Frame {
    LAS unsigned char* lds;
    gu32* ctl;
    unsigned char* ws;
    int tid, lane, wave, G, bid;
};
DI const void* argin(const Args&, int k) {
    typedef const void* const __attribute__((address_space(4)))* kptr_t;
    kptr_t p = (kptr_t)__builtin_amdgcn_kernarg_segment_ptr(); asm volatile("" : "+s"(p));
    return (const void*)p[k]; }
DI int launder_s(int x) { asm volatile("" : "+s"(x)); return x; }
DI Frame phase_frame(const Frame& F0) { Frame F = F0;
    int l; asm volatile("v_mbcnt_lo_u32_b32 %0, -1, 0\n\tv_mbcnt_hi_u32_b32 %0, -1, %0" : "=v"(l));
    F.wave = launder_s(F0.wave); F.bid = launder_s(F0.bid); F.G = launder_s(F0.G);
    F.lane = l; F.tid = F.wave * 64 + l;
    { unsigned long long wsb = (unsigned long long)F0.ws; asm volatile("" : "+s"(wsb)); F.ws = (unsigned char*)wsb; }
    { unsigned ll = (unsigned)(size_t)F0.lds; asm volatile("" : "+s"(ll)); F.lds = (LAS unsigned char*)(size_t)ll; }
    return F; }
DI unsigned char* lw_ptr(const Frame& F, int layer, size_t off) { return F.ws + WS_W + (size_t)layer * LW_STRIDE + off; }

template <bool FRAGMAJOR = false>
DI void transpose_item(const float* W, int K, int Nsrc, int nsrc0, bf16* WT, int dst_row0, int k0, LAS float* scr, int lane) {
#pragma unroll 8
    for (int i = 0; i < 32; ++i) { const int kk = 2 * i + (lane >> 5); scr[kk * 33 + (lane & 31)] = W[(size_t)(k0 + kk) * Nsrc + nsrc0 + (lane & 31)]; }
    LDS_WAIT(); asm volatile("" ::: "memory");
    const int c = lane & 7;
#pragma unroll
    for (int j = 0; j < 4; ++j) { const int n = (lane >> 3) + 8 * j; const LAS float* s = scr + (8 * c) * 33 + n;
        u32x4 o; o.x = pk2(s[0 * 33], s[1 * 33]); o.y = pk2(s[2 * 33], s[3 * 33]); o.z = pk2(s[4 * 33], s[5 * 33]); o.w = pk2(s[6 * 33], s[7 * 33]);
        if (FRAGMAJOR) { const int hid = dst_row0 + n, kk = k0 + 8 * c;
            *(u32x4*)(WT + ((size_t)((hid >> 4) * (K >> 5) + (kk >> 5)) * 64 + (((kk >> 3) & 3) * 16 + (hid & 15))) * 8) = o; }
        else *(u32x4*)(WT + (size_t)(dst_row0 + n) * K + k0 + 8 * c) = o; }
    LDS_WAIT(); asm volatile("" ::: "memory");
}
DI int proj_src_col(int d) {
    if (d < 5120) {
        const int pn = d >> 8; const bool rp = (pn < 10) || pn == 12 || pn == 13 || pn == 16 || pn == 17;
        if (!rp) return d;
        const int c = d & 255, bj = c >> 7, wc = (c >> 5) & 3;
        return (pn << 8) + 128 * (wc >> 1) + 64 * bj + 32 * (wc & 1);
    }
    if (d < 16384) return d + 48;
    if (d < 22528) return d + 80;
    if (d < 22592) return S_GN + (d - 22528);
    if (d < 22624) return S_DT + (d - 22592);
    return 0;
}
constexpr int TI_IN = 32 * 712, TI_O = 32 * 64, TI_UP = 32 * 256, TI_DOWN = 128 * 64, TI_PG = 32 * 64, TI_PLE = 4 * 64, TI_P1 = 64 * 4, TI_P2 = 2 * 4;
constexpr int TI_LAYER = TI_IN + TI_O + TI_UP + TI_DOWN + TI_PG + TI_PLE + 2 * TI_P1 + 2 * TI_P2;

DI void p0_prologue(const Frame& F0, const Args& A) {
    const Frame F = phase_frame(F0);
    LAS float* scr = (LAS float*)(F.lds + F.wave * 16384);
    const int gw = F.bid * NWAVES + F.wave, NGW = F.G * NWAVES;
    for (int it = gw; it < DEPTH * TI_LAYER; it += NGW) {
        const int layer = it / TI_LAYER; int r = it - layer * TI_LAYER;
        if (r < TI_IN) { const int kb = r / 712, nb = r - kb * 712;
            transpose_item((const float*)argin(A, 4) + (size_t)layer * DM * PROJ_SRC, DM, PROJ_SRC, proj_src_col(nb * 32), (bf16*)lw_ptr(F, layer, LW_IN), nb * 32, kb * 64, scr, F.lane); continue; } r -= TI_IN;
        if (r < TI_O) { const int kb = r / 64, nb = r % 64;
            transpose_item((const float*)argin(A, 22) + (size_t)layer * DM * DM, DM, DM, nb * 32, (bf16*)lw_ptr(F, layer, LW_O), nb * 32, kb * 64, scr, F.lane); continue; } r -= TI_O;
        if (r < TI_UP) { const int kb = r / 256, nb = r % 256;
            transpose_item((const float*)argin(A, 24) + (size_t)layer * DM * DFF, DM, DFF, nb * 32, (bf16*)lw_ptr(F, layer, LW_UP), nb * 32, kb * 64, scr, F.lane); continue; } r -= TI_UP;
        if (r < TI_DOWN) { const int kb = r / 64, nb = r % 64;
            transpose_item((const float*)argin(A, 25) + (size_t)layer * DFF * DM, DFF, DM, nb * 32, (bf16*)lw_ptr(F, layer, LW_DOWN), nb * 32, kb * 64, scr, F.lane); continue; } r -= TI_DOWN;
        if (r < TI_PG) { const int kb = r / 64, nb = r % 64;
            transpose_item((const float*)argin(A, 28) + (size_t)layer * DM * DM, DM, DM, nb * 32, (bf16*)lw_ptr(F, layer, LW_PG), nb * 32, kb * 64, scr, F.lane); continue; } r -= TI_PG;
        if (r < TI_PLE) { const int kb = r / 64, nb = r % 64;
            transpose_item((const float*)argin(A, 27) + (size_t)layer * PLE * DM, PLE, DM, nb * 32, (bf16*)lw_ptr(F, layer, LW_PLE), nb * 32, kb * 64, scr, F.lane); continue; } r -= TI_PLE;
        if (r < TI_P1) { const int kb = r / 4, nb = r % 4;
            transpose_item<true>((const float*)argin(A, 7) + (size_t)layer * 4096 * 128, 4096, 128, nb * 32, (bf16*)lw_ptr(F, layer, LW_PK1), nb * 32, kb * 64, scr, F.lane); continue; } r -= TI_P1;
        if (r < TI_P1) { const int kb = r / 4, nb = r % 4;
            transpose_item<true>((const float*)argin(A, 11) + (size_t)layer * 4096 * 128, 4096, 128, nb * 32, (bf16*)lw_ptr(F, layer, LW_PV1), nb * 32, kb * 64, scr, F.lane); continue; } r -= TI_P1;
        if (r < TI_P2) { const int kb = r / 4, nb = r % 4;
            transpose_item((const float*)argin(A, 9) + (size_t)layer * 128 * 128, 128, 128, nb * 32, (bf16*)lw_ptr(F, layer, LW_PK2), nb * 32, kb * 64, scr, F.lane); continue; } r -= TI_P2;
        { const int kb = r / 4, nb = r % 4;
            transpose_item((const float*)argin(A, 13) + (size_t)layer * 128 * 128, 128, 128, nb * 32, (bf16*)lw_ptr(F, layer, LW_PV2), nb * 32, kb * 64, scr, F.lane); }
    }
    const size_t gt = (size_t)F.bid * NTHR + F.tid, NGT = (size_t)F.G * NTHR;
    { const float* p = (const float*)argin(A, 1); bf16* pb = (bf16*)(F.ws + WS_PB);
      for (size_t i = gt; i < (size_t)DEPTH * M * PLE / 8; i += NGT) { const f32x4 a = *(const f32x4*)(p + i * 8), b = *(const f32x4*)(p + i * 8 + 4);
          u32x4 o; o.x = pk2(a[0], a[1]); o.y = pk2(a[2], a[3]); o.z = pk2(b[0], b[1]); o.w = pk2(b[2], b[3]); *(u32x4*)(pb + i * 8) = o; } }
    { const int* pos = (const int*)argin(A, 2); float* rope = (float*)(F.ws + WS_ROPE);
      for (size_t i = gt; i < (size_t)M * 64; i += NGT) { const int row = (int)(i >> 6), jj = (int)(i & 63);
          const float inv = 1.0f / powf(10000.0f, (float)(2 * jj) * (1.0f / 128.0f));
          const float ang = (float)pos[row] * inv;
          double a = (double)ang; a -= 6.283185307179586476925 * __builtin_rint(a * 0.15915494309189533577);
          const float ar = (float)a;
          rope[i * 2] = cosf(ar); rope[i * 2 + 1] = sinf(ar); } }
    { float* part = (float*)(F.ws + WS_MISC);
      for (size_t i = gt; i < (size_t)DEPTH * 2 * 8 * 128; i += NGT) { const int hid = (int)(i & 127), c = (int)(i >> 7) & 7, kv = (int)(i >> 10) & 1, layer = (int)(i >> 11);
          const float* pe = (const float*)(kv ? A.in[6] : A.in[5]) + (size_t)layer * 4096 + c * 512;
          const float* w1 = (const float*)(kv ? A.in[11] : A.in[7]) + (size_t)layer * 4096 * 128 + (size_t)c * 512 * 128 + hid;
          float s = 0.f;
#pragma unroll 8
          for (int kk = 0; kk < 512; ++kk) s += pe[kk] * w1[(size_t)kk * 128];
          part[i] = s; } }
}

template <bool OUTF32> DI void norm_rows(const Frame& F0, const float* x, const float* g, void* outp) {
    const Frame F = phase_frame(F0);
    const int gw = F.bid * NWAVES + F.wave, NGW = F.G * NWAVES;
    for (int m = gw; m < M; m += NGW) {
        const f32x4* xr = (const f32x4*)(x + (size_t)m * DM) + F.lane;
        f32x4 v[8]; float s = 0.f;
#pragma unroll
        for (int j = 0; j < 8; ++j) { v[j] = xr[64 * j]; s += (v[j][0] * v[j][0] + v[j][1] * v[j][1]) + (v[j][2] * v[j][2] + v[j][3] * v[j][3]); }
        const float rstd = 1.0f / sqrtf(wave_sum(s, F.lane) * (1.0f / DM) + EPS);
#pragma unroll
        for (int j = 0; j < 8; ++j) { const f32x4 gv = ((const f32x4*)g)[F.lane + 64 * j]; const f32x4 o = v[j] * rstd * gv;
            if (OUTF32) ((f32x4*)((float*)outp + (size_t)m * DM))[F.lane + 64 * j] = o;
            else { u32x2 w; w.x = pk2(o[0], o[1]); w.y = pk2(o[2], o[3]); ((u32x2*)((bf16*)outp + (size_t)m * DM))[F.lane + 64 * j] = w; } }
    }
}
template <bool OUTF32> DI void addnorm_rows(const Frame& F0, const float* xin, const bf16* delta, const float* g, float* xout, void* outp) {
    const Frame F = phase_frame(F0);
    const int gw = F.bid * NWAVES + F.wave, NGW = F.G * NWAVES;
    for (int m = gw; m < M; m += NGW) {
        const f32x4* xr = (const f32x4*)(xin + (size_t)m * DM) + F.lane; const u32x2* dr = (const u32x2*)(delta + (size_t)m * DM) + F.lane;
        f32x4 v[8]; u32x2 d[8]; float s = 0.f;
#pragma unroll
        for (int j = 0; j < 8; ++j) { v[j] = xr[64 * j]; d[j] = dr[64 * j]; }
#pragma unroll
        for (int j = 0; j < 8; ++j) { v[j][0] += bflo(d[j].x); v[j][1] += bfhi(d[j].x); v[j][2] += bflo(d[j].y); v[j][3] += bfhi(d[j].y);
            s += (v[j][0] * v[j][0] + v[j][1] * v[j][1]) + (v[j][2] * v[j][2] + v[j][3] * v[j][3]);
            if (!OUTF32) ((f32x4*)(xout + (size_t)m * DM))[F.lane + 64 * j] = v[j]; }
        const float rstd = 1.0f / sqrtf(wave_sum(s, F.lane) * (1.0f / DM) + EPS);
#pragma unroll
        for (int j = 0; j < 8; ++j) { const f32x4 gv = ((const f32x4*)g)[F.lane + 64 * j]; const f32x4 o = v[j] * rstd * gv;
            if (OUTF32) ((f32x4*)((float*)outp + (size_t)m * DM))[F.lane + 64 * j] = o;
            else { u32x2 w; w.x = pk2(o[0], o[1]); w.y = pk2(o[2], o[3]); ((u32x2*)((bf16*)outp + (size_t)m * DM))[F.lane + 64 * j] = w; } }
    }
}
DI void unpack8(u32x4 w, float (&f)[8]) { f[0] = bflo(w.x); f[1] = bfhi(w.x); f[2] = bflo(w.y); f[3] = bfhi(w.y); f[4] = bflo(w.z); f[5] = bfhi(w.z); f[6] = bflo(w.w); f[7] = bfhi(w.w); }
DI u32x4 pack8f(const float (&f)[8]) { u32x4 o; o.x = pk2(f[0], f[1]); o.y = pk2(f[2], f[3]); o.z = pk2(f[4], f[5]); o.w = pk2(f[6], f[7]); return o; }

DI void ssd_conv_pass(const Frame& F0, const Args& A, int layer) {
    const Frame F = phase_frame(F0);
    const bf16* proj = (const bf16*)(F.ws + WS_PROJ); bf16* xbc = (bf16*)(F.ws + WS_XBC);
    const float* cw = (const float*)argin(A, 16) + (size_t)layer * 4 * SSD_XBC; const float* cb = (const float*)argin(A, 17) + (size_t)layer * SSD_XBC;
    const int gt = F.bid * NTHR + F.tid, NGT = F.G * NTHR;
    for (int task = gt; task < 512 * 384; task += NGT) {
        const int run = task / 384, cg = task - run * 384, ch = cg * 8, row0 = run * 32;
        float w[4][8], bs[8], xm3[8], xm2[8], xm1[8];
#pragma unroll
        for (int j = 0; j < 4; ++j) { const f32x4 a = *(const f32x4*)(cw + j * SSD_XBC + ch), b = *(const f32x4*)(cw + j * SSD_XBC + ch + 4);
            w[j][0] = a[0]; w[j][1] = a[1]; w[j][2] = a[2]; w[j][3] = a[3]; w[j][4] = b[0]; w[j][5] = b[1]; w[j][6] = b[2]; w[j][7] = b[3]; }
        { const f32x4 a = *(const f32x4*)(cb + ch), b = *(const f32x4*)(cb + ch + 4); bs[0] = a[0]; bs[1] = a[1]; bs[2] = a[2]; bs[3] = a[3]; bs[4] = b[0]; bs[5] = b[1]; bs[6] = b[2]; bs[7] = b[3]; }
        if ((row0 & (SEQ - 1)) != 0) {
            unpack8(*(const u32x4*)(proj + (size_t)(row0 - 3) * LDP + C_XBC + ch), xm3);
            unpack8(*(const u32x4*)(proj + (size_t)(row0 - 2) * LDP + C_XBC + ch), xm2);
            unpack8(*(const u32x4*)(proj + (size_t)(row0 - 1) * LDP + C_XBC + ch), xm1);
        } else {
#pragma unroll
            for (int k = 0; k < 8; ++k) { xm3[k] = 0.f; xm2[k] = 0.f; xm1[k] = 0.f; }
        }
#pragma unroll 4
        for (int r = 0; r < 32; ++r) {
            float cur[8], y[8]; unpack8(*(const u32x4*)(proj + (size_t)(row0 + r) * LDP + C_XBC + ch), cur);
#pragma unroll
            for (int k = 0; k < 8; ++k) { const float v = w[0][k] * xm3[k] + w[1][k] * xm2[k] + w[2][k] * xm1[k] + w[3][k] * cur[k] + bs[k]; y[k] = siluf_(v); xm3[k] = xm2[k]; xm2[k] = xm1[k]; xm1[k] = cur[k]; }
            *(u32x4*)(xbc + (size_t)(row0 + r) * SSD_XBC + ch) = pack8f(y);
        }
    }
    const float* dtb = (const float*)argin(A, 18) + layer * SSD_H; float* dt = (float*)(F.ws + WS_DT);
    for (int i = gt; i < M * SSD_H; i += NGT) { const int row = i >> 5, h = i & 31;
        const float x = bf2f(proj[(size_t)row * LDP + C_DT + h]) + dtb[h];
        dt[i] = fmaxf(x, 0.f) + log1pf(__expf(-fabsf(x))); }
}

DI void merge_pass(const Frame& F0, const Args& A, int layer) {
    const Frame F = phase_frame(F0);
    const bf16* proj = (const bf16*)(F.ws + WS_PROJ); const bf16* ya = (const bf16*)(F.ws + WS_YA); const bf16* yc = (const bf16*)(F.ws + WS_YC); bf16* hb = (bf16*)(F.ws + WS_HB);
    const float* sw = (const float*)argin(A, 15) + (size_t)layer * 3 * DM; const float* ngp = (const float*)argin(A, 21) + (size_t)layer * DM; const float* rstdp = (const float*)(F.ws + WS_RSTD);
    const int gt = F.bid * NTHR + F.tid, NGT = F.G * NTHR;
    for (int task = gt; task < 512 * 256; task += NGT) {
        const int run = task >> 8, cg = task & 255, ch = cg * 8, row0 = run * 32;
        float w[3][8], pm2[8], pm1[8], ng8[8];
        { const f32x4 a = *(const f32x4*)(ngp + ch), b = *(const f32x4*)(ngp + ch + 4); ng8[0] = a[0]; ng8[1] = a[1]; ng8[2] = a[2]; ng8[3] = a[3]; ng8[4] = b[0]; ng8[5] = b[1]; ng8[6] = b[2]; ng8[7] = b[3]; }
#pragma unroll
        for (int j = 0; j < 3; ++j) { const f32x4 a = *(const f32x4*)(sw + j * DM + ch), b = *(const f32x4*)(sw + j * DM + ch + 4);
            w[j][0] = a[0]; w[j][1] = a[1]; w[j][2] = a[2]; w[j][3] = a[3]; w[j][4] = b[0]; w[j][5] = b[1]; w[j][6] = b[2]; w[j][7] = b[3]; }
        if ((row0 & (SEQ - 1)) != 0) {
            float c1[8], u1[8];
            unpack8(*(const u32x4*)(proj + (size_t)(row0 - 2) * LDP + C_CC + ch), c1); unpack8(*(const u32x4*)(proj + (size_t)(row0 - 2) * LDP + C_CU + ch), u1);
#pragma unroll
            for (int k = 0; k < 8; ++k) pm2[k] = c1[k] * u1[k];
            unpack8(*(const u32x4*)(proj + (size_t)(row0 - 1) * LDP + C_CC + ch), c1); unpack8(*(const u32x4*)(proj + (size_t)(row0 - 1) * LDP + C_CU + ch), u1);
#pragma unroll
            for (int k = 0; k < 8; ++k) pm1[k] = c1[k] * u1[k];
        } else {
#pragma unroll
            for (int k = 0; k < 8; ++k) { pm2[k] = 0.f; pm1[k] = 0.f; }
        }
#pragma unroll 2
        for (int r = 0; r < 32; ++r) {
            const size_t pr = (size_t)(row0 + r) * LDP + ch, yr = (size_t)(row0 + r) * DM + ch;
            float cc[8], cu[8], cbv[8], g0[8], g1[8], g2[8], a[8], c[8], o[8];
            unpack8(*(const u32x4*)(proj + pr + C_CC), cc); unpack8(*(const u32x4*)(proj + pr + C_CU), cu); unpack8(*(const u32x4*)(proj + pr + C_CB), cbv);
            unpack8(*(const u32x4*)(proj + pr + C_GM), g0); unpack8(*(const u32x4*)(proj + pr + C_GM + DM), g1); unpack8(*(const u32x4*)(proj + pr + C_GM + 2 * DM), g2);
            unpack8(*(const u32x4*)(ya + yr), a); unpack8(*(const u32x4*)(yc + yr), c);
            const float rs = rstdp[(size_t)(row0 + r) * SSD_G + (ch >> 9)];
#pragma unroll
            for (int k = 0; k < 8; ++k) { const float pc = cc[k] * cu[k]; const float cv = w[0][k] * pm2[k] + w[1][k] * pm1[k] + w[2][k] * pc; pm2[k] = pm1[k]; pm1[k] = pc;
                o[k] = sigmoidf_(g0[k]) * a[k] + sigmoidf_(g1[k]) * (cbv[k] * cv) + sigmoidf_(g2[k]) * (c[k] * rs * ng8[k]); }
            *(u32x4*)(hb + yr) = pack8f(o);
        }
    }
}

DI void compress_phase(const Frame& F0, const Args& A, int layer) {
    const Frame F = phase_frame(F0);
    const bf16* proj = (const bf16*)(F.ws + WS_PROJ);
    LAS unsigned char* slab = F.lds;
    LAS unsigned char* hidl = F.lds + 73728;
    LAS float* b1s = (LAS float*)(F.lds + 81920);
    const int lane = F.lane, w = F.wave, i = lane & 15, qd = lane >> 4;
    const float* part = (const float*)(F.ws + WS_MISC);
    for (int u = F.bid; u < 512; u += F.G) {
        const int kv = u >> 8, b = (u >> 7) & 1, g = (u >> 5) & 3, nb = u & 31, n0 = nb * 16, tok0 = n0 * 16;
        const bf16* src = (const bf16*)(F.ws + WS_KV) + kv_off(kv, b, g, 0);
        for (int id = F.tid; id < 272 * 16; id += NTHR) { const int row = id >> 4, ch = id & 15, t = tok0 + row;
            u32x4 v = {0u, 0u, 0u, 0u}; if (t < SEQ) v = *(const u32x4*)(src + (size_t)t * HD + ch * 8);
            *(LAS u32x4*)(slab + off_b(row, ch)) = v; }
        if (F.tid < 128) { float s = ((const float*)argin(A, kv ? 12 : 8))[layer * 128 + F.tid];
#pragma unroll
            for (int c = 0; c < 8; ++c) s += part[(((size_t)layer * 2 + kv) * 8 + c) * 128 + F.tid];
            b1s[F.tid] = s; }
        __syncthreads();
        const bf16* w1t = (const bf16*)lw_ptr(F, layer, kv ? LW_PV1 : LW_PK1) + ((size_t)w * 128 * 64 + lane) * 8;
        f32x4 acc = {0.f, 0.f, 0.f, 0.f};
#if defined(SSD_IGLP)
        __builtin_amdgcn_iglp_opt(0);
#endif
        for (int k0 = 0; k0 < 128; k0 += 32) {
            bf16x8 bb[32];
#pragma unroll
            for (int k = 0; k < 32; ++k) bb[k] = *(const bf16x8*)(w1t + 512 * (k0 + k));
#pragma unroll
            for (int k = 0; k < 32; ++k) { const int ks = k0 + k;
                acc = MFMA16(lds_rd8(slab + off_b(16 * i + (ks >> 2), 4 * (ks & 3) + qd)), bb[k], acc); }
        }
        { const float bv = b1s[16 * w + i];
#pragma unroll
          for (int j = 0; j < 4; ++j) *(LAS bf16*)(hidl + (4 * qd + j) * 272 + (16 * w + i) * 2) = (bf16)f2bf(siluf_(acc[j] + bv)); }
        __syncthreads();
        const bf16* w2t = (const bf16*)lw_ptr(F, layer, kv ? LW_PV2 : LW_PK2) + (size_t)(16 * w + i) * 128 + 8 * qd;
        f32x4 acc2 = {0.f, 0.f, 0.f, 0.f};
#pragma unroll
        for (int s = 0; s < 4; ++s) {
            const bf16x8 a = lds_rd8(hidl + i * 272 + 64 * s + 16 * qd);
            const bf16x8 bb = *(const bf16x8*)(w2t + 32 * s);
            acc2 = MFMA16(a, bb, acc2);
        }
        const float b2 = ((const float*)argin(A, kv ? 14 : 10))[layer * 128 + 16 * w + i];
        bf16* dst = (bf16*)(F.ws + (kv ? WS_VCMP : WS_KCMP)) + ((size_t)(b * NG + g) * NCMP_PAD + n0) * HD + 16 * w + i;
#pragma unroll
        for (int j = 0; j < 4; ++j) dst[(size_t)(4 * qd + j) * HD] = (bf16)f2bf(acc2[j] + b2);
        __syncthreads();
    }
}

DI void ssd_states_phase(const Frame& F0, const Args& A, int layer) {
    const Frame F = phase_frame(F0);
    const bf16* xbc = (const bf16*)(F.ws + WS_XBC); const float* dt = (const float*)(F.ws + WS_DT);
    float* acs = (float*)(F.ws + WS_ACS); float* cdec = (float*)(F.ws + WS_CDEC); float* st = (float*)(F.ws + WS_ST);
    LAS unsigned char* Bt = F.lds; LAS unsigned char* Xt = F.lds + 32768; LAS float* sc = (LAS float*)(F.lds + 65536);
    const float* alog = (const float*)argin(A, 19) + layer * SSD_H;
    const int lane = F.lane, w = F.wave, i = lane & 15, qd = lane >> 4;
    for (int u = F.bid; u < 512; u += F.G) {
        const int b = u >> 8, c = (u >> 2) & 63, g = u & 3, row0 = b * SEQ + c * SSD_CH;
        {
            const int hh = g * 8 + w; const float a = -__expf(alog[hh]);
            const float dt0 = dt[(size_t)(row0 + 2 * lane) * SSD_H + hh], dt1 = dt[(size_t)(row0 + 2 * lane + 1) * SSD_H + hh];
            const float d0 = dt0 * a, d1 = dt1 * a, pair = d0 + d1; float s = pair;
#pragma unroll
            for (int o = 1; o < 64; o <<= 1) { const float t = shfl_idx(s, lane - o); if (lane >= o) s += t; }
            const float a0 = (s - pair) + d0, a1 = s, total = __builtin_bit_cast(float, __builtin_amdgcn_readlane(__builtin_bit_cast(int, s), 63));
            acs[(size_t)(row0 + 2 * lane) * SSD_H + hh] = a0; acs[(size_t)(row0 + 2 * lane + 1) * SSD_H + hh] = a1;
            sc[w * 128 + 2 * lane] = dt0 * __expf(total - a0); sc[w * 128 + 2 * lane + 1] = dt1 * __expf(total - a1);
            if (lane == 0) cdec[(size_t)(b * SSD_NC + c) * SSD_H + hh] = __expf(total);
        }
        for (int id = F.tid; id < 128 * 16; id += NTHR) { const int row = id >> 4, ch = id & 15;
            *(LAS u32x4*)(Bt + off_b(row, ch)) = *(const u32x4*)(xbc + (size_t)(row0 + row) * SSD_XBC + 2048 + g * 128 + ch * 8); }
        bf16x8 bfr[4];
        for (int hp = 0; hp < 4; ++hp) {
            __syncthreads();
            for (int id = F.tid; id < 128 * 16; id += NTHR) { const int row = id >> 4, ch = id & 15;
                float x[8]; unpack8(*(const u32x4*)(xbc + (size_t)(row0 + row) * SSD_XBC + g * 512 + hp * 128 + ch * 8), x);
                const float f = sc[(hp * 2 + (ch >> 3)) * 128 + row];
#pragma unroll
                for (int k = 0; k < 8; ++k) x[k] *= f;
                *(LAS u32x4*)(Xt + off_b(row, ch)) = pack8f(x); }
            __syncthreads();
            if (hp == 0) {
#pragma unroll
                for (int ks = 0; ks < 4; ++ks) bfr[ks] = tr_read8(Bt, lane, 32 * ks, w);
            }
#pragma unroll
            for (int h2 = 0; h2 < 2; ++h2) {
                const int head = g * 8 + hp * 2 + h2;
                float* dst = st + ((size_t)((b * SSD_NC + c) * SSD_H + head) * SSD_N + 16 * w + i) * SSD_P + 4 * qd;
#pragma unroll
                for (int pt = 0; pt < 4; ++pt) {
                    f32x4 acc = {0.f, 0.f, 0.f, 0.f};
#pragma unroll
                    for (int ks = 0; ks < 4; ++ks) acc = MFMA16(tr_read8(Xt, lane, 32 * ks, h2 * 4 + pt), bfr[ks], acc);
                    *(f32x4*)(dst + 16 * pt) = acc;
                }
            }
        }
        __syncthreads();
    }
}
DI void ssd_scan_phase(const Frame& F0) {
    const Frame F = phase_frame(F0);
    const f32x4* st = (const f32x4*)(F.ws + WS_ST); u32x2* hin = (u32x2*)(F.ws + WS_HIN); const float* cdec = (const float*)(F.ws + WS_CDEC);
    const int gt = F.bid * NTHR + F.tid, NGT = F.G * NTHR;
    for (int v = gt; v < BATCH * SSD_H * 2048; v += NGT) {
        const int b = v >> 16, h = (v >> 11) & 31, e = v & 2047;
        const size_t o0 = ((size_t)(b * SSD_NC) * SSD_H + h) * 2048 + e;
        const float* dc = cdec + (size_t)(b * SSD_NC) * SSD_H + h;
        f32x4 hs = {0.f, 0.f, 0.f, 0.f};
        for (int c0 = 0; c0 < SSD_NC; c0 += 8) {
            f32x4 s[8]; float d[8];
#pragma unroll
            for (int k = 0; k < 8; ++k) { s[k] = st[o0 + (size_t)(c0 + k) * 65536]; d[k] = dc[(c0 + k) * SSD_H]; }
#pragma unroll
            for (int k = 0; k < 8; ++k) { u32x2 o; o.x = pk2(hs[0], hs[1]); o.y = pk2(hs[2], hs[3]); hin[o0 + (size_t)(c0 + k) * 65536] = o; hs = hs * d[k] + s[k]; }
        }
    }
}
DI void ssd_out_phase(const Frame& F0, const Args& A, int layer) {
    const Frame F = phase_frame(F0);
    const bf16* xbc = (const bf16*)(F.ws + WS_XBC); const bf16* proj = (const bf16*)(F.ws + WS_PROJ);
    const float* dt = (const float*)(F.ws + WS_DT); const float* acs = (const float*)(F.ws + WS_ACS); const bf16* hin = (const bf16*)(F.ws + WS_HIN);
    bf16* yc = (bf16*)(F.ws + WS_YC); float* rstdp = (float*)(F.ws + WS_RSTD);
    LAS unsigned char* Bt = F.lds; LAS unsigned char* Ct = F.lds + 32768; LAS unsigned char* Xt = F.lds + 65536; LAS unsigned char* Ht = F.lds + 98304;
    LAS float* acsl = (LAS float*)(F.lds + LX_OFF);
    const float* dsk = (const float*)argin(A, 20) + layer * SSD_H;
    const int lane = F.lane, w = F.wave, i = lane & 15, qd = lane >> 4;
    for (int u = F.bid; u < 512; u += F.G) {
        const int b = u >> 8, c = (u >> 2) & 63, g = u & 3, row0 = b * SEQ + c * SSD_CH;
        for (int id = F.tid; id < 128 * 16; id += NTHR) { const int row = id >> 4, ch = id & 15; const bf16* src = xbc + (size_t)(row0 + row) * SSD_XBC + 2048 + g * 128 + ch * 8;
            *(LAS u32x4*)(Bt + off_b(row, ch)) = *(const u32x4*)(src); *(LAS u32x4*)(Ct + off_b(row, ch)) = *(const u32x4*)(src + 512); }
        __syncthreads();
        bf16x8 cfr[4];
#pragma unroll
        for (int ks = 0; ks < 4; ++ks) cfr[ks] = lds_rd8(Ct + off_b(16 * w + i, 4 * ks + qd));
        f32x4 cb[4][2];
#pragma unroll
        for (int k = 0; k < 4; ++k)
#pragma unroll
            for (int T = 0; T < 2; ++T) { f32x4 acc = {0.f, 0.f, 0.f, 0.f};
#pragma unroll
                for (int ks = 0; ks < 4; ++ks) acc = MFMA16(lds_rd8(Bt + off_b(32 * k + 8 * (i >> 2) + (i & 3) + 4 * T, 4 * ks + qd)), cfr[ks], acc);
                cb[k][T] = acc; }
        const int lrow = 16 * w + i, row = row0 + lrow;
        float ssq = 0.f;
        for (int hp = 0; hp < 4; ++hp) {
            __syncthreads();
            if (F.tid < 256) { const int h2 = F.tid >> 7, l = F.tid & 127; acsl[F.tid] = acs[(size_t)(row0 + l) * SSD_H + g * 8 + hp * 2 + h2]; }
            for (int id = F.tid; id < 128 * 16; id += NTHR) { const int r = id >> 4, ch = id & 15, head = g * 8 + hp * 2 + (ch >> 3);
                float x[8]; unpack8(*(const u32x4*)(xbc + (size_t)(row0 + r) * SSD_XBC + g * 512 + hp * 128 + ch * 8), x);
                const float f = dt[(size_t)(row0 + r) * SSD_H + head];
#pragma unroll
                for (int k = 0; k < 8; ++k) x[k] *= f;
                *(LAS u32x4*)(Xt + off_b(r, ch)) = pack8f(x);
                *(LAS u32x4*)(Ht + off_b(r, ch)) = *(const u32x4*)(hin + ((size_t)((b * SSD_NC + c) * SSD_H + head) * SSD_N + r) * SSD_P + (ch & 7) * 8); }
            __syncthreads();
#pragma unroll
            for (int h2 = 0; h2 < 2; ++h2) {
                const int head = g * 8 + hp * 2 + h2;
#if defined(SSD_IGLP)
                __builtin_amdgcn_iglp_opt(0);
#endif
                const float al = acsl[h2 * 128 + lrow], ea = __expf(al), dsv = dsk[head];
                u32x2 xv4[4], zv4[4];
#pragma unroll
                for (int pt = 0; pt < 4; ++pt) { const int chn = head * SSD_P + 16 * pt + 4 * qd;
                    xv4[pt] = *(const u32x2*)(xbc + (size_t)row * SSD_XBC + chn); zv4[pt] = *(const u32x2*)(proj + (size_t)row * LDP + C_Z + chn); }
                bf16x8 mfr[4];
#pragma unroll
                for (int k = 0; k < 4; ++k) {
                    const f32x4 a0 = *(const LAS f32x4*)(acsl + h2 * 128 + 32 * k + 8 * qd), a1 = *(const LAS f32x4*)(acsl + h2 * 128 + 32 * k + 8 * qd + 4);
                    float mv[8];
#pragma unroll
                    for (int j = 0; j < 4; ++j) { const int s0 = 32 * k + 8 * qd + j, s1 = s0 + 4;
                        mv[j] = (s0 <= lrow) ? cb[k][0][j] * __expf(al - a0[j]) : 0.f;
                        mv[4 + j] = (s1 <= lrow) ? cb[k][1][j] * __expf(al - a1[j]) : 0.f; }
                    mfr[k] = as_bf16x8(pack8f(mv));
                }
#pragma unroll
                for (int pt = 0; pt < 4; ++pt) {
                    f32x4 yd = {0.f, 0.f, 0.f, 0.f}, yo = {0.f, 0.f, 0.f, 0.f};
#pragma unroll
                    for (int k = 0; k < 4; ++k) yd = MFMA16(tr_read8(Xt, lane, 32 * k, h2 * 4 + pt), mfr[k], yd);
#pragma unroll
                    for (int ks = 0; ks < 4; ++ks) yo = MFMA16(tr_read8(Ht, lane, 32 * ks, h2 * 4 + pt), cfr[ks], yo);
                    const int chn = head * SSD_P + 16 * pt + 4 * qd;
                    const u32x2 xv = xv4[pt], zv = zv4[pt];
                    const float xs[4] = {bflo(xv.x), bfhi(xv.x), bflo(xv.y), bfhi(xv.y)}, zz[4] = {bflo(zv.x), bfhi(zv.x), bflo(zv.y), bfhi(zv.y)};
                    float gy[4];
#pragma unroll
                    for (int j = 0; j < 4; ++j) { const float y = yd[j] + ea * yo[j] + dsv * xs[j]; gy[j] = y * siluf_(zz[j]); ssq += gy[j] * gy[j]; }
                    u32x2 o; o.x = pk2(gy[0], gy[1]); o.y = pk2(gy[2], gy[3]);
                    *(u32x2*)(yc + (size_t)row * DM + chn) = o;
                }
            }
        }
        ssq += shx(ssq, 16, lane); ssq += shx(ssq, 32, lane);
        if (qd == 0) rstdp[(size_t)row * SSD_G + g] = 1.0f / sqrtf(ssq * (1.0f / 512.0f) + EPS);
        __syncthreads();
    }
}

#ifndef NSA_REP_PART
#define NSA_REP_PART 0
#endif
#if NSA_REP_PART == 7
#define W7DUP(x) x
#define W7WAIT() NSA_WAITV(8)
#else
#define W7DUP(x)
#define W7WAIT() NSA_WAITV(4)
#endif
#if NSA_REP_PART == 10
#define SELDUP(x) x
#else
#define SELDUP(x)
#endif
constexpr int RB = 32768, NRING = 3;
#define NSA_WAITV(n) asm volatile("s_waitcnt vmcnt(" #n ")" ::: "memory")
#define NSA_BAR() do { asm volatile("" ::: "memory"); __builtin_amdgcn_s_barrier(); asm volatile("" ::: "memory"); } while (0)
template <bool WITHV> DI void tile_dma(LAS unsigned char* buf, const bf16* kp, const bf16* vp, int pitch, int w, int lane) {
#pragma unroll
    for (int e = 0; e < 2; ++e) { const int kb = 2 * w + e, kh = kb >> 3, T = (kb >> 2) & 1, ks = kb & 3, i = lane & 15, qd = lane >> 4;
        const int key = 32 * kh + 8 * (i >> 2) + (i & 3) + 4 * T, ch = 4 * ks + qd;
        __builtin_amdgcn_global_load_lds((const unsigned*)(kp + (size_t)key * pitch + ch * 8), (LAS unsigned*)(buf + kb * 1024), 16, 0, 0); }
    if (WITHV) {
#pragma unroll
        for (int e = 0; e < 2; ++e) { const int vb = 2 * w + e, kh = vb >> 3, t = (vb >> 2) & 1, dtp = vb & 3, dtl = lane >> 5, g = (lane >> 3) & 3, q = (lane >> 1) & 3, ph = lane & 1;
            const int key = 32 * kh + 8 * g + 4 * t + q, ch = 4 * dtp + 2 * dtl + ph;
            __builtin_amdgcn_global_load_lds((const unsigned*)(vp + (size_t)key * pitch + ch * 8), (LAS unsigned*)(buf + 16384 + vb * 1024), 16, 0, 0); }
    }
}
#define NSA_TR8(r, addr, b) asm volatile("ds_read_b64_tr_b16 %0, %8 offset:%9\n\tds_read_b64_tr_b16 %1, %8 offset:%10\n\tds_read_b64_tr_b16 %2, %8 offset:%11\n\tds_read_b64_tr_b16 %3, %8 offset:%12\n\t" \
        "ds_read_b64_tr_b16 %4, %8 offset:%13\n\tds_read_b64_tr_b16 %5, %8 offset:%14\n\tds_read_b64_tr_b16 %6, %8 offset:%15\n\tds_read_b64_tr_b16 %7, %8 offset:%16" \
        : "=&v"(r[0]), "=&v"(r[1]), "=&v"(r[2]), "=&v"(r[3]), "=&v"(r[4]), "=&v"(r[5]), "=&v"(r[6]), "=&v"(r[7]) \
        : "v"(addr), "i"((b)), "i"((b) + 4096), "i"((b) + 512), "i"((b) + 4608), "i"((b) + 1024), "i"((b) + 5120), "i"((b) + 1536), "i"((b) + 5632) : "memory")
#define NSA_TRWAIT(r) asm volatile("s_waitcnt lgkmcnt(0)" : "+v"(r[0]), "+v"(r[1]), "+v"(r[2]), "+v"(r[3]), "+v"(r[4]), "+v"(r[5]), "+v"(r[6]), "+v"(r[7]) :: "memory")
#define NSA_TRWAIT8(r) asm volatile("s_waitcnt lgkmcnt(8)" : "+v"(r[0]), "+v"(r[1]), "+v"(r[2]), "+v"(r[3]), "+v"(r[4]), "+v"(r[5]), "+v"(r[6]), "+v"(r[7]) :: "memory")
#define NSA_SB() __builtin_amdgcn_sched_barrier(0)
#define NSA_PV4(r, kh, d0) do { _Pragma("unroll") for (int q_ = 0; q_ < 4; ++q_) { const bf16x8 vf_ = __builtin_shufflevector(r[2 * q_], r[2 * q_ + 1], 0, 1, 2, 3, 4, 5, 6, 7); \
        if (SM & 1) O[0][(d0) + q_] = MFMA16(vf_, pf[0][kh], O[0][(d0) + q_]); if (SM & 2) O[1][(d0) + q_] = MFMA16(vf_, pf[1][kh], O[1][(d0) + q_]); } } while (0)
template <int MODE, int SM>
DI void attn_tile(LAS const unsigned char* Kt, LAS const unsigned char* Vt, const bf16x8 (&Qf)[2][4], f32x4 (&O)[2][8], float (&m)[2], float (&l)[2], const int (&lo)[2], const int (&hi)[2], bool needmask,
                  float c2, const float (&inv_l)[2], LAS float* imp, const int (&ql)[2], int jb0, float (&cin)[2], int lane) {
    const int qd = lane >> 4;
    f32x4 sc[2][2][2];
#if !defined(NSA_NO_IGLP)
    __builtin_amdgcn_iglp_opt(0);
#endif
#pragma unroll
    for (int kh = 0; kh < 2; ++kh)
#pragma unroll
        for (int T = 0; T < 2; ++T) { f32x4 a0 = {0.f, 0.f, 0.f, 0.f}, a1 = {0.f, 0.f, 0.f, 0.f};
#pragma unroll
            for (int ks = 0; ks < 4; ++ks) { const bf16x8 kf = lds_rd8(Kt + (kh * 8 + T * 4 + ks) * 1024);
                if (SM & 1) a0 = MFMA16(kf, Qf[0][ks], a0); if (SM & 2) a1 = MFMA16(kf, Qf[1][ks], a1); }
            sc[0][kh][T] = a0; sc[1][kh][T] = a1; }
    const float NEG = -__builtin_inff();
    bf16x8 pf[2][2];
#pragma unroll
    for (int s = 0; s < 2; ++s) if (SM & (1 << s)) {
        if (needmask) {
#pragma unroll
            for (int kh = 0; kh < 2; ++kh)
#pragma unroll
                for (int T = 0; T < 2; ++T)
#pragma unroll
                    for (int j = 0; j < 4; ++j) { const int kk = 32 * kh + 8 * qd + 4 * T + j; if (kk < lo[s] || kk > hi[s]) sc[s][kh][T][j] = NEG; }
        }
        float mn = m[s];
        if (MODE != 2) {
            float tmax = fmaxf(fmaxf(sc[s][0][0][0], sc[s][0][0][1]), fmaxf(sc[s][0][0][2], sc[s][0][0][3]));
            tmax = fmaxf(tmax, fmaxf(fmaxf(sc[s][0][1][0], sc[s][0][1][1]), fmaxf(sc[s][0][1][2], sc[s][0][1][3])));
            tmax = fmaxf(tmax, fmaxf(fmaxf(sc[s][1][0][0], sc[s][1][0][1]), fmaxf(sc[s][1][0][2], sc[s][1][0][3])));
            tmax = fmaxf(tmax, fmaxf(fmaxf(sc[s][1][1][0], sc[s][1][1][1]), fmaxf(sc[s][1][1][2], sc[s][1][1][3])));
            tmax = xq_max(tmax);
            mn = fmaxf(m[s], tmax);
            if (__ballot(mn != m[s]) != 0ull) {
                const float alpha = __builtin_amdgcn_exp2f((m[s] - mn) * c2);
                l[s] *= alpha;
                if (MODE == 1) {
#pragma unroll
                    for (int dt = 0; dt < 8; ++dt) O[s][dt] = O[s][dt] * alpha;
                }
                m[s] = mn;
            }
        }
        const float nmc = -mn * c2; float ps = 0.f;
#pragma unroll
        for (int kh = 0; kh < 2; ++kh)
#pragma unroll
            for (int T = 0; T < 2; ++T)
#pragma unroll
                for (int j = 0; j < 4; ++j) { float p = __builtin_amdgcn_exp2f(__builtin_fmaf(sc[s][kh][T][j], c2, nmc)); if (MODE == 2) p *= inv_l[s]; sc[s][kh][T][j] = p; ps += p; }
        if (MODE != 2) l[s] += ps;
        if (MODE == 2) {
            float s4[2][2], cy[2][2];
#pragma unroll
            for (int kh = 0; kh < 2; ++kh)
#pragma unroll
                for (int T = 0; T < 2; ++T) {
                    float a = (sc[s][kh][T][0] + sc[s][kh][T][1]) + (sc[s][kh][T][2] + sc[s][kh][T][3]), c = sc[s][kh][T][3];
                    a = quad_sum(a); c = quad_sum(c);
                    s4[kh][T] = a; cy[kh][T] = c; }
            const float x0 = shfl_idx(cy[0][1], (lane - 16) & 63), x1 = shfl_idx(cy[1][1], (lane - 16) & 63);
            const float p00 = (qd == 0) ? cin[s] : x0, p10 = (qd == 0) ? x0 : x1;
            cin[s] = x1;
            if ((lane & 3) == 0) { const int jb = jb0 + 2 * qd;
                *(LAS f32x2*)(imp + ql[s] * 128 + jb) = (f32x2){s4[0][0] + p00, s4[0][1] + cy[0][0]};
                *(LAS f32x2*)(imp + ql[s] * 128 + jb + 8) = (f32x2){s4[1][0] + p10, s4[1][1] + cy[1][0]}; }
        }
        if (MODE != 0) {
#pragma unroll
            for (int kh = 0; kh < 2; ++kh) { u32x4 pw; pw.x = pk2(sc[s][kh][0][0], sc[s][kh][0][1]); pw.y = pk2(sc[s][kh][0][2], sc[s][kh][0][3]); pw.z = pk2(sc[s][kh][1][0], sc[s][kh][1][1]); pw.w = pk2(sc[s][kh][1][2], sc[s][kh][1][3]); pf[s][kh] = as_bf16x8(pw); }
        }
    }
    if (MODE != 0) {
        const unsigned va = (unsigned)(size_t)Vt;
        s16x4 ra[8], rb[8];
        NSA_TR8(ra, va, 0);     NSA_TR8(rb, va, 2048); NSA_SB();
        NSA_TRWAIT8(ra); NSA_SB(); NSA_PV4(ra, 0, 0); NSA_SB(); NSA_TR8(ra, va, 8192);  NSA_SB();
        NSA_TRWAIT8(rb); NSA_SB(); NSA_PV4(rb, 0, 4); NSA_SB(); NSA_TR8(rb, va, 10240); NSA_SB();
        NSA_TRWAIT8(ra); NSA_SB(); NSA_PV4(ra, 1, 0); NSA_SB();
        NSA_TRWAIT(rb);  NSA_SB(); NSA_PV4(rb, 1, 4);
    }
}
template <bool FIRST> DI void nsa_emit(const f32x4 (&O)[8], float scale, bf16* dst  ) {
    u32x2 old[8];
    if (!FIRST) {
#pragma unroll
        for (int dt = 0; dt < 8; ++dt) old[dt] = *(const u32x2*)(dst + 16 * dt);
    }
#pragma unroll
    for (int dt = 0; dt < 8; ++dt) { f32x4 v = O[dt] * scale;
        if (!FIRST) { v[0] += bflo(old[dt].x); v[1] += bfhi(old[dt].x); v[2] += bflo(old[dt].y); v[3] += bfhi(old[dt].y); }
        u32x2 o; o.x = pk2(v[0], v[1]); o.y = pk2(v[2], v[3]); *(u32x2*)(dst + 16 * dt) = o; }
}
DI int next_bit(unsigned u0, unsigned u1, unsigned u2, unsigned u3, int from) {
    if (from >= 128) return -1;
    const int wd = from >> 5; const unsigned msk = ~0u << (from & 31);
    const unsigned x0 = (wd == 0) ? (u0 & msk) : 0u;
    const unsigned x1 = (wd < 1) ? u1 : ((wd == 1) ? (u1 & msk) : 0u);
    const unsigned x2 = (wd < 2) ? u2 : ((wd == 2) ? (u2 & msk) : 0u);
    const unsigned x3 = (wd < 3) ? u3 : (u3 & msk);
    if (x0) return __builtin_ctz(x0);
    if (x1) return 32 + __builtin_ctz(x1);
    if (x2) return 64 + __builtin_ctz(x2);
    if (x3) return 96 + __builtin_ctz(x3);
    return -1;
}

DI void nsa_phase(const Frame& F0, const Args& A, int layer) {
    const Frame F = phase_frame(F0);
    const bf16* proj = (const bf16*)(F.ws + WS_PROJ); const bf16* kcmp = (const bf16*)(F.ws + WS_KCMP); const bf16* vcmp = (const bf16*)(F.ws + WS_VCMP);
    bf16* ya = (bf16*)(F.ws + WS_YA);
    LAS unsigned char* const RG = F.lds;
    LAS float* imp = (LAS float*)(F.lds + NRING * RB);
    LAS unsigned* selm = (LAS unsigned*)(F.lds + NRING * RB + 32768); LAS unsigned* uml = selm + 256;
    static_assert(NRING * RB + 32768 + 1024 + 16 <= LDSCTL_OFF && NRING * RB + 32768 == 4 * RB, "nsa LDS map (the selected loop's pair buffers overlay ring + importance table)");
    const float c2 = 0.08838834764831845f * 1.4426950408889634f;
    (void)A; (void)layer;
#if defined(NSA_PRIO)
    if (F.wave < 4) __builtin_amdgcn_s_setprio(2); else __builtin_amdgcn_s_setprio(0);
#endif
    for (int u = F.bid; u < 1024; u += F.G) {
        int tid_l = F.tid; asm volatile("" : "+v"(tid_l));
        const int tid = tid_l, lane = tid & 63, w = F.wave, i = lane & 15, qd = lane >> 4, hd = i & 3;
        const int klane = 16 * lane, vlane = 16384 + 8 * lane;
        const int xg = u & 7, jj = (u >> 3) & 31, rr = u >> 8;
        const int b = xg >> 2, g = xg & 3;
        const int qt = (rr == 0) ? 127 - jj : (rr == 1) ? 64 + jj : (rr == 2) ? 63 - jj : jj;
        const int s0 = qt * 64, cur = qt, rowb = b * SEQ;
        int ql[2], trow[2]; bf16x8 Qf[2][4];
#pragma unroll
        for (int s = 0; s < 2; ++s) { ql[s] = 8 * w + 4 * s + (i >> 2); trow[s] = rowb + s0 + ql[s];
#pragma unroll
            for (int ks = 0; ks < 4; ++ks) Qf[s][ks] = *(const bf16x8*)(proj + (size_t)trow[s] * LDP + C_Q + (4 * g + hd) * HD + 32 * ks + 8 * qd); }
        f32x4 O[2][8]; float mrow[2], lrow[2], cin[2], invl[2] = {0.f, 0.f};
        const int ntc = (4 * qt + 3 + 63) >> 6;
        const bf16* kc0 = kcmp + (size_t)(b * NG + g) * NCMP_PAD * HD; const bf16* vc0 = vcmp + (size_t)(b * NG + g) * NCMP_PAD * HD;
        int nmax[2];
#pragma unroll
        for (int s = 0; s < 2; ++s) { const int t = s0 + ql[s]; nmax[s] = (t >= 31) ? ((t - 31) >> 4) : -1; mrow[s] = -1e30f; lrow[s] = 0.f; cin[s] = 0.f; }
        for (int rep_ = 0; rep_ < (NSA_REP_PART == 2 ? 2 : 1); ++rep_) {
#pragma unroll
        for (int s = 0; s < 2; ++s) { mrow[s] = -1e30f; lrow[s] = 0.f; cin[s] = 0.f; }
        NSA_WAITV(0); NSA_BAR();
        tile_dma<false>(RG, kc0, vc0, HD, w, lane); if (ntc > 1) tile_dma<false>(RG + RB, kc0 + (size_t)64 * HD, vc0, HD, w, lane);
        for (int tc = 0, rb = 0; tc < ntc; ++tc) {
            if (tc + 1 < ntc) NSA_WAITV(2); else NSA_WAITV(0);
            NSA_BAR();
            if (tc + 2 < ntc) { const int nb2 = (rb + 2 >= NRING) ? rb + 2 - NRING : rb + 2; tile_dma<false>(RG + nb2 * RB, kc0 + (size_t)(tc + 2) * 64 * HD, vc0, HD, w, lane); }
            { const int lo2[2] = {0, 0}, hi2[2] = {nmax[0] - 64 * tc, nmax[1] - 64 * tc}; const bool nm = __ballot(hi2[0] < 63 || hi2[1] < 63) != 0ull;
              attn_tile<0, 3>(RG + rb * RB + klane, RG, Qf, O, mrow, lrow, lo2, hi2, nm, c2, invl, imp, ql, 0, cin, lane); }
            rb = (rb + 1 == NRING) ? 0 : rb + 1;
        }
#pragma unroll
        for (int s = 0; s < 2; ++s) { float lt = lrow[s]; lt = xq_sum(lt); invl[s] = (lt > 0.f) ? 1.0f / lt : 0.f;
#pragma unroll
            for (int dt = 0; dt < 8; ++dt) O[s][dt] = (f32x4){0.f, 0.f, 0.f, 0.f}; }
        NSA_BAR();
        tile_dma<true>(RG, kc0, vc0, HD, w, lane); if (ntc > 1) tile_dma<true>(RG + RB, kc0 + (size_t)64 * HD, vc0 + (size_t)64 * HD, HD, w, lane);
        for (int tc = 0, rb = 0; tc < ntc; ++tc) {
            if (tc + 1 < ntc) NSA_WAITV(4); else NSA_WAITV(0);
            NSA_BAR();
            if (tc + 2 < ntc) { const int nb2 = (rb + 2 >= NRING) ? rb + 2 - NRING : rb + 2; tile_dma<true>(RG + nb2 * RB, kc0 + (size_t)(tc + 2) * 64 * HD, vc0 + (size_t)(tc + 2) * 64 * HD, HD, w, lane); }
            { const int lo2[2] = {0, 0}, hi2[2] = {nmax[0] - 64 * tc, nmax[1] - 64 * tc}; const bool nm = __ballot(hi2[0] < 63 || hi2[1] < 63) != 0ull;
              attn_tile<2, 3>(RG + rb * RB + klane, RG + rb * RB + vlane, Qf, O, mrow, lrow, lo2, hi2, nm, c2, invl, imp, ql, 16 * tc, cin, lane); }
            rb = (rb + 1 == NRING) ? 0 : rb + 1;
        }
#pragma unroll
        for (int s = 0; s < 2; ++s) { const float gate = sigmoidf_(bf2f(proj[(size_t)trow[s] * LDP + C_GN + (4 * g + hd) * 3 + 0]));
            nsa_emit<true>(O[s], gate, ya + (size_t)trow[s] * DM + (4 * g + hd) * HD + 4 * qd); }
        }
        for (int rep_ = 0; rep_ < (NSA_REP_PART == 1 ? 2 : 1); ++rep_) {
            LDS_WAIT();
            const int nforced = (cur == 0) ? 1 : (cur == 1) ? 2 : 3; const int nsel = (cur + 1 < NSEL) ? cur + 1 : NSEL; const int R = nsel - nforced;
            const int E = (cur >= 3) ? cur - 2 : 0;
            for (int q8 = 0; q8 < 8; ++q8) {
                const int q = 8 * w + q8;
                const int j0 = lane, j1 = lane + 64;
                const bool e0 = (j0 >= 1) && (j0 <= cur - 2), e1 = (j1 <= cur - 2);
                const bool f0 = (j0 == 0) || (j0 == cur) || (j0 == cur - 1), f1 = (j1 == cur) || (j1 == cur - 1);
                bool s0 = e0, s1 = e1;
                if (R < E) {
                    const unsigned k0 = e0 ? __builtin_bit_cast(unsigned, imp[q * 128 + j0]) + 1u : 0u, k1 = e1 ? __builtin_bit_cast(unsigned, imp[q * 128 + j1]) + 1u : 0u;
                    unsigned T = 0u;
#pragma unroll 1
                    for (int bit = 30; bit >= 0; --bit) { const unsigned c = T | (1u << bit);
                        const int n = __builtin_popcountll(__ballot(k0 >= c)) + __builtin_popcountll(__ballot(k1 >= c));
                        if (n >= R) T = c; }
                    const unsigned long long eq0 = __ballot(k0 == T), eq1 = __ballot(k1 == T);
                    const int G = __builtin_popcountll(__ballot(k0 > T)) + __builtin_popcountll(__ballot(k1 > T));
                    const unsigned long long lt = (1ull << lane) - 1ull;
                    const int r0 = __builtin_popcountll(eq0 & lt), r1 = __builtin_popcountll(eq0) + __builtin_popcountll(eq1 & lt);
                    s0 = (k0 > T) || (k0 == T && r0 < R - G); s1 = (k1 > T) || (k1 == T && r1 < R - G);
                }
                const unsigned long long m0 = __ballot(f0 || s0), m1 = __ballot(f1 || s1);
                if (lane == 0) { selm[q * 4 + 0] = (unsigned)m0; selm[q * 4 + 1] = (unsigned)(m0 >> 32); selm[q * 4 + 2] = (unsigned)m1; selm[q * 4 + 3] = (unsigned)(m1 >> 32); }
            }
            __syncthreads();
            if (w == 0) { unsigned x0 = selm[lane * 4 + 0], x1 = selm[lane * 4 + 1], x2 = selm[lane * 4 + 2], x3 = selm[lane * 4 + 3];
#pragma unroll
                for (int o = 1; o < 64; o <<= 1) { x0 |= shfl_idx_u(x0, lane ^ o); x1 |= shfl_idx_u(x1, lane ^ o); x2 |= shfl_idx_u(x2, lane ^ o); x3 |= shfl_idx_u(x3, lane ^ o); }
                if (lane == 0) { uml[0] = x0; uml[1] = x1; uml[2] = x2; uml[3] = x3; } }
            __syncthreads();
        }
        const unsigned um0 = __builtin_amdgcn_readfirstlane(uml[0]), um1 = __builtin_amdgcn_readfirstlane(uml[1]), um2 = __builtin_amdgcn_readfirstlane(uml[2]), um3 = __builtin_amdgcn_readfirstlane(uml[3]);
        for (int rep_ = 0; rep_ < (NSA_REP_PART == 3 ? 2 : 1); ++rep_) {
            const bf16* ks0 = (const bf16*)(F.ws + WS_KV) + kv_off(2, b, g, 0); const bf16* vs0 = (const bf16*)(F.ws + WS_KV) + kv_off(3, b, g, 0);
#pragma unroll
            for (int s = 0; s < 2; ++s) { mrow[s] = -1e30f; lrow[s] = 0.f;
#pragma unroll
                for (int dt = 0; dt < 8; ++dt) O[s][dt] = (f32x4){0.f, 0.f, 0.f, 0.f}; }
#if NSA_REP_PART == 11
            {
            int jaD = next_bit(um0, um1, um2, um3, 0), jbD = next_bit(um0, um1, um2, um3, jaD + 1), pbD = 0;
            VM_WAIT(); if (NSA_REP_PART == 3) NSA_BAR();
            tile_dma<true>(RG, ks0 + (size_t)jaD * 64 * HD, vs0 + (size_t)jaD * 64 * HD, HD, w, lane); SELDUP(tile_dma<true>(RG, ks0 + (size_t)jaD * 64 * HD, vs0 + (size_t)jaD * 64 * HD, HD, w, lane);)
            if (jbD >= 0) tile_dma<true>(RG + RB, ks0 + (size_t)jbD * 64 * HD, vs0 + (size_t)jbD * 64 * HD, HD, w, lane); SELDUP(tile_dma<true>(RG + RB, ks0 + (size_t)jbD * 64 * HD, vs0 + (size_t)jbD * 64 * HD, HD, w, lane);)
            while (jaD >= 0) {
                const int jcD = (jbD >= 0) ? next_bit(um0, um1, um2, um3, jbD + 1) : -1, jdD = (jcD >= 0) ? next_bit(um0, um1, um2, um3, jcD + 1) : -1;
                NSA_WAITV(0);
                NSA_BAR();
                if (jcD >= 0) { LAS unsigned char* nb = RG + (pbD ^ 1) * 2 * RB; tile_dma<true>(nb, ks0 + (size_t)jcD * 64 * HD, vs0 + (size_t)jcD * 64 * HD, HD, w, lane); SELDUP(tile_dma<true>(nb, ks0 + (size_t)jcD * 64 * HD, vs0 + (size_t)jcD * 64 * HD, HD, w, lane);)
                    if (jdD >= 0) tile_dma<true>(nb + RB, ks0 + (size_t)jdD * 64 * HD, vs0 + (size_t)jdD * 64 * HD, HD, w, lane); SELDUP(tile_dma<true>(nb + RB, ks0 + (size_t)jdD * 64 * HD, vs0 + (size_t)jdD * 64 * HD, HD, w, lane);) }
                jaD = jcD; jbD = jdD; pbD ^= 1;
            }
            NSA_BAR();
            }
#endif
            int ja = next_bit(um0, um1, um2, um3, 0), jbb = next_bit(um0, um1, um2, um3, ja + 1), pbuf = 0;
            VM_WAIT(); if (NSA_REP_PART == 3) NSA_BAR();
            tile_dma<true>(RG, ks0 + (size_t)ja * 64 * HD, vs0 + (size_t)ja * 64 * HD, HD, w, lane); SELDUP(tile_dma<true>(RG, ks0 + (size_t)ja * 64 * HD, vs0 + (size_t)ja * 64 * HD, HD, w, lane);)
            if (jbb >= 0) tile_dma<true>(RG + RB, ks0 + (size_t)jbb * 64 * HD, vs0 + (size_t)jbb * 64 * HD, HD, w, lane); SELDUP(tile_dma<true>(RG + RB, ks0 + (size_t)jbb * 64 * HD, vs0 + (size_t)jbb * 64 * HD, HD, w, lane);)
            while (ja >= 0) {
                const int jc = (jbb >= 0) ? next_bit(um0, um1, um2, um3, jbb + 1) : -1, jd = (jc >= 0) ? next_bit(um0, um1, um2, um3, jc + 1) : -1;
                NSA_WAITV(0);
                NSA_BAR();
                if (jc >= 0) { LAS unsigned char* nb = RG + (pbuf ^ 1) * 2 * RB; tile_dma<true>(nb, ks0 + (size_t)jc * 64 * HD, vs0 + (size_t)jc * 64 * HD, HD, w, lane); SELDUP(tile_dma<true>(nb, ks0 + (size_t)jc * 64 * HD, vs0 + (size_t)jc * 64 * HD, HD, w, lane);)
                    if (jd >= 0) tile_dma<true>(nb + RB, ks0 + (size_t)jd * 64 * HD, vs0 + (size_t)jd * 64 * HD, HD, w, lane); SELDUP(tile_dma<true>(nb + RB, ks0 + (size_t)jd * 64 * HD, vs0 + (size_t)jd * 64 * HD, HD, w, lane);) }
#pragma unroll 1
                for (int e2 = 0; e2 < 2; ++e2) { const int jb = e2 ? jbb : ja; if (jb < 0) break;
                  const bool act0 = (selm[ql[0] * 4 + (jb >> 5)] >> (jb & 31)) & 1u, act1 = (selm[ql[1] * 4 + (jb >> 5)] >> (jb & 31)) & 1u;
                  const bool any0 = __ballot(act0) != 0ull, any1 = __ballot(act1) != 0ull;
                  const int lo2[2] = {0, 0}, hi2[2] = {act0 ? ((jb < cur) ? 63 : ql[0]) : -1, act1 ? ((jb < cur) ? 63 : ql[1]) : -1};
                  LAS const unsigned char* kt = RG + (pbuf * 2 + e2) * RB + klane; LAS const unsigned char* vt = RG + (pbuf * 2 + e2) * RB + vlane;
                  if (any0 && any1) { const bool nm = __ballot(hi2[0] < 63 || hi2[1] < 63) != 0ull; attn_tile<1, 3>(kt, vt, Qf, O, mrow, lrow, lo2, hi2, nm, c2, invl, imp, ql, 0, cin, lane); }
                  else if (any0) { const bool nm = __ballot(hi2[0] < 63) != 0ull; attn_tile<1, 1>(kt, vt, Qf, O, mrow, lrow, lo2, hi2, nm, c2, invl, imp, ql, 0, cin, lane); }
                  else if (any1) { const bool nm = __ballot(hi2[1] < 63) != 0ull; attn_tile<1, 2>(kt, vt, Qf, O, mrow, lrow, lo2, hi2, nm, c2, invl, imp, ql, 0, cin, lane); } }
                ja = jc; jbb = jd; pbuf ^= 1;
            }
            NSA_BAR();
#pragma unroll
            for (int s = 0; s < 2; ++s) { float lt = lrow[s]; lt = xq_sum(lt);
                const float gate = sigmoidf_(bf2f(proj[(size_t)trow[s] * LDP + C_GN + (4 * g + hd) * 3 + 1]));
                if (rep_ == 0) nsa_emit<false>(O[s], (lt > 0.f) ? gate / lt : 0.f, ya + (size_t)trow[s] * DM + (4 * g + hd) * HD + 4 * qd); }
        }
        for (int rep_ = 0; rep_ < (NSA_REP_PART == 4 ? 2 : 1); ++rep_) {
            const bf16* kw0 = (const bf16*)(F.ws + WS_KV) + kv_off(4, b, g, 0); const bf16* vw0 = (const bf16*)(F.ws + WS_KV) + kv_off(5, b, g, 0);
#pragma unroll
            for (int s = 0; s < 2; ++s) { mrow[s] = -1e30f; lrow[s] = 0.f;
#pragma unroll
                for (int dt = 0; dt < 8; ++dt) O[s][dt] = (f32x4){0.f, 0.f, 0.f, 0.f}; }
#if NSA_REP_PART == 8
            {
            const int tt0d = (qt >= 8) ? 0 : 8 - qt;
            VM_WAIT(); NSA_BAR();
            { const size_t r0 = (size_t)(s0 - 512 + 64 * tt0d) * HD; tile_dma<true>(RG, kw0 + r0, vw0 + r0, HD, w, lane); W7DUP(tile_dma<true>(RG, kw0 + r0, vw0 + r0, HD, w, lane);) }
            if (tt0d < 8) { const size_t r0 = (size_t)(s0 - 512 + 64 * (tt0d + 1)) * HD; tile_dma<true>(RG + RB, kw0 + r0, vw0 + r0, HD, w, lane); W7DUP(tile_dma<true>(RG + RB, kw0 + r0, vw0 + r0, HD, w, lane);) }
            for (int tt = tt0d, rb = 0; tt <= 8; ++tt) {
                if (tt < 8) { W7WAIT(); } else NSA_WAITV(0);
                NSA_BAR();
                if (tt + 2 <= 8) { const int nb2 = (rb + 2 >= NRING) ? rb + 2 - NRING : rb + 2; const size_t r0 = (size_t)(s0 - 512 + 64 * (tt + 2)) * HD; tile_dma<true>(RG + nb2 * RB, kw0 + r0, vw0 + r0, HD, w, lane); W7DUP(tile_dma<true>(RG + nb2 * RB, kw0 + r0, vw0 + r0, HD, w, lane);) }
                rb = (rb + 1 == NRING) ? 0 : rb + 1;
            }
            }
#endif
            const int tt0 = (qt >= 8) ? 0 : 8 - qt;
            VM_WAIT(); NSA_BAR();
            { const size_t r0 = (size_t)(s0 - 512 + 64 * tt0) * HD; tile_dma<true>(RG, kw0 + r0, vw0 + r0, HD, w, lane); W7DUP(tile_dma<true>(RG, kw0 + r0, vw0 + r0, HD, w, lane);) }
            if (tt0 < 8) { const size_t r0 = (size_t)(s0 - 512 + 64 * (tt0 + 1)) * HD; tile_dma<true>(RG + RB, kw0 + r0, vw0 + r0, HD, w, lane); W7DUP(tile_dma<true>(RG + RB, kw0 + r0, vw0 + r0, HD, w, lane);) }
            for (int tt = tt0, rb = 0; tt <= 8; ++tt) {
                if (tt < 8) { W7WAIT(); } else NSA_WAITV(0);
                NSA_BAR();
                if (tt + 2 <= 8) { const int nb2 = (rb + 2 >= NRING) ? rb + 2 - NRING : rb + 2; const size_t r0 = (size_t)(s0 - 512 + 64 * (tt + 2)) * HD; tile_dma<true>(RG + nb2 * RB, kw0 + r0, vw0 + r0, HD, w, lane); W7DUP(tile_dma<true>(RG + nb2 * RB, kw0 + r0, vw0 + r0, HD, w, lane);) }
                { const int lo2[2] = {(tt == 0) ? ql[0] + 1 : 0, (tt == 0) ? ql[1] + 1 : 0}, hi2[2] = {(tt == 8) ? ql[0] : 63, (tt == 8) ? ql[1] : 63};
                  attn_tile<1, 3>(RG + rb * RB + klane, RG + rb * RB + vlane, Qf, O, mrow, lrow, lo2, hi2, (tt == 0) || (tt == 8), c2, invl, imp, ql, 0, cin, lane);
#if NSA_REP_PART == 5
                  { const int him[2] = {-1, -1}; attn_tile<1, 3>(RG + rb * RB + klane, RG + rb * RB + vlane, Qf, O, mrow, lrow, lo2, him, true, c2, invl, imp, ql, 0, cin, lane); }
#endif
#if NSA_REP_PART == 6
                  NSA_BAR(); NSA_BAR(); NSA_BAR(); NSA_BAR();
#endif
                }
                rb = (rb + 1 == NRING) ? 0 : rb + 1;
            }
            VM_WAIT();
#pragma unroll
            for (int s = 0; s < 2; ++s) { float lt = lrow[s]; lt = xq_sum(lt);
                const float gate = sigmoidf_(bf2f(proj[(size_t)trow[s] * LDP + C_GN + (4 * g + hd) * 3 + 2]));
                if (rep_ == 0) nsa_emit<false>(O[s], (lt > 0.f) ? gate / lt : 0.f, ya + (size_t)trow[s] * DM + (4 * g + hd) * HD + 4 * qd); }
        }
        __syncthreads();
    }
    __builtin_amdgcn_s_setprio(0);
}

#if defined(CHECK_BUILD) && CHECK_BUILD
DI unsigned hash_u(unsigned x) { x ^= x >> 16; x *= 0x7feb352du; x ^= x >> 15; x *= 0x846ca68bu; x ^= x >> 16; return x; }
DI float blk_sum(float v, LAS float* red, int tid, int nthr) {
    for (int o = 32; o >= 1; o >>= 1) v += __shfl_xor(v, o);
    __syncthreads(); if ((tid & 63) == 0) red[tid >> 6] = v; __syncthreads();
    float s = 0.f; for (int k = 0; k < nthr / 64; ++k) s += red[k]; __syncthreads(); return s;
}
__global__ void chk_proj(Args args) {
    const int lane = threadIdx.x & 63, smp = blockIdx.x * (blockDim.x >> 6) + (threadIdx.x >> 6);
    const bf16* hb = (const bf16*)(args.ws + WS_HB); const bf16* proj = (const bf16*)(args.ws + WS_PROJ); const float* win = (const float*)args.in[4]; const int* pos = (const int*)args.in[2];
    unsigned* res = (unsigned*)(args.ws + WS_CTL) + CW_CHK;
    const unsigned h = hash_u(smp * 2654435761u + 12345u);
    int row = h % M; if (smp < 4) row = (smp == 0) ? 0 : (smp == 1) ? 8191 : (smp == 2) ? 8192 : 16383;
    const int kind = smp % 15; const unsigned h2 = hash_u(h + 77u);
    const int srcb[15] = {0, 2048, 2560, 3072, 3584, 4096, 4608, 5120, 5168, 7216, 9264, 11312, 13360, 16432, 16464};
    const int dstb[15] = {C_Q, C_KC, C_VC, C_KS, C_VS, C_KW, C_VW, C_GN, C_CB, C_CC, C_CU, C_Z, C_XBC, C_DT, C_GM};
    const int wid[15] = {2048, 512, 512, 512, 512, 512, 512, 48, 2048, 2048, 2048, 2048, 3072, 32, 6144};
    const bool rope = (kind == 0 || kind == 1 || kind == 3 || kind == 5);
    int e = h2 % wid[kind]; if (rope) e = (e / 128) * 128 + (e % 64);
    float d0 = 0.f, d1 = 0.f;
    for (int k = lane; k < DM; k += 64) { const float a = bf2f(hb[(size_t)row * DM + k]); d0 += a * win[(size_t)k * PROJ_SRC + srcb[kind] + e]; if (rope) d1 += a * win[(size_t)k * PROJ_SRC + srcb[kind] + e + 64]; }
    for (int o = 32; o >= 1; o >>= 1) { d0 += __shfl_xor(d0, o); d1 += __shfl_xor(d1, o); }
    float e0 = d0, e1 = d1;
    if (rope) { const double inv = exp(-(double)(2 * (e % 64)) / 128.0 * 9.210340371976184); double ang = (double)pos[row] * inv; ang -= 6.283185307179586476925 * __builtin_rint(ang * 0.15915494309189533577); const float c = cosf((float)ang), s = sinf((float)ang); e0 = d0 * c - d1 * s; e1 = d1 * c + d0 * s; }
    if (lane == 0) {
        const bf16* kvb = (const bf16*)(args.ws + WS_KV);
        const bool inkv = (kind >= 1 && kind <= 6);
        const bf16* src = inkv ? kvb + kv_off(kind - 1, row >> 13, e >> 7, row & 8191) + (e & 127) : proj + (size_t)row * LDP + dstb[kind] + e;
        const float g0 = bf2f(src[0]); float err = fabsf(g0 - e0) / (0.03f + 0.02f * fabsf(e0));
        if (rope) { const float g1 = bf2f(src[64]); err = fmaxf(err, fabsf(g1 - e1) / (0.03f + 0.02f * fabsf(e1))); }
        if (!(err <= 1.0f)) atomicAdd(res + 0, 1u);
        atomicMax(res + 1, __float_as_uint(fminf(err, 1e6f)));
    }
}
__global__ void chk_cmp(Args args) {
    __shared__ float hid[128];
    const int tid = threadIdx.x, smp = blockIdx.x;
    const unsigned h = hash_u(smp * 40503u + 99u);
    const int kv = smp & 1, b = (smp >> 1) & 1, g = (smp >> 2) & 3; int n = h % NCMP; if (smp < 8) n = (smp < 4) ? 0 : 510;
    const bf16* proj = (const bf16*)(args.ws + WS_PROJ);
    const float* pe = (const float*)args.in[kv ? 6 : 5]; const float* w1 = (const float*)args.in[kv ? 11 : 7]; const float* b1 = (const float*)args.in[kv ? 12 : 8];
    const float* w2 = (const float*)args.in[kv ? 13 : 9]; const float* b2 = (const float*)args.in[kv ? 14 : 10];
    const bf16* out = (const bf16*)(args.ws + (kv ? WS_VCMP : WS_KCMP));
    unsigned* res = (unsigned*)(args.ws + WS_CTL) + CW_CHK;
    float s = b1[tid];
    for (int l = 0; l < 32; ++l) { const bf16* kr = (const bf16*)(args.ws + WS_KV) + kv_off(kv, b, g, 16 * n + l);
        for (int d = 0; d < 128; ++d) s += (bf2f(kr[d]) + pe[l * 128 + d]) * w1[(size_t)(l * 128 + d) * 128 + tid]; }
    hid[tid] = s / (1.0f + expf(-s));
    __syncthreads();
    float o = b2[tid];
    for (int k = 0; k < 128; ++k) o += hid[k] * w2[k * 128 + tid];
    const float got = bf2f(out[((size_t)(b * NG + g) * NCMP_PAD + n) * HD + tid]);
    const float err = fabsf(got - o) / (0.02f + 0.02f * fabsf(o));
    if (!(err <= 1.0f)) atomicAdd(res + 2, 1u);
    atomicMax(res + 3, __float_as_uint(fminf(err, 1e6f)));
}
constexpr int CHK_NT = 24;
__global__ void __launch_bounds__(256) chk_nsa(Args args) {
    __shared__ float qf[4][128], oacc[4][128], obr[4][128], sc[4][1024], imp[128], red[8];
    __shared__ int kl[1024], seln[16], usedl[128];
    const int tlist[CHK_NT] = {0, 1, 30, 31, 47, 63, 64, 65, 127, 128, 500, 511, 512, 513, 575, 1023, 1024, 1087, 2000, 4095, 4096, 6000, 8128, 8191};
    const int tid = threadIdx.x, smp = blockIdx.x;
    const int t = tlist[smp % CHK_NT], bg = (smp / CHK_NT + smp) & 7, b = bg >> 2, g = bg & 3, row = b * SEQ + t, cur = t >> 6;
    const bf16* proj = (const bf16*)(args.ws + WS_PROJ); const bf16* kcmp = (const bf16*)(args.ws + WS_KCMP) + (size_t)(b * NG + g) * NCMP_PAD * HD; const bf16* vcmp = (const bf16*)(args.ws + WS_VCMP) + (size_t)(b * NG + g) * NCMP_PAD * HD;
    const bf16* ya = (const bf16*)(args.ws + WS_YA);
    unsigned* res = (unsigned*)(args.ws + WS_CTL) + CW_CHK;
    const float scale = 0.08838834764831845f;
    for (int k = tid; k < 512; k += 256) { const int r = k >> 7, d = k & 127; qf[r][d] = bf2f(proj[(size_t)row * LDP + C_Q + (4 * g + r) * HD + d]); oacc[r][d] = 0.f; }
    __syncthreads();
    for (int br = 0; br < 3; ++br) {
        int nk = 0;
        if (br == 0) { nk = (t >= 31) ? ((t - 31) >> 4) + 1 : 0; for (int k = tid; k < nk; k += 256) kl[k] = k; }
        else if (br == 1) {
            if (tid == 0) {
                for (int j = 0; j < 128; ++j) usedl[j] = 0;
                for (int it = 0; it < 16; ++it) { int best = -1; float bv = 0.f;
                    for (int j = 0; j < 128; ++j) { if (usedl[j]) continue; const bool valid = (64 * j <= t); const bool forced = (j == 0) || (j == cur) || (j == cur - 1);
                        const float v = valid ? imp[j] + (forced ? 1.0e4f : 0.f) : -__builtin_inff();
                        if (best < 0 || v > bv) { best = j; bv = v; } }
                    usedl[best] = 1; seln[it] = best; } }
            __syncthreads();
            for (int k = tid; k < 1024; k += 256) kl[k] = seln[k >> 6] * 64 + (k & 63);
            nk = 1024;
        } else { nk = 576; for (int k = tid; k < 576; k += 256) kl[k] = (t & ~63) - WIN + k; }
        __syncthreads();
        for (int idx = tid; idx < 4 * nk; idx += 256) { const int r = idx / nk, k = idx - r * nk, key = kl[k];
            bool ok; const bf16* kp;
            if (br == 0) { ok = true; kp = kcmp + (size_t)key * HD; }
            else if (br == 1) { ok = (key <= t); kp = (const bf16*)(args.ws + WS_KV) + kv_off(2, b, g, key); }
            else { ok = (key >= 0) && (key <= t) && (key > t - WIN); kp = (const bf16*)(args.ws + WS_KV) + kv_off(4, b, g, key < 0 ? 0 : key); }
            float s = 0.f; for (int d = 0; d < 128; ++d) s += qf[r][d] * bf2f(kp[d]);
            sc[r][k] = ok ? s * scale : -__builtin_inff(); }
        __syncthreads();
        if (tid < 4) { float m = -__builtin_inff(); for (int k = 0; k < nk; ++k) m = fmaxf(m, sc[tid][k]);
            const float mm = (m > -1e30f) ? m : 0.f; float l = 0.f; for (int k = 0; k < nk; ++k) { const float e = (sc[tid][k] > -1e30f) ? expf(sc[tid][k] - mm) : 0.f; sc[tid][k] = e; l += e; }
            const float il = (l > 0.f) ? 1.0f / l : 0.f; for (int k = 0; k < nk; ++k) sc[tid][k] *= il; }
        __syncthreads();
        if (br == 0) { if (tid < 128) { float s = 0.f; for (int r = 0; r < 4; ++r) for (int n = 4 * tid - 1; n <= 4 * tid + 3; ++n) if (n >= 0 && n < nk) s += sc[r][n]; imp[tid] = s; } }
        for (int o = tid; o < 512; o += 256) { const int r = o >> 7, d = o & 127; float s = 0.f;
            for (int k = 0; k < nk; ++k) { const float p = sc[r][k]; if (p == 0.f) continue; const int key = kl[k];
                const bf16* vp = (br == 0) ? vcmp + (size_t)key * HD : (const bf16*)(args.ws + WS_KV) + kv_off(br == 1 ? 3 : 5, b, g, key);
                s += p * bf2f(vp[d]); }
            const float gate = 1.0f / (1.0f + expf(-bf2f(proj[(size_t)row * LDP + C_GN + (4 * g + r) * 3 + br])));
            oacc[r][d] += gate * s; obr[r][d] = s; }
        __syncthreads();
    }
    float errm = 0.f;
    for (int o = tid; o < 512; o += 256) { const int r = o >> 7, d = o & 127; const float got = bf2f(ya[(size_t)row * DM + (4 * g + r) * HD + d]), ex = oacc[r][d] * (CHECK_BUILD == 2 ? ((smp & 1) ? 1.5f : 1.0f) : 1.0f);
        errm = fmaxf(errm, fabsf(got - ex) / (0.006f + 0.03f * fabsf(ex))); }
    for (int o = 32; o >= 1; o >>= 1) errm = fmaxf(errm, __shfl_xor(errm, o));
    if ((tid & 63) == 0) red[tid >> 6] = errm;
    __syncthreads();
    if (tid == 0) { const float e = fmaxf(fmaxf(red[0], red[1]), fmaxf(red[2], red[3])); if (!(e <= 1.0f)) atomicAdd(res + 4, 1u); atomicMax(res + 5, __float_as_uint(fminf(e, 1e6f))); }
}
#ifndef CHK_B_SEL
#define CHK_B_SEL 5
#endif
__global__ void chk_report(Args args) {
    const unsigned* res = (const unsigned*)(args.ws + WS_CTL) + CW_CHK;
    const float A = 4.0f * (float)res[4] + (res[2] ? 2000.f : 0.f) + (res[0] ? 40000.f : 0.f);
    const float B = fminf(__uint_as_float(res[CHK_B_SEL]), 100.f);
    const size_t i = (size_t)blockIdx.x * blockDim.x + threadIdx.x;
    if (A > 0.f) { if (i == 0) args.out[0] += A; if (i >= 1 && i <= (1u << 20)) args.out[i] += B; }
}
#endif

constexpr int NPH_LAYER = 13, NPH = 2 + NPH_LAYER * DEPTH;
#ifndef PG8_SP2
#define PG8_SP2 true
#endif
#ifndef PG8_ALIGN
#define PG8_ALIGN true
#endif
#ifndef PH_MASK
#define PH_MASK 0xFFFFFFFFu
#endif
#ifndef REP_MASK
#define REP_MASK 0u
#endif
#ifndef REP_CNT
#define REP_CNT 2
#endif
#define REPN(kk) ((((unsigned)REP_MASK >> (kk)) & 1u) ? REP_CNT : 1)
#define INK(k, kk) (((PH_MASK >> (kk)) & 1u) && lo <= (k) && (k) < hi)
#if defined(TIME_PROBE)
#define STAMP(i) do { if (F.bid == 0 && F.tid == 0) ((unsigned long long*)(F.ctl + CW_TS))[i] = __builtin_amdgcn_s_memrealtime(); } while (0)
#else
#define STAMP(i) do { } while (0)
#endif
#if defined(BAR_TWICE)
#define SEAM_TWICE(x) x
#else
#define SEAM_TWICE(x)
#endif
#define SEAM(k) do { if (lo <= (k) && (k) + 1 < hi) { XcdBarrier b_ = bar; { unsigned long long p_ = (unsigned long long)bar.bar; asm volatile("" : "+s"(p_)); b_.bar = (unsigned*)p_; } xcd_barrier(b_); SEAM_TWICE(xcd_barrier(b_);) } STAMP((k) + 1); } while (0)
template <int LAYER> DI void g1_block(const Frame& F, const Args& args) {
    constexpr int layer = LAYER;
    bf16* hb = (bf16*)(F.ws + WS_HB); bf16* projb = (bf16*)(F.ws + WS_PROJ); bf16* eb = (bf16*)(F.ws + WS_EB);
#ifndef NO_G1
            { const Frame Fp = phase_frame(F);  pg8::Gemm g{hb, (const bf16*)lw_ptr(Fp, layer, LW_IN), M, LDP, DM}; pg8::StaticOrder S; S.init(M, LDP, Fp.G, Fp.bid);
              pg8::EpiB<2> E{projb, LDP, (const float*)(Fp.ws + WS_ROPE), (bf16*)(Fp.ws + WS_KV)};
              pg8::gemm_phase<pg8::EpiB<2>, pg8::StaticOrder, PG8_ALIGN, PG8_SP2>(Fp.lds, g, S, E, Fp.wave); }
#endif
#ifndef NO_G5
            { const Frame Fp = phase_frame(F);  pg8::Gemm g{(const bf16*)(Fp.ws + WS_PB) + (size_t)layer * M * PLE, (const bf16*)lw_ptr(Fp, layer, LW_PLE), M, DM, PLE}; pg8::LightOrder S; S.init(M, DM, Fp.G, Fp.bid);
              pg8::EpiB<0> E{eb, DM, nullptr, nullptr};
              pg8::gemm_phase<pg8::EpiB<0>, pg8::LightOrder, PG8_ALIGN, PG8_SP2>(Fp.lds, g, S, E, Fp.wave); }
#endif
}
template <int LAYER> DI void layer_phases(const Frame& F, const Args& args, const XcdBarrier& bar, const int lo, const int hi) {
    constexpr int layer = LAYER, layer_ = LAYER;
    float* xres = (float*)(F.ws + WS_X); bf16* hb = (bf16*)(F.ws + WS_HB); bf16* projb = (bf16*)(F.ws + WS_PROJ); bf16* ub = (bf16*)(F.ws + WS_U); bf16* eb = (bf16*)(F.ws + WS_EB);
        const int pb = 1 + NPH_LAYER * layer;
        const float* xin = (layer == 0) ? (const float*)argin(args, 0) : (const float*)xres;
        if (INK(pb + 0, 0)) { if (layer == 0) norm_rows<false>(F, xin, (const float*)argin(args, 3), hb);
                              else addnorm_rows<false>(F, xres, (const bf16*)(F.ws + WS_DELTA), (const float*)argin(args, 3) + (size_t)layer * DM, xres, hb); }
        SEAM(pb + 0);
        if (INK(pb + 1, 1)) { g1_block<LAYER>(F, args); if (REPN(1) >= 2) g1_block<LAYER>(F, args); }
        SEAM(pb + 1);
        if (INK(pb + 2, 2)) for (int rep = 0; rep < REPN(2); ++rep) { ssd_conv_pass(F, args, layer); compress_phase(F, args, layer); }
        SEAM(pb + 2);
        if (INK(pb + 3, 3)) for (int rep = 0; rep < REPN(3); ++rep) ssd_states_phase(F, args, layer);
        SEAM(pb + 3);
        if (INK(pb + 4, 4)) ssd_scan_phase(F);
        SEAM(pb + 4);
        if (INK(pb + 5, 5)) {
#ifndef NO_S3
            for (int rep = 0; rep < REPN(15); ++rep) ssd_out_phase(F, args, layer);
#endif
            STAMP(60 + layer);
#ifndef NO_NSA
            for (int rep = 0; rep < REPN(5); ++rep) nsa_phase(F, args, layer);
#endif
        }
        SEAM(pb + 5);
        if (INK(pb + 6, 6)) for (int rep = 0; rep < REPN(6); ++rep) merge_pass(F, args, layer);
        SEAM(pb + 6);
        if (INK(pb + 7, 7)) for (int rep = 0; rep < REPN(7); ++rep) { const Frame Fp = phase_frame(F);  pg8::Gemm g{hb, (const bf16*)lw_ptr(Fp, layer, LW_O), M, DM, DM}; pg8::StaticOrder S; S.init(M, DM, Fp.G, Fp.bid);
            pg8::EpiB<0> E{(bf16*)(Fp.ws + WS_DELTA), DM, nullptr, nullptr};
            pg8::gemm_phase<pg8::EpiB<0>, pg8::StaticOrder, PG8_ALIGN, PG8_SP2>(Fp.lds, g, S, E, Fp.wave); }
        SEAM(pb + 7);
        if (INK(pb + 8, 8)) for (int rep = 0; rep < REPN(8); ++rep) addnorm_rows<false>(F, xin, (const bf16*)(F.ws + WS_DELTA), (const float*)argin(args, 23) + (size_t)layer * DM, rep ? (float*)(F.ws + WS_ST) : xres, rep ? (bf16*)(F.ws + WS_ST + 128 * MiB - 64 * MiB) : hb);
        SEAM(pb + 8);
        if (INK(pb + 9, 9)) for (int rep = 0; rep < REPN(9); ++rep) { const Frame Fp = phase_frame(F);  pg8::Gemm g{hb, (const bf16*)lw_ptr(Fp, layer, LW_UP), M, DFF, DM}; pg8::StaticOrder S; S.init(M, DFF, Fp.G, Fp.bid);
            pg8::EpiB<1> E{ub, DFF, nullptr, nullptr};
            pg8::gemm_phase<pg8::EpiB<1>, pg8::StaticOrder, PG8_ALIGN, PG8_SP2>(Fp.lds, g, S, E, Fp.wave); }
        SEAM(pb + 9);
        if (INK(pb + 10, 10)) for (int rep = 0; rep < REPN(10); ++rep) { const Frame Fp = phase_frame(F);  pg8::Gemm g{ub, (const bf16*)lw_ptr(Fp, layer, LW_DOWN), M, DM, DFF}; pg8::StaticOrder S; S.init(M, DM, Fp.G, Fp.bid);
            pg8::EpiB<0> E{(bf16*)(Fp.ws + WS_DELTA), DM, nullptr, nullptr};
            pg8::gemm_phase<pg8::EpiB<0>, pg8::StaticOrder, PG8_ALIGN, PG8_SP2>(Fp.lds, g, S, E, Fp.wave); }
        SEAM(pb + 10);
        if (INK(pb + 11, 11)) addnorm_rows<false>(F, xres, (const bf16*)(F.ws + WS_DELTA), (const float*)argin(args, 26) + (size_t)layer * DM, xres, hb);
        SEAM(pb + 11);
        if (INK(pb + 12, 12)) for (int rep = 0; rep < REPN(12); ++rep) { const Frame Fp = phase_frame(F);  pg8::Gemm g{hb, (const bf16*)lw_ptr(Fp, layer, LW_PG), M, DM, DM}; pg8::StaticOrder S; S.init(M, DM, Fp.G, Fp.bid);
            pg8::EpiB<3> E{(bf16*)(Fp.ws + WS_DELTA), DM, (const float*)eb, nullptr};
            pg8::gemm_phase<pg8::EpiB<3>, pg8::StaticOrder, PG8_ALIGN, PG8_SP2>(Fp.lds, g, S, E, Fp.wave); }
        SEAM(pb + 12);
}
__global__ void __launch_bounds__(NTHR, 2) hyb_fwd(Args args) {
    extern __shared__ __attribute__((aligned(16))) unsigned char lds_raw[];
    Frame F;
    F.lds = (LAS unsigned char*)lds_raw; F.ws = args.ws; F.ctl = (gu32*)(args.ws + WS_CTL);
    F.tid = threadIdx.x; F.lane = F.tid & 63; F.wave = __builtin_amdgcn_readfirstlane(threadIdx.x >> 6); F.G = gridDim.x; F.bid = blockIdx.x;
    const int lo = args.ph_lo, hi = args.ph_hi;
    if (F.tid < 64) ((LAS unsigned*)(F.lds + LDSCTL_OFF))[F.tid] = 0u;
    __syncthreads();
    XcdBarrier bar; bar.bar = (unsigned*)(F.ctl + CW_BAR); bar.x = 0; bar.st = (volatile LAS unsigned*)(F.lds + LDSCTL_OFF);
    if (hi - lo > 1) bar = xcd_barrier_post((unsigned*)(F.ctl + CW_BAR), (volatile LAS unsigned*)(F.lds + LDSCTL_OFF));
    STAMP(0);
    if (INK(0, 13)) for (int rep = 0; rep < REPN(13); ++rep) p0_prologue(F, args);
    SEAM(0);
    layer_phases<0>(F, args, bar, lo, hi); layer_phases<1>(F, args, bar, lo, hi); layer_phases<2>(F, args, bar, lo, hi); layer_phases<3>(F, args, bar, lo, hi);
    float* xres = (float*)(F.ws + WS_X);
    int hi_l = hi; asm volatile("" : "+s"(hi_l));
    if (((PH_MASK >> 14) & 1u) && lo <= NPH - 1 && NPH - 1 < hi_l) addnorm_rows<true>(F, xres, (const bf16*)(F.ws + WS_DELTA), (const float*)argin(args, 29), nullptr, args.out);
#if defined(TIME_PROBE)
    { XcdBarrier b_ = bar; xcd_barrier(b_); STAMP(NPH);
      if (F.bid == 0) {
        LAS float* ab = (LAS float*)(F.lds);
        if (F.tid == 0) { const unsigned long long* ts = (const unsigned long long*)(F.ctl + CW_TS); float sum[17];
            float sA = 0.f, sB = 0.f;
            for (int ph = 0; ph < NPH; ++ph) { int kind = (ph == 0) ? 13 : (ph == NPH - 1) ? 14 : (ph - 1) % NPH_LAYER; float d = (float)(ts[ph + 1] - ts[ph]) * 0.01f;
                if (kind == 5) { const int L = (ph - 1) / NPH_LAYER; const float d3 = (float)(ts[60 + L] - ts[ph]) * 0.01f; if (TIME_PROBE_A == 15) sA += d3; if (TIME_PROBE_B == 15) sB += d3; d -= d3; }
                if (kind == TIME_PROBE_A || (TIME_PROBE_A == 16 && (kind == 0 || kind == 8 || kind == 11))) sA += d;
                if (kind == TIME_PROBE_B || (TIME_PROBE_B == 16 && (kind == 0 || kind == 8 || kind == 11))) sB += d; }
            ab[0] = sA; ab[1] = sB * 0.01f; (void)sum; }
        __syncthreads();
        const float A = ab[0], B = ab[1];
        if (F.tid == 0) args.out[0] += A;
        for (int j = 0; j < 2048; ++j) args.out[1 + F.tid + NTHR * j] += B;
      } }
#endif
#undef INK
#undef SEAM
}

#ifndef MK_ONE_LAUNCH
#define MK_ONE_LAUNCH 1
#endif
extern "C" void kernel_launch(void* const* d_in, const int* in_sizes, int n_in, void* d_out, int out_size, void* d_ws, size_t ws_size, hipStream_t stream) {
    static int grid = 0;
    if (grid == 0) {
        if (n_in != 30 || out_size != M * DM || ws_size < WS_END) { fprintf(stderr, "kernel_launch: unexpected shapes (n_in %d out %d ws %zu need %zu)\n", n_in, out_size, ws_size, (size_t)WS_END); grid = -1; return; }
        int dev = 0, cus = 0, per_cu = 0;
        if (hipGetDevice(&dev) != hipSuccess || hipDeviceGetAttribute(&cus, hipDeviceAttributeMultiprocessorCount, dev) != hipSuccess) { grid = -1; return; }
        if (hipFuncSetAttribute((const void*)hyb_fwd, hipFuncAttributeMaxDynamicSharedMemorySize, LDS_BYTES) != hipSuccess) { fprintf(stderr, "kernel_launch: hipFuncSetAttribute failed\n"); grid = -1; return; }
        if (hipOccupancyMaxActiveBlocksPerMultiprocessor(&per_cu, (const void*)hyb_fwd, NTHR, LDS_BYTES) != hipSuccess || per_cu < 1) { fprintf(stderr, "kernel_launch: occupancy query says %d\n", per_cu); }
        (void)hipGetLastError();
        grid = cus;
    }
    if (grid < 0) return;
    (void)hipMemsetAsync((char*)d_ws + WS_CTL, 0, CTL_ZERO_BYTES, stream);
    Args a{};
    for (int i = 0; i < 30; ++i) a.in[i] = d_in[i];
    a.out = (float*)d_out; a.ws = (unsigned char*)d_ws;
#if MK_ONE_LAUNCH
    a.ph_lo = 0; a.ph_hi = NPH;
    hipLaunchKernelGGL(hyb_fwd, dim3(grid), dim3(NTHR), LDS_BYTES, stream, a);
#else
    for (int ph = 0; ph < NPH; ++ph) { a.ph_lo = ph; a.ph_hi = ph + 1; hipLaunchKernelGGL(hyb_fwd, dim3(grid), dim3(NTHR), LDS_BYTES, stream, a);
#if defined(CHECK_BUILD) && CHECK_BUILD
        if (ph == 2) hipLaunchKernelGGL(chk_proj, dim3(1024), dim3(256), 0, stream, a);
        if (ph == 3) hipLaunchKernelGGL(chk_cmp, dim3(128), dim3(128), 0, stream, a);
        if (ph == 6) hipLaunchKernelGGL(chk_nsa, dim3(8 * CHK_NT), dim3(256), 0, stream, a);
        if (ph == NPH - 1) hipLaunchKernelGGL(chk_report, dim3(4098), dim3(256), 0, stream, a);
#endif
    }
#endif
    (void)in_sizes;
}
```

```cpp
#include <hip/hip_runtime.h>
#include <cstdio>
#include <cstdint>
namespace pg8 {
#define PG8_LAS __attribute__((address_space(3)))
typedef unsigned short bf16_t;
typedef short bf16x8 __attribute__((ext_vector_type(8)));
typedef float f32x4 __attribute__((ext_vector_type(4)));
typedef unsigned u32x4 __attribute__((ext_vector_type(4)));
constexpr int BM = 256, BK = 64, HALF = 128, HTB = HALF * BK * 2  , STAGE_BYTES = 8 * HTB, NXCD = 8,
#ifdef PG8_WGM
    WGM = PG8_WGM;
#else
    WGM = 8;
#endif

__host__ __device__ __forceinline__ int lds_byte(int r, int c) { const int st = (r >> 4) * 2 + (c >> 5), rr = r & 15, cc = c & 31, ob = rr * 64 + cc * 2; return st * 1024 + (ob ^ (((ob >> 9) & 1) << 5)); }
__host__ __device__ __forceinline__ void stage_rc(int b, int& R, int& C) { const int st = b / 1024, sb = b % 1024, swz = sb ^ (((sb >> 9) & 1) << 5); R = (st >> 1) * 16 + swz / 64; C = (st & 1) * 32 + (swz % 64) / 2; }
__host__ __device__ __forceinline__ int perm32(int rho) { const int n = rho >> 4, i = rho & 15; return 8 * (i >> 2) + 4 * n + (i & 3); }

struct Unit { int pm, pn; };
struct Gemm { const bf16_t* A; const bf16_t* Bt; int M, N, K; };

struct StaticOrder {
    int nM, nN, nwg, G, c;
    __host__ __device__ void init(int M, int N, int G_, int c_) { nM = M / BM; nN = N / BM; nwg = nM * nN; G = G_; c = c_; }
    __host__ __device__ bool next(int i, Unit& u) const {
        const long L = (long)i * G + c; if (L >= nwg) return false;
        int wgid = (int)L; { const int q = nwg / NXCD, r = nwg % NXCD, xcd = wgid % NXCD, off = wgid / NXCD; wgid = (xcd < r ? xcd * (q + 1) : r * (q + 1) + (xcd - r) * q) + off; }
        const int nig = WGM * nN, gid = wgid / nig, fm = gid * WGM, gsz = (nM - fm) < WGM ? (nM - fm) : WGM;
        u.pm = fm + ((wgid % nig) % gsz); u.pn = (wgid % nig) / gsz; return true;
    }
    __device__ __forceinline__ void a_ready(const Unit&) const {}
    __device__ __forceinline__ void done(const Unit&) const {}
};
__device__ __forceinline__ unsigned cvt_pk_bf16(float lo, float hi) { unsigned r; asm volatile("v_cvt_pk_bf16_f32 %0, %1, %2" : "=v"(r) : "v"(lo), "v"(hi)); return r; }
template <class Epi, class Sched, bool ALIGN_EPI = false, bool SP2 = false>
__device__ __forceinline__ void gemm_phase(PG8_LAS unsigned char* lds, const Gemm g, const Sched& S, const Epi& E, const int wave_idx  ) {
    int lane_l; asm volatile("v_mbcnt_lo_u32_b32 %0, -1, 0\n\tv_mbcnt_hi_u32_b32 %0, -1, %0" : "=v"(lane_l));
    const int wid = wave_idx, tid = wid * 64 + lane_l, lane = tid & 63, wr = wid >> 2, wc = wid & 3, fr = lane & 15, fq = lane >> 4;
    const int K = g.K, nt = K / BK;
    unsigned voffA[2], voffB[2];
#pragma unroll
    for (int i = 0; i < 2; ++i) { int R, C; stage_rc(tid * 16 + i * 8192, R, C); const int Rb = Epi::PERM ? ((R & ~31) + perm32(R & 31)) : R;
        voffA[i] = (unsigned)(R * K + C) * 2u; voffB[i] = (unsigned)(Rb * K + C) * 2u; }
    const size_t kstep = (size_t)(BK * 2);
    const size_t hstep = (size_t)HALF * K * 2;
    const size_t tstep = 2 * hstep;
    const unsigned ldsw = (unsigned)wid * 1024u;
    const int aoff = lds_byte(wr * 64 + fr, fq * 8), boff = lds_byte(wc * 32 + fr, fq * 8);
#define PG8_SA(b, h) (((b) * 2 + (h)) * HTB)
#define PG8_SB(b, h) ((4 + (b) * 2 + (h)) * HTB)
#define PG8_STAGE(bufoff, gbase, voff) do { _Pragma("unroll") for (int _i = 0; _i < 2; ++_i) \
        __builtin_amdgcn_global_load_lds((const unsigned*)((const char*)(gbase) + (voff)[_i]), (PG8_LAS unsigned*)(lds + (bufoff) + ldsw + _i * 8192), 16, 0, 0); } while (0)
#define PG8_LDA(dst, b, h) do { _Pragma("unroll") for (int m = 0; m < 4; ++m) _Pragma("unroll") for (int k = 0; k < 2; ++k) dst[m][k] = *(const PG8_LAS bf16x8*)(lds + PG8_SA(b, h) + aoff + m * 2048 + k * 1024); } while (0)
#define PG8_LDB(dst, b, h) do { _Pragma("unroll") for (int n = 0; n < 2; ++n) _Pragma("unroll") for (int k = 0; k < 2; ++k) dst[n][k] = *(const PG8_LAS bf16x8*)(lds + PG8_SB(b, h) + boff + n * 2048 + k * 1024); } while (0)
#define PG8_MMA(ai, bj, At, Bt) do { __builtin_amdgcn_s_setprio(1); _Pragma("unroll") for (int m = 0; m < 4; ++m) _Pragma("unroll") for (int n = 0; n < 2; ++n) _Pragma("unroll") for (int k = 0; k < 2; ++k) \
        acc[ai][bj][m][n] = __builtin_amdgcn_mfma_f32_16x16x32_bf16(Bt[n][k], At[m][k], acc[ai][bj][m][n], 0, 0, 0); __builtin_amdgcn_s_setprio(0); } while (0)
#define PG8_WAIT_V(n) asm volatile("s_waitcnt vmcnt(" #n ")" ::: "memory")
#define PG8_WAIT_L(n) asm volatile("s_waitcnt lgkmcnt(" #n ")" ::: "memory")
#define PG8_BAR __builtin_amdgcn_s_barrier()
#define PG8_SCHED __builtin_amdgcn_sched_barrier(0)
    Unit cur, nxt; int ui = 0;
    if (!S.next(0, cur)) return;
    f32x4 acc[2][2][4][2];
#pragma unroll
    for (int a = 0; a < 2; ++a)
#pragma unroll
        for (int b = 0; b < 2; ++b)
#pragma unroll
            for (int m = 0; m < 4; ++m)
#pragma unroll
                for (int n = 0; n < 2; ++n) acc[a][b][m][n] = (f32x4){0.f, 0.f, 0.f, 0.f};
    bf16x8 At[4][2], B0[2][2], B1[2][2];
    const char* cA = (const char*)g.A + (size_t)cur.pm * tstep; const char* cB = (const char*)g.Bt + (size_t)cur.pn * tstep;
    S.a_ready(cur);
    if constexpr (SP2) {
        PG8_STAGE(PG8_SB(0, 0), cB, voffB); PG8_STAGE(PG8_SB(0, 1), cB + hstep, voffB); PG8_STAGE(PG8_SA(0, 0), cA, voffA); PG8_STAGE(PG8_SA(0, 1), cA + hstep, voffA);
        if (wr == 1) PG8_BAR;
        PG8_WAIT_V(2); PG8_BAR;
        PG8_STAGE(PG8_SB(1, 0), cB + kstep, voffB); PG8_STAGE(PG8_SA(1, 0), cA + kstep, voffA); PG8_STAGE(PG8_SB(1, 1), cB + hstep + kstep, voffB);
        PG8_WAIT_V(6); PG8_BAR;
    } else {
        PG8_STAGE(PG8_SB(0, 0), cB, voffB); PG8_STAGE(PG8_SA(0, 0), cA, voffA); PG8_STAGE(PG8_SB(0, 1), cB + hstep, voffB); PG8_STAGE(PG8_SA(0, 1), cA + hstep, voffA);
        if (wr == 1) PG8_BAR;
        PG8_WAIT_V(4); PG8_BAR;
        PG8_STAGE(PG8_SB(1, 0), cB + kstep, voffB); PG8_STAGE(PG8_SA(1, 0), cA + kstep, voffA); PG8_STAGE(PG8_SB(1, 1), cB + hstep + kstep, voffB);
        PG8_WAIT_V(6); PG8_BAR;
    }
    for (;;) {
        const bool has_next = S.next(ui + 1, nxt);
        const char* nA = has_next ? (const char*)g.A + (size_t)nxt.pm * tstep : cA; const char* nB = has_next ? (const char*)g.Bt + (size_t)nxt.pn * tstep : cB;
        for (int t = 0; t < nt; t += 2) {
            const bool last = (t == nt - 2);
            const char* a1 = cA + (size_t)(t + 1) * kstep;
            const char* a2 = last ? nA : cA + (size_t)(t + 2) * kstep; const char* b2 = last ? nB : cB + (size_t)(t + 2) * kstep;
            const char* a3 = a2 + kstep; const char* b3 = b2 + kstep;
            if (last && has_next) S.a_ready(nxt);
            if constexpr (SP2) {
            PG8_LDB(B0, 0, 0); PG8_LDB(B1, 0, 1); PG8_SCHED; PG8_LDA(At, 0, 0); PG8_STAGE(PG8_SA(1, 1), a1 + hstep, voffA);
            PG8_WAIT_V(8); PG8_WAIT_L(0); PG8_BAR; PG8_MMA(0, 0, At, B0); PG8_MMA(0, 1, At, B1); PG8_BAR; PG8_SCHED;
            PG8_LDA(At, 0, 1); PG8_STAGE(PG8_SB(0, 0), b2, voffB); PG8_STAGE(PG8_SB(0, 1), b2 + hstep, voffB); PG8_STAGE(PG8_SA(0, 0), a2, voffA);
            PG8_WAIT_V(8); PG8_WAIT_L(0); PG8_BAR; PG8_MMA(1, 0, At, B0); PG8_MMA(1, 1, At, B1); PG8_BAR; PG8_SCHED;
            PG8_LDB(B0, 1, 0); PG8_LDB(B1, 1, 1); PG8_SCHED; PG8_LDA(At, 1, 0); PG8_STAGE(PG8_SA(0, 1), a2 + hstep, voffA);
            PG8_WAIT_V(8); PG8_WAIT_L(0); PG8_BAR; PG8_MMA(0, 0, At, B0); PG8_MMA(0, 1, At, B1); PG8_BAR; PG8_SCHED;
            PG8_LDA(At, 1, 1); PG8_STAGE(PG8_SB(1, 0), b3, voffB); PG8_STAGE(PG8_SB(1, 1), b3 + hstep, voffB); PG8_STAGE(PG8_SA(1, 0), a3, voffA);
            PG8_WAIT_V(8); PG8_WAIT_L(0); PG8_BAR; PG8_MMA(1, 0, At, B0); PG8_MMA(1, 1, At, B1); PG8_BAR; PG8_SCHED;
            } else {
            PG8_LDB(B0, 0, 0); PG8_SCHED; PG8_LDA(At, 0, 0); PG8_STAGE(PG8_SA(1, 1), a1 + hstep, voffA);
            PG8_WAIT_L(8); PG8_BAR; PG8_WAIT_L(0); PG8_MMA(0, 0, At, B0); PG8_BAR; PG8_SCHED;
            PG8_LDB(B1, 0, 1); PG8_STAGE(PG8_SB(0, 0), b2, voffB);
            PG8_BAR; PG8_WAIT_L(0); PG8_MMA(0, 1, At, B1); PG8_BAR;
            PG8_LDA(At, 0, 1); PG8_STAGE(PG8_SA(0, 0), a2, voffA);
            PG8_BAR; PG8_WAIT_L(0); PG8_MMA(1, 0, At, B0); PG8_BAR; PG8_SCHED;
            PG8_STAGE(PG8_SB(0, 1), b2 + hstep, voffB);
            PG8_WAIT_V(6); PG8_BAR; PG8_MMA(1, 1, At, B1); PG8_BAR;
            PG8_LDB(B0, 1, 0); PG8_SCHED; PG8_LDA(At, 1, 0); PG8_STAGE(PG8_SA(0, 1), a2 + hstep, voffA);
            PG8_WAIT_L(8); PG8_BAR; PG8_WAIT_L(0); PG8_MMA(0, 0, At, B0); PG8_BAR; PG8_SCHED;
            PG8_LDB(B1, 1, 1); PG8_STAGE(PG8_SB(1, 0), b3, voffB);
            PG8_BAR; PG8_WAIT_L(0); PG8_MMA(0, 1, At, B1); PG8_BAR;
            PG8_LDA(At, 1, 1); PG8_STAGE(PG8_SA(1, 0), a3, voffA);
            PG8_BAR; PG8_WAIT_L(0); PG8_MMA(1, 0, At, B0); PG8_BAR; PG8_SCHED;
            PG8_STAGE(PG8_SB(1, 1), b3 + hstep, voffB);
            PG8_WAIT_V(6); PG8_BAR; PG8_MMA(1, 1, At, B1); PG8_BAR;
            }
        }
        if constexpr (ALIGN_EPI) { if (wr == 0) PG8_BAR; }
        if constexpr (!Epi::AFTER_DRAIN) { E(acc, cur, wr, wc, fr, fq);
#if defined(EPI_TWICE)
            if constexpr (Epi::PERM) E(acc, cur, wr, wc, fr, fq);
#endif
            S.done(cur); }
        if (!has_next) break;
#pragma unroll
        for (int a = 0; a < 2; ++a)
#pragma unroll
            for (int b = 0; b < 2; ++b)
#pragma unroll
                for (int m = 0; m < 4; ++m)
#pragma unroll
                    for (int n = 0; n < 2; ++n) acc[a][b][m][n] = (f32x4){0.f, 0.f, 0.f, 0.f};
        cur = nxt; cA = nA; cB = nB; ++ui;
        if constexpr (ALIGN_EPI) { if (wr == 1) PG8_BAR; }
    }
    PG8_WAIT_V(0);
    if constexpr (!ALIGN_EPI) { if (wr == 0) PG8_BAR; }
    PG8_BAR;
    if constexpr (Epi::AFTER_DRAIN) { E.fused(acc, cur, wr, wc, fr, fq, lds, wid, lane); S.done(cur); }
#undef PG8_SA
#undef PG8_SB
#undef PG8_STAGE
#undef PG8_LDA
#undef PG8_LDB
#undef PG8_MMA
#undef PG8_WAIT_V
#undef PG8_WAIT_L
#undef PG8_BAR
#undef PG8_SCHED
}
}

constexpr int BATCH = 2, SEQ = 8192, DM = 2048, DEPTH = 4;
constexpr int M = BATCH * SEQ;
constexpr int NH = 16, HD = 128, NG = 4, RH = 4;
constexpr int NCMP = 511, NCMP_PAD = 512, NSLC = 128, NSEL = 16, WIN = 512;
constexpr int SSD_H = 32, SSD_P = 64, SSD_N = 128, SSD_G = 4, SSD_CH = 128, SSD_NC = 64, SSD_XBC = 3072;
constexpr int DFF = 8192, PLE = 256;
constexpr float EPS = 1e-6f;
constexpr int PROJ_SRC = 22608;
constexpr int C_Q = 0, C_KC = 2048, C_VC = 2560, C_KS = 3072, C_VS = 3584, C_KW = 4096, C_VW = 4608;
constexpr int C_CB = 5120, C_CC = 7168, C_CU = 9216, C_Z = 11264, C_XBC = 13312, C_GM = 16384, C_GN = 22528, C_DT = 22592;
constexpr int LDP = 22784;
constexpr int S_GN = 5120, S_DT = 16432;

constexpr size_t MiB = 1u << 20;
constexpr size_t WS_CTL = 0, CTL_ZERO_BYTES = 1 * MiB;
constexpr size_t WS_ROPE = 1 * MiB;
constexpr size_t WS_MISC = 9 * MiB;
constexpr size_t WS_DT = 10 * MiB;
constexpr size_t WS_ACS = 12 * MiB;
constexpr size_t WS_CDEC = 14 * MiB;
constexpr size_t WS_KCMP = 15 * MiB;
constexpr size_t WS_VCMP = 16 * MiB;
constexpr size_t WS_X = 32 * MiB;
constexpr size_t WS_HB = 160 * MiB;
constexpr size_t WS_PB = 224 * MiB;
constexpr size_t WS_EB = 256 * MiB;
constexpr size_t WS_YA = 320 * MiB;
constexpr size_t WS_YC = 384 * MiB;
constexpr size_t WS_XBC = 448 * MiB;
constexpr size_t WS_ST = 544 * MiB;
constexpr size_t WS_PROJ = 672 * MiB;
constexpr size_t WS_U = WS_PROJ;
constexpr size_t WS_W = 1384 * MiB;
constexpr size_t LW_IN = 0;
constexpr size_t LW_O = 89 * MiB;
constexpr size_t LW_UP = 97 * MiB;
constexpr size_t LW_DOWN = 129 * MiB;
constexpr size_t LW_PG = 161 * MiB;
constexpr size_t LW_PLE = 169 * MiB;
constexpr size_t LW_PK1 = 170 * MiB;
constexpr size_t LW_PV1 = 171 * MiB;
constexpr size_t LW_PK2 = 172 * MiB;
constexpr size_t LW_PV2 = 172 * MiB + 64 * 1024;
constexpr size_t LW_STRIDE = 173 * MiB;
constexpr size_t WS_HIN = WS_W + 4 * LW_STRIDE;
constexpr size_t WS_RSTD = WS_MISC + 512 * 1024;
constexpr size_t WS_DELTA = WS_HIN + 64 * MiB;
constexpr size_t WS_KV = WS_DELTA + 64 * MiB;
constexpr size_t WS_END = WS_KV + 96 * MiB;
static_assert((size_t)M * LDP * 2 <= 712 * MiB && (size_t)LDP * 2048 * 2 <= 89 * MiB, "ws map");

constexpr int CW_BAR = 4096;
constexpr int CW_CHK = 16384;
constexpr int CW_TS = 20480;

constexpr int RING_BYTES = 131072;
constexpr int LX_OFF = RING_BYTES;
constexpr int LX_BYTES = 8192;
constexpr int LDSCTL_OFF = LX_OFF + LX_BYTES;
constexpr int LDS_BYTES = LDSCTL_OFF + 256;
constexpr int NWAVES = 8, NTHR = 512;

#define DI __device__ __forceinline__
#define GAS __attribute__((address_space(1)))
#define LAS __attribute__((address_space(3)))
typedef unsigned short bf16;
typedef unsigned u32x4 __attribute__((ext_vector_type(4)));
typedef unsigned u32x2 __attribute__((ext_vector_type(2)));
typedef float f32x4 __attribute__((ext_vector_type(4)));
typedef float f32x2 __attribute__((ext_vector_type(2)));
typedef short bf16x8 __attribute__((ext_vector_type(8)));
typedef short s16x4 __attribute__((ext_vector_type(4)));
typedef GAS unsigned gu32;
#define RLX_AGENT __ATOMIC_RELAXED, __HIP_MEMORY_SCOPE_AGENT
#define LDS_WAIT() asm volatile("s_waitcnt lgkmcnt(0)" ::: "memory")
#define VM_WAIT() asm volatile("s_waitcnt vmcnt(0)" ::: "memory")
DI size_t kv_off(int kind, int b, int g, int t) { return ((((size_t)kind * BATCH + b) * NG + g) * SEQ + t) * HD; }
DI unsigned f2bf(float f) { unsigned u = __builtin_bit_cast(unsigned, f); return (u + 0x7fffu + ((u >> 16) & 1u)) >> 16; }
DI unsigned pk2(float lo, float hi) { unsigned r; asm("v_cvt_pk_bf16_f32 %0, %1, %2" : "=v"(r) : "v"(lo), "v"(hi)); return r; }
DI float bf2f(unsigned h) { return __builtin_bit_cast(float, h << 16); }
DI float bflo(unsigned w) { return __builtin_bit_cast(float, w << 16); }
DI float bfhi(unsigned w) { return __builtin_bit_cast(float, w & 0xffff0000u); }
DI float sigmoidf_(float x) { return 1.0f / (1.0f + __expf(-x)); }
DI float siluf_(float x) { return x / (1.0f + __expf(-x)); }
DI float shfl_idx(float v, int src) { return __builtin_bit_cast(float, __builtin_amdgcn_ds_bpermute(src << 2, __builtin_bit_cast(int, v))); }
DI unsigned shfl_idx_u(unsigned v, int src) { return (unsigned)__builtin_amdgcn_ds_bpermute(src << 2, (int)v); }
DI float shx(float v, int m, int lane) { return shfl_idx(v, lane ^ m); }
DI float xq_max(float x) {
    float a = x, b = x;
    asm("s_nop 1\n\tv_permlane32_swap_b32 %0, %1" : "+v"(a), "+v"(b)); x = fmaxf(a, b);
    a = x; b = x;
    asm("s_nop 1\n\tv_permlane16_swap_b32 %0, %1" : "+v"(a), "+v"(b)); return fmaxf(a, b);
}
DI float xq_sum(float x) {
    float a = x, b = x;
    asm("s_nop 1\n\tv_permlane32_swap_b32 %0, %1" : "+v"(a), "+v"(b)); x = a + b;
    a = x; b = x;
    asm("s_nop 1\n\tv_permlane16_swap_b32 %0, %1" : "+v"(a), "+v"(b)); return a + b;
}
DI float quad_sum(float v) {
    v += __builtin_bit_cast(float, __builtin_amdgcn_update_dpp(0, __builtin_bit_cast(int, v), 0xB1, 0xF, 0xF, true));
    v += __builtin_bit_cast(float, __builtin_amdgcn_update_dpp(0, __builtin_bit_cast(int, v), 0x4E, 0xF, 0xF, true));
    return v;
}
DI float wave_sum(float v, int lane) {
#pragma unroll
    for (int o = 1; o < 64; o <<= 1) v += shx(v, o, lane);
    return v;
}
DI unsigned off_b(unsigned row, unsigned ch) { return 256u * row + 16u * (ch ^ (((row & 3u) << 2) | ((row >> 2) & 3u))); }
DI unsigned tr_addr(unsigned lane, unsigned r0, unsigned c, unsigned t) {
    const unsigned g = lane >> 4, q = (lane & 15u) >> 2, p = lane & 3u;
    return off_b(r0 + 8u * g + 4u * t + q, 2u * c + (p >> 1)) + 8u * (p & 1u);
}
DI s16x4 tr_read(LAS const unsigned char* p) { return __builtin_amdgcn_ds_read_tr16_b64_v4i16((LAS s16x4*)p); }
DI bf16x8 tr_read8(LAS const unsigned char* base, unsigned lane, unsigned r0, unsigned c) {
    const s16x4 lo = tr_read(base + tr_addr(lane, r0, c, 0)), hi = tr_read(base + tr_addr(lane, r0, c, 1));
    return __builtin_shufflevector(lo, hi, 0, 1, 2, 3, 4, 5, 6, 7);
}
DI bf16x8 lds_rd8(LAS const unsigned char* p) { return *(const LAS bf16x8*)p; }
DI bf16x8 as_bf16x8(u32x4 v) { return __builtin_bit_cast(bf16x8, v); }
#define MFMA16(a, b, c) __builtin_amdgcn_mfma_f32_16x16x32_bf16((a), (b), (c), 0, 0, 0)

namespace pg8 {
struct LightOrder {
    int G, c, nunits, nN;
    __host__ __device__ void init(int M, int N, int G_, int c_) { G = G_; c = c_; nN = N / BM; nunits = (M / BM) * nN; }
    __host__ __device__ bool next(int i, Unit& u) const {
        int j;
        if (G == 256) { if (c < 64) return false; j = (c - 64) + 192 * i; } else j = c + G * i;
        if (j >= nunits) return false;
        u.pm = j / nN; u.pn = j % nN; return true;
    }
    __device__ __forceinline__ void a_ready(const Unit&) const {}
    __device__ __forceinline__ void done(const Unit&) const {}
};
template <int MODE> struct EpiB {
    static constexpr bool PERM = true, AFTER_DRAIN = false;
    bf16_t* O; int ldc; const float* rope;
    bf16_t* kv;
    __device__ __forceinline__ void operator()(const f32x4 (&acc)[2][2][4][2], const Unit& u, int wr, int wc, int fr, int fq) const {
        { int l; asm volatile("v_mbcnt_lo_u32_b32 %0, -1, 0\n\tv_mbcnt_hi_u32_b32 %0, -1, %0" : "=v"(l)); fr = l & 15; fq = l >> 4; }
        const int row0 = u.pm * BM + wr * 64 + fr;
        bool rp = false;
        if (MODE == 2) { const int pn = u.pn; rp = (pn < 10) || pn == 12 || pn == 13 || pn == 16 || pn == 17; }
        if (MODE == 2 && rp) {
            const int colb = u.pn * BM + 128 * (wc >> 1) + 32 * (wc & 1) + 8 * fq, jj0 = 32 * (wc & 1) + 8 * fq;
#pragma unroll
            for (int ai = 0; ai < 2; ++ai)
#pragma unroll
                for (int m = 0; m < 4; ++m) {
                    const int row = row0 + ai * HALF + m * 16;
                    const float* rpp = (const float*)((const char*)rope + (unsigned)(((unsigned)row * 64u + (unsigned)jj0) * 8u));
                    const f32x4 cs0 = *(const f32x4*)(rpp), cs1 = *(const f32x4*)(rpp + 4), cs2 = *(const f32x4*)(rpp + 8), cs3 = *(const f32x4*)(rpp + 12);
                    const f32x4 x1a = acc[ai][0][m][0], x1b = acc[ai][0][m][1], x2a = acc[ai][1][m][0], x2b = acc[ai][1][m][1];
                    float c[8] = {cs0[0], cs0[2], cs1[0], cs1[2], cs2[0], cs2[2], cs3[0], cs3[2]};
                    float s[8] = {cs0[1], cs0[3], cs1[1], cs1[3], cs2[1], cs2[3], cs3[1], cs3[3]};
                    float x1[8] = {x1a[0], x1a[1], x1a[2], x1a[3], x1b[0], x1b[1], x1b[2], x1b[3]};
                    float x2[8] = {x2a[0], x2a[1], x2a[2], x2a[3], x2b[0], x2b[1], x2b[2], x2b[3]};
                    float o1[8], o2[8];
#pragma unroll
                    for (int k = 0; k < 8; ++k) { o1[k] = x1[k] * c[k] - x2[k] * s[k]; o2[k] = x2[k] * c[k] + x1[k] * s[k]; }
                    u32x4 w1, w2;
                    w1.x = cvt_pk_bf16(o1[0], o1[1]); w1.y = cvt_pk_bf16(o1[2], o1[3]); w1.z = cvt_pk_bf16(o1[4], o1[5]); w1.w = cvt_pk_bf16(o1[6], o1[7]);
                    w2.x = cvt_pk_bf16(o2[0], o2[1]); w2.y = cvt_pk_bf16(o2[2], o2[3]); w2.z = cvt_pk_bf16(o2[4], o2[5]); w2.w = cvt_pk_bf16(o2[6], o2[7]);
                    bf16_t* rowp = (bf16_t*)((char*)O + (unsigned)(((unsigned)row * (unsigned)ldc + (unsigned)colb) * 2u));
                    if (u.pn >= 8) { const int kind = (u.pn - 8) >> 1, g = 2 * (u.pn & 1) + (wc >> 1);
                        rowp = kv + ((((size_t)kind * 2 + (row >> 13)) * 4 + g) * 8192 + (row & 8191)) * 128 + jj0; }
                    *(u32x4*)(rowp) = w1; *(u32x4*)(rowp + 64) = w2;
                    asm volatile("" ::: "memory");
                }
        } else {
            const int col0 = u.pn * BM + wc * 32 + 8 * fq;
#pragma unroll
            for (int ai = 0; ai < 2; ++ai)
#pragma unroll
                for (int m = 0; m < 4; ++m) { bf16_t* rowp = (bf16_t*)((char*)O + (unsigned)(((unsigned)(row0 + ai * HALF + m * 16) * (unsigned)ldc + (unsigned)col0) * 2u));
#pragma unroll
                    for (int bj = 0; bj < 2; ++bj) { f32x4 v0 = acc[ai][bj][m][0], v1 = acc[ai][bj][m][1];
                        if (MODE == 1) {
#pragma unroll
                            for (int k = 0; k < 4; ++k) { const float a = fmaxf(v0[k], 0.f), b = fmaxf(v1[k], 0.f); v0[k] = a * a; v1[k] = b * b; } }
                        if (MODE == 3) { const u32x4 ev = *(const u32x4*)((const bf16_t*)rope + (rowp - O) + bj * HALF);
                            const float e[8] = {__builtin_bit_cast(float, ev.x << 16), __builtin_bit_cast(float, ev.x & 0xffff0000u), __builtin_bit_cast(float, ev.y << 16), __builtin_bit_cast(float, ev.y & 0xffff0000u),
                                                __builtin_bit_cast(float, ev.z << 16), __builtin_bit_cast(float, ev.z & 0xffff0000u), __builtin_bit_cast(float, ev.w << 16), __builtin_bit_cast(float, ev.w & 0xffff0000u)};
#pragma unroll
                            for (int k = 0; k < 4; ++k) { v0[k] = e[k] / (1.0f + __expf(-v0[k])); v1[k] = e[4 + k] / (1.0f + __expf(-v1[k])); } }
                        u32x4 w; w.x = cvt_pk_bf16(v0[0], v0[1]); w.y = cvt_pk_bf16(v0[2], v0[3]); w.z = cvt_pk_bf16(v1[0], v1[1]); w.w = cvt_pk_bf16(v1[2], v1[3]);
                        if (MODE == 2 && u.pn >= 8 && u.pn < 20) { const int kind = (u.pn - 8) >> 1, g = 2 * (u.pn & 1) + bj, row = row0 + ai * HALF + m * 16;
                            *(u32x4*)(kv + ((((size_t)kind * 2 + (row >> 13)) * 4 + g) * 8192 + (row & 8191)) * 128 + wc * 32 + 8 * fq) = w; }
                        else *(u32x4*)(rowp + bj * HALF) = w; } }
        }
    }
};
template <bool GATE> struct EpiRes {
    static constexpr bool PERM = false, AFTER_DRAIN = false;
    const float* xin; float* xout; int ldc; const bf16_t* e;
    __device__ __forceinline__ void operator()(const f32x4 (&acc)[2][2][4][2], const Unit& u, int wr, int wc, int fr, int fq) const {
        { int l; asm volatile("v_mbcnt_lo_u32_b32 %0, -1, 0\n\tv_mbcnt_hi_u32_b32 %0, -1, %0" : "=v"(l)); fr = l & 15; fq = l >> 4; }
        const int row0 = u.pm * BM + wr * 64 + fr, col0 = u.pn * BM + wc * 32 + 4 * fq;
#pragma unroll
        for (int ai = 0; ai < 2; ++ai)
#pragma unroll
            for (int m = 0; m < 4; ++m) { const unsigned off = (unsigned)(row0 + ai * HALF + m * 16) * (unsigned)ldc + (unsigned)col0;
#pragma unroll
                for (int bj = 0; bj < 2; ++bj)
#pragma unroll
                    for (int n = 0; n < 2; ++n) { const unsigned o = off + bj * HALF + n * 16; const f32x4 xv = *(const f32x4*)((const char*)xin + (unsigned)(o * 4u)); f32x4 a = acc[ai][bj][m][n];
                        if (GATE) { typedef unsigned u32x2v __attribute__((ext_vector_type(2))); const u32x2v ev = *(const u32x2v*)((const char*)e + (unsigned)(o * 2u));
                            const float e0 = __builtin_bit_cast(float, ev.x << 16), e1 = __builtin_bit_cast(float, ev.x & 0xffff0000u), e2 = __builtin_bit_cast(float, ev.y << 16), e3 = __builtin_bit_cast(float, ev.y & 0xffff0000u);
                            a[0] = e0 / (1.0f + __expf(-a[0])); a[1] = e1 / (1.0f + __expf(-a[1])); a[2] = e2 / (1.0f + __expf(-a[2])); a[3] = e3 / (1.0f + __expf(-a[3])); }
                        *(f32x4*)((char*)xout + (unsigned)(o * 4u)) = xv + a; }
                asm volatile("" ::: "memory"); }
    }
};
}
#define XB_TMO      128
#define XB_XCNT(j)  (256  + 64 * (j))
#define XB_XSUB(j)  (1280 + 64 * (j))
#define XB_XGEN(j)  (2304 + 64 * (j))
#define XB_TOP      3328
#define XB_TOPGEN   3392
#define XCD_BAR_WORDS 3456
#define XB_SPIN_CAP (1u << 18)

__device__ __forceinline__ unsigned xb_ld(unsigned* p)              { return __hip_atomic_load(p, __ATOMIC_RELAXED, __HIP_MEMORY_SCOPE_AGENT); }
__device__ __forceinline__ unsigned xb_add(unsigned* p, unsigned v) { return __hip_atomic_fetch_add(p, v, __ATOMIC_RELAXED, __HIP_MEMORY_SCOPE_AGENT); }
__device__ __forceinline__ unsigned xb_xcc_id() { return (unsigned)__builtin_amdgcn_s_getreg((3 << 11) | 20) & 0xFu; }
#define XB_SPIN(cond, bar) do { unsigned _sp = 0; while (cond) { __builtin_amdgcn_s_sleep(1); \
    if ((++_sp & 255u) == 0u) { if (xb_ld(&(bar)[XB_TMO])) break; if (_sp > XB_SPIN_CAP) { atomicAdd(&(bar)[XB_TMO], 1u); break; } } } } while (0)

struct XcdBarrier {
    unsigned* bar; unsigned x;
    volatile LAS unsigned* st;
};

__device__ __forceinline__ XcdBarrier xcd_barrier_post(unsigned* bar, volatile LAS unsigned* st) {
    XcdBarrier b; b.bar = bar; b.x = xb_xcc_id(); b.st = st;
    if (threadIdx.x == 0) (void)xb_add(&bar[XB_XCNT(b.x)], 1u);
    return b;
}
__device__ __forceinline__ void xcd_barrier_complete(unsigned* bar, unsigned x, unsigned& nloc, unsigned& nx) {
    const unsigned G = gridDim.x * gridDim.y * gridDim.z;
    unsigned sum, cnt, mine, sp = 0u;
    for (;;) {
        sum = 0u; cnt = 0u; mine = 0u;
#pragma unroll
        for (unsigned j = 0; j < 16; ++j) { const unsigned c = xb_ld(&bar[XB_XCNT(j)]); sum += c; cnt += (c > 0u) ? 1u : 0u; mine = (j == x) ? c : mine; }
        if (sum == G) break;
        __builtin_amdgcn_s_sleep(1);
        if ((++sp & 255u) == 0u) { if (xb_ld(&bar[XB_TMO])) break; if (sp > XB_SPIN_CAP) { atomicAdd(&bar[XB_TMO], 1u); break; } }
    }
    nloc = mine > 0u ? mine : 1u; nx = cnt > 0u ? cnt : 1u;
}

__device__ __forceinline__ void xcd_barrier(const XcdBarrier& b) {
    asm volatile("s_waitcnt vmcnt(0)" ::: "memory");
    __syncthreads();
    if (threadIdx.x == 0) {
        unsigned* bar = b.bar;
        __builtin_amdgcn_s_waitcnt(0);
        unsigned nloc = b.st[0], nx = b.st[1];
        if (nloc == 0u) { xcd_barrier_complete(bar, b.x, nloc, nx); b.st[0] = nloc; b.st[1] = nx; }
        const unsigned old = xb_add(&bar[XB_XSUB(b.x)], 1u);
        const unsigned gen = old / nloc;
        if (old + 1u == (gen + 1u) * nloc) {
            __builtin_amdgcn_fence(__ATOMIC_RELEASE, "agent");
            asm volatile("s_waitcnt vmcnt(0)" ::: "memory");
            const unsigned og = xb_add(&bar[XB_TOP], 1u);
            const unsigned tg = og / nx;
            if (og + 1u == (tg + 1u) * nx) xb_add(&bar[XB_TOPGEN], 1u);
            else XB_SPIN(xb_ld(&bar[XB_TOPGEN]) == tg, bar);
            __builtin_amdgcn_fence(__ATOMIC_ACQUIRE, "agent");
            xb_add(&bar[XB_XGEN(b.x)], 1u);
            asm volatile("s_waitcnt vmcnt(0)" ::: "memory");
        } else {
            XB_SPIN(xb_ld(&bar[XB_XGEN(b.x)]) == gen, bar);
            __builtin_amdgcn_fence(__ATOMIC_ACQUIRE, "agent");
            asm volatile("s_waitcnt vmcnt(0)" ::: "memory");
        }
    }
    __syncthreads();
}

struct Args { const void* in[30]; float* out; unsigned char* ws; int ph_lo, ph_hi; };
struct Frame {
    LAS unsigned char* lds;
    gu32* ctl;
    unsigned char* ws;
    int tid, lane, wave, G, bid;
};
DI const void* argin(const Args&, int k) {
    typedef const void* const __attribute__((address_space(4)))* kptr_t;
    kptr_t p = (kptr_t)__builtin_amdgcn_kernarg_segment_ptr(); asm volatile("" : "+s"(p));
    return (const void*)p[k]; }
DI int launder_s(int x) { asm volatile("" : "+s"(x)); return x; }
DI Frame phase_frame(const Frame& F0) { Frame F = F0;
    int l; asm volatile("v_mbcnt_lo_u32_b32 %0, -1, 0\n\tv_mbcnt_hi_u32_b32 %0, -1, %0" : "=v"(l));
    F.wave = launder_s(F0.wave); F.bid = launder_s(F0.bid); F.G = launder_s(F0.G);
    F.lane = l; F.tid = F.wave * 64 + l;
    { unsigned long long wsb = (unsigned long long)F0.ws; asm volatile("" : "+s"(wsb)); F.ws = (unsigned char*)wsb; }
    { unsigned ll = (unsigned)(size_t)F0.lds; asm volatile("" : "+s"(ll)); F.lds = (LAS unsigned char*)(size_t)ll; }
    return F; }
DI unsigned char* lw_ptr(const Frame& F, int layer, size_t off) { return F.ws + WS_W + (size_t)layer * LW_STRIDE + off; }

template <bool FRAGMAJOR = false>
DI void transpose_item(const float* W, int K, int Nsrc, int nsrc0, bf16* WT, int dst_row0, int k0, LAS float* scr, int lane) {
#pragma unroll 8
    for (int i = 0; i < 32; ++i) { const int kk = 2 * i + (lane >> 5); scr[kk * 33 + (lane & 31)] = W[(size_t)(k0 + kk) * Nsrc + nsrc0 + (lane & 31)]; }
    LDS_WAIT(); asm volatile("" ::: "memory");
    const int c = lane & 7;
#pragma unroll
    for (int j = 0; j < 4; ++j) { const int n = (lane >> 3) + 8 * j; const LAS float* s = scr + (8 * c) * 33 + n;
        u32x4 o; o.x = pk2(s[0 * 33], s[1 * 33]); o.y = pk2(s[2 * 33], s[3 * 33]); o.z = pk2(s[4 * 33], s[5 * 33]); o.w = pk2(s[6 * 33], s[7 * 33]);
        if (FRAGMAJOR) { const int hid = dst_row0 + n, kk = k0 + 8 * c;
            *(u32x4*)(WT + ((size_t)((hid >> 4) * (K >> 5) + (kk >> 5)) * 64 + (((kk >> 3) & 3) * 16 + (hid & 15))) * 8) = o; }
        else *(u32x4*)(WT + (size_t)(dst_row0 + n) * K + k0 + 8 * c) = o; }
    LDS_WAIT(); asm volatile("" ::: "memory");
}
DI int proj_src_col(int d) {
    if (d < 5120) {
        const int pn = d >> 8; const bool rp = (pn < 10) || pn == 12 || pn == 13 || pn == 16 || pn == 17;
        if (!rp) return d;
        const int c = d & 255, bj = c >> 7, wc = (c >> 5) & 3;
        return (pn << 8) + 128 * (wc >> 1) + 64 * bj + 32 * (wc & 1);
    }
    if (d < 16384) return d + 48;
    if (d < 22528) return d + 80;
    if (d < 22592) return S_GN + (d - 22528);
    if (d < 22624) return S_DT + (d - 22592);
    return 0;
}
constexpr int TI_IN = 32 * 712, TI_O = 32 * 64, TI_UP = 32 * 256, TI_DOWN = 128 * 64, TI_PG = 32 * 64, TI_PLE = 4 * 64, TI_P1 = 64 * 4, TI_P2 = 2 * 4;
constexpr int TI_LAYER = TI_IN + TI_O + TI_UP + TI_DOWN + TI_PG + TI_PLE + 2 * TI_P1 + 2 * TI_P2;

DI void p0_prologue(const Frame& F0, const Args& A) {
    const Frame F = phase_frame(F0);
    LAS float* scr = (LAS float*)(F.lds + F.wave * 16384);
    const int gw = F.bid * NWAVES + F.wave, NGW = F.G * NWAVES;
    for (int it = gw; it < DEPTH * TI_LAYER; it += NGW) {
        const int layer = it / TI_LAYER; int r = it - layer * TI_LAYER;
        if (r < TI_IN) { const int kb = r / 712, nb = r - kb * 712;
            transpose_item((const float*)argin(A, 4) + (size_t)layer * DM * PROJ_SRC, DM, PROJ_SRC, proj_src_col(nb * 32), (bf16*)lw_ptr(F, layer, LW_IN), nb * 32, kb * 64, scr, F.lane); continue; } r -= TI_IN;
        if (r < TI_O) { const int kb = r / 64, nb = r % 64;
            transpose_item((const float*)argin(A, 22) + (size_t)layer * DM * DM, DM, DM, nb * 32, (bf16*)lw_ptr(F, layer, LW_O), nb * 32, kb * 64, scr, F.lane); continue; } r -= TI_O;
        if (r < TI_UP) { const int kb = r / 256, nb = r % 256;
            transpose_item((const float*)argin(A, 24) + (size_t)layer * DM * DFF, DM, DFF, nb * 32, (bf16*)lw_ptr(F, layer, LW_UP), nb * 32, kb * 64, scr, F.lane); continue; } r -= TI_UP;
        if (r < TI_DOWN) { const int kb = r / 64, nb = r % 64;
            transpose_item((const float*)argin(A, 25) + (size_t)layer * DFF * DM, DFF, DM, nb * 32, (bf16*)lw_ptr(F, layer, LW_DOWN), nb * 32, kb * 64, scr, F.lane); continue; } r -= TI_DOWN;
        if (r < TI_PG) { const int kb = r / 64, nb = r % 64;
            transpose_item((const float*)argin(A, 28) + (size_t)layer * DM * DM, DM, DM, nb * 32, (bf16*)lw_ptr(F, layer, LW_PG), nb * 32, kb * 64, scr, F.lane); continue; } r -= TI_PG;
        if (r < TI_PLE) { const int kb = r / 64, nb = r % 64;
            transpose_item((const float*)argin(A, 27) + (size_t)layer * PLE * DM, PLE, DM, nb * 32, (bf16*)lw_ptr(F, layer, LW_PLE), nb * 32, kb * 64, scr, F.lane); continue; } r -= TI_PLE;
        if (r < TI_P1) { const int kb = r / 4, nb = r % 4;
            transpose_item<true>((const float*)argin(A, 7) + (size_t)layer * 4096 * 128, 4096, 128, nb * 32, (bf16*)lw_ptr(F, layer, LW_PK1), nb * 32, kb * 64, scr, F.lane); continue; } r -= TI_P1;
        if (r < TI_P1) { const int kb = r / 4, nb = r % 4;
            transpose_item<true>((const float*)argin(A, 11) + (size_t)layer * 4096 * 128, 4096, 128, nb * 32, (bf16*)lw_ptr(F, layer, LW_PV1), nb * 32, kb * 64, scr, F.lane); continue; } r -= TI_P1;
        if (r < TI_P2) { const int kb = r / 4, nb = r % 4;
            transpose_item((const float*)argin(A, 9) + (size_t)layer * 128 * 128, 128, 128, nb * 32, (bf16*)lw_ptr(F, layer, LW_PK2), nb * 32, kb * 64, scr, F.lane); continue; } r -= TI_P2;
        { const int kb = r / 4, nb = r % 4;
            transpose_item((const float*)argin(A, 13) + (size_t)layer * 128 * 128, 128, 128, nb * 32, (bf16*)lw_ptr(F, layer, LW_PV2), nb * 32, kb * 64, scr, F.lane); }
    }
    const size_t gt = (size_t)F.bid * NTHR + F.tid, NGT = (size_t)F.G * NTHR;
    { const float* p = (const float*)argin(A, 1); bf16* pb = (bf16*)(F.ws + WS_PB);
      for (size_t i = gt; i < (size_t)DEPTH * M * PLE / 8; i += NGT) { const f32x4 a = *(const f32x4*)(p + i * 8), b = *(const f32x4*)(p + i * 8 + 4);
          u32x4 o; o.x = pk2(a[0], a[1]); o.y = pk2(a[2], a[3]); o.z = pk2(b[0], b[1]); o.w = pk2(b[2], b[3]); *(u32x4*)(pb + i * 8) = o; } }
    { const int* pos = (const int*)argin(A, 2); float* rope = (float*)(F.ws + WS_ROPE);
      for (size_t i = gt; i < (size_t)M * 64; i += NGT) { const int row = (int)(i >> 6), jj = (int)(i & 63);
          const float inv = 1.0f / powf(10000.0f, (float)(2 * jj) * (1.0f / 128.0f));
          const float ang = (float)pos[row] * inv;
          double a = (double)ang; a -= 6.283185307179586476925 * __builtin_rint(a * 0.15915494309189533577);
          const float ar = (float)a;
          rope[i * 2] = cosf(ar); rope[i * 2 + 1] = sinf(ar); } }
    { float* part = (float*)(F.ws + WS_MISC);
      for (size_t i = gt; i < (size_t)DEPTH * 2 * 8 * 128; i += NGT) { const int hid = (int)(i & 127), c = (int)(i >> 7) & 7, kv = (int)(i >> 10) & 1, layer = (int)(i >> 11);
          const float* pe = (const float*)(kv ? A.in[6] : A.in[5]) + (size_t)layer * 4096 + c * 512;
          const float* w1 = (const float*)(kv ? A.in[11] : A.in[7]) + (size_t)layer * 4096 * 128 + (size_t)c * 512 * 128 + hid;
          float s = 0.f;
#pragma unroll 8
          for (int kk = 0; kk < 512; ++kk) s += pe[kk] * w1[(size_t)kk * 128];
          part[i] = s; } }
}

template <bool OUTF32> DI void norm_rows(const Frame& F0, const float* x, const float* g, void* outp) {
    const Frame F = phase_frame(F0);
    const int gw = F.bid * NWAVES + F.wave, NGW = F.G * NWAVES;
    for (int m = gw; m < M; m += NGW) {
        const f32x4* xr = (const f32x4*)(x + (size_t)m * DM) + F.lane;
        f32x4 v[8]; float s = 0.f;
#pragma unroll
        for (int j = 0; j < 8; ++j) { v[j] = xr[64 * j]; s += (v[j][0] * v[j][0] + v[j][1] * v[j][1]) + (v[j][2] * v[j][2] + v[j][3] * v[j][3]); }
        const float rstd = 1.0f / sqrtf(wave_sum(s, F.lane) * (1.0f / DM) + EPS);
#pragma unroll
        for (int j = 0; j < 8; ++j) { const f32x4 gv = ((const f32x4*)g)[F.lane + 64 * j]; const f32x4 o = v[j] * rstd * gv;
            if (OUTF32) ((f32x4*)((float*)outp + (size_t)m * DM))[F.lane + 64 * j] = o;
            else { u32x2 w; w.x = pk2(o[0], o[1]); w.y = pk2(o[2], o[3]); ((u32x2*)((bf16*)outp + (size_t)m * DM))[F.lane + 64 * j] = w; } }
    }
}
template <bool OUTF32> DI void addnorm_rows(const Frame& F0, const float* xin, const bf16* delta, const float* g, float* xout, void* outp) {
    const Frame F = phase_frame(F0);
    const int gw = F.bid * NWAVES + F.wave, NGW = F.G * NWAVES;
    for (int m = gw; m < M; m += NGW) {
        const f32x4* xr = (const f32x4*)(xin + (size_t)m * DM) + F.lane; const u32x2* dr = (const u32x2*)(delta + (size_t)m * DM) + F.lane;
        f32x4 v[8]; u32x2 d[8]; float s = 0.f;
#pragma unroll
        for (int j = 0; j < 8; ++j) { v[j] = xr[64 * j]; d[j] = dr[64 * j]; }
#pragma unroll
        for (int j = 0; j < 8; ++j) { v[j][0] += bflo(d[j].x); v[j][1] += bfhi(d[j].x); v[j][2] += bflo(d[j].y); v[j][3] += bfhi(d[j].y);
            s += (v[j][0] * v[j][0] + v[j][1] * v[j][1]) + (v[j][2] * v[j][2] + v[j][3] * v[j][3]);
            if (!OUTF32) ((f32x4*)(xout + (size_t)m * DM))[F.lane + 64 * j] = v[j]; }
        const float rstd = 1.0f / sqrtf(wave_sum(s, F.lane) * (1.0f / DM) + EPS);
#pragma unroll
        for (int j = 0; j < 8; ++j) { const f32x4 gv = ((const f32x4*)g)[F.lane + 64 * j]; const f32x4 o = v[j] * rstd * gv;
            if (OUTF32) ((f32x4*)((float*)outp + (size_t)m * DM))[F.lane + 64 * j] = o;
            else { u32x2 w; w.x = pk2(o[0], o[1]); w.y = pk2(o[2], o[3]); ((u32x2*)((bf16*)outp + (size_t)m * DM))[F.lane + 64 * j] = w; } }
    }
}
DI void unpack8(u32x4 w, float (&f)[8]) { f[0] = bflo(w.x); f[1] = bfhi(w.x); f[2] = bflo(w.y); f[3] = bfhi(w.y); f[4] = bflo(w.z); f[5] = bfhi(w.z); f[6] = bflo(w.w); f[7] = bfhi(w.w); }
DI u32x4 pack8f(const float (&f)[8]) { u32x4 o; o.x = pk2(f[0], f[1]); o.y = pk2(f[2], f[3]); o.z = pk2(f[4], f[5]); o.w = pk2(f[6], f[7]); return o; }

DI void ssd_conv_pass(const Frame& F0, const Args& A, int layer) {
    const Frame F = phase_frame(F0);
    const bf16* proj = (const bf16*)(F.ws + WS_PROJ); bf16* xbc = (bf16*)(F.ws + WS_XBC);
    const float* cw = (const float*)argin(A, 16) + (size_t)layer * 4 * SSD_XBC; const float* cb = (const float*)argin(A, 17) + (size_t)layer * SSD_XBC;
    const int gt = F.bid * NTHR + F.tid, NGT = F.G * NTHR;
    for (int task = gt; task < 512 * 384; task += NGT) {
        const int run = task / 384, cg = task - run * 384, ch = cg * 8, row0 = run * 32;
        float w[4][8], bs[8], xm3[8], xm2[8], xm1[8];
#pragma unroll
        for (int j = 0; j < 4; ++j) { const f32x4 a = *(const f32x4*)(cw + j * SSD_XBC + ch), b = *(const f32x4*)(cw + j * SSD_XBC + ch + 4);
            w[j][0] = a[0]; w[j][1] = a[1]; w[j][2] = a[2]; w[j][3] = a[3]; w[j][4] = b[0]; w[j][5] = b[1]; w[j][6] = b[2]; w[j][7] = b[3]; }
        { const f32x4 a = *(const f32x4*)(cb + ch), b = *(const f32x4*)(cb + ch + 4); bs[0] = a[0]; bs[1] = a[1]; bs[2] = a[2]; bs[3] = a[3]; bs[4] = b[0]; bs[5] = b[1]; bs[6] = b[2]; bs[7] = b[3]; }
        if ((row0 & (SEQ - 1)) != 0) {
            unpack8(*(const u32x4*)(proj + (size_t)(row0 - 3) * LDP + C_XBC + ch), xm3);
            unpack8(*(const u32x4*)(proj + (size_t)(row0 - 2) * LDP + C_XBC + ch), xm2);
            unpack8(*(const u32x4*)(proj + (size_t)(row0 - 1) * LDP + C_XBC + ch), xm1);
        } else {
#pragma unroll
            for (int k = 0; k < 8; ++k) { xm3[k] = 0.f; xm2[k] = 0.f; xm1[k] = 0.f; }
        }
#pragma unroll 4
        for (int r = 0; r < 32; ++r) {
            float cur[8], y[8]; unpack8(*(const u32x4*)(proj + (size_t)(row0 + r) * LDP + C_XBC + ch), cur);
#pragma unroll
            for (int k = 0; k < 8; ++k) { const float v = w[0][k] * xm3[k] + w[1][k] * xm2[k] + w[2][k] * xm1[k] + w[3][k] * cur[k] + bs[k]; y[k] = siluf_(v); xm3[k] = xm2[k]; xm2[k] = xm1[k]; xm1[k] = cur[k]; }
            *(u32x4*)(xbc + (size_t)(row0 + r) * SSD_XBC + ch) = pack8f(y);
        }
    }
    const float* dtb = (const float*)argin(A, 18) + layer * SSD_H; float* dt = (float*)(F.ws + WS_DT);
    for (int i = gt; i < M * SSD_H; i += NGT) { const int row = i >> 5, h = i & 31;
        const float x = bf2f(proj[(size_t)row * LDP + C_DT + h]) + dtb[h];
        dt[i] = fmaxf(x, 0.f) + log1pf(__expf(-fabsf(x))); }
}

DI void merge_pass(const Frame& F0, const Args& A, int layer) {
    const Frame F = phase_frame(F0);
    const bf16* proj = (const bf16*)(F.ws + WS_PROJ); const bf16* ya = (const bf16*)(F.ws + WS_YA); const bf16* yc = (const bf16*)(F.ws + WS_YC); bf16* hb = (bf16*)(F.ws + WS_HB);
    const float* sw = (const float*)argin(A, 15) + (size_t)layer * 3 * DM; const float* ngp = (const float*)argin(A, 21) + (size_t)layer * DM; const float* rstdp = (const float*)(F.ws + WS_RSTD);
    const int gt = F.bid * NTHR + F.tid, NGT = F.G * NTHR;
    for (int task = gt; task < 512 * 256; task += NGT) {
        const int run = task >> 8, cg = task & 255, ch = cg * 8, row0 = run * 32;
        float w[3][8], pm2[8], pm1[8], ng8[8];
        { const f32x4 a = *(const f32x4*)(ngp + ch), b = *(const f32x4*)(ngp + ch + 4); ng8[0] = a[0]; ng8[1] = a[1]; ng8[2] = a[2]; ng8[3] = a[3]; ng8[4] = b[0]; ng8[5] = b[1]; ng8[6] = b[2]; ng8[7] = b[3]; }
#pragma unroll
        for (int j = 0; j < 3; ++j) { const f32x4 a = *(const f32x4*)(sw + j * DM + ch), b = *(const f32x4*)(sw + j * DM + ch + 4);
            w[j][0] = a[0]; w[j][1] = a[1]; w[j][2] = a[2]; w[j][3] = a[3]; w[j][4] = b[0]; w[j][5] = b[1]; w[j][6] = b[2]; w[j][7] = b[3]; }
        if ((row0 & (SEQ - 1)) != 0) {
            float c1[8], u1[8];
            unpack8(*(const u32x4*)(proj + (size_t)(row0 - 2) * LDP + C_CC + ch), c1); unpack8(*(const u32x4*)(proj + (size_t)(row0 - 2) * LDP + C_CU + ch), u1);
#pragma unroll
            for (int k = 0; k < 8; ++k) pm2[k] = c1[k] * u1[k];
            unpack8(*(const u32x4*)(proj + (size_t)(row0 - 1) * LDP + C_CC + ch), c1); unpack8(*(const u32x4*)(proj + (size_t)(row0 - 1) * LDP + C_CU + ch), u1);
#pragma unroll
            for (int k = 0; k < 8; ++k) pm1[k] = c1[k] * u1[k];
        } else {
#pragma unroll
            for (int k = 0; k < 8; ++k) { pm2[k] = 0.f; pm1[k] = 0.f; }
        }
#pragma unroll 2
        for (int r = 0; r < 32; ++r) {
            const size_t pr = (size_t)(row0 + r) * LDP + ch, yr = (size_t)(row0 + r) * DM + ch;
            float cc[8], cu[8], cbv[8], g0[8], g1[8], g2[8], a[8], c[8], o[8];
            unpack8(*(const u32x4*)(proj + pr + C_CC), cc); unpack8(*(const u32x4*)(proj + pr + C_CU), cu); unpack8(*(const u32x4*)(proj + pr + C_CB), cbv);
            unpack8(*(const u32x4*)(proj + pr + C_GM), g0); unpack8(*(const u32x4*)(proj + pr + C_GM + DM), g1); unpack8(*(const u32x4*)(proj + pr + C_GM + 2 * DM), g2);
            unpack8(*(const u32x4*)(ya + yr), a); unpack8(*(const u32x4*)(yc + yr), c);
            const float rs = rstdp[(size_t)(row0 + r) * SSD_G + (ch >> 9)];
#pragma unroll
            for (int k = 0; k < 8; ++k) { const float pc = cc[k] * cu[k]; const float cv = w[0][k] * pm2[k] + w[1][k] * pm1[k] + w[2][k] * pc; pm2[k] = pm1[k]; pm1[k] = pc;
                o[k] = sigmoidf_(g0[k]) * a[k] + sigmoidf_(g1[k]) * (cbv[k] * cv) + sigmoidf_(g2[k]) * (c[k] * rs * ng8[k]); }
            *(u32x4*)(hb + yr) = pack8f(o);
        }
    }
}

DI void compress_phase(const Frame& F0, const Args& A, int layer) {
    const Frame F = phase_frame(F0);
    const bf16* proj = (const bf16*)(F.ws + WS_PROJ);
    LAS unsigned char* slab = F.lds;
    LAS unsigned char* hidl = F.lds + 73728;
    LAS float* b1s = (LAS float*)(F.lds + 81920);
    const int lane = F.lane, w = F.wave, i = lane & 15, qd = lane >> 4;
    const float* part = (const float*)(F.ws + WS_MISC);
    for (int u = F.bid; u < 512; u += F.G) {
        const int kv = u >> 8, b = (u >> 7) & 1, g = (u >> 5) & 3, nb = u & 31, n0 = nb * 16, tok0 = n0 * 16;
        const bf16* src = (const bf16*)(F.ws + WS_KV) + kv_off(kv, b, g, 0);
        for (int id = F.tid; id < 272 * 16; id += NTHR) { const int row = id >> 4, ch = id & 15, t = tok0 + row;
            u32x4 v = {0u, 0u, 0u, 0u}; if (t < SEQ) v = *(const u32x4*)(src + (size_t)t * HD + ch * 8);
            *(LAS u32x4*)(slab + off_b(row, ch)) = v; }
        if (F.tid < 128) { float s = ((const float*)argin(A, kv ? 12 : 8))[layer * 128 + F.tid];
#pragma unroll
            for (int c = 0; c < 8; ++c) s += part[(((size_t)layer * 2 + kv) * 8 + c) * 128 + F.tid];
            b1s[F.tid] = s; }
        __syncthreads();
        const bf16* w1t = (const bf16*)lw_ptr(F, layer, kv ? LW_PV1 : LW_PK1) + ((size_t)w * 128 * 64 + lane) * 8;
        f32x4 acc = {0.f, 0.f, 0.f, 0.f};
#if defined(SSD_IGLP)
        __builtin_amdgcn_iglp_opt(0);
#endif
        for (int k0 = 0; k0 < 128; k0 += 32) {
            bf16x8 bb[32];
#pragma unroll
            for (int k = 0; k < 32; ++k) bb[k] = *(const bf16x8*)(w1t + 512 * (k0 + k));
#pragma unroll
            for (int k = 0; k < 32; ++k) { const int ks = k0 + k;
                acc = MFMA16(lds_rd8(slab + off_b(16 * i + (ks >> 2), 4 * (ks & 3) + qd)), bb[k], acc); }
        }
        { const float bv = b1s[16 * w + i];
#pragma unroll
          for (int j = 0; j < 4; ++j) *(LAS bf16*)(hidl + (4 * qd + j) * 272 + (16 * w + i) * 2) = (bf16)f2bf(siluf_(acc[j] + bv)); }
        __syncthreads();
        const bf16* w2t = (const bf16*)lw_ptr(F, layer, kv ? LW_PV2 : LW_PK2) + (size_t)(16 * w + i) * 128 + 8 * qd;
        f32x4 acc2 = {0.f, 0.f, 0.f, 0.f};
#pragma unroll
        for (int s = 0; s < 4; ++s) {
            const bf16x8 a = lds_rd8(hidl + i * 272 + 64 * s + 16 * qd);
            const bf16x8 bb = *(const bf16x8*)(w2t + 32 * s);
            acc2 = MFMA16(a, bb, acc2);
        }
        const float b2 = ((const float*)argin(A, kv ? 14 : 10))[layer * 128 + 16 * w + i];
        bf16* dst = (bf16*)(F.ws + (kv ? WS_VCMP : WS_KCMP)) + ((size_t)(b * NG + g) * NCMP_PAD + n0) * HD + 16 * w + i;
#pragma unroll
        for (int j = 0; j < 4; ++j) dst[(size_t)(4 * qd + j) * HD] = (bf16)f2bf(acc2[j] + b2);
        __syncthreads();
    }
}

DI void ssd_states_phase(const Frame& F0, const Args& A, int layer) {
    const Frame F = phase_frame(F0);
    const bf16* xbc = (const bf16*)(F.ws + WS_XBC); const float* dt = (const float*)(F.ws + WS_DT);
    float* acs = (float*)(F.ws + WS_ACS); float* cdec = (float*)(F.ws + WS_CDEC); float* st = (float*)(F.ws + WS_ST);
    LAS unsigned char* Bt = F.lds; LAS unsigned char* Xt = F.lds + 32768; LAS float* sc = (LAS float*)(F.lds + 65536);
    const float* alog = (const float*)argin(A, 19) + layer * SSD_H;
    const int lane = F.lane, w = F.wave, i = lane & 15, qd = lane >> 4;
    for (int u = F.bid; u < 512; u += F.G) {
        const int b = u >> 8, c = (u >> 2) & 63, g = u & 3, row0 = b * SEQ + c * SSD_CH;
        {
            const int hh = g * 8 + w; const float a = -__expf(alog[hh]);
            const float dt0 = dt[(size_t)(row0 + 2 * lane) * SSD_H + hh], dt1 = dt[(size_t)(row0 + 2 * lane + 1) * SSD_H + hh];
            const float d0 = dt0 * a, d1 = dt1 * a, pair = d0 + d1; float s = pair;
#pragma unroll
            for (int o = 1; o < 64; o <<= 1) { const float t = shfl_idx(s, lane - o); if (lane >= o) s += t; }
            const float a0 = (s - pair) + d0, a1 = s, total = __builtin_bit_cast(float, __builtin_amdgcn_readlane(__builtin_bit_cast(int, s), 63));
            acs[(size_t)(row0 + 2 * lane) * SSD_H + hh] = a0; acs[(size_t)(row0 + 2 * lane + 1) * SSD_H + hh] = a1;
            sc[w * 128 + 2 * lane] = dt0 * __expf(total - a0); sc[w * 128 + 2 * lane + 1] = dt1 * __expf(total - a1);
            if (lane == 0) cdec[(size_t)(b * SSD_NC + c) * SSD_H + hh] = __expf(total);
        }
        for (int id = F.tid; id < 128 * 16; id += NTHR) { const int row = id >> 4, ch = id & 15;
            *(LAS u32x4*)(Bt + off_b(row, ch)) = *(const u32x4*)(xbc + (size_t)(row0 + row) * SSD_XBC + 2048 + g * 128 + ch * 8); }
        bf16x8 bfr[4];
        for (int hp = 0; hp < 4; ++hp) {
            __syncthreads();
            for (int id = F.tid; id < 128 * 16; id += NTHR) { const int row = id >> 4, ch = id & 15;
                float x[8]; unpack8(*(const u32x4*)(xbc + (size_t)(row0 + row) * SSD_XBC + g * 512 + hp * 128 + ch * 8), x);
                const float f = sc[(hp * 2 + (ch >> 3)) * 128 + row];
#pragma unroll
                for (int k = 0; k < 8; ++k) x[k] *= f;
                *(LAS u32x4*)(Xt + off_b(row, ch)) = pack8f(x); }
            __syncthreads();
            if (hp == 0) {
#pragma unroll
                for (int ks = 0; ks < 4; ++ks) bfr[ks] = tr_read8(Bt, lane, 32 * ks, w);
            }
#pragma unroll
            for (int h2 = 0; h2 < 2; ++h2) {
                const int head = g * 8 + hp * 2 + h2;
                float* dst = st + ((size_t)((b * SSD_NC + c) * SSD_H + head) * SSD_N + 16 * w + i) * SSD_P + 4 * qd;
#pragma unroll
                for (int pt = 0; pt < 4; ++pt) {
                    f32x4 acc = {0.f, 0.f, 0.f, 0.f};
#pragma unroll
                    for (int ks = 0; ks < 4; ++ks) acc = MFMA16(tr_read8(Xt, lane, 32 * ks, h2 * 4 + pt), bfr[ks], acc);
                    *(f32x4*)(dst + 16 * pt) = acc;
                }
            }
        }
        __syncthreads();
    }
}
DI void ssd_scan_phase(const Frame& F0) {
    const Frame F = phase_frame(F0);
    const f32x4* st = (const f32x4*)(F.ws + WS_ST); u32x2* hin = (u32x2*)(F.ws + WS_HIN); const float* cdec = (const float*)(F.ws + WS_CDEC);
    const int gt = F.bid * NTHR + F.tid, NGT = F.G * NTHR;
    for (int v = gt; v < BATCH * SSD_H * 2048; v += NGT) {
        const int b = v >> 16, h = (v >> 11) & 31, e = v & 2047;
        const size_t o0 = ((size_t)(b * SSD_NC) * SSD_H + h) * 2048 + e;
        const float* dc = cdec + (size_t)(b * SSD_NC) * SSD_H + h;
        f32x4 hs = {0.f, 0.f, 0.f, 0.f};
        for (int c0 = 0; c0 < SSD_NC; c0 += 8) {
            f32x4 s[8]; float d[8];
#pragma unroll
            for (int k = 0; k < 8; ++k) { s[k] = st[o0 + (size_t)(c0 + k) * 65536]; d[k] = dc[(c0 + k) * SSD_H]; }
#pragma unroll
            for (int k = 0; k < 8; ++k) { u32x2 o; o.x = pk2(hs[0], hs[1]); o.y = pk2(hs[2], hs[3]); hin[o0 + (size_t)(c0 + k) * 65536] = o; hs = hs * d[k] + s[k]; }
        }
    }
}
DI void ssd_out_phase(const Frame& F0, const Args& A, int layer) {
    const Frame F = phase_frame(F0);
    const bf16* xbc = (const bf16*)(F.ws + WS_XBC); const bf16* proj = (const bf16*)(F.ws + WS_PROJ);
    const float* dt = (const float*)(F.ws + WS_DT); const float* acs = (const float*)(F.ws + WS_ACS); const bf16* hin = (const bf16*)(F.ws + WS_HIN);
    bf16* yc = (bf16*)(F.ws + WS_YC); float* rstdp = (float*)(F.ws + WS_RSTD);
    LAS unsigned char* Bt = F.lds; LAS unsigned char* Ct = F.lds + 32768; LAS unsigned char* Xt = F.lds + 65536; LAS unsigned char* Ht = F.lds + 98304;
    LAS float* acsl = (LAS float*)(F.lds + LX_OFF);
    const float* dsk = (const float*)argin(A, 20) + layer * SSD_H;
    const int lane = F.lane, w = F.wave, i = lane & 15, qd = lane >> 4;
    for (int u = F.bid; u < 512; u += F.G) {
        const int b = u >> 8, c = (u >> 2) & 63, g = u & 3, row0 = b * SEQ + c * SSD_CH;
        for (int id = F.tid; id < 128 * 16; id += NTHR) { const int row = id >> 4, ch = id & 15; const bf16* src = xbc + (size_t)(row0 + row) * SSD_XBC + 2048 + g * 128 + ch * 8;
            *(LAS u32x4*)(Bt + off_b(row, ch)) = *(const u32x4*)(src); *(LAS u32x4*)(Ct + off_b(row, ch)) = *(const u32x4*)(src + 512); }
        __syncthreads();
        bf16x8 cfr[4];
#pragma unroll
        for (int ks = 0; ks < 4; ++ks) cfr[ks] = lds_rd8(Ct + off_b(16 * w + i, 4 * ks + qd));
        f32x4 cb[4][2];
#pragma unroll
        for (int k = 0; k < 4; ++k)
#pragma unroll
            for (int T = 0; T < 2; ++T) { f32x4 acc = {0.f, 0.f, 0.f, 0.f};
#pragma unroll
                for (int ks = 0; ks < 4; ++ks) acc = MFMA16(lds_rd8(Bt + off_b(32 * k + 8 * (i >> 2) + (i & 3) + 4 * T, 4 * ks + qd)), cfr[ks], acc);
                cb[k][T] = acc; }
        const int lrow = 16 * w + i, row = row0 + lrow;
        float ssq = 0.f;
        for (int hp = 0; hp < 4; ++hp) {
            __syncthreads();
            if (F.tid < 256) { const int h2 = F.tid >> 7, l = F.tid & 127; acsl[F.tid] = acs[(size_t)(row0 + l) * SSD_H + g * 8 + hp * 2 + h2]; }
            for (int id = F.tid; id < 128 * 16; id += NTHR) { const int r = id >> 4, ch = id & 15, head = g * 8 + hp * 2 + (ch >> 3);
                float x[8]; unpack8(*(const u32x4*)(xbc + (size_t)(row0 + r) * SSD_XBC + g * 512 + hp * 128 + ch * 8), x);
                const float f = dt[(size_t)(row0 + r) * SSD_H + head];
#pragma unroll
                for (int k = 0; k < 8; ++k) x[k] *= f;
                *(LAS u32x4*)(Xt + off_b(r, ch)) = pack8f(x);
                *(LAS u32x4*)(Ht + off_b(r, ch)) = *(const u32x4*)(hin + ((size_t)((b * SSD_NC + c) * SSD_H + head) * SSD_N + r) * SSD_P + (ch & 7) * 8); }
            __syncthreads();
#pragma unroll
            for (int h2 = 0; h2 < 2; ++h2) {
                const int head = g * 8 + hp * 2 + h2;
#if defined(SSD_IGLP)
                __builtin_amdgcn_iglp_opt(0);
#endif
                const float al = acsl[h2 * 128 + lrow], ea = __expf(al), dsv = dsk[head];
                u32x2 xv4[4], zv4[4];
#pragma unroll
                for (int pt = 0; pt < 4; ++pt) { const int chn = head * SSD_P + 16 * pt + 4 * qd;
                    xv4[pt] = *(const u32x2*)(xbc + (size_t)row * SSD_XBC + chn); zv4[pt] = *(const u32x2*)(proj + (size_t)row * LDP + C_Z + chn); }
                bf16x8 mfr[4];
#pragma unroll
                for (int k = 0; k < 4; ++k) {
                    const f32x4 a0 = *(const LAS f32x4*)(acsl + h2 * 128 + 32 * k + 8 * qd), a1 = *(const LAS f32x4*)(acsl + h2 * 128 + 32 * k + 8 * qd + 4);
                    float mv[8];
#pragma unroll
                    for (int j = 0; j < 4; ++j) { const int s0 = 32 * k + 8 * qd + j, s1 = s0 + 4;
                        mv[j] = (s0 <= lrow) ? cb[k][0][j] * __expf(al - a0[j]) : 0.f;
                        mv[4 + j] = (s1 <= lrow) ? cb[k][1][j] * __expf(al - a1[j]) : 0.f; }
                    mfr[k] = as_bf16x8(pack8f(mv));
                }
#pragma unroll
                for (int pt = 0; pt < 4; ++pt) {
                    f32x4 yd = {0.f, 0.f, 0.f, 0.f}, yo = {0.f, 0.f, 0.f, 0.f};
#pragma unroll
                    for (int k = 0; k < 4; ++k) yd = MFMA16(tr_read8(Xt, lane, 32 * k, h2 * 4 + pt), mfr[k], yd);
#pragma unroll
                    for (int ks = 0; ks < 4; ++ks) yo = MFMA16(tr_read8(Ht, lane, 32 * ks, h2 * 4 + pt), cfr[ks], yo);
                    const int chn = head * SSD_P + 16 * pt + 4 * qd;
                    const u32x2 xv = xv4[pt], zv = zv4[pt];
                    const float xs[4] = {bflo(xv.x), bfhi(xv.x), bflo(xv.y), bfhi(xv.y)}, zz[4] = {bflo(zv.x), bfhi(zv.x), bflo(zv.y), bfhi(zv.y)};
                    float gy[4];
#pragma unroll
                    for (int j = 0; j < 4; ++j) { const float y = yd[j] + ea * yo[j] + dsv * xs[j]; gy[j] = y * siluf_(zz[j]); ssq += gy[j] * gy[j]; }
                    u32x2 o; o.x = pk2(gy[0], gy[1]); o.y = pk2(gy[2], gy[3]);
                    *(u32x2*)(yc + (size_t)row * DM + chn) = o;
                }
            }
        }
        ssq += shx(ssq, 16, lane); ssq += shx(ssq, 32, lane);
        if (qd == 0) rstdp[(size_t)row * SSD_G + g] = 1.0f / sqrtf(ssq * (1.0f / 512.0f) + EPS);
        __syncthreads();
    }
}

#ifndef NSA_REP_PART
#define NSA_REP_PART 0
#endif
#if NSA_REP_PART == 7
#define W7DUP(x) x
#define W7WAIT() NSA_WAITV(8)
#else
#define W7DUP(x)
#define W7WAIT() NSA_WAITV(4)
#endif
#if NSA_REP_PART == 10
#define SELDUP(x) x
#else
#define SELDUP(x)
#endif
constexpr int RB = 32768, NRING = 3;
#define NSA_WAITV(n) asm volatile("s_waitcnt vmcnt(" #n ")" ::: "memory")
#define NSA_BAR() do { asm volatile("" ::: "memory"); __builtin_amdgcn_s_barrier(); asm volatile("" ::: "memory"); } while (0)
template <bool WITHV> DI void tile_dma(LAS unsigned char* buf, const bf16* kp, const bf16* vp, int pitch, int w, int lane) {
#pragma unroll
    for (int e = 0; e < 2; ++e) { const int kb = 2 * w + e, kh = kb >> 3, T = (kb >> 2) & 1, ks = kb & 3, i = lane & 15, qd = lane >> 4;
        const int key = 32 * kh + 8 * (i >> 2) + (i & 3) + 4 * T, ch = 4 * ks + qd;
        __builtin_amdgcn_global_load_lds((const unsigned*)(kp + (size_t)key * pitch + ch * 8), (LAS unsigned*)(buf + kb * 1024), 16, 0, 0); }
    if (WITHV) {
#pragma unroll
        for (int e = 0; e < 2; ++e) { const int vb = 2 * w + e, kh = vb >> 3, t = (vb >> 2) & 1, dtp = vb & 3, dtl = lane >> 5, g = (lane >> 3) & 3, q = (lane >> 1) & 3, ph = lane & 1;
            const int key = 32 * kh + 8 * g + 4 * t + q, ch = 4 * dtp + 2 * dtl + ph;
            __builtin_amdgcn_global_load_lds((const unsigned*)(vp + (size_t)key * pitch + ch * 8), (LAS unsigned*)(buf + 16384 + vb * 1024), 16, 0, 0); }
    }
}
#define NSA_TR8(r, addr, b) asm volatile("ds_read_b64_tr_b16 %0, %8 offset:%9\n\tds_read_b64_tr_b16 %1, %8 offset:%10\n\tds_read_b64_tr_b16 %2, %8 offset:%11\n\tds_read_b64_tr_b16 %3, %8 offset:%12\n\t" \
        "ds_read_b64_tr_b16 %4, %8 offset:%13\n\tds_read_b64_tr_b16 %5, %8 offset:%14\n\tds_read_b64_tr_b16 %6, %8 offset:%15\n\tds_read_b64_tr_b16 %7, %8 offset:%16" \
        : "=&v"(r[0]), "=&v"(r[1]), "=&v"(r[2]), "=&v"(r[3]), "=&v"(r[4]), "=&v"(r[5]), "=&v"(r[6]), "=&v"(r[7]) \
        : "v"(addr), "i"((b)), "i"((b) + 4096), "i"((b) + 512), "i"((b) + 4608), "i"((b) + 1024), "i"((b) + 5120), "i"((b) + 1536), "i"((b) + 5632) : "memory")
#define NSA_TRWAIT(r) asm volatile("s_waitcnt lgkmcnt(0)" : "+v"(r[0]), "+v"(r[1]), "+v"(r[2]), "+v"(r[3]), "+v"(r[4]), "+v"(r[5]), "+v"(r[6]), "+v"(r[7]) :: "memory")
#define NSA_TRWAIT8(r) asm volatile("s_waitcnt lgkmcnt(8)" : "+v"(r[0]), "+v"(r[1]), "+v"(r[2]), "+v"(r[3]), "+v"(r[4]), "+v"(r[5]), "+v"(r[6]), "+v"(r[7]) :: "memory")
#define NSA_SB() __builtin_amdgcn_sched_barrier(0)
#if !defined(NSA_NO_SETPRIO)
#define NSA_PRIO(x) __builtin_amdgcn_s_setprio(x)
#else
#define NSA_PRIO(x)
#endif
#define NSA_PV4(r, kh, d0) do { NSA_PRIO(1); _Pragma("unroll") for (int q_ = 0; q_ < 4; ++q_) { const bf16x8 vf_ = __builtin_shufflevector(r[2 * q_], r[2 * q_ + 1], 0, 1, 2, 3, 4, 5, 6, 7); \
        if (SM & 1) O[0][(d0) + q_] = MFMA16(vf_, pf[0][kh], O[0][(d0) + q_]); if (SM & 2) O[1][(d0) + q_] = MFMA16(vf_, pf[1][kh], O[1][(d0) + q_]); } NSA_PRIO(0); } while (0)
template <int MODE, int SM>
DI void attn_tile(LAS const unsigned char* Kt, LAS const unsigned char* Vt, const bf16x8 (&Qf)[2][4], f32x4 (&O)[2][8], float (&m)[2], float (&l)[2], const int (&lo)[2], const int (&hi)[2], bool needmask,
                  float c2, const float (&inv_l)[2], LAS float* imp, const int (&ql)[2], int jb0, float (&cin)[2], int lane) {
    const int qd = lane >> 4;
    f32x4 sc[2][2][2];
#if !defined(NSA_NO_IGLP)
    __builtin_amdgcn_iglp_opt(0);
#endif
#pragma unroll
    for (int kh = 0; kh < 2; ++kh)
#pragma unroll
        for (int T = 0; T < 2; ++T) { f32x4 a0 = {0.f, 0.f, 0.f, 0.f}, a1 = {0.f, 0.f, 0.f, 0.f};
#pragma unroll
            for (int ks = 0; ks < 4; ++ks) { const bf16x8 kf = lds_rd8(Kt + (kh * 8 + T * 4 + ks) * 1024);
                if (SM & 1) a0 = MFMA16(kf, Qf[0][ks], a0); if (SM & 2) a1 = MFMA16(kf, Qf[1][ks], a1); }
            sc[0][kh][T] = a0; sc[1][kh][T] = a1; }
    const float NEG = -__builtin_inff();
    bf16x8 pf[2][2];
#pragma unroll
    for (int s = 0; s < 2; ++s) if (SM & (1 << s)) {
        if (needmask) {
#pragma unroll
            for (int kh = 0; kh < 2; ++kh)
#pragma unroll
                for (int T = 0; T < 2; ++T)
#pragma unroll
                    for (int j = 0; j < 4; ++j) { const int kk = 32 * kh + 8 * qd + 4 * T + j; if (kk < lo[s] || kk > hi[s]) sc[s][kh][T][j] = NEG; }
        }
        float mn = m[s];
        if (MODE != 2) {
            float tmax = fmaxf(fmaxf(sc[s][0][0][0], sc[s][0][0][1]), fmaxf(sc[s][0][0][2], sc[s][0][0][3]));
            tmax = fmaxf(tmax, fmaxf(fmaxf(sc[s][0][1][0], sc[s][0][1][1]), fmaxf(sc[s][0][1][2], sc[s][0][1][3])));
            tmax = fmaxf(tmax, fmaxf(fmaxf(sc[s][1][0][0], sc[s][1][0][1]), fmaxf(sc[s][1][0][2], sc[s][1][0][3])));
            tmax = fmaxf(tmax, fmaxf(fmaxf(sc[s][1][1][0], sc[s][1][1][1]), fmaxf(sc[s][1][1][2], sc[s][1][1][3])));
            tmax = xq_max(tmax);
            mn = fmaxf(m[s], tmax);
            if (__ballot(mn != m[s]) != 0ull) {
                const float alpha = __builtin_amdgcn_exp2f((m[s] - mn) * c2);
                l[s] *= alpha;
                if (MODE == 1) {
#pragma unroll
                    for (int dt = 0; dt < 8; ++dt) O[s][dt] = O[s][dt] * alpha;
                }
                m[s] = mn;
            }
        }
        const float nmc = -mn * c2; float ps = 0.f;
#pragma unroll
        for (int kh = 0; kh < 2; ++kh)
#pragma unroll
            for (int T = 0; T < 2; ++T)
#pragma unroll
                for (int j = 0; j < 4; ++j) { float p = __builtin_amdgcn_exp2f(__builtin_fmaf(sc[s][kh][T][j], c2, nmc)); if (MODE == 2) p *= inv_l[s]; sc[s][kh][T][j] = p; ps += p; }
        if (MODE != 2) l[s] += ps;
        if (MODE == 2) {
            float s4[2][2], cy[2][2];
#pragma unroll
            for (int kh = 0; kh < 2; ++kh)
#pragma unroll
                for (int T = 0; T < 2; ++T) {
                    float a = (sc[s][kh][T][0] + sc[s][kh][T][1]) + (sc[s][kh][T][2] + sc[s][kh][T][3]), c = sc[s][kh][T][3];
                    a = quad_sum(a); c = quad_sum(c);
                    s4[kh][T] = a; cy[kh][T] = c; }
            const float x0 = shfl_idx(cy[0][1], (lane - 16) & 63), x1 = shfl_idx(cy[1][1], (lane - 16) & 63);
            const float p00 = (qd == 0) ? cin[s] : x0, p10 = (qd == 0) ? x0 : x1;
            cin[s] = x1;
            if ((lane & 3) == 0) { const int jb = jb0 + 2 * qd;
                *(LAS f32x2*)(imp + ql[s] * 128 + jb) = (f32x2){s4[0][0] + p00, s4[0][1] + cy[0][0]};
                *(LAS f32x2*)(imp + ql[s] * 128 + jb + 8) = (f32x2){s4[1][0] + p10, s4[1][1] + cy[1][0]}; }
        }
        if (MODE != 0) {
#pragma unroll
            for (int kh = 0; kh < 2; ++kh) { u32x4 pw; pw.x = pk2(sc[s][kh][0][0], sc[s][kh][0][1]); pw.y = pk2(sc[s][kh][0][2], sc[s][kh][0][3]); pw.z = pk2(sc[s][kh][1][0], sc[s][kh][1][1]); pw.w = pk2(sc[s][kh][1][2], sc[s][kh][1][3]); pf[s][kh] = as_bf16x8(pw); }
        }
    }
    if (MODE != 0) {
        const unsigned va = (unsigned)(size_t)Vt;
        s16x4 ra[8], rb[8];
        NSA_TR8(ra, va, 0);     NSA_TR8(rb, va, 2048); NSA_SB();
        NSA_TRWAIT8(ra); NSA_SB(); NSA_PV4(ra, 0, 0); NSA_SB(); NSA_TR8(ra, va, 8192);  NSA_SB();
        NSA_TRWAIT8(rb); NSA_SB(); NSA_PV4(rb, 0, 4); NSA_SB(); NSA_TR8(rb, va, 10240); NSA_SB();
        NSA_TRWAIT8(ra); NSA_SB(); NSA_PV4(ra, 1, 0); NSA_SB();
        NSA_TRWAIT(rb);  NSA_SB(); NSA_PV4(rb, 1, 4);
    }
}
template <bool FIRST> DI void nsa_emit(const f32x4 (&O)[8], float scale, bf16* dst  ) {
    u32x2 old[8];
    if (!FIRST) {
#pragma unroll
        for (int dt = 0; dt < 8; ++dt) old[dt] = *(const u32x2*)(dst + 16 * dt);
    }
#pragma unroll
    for (int dt = 0; dt < 8; ++dt) { f32x4 v = O[dt] * scale;
        if (!FIRST) { v[0] += bflo(old[dt].x); v[1] += bfhi(old[dt].x); v[2] += bflo(old[dt].y); v[3] += bfhi(old[dt].y); }
        u32x2 o; o.x = pk2(v[0], v[1]); o.y = pk2(v[2], v[3]); *(u32x2*)(dst + 16 * dt) = o; }
}
DI int next_bit(unsigned u0, unsigned u1, unsigned u2, unsigned u3, int from) {
    if (from >= 128) return -1;
    const int wd = from >> 5; const unsigned msk = ~0u << (from & 31);
    const unsigned x0 = (wd == 0) ? (u0 & msk) : 0u;
    const unsigned x1 = (wd < 1) ? u1 : ((wd == 1) ? (u1 & msk) : 0u);
    const unsigned x2 = (wd < 2) ? u2 : ((wd == 2) ? (u2 & msk) : 0u);
    const unsigned x3 = (wd < 3) ? u3 : (u3 & msk);
    if (x0) return __builtin_ctz(x0);
    if (x1) return 32 + __builtin_ctz(x1);
    if (x2) return 64 + __builtin_ctz(x2);
    if (x3) return 96 + __builtin_ctz(x3);
    return -1;
}

DI void nsa_phase(const Frame& F0, const Args& A, int layer) {
    const Frame F = phase_frame(F0);
    const bf16* proj = (const bf16*)(F.ws + WS_PROJ); const bf16* kcmp = (const bf16*)(F.ws + WS_KCMP); const bf16* vcmp = (const bf16*)(F.ws + WS_VCMP);
    bf16* ya = (bf16*)(F.ws + WS_YA);
    LAS unsigned char* const RG = F.lds;
    LAS float* imp = (LAS float*)(F.lds + NRING * RB);
    LAS unsigned* selm = (LAS unsigned*)(F.lds + NRING * RB + 32768); LAS unsigned* uml = selm + 256;
    static_assert(NRING * RB + 32768 + 1024 + 16 <= LDSCTL_OFF && NRING * RB + 32768 == 4 * RB, "nsa LDS map (the selected loop's pair buffers overlay ring + importance table)");
    const float c2 = 0.08838834764831845f * 1.4426950408889634f;
    (void)A; (void)layer;
#if defined(NSA_PRIO)
    if (F.wave < 4) __builtin_amdgcn_s_setprio(2); else __builtin_amdgcn_s_setprio(0);
#endif
    for (int u = F.bid; u < 1024; u += F.G) {
        int tid_l = F.tid; asm volatile("" : "+v"(tid_l));
        const int tid = tid_l, lane = tid & 63, w = F.wave, i = lane & 15, qd = lane >> 4, hd = i & 3;
        const int klane = 16 * lane, vlane = 16384 + 8 * lane;
        const int xg = u & 7, jj = (u >> 3) & 31, rr = u >> 8;
        const int b = xg >> 2, g = xg & 3;
        const int qt = (rr == 0) ? 127 - jj : (rr == 1) ? 64 + jj : (rr == 2) ? 63 - jj : jj;
        const int s0 = qt * 64, cur = qt, rowb = b * SEQ;
        int ql[2], trow[2]; bf16x8 Qf[2][4];
#pragma unroll
        for (int s = 0; s < 2; ++s) { ql[s] = 8 * w + 4 * s + (i >> 2); trow[s] = rowb + s0 + ql[s];
#pragma unroll
            for (int ks = 0; ks < 4; ++ks) Qf[s][ks] = *(const bf16x8*)(proj + (size_t)trow[s] * LDP + C_Q + (4 * g + hd) * HD + 32 * ks + 8 * qd); }
        f32x4 O[2][8]; float mrow[2], lrow[2], cin[2], invl[2] = {0.f, 0.f};
        const int ntc = (4 * qt + 3 + 63) >> 6;
        const bf16* kc0 = kcmp + (size_t)(b * NG + g) * NCMP_PAD * HD; const bf16* vc0 = vcmp + (size_t)(b * NG + g) * NCMP_PAD * HD;
        int nmax[2];
#pragma unroll
        for (int s = 0; s < 2; ++s) { const int t = s0 + ql[s]; nmax[s] = (t >= 31) ? ((t - 31) >> 4) : -1; mrow[s] = -1e30f; lrow[s] = 0.f; cin[s] = 0.f; }
        for (int rep_ = 0; rep_ < (NSA_REP_PART == 2 ? 2 : 1); ++rep_) {
#pragma unroll
        for (int s = 0; s < 2; ++s) { mrow[s] = -1e30f; lrow[s] = 0.f; cin[s] = 0.f; }
        NSA_WAITV(0); NSA_BAR();
        tile_dma<false>(RG, kc0, vc0, HD, w, lane); if (ntc > 1) tile_dma<false>(RG + RB, kc0 + (size_t)64 * HD, vc0, HD, w, lane);
        for (int tc = 0, rb = 0; tc < ntc; ++tc) {
            if (tc + 1 < ntc) NSA_WAITV(2); else NSA_WAITV(0);
            NSA_BAR();
            if (tc + 2 < ntc) { const int nb2 = (rb + 2 >= NRING) ? rb + 2 - NRING : rb + 2; tile_dma<false>(RG + nb2 * RB, kc0 + (size_t)(tc + 2) * 64 * HD, vc0, HD, w, lane); }
            { const int lo2[2] = {0, 0}, hi2[2] = {nmax[0] - 64 * tc, nmax[1] - 64 * tc}; const bool nm = __ballot(hi2[0] < 63 || hi2[1] < 63) != 0ull;
              attn_tile<0, 3>(RG + rb * RB + klane, RG, Qf, O, mrow, lrow, lo2, hi2, nm, c2, invl, imp, ql, 0, cin, lane); }
            rb = (rb + 1 == NRING) ? 0 : rb + 1;
        }
#pragma unroll
        for (int s = 0; s < 2; ++s) { float lt = lrow[s]; lt = xq_sum(lt); invl[s] = (lt > 0.f) ? 1.0f / lt : 0.f;
#pragma unroll
            for (int dt = 0; dt < 8; ++dt) O[s][dt] = (f32x4){0.f, 0.f, 0.f, 0.f}; }
        NSA_BAR();
        tile_dma<true>(RG, kc0, vc0, HD, w, lane); if (ntc > 1) tile_dma<true>(RG + RB, kc0 + (size_t)64 * HD, vc0 + (size_t)64 * HD, HD, w, lane);
        for (int tc = 0, rb = 0; tc < ntc; ++tc) {
            if (tc + 1 < ntc) NSA_WAITV(4); else NSA_WAITV(0);
            NSA_BAR();
            if (tc + 2 < ntc) { const int nb2 = (rb + 2 >= NRING) ? rb + 2 - NRING : rb + 2; tile_dma<true>(RG + nb2 * RB, kc0 + (size_t)(tc + 2) * 64 * HD, vc0 + (size_t)(tc + 2) * 64 * HD, HD, w, lane); }
            { const int lo2[2] = {0, 0}, hi2[2] = {nmax[0] - 64 * tc, nmax[1] - 64 * tc}; const bool nm = __ballot(hi2[0] < 63 || hi2[1] < 63) != 0ull;
              attn_tile<2, 3>(RG + rb * RB + klane, RG + rb * RB + vlane, Qf, O, mrow, lrow, lo2, hi2, nm, c2, invl, imp, ql, 16 * tc, cin, lane); }
            rb = (rb + 1 == NRING) ? 0 : rb + 1;
        }
#pragma unroll
        for (int s = 0; s < 2; ++s) { const float gate = sigmoidf_(bf2f(proj[(size_t)trow[s] * LDP + C_GN + (4 * g + hd) * 3 + 0]));
            nsa_emit<true>(O[s], gate, ya + (size_t)trow[s] * DM + (4 * g + hd) * HD + 4 * qd); }
        }
        for (int rep_ = 0; rep_ < (NSA_REP_PART == 1 ? 2 : 1); ++rep_) {
            LDS_WAIT();
            const int nforced = (cur == 0) ? 1 : (cur == 1) ? 2 : 3; const int nsel = (cur + 1 < NSEL) ? cur + 1 : NSEL; const int R = nsel - nforced;
            const int E = (cur >= 3) ? cur - 2 : 0;
            for (int q8 = 0; q8 < 8; ++q8) {
                const int q = 8 * w + q8;
                const int j0 = lane, j1 = lane + 64;
                const bool e0 = (j0 >= 1) && (j0 <= cur - 2), e1 = (j1 <= cur - 2);
                const bool f0 = (j0 == 0) || (j0 == cur) || (j0 == cur - 1), f1 = (j1 == cur) || (j1 == cur - 1);
                bool s0 = e0, s1 = e1;
                if (R < E) {
                    const unsigned k0 = e0 ? __builtin_bit_cast(unsigned, imp[q * 128 + j0]) + 1u : 0u, k1 = e1 ? __builtin_bit_cast(unsigned, imp[q * 128 + j1]) + 1u : 0u;
                    unsigned T = 0u;
#pragma unroll 1
                    for (int bit = 30; bit >= 0; --bit) { const unsigned c = T | (1u << bit);
                        const int n = __builtin_popcountll(__ballot(k0 >= c)) + __builtin_popcountll(__ballot(k1 >= c));
                        if (n >= R) T = c; }
                    const unsigned long long eq0 = __ballot(k0 == T), eq1 = __ballot(k1 == T);
                    const int G = __builtin_popcountll(__ballot(k0 > T)) + __builtin_popcountll(__ballot(k1 > T));
                    const unsigned long long lt = (1ull << lane) - 1ull;
                    const int r0 = __builtin_popcountll(eq0 & lt), r1 = __builtin_popcountll(eq0) + __builtin_popcountll(eq1 & lt);
                    s0 = (k0 > T) || (k0 == T && r0 < R - G); s1 = (k1 > T) || (k1 == T && r1 < R - G);
                }
                const unsigned long long m0 = __ballot(f0 || s0), m1 = __ballot(f1 || s1);
                if (lane == 0) { selm[q * 4 + 0] = (unsigned)m0; selm[q * 4 + 1] = (unsigned)(m0 >> 32); selm[q * 4 + 2] = (unsigned)m1; selm[q * 4 + 3] = (unsigned)(m1 >> 32); }
            }
            __syncthreads();
            if (w == 0) { unsigned x0 = selm[lane * 4 + 0], x1 = selm[lane * 4 + 1], x2 = selm[lane * 4 + 2], x3 = selm[lane * 4 + 3];
#pragma unroll
                for (int o = 1; o < 64; o <<= 1) { x0 |= shfl_idx_u(x0, lane ^ o); x1 |= shfl_idx_u(x1, lane ^ o); x2 |= shfl_idx_u(x2, lane ^ o); x3 |= shfl_idx_u(x3, lane ^ o); }
                if (lane == 0) { uml[0] = x0; uml[1] = x1; uml[2] = x2; uml[3] = x3; } }
            __syncthreads();
        }
        const unsigned um0 = __builtin_amdgcn_readfirstlane(uml[0]), um1 = __builtin_amdgcn_readfirstlane(uml[1]), um2 = __builtin_amdgcn_readfirstlane(uml[2]), um3 = __builtin_amdgcn_readfirstlane(uml[3]);
        for (int rep_ = 0; rep_ < (NSA_REP_PART == 3 ? 2 : 1); ++rep_) {
            const bf16* ks0 = (const bf16*)(F.ws + WS_KV) + kv_off(2, b, g, 0); const bf16* vs0 = (const bf16*)(F.ws + WS_KV) + kv_off(3, b, g, 0);
#pragma unroll
            for (int s = 0; s < 2; ++s) { mrow[s] = -1e30f; lrow[s] = 0.f;
#pragma unroll
                for (int dt = 0; dt < 8; ++dt) O[s][dt] = (f32x4){0.f, 0.f, 0.f, 0.f}; }
#if NSA_REP_PART == 11
            {
            int jaD = next_bit(um0, um1, um2, um3, 0), jbD = next_bit(um0, um1, um2, um3, jaD + 1), pbD = 0;
            VM_WAIT(); if (NSA_REP_PART == 3) NSA_BAR();
            tile_dma<true>(RG, ks0 + (size_t)jaD * 64 * HD, vs0 + (size_t)jaD * 64 * HD, HD, w, lane); SELDUP(tile_dma<true>(RG, ks0 + (size_t)jaD * 64 * HD, vs0 + (size_t)jaD * 64 * HD, HD, w, lane);)
            if (jbD >= 0) tile_dma<true>(RG + RB, ks0 + (size_t)jbD * 64 * HD, vs0 + (size_t)jbD * 64 * HD, HD, w, lane); SELDUP(tile_dma<true>(RG + RB, ks0 + (size_t)jbD * 64 * HD, vs0 + (size_t)jbD * 64 * HD, HD, w, lane);)
            while (jaD >= 0) {
                const int jcD = (jbD >= 0) ? next_bit(um0, um1, um2, um3, jbD + 1) : -1, jdD = (jcD >= 0) ? next_bit(um0, um1, um2, um3, jcD + 1) : -1;
                NSA_WAITV(0);
                NSA_BAR();
                if (jcD >= 0) { LAS unsigned char* nb = RG + (pbD ^ 1) * 2 * RB; tile_dma<true>(nb, ks0 + (size_t)jcD * 64 * HD, vs0 + (size_t)jcD * 64 * HD, HD, w, lane); SELDUP(tile_dma<true>(nb, ks0 + (size_t)jcD * 64 * HD, vs0 + (size_t)jcD * 64 * HD, HD, w, lane);)
                    if (jdD >= 0) tile_dma<true>(nb + RB, ks0 + (size_t)jdD * 64 * HD, vs0 + (size_t)jdD * 64 * HD, HD, w, lane); SELDUP(tile_dma<true>(nb + RB, ks0 + (size_t)jdD * 64 * HD, vs0 + (size_t)jdD * 64 * HD, HD, w, lane);) }
                jaD = jcD; jbD = jdD; pbD ^= 1;
            }
            NSA_BAR();
            }
#endif
            int ja = next_bit(um0, um1, um2, um3, 0), jbb = next_bit(um0, um1, um2, um3, ja + 1), pbuf = 0;
            VM_WAIT(); if (NSA_REP_PART == 3) NSA_BAR();
            tile_dma<true>(RG, ks0 + (size_t)ja * 64 * HD, vs0 + (size_t)ja * 64 * HD, HD, w, lane); SELDUP(tile_dma<true>(RG, ks0 + (size_t)ja * 64 * HD, vs0 + (size_t)ja * 64 * HD, HD, w, lane);)
            if (jbb >= 0) tile_dma<true>(RG + RB, ks0 + (size_t)jbb * 64 * HD, vs0 + (size_t)jbb * 64 * HD, HD, w, lane); SELDUP(tile_dma<true>(RG + RB, ks0 + (size_t)jbb * 64 * HD, vs0 + (size_t)jbb * 64 * HD, HD, w, lane);)
            while (ja >= 0) {
                const int jc = (jbb >= 0) ? next_bit(um0, um1, um2, um3, jbb + 1) : -1, jd = (jc >= 0) ? next_bit(um0, um1, um2, um3, jc + 1) : -1;
                NSA_WAITV(0);
                NSA_BAR();
                if (jc >= 0) { LAS unsigned char* nb = RG + (pbuf ^ 1) * 2 * RB; tile_dma<true>(nb, ks0 + (size_t)jc * 64 * HD, vs0 + (size_t)jc * 64 * HD, HD, w, lane); SELDUP(tile_dma<true>(nb, ks0 + (size_t)jc * 64 * HD, vs0 + (size_t)jc * 64 * HD, HD, w, lane);)
                    if (jd >= 0) tile_dma<true>(nb + RB, ks0 + (size_t)jd * 64 * HD, vs0 + (size_t)jd * 64 * HD, HD, w, lane); SELDUP(tile_dma<true>(nb + RB, ks0 + (size_t)jd * 64 * HD, vs0 + (size_t)jd * 64 * HD, HD, w, lane);) }
#pragma unroll 1
                for (int e2 = 0; e2 < 2; ++e2) { const int jb = e2 ? jbb : ja; if (jb < 0) break;
                  const bool act0 = (selm[ql[0] * 4 + (jb >> 5)] >> (jb & 31)) & 1u, act1 = (selm[ql[1] * 4 + (jb >> 5)] >> (jb & 31)) & 1u;
                  const bool any0 = __ballot(act0) != 0ull, any1 = __ballot(act1) != 0ull;
                  const int lo2[2] = {0, 0}, hi2[2] = {act0 ? ((jb < cur) ? 63 : ql[0]) : -1, act1 ? ((jb < cur) ? 63 : ql[1]) : -1};
                  LAS const unsigned char* kt = RG + (pbuf * 2 + e2) * RB + klane; LAS const unsigned char* vt = RG + (pbuf * 2 + e2) * RB + vlane;
                  if (any0 && any1) { const bool nm = __ballot(hi2[0] < 63 || hi2[1] < 63) != 0ull; attn_tile<1, 3>(kt, vt, Qf, O, mrow, lrow, lo2, hi2, nm, c2, invl, imp, ql, 0, cin, lane); }
                  else if (any0) { const bool nm = __ballot(hi2[0] < 63) != 0ull; attn_tile<1, 1>(kt, vt, Qf, O, mrow, lrow, lo2, hi2, nm, c2, invl, imp, ql, 0, cin, lane); }
                  else if (any1) { const bool nm = __ballot(hi2[1] < 63) != 0ull; attn_tile<1, 2>(kt, vt, Qf, O, mrow, lrow, lo2, hi2, nm, c2, invl, imp, ql, 0, cin, lane); } }
                ja = jc; jbb = jd; pbuf ^= 1;
            }
            NSA_BAR();
#pragma unroll
            for (int s = 0; s < 2; ++s) { float lt = lrow[s]; lt = xq_sum(lt);
                const float gate = sigmoidf_(bf2f(proj[(size_t)trow[s] * LDP + C_GN + (4 * g + hd) * 3 + 1]));
                if (rep_ == 0) nsa_emit<false>(O[s], (lt > 0.f) ? gate / lt : 0.f, ya + (size_t)trow[s] * DM + (4 * g + hd) * HD + 4 * qd); }
        }
        for (int rep_ = 0; rep_ < (NSA_REP_PART == 4 ? 2 : 1); ++rep_) {
            const bf16* kw0 = (const bf16*)(F.ws + WS_KV) + kv_off(4, b, g, 0); const bf16* vw0 = (const bf16*)(F.ws + WS_KV) + kv_off(5, b, g, 0);
#pragma unroll
            for (int s = 0; s < 2; ++s) { mrow[s] = -1e30f; lrow[s] = 0.f;
#pragma unroll
                for (int dt = 0; dt < 8; ++dt) O[s][dt] = (f32x4){0.f, 0.f, 0.f, 0.f}; }
#if NSA_REP_PART == 8
            {
            const int tt0d = (qt >= 8) ? 0 : 8 - qt;
            VM_WAIT(); NSA_BAR();
            { const size_t r0 = (size_t)(s0 - 512 + 64 * tt0d) * HD; tile_dma<true>(RG, kw0 + r0, vw0 + r0, HD, w, lane); W7DUP(tile_dma<true>(RG, kw0 + r0, vw0 + r0, HD, w, lane);) }
            if (tt0d < 8) { const size_t r0 = (size_t)(s0 - 512 + 64 * (tt0d + 1)) * HD; tile_dma<true>(RG + RB, kw0 + r0, vw0 + r0, HD, w, lane); W7DUP(tile_dma<true>(RG + RB, kw0 + r0, vw0 + r0, HD, w, lane);) }
            for (int tt = tt0d, rb = 0; tt <= 8; ++tt) {
                if (tt < 8) { W7WAIT(); } else NSA_WAITV(0);
                NSA_BAR();
                if (tt + 2 <= 8) { const int nb2 = (rb + 2 >= NRING) ? rb + 2 - NRING : rb + 2; const size_t r0 = (size_t)(s0 - 512 + 64 * (tt + 2)) * HD; tile_dma<true>(RG + nb2 * RB, kw0 + r0, vw0 + r0, HD, w, lane); W7DUP(tile_dma<true>(RG + nb2 * RB, kw0 + r0, vw0 + r0, HD, w, lane);) }
                rb = (rb + 1 == NRING) ? 0 : rb + 1;
            }
            }
#endif
            const int tt0 = (qt >= 8) ? 0 : 8 - qt;
            VM_WAIT(); NSA_BAR();
            { const size_t r0 = (size_t)(s0 - 512 + 64 * tt0) * HD; tile_dma<true>(RG, kw0 + r0, vw0 + r0, HD, w, lane); W7DUP(tile_dma<true>(RG, kw0 + r0, vw0 + r0, HD, w, lane);) }
            if (tt0 < 8) { const size_t r0 = (size_t)(s0 - 512 + 64 * (tt0 + 1)) * HD; tile_dma<true>(RG + RB, kw0 + r0, vw0 + r0, HD, w, lane); W7DUP(tile_dma<true>(RG + RB, kw0 + r0, vw0 + r0, HD, w, lane);) }
            for (int tt = tt0, rb = 0; tt <= 8; ++tt) {
                if (tt < 8) { W7WAIT(); } else NSA_WAITV(0);
                NSA_BAR();
                if (tt + 2 <= 8) { const int nb2 = (rb + 2 >= NRING) ? rb + 2 - NRING : rb + 2; const size_t r0 = (size_t)(s0 - 512 + 64 * (tt + 2)) * HD; tile_dma<true>(RG + nb2 * RB, kw0 + r0, vw0 + r0, HD, w, lane); W7DUP(tile_dma<true>(RG + nb2 * RB, kw0 + r0, vw0 + r0, HD, w, lane);) }
                { const int lo2[2] = {(tt == 0) ? ql[0] + 1 : 0, (tt == 0) ? ql[1] + 1 : 0}, hi2[2] = {(tt == 8) ? ql[0] : 63, (tt == 8) ? ql[1] : 63};
                  attn_tile<1, 3>(RG + rb * RB + klane, RG + rb * RB + vlane, Qf, O, mrow, lrow, lo2, hi2, (tt == 0) || (tt == 8), c2, invl, imp, ql, 0, cin, lane);
#if NSA_REP_PART == 5
                  { const int him[2] = {-1, -1}; attn_tile<1, 3>(RG + rb * RB + klane, RG + rb * RB + vlane, Qf, O, mrow, lrow, lo2, him, true, c2, invl, imp, ql, 0, cin, lane); }
#endif
#if NSA_REP_PART == 6
                  NSA_BAR(); NSA_BAR(); NSA_BAR(); NSA_BAR();
#endif
                }
                rb = (rb + 1 == NRING) ? 0 : rb + 1;
            }
            VM_WAIT();
#pragma unroll
            for (int s = 0; s < 2; ++s) { float lt = lrow[s]; lt = xq_sum(lt);
                const float gate = sigmoidf_(bf2f(proj[(size_t)trow[s] * LDP + C_GN + (4 * g + hd) * 3 + 2]));
                if (rep_ == 0) nsa_emit<false>(O[s], (lt > 0.f) ? gate / lt : 0.f, ya + (size_t)trow[s] * DM + (4 * g + hd) * HD + 4 * qd); }
        }
        __syncthreads();
    }
    __builtin_amdgcn_s_setprio(0);
}

#if defined(CHECK_BUILD) && CHECK_BUILD
DI unsigned hash_u(unsigned x) { x ^= x >> 16; x *= 0x7feb352du; x ^= x >> 15; x *= 0x846ca68bu; x ^= x >> 16; return x; }
DI float blk_sum(float v, LAS float* red, int tid, int nthr) {
    for (int o = 32; o >= 1; o >>= 1) v += __shfl_xor(v, o);
    __syncthreads(); if ((tid & 63) == 0) red[tid >> 6] = v; __syncthreads();
    float s = 0.f; for (int k = 0; k < nthr / 64; ++k) s += red[k]; __syncthreads(); return s;
}
__global__ void chk_proj(Args args) {
    const int lane = threadIdx.x & 63, smp = blockIdx.x * (blockDim.x >> 6) + (threadIdx.x >> 6);
    const bf16* hb = (const bf16*)(args.ws + WS_HB); const bf16* proj = (const bf16*)(args.ws + WS_PROJ); const float* win = (const float*)args.in[4]; const int* pos = (const int*)args.in[2];
    unsigned* res = (unsigned*)(args.ws + WS_CTL) + CW_CHK;
    const unsigned h = hash_u(smp * 2654435761u + 12345u);
    int row = h % M; if (smp < 4) row = (smp == 0) ? 0 : (smp == 1) ? 8191 : (smp == 2) ? 8192 : 16383;
    const int kind = smp % 15; const unsigned h2 = hash_u(h + 77u);
    const int srcb[15] = {0, 2048, 2560, 3072, 3584, 4096, 4608, 5120, 5168, 7216, 9264, 11312, 13360, 16432, 16464};
    const int dstb[15] = {C_Q, C_KC, C_VC, C_KS, C_VS, C_KW, C_VW, C_GN, C_CB, C_CC, C_CU, C_Z, C_XBC, C_DT, C_GM};
    const int wid[15] = {2048, 512, 512, 512, 512, 512, 512, 48, 2048, 2048, 2048, 2048, 3072, 32, 6144};
    const bool rope = (kind == 0 || kind == 1 || kind == 3 || kind == 5);
    int e = h2 % wid[kind]; if (rope) e = (e / 128) * 128 + (e % 64);
    float d0 = 0.f, d1 = 0.f;
    for (int k = lane; k < DM; k += 64) { const float a = bf2f(hb[(size_t)row * DM + k]); d0 += a * win[(size_t)k * PROJ_SRC + srcb[kind] + e]; if (rope) d1 += a * win[(size_t)k * PROJ_SRC + srcb[kind] + e + 64]; }
    for (int o = 32; o >= 1; o >>= 1) { d0 += __shfl_xor(d0, o); d1 += __shfl_xor(d1, o); }
    float e0 = d0, e1 = d1;
    if (rope) { const double inv = exp(-(double)(2 * (e % 64)) / 128.0 * 9.210340371976184); double ang = (double)pos[row] * inv; ang -= 6.283185307179586476925 * __builtin_rint(ang * 0.15915494309189533577); const float c = cosf((float)ang), s = sinf((float)ang); e0 = d0 * c - d1 * s; e1 = d1 * c + d0 * s; }
    if (lane == 0) {
        const bf16* kvb = (const bf16*)(args.ws + WS_KV);
        const bool inkv = (kind >= 1 && kind <= 6);
        const bf16* src = inkv ? kvb + kv_off(kind - 1, row >> 13, e >> 7, row & 8191) + (e & 127) : proj + (size_t)row * LDP + dstb[kind] + e;
        const float g0 = bf2f(src[0]); float err = fabsf(g0 - e0) / (0.03f + 0.02f * fabsf(e0));
        if (rope) { const float g1 = bf2f(src[64]); err = fmaxf(err, fabsf(g1 - e1) / (0.03f + 0.02f * fabsf(e1))); }
        if (!(err <= 1.0f)) atomicAdd(res + 0, 1u);
        atomicMax(res + 1, __float_as_uint(fminf(err, 1e6f)));
    }
}
__global__ void chk_cmp(Args args) {
    __shared__ float hid[128];
    const int tid = threadIdx.x, smp = blockIdx.x;
    const unsigned h = hash_u(smp * 40503u + 99u);
    const int kv = smp & 1, b = (smp >> 1) & 1, g = (smp >> 2) & 3; int n = h % NCMP; if (smp < 8) n = (smp < 4) ? 0 : 510;
    const bf16* proj = (const bf16*)(args.ws + WS_PROJ);
    const float* pe = (const float*)args.in[kv ? 6 : 5]; const float* w1 = (const float*)args.in[kv ? 11 : 7]; const float* b1 = (const float*)args.in[kv ? 12 : 8];
    const float* w2 = (const float*)args.in[kv ? 13 : 9]; const float* b2 = (const float*)args.in[kv ? 14 : 10];
    const bf16* out = (const bf16*)(args.ws + (kv ? WS_VCMP : WS_KCMP));
    unsigned* res = (unsigned*)(args.ws + WS_CTL) + CW_CHK;
    float s = b1[tid];
    for (int l = 0; l < 32; ++l) { const bf16* kr = (const bf16*)(args.ws + WS_KV) + kv_off(kv, b, g, 16 * n + l);
        for (int d = 0; d < 128; ++d) s += (bf2f(kr[d]) + pe[l * 128 + d]) * w1[(size_t)(l * 128 + d) * 128 + tid]; }
    hid[tid] = s / (1.0f + expf(-s));
    __syncthreads();
    float o = b2[tid];
    for (int k = 0; k < 128; ++k) o += hid[k] * w2[k * 128 + tid];
    const float got = bf2f(out[((size_t)(b * NG + g) * NCMP_PAD + n) * HD + tid]);
    const float err = fabsf(got - o) / (0.02f + 0.02f * fabsf(o));
    if (!(err <= 1.0f)) atomicAdd(res + 2, 1u);
    atomicMax(res + 3, __float_as_uint(fminf(err, 1e6f)));
}
constexpr int CHK_NT = 24;
__global__ void __launch_bounds__(256) chk_nsa(Args args) {
    __shared__ float qf[4][128], oacc[4][128], obr[4][128], sc[4][1024], imp[128], red[8];
    __shared__ int kl[1024], seln[16], usedl[128];
    const int tlist[CHK_NT] = {0, 1, 30, 31, 47, 63, 64, 65, 127, 128, 500, 511, 512, 513, 575, 1023, 1024, 1087, 2000, 4095, 4096, 6000, 8128, 8191};
    const int tid = threadIdx.x, smp = blockIdx.x;
    const int t = tlist[smp % CHK_NT], bg = (smp / CHK_NT + smp) & 7, b = bg >> 2, g = bg & 3, row = b * SEQ + t, cur = t >> 6;
    const bf16* proj = (const bf16*)(args.ws + WS_PROJ); const bf16* kcmp = (const bf16*)(args.ws + WS_KCMP) + (size_t)(b * NG + g) * NCMP_PAD * HD; const bf16* vcmp = (const bf16*)(args.ws + WS_VCMP) + (size_t)(b * NG + g) * NCMP_PAD * HD;
    const bf16* ya = (const bf16*)(args.ws + WS_YA);
    unsigned* res = (unsigned*)(args.ws + WS_CTL) + CW_CHK;
    const float scale = 0.08838834764831845f;
    for (int k = tid; k < 512; k += 256) { const int r = k >> 7, d = k & 127; qf[r][d] = bf2f(proj[(size_t)row * LDP + C_Q + (4 * g + r) * HD + d]); oacc[r][d] = 0.f; }
    __syncthreads();
    for (int br = 0; br < 3; ++br) {
        int nk = 0;
        if (br == 0) { nk = (t >= 31) ? ((t - 31) >> 4) + 1 : 0; for (int k = tid; k < nk; k += 256) kl[k] = k; }
        else if (br == 1) {
            if (tid == 0) {
                for (int j = 0; j < 128; ++j) usedl[j] = 0;
                for (int it = 0; it < 16; ++it) { int best = -1; float bv = 0.f;
                    for (int j = 0; j < 128; ++j) { if (usedl[j]) continue; const bool valid = (64 * j <= t); const bool forced = (j == 0) || (j == cur) || (j == cur - 1);
                        const float v = valid ? imp[j] + (forced ? 1.0e4f : 0.f) : -__builtin_inff();
                        if (best < 0 || v > bv) { best = j; bv = v; } }
                    usedl[best] = 1; seln[it] = best; } }
            __syncthreads();
            for (int k = tid; k < 1024; k += 256) kl[k] = seln[k >> 6] * 64 + (k & 63);
            nk = 1024;
        } else { nk = 576; for (int k = tid; k < 576; k += 256) kl[k] = (t & ~63) - WIN + k; }
        __syncthreads();
        for (int idx = tid; idx < 4 * nk; idx += 256) { const int r = idx / nk, k = idx - r * nk, key = kl[k];
            bool ok; const bf16* kp;
            if (br == 0) { ok = true; kp = kcmp + (size_t)key * HD; }
            else if (br == 1) { ok = (key <= t); kp = (const bf16*)(args.ws + WS_KV) + kv_off(2, b, g, key); }
            else { ok = (key >= 0) && (key <= t) && (key > t - WIN); kp = (const bf16*)(args.ws + WS_KV) + kv_off(4, b, g, key < 0 ? 0 : key); }
            float s = 0.f; for (int d = 0; d < 128; ++d) s += qf[r][d] * bf2f(kp[d]);
            sc[r][k] = ok ? s * scale : -__builtin_inff(); }
        __syncthreads();
        if (tid < 4) { float m = -__builtin_inff(); for (int k = 0; k < nk; ++k) m = fmaxf(m, sc[tid][k]);
            const float mm = (m > -1e30f) ? m : 0.f; float l = 0.f; for (int k = 0; k < nk; ++k) { const float e = (sc[tid][k] > -1e30f) ? expf(sc[tid][k] - mm) : 0.f; sc[tid][k] = e; l += e; }
            const float il = (l > 0.f) ? 1.0f / l : 0.f; for (int k = 0; k < nk; ++k) sc[tid][k] *= il; }
        __syncthreads();
        if (br == 0) { if (tid < 128) { float s = 0.f; for (int r = 0; r < 4; ++r) for (int n = 4 * tid - 1; n <= 4 * tid + 3; ++n) if (n >= 0 && n < nk) s += sc[r][n]; imp[tid] = s; } }
        for (int o = tid; o < 512; o += 256) { const int r = o >> 7, d = o & 127; float s = 0.f;
            for (int k = 0; k < nk; ++k) { const float p = sc[r][k]; if (p == 0.f) continue; const int key = kl[k];
                const bf16* vp = (br == 0) ? vcmp + (size_t)key * HD : (const bf16*)(args.ws + WS_KV) + kv_off(br == 1 ? 3 : 5, b, g, key);
                s += p * bf2f(vp[d]); }
            const float gate = 1.0f / (1.0f + expf(-bf2f(proj[(size_t)row * LDP + C_GN + (4 * g + r) * 3 + br])));
            oacc[r][d] += gate * s; obr[r][d] = s; }
        __syncthreads();
    }
    float errm = 0.f;
    for (int o = tid; o < 512; o += 256) { const int r = o >> 7, d = o & 127; const float got = bf2f(ya[(size_t)row * DM + (4 * g + r) * HD + d]), ex = oacc[r][d] * (CHECK_BUILD == 2 ? ((smp & 1) ? 1.5f : 1.0f) : 1.0f);
        errm = fmaxf(errm, fabsf(got - ex) / (0.006f + 0.03f * fabsf(ex))); }
    for (int o = 32; o >= 1; o >>= 1) errm = fmaxf(errm, __shfl_xor(errm, o));
    if ((tid & 63) == 0) red[tid >> 6] = errm;
    __syncthreads();
    if (tid == 0) { const float e = fmaxf(fmaxf(red[0], red[1]), fmaxf(red[2], red[3])); if (!(e <= 1.0f)) atomicAdd(res + 4, 1u); atomicMax(res + 5, __float_as_uint(fminf(e, 1e6f))); }
}
#ifndef CHK_B_SEL
#define CHK_B_SEL 5
#endif
__global__ void chk_report(Args args) {
    const unsigned* res = (const unsigned*)(args.ws + WS_CTL) + CW_CHK;
    const float A = 4.0f * (float)res[4] + (res[2] ? 2000.f : 0.f) + (res[0] ? 40000.f : 0.f);
    const float B = fminf(__uint_as_float(res[CHK_B_SEL]), 100.f);
    const size_t i = (size_t)blockIdx.x * blockDim.x + threadIdx.x;
    if (A > 0.f) { if (i == 0) args.out[0] += A; if (i >= 1 && i <= (1u << 20)) args.out[i] += B; }
}
#endif

constexpr int NPH_LAYER = 13, NPH = 2 + NPH_LAYER * DEPTH;
#ifndef PG8_SP2
#define PG8_SP2 true
#endif
#ifndef PG8_ALIGN
#define PG8_ALIGN true
#endif
#ifndef PH_MASK
#define PH_MASK 0xFFFFFFFFu
#endif
#ifndef REP_MASK
#define REP_MASK 0u
#endif
#ifndef REP_CNT
#define REP_CNT 2
#endif
#define REPN(kk) ((((unsigned)REP_MASK >> (kk)) & 1u) ? REP_CNT : 1)
#define INK(k, kk) (((PH_MASK >> (kk)) & 1u) && lo <= (k) && (k) < hi)
#if defined(TIME_PROBE)
#define STAMP(i) do { if (F.bid == 0 && F.tid == 0) ((unsigned long long*)(F.ctl + CW_TS))[i] = __builtin_amdgcn_s_memrealtime(); } while (0)
#else
#define STAMP(i) do { } while (0)
#endif
#if defined(BAR_TWICE)
#define SEAM_TWICE(x) x
#else
#define SEAM_TWICE(x)
#endif
#define SEAM(k) do { if (lo <= (k) && (k) + 1 < hi) { XcdBarrier b_ = bar; { unsigned long long p_ = (unsigned long long)bar.bar; asm volatile("" : "+s"(p_)); b_.bar = (unsigned*)p_; } xcd_barrier(b_); SEAM_TWICE(xcd_barrier(b_);) } STAMP((k) + 1); } while (0)
template <int LAYER> DI void g1_block(const Frame& F, const Args& args) {
    constexpr int layer = LAYER;
    bf16* hb = (bf16*)(F.ws + WS_HB); bf16* projb = (bf16*)(F.ws + WS_PROJ); bf16* eb = (bf16*)(F.ws + WS_EB);
#ifndef NO_G1
            { const Frame Fp = phase_frame(F);  pg8::Gemm g{hb, (const bf16*)lw_ptr(Fp, layer, LW_IN), M, LDP, DM}; pg8::StaticOrder S; S.init(M, LDP, Fp.G, Fp.bid);
              pg8::EpiB<2> E{projb, LDP, (const float*)(Fp.ws + WS_ROPE), (bf16*)(Fp.ws + WS_KV)};
              pg8::gemm_phase<pg8::EpiB<2>, pg8::StaticOrder, PG8_ALIGN, PG8_SP2>(Fp.lds, g, S, E, Fp.wave); }
#endif
#ifndef NO_G5
            { const Frame Fp = phase_frame(F);  pg8::Gemm g{(const bf16*)(Fp.ws + WS_PB) + (size_t)layer * M * PLE, (const bf16*)lw_ptr(Fp, layer, LW_PLE), M, DM, PLE}; pg8::LightOrder S; S.init(M, DM, Fp.G, Fp.bid);
              pg8::EpiB<0> E{eb, DM, nullptr, nullptr};
              pg8::gemm_phase<pg8::EpiB<0>, pg8::LightOrder, PG8_ALIGN, PG8_SP2>(Fp.lds, g, S, E, Fp.wave); }
#endif
}
template <int LAYER> DI void layer_phases(const Frame& F, const Args& args, const XcdBarrier& bar, const int lo, const int hi) {
    constexpr int layer = LAYER, layer_ = LAYER;
    float* xres = (float*)(F.ws + WS_X); bf16* hb = (bf16*)(F.ws + WS_HB); bf16* projb = (bf16*)(F.ws + WS_PROJ); bf16* ub = (bf16*)(F.ws + WS_U); bf16* eb = (bf16*)(F.ws + WS_EB);
        const int pb = 1 + NPH_LAYER * layer;
        const float* xin = (layer == 0) ? (const float*)argin(args, 0) : (const float*)xres;
        if (INK(pb + 0, 0)) { if (layer == 0) norm_rows<false>(F, xin, (const float*)argin(args, 3), hb);
                              else addnorm_rows<false>(F, xres, (const bf16*)(F.ws + WS_DELTA), (const float*)argin(args, 3) + (size_t)layer * DM, xres, hb); }
        SEAM(pb + 0);
        if (INK(pb + 1, 1)) { g1_block<LAYER>(F, args); if (REPN(1) >= 2) g1_block<LAYER>(F, args); }
        SEAM(pb + 1);
        if (INK(pb + 2, 2)) for (int rep = 0; rep < REPN(2); ++rep) { ssd_conv_pass(F, args, layer); compress_phase(F, args, layer); }
        SEAM(pb + 2);
        if (INK(pb + 3, 3)) for (int rep = 0; rep < REPN(3); ++rep) ssd_states_phase(F, args, layer);
        SEAM(pb + 3);
        if (INK(pb + 4, 4)) ssd_scan_phase(F);
        SEAM(pb + 4);
        if (INK(pb + 5, 5)) {
#ifndef NO_S3
            for (int rep = 0; rep < REPN(15); ++rep) ssd_out_phase(F, args, layer);
#endif
            STAMP(60 + layer);
#ifndef NO_NSA
            for (int rep = 0; rep < REPN(5); ++rep) nsa_phase(F, args, layer);
#endif
        }
        SEAM(pb + 5);
        if (INK(pb + 6, 6)) for (int rep = 0; rep < REPN(6); ++rep) merge_pass(F, args, layer);
        SEAM(pb + 6);
        if (INK(pb + 7, 7)) for (int rep = 0; rep < REPN(7); ++rep) { const Frame Fp = phase_frame(F);  pg8::Gemm g{hb, (const bf16*)lw_ptr(Fp, layer, LW_O), M, DM, DM}; pg8::StaticOrder S; S.init(M, DM, Fp.G, Fp.bid);
            pg8::EpiB<0> E{(bf16*)(Fp.ws + WS_DELTA), DM, nullptr, nullptr};
            pg8::gemm_phase<pg8::EpiB<0>, pg8::StaticOrder, PG8_ALIGN, PG8_SP2>(Fp.lds, g, S, E, Fp.wave); }
        SEAM(pb + 7);
        if (INK(pb + 8, 8)) for (int rep = 0; rep < REPN(8); ++rep) addnorm_rows<false>(F, xin, (const bf16*)(F.ws + WS_DELTA), (const float*)argin(args, 23) + (size_t)layer * DM, rep ? (float*)(F.ws + WS_ST) : xres, rep ? (bf16*)(F.ws + WS_ST + 128 * MiB - 64 * MiB) : hb);
        SEAM(pb + 8);
        if (INK(pb + 9, 9)) for (int rep = 0; rep < REPN(9); ++rep) { const Frame Fp = phase_frame(F);  pg8::Gemm g{hb, (const bf16*)lw_ptr(Fp, layer, LW_UP), M, DFF, DM}; pg8::StaticOrder S; S.init(M, DFF, Fp.G, Fp.bid);
            pg8::EpiB<1> E{ub, DFF, nullptr, nullptr};
            pg8::gemm_phase<pg8::EpiB<1>, pg8::StaticOrder, PG8_ALIGN, PG8_SP2>(Fp.lds, g, S, E, Fp.wave); }
        SEAM(pb + 9);
        if (INK(pb + 10, 10)) for (int rep = 0; rep < REPN(10); ++rep) { const Frame Fp = phase_frame(F);  pg8::Gemm g{ub, (const bf16*)lw_ptr(Fp, layer, LW_DOWN), M, DM, DFF}; pg8::StaticOrder S; S.init(M, DM, Fp.G, Fp.bid);
            pg8::EpiB<0> E{(bf16*)(Fp.ws + WS_DELTA), DM, nullptr, nullptr};
            pg8::gemm_phase<pg8::EpiB<0>, pg8::StaticOrder, PG8_ALIGN, PG8_SP2>(Fp.lds, g, S, E, Fp.wave); }
        SEAM(pb + 10);
        if (INK(pb + 11, 11)) addnorm_rows<false>(F, xres, (const bf16*)(F.ws + WS_DELTA), (const float*)argin(args, 26) + (size_t)layer * DM, xres, hb);
        SEAM(pb + 11);
        if (INK(pb + 12, 12)) for (int rep = 0; rep < REPN(12); ++rep) { const Frame Fp = phase_frame(F);  pg8::Gemm g{hb, (const bf16*)lw_ptr(Fp, layer, LW_PG), M, DM, DM}; pg8::StaticOrder S; S.init(M, DM, Fp.G, Fp.bid);
            pg8::EpiB<3> E{(bf16*)(Fp.ws + WS_DELTA), DM, (const float*)eb, nullptr};
            pg8::gemm_phase<pg8::EpiB<3>, pg8::StaticOrder, PG8_ALIGN, PG8_SP2>(Fp.lds, g, S, E, Fp.wave); }
        SEAM(pb + 12);
}
__global__ void __launch_bounds__(NTHR, 2) hyb_fwd(Args args) {
    extern __shared__ __attribute__((aligned(16))) unsigned char lds_raw[];
    Frame F;
    F.lds = (LAS unsigned char*)lds_raw; F.ws = args.ws; F.ctl = (gu32*)(args.ws + WS_CTL);
    F.tid = threadIdx.x; F.lane = F.tid & 63; F.wave = __builtin_amdgcn_readfirstlane(threadIdx.x >> 6); F.G = gridDim.x; F.bid = blockIdx.x;
    const int lo = args.ph_lo, hi = args.ph_hi;
    if (F.tid < 64) ((LAS unsigned*)(F.lds + LDSCTL_OFF))[F.tid] = 0u;
    __syncthreads();
    XcdBarrier bar; bar.bar = (unsigned*)(F.ctl + CW_BAR); bar.x = 0; bar.st = (volatile LAS unsigned*)(F.lds + LDSCTL_OFF);
    if (hi - lo > 1) bar = xcd_barrier_post((unsigned*)(F.ctl + CW_BAR), (volatile LAS unsigned*)(F.lds + LDSCTL_OFF));
    STAMP(0);
    if (INK(0, 13)) for (int rep = 0; rep < REPN(13); ++rep) p0_prologue(F, args);
    SEAM(0);
    layer_phases<0>(F, args, bar, lo, hi); layer_phases<1>(F, args, bar, lo, hi); layer_phases<2>(F, args, bar, lo, hi); layer_phases<3>(F, args, bar, lo, hi);
    float* xres = (float*)(F.ws + WS_X);
    int hi_l = hi; asm volatile("" : "+s"(hi_l));
    if (((PH_MASK >> 14) & 1u) && lo <= NPH - 1 && NPH - 1 < hi_l) addnorm_rows<true>(F, xres, (const bf16*)(F.ws + WS_DELTA), (const float*)argin(args, 29), nullptr, args.out);
#if defined(TIME_PROBE)
    { XcdBarrier b_ = bar; xcd_barrier(b_); STAMP(NPH);
      if (F.bid == 0) {
        LAS float* ab = (LAS float*)(F.lds);
        if (F.tid == 0) { const unsigned long long* ts = (const unsigned long long*)(F.ctl + CW_TS); float sum[17];
            float sA = 0.f, sB = 0.f;
            for (int ph = 0; ph < NPH; ++ph) { int kind = (ph == 0) ? 13 : (ph == NPH - 1) ? 14 : (ph - 1) % NPH_LAYER; float d = (float)(ts[ph + 1] - ts[ph]) * 0.01f;
                if (kind == 5) { const int L = (ph - 1) / NPH_LAYER; const float d3 = (float)(ts[60 + L] - ts[ph]) * 0.01f; if (TIME_PROBE_A == 15) sA += d3; if (TIME_PROBE_B == 15) sB += d3; d -= d3; }
                if (kind == TIME_PROBE_A || (TIME_PROBE_A == 16 && (kind == 0 || kind == 8 || kind == 11))) sA += d;
                if (kind == TIME_PROBE_B || (TIME_PROBE_B == 16 && (kind == 0 || kind == 8 || kind == 11))) sB += d; }
            ab[0] = sA; ab[1] = sB * 0.01f; (void)sum; }
        __syncthreads();
        const float A = ab[0], B = ab[1];
        if (F.tid == 0) args.out[0] += A;
        for (int j = 0; j < 2048; ++j) args.out[1 + F.tid + NTHR * j] += B;
      } }
#endif
#undef INK
#undef SEAM
}

#ifndef MK_ONE_LAUNCH
#define MK_ONE_LAUNCH 1
#endif
extern "C" void kernel_launch(void* const* d_in, const int* in_sizes, int n_in, void* d_out, int out_size, void* d_ws, size_t ws_size, hipStream_t stream) {
    static int grid = 0;
    if (grid == 0) {
        if (n_in != 30 || out_size != M * DM || ws_size < WS_END) { fprintf(stderr, "kernel_launch: unexpected shapes (n_in %d out %d ws %zu need %zu)\n", n_in, out_size, ws_size, (size_t)WS_END); grid = -1; return; }
        int dev = 0, cus = 0, per_cu = 0;
        if (hipGetDevice(&dev) != hipSuccess || hipDeviceGetAttribute(&cus, hipDeviceAttributeMultiprocessorCount, dev) != hipSuccess) { grid = -1; return; }
        if (hipFuncSetAttribute((const void*)hyb_fwd, hipFuncAttributeMaxDynamicSharedMemorySize, LDS_BYTES) != hipSuccess) { fprintf(stderr, "kernel_launch: hipFuncSetAttribute failed\n"); grid = -1; return; }
        if (hipOccupancyMaxActiveBlocksPerMultiprocessor(&per_cu, (const void*)hyb_fwd, NTHR, LDS_BYTES) != hipSuccess || per_cu < 1) { fprintf(stderr, "kernel_launch: occupancy query says %d\n", per_cu); }
        (void)hipGetLastError();
        grid = cus;
    }
    if (grid < 0) return;
    (void)hipMemsetAsync((char*)d_ws + WS_CTL, 0, CTL_ZERO_BYTES, stream);
    Args a{};
    for (int i = 0; i < 30; ++i) a.in[i] = d_in[i];
    a.out = (float*)d_out; a.ws = (unsigned char*)d_ws;
#if MK_ONE_LAUNCH
    a.ph_lo = 0; a.ph_hi = NPH;
    hipLaunchKernelGGL(hyb_fwd, dim3(grid), dim3(NTHR), LDS_BYTES, stream, a);
#else
    for (int ph = 0; ph < NPH; ++ph) { a.ph_lo = ph; a.ph_hi = ph + 1; hipLaunchKernelGGL(hyb_fwd, dim3(grid), dim3(NTHR), LDS_BYTES, stream, a);
#if defined(CHECK_BUILD) && CHECK_BUILD
        if (ph == 2) hipLaunchKernelGGL(chk_proj, dim3(1024), dim3(256), 0, stream, a);
        if (ph == 3) hipLaunchKernelGGL(chk_cmp, dim3(128), dim3(128), 0, stream, a);
        if (ph == 6) hipLaunchKernelGGL(chk_nsa, dim3(8 * CHK_NT), dim3(256), 0, stream, a);
        if (ph == NPH - 1) hipLaunchKernelGGL(chk_report, dim3(4098), dim3(256), 0, stream, a);
#endif
    }
#endif
    (void)in_sizes;
}
```

```cpp
#define S3_PREFETCH 1
#include <hip/hip_runtime.h>
#include <cstdio>
#include <cstdint>
namespace pg8 {
#define PG8_LAS __attribute__((address_space(3)))
typedef unsigned short bf16_t;
typedef short bf16x8 __attribute__((ext_vector_type(8)));
typedef float f32x4 __attribute__((ext_vector_type(4)));
typedef unsigned u32x4 __attribute__((ext_vector_type(4)));
constexpr int BM = 256, BK = 64, HALF = 128, HTB = HALF * BK * 2  , STAGE_BYTES = 8 * HTB, NXCD = 8,
#ifdef PG8_WGM
    WGM = PG8_WGM;
#else
    WGM = 8;
#endif

__host__ __device__ __forceinline__ int lds_byte(int r, int c) { const int st = (r >> 4) * 2 + (c >> 5), rr = r & 15, cc = c & 31, ob = rr * 64 + cc * 2; return st * 1024 + (ob ^ (((ob >> 9) & 1) << 5)); }
__host__ __device__ __forceinline__ void stage_rc(int b, int& R, int& C) { const int st = b / 1024, sb = b % 1024, swz = sb ^ (((sb >> 9) & 1) << 5); R = (st >> 1) * 16 + swz / 64; C = (st & 1) * 32 + (swz % 64) / 2; }
__host__ __device__ __forceinline__ int perm32(int rho) { const int n = rho >> 4, i = rho & 15; return 8 * (i >> 2) + 4 * n + (i & 3); }

struct Unit { int pm, pn; };
struct Gemm { const bf16_t* A; const bf16_t* Bt; int M, N, K; };

struct StaticOrder {
    int nM, nN, nwg, G, c;
    __host__ __device__ void init(int M, int N, int G_, int c_) { nM = M / BM; nN = N / BM; nwg = nM * nN; G = G_; c = c_; }
    __host__ __device__ bool next(int i, Unit& u) const {
        const long L = (long)i * G + c; if (L >= nwg) return false;
        int wgid = (int)L; { const int q = nwg / NXCD, r = nwg % NXCD, xcd = wgid % NXCD, off = wgid / NXCD; wgid = (xcd < r ? xcd * (q + 1) : r * (q + 1) + (xcd - r) * q) + off; }
        const int nig = WGM * nN, gid = wgid / nig, fm = gid * WGM, gsz = (nM - fm) < WGM ? (nM - fm) : WGM;
        u.pm = fm + ((wgid % nig) % gsz); u.pn = (wgid % nig) / gsz; return true;
    }
    __device__ __forceinline__ void a_ready(const Unit&) const {}
    __device__ __forceinline__ void done(const Unit&) const {}
};
__device__ __forceinline__ unsigned cvt_pk_bf16(float lo, float hi) { unsigned r; asm volatile("v_cvt_pk_bf16_f32 %0, %1, %2" : "=v"(r) : "v"(lo), "v"(hi)); return r; }
template <class Epi, class Sched, bool ALIGN_EPI = false, bool SP2 = false>
__device__ __forceinline__ void gemm_phase(PG8_LAS unsigned char* lds, const Gemm g, const Sched& S, const Epi& E, const int wave_idx  ) {
    int lane_l; asm volatile("v_mbcnt_lo_u32_b32 %0, -1, 0\n\tv_mbcnt_hi_u32_b32 %0, -1, %0" : "=v"(lane_l));
    const int wid = wave_idx, tid = wid * 64 + lane_l, lane = tid & 63, wr = wid >> 2, wc = wid & 3, fr = lane & 15, fq = lane >> 4;
    const int K = g.K, nt = K / BK;
    unsigned voffA[2], voffB[2];
#pragma unroll
    for (int i = 0; i < 2; ++i) { int R, C; stage_rc(tid * 16 + i * 8192, R, C); const int Rb = Epi::PERM ? ((R & ~31) + perm32(R & 31)) : R;
        voffA[i] = (unsigned)(R * K + C) * 2u; voffB[i] = (unsigned)(Rb * K + C) * 2u; }
    const size_t kstep = (size_t)(BK * 2);
    const size_t hstep = (size_t)HALF * K * 2;
    const size_t tstep = 2 * hstep;
    const unsigned ldsw = (unsigned)wid * 1024u;
    const int aoff = lds_byte(wr * 64 + fr, fq * 8), boff = lds_byte(wc * 32 + fr, fq * 8);
#define PG8_SA(b, h) (((b) * 2 + (h)) * HTB)
#define PG8_SB(b, h) ((4 + (b) * 2 + (h)) * HTB)
#define PG8_STAGE(bufoff, gbase, voff) do { _Pragma("unroll") for (int _i = 0; _i < 2; ++_i) \
        __builtin_amdgcn_global_load_lds((const unsigned*)((const char*)(gbase) + (voff)[_i]), (PG8_LAS unsigned*)(lds + (bufoff) + ldsw + _i * 8192), 16, 0, 0); } while (0)
#define PG8_LDA(dst, b, h) do { _Pragma("unroll") for (int m = 0; m < 4; ++m) _Pragma("unroll") for (int k = 0; k < 2; ++k) dst[m][k] = *(const PG8_LAS bf16x8*)(lds + PG8_SA(b, h) + aoff + m * 2048 + k * 1024); } while (0)
#define PG8_LDB(dst, b, h) do { _Pragma("unroll") for (int n = 0; n < 2; ++n) _Pragma("unroll") for (int k = 0; k < 2; ++k) dst[n][k] = *(const PG8_LAS bf16x8*)(lds + PG8_SB(b, h) + boff + n * 2048 + k * 1024); } while (0)
#define PG8_MMA(ai, bj, At, Bt) do { __builtin_amdgcn_s_setprio(1); _Pragma("unroll") for (int m = 0; m < 4; ++m) _Pragma("unroll") for (int n = 0; n < 2; ++n) _Pragma("unroll") for (int k = 0; k < 2; ++k) \
        acc[ai][bj][m][n] = __builtin_amdgcn_mfma_f32_16x16x32_bf16(Bt[n][k], At[m][k], acc[ai][bj][m][n], 0, 0, 0); __builtin_amdgcn_s_setprio(0); } while (0)
#define PG8_WAIT_V(n) asm volatile("s_waitcnt vmcnt(" #n ")" ::: "memory")
#define PG8_WAIT_L(n) asm volatile("s_waitcnt lgkmcnt(" #n ")" ::: "memory")
#define PG8_BAR __builtin_amdgcn_s_barrier()
#define PG8_SCHED __builtin_amdgcn_sched_barrier(0)
    Unit cur, nxt; int ui = 0;
    if (!S.next(0, cur)) return;
    f32x4 acc[2][2][4][2];
#pragma unroll
    for (int a = 0; a < 2; ++a)
#pragma unroll
        for (int b = 0; b < 2; ++b)
#pragma unroll
            for (int m = 0; m < 4; ++m)
#pragma unroll
                for (int n = 0; n < 2; ++n) acc[a][b][m][n] = (f32x4){0.f, 0.f, 0.f, 0.f};
    bf16x8 At[4][2], B0[2][2], B1[2][2];
    const char* cA = (const char*)g.A + (size_t)cur.pm * tstep; const char* cB = (const char*)g.Bt + (size_t)cur.pn * tstep;
    S.a_ready(cur);
    if constexpr (SP2) {
        PG8_STAGE(PG8_SB(0, 0), cB, voffB); PG8_STAGE(PG8_SB(0, 1), cB + hstep, voffB); PG8_STAGE(PG8_SA(0, 0), cA, voffA); PG8_STAGE(PG8_SA(0, 1), cA + hstep, voffA);
        if (wr == 1) PG8_BAR;
        PG8_WAIT_V(2); PG8_BAR;
        PG8_STAGE(PG8_SB(1, 0), cB + kstep, voffB); PG8_STAGE(PG8_SA(1, 0), cA + kstep, voffA); PG8_STAGE(PG8_SB(1, 1), cB + hstep + kstep, voffB);
        PG8_WAIT_V(6); PG8_BAR;
    } else {
        PG8_STAGE(PG8_SB(0, 0), cB, voffB); PG8_STAGE(PG8_SA(0, 0), cA, voffA); PG8_STAGE(PG8_SB(0, 1), cB + hstep, voffB); PG8_STAGE(PG8_SA(0, 1), cA + hstep, voffA);
        if (wr == 1) PG8_BAR;
        PG8_WAIT_V(4); PG8_BAR;
        PG8_STAGE(PG8_SB(1, 0), cB + kstep, voffB); PG8_STAGE(PG8_SA(1, 0), cA + kstep, voffA); PG8_STAGE(PG8_SB(1, 1), cB + hstep + kstep, voffB);
        PG8_WAIT_V(6); PG8_BAR;
    }
    for (;;) {
        const bool has_next = S.next(ui + 1, nxt);
        const char* nA = has_next ? (const char*)g.A + (size_t)nxt.pm * tstep : cA; const char* nB = has_next ? (const char*)g.Bt + (size_t)nxt.pn * tstep : cB;
        for (int t = 0; t < nt; t += 2) {
            const bool last = (t == nt - 2);
            const char* a1 = cA + (size_t)(t + 1) * kstep;
            const char* a2 = last ? nA : cA + (size_t)(t + 2) * kstep; const char* b2 = last ? nB : cB + (size_t)(t + 2) * kstep;
            const char* a3 = a2 + kstep; const char* b3 = b2 + kstep;
            if (last && has_next) S.a_ready(nxt);
            if constexpr (SP2) {
            PG8_LDB(B0, 0, 0); PG8_LDB(B1, 0, 1); PG8_SCHED; PG8_LDA(At, 0, 0); PG8_STAGE(PG8_SA(1, 1), a1 + hstep, voffA);
            PG8_WAIT_V(8); PG8_WAIT_L(0); PG8_BAR; PG8_MMA(0, 0, At, B0); PG8_MMA(0, 1, At, B1); PG8_BAR; PG8_SCHED;
            PG8_LDA(At, 0, 1); PG8_STAGE(PG8_SB(0, 0), b2, voffB); PG8_STAGE(PG8_SB(0, 1), b2 + hstep, voffB); PG8_STAGE(PG8_SA(0, 0), a2, voffA);
            PG8_WAIT_V(8); PG8_WAIT_L(0); PG8_BAR; PG8_MMA(1, 0, At, B0); PG8_MMA(1, 1, At, B1); PG8_BAR; PG8_SCHED;
            PG8_LDB(B0, 1, 0); PG8_LDB(B1, 1, 1); PG8_SCHED; PG8_LDA(At, 1, 0); PG8_STAGE(PG8_SA(0, 1), a2 + hstep, voffA);
            PG8_WAIT_V(8); PG8_WAIT_L(0); PG8_BAR; PG8_MMA(0, 0, At, B0); PG8_MMA(0, 1, At, B1); PG8_BAR; PG8_SCHED;
            PG8_LDA(At, 1, 1); PG8_STAGE(PG8_SB(1, 0), b3, voffB); PG8_STAGE(PG8_SB(1, 1), b3 + hstep, voffB); PG8_STAGE(PG8_SA(1, 0), a3, voffA);
            PG8_WAIT_V(8); PG8_WAIT_L(0); PG8_BAR; PG8_MMA(1, 0, At, B0); PG8_MMA(1, 1, At, B1); PG8_BAR; PG8_SCHED;
            } else {
            PG8_LDB(B0, 0, 0); PG8_SCHED; PG8_LDA(At, 0, 0); PG8_STAGE(PG8_SA(1, 1), a1 + hstep, voffA);
            PG8_WAIT_L(8); PG8_BAR; PG8_WAIT_L(0); PG8_MMA(0, 0, At, B0); PG8_BAR; PG8_SCHED;
            PG8_LDB(B1, 0, 1); PG8_STAGE(PG8_SB(0, 0), b2, voffB);
            PG8_BAR; PG8_WAIT_L(0); PG8_MMA(0, 1, At, B1); PG8_BAR;
            PG8_LDA(At, 0, 1); PG8_STAGE(PG8_SA(0, 0), a2, voffA);
            PG8_BAR; PG8_WAIT_L(0); PG8_MMA(1, 0, At, B0); PG8_BAR; PG8_SCHED;
            PG8_STAGE(PG8_SB(0, 1), b2 + hstep, voffB);
            PG8_WAIT_V(6); PG8_BAR; PG8_MMA(1, 1, At, B1); PG8_BAR;
            PG8_LDB(B0, 1, 0); PG8_SCHED; PG8_LDA(At, 1, 0); PG8_STAGE(PG8_SA(0, 1), a2 + hstep, voffA);
            PG8_WAIT_L(8); PG8_BAR; PG8_WAIT_L(0); PG8_MMA(0, 0, At, B0); PG8_BAR; PG8_SCHED;
            PG8_LDB(B1, 1, 1); PG8_STAGE(PG8_SB(1, 0), b3, voffB);
            PG8_BAR; PG8_WAIT_L(0); PG8_MMA(0, 1, At, B1); PG8_BAR;
            PG8_LDA(At, 1, 1); PG8_STAGE(PG8_SA(1, 0), a3, voffA);
            PG8_BAR; PG8_WAIT_L(0); PG8_MMA(1, 0, At, B0); PG8_BAR; PG8_SCHED;
            PG8_STAGE(PG8_SB(1, 1), b3 + hstep, voffB);
            PG8_WAIT_V(6); PG8_BAR; PG8_MMA(1, 1, At, B1); PG8_BAR;
            }
        }
        if constexpr (ALIGN_EPI) { if (wr == 0) PG8_BAR; }
        if constexpr (!Epi::AFTER_DRAIN) { E(acc, cur, wr, wc, fr, fq);
#if defined(EPI_TWICE)
            if constexpr (Epi::PERM) E(acc, cur, wr, wc, fr, fq);
#endif
            S.done(cur); }
        if (!has_next) break;
#pragma unroll
        for (int a = 0; a < 2; ++a)
#pragma unroll
            for (int b = 0; b < 2; ++b)
#pragma unroll
                for (int m = 0; m < 4; ++m)
#pragma unroll
                    for (int n = 0; n < 2; ++n) acc[a][b][m][n] = (f32x4){0.f, 0.f, 0.f, 0.f};
        cur = nxt; cA = nA; cB = nB; ++ui;
        if constexpr (ALIGN_EPI) { if (wr == 1) PG8_BAR; }
    }
    PG8_WAIT_V(0);
    if constexpr (!ALIGN_EPI) { if (wr == 0) PG8_BAR; }
    PG8_BAR;
    if constexpr (Epi::AFTER_DRAIN) { E.fused(acc, cur, wr, wc, fr, fq, lds, wid, lane); S.done(cur); }
#undef PG8_SA
#undef PG8_SB
#undef PG8_STAGE
#undef PG8_LDA
#undef PG8_LDB
#undef PG8_MMA
#undef PG8_WAIT_V
#undef PG8_WAIT_L
#undef PG8_BAR
#undef PG8_SCHED
}
}

constexpr int BATCH = 2, SEQ = 8192, DM = 2048, DEPTH = 4;
constexpr int M = BATCH * SEQ;
constexpr int NH = 16, HD = 128, NG = 4, RH = 4;
constexpr int NCMP = 511, NCMP_PAD = 512, NSLC = 128, NSEL = 16, WIN = 512;
constexpr int SSD_H = 32, SSD_P = 64, SSD_N = 128, SSD_G = 4, SSD_CH = 128, SSD_NC = 64, SSD_XBC = 3072;
constexpr int DFF = 8192, PLE = 256;
constexpr float EPS = 1e-6f;
constexpr int PROJ_SRC = 22608;
constexpr int C_Q = 0, C_KC = 2048, C_VC = 2560, C_KS = 3072, C_VS = 3584, C_KW = 4096, C_VW = 4608;
constexpr int C_CB = 5120, C_CC = 7168, C_CU = 9216, C_Z = 11264, C_XBC = 13312, C_GM = 16384, C_GN = 22528, C_DT = 22592;
constexpr int LDP = 22784;
constexpr int S_GN = 5120, S_DT = 16432;

constexpr size_t MiB = 1u << 20;
constexpr size_t WS_CTL = 0, CTL_ZERO_BYTES = 1 * MiB;
constexpr size_t WS_ROPE = 1 * MiB;
constexpr size_t WS_MISC = 9 * MiB;
constexpr size_t WS_DT = 10 * MiB;
constexpr size_t WS_ACS = 12 * MiB;
constexpr size_t WS_CDEC = 14 * MiB;
constexpr size_t WS_KCMP = 15 * MiB;
constexpr size_t WS_VCMP = 16 * MiB;
constexpr size_t WS_X = 32 * MiB;
constexpr size_t WS_HB = 160 * MiB;
constexpr size_t WS_PB = 224 * MiB;
constexpr size_t WS_EB = 256 * MiB;
constexpr size_t WS_YA = 320 * MiB;
constexpr size_t WS_YC = 384 * MiB;
constexpr size_t WS_XBC = 448 * MiB;
constexpr size_t WS_ST = 544 * MiB;
constexpr size_t WS_PROJ = 672 * MiB;
constexpr size_t WS_U = WS_PROJ;
constexpr size_t WS_W = 1384 * MiB;
constexpr size_t LW_IN = 0;
constexpr size_t LW_O = 89 * MiB;
constexpr size_t LW_UP = 97 * MiB;
constexpr size_t LW_DOWN = 129 * MiB;
constexpr size_t LW_PG = 161 * MiB;
constexpr size_t LW_PLE = 169 * MiB;
constexpr size_t LW_PK1 = 170 * MiB;
constexpr size_t LW_PV1 = 171 * MiB;
constexpr size_t LW_PK2 = 172 * MiB;
constexpr size_t LW_PV2 = 172 * MiB + 64 * 1024;
constexpr size_t LW_STRIDE = 173 * MiB;
constexpr size_t WS_HIN = WS_W + 4 * LW_STRIDE;
constexpr size_t WS_RSTD = WS_MISC + 512 * 1024;
constexpr size_t WS_DELTA = WS_HIN + 64 * MiB;
constexpr size_t WS_KV = WS_DELTA + 64 * MiB;
constexpr size_t WS_END = WS_KV + 96 * MiB;
static_assert((size_t)M * LDP * 2 <= 712 * MiB && (size_t)LDP * 2048 * 2 <= 89 * MiB, "ws map");

constexpr int CW_BAR = 4096;
constexpr int CW_CHK = 16384;
constexpr int CW_TS = 20480;

constexpr int RING_BYTES = 131072;
constexpr int LX_OFF = RING_BYTES;
constexpr int LX_BYTES = 8192;
constexpr int LDSCTL_OFF = LX_OFF + LX_BYTES;
constexpr int LDS_BYTES = LDSCTL_OFF + 256;
constexpr int NWAVES = 8, NTHR = 512;

#define DI __device__ __forceinline__
#define GAS __attribute__((address_space(1)))
#define LAS __attribute__((address_space(3)))
typedef unsigned short bf16;
typedef unsigned u32x4 __attribute__((ext_vector_type(4)));
typedef unsigned u32x2 __attribute__((ext_vector_type(2)));
typedef float f32x4 __attribute__((ext_vector_type(4)));
typedef float f32x2 __attribute__((ext_vector_type(2)));
typedef short bf16x8 __attribute__((ext_vector_type(8)));
typedef short s16x4 __attribute__((ext_vector_type(4)));
typedef GAS unsigned gu32;
#define RLX_AGENT __ATOMIC_RELAXED, __HIP_MEMORY_SCOPE_AGENT
#define LDS_WAIT() asm volatile("s_waitcnt lgkmcnt(0)" ::: "memory")
#define VM_WAIT() asm volatile("s_waitcnt vmcnt(0)" ::: "memory")
DI size_t kv_off(int kind, int b, int g, int t) { return ((((size_t)kind * BATCH + b) * NG + g) * SEQ + t) * HD; }
DI unsigned f2bf(float f) { unsigned u = __builtin_bit_cast(unsigned, f); return (u + 0x7fffu + ((u >> 16) & 1u)) >> 16; }
DI unsigned pk2(float lo, float hi) { unsigned r; asm("v_cvt_pk_bf16_f32 %0, %1, %2" : "=v"(r) : "v"(lo), "v"(hi)); return r; }
DI float bf2f(unsigned h) { return __builtin_bit_cast(float, h << 16); }
DI float bflo(unsigned w) { return __builtin_bit_cast(float, w << 16); }
DI float bfhi(unsigned w) { return __builtin_bit_cast(float, w & 0xffff0000u); }
DI float sigmoidf_(float x) { return 1.0f / (1.0f + __expf(-x)); }
DI float siluf_(float x) { return x / (1.0f + __expf(-x)); }
DI float shfl_idx(float v, int src) { return __builtin_bit_cast(float, __builtin_amdgcn_ds_bpermute(src << 2, __builtin_bit_cast(int, v))); }
DI unsigned shfl_idx_u(unsigned v, int src) { return (unsigned)__builtin_amdgcn_ds_bpermute(src << 2, (int)v); }
DI float shx(float v, int m, int lane) { return shfl_idx(v, lane ^ m); }
DI float xq_max(float x) {
    float a = x, b = x;
    asm("s_nop 1\n\tv_permlane32_swap_b32 %0, %1" : "+v"(a), "+v"(b)); x = fmaxf(a, b);
    a = x; b = x;
    asm("s_nop 1\n\tv_permlane16_swap_b32 %0, %1" : "+v"(a), "+v"(b)); return fmaxf(a, b);
}
DI float xq_sum(float x) {
    float a = x, b = x;
    asm("s_nop 1\n\tv_permlane32_swap_b32 %0, %1" : "+v"(a), "+v"(b)); x = a + b;
    a = x; b = x;
    asm("s_nop 1\n\tv_permlane16_swap_b32 %0, %1" : "+v"(a), "+v"(b)); return a + b;
}
DI float quad_sum(float v) {
    v += __builtin_bit_cast(float, __builtin_amdgcn_update_dpp(0, __builtin_bit_cast(int, v), 0xB1, 0xF, 0xF, true));
    v += __builtin_bit_cast(float, __builtin_amdgcn_update_dpp(0, __builtin_bit_cast(int, v), 0x4E, 0xF, 0xF, true));
    return v;
}
DI float wave_sum(float v, int lane) {
#pragma unroll
    for (int o = 1; o < 64; o <<= 1) v += shx(v, o, lane);
    return v;
}
DI unsigned off_b(unsigned row, unsigned ch) { return 256u * row + 16u * (ch ^ (((row & 3u) << 2) | ((row >> 2) & 3u))); }
DI unsigned tr_addr(unsigned lane, unsigned r0, unsigned c, unsigned t) {
    const unsigned g = lane >> 4, q = (lane & 15u) >> 2, p = lane & 3u;
    return off_b(r0 + 8u * g + 4u * t + q, 2u * c + (p >> 1)) + 8u * (p & 1u);
}
DI s16x4 tr_read(LAS const unsigned char* p) { return __builtin_amdgcn_ds_read_tr16_b64_v4i16((LAS s16x4*)p); }
DI bf16x8 tr_read8(LAS const unsigned char* base, unsigned lane, unsigned r0, unsigned c) {
    const s16x4 lo = tr_read(base + tr_addr(lane, r0, c, 0)), hi = tr_read(base + tr_addr(lane, r0, c, 1));
    return __builtin_shufflevector(lo, hi, 0, 1, 2, 3, 4, 5, 6, 7);
}
DI bf16x8 lds_rd8(LAS const unsigned char* p) { return *(const LAS bf16x8*)p; }
DI bf16x8 as_bf16x8(u32x4 v) { return __builtin_bit_cast(bf16x8, v); }
#define MFMA16(a, b, c) __builtin_amdgcn_mfma_f32_16x16x32_bf16((a), (b), (c), 0, 0, 0)

namespace pg8 {
struct LightOrder {
    int G, c, nunits, nN;
    __host__ __device__ void init(int M, int N, int G_, int c_) { G = G_; c = c_; nN = N / BM; nunits = (M / BM) * nN; }
    __host__ __device__ bool next(int i, Unit& u) const {
        int j;
        if (G == 256) { if (c < 64) return false; j = (c - 64) + 192 * i; } else j = c + G * i;
        if (j >= nunits) return false;
        u.pm = j / nN; u.pn = j % nN; return true;
    }
    __device__ __forceinline__ void a_ready(const Unit&) const {}
    __device__ __forceinline__ void done(const Unit&) const {}
};
template <int MODE> struct EpiB {
    static constexpr bool PERM = true, AFTER_DRAIN = false;
    bf16_t* O; int ldc; const float* rope;
    bf16_t* kv;
    __device__ __forceinline__ void operator()(const f32x4 (&acc)[2][2][4][2], const Unit& u, int wr, int wc, int fr, int fq) const {
        { int l; asm volatile("v_mbcnt_lo_u32_b32 %0, -1, 0\n\tv_mbcnt_hi_u32_b32 %0, -1, %0" : "=v"(l)); fr = l & 15; fq = l >> 4; }
        const int row0 = u.pm * BM + wr * 64 + fr;
        bool rp = false;
        if (MODE == 2) { const int pn = u.pn; rp = (pn < 10) || pn == 12 || pn == 13 || pn == 16 || pn == 17; }
        if (MODE == 2 && rp) {
            const int colb = u.pn * BM + 128 * (wc >> 1) + 32 * (wc & 1) + 8 * fq, jj0 = 32 * (wc & 1) + 8 * fq;
#pragma unroll
            for (int ai = 0; ai < 2; ++ai)
#pragma unroll
                for (int m = 0; m < 4; ++m) {
                    const int row = row0 + ai * HALF + m * 16;
                    const float* rpp = (const float*)((const char*)rope + (unsigned)(((unsigned)row * 64u + (unsigned)jj0) * 8u));
                    const f32x4 cs0 = *(const f32x4*)(rpp), cs1 = *(const f32x4*)(rpp + 4), cs2 = *(const f32x4*)(rpp + 8), cs3 = *(const f32x4*)(rpp + 12);
                    const f32x4 x1a = acc[ai][0][m][0], x1b = acc[ai][0][m][1], x2a = acc[ai][1][m][0], x2b = acc[ai][1][m][1];
                    float c[8] = {cs0[0], cs0[2], cs1[0], cs1[2], cs2[0], cs2[2], cs3[0], cs3[2]};
                    float s[8] = {cs0[1], cs0[3], cs1[1], cs1[3], cs2[1], cs2[3], cs3[1], cs3[3]};
                    float x1[8] = {x1a[0], x1a[1], x1a[2], x1a[3], x1b[0], x1b[1], x1b[2], x1b[3]};
                    float x2[8] = {x2a[0], x2a[1], x2a[2], x2a[3], x2b[0], x2b[1], x2b[2], x2b[3]};
                    float o1[8], o2[8];
#pragma unroll
                    for (int k = 0; k < 8; ++k) { o1[k] = x1[k] * c[k] - x2[k] * s[k]; o2[k] = x2[k] * c[k] + x1[k] * s[k]; }
                    u32x4 w1, w2;
                    w1.x = cvt_pk_bf16(o1[0], o1[1]); w1.y = cvt_pk_bf16(o1[2], o1[3]); w1.z = cvt_pk_bf16(o1[4], o1[5]); w1.w = cvt_pk_bf16(o1[6], o1[7]);
                    w2.x = cvt_pk_bf16(o2[0], o2[1]); w2.y = cvt_pk_bf16(o2[2], o2[3]); w2.z = cvt_pk_bf16(o2[4], o2[5]); w2.w = cvt_pk_bf16(o2[6], o2[7]);
                    bf16_t* rowp = (bf16_t*)((char*)O + (unsigned)(((unsigned)row * (unsigned)ldc + (unsigned)colb) * 2u));
                    if (u.pn >= 8) { const int kind = (u.pn - 8) >> 1, g = 2 * (u.pn & 1) + (wc >> 1);
                        rowp = kv + ((((size_t)kind * 2 + (row >> 13)) * 4 + g) * 8192 + (row & 8191)) * 128 + jj0; }
                    *(u32x4*)(rowp) = w1; *(u32x4*)(rowp + 64) = w2;
                    asm volatile("" ::: "memory");
                }
        } else {
            const int col0 = u.pn * BM + wc * 32 + 8 * fq;
#pragma unroll
            for (int ai = 0; ai < 2; ++ai)
#pragma unroll
                for (int m = 0; m < 4; ++m) { bf16_t* rowp = (bf16_t*)((char*)O + (unsigned)(((unsigned)(row0 + ai * HALF + m * 16) * (unsigned)ldc + (unsigned)col0) * 2u));
#pragma unroll
                    for (int bj = 0; bj < 2; ++bj) { f32x4 v0 = acc[ai][bj][m][0], v1 = acc[ai][bj][m][1];
                        if (MODE == 1) {
#pragma unroll
                            for (int k = 0; k < 4; ++k) { const float a = fmaxf(v0[k], 0.f), b = fmaxf(v1[k], 0.f); v0[k] = a * a; v1[k] = b * b; } }
                        if (MODE == 3) { const u32x4 ev = *(const u32x4*)((const bf16_t*)rope + (rowp - O) + bj * HALF);
                            const float e[8] = {__builtin_bit_cast(float, ev.x << 16), __builtin_bit_cast(float, ev.x & 0xffff0000u), __builtin_bit_cast(float, ev.y << 16), __builtin_bit_cast(float, ev.y & 0xffff0000u),
                                                __builtin_bit_cast(float, ev.z << 16), __builtin_bit_cast(float, ev.z & 0xffff0000u), __builtin_bit_cast(float, ev.w << 16), __builtin_bit_cast(float, ev.w & 0xffff0000u)};
#pragma unroll
                            for (int k = 0; k < 4; ++k) { v0[k] = e[k] / (1.0f + __expf(-v0[k])); v1[k] = e[4 + k] / (1.0f + __expf(-v1[k])); } }
                        u32x4 w; w.x = cvt_pk_bf16(v0[0], v0[1]); w.y = cvt_pk_bf16(v0[2], v0[3]); w.z = cvt_pk_bf16(v1[0], v1[1]); w.w = cvt_pk_bf16(v1[2], v1[3]);
                        if (MODE == 2 && u.pn >= 8 && u.pn < 20) { const int kind = (u.pn - 8) >> 1, g = 2 * (u.pn & 1) + bj, row = row0 + ai * HALF + m * 16;
                            *(u32x4*)(kv + ((((size_t)kind * 2 + (row >> 13)) * 4 + g) * 8192 + (row & 8191)) * 128 + wc * 32 + 8 * fq) = w; }
                        else *(u32x4*)(rowp + bj * HALF) = w; } }
        }
    }
};
template <bool GATE> struct EpiRes {
    static constexpr bool PERM = false, AFTER_DRAIN = false;
    const float* xin; float* xout; int ldc; const bf16_t* e;
    __device__ __forceinline__ void operator()(const f32x4 (&acc)[2][2][4][2], const Unit& u, int wr, int wc, int fr, int fq) const {
        { int l; asm volatile("v_mbcnt_lo_u32_b32 %0, -1, 0\n\tv_mbcnt_hi_u32_b32 %0, -1, %0" : "=v"(l)); fr = l & 15; fq = l >> 4; }
        const int row0 = u.pm * BM + wr * 64 + fr, col0 = u.pn * BM + wc * 32 + 4 * fq;
#pragma unroll
        for (int ai = 0; ai < 2; ++ai)
#pragma unroll
            for (int m = 0; m < 4; ++m) { const unsigned off = (unsigned)(row0 + ai * HALF + m * 16) * (unsigned)ldc + (unsigned)col0;
#pragma unroll
                for (int bj = 0; bj < 2; ++bj)
#pragma unroll
                    for (int n = 0; n < 2; ++n) { const unsigned o = off + bj * HALF + n * 16; const f32x4 xv = *(const f32x4*)((const char*)xin + (unsigned)(o * 4u)); f32x4 a = acc[ai][bj][m][n];
                        if (GATE) { typedef unsigned u32x2v __attribute__((ext_vector_type(2))); const u32x2v ev = *(const u32x2v*)((const char*)e + (unsigned)(o * 2u));
                            const float e0 = __builtin_bit_cast(float, ev.x << 16), e1 = __builtin_bit_cast(float, ev.x & 0xffff0000u), e2 = __builtin_bit_cast(float, ev.y << 16), e3 = __builtin_bit_cast(float, ev.y & 0xffff0000u);
                            a[0] = e0 / (1.0f + __expf(-a[0])); a[1] = e1 / (1.0f + __expf(-a[1])); a[2] = e2 / (1.0f + __expf(-a[2])); a[3] = e3 / (1.0f + __expf(-a[3])); }
                        *(f32x4*)((char*)xout + (unsigned)(o * 4u)) = xv + a; }
                asm volatile("" ::: "memory"); }
    }
};
}
#define XB_TMO      128
#define XB_XCNT(j)  (256  + 64 * (j))
#define XB_XSUB(j)  (1280 + 64 * (j))
#define XB_XGEN(j)  (2304 + 64 * (j))
#define XB_TOP      3328
#define XB_TOPGEN   3392
#define XCD_BAR_WORDS 3456
#define XB_SPIN_CAP (1u << 18)

__device__ __forceinline__ unsigned xb_ld(unsigned* p)              { return __hip_atomic_load(p, __ATOMIC_RELAXED, __HIP_MEMORY_SCOPE_AGENT); }
__device__ __forceinline__ unsigned xb_add(unsigned* p, unsigned v) { return __hip_atomic_fetch_add(p, v, __ATOMIC_RELAXED, __HIP_MEMORY_SCOPE_AGENT); }
__device__ __forceinline__ unsigned xb_xcc_id() { return (unsigned)__builtin_amdgcn_s_getreg((3 << 11) | 20) & 0xFu; }
#define XB_SPIN(cond, bar) do { unsigned _sp = 0; while (cond) { __builtin_amdgcn_s_sleep(1); \
    if ((++_sp & 255u) == 0u) { if (xb_ld(&(bar)[XB_TMO])) break; if (_sp > XB_SPIN_CAP) { atomicAdd(&(bar)[XB_TMO], 1u); break; } } } } while (0)

struct XcdBarrier {
    unsigned* bar; unsigned x;
    volatile LAS unsigned* st;
};

__device__ __forceinline__ XcdBarrier xcd_barrier_post(unsigned* bar, volatile LAS unsigned* st) {
    XcdBarrier b; b.bar = bar; b.x = xb_xcc_id(); b.st = st;
    if (threadIdx.x == 0) (void)xb_add(&bar[XB_XCNT(b.x)], 1u);
    return b;
}
__device__ __forceinline__ void xcd_barrier_complete(unsigned* bar, unsigned x, unsigned& nloc, unsigned& nx) {
    const unsigned G = gridDim.x * gridDim.y * gridDim.z;
    unsigned sum, cnt, mine, sp = 0u;
    for (;;) {
        sum = 0u; cnt = 0u; mine = 0u;
#pragma unroll
        for (unsigned j = 0; j < 16; ++j) { const unsigned c = xb_ld(&bar[XB_XCNT(j)]); sum += c; cnt += (c > 0u) ? 1u : 0u; mine = (j == x) ? c : mine; }
        if (sum == G) break;
        __builtin_amdgcn_s_sleep(1);
        if ((++sp & 255u) == 0u) { if (xb_ld(&bar[XB_TMO])) break; if (sp > XB_SPIN_CAP) { atomicAdd(&bar[XB_TMO], 1u); break; } }
    }
    nloc = mine > 0u ? mine : 1u; nx = cnt > 0u ? cnt : 1u;
}

__device__ __forceinline__ void xcd_barrier(const XcdBarrier& b) {
    asm volatile("s_waitcnt vmcnt(0)" ::: "memory");
    __syncthreads();
    if (threadIdx.x == 0) {
        unsigned* bar = b.bar;
        __builtin_amdgcn_s_waitcnt(0);
        unsigned nloc = b.st[0], nx = b.st[1];
        if (nloc == 0u) { xcd_barrier_complete(bar, b.x, nloc, nx); b.st[0] = nloc; b.st[1] = nx; }
        const unsigned old = xb_add(&bar[XB_XSUB(b.x)], 1u);
        const unsigned gen = old / nloc;
        if (old + 1u == (gen + 1u) * nloc) {
            __builtin_amdgcn_fence(__ATOMIC_RELEASE, "agent");
            asm volatile("s_waitcnt vmcnt(0)" ::: "memory");
            const unsigned og = xb_add(&bar[XB_TOP], 1u);
            const unsigned tg = og / nx;
            if (og + 1u == (tg + 1u) * nx) xb_add(&bar[XB_TOPGEN], 1u);
            else XB_SPIN(xb_ld(&bar[XB_TOPGEN]) == tg, bar);
            __builtin_amdgcn_fence(__ATOMIC_ACQUIRE, "agent");
            xb_add(&bar[XB_XGEN(b.x)], 1u);
            asm volatile("s_waitcnt vmcnt(0)" ::: "memory");
        } else {
            XB_SPIN(xb_ld(&bar[XB_XGEN(b.x)]) == gen, bar);
            __builtin_amdgcn_fence(__ATOMIC_ACQUIRE, "agent");
            asm volatile("s_waitcnt vmcnt(0)" ::: "memory");
        }
    }
    __syncthreads();
}

struct Args { const void* in[30]; float* out; unsigned char* ws; int ph_lo, ph_hi; };
struct Frame {
    LAS unsigned char* lds;
    gu32* ctl;
    unsigned char* ws;
    int tid, lane, wave, G, bid;
};
DI const void* argin(const Args&, int k) {
    typedef const void* const __attribute__((address_space(4)))* kptr_t;
    kptr_t p = (kptr_t)__builtin_amdgcn_kernarg_segment_ptr(); asm volatile("" : "+s"(p));
    return (const void*)p[k]; }
DI int launder_s(int x) { asm volatile("" : "+s"(x)); return x; }
DI Frame phase_frame(const Frame& F0) { Frame F = F0;
    int l; asm volatile("v_mbcnt_lo_u32_b32 %0, -1, 0\n\tv_mbcnt_hi_u32_b32 %0, -1, %0" : "=v"(l));
    F.wave = launder_s(F0.wave); F.bid = launder_s(F0.bid); F.G = launder_s(F0.G);
    F.lane = l; F.tid = F.wave * 64 + l;
    { unsigned long long wsb = (unsigned long long)F0.ws; asm volatile("" : "+s"(wsb)); F.ws = (unsigned char*)wsb; }
    { unsigned ll = (unsigned)(size_t)F0.lds; asm volatile("" : "+s"(ll)); F.lds = (LAS unsigned char*)(size_t)ll; }
    return F; }
DI unsigned char* lw_ptr(const Frame& F, int layer, size_t off) { return F.ws + WS_W + (size_t)layer * LW_STRIDE + off; }

template <bool FRAGMAJOR = false>
DI void transpose_item(const float* W, int K, int Nsrc, int nsrc0, bf16* WT, int dst_row0, int k0, LAS float* scr, int lane) {
#pragma unroll 8
    for (int i = 0; i < 32; ++i) { const int kk = 2 * i + (lane >> 5); scr[kk * 33 + (lane & 31)] = W[(size_t)(k0 + kk) * Nsrc + nsrc0 + (lane & 31)]; }
    LDS_WAIT(); asm volatile("" ::: "memory");
    const int c = lane & 7;
#pragma unroll
    for (int j = 0; j < 4; ++j) { const int n = (lane >> 3) + 8 * j; const LAS float* s = scr + (8 * c) * 33 + n;
        u32x4 o; o.x = pk2(s[0 * 33], s[1 * 33]); o.y = pk2(s[2 * 33], s[3 * 33]); o.z = pk2(s[4 * 33], s[5 * 33]); o.w = pk2(s[6 * 33], s[7 * 33]);
        if (FRAGMAJOR) { const int hid = dst_row0 + n, kk = k0 + 8 * c;
            *(u32x4*)(WT + ((size_t)((hid >> 4) * (K >> 5) + (kk >> 5)) * 64 + (((kk >> 3) & 3) * 16 + (hid & 15))) * 8) = o; }
        else *(u32x4*)(WT + (size_t)(dst_row0 + n) * K + k0 + 8 * c) = o; }
    LDS_WAIT(); asm volatile("" ::: "memory");
}
DI int proj_src_col(int d) {
    if (d < 5120) {
        const int pn = d >> 8; const bool rp = (pn < 10) || pn == 12 || pn == 13 || pn == 16 || pn == 17;
        if (!rp) return d;
        const int c = d & 255, bj = c >> 7, wc = (c >> 5) & 3;
        return (pn << 8) + 128 * (wc >> 1) + 64 * bj + 32 * (wc & 1);
    }
    if (d < 16384) return d + 48;
    if (d < 22528) return d + 80;
    if (d < 22592) return S_GN + (d - 22528);
    if (d < 22624) return S_DT + (d - 22592);
    return 0;
}
constexpr int TI_IN = 32 * 712, TI_O = 32 * 64, TI_UP = 32 * 256, TI_DOWN = 128 * 64, TI_PG = 32 * 64, TI_PLE = 4 * 64, TI_P1 = 64 * 4, TI_P2 = 2 * 4;
constexpr int TI_LAYER = TI_IN + TI_O + TI_UP + TI_DOWN + TI_PG + TI_PLE + 2 * TI_P1 + 2 * TI_P2;

DI void p0_prologue(const Frame& F0, const Args& A) {
    const Frame F = phase_frame(F0);
    LAS float* scr = (LAS float*)(F.lds + F.wave * 16384);
    const int gw = F.bid * NWAVES + F.wave, NGW = F.G * NWAVES;
    for (int it = gw; it < DEPTH * TI_LAYER; it += NGW) {
        const int layer = it / TI_LAYER; int r = it - layer * TI_LAYER;
        if (r < TI_IN) { const int kb = r / 712, nb = r - kb * 712;
            transpose_item((const float*)argin(A, 4) + (size_t)layer * DM * PROJ_SRC, DM, PROJ_SRC, proj_src_col(nb * 32), (bf16*)lw_ptr(F, layer, LW_IN), nb * 32, kb * 64, scr, F.lane); continue; } r -= TI_IN;
        if (r < TI_O) { const int kb = r / 64, nb = r % 64;
            transpose_item((const float*)argin(A, 22) + (size_t)layer * DM * DM, DM, DM, nb * 32, (bf16*)lw_ptr(F, layer, LW_O), nb * 32, kb * 64, scr, F.lane); continue; } r -= TI_O;
        if (r < TI_UP) { const int kb = r / 256, nb = r % 256;
            transpose_item((const float*)argin(A, 24) + (size_t)layer * DM * DFF, DM, DFF, nb * 32, (bf16*)lw_ptr(F, layer, LW_UP), nb * 32, kb * 64, scr, F.lane); continue; } r -= TI_UP;
        if (r < TI_DOWN) { const int kb = r / 64, nb = r % 64;
            transpose_item((const float*)argin(A, 25) + (size_t)layer * DFF * DM, DFF, DM, nb * 32, (bf16*)lw_ptr(F, layer, LW_DOWN), nb * 32, kb * 64, scr, F.lane); continue; } r -= TI_DOWN;
        if (r < TI_PG) { const int kb = r / 64, nb = r % 64;
            transpose_item((const float*)argin(A, 28) + (size_t)layer * DM * DM, DM, DM, nb * 32, (bf16*)lw_ptr(F, layer, LW_PG), nb * 32, kb * 64, scr, F.lane); continue; } r -= TI_PG;
        if (r < TI_PLE) { const int kb = r / 64, nb = r % 64;
            transpose_item((const float*)argin(A, 27) + (size_t)layer * PLE * DM, PLE, DM, nb * 32, (bf16*)lw_ptr(F, layer, LW_PLE), nb * 32, kb * 64, scr, F.lane); continue; } r -= TI_PLE;
        if (r < TI_P1) { const int kb = r / 4, nb = r % 4;
            transpose_item<true>((const float*)argin(A, 7) + (size_t)layer * 4096 * 128, 4096, 128, nb * 32, (bf16*)lw_ptr(F, layer, LW_PK1), nb * 32, kb * 64, scr, F.lane); continue; } r -= TI_P1;
        if (r < TI_P1) { const int kb = r / 4, nb = r % 4;
            transpose_item<true>((const float*)argin(A, 11) + (size_t)layer * 4096 * 128, 4096, 128, nb * 32, (bf16*)lw_ptr(F, layer, LW_PV1), nb * 32, kb * 64, scr, F.lane); continue; } r -= TI_P1;
        if (r < TI_P2) { const int kb = r / 4, nb = r % 4;
            transpose_item((const float*)argin(A, 9) + (size_t)layer * 128 * 128, 128, 128, nb * 32, (bf16*)lw_ptr(F, layer, LW_PK2), nb * 32, kb * 64, scr, F.lane); continue; } r -= TI_P2;
        { const int kb = r / 4, nb = r % 4;
            transpose_item((const float*)argin(A, 13) + (size_t)layer * 128 * 128, 128, 128, nb * 32, (bf16*)lw_ptr(F, layer, LW_PV2), nb * 32, kb * 64, scr, F.lane); }
    }
    const size_t gt = (size_t)F.bid * NTHR + F.tid, NGT = (size_t)F.G * NTHR;
    { const float* p = (const float*)argin(A, 1); bf16* pb = (bf16*)(F.ws + WS_PB);
      for (size_t i = gt; i < (size_t)DEPTH * M * PLE / 8; i += NGT) { const f32x4 a = *(const f32x4*)(p + i * 8), b = *(const f32x4*)(p + i * 8 + 4);
          u32x4 o; o.x = pk2(a[0], a[1]); o.y = pk2(a[2], a[3]); o.z = pk2(b[0], b[1]); o.w = pk2(b[2], b[3]); *(u32x4*)(pb + i * 8) = o; } }
    { const int* pos = (const int*)argin(A, 2); float* rope = (float*)(F.ws + WS_ROPE);
      for (size_t i = gt; i < (size_t)M * 64; i += NGT) { const int row = (int)(i >> 6), jj = (int)(i & 63);
          const float inv = 1.0f / powf(10000.0f, (float)(2 * jj) * (1.0f / 128.0f));
          const float ang = (float)pos[row] * inv;
          double a = (double)ang; a -= 6.283185307179586476925 * __builtin_rint(a * 0.15915494309189533577);
          const float ar = (float)a;
          rope[i * 2] = cosf(ar); rope[i * 2 + 1] = sinf(ar); } }
    { float* part = (float*)(F.ws + WS_MISC);
      for (size_t i = gt; i < (size_t)DEPTH * 2 * 8 * 128; i += NGT) { const int hid = (int)(i & 127), c = (int)(i >> 7) & 7, kv = (int)(i >> 10) & 1, layer = (int)(i >> 11);
          const float* pe = (const float*)(kv ? A.in[6] : A.in[5]) + (size_t)layer * 4096 + c * 512;
          const float* w1 = (const float*)(kv ? A.in[11] : A.in[7]) + (size_t)layer * 4096 * 128 + (size_t)c * 512 * 128 + hid;
          float s = 0.f;
#pragma unroll 8
          for (int kk = 0; kk < 512; ++kk) s += pe[kk] * w1[(size_t)kk * 128];
          part[i] = s; } }
}

template <bool OUTF32> DI void norm_rows(const Frame& F0, const float* x, const float* g, void* outp) {
    const Frame F = phase_frame(F0);
    const int gw = F.bid * NWAVES + F.wave, NGW = F.G * NWAVES;
    for (int m = gw; m < M; m += NGW) {
        const f32x4* xr = (const f32x4*)(x + (size_t)m * DM) + F.lane;
        f32x4 v[8]; float s = 0.f;
#pragma unroll
        for (int j = 0; j < 8; ++j) { v[j] = xr[64 * j]; s += (v[j][0] * v[j][0] + v[j][1] * v[j][1]) + (v[j][2] * v[j][2] + v[j][3] * v[j][3]); }
        const float rstd = 1.0f / sqrtf(wave_sum(s, F.lane) * (1.0f / DM) + EPS);
#pragma unroll
        for (int j = 0; j < 8; ++j) { const f32x4 gv = ((const f32x4*)g)[F.lane + 64 * j]; const f32x4 o = v[j] * rstd * gv;
            if (OUTF32) ((f32x4*)((float*)outp + (size_t)m * DM))[F.lane + 64 * j] = o;
            else { u32x2 w; w.x = pk2(o[0], o[1]); w.y = pk2(o[2], o[3]); ((u32x2*)((bf16*)outp + (size_t)m * DM))[F.lane + 64 * j] = w; } }
    }
}
template <bool OUTF32> DI void addnorm_rows(const Frame& F0, const float* xin, const bf16* delta, const float* g, float* xout, void* outp) {
    const Frame F = phase_frame(F0);
    const int gw = F.bid * NWAVES + F.wave, NGW = F.G * NWAVES;
    for (int m = gw; m < M; m += NGW) {
        const f32x4* xr = (const f32x4*)(xin + (size_t)m * DM) + F.lane; const u32x2* dr = (const u32x2*)(delta + (size_t)m * DM) + F.lane;
        f32x4 v[8]; u32x2 d[8]; float s = 0.f;
#pragma unroll
        for (int j = 0; j < 8; ++j) { v[j] = xr[64 * j]; d[j] = dr[64 * j]; }
#pragma unroll
        for (int j = 0; j < 8; ++j) { v[j][0] += bflo(d[j].x); v[j][1] += bfhi(d[j].x); v[j][2] += bflo(d[j].y); v[j][3] += bfhi(d[j].y);
            s += (v[j][0] * v[j][0] + v[j][1] * v[j][1]) + (v[j][2] * v[j][2] + v[j][3] * v[j][3]);
            if (!OUTF32) ((f32x4*)(xout + (size_t)m * DM))[F.lane + 64 * j] = v[j]; }
        const float rstd = 1.0f / sqrtf(wave_sum(s, F.lane) * (1.0f / DM) + EPS);
#pragma unroll
        for (int j = 0; j < 8; ++j) { const f32x4 gv = ((const f32x4*)g)[F.lane + 64 * j]; const f32x4 o = v[j] * rstd * gv;
            if (OUTF32) ((f32x4*)((float*)outp + (size_t)m * DM))[F.lane + 64 * j] = o;
            else { u32x2 w; w.x = pk2(o[0], o[1]); w.y = pk2(o[2], o[3]); ((u32x2*)((bf16*)outp + (size_t)m * DM))[F.lane + 64 * j] = w; } }
    }
}
DI void unpack8(u32x4 w, float (&f)[8]) { f[0] = bflo(w.x); f[1] = bfhi(w.x); f[2] = bflo(w.y); f[3] = bfhi(w.y); f[4] = bflo(w.z); f[5] = bfhi(w.z); f[6] = bflo(w.w); f[7] = bfhi(w.w); }
DI u32x4 pack8f(const float (&f)[8]) { u32x4 o; o.x = pk2(f[0], f[1]); o.y = pk2(f[2], f[3]); o.z = pk2(f[4], f[5]); o.w = pk2(f[6], f[7]); return o; }

DI void ssd_conv_pass(const Frame& F0, const Args& A, int layer) {
    const Frame F = phase_frame(F0);
    const bf16* proj = (const bf16*)(F.ws + WS_PROJ); bf16* xbc = (bf16*)(F.ws + WS_XBC);
    const float* cw = (const float*)argin(A, 16) + (size_t)layer * 4 * SSD_XBC; const float* cb = (const float*)argin(A, 17) + (size_t)layer * SSD_XBC;
    const int gt = F.bid * NTHR + F.tid, NGT = F.G * NTHR;
    for (int task = gt; task < 512 * 384; task += NGT) {
        const int run = task / 384, cg = task - run * 384, ch = cg * 8, row0 = run * 32;
        float w[4][8], bs[8], xm3[8], xm2[8], xm1[8];
#pragma unroll
        for (int j = 0; j < 4; ++j) { const f32x4 a = *(const f32x4*)(cw + j * SSD_XBC + ch), b = *(const f32x4*)(cw + j * SSD_XBC + ch + 4);
            w[j][0] = a[0]; w[j][1] = a[1]; w[j][2] = a[2]; w[j][3] = a[3]; w[j][4] = b[0]; w[j][5] = b[1]; w[j][6] = b[2]; w[j][7] = b[3]; }
        { const f32x4 a = *(const f32x4*)(cb + ch), b = *(const f32x4*)(cb + ch + 4); bs[0] = a[0]; bs[1] = a[1]; bs[2] = a[2]; bs[3] = a[3]; bs[4] = b[0]; bs[5] = b[1]; bs[6] = b[2]; bs[7] = b[3]; }
        if ((row0 & (SEQ - 1)) != 0) {
            unpack8(*(const u32x4*)(proj + (size_t)(row0 - 3) * LDP + C_XBC + ch), xm3);
            unpack8(*(const u32x4*)(proj + (size_t)(row0 - 2) * LDP + C_XBC + ch), xm2);
            unpack8(*(const u32x4*)(proj + (size_t)(row0 - 1) * LDP + C_XBC + ch), xm1);
        } else {
#pragma unroll
            for (int k = 0; k < 8; ++k) { xm3[k] = 0.f; xm2[k] = 0.f; xm1[k] = 0.f; }
        }
#pragma unroll 4
        for (int r = 0; r < 32; ++r) {
            float cur[8], y[8]; unpack8(*(const u32x4*)(proj + (size_t)(row0 + r) * LDP + C_XBC + ch), cur);
#pragma unroll
            for (int k = 0; k < 8; ++k) { const float v = w[0][k] * xm3[k] + w[1][k] * xm2[k] + w[2][k] * xm1[k] + w[3][k] * cur[k] + bs[k]; y[k] = siluf_(v); xm3[k] = xm2[k]; xm2[k] = xm1[k]; xm1[k] = cur[k]; }
            *(u32x4*)(xbc + (size_t)(row0 + r) * SSD_XBC + ch) = pack8f(y);
        }
    }
    const float* dtb = (const float*)argin(A, 18) + layer * SSD_H; float* dt = (float*)(F.ws + WS_DT);
    for (int i = gt; i < M * SSD_H; i += NGT) { const int row = i >> 5, h = i & 31;
        const float x = bf2f(proj[(size_t)row * LDP + C_DT + h]) + dtb[h];
        dt[i] = fmaxf(x, 0.f) + log1pf(__expf(-fabsf(x))); }
}

DI void merge_pass(const Frame& F0, const Args& A, int layer) {
    const Frame F = phase_frame(F0);
    const bf16* proj = (const bf16*)(F.ws + WS_PROJ); const bf16* ya = (const bf16*)(F.ws + WS_YA); const bf16* yc = (const bf16*)(F.ws + WS_YC); bf16* hb = (bf16*)(F.ws + WS_HB);
    const float* sw = (const float*)argin(A, 15) + (size_t)layer * 3 * DM; const float* ngp = (const float*)argin(A, 21) + (size_t)layer * DM; const float* rstdp = (const float*)(F.ws + WS_RSTD);
    const int gt = F.bid * NTHR + F.tid, NGT = F.G * NTHR;
    for (int task = gt; task < 512 * 256; task += NGT) {
        const int run = task >> 8, cg = task & 255, ch = cg * 8, row0 = run * 32;
        float w[3][8], pm2[8], pm1[8], ng8[8];
        { const f32x4 a = *(const f32x4*)(ngp + ch), b = *(const f32x4*)(ngp + ch + 4); ng8[0] = a[0]; ng8[1] = a[1]; ng8[2] = a[2]; ng8[3] = a[3]; ng8[4] = b[0]; ng8[5] = b[1]; ng8[6] = b[2]; ng8[7] = b[3]; }
#pragma unroll
        for (int j = 0; j < 3; ++j) { const f32x4 a = *(const f32x4*)(sw + j * DM + ch), b = *(const f32x4*)(sw + j * DM + ch + 4);
            w[j][0] = a[0]; w[j][1] = a[1]; w[j][2] = a[2]; w[j][3] = a[3]; w[j][4] = b[0]; w[j][5] = b[1]; w[j][6] = b[2]; w[j][7] = b[3]; }
        if ((row0 & (SEQ - 1)) != 0) {
            float c1[8], u1[8];
            unpack8(*(const u32x4*)(proj + (size_t)(row0 - 2) * LDP + C_CC + ch), c1); unpack8(*(const u32x4*)(proj + (size_t)(row0 - 2) * LDP + C_CU + ch), u1);
#pragma unroll
            for (int k = 0; k < 8; ++k) pm2[k] = c1[k] * u1[k];
            unpack8(*(const u32x4*)(proj + (size_t)(row0 - 1) * LDP + C_CC + ch), c1); unpack8(*(const u32x4*)(proj + (size_t)(row0 - 1) * LDP + C_CU + ch), u1);
#pragma unroll
            for (int k = 0; k < 8; ++k) pm1[k] = c1[k] * u1[k];
        } else {
#pragma unroll
            for (int k = 0; k < 8; ++k) { pm2[k] = 0.f; pm1[k] = 0.f; }
        }
#pragma unroll 2
        for (int r = 0; r < 32; ++r) {
            const size_t pr = (size_t)(row0 + r) * LDP + ch, yr = (size_t)(row0 + r) * DM + ch;
            float cc[8], cu[8], cbv[8], g0[8], g1[8], g2[8], a[8], c[8], o[8];
            unpack8(*(const u32x4*)(proj + pr + C_CC), cc); unpack8(*(const u32x4*)(proj + pr + C_CU), cu); unpack8(*(const u32x4*)(proj + pr + C_CB), cbv);
            unpack8(*(const u32x4*)(proj + pr + C_GM), g0); unpack8(*(const u32x4*)(proj + pr + C_GM + DM), g1); unpack8(*(const u32x4*)(proj + pr + C_GM + 2 * DM), g2);
            unpack8(*(const u32x4*)(ya + yr), a); unpack8(*(const u32x4*)(yc + yr), c);
            const float rs = rstdp[(size_t)(row0 + r) * SSD_G + (ch >> 9)];
#pragma unroll
            for (int k = 0; k < 8; ++k) { const float pc = cc[k] * cu[k]; const float cv = w[0][k] * pm2[k] + w[1][k] * pm1[k] + w[2][k] * pc; pm2[k] = pm1[k]; pm1[k] = pc;
                o[k] = sigmoidf_(g0[k]) * a[k] + sigmoidf_(g1[k]) * (cbv[k] * cv) + sigmoidf_(g2[k]) * (c[k] * rs * ng8[k]); }
            *(u32x4*)(hb + yr) = pack8f(o);
        }
    }
}

DI void compress_phase(const Frame& F0, const Args& A, int layer) {
    const Frame F = phase_frame(F0);
    const bf16* proj = (const bf16*)(F.ws + WS_PROJ);
    LAS unsigned char* slab = F.lds;
    LAS unsigned char* hidl = F.lds + 73728;
    LAS float* b1s = (LAS float*)(F.lds + 81920);
    const int lane = F.lane, w = F.wave, i = lane & 15, qd = lane >> 4;
    const float* part = (const float*)(F.ws + WS_MISC);
    for (int u = F.bid; u < 512; u += F.G) {
        const int kv = u >> 8, b = (u >> 7) & 1, g = (u >> 5) & 3, nb = u & 31, n0 = nb * 16, tok0 = n0 * 16;
        const bf16* src = (const bf16*)(F.ws + WS_KV) + kv_off(kv, b, g, 0);
        for (int id = F.tid; id < 272 * 16; id += NTHR) { const int row = id >> 4, ch = id & 15, t = tok0 + row;
            u32x4 v = {0u, 0u, 0u, 0u}; if (t < SEQ) v = *(const u32x4*)(src + (size_t)t * HD + ch * 8);
            *(LAS u32x4*)(slab + off_b(row, ch)) = v; }
        if (F.tid < 128) { float s = ((const float*)argin(A, kv ? 12 : 8))[layer * 128 + F.tid];
#pragma unroll
            for (int c = 0; c < 8; ++c) s += part[(((size_t)layer * 2 + kv) * 8 + c) * 128 + F.tid];
            b1s[F.tid] = s; }
        __syncthreads();
        const bf16* w1t = (const bf16*)lw_ptr(F, layer, kv ? LW_PV1 : LW_PK1) + ((size_t)w * 128 * 64 + lane) * 8;
        f32x4 acc = {0.f, 0.f, 0.f, 0.f};
#if defined(SSD_IGLP)
        __builtin_amdgcn_iglp_opt(0);
#endif
        for (int k0 = 0; k0 < 128; k0 += 32) {
            bf16x8 bb[32];
#pragma unroll
            for (int k = 0; k < 32; ++k) bb[k] = *(const bf16x8*)(w1t + 512 * (k0 + k));
#pragma unroll
            for (int k = 0; k < 32; ++k) { const int ks = k0 + k;
                acc = MFMA16(lds_rd8(slab + off_b(16 * i + (ks >> 2), 4 * (ks & 3) + qd)), bb[k], acc); }
        }
        { const float bv = b1s[16 * w + i];
#pragma unroll
          for (int j = 0; j < 4; ++j) *(LAS bf16*)(hidl + (4 * qd + j) * 272 + (16 * w + i) * 2) = (bf16)f2bf(siluf_(acc[j] + bv)); }
        __syncthreads();
        const bf16* w2t = (const bf16*)lw_ptr(F, layer, kv ? LW_PV2 : LW_PK2) + (size_t)(16 * w + i) * 128 + 8 * qd;
        f32x4 acc2 = {0.f, 0.f, 0.f, 0.f};
#pragma unroll
        for (int s = 0; s < 4; ++s) {
            const bf16x8 a = lds_rd8(hidl + i * 272 + 64 * s + 16 * qd);
            const bf16x8 bb = *(const bf16x8*)(w2t + 32 * s);
            acc2 = MFMA16(a, bb, acc2);
        }
        const float b2 = ((const float*)argin(A, kv ? 14 : 10))[layer * 128 + 16 * w + i];
        bf16* dst = (bf16*)(F.ws + (kv ? WS_VCMP : WS_KCMP)) + ((size_t)(b * NG + g) * NCMP_PAD + n0) * HD + 16 * w + i;
#pragma unroll
        for (int j = 0; j < 4; ++j) dst[(size_t)(4 * qd + j) * HD] = (bf16)f2bf(acc2[j] + b2);
        __syncthreads();
    }
}

DI void ssd_states_phase(const Frame& F0, const Args& A, int layer) {
    const Frame F = phase_frame(F0);
    const bf16* xbc = (const bf16*)(F.ws + WS_XBC); const float* dt = (const float*)(F.ws + WS_DT);
    float* acs = (float*)(F.ws + WS_ACS); float* cdec = (float*)(F.ws + WS_CDEC); float* st = (float*)(F.ws + WS_ST);
    LAS unsigned char* Bt = F.lds; LAS unsigned char* Xt = F.lds + 32768; LAS float* sc = (LAS float*)(F.lds + 65536);
    const float* alog = (const float*)argin(A, 19) + layer * SSD_H;
    const int lane = F.lane, w = F.wave, i = lane & 15, qd = lane >> 4;
    for (int u = F.bid; u < 512; u += F.G) {
        const int b = u >> 8, c = (u >> 2) & 63, g = u & 3, row0 = b * SEQ + c * SSD_CH;
        {
            const int hh = g * 8 + w; const float a = -__expf(alog[hh]);
            const float dt0 = dt[(size_t)(row0 + 2 * lane) * SSD_H + hh], dt1 = dt[(size_t)(row0 + 2 * lane + 1) * SSD_H + hh];
            const float d0 = dt0 * a, d1 = dt1 * a, pair = d0 + d1; float s = pair;
#pragma unroll
            for (int o = 1; o < 64; o <<= 1) { const float t = shfl_idx(s, lane - o); if (lane >= o) s += t; }
            const float a0 = (s - pair) + d0, a1 = s, total = __builtin_bit_cast(float, __builtin_amdgcn_readlane(__builtin_bit_cast(int, s), 63));
            acs[(size_t)(row0 + 2 * lane) * SSD_H + hh] = a0; acs[(size_t)(row0 + 2 * lane + 1) * SSD_H + hh] = a1;
            sc[w * 128 + 2 * lane] = dt0 * __expf(total - a0); sc[w * 128 + 2 * lane + 1] = dt1 * __expf(total - a1);
            if (lane == 0) cdec[(size_t)(b * SSD_NC + c) * SSD_H + hh] = __expf(total);
        }
        for (int id = F.tid; id < 128 * 16; id += NTHR) { const int row = id >> 4, ch = id & 15;
            *(LAS u32x4*)(Bt + off_b(row, ch)) = *(const u32x4*)(xbc + (size_t)(row0 + row) * SSD_XBC + 2048 + g * 128 + ch * 8); }
        bf16x8 bfr[4];
        for (int hp = 0; hp < 4; ++hp) {
            __syncthreads();
            for (int id = F.tid; id < 128 * 16; id += NTHR) { const int row = id >> 4, ch = id & 15;
                float x[8]; unpack8(*(const u32x4*)(xbc + (size_t)(row0 + row) * SSD_XBC + g * 512 + hp * 128 + ch * 8), x);
                const float f = sc[(hp * 2 + (ch >> 3)) * 128 + row];
#pragma unroll
                for (int k = 0; k < 8; ++k) x[k] *= f;
                *(LAS u32x4*)(Xt + off_b(row, ch)) = pack8f(x); }
            __syncthreads();
            if (hp == 0) {
#pragma unroll
                for (int ks = 0; ks < 4; ++ks) bfr[ks] = tr_read8(Bt, lane, 32 * ks, w);
            }
#pragma unroll
            for (int h2 = 0; h2 < 2; ++h2) {
                const int head = g * 8 + hp * 2 + h2;
                float* dst = st + ((size_t)((b * SSD_NC + c) * SSD_H + head) * SSD_N + 16 * w + i) * SSD_P + 4 * qd;
#pragma unroll
                for (int pt = 0; pt < 4; ++pt) {
                    f32x4 acc = {0.f, 0.f, 0.f, 0.f};
#pragma unroll
                    for (int ks = 0; ks < 4; ++ks) acc = MFMA16(tr_read8(Xt, lane, 32 * ks, h2 * 4 + pt), bfr[ks], acc);
                    *(f32x4*)(dst + 16 * pt) = acc;
                }
            }
        }
        __syncthreads();
    }
}
DI void ssd_scan_phase(const Frame& F0) {
    const Frame F = phase_frame(F0);
    const f32x4* st = (const f32x4*)(F.ws + WS_ST); u32x2* hin = (u32x2*)(F.ws + WS_HIN); const float* cdec = (const float*)(F.ws + WS_CDEC);
    const int gt = F.bid * NTHR + F.tid, NGT = F.G * NTHR;
    for (int v = gt; v < BATCH * SSD_H * 2048; v += NGT) {
        const int b = v >> 16, h = (v >> 11) & 31, e = v & 2047;
        const size_t o0 = ((size_t)(b * SSD_NC) * SSD_H + h) * 2048 + e;
        const float* dc = cdec + (size_t)(b * SSD_NC) * SSD_H + h;
        f32x4 hs = {0.f, 0.f, 0.f, 0.f};
        for (int c0 = 0; c0 < SSD_NC; c0 += 8) {
            f32x4 s[8]; float d[8];
#pragma unroll
            for (int k = 0; k < 8; ++k) { s[k] = st[o0 + (size_t)(c0 + k) * 65536]; d[k] = dc[(c0 + k) * SSD_H]; }
#pragma unroll
            for (int k = 0; k < 8; ++k) { u32x2 o; o.x = pk2(hs[0], hs[1]); o.y = pk2(hs[2], hs[3]); hin[o0 + (size_t)(c0 + k) * 65536] = o; hs = hs * d[k] + s[k]; }
        }
    }
}
DI void ssd_out_phase(const Frame& F0, const Args& A, int layer) {
    const Frame F = phase_frame(F0);
    const bf16* xbc = (const bf16*)(F.ws + WS_XBC); const bf16* proj = (const bf16*)(F.ws + WS_PROJ);
    const float* dt = (const float*)(F.ws + WS_DT); const float* acs = (const float*)(F.ws + WS_ACS); const bf16* hin = (const bf16*)(F.ws + WS_HIN);
    bf16* yc = (bf16*)(F.ws + WS_YC); float* rstdp = (float*)(F.ws + WS_RSTD);
    LAS unsigned char* Bt = F.lds; LAS unsigned char* Ct = F.lds + 32768; LAS unsigned char* Xt = F.lds + 65536; LAS unsigned char* Ht = F.lds + 98304;
    LAS float* acsl = (LAS float*)(F.lds + LX_OFF);
    const float* dsk = (const float*)argin(A, 20) + layer * SSD_H;
    const int lane = F.lane, w = F.wave, i = lane & 15, qd = lane >> 4;
    for (int u = F.bid; u < 512; u += F.G) {
        const int b = u >> 8, c = (u >> 2) & 63, g = u & 3, row0 = b * SEQ + c * SSD_CH;
        for (int id = F.tid; id < 128 * 16; id += NTHR) { const int row = id >> 4, ch = id & 15; const bf16* src = xbc + (size_t)(row0 + row) * SSD_XBC + 2048 + g * 128 + ch * 8;
            *(LAS u32x4*)(Bt + off_b(row, ch)) = *(const u32x4*)(src); *(LAS u32x4*)(Ct + off_b(row, ch)) = *(const u32x4*)(src + 512); }
        __syncthreads();
        bf16x8 cfr[4];
#pragma unroll
        for (int ks = 0; ks < 4; ++ks) cfr[ks] = lds_rd8(Ct + off_b(16 * w + i, 4 * ks + qd));
        f32x4 cb[4][2];
#pragma unroll
        for (int k = 0; k < 4; ++k)
#pragma unroll
            for (int T = 0; T < 2; ++T) { f32x4 acc = {0.f, 0.f, 0.f, 0.f};
#pragma unroll
                for (int ks = 0; ks < 4; ++ks) acc = MFMA16(lds_rd8(Bt + off_b(32 * k + 8 * (i >> 2) + (i & 3) + 4 * T, 4 * ks + qd)), cfr[ks], acc);
                cb[k][T] = acc; }
        const int lrow = 16 * w + i, row = row0 + lrow;
        float ssq = 0.f;
#if defined(S3_PREFETCH)
        u32x4 px[4], ph[4]; float pd[4], pa = 0.f;
#define S3_PF_LOAD(HP) do { \
            if (F.tid < 256) { const int h2_ = F.tid >> 7, l_ = F.tid & 127; pa = acs[(size_t)(row0 + l_) * SSD_H + g * 8 + (HP) * 2 + h2_]; } \
            _Pragma("unroll") for (int j_ = 0; j_ < 4; ++j_) { const int id_ = F.tid + NTHR * j_, r_ = id_ >> 4, ch_ = id_ & 15, head_ = g * 8 + (HP) * 2 + (ch_ >> 3); \
                px[j_] = *(const u32x4*)(xbc + (size_t)(row0 + r_) * SSD_XBC + g * 512 + (HP) * 128 + ch_ * 8); pd[j_] = dt[(size_t)(row0 + r_) * SSD_H + head_]; \
                ph[j_] = *(const u32x4*)(hin + ((size_t)((b * SSD_NC + c) * SSD_H + head_) * SSD_N + r_) * SSD_P + (ch_ & 7) * 8); } } while (0)
        S3_PF_LOAD(0);
#endif
        for (int hp = 0; hp < 4; ++hp) {
            __syncthreads();
#if defined(S3_PREFETCH)
            if (F.tid < 256) acsl[F.tid] = pa;
#pragma unroll
            for (int j = 0; j < 4; ++j) { const int id = F.tid + NTHR * j, r = id >> 4, ch = id & 15;
                float x[8]; unpack8(px[j], x);
#pragma unroll
                for (int k = 0; k < 8; ++k) x[k] *= pd[j];
                *(LAS u32x4*)(Xt + off_b(r, ch)) = pack8f(x); *(LAS u32x4*)(Ht + off_b(r, ch)) = ph[j]; }
            __syncthreads();
            u32x2 xva[4], zva[4];
#pragma unroll
            for (int pt = 0; pt < 4; ++pt) { const int chn = (g * 8 + hp * 2) * SSD_P + 16 * pt + 4 * qd;
                xva[pt] = *(const u32x2*)(xbc + (size_t)row * SSD_XBC + chn); zva[pt] = *(const u32x2*)(proj + (size_t)row * LDP + C_Z + chn); }
            __builtin_amdgcn_sched_barrier(0);
            if (hp < 3) S3_PF_LOAD(hp + 1);
            __builtin_amdgcn_sched_barrier(0);
#else
            if (F.tid < 256) { const int h2 = F.tid >> 7, l = F.tid & 127; acsl[F.tid] = acs[(size_t)(row0 + l) * SSD_H + g * 8 + hp * 2 + h2]; }
            for (int id = F.tid; id < 128 * 16; id += NTHR) { const int r = id >> 4, ch = id & 15, head = g * 8 + hp * 2 + (ch >> 3);
                float x[8]; unpack8(*(const u32x4*)(xbc + (size_t)(row0 + r) * SSD_XBC + g * 512 + hp * 128 + ch * 8), x);
                const float f = dt[(size_t)(row0 + r) * SSD_H + head];
#pragma unroll
                for (int k = 0; k < 8; ++k) x[k] *= f;
                *(LAS u32x4*)(Xt + off_b(r, ch)) = pack8f(x);
                *(LAS u32x4*)(Ht + off_b(r, ch)) = *(const u32x4*)(hin + ((size_t)((b * SSD_NC + c) * SSD_H + head) * SSD_N + r) * SSD_P + (ch & 7) * 8); }
            __syncthreads();
#endif
#if defined(S3_PREFETCH)
#pragma unroll 1
#else
#pragma unroll
#endif
            for (int h2 = 0; h2 < 2; ++h2) {
                const int head = g * 8 + hp * 2 + h2;
#if defined(SSD_IGLP)
                __builtin_amdgcn_iglp_opt(0);
#endif
                const float al = acsl[h2 * 128 + lrow], ea = __expf(al), dsv = dsk[head];
#if defined(S3_PREFETCH)
                if (h2 == 1) {
#pragma unroll
                    for (int pt = 0; pt < 4; ++pt) { const int chn = head * SSD_P + 16 * pt + 4 * qd;
                        xva[pt] = *(const u32x2*)(xbc + (size_t)row * SSD_XBC + chn); zva[pt] = *(const u32x2*)(proj + (size_t)row * LDP + C_Z + chn); } }
#else
                u32x2 xv4[4], zv4[4];
#pragma unroll
                for (int pt = 0; pt < 4; ++pt) { const int chn = head * SSD_P + 16 * pt + 4 * qd;
                    xv4[pt] = *(const u32x2*)(xbc + (size_t)row * SSD_XBC + chn); zv4[pt] = *(const u32x2*)(proj + (size_t)row * LDP + C_Z + chn); }
#endif
                bf16x8 mfr[4];
#pragma unroll
                for (int k = 0; k < 4; ++k) {
                    const f32x4 a0 = *(const LAS f32x4*)(acsl + h2 * 128 + 32 * k + 8 * qd), a1 = *(const LAS f32x4*)(acsl + h2 * 128 + 32 * k + 8 * qd + 4);
                    float mv[8];
#pragma unroll
                    for (int j = 0; j < 4; ++j) { const int s0 = 32 * k + 8 * qd + j, s1 = s0 + 4;
                        mv[j] = (s0 <= lrow) ? cb[k][0][j] * __expf(al - a0[j]) : 0.f;
                        mv[4 + j] = (s1 <= lrow) ? cb[k][1][j] * __expf(al - a1[j]) : 0.f; }
                    mfr[k] = as_bf16x8(pack8f(mv));
                }
#pragma unroll
                for (int pt = 0; pt < 4; ++pt) {
                    f32x4 yd = {0.f, 0.f, 0.f, 0.f}, yo = {0.f, 0.f, 0.f, 0.f};
#pragma unroll
                    for (int k = 0; k < 4; ++k) yd = MFMA16(tr_read8(Xt, lane, 32 * k, h2 * 4 + pt), mfr[k], yd);
#pragma unroll
                    for (int ks = 0; ks < 4; ++ks) yo = MFMA16(tr_read8(Ht, lane, 32 * ks, h2 * 4 + pt), cfr[ks], yo);
                    const int chn = head * SSD_P + 16 * pt + 4 * qd;
#if defined(S3_PREFETCH)
                    const u32x2 xv = xva[pt], zv = zva[pt];
#else
                    const u32x2 xv = xv4[pt], zv = zv4[pt];
#endif
                    const float xs[4] = {bflo(xv.x), bfhi(xv.x), bflo(xv.y), bfhi(xv.y)}, zz[4] = {bflo(zv.x), bfhi(zv.x), bflo(zv.y), bfhi(zv.y)};
                    float gy[4];
#pragma unroll
                    for (int j = 0; j < 4; ++j) { const float y = yd[j] + ea * yo[j] + dsv * xs[j]; gy[j] = y * siluf_(zz[j]); ssq += gy[j] * gy[j]; }
                    u32x2 o; o.x = pk2(gy[0], gy[1]); o.y = pk2(gy[2], gy[3]);
                    *(u32x2*)(yc + (size_t)row * DM + chn) = o;
                }
            }
        }
        ssq += shx(ssq, 16, lane); ssq += shx(ssq, 32, lane);
        if (qd == 0) rstdp[(size_t)row * SSD_G + g] = 1.0f / sqrtf(ssq * (1.0f / 512.0f) + EPS);
        __syncthreads();
    }
}

#ifndef NSA_REP_PART
#define NSA_REP_PART 0
#endif
#if NSA_REP_PART == 7
#define W7DUP(x) x
#define W7WAIT() NSA_WAITV(8)
#else
#define W7DUP(x)
#define W7WAIT() NSA_WAITV(4)
#endif
#if NSA_REP_PART == 10
#define SELDUP(x) x
#else
#define SELDUP(x)
#endif
constexpr int RB = 32768, NRING = 3;
#define NSA_WAITV(n) asm volatile("s_waitcnt vmcnt(" #n ")" ::: "memory")
#define NSA_BAR() do { asm volatile("" ::: "memory"); __builtin_amdgcn_s_barrier(); asm volatile("" ::: "memory"); } while (0)
template <bool WITHV> DI void tile_dma(LAS unsigned char* buf, const bf16* kp, const bf16* vp, int pitch, int w, int lane) {
#pragma unroll
    for (int e = 0; e < 2; ++e) { const int kb = 2 * w + e, kh = kb >> 3, T = (kb >> 2) & 1, ks = kb & 3, i = lane & 15, qd = lane >> 4;
        const int key = 32 * kh + 8 * (i >> 2) + (i & 3) + 4 * T, ch = 4 * ks + qd;
        __builtin_amdgcn_global_load_lds((const unsigned*)(kp + (size_t)key * pitch + ch * 8), (LAS unsigned*)(buf + kb * 1024), 16, 0, 0); }
    if (WITHV) {
#pragma unroll
        for (int e = 0; e < 2; ++e) { const int vb = 2 * w + e, kh = vb >> 3, t = (vb >> 2) & 1, dtp = vb & 3, dtl = lane >> 5, g = (lane >> 3) & 3, q = (lane >> 1) & 3, ph = lane & 1;
            const int key = 32 * kh + 8 * g + 4 * t + q, ch = 4 * dtp + 2 * dtl + ph;
            __builtin_amdgcn_global_load_lds((const unsigned*)(vp + (size_t)key * pitch + ch * 8), (LAS unsigned*)(buf + 16384 + vb * 1024), 16, 0, 0); }
    }
}
#define NSA_TR8(r, addr, b) asm volatile("ds_read_b64_tr_b16 %0, %8 offset:%9\n\tds_read_b64_tr_b16 %1, %8 offset:%10\n\tds_read_b64_tr_b16 %2, %8 offset:%11\n\tds_read_b64_tr_b16 %3, %8 offset:%12\n\t" \
        "ds_read_b64_tr_b16 %4, %8 offset:%13\n\tds_read_b64_tr_b16 %5, %8 offset:%14\n\tds_read_b64_tr_b16 %6, %8 offset:%15\n\tds_read_b64_tr_b16 %7, %8 offset:%16" \
        : "=&v"(r[0]), "=&v"(r[1]), "=&v"(r[2]), "=&v"(r[3]), "=&v"(r[4]), "=&v"(r[5]), "=&v"(r[6]), "=&v"(r[7]) \
        : "v"(addr), "i"((b)), "i"((b) + 4096), "i"((b) + 512), "i"((b) + 4608), "i"((b) + 1024), "i"((b) + 5120), "i"((b) + 1536), "i"((b) + 5632) : "memory")
#define NSA_TRWAIT(r) asm volatile("s_waitcnt lgkmcnt(0)" : "+v"(r[0]), "+v"(r[1]), "+v"(r[2]), "+v"(r[3]), "+v"(r[4]), "+v"(r[5]), "+v"(r[6]), "+v"(r[7]) :: "memory")
#define NSA_TRWAIT8(r) asm volatile("s_waitcnt lgkmcnt(8)" : "+v"(r[0]), "+v"(r[1]), "+v"(r[2]), "+v"(r[3]), "+v"(r[4]), "+v"(r[5]), "+v"(r[6]), "+v"(r[7]) :: "memory")
#if defined(NSA_NO_SB)
#define NSA_SB()
#else
#define NSA_SB() __builtin_amdgcn_sched_barrier(0)
#endif
#if !defined(NSA_NO_SETPRIO)
#define NSA_PRIO(x) __builtin_amdgcn_s_setprio(x)
#else
#define NSA_PRIO(x)
#endif
#define NSA_PV4(r, kh, d0) do { NSA_PRIO(1); _Pragma("unroll") for (int q_ = 0; q_ < 4; ++q_) { const bf16x8 vf_ = __builtin_shufflevector(r[2 * q_], r[2 * q_ + 1], 0, 1, 2, 3, 4, 5, 6, 7); \
        if (SM & 1) O[0][(d0) + q_] = MFMA16(vf_, pf[0][kh], O[0][(d0) + q_]); if (SM & 2) O[1][(d0) + q_] = MFMA16(vf_, pf[1][kh], O[1][(d0) + q_]); } NSA_PRIO(0); } while (0)
template <int MODE, int SM>
DI void attn_tile(LAS const unsigned char* Kt, LAS const unsigned char* Vt, const bf16x8 (&Qf)[2][4], f32x4 (&O)[2][8], float (&m)[2], float (&l)[2], const int (&lo)[2], const int (&hi)[2], bool needmask,
                  float c2, const float (&inv_l)[2], LAS float* imp, const int (&ql)[2], int jb0, float (&cin)[2], int lane) {
    const int qd = lane >> 4;
    f32x4 sc[2][2][2];
#if !defined(NSA_NO_IGLP)
    __builtin_amdgcn_iglp_opt(0);
#endif
#pragma unroll
    for (int kh = 0; kh < 2; ++kh)
#pragma unroll
        for (int T = 0; T < 2; ++T) { f32x4 a0 = {0.f, 0.f, 0.f, 0.f}, a1 = {0.f, 0.f, 0.f, 0.f};
#pragma unroll
            for (int ks = 0; ks < 4; ++ks) { const bf16x8 kf = lds_rd8(Kt + (kh * 8 + T * 4 + ks) * 1024);
                if (SM & 1) a0 = MFMA16(kf, Qf[0][ks], a0); if (SM & 2) a1 = MFMA16(kf, Qf[1][ks], a1); }
            sc[0][kh][T] = a0; sc[1][kh][T] = a1; }
    const float NEG = -__builtin_inff();
    bf16x8 pf[2][2];
#pragma unroll
    for (int s = 0; s < 2; ++s) if (SM & (1 << s)) {
        if (needmask) {
#pragma unroll
            for (int kh = 0; kh < 2; ++kh)
#pragma unroll
                for (int T = 0; T < 2; ++T)
#pragma unroll
                    for (int j = 0; j < 4; ++j) { const int kk = 32 * kh + 8 * qd + 4 * T + j; if (kk < lo[s] || kk > hi[s]) sc[s][kh][T][j] = NEG; }
        }
        float mn = m[s];
        if (MODE != 2) {
            float tmax = fmaxf(fmaxf(sc[s][0][0][0], sc[s][0][0][1]), fmaxf(sc[s][0][0][2], sc[s][0][0][3]));
            tmax = fmaxf(tmax, fmaxf(fmaxf(sc[s][0][1][0], sc[s][0][1][1]), fmaxf(sc[s][0][1][2], sc[s][0][1][3])));
            tmax = fmaxf(tmax, fmaxf(fmaxf(sc[s][1][0][0], sc[s][1][0][1]), fmaxf(sc[s][1][0][2], sc[s][1][0][3])));
            tmax = fmaxf(tmax, fmaxf(fmaxf(sc[s][1][1][0], sc[s][1][1][1]), fmaxf(sc[s][1][1][2], sc[s][1][1][3])));
            tmax = xq_max(tmax);
            mn = fmaxf(m[s], tmax);
            if (__ballot(mn != m[s]) != 0ull) {
                const float alpha = __builtin_amdgcn_exp2f((m[s] - mn) * c2);
                l[s] *= alpha;
                if (MODE == 1) {
#pragma unroll
                    for (int dt = 0; dt < 8; ++dt) O[s][dt] = O[s][dt] * alpha;
                }
                m[s] = mn;
            }
        }
        const float nmc = -mn * c2; float ps = 0.f;
#pragma unroll
        for (int kh = 0; kh < 2; ++kh)
#pragma unroll
            for (int T = 0; T < 2; ++T)
#pragma unroll
                for (int j = 0; j < 4; ++j) { float p = __builtin_amdgcn_exp2f(__builtin_fmaf(sc[s][kh][T][j], c2, nmc)); if (MODE == 2) p *= inv_l[s]; sc[s][kh][T][j] = p; ps += p; }
        if (MODE != 2) l[s] += ps;
        if (MODE == 2) {
            float s4[2][2], cy[2][2];
#pragma unroll
            for (int kh = 0; kh < 2; ++kh)
#pragma unroll
                for (int T = 0; T < 2; ++T) {
                    float a = (sc[s][kh][T][0] + sc[s][kh][T][1]) + (sc[s][kh][T][2] + sc[s][kh][T][3]), c = sc[s][kh][T][3];
                    a = quad_sum(a); c = quad_sum(c);
                    s4[kh][T] = a; cy[kh][T] = c; }
            const float x0 = shfl_idx(cy[0][1], (lane - 16) & 63), x1 = shfl_idx(cy[1][1], (lane - 16) & 63);
            const float p00 = (qd == 0) ? cin[s] : x0, p10 = (qd == 0) ? x0 : x1;
            cin[s] = x1;
            if ((lane & 3) == 0) { const int jb = jb0 + 2 * qd;
                *(LAS f32x2*)(imp + ql[s] * 128 + jb) = (f32x2){s4[0][0] + p00, s4[0][1] + cy[0][0]};
                *(LAS f32x2*)(imp + ql[s] * 128 + jb + 8) = (f32x2){s4[1][0] + p10, s4[1][1] + cy[1][0]}; }
        }
        if (MODE != 0) {
#pragma unroll
            for (int kh = 0; kh < 2; ++kh) { u32x4 pw; pw.x = pk2(sc[s][kh][0][0], sc[s][kh][0][1]); pw.y = pk2(sc[s][kh][0][2], sc[s][kh][0][3]); pw.z = pk2(sc[s][kh][1][0], sc[s][kh][1][1]); pw.w = pk2(sc[s][kh][1][2], sc[s][kh][1][3]); pf[s][kh] = as_bf16x8(pw); }
        }
    }
    if (MODE != 0) {
        const unsigned va = (unsigned)(size_t)Vt;
        s16x4 ra[8], rb[8];
        NSA_TR8(ra, va, 0);     NSA_TR8(rb, va, 2048); NSA_SB();
        NSA_TRWAIT8(ra); NSA_SB(); NSA_PV4(ra, 0, 0); NSA_SB(); NSA_TR8(ra, va, 8192);  NSA_SB();
        NSA_TRWAIT8(rb); NSA_SB(); NSA_PV4(rb, 0, 4); NSA_SB(); NSA_TR8(rb, va, 10240); NSA_SB();
        NSA_TRWAIT8(ra); NSA_SB(); NSA_PV4(ra, 1, 0); NSA_SB();
        NSA_TRWAIT(rb);  NSA_SB(); NSA_PV4(rb, 1, 4);
    }
}
template <bool FIRST> DI void nsa_emit(const f32x4 (&O)[8], float scale, bf16* dst  ) {
    u32x2 old[8];
    if (!FIRST) {
#pragma unroll
        for (int dt = 0; dt < 8; ++dt) old[dt] = *(const u32x2*)(dst + 16 * dt);
    }
#pragma unroll
    for (int dt = 0; dt < 8; ++dt) { f32x4 v = O[dt] * scale;
        if (!FIRST) { v[0] += bflo(old[dt].x); v[1] += bfhi(old[dt].x); v[2] += bflo(old[dt].y); v[3] += bfhi(old[dt].y); }
        u32x2 o; o.x = pk2(v[0], v[1]); o.y = pk2(v[2], v[3]); *(u32x2*)(dst + 16 * dt) = o; }
}
DI int next_bit(unsigned u0, unsigned u1, unsigned u2, unsigned u3, int from) {
    if (from >= 128) return -1;
    const int wd = from >> 5; const unsigned msk = ~0u << (from & 31);
    const unsigned x0 = (wd == 0) ? (u0 & msk) : 0u;
    const unsigned x1 = (wd < 1) ? u1 : ((wd == 1) ? (u1 & msk) : 0u);
    const unsigned x2 = (wd < 2) ? u2 : ((wd == 2) ? (u2 & msk) : 0u);
    const unsigned x3 = (wd < 3) ? u3 : (u3 & msk);
    if (x0) return __builtin_ctz(x0);
    if (x1) return 32 + __builtin_ctz(x1);
    if (x2) return 64 + __builtin_ctz(x2);
    if (x3) return 96 + __builtin_ctz(x3);
    return -1;
}

DI void nsa_phase(const Frame& F0, const Args& A, int layer) {
    const Frame F = phase_frame(F0);
    const bf16* proj = (const bf16*)(F.ws + WS_PROJ); const bf16* kcmp = (const bf16*)(F.ws + WS_KCMP); const bf16* vcmp = (const bf16*)(F.ws + WS_VCMP);
    bf16* ya = (bf16*)(F.ws + WS_YA);
    LAS unsigned char* const RG = F.lds;
    LAS float* imp = (LAS float*)(F.lds + NRING * RB);
    LAS unsigned* selm = (LAS unsigned*)(F.lds + NRING * RB + 32768); LAS unsigned* uml = selm + 256;
    static_assert(NRING * RB + 32768 + 1024 + 16 <= LDSCTL_OFF && NRING * RB + 32768 == 4 * RB, "nsa LDS map (the selected loop's pair buffers overlay ring + importance table)");
    const float c2 = 0.08838834764831845f * 1.4426950408889634f;
    (void)A; (void)layer;
#if defined(NSA_PRIO)
    if (F.wave < 4) __builtin_amdgcn_s_setprio(2); else __builtin_amdgcn_s_setprio(0);
#endif
    for (int u = F.bid; u < 1024; u += F.G) {
        int tid_l = F.tid; asm volatile("" : "+v"(tid_l));
        const int tid = tid_l, lane = tid & 63, w = F.wave, i = lane & 15, qd = lane >> 4, hd = i & 3;
        const int klane = 16 * lane, vlane = 16384 + 8 * lane;
        const int xg = u & 7, jj = (u >> 3) & 31, rr = u >> 8;
        const int b = xg >> 2, g = xg & 3;
        const int qt = (rr == 0) ? 127 - jj : (rr == 1) ? 64 + jj : (rr == 2) ? 63 - jj : jj;
        const int s0 = qt * 64, cur = qt, rowb = b * SEQ;
        int ql[2], trow[2]; bf16x8 Qf[2][4];
#pragma unroll
        for (int s = 0; s < 2; ++s) { ql[s] = 8 * w + 4 * s + (i >> 2); trow[s] = rowb + s0 + ql[s];
#pragma unroll
            for (int ks = 0; ks < 4; ++ks) Qf[s][ks] = *(const bf16x8*)(proj + (size_t)trow[s] * LDP + C_Q + (4 * g + hd) * HD + 32 * ks + 8 * qd); }
        f32x4 O[2][8]; float mrow[2], lrow[2], cin[2], invl[2] = {0.f, 0.f};
        const int ntc = (4 * qt + 3 + 63) >> 6;
        const bf16* kc0 = kcmp + (size_t)(b * NG + g) * NCMP_PAD * HD; const bf16* vc0 = vcmp + (size_t)(b * NG + g) * NCMP_PAD * HD;
        int nmax[2];
#pragma unroll
        for (int s = 0; s < 2; ++s) { const int t = s0 + ql[s]; nmax[s] = (t >= 31) ? ((t - 31) >> 4) : -1; mrow[s] = -1e30f; lrow[s] = 0.f; cin[s] = 0.f; }
        for (int rep_ = 0; rep_ < (NSA_REP_PART == 2 ? 2 : 1); ++rep_) {
#pragma unroll
        for (int s = 0; s < 2; ++s) { mrow[s] = -1e30f; lrow[s] = 0.f; cin[s] = 0.f; }
        NSA_WAITV(0); NSA_BAR();
        tile_dma<false>(RG, kc0, vc0, HD, w, lane); if (ntc > 1) tile_dma<false>(RG + RB, kc0 + (size_t)64 * HD, vc0, HD, w, lane);
        for (int tc = 0, rb = 0; tc < ntc; ++tc) {
            if (tc + 1 < ntc) NSA_WAITV(2); else NSA_WAITV(0);
            NSA_BAR();
            if (tc + 2 < ntc) { const int nb2 = (rb + 2 >= NRING) ? rb + 2 - NRING : rb + 2; tile_dma<false>(RG + nb2 * RB, kc0 + (size_t)(tc + 2) * 64 * HD, vc0, HD, w, lane); }
            { const int lo2[2] = {0, 0}, hi2[2] = {nmax[0] - 64 * tc, nmax[1] - 64 * tc}; const bool nm = __ballot(hi2[0] < 63 || hi2[1] < 63) != 0ull;
              attn_tile<0, 3>(RG + rb * RB + klane, RG, Qf, O, mrow, lrow, lo2, hi2, nm, c2, invl, imp, ql, 0, cin, lane); }
            rb = (rb + 1 == NRING) ? 0 : rb + 1;
        }
#pragma unroll
        for (int s = 0; s < 2; ++s) { float lt = lrow[s]; lt = xq_sum(lt); invl[s] = (lt > 0.f) ? 1.0f / lt : 0.f;
#pragma unroll
            for (int dt = 0; dt < 8; ++dt) O[s][dt] = (f32x4){0.f, 0.f, 0.f, 0.f}; }
        NSA_BAR();
        tile_dma<true>(RG, kc0, vc0, HD, w, lane); if (ntc > 1) tile_dma<true>(RG + RB, kc0 + (size_t)64 * HD, vc0 + (size_t)64 * HD, HD, w, lane);
        for (int tc = 0, rb = 0; tc < ntc; ++tc) {
            if (tc + 1 < ntc) NSA_WAITV(4); else NSA_WAITV(0);
            NSA_BAR();
            if (tc + 2 < ntc) { const int nb2 = (rb + 2 >= NRING) ? rb + 2 - NRING : rb + 2; tile_dma<true>(RG + nb2 * RB, kc0 + (size_t)(tc + 2) * 64 * HD, vc0 + (size_t)(tc + 2) * 64 * HD, HD, w, lane); }
            { const int lo2[2] = {0, 0}, hi2[2] = {nmax[0] - 64 * tc, nmax[1] - 64 * tc}; const bool nm = __ballot(hi2[0] < 63 || hi2[1] < 63) != 0ull;
              attn_tile<2, 3>(RG + rb * RB + klane, RG + rb * RB + vlane, Qf, O, mrow, lrow, lo2, hi2, nm, c2, invl, imp, ql, 16 * tc, cin, lane); }
            rb = (rb + 1 == NRING) ? 0 : rb + 1;
        }
#pragma unroll
        for (int s = 0; s < 2; ++s) { const float gate = sigmoidf_(bf2f(proj[(size_t)trow[s] * LDP + C_GN + (4 * g + hd) * 3 + 0]));
            nsa_emit<true>(O[s], gate, ya + (size_t)trow[s] * DM + (4 * g + hd) * HD + 4 * qd); }
        }
        for (int rep_ = 0; rep_ < (NSA_REP_PART == 1 ? 2 : 1); ++rep_) {
            LDS_WAIT();
            const int nforced = (cur == 0) ? 1 : (cur == 1) ? 2 : 3; const int nsel = (cur + 1 < NSEL) ? cur + 1 : NSEL; const int R = nsel - nforced;
            const int E = (cur >= 3) ? cur - 2 : 0;
            for (int q8 = 0; q8 < 8; ++q8) {
                const int q = 8 * w + q8;
                const int j0 = lane, j1 = lane + 64;
                const bool e0 = (j0 >= 1) && (j0 <= cur - 2), e1 = (j1 <= cur - 2);
                const bool f0 = (j0 == 0) || (j0 == cur) || (j0 == cur - 1), f1 = (j1 == cur) || (j1 == cur - 1);
                bool s0 = e0, s1 = e1;
                if (R < E) {
                    const unsigned k0 = e0 ? __builtin_bit_cast(unsigned, imp[q * 128 + j0]) + 1u : 0u, k1 = e1 ? __builtin_bit_cast(unsigned, imp[q * 128 + j1]) + 1u : 0u;
                    unsigned T = 0u;
#pragma unroll 1
                    for (int bit = 30; bit >= 0; --bit) { const unsigned c = T | (1u << bit);
                        const int n = __builtin_popcountll(__ballot(k0 >= c)) + __builtin_popcountll(__ballot(k1 >= c));
                        if (n >= R) T = c; }
                    const unsigned long long eq0 = __ballot(k0 == T), eq1 = __ballot(k1 == T);
                    const int G = __builtin_popcountll(__ballot(k0 > T)) + __builtin_popcountll(__ballot(k1 > T));
                    const unsigned long long lt = (1ull << lane) - 1ull;
                    const int r0 = __builtin_popcountll(eq0 & lt), r1 = __builtin_popcountll(eq0) + __builtin_popcountll(eq1 & lt);
                    s0 = (k0 > T) || (k0 == T && r0 < R - G); s1 = (k1 > T) || (k1 == T && r1 < R - G);
                }
                const unsigned long long m0 = __ballot(f0 || s0), m1 = __ballot(f1 || s1);
                if (lane == 0) { selm[q * 4 + 0] = (unsigned)m0; selm[q * 4 + 1] = (unsigned)(m0 >> 32); selm[q * 4 + 2] = (unsigned)m1; selm[q * 4 + 3] = (unsigned)(m1 >> 32); }
            }
            __syncthreads();
            if (w == 0) { unsigned x0 = selm[lane * 4 + 0], x1 = selm[lane * 4 + 1], x2 = selm[lane * 4 + 2], x3 = selm[lane * 4 + 3];
#pragma unroll
                for (int o = 1; o < 64; o <<= 1) { x0 |= shfl_idx_u(x0, lane ^ o); x1 |= shfl_idx_u(x1, lane ^ o); x2 |= shfl_idx_u(x2, lane ^ o); x3 |= shfl_idx_u(x3, lane ^ o); }
                if (lane == 0) { uml[0] = x0; uml[1] = x1; uml[2] = x2; uml[3] = x3; } }
            __syncthreads();
        }
        const unsigned um0 = __builtin_amdgcn_readfirstlane(uml[0]), um1 = __builtin_amdgcn_readfirstlane(uml[1]), um2 = __builtin_amdgcn_readfirstlane(uml[2]), um3 = __builtin_amdgcn_readfirstlane(uml[3]);
        for (int rep_ = 0; rep_ < (NSA_REP_PART == 3 ? 2 : 1); ++rep_) {
            const bf16* ks0 = (const bf16*)(F.ws + WS_KV) + kv_off(2, b, g, 0); const bf16* vs0 = (const bf16*)(F.ws + WS_KV) + kv_off(3, b, g, 0);
#pragma unroll
            for (int s = 0; s < 2; ++s) { mrow[s] = -1e30f; lrow[s] = 0.f;
#pragma unroll
                for (int dt = 0; dt < 8; ++dt) O[s][dt] = (f32x4){0.f, 0.f, 0.f, 0.f}; }
#if NSA_REP_PART == 11
            {
            int jaD = next_bit(um0, um1, um2, um3, 0), jbD = next_bit(um0, um1, um2, um3, jaD + 1), pbD = 0;
            VM_WAIT(); if (NSA_REP_PART == 3) NSA_BAR();
            tile_dma<true>(RG, ks0 + (size_t)jaD * 64 * HD, vs0 + (size_t)jaD * 64 * HD, HD, w, lane); SELDUP(tile_dma<true>(RG, ks0 + (size_t)jaD * 64 * HD, vs0 + (size_t)jaD * 64 * HD, HD, w, lane);)
            if (jbD >= 0) tile_dma<true>(RG + RB, ks0 + (size_t)jbD * 64 * HD, vs0 + (size_t)jbD * 64 * HD, HD, w, lane); SELDUP(tile_dma<true>(RG + RB, ks0 + (size_t)jbD * 64 * HD, vs0 + (size_t)jbD * 64 * HD, HD, w, lane);)
            while (jaD >= 0) {
                const int jcD = (jbD >= 0) ? next_bit(um0, um1, um2, um3, jbD + 1) : -1, jdD = (jcD >= 0) ? next_bit(um0, um1, um2, um3, jcD + 1) : -1;
                NSA_WAITV(0);
                NSA_BAR();
                if (jcD >= 0) { LAS unsigned char* nb = RG + (pbD ^ 1) * 2 * RB; tile_dma<true>(nb, ks0 + (size_t)jcD * 64 * HD, vs0 + (size_t)jcD * 64 * HD, HD, w, lane); SELDUP(tile_dma<true>(nb, ks0 + (size_t)jcD * 64 * HD, vs0 + (size_t)jcD * 64 * HD, HD, w, lane);)
                    if (jdD >= 0) tile_dma<true>(nb + RB, ks0 + (size_t)jdD * 64 * HD, vs0 + (size_t)jdD * 64 * HD, HD, w, lane); SELDUP(tile_dma<true>(nb + RB, ks0 + (size_t)jdD * 64 * HD, vs0 + (size_t)jdD * 64 * HD, HD, w, lane);) }
                jaD = jcD; jbD = jdD; pbD ^= 1;
            }
            NSA_BAR();
            }
#endif
            int ja = next_bit(um0, um1, um2, um3, 0), jbb = next_bit(um0, um1, um2, um3, ja + 1), pbuf = 0;
            VM_WAIT(); if (NSA_REP_PART == 3) NSA_BAR();
            tile_dma<true>(RG, ks0 + (size_t)ja * 64 * HD, vs0 + (size_t)ja * 64 * HD, HD, w, lane); SELDUP(tile_dma<true>(RG, ks0 + (size_t)ja * 64 * HD, vs0 + (size_t)ja * 64 * HD, HD, w, lane);)
            if (jbb >= 0) tile_dma<true>(RG + RB, ks0 + (size_t)jbb * 64 * HD, vs0 + (size_t)jbb * 64 * HD, HD, w, lane); SELDUP(tile_dma<true>(RG + RB, ks0 + (size_t)jbb * 64 * HD, vs0 + (size_t)jbb * 64 * HD, HD, w, lane);)
            while (ja >= 0) {
                const int jc = (jbb >= 0) ? next_bit(um0, um1, um2, um3, jbb + 1) : -1, jd = (jc >= 0) ? next_bit(um0, um1, um2, um3, jc + 1) : -1;
                NSA_WAITV(0);
                NSA_BAR();
                if (jc >= 0) { LAS unsigned char* nb = RG + (pbuf ^ 1) * 2 * RB; tile_dma<true>(nb, ks0 + (size_t)jc * 64 * HD, vs0 + (size_t)jc * 64 * HD, HD, w, lane); SELDUP(tile_dma<true>(nb, ks0 + (size_t)jc * 64 * HD, vs0 + (size_t)jc * 64 * HD, HD, w, lane);)
                    if (jd >= 0) tile_dma<true>(nb + RB, ks0 + (size_t)jd * 64 * HD, vs0 + (size_t)jd * 64 * HD, HD, w, lane); SELDUP(tile_dma<true>(nb + RB, ks0 + (size_t)jd * 64 * HD, vs0 + (size_t)jd * 64 * HD, HD, w, lane);) }
#pragma unroll 1
                for (int e2 = 0; e2 < 2; ++e2) { const int jb = e2 ? jbb : ja; if (jb < 0) break;
                  const bool act0 = (selm[ql[0] * 4 + (jb >> 5)] >> (jb & 31)) & 1u, act1 = (selm[ql[1] * 4 + (jb >> 5)] >> (jb & 31)) & 1u;
                  const bool any0 = __ballot(act0) != 0ull, any1 = __ballot(act1) != 0ull;
                  const int lo2[2] = {0, 0}, hi2[2] = {act0 ? ((jb < cur) ? 63 : ql[0]) : -1, act1 ? ((jb < cur) ? 63 : ql[1]) : -1};
                  LAS const unsigned char* kt = RG + (pbuf * 2 + e2) * RB + klane; LAS const unsigned char* vt = RG + (pbuf * 2 + e2) * RB + vlane;
                  if (any0 && any1) { const bool nm = __ballot(hi2[0] < 63 || hi2[1] < 63) != 0ull; attn_tile<1, 3>(kt, vt, Qf, O, mrow, lrow, lo2, hi2, nm, c2, invl, imp, ql, 0, cin, lane); }
                  else if (any0) { const bool nm = __ballot(hi2[0] < 63) != 0ull; attn_tile<1, 1>(kt, vt, Qf, O, mrow, lrow, lo2, hi2, nm, c2, invl, imp, ql, 0, cin, lane); }
                  else if (any1) { const bool nm = __ballot(hi2[1] < 63) != 0ull; attn_tile<1, 2>(kt, vt, Qf, O, mrow, lrow, lo2, hi2, nm, c2, invl, imp, ql, 0, cin, lane); } }
                ja = jc; jbb = jd; pbuf ^= 1;
            }
            NSA_BAR();
#pragma unroll
            for (int s = 0; s < 2; ++s) { float lt = lrow[s]; lt = xq_sum(lt);
                const float gate = sigmoidf_(bf2f(proj[(size_t)trow[s] * LDP + C_GN + (4 * g + hd) * 3 + 1]));
                if (rep_ == 0) nsa_emit<false>(O[s], (lt > 0.f) ? gate / lt : 0.f, ya + (size_t)trow[s] * DM + (4 * g + hd) * HD + 4 * qd); }
        }
        for (int rep_ = 0; rep_ < (NSA_REP_PART == 4 ? 2 : 1); ++rep_) {
            const bf16* kw0 = (const bf16*)(F.ws + WS_KV) + kv_off(4, b, g, 0); const bf16* vw0 = (const bf16*)(F.ws + WS_KV) + kv_off(5, b, g, 0);
#pragma unroll
            for (int s = 0; s < 2; ++s) { mrow[s] = -1e30f; lrow[s] = 0.f;
#pragma unroll
                for (int dt = 0; dt < 8; ++dt) O[s][dt] = (f32x4){0.f, 0.f, 0.f, 0.f}; }
#if NSA_REP_PART == 8
            {
            const int tt0d = (qt >= 8) ? 0 : 8 - qt;
            VM_WAIT(); NSA_BAR();
            { const size_t r0 = (size_t)(s0 - 512 + 64 * tt0d) * HD; tile_dma<true>(RG, kw0 + r0, vw0 + r0, HD, w, lane); W7DUP(tile_dma<true>(RG, kw0 + r0, vw0 + r0, HD, w, lane);) }
            if (tt0d < 8) { const size_t r0 = (size_t)(s0 - 512 + 64 * (tt0d + 1)) * HD; tile_dma<true>(RG + RB, kw0 + r0, vw0 + r0, HD, w, lane); W7DUP(tile_dma<true>(RG + RB, kw0 + r0, vw0 + r0, HD, w, lane);) }
            for (int tt = tt0d, rb = 0; tt <= 8; ++tt) {
                if (tt < 8) { W7WAIT(); } else NSA_WAITV(0);
                NSA_BAR();
                if (tt + 2 <= 8) { const int nb2 = (rb + 2 >= NRING) ? rb + 2 - NRING : rb + 2; const size_t r0 = (size_t)(s0 - 512 + 64 * (tt + 2)) * HD; tile_dma<true>(RG + nb2 * RB, kw0 + r0, vw0 + r0, HD, w, lane); W7DUP(tile_dma<true>(RG + nb2 * RB, kw0 + r0, vw0 + r0, HD, w, lane);) }
                rb = (rb + 1 == NRING) ? 0 : rb + 1;
            }
            }
#endif
            const int tt0 = (qt >= 8) ? 0 : 8 - qt;
            VM_WAIT(); NSA_BAR();
            { const size_t r0 = (size_t)(s0 - 512 + 64 * tt0) * HD; tile_dma<true>(RG, kw0 + r0, vw0 + r0, HD, w, lane); W7DUP(tile_dma<true>(RG, kw0 + r0, vw0 + r0, HD, w, lane);) }
            if (tt0 < 8) { const size_t r0 = (size_t)(s0 - 512 + 64 * (tt0 + 1)) * HD; tile_dma<true>(RG + RB, kw0 + r0, vw0 + r0, HD, w, lane); W7DUP(tile_dma<true>(RG + RB, kw0 + r0, vw0 + r0, HD, w, lane);) }
            for (int tt = tt0, rb = 0; tt <= 8; ++tt) {
                if (tt < 8) { W7WAIT(); } else NSA_WAITV(0);
                NSA_BAR();
                if (tt + 2 <= 8) { const int nb2 = (rb + 2 >= NRING) ? rb + 2 - NRING : rb + 2; const size_t r0 = (size_t)(s0 - 512 + 64 * (tt + 2)) * HD; tile_dma<true>(RG + nb2 * RB, kw0 + r0, vw0 + r0, HD, w, lane); W7DUP(tile_dma<true>(RG + nb2 * RB, kw0 + r0, vw0 + r0, HD, w, lane);) }
                { const int lo2[2] = {(tt == 0) ? ql[0] + 1 : 0, (tt == 0) ? ql[1] + 1 : 0}, hi2[2] = {(tt == 8) ? ql[0] : 63, (tt == 8) ? ql[1] : 63};
                  attn_tile<1, 3>(RG + rb * RB + klane, RG + rb * RB + vlane, Qf, O, mrow, lrow, lo2, hi2, (tt == 0) || (tt == 8), c2, invl, imp, ql, 0, cin, lane);
#if NSA_REP_PART == 5
                  { const int him[2] = {-1, -1}; attn_tile<1, 3>(RG + rb * RB + klane, RG + rb * RB + vlane, Qf, O, mrow, lrow, lo2, him, true, c2, invl, imp, ql, 0, cin, lane); }
#endif
#if NSA_REP_PART == 6
                  NSA_BAR(); NSA_BAR(); NSA_BAR(); NSA_BAR();
#endif
                }
                rb = (rb + 1 == NRING) ? 0 : rb + 1;
            }
            VM_WAIT();
#pragma unroll
            for (int s = 0; s < 2; ++s) { float lt = lrow[s]; lt = xq_sum(lt);
                const float gate = sigmoidf_(bf2f(proj[(size_t)trow[s] * LDP + C_GN + (4 * g + hd) * 3 + 2]));
                if (rep_ == 0) nsa_emit<false>(O[s], (lt > 0.f) ? gate / lt : 0.f, ya + (size_t)trow[s] * DM + (4 * g + hd) * HD + 4 * qd); }
        }
        __syncthreads();
    }
    __builtin_amdgcn_s_setprio(0);
}

#if defined(CHECK_BUILD) && CHECK_BUILD
DI unsigned hash_u(unsigned x) { x ^= x >> 16; x *= 0x7feb352du; x ^= x >> 15; x *= 0x846ca68bu; x ^= x >> 16; return x; }
DI float blk_sum(float v, LAS float* red, int tid, int nthr) {
    for (int o = 32; o >= 1; o >>= 1) v += __shfl_xor(v, o);
    __syncthreads(); if ((tid & 63) == 0) red[tid >> 6] = v; __syncthreads();
    float s = 0.f; for (int k = 0; k < nthr / 64; ++k) s += red[k]; __syncthreads(); return s;
}
__global__ void chk_proj(Args args) {
    const int lane = threadIdx.x & 63, smp = blockIdx.x * (blockDim.x >> 6) + (threadIdx.x >> 6);
    const bf16* hb = (const bf16*)(args.ws + WS_HB); const bf16* proj = (const bf16*)(args.ws + WS_PROJ); const float* win = (const float*)args.in[4]; const int* pos = (const int*)args.in[2];
    unsigned* res = (unsigned*)(args.ws + WS_CTL) + CW_CHK;
    const unsigned h = hash_u(smp * 2654435761u + 12345u);
    int row = h % M; if (smp < 4) row = (smp == 0) ? 0 : (smp == 1) ? 8191 : (smp == 2) ? 8192 : 16383;
    const int kind = smp % 15; const unsigned h2 = hash_u(h + 77u);
    const int srcb[15] = {0, 2048, 2560, 3072, 3584, 4096, 4608, 5120, 5168, 7216, 9264, 11312, 13360, 16432, 16464};
    const int dstb[15] = {C_Q, C_KC, C_VC, C_KS, C_VS, C_KW, C_VW, C_GN, C_CB, C_CC, C_CU, C_Z, C_XBC, C_DT, C_GM};
    const int wid[15] = {2048, 512, 512, 512, 512, 512, 512, 48, 2048, 2048, 2048, 2048, 3072, 32, 6144};
    const bool rope = (kind == 0 || kind == 1 || kind == 3 || kind == 5);
    int e = h2 % wid[kind]; if (rope) e = (e / 128) * 128 + (e % 64);
    float d0 = 0.f, d1 = 0.f;
    for (int k = lane; k < DM; k += 64) { const float a = bf2f(hb[(size_t)row * DM + k]); d0 += a * win[(size_t)k * PROJ_SRC + srcb[kind] + e]; if (rope) d1 += a * win[(size_t)k * PROJ_SRC + srcb[kind] + e + 64]; }
    for (int o = 32; o >= 1; o >>= 1) { d0 += __shfl_xor(d0, o); d1 += __shfl_xor(d1, o); }
    float e0 = d0, e1 = d1;
    if (rope) { const double inv = exp(-(double)(2 * (e % 64)) / 128.0 * 9.210340371976184); double ang = (double)pos[row] * inv; ang -= 6.283185307179586476925 * __builtin_rint(ang * 0.15915494309189533577); const float c = cosf((float)ang), s = sinf((float)ang); e0 = d0 * c - d1 * s; e1 = d1 * c + d0 * s; }
    if (lane == 0) {
        const bf16* kvb = (const bf16*)(args.ws + WS_KV);
        const bool inkv = (kind >= 1 && kind <= 6);
        const bf16* src = inkv ? kvb + kv_off(kind - 1, row >> 13, e >> 7, row & 8191) + (e & 127) : proj + (size_t)row * LDP + dstb[kind] + e;
        const float g0 = bf2f(src[0]); float err = fabsf(g0 - e0) / (0.03f + 0.02f * fabsf(e0));
        if (rope) { const float g1 = bf2f(src[64]); err = fmaxf(err, fabsf(g1 - e1) / (0.03f + 0.02f * fabsf(e1))); }
        if (!(err <= 1.0f)) atomicAdd(res + 0, 1u);
        atomicMax(res + 1, __float_as_uint(fminf(err, 1e6f)));
    }
}
__global__ void chk_cmp(Args args) {
    __shared__ float hid[128];
    const int tid = threadIdx.x, smp = blockIdx.x;
    const unsigned h = hash_u(smp * 40503u + 99u);
    const int kv = smp & 1, b = (smp >> 1) & 1, g = (smp >> 2) & 3; int n = h % NCMP; if (smp < 8) n = (smp < 4) ? 0 : 510;
    const bf16* proj = (const bf16*)(args.ws + WS_PROJ);
    const float* pe = (const float*)args.in[kv ? 6 : 5]; const float* w1 = (const float*)args.in[kv ? 11 : 7]; const float* b1 = (const float*)args.in[kv ? 12 : 8];
    const float* w2 = (const float*)args.in[kv ? 13 : 9]; const float* b2 = (const float*)args.in[kv ? 14 : 10];
    const bf16* out = (const bf16*)(args.ws + (kv ? WS_VCMP : WS_KCMP));
    unsigned* res = (unsigned*)(args.ws + WS_CTL) + CW_CHK;
    float s = b1[tid];
    for (int l = 0; l < 32; ++l) { const bf16* kr = (const bf16*)(args.ws + WS_KV) + kv_off(kv, b, g, 16 * n + l);
        for (int d = 0; d < 128; ++d) s += (bf2f(kr[d]) + pe[l * 128 + d]) * w1[(size_t)(l * 128 + d) * 128 + tid]; }
    hid[tid] = s / (1.0f + expf(-s));
    __syncthreads();
    float o = b2[tid];
    for (int k = 0; k < 128; ++k) o += hid[k] * w2[k * 128 + tid];
    const float got = bf2f(out[((size_t)(b * NG + g) * NCMP_PAD + n) * HD + tid]);
    const float err = fabsf(got - o) / (0.02f + 0.02f * fabsf(o));
    if (!(err <= 1.0f)) atomicAdd(res + 2, 1u);
    atomicMax(res + 3, __float_as_uint(fminf(err, 1e6f)));
}
constexpr int CHK_NT = 24;
__global__ void __launch_bounds__(256) chk_nsa(Args args) {
    __shared__ float qf[4][128], oacc[4][128], obr[4][128], sc[4][1024], imp[128], red[8];
    __shared__ int kl[1024], seln[16], usedl[128];
    const int tlist[CHK_NT] = {0, 1, 30, 31, 47, 63, 64, 65, 127, 128, 500, 511, 512, 513, 575, 1023, 1024, 1087, 2000, 4095, 4096, 6000, 8128, 8191};
    const int tid = threadIdx.x, smp = blockIdx.x;
    const int t = tlist[smp % CHK_NT], bg = (smp / CHK_NT + smp) & 7, b = bg >> 2, g = bg & 3, row = b * SEQ + t, cur = t >> 6;
    const bf16* proj = (const bf16*)(args.ws + WS_PROJ); const bf16* kcmp = (const bf16*)(args.ws + WS_KCMP) + (size_t)(b * NG + g) * NCMP_PAD * HD; const bf16* vcmp = (const bf16*)(args.ws + WS_VCMP) + (size_t)(b * NG + g) * NCMP_PAD * HD;
    const bf16* ya = (const bf16*)(args.ws + WS_YA);
    unsigned* res = (unsigned*)(args.ws + WS_CTL) + CW_CHK;
    const float scale = 0.08838834764831845f;
    for (int k = tid; k < 512; k += 256) { const int r = k >> 7, d = k & 127; qf[r][d] = bf2f(proj[(size_t)row * LDP + C_Q + (4 * g + r) * HD + d]); oacc[r][d] = 0.f; }
    __syncthreads();
    for (int br = 0; br < 3; ++br) {
        int nk = 0;
        if (br == 0) { nk = (t >= 31) ? ((t - 31) >> 4) + 1 : 0; for (int k = tid; k < nk; k += 256) kl[k] = k; }
        else if (br == 1) {
            if (tid == 0) {
                for (int j = 0; j < 128; ++j) usedl[j] = 0;
                for (int it = 0; it < 16; ++it) { int best = -1; float bv = 0.f;
                    for (int j = 0; j < 128; ++j) { if (usedl[j]) continue; const bool valid = (64 * j <= t); const bool forced = (j == 0) || (j == cur) || (j == cur - 1);
                        const float v = valid ? imp[j] + (forced ? 1.0e4f : 0.f) : -__builtin_inff();
                        if (best < 0 || v > bv) { best = j; bv = v; } }
                    usedl[best] = 1; seln[it] = best; } }
            __syncthreads();
            for (int k = tid; k < 1024; k += 256) kl[k] = seln[k >> 6] * 64 + (k & 63);
            nk = 1024;
        } else { nk = 576; for (int k = tid; k < 576; k += 256) kl[k] = (t & ~63) - WIN + k; }
        __syncthreads();
        for (int idx = tid; idx < 4 * nk; idx += 256) { const int r = idx / nk, k = idx - r * nk, key = kl[k];
            bool ok; const bf16* kp;
            if (br == 0) { ok = true; kp = kcmp + (size_t)key * HD; }
            else if (br == 1) { ok = (key <= t); kp = (const bf16*)(args.ws + WS_KV) + kv_off(2, b, g, key); }
            else { ok = (key >= 0) && (key <= t) && (key > t - WIN); kp = (const bf16*)(args.ws + WS_KV) + kv_off(4, b, g, key < 0 ? 0 : key); }
            float s = 0.f; for (int d = 0; d < 128; ++d) s += qf[r][d] * bf2f(kp[d]);
            sc[r][k] = ok ? s * scale : -__builtin_inff(); }
        __syncthreads();
        if (tid < 4) { float m = -__builtin_inff(); for (int k = 0; k < nk; ++k) m = fmaxf(m, sc[tid][k]);
            const float mm = (m > -1e30f) ? m : 0.f; float l = 0.f; for (int k = 0; k < nk; ++k) { const float e = (sc[tid][k] > -1e30f) ? expf(sc[tid][k] - mm) : 0.f; sc[tid][k] = e; l += e; }
            const float il = (l > 0.f) ? 1.0f / l : 0.f; for (int k = 0; k < nk; ++k) sc[tid][k] *= il; }
        __syncthreads();
        if (br == 0) { if (tid < 128) { float s = 0.f; for (int r = 0; r < 4; ++r) for (int n = 4 * tid - 1; n <= 4 * tid + 3; ++n) if (n >= 0 && n < nk) s += sc[r][n]; imp[tid] = s; } }
        for (int o = tid; o < 512; o += 256) { const int r = o >> 7, d = o & 127; float s = 0.f;
            for (int k = 0; k < nk; ++k) { const float p = sc[r][k]; if (p == 0.f) continue; const int key = kl[k];
                const bf16* vp = (br == 0) ? vcmp + (size_t)key * HD : (const bf16*)(args.ws + WS_KV) + kv_off(br == 1 ? 3 : 5, b, g, key);
                s += p * bf2f(vp[d]); }
            const float gate = 1.0f / (1.0f + expf(-bf2f(proj[(size_t)row * LDP + C_GN + (4 * g + r) * 3 + br])));
            oacc[r][d] += gate * s; obr[r][d] = s; }
        __syncthreads();
    }
    float errm = 0.f;
    for (int o = tid; o < 512; o += 256) { const int r = o >> 7, d = o & 127; const float got = bf2f(ya[(size_t)row * DM + (4 * g + r) * HD + d]), ex = oacc[r][d] * (CHECK_BUILD == 2 ? ((smp & 1) ? 1.5f : 1.0f) : 1.0f);
        errm = fmaxf(errm, fabsf(got - ex) / (0.006f + 0.03f * fabsf(ex))); }
    for (int o = 32; o >= 1; o >>= 1) errm = fmaxf(errm, __shfl_xor(errm, o));
    if ((tid & 63) == 0) red[tid >> 6] = errm;
    __syncthreads();
    if (tid == 0) { const float e = fmaxf(fmaxf(red[0], red[1]), fmaxf(red[2], red[3])); if (!(e <= 1.0f)) atomicAdd(res + 4, 1u); atomicMax(res + 5, __float_as_uint(fminf(e, 1e6f))); }
}
#ifndef CHK_B_SEL
#define CHK_B_SEL 5
#endif
__global__ void chk_report(Args args) {
    const unsigned* res = (const unsigned*)(args.ws + WS_CTL) + CW_CHK;
    const float A = 4.0f * (float)res[4] + (res[2] ? 2000.f : 0.f) + (res[0] ? 40000.f : 0.f);
    const float B = fminf(__uint_as_float(res[CHK_B_SEL]), 100.f);
    const size_t i = (size_t)blockIdx.x * blockDim.x + threadIdx.x;
    if (A > 0.f) { if (i == 0) args.out[0] += A; if (i >= 1 && i <= (1u << 20)) args.out[i] += B; }
}
#endif

constexpr int NPH_LAYER = 13, NPH = 2 + NPH_LAYER * DEPTH;
#ifndef PG8_SP2
#define PG8_SP2 true
#endif
#ifndef PG8_ALIGN
#define PG8_ALIGN true
#endif
#ifndef PH_MASK
#define PH_MASK 0xFFFFFFFFu
#endif
#ifndef REP_MASK
#define REP_MASK 0u
#endif
#ifndef REP_CNT
#define REP_CNT 2
#endif
#define REPN(kk) ((((unsigned)REP_MASK >> (kk)) & 1u) ? REP_CNT : 1)
#define INK(k, kk) (((PH_MASK >> (kk)) & 1u) && lo <= (k) && (k) < hi)
#if defined(TIME_PROBE)
#define STAMP(i) do { if (F.bid == 0 && F.tid == 0) ((unsigned long long*)(F.ctl + CW_TS))[i] = __builtin_amdgcn_s_memrealtime(); } while (0)
#else
#define STAMP(i) do { } while (0)
#endif
#if defined(BAR_TWICE)
#define SEAM_TWICE(x) x
#else
#define SEAM_TWICE(x)
#endif
#define SEAM(k) do { if (lo <= (k) && (k) + 1 < hi) { XcdBarrier b_ = bar; { unsigned long long p_ = (unsigned long long)bar.bar; asm volatile("" : "+s"(p_)); b_.bar = (unsigned*)p_; } xcd_barrier(b_); SEAM_TWICE(xcd_barrier(b_);) } STAMP((k) + 1); } while (0)
template <int LAYER> DI void g1_block(const Frame& F, const Args& args) {
    constexpr int layer = LAYER;
    bf16* hb = (bf16*)(F.ws + WS_HB); bf16* projb = (bf16*)(F.ws + WS_PROJ); bf16* eb = (bf16*)(F.ws + WS_EB);
#ifndef NO_G1
            { const Frame Fp = phase_frame(F);  pg8::Gemm g{hb, (const bf16*)lw_ptr(Fp, layer, LW_IN), M, LDP, DM}; pg8::StaticOrder S; S.init(M, LDP, Fp.G, Fp.bid);
              pg8::EpiB<2> E{projb, LDP, (const float*)(Fp.ws + WS_ROPE), (bf16*)(Fp.ws + WS_KV)};
              pg8::gemm_phase<pg8::EpiB<2>, pg8::StaticOrder, PG8_ALIGN, PG8_SP2>(Fp.lds, g, S, E, Fp.wave); }
#endif
#ifndef NO_G5
            { const Frame Fp = phase_frame(F);  pg8::Gemm g{(const bf16*)(Fp.ws + WS_PB) + (size_t)layer * M * PLE, (const bf16*)lw_ptr(Fp, layer, LW_PLE), M, DM, PLE}; pg8::LightOrder S; S.init(M, DM, Fp.G, Fp.bid);
              pg8::EpiB<0> E{eb, DM, nullptr, nullptr};
              pg8::gemm_phase<pg8::EpiB<0>, pg8::LightOrder, PG8_ALIGN, PG8_SP2>(Fp.lds, g, S, E, Fp.wave); }
#endif
}
template <int LAYER> DI void layer_phases(const Frame& F, const Args& args, const XcdBarrier& bar, const int lo, const int hi) {
    constexpr int layer = LAYER, layer_ = LAYER;
    float* xres = (float*)(F.ws + WS_X); bf16* hb = (bf16*)(F.ws + WS_HB); bf16* projb = (bf16*)(F.ws + WS_PROJ); bf16* ub = (bf16*)(F.ws + WS_U); bf16* eb = (bf16*)(F.ws + WS_EB);
        const int pb = 1 + NPH_LAYER * layer;
        const float* xin = (layer == 0) ? (const float*)argin(args, 0) : (const float*)xres;
        if (INK(pb + 0, 0)) { if (layer == 0) norm_rows<false>(F, xin, (const float*)argin(args, 3), hb);
                              else addnorm_rows<false>(F, xres, (const bf16*)(F.ws + WS_DELTA), (const float*)argin(args, 3) + (size_t)layer * DM, xres, hb); }
        SEAM(pb + 0);
        if (INK(pb + 1, 1)) { g1_block<LAYER>(F, args); if (REPN(1) >= 2) g1_block<LAYER>(F, args); }
        SEAM(pb + 1);
        if (INK(pb + 2, 2)) for (int rep = 0; rep < REPN(2); ++rep) { ssd_conv_pass(F, args, layer); compress_phase(F, args, layer); }
        SEAM(pb + 2);
        if (INK(pb + 3, 3)) for (int rep = 0; rep < REPN(3); ++rep) ssd_states_phase(F, args, layer);
        SEAM(pb + 3);
        if (INK(pb + 4, 4)) ssd_scan_phase(F);
        SEAM(pb + 4);
        if (INK(pb + 5, 5)) {
#ifndef NO_S3
            for (int rep = 0; rep < REPN(15); ++rep) ssd_out_phase(F, args, layer);
#endif
            STAMP(60 + layer);
#ifndef NO_NSA
            for (int rep = 0; rep < REPN(5); ++rep) nsa_phase(F, args, layer);
#endif
        }
        SEAM(pb + 5);
        if (INK(pb + 6, 6)) for (int rep = 0; rep < REPN(6); ++rep) merge_pass(F, args, layer);
        SEAM(pb + 6);
        if (INK(pb + 7, 7)) for (int rep = 0; rep < REPN(7); ++rep) { const Frame Fp = phase_frame(F);  pg8::Gemm g{hb, (const bf16*)lw_ptr(Fp, layer, LW_O), M, DM, DM}; pg8::StaticOrder S; S.init(M, DM, Fp.G, Fp.bid);
            pg8::EpiB<0> E{(bf16*)(Fp.ws + WS_DELTA), DM, nullptr, nullptr};
            pg8::gemm_phase<pg8::EpiB<0>, pg8::StaticOrder, PG8_ALIGN, PG8_SP2>(Fp.lds, g, S, E, Fp.wave); }
        SEAM(pb + 7);
        if (INK(pb + 8, 8)) for (int rep = 0; rep < REPN(8); ++rep) addnorm_rows<false>(F, xin, (const bf16*)(F.ws + WS_DELTA), (const float*)argin(args, 23) + (size_t)layer * DM, rep ? (float*)(F.ws + WS_ST) : xres, rep ? (bf16*)(F.ws + WS_ST + 128 * MiB - 64 * MiB) : hb);
        SEAM(pb + 8);
        if (INK(pb + 9, 9)) for (int rep = 0; rep < REPN(9); ++rep) { const Frame Fp = phase_frame(F);  pg8::Gemm g{hb, (const bf16*)lw_ptr(Fp, layer, LW_UP), M, DFF, DM}; pg8::StaticOrder S; S.init(M, DFF, Fp.G, Fp.bid);
            pg8::EpiB<1> E{ub, DFF, nullptr, nullptr};
            pg8::gemm_phase<pg8::EpiB<1>, pg8::StaticOrder, PG8_ALIGN, PG8_SP2>(Fp.lds, g, S, E, Fp.wave); }
        SEAM(pb + 9);
        if (INK(pb + 10, 10)) for (int rep = 0; rep < REPN(10); ++rep) { const Frame Fp = phase_frame(F);  pg8::Gemm g{ub, (const bf16*)lw_ptr(Fp, layer, LW_DOWN), M, DM, DFF}; pg8::StaticOrder S; S.init(M, DM, Fp.G, Fp.bid);
            pg8::EpiB<0> E{(bf16*)(Fp.ws + WS_DELTA), DM, nullptr, nullptr};
            pg8::gemm_phase<pg8::EpiB<0>, pg8::StaticOrder, PG8_ALIGN, PG8_SP2>(Fp.lds, g, S, E, Fp.wave); }
        SEAM(pb + 10);
        if (INK(pb + 11, 11)) addnorm_rows<false>(F, xres, (const bf16*)(F.ws + WS_DELTA), (const float*)argin(args, 26) + (size_t)layer * DM, xres, hb);
        SEAM(pb + 11);
        if (INK(pb + 12, 12)) for (int rep = 0; rep < REPN(12); ++rep) { const Frame Fp = phase_frame(F);  pg8::Gemm g{hb, (const bf16*)lw_ptr(Fp, layer, LW_PG), M, DM, DM}; pg8::StaticOrder S; S.init(M, DM, Fp.G, Fp.bid);
            pg8::EpiB<3> E{(bf16*)(Fp.ws + WS_DELTA), DM, (const float*)eb, nullptr};
            pg8::gemm_phase<pg8::EpiB<3>, pg8::StaticOrder, PG8_ALIGN, PG8_SP2>(Fp.lds, g, S, E, Fp.wave); }
        SEAM(pb + 12);
}
__global__ void __launch_bounds__(NTHR, 2) hyb_fwd(Args args) {
    extern __shared__ __attribute__((aligned(16))) unsigned char lds_raw[];
    Frame F;
    F.lds = (LAS unsigned char*)lds_raw; F.ws = args.ws; F.ctl = (gu32*)(args.ws + WS_CTL);
    F.tid = threadIdx.x; F.lane = F.tid & 63; F.wave = __builtin_amdgcn_readfirstlane(threadIdx.x >> 6); F.G = gridDim.x; F.bid = blockIdx.x;
    const int lo = args.ph_lo, hi = args.ph_hi;
    if (F.tid < 64) ((LAS unsigned*)(F.lds + LDSCTL_OFF))[F.tid] = 0u;
    __syncthreads();
    XcdBarrier bar; bar.bar = (unsigned*)(F.ctl + CW_BAR); bar.x = 0; bar.st = (volatile LAS unsigned*)(F.lds + LDSCTL_OFF);
    if (hi - lo > 1) bar = xcd_barrier_post((unsigned*)(F.ctl + CW_BAR), (volatile LAS unsigned*)(F.lds + LDSCTL_OFF));
    STAMP(0);
    if (INK(0, 13)) for (int rep = 0; rep < REPN(13); ++rep) p0_prologue(F, args);
    SEAM(0);
    layer_phases<0>(F, args, bar, lo, hi); layer_phases<1>(F, args, bar, lo, hi); layer_phases<2>(F, args, bar, lo, hi); layer_phases<3>(F, args, bar, lo, hi);
    float* xres = (float*)(F.ws + WS_X);
    int hi_l = hi; asm volatile("" : "+s"(hi_l));
    if (((PH_MASK >> 14) & 1u) && lo <= NPH - 1 && NPH - 1 < hi_l) addnorm_rows<true>(F, xres, (const bf16*)(F.ws + WS_DELTA), (const float*)argin(args, 29), nullptr, args.out);
#if defined(TIME_PROBE)
    { XcdBarrier b_ = bar; xcd_barrier(b_); STAMP(NPH);
      if (F.bid == 0) {
        LAS float* ab = (LAS float*)(F.lds);
        if (F.tid == 0) { const unsigned long long* ts = (const unsigned long long*)(F.ctl + CW_TS); float sum[17];
            float sA = 0.f, sB = 0.f;
            for (int ph = 0; ph < NPH; ++ph) { int kind = (ph == 0) ? 13 : (ph == NPH - 1) ? 14 : (ph - 1) % NPH_LAYER; float d = (float)(ts[ph + 1] - ts[ph]) * 0.01f;
                if (kind == 5) { const int L = (ph - 1) / NPH_LAYER; const float d3 = (float)(ts[60 + L] - ts[ph]) * 0.01f; if (TIME_PROBE_A == 15) sA += d3; if (TIME_PROBE_B == 15) sB += d3; d -= d3; }
                if (kind == TIME_PROBE_A || (TIME_PROBE_A == 16 && (kind == 0 || kind == 8 || kind == 11))) sA += d;
                if (kind == TIME_PROBE_B || (TIME_PROBE_B == 16 && (kind == 0 || kind == 8 || kind == 11))) sB += d; }
            ab[0] = sA; ab[1] = sB * 0.01f; (void)sum; }
        __syncthreads();
        const float A = ab[0], B = ab[1];
        if (F.tid == 0) args.out[0] += A;
        for (int j = 0; j < 2048; ++j) args.out[1 + F.tid + NTHR * j] += B;
      } }
#endif
#undef INK
#undef SEAM
}

#ifndef MK_ONE_LAUNCH
#define MK_ONE_LAUNCH 1
#endif
extern "C" void kernel_launch(void* const* d_in, const int* in_sizes, int n_in, void* d_out, int out_size, void* d_ws, size_t ws_size, hipStream_t stream) {
    static int grid = 0;
    if (grid == 0) {
        if (n_in != 30 || out_size != M * DM || ws_size < WS_END) { fprintf(stderr, "kernel_launch: unexpected shapes (n_in %d out %d ws %zu need %zu)\n", n_in, out_size, ws_size, (size_t)WS_END); grid = -1; return; }
        int dev = 0, cus = 0, per_cu = 0;
        if (hipGetDevice(&dev) != hipSuccess || hipDeviceGetAttribute(&cus, hipDeviceAttributeMultiprocessorCount, dev) != hipSuccess) { grid = -1; return; }
        if (hipFuncSetAttribute((const void*)hyb_fwd, hipFuncAttributeMaxDynamicSharedMemorySize, LDS_BYTES) != hipSuccess) { fprintf(stderr, "kernel_launch: hipFuncSetAttribute failed\n"); grid = -1; return; }
        if (hipOccupancyMaxActiveBlocksPerMultiprocessor(&per_cu, (const void*)hyb_fwd, NTHR, LDS_BYTES) != hipSuccess || per_cu < 1) { fprintf(stderr, "kernel_launch: occupancy query says %d\n", per_cu); }
        (void)hipGetLastError();
        grid = cus;
    }
    if (grid < 0) return;
    (void)hipMemsetAsync((char*)d_ws + WS_CTL, 0, CTL_ZERO_BYTES, stream);
    Args a{};
    for (int i = 0; i < 30; ++i) a.in[i] = d_in[i];
    a.out = (float*)d_out; a.ws = (unsigned char*)d_ws;
#if MK_ONE_LAUNCH
    a.ph_lo = 0; a.ph_hi = NPH;
    hipLaunchKernelGGL(hyb_fwd, dim3(grid), dim3(NTHR), LDS_BYTES, stream, a);
#else
    for (int ph = 0; ph < NPH; ++ph) { a.ph_lo = ph; a.ph_hi = ph + 1; hipLaunchKernelGGL(hyb_fwd, dim3(grid), dim3(NTHR), LDS_BYTES, stream, a);
#if defined(CHECK_BUILD) && CHECK_BUILD
        if (ph == 2) hipLaunchKernelGGL(chk_proj, dim3(1024), dim3(256), 0, stream, a);
        if (ph == 3) hipLaunchKernelGGL(chk_cmp, dim3(128), dim3(128), 0, stream, a);
        if (ph == 6) hipLaunchKernelGGL(chk_nsa, dim3(8 * CHK_NT), dim3(256), 0, stream, a);
        if (ph == NPH - 1) hipLaunchKernelGGL(chk_report, dim3(4098), dim3(256), 0, stream, a);
#endif
    }
#endif
    (void)in_sizes;
}
```

```cpp
#define S3_PREFETCH 1
#define ST_BF16 1
#include <hip/hip_runtime.h>
#include <cstdio>
#include <cstdint>
namespace pg8 {
#define PG8_LAS __attribute__((address_space(3)))
typedef unsigned short bf16_t;
typedef short bf16x8 __attribute__((ext_vector_type(8)));
typedef float f32x4 __attribute__((ext_vector_type(4)));
typedef unsigned u32x4 __attribute__((ext_vector_type(4)));
constexpr int BM = 256, BK = 64, HALF = 128, HTB = HALF * BK * 2  , STAGE_BYTES = 8 * HTB, NXCD = 8,
#ifdef PG8_WGM
    WGM = PG8_WGM;
#else
    WGM = 8;
#endif

__host__ __device__ __forceinline__ int lds_byte(int r, int c) { const int st = (r >> 4) * 2 + (c >> 5), rr = r & 15, cc = c & 31, ob = rr * 64 + cc * 2; return st * 1024 + (ob ^ (((ob >> 9) & 1) << 5)); }
__host__ __device__ __forceinline__ void stage_rc(int b, int& R, int& C) { const int st = b / 1024, sb = b % 1024, swz = sb ^ (((sb >> 9) & 1) << 5); R = (st >> 1) * 16 + swz / 64; C = (st & 1) * 32 + (swz % 64) / 2; }
__host__ __device__ __forceinline__ int perm32(int rho) { const int n = rho >> 4, i = rho & 15; return 8 * (i >> 2) + 4 * n + (i & 3); }

struct Unit { int pm, pn; };
struct Gemm { const bf16_t* A; const bf16_t* Bt; int M, N, K; };

struct StaticOrder {
    int nM, nN, nwg, G, c;
    __host__ __device__ void init(int M, int N, int G_, int c_) { nM = M / BM; nN = N / BM; nwg = nM * nN; G = G_; c = c_; }
    __host__ __device__ bool next(int i, Unit& u) const {
        const long L = (long)i * G + c; if (L >= nwg) return false;
        int wgid = (int)L; { const int q = nwg / NXCD, r = nwg % NXCD, xcd = wgid % NXCD, off = wgid / NXCD; wgid = (xcd < r ? xcd * (q + 1) : r * (q + 1) + (xcd - r) * q) + off; }
        const int nig = WGM * nN, gid = wgid / nig, fm = gid * WGM, gsz = (nM - fm) < WGM ? (nM - fm) : WGM;
        u.pm = fm + ((wgid % nig) % gsz); u.pn = (wgid % nig) / gsz; return true;
    }
    __device__ __forceinline__ void a_ready(const Unit&) const {}
    __device__ __forceinline__ void done(const Unit&) const {}
};
__device__ __forceinline__ unsigned cvt_pk_bf16(float lo, float hi) { unsigned r; asm volatile("v_cvt_pk_bf16_f32 %0, %1, %2" : "=v"(r) : "v"(lo), "v"(hi)); return r; }
template <class Epi, class Sched, bool ALIGN_EPI = false, bool SP2 = false>
__device__ __forceinline__ void gemm_phase(PG8_LAS unsigned char* lds, const Gemm g, const Sched& S, const Epi& E, const int wave_idx  ) {
    int lane_l; asm volatile("v_mbcnt_lo_u32_b32 %0, -1, 0\n\tv_mbcnt_hi_u32_b32 %0, -1, %0" : "=v"(lane_l));
    const int wid = wave_idx, tid = wid * 64 + lane_l, lane = tid & 63, wr = wid >> 2, wc = wid & 3, fr = lane & 15, fq = lane >> 4;
    const int K = g.K, nt = K / BK;
    unsigned voffA[2], voffB[2];
#pragma unroll
    for (int i = 0; i < 2; ++i) { int R, C; stage_rc(tid * 16 + i * 8192, R, C); const int Rb = Epi::PERM ? ((R & ~31) + perm32(R & 31)) : R;
        voffA[i] = (unsigned)(R * K + C) * 2u; voffB[i] = (unsigned)(Rb * K + C) * 2u; }
    const size_t kstep = (size_t)(BK * 2);
    const size_t hstep = (size_t)HALF * K * 2;
    const size_t tstep = 2 * hstep;
    const unsigned ldsw = (unsigned)wid * 1024u;
    const int aoff = lds_byte(wr * 64 + fr, fq * 8), boff = lds_byte(wc * 32 + fr, fq * 8);
#define PG8_SA(b, h) (((b) * 2 + (h)) * HTB)
#define PG8_SB(b, h) ((4 + (b) * 2 + (h)) * HTB)
#define PG8_STAGE(bufoff, gbase, voff) do { _Pragma("unroll") for (int _i = 0; _i < 2; ++_i) \
        __builtin_amdgcn_global_load_lds((const unsigned*)((const char*)(gbase) + (voff)[_i]), (PG8_LAS unsigned*)(lds + (bufoff) + ldsw + _i * 8192), 16, 0, 0); } while (0)
#define PG8_LDA(dst, b, h) do { _Pragma("unroll") for (int m = 0; m < 4; ++m) _Pragma("unroll") for (int k = 0; k < 2; ++k) dst[m][k] = *(const PG8_LAS bf16x8*)(lds + PG8_SA(b, h) + aoff + m * 2048 + k * 1024); } while (0)
#define PG8_LDB(dst, b, h) do { _Pragma("unroll") for (int n = 0; n < 2; ++n) _Pragma("unroll") for (int k = 0; k < 2; ++k) dst[n][k] = *(const PG8_LAS bf16x8*)(lds + PG8_SB(b, h) + boff + n * 2048 + k * 1024); } while (0)
#define PG8_MMA(ai, bj, At, Bt) do { __builtin_amdgcn_s_setprio(1); _Pragma("unroll") for (int m = 0; m < 4; ++m) _Pragma("unroll") for (int n = 0; n < 2; ++n) _Pragma("unroll") for (int k = 0; k < 2; ++k) \
        acc[ai][bj][m][n] = __builtin_amdgcn_mfma_f32_16x16x32_bf16(Bt[n][k], At[m][k], acc[ai][bj][m][n], 0, 0, 0); __builtin_amdgcn_s_setprio(0); } while (0)
#define PG8_WAIT_V(n) asm volatile("s_waitcnt vmcnt(" #n ")" ::: "memory")
#define PG8_WAIT_L(n) asm volatile("s_waitcnt lgkmcnt(" #n ")" ::: "memory")
#define PG8_BAR __builtin_amdgcn_s_barrier()
#define PG8_SCHED __builtin_amdgcn_sched_barrier(0)
    Unit cur, nxt; int ui = 0;
    if (!S.next(0, cur)) return;
    f32x4 acc[2][2][4][2];
#pragma unroll
    for (int a = 0; a < 2; ++a)
#pragma unroll
        for (int b = 0; b < 2; ++b)
#pragma unroll
            for (int m = 0; m < 4; ++m)
#pragma unroll
                for (int n = 0; n < 2; ++n) acc[a][b][m][n] = (f32x4){0.f, 0.f, 0.f, 0.f};
    bf16x8 At[4][2], B0[2][2], B1[2][2];
    const char* cA = (const char*)g.A + (size_t)cur.pm * tstep; const char* cB = (const char*)g.Bt + (size_t)cur.pn * tstep;
    S.a_ready(cur);
    if constexpr (SP2) {
        PG8_STAGE(PG8_SB(0, 0), cB, voffB); PG8_STAGE(PG8_SB(0, 1), cB + hstep, voffB); PG8_STAGE(PG8_SA(0, 0), cA, voffA); PG8_STAGE(PG8_SA(0, 1), cA + hstep, voffA);
        if (wr == 1) PG8_BAR;
        PG8_WAIT_V(2); PG8_BAR;
        PG8_STAGE(PG8_SB(1, 0), cB + kstep, voffB); PG8_STAGE(PG8_SA(1, 0), cA + kstep, voffA); PG8_STAGE(PG8_SB(1, 1), cB + hstep + kstep, voffB);
        PG8_WAIT_V(6); PG8_BAR;
    } else {
        PG8_STAGE(PG8_SB(0, 0), cB, voffB); PG8_STAGE(PG8_SA(0, 0), cA, voffA); PG8_STAGE(PG8_SB(0, 1), cB + hstep, voffB); PG8_STAGE(PG8_SA(0, 1), cA + hstep, voffA);
        if (wr == 1) PG8_BAR;
        PG8_WAIT_V(4); PG8_BAR;
        PG8_STAGE(PG8_SB(1, 0), cB + kstep, voffB); PG8_STAGE(PG8_SA(1, 0), cA + kstep, voffA); PG8_STAGE(PG8_SB(1, 1), cB + hstep + kstep, voffB);
        PG8_WAIT_V(6); PG8_BAR;
    }
    for (;;) {
        const bool has_next = S.next(ui + 1, nxt);
        const char* nA = has_next ? (const char*)g.A + (size_t)nxt.pm * tstep : cA; const char* nB = has_next ? (const char*)g.Bt + (size_t)nxt.pn * tstep : cB;
        for (int t = 0; t < nt; t += 2) {
            const bool last = (t == nt - 2);
            const char* a1 = cA + (size_t)(t + 1) * kstep;
            const char* a2 = last ? nA : cA + (size_t)(t + 2) * kstep; const char* b2 = last ? nB : cB + (size_t)(t + 2) * kstep;
            const char* a3 = a2 + kstep; const char* b3 = b2 + kstep;
            if (last && has_next) S.a_ready(nxt);
            if constexpr (SP2) {
            PG8_LDB(B0, 0, 0); PG8_LDB(B1, 0, 1); PG8_SCHED; PG8_LDA(At, 0, 0); PG8_STAGE(PG8_SA(1, 1), a1 + hstep, voffA);
            PG8_WAIT_V(8); PG8_WAIT_L(0); PG8_BAR; PG8_MMA(0, 0, At, B0); PG8_MMA(0, 1, At, B1); PG8_BAR; PG8_SCHED;
            PG8_LDA(At, 0, 1); PG8_STAGE(PG8_SB(0, 0), b2, voffB); PG8_STAGE(PG8_SB(0, 1), b2 + hstep, voffB); PG8_STAGE(PG8_SA(0, 0), a2, voffA);
            PG8_WAIT_V(8); PG8_WAIT_L(0); PG8_BAR; PG8_MMA(1, 0, At, B0); PG8_MMA(1, 1, At, B1); PG8_BAR; PG8_SCHED;
            PG8_LDB(B0, 1, 0); PG8_LDB(B1, 1, 1); PG8_SCHED; PG8_LDA(At, 1, 0); PG8_STAGE(PG8_SA(0, 1), a2 + hstep, voffA);
            PG8_WAIT_V(8); PG8_WAIT_L(0); PG8_BAR; PG8_MMA(0, 0, At, B0); PG8_MMA(0, 1, At, B1); PG8_BAR; PG8_SCHED;
            PG8_LDA(At, 1, 1); PG8_STAGE(PG8_SB(1, 0), b3, voffB); PG8_STAGE(PG8_SB(1, 1), b3 + hstep, voffB); PG8_STAGE(PG8_SA(1, 0), a3, voffA);
            PG8_WAIT_V(8); PG8_WAIT_L(0); PG8_BAR; PG8_MMA(1, 0, At, B0); PG8_MMA(1, 1, At, B1); PG8_BAR; PG8_SCHED;
            } else {
            PG8_LDB(B0, 0, 0); PG8_SCHED; PG8_LDA(At, 0, 0); PG8_STAGE(PG8_SA(1, 1), a1 + hstep, voffA);
            PG8_WAIT_L(8); PG8_BAR; PG8_WAIT_L(0); PG8_MMA(0, 0, At, B0); PG8_BAR; PG8_SCHED;
            PG8_LDB(B1, 0, 1); PG8_STAGE(PG8_SB(0, 0), b2, voffB);
            PG8_BAR; PG8_WAIT_L(0); PG8_MMA(0, 1, At, B1); PG8_BAR;
            PG8_LDA(At, 0, 1); PG8_STAGE(PG8_SA(0, 0), a2, voffA);
            PG8_BAR; PG8_WAIT_L(0); PG8_MMA(1, 0, At, B0); PG8_BAR; PG8_SCHED;
            PG8_STAGE(PG8_SB(0, 1), b2 + hstep, voffB);
            PG8_WAIT_V(6); PG8_BAR; PG8_MMA(1, 1, At, B1); PG8_BAR;
            PG8_LDB(B0, 1, 0); PG8_SCHED; PG8_LDA(At, 1, 0); PG8_STAGE(PG8_SA(0, 1), a2 + hstep, voffA);
            PG8_WAIT_L(8); PG8_BAR; PG8_WAIT_L(0); PG8_MMA(0, 0, At, B0); PG8_BAR; PG8_SCHED;
            PG8_LDB(B1, 1, 1); PG8_STAGE(PG8_SB(1, 0), b3, voffB);
            PG8_BAR; PG8_WAIT_L(0); PG8_MMA(0, 1, At, B1); PG8_BAR;
            PG8_LDA(At, 1, 1); PG8_STAGE(PG8_SA(1, 0), a3, voffA);
            PG8_BAR; PG8_WAIT_L(0); PG8_MMA(1, 0, At, B0); PG8_BAR; PG8_SCHED;
            PG8_STAGE(PG8_SB(1, 1), b3 + hstep, voffB);
            PG8_WAIT_V(6); PG8_BAR; PG8_MMA(1, 1, At, B1); PG8_BAR;
            }
        }
        if constexpr (ALIGN_EPI) { if (wr == 0) PG8_BAR; }
        if constexpr (!Epi::AFTER_DRAIN) { E(acc, cur, wr, wc, fr, fq);
#if defined(EPI_TWICE)
            if constexpr (Epi::PERM) E(acc, cur, wr, wc, fr, fq);
#endif
            S.done(cur); }
        if (!has_next) break;
#pragma unroll
        for (int a = 0; a < 2; ++a)
#pragma unroll
            for (int b = 0; b < 2; ++b)
#pragma unroll
                for (int m = 0; m < 4; ++m)
#pragma unroll
                    for (int n = 0; n < 2; ++n) acc[a][b][m][n] = (f32x4){0.f, 0.f, 0.f, 0.f};
        cur = nxt; cA = nA; cB = nB; ++ui;
        if constexpr (ALIGN_EPI) { if (wr == 1) PG8_BAR; }
    }
    PG8_WAIT_V(0);
    if constexpr (!ALIGN_EPI) { if (wr == 0) PG8_BAR; }
    PG8_BAR;
    if constexpr (Epi::AFTER_DRAIN) { E.fused(acc, cur, wr, wc, fr, fq, lds, wid, lane); S.done(cur); }
#undef PG8_SA
#undef PG8_SB
#undef PG8_STAGE
#undef PG8_LDA
#undef PG8_LDB
#undef PG8_MMA
#undef PG8_WAIT_V
#undef PG8_WAIT_L
#undef PG8_BAR
#undef PG8_SCHED
}
}

constexpr int BATCH = 2, SEQ = 8192, DM = 2048, DEPTH = 4;
constexpr int M = BATCH * SEQ;
constexpr int NH = 16, HD = 128, NG = 4, RH = 4;
constexpr int NCMP = 511, NCMP_PAD = 512, NSLC = 128, NSEL = 16, WIN = 512;
constexpr int SSD_H = 32, SSD_P = 64, SSD_N = 128, SSD_G = 4, SSD_CH = 128, SSD_NC = 64, SSD_XBC = 3072;
constexpr int DFF = 8192, PLE = 256;
constexpr float EPS = 1e-6f;
constexpr int PROJ_SRC = 22608;
constexpr int C_Q = 0, C_KC = 2048, C_VC = 2560, C_KS = 3072, C_VS = 3584, C_KW = 4096, C_VW = 4608;
constexpr int C_CB = 5120, C_CC = 7168, C_CU = 9216, C_Z = 11264, C_XBC = 13312, C_GM = 16384, C_GN = 22528, C_DT = 22592;
constexpr int LDP = 22784;
constexpr int S_GN = 5120, S_DT = 16432;

constexpr size_t MiB = 1u << 20;
constexpr size_t WS_CTL = 0, CTL_ZERO_BYTES = 1 * MiB;
constexpr size_t WS_ROPE = 1 * MiB;
constexpr size_t WS_MISC = 9 * MiB;
constexpr size_t WS_DT = 10 * MiB;
constexpr size_t WS_ACS = 12 * MiB;
constexpr size_t WS_CDEC = 14 * MiB;
constexpr size_t WS_KCMP = 15 * MiB;
constexpr size_t WS_VCMP = 16 * MiB;
constexpr size_t WS_X = 32 * MiB;
constexpr size_t WS_HB = 160 * MiB;
constexpr size_t WS_PB = 224 * MiB;
constexpr size_t WS_EB = 256 * MiB;
constexpr size_t WS_YA = 320 * MiB;
constexpr size_t WS_YC = 384 * MiB;
constexpr size_t WS_XBC = 448 * MiB;
constexpr size_t WS_ST = 544 * MiB;
constexpr size_t WS_PROJ = 672 * MiB;
constexpr size_t WS_U = WS_PROJ;
constexpr size_t WS_W = 1384 * MiB;
constexpr size_t LW_IN = 0;
constexpr size_t LW_O = 89 * MiB;
constexpr size_t LW_UP = 97 * MiB;
constexpr size_t LW_DOWN = 129 * MiB;
constexpr size_t LW_PG = 161 * MiB;
constexpr size_t LW_PLE = 169 * MiB;
constexpr size_t LW_PK1 = 170 * MiB;
constexpr size_t LW_PV1 = 171 * MiB;
constexpr size_t LW_PK2 = 172 * MiB;
constexpr size_t LW_PV2 = 172 * MiB + 64 * 1024;
constexpr size_t LW_STRIDE = 173 * MiB;
constexpr size_t WS_HIN = WS_W + 4 * LW_STRIDE;
constexpr size_t WS_RSTD = WS_MISC + 512 * 1024;
constexpr size_t WS_DELTA = WS_HIN + 64 * MiB;
constexpr size_t WS_KV = WS_DELTA + 64 * MiB;
constexpr size_t WS_END = WS_KV + 96 * MiB;
static_assert((size_t)M * LDP * 2 <= 712 * MiB && (size_t)LDP * 2048 * 2 <= 89 * MiB, "ws map");

constexpr int CW_BAR = 4096;
constexpr int CW_CHK = 16384;
constexpr int CW_TS = 20480;

constexpr int RING_BYTES = 131072;
constexpr int LX_OFF = RING_BYTES;
constexpr int LX_BYTES = 8192;
constexpr int LDSCTL_OFF = LX_OFF + LX_BYTES;
constexpr int LDS_BYTES = LDSCTL_OFF + 256;
constexpr int NWAVES = 8, NTHR = 512;

#define DI __device__ __forceinline__
#define GAS __attribute__((address_space(1)))
#define LAS __attribute__((address_space(3)))
typedef unsigned short bf16;
typedef unsigned u32x4 __attribute__((ext_vector_type(4)));
typedef unsigned u32x2 __attribute__((ext_vector_type(2)));
typedef float f32x4 __attribute__((ext_vector_type(4)));
typedef float f32x2 __attribute__((ext_vector_type(2)));
typedef short bf16x8 __attribute__((ext_vector_type(8)));
typedef short s16x4 __attribute__((ext_vector_type(4)));
typedef GAS unsigned gu32;
#define RLX_AGENT __ATOMIC_RELAXED, __HIP_MEMORY_SCOPE_AGENT
#define LDS_WAIT() asm volatile("s_waitcnt lgkmcnt(0)" ::: "memory")
#define VM_WAIT() asm volatile("s_waitcnt vmcnt(0)" ::: "memory")
DI size_t kv_off(int kind, int b, int g, int t) { return ((((size_t)kind * BATCH + b) * NG + g) * SEQ + t) * HD; }
DI unsigned f2bf(float f) { unsigned u = __builtin_bit_cast(unsigned, f); return (u + 0x7fffu + ((u >> 16) & 1u)) >> 16; }
DI unsigned pk2(float lo, float hi) { unsigned r; asm("v_cvt_pk_bf16_f32 %0, %1, %2" : "=v"(r) : "v"(lo), "v"(hi)); return r; }
DI float bf2f(unsigned h) { return __builtin_bit_cast(float, h << 16); }
DI float bflo(unsigned w) { return __builtin_bit_cast(float, w << 16); }
DI float bfhi(unsigned w) { return __builtin_bit_cast(float, w & 0xffff0000u); }
DI float sigmoidf_(float x) { return 1.0f / (1.0f + __expf(-x)); }
DI float siluf_(float x) { return x / (1.0f + __expf(-x)); }
DI float shfl_idx(float v, int src) { return __builtin_bit_cast(float, __builtin_amdgcn_ds_bpermute(src << 2, __builtin_bit_cast(int, v))); }
DI unsigned shfl_idx_u(unsigned v, int src) { return (unsigned)__builtin_amdgcn_ds_bpermute(src << 2, (int)v); }
DI float shx(float v, int m, int lane) { return shfl_idx(v, lane ^ m); }
DI float xq_max(float x) {
    float a = x, b = x;
    asm("s_nop 1\n\tv_permlane32_swap_b32 %0, %1" : "+v"(a), "+v"(b)); x = fmaxf(a, b);
    a = x; b = x;
    asm("s_nop 1\n\tv_permlane16_swap_b32 %0, %1" : "+v"(a), "+v"(b)); return fmaxf(a, b);
}
DI float xq_sum(float x) {
    float a = x, b = x;
    asm("s_nop 1\n\tv_permlane32_swap_b32 %0, %1" : "+v"(a), "+v"(b)); x = a + b;
    a = x; b = x;
    asm("s_nop 1\n\tv_permlane16_swap_b32 %0, %1" : "+v"(a), "+v"(b)); return a + b;
}
DI float quad_sum(float v) {
    v += __builtin_bit_cast(float, __builtin_amdgcn_update_dpp(0, __builtin_bit_cast(int, v), 0xB1, 0xF, 0xF, true));
    v += __builtin_bit_cast(float, __builtin_amdgcn_update_dpp(0, __builtin_bit_cast(int, v), 0x4E, 0xF, 0xF, true));
    return v;
}
DI float wave_sum(float v, int lane) {
#pragma unroll
    for (int o = 1; o < 64; o <<= 1) v += shx(v, o, lane);
    return v;
}
DI unsigned off_b(unsigned row, unsigned ch) { return 256u * row + 16u * (ch ^ (((row & 3u) << 2) | ((row >> 2) & 3u))); }
DI unsigned tr_addr(unsigned lane, unsigned r0, unsigned c, unsigned t) {
    const unsigned g = lane >> 4, q = (lane & 15u) >> 2, p = lane & 3u;
    return off_b(r0 + 8u * g + 4u * t + q, 2u * c + (p >> 1)) + 8u * (p & 1u);
}
DI s16x4 tr_read(LAS const unsigned char* p) { return __builtin_amdgcn_ds_read_tr16_b64_v4i16((LAS s16x4*)p); }
DI bf16x8 tr_read8(LAS const unsigned char* base, unsigned lane, unsigned r0, unsigned c) {
    const s16x4 lo = tr_read(base + tr_addr(lane, r0, c, 0)), hi = tr_read(base + tr_addr(lane, r0, c, 1));
    return __builtin_shufflevector(lo, hi, 0, 1, 2, 3, 4, 5, 6, 7);
}
DI bf16x8 lds_rd8(LAS const unsigned char* p) { return *(const LAS bf16x8*)p; }
DI bf16x8 as_bf16x8(u32x4 v) { return __builtin_bit_cast(bf16x8, v); }
#define MFMA16(a, b, c) __builtin_amdgcn_mfma_f32_16x16x32_bf16((a), (b), (c), 0, 0, 0)

namespace pg8 {
struct LightOrder {
    int G, c, nunits, nN;
    __host__ __device__ void init(int M, int N, int G_, int c_) { G = G_; c = c_; nN = N / BM; nunits = (M / BM) * nN; }
    __host__ __device__ bool next(int i, Unit& u) const {
        int j;
        if (G == 256) { if (c < 64) return false; j = (c - 64) + 192 * i; } else j = c + G * i;
        if (j >= nunits) return false;
        u.pm = j / nN; u.pn = j % nN; return true;
    }
    __device__ __forceinline__ void a_ready(const Unit&) const {}
    __device__ __forceinline__ void done(const Unit&) const {}
};
template <int MODE> struct EpiB {
    static constexpr bool PERM = true, AFTER_DRAIN = false;
    bf16_t* O; int ldc; const float* rope;
    bf16_t* kv;
    __device__ __forceinline__ void operator()(const f32x4 (&acc)[2][2][4][2], const Unit& u, int wr, int wc, int fr, int fq) const {
        { int l; asm volatile("v_mbcnt_lo_u32_b32 %0, -1, 0\n\tv_mbcnt_hi_u32_b32 %0, -1, %0" : "=v"(l)); fr = l & 15; fq = l >> 4; }
        const int row0 = u.pm * BM + wr * 64 + fr;
        bool rp = false;
        if (MODE == 2) { const int pn = u.pn; rp = (pn < 10) || pn == 12 || pn == 13 || pn == 16 || pn == 17; }
        if (MODE == 2 && rp) {
            const int colb = u.pn * BM + 128 * (wc >> 1) + 32 * (wc & 1) + 8 * fq, jj0 = 32 * (wc & 1) + 8 * fq;
#pragma unroll
            for (int ai = 0; ai < 2; ++ai)
#pragma unroll
                for (int m = 0; m < 4; ++m) {
                    const int row = row0 + ai * HALF + m * 16;
                    const float* rpp = (const float*)((const char*)rope + (unsigned)(((unsigned)row * 64u + (unsigned)jj0) * 8u));
                    const f32x4 cs0 = *(const f32x4*)(rpp), cs1 = *(const f32x4*)(rpp + 4), cs2 = *(const f32x4*)(rpp + 8), cs3 = *(const f32x4*)(rpp + 12);
                    const f32x4 x1a = acc[ai][0][m][0], x1b = acc[ai][0][m][1], x2a = acc[ai][1][m][0], x2b = acc[ai][1][m][1];
                    float c[8] = {cs0[0], cs0[2], cs1[0], cs1[2], cs2[0], cs2[2], cs3[0], cs3[2]};
                    float s[8] = {cs0[1], cs0[3], cs1[1], cs1[3], cs2[1], cs2[3], cs3[1], cs3[3]};
                    float x1[8] = {x1a[0], x1a[1], x1a[2], x1a[3], x1b[0], x1b[1], x1b[2], x1b[3]};
                    float x2[8] = {x2a[0], x2a[1], x2a[2], x2a[3], x2b[0], x2b[1], x2b[2], x2b[3]};
                    float o1[8], o2[8];
#pragma unroll
                    for (int k = 0; k < 8; ++k) { o1[k] = x1[k] * c[k] - x2[k] * s[k]; o2[k] = x2[k] * c[k] + x1[k] * s[k]; }
                    u32x4 w1, w2;
                    w1.x = cvt_pk_bf16(o1[0], o1[1]); w1.y = cvt_pk_bf16(o1[2], o1[3]); w1.z = cvt_pk_bf16(o1[4], o1[5]); w1.w = cvt_pk_bf16(o1[6], o1[7]);
                    w2.x = cvt_pk_bf16(o2[0], o2[1]); w2.y = cvt_pk_bf16(o2[2], o2[3]); w2.z = cvt_pk_bf16(o2[4], o2[5]); w2.w = cvt_pk_bf16(o2[6], o2[7]);
                    bf16_t* rowp = (bf16_t*)((char*)O + (unsigned)(((unsigned)row * (unsigned)ldc + (unsigned)colb) * 2u));
                    if (u.pn >= 8) { const int kind = (u.pn - 8) >> 1, g = 2 * (u.pn & 1) + (wc >> 1);
                        rowp = kv + ((((size_t)kind * 2 + (row >> 13)) * 4 + g) * 8192 + (row & 8191)) * 128 + jj0; }
                    *(u32x4*)(rowp) = w1; *(u32x4*)(rowp + 64) = w2;
                    asm volatile("" ::: "memory");
                }
        } else {
            const int col0 = u.pn * BM + wc * 32 + 8 * fq;
#pragma unroll
            for (int ai = 0; ai < 2; ++ai)
#pragma unroll
                for (int m = 0; m < 4; ++m) { bf16_t* rowp = (bf16_t*)((char*)O + (unsigned)(((unsigned)(row0 + ai * HALF + m * 16) * (unsigned)ldc + (unsigned)col0) * 2u));
#pragma unroll
                    for (int bj = 0; bj < 2; ++bj) { f32x4 v0 = acc[ai][bj][m][0], v1 = acc[ai][bj][m][1];
                        if (MODE == 1) {
#pragma unroll
                            for (int k = 0; k < 4; ++k) { const float a = fmaxf(v0[k], 0.f), b = fmaxf(v1[k], 0.f); v0[k] = a * a; v1[k] = b * b; } }
                        if (MODE == 3) { const u32x4 ev = *(const u32x4*)((const bf16_t*)rope + (rowp - O) + bj * HALF);
                            const float e[8] = {__builtin_bit_cast(float, ev.x << 16), __builtin_bit_cast(float, ev.x & 0xffff0000u), __builtin_bit_cast(float, ev.y << 16), __builtin_bit_cast(float, ev.y & 0xffff0000u),
                                                __builtin_bit_cast(float, ev.z << 16), __builtin_bit_cast(float, ev.z & 0xffff0000u), __builtin_bit_cast(float, ev.w << 16), __builtin_bit_cast(float, ev.w & 0xffff0000u)};
#pragma unroll
                            for (int k = 0; k < 4; ++k) { v0[k] = e[k] / (1.0f + __expf(-v0[k])); v1[k] = e[4 + k] / (1.0f + __expf(-v1[k])); } }
                        u32x4 w; w.x = cvt_pk_bf16(v0[0], v0[1]); w.y = cvt_pk_bf16(v0[2], v0[3]); w.z = cvt_pk_bf16(v1[0], v1[1]); w.w = cvt_pk_bf16(v1[2], v1[3]);
                        if (MODE == 2 && u.pn >= 8 && u.pn < 20) { const int kind = (u.pn - 8) >> 1, g = 2 * (u.pn & 1) + bj, row = row0 + ai * HALF + m * 16;
                            *(u32x4*)(kv + ((((size_t)kind * 2 + (row >> 13)) * 4 + g) * 8192 + (row & 8191)) * 128 + wc * 32 + 8 * fq) = w; }
                        else *(u32x4*)(rowp + bj * HALF) = w; } }
        }
    }
};
template <bool GATE> struct EpiRes {
    static constexpr bool PERM = false, AFTER_DRAIN = false;
    const float* xin; float* xout; int ldc; const bf16_t* e;
    __device__ __forceinline__ void operator()(const f32x4 (&acc)[2][2][4][2], const Unit& u, int wr, int wc, int fr, int fq) const {
        { int l; asm volatile("v_mbcnt_lo_u32_b32 %0, -1, 0\n\tv_mbcnt_hi_u32_b32 %0, -1, %0" : "=v"(l)); fr = l & 15; fq = l >> 4; }
        const int row0 = u.pm * BM + wr * 64 + fr, col0 = u.pn * BM + wc * 32 + 4 * fq;
#pragma unroll
        for (int ai = 0; ai < 2; ++ai)
#pragma unroll
            for (int m = 0; m < 4; ++m) { const unsigned off = (unsigned)(row0 + ai * HALF + m * 16) * (unsigned)ldc + (unsigned)col0;
#pragma unroll
                for (int bj = 0; bj < 2; ++bj)
#pragma unroll
                    for (int n = 0; n < 2; ++n) { const unsigned o = off + bj * HALF + n * 16; const f32x4 xv = *(const f32x4*)((const char*)xin + (unsigned)(o * 4u)); f32x4 a = acc[ai][bj][m][n];
                        if (GATE) { typedef unsigned u32x2v __attribute__((ext_vector_type(2))); const u32x2v ev = *(const u32x2v*)((const char*)e + (unsigned)(o * 2u));
                            const float e0 = __builtin_bit_cast(float, ev.x << 16), e1 = __builtin_bit_cast(float, ev.x & 0xffff0000u), e2 = __builtin_bit_cast(float, ev.y << 16), e3 = __builtin_bit_cast(float, ev.y & 0xffff0000u);
                            a[0] = e0 / (1.0f + __expf(-a[0])); a[1] = e1 / (1.0f + __expf(-a[1])); a[2] = e2 / (1.0f + __expf(-a[2])); a[3] = e3 / (1.0f + __expf(-a[3])); }
                        *(f32x4*)((char*)xout + (unsigned)(o * 4u)) = xv + a; }
                asm volatile("" ::: "memory"); }
    }
};
}
#define XB_TMO      128
#define XB_XCNT(j)  (256  + 64 * (j))
#define XB_XSUB(j)  (1280 + 64 * (j))
#define XB_XGEN(j)  (2304 + 64 * (j))
#define XB_TOP      3328
#define XB_TOPGEN   3392
#define XCD_BAR_WORDS 3456
#define XB_SPIN_CAP (1u << 18)

__device__ __forceinline__ unsigned xb_ld(unsigned* p)              { return __hip_atomic_load(p, __ATOMIC_RELAXED, __HIP_MEMORY_SCOPE_AGENT); }
__device__ __forceinline__ unsigned xb_add(unsigned* p, unsigned v) { return __hip_atomic_fetch_add(p, v, __ATOMIC_RELAXED, __HIP_MEMORY_SCOPE_AGENT); }
__device__ __forceinline__ unsigned xb_xcc_id() { return (unsigned)__builtin_amdgcn_s_getreg((3 << 11) | 20) & 0xFu; }
#define XB_SPIN(cond, bar) do { unsigned _sp = 0; while (cond) { __builtin_amdgcn_s_sleep(1); \
    if ((++_sp & 255u) == 0u) { if (xb_ld(&(bar)[XB_TMO])) break; if (_sp > XB_SPIN_CAP) { atomicAdd(&(bar)[XB_TMO], 1u); break; } } } } while (0)

struct XcdBarrier {
    unsigned* bar; unsigned x;
    volatile LAS unsigned* st;
};

__device__ __forceinline__ XcdBarrier xcd_barrier_post(unsigned* bar, volatile LAS unsigned* st) {
    XcdBarrier b; b.bar = bar; b.x = xb_xcc_id(); b.st = st;
    if (threadIdx.x == 0) (void)xb_add(&bar[XB_XCNT(b.x)], 1u);
    return b;
}
__device__ __forceinline__ void xcd_barrier_complete(unsigned* bar, unsigned x, unsigned& nloc, unsigned& nx) {
    const unsigned G = gridDim.x * gridDim.y * gridDim.z;
    unsigned sum, cnt, mine, sp = 0u;
    for (;;) {
        sum = 0u; cnt = 0u; mine = 0u;
#pragma unroll
        for (unsigned j = 0; j < 16; ++j) { const unsigned c = xb_ld(&bar[XB_XCNT(j)]); sum += c; cnt += (c > 0u) ? 1u : 0u; mine = (j == x) ? c : mine; }
        if (sum == G) break;
        __builtin_amdgcn_s_sleep(1);
        if ((++sp & 255u) == 0u) { if (xb_ld(&bar[XB_TMO])) break; if (sp > XB_SPIN_CAP) { atomicAdd(&bar[XB_TMO], 1u); break; } }
    }
    nloc = mine > 0u ? mine : 1u; nx = cnt > 0u ? cnt : 1u;
}

__device__ __forceinline__ void xcd_barrier(const XcdBarrier& b) {
    asm volatile("s_waitcnt vmcnt(0)" ::: "memory");
    __syncthreads();
    if (threadIdx.x == 0) {
        unsigned* bar = b.bar;
        __builtin_amdgcn_s_waitcnt(0);
        unsigned nloc = b.st[0], nx = b.st[1];
        if (nloc == 0u) { xcd_barrier_complete(bar, b.x, nloc, nx); b.st[0] = nloc; b.st[1] = nx; }
        const unsigned old = xb_add(&bar[XB_XSUB(b.x)], 1u);
        const unsigned gen = old / nloc;
        if (old + 1u == (gen + 1u) * nloc) {
            __builtin_amdgcn_fence(__ATOMIC_RELEASE, "agent");
            asm volatile("s_waitcnt vmcnt(0)" ::: "memory");
            const unsigned og = xb_add(&bar[XB_TOP], 1u);
            const unsigned tg = og / nx;
            if (og + 1u == (tg + 1u) * nx) xb_add(&bar[XB_TOPGEN], 1u);
            else XB_SPIN(xb_ld(&bar[XB_TOPGEN]) == tg, bar);
            __builtin_amdgcn_fence(__ATOMIC_ACQUIRE, "agent");
            xb_add(&bar[XB_XGEN(b.x)], 1u);
            asm volatile("s_waitcnt vmcnt(0)" ::: "memory");
        } else {
            XB_SPIN(xb_ld(&bar[XB_XGEN(b.x)]) == gen, bar);
            __builtin_amdgcn_fence(__ATOMIC_ACQUIRE, "agent");
            asm volatile("s_waitcnt vmcnt(0)" ::: "memory");
        }
    }
    __syncthreads();
}

struct Args { const void* in[30]; float* out; unsigned char* ws; int ph_lo, ph_hi; };
struct Frame {
    LAS unsigned char* lds;
    gu32* ctl;
    unsigned char* ws;
    int tid, lane, wave, G, bid;
};
DI const void* argin(const Args&, int k) {
    typedef const void* const __attribute__((address_space(4)))* kptr_t;
    kptr_t p = (kptr_t)__builtin_amdgcn_kernarg_segment_ptr(); asm volatile("" : "+s"(p));
    return (const void*)p[k]; }
DI int launder_s(int x) { asm volatile("" : "+s"(x)); return x; }
DI Frame phase_frame(const Frame& F0) { Frame F = F0;
    int l; asm volatile("v_mbcnt_lo_u32_b32 %0, -1, 0\n\tv_mbcnt_hi_u32_b32 %0, -1, %0" : "=v"(l));
    F.wave = launder_s(F0.wave); F.bid = launder_s(F0.bid); F.G = launder_s(F0.G);
    F.lane = l; F.tid = F.wave * 64 + l;
    { unsigned long long wsb = (unsigned long long)F0.ws; asm volatile("" : "+s"(wsb)); F.ws = (unsigned char*)wsb; }
    { unsigned ll = (unsigned)(size_t)F0.lds; asm volatile("" : "+s"(ll)); F.lds = (LAS unsigned char*)(size_t)ll; }
    return F; }
DI unsigned char* lw_ptr(const Frame& F, int layer, size_t off) { return F.ws + WS_W + (size_t)layer * LW_STRIDE + off; }

template <bool FRAGMAJOR = false>
DI void transpose_item(const float* W, int K, int Nsrc, int nsrc0, bf16* WT, int dst_row0, int k0, LAS float* scr, int lane) {
#pragma unroll 8
    for (int i = 0; i < 32; ++i) { const int kk = 2 * i + (lane >> 5); scr[kk * 33 + (lane & 31)] = W[(size_t)(k0 + kk) * Nsrc + nsrc0 + (lane & 31)]; }
    LDS_WAIT(); asm volatile("" ::: "memory");
    const int c = lane & 7;
#pragma unroll
    for (int j = 0; j < 4; ++j) { const int n = (lane >> 3) + 8 * j; const LAS float* s = scr + (8 * c) * 33 + n;
        u32x4 o; o.x = pk2(s[0 * 33], s[1 * 33]); o.y = pk2(s[2 * 33], s[3 * 33]); o.z = pk2(s[4 * 33], s[5 * 33]); o.w = pk2(s[6 * 33], s[7 * 33]);
        if (FRAGMAJOR) { const int hid = dst_row0 + n, kk = k0 + 8 * c;
            *(u32x4*)(WT + ((size_t)((hid >> 4) * (K >> 5) + (kk >> 5)) * 64 + (((kk >> 3) & 3) * 16 + (hid & 15))) * 8) = o; }
        else *(u32x4*)(WT + (size_t)(dst_row0 + n) * K + k0 + 8 * c) = o; }
    LDS_WAIT(); asm volatile("" ::: "memory");
}
DI int proj_src_col(int d) {
    if (d < 5120) {
        const int pn = d >> 8; const bool rp = (pn < 10) || pn == 12 || pn == 13 || pn == 16 || pn == 17;
        if (!rp) return d;
        const int c = d & 255, bj = c >> 7, wc = (c >> 5) & 3;
        return (pn << 8) + 128 * (wc >> 1) + 64 * bj + 32 * (wc & 1);
    }
    if (d < 16384) return d + 48;
    if (d < 22528) return d + 80;
    if (d < 22592) return S_GN + (d - 22528);
    if (d < 22624) return S_DT + (d - 22592);
    return 0;
}
constexpr int TI_IN = 32 * 712, TI_O = 32 * 64, TI_UP = 32 * 256, TI_DOWN = 128 * 64, TI_PG = 32 * 64, TI_PLE = 4 * 64, TI_P1 = 64 * 4, TI_P2 = 2 * 4;
constexpr int TI_LAYER = TI_IN + TI_O + TI_UP + TI_DOWN + TI_PG + TI_PLE + 2 * TI_P1 + 2 * TI_P2;

DI void p0_prologue(const Frame& F0, const Args& A) {
    const Frame F = phase_frame(F0);
    LAS float* scr = (LAS float*)(F.lds + F.wave * 16384);
    const int gw = F.bid * NWAVES + F.wave, NGW = F.G * NWAVES;
    for (int it = gw; it < DEPTH * TI_LAYER; it += NGW) {
        const int layer = it / TI_LAYER; int r = it - layer * TI_LAYER;
        if (r < TI_IN) { const int kb = r / 712, nb = r - kb * 712;
            transpose_item((const float*)argin(A, 4) + (size_t)layer * DM * PROJ_SRC, DM, PROJ_SRC, proj_src_col(nb * 32), (bf16*)lw_ptr(F, layer, LW_IN), nb * 32, kb * 64, scr, F.lane); continue; } r -= TI_IN;
        if (r < TI_O) { const int kb = r / 64, nb = r % 64;
            transpose_item((const float*)argin(A, 22) + (size_t)layer * DM * DM, DM, DM, nb * 32, (bf16*)lw_ptr(F, layer, LW_O), nb * 32, kb * 64, scr, F.lane); continue; } r -= TI_O;
        if (r < TI_UP) { const int kb = r / 256, nb = r % 256;
            transpose_item((const float*)argin(A, 24) + (size_t)layer * DM * DFF, DM, DFF, nb * 32, (bf16*)lw_ptr(F, layer, LW_UP), nb * 32, kb * 64, scr, F.lane); continue; } r -= TI_UP;
        if (r < TI_DOWN) { const int kb = r / 64, nb = r % 64;
            transpose_item((const float*)argin(A, 25) + (size_t)layer * DFF * DM, DFF, DM, nb * 32, (bf16*)lw_ptr(F, layer, LW_DOWN), nb * 32, kb * 64, scr, F.lane); continue; } r -= TI_DOWN;
        if (r < TI_PG) { const int kb = r / 64, nb = r % 64;
            transpose_item((const float*)argin(A, 28) + (size_t)layer * DM * DM, DM, DM, nb * 32, (bf16*)lw_ptr(F, layer, LW_PG), nb * 32, kb * 64, scr, F.lane); continue; } r -= TI_PG;
        if (r < TI_PLE) { const int kb = r / 64, nb = r % 64;
            transpose_item((const float*)argin(A, 27) + (size_t)layer * PLE * DM, PLE, DM, nb * 32, (bf16*)lw_ptr(F, layer, LW_PLE), nb * 32, kb * 64, scr, F.lane); continue; } r -= TI_PLE;
        if (r < TI_P1) { const int kb = r / 4, nb = r % 4;
            transpose_item<true>((const float*)argin(A, 7) + (size_t)layer * 4096 * 128, 4096, 128, nb * 32, (bf16*)lw_ptr(F, layer, LW_PK1), nb * 32, kb * 64, scr, F.lane); continue; } r -= TI_P1;
        if (r < TI_P1) { const int kb = r / 4, nb = r % 4;
            transpose_item<true>((const float*)argin(A, 11) + (size_t)layer * 4096 * 128, 4096, 128, nb * 32, (bf16*)lw_ptr(F, layer, LW_PV1), nb * 32, kb * 64, scr, F.lane); continue; } r -= TI_P1;
        if (r < TI_P2) { const int kb = r / 4, nb = r % 4;
            transpose_item((const float*)argin(A, 9) + (size_t)layer * 128 * 128, 128, 128, nb * 32, (bf16*)lw_ptr(F, layer, LW_PK2), nb * 32, kb * 64, scr, F.lane); continue; } r -= TI_P2;
        { const int kb = r / 4, nb = r % 4;
            transpose_item((const float*)argin(A, 13) + (size_t)layer * 128 * 128, 128, 128, nb * 32, (bf16*)lw_ptr(F, layer, LW_PV2), nb * 32, kb * 64, scr, F.lane); }
    }
    const size_t gt = (size_t)F.bid * NTHR + F.tid, NGT = (size_t)F.G * NTHR;
    { const float* p = (const float*)argin(A, 1); bf16* pb = (bf16*)(F.ws + WS_PB);
      for (size_t i = gt; i < (size_t)DEPTH * M * PLE / 8; i += NGT) { const f32x4 a = *(const f32x4*)(p + i * 8), b = *(const f32x4*)(p + i * 8 + 4);
          u32x4 o; o.x = pk2(a[0], a[1]); o.y = pk2(a[2], a[3]); o.z = pk2(b[0], b[1]); o.w = pk2(b[2], b[3]); *(u32x4*)(pb + i * 8) = o; } }
    { const int* pos = (const int*)argin(A, 2); float* rope = (float*)(F.ws + WS_ROPE);
      for (size_t i = gt; i < (size_t)M * 64; i += NGT) { const int row = (int)(i >> 6), jj = (int)(i & 63);
          const float inv = 1.0f / powf(10000.0f, (float)(2 * jj) * (1.0f / 128.0f));
          const float ang = (float)pos[row] * inv;
          double a = (double)ang; a -= 6.283185307179586476925 * __builtin_rint(a * 0.15915494309189533577);
          const float ar = (float)a;
          rope[i * 2] = cosf(ar); rope[i * 2 + 1] = sinf(ar); } }
    { float* part = (float*)(F.ws + WS_MISC);
      for (size_t i = gt; i < (size_t)DEPTH * 2 * 8 * 128; i += NGT) { const int hid = (int)(i & 127), c = (int)(i >> 7) & 7, kv = (int)(i >> 10) & 1, layer = (int)(i >> 11);
          const float* pe = (const float*)(kv ? A.in[6] : A.in[5]) + (size_t)layer * 4096 + c * 512;
          const float* w1 = (const float*)(kv ? A.in[11] : A.in[7]) + (size_t)layer * 4096 * 128 + (size_t)c * 512 * 128 + hid;
          float s = 0.f;
#pragma unroll 8
          for (int kk = 0; kk < 512; ++kk) s += pe[kk] * w1[(size_t)kk * 128];
          part[i] = s; } }
}

template <bool OUTF32> DI void norm_rows(const Frame& F0, const float* x, const float* g, void* outp) {
    const Frame F = phase_frame(F0);
    const int gw = F.bid * NWAVES + F.wave, NGW = F.G * NWAVES;
    for (int m = gw; m < M; m += NGW) {
        const f32x4* xr = (const f32x4*)(x + (size_t)m * DM) + F.lane;
        f32x4 v[8]; float s = 0.f;
#pragma unroll
        for (int j = 0; j < 8; ++j) { v[j] = xr[64 * j]; s += (v[j][0] * v[j][0] + v[j][1] * v[j][1]) + (v[j][2] * v[j][2] + v[j][3] * v[j][3]); }
        const float rstd = 1.0f / sqrtf(wave_sum(s, F.lane) * (1.0f / DM) + EPS);
#pragma unroll
        for (int j = 0; j < 8; ++j) { const f32x4 gv = ((const f32x4*)g)[F.lane + 64 * j]; const f32x4 o = v[j] * rstd * gv;
            if (OUTF32) ((f32x4*)((float*)outp + (size_t)m * DM))[F.lane + 64 * j] = o;
            else { u32x2 w; w.x = pk2(o[0], o[1]); w.y = pk2(o[2], o[3]); ((u32x2*)((bf16*)outp + (size_t)m * DM))[F.lane + 64 * j] = w; } }
    }
}
template <bool OUTF32> DI void addnorm_rows(const Frame& F0, const float* xin, const bf16* delta, const float* g, float* xout, void* outp) {
    const Frame F = phase_frame(F0);
    const int gw = F.bid * NWAVES + F.wave, NGW = F.G * NWAVES;
    for (int m = gw; m < M; m += NGW) {
        const f32x4* xr = (const f32x4*)(xin + (size_t)m * DM) + F.lane; const u32x2* dr = (const u32x2*)(delta + (size_t)m * DM) + F.lane;
        f32x4 v[8]; u32x2 d[8]; float s = 0.f;
#pragma unroll
        for (int j = 0; j < 8; ++j) { v[j] = xr[64 * j]; d[j] = dr[64 * j]; }
#pragma unroll
        for (int j = 0; j < 8; ++j) { v[j][0] += bflo(d[j].x); v[j][1] += bfhi(d[j].x); v[j][2] += bflo(d[j].y); v[j][3] += bfhi(d[j].y);
            s += (v[j][0] * v[j][0] + v[j][1] * v[j][1]) + (v[j][2] * v[j][2] + v[j][3] * v[j][3]);
            if (!OUTF32) ((f32x4*)(xout + (size_t)m * DM))[F.lane + 64 * j] = v[j]; }
        const float rstd = 1.0f / sqrtf(wave_sum(s, F.lane) * (1.0f / DM) + EPS);
#pragma unroll
        for (int j = 0; j < 8; ++j) { const f32x4 gv = ((const f32x4*)g)[F.lane + 64 * j]; const f32x4 o = v[j] * rstd * gv;
            if (OUTF32) ((f32x4*)((float*)outp + (size_t)m * DM))[F.lane + 64 * j] = o;
            else { u32x2 w; w.x = pk2(o[0], o[1]); w.y = pk2(o[2], o[3]); ((u32x2*)((bf16*)outp + (size_t)m * DM))[F.lane + 64 * j] = w; } }
    }
}
DI void unpack8(u32x4 w, float (&f)[8]) { f[0] = bflo(w.x); f[1] = bfhi(w.x); f[2] = bflo(w.y); f[3] = bfhi(w.y); f[4] = bflo(w.z); f[5] = bfhi(w.z); f[6] = bflo(w.w); f[7] = bfhi(w.w); }
DI u32x4 pack8f(const float (&f)[8]) { u32x4 o; o.x = pk2(f[0], f[1]); o.y = pk2(f[2], f[3]); o.z = pk2(f[4], f[5]); o.w = pk2(f[6], f[7]); return o; }

DI void ssd_conv_pass(const Frame& F0, const Args& A, int layer) {
    const Frame F = phase_frame(F0);
    const bf16* proj = (const bf16*)(F.ws + WS_PROJ); bf16* xbc = (bf16*)(F.ws + WS_XBC);
    const float* cw = (const float*)argin(A, 16) + (size_t)layer * 4 * SSD_XBC; const float* cb = (const float*)argin(A, 17) + (size_t)layer * SSD_XBC;
    const int gt = F.bid * NTHR + F.tid, NGT = F.G * NTHR;
    for (int task = gt; task < 512 * 384; task += NGT) {
        const int run = task / 384, cg = task - run * 384, ch = cg * 8, row0 = run * 32;
        float w[4][8], bs[8], xm3[8], xm2[8], xm1[8];
#pragma unroll
        for (int j = 0; j < 4; ++j) { const f32x4 a = *(const f32x4*)(cw + j * SSD_XBC + ch), b = *(const f32x4*)(cw + j * SSD_XBC + ch + 4);
            w[j][0] = a[0]; w[j][1] = a[1]; w[j][2] = a[2]; w[j][3] = a[3]; w[j][4] = b[0]; w[j][5] = b[1]; w[j][6] = b[2]; w[j][7] = b[3]; }
        { const f32x4 a = *(const f32x4*)(cb + ch), b = *(const f32x4*)(cb + ch + 4); bs[0] = a[0]; bs[1] = a[1]; bs[2] = a[2]; bs[3] = a[3]; bs[4] = b[0]; bs[5] = b[1]; bs[6] = b[2]; bs[7] = b[3]; }
        if ((row0 & (SEQ - 1)) != 0) {
            unpack8(*(const u32x4*)(proj + (size_t)(row0 - 3) * LDP + C_XBC + ch), xm3);
            unpack8(*(const u32x4*)(proj + (size_t)(row0 - 2) * LDP + C_XBC + ch), xm2);
            unpack8(*(const u32x4*)(proj + (size_t)(row0 - 1) * LDP + C_XBC + ch), xm1);
        } else {
#pragma unroll
            for (int k = 0; k < 8; ++k) { xm3[k] = 0.f; xm2[k] = 0.f; xm1[k] = 0.f; }
        }
#pragma unroll 4
        for (int r = 0; r < 32; ++r) {
            float cur[8], y[8]; unpack8(*(const u32x4*)(proj + (size_t)(row0 + r) * LDP + C_XBC + ch), cur);
#pragma unroll
            for (int k = 0; k < 8; ++k) { const float v = w[0][k] * xm3[k] + w[1][k] * xm2[k] + w[2][k] * xm1[k] + w[3][k] * cur[k] + bs[k]; y[k] = siluf_(v); xm3[k] = xm2[k]; xm2[k] = xm1[k]; xm1[k] = cur[k]; }
            *(u32x4*)(xbc + (size_t)(row0 + r) * SSD_XBC + ch) = pack8f(y);
        }
    }
    const float* dtb = (const float*)argin(A, 18) + layer * SSD_H; float* dt = (float*)(F.ws + WS_DT);
    for (int i = gt; i < M * SSD_H; i += NGT) { const int row = i >> 5, h = i & 31;
        const float x = bf2f(proj[(size_t)row * LDP + C_DT + h]) + dtb[h];
        dt[i] = fmaxf(x, 0.f) + log1pf(__expf(-fabsf(x))); }
}

DI void merge_pass(const Frame& F0, const Args& A, int layer) {
    const Frame F = phase_frame(F0);
    const bf16* proj = (const bf16*)(F.ws + WS_PROJ); const bf16* ya = (const bf16*)(F.ws + WS_YA); const bf16* yc = (const bf16*)(F.ws + WS_YC); bf16* hb = (bf16*)(F.ws + WS_HB);
    const float* sw = (const float*)argin(A, 15) + (size_t)layer * 3 * DM; const float* ngp = (const float*)argin(A, 21) + (size_t)layer * DM; const float* rstdp = (const float*)(F.ws + WS_RSTD);
    const int gt = F.bid * NTHR + F.tid, NGT = F.G * NTHR;
    for (int task = gt; task < 512 * 256; task += NGT) {
        const int run = task >> 8, cg = task & 255, ch = cg * 8, row0 = run * 32;
        float w[3][8], pm2[8], pm1[8], ng8[8];
        { const f32x4 a = *(const f32x4*)(ngp + ch), b = *(const f32x4*)(ngp + ch + 4); ng8[0] = a[0]; ng8[1] = a[1]; ng8[2] = a[2]; ng8[3] = a[3]; ng8[4] = b[0]; ng8[5] = b[1]; ng8[6] = b[2]; ng8[7] = b[3]; }
#pragma unroll
        for (int j = 0; j < 3; ++j) { const f32x4 a = *(const f32x4*)(sw + j * DM + ch), b = *(const f32x4*)(sw + j * DM + ch + 4);
            w[j][0] = a[0]; w[j][1] = a[1]; w[j][2] = a[2]; w[j][3] = a[3]; w[j][4] = b[0]; w[j][5] = b[1]; w[j][6] = b[2]; w[j][7] = b[3]; }
        if ((row0 & (SEQ - 1)) != 0) {
            float c1[8], u1[8];
            unpack8(*(const u32x4*)(proj + (size_t)(row0 - 2) * LDP + C_CC + ch), c1); unpack8(*(const u32x4*)(proj + (size_t)(row0 - 2) * LDP + C_CU + ch), u1);
#pragma unroll
            for (int k = 0; k < 8; ++k) pm2[k] = c1[k] * u1[k];
            unpack8(*(const u32x4*)(proj + (size_t)(row0 - 1) * LDP + C_CC + ch), c1); unpack8(*(const u32x4*)(proj + (size_t)(row0 - 1) * LDP + C_CU + ch), u1);
#pragma unroll
            for (int k = 0; k < 8; ++k) pm1[k] = c1[k] * u1[k];
        } else {
#pragma unroll
            for (int k = 0; k < 8; ++k) { pm2[k] = 0.f; pm1[k] = 0.f; }
        }
#pragma unroll 2
        for (int r = 0; r < 32; ++r) {
            const size_t pr = (size_t)(row0 + r) * LDP + ch, yr = (size_t)(row0 + r) * DM + ch;
            float cc[8], cu[8], cbv[8], g0[8], g1[8], g2[8], a[8], c[8], o[8];
            unpack8(*(const u32x4*)(proj + pr + C_CC), cc); unpack8(*(const u32x4*)(proj + pr + C_CU), cu); unpack8(*(const u32x4*)(proj + pr + C_CB), cbv);
            unpack8(*(const u32x4*)(proj + pr + C_GM), g0); unpack8(*(const u32x4*)(proj + pr + C_GM + DM), g1); unpack8(*(const u32x4*)(proj + pr + C_GM + 2 * DM), g2);
            unpack8(*(const u32x4*)(ya + yr), a); unpack8(*(const u32x4*)(yc + yr), c);
            const float rs = rstdp[(size_t)(row0 + r) * SSD_G + (ch >> 9)];
#pragma unroll
            for (int k = 0; k < 8; ++k) { const float pc = cc[k] * cu[k]; const float cv = w[0][k] * pm2[k] + w[1][k] * pm1[k] + w[2][k] * pc; pm2[k] = pm1[k]; pm1[k] = pc;
                o[k] = sigmoidf_(g0[k]) * a[k] + sigmoidf_(g1[k]) * (cbv[k] * cv) + sigmoidf_(g2[k]) * (c[k] * rs * ng8[k]); }
            *(u32x4*)(hb + yr) = pack8f(o);
        }
    }
}

DI void compress_phase(const Frame& F0, const Args& A, int layer) {
    const Frame F = phase_frame(F0);
    const bf16* proj = (const bf16*)(F.ws + WS_PROJ);
    LAS unsigned char* slab = F.lds;
    LAS unsigned char* hidl = F.lds + 73728;
    LAS float* b1s = (LAS float*)(F.lds + 81920);
    const int lane = F.lane, w = F.wave, i = lane & 15, qd = lane >> 4;
    const float* part = (const float*)(F.ws + WS_MISC);
    for (int u = F.bid; u < 512; u += F.G) {
        const int kv = u >> 8, b = (u >> 7) & 1, g = (u >> 5) & 3, nb = u & 31, n0 = nb * 16, tok0 = n0 * 16;
        const bf16* src = (const bf16*)(F.ws + WS_KV) + kv_off(kv, b, g, 0);
        for (int id = F.tid; id < 272 * 16; id += NTHR) { const int row = id >> 4, ch = id & 15, t = tok0 + row;
            u32x4 v = {0u, 0u, 0u, 0u}; if (t < SEQ) v = *(const u32x4*)(src + (size_t)t * HD + ch * 8);
            *(LAS u32x4*)(slab + off_b(row, ch)) = v; }
        if (F.tid < 128) { float s = ((const float*)argin(A, kv ? 12 : 8))[layer * 128 + F.tid];
#pragma unroll
            for (int c = 0; c < 8; ++c) s += part[(((size_t)layer * 2 + kv) * 8 + c) * 128 + F.tid];
            b1s[F.tid] = s; }
        __syncthreads();
        const bf16* w1t = (const bf16*)lw_ptr(F, layer, kv ? LW_PV1 : LW_PK1) + ((size_t)w * 128 * 64 + lane) * 8;
        f32x4 acc = {0.f, 0.f, 0.f, 0.f};
#if defined(SSD_IGLP)
        __builtin_amdgcn_iglp_opt(0);
#endif
        for (int k0 = 0; k0 < 128; k0 += 32) {
            bf16x8 bb[32];
#pragma unroll
            for (int k = 0; k < 32; ++k) bb[k] = *(const bf16x8*)(w1t + 512 * (k0 + k));
#pragma unroll
            for (int k = 0; k < 32; ++k) { const int ks = k0 + k;
                acc = MFMA16(lds_rd8(slab + off_b(16 * i + (ks >> 2), 4 * (ks & 3) + qd)), bb[k], acc); }
        }
        { const float bv = b1s[16 * w + i];
#pragma unroll
          for (int j = 0; j < 4; ++j) *(LAS bf16*)(hidl + (4 * qd + j) * 272 + (16 * w + i) * 2) = (bf16)f2bf(siluf_(acc[j] + bv)); }
        __syncthreads();
        const bf16* w2t = (const bf16*)lw_ptr(F, layer, kv ? LW_PV2 : LW_PK2) + (size_t)(16 * w + i) * 128 + 8 * qd;
        f32x4 acc2 = {0.f, 0.f, 0.f, 0.f};
#pragma unroll
        for (int s = 0; s < 4; ++s) {
            const bf16x8 a = lds_rd8(hidl + i * 272 + 64 * s + 16 * qd);
            const bf16x8 bb = *(const bf16x8*)(w2t + 32 * s);
            acc2 = MFMA16(a, bb, acc2);
        }
        const float b2 = ((const float*)argin(A, kv ? 14 : 10))[layer * 128 + 16 * w + i];
        bf16* dst = (bf16*)(F.ws + (kv ? WS_VCMP : WS_KCMP)) + ((size_t)(b * NG + g) * NCMP_PAD + n0) * HD + 16 * w + i;
#pragma unroll
        for (int j = 0; j < 4; ++j) dst[(size_t)(4 * qd + j) * HD] = (bf16)f2bf(acc2[j] + b2);
        __syncthreads();
    }
}

DI unsigned pk2_sw(float a, float b) {
    unsigned ua = __builtin_bit_cast(unsigned, a), ub = __builtin_bit_cast(unsigned, b);
    ua += 0x7FFFu + ((ua >> 16) & 1u); ub += 0x7FFFu + ((ub >> 16) & 1u);
    return (ua >> 16) | (ub & 0xFFFF0000u);
}
DI void ssd_states_phase(const Frame& F0, const Args& A, int layer) {
    const Frame F = phase_frame(F0);
    const bf16* xbc = (const bf16*)(F.ws + WS_XBC); const float* dt = (const float*)(F.ws + WS_DT);
    float* acs = (float*)(F.ws + WS_ACS); float* cdec = (float*)(F.ws + WS_CDEC); float* st = (float*)(F.ws + WS_ST);
    LAS unsigned char* Bt = F.lds; LAS unsigned char* Xt = F.lds + 32768; LAS float* sc = (LAS float*)(F.lds + 65536);
    const float* alog = (const float*)argin(A, 19) + layer * SSD_H;
    const int lane = F.lane, w = F.wave, i = lane & 15, qd = lane >> 4;
    for (int u = F.bid; u < 512; u += F.G) {
        const int b = u >> 8, c = (u >> 2) & 63, g = u & 3, row0 = b * SEQ + c * SSD_CH;
        {
            const int hh = g * 8 + w; const float a = -__expf(alog[hh]);
            const float dt0 = dt[(size_t)(row0 + 2 * lane) * SSD_H + hh], dt1 = dt[(size_t)(row0 + 2 * lane + 1) * SSD_H + hh];
            const float d0 = dt0 * a, d1 = dt1 * a, pair = d0 + d1; float s = pair;
#pragma unroll
            for (int o = 1; o < 64; o <<= 1) { const float t = shfl_idx(s, lane - o); if (lane >= o) s += t; }
            const float a0 = (s - pair) + d0, a1 = s, total = __builtin_bit_cast(float, __builtin_amdgcn_readlane(__builtin_bit_cast(int, s), 63));
            acs[(size_t)(row0 + 2 * lane) * SSD_H + hh] = a0; acs[(size_t)(row0 + 2 * lane + 1) * SSD_H + hh] = a1;
            sc[w * 128 + 2 * lane] = dt0 * __expf(total - a0); sc[w * 128 + 2 * lane + 1] = dt1 * __expf(total - a1);
            if (lane == 0) cdec[(size_t)(b * SSD_NC + c) * SSD_H + hh] = __expf(total);
        }
#if defined(S1_PRELOAD)
        u32x4 xr[4][4];
#pragma unroll
        for (int hp = 0; hp < 4; ++hp)
#pragma unroll
            for (int j = 0; j < 4; ++j) { const int id = F.tid + NTHR * j, row = id >> 4, ch = id & 15;
                xr[hp][j] = *(const u32x4*)(xbc + (size_t)(row0 + row) * SSD_XBC + g * 512 + hp * 128 + ch * 8); }
#pragma unroll
        for (int j = 0; j < 4; ++j) { const int id = F.tid + NTHR * j, row = id >> 4, ch = id & 15;
            *(LAS u32x4*)(Bt + off_b(row, ch)) = *(const u32x4*)(xbc + (size_t)(row0 + row) * SSD_XBC + 2048 + g * 128 + ch * 8); }
        __syncthreads();
        bf16x8 bfr[4];
#pragma unroll
        for (int ks = 0; ks < 4; ++ks) bfr[ks] = tr_read8(Bt, lane, 32 * ks, w);
#pragma unroll
        for (int hp = 0; hp < 4; ++hp) {
            LAS unsigned char* Xb = Xt + (hp & 1) * 32768 + ((hp & 1) ? 4096 : 0);
#pragma unroll
            for (int j = 0; j < 4; ++j) { const int id = F.tid + NTHR * j, row = id >> 4, ch = id & 15;
                float x[8]; unpack8(xr[hp][j], x);
                const float f = sc[(hp * 2 + (ch >> 3)) * 128 + row];
#pragma unroll
                for (int k = 0; k < 8; ++k) x[k] *= f;
                *(LAS u32x4*)(Xb + off_b(row, ch)) = pack8f(x); }
            __syncthreads();
#pragma unroll
            for (int h2 = 0; h2 < 2; ++h2) {
                const int head = g * 8 + hp * 2 + h2;
                float* dst = st + ((size_t)((b * SSD_NC + c) * SSD_H + head) * SSD_N + 16 * w + i) * SSD_P + 4 * qd;
#pragma unroll
                for (int pt = 0; pt < 4; ++pt) {
                    f32x4 acc = {0.f, 0.f, 0.f, 0.f};
#pragma unroll
                    for (int ks = 0; ks < 4; ++ks) acc = MFMA16(tr_read8(Xb, lane, 32 * ks, h2 * 4 + pt), bfr[ks], acc);
#if defined(ST_BF16)
                    { u32x2 o_; o_.x = pk2_sw(acc[0], acc[1]); o_.y = pk2_sw(acc[2], acc[3]); *(u32x2*)((bf16*)st + (size_t)(dst - st) + 16 * pt) = o_; }
#else
                    *(f32x4*)(dst + 16 * pt) = acc;
#endif
                }
            }
        }
#else
        for (int id = F.tid; id < 128 * 16; id += NTHR) { const int row = id >> 4, ch = id & 15;
            *(LAS u32x4*)(Bt + off_b(row, ch)) = *(const u32x4*)(xbc + (size_t)(row0 + row) * SSD_XBC + 2048 + g * 128 + ch * 8); }
        bf16x8 bfr[4];
        for (int hp = 0; hp < 4; ++hp) {
            __syncthreads();
            for (int id = F.tid; id < 128 * 16; id += NTHR) { const int row = id >> 4, ch = id & 15;
                float x[8]; unpack8(*(const u32x4*)(xbc + (size_t)(row0 + row) * SSD_XBC + g * 512 + hp * 128 + ch * 8), x);
                const float f = sc[(hp * 2 + (ch >> 3)) * 128 + row];
#pragma unroll
                for (int k = 0; k < 8; ++k) x[k] *= f;
                *(LAS u32x4*)(Xt + off_b(row, ch)) = pack8f(x); }
            __syncthreads();
            if (hp == 0) {
#pragma unroll
                for (int ks = 0; ks < 4; ++ks) bfr[ks] = tr_read8(Bt, lane, 32 * ks, w);
            }
#pragma unroll
            for (int h2 = 0; h2 < 2; ++h2) {
                const int head = g * 8 + hp * 2 + h2;
                float* dst = st + ((size_t)((b * SSD_NC + c) * SSD_H + head) * SSD_N + 16 * w + i) * SSD_P + 4 * qd;
#pragma unroll
                for (int pt = 0; pt < 4; ++pt) {
                    f32x4 acc = {0.f, 0.f, 0.f, 0.f};
#pragma unroll
                    for (int ks = 0; ks < 4; ++ks) acc = MFMA16(tr_read8(Xt, lane, 32 * ks, h2 * 4 + pt), bfr[ks], acc);
#if defined(ST_BF16)
                    { u32x2 o_; o_.x = pk2_sw(acc[0], acc[1]); o_.y = pk2_sw(acc[2], acc[3]); *(u32x2*)((bf16*)st + (size_t)(dst - st) + 16 * pt) = o_; }
#else
                    *(f32x4*)(dst + 16 * pt) = acc;
#endif
                }
            }
        }
#endif
        __syncthreads();
    }
}
DI void ssd_scan_phase(const Frame& F0) {
    const Frame F = phase_frame(F0);
    const f32x4* st = (const f32x4*)(F.ws + WS_ST); u32x2* hin = (u32x2*)(F.ws + WS_HIN); const float* cdec = (const float*)(F.ws + WS_CDEC);
    const int gt = F.bid * NTHR + F.tid, NGT = F.G * NTHR;
    for (int v = gt; v < BATCH * SSD_H * 2048; v += NGT) {
        const int b = v >> 16, h = (v >> 11) & 31, e = v & 2047;
        const size_t o0 = ((size_t)(b * SSD_NC) * SSD_H + h) * 2048 + e;
        const float* dc = cdec + (size_t)(b * SSD_NC) * SSD_H + h;
        f32x4 hs = {0.f, 0.f, 0.f, 0.f};
        for (int c0 = 0; c0 < SSD_NC; c0 += 8) {
            f32x4 s[8]; float d[8];
#pragma unroll
#if defined(ST_BF16)
            for (int k = 0; k < 8; ++k) { const u32x2 t_ = ((const u32x2*)st)[o0 + (size_t)(c0 + k) * 65536]; s[k][0] = bflo(t_.x); s[k][1] = bfhi(t_.x); s[k][2] = bflo(t_.y); s[k][3] = bfhi(t_.y); d[k] = dc[(c0 + k) * SSD_H]; }
#else
            for (int k = 0; k < 8; ++k) { s[k] = st[o0 + (size_t)(c0 + k) * 65536]; d[k] = dc[(c0 + k) * SSD_H]; }
#endif
#pragma unroll
            for (int k = 0; k < 8; ++k) { u32x2 o; o.x = pk2(hs[0], hs[1]); o.y = pk2(hs[2], hs[3]); hin[o0 + (size_t)(c0 + k) * 65536] = o; hs = hs * d[k] + s[k]; }
        }
    }
}
DI void ssd_out_phase(const Frame& F0, const Args& A, int layer) {
    const Frame F = phase_frame(F0);
    const bf16* xbc = (const bf16*)(F.ws + WS_XBC); const bf16* proj = (const bf16*)(F.ws + WS_PROJ);
    const float* dt = (const float*)(F.ws + WS_DT); const float* acs = (const float*)(F.ws + WS_ACS); const bf16* hin = (const bf16*)(F.ws + WS_HIN);
    bf16* yc = (bf16*)(F.ws + WS_YC); float* rstdp = (float*)(F.ws + WS_RSTD);
    LAS unsigned char* Bt = F.lds; LAS unsigned char* Ct = F.lds + 32768; LAS unsigned char* Xt = F.lds + 65536; LAS unsigned char* Ht = F.lds + 98304;
    LAS float* acsl = (LAS float*)(F.lds + LX_OFF);
    const float* dsk = (const float*)argin(A, 20) + layer * SSD_H;
    const int lane = F.lane, w = F.wave, i = lane & 15, qd = lane >> 4;
    for (int u = F.bid; u < 512; u += F.G) {
        const int b = u >> 8, c = (u >> 2) & 63, g = u & 3, row0 = b * SEQ + c * SSD_CH;
        for (int id = F.tid; id < 128 * 16; id += NTHR) { const int row = id >> 4, ch = id & 15; const bf16* src = xbc + (size_t)(row0 + row) * SSD_XBC + 2048 + g * 128 + ch * 8;
            *(LAS u32x4*)(Bt + off_b(row, ch)) = *(const u32x4*)(src); *(LAS u32x4*)(Ct + off_b(row, ch)) = *(const u32x4*)(src + 512); }
        __syncthreads();
        bf16x8 cfr[4];
#pragma unroll
        for (int ks = 0; ks < 4; ++ks) cfr[ks] = lds_rd8(Ct + off_b(16 * w + i, 4 * ks + qd));
        f32x4 cb[4][2];
#pragma unroll
        for (int k = 0; k < 4; ++k)
#pragma unroll
            for (int T = 0; T < 2; ++T) { f32x4 acc = {0.f, 0.f, 0.f, 0.f};
#pragma unroll
                for (int ks = 0; ks < 4; ++ks) acc = MFMA16(lds_rd8(Bt + off_b(32 * k + 8 * (i >> 2) + (i & 3) + 4 * T, 4 * ks + qd)), cfr[ks], acc);
                cb[k][T] = acc; }
        const int lrow = 16 * w + i, row = row0 + lrow;
        float ssq = 0.f;
#if defined(S3_PREFETCH)
        u32x4 px[4], ph[4]; float pd[4], pa = 0.f;
#define S3_PF_LOAD(HP) do { \
            if (F.tid < 256) { const int h2_ = F.tid >> 7, l_ = F.tid & 127; pa = acs[(size_t)(row0 + l_) * SSD_H + g * 8 + (HP) * 2 + h2_]; } \
            _Pragma("unroll") for (int j_ = 0; j_ < 4; ++j_) { const int id_ = F.tid + NTHR * j_, r_ = id_ >> 4, ch_ = id_ & 15, head_ = g * 8 + (HP) * 2 + (ch_ >> 3); \
                px[j_] = *(const u32x4*)(xbc + (size_t)(row0 + r_) * SSD_XBC + g * 512 + (HP) * 128 + ch_ * 8); pd[j_] = dt[(size_t)(row0 + r_) * SSD_H + head_]; \
                ph[j_] = *(const u32x4*)(hin + ((size_t)((b * SSD_NC + c) * SSD_H + head_) * SSD_N + r_) * SSD_P + (ch_ & 7) * 8); } } while (0)
        S3_PF_LOAD(0);
#endif
        for (int hp = 0; hp < 4; ++hp) {
            __syncthreads();
#if defined(S3_PREFETCH)
            if (F.tid < 256) acsl[F.tid] = pa;
#pragma unroll
            for (int j = 0; j < 4; ++j) { const int id = F.tid + NTHR * j, r = id >> 4, ch = id & 15;
                float x[8]; unpack8(px[j], x);
#pragma unroll
                for (int k = 0; k < 8; ++k) x[k] *= pd[j];
                *(LAS u32x4*)(Xt + off_b(r, ch)) = pack8f(x); *(LAS u32x4*)(Ht + off_b(r, ch)) = ph[j]; }
            __syncthreads();
            u32x2 xva[4], zva[4];
#pragma unroll
            for (int pt = 0; pt < 4; ++pt) { const int chn = (g * 8 + hp * 2) * SSD_P + 16 * pt + 4 * qd;
                xva[pt] = *(const u32x2*)(xbc + (size_t)row * SSD_XBC + chn); zva[pt] = *(const u32x2*)(proj + (size_t)row * LDP + C_Z + chn); }
            __builtin_amdgcn_sched_barrier(0);
            if (hp < 3) S3_PF_LOAD(hp + 1);
            __builtin_amdgcn_sched_barrier(0);
#else
            if (F.tid < 256) { const int h2 = F.tid >> 7, l = F.tid & 127; acsl[F.tid] = acs[(size_t)(row0 + l) * SSD_H + g * 8 + hp * 2 + h2]; }
            for (int id = F.tid; id < 128 * 16; id += NTHR) { const int r = id >> 4, ch = id & 15, head = g * 8 + hp * 2 + (ch >> 3);
                float x[8]; unpack8(*(const u32x4*)(xbc + (size_t)(row0 + r) * SSD_XBC + g * 512 + hp * 128 + ch * 8), x);
                const float f = dt[(size_t)(row0 + r) * SSD_H + head];
#pragma unroll
                for (int k = 0; k < 8; ++k) x[k] *= f;
                *(LAS u32x4*)(Xt + off_b(r, ch)) = pack8f(x);
                *(LAS u32x4*)(Ht + off_b(r, ch)) = *(const u32x4*)(hin + ((size_t)((b * SSD_NC + c) * SSD_H + head) * SSD_N + r) * SSD_P + (ch & 7) * 8); }
            __syncthreads();
#endif
#if defined(S3_PREFETCH)
#pragma unroll 1
#else
#pragma unroll
#endif
            for (int h2 = 0; h2 < 2; ++h2) {
                const int head = g * 8 + hp * 2 + h2;
#if defined(SSD_IGLP)
                __builtin_amdgcn_iglp_opt(0);
#endif
                const float al = acsl[h2 * 128 + lrow], ea = __expf(al), dsv = dsk[head];
#if defined(S3_PREFETCH)
                if (h2 == 1) {
#pragma unroll
                    for (int pt = 0; pt < 4; ++pt) { const int chn = head * SSD_P + 16 * pt + 4 * qd;
                        xva[pt] = *(const u32x2*)(xbc + (size_t)row * SSD_XBC + chn); zva[pt] = *(const u32x2*)(proj + (size_t)row * LDP + C_Z + chn); } }
#else
                u32x2 xv4[4], zv4[4];
#pragma unroll
                for (int pt = 0; pt < 4; ++pt) { const int chn = head * SSD_P + 16 * pt + 4 * qd;
                    xv4[pt] = *(const u32x2*)(xbc + (size_t)row * SSD_XBC + chn); zv4[pt] = *(const u32x2*)(proj + (size_t)row * LDP + C_Z + chn); }
#endif
                bf16x8 mfr[4];
#pragma unroll
                for (int k = 0; k < 4; ++k) {
                    const f32x4 a0 = *(const LAS f32x4*)(acsl + h2 * 128 + 32 * k + 8 * qd), a1 = *(const LAS f32x4*)(acsl + h2 * 128 + 32 * k + 8 * qd + 4);
                    float mv[8];
#pragma unroll
                    for (int j = 0; j < 4; ++j) { const int s0 = 32 * k + 8 * qd + j, s1 = s0 + 4;
                        mv[j] = (s0 <= lrow) ? cb[k][0][j] * __expf(al - a0[j]) : 0.f;
                        mv[4 + j] = (s1 <= lrow) ? cb[k][1][j] * __expf(al - a1[j]) : 0.f; }
                    mfr[k] = as_bf16x8(pack8f(mv));
                }
#pragma unroll
                for (int pt = 0; pt < 4; ++pt) {
                    f32x4 yd = {0.f, 0.f, 0.f, 0.f}, yo = {0.f, 0.f, 0.f, 0.f};
#pragma unroll
                    for (int k = 0; k < 4; ++k) yd = MFMA16(tr_read8(Xt, lane, 32 * k, h2 * 4 + pt), mfr[k], yd);
#pragma unroll
                    for (int ks = 0; ks < 4; ++ks) yo = MFMA16(tr_read8(Ht, lane, 32 * ks, h2 * 4 + pt), cfr[ks], yo);
                    const int chn = head * SSD_P + 16 * pt + 4 * qd;
#if defined(S3_PREFETCH)
                    const u32x2 xv = xva[pt], zv = zva[pt];
#else
                    const u32x2 xv = xv4[pt], zv = zv4[pt];
#endif
                    const float xs[4] = {bflo(xv.x), bfhi(xv.x), bflo(xv.y), bfhi(xv.y)}, zz[4] = {bflo(zv.x), bfhi(zv.x), bflo(zv.y), bfhi(zv.y)};
                    float gy[4];
#pragma unroll
                    for (int j = 0; j < 4; ++j) { const float y = yd[j] + ea * yo[j] + dsv * xs[j]; gy[j] = y * siluf_(zz[j]); ssq += gy[j] * gy[j]; }
                    u32x2 o; o.x = pk2(gy[0], gy[1]); o.y = pk2(gy[2], gy[3]);
                    *(u32x2*)(yc + (size_t)row * DM + chn) = o;
                }
            }
        }
        ssq += shx(ssq, 16, lane); ssq += shx(ssq, 32, lane);
        if (qd == 0) rstdp[(size_t)row * SSD_G + g] = 1.0f / sqrtf(ssq * (1.0f / 512.0f) + EPS);
        __syncthreads();
    }
}

#ifndef NSA_REP_PART
#define NSA_REP_PART 0
#endif
#if NSA_REP_PART == 7
#define W7DUP(x) x
#define W7WAIT() NSA_WAITV(8)
#else
#define W7DUP(x)
#define W7WAIT() NSA_WAITV(4)
#endif
#if NSA_REP_PART == 10
#define SELDUP(x) x
#else
#define SELDUP(x)
#endif
constexpr int RB = 32768, NRING = 3;
#define NSA_WAITV(n) asm volatile("s_waitcnt vmcnt(" #n ")" ::: "memory")
#define NSA_BAR() do { asm volatile("" ::: "memory"); __builtin_amdgcn_s_barrier(); asm volatile("" ::: "memory"); } while (0)
template <bool WITHV> DI void tile_dma(LAS unsigned char* buf, const bf16* kp, const bf16* vp, int pitch, int w, int lane) {
#pragma unroll
    for (int e = 0; e < 2; ++e) { const int kb = 2 * w + e, kh = kb >> 3, T = (kb >> 2) & 1, ks = kb & 3, i = lane & 15, qd = lane >> 4;
        const int key = 32 * kh + 8 * (i >> 2) + (i & 3) + 4 * T, ch = 4 * ks + qd;
        __builtin_amdgcn_global_load_lds((const unsigned*)(kp + (size_t)key * pitch + ch * 8), (LAS unsigned*)(buf + kb * 1024), 16, 0, 0); }
    if (WITHV) {
#pragma unroll
        for (int e = 0; e < 2; ++e) { const int vb = 2 * w + e, kh = vb >> 3, t = (vb >> 2) & 1, dtp = vb & 3, dtl = lane >> 5, g = (lane >> 3) & 3, q = (lane >> 1) & 3, ph = lane & 1;
            const int key = 32 * kh + 8 * g + 4 * t + q, ch = 4 * dtp + 2 * dtl + ph;
            __builtin_amdgcn_global_load_lds((const unsigned*)(vp + (size_t)key * pitch + ch * 8), (LAS unsigned*)(buf + 16384 + vb * 1024), 16, 0, 0); }
    }
}
#define NSA_TR8(r, addr, b) asm volatile("ds_read_b64_tr_b16 %0, %8 offset:%9\n\tds_read_b64_tr_b16 %1, %8 offset:%10\n\tds_read_b64_tr_b16 %2, %8 offset:%11\n\tds_read_b64_tr_b16 %3, %8 offset:%12\n\t" \
        "ds_read_b64_tr_b16 %4, %8 offset:%13\n\tds_read_b64_tr_b16 %5, %8 offset:%14\n\tds_read_b64_tr_b16 %6, %8 offset:%15\n\tds_read_b64_tr_b16 %7, %8 offset:%16" \
        : "=&v"(r[0]), "=&v"(r[1]), "=&v"(r[2]), "=&v"(r[3]), "=&v"(r[4]), "=&v"(r[5]), "=&v"(r[6]), "=&v"(r[7]) \
        : "v"(addr), "i"((b)), "i"((b) + 4096), "i"((b) + 512), "i"((b) + 4608), "i"((b) + 1024), "i"((b) + 5120), "i"((b) + 1536), "i"((b) + 5632) : "memory")
#define NSA_TRWAIT(r) asm volatile("s_waitcnt lgkmcnt(0)" : "+v"(r[0]), "+v"(r[1]), "+v"(r[2]), "+v"(r[3]), "+v"(r[4]), "+v"(r[5]), "+v"(r[6]), "+v"(r[7]) :: "memory")
#define NSA_TRWAIT8(r) asm volatile("s_waitcnt lgkmcnt(8)" : "+v"(r[0]), "+v"(r[1]), "+v"(r[2]), "+v"(r[3]), "+v"(r[4]), "+v"(r[5]), "+v"(r[6]), "+v"(r[7]) :: "memory")
#if defined(NSA_NO_SB)
#define NSA_SB()
#else
#define NSA_SB() __builtin_amdgcn_sched_barrier(0)
#endif
#if !defined(NSA_NO_SETPRIO)
#define NSA_PRIO(x) __builtin_amdgcn_s_setprio(x)
#else
#define NSA_PRIO(x)
#endif
#define NSA_PV4(r, kh, d0) do { NSA_PRIO(1); _Pragma("unroll") for (int q_ = 0; q_ < 4; ++q_) { const bf16x8 vf_ = __builtin_shufflevector(r[2 * q_], r[2 * q_ + 1], 0, 1, 2, 3, 4, 5, 6, 7); \
        if (SM & 1) O[0][(d0) + q_] = MFMA16(vf_, pf[0][kh], O[0][(d0) + q_]); if (SM & 2) O[1][(d0) + q_] = MFMA16(vf_, pf[1][kh], O[1][(d0) + q_]); } NSA_PRIO(0); } while (0)
template <int MODE, int SM>
DI void attn_tile(LAS const unsigned char* Kt, LAS const unsigned char* Vt, const bf16x8 (&Qf)[2][4], f32x4 (&O)[2][8], float (&m)[2], float (&l)[2], const int (&lo)[2], const int (&hi)[2], bool needmask,
                  float c2, const float (&inv_l)[2], LAS float* imp, const int (&ql)[2], int jb0, float (&cin)[2], int lane) {
    const int qd = lane >> 4;
    f32x4 sc[2][2][2];
#if !defined(NSA_NO_IGLP)
    __builtin_amdgcn_iglp_opt(0);
#endif
#pragma unroll
    for (int kh = 0; kh < 2; ++kh)
#pragma unroll
        for (int T = 0; T < 2; ++T) { f32x4 a0 = {0.f, 0.f, 0.f, 0.f}, a1 = {0.f, 0.f, 0.f, 0.f};
#pragma unroll
            for (int ks = 0; ks < 4; ++ks) { const bf16x8 kf = lds_rd8(Kt + (kh * 8 + T * 4 + ks) * 1024);
                if (SM & 1) a0 = MFMA16(kf, Qf[0][ks], a0); if (SM & 2) a1 = MFMA16(kf, Qf[1][ks], a1); }
            sc[0][kh][T] = a0; sc[1][kh][T] = a1; }
    const float NEG = -__builtin_inff();
    bf16x8 pf[2][2];
#pragma unroll
    for (int s = 0; s < 2; ++s) if (SM & (1 << s)) {
        if (needmask) {
#pragma unroll
            for (int kh = 0; kh < 2; ++kh)
#pragma unroll
                for (int T = 0; T < 2; ++T)
#pragma unroll
                    for (int j = 0; j < 4; ++j) { const int kk = 32 * kh + 8 * qd + 4 * T + j; if (kk < lo[s] || kk > hi[s]) sc[s][kh][T][j] = NEG; }
        }
        float mn = m[s];
        if (MODE != 2) {
            float tmax = fmaxf(fmaxf(sc[s][0][0][0], sc[s][0][0][1]), fmaxf(sc[s][0][0][2], sc[s][0][0][3]));
            tmax = fmaxf(tmax, fmaxf(fmaxf(sc[s][0][1][0], sc[s][0][1][1]), fmaxf(sc[s][0][1][2], sc[s][0][1][3])));
            tmax = fmaxf(tmax, fmaxf(fmaxf(sc[s][1][0][0], sc[s][1][0][1]), fmaxf(sc[s][1][0][2], sc[s][1][0][3])));
            tmax = fmaxf(tmax, fmaxf(fmaxf(sc[s][1][1][0], sc[s][1][1][1]), fmaxf(sc[s][1][1][2], sc[s][1][1][3])));
            tmax = xq_max(tmax);
            mn = fmaxf(m[s], tmax);
            if (__ballot(mn != m[s]) != 0ull) {
                const float alpha = __builtin_amdgcn_exp2f((m[s] - mn) * c2);
                l[s] *= alpha;
                if (MODE == 1) {
#pragma unroll
                    for (int dt = 0; dt < 8; ++dt) O[s][dt] = O[s][dt] * alpha;
                }
                m[s] = mn;
            }
        }
        const float nmc = -mn * c2; float ps = 0.f;
#pragma unroll
        for (int kh = 0; kh < 2; ++kh)
#pragma unroll
            for (int T = 0; T < 2; ++T)
#pragma unroll
                for (int j = 0; j < 4; ++j) { float p = __builtin_amdgcn_exp2f(__builtin_fmaf(sc[s][kh][T][j], c2, nmc)); if (MODE == 2) p *= inv_l[s]; sc[s][kh][T][j] = p; ps += p; }
        if (MODE != 2) l[s] += ps;
        if (MODE == 2) {
            float s4[2][2], cy[2][2];
#pragma unroll
            for (int kh = 0; kh < 2; ++kh)
#pragma unroll
                for (int T = 0; T < 2; ++T) {
                    float a = (sc[s][kh][T][0] + sc[s][kh][T][1]) + (sc[s][kh][T][2] + sc[s][kh][T][3]), c = sc[s][kh][T][3];
                    a = quad_sum(a); c = quad_sum(c);
                    s4[kh][T] = a; cy[kh][T] = c; }
            const float x0 = shfl_idx(cy[0][1], (lane - 16) & 63), x1 = shfl_idx(cy[1][1], (lane - 16) & 63);
            const float p00 = (qd == 0) ? cin[s] : x0, p10 = (qd == 0) ? x0 : x1;
            cin[s] = x1;
            if ((lane & 3) == 0) { const int jb = jb0 + 2 * qd;
                *(LAS f32x2*)(imp + ql[s] * 128 + jb) = (f32x2){s4[0][0] + p00, s4[0][1] + cy[0][0]};
                *(LAS f32x2*)(imp + ql[s] * 128 + jb + 8) = (f32x2){s4[1][0] + p10, s4[1][1] + cy[1][0]}; }
        }
        if (MODE != 0) {
#pragma unroll
            for (int kh = 0; kh < 2; ++kh) { u32x4 pw; pw.x = pk2(sc[s][kh][0][0], sc[s][kh][0][1]); pw.y = pk2(sc[s][kh][0][2], sc[s][kh][0][3]); pw.z = pk2(sc[s][kh][1][0], sc[s][kh][1][1]); pw.w = pk2(sc[s][kh][1][2], sc[s][kh][1][3]); pf[s][kh] = as_bf16x8(pw); }
        }
    }
    if (MODE != 0) {
        const unsigned va = (unsigned)(size_t)Vt;
        s16x4 ra[8], rb[8];
        NSA_TR8(ra, va, 0);     NSA_TR8(rb, va, 2048); NSA_SB();
        NSA_TRWAIT8(ra); NSA_SB(); NSA_PV4(ra, 0, 0); NSA_SB(); NSA_TR8(ra, va, 8192);  NSA_SB();
        NSA_TRWAIT8(rb); NSA_SB(); NSA_PV4(rb, 0, 4); NSA_SB(); NSA_TR8(rb, va, 10240); NSA_SB();
        NSA_TRWAIT8(ra); NSA_SB(); NSA_PV4(ra, 1, 0); NSA_SB();
        NSA_TRWAIT(rb);  NSA_SB(); NSA_PV4(rb, 1, 4);
    }
}
template <bool FIRST> DI void nsa_emit(const f32x4 (&O)[8], float scale, bf16* dst  ) {
    u32x2 old[8];
    if (!FIRST) {
#pragma unroll
        for (int dt = 0; dt < 8; ++dt) old[dt] = *(const u32x2*)(dst + 16 * dt);
    }
#pragma unroll
    for (int dt = 0; dt < 8; ++dt) { f32x4 v = O[dt] * scale;
        if (!FIRST) { v[0] += bflo(old[dt].x); v[1] += bfhi(old[dt].x); v[2] += bflo(old[dt].y); v[3] += bfhi(old[dt].y); }
        u32x2 o; o.x = pk2(v[0], v[1]); o.y = pk2(v[2], v[3]); *(u32x2*)(dst + 16 * dt) = o; }
}
DI int next_bit(unsigned u0, unsigned u1, unsigned u2, unsigned u3, int from) {
    if (from >= 128) return -1;
    const int wd = from >> 5; const unsigned msk = ~0u << (from & 31);
    const unsigned x0 = (wd == 0) ? (u0 & msk) : 0u;
    const unsigned x1 = (wd < 1) ? u1 : ((wd == 1) ? (u1 & msk) : 0u);
    const unsigned x2 = (wd < 2) ? u2 : ((wd == 2) ? (u2 & msk) : 0u);
    const unsigned x3 = (wd < 3) ? u3 : (u3 & msk);
    if (x0) return __builtin_ctz(x0);
    if (x1) return 32 + __builtin_ctz(x1);
    if (x2) return 64 + __builtin_ctz(x2);
    if (x3) return 96 + __builtin_ctz(x3);
    return -1;
}

DI void nsa_phase(const Frame& F0, const Args& A, int layer) {
    const Frame F = phase_frame(F0);
    const bf16* proj = (const bf16*)(F.ws + WS_PROJ); const bf16* kcmp = (const bf16*)(F.ws + WS_KCMP); const bf16* vcmp = (const bf16*)(F.ws + WS_VCMP);
    bf16* ya = (bf16*)(F.ws + WS_YA);
    LAS unsigned char* const RG = F.lds;
    LAS float* imp = (LAS float*)(F.lds + NRING * RB);
    LAS unsigned* selm = (LAS unsigned*)(F.lds + NRING * RB + 32768); LAS unsigned* uml = selm + 256;
    static_assert(NRING * RB + 32768 + 1024 + 16 <= LDSCTL_OFF && NRING * RB + 32768 == 4 * RB, "nsa LDS map (the selected loop's pair buffers overlay ring + importance table)");
    const float c2 = 0.08838834764831845f * 1.4426950408889634f;
    (void)A; (void)layer;
#if defined(NSA_PRIO)
    if (F.wave < 4) __builtin_amdgcn_s_setprio(2); else __builtin_amdgcn_s_setprio(0);
#endif
    for (int u = F.bid; u < 1024; u += F.G) {
        int tid_l = F.tid; asm volatile("" : "+v"(tid_l));
        const int tid = tid_l, lane = tid & 63, w = F.wave, i = lane & 15, qd = lane >> 4, hd = i & 3;
        const int klane = 16 * lane, vlane = 16384 + 8 * lane;
        const int xg = u & 7, jj = (u >> 3) & 31, rr = u >> 8;
        const int b = xg >> 2, g = xg & 3;
        const int qt = (rr == 0) ? 127 - jj : (rr == 1) ? 64 + jj : (rr == 2) ? 63 - jj : jj;
        const int s0 = qt * 64, cur = qt, rowb = b * SEQ;
        int ql[2], trow[2]; bf16x8 Qf[2][4];
#pragma unroll
        for (int s = 0; s < 2; ++s) { ql[s] = 8 * w + 4 * s + (i >> 2); trow[s] = rowb + s0 + ql[s];
#pragma unroll
            for (int ks = 0; ks < 4; ++ks) Qf[s][ks] = *(const bf16x8*)(proj + (size_t)trow[s] * LDP + C_Q + (4 * g + hd) * HD + 32 * ks + 8 * qd); }
        f32x4 O[2][8]; float mrow[2], lrow[2], cin[2], invl[2] = {0.f, 0.f};
        const int ntc = (4 * qt + 3 + 63) >> 6;
        const bf16* kc0 = kcmp + (size_t)(b * NG + g) * NCMP_PAD * HD; const bf16* vc0 = vcmp + (size_t)(b * NG + g) * NCMP_PAD * HD;
        int nmax[2];
#pragma unroll
        for (int s = 0; s < 2; ++s) { const int t = s0 + ql[s]; nmax[s] = (t >= 31) ? ((t - 31) >> 4) : -1; mrow[s] = -1e30f; lrow[s] = 0.f; cin[s] = 0.f; }
        for (int rep_ = 0; rep_ < (NSA_REP_PART == 2 ? 2 : 1); ++rep_) {
#pragma unroll
        for (int s = 0; s < 2; ++s) { mrow[s] = -1e30f; lrow[s] = 0.f; cin[s] = 0.f; }
        NSA_WAITV(0); NSA_BAR();
        tile_dma<false>(RG, kc0, vc0, HD, w, lane); if (ntc > 1) tile_dma<false>(RG + RB, kc0 + (size_t)64 * HD, vc0, HD, w, lane);
        for (int tc = 0, rb = 0; tc < ntc; ++tc) {
            if (tc + 1 < ntc) NSA_WAITV(2); else NSA_WAITV(0);
            NSA_BAR();
            if (tc + 2 < ntc) { const int nb2 = (rb + 2 >= NRING) ? rb + 2 - NRING : rb + 2; tile_dma<false>(RG + nb2 * RB, kc0 + (size_t)(tc + 2) * 64 * HD, vc0, HD, w, lane); }
            { const int lo2[2] = {0, 0}, hi2[2] = {nmax[0] - 64 * tc, nmax[1] - 64 * tc}; const bool nm = __ballot(hi2[0] < 63 || hi2[1] < 63) != 0ull;
              attn_tile<0, 3>(RG + rb * RB + klane, RG, Qf, O, mrow, lrow, lo2, hi2, nm, c2, invl, imp, ql, 0, cin, lane); }
            rb = (rb + 1 == NRING) ? 0 : rb + 1;
        }
#pragma unroll
        for (int s = 0; s < 2; ++s) { float lt = lrow[s]; lt = xq_sum(lt); invl[s] = (lt > 0.f) ? 1.0f / lt : 0.f;
#pragma unroll
            for (int dt = 0; dt < 8; ++dt) O[s][dt] = (f32x4){0.f, 0.f, 0.f, 0.f}; }
        NSA_BAR();
        tile_dma<true>(RG, kc0, vc0, HD, w, lane); if (ntc > 1) tile_dma<true>(RG + RB, kc0 + (size_t)64 * HD, vc0 + (size_t)64 * HD, HD, w, lane);
        for (int tc = 0, rb = 0; tc < ntc; ++tc) {
            if (tc + 1 < ntc) NSA_WAITV(4); else NSA_WAITV(0);
            NSA_BAR();
            if (tc + 2 < ntc) { const int nb2 = (rb + 2 >= NRING) ? rb + 2 - NRING : rb + 2; tile_dma<true>(RG + nb2 * RB, kc0 + (size_t)(tc + 2) * 64 * HD, vc0 + (size_t)(tc + 2) * 64 * HD, HD, w, lane); }
            { const int lo2[2] = {0, 0}, hi2[2] = {nmax[0] - 64 * tc, nmax[1] - 64 * tc}; const bool nm = __ballot(hi2[0] < 63 || hi2[1] < 63) != 0ull;
              attn_tile<2, 3>(RG + rb * RB + klane, RG + rb * RB + vlane, Qf, O, mrow, lrow, lo2, hi2, nm, c2, invl, imp, ql, 16 * tc, cin, lane); }
            rb = (rb + 1 == NRING) ? 0 : rb + 1;
        }
#pragma unroll
        for (int s = 0; s < 2; ++s) { const float gate = sigmoidf_(bf2f(proj[(size_t)trow[s] * LDP + C_GN + (4 * g + hd) * 3 + 0]));
            nsa_emit<true>(O[s], gate, ya + (size_t)trow[s] * DM + (4 * g + hd) * HD + 4 * qd); }
        }
        for (int rep_ = 0; rep_ < (NSA_REP_PART == 1 ? 2 : 1); ++rep_) {
            LDS_WAIT();
            const int nforced = (cur == 0) ? 1 : (cur == 1) ? 2 : 3; const int nsel = (cur + 1 < NSEL) ? cur + 1 : NSEL; const int R = nsel - nforced;
            const int E = (cur >= 3) ? cur - 2 : 0;
            for (int q8 = 0; q8 < 8; ++q8) {
                const int q = 8 * w + q8;
                const int j0 = lane, j1 = lane + 64;
                const bool e0 = (j0 >= 1) && (j0 <= cur - 2), e1 = (j1 <= cur - 2);
                const bool f0 = (j0 == 0) || (j0 == cur) || (j0 == cur - 1), f1 = (j1 == cur) || (j1 == cur - 1);
                bool s0 = e0, s1 = e1;
                if (R < E) {
                    const unsigned k0 = e0 ? __builtin_bit_cast(unsigned, imp[q * 128 + j0]) + 1u : 0u, k1 = e1 ? __builtin_bit_cast(unsigned, imp[q * 128 + j1]) + 1u : 0u;
                    unsigned T = 0u;
#pragma unroll 1
                    for (int bit = 30; bit >= 0; --bit) { const unsigned c = T | (1u << bit);
                        const int n = __builtin_popcountll(__ballot(k0 >= c)) + __builtin_popcountll(__ballot(k1 >= c));
                        if (n >= R) T = c; }
                    const unsigned long long eq0 = __ballot(k0 == T), eq1 = __ballot(k1 == T);
                    const int G = __builtin_popcountll(__ballot(k0 > T)) + __builtin_popcountll(__ballot(k1 > T));
                    const unsigned long long lt = (1ull << lane) - 1ull;
                    const int r0 = __builtin_popcountll(eq0 & lt), r1 = __builtin_popcountll(eq0) + __builtin_popcountll(eq1 & lt);
                    s0 = (k0 > T) || (k0 == T && r0 < R - G); s1 = (k1 > T) || (k1 == T && r1 < R - G);
                }
                const unsigned long long m0 = __ballot(f0 || s0), m1 = __ballot(f1 || s1);
                if (lane == 0) { selm[q * 4 + 0] = (unsigned)m0; selm[q * 4 + 1] = (unsigned)(m0 >> 32); selm[q * 4 + 2] = (unsigned)m1; selm[q * 4 + 3] = (unsigned)(m1 >> 32); }
            }
            __syncthreads();
            if (w == 0) { unsigned x0 = selm[lane * 4 + 0], x1 = selm[lane * 4 + 1], x2 = selm[lane * 4 + 2], x3 = selm[lane * 4 + 3];
#pragma unroll
                for (int o = 1; o < 64; o <<= 1) { x0 |= shfl_idx_u(x0, lane ^ o); x1 |= shfl_idx_u(x1, lane ^ o); x2 |= shfl_idx_u(x2, lane ^ o); x3 |= shfl_idx_u(x3, lane ^ o); }
                if (lane == 0) { uml[0] = x0; uml[1] = x1; uml[2] = x2; uml[3] = x3; } }
            __syncthreads();
        }
        const unsigned um0 = __builtin_amdgcn_readfirstlane(uml[0]), um1 = __builtin_amdgcn_readfirstlane(uml[1]), um2 = __builtin_amdgcn_readfirstlane(uml[2]), um3 = __builtin_amdgcn_readfirstlane(uml[3]);
        for (int rep_ = 0; rep_ < (NSA_REP_PART == 3 ? 2 : 1); ++rep_) {
            const bf16* ks0 = (const bf16*)(F.ws + WS_KV) + kv_off(2, b, g, 0); const bf16* vs0 = (const bf16*)(F.ws + WS_KV) + kv_off(3, b, g, 0);
#pragma unroll
            for (int s = 0; s < 2; ++s) { mrow[s] = -1e30f; lrow[s] = 0.f;
#pragma unroll
                for (int dt = 0; dt < 8; ++dt) O[s][dt] = (f32x4){0.f, 0.f, 0.f, 0.f}; }
#if NSA_REP_PART == 11
            {
            int jaD = next_bit(um0, um1, um2, um3, 0), jbD = next_bit(um0, um1, um2, um3, jaD + 1), pbD = 0;
            VM_WAIT(); if (NSA_REP_PART == 3) NSA_BAR();
            tile_dma<true>(RG, ks0 + (size_t)jaD * 64 * HD, vs0 + (size_t)jaD * 64 * HD, HD, w, lane); SELDUP(tile_dma<true>(RG, ks0 + (size_t)jaD * 64 * HD, vs0 + (size_t)jaD * 64 * HD, HD, w, lane);)
            if (jbD >= 0) tile_dma<true>(RG + RB, ks0 + (size_t)jbD * 64 * HD, vs0 + (size_t)jbD * 64 * HD, HD, w, lane); SELDUP(tile_dma<true>(RG + RB, ks0 + (size_t)jbD * 64 * HD, vs0 + (size_t)jbD * 64 * HD, HD, w, lane);)
            while (jaD >= 0) {
                const int jcD = (jbD >= 0) ? next_bit(um0, um1, um2, um3, jbD + 1) : -1, jdD = (jcD >= 0) ? next_bit(um0, um1, um2, um3, jcD + 1) : -1;
                NSA_WAITV(0);
                NSA_BAR();
                if (jcD >= 0) { LAS unsigned char* nb = RG + (pbD ^ 1) * 2 * RB; tile_dma<true>(nb, ks0 + (size_t)jcD * 64 * HD, vs0 + (size_t)jcD * 64 * HD, HD, w, lane); SELDUP(tile_dma<true>(nb, ks0 + (size_t)jcD * 64 * HD, vs0 + (size_t)jcD * 64 * HD, HD, w, lane);)
                    if (jdD >= 0) tile_dma<true>(nb + RB, ks0 + (size_t)jdD * 64 * HD, vs0 + (size_t)jdD * 64 * HD, HD, w, lane); SELDUP(tile_dma<true>(nb + RB, ks0 + (size_t)jdD * 64 * HD, vs0 + (size_t)jdD * 64 * HD, HD, w, lane);) }
                jaD = jcD; jbD = jdD; pbD ^= 1;
            }
            NSA_BAR();
            }
#endif
            int ja = next_bit(um0, um1, um2, um3, 0), jbb = next_bit(um0, um1, um2, um3, ja + 1), pbuf = 0;
            VM_WAIT(); if (NSA_REP_PART == 3) NSA_BAR();
            tile_dma<true>(RG, ks0 + (size_t)ja * 64 * HD, vs0 + (size_t)ja * 64 * HD, HD, w, lane); SELDUP(tile_dma<true>(RG, ks0 + (size_t)ja * 64 * HD, vs0 + (size_t)ja * 64 * HD, HD, w, lane);)
            if (jbb >= 0) tile_dma<true>(RG + RB, ks0 + (size_t)jbb * 64 * HD, vs0 + (size_t)jbb * 64 * HD, HD, w, lane); SELDUP(tile_dma<true>(RG + RB, ks0 + (size_t)jbb * 64 * HD, vs0 + (size_t)jbb * 64 * HD, HD, w, lane);)
            while (ja >= 0) {
                const int jc = (jbb >= 0) ? next_bit(um0, um1, um2, um3, jbb + 1) : -1, jd = (jc >= 0) ? next_bit(um0, um1, um2, um3, jc + 1) : -1;
                NSA_WAITV(0);
                NSA_BAR();
                if (jc >= 0) { LAS unsigned char* nb = RG + (pbuf ^ 1) * 2 * RB; tile_dma<true>(nb, ks0 + (size_t)jc * 64 * HD, vs0 + (size_t)jc * 64 * HD, HD, w, lane); SELDUP(tile_dma<true>(nb, ks0 + (size_t)jc * 64 * HD, vs0 + (size_t)jc * 64 * HD, HD, w, lane);)
                    if (jd >= 0) tile_dma<true>(nb + RB, ks0 + (size_t)jd * 64 * HD, vs0 + (size_t)jd * 64 * HD, HD, w, lane); SELDUP(tile_dma<true>(nb + RB, ks0 + (size_t)jd * 64 * HD, vs0 + (size_t)jd * 64 * HD, HD, w, lane);) }
#pragma unroll 1
                for (int e2 = 0; e2 < 2; ++e2) { const int jb = e2 ? jbb : ja; if (jb < 0) break;
                  const bool act0 = (selm[ql[0] * 4 + (jb >> 5)] >> (jb & 31)) & 1u, act1 = (selm[ql[1] * 4 + (jb >> 5)] >> (jb & 31)) & 1u;
                  const bool any0 = __ballot(act0) != 0ull, any1 = __ballot(act1) != 0ull;
                  const int lo2[2] = {0, 0}, hi2[2] = {act0 ? ((jb < cur) ? 63 : ql[0]) : -1, act1 ? ((jb < cur) ? 63 : ql[1]) : -1};
                  LAS const unsigned char* kt = RG + (pbuf * 2 + e2) * RB + klane; LAS const unsigned char* vt = RG + (pbuf * 2 + e2) * RB + vlane;
                  if (any0 && any1) { const bool nm = __ballot(hi2[0] < 63 || hi2[1] < 63) != 0ull; attn_tile<1, 3>(kt, vt, Qf, O, mrow, lrow, lo2, hi2, nm, c2, invl, imp, ql, 0, cin, lane); }
                  else if (any0) { const bool nm = __ballot(hi2[0] < 63) != 0ull; attn_tile<1, 1>(kt, vt, Qf, O, mrow, lrow, lo2, hi2, nm, c2, invl, imp, ql, 0, cin, lane); }
                  else if (any1) { const bool nm = __ballot(hi2[1] < 63) != 0ull; attn_tile<1, 2>(kt, vt, Qf, O, mrow, lrow, lo2, hi2, nm, c2, invl, imp, ql, 0, cin, lane); } }
                ja = jc; jbb = jd; pbuf ^= 1;
            }
            NSA_BAR();
#pragma unroll
            for (int s = 0; s < 2; ++s) { float lt = lrow[s]; lt = xq_sum(lt);
                const float gate = sigmoidf_(bf2f(proj[(size_t)trow[s] * LDP + C_GN + (4 * g + hd) * 3 + 1]));
                if (rep_ == 0) nsa_emit<false>(O[s], (lt > 0.f) ? gate / lt : 0.f, ya + (size_t)trow[s] * DM + (4 * g + hd) * HD + 4 * qd); }
        }
        for (int rep_ = 0; rep_ < (NSA_REP_PART == 4 ? 2 : 1); ++rep_) {
            const bf16* kw0 = (const bf16*)(F.ws + WS_KV) + kv_off(4, b, g, 0); const bf16* vw0 = (const bf16*)(F.ws + WS_KV) + kv_off(5, b, g, 0);
#pragma unroll
            for (int s = 0; s < 2; ++s) { mrow[s] = -1e30f; lrow[s] = 0.f;
#pragma unroll
                for (int dt = 0; dt < 8; ++dt) O[s][dt] = (f32x4){0.f, 0.f, 0.f, 0.f}; }
#if NSA_REP_PART == 8
            {
            const int tt0d = (qt >= 8) ? 0 : 8 - qt;
            VM_WAIT(); NSA_BAR();
            { const size_t r0 = (size_t)(s0 - 512 + 64 * tt0d) * HD; tile_dma<true>(RG, kw0 + r0, vw0 + r0, HD, w, lane); W7DUP(tile_dma<true>(RG, kw0 + r0, vw0 + r0, HD, w, lane);) }
            if (tt0d < 8) { const size_t r0 = (size_t)(s0 - 512 + 64 * (tt0d + 1)) * HD; tile_dma<true>(RG + RB, kw0 + r0, vw0 + r0, HD, w, lane); W7DUP(tile_dma<true>(RG + RB, kw0 + r0, vw0 + r0, HD, w, lane);) }
            for (int tt = tt0d, rb = 0; tt <= 8; ++tt) {
                if (tt < 8) { W7WAIT(); } else NSA_WAITV(0);
                NSA_BAR();
                if (tt + 2 <= 8) { const int nb2 = (rb + 2 >= NRING) ? rb + 2 - NRING : rb + 2; const size_t r0 = (size_t)(s0 - 512 + 64 * (tt + 2)) * HD; tile_dma<true>(RG + nb2 * RB, kw0 + r0, vw0 + r0, HD, w, lane); W7DUP(tile_dma<true>(RG + nb2 * RB, kw0 + r0, vw0 + r0, HD, w, lane);) }
                rb = (rb + 1 == NRING) ? 0 : rb + 1;
            }
            }
#endif
            const int tt0 = (qt >= 8) ? 0 : 8 - qt;
            VM_WAIT(); NSA_BAR();
            { const size_t r0 = (size_t)(s0 - 512 + 64 * tt0) * HD; tile_dma<true>(RG, kw0 + r0, vw0 + r0, HD, w, lane); W7DUP(tile_dma<true>(RG, kw0 + r0, vw0 + r0, HD, w, lane);) }
            if (tt0 < 8) { const size_t r0 = (size_t)(s0 - 512 + 64 * (tt0 + 1)) * HD; tile_dma<true>(RG + RB, kw0 + r0, vw0 + r0, HD, w, lane); W7DUP(tile_dma<true>(RG + RB, kw0 + r0, vw0 + r0, HD, w, lane);) }
            for (int tt = tt0, rb = 0; tt <= 8; ++tt) {
                if (tt < 8) { W7WAIT(); } else NSA_WAITV(0);
                NSA_BAR();
                if (tt + 2 <= 8) { const int nb2 = (rb + 2 >= NRING) ? rb + 2 - NRING : rb + 2; const size_t r0 = (size_t)(s0 - 512 + 64 * (tt + 2)) * HD; tile_dma<true>(RG + nb2 * RB, kw0 + r0, vw0 + r0, HD, w, lane); W7DUP(tile_dma<true>(RG + nb2 * RB, kw0 + r0, vw0 + r0, HD, w, lane);) }
                { const int lo2[2] = {(tt == 0) ? ql[0] + 1 : 0, (tt == 0) ? ql[1] + 1 : 0}, hi2[2] = {(tt == 8) ? ql[0] : 63, (tt == 8) ? ql[1] : 63};
                  attn_tile<1, 3>(RG + rb * RB + klane, RG + rb * RB + vlane, Qf, O, mrow, lrow, lo2, hi2, (tt == 0) || (tt == 8), c2, invl, imp, ql, 0, cin, lane);
#if NSA_REP_PART == 5
                  { const int him[2] = {-1, -1}; attn_tile<1, 3>(RG + rb * RB + klane, RG + rb * RB + vlane, Qf, O, mrow, lrow, lo2, him, true, c2, invl, imp, ql, 0, cin, lane); }
#endif
#if NSA_REP_PART == 6
                  NSA_BAR(); NSA_BAR(); NSA_BAR(); NSA_BAR();
#endif
                }
                rb = (rb + 1 == NRING) ? 0 : rb + 1;
            }
            VM_WAIT();
#pragma unroll
            for (int s = 0; s < 2; ++s) { float lt = lrow[s]; lt = xq_sum(lt);
                const float gate = sigmoidf_(bf2f(proj[(size_t)trow[s] * LDP + C_GN + (4 * g + hd) * 3 + 2]));
                if (rep_ == 0) nsa_emit<false>(O[s], (lt > 0.f) ? gate / lt : 0.f, ya + (size_t)trow[s] * DM + (4 * g + hd) * HD + 4 * qd); }
        }
        __syncthreads();
    }
    __builtin_amdgcn_s_setprio(0);
}

#if defined(CHECK_BUILD) && CHECK_BUILD
DI unsigned hash_u(unsigned x) { x ^= x >> 16; x *= 0x7feb352du; x ^= x >> 15; x *= 0x846ca68bu; x ^= x >> 16; return x; }
DI float blk_sum(float v, LAS float* red, int tid, int nthr) {
    for (int o = 32; o >= 1; o >>= 1) v += __shfl_xor(v, o);
    __syncthreads(); if ((tid & 63) == 0) red[tid >> 6] = v; __syncthreads();
    float s = 0.f; for (int k = 0; k < nthr / 64; ++k) s += red[k]; __syncthreads(); return s;
}
__global__ void chk_proj(Args args) {
    const int lane = threadIdx.x & 63, smp = blockIdx.x * (blockDim.x >> 6) + (threadIdx.x >> 6);
    const bf16* hb = (const bf16*)(args.ws + WS_HB); const bf16* proj = (const bf16*)(args.ws + WS_PROJ); const float* win = (const float*)args.in[4]; const int* pos = (const int*)args.in[2];
    unsigned* res = (unsigned*)(args.ws + WS_CTL) + CW_CHK;
    const unsigned h = hash_u(smp * 2654435761u + 12345u);
    int row = h % M; if (smp < 4) row = (smp == 0) ? 0 : (smp == 1) ? 8191 : (smp == 2) ? 8192 : 16383;
    const int kind = smp % 15; const unsigned h2 = hash_u(h + 77u);
    const int srcb[15] = {0, 2048, 2560, 3072, 3584, 4096, 4608, 5120, 5168, 7216, 9264, 11312, 13360, 16432, 16464};
    const int dstb[15] = {C_Q, C_KC, C_VC, C_KS, C_VS, C_KW, C_VW, C_GN, C_CB, C_CC, C_CU, C_Z, C_XBC, C_DT, C_GM};
    const int wid[15] = {2048, 512, 512, 512, 512, 512, 512, 48, 2048, 2048, 2048, 2048, 3072, 32, 6144};
    const bool rope = (kind == 0 || kind == 1 || kind == 3 || kind == 5);
    int e = h2 % wid[kind]; if (rope) e = (e / 128) * 128 + (e % 64);
    float d0 = 0.f, d1 = 0.f;
    for (int k = lane; k < DM; k += 64) { const float a = bf2f(hb[(size_t)row * DM + k]); d0 += a * win[(size_t)k * PROJ_SRC + srcb[kind] + e]; if (rope) d1 += a * win[(size_t)k * PROJ_SRC + srcb[kind] + e + 64]; }
    for (int o = 32; o >= 1; o >>= 1) { d0 += __shfl_xor(d0, o); d1 += __shfl_xor(d1, o); }
    float e0 = d0, e1 = d1;
    if (rope) { const double inv = exp(-(double)(2 * (e % 64)) / 128.0 * 9.210340371976184); double ang = (double)pos[row] * inv; ang -= 6.283185307179586476925 * __builtin_rint(ang * 0.15915494309189533577); const float c = cosf((float)ang), s = sinf((float)ang); e0 = d0 * c - d1 * s; e1 = d1 * c + d0 * s; }
    if (lane == 0) {
        const bf16* kvb = (const bf16*)(args.ws + WS_KV);
        const bool inkv = (kind >= 1 && kind <= 6);
        const bf16* src = inkv ? kvb + kv_off(kind - 1, row >> 13, e >> 7, row & 8191) + (e & 127) : proj + (size_t)row * LDP + dstb[kind] + e;
        const float g0 = bf2f(src[0]); float err = fabsf(g0 - e0) / (0.03f + 0.02f * fabsf(e0));
        if (rope) { const float g1 = bf2f(src[64]); err = fmaxf(err, fabsf(g1 - e1) / (0.03f + 0.02f * fabsf(e1))); }
        if (!(err <= 1.0f)) atomicAdd(res + 0, 1u);
        atomicMax(res + 1, __float_as_uint(fminf(err, 1e6f)));
    }
}
__global__ void chk_cmp(Args args) {
    __shared__ float hid[128];
    const int tid = threadIdx.x, smp = blockIdx.x;
    const unsigned h = hash_u(smp * 40503u + 99u);
    const int kv = smp & 1, b = (smp >> 1) & 1, g = (smp >> 2) & 3; int n = h % NCMP; if (smp < 8) n = (smp < 4) ? 0 : 510;
    const bf16* proj = (const bf16*)(args.ws + WS_PROJ);
    const float* pe = (const float*)args.in[kv ? 6 : 5]; const float* w1 = (const float*)args.in[kv ? 11 : 7]; const float* b1 = (const float*)args.in[kv ? 12 : 8];
    const float* w2 = (const float*)args.in[kv ? 13 : 9]; const float* b2 = (const float*)args.in[kv ? 14 : 10];
    const bf16* out = (const bf16*)(args.ws + (kv ? WS_VCMP : WS_KCMP));
    unsigned* res = (unsigned*)(args.ws + WS_CTL) + CW_CHK;
    float s = b1[tid];
    for (int l = 0; l < 32; ++l) { const bf16* kr = (const bf16*)(args.ws + WS_KV) + kv_off(kv, b, g, 16 * n + l);
        for (int d = 0; d < 128; ++d) s += (bf2f(kr[d]) + pe[l * 128 + d]) * w1[(size_t)(l * 128 + d) * 128 + tid]; }
    hid[tid] = s / (1.0f + expf(-s));
    __syncthreads();
    float o = b2[tid];
    for (int k = 0; k < 128; ++k) o += hid[k] * w2[k * 128 + tid];
    const float got = bf2f(out[((size_t)(b * NG + g) * NCMP_PAD + n) * HD + tid]);
    const float err = fabsf(got - o) / (0.02f + 0.02f * fabsf(o));
    if (!(err <= 1.0f)) atomicAdd(res + 2, 1u);
    atomicMax(res + 3, __float_as_uint(fminf(err, 1e6f)));
}
constexpr int CHK_NT = 24;
__global__ void __launch_bounds__(256) chk_nsa(Args args) {
    __shared__ float qf[4][128], oacc[4][128], obr[4][128], sc[4][1024], imp[128], red[8];
    __shared__ int kl[1024], seln[16], usedl[128];
    const int tlist[CHK_NT] = {0, 1, 30, 31, 47, 63, 64, 65, 127, 128, 500, 511, 512, 513, 575, 1023, 1024, 1087, 2000, 4095, 4096, 6000, 8128, 8191};
    const int tid = threadIdx.x, smp = blockIdx.x;
    const int t = tlist[smp % CHK_NT], bg = (smp / CHK_NT + smp) & 7, b = bg >> 2, g = bg & 3, row = b * SEQ + t, cur = t >> 6;
    const bf16* proj = (const bf16*)(args.ws + WS_PROJ); const bf16* kcmp = (const bf16*)(args.ws + WS_KCMP) + (size_t)(b * NG + g) * NCMP_PAD * HD; const bf16* vcmp = (const bf16*)(args.ws + WS_VCMP) + (size_t)(b * NG + g) * NCMP_PAD * HD;
    const bf16* ya = (const bf16*)(args.ws + WS_YA);
    unsigned* res = (unsigned*)(args.ws + WS_CTL) + CW_CHK;
    const float scale = 0.08838834764831845f;
    for (int k = tid; k < 512; k += 256) { const int r = k >> 7, d = k & 127; qf[r][d] = bf2f(proj[(size_t)row * LDP + C_Q + (4 * g + r) * HD + d]); oacc[r][d] = 0.f; }
    __syncthreads();
    for (int br = 0; br < 3; ++br) {
        int nk = 0;
        if (br == 0) { nk = (t >= 31) ? ((t - 31) >> 4) + 1 : 0; for (int k = tid; k < nk; k += 256) kl[k] = k; }
        else if (br == 1) {
            if (tid == 0) {
                for (int j = 0; j < 128; ++j) usedl[j] = 0;
                for (int it = 0; it < 16; ++it) { int best = -1; float bv = 0.f;
                    for (int j = 0; j < 128; ++j) { if (usedl[j]) continue; const bool valid = (64 * j <= t); const bool forced = (j == 0) || (j == cur) || (j == cur - 1);
                        const float v = valid ? imp[j] + (forced ? 1.0e4f : 0.f) : -__builtin_inff();
                        if (best < 0 || v > bv) { best = j; bv = v; } }
                    usedl[best] = 1; seln[it] = best; } }
            __syncthreads();
            for (int k = tid; k < 1024; k += 256) kl[k] = seln[k >> 6] * 64 + (k & 63);
            nk = 1024;
        } else { nk = 576; for (int k = tid; k < 576; k += 256) kl[k] = (t & ~63) - WIN + k; }
        __syncthreads();
        for (int idx = tid; idx < 4 * nk; idx += 256) { const int r = idx / nk, k = idx - r * nk, key = kl[k];
            bool ok; const bf16* kp;
            if (br == 0) { ok = true; kp = kcmp + (size_t)key * HD; }
            else if (br == 1) { ok = (key <= t); kp = (const bf16*)(args.ws + WS_KV) + kv_off(2, b, g, key); }
            else { ok = (key >= 0) && (key <= t) && (key > t - WIN); kp = (const bf16*)(args.ws + WS_KV) + kv_off(4, b, g, key < 0 ? 0 : key); }
            float s = 0.f; for (int d = 0; d < 128; ++d) s += qf[r][d] * bf2f(kp[d]);
            sc[r][k] = ok ? s * scale : -__builtin_inff(); }
        __syncthreads();
        if (tid < 4) { float m = -__builtin_inff(); for (int k = 0; k < nk; ++k) m = fmaxf(m, sc[tid][k]);
            const float mm = (m > -1e30f) ? m : 0.f; float l = 0.f; for (int k = 0; k < nk; ++k) { const float e = (sc[tid][k] > -1e30f) ? expf(sc[tid][k] - mm) : 0.f; sc[tid][k] = e; l += e; }
            const float il = (l > 0.f) ? 1.0f / l : 0.f; for (int k = 0; k < nk; ++k) sc[tid][k] *= il; }
        __syncthreads();
        if (br == 0) { if (tid < 128) { float s = 0.f; for (int r = 0; r < 4; ++r) for (int n = 4 * tid - 1; n <= 4 * tid + 3; ++n) if (n >= 0 && n < nk) s += sc[r][n]; imp[tid] = s; } }
        for (int o = tid; o < 512; o += 256) { const int r = o >> 7, d = o & 127; float s = 0.f;
            for (int k = 0; k < nk; ++k) { const float p = sc[r][k]; if (p == 0.f) continue; const int key = kl[k];
                const bf16* vp = (br == 0) ? vcmp + (size_t)key * HD : (const bf16*)(args.ws + WS_KV) + kv_off(br == 1 ? 3 : 5, b, g, key);
                s += p * bf2f(vp[d]); }
            const float gate = 1.0f / (1.0f + expf(-bf2f(proj[(size_t)row * LDP + C_GN + (4 * g + r) * 3 + br])));
            oacc[r][d] += gate * s; obr[r][d] = s; }
        __syncthreads();
    }
    float errm = 0.f;
    for (int o = tid; o < 512; o += 256) { const int r = o >> 7, d = o & 127; const float got = bf2f(ya[(size_t)row * DM + (4 * g + r) * HD + d]), ex = oacc[r][d] * (CHECK_BUILD == 2 ? ((smp & 1) ? 1.5f : 1.0f) : 1.0f);
        errm = fmaxf(errm, fabsf(got - ex) / (0.006f + 0.03f * fabsf(ex))); }
    for (int o = 32; o >= 1; o >>= 1) errm = fmaxf(errm, __shfl_xor(errm, o));
    if ((tid & 63) == 0) red[tid >> 6] = errm;
    __syncthreads();
    if (tid == 0) { const float e = fmaxf(fmaxf(red[0], red[1]), fmaxf(red[2], red[3])); if (!(e <= 1.0f)) atomicAdd(res + 4, 1u); atomicMax(res + 5, __float_as_uint(fminf(e, 1e6f))); }
}
#ifndef CHK_B_SEL
#define CHK_B_SEL 5
#endif
__global__ void chk_report(Args args) {
    const unsigned* res = (const unsigned*)(args.ws + WS_CTL) + CW_CHK;
    const float A = 4.0f * (float)res[4] + (res[2] ? 2000.f : 0.f) + (res[0] ? 40000.f : 0.f);
    const float B = fminf(__uint_as_float(res[CHK_B_SEL]), 100.f);
    const size_t i = (size_t)blockIdx.x * blockDim.x + threadIdx.x;
    if (A > 0.f) { if (i == 0) args.out[0] += A; if (i >= 1 && i <= (1u << 20)) args.out[i] += B; }
}
#endif

constexpr int NPH_LAYER = 13, NPH = 2 + NPH_LAYER * DEPTH;
#ifndef PG8_SP2
#define PG8_SP2 true
#endif
#ifndef PG8_ALIGN
#define PG8_ALIGN true
#endif
#ifndef PH_MASK
#define PH_MASK 0xFFFFFFFFu
#endif
#ifndef REP_MASK
#define REP_MASK 0u
#endif
#ifndef REP_CNT
#define REP_CNT 2
#endif
#define REPN(kk) ((((unsigned)REP_MASK >> (kk)) & 1u) ? REP_CNT : 1)
#define INK(k, kk) (((PH_MASK >> (kk)) & 1u) && lo <= (k) && (k) < hi)
#if defined(TIME_PROBE)
#define STAMP(i) do { if (F.bid == 0 && F.tid == 0) ((unsigned long long*)(F.ctl + CW_TS))[i] = __builtin_amdgcn_s_memrealtime(); } while (0)
#else
#define STAMP(i) do { } while (0)
#endif
#if defined(BAR_TWICE)
#define SEAM_TWICE(x) x
#else
#define SEAM_TWICE(x)
#endif
#define SEAM(k) do { if (lo <= (k) && (k) + 1 < hi) { XcdBarrier b_ = bar; { unsigned long long p_ = (unsigned long long)bar.bar; asm volatile("" : "+s"(p_)); b_.bar = (unsigned*)p_; } xcd_barrier(b_); SEAM_TWICE(xcd_barrier(b_);) } STAMP((k) + 1); } while (0)
template <int LAYER> DI void g1_block(const Frame& F, const Args& args) {
    constexpr int layer = LAYER;
    bf16* hb = (bf16*)(F.ws + WS_HB); bf16* projb = (bf16*)(F.ws + WS_PROJ); bf16* eb = (bf16*)(F.ws + WS_EB);
#ifndef NO_G1
            { const Frame Fp = phase_frame(F);  pg8::Gemm g{hb, (const bf16*)lw_ptr(Fp, layer, LW_IN), M, LDP, DM}; pg8::StaticOrder S; S.init(M, LDP, Fp.G, Fp.bid);
              pg8::EpiB<2> E{projb, LDP, (const float*)(Fp.ws + WS_ROPE), (bf16*)(Fp.ws + WS_KV)};
              pg8::gemm_phase<pg8::EpiB<2>, pg8::StaticOrder, PG8_ALIGN, PG8_SP2>(Fp.lds, g, S, E, Fp.wave); }
#endif
#ifndef NO_G5
            { const Frame Fp = phase_frame(F);  pg8::Gemm g{(const bf16*)(Fp.ws + WS_PB) + (size_t)layer * M * PLE, (const bf16*)lw_ptr(Fp, layer, LW_PLE), M, DM, PLE}; pg8::LightOrder S; S.init(M, DM, Fp.G, Fp.bid);
              pg8::EpiB<0> E{eb, DM, nullptr, nullptr};
              pg8::gemm_phase<pg8::EpiB<0>, pg8::LightOrder, PG8_ALIGN, PG8_SP2>(Fp.lds, g, S, E, Fp.wave); }
#endif
}
template <int LAYER> DI void layer_phases(const Frame& F, const Args& args, const XcdBarrier& bar, const int lo, const int hi) {
    constexpr int layer = LAYER, layer_ = LAYER;
    float* xres = (float*)(F.ws + WS_X); bf16* hb = (bf16*)(F.ws + WS_HB); bf16* projb = (bf16*)(F.ws + WS_PROJ); bf16* ub = (bf16*)(F.ws + WS_U); bf16* eb = (bf16*)(F.ws + WS_EB);
        const int pb = 1 + NPH_LAYER * layer;
        const float* xin = (layer == 0) ? (const float*)argin(args, 0) : (const float*)xres;
        if (INK(pb + 0, 0)) { if (layer == 0) norm_rows<false>(F, xin, (const float*)argin(args, 3), hb);
                              else addnorm_rows<false>(F, xres, (const bf16*)(F.ws + WS_DELTA), (const float*)argin(args, 3) + (size_t)layer * DM, xres, hb); }
        SEAM(pb + 0);
        if (INK(pb + 1, 1)) { g1_block<LAYER>(F, args); if (REPN(1) >= 2) g1_block<LAYER>(F, args); }
        SEAM(pb + 1);
        if (INK(pb + 2, 2)) for (int rep = 0; rep < REPN(2); ++rep) { ssd_conv_pass(F, args, layer); compress_phase(F, args, layer); }
        SEAM(pb + 2);
        if (INK(pb + 3, 3)) for (int rep = 0; rep < REPN(3); ++rep) ssd_states_phase(F, args, layer);
        SEAM(pb + 3);
        if (INK(pb + 4, 4)) ssd_scan_phase(F);
        SEAM(pb + 4);
        if (INK(pb + 5, 5)) {
#ifndef NO_S3
            for (int rep = 0; rep < REPN(15); ++rep) ssd_out_phase(F, args, layer);
#endif
            STAMP(60 + layer);
#ifndef NO_NSA
            for (int rep = 0; rep < REPN(5); ++rep) nsa_phase(F, args, layer);
#endif
        }
        SEAM(pb + 5);
        if (INK(pb + 6, 6)) for (int rep = 0; rep < REPN(6); ++rep) merge_pass(F, args, layer);
        SEAM(pb + 6);
        if (INK(pb + 7, 7)) for (int rep = 0; rep < REPN(7); ++rep) { const Frame Fp = phase_frame(F);  pg8::Gemm g{hb, (const bf16*)lw_ptr(Fp, layer, LW_O), M, DM, DM}; pg8::StaticOrder S; S.init(M, DM, Fp.G, Fp.bid);
            pg8::EpiB<0> E{(bf16*)(Fp.ws + WS_DELTA), DM, nullptr, nullptr};
            pg8::gemm_phase<pg8::EpiB<0>, pg8::StaticOrder, PG8_ALIGN, PG8_SP2>(Fp.lds, g, S, E, Fp.wave); }
        SEAM(pb + 7);
        if (INK(pb + 8, 8)) for (int rep = 0; rep < REPN(8); ++rep) addnorm_rows<false>(F, xin, (const bf16*)(F.ws + WS_DELTA), (const float*)argin(args, 23) + (size_t)layer * DM, rep ? (float*)(F.ws + WS_ST) : xres, rep ? (bf16*)(F.ws + WS_ST + 128 * MiB - 64 * MiB) : hb);
        SEAM(pb + 8);
        if (INK(pb + 9, 9)) for (int rep = 0; rep < REPN(9); ++rep) { const Frame Fp = phase_frame(F);  pg8::Gemm g{hb, (const bf16*)lw_ptr(Fp, layer, LW_UP), M, DFF, DM}; pg8::StaticOrder S; S.init(M, DFF, Fp.G, Fp.bid);
            pg8::EpiB<1> E{ub, DFF, nullptr, nullptr};
            pg8::gemm_phase<pg8::EpiB<1>, pg8::StaticOrder, PG8_ALIGN, PG8_SP2>(Fp.lds, g, S, E, Fp.wave); }
        SEAM(pb + 9);
        if (INK(pb + 10, 10)) for (int rep = 0; rep < REPN(10); ++rep) { const Frame Fp = phase_frame(F);  pg8::Gemm g{ub, (const bf16*)lw_ptr(Fp, layer, LW_DOWN), M, DM, DFF}; pg8::StaticOrder S; S.init(M, DM, Fp.G, Fp.bid);
            pg8::EpiB<0> E{(bf16*)(Fp.ws + WS_DELTA), DM, nullptr, nullptr};
            pg8::gemm_phase<pg8::EpiB<0>, pg8::StaticOrder, PG8_ALIGN, PG8_SP2>(Fp.lds, g, S, E, Fp.wave); }
        SEAM(pb + 10);
        if (INK(pb + 11, 11)) addnorm_rows<false>(F, xres, (const bf16*)(F.ws + WS_DELTA), (const float*)argin(args, 26) + (size_t)layer * DM, xres, hb);
        SEAM(pb + 11);
        if (INK(pb + 12, 12)) for (int rep = 0; rep < REPN(12); ++rep) { const Frame Fp = phase_frame(F);  pg8::Gemm g{hb, (const bf16*)lw_ptr(Fp, layer, LW_PG), M, DM, DM}; pg8::StaticOrder S; S.init(M, DM, Fp.G, Fp.bid);
            pg8::EpiB<3> E{(bf16*)(Fp.ws + WS_DELTA), DM, (const float*)eb, nullptr};
            pg8::gemm_phase<pg8::EpiB<3>, pg8::StaticOrder, PG8_ALIGN, PG8_SP2>(Fp.lds, g, S, E, Fp.wave); }
        SEAM(pb + 12);
}
__global__ void __launch_bounds__(NTHR, 2) hyb_fwd(Args args) {
    extern __shared__ __attribute__((aligned(16))) unsigned char lds_raw[];
    Frame F;
    F.lds = (LAS unsigned char*)lds_raw; F.ws = args.ws; F.ctl = (gu32*)(args.ws + WS_CTL);
    F.tid = threadIdx.x; F.lane = F.tid & 63; F.wave = __builtin_amdgcn_readfirstlane(threadIdx.x >> 6); F.G = gridDim.x; F.bid = blockIdx.x;
    const int lo = args.ph_lo, hi = args.ph_hi;
    if (F.tid < 64) ((LAS unsigned*)(F.lds + LDSCTL_OFF))[F.tid] = 0u;
    __syncthreads();
    XcdBarrier bar; bar.bar = (unsigned*)(F.ctl + CW_BAR); bar.x = 0; bar.st = (volatile LAS unsigned*)(F.lds + LDSCTL_OFF);
    if (hi - lo > 1) bar = xcd_barrier_post((unsigned*)(F.ctl + CW_BAR), (volatile LAS unsigned*)(F.lds + LDSCTL_OFF));
    STAMP(0);
    if (INK(0, 13)) for (int rep = 0; rep < REPN(13); ++rep) p0_prologue(F, args);
    SEAM(0);
    layer_phases<0>(F, args, bar, lo, hi); layer_phases<1>(F, args, bar, lo, hi); layer_phases<2>(F, args, bar, lo, hi); layer_phases<3>(F, args, bar, lo, hi);
    float* xres = (float*)(F.ws + WS_X);
    int hi_l = hi; asm volatile("" : "+s"(hi_l));
    if (((PH_MASK >> 14) & 1u) && lo <= NPH - 1 && NPH - 1 < hi_l) addnorm_rows<true>(F, xres, (const bf16*)(F.ws + WS_DELTA), (const float*)argin(args, 29), nullptr, args.out);
#if defined(TIME_PROBE)
    { XcdBarrier b_ = bar; xcd_barrier(b_); STAMP(NPH);
      if (F.bid == 0) {
        LAS float* ab = (LAS float*)(F.lds);
        if (F.tid == 0) { const unsigned long long* ts = (const unsigned long long*)(F.ctl + CW_TS); float sum[17];
            float sA = 0.f, sB = 0.f;
            for (int ph = 0; ph < NPH; ++ph) { int kind = (ph == 0) ? 13 : (ph == NPH - 1) ? 14 : (ph - 1) % NPH_LAYER; float d = (float)(ts[ph + 1] - ts[ph]) * 0.01f;
                if (kind == 5) { const int L = (ph - 1) / NPH_LAYER; const float d3 = (float)(ts[60 + L] - ts[ph]) * 0.01f; if (TIME_PROBE_A == 15) sA += d3; if (TIME_PROBE_B == 15) sB += d3; d -= d3; }
                if (kind == TIME_PROBE_A || (TIME_PROBE_A == 16 && (kind == 0 || kind == 8 || kind == 11))) sA += d;
                if (kind == TIME_PROBE_B || (TIME_PROBE_B == 16 && (kind == 0 || kind == 8 || kind == 11))) sB += d; }
            ab[0] = sA; ab[1] = sB * 0.01f; (void)sum; }
        __syncthreads();
        const float A = ab[0], B = ab[1];
        if (F.tid == 0) args.out[0] += A;
        for (int j = 0; j < 2048; ++j) args.out[1 + F.tid + NTHR * j] += B;
      } }
#endif
#undef INK
#undef SEAM
}

#ifndef MK_ONE_LAUNCH
#define MK_ONE_LAUNCH 1
#endif
extern "C" void kernel_launch(void* const* d_in, const int* in_sizes, int n_in, void* d_out, int out_size, void* d_ws, size_t ws_size, hipStream_t stream) {
    static int grid = 0;
    if (grid == 0) {
        if (n_in != 30 || out_size != M * DM || ws_size < WS_END) { fprintf(stderr, "kernel_launch: unexpected shapes (n_in %d out %d ws %zu need %zu)\n", n_in, out_size, ws_size, (size_t)WS_END); grid = -1; return; }
        int dev = 0, cus = 0, per_cu = 0;
        if (hipGetDevice(&dev) != hipSuccess || hipDeviceGetAttribute(&cus, hipDeviceAttributeMultiprocessorCount, dev) != hipSuccess) { grid = -1; return; }
        if (hipFuncSetAttribute((const void*)hyb_fwd, hipFuncAttributeMaxDynamicSharedMemorySize, LDS_BYTES) != hipSuccess) { fprintf(stderr, "kernel_launch: hipFuncSetAttribute failed\n"); grid = -1; return; }
        if (hipOccupancyMaxActiveBlocksPerMultiprocessor(&per_cu, (const void*)hyb_fwd, NTHR, LDS_BYTES) != hipSuccess || per_cu < 1) { fprintf(stderr, "kernel_launch: occupancy query says %d\n", per_cu); }
        (void)hipGetLastError();
        grid = cus;
    }
    if (grid < 0) return;
    (void)hipMemsetAsync((char*)d_ws + WS_CTL, 0, CTL_ZERO_BYTES, stream);
    Args a{};
    for (int i = 0; i < 30; ++i) a.in[i] = d_in[i];
    a.out = (float*)d_out; a.ws = (unsigned char*)d_ws;
#if MK_ONE_LAUNCH
    a.ph_lo = 0; a.ph_hi = NPH;
    hipLaunchKernelGGL(hyb_fwd, dim3(grid), dim3(NTHR), LDS_BYTES, stream, a);
#else
    for (int ph = 0; ph < NPH; ++ph) { a.ph_lo = ph; a.ph_hi = ph + 1; hipLaunchKernelGGL(hyb_fwd, dim3(grid), dim3(NTHR), LDS_BYTES, stream, a);
#if defined(CHECK_BUILD) && CHECK_BUILD
        if (ph == 2) hipLaunchKernelGGL(chk_proj, dim3(1024), dim3(256), 0, stream, a);
        if (ph == 3) hipLaunchKernelGGL(chk_cmp, dim3(128), dim3(128), 0, stream, a);
        if (ph == 6) hipLaunchKernelGGL(chk_nsa, dim3(8 * CHK_NT), dim3(256), 0, stream, a);
        if (ph == NPH - 1) hipLaunchKernelGGL(chk_report, dim3(4098), dim3(256), 0, stream, a);
#endif
    }
#endif
    (void)in_sizes;
}
```

```cpp
#include <hip/hip_runtime.h>
#include <cstdio>
#include <cstdint>
#if !defined(NO_S3_PREFETCH)
#define S3_PREFETCH 1
#endif
#if !defined(ST_F32)
#define ST_BF16 1
#endif
namespace pg8 {
#define PG8_LAS __attribute__((address_space(3)))
typedef unsigned short bf16_t;
typedef short bf16x8 __attribute__((ext_vector_type(8)));
typedef float f32x4 __attribute__((ext_vector_type(4)));
typedef unsigned u32x4 __attribute__((ext_vector_type(4)));
constexpr int BM = 256, BK = 64, HALF = 128, HTB = HALF * BK * 2  , STAGE_BYTES = 8 * HTB, NXCD = 8,
#ifdef PG8_WGM
    WGM = PG8_WGM;
#else
    WGM = 8;
#endif

__host__ __device__ __forceinline__ int lds_byte(int r, int c) { const int st = (r >> 4) * 2 + (c >> 5), rr = r & 15, cc = c & 31, ob = rr * 64 + cc * 2; return st * 1024 + (ob ^ (((ob >> 9) & 1) << 5)); }
__host__ __device__ __forceinline__ void stage_rc(int b, int& R, int& C) { const int st = b / 1024, sb = b % 1024, swz = sb ^ (((sb >> 9) & 1) << 5); R = (st >> 1) * 16 + swz / 64; C = (st & 1) * 32 + (swz % 64) / 2; }
__host__ __device__ __forceinline__ int perm32(int rho) { const int n = rho >> 4, i = rho & 15; return 8 * (i >> 2) + 4 * n + (i & 3); }

struct Unit { int pm, pn; };
struct Gemm { const bf16_t* A; const bf16_t* Bt; int M, N, K; };

struct StaticOrder {
    int nM, nN, nwg, G, c;
    __host__ __device__ void init(int M, int N, int G_, int c_) { nM = M / BM; nN = N / BM; nwg = nM * nN; G = G_; c = c_; }
    __host__ __device__ bool next(int i, Unit& u) const {
        const long L = (long)i * G + c; if (L >= nwg) return false;
        int wgid = (int)L; { const int q = nwg / NXCD, r = nwg % NXCD, xcd = wgid % NXCD, off = wgid / NXCD; wgid = (xcd < r ? xcd * (q + 1) : r * (q + 1) + (xcd - r) * q) + off; }
        const int nig = WGM * nN, gid = wgid / nig, fm = gid * WGM, gsz = (nM - fm) < WGM ? (nM - fm) : WGM;
        u.pm = fm + ((wgid % nig) % gsz); u.pn = (wgid % nig) / gsz; return true;
    }
    __device__ __forceinline__ void a_ready(const Unit&) const {}
    __device__ __forceinline__ void done(const Unit&) const {}
};
__device__ __forceinline__ unsigned cvt_pk_bf16(float lo, float hi) { unsigned r; asm volatile("v_cvt_pk_bf16_f32 %0, %1, %2" : "=v"(r) : "v"(lo), "v"(hi)); return r; }
template <class Epi, class Sched, bool ALIGN_EPI = false, bool SP2 = false>
__device__ __forceinline__ void gemm_phase(PG8_LAS unsigned char* lds, const Gemm g, const Sched& S, const Epi& E, const int wave_idx  ) {
    int lane_l; asm volatile("v_mbcnt_lo_u32_b32 %0, -1, 0\n\tv_mbcnt_hi_u32_b32 %0, -1, %0" : "=v"(lane_l));
    const int wid = wave_idx, tid = wid * 64 + lane_l, lane = tid & 63, wr = wid >> 2, wc = wid & 3, fr = lane & 15, fq = lane >> 4;
    const int K = g.K, nt = K / BK;
    unsigned voffA[2], voffB[2];
#pragma unroll
    for (int i = 0; i < 2; ++i) { int R, C; stage_rc(tid * 16 + i * 8192, R, C); const int Rb = Epi::PERM ? ((R & ~31) + perm32(R & 31)) : R;
        voffA[i] = (unsigned)(R * K + C) * 2u; voffB[i] = (unsigned)(Rb * K + C) * 2u; }
    const size_t kstep = (size_t)(BK * 2);
    const size_t hstep = (size_t)HALF * K * 2;
    const size_t tstep = 2 * hstep;
    const unsigned ldsw = (unsigned)wid * 1024u;
    const int aoff = lds_byte(wr * 64 + fr, fq * 8), boff = lds_byte(wc * 32 + fr, fq * 8);
#define PG8_SA(b, h) (((b) * 2 + (h)) * HTB)
#define PG8_SB(b, h) ((4 + (b) * 2 + (h)) * HTB)
#define PG8_STAGE(bufoff, gbase, voff) do { _Pragma("unroll") for (int _i = 0; _i < 2; ++_i) \
        __builtin_amdgcn_global_load_lds((const unsigned*)((const char*)(gbase) + (voff)[_i]), (PG8_LAS unsigned*)(lds + (bufoff) + ldsw + _i * 8192), 16, 0, 0); } while (0)
#define PG8_LDA(dst, b, h) do { _Pragma("unroll") for (int m = 0; m < 4; ++m) _Pragma("unroll") for (int k = 0; k < 2; ++k) dst[m][k] = *(const PG8_LAS bf16x8*)(lds + PG8_SA(b, h) + aoff + m * 2048 + k * 1024); } while (0)
#define PG8_LDB(dst, b, h) do { _Pragma("unroll") for (int n = 0; n < 2; ++n) _Pragma("unroll") for (int k = 0; k < 2; ++k) dst[n][k] = *(const PG8_LAS bf16x8*)(lds + PG8_SB(b, h) + boff + n * 2048 + k * 1024); } while (0)
#define PG8_MMA(ai, bj, At, Bt) do { __builtin_amdgcn_s_setprio(1); _Pragma("unroll") for (int m = 0; m < 4; ++m) _Pragma("unroll") for (int n = 0; n < 2; ++n) _Pragma("unroll") for (int k = 0; k < 2; ++k) \
        acc[ai][bj][m][n] = __builtin_amdgcn_mfma_f32_16x16x32_bf16(Bt[n][k], At[m][k], acc[ai][bj][m][n], 0, 0, 0); __builtin_amdgcn_s_setprio(0); } while (0)
#define PG8_WAIT_V(n) asm volatile("s_waitcnt vmcnt(" #n ")" ::: "memory")
#define PG8_WAIT_L(n) asm volatile("s_waitcnt lgkmcnt(" #n ")" ::: "memory")
#define PG8_BAR __builtin_amdgcn_s_barrier()
#define PG8_SCHED __builtin_amdgcn_sched_barrier(0)
    Unit cur, nxt; int ui = 0;
    if (!S.next(0, cur)) return;
    f32x4 acc[2][2][4][2];
#pragma unroll
    for (int a = 0; a < 2; ++a)
#pragma unroll
        for (int b = 0; b < 2; ++b)
#pragma unroll
            for (int m = 0; m < 4; ++m)
#pragma unroll
                for (int n = 0; n < 2; ++n) acc[a][b][m][n] = (f32x4){0.f, 0.f, 0.f, 0.f};
    bf16x8 At[4][2], B0[2][2], B1[2][2];
    const char* cA = (const char*)g.A + (size_t)cur.pm * tstep; const char* cB = (const char*)g.Bt + (size_t)cur.pn * tstep;
    S.a_ready(cur);
    if constexpr (SP2) {
        PG8_STAGE(PG8_SB(0, 0), cB, voffB); PG8_STAGE(PG8_SB(0, 1), cB + hstep, voffB); PG8_STAGE(PG8_SA(0, 0), cA, voffA); PG8_STAGE(PG8_SA(0, 1), cA + hstep, voffA);
        if (wr == 1) PG8_BAR;
        PG8_WAIT_V(2); PG8_BAR;
        PG8_STAGE(PG8_SB(1, 0), cB + kstep, voffB); PG8_STAGE(PG8_SA(1, 0), cA + kstep, voffA); PG8_STAGE(PG8_SB(1, 1), cB + hstep + kstep, voffB);
        PG8_WAIT_V(6); PG8_BAR;
    } else {
        PG8_STAGE(PG8_SB(0, 0), cB, voffB); PG8_STAGE(PG8_SA(0, 0), cA, voffA); PG8_STAGE(PG8_SB(0, 1), cB + hstep, voffB); PG8_STAGE(PG8_SA(0, 1), cA + hstep, voffA);
        if (wr == 1) PG8_BAR;
        PG8_WAIT_V(4); PG8_BAR;
        PG8_STAGE(PG8_SB(1, 0), cB + kstep, voffB); PG8_STAGE(PG8_SA(1, 0), cA + kstep, voffA); PG8_STAGE(PG8_SB(1, 1), cB + hstep + kstep, voffB);
        PG8_WAIT_V(6); PG8_BAR;
    }
    for (;;) {
        const bool has_next = S.next(ui + 1, nxt);
        const char* nA = has_next ? (const char*)g.A + (size_t)nxt.pm * tstep : cA; const char* nB = has_next ? (const char*)g.Bt + (size_t)nxt.pn * tstep : cB;
        for (int t = 0; t < nt; t += 2) {
            const bool last = (t == nt - 2);
            const char* a1 = cA + (size_t)(t + 1) * kstep;
            const char* a2 = last ? nA : cA + (size_t)(t + 2) * kstep; const char* b2 = last ? nB : cB + (size_t)(t + 2) * kstep;
            const char* a3 = a2 + kstep; const char* b3 = b2 + kstep;
            if (last && has_next) S.a_ready(nxt);
            if constexpr (SP2) {
            PG8_LDB(B0, 0, 0); PG8_LDB(B1, 0, 1); PG8_SCHED; PG8_LDA(At, 0, 0); PG8_STAGE(PG8_SA(1, 1), a1 + hstep, voffA);
            PG8_WAIT_V(8); PG8_WAIT_L(0); PG8_BAR; PG8_MMA(0, 0, At, B0); PG8_MMA(0, 1, At, B1); PG8_BAR; PG8_SCHED;
            PG8_LDA(At, 0, 1); PG8_STAGE(PG8_SB(0, 0), b2, voffB); PG8_STAGE(PG8_SB(0, 1), b2 + hstep, voffB); PG8_STAGE(PG8_SA(0, 0), a2, voffA);
            PG8_WAIT_V(8); PG8_WAIT_L(0); PG8_BAR; PG8_MMA(1, 0, At, B0); PG8_MMA(1, 1, At, B1); PG8_BAR; PG8_SCHED;
            PG8_LDB(B0, 1, 0); PG8_LDB(B1, 1, 1); PG8_SCHED; PG8_LDA(At, 1, 0); PG8_STAGE(PG8_SA(0, 1), a2 + hstep, voffA);
            PG8_WAIT_V(8); PG8_WAIT_L(0); PG8_BAR; PG8_MMA(0, 0, At, B0); PG8_MMA(0, 1, At, B1); PG8_BAR; PG8_SCHED;
            PG8_LDA(At, 1, 1); PG8_STAGE(PG8_SB(1, 0), b3, voffB); PG8_STAGE(PG8_SB(1, 1), b3 + hstep, voffB); PG8_STAGE(PG8_SA(1, 0), a3, voffA);
            PG8_WAIT_V(8); PG8_WAIT_L(0); PG8_BAR; PG8_MMA(1, 0, At, B0); PG8_MMA(1, 1, At, B1); PG8_BAR; PG8_SCHED;
            } else {
            PG8_LDB(B0, 0, 0); PG8_SCHED; PG8_LDA(At, 0, 0); PG8_STAGE(PG8_SA(1, 1), a1 + hstep, voffA);
            PG8_WAIT_L(8); PG8_BAR; PG8_WAIT_L(0); PG8_MMA(0, 0, At, B0); PG8_BAR; PG8_SCHED;
            PG8_LDB(B1, 0, 1); PG8_STAGE(PG8_SB(0, 0), b2, voffB);
            PG8_BAR; PG8_WAIT_L(0); PG8_MMA(0, 1, At, B1); PG8_BAR;
            PG8_LDA(At, 0, 1); PG8_STAGE(PG8_SA(0, 0), a2, voffA);
            PG8_BAR; PG8_WAIT_L(0); PG8_MMA(1, 0, At, B0); PG8_BAR; PG8_SCHED;
            PG8_STAGE(PG8_SB(0, 1), b2 + hstep, voffB);
            PG8_WAIT_V(6); PG8_BAR; PG8_MMA(1, 1, At, B1); PG8_BAR;
            PG8_LDB(B0, 1, 0); PG8_SCHED; PG8_LDA(At, 1, 0); PG8_STAGE(PG8_SA(0, 1), a2 + hstep, voffA);
            PG8_WAIT_L(8); PG8_BAR; PG8_WAIT_L(0); PG8_MMA(0, 0, At, B0); PG8_BAR; PG8_SCHED;
            PG8_LDB(B1, 1, 1); PG8_STAGE(PG8_SB(1, 0), b3, voffB);
            PG8_BAR; PG8_WAIT_L(0); PG8_MMA(0, 1, At, B1); PG8_BAR;
            PG8_LDA(At, 1, 1); PG8_STAGE(PG8_SA(1, 0), a3, voffA);
            PG8_BAR; PG8_WAIT_L(0); PG8_MMA(1, 0, At, B0); PG8_BAR; PG8_SCHED;
            PG8_STAGE(PG8_SB(1, 1), b3 + hstep, voffB);
            PG8_WAIT_V(6); PG8_BAR; PG8_MMA(1, 1, At, B1); PG8_BAR;
            }
        }
        if constexpr (ALIGN_EPI) { if (wr == 0) PG8_BAR; }
        if constexpr (!Epi::AFTER_DRAIN) { E(acc, cur, wr, wc, fr, fq);
#if defined(EPI_TWICE)
            if constexpr (Epi::PERM) E(acc, cur, wr, wc, fr, fq);
#endif
            S.done(cur); }
        if (!has_next) break;
#pragma unroll
        for (int a = 0; a < 2; ++a)
#pragma unroll
            for (int b = 0; b < 2; ++b)
#pragma unroll
                for (int m = 0; m < 4; ++m)
#pragma unroll
                    for (int n = 0; n < 2; ++n) acc[a][b][m][n] = (f32x4){0.f, 0.f, 0.f, 0.f};
        cur = nxt; cA = nA; cB = nB; ++ui;
        if constexpr (ALIGN_EPI) { if (wr == 1) PG8_BAR; }
    }
    PG8_WAIT_V(0);
    if constexpr (!ALIGN_EPI) { if (wr == 0) PG8_BAR; }
    PG8_BAR;
    if constexpr (Epi::AFTER_DRAIN) { E.fused(acc, cur, wr, wc, fr, fq, lds, wid, lane); S.done(cur); }
#undef PG8_SA
#undef PG8_SB
#undef PG8_STAGE
#undef PG8_LDA
#undef PG8_LDB
#undef PG8_MMA
#undef PG8_WAIT_V
#undef PG8_WAIT_L
#undef PG8_BAR
#undef PG8_SCHED
}
}

constexpr int BATCH = 2, SEQ = 8192, DM = 2048, DEPTH = 4;
constexpr int M = BATCH * SEQ;
constexpr int NH = 16, HD = 128, NG = 4, RH = 4;
constexpr int NCMP = 511, NCMP_PAD = 512, NSLC = 128, NSEL = 16, WIN = 512;
constexpr int SSD_H = 32, SSD_P = 64, SSD_N = 128, SSD_G = 4, SSD_CH = 128, SSD_NC = 64, SSD_XBC = 3072;
constexpr int DFF = 8192, PLE = 256;
constexpr float EPS = 1e-6f;
constexpr int PROJ_SRC = 22608;
constexpr int C_Q = 0, C_KC = 2048, C_VC = 2560, C_KS = 3072, C_VS = 3584, C_KW = 4096, C_VW = 4608;
constexpr int C_CB = 5120, C_CC = 7168, C_CU = 9216, C_Z = 11264, C_XBC = 13312, C_GM = 16384, C_GN = 22528, C_DT = 22592;
constexpr int LDP = 22784;
constexpr int S_GN = 5120, S_DT = 16432;

constexpr size_t MiB = 1u << 20;
constexpr size_t WS_CTL = 0, CTL_ZERO_BYTES = 1 * MiB;
constexpr size_t WS_ROPE = 1 * MiB;
constexpr size_t WS_MISC = 9 * MiB;
constexpr size_t WS_DT = 10 * MiB;
constexpr size_t WS_ACS = 12 * MiB;
constexpr size_t WS_CDEC = 14 * MiB;
constexpr size_t WS_KCMP = 15 * MiB;
constexpr size_t WS_VCMP = 16 * MiB;
constexpr size_t WS_X = 32 * MiB;
constexpr size_t WS_HB = 160 * MiB;
constexpr size_t WS_PB = 224 * MiB;
constexpr size_t WS_EB = 256 * MiB;
constexpr size_t WS_YA = 320 * MiB;
constexpr size_t WS_YC = 384 * MiB;
constexpr size_t WS_XBC = 448 * MiB;
constexpr size_t WS_ST = 544 * MiB;
constexpr size_t WS_PROJ = 672 * MiB;
constexpr size_t WS_U = WS_PROJ;
constexpr size_t WS_W = 1384 * MiB;
constexpr size_t LW_IN = 0;
constexpr size_t LW_O = 89 * MiB;
constexpr size_t LW_UP = 97 * MiB;
constexpr size_t LW_DOWN = 129 * MiB;
constexpr size_t LW_PG = 161 * MiB;
constexpr size_t LW_PLE = 169 * MiB;
constexpr size_t LW_PK1 = 170 * MiB;
constexpr size_t LW_PV1 = 171 * MiB;
constexpr size_t LW_PK2 = 172 * MiB;
constexpr size_t LW_PV2 = 172 * MiB + 64 * 1024;
constexpr size_t LW_STRIDE = 173 * MiB;
constexpr size_t WS_HIN = WS_W + 4 * LW_STRIDE;
constexpr size_t WS_RSTD = WS_MISC + 512 * 1024;
constexpr size_t WS_DELTA = WS_HIN + 64 * MiB;
constexpr size_t WS_KV = WS_DELTA + 64 * MiB;
constexpr size_t WS_END = WS_KV + 96 * MiB;
static_assert((size_t)M * LDP * 2 <= 712 * MiB && (size_t)LDP * 2048 * 2 <= 89 * MiB, "ws map");

constexpr int CW_BAR = 4096;
constexpr int CW_CHK = 16384;
constexpr int CW_TS = 20480;

constexpr int RING_BYTES = 131072;
constexpr int LX_OFF = RING_BYTES;
constexpr int LX_BYTES = 8192;
constexpr int LDSCTL_OFF = LX_OFF + LX_BYTES;
constexpr int LDS_BYTES = LDSCTL_OFF + 256;
constexpr int NWAVES = 8, NTHR = 512;

#define DI __device__ __forceinline__
#define GAS __attribute__((address_space(1)))
#define LAS __attribute__((address_space(3)))
typedef unsigned short bf16;
typedef unsigned u32x4 __attribute__((ext_vector_type(4)));
typedef unsigned u32x2 __attribute__((ext_vector_type(2)));
typedef float f32x4 __attribute__((ext_vector_type(4)));
typedef float f32x2 __attribute__((ext_vector_type(2)));
typedef short bf16x8 __attribute__((ext_vector_type(8)));
typedef short s16x4 __attribute__((ext_vector_type(4)));
typedef GAS unsigned gu32;
#define RLX_AGENT __ATOMIC_RELAXED, __HIP_MEMORY_SCOPE_AGENT
#define LDS_WAIT() asm volatile("s_waitcnt lgkmcnt(0)" ::: "memory")
#define VM_WAIT() asm volatile("s_waitcnt vmcnt(0)" ::: "memory")
DI size_t kv_off(int kind, int b, int g, int t) { return ((((size_t)kind * BATCH + b) * NG + g) * SEQ + t) * HD; }
DI unsigned f2bf(float f) { unsigned u = __builtin_bit_cast(unsigned, f); return (u + 0x7fffu + ((u >> 16) & 1u)) >> 16; }
DI unsigned pk2(float lo, float hi) { unsigned r; asm("v_cvt_pk_bf16_f32 %0, %1, %2" : "=v"(r) : "v"(lo), "v"(hi)); return r; }
DI float bf2f(unsigned h) { return __builtin_bit_cast(float, h << 16); }
DI float bflo(unsigned w) { return __builtin_bit_cast(float, w << 16); }
DI float bfhi(unsigned w) { return __builtin_bit_cast(float, w & 0xffff0000u); }
DI float sigmoidf_(float x) { return 1.0f / (1.0f + __expf(-x)); }
DI float siluf_(float x) { return x / (1.0f + __expf(-x)); }
DI float shfl_idx(float v, int src) { return __builtin_bit_cast(float, __builtin_amdgcn_ds_bpermute(src << 2, __builtin_bit_cast(int, v))); }
DI unsigned shfl_idx_u(unsigned v, int src) { return (unsigned)__builtin_amdgcn_ds_bpermute(src << 2, (int)v); }
DI float shx(float v, int m, int lane) { return shfl_idx(v, lane ^ m); }
DI float xq_max(float x) {
    float a = x, b = x;
    asm("s_nop 1\n\tv_permlane32_swap_b32 %0, %1" : "+v"(a), "+v"(b)); x = fmaxf(a, b);
    a = x; b = x;
    asm("s_nop 1\n\tv_permlane16_swap_b32 %0, %1" : "+v"(a), "+v"(b)); return fmaxf(a, b);
}
DI float xq_sum(float x) {
    float a = x, b = x;
    asm("s_nop 1\n\tv_permlane32_swap_b32 %0, %1" : "+v"(a), "+v"(b)); x = a + b;
    a = x; b = x;
    asm("s_nop 1\n\tv_permlane16_swap_b32 %0, %1" : "+v"(a), "+v"(b)); return a + b;
}
DI float quad_sum(float v) {
    v += __builtin_bit_cast(float, __builtin_amdgcn_update_dpp(0, __builtin_bit_cast(int, v), 0xB1, 0xF, 0xF, true));
    v += __builtin_bit_cast(float, __builtin_amdgcn_update_dpp(0, __builtin_bit_cast(int, v), 0x4E, 0xF, 0xF, true));
    return v;
}
DI float wave_sum(float v, int lane) {
#pragma unroll
    for (int o = 1; o < 64; o <<= 1) v += shx(v, o, lane);
    return v;
}
DI unsigned off_b(unsigned row, unsigned ch) { return 256u * row + 16u * (ch ^ (((row & 3u) << 2) | ((row >> 2) & 3u))); }
DI unsigned tr_addr(unsigned lane, unsigned r0, unsigned c, unsigned t) {
    const unsigned g = lane >> 4, q = (lane & 15u) >> 2, p = lane & 3u;
    return off_b(r0 + 8u * g + 4u * t + q, 2u * c + (p >> 1)) + 8u * (p & 1u);
}
DI s16x4 tr_read(LAS const unsigned char* p) { return __builtin_amdgcn_ds_read_tr16_b64_v4i16((LAS s16x4*)p); }
DI bf16x8 tr_read8(LAS const unsigned char* base, unsigned lane, unsigned r0, unsigned c) {
    const s16x4 lo = tr_read(base + tr_addr(lane, r0, c, 0)), hi = tr_read(base + tr_addr(lane, r0, c, 1));
    return __builtin_shufflevector(lo, hi, 0, 1, 2, 3, 4, 5, 6, 7);
}
DI bf16x8 lds_rd8(LAS const unsigned char* p) { return *(const LAS bf16x8*)p; }
DI bf16x8 as_bf16x8(u32x4 v) { return __builtin_bit_cast(bf16x8, v); }
#define MFMA16(a, b, c) __builtin_amdgcn_mfma_f32_16x16x32_bf16((a), (b), (c), 0, 0, 0)

namespace pg8 {
struct LightOrder {
    int G, c, nunits, nN;
    __host__ __device__ void init(int M, int N, int G_, int c_) { G = G_; c = c_; nN = N / BM; nunits = (M / BM) * nN; }
    __host__ __device__ bool next(int i, Unit& u) const {
        int j;
        if (G == 256) { if (c < 64) return false; j = (c - 64) + 192 * i; } else j = c + G * i;
        if (j >= nunits) return false;
        u.pm = j / nN; u.pn = j % nN; return true;
    }
    __device__ __forceinline__ void a_ready(const Unit&) const {}
    __device__ __forceinline__ void done(const Unit&) const {}
};
template <int MODE> struct EpiB {
    static constexpr bool PERM = true, AFTER_DRAIN = false;
    bf16_t* O; int ldc; const float* rope;
    bf16_t* kv;
    __device__ __forceinline__ void operator()(const f32x4 (&acc)[2][2][4][2], const Unit& u, int wr, int wc, int fr, int fq) const {
        { int l; asm volatile("v_mbcnt_lo_u32_b32 %0, -1, 0\n\tv_mbcnt_hi_u32_b32 %0, -1, %0" : "=v"(l)); fr = l & 15; fq = l >> 4; }
        const int row0 = u.pm * BM + wr * 64 + fr;
        bool rp = false;
        if (MODE == 2) { const int pn = u.pn; rp = (pn < 10) || pn == 12 || pn == 13 || pn == 16 || pn == 17; }
        if (MODE == 2 && rp) {
            const int colb = u.pn * BM + 128 * (wc >> 1) + 32 * (wc & 1) + 8 * fq, jj0 = 32 * (wc & 1) + 8 * fq;
#pragma unroll
            for (int ai = 0; ai < 2; ++ai)
#pragma unroll
                for (int m = 0; m < 4; ++m) {
                    const int row = row0 + ai * HALF + m * 16;
                    const float* rpp = (const float*)((const char*)rope + (unsigned)(((unsigned)row * 64u + (unsigned)jj0) * 8u));
                    const f32x4 cs0 = *(const f32x4*)(rpp), cs1 = *(const f32x4*)(rpp + 4), cs2 = *(const f32x4*)(rpp + 8), cs3 = *(const f32x4*)(rpp + 12);
                    const f32x4 x1a = acc[ai][0][m][0], x1b = acc[ai][0][m][1], x2a = acc[ai][1][m][0], x2b = acc[ai][1][m][1];
                    float c[8] = {cs0[0], cs0[2], cs1[0], cs1[2], cs2[0], cs2[2], cs3[0], cs3[2]};
                    float s[8] = {cs0[1], cs0[3], cs1[1], cs1[3], cs2[1], cs2[3], cs3[1], cs3[3]};
                    float x1[8] = {x1a[0], x1a[1], x1a[2], x1a[3], x1b[0], x1b[1], x1b[2], x1b[3]};
                    float x2[8] = {x2a[0], x2a[1], x2a[2], x2a[3], x2b[0], x2b[1], x2b[2], x2b[3]};
                    float o1[8], o2[8];
#pragma unroll
                    for (int k = 0; k < 8; ++k) { o1[k] = x1[k] * c[k] - x2[k] * s[k]; o2[k] = x2[k] * c[k] + x1[k] * s[k]; }
                    u32x4 w1, w2;
                    w1.x = cvt_pk_bf16(o1[0], o1[1]); w1.y = cvt_pk_bf16(o1[2], o1[3]); w1.z = cvt_pk_bf16(o1[4], o1[5]); w1.w = cvt_pk_bf16(o1[6], o1[7]);
                    w2.x = cvt_pk_bf16(o2[0], o2[1]); w2.y = cvt_pk_bf16(o2[2], o2[3]); w2.z = cvt_pk_bf16(o2[4], o2[5]); w2.w = cvt_pk_bf16(o2[6], o2[7]);
                    bf16_t* rowp = (bf16_t*)((char*)O + (unsigned)(((unsigned)row * (unsigned)ldc + (unsigned)colb) * 2u));
                    if (u.pn >= 8) { const int kind = (u.pn - 8) >> 1, g = 2 * (u.pn & 1) + (wc >> 1);
                        rowp = kv + ((((size_t)kind * 2 + (row >> 13)) * 4 + g) * 8192 + (row & 8191)) * 128 + jj0; }
                    *(u32x4*)(rowp) = w1; *(u32x4*)(rowp + 64) = w2;
                    asm volatile("" ::: "memory");
                }
        } else {
            const int col0 = u.pn * BM + wc * 32 + 8 * fq;
#pragma unroll
            for (int ai = 0; ai < 2; ++ai)
#pragma unroll
                for (int m = 0; m < 4; ++m) { bf16_t* rowp = (bf16_t*)((char*)O + (unsigned)(((unsigned)(row0 + ai * HALF + m * 16) * (unsigned)ldc + (unsigned)col0) * 2u));
#pragma unroll
                    for (int bj = 0; bj < 2; ++bj) { f32x4 v0 = acc[ai][bj][m][0], v1 = acc[ai][bj][m][1];
                        if (MODE == 1) {
#pragma unroll
                            for (int k = 0; k < 4; ++k) { const float a = fmaxf(v0[k], 0.f), b = fmaxf(v1[k], 0.f); v0[k] = a * a; v1[k] = b * b; } }
                        if (MODE == 3) { const u32x4 ev = *(const u32x4*)((const bf16_t*)rope + (rowp - O) + bj * HALF);
                            const float e[8] = {__builtin_bit_cast(float, ev.x << 16), __builtin_bit_cast(float, ev.x & 0xffff0000u), __builtin_bit_cast(float, ev.y << 16), __builtin_bit_cast(float, ev.y & 0xffff0000u),
                                                __builtin_bit_cast(float, ev.z << 16), __builtin_bit_cast(float, ev.z & 0xffff0000u), __builtin_bit_cast(float, ev.w << 16), __builtin_bit_cast(float, ev.w & 0xffff0000u)};
#pragma unroll
                            for (int k = 0; k < 4; ++k) { v0[k] = e[k] / (1.0f + __expf(-v0[k])); v1[k] = e[4 + k] / (1.0f + __expf(-v1[k])); } }
                        u32x4 w; w.x = cvt_pk_bf16(v0[0], v0[1]); w.y = cvt_pk_bf16(v0[2], v0[3]); w.z = cvt_pk_bf16(v1[0], v1[1]); w.w = cvt_pk_bf16(v1[2], v1[3]);
                        if (MODE == 2 && u.pn >= 8 && u.pn < 20) { const int kind = (u.pn - 8) >> 1, g = 2 * (u.pn & 1) + bj, row = row0 + ai * HALF + m * 16;
                            *(u32x4*)(kv + ((((size_t)kind * 2 + (row >> 13)) * 4 + g) * 8192 + (row & 8191)) * 128 + wc * 32 + 8 * fq) = w; }
                        else *(u32x4*)(rowp + bj * HALF) = w; } }
        }
    }
};
template <bool GATE> struct EpiRes {
    static constexpr bool PERM = false, AFTER_DRAIN = false;
    const float* xin; float* xout; int ldc; const bf16_t* e;
    __device__ __forceinline__ void operator()(const f32x4 (&acc)[2][2][4][2], const Unit& u, int wr, int wc, int fr, int fq) const {
        { int l; asm volatile("v_mbcnt_lo_u32_b32 %0, -1, 0\n\tv_mbcnt_hi_u32_b32 %0, -1, %0" : "=v"(l)); fr = l & 15; fq = l >> 4; }
        const int row0 = u.pm * BM + wr * 64 + fr, col0 = u.pn * BM + wc * 32 + 4 * fq;
#pragma unroll
        for (int ai = 0; ai < 2; ++ai)
#pragma unroll
            for (int m = 0; m < 4; ++m) { const unsigned off = (unsigned)(row0 + ai * HALF + m * 16) * (unsigned)ldc + (unsigned)col0;
#pragma unroll
                for (int bj = 0; bj < 2; ++bj)
#pragma unroll
                    for (int n = 0; n < 2; ++n) { const unsigned o = off + bj * HALF + n * 16; const f32x4 xv = *(const f32x4*)((const char*)xin + (unsigned)(o * 4u)); f32x4 a = acc[ai][bj][m][n];
                        if (GATE) { typedef unsigned u32x2v __attribute__((ext_vector_type(2))); const u32x2v ev = *(const u32x2v*)((const char*)e + (unsigned)(o * 2u));
                            const float e0 = __builtin_bit_cast(float, ev.x << 16), e1 = __builtin_bit_cast(float, ev.x & 0xffff0000u), e2 = __builtin_bit_cast(float, ev.y << 16), e3 = __builtin_bit_cast(float, ev.y & 0xffff0000u);
                            a[0] = e0 / (1.0f + __expf(-a[0])); a[1] = e1 / (1.0f + __expf(-a[1])); a[2] = e2 / (1.0f + __expf(-a[2])); a[3] = e3 / (1.0f + __expf(-a[3])); }
                        *(f32x4*)((char*)xout + (unsigned)(o * 4u)) = xv + a; }
                asm volatile("" ::: "memory"); }
    }
};
}
#define XB_TMO      128
#define XB_XCNT(j)  (256  + 64 * (j))
#define XB_XSUB(j)  (1280 + 64 * (j))
#define XB_XGEN(j)  (2304 + 64 * (j))
#define XB_TOP      3328
#define XB_TOPGEN   3392
#define XCD_BAR_WORDS 3456
#define XB_SPIN_CAP (1u << 18)

__device__ __forceinline__ unsigned xb_ld(unsigned* p)              { return __hip_atomic_load(p, __ATOMIC_RELAXED, __HIP_MEMORY_SCOPE_AGENT); }
__device__ __forceinline__ unsigned xb_add(unsigned* p, unsigned v) { return __hip_atomic_fetch_add(p, v, __ATOMIC_RELAXED, __HIP_MEMORY_SCOPE_AGENT); }
__device__ __forceinline__ unsigned xb_xcc_id() { return (unsigned)__builtin_amdgcn_s_getreg((3 << 11) | 20) & 0xFu; }
#define XB_SPIN(cond, bar) do { unsigned _sp = 0; while (cond) { __builtin_amdgcn_s_sleep(1); \
    if ((++_sp & 255u) == 0u) { if (xb_ld(&(bar)[XB_TMO])) break; if (_sp > XB_SPIN_CAP) { atomicAdd(&(bar)[XB_TMO], 1u); break; } } } } while (0)

struct XcdBarrier {
    unsigned* bar; unsigned x;
    volatile LAS unsigned* st;
};

__device__ __forceinline__ XcdBarrier xcd_barrier_post(unsigned* bar, volatile LAS unsigned* st) {
    XcdBarrier b; b.bar = bar; b.x = xb_xcc_id(); b.st = st;
    if (threadIdx.x == 0) (void)xb_add(&bar[XB_XCNT(b.x)], 1u);
    return b;
}
__device__ __forceinline__ void xcd_barrier_complete(unsigned* bar, unsigned x, unsigned& nloc, unsigned& nx) {
    const unsigned G = gridDim.x * gridDim.y * gridDim.z;
    unsigned sum, cnt, mine, sp = 0u;
    for (;;) {
        sum = 0u; cnt = 0u; mine = 0u;
#pragma unroll
        for (unsigned j = 0; j < 16; ++j) { const unsigned c = xb_ld(&bar[XB_XCNT(j)]); sum += c; cnt += (c > 0u) ? 1u : 0u; mine = (j == x) ? c : mine; }
        if (sum == G) break;
        __builtin_amdgcn_s_sleep(1);
        if ((++sp & 255u) == 0u) { if (xb_ld(&bar[XB_TMO])) break; if (sp > XB_SPIN_CAP) { atomicAdd(&bar[XB_TMO], 1u); break; } }
    }
    nloc = mine > 0u ? mine : 1u; nx = cnt > 0u ? cnt : 1u;
}

__device__ __forceinline__ void xcd_barrier(const XcdBarrier& b) {
    asm volatile("s_waitcnt vmcnt(0)" ::: "memory");
    __syncthreads();
    if (threadIdx.x == 0) {
        unsigned* bar = b.bar;
        __builtin_amdgcn_s_waitcnt(0);
        unsigned nloc = b.st[0], nx = b.st[1];
        if (nloc == 0u) { xcd_barrier_complete(bar, b.x, nloc, nx); b.st[0] = nloc; b.st[1] = nx; }
        const unsigned old = xb_add(&bar[XB_XSUB(b.x)], 1u);
        const unsigned gen = old / nloc;
        if (old + 1u == (gen + 1u) * nloc) {
            __builtin_amdgcn_fence(__ATOMIC_RELEASE, "agent");
            asm volatile("s_waitcnt vmcnt(0)" ::: "memory");
            const unsigned og = xb_add(&bar[XB_TOP], 1u);
            const unsigned tg = og / nx;
            if (og + 1u == (tg + 1u) * nx) xb_add(&bar[XB_TOPGEN], 1u);
            else XB_SPIN(xb_ld(&bar[XB_TOPGEN]) == tg, bar);
            __builtin_amdgcn_fence(__ATOMIC_ACQUIRE, "agent");
            xb_add(&bar[XB_XGEN(b.x)], 1u);
            asm volatile("s_waitcnt vmcnt(0)" ::: "memory");
        } else {
            XB_SPIN(xb_ld(&bar[XB_XGEN(b.x)]) == gen, bar);
            __builtin_amdgcn_fence(__ATOMIC_ACQUIRE, "agent");
            asm volatile("s_waitcnt vmcnt(0)" ::: "memory");
        }
    }
    __syncthreads();
}

struct Args { const void* in[30]; float* out; unsigned char* ws; int ph_lo, ph_hi; };
struct Frame {
    LAS unsigned char* lds;
    gu32* ctl;
    unsigned char* ws;
    int tid, lane, wave, G, bid;
};
DI const void* argin(const Args&, int k) {
    typedef const void* const __attribute__((address_space(4)))* kptr_t;
    kptr_t p = (kptr_t)__builtin_amdgcn_kernarg_segment_ptr(); asm volatile("" : "+s"(p));
    return (const void*)p[k]; }
DI int launder_s(int x) { asm volatile("" : "+s"(x)); return x; }
DI Frame phase_frame(const Frame& F0) { Frame F = F0;
    int l; asm volatile("v_mbcnt_lo_u32_b32 %0, -1, 0\n\tv_mbcnt_hi_u32_b32 %0, -1, %0" : "=v"(l));
    F.wave = launder_s(F0.wave); F.bid = launder_s(F0.bid); F.G = launder_s(F0.G);
    F.lane = l; F.tid = F.wave * 64 + l;
    { unsigned long long wsb = (unsigned long long)F0.ws; asm volatile("" : "+s"(wsb)); F.ws = (unsigned char*)wsb; }
    { unsigned ll = (unsigned)(size_t)F0.lds; asm volatile("" : "+s"(ll)); F.lds = (LAS unsigned char*)(size_t)ll; }
    return F; }
DI unsigned char* lw_ptr(const Frame& F, int layer, size_t off) { return F.ws + WS_W + (size_t)layer * LW_STRIDE + off; }

template <bool FRAGMAJOR = false>
DI void transpose_item(const float* W, int K, int Nsrc, int nsrc0, bf16* WT, int dst_row0, int k0, LAS float* scr, int lane) {
#pragma unroll 8
    for (int i = 0; i < 32; ++i) { const int kk = 2 * i + (lane >> 5); scr[kk * 33 + (lane & 31)] = W[(size_t)(k0 + kk) * Nsrc + nsrc0 + (lane & 31)]; }
    LDS_WAIT(); asm volatile("" ::: "memory");
    const int c = lane & 7;
#pragma unroll
    for (int j = 0; j < 4; ++j) { const int n = (lane >> 3) + 8 * j; const LAS float* s = scr + (8 * c) * 33 + n;
        u32x4 o; o.x = pk2(s[0 * 33], s[1 * 33]); o.y = pk2(s[2 * 33], s[3 * 33]); o.z = pk2(s[4 * 33], s[5 * 33]); o.w = pk2(s[6 * 33], s[7 * 33]);
        if (FRAGMAJOR) { const int hid = dst_row0 + n, kk = k0 + 8 * c;
            *(u32x4*)(WT + ((size_t)((hid >> 4) * (K >> 5) + (kk >> 5)) * 64 + (((kk >> 3) & 3) * 16 + (hid & 15))) * 8) = o; }
        else *(u32x4*)(WT + (size_t)(dst_row0 + n) * K + k0 + 8 * c) = o; }
    LDS_WAIT(); asm volatile("" ::: "memory");
}
DI int proj_src_col(int d) {
    if (d < 5120) {
        const int pn = d >> 8; const bool rp = (pn < 10) || pn == 12 || pn == 13 || pn == 16 || pn == 17;
        if (!rp) return d;
        const int c = d & 255, bj = c >> 7, wc = (c >> 5) & 3;
        return (pn << 8) + 128 * (wc >> 1) + 64 * bj + 32 * (wc & 1);
    }
    if (d < 16384) return d + 48;
    if (d < 22528) return d + 80;
    if (d < 22592) return S_GN + (d - 22528);
    if (d < 22624) return S_DT + (d - 22592);
    return 0;
}
constexpr int TI_IN = 32 * 712, TI_O = 32 * 64, TI_UP = 32 * 256, TI_DOWN = 128 * 64, TI_PG = 32 * 64, TI_PLE = 4 * 64, TI_P1 = 64 * 4, TI_P2 = 2 * 4;
constexpr int TI_LAYER = TI_IN + TI_O + TI_UP + TI_DOWN + TI_PG + TI_PLE + 2 * TI_P1 + 2 * TI_P2;

DI void p0_prologue(const Frame& F0, const Args& A) {
    const Frame F = phase_frame(F0);
    LAS float* scr = (LAS float*)(F.lds + F.wave * 16384);
    const int gw = F.bid * NWAVES + F.wave, NGW = F.G * NWAVES;
    for (int it = gw; it < DEPTH * TI_LAYER; it += NGW) {
        const int layer = it / TI_LAYER; int r = it - layer * TI_LAYER;
        if (r < TI_IN) { const int kb = r / 712, nb = r - kb * 712;
            transpose_item((const float*)argin(A, 4) + (size_t)layer * DM * PROJ_SRC, DM, PROJ_SRC, proj_src_col(nb * 32), (bf16*)lw_ptr(F, layer, LW_IN), nb * 32, kb * 64, scr, F.lane); continue; } r -= TI_IN;
        if (r < TI_O) { const int kb = r / 64, nb = r % 64;
            transpose_item((const float*)argin(A, 22) + (size_t)layer * DM * DM, DM, DM, nb * 32, (bf16*)lw_ptr(F, layer, LW_O), nb * 32, kb * 64, scr, F.lane); continue; } r -= TI_O;
        if (r < TI_UP) { const int kb = r / 256, nb = r % 256;
            transpose_item((const float*)argin(A, 24) + (size_t)layer * DM * DFF, DM, DFF, nb * 32, (bf16*)lw_ptr(F, layer, LW_UP), nb * 32, kb * 64, scr, F.lane); continue; } r -= TI_UP;
        if (r < TI_DOWN) { const int kb = r / 64, nb = r % 64;
            transpose_item((const float*)argin(A, 25) + (size_t)layer * DFF * DM, DFF, DM, nb * 32, (bf16*)lw_ptr(F, layer, LW_DOWN), nb * 32, kb * 64, scr, F.lane); continue; } r -= TI_DOWN;
        if (r < TI_PG) { const int kb = r / 64, nb = r % 64;
            transpose_item((const float*)argin(A, 28) + (size_t)layer * DM * DM, DM, DM, nb * 32, (bf16*)lw_ptr(F, layer, LW_PG), nb * 32, kb * 64, scr, F.lane); continue; } r -= TI_PG;
        if (r < TI_PLE) { const int kb = r / 64, nb = r % 64;
            transpose_item((const float*)argin(A, 27) + (size_t)layer * PLE * DM, PLE, DM, nb * 32, (bf16*)lw_ptr(F, layer, LW_PLE), nb * 32, kb * 64, scr, F.lane); continue; } r -= TI_PLE;
        if (r < TI_P1) { const int kb = r / 4, nb = r % 4;
            transpose_item<true>((const float*)argin(A, 7) + (size_t)layer * 4096 * 128, 4096, 128, nb * 32, (bf16*)lw_ptr(F, layer, LW_PK1), nb * 32, kb * 64, scr, F.lane); continue; } r -= TI_P1;
        if (r < TI_P1) { const int kb = r / 4, nb = r % 4;
            transpose_item<true>((const float*)argin(A, 11) + (size_t)layer * 4096 * 128, 4096, 128, nb * 32, (bf16*)lw_ptr(F, layer, LW_PV1), nb * 32, kb * 64, scr, F.lane); continue; } r -= TI_P1;
        if (r < TI_P2) { const int kb = r / 4, nb = r % 4;
            transpose_item((const float*)argin(A, 9) + (size_t)layer * 128 * 128, 128, 128, nb * 32, (bf16*)lw_ptr(F, layer, LW_PK2), nb * 32, kb * 64, scr, F.lane); continue; } r -= TI_P2;
        { const int kb = r / 4, nb = r % 4;
            transpose_item((const float*)argin(A, 13) + (size_t)layer * 128 * 128, 128, 128, nb * 32, (bf16*)lw_ptr(F, layer, LW_PV2), nb * 32, kb * 64, scr, F.lane); }
    }
    const size_t gt = (size_t)F.bid * NTHR + F.tid, NGT = (size_t)F.G * NTHR;
    { const float* p = (const float*)argin(A, 1); bf16* pb = (bf16*)(F.ws + WS_PB);
      for (size_t i = gt; i < (size_t)DEPTH * M * PLE / 8; i += NGT) { const f32x4 a = *(const f32x4*)(p + i * 8), b = *(const f32x4*)(p + i * 8 + 4);
          u32x4 o; o.x = pk2(a[0], a[1]); o.y = pk2(a[2], a[3]); o.z = pk2(b[0], b[1]); o.w = pk2(b[2], b[3]); *(u32x4*)(pb + i * 8) = o; } }
    { const int* pos = (const int*)argin(A, 2); float* rope = (float*)(F.ws + WS_ROPE);
      for (size_t i = gt; i < (size_t)M * 64; i += NGT) { const int row = (int)(i >> 6), jj = (int)(i & 63);
          const float inv = 1.0f / powf(10000.0f, (float)(2 * jj) * (1.0f / 128.0f));
          const float ang = (float)pos[row] * inv;
          double a = (double)ang; a -= 6.283185307179586476925 * __builtin_rint(a * 0.15915494309189533577);
          const float ar = (float)a;
          rope[i * 2] = cosf(ar); rope[i * 2 + 1] = sinf(ar); } }
    { float* part = (float*)(F.ws + WS_MISC);
      for (size_t i = gt; i < (size_t)DEPTH * 2 * 8 * 128; i += NGT) { const int hid = (int)(i & 127), c = (int)(i >> 7) & 7, kv = (int)(i >> 10) & 1, layer = (int)(i >> 11);
          const float* pe = (const float*)(kv ? A.in[6] : A.in[5]) + (size_t)layer * 4096 + c * 512;
          const float* w1 = (const float*)(kv ? A.in[11] : A.in[7]) + (size_t)layer * 4096 * 128 + (size_t)c * 512 * 128 + hid;
          float s = 0.f;
#pragma unroll 8
          for (int kk = 0; kk < 512; ++kk) s += pe[kk] * w1[(size_t)kk * 128];
          part[i] = s; } }
}

template <bool OUTF32> DI void norm_rows(const Frame& F0, const float* x, const float* g, void* outp) {
    const Frame F = phase_frame(F0);
    const int gw = F.bid * NWAVES + F.wave, NGW = F.G * NWAVES;
    for (int m = gw; m < M; m += NGW) {
        const f32x4* xr = (const f32x4*)(x + (size_t)m * DM) + F.lane;
        f32x4 v[8]; float s = 0.f;
#pragma unroll
        for (int j = 0; j < 8; ++j) { v[j] = xr[64 * j]; s += (v[j][0] * v[j][0] + v[j][1] * v[j][1]) + (v[j][2] * v[j][2] + v[j][3] * v[j][3]); }
        const float rstd = 1.0f / sqrtf(wave_sum(s, F.lane) * (1.0f / DM) + EPS);
#pragma unroll
        for (int j = 0; j < 8; ++j) { const f32x4 gv = ((const f32x4*)g)[F.lane + 64 * j]; const f32x4 o = v[j] * rstd * gv;
            if (OUTF32) ((f32x4*)((float*)outp + (size_t)m * DM))[F.lane + 64 * j] = o;
            else { u32x2 w; w.x = pk2(o[0], o[1]); w.y = pk2(o[2], o[3]); ((u32x2*)((bf16*)outp + (size_t)m * DM))[F.lane + 64 * j] = w; } }
    }
}
template <bool OUTF32> DI void addnorm_rows(const Frame& F0, const float* xin, const bf16* delta, const float* g, float* xout, void* outp) {
    const Frame F = phase_frame(F0);
    const int gw = F.bid * NWAVES + F.wave, NGW = F.G * NWAVES;
    for (int m = gw; m < M; m += NGW) {
        const f32x4* xr = (const f32x4*)(xin + (size_t)m * DM) + F.lane; const u32x2* dr = (const u32x2*)(delta + (size_t)m * DM) + F.lane;
        f32x4 v[8]; u32x2 d[8]; float s = 0.f;
#pragma unroll
        for (int j = 0; j < 8; ++j) { v[j] = xr[64 * j]; d[j] = dr[64 * j]; }
#pragma unroll
        for (int j = 0; j < 8; ++j) { v[j][0] += bflo(d[j].x); v[j][1] += bfhi(d[j].x); v[j][2] += bflo(d[j].y); v[j][3] += bfhi(d[j].y);
            s += (v[j][0] * v[j][0] + v[j][1] * v[j][1]) + (v[j][2] * v[j][2] + v[j][3] * v[j][3]);
            if (!OUTF32) ((f32x4*)(xout + (size_t)m * DM))[F.lane + 64 * j] = v[j]; }
        const float rstd = 1.0f / sqrtf(wave_sum(s, F.lane) * (1.0f / DM) + EPS);
#pragma unroll
        for (int j = 0; j < 8; ++j) { const f32x4 gv = ((const f32x4*)g)[F.lane + 64 * j]; const f32x4 o = v[j] * rstd * gv;
            if (OUTF32) ((f32x4*)((float*)outp + (size_t)m * DM))[F.lane + 64 * j] = o;
            else { u32x2 w; w.x = pk2(o[0], o[1]); w.y = pk2(o[2], o[3]); ((u32x2*)((bf16*)outp + (size_t)m * DM))[F.lane + 64 * j] = w; } }
    }
}
DI void unpack8(u32x4 w, float (&f)[8]) { f[0] = bflo(w.x); f[1] = bfhi(w.x); f[2] = bflo(w.y); f[3] = bfhi(w.y); f[4] = bflo(w.z); f[5] = bfhi(w.z); f[6] = bflo(w.w); f[7] = bfhi(w.w); }
DI u32x4 pack8f(const float (&f)[8]) { u32x4 o; o.x = pk2(f[0], f[1]); o.y = pk2(f[2], f[3]); o.z = pk2(f[4], f[5]); o.w = pk2(f[6], f[7]); return o; }

DI void ssd_conv_pass(const Frame& F0, const Args& A, int layer) {
    const Frame F = phase_frame(F0);
    const bf16* proj = (const bf16*)(F.ws + WS_PROJ); bf16* xbc = (bf16*)(F.ws + WS_XBC);
    const float* cw = (const float*)argin(A, 16) + (size_t)layer * 4 * SSD_XBC; const float* cb = (const float*)argin(A, 17) + (size_t)layer * SSD_XBC;
    const int gt = F.bid * NTHR + F.tid, NGT = F.G * NTHR;
    for (int task = gt; task < 512 * 384; task += NGT) {
        const int run = task / 384, cg = task - run * 384, ch = cg * 8, row0 = run * 32;
        float w[4][8], bs[8], xm3[8], xm2[8], xm1[8];
#pragma unroll
        for (int j = 0; j < 4; ++j) { const f32x4 a = *(const f32x4*)(cw + j * SSD_XBC + ch), b = *(const f32x4*)(cw + j * SSD_XBC + ch + 4);
            w[j][0] = a[0]; w[j][1] = a[1]; w[j][2] = a[2]; w[j][3] = a[3]; w[j][4] = b[0]; w[j][5] = b[1]; w[j][6] = b[2]; w[j][7] = b[3]; }
        { const f32x4 a = *(const f32x4*)(cb + ch), b = *(const f32x4*)(cb + ch + 4); bs[0] = a[0]; bs[1] = a[1]; bs[2] = a[2]; bs[3] = a[3]; bs[4] = b[0]; bs[5] = b[1]; bs[6] = b[2]; bs[7] = b[3]; }
        if ((row0 & (SEQ - 1)) != 0) {
            unpack8(*(const u32x4*)(proj + (size_t)(row0 - 3) * LDP + C_XBC + ch), xm3);
            unpack8(*(const u32x4*)(proj + (size_t)(row0 - 2) * LDP + C_XBC + ch), xm2);
            unpack8(*(const u32x4*)(proj + (size_t)(row0 - 1) * LDP + C_XBC + ch), xm1);
        } else {
#pragma unroll
            for (int k = 0; k < 8; ++k) { xm3[k] = 0.f; xm2[k] = 0.f; xm1[k] = 0.f; }
        }
#pragma unroll 4
        for (int r = 0; r < 32; ++r) {
            float cur[8], y[8]; unpack8(*(const u32x4*)(proj + (size_t)(row0 + r) * LDP + C_XBC + ch), cur);
#pragma unroll
            for (int k = 0; k < 8; ++k) { const float v = w[0][k] * xm3[k] + w[1][k] * xm2[k] + w[2][k] * xm1[k] + w[3][k] * cur[k] + bs[k]; y[k] = siluf_(v); xm3[k] = xm2[k]; xm2[k] = xm1[k]; xm1[k] = cur[k]; }
            *(u32x4*)(xbc + (size_t)(row0 + r) * SSD_XBC + ch) = pack8f(y);
        }
    }
    const float* dtb = (const float*)argin(A, 18) + layer * SSD_H; float* dt = (float*)(F.ws + WS_DT);
    for (int i = gt; i < M * SSD_H; i += NGT) { const int row = i >> 5, h = i & 31;
        const float x = bf2f(proj[(size_t)row * LDP + C_DT + h]) + dtb[h];
        dt[i] = fmaxf(x, 0.f) + log1pf(__expf(-fabsf(x))); }
}

DI void merge_pass(const Frame& F0, const Args& A, int layer) {
    const Frame F = phase_frame(F0);
    const bf16* proj = (const bf16*)(F.ws + WS_PROJ); const bf16* ya = (const bf16*)(F.ws + WS_YA); const bf16* yc = (const bf16*)(F.ws + WS_YC); bf16* hb = (bf16*)(F.ws + WS_HB);
    const float* sw = (const float*)argin(A, 15) + (size_t)layer * 3 * DM; const float* ngp = (const float*)argin(A, 21) + (size_t)layer * DM; const float* rstdp = (const float*)(F.ws + WS_RSTD);
    const int gt = F.bid * NTHR + F.tid, NGT = F.G * NTHR;
    for (int task = gt; task < 512 * 256; task += NGT) {
        const int run = task >> 8, cg = task & 255, ch = cg * 8, row0 = run * 32;
        float w[3][8], pm2[8], pm1[8], ng8[8];
        { const f32x4 a = *(const f32x4*)(ngp + ch), b = *(const f32x4*)(ngp + ch + 4); ng8[0] = a[0]; ng8[1] = a[1]; ng8[2] = a[2]; ng8[3] = a[3]; ng8[4] = b[0]; ng8[5] = b[1]; ng8[6] = b[2]; ng8[7] = b[3]; }
#pragma unroll
        for (int j = 0; j < 3; ++j) { const f32x4 a = *(const f32x4*)(sw + j * DM + ch), b = *(const f32x4*)(sw + j * DM + ch + 4);
            w[j][0] = a[0]; w[j][1] = a[1]; w[j][2] = a[2]; w[j][3] = a[3]; w[j][4] = b[0]; w[j][5] = b[1]; w[j][6] = b[2]; w[j][7] = b[3]; }
        if ((row0 & (SEQ - 1)) != 0) {
            float c1[8], u1[8];
            unpack8(*(const u32x4*)(proj + (size_t)(row0 - 2) * LDP + C_CC + ch), c1); unpack8(*(const u32x4*)(proj + (size_t)(row0 - 2) * LDP + C_CU + ch), u1);
#pragma unroll
            for (int k = 0; k < 8; ++k) pm2[k] = c1[k] * u1[k];
            unpack8(*(const u32x4*)(proj + (size_t)(row0 - 1) * LDP + C_CC + ch), c1); unpack8(*(const u32x4*)(proj + (size_t)(row0 - 1) * LDP + C_CU + ch), u1);
#pragma unroll
            for (int k = 0; k < 8; ++k) pm1[k] = c1[k] * u1[k];
        } else {
#pragma unroll
            for (int k = 0; k < 8; ++k) { pm2[k] = 0.f; pm1[k] = 0.f; }
        }
#pragma unroll 2
        for (int r = 0; r < 32; ++r) {
            const size_t pr = (size_t)(row0 + r) * LDP + ch, yr = (size_t)(row0 + r) * DM + ch;
            float cc[8], cu[8], cbv[8], g0[8], g1[8], g2[8], a[8], c[8], o[8];
            unpack8(*(const u32x4*)(proj + pr + C_CC), cc); unpack8(*(const u32x4*)(proj + pr + C_CU), cu); unpack8(*(const u32x4*)(proj + pr + C_CB), cbv);
            unpack8(*(const u32x4*)(proj + pr + C_GM), g0); unpack8(*(const u32x4*)(proj + pr + C_GM + DM), g1); unpack8(*(const u32x4*)(proj + pr + C_GM + 2 * DM), g2);
            unpack8(*(const u32x4*)(ya + yr), a); unpack8(*(const u32x4*)(yc + yr), c);
            const float rs = rstdp[(size_t)(row0 + r) * SSD_G + (ch >> 9)];
#pragma unroll
            for (int k = 0; k < 8; ++k) { const float pc = cc[k] * cu[k]; const float cv = w[0][k] * pm2[k] + w[1][k] * pm1[k] + w[2][k] * pc; pm2[k] = pm1[k]; pm1[k] = pc;
                o[k] = sigmoidf_(g0[k]) * a[k] + sigmoidf_(g1[k]) * (cbv[k] * cv) + sigmoidf_(g2[k]) * (c[k] * rs * ng8[k]); }
            *(u32x4*)(hb + yr) = pack8f(o);
        }
    }
}

DI void compress_phase(const Frame& F0, const Args& A, int layer) {
    const Frame F = phase_frame(F0);
    const bf16* proj = (const bf16*)(F.ws + WS_PROJ);
    LAS unsigned char* slab = F.lds;
    LAS unsigned char* hidl = F.lds + 73728;
    LAS float* b1s = (LAS float*)(F.lds + 81920);
    const int lane = F.lane, w = F.wave, i = lane & 15, qd = lane >> 4;
    const float* part = (const float*)(F.ws + WS_MISC);
    for (int u = F.bid; u < 512; u += F.G) {
        const int kv = u >> 8, b = (u >> 7) & 1, g = (u >> 5) & 3, nb = u & 31, n0 = nb * 16, tok0 = n0 * 16;
        const bf16* src = (const bf16*)(F.ws + WS_KV) + kv_off(kv, b, g, 0);
        for (int id = F.tid; id < 272 * 16; id += NTHR) { const int row = id >> 4, ch = id & 15, t = tok0 + row;
            u32x4 v = {0u, 0u, 0u, 0u}; if (t < SEQ) v = *(const u32x4*)(src + (size_t)t * HD + ch * 8);
            *(LAS u32x4*)(slab + off_b(row, ch)) = v; }
        if (F.tid < 128) { float s = ((const float*)argin(A, kv ? 12 : 8))[layer * 128 + F.tid];
#pragma unroll
            for (int c = 0; c < 8; ++c) s += part[(((size_t)layer * 2 + kv) * 8 + c) * 128 + F.tid];
            b1s[F.tid] = s; }
        __syncthreads();
        const bf16* w1t = (const bf16*)lw_ptr(F, layer, kv ? LW_PV1 : LW_PK1) + ((size_t)w * 128 * 64 + lane) * 8;
        f32x4 acc = {0.f, 0.f, 0.f, 0.f};
#if defined(SSD_IGLP)
        __builtin_amdgcn_iglp_opt(0);
#endif
        for (int k0 = 0; k0 < 128; k0 += 32) {
            bf16x8 bb[32];
#pragma unroll
            for (int k = 0; k < 32; ++k) bb[k] = *(const bf16x8*)(w1t + 512 * (k0 + k));
#pragma unroll
            for (int k = 0; k < 32; ++k) { const int ks = k0 + k;
                acc = MFMA16(lds_rd8(slab + off_b(16 * i + (ks >> 2), 4 * (ks & 3) + qd)), bb[k], acc); }
        }
        { const float bv = b1s[16 * w + i];
#pragma unroll
          for (int j = 0; j < 4; ++j) *(LAS bf16*)(hidl + (4 * qd + j) * 272 + (16 * w + i) * 2) = (bf16)f2bf(siluf_(acc[j] + bv)); }
        __syncthreads();
        const bf16* w2t = (const bf16*)lw_ptr(F, layer, kv ? LW_PV2 : LW_PK2) + (size_t)(16 * w + i) * 128 + 8 * qd;
        f32x4 acc2 = {0.f, 0.f, 0.f, 0.f};
#pragma unroll
        for (int s = 0; s < 4; ++s) {
            const bf16x8 a = lds_rd8(hidl + i * 272 + 64 * s + 16 * qd);
            const bf16x8 bb = *(const bf16x8*)(w2t + 32 * s);
            acc2 = MFMA16(a, bb, acc2);
        }
        const float b2 = ((const float*)argin(A, kv ? 14 : 10))[layer * 128 + 16 * w + i];
        bf16* dst = (bf16*)(F.ws + (kv ? WS_VCMP : WS_KCMP)) + ((size_t)(b * NG + g) * NCMP_PAD + n0) * HD + 16 * w + i;
#pragma unroll
        for (int j = 0; j < 4; ++j) dst[(size_t)(4 * qd + j) * HD] = (bf16)f2bf(acc2[j] + b2);
        __syncthreads();
    }
}

DI unsigned pk2_sw(float a, float b) {
    unsigned ua = __builtin_bit_cast(unsigned, a), ub = __builtin_bit_cast(unsigned, b);
    ua += 0x7FFFu + ((ua >> 16) & 1u); ub += 0x7FFFu + ((ub >> 16) & 1u);
    return (ua >> 16) | (ub & 0xFFFF0000u);
}
DI void ssd_states_phase(const Frame& F0, const Args& A, int layer) {
    const Frame F = phase_frame(F0);
    const bf16* xbc = (const bf16*)(F.ws + WS_XBC); const float* dt = (const float*)(F.ws + WS_DT);
    float* acs = (float*)(F.ws + WS_ACS); float* cdec = (float*)(F.ws + WS_CDEC); float* st = (float*)(F.ws + WS_ST);
    LAS unsigned char* Bt = F.lds; LAS unsigned char* Xt = F.lds + 32768; LAS float* sc = (LAS float*)(F.lds + 65536);
    const float* alog = (const float*)argin(A, 19) + layer * SSD_H;
    const int lane = F.lane, w = F.wave, i = lane & 15, qd = lane >> 4;
    for (int u = F.bid; u < 512; u += F.G) {
        const int b = u >> 8, c = (u >> 2) & 63, g = u & 3, row0 = b * SEQ + c * SSD_CH;
        {
            const int hh = g * 8 + w; const float a = -__expf(alog[hh]);
            const float dt0 = dt[(size_t)(row0 + 2 * lane) * SSD_H + hh], dt1 = dt[(size_t)(row0 + 2 * lane + 1) * SSD_H + hh];
            const float d0 = dt0 * a, d1 = dt1 * a, pair = d0 + d1; float s = pair;
#pragma unroll
            for (int o = 1; o < 64; o <<= 1) { const float t = shfl_idx(s, lane - o); if (lane >= o) s += t; }
            const float a0 = (s - pair) + d0, a1 = s, total = __builtin_bit_cast(float, __builtin_amdgcn_readlane(__builtin_bit_cast(int, s), 63));
            acs[(size_t)(row0 + 2 * lane) * SSD_H + hh] = a0; acs[(size_t)(row0 + 2 * lane + 1) * SSD_H + hh] = a1;
            sc[w * 128 + 2 * lane] = dt0 * __expf(total - a0); sc[w * 128 + 2 * lane + 1] = dt1 * __expf(total - a1);
            if (lane == 0) cdec[(size_t)(b * SSD_NC + c) * SSD_H + hh] = __expf(total);
        }
#if defined(S1_PRELOAD)
        u32x4 xr[4][4];
#pragma unroll
        for (int hp = 0; hp < 4; ++hp)
#pragma unroll
            for (int j = 0; j < 4; ++j) { const int id = F.tid + NTHR * j, row = id >> 4, ch = id & 15;
                xr[hp][j] = *(const u32x4*)(xbc + (size_t)(row0 + row) * SSD_XBC + g * 512 + hp * 128 + ch * 8); }
#pragma unroll
        for (int j = 0; j < 4; ++j) { const int id = F.tid + NTHR * j, row = id >> 4, ch = id & 15;
            *(LAS u32x4*)(Bt + off_b(row, ch)) = *(const u32x4*)(xbc + (size_t)(row0 + row) * SSD_XBC + 2048 + g * 128 + ch * 8); }
        __syncthreads();
        bf16x8 bfr[4];
#pragma unroll
        for (int ks = 0; ks < 4; ++ks) bfr[ks] = tr_read8(Bt, lane, 32 * ks, w);
#pragma unroll
        for (int hp = 0; hp < 4; ++hp) {
            LAS unsigned char* Xb = Xt + (hp & 1) * 32768 + ((hp & 1) ? 4096 : 0);
#pragma unroll
            for (int j = 0; j < 4; ++j) { const int id = F.tid + NTHR * j, row = id >> 4, ch = id & 15;
                float x[8]; unpack8(xr[hp][j], x);
                const float f = sc[(hp * 2 + (ch >> 3)) * 128 + row];
#pragma unroll
                for (int k = 0; k < 8; ++k) x[k] *= f;
                *(LAS u32x4*)(Xb + off_b(row, ch)) = pack8f(x); }
            __syncthreads();
#pragma unroll
            for (int h2 = 0; h2 < 2; ++h2) {
                const int head = g * 8 + hp * 2 + h2;
                float* dst = st + ((size_t)((b * SSD_NC + c) * SSD_H + head) * SSD_N + 16 * w + i) * SSD_P + 4 * qd;
#pragma unroll
                for (int pt = 0; pt < 4; ++pt) {
                    f32x4 acc = {0.f, 0.f, 0.f, 0.f};
#pragma unroll
                    for (int ks = 0; ks < 4; ++ks) acc = MFMA16(tr_read8(Xb, lane, 32 * ks, h2 * 4 + pt), bfr[ks], acc);
#if defined(ST_BF16)
                    { u32x2 o_; o_.x = pk2_sw(acc[0], acc[1]); o_.y = pk2_sw(acc[2], acc[3]); *(u32x2*)((bf16*)st + (size_t)(dst - st) + 16 * pt) = o_; }
#else
                    *(f32x4*)(dst + 16 * pt) = acc;
#endif
                }
            }
        }
#else
        for (int id = F.tid; id < 128 * 16; id += NTHR) { const int row = id >> 4, ch = id & 15;
            *(LAS u32x4*)(Bt + off_b(row, ch)) = *(const u32x4*)(xbc + (size_t)(row0 + row) * SSD_XBC + 2048 + g * 128 + ch * 8); }
        bf16x8 bfr[4];
        for (int hp = 0; hp < 4; ++hp) {
            __syncthreads();
            for (int id = F.tid; id < 128 * 16; id += NTHR) { const int row = id >> 4, ch = id & 15;
                float x[8]; unpack8(*(const u32x4*)(xbc + (size_t)(row0 + row) * SSD_XBC + g * 512 + hp * 128 + ch * 8), x);
                const float f = sc[(hp * 2 + (ch >> 3)) * 128 + row];
#pragma unroll
                for (int k = 0; k < 8; ++k) x[k] *= f;
                *(LAS u32x4*)(Xt + off_b(row, ch)) = pack8f(x); }
            __syncthreads();
            if (hp == 0) {
#pragma unroll
                for (int ks = 0; ks < 4; ++ks) bfr[ks] = tr_read8(Bt, lane, 32 * ks, w);
            }
#pragma unroll
            for (int h2 = 0; h2 < 2; ++h2) {
                const int head = g * 8 + hp * 2 + h2;
                float* dst = st + ((size_t)((b * SSD_NC + c) * SSD_H + head) * SSD_N + 16 * w + i) * SSD_P + 4 * qd;
#pragma unroll
                for (int pt = 0; pt < 4; ++pt) {
                    f32x4 acc = {0.f, 0.f, 0.f, 0.f};
#pragma unroll
                    for (int ks = 0; ks < 4; ++ks) acc = MFMA16(tr_read8(Xt, lane, 32 * ks, h2 * 4 + pt), bfr[ks], acc);
#if defined(ST_BF16)
                    { u32x2 o_; o_.x = pk2_sw(acc[0], acc[1]); o_.y = pk2_sw(acc[2], acc[3]); *(u32x2*)((bf16*)st + (size_t)(dst - st) + 16 * pt) = o_; }
#else
                    *(f32x4*)(dst + 16 * pt) = acc;
#endif
                }
            }
        }
#endif
        __syncthreads();
    }
}
DI void ssd_scan_phase(const Frame& F0) {
    const Frame F = phase_frame(F0);
    const f32x4* st = (const f32x4*)(F.ws + WS_ST); u32x2* hin = (u32x2*)(F.ws + WS_HIN); const float* cdec = (const float*)(F.ws + WS_CDEC);
    const int gt = F.bid * NTHR + F.tid, NGT = F.G * NTHR;
    for (int v = gt; v < BATCH * SSD_H * 2048; v += NGT) {
        const int b = v >> 16, h = (v >> 11) & 31, e = v & 2047;
        const size_t o0 = ((size_t)(b * SSD_NC) * SSD_H + h) * 2048 + e;
        const float* dc = cdec + (size_t)(b * SSD_NC) * SSD_H + h;
        f32x4 hs = {0.f, 0.f, 0.f, 0.f};
        for (int c0 = 0; c0 < SSD_NC; c0 += 8) {
            f32x4 s[8]; float d[8];
#pragma unroll
#if defined(ST_BF16)
            for (int k = 0; k < 8; ++k) { const u32x2 t_ = ((const u32x2*)st)[o0 + (size_t)(c0 + k) * 65536]; s[k][0] = bflo(t_.x); s[k][1] = bfhi(t_.x); s[k][2] = bflo(t_.y); s[k][3] = bfhi(t_.y); d[k] = dc[(c0 + k) * SSD_H]; }
#else
            for (int k = 0; k < 8; ++k) { s[k] = st[o0 + (size_t)(c0 + k) * 65536]; d[k] = dc[(c0 + k) * SSD_H]; }
#endif
#pragma unroll
            for (int k = 0; k < 8; ++k) { u32x2 o; o.x = pk2(hs[0], hs[1]); o.y = pk2(hs[2], hs[3]); hin[o0 + (size_t)(c0 + k) * 65536] = o; hs = hs * d[k] + s[k]; }
        }
    }
}
DI void ssd_out_phase(const Frame& F0, const Args& A, int layer) {
    const Frame F = phase_frame(F0);
    const bf16* xbc = (const bf16*)(F.ws + WS_XBC); const bf16* proj = (const bf16*)(F.ws + WS_PROJ);
    const float* dt = (const float*)(F.ws + WS_DT); const float* acs = (const float*)(F.ws + WS_ACS); const bf16* hin = (const bf16*)(F.ws + WS_HIN);
    bf16* yc = (bf16*)(F.ws + WS_YC); float* rstdp = (float*)(F.ws + WS_RSTD);
    LAS unsigned char* Bt = F.lds; LAS unsigned char* Ct = F.lds + 32768; LAS unsigned char* Xt = F.lds + 65536; LAS unsigned char* Ht = F.lds + 98304;
    LAS float* acsl = (LAS float*)(F.lds + LX_OFF);
    const float* dsk = (const float*)argin(A, 20) + layer * SSD_H;
    const int lane = F.lane, w = F.wave, i = lane & 15, qd = lane >> 4;
    for (int u = F.bid; u < 512; u += F.G) {
        const int b = u >> 8, c = (u >> 2) & 63, g = u & 3, row0 = b * SEQ + c * SSD_CH;
        for (int id = F.tid; id < 128 * 16; id += NTHR) { const int row = id >> 4, ch = id & 15; const bf16* src = xbc + (size_t)(row0 + row) * SSD_XBC + 2048 + g * 128 + ch * 8;
            *(LAS u32x4*)(Bt + off_b(row, ch)) = *(const u32x4*)(src); *(LAS u32x4*)(Ct + off_b(row, ch)) = *(const u32x4*)(src + 512); }
        __syncthreads();
        bf16x8 cfr[4];
#pragma unroll
        for (int ks = 0; ks < 4; ++ks) cfr[ks] = lds_rd8(Ct + off_b(16 * w + i, 4 * ks + qd));
        f32x4 cb[4][2];
#pragma unroll
        for (int k = 0; k < 4; ++k)
#pragma unroll
            for (int T = 0; T < 2; ++T) { f32x4 acc = {0.f, 0.f, 0.f, 0.f};
#pragma unroll
                for (int ks = 0; ks < 4; ++ks) acc = MFMA16(lds_rd8(Bt + off_b(32 * k + 8 * (i >> 2) + (i & 3) + 4 * T, 4 * ks + qd)), cfr[ks], acc);
                cb[k][T] = acc; }
        const int lrow = 16 * w + i, row = row0 + lrow;
        float ssq = 0.f;
#if defined(S3_PREFETCH)
        u32x4 px[4], ph[4]; float pd[4], pa = 0.f;
#define S3_PF_LOAD(HP) do { \
            if (F.tid < 256) { const int h2_ = F.tid >> 7, l_ = F.tid & 127; pa = acs[(size_t)(row0 + l_) * SSD_H + g * 8 + (HP) * 2 + h2_]; } \
            _Pragma("unroll") for (int j_ = 0; j_ < 4; ++j_) { const int id_ = F.tid + NTHR * j_, r_ = id_ >> 4, ch_ = id_ & 15, head_ = g * 8 + (HP) * 2 + (ch_ >> 3); \
                px[j_] = *(const u32x4*)(xbc + (size_t)(row0 + r_) * SSD_XBC + g * 512 + (HP) * 128 + ch_ * 8); pd[j_] = dt[(size_t)(row0 + r_) * SSD_H + head_]; \
                ph[j_] = *(const u32x4*)(hin + ((size_t)((b * SSD_NC + c) * SSD_H + head_) * SSD_N + r_) * SSD_P + (ch_ & 7) * 8); } } while (0)
        S3_PF_LOAD(0);
#endif
        for (int hp = 0; hp < 4; ++hp) {
            __syncthreads();
#if defined(S3_PREFETCH)
            if (F.tid < 256) acsl[F.tid] = pa;
#pragma unroll
            for (int j = 0; j < 4; ++j) { const int id = F.tid + NTHR * j, r = id >> 4, ch = id & 15;
                float x[8]; unpack8(px[j], x);
#pragma unroll
                for (int k = 0; k < 8; ++k) x[k] *= pd[j];
                *(LAS u32x4*)(Xt + off_b(r, ch)) = pack8f(x); *(LAS u32x4*)(Ht + off_b(r, ch)) = ph[j]; }
            __syncthreads();
            u32x2 xva[4], zva[4];
#pragma unroll
            for (int pt = 0; pt < 4; ++pt) { const int chn = (g * 8 + hp * 2) * SSD_P + 16 * pt + 4 * qd;
                xva[pt] = *(const u32x2*)(xbc + (size_t)row * SSD_XBC + chn); zva[pt] = *(const u32x2*)(proj + (size_t)row * LDP + C_Z + chn); }
            __builtin_amdgcn_sched_barrier(0);
            if (hp < 3) S3_PF_LOAD(hp + 1);
            __builtin_amdgcn_sched_barrier(0);
#else
            if (F.tid < 256) { const int h2 = F.tid >> 7, l = F.tid & 127; acsl[F.tid] = acs[(size_t)(row0 + l) * SSD_H + g * 8 + hp * 2 + h2]; }
            for (int id = F.tid; id < 128 * 16; id += NTHR) { const int r = id >> 4, ch = id & 15, head = g * 8 + hp * 2 + (ch >> 3);
                float x[8]; unpack8(*(const u32x4*)(xbc + (size_t)(row0 + r) * SSD_XBC + g * 512 + hp * 128 + ch * 8), x);
                const float f = dt[(size_t)(row0 + r) * SSD_H + head];
#pragma unroll
                for (int k = 0; k < 8; ++k) x[k] *= f;
                *(LAS u32x4*)(Xt + off_b(r, ch)) = pack8f(x);
                *(LAS u32x4*)(Ht + off_b(r, ch)) = *(const u32x4*)(hin + ((size_t)((b * SSD_NC + c) * SSD_H + head) * SSD_N + r) * SSD_P + (ch & 7) * 8); }
            __syncthreads();
#endif
#if defined(S3_PREFETCH)
#pragma unroll 1
#else
#pragma unroll
#endif
            for (int h2 = 0; h2 < 2; ++h2) {
                const int head = g * 8 + hp * 2 + h2;
#if defined(SSD_IGLP)
                __builtin_amdgcn_iglp_opt(0);
#endif
                const float al = acsl[h2 * 128 + lrow], ea = __expf(al), dsv = dsk[head];
#if defined(S3_PREFETCH)
                if (h2 == 1) {
#pragma unroll
                    for (int pt = 0; pt < 4; ++pt) { const int chn = head * SSD_P + 16 * pt + 4 * qd;
                        xva[pt] = *(const u32x2*)(xbc + (size_t)row * SSD_XBC + chn); zva[pt] = *(const u32x2*)(proj + (size_t)row * LDP + C_Z + chn); } }
#else
                u32x2 xv4[4], zv4[4];
#pragma unroll
                for (int pt = 0; pt < 4; ++pt) { const int chn = head * SSD_P + 16 * pt + 4 * qd;
                    xv4[pt] = *(const u32x2*)(xbc + (size_t)row * SSD_XBC + chn); zv4[pt] = *(const u32x2*)(proj + (size_t)row * LDP + C_Z + chn); }
#endif
                bf16x8 mfr[4];
#pragma unroll
                for (int k = 0; k < 4; ++k) {
                    const f32x4 a0 = *(const LAS f32x4*)(acsl + h2 * 128 + 32 * k + 8 * qd), a1 = *(const LAS f32x4*)(acsl + h2 * 128 + 32 * k + 8 * qd + 4);
                    float mv[8];
#pragma unroll
                    for (int j = 0; j < 4; ++j) { const int s0 = 32 * k + 8 * qd + j, s1 = s0 + 4;
                        mv[j] = (s0 <= lrow) ? cb[k][0][j] * __expf(al - a0[j]) : 0.f;
                        mv[4 + j] = (s1 <= lrow) ? cb[k][1][j] * __expf(al - a1[j]) : 0.f; }
                    mfr[k] = as_bf16x8(pack8f(mv));
                }
#pragma unroll
                for (int pt = 0; pt < 4; ++pt) {
                    f32x4 yd = {0.f, 0.f, 0.f, 0.f}, yo = {0.f, 0.f, 0.f, 0.f};
#pragma unroll
                    for (int k = 0; k < 4; ++k) yd = MFMA16(tr_read8(Xt, lane, 32 * k, h2 * 4 + pt), mfr[k], yd);
#pragma unroll
                    for (int ks = 0; ks < 4; ++ks) yo = MFMA16(tr_read8(Ht, lane, 32 * ks, h2 * 4 + pt), cfr[ks], yo);
                    const int chn = head * SSD_P + 16 * pt + 4 * qd;
#if defined(S3_PREFETCH)
                    const u32x2 xv = xva[pt], zv = zva[pt];
#else
                    const u32x2 xv = xv4[pt], zv = zv4[pt];
#endif
                    const float xs[4] = {bflo(xv.x), bfhi(xv.x), bflo(xv.y), bfhi(xv.y)}, zz[4] = {bflo(zv.x), bfhi(zv.x), bflo(zv.y), bfhi(zv.y)};
                    float gy[4];
#pragma unroll
                    for (int j = 0; j < 4; ++j) { const float y = yd[j] + ea * yo[j] + dsv * xs[j]; gy[j] = y * siluf_(zz[j]); ssq += gy[j] * gy[j]; }
                    u32x2 o; o.x = pk2(gy[0], gy[1]); o.y = pk2(gy[2], gy[3]);
                    *(u32x2*)(yc + (size_t)row * DM + chn) = o;
                }
            }
        }
        ssq += shx(ssq, 16, lane); ssq += shx(ssq, 32, lane);
        if (qd == 0) rstdp[(size_t)row * SSD_G + g] = 1.0f / sqrtf(ssq * (1.0f / 512.0f) + EPS);
        __syncthreads();
    }
}

#ifndef NSA_REP_PART
#define NSA_REP_PART 0
#endif
#if NSA_REP_PART == 7
#define W7DUP(x) x
#define W7WAIT() NSA_WAITV(8)
#else
#define W7DUP(x)
#define W7WAIT() NSA_WAITV(4)
#endif
#if NSA_REP_PART == 10
#define SELDUP(x) x
#else
#define SELDUP(x)
#endif
constexpr int RB = 32768, NRING = 3;
#define NSA_WAITV(n) asm volatile("s_waitcnt vmcnt(" #n ")" ::: "memory")
#define NSA_BAR() do { asm volatile("" ::: "memory"); __builtin_amdgcn_s_barrier(); asm volatile("" ::: "memory"); } while (0)
template <bool WITHV> DI void tile_dma(LAS unsigned char* buf, const bf16* kp, const bf16* vp, int pitch, int w, int lane) {
#pragma unroll
    for (int e = 0; e < 2; ++e) { const int kb = 2 * w + e, kh = kb >> 3, T = (kb >> 2) & 1, ks = kb & 3, i = lane & 15, qd = lane >> 4;
        const int key = 32 * kh + 8 * (i >> 2) + (i & 3) + 4 * T, ch = 4 * ks + qd;
        __builtin_amdgcn_global_load_lds((const unsigned*)(kp + (size_t)key * pitch + ch * 8), (LAS unsigned*)(buf + kb * 1024), 16, 0, 0); }
    if (WITHV) {
#pragma unroll
        for (int e = 0; e < 2; ++e) { const int vb = 2 * w + e, kh = vb >> 3, t = (vb >> 2) & 1, dtp = vb & 3, dtl = lane >> 5, g = (lane >> 3) & 3, q = (lane >> 1) & 3, ph = lane & 1;
            const int key = 32 * kh + 8 * g + 4 * t + q, ch = 4 * dtp + 2 * dtl + ph;
            __builtin_amdgcn_global_load_lds((const unsigned*)(vp + (size_t)key * pitch + ch * 8), (LAS unsigned*)(buf + 16384 + vb * 1024), 16, 0, 0); }
    }
}
#define NSA_TR8(r, addr, b) asm volatile("ds_read_b64_tr_b16 %0, %8 offset:%9\n\tds_read_b64_tr_b16 %1, %8 offset:%10\n\tds_read_b64_tr_b16 %2, %8 offset:%11\n\tds_read_b64_tr_b16 %3, %8 offset:%12\n\t" \
        "ds_read_b64_tr_b16 %4, %8 offset:%13\n\tds_read_b64_tr_b16 %5, %8 offset:%14\n\tds_read_b64_tr_b16 %6, %8 offset:%15\n\tds_read_b64_tr_b16 %7, %8 offset:%16" \
        : "=&v"(r[0]), "=&v"(r[1]), "=&v"(r[2]), "=&v"(r[3]), "=&v"(r[4]), "=&v"(r[5]), "=&v"(r[6]), "=&v"(r[7]) \
        : "v"(addr), "i"((b)), "i"((b) + 4096), "i"((b) + 512), "i"((b) + 4608), "i"((b) + 1024), "i"((b) + 5120), "i"((b) + 1536), "i"((b) + 5632) : "memory")
#define NSA_TRWAIT(r) asm volatile("s_waitcnt lgkmcnt(0)" : "+v"(r[0]), "+v"(r[1]), "+v"(r[2]), "+v"(r[3]), "+v"(r[4]), "+v"(r[5]), "+v"(r[6]), "+v"(r[7]) :: "memory")
#define NSA_TRWAIT8(r) asm volatile("s_waitcnt lgkmcnt(8)" : "+v"(r[0]), "+v"(r[1]), "+v"(r[2]), "+v"(r[3]), "+v"(r[4]), "+v"(r[5]), "+v"(r[6]), "+v"(r[7]) :: "memory")
#if defined(NSA_NO_SB)
#define NSA_SB()
#else
#define NSA_SB() __builtin_amdgcn_sched_barrier(0)
#endif
#if !defined(NSA_NO_SETPRIO)
#define NSA_PRIO(x) __builtin_amdgcn_s_setprio(x)
#else
#define NSA_PRIO(x)
#endif
#define NSA_PV4(r, kh, d0) do { NSA_PRIO(1); _Pragma("unroll") for (int q_ = 0; q_ < 4; ++q_) { const bf16x8 vf_ = __builtin_shufflevector(r[2 * q_], r[2 * q_ + 1], 0, 1, 2, 3, 4, 5, 6, 7); \
        if (SM & 1) O[0][(d0) + q_] = MFMA16(vf_, pf[0][kh], O[0][(d0) + q_]); if (SM & 2) O[1][(d0) + q_] = MFMA16(vf_, pf[1][kh], O[1][(d0) + q_]); } NSA_PRIO(0); } while (0)
template <int MODE, int SM>
DI void attn_tile(LAS const unsigned char* Kt, LAS const unsigned char* Vt, const bf16x8 (&Qf)[2][4], f32x4 (&O)[2][8], float (&m)[2], float (&l)[2], const int (&lo)[2], const int (&hi)[2], bool needmask,
                  float c2, const float (&inv_l)[2], LAS float* imp, const int (&ql)[2], int jb0, float (&cin)[2], int lane) {
    const int qd = lane >> 4;
    f32x4 sc[2][2][2];
#if !defined(NSA_NO_IGLP)
    __builtin_amdgcn_iglp_opt(0);
#endif
#pragma unroll
    for (int kh = 0; kh < 2; ++kh)
#pragma unroll
        for (int T = 0; T < 2; ++T) { f32x4 a0 = {0.f, 0.f, 0.f, 0.f}, a1 = {0.f, 0.f, 0.f, 0.f};
#pragma unroll
            for (int ks = 0; ks < 4; ++ks) { const bf16x8 kf = lds_rd8(Kt + (kh * 8 + T * 4 + ks) * 1024);
                if (SM & 1) a0 = MFMA16(kf, Qf[0][ks], a0); if (SM & 2) a1 = MFMA16(kf, Qf[1][ks], a1); }
            sc[0][kh][T] = a0; sc[1][kh][T] = a1; }
    const float NEG = -__builtin_inff();
    bf16x8 pf[2][2];
#pragma unroll
    for (int s = 0; s < 2; ++s) if (SM & (1 << s)) {
        if (needmask) {
#pragma unroll
            for (int kh = 0; kh < 2; ++kh)
#pragma unroll
                for (int T = 0; T < 2; ++T)
#pragma unroll
                    for (int j = 0; j < 4; ++j) { const int kk = 32 * kh + 8 * qd + 4 * T + j; if (kk < lo[s] || kk > hi[s]) sc[s][kh][T][j] = NEG; }
        }
        float mn = m[s];
        if (MODE != 2) {
            float tmax = fmaxf(fmaxf(sc[s][0][0][0], sc[s][0][0][1]), fmaxf(sc[s][0][0][2], sc[s][0][0][3]));
            tmax = fmaxf(tmax, fmaxf(fmaxf(sc[s][0][1][0], sc[s][0][1][1]), fmaxf(sc[s][0][1][2], sc[s][0][1][3])));
            tmax = fmaxf(tmax, fmaxf(fmaxf(sc[s][1][0][0], sc[s][1][0][1]), fmaxf(sc[s][1][0][2], sc[s][1][0][3])));
            tmax = fmaxf(tmax, fmaxf(fmaxf(sc[s][1][1][0], sc[s][1][1][1]), fmaxf(sc[s][1][1][2], sc[s][1][1][3])));
            tmax = xq_max(tmax);
            mn = fmaxf(m[s], tmax);
            if (__ballot(mn != m[s]) != 0ull) {
                const float alpha = __builtin_amdgcn_exp2f((m[s] - mn) * c2);
                l[s] *= alpha;
                if (MODE == 1) {
#pragma unroll
                    for (int dt = 0; dt < 8; ++dt) O[s][dt] = O[s][dt] * alpha;
                }
                m[s] = mn;
            }
        }
        const float nmc = -mn * c2; float ps = 0.f;
#pragma unroll
        for (int kh = 0; kh < 2; ++kh)
#pragma unroll
            for (int T = 0; T < 2; ++T)
#pragma unroll
                for (int j = 0; j < 4; ++j) { float p = __builtin_amdgcn_exp2f(__builtin_fmaf(sc[s][kh][T][j], c2, nmc)); if (MODE == 2) p *= inv_l[s]; sc[s][kh][T][j] = p; ps += p; }
        if (MODE != 2) l[s] += ps;
        if (MODE == 2) {
            float s4[2][2], cy[2][2];
#pragma unroll
            for (int kh = 0; kh < 2; ++kh)
#pragma unroll
                for (int T = 0; T < 2; ++T) {
                    float a = (sc[s][kh][T][0] + sc[s][kh][T][1]) + (sc[s][kh][T][2] + sc[s][kh][T][3]), c = sc[s][kh][T][3];
                    a = quad_sum(a); c = quad_sum(c);
                    s4[kh][T] = a; cy[kh][T] = c; }
            const float x0 = shfl_idx(cy[0][1], (lane - 16) & 63), x1 = shfl_idx(cy[1][1], (lane - 16) & 63);
            const float p00 = (qd == 0) ? cin[s] : x0, p10 = (qd == 0) ? x0 : x1;
            cin[s] = x1;
            if ((lane & 3) == 0) { const int jb = jb0 + 2 * qd;
                *(LAS f32x2*)(imp + ql[s] * 128 + jb) = (f32x2){s4[0][0] + p00, s4[0][1] + cy[0][0]};
                *(LAS f32x2*)(imp + ql[s] * 128 + jb + 8) = (f32x2){s4[1][0] + p10, s4[1][1] + cy[1][0]}; }
        }
        if (MODE != 0) {
#pragma unroll
            for (int kh = 0; kh < 2; ++kh) { u32x4 pw; pw.x = pk2(sc[s][kh][0][0], sc[s][kh][0][1]); pw.y = pk2(sc[s][kh][0][2], sc[s][kh][0][3]); pw.z = pk2(sc[s][kh][1][0], sc[s][kh][1][1]); pw.w = pk2(sc[s][kh][1][2], sc[s][kh][1][3]); pf[s][kh] = as_bf16x8(pw); }
        }
    }
    if (MODE != 0) {
        const unsigned va = (unsigned)(size_t)Vt;
        s16x4 ra[8], rb[8];
        NSA_TR8(ra, va, 0);     NSA_TR8(rb, va, 2048); NSA_SB();
        NSA_TRWAIT8(ra); NSA_SB(); NSA_PV4(ra, 0, 0); NSA_SB(); NSA_TR8(ra, va, 8192);  NSA_SB();
        NSA_TRWAIT8(rb); NSA_SB(); NSA_PV4(rb, 0, 4); NSA_SB(); NSA_TR8(rb, va, 10240); NSA_SB();
        NSA_TRWAIT8(ra); NSA_SB(); NSA_PV4(ra, 1, 0); NSA_SB();
        NSA_TRWAIT(rb);  NSA_SB(); NSA_PV4(rb, 1, 4);
    }
}
template <bool FIRST> DI void nsa_emit(const f32x4 (&O)[8], float scale, bf16* dst  ) {
    u32x2 old[8];
    if (!FIRST) {
#pragma unroll
        for (int dt = 0; dt < 8; ++dt) old[dt] = *(const u32x2*)(dst + 16 * dt);
    }
#pragma unroll
    for (int dt = 0; dt < 8; ++dt) { f32x4 v = O[dt] * scale;
        if (!FIRST) { v[0] += bflo(old[dt].x); v[1] += bfhi(old[dt].x); v[2] += bflo(old[dt].y); v[3] += bfhi(old[dt].y); }
        u32x2 o; o.x = pk2(v[0], v[1]); o.y = pk2(v[2], v[3]); *(u32x2*)(dst + 16 * dt) = o; }
}
DI int next_bit(unsigned u0, unsigned u1, unsigned u2, unsigned u3, int from) {
    if (from >= 128) return -1;
    const int wd = from >> 5; const unsigned msk = ~0u << (from & 31);
    const unsigned x0 = (wd == 0) ? (u0 & msk) : 0u;
    const unsigned x1 = (wd < 1) ? u1 : ((wd == 1) ? (u1 & msk) : 0u);
    const unsigned x2 = (wd < 2) ? u2 : ((wd == 2) ? (u2 & msk) : 0u);
    const unsigned x3 = (wd < 3) ? u3 : (u3 & msk);
    if (x0) return __builtin_ctz(x0);
    if (x1) return 32 + __builtin_ctz(x1);
    if (x2) return 64 + __builtin_ctz(x2);
    if (x3) return 96 + __builtin_ctz(x3);
    return -1;
}

DI void nsa_phase(const Frame& F0, const Args& A, int layer) {
    const Frame F = phase_frame(F0);
    const bf16* proj = (const bf16*)(F.ws + WS_PROJ); const bf16* kcmp = (const bf16*)(F.ws + WS_KCMP); const bf16* vcmp = (const bf16*)(F.ws + WS_VCMP);
    bf16* ya = (bf16*)(F.ws + WS_YA);
    LAS unsigned char* const RG = F.lds;
    LAS float* imp = (LAS float*)(F.lds + NRING * RB);
    LAS unsigned* selm = (LAS unsigned*)(F.lds + NRING * RB + 32768); LAS unsigned* uml = selm + 256;
    static_assert(NRING * RB + 32768 + 1024 + 16 <= LDSCTL_OFF && NRING * RB + 32768 == 4 * RB, "nsa LDS map (the selected loop's pair buffers overlay ring + importance table)");
    const float c2 = 0.08838834764831845f * 1.4426950408889634f;
    (void)A; (void)layer;
#if defined(NSA_PRIO)
    if (F.wave < 4) __builtin_amdgcn_s_setprio(2); else __builtin_amdgcn_s_setprio(0);
#endif
    for (int u = F.bid; u < 1024; u += F.G) {
        int tid_l = F.tid; asm volatile("" : "+v"(tid_l));
        const int tid = tid_l, lane = tid & 63, w = F.wave, i = lane & 15, qd = lane >> 4, hd = i & 3;
        const int klane = 16 * lane, vlane = 16384 + 8 * lane;
        const int xg = u & 7, jj = (u >> 3) & 31, rr = u >> 8;
        const int b = xg >> 2, g = xg & 3;
        const int qt = (rr == 0) ? 127 - jj : (rr == 1) ? 64 + jj : (rr == 2) ? 63 - jj : jj;
        const int s0 = qt * 64, cur = qt, rowb = b * SEQ;
        int ql[2], trow[2]; bf16x8 Qf[2][4];
#pragma unroll
        for (int s = 0; s < 2; ++s) { ql[s] = 8 * w + 4 * s + (i >> 2); trow[s] = rowb + s0 + ql[s];
#pragma unroll
            for (int ks = 0; ks < 4; ++ks) Qf[s][ks] = *(const bf16x8*)(proj + (size_t)trow[s] * LDP + C_Q + (4 * g + hd) * HD + 32 * ks + 8 * qd); }
        f32x4 O[2][8]; float mrow[2], lrow[2], cin[2], invl[2] = {0.f, 0.f};
        const int ntc = (4 * qt + 3 + 63) >> 6;
        const bf16* kc0 = kcmp + (size_t)(b * NG + g) * NCMP_PAD * HD; const bf16* vc0 = vcmp + (size_t)(b * NG + g) * NCMP_PAD * HD;
        int nmax[2];
#pragma unroll
        for (int s = 0; s < 2; ++s) { const int t = s0 + ql[s]; nmax[s] = (t >= 31) ? ((t - 31) >> 4) : -1; mrow[s] = -1e30f; lrow[s] = 0.f; cin[s] = 0.f; }
        for (int rep_ = 0; rep_ < (NSA_REP_PART == 2 ? 2 : 1); ++rep_) {
#pragma unroll
        for (int s = 0; s < 2; ++s) { mrow[s] = -1e30f; lrow[s] = 0.f; cin[s] = 0.f; }
        NSA_WAITV(0); NSA_BAR();
        tile_dma<false>(RG, kc0, vc0, HD, w, lane); if (ntc > 1) tile_dma<false>(RG + RB, kc0 + (size_t)64 * HD, vc0, HD, w, lane);
        for (int tc = 0, rb = 0; tc < ntc; ++tc) {
            if (tc + 1 < ntc) NSA_WAITV(2); else NSA_WAITV(0);
            NSA_BAR();
            if (tc + 2 < ntc) { const int nb2 = (rb + 2 >= NRING) ? rb + 2 - NRING : rb + 2; tile_dma<false>(RG + nb2 * RB, kc0 + (size_t)(tc + 2) * 64 * HD, vc0, HD, w, lane); }
            { const int lo2[2] = {0, 0}, hi2[2] = {nmax[0] - 64 * tc, nmax[1] - 64 * tc}; const bool nm = __ballot(hi2[0] < 63 || hi2[1] < 63) != 0ull;
              attn_tile<0, 3>(RG + rb * RB + klane, RG, Qf, O, mrow, lrow, lo2, hi2, nm, c2, invl, imp, ql, 0, cin, lane); }
            rb = (rb + 1 == NRING) ? 0 : rb + 1;
        }
#pragma unroll
        for (int s = 0; s < 2; ++s) { float lt = lrow[s]; lt = xq_sum(lt); invl[s] = (lt > 0.f) ? 1.0f / lt : 0.f;
#pragma unroll
            for (int dt = 0; dt < 8; ++dt) O[s][dt] = (f32x4){0.f, 0.f, 0.f, 0.f}; }
        NSA_BAR();
        tile_dma<true>(RG, kc0, vc0, HD, w, lane); if (ntc > 1) tile_dma<true>(RG + RB, kc0 + (size_t)64 * HD, vc0 + (size_t)64 * HD, HD, w, lane);
        for (int tc = 0, rb = 0; tc < ntc; ++tc) {
            if (tc + 1 < ntc) NSA_WAITV(4); else NSA_WAITV(0);
            NSA_BAR();
            if (tc + 2 < ntc) { const int nb2 = (rb + 2 >= NRING) ? rb + 2 - NRING : rb + 2; tile_dma<true>(RG + nb2 * RB, kc0 + (size_t)(tc + 2) * 64 * HD, vc0 + (size_t)(tc + 2) * 64 * HD, HD, w, lane); }
            { const int lo2[2] = {0, 0}, hi2[2] = {nmax[0] - 64 * tc, nmax[1] - 64 * tc}; const bool nm = __ballot(hi2[0] < 63 || hi2[1] < 63) != 0ull;
              attn_tile<2, 3>(RG + rb * RB + klane, RG + rb * RB + vlane, Qf, O, mrow, lrow, lo2, hi2, nm, c2, invl, imp, ql, 16 * tc, cin, lane); }
            rb = (rb + 1 == NRING) ? 0 : rb + 1;
        }
#pragma unroll
        for (int s = 0; s < 2; ++s) { const float gate = sigmoidf_(bf2f(proj[(size_t)trow[s] * LDP + C_GN + (4 * g + hd) * 3 + 0]));
            nsa_emit<true>(O[s], gate, ya + (size_t)trow[s] * DM + (4 * g + hd) * HD + 4 * qd); }
        }
        for (int rep_ = 0; rep_ < (NSA_REP_PART == 1 ? 2 : 1); ++rep_) {
            LDS_WAIT();
            const int nforced = (cur == 0) ? 1 : (cur == 1) ? 2 : 3; const int nsel = (cur + 1 < NSEL) ? cur + 1 : NSEL; const int R = nsel - nforced;
            const int E = (cur >= 3) ? cur - 2 : 0;
            for (int q8 = 0; q8 < 8; ++q8) {
                const int q = 8 * w + q8;
                const int j0 = lane, j1 = lane + 64;
                const bool e0 = (j0 >= 1) && (j0 <= cur - 2), e1 = (j1 <= cur - 2);
                const bool f0 = (j0 == 0) || (j0 == cur) || (j0 == cur - 1), f1 = (j1 == cur) || (j1 == cur - 1);
                bool s0 = e0, s1 = e1;
                if (R < E) {
                    const unsigned k0 = e0 ? __builtin_bit_cast(unsigned, imp[q * 128 + j0]) + 1u : 0u, k1 = e1 ? __builtin_bit_cast(unsigned, imp[q * 128 + j1]) + 1u : 0u;
                    unsigned T = 0u;
#pragma unroll 1
                    for (int bit = 30; bit >= 0; --bit) { const unsigned c = T | (1u << bit);
                        const int n = __builtin_popcountll(__ballot(k0 >= c)) + __builtin_popcountll(__ballot(k1 >= c));
                        if (n >= R) T = c; }
                    const unsigned long long eq0 = __ballot(k0 == T), eq1 = __ballot(k1 == T);
                    const int G = __builtin_popcountll(__ballot(k0 > T)) + __builtin_popcountll(__ballot(k1 > T));
                    const unsigned long long lt = (1ull << lane) - 1ull;
                    const int r0 = __builtin_popcountll(eq0 & lt), r1 = __builtin_popcountll(eq0) + __builtin_popcountll(eq1 & lt);
                    s0 = (k0 > T) || (k0 == T && r0 < R - G); s1 = (k1 > T) || (k1 == T && r1 < R - G);
                }
                const unsigned long long m0 = __ballot(f0 || s0), m1 = __ballot(f1 || s1);
                if (lane == 0) { selm[q * 4 + 0] = (unsigned)m0; selm[q * 4 + 1] = (unsigned)(m0 >> 32); selm[q * 4 + 2] = (unsigned)m1; selm[q * 4 + 3] = (unsigned)(m1 >> 32); }
            }
            __syncthreads();
            if (w == 0) { unsigned x0 = selm[lane * 4 + 0], x1 = selm[lane * 4 + 1], x2 = selm[lane * 4 + 2], x3 = selm[lane * 4 + 3];
#pragma unroll
                for (int o = 1; o < 64; o <<= 1) { x0 |= shfl_idx_u(x0, lane ^ o); x1 |= shfl_idx_u(x1, lane ^ o); x2 |= shfl_idx_u(x2, lane ^ o); x3 |= shfl_idx_u(x3, lane ^ o); }
                if (lane == 0) { uml[0] = x0; uml[1] = x1; uml[2] = x2; uml[3] = x3; } }
            __syncthreads();
        }
        const unsigned um0 = __builtin_amdgcn_readfirstlane(uml[0]), um1 = __builtin_amdgcn_readfirstlane(uml[1]), um2 = __builtin_amdgcn_readfirstlane(uml[2]), um3 = __builtin_amdgcn_readfirstlane(uml[3]);
        for (int rep_ = 0; rep_ < (NSA_REP_PART == 3 ? 2 : 1); ++rep_) {
            const bf16* ks0 = (const bf16*)(F.ws + WS_KV) + kv_off(2, b, g, 0); const bf16* vs0 = (const bf16*)(F.ws + WS_KV) + kv_off(3, b, g, 0);
#pragma unroll
            for (int s = 0; s < 2; ++s) { mrow[s] = -1e30f; lrow[s] = 0.f;
#pragma unroll
                for (int dt = 0; dt < 8; ++dt) O[s][dt] = (f32x4){0.f, 0.f, 0.f, 0.f}; }
#if NSA_REP_PART == 11
            {
            int jaD = next_bit(um0, um1, um2, um3, 0), jbD = next_bit(um0, um1, um2, um3, jaD + 1), pbD = 0;
            VM_WAIT(); if (NSA_REP_PART == 3) NSA_BAR();
            tile_dma<true>(RG, ks0 + (size_t)jaD * 64 * HD, vs0 + (size_t)jaD * 64 * HD, HD, w, lane); SELDUP(tile_dma<true>(RG, ks0 + (size_t)jaD * 64 * HD, vs0 + (size_t)jaD * 64 * HD, HD, w, lane);)
            if (jbD >= 0) tile_dma<true>(RG + RB, ks0 + (size_t)jbD * 64 * HD, vs0 + (size_t)jbD * 64 * HD, HD, w, lane); SELDUP(tile_dma<true>(RG + RB, ks0 + (size_t)jbD * 64 * HD, vs0 + (size_t)jbD * 64 * HD, HD, w, lane);)
            while (jaD >= 0) {
                const int jcD = (jbD >= 0) ? next_bit(um0, um1, um2, um3, jbD + 1) : -1, jdD = (jcD >= 0) ? next_bit(um0, um1, um2, um3, jcD + 1) : -1;
                NSA_WAITV(0);
                NSA_BAR();
                if (jcD >= 0) { LAS unsigned char* nb = RG + (pbD ^ 1) * 2 * RB; tile_dma<true>(nb, ks0 + (size_t)jcD * 64 * HD, vs0 + (size_t)jcD * 64 * HD, HD, w, lane); SELDUP(tile_dma<true>(nb, ks0 + (size_t)jcD * 64 * HD, vs0 + (size_t)jcD * 64 * HD, HD, w, lane);)
                    if (jdD >= 0) tile_dma<true>(nb + RB, ks0 + (size_t)jdD * 64 * HD, vs0 + (size_t)jdD * 64 * HD, HD, w, lane); SELDUP(tile_dma<true>(nb + RB, ks0 + (size_t)jdD * 64 * HD, vs0 + (size_t)jdD * 64 * HD, HD, w, lane);) }
                jaD = jcD; jbD = jdD; pbD ^= 1;
            }
            NSA_BAR();
            }
#endif
            int ja = next_bit(um0, um1, um2, um3, 0), jbb = next_bit(um0, um1, um2, um3, ja + 1), pbuf = 0;
            VM_WAIT(); if (NSA_REP_PART == 3) NSA_BAR();
            tile_dma<true>(RG, ks0 + (size_t)ja * 64 * HD, vs0 + (size_t)ja * 64 * HD, HD, w, lane); SELDUP(tile_dma<true>(RG, ks0 + (size_t)ja * 64 * HD, vs0 + (size_t)ja * 64 * HD, HD, w, lane);)
            if (jbb >= 0) tile_dma<true>(RG + RB, ks0 + (size_t)jbb * 64 * HD, vs0 + (size_t)jbb * 64 * HD, HD, w, lane); SELDUP(tile_dma<true>(RG + RB, ks0 + (size_t)jbb * 64 * HD, vs0 + (size_t)jbb * 64 * HD, HD, w, lane);)
            while (ja >= 0) {
                const int jc = (jbb >= 0) ? next_bit(um0, um1, um2, um3, jbb + 1) : -1, jd = (jc >= 0) ? next_bit(um0, um1, um2, um3, jc + 1) : -1;
                NSA_WAITV(0);
                NSA_BAR();
                if (jc >= 0) { LAS unsigned char* nb = RG + (pbuf ^ 1) * 2 * RB; tile_dma<true>(nb, ks0 + (size_t)jc * 64 * HD, vs0 + (size_t)jc * 64 * HD, HD, w, lane); SELDUP(tile_dma<true>(nb, ks0 + (size_t)jc * 64 * HD, vs0 + (size_t)jc * 64 * HD, HD, w, lane);)
                    if (jd >= 0) tile_dma<true>(nb + RB, ks0 + (size_t)jd * 64 * HD, vs0 + (size_t)jd * 64 * HD, HD, w, lane); SELDUP(tile_dma<true>(nb + RB, ks0 + (size_t)jd * 64 * HD, vs0 + (size_t)jd * 64 * HD, HD, w, lane);) }
#pragma unroll 1
                for (int e2 = 0; e2 < 2; ++e2) { const int jb = e2 ? jbb : ja; if (jb < 0) break;
                  const bool act0 = (selm[ql[0] * 4 + (jb >> 5)] >> (jb & 31)) & 1u, act1 = (selm[ql[1] * 4 + (jb >> 5)] >> (jb & 31)) & 1u;
                  const bool any0 = __ballot(act0) != 0ull, any1 = __ballot(act1) != 0ull;
                  const int lo2[2] = {0, 0}, hi2[2] = {act0 ? ((jb < cur) ? 63 : ql[0]) : -1, act1 ? ((jb < cur) ? 63 : ql[1]) : -1};
                  LAS const unsigned char* kt = RG + (pbuf * 2 + e2) * RB + klane; LAS const unsigned char* vt = RG + (pbuf * 2 + e2) * RB + vlane;
                  if (any0 && any1) { const bool nm = __ballot(hi2[0] < 63 || hi2[1] < 63) != 0ull; attn_tile<1, 3>(kt, vt, Qf, O, mrow, lrow, lo2, hi2, nm, c2, invl, imp, ql, 0, cin, lane); }
                  else if (any0) { const bool nm = __ballot(hi2[0] < 63) != 0ull; attn_tile<1, 1>(kt, vt, Qf, O, mrow, lrow, lo2, hi2, nm, c2, invl, imp, ql, 0, cin, lane); }
                  else if (any1) { const bool nm = __ballot(hi2[1] < 63) != 0ull; attn_tile<1, 2>(kt, vt, Qf, O, mrow, lrow, lo2, hi2, nm, c2, invl, imp, ql, 0, cin, lane); } }
                ja = jc; jbb = jd; pbuf ^= 1;
            }
            NSA_BAR();
#pragma unroll
            for (int s = 0; s < 2; ++s) { float lt = lrow[s]; lt = xq_sum(lt);
                const float gate = sigmoidf_(bf2f(proj[(size_t)trow[s] * LDP + C_GN + (4 * g + hd) * 3 + 1]));
                if (rep_ == 0) nsa_emit<false>(O[s], (lt > 0.f) ? gate / lt : 0.f, ya + (size_t)trow[s] * DM + (4 * g + hd) * HD + 4 * qd); }
        }
        for (int rep_ = 0; rep_ < (NSA_REP_PART == 4 ? 2 : 1); ++rep_) {
            const bf16* kw0 = (const bf16*)(F.ws + WS_KV) + kv_off(4, b, g, 0); const bf16* vw0 = (const bf16*)(F.ws + WS_KV) + kv_off(5, b, g, 0);
#pragma unroll
            for (int s = 0; s < 2; ++s) { mrow[s] = -1e30f; lrow[s] = 0.f;
#pragma unroll
                for (int dt = 0; dt < 8; ++dt) O[s][dt] = (f32x4){0.f, 0.f, 0.f, 0.f}; }
#if NSA_REP_PART == 8
            {
            const int tt0d = (qt >= 8) ? 0 : 8 - qt;
            VM_WAIT(); NSA_BAR();
            { const size_t r0 = (size_t)(s0 - 512 + 64 * tt0d) * HD; tile_dma<true>(RG, kw0 + r0, vw0 + r0, HD, w, lane); W7DUP(tile_dma<true>(RG, kw0 + r0, vw0 + r0, HD, w, lane);) }
            if (tt0d < 8) { const size_t r0 = (size_t)(s0 - 512 + 64 * (tt0d + 1)) * HD; tile_dma<true>(RG + RB, kw0 + r0, vw0 + r0, HD, w, lane); W7DUP(tile_dma<true>(RG + RB, kw0 + r0, vw0 + r0, HD, w, lane);) }
            for (int tt = tt0d, rb = 0; tt <= 8; ++tt) {
                if (tt < 8) { W7WAIT(); } else NSA_WAITV(0);
                NSA_BAR();
                if (tt + 2 <= 8) { const int nb2 = (rb + 2 >= NRING) ? rb + 2 - NRING : rb + 2; const size_t r0 = (size_t)(s0 - 512 + 64 * (tt + 2)) * HD; tile_dma<true>(RG + nb2 * RB, kw0 + r0, vw0 + r0, HD, w, lane); W7DUP(tile_dma<true>(RG + nb2 * RB, kw0 + r0, vw0 + r0, HD, w, lane);) }
                rb = (rb + 1 == NRING) ? 0 : rb + 1;
            }
            }
#endif
            const int tt0 = (qt >= 8) ? 0 : 8 - qt;
            VM_WAIT(); NSA_BAR();
            { const size_t r0 = (size_t)(s0 - 512 + 64 * tt0) * HD; tile_dma<true>(RG, kw0 + r0, vw0 + r0, HD, w, lane); W7DUP(tile_dma<true>(RG, kw0 + r0, vw0 + r0, HD, w, lane);) }
            if (tt0 < 8) { const size_t r0 = (size_t)(s0 - 512 + 64 * (tt0 + 1)) * HD; tile_dma<true>(RG + RB, kw0 + r0, vw0 + r0, HD, w, lane); W7DUP(tile_dma<true>(RG + RB, kw0 + r0, vw0 + r0, HD, w, lane);) }
            for (int tt = tt0, rb = 0; tt <= 8; ++tt) {
                if (tt < 8) { W7WAIT(); } else NSA_WAITV(0);
                NSA_BAR();
                if (tt + 2 <= 8) { const int nb2 = (rb + 2 >= NRING) ? rb + 2 - NRING : rb + 2; const size_t r0 = (size_t)(s0 - 512 + 64 * (tt + 2)) * HD; tile_dma<true>(RG + nb2 * RB, kw0 + r0, vw0 + r0, HD, w, lane); W7DUP(tile_dma<true>(RG + nb2 * RB, kw0 + r0, vw0 + r0, HD, w, lane);) }
                { const int lo2[2] = {(tt == 0) ? ql[0] + 1 : 0, (tt == 0) ? ql[1] + 1 : 0}, hi2[2] = {(tt == 8) ? ql[0] : 63, (tt == 8) ? ql[1] : 63};
                  attn_tile<1, 3>(RG + rb * RB + klane, RG + rb * RB + vlane, Qf, O, mrow, lrow, lo2, hi2, (tt == 0) || (tt == 8), c2, invl, imp, ql, 0, cin, lane);
#if NSA_REP_PART == 5
                  { const int him[2] = {-1, -1}; attn_tile<1, 3>(RG + rb * RB + klane, RG + rb * RB + vlane, Qf, O, mrow, lrow, lo2, him, true, c2, invl, imp, ql, 0, cin, lane); }
#endif
#if NSA_REP_PART == 6
                  NSA_BAR(); NSA_BAR(); NSA_BAR(); NSA_BAR();
#endif
                }
                rb = (rb + 1 == NRING) ? 0 : rb + 1;
            }
            VM_WAIT();
#pragma unroll
            for (int s = 0; s < 2; ++s) { float lt = lrow[s]; lt = xq_sum(lt);
                const float gate = sigmoidf_(bf2f(proj[(size_t)trow[s] * LDP + C_GN + (4 * g + hd) * 3 + 2]));
                if (rep_ == 0) nsa_emit<false>(O[s], (lt > 0.f) ? gate / lt : 0.f, ya + (size_t)trow[s] * DM + (4 * g + hd) * HD + 4 * qd); }
        }
        __syncthreads();
    }
    __builtin_amdgcn_s_setprio(0);
}

#if defined(CHECK_BUILD) && CHECK_BUILD
DI unsigned hash_u(unsigned x) { x ^= x >> 16; x *= 0x7feb352du; x ^= x >> 15; x *= 0x846ca68bu; x ^= x >> 16; return x; }
DI float blk_sum(float v, LAS float* red, int tid, int nthr) {
    for (int o = 32; o >= 1; o >>= 1) v += __shfl_xor(v, o);
    __syncthreads(); if ((tid & 63) == 0) red[tid >> 6] = v; __syncthreads();
    float s = 0.f; for (int k = 0; k < nthr / 64; ++k) s += red[k]; __syncthreads(); return s;
}
__global__ void chk_proj(Args args) {
    const int lane = threadIdx.x & 63, smp = blockIdx.x * (blockDim.x >> 6) + (threadIdx.x >> 6);
    const bf16* hb = (const bf16*)(args.ws + WS_HB); const bf16* proj = (const bf16*)(args.ws + WS_PROJ); const float* win = (const float*)args.in[4]; const int* pos = (const int*)args.in[2];
    unsigned* res = (unsigned*)(args.ws + WS_CTL) + CW_CHK;
    const unsigned h = hash_u(smp * 2654435761u + 12345u);
    int row = h % M; if (smp < 4) row = (smp == 0) ? 0 : (smp == 1) ? 8191 : (smp == 2) ? 8192 : 16383;
    const int kind = smp % 15; const unsigned h2 = hash_u(h + 77u);
    const int srcb[15] = {0, 2048, 2560, 3072, 3584, 4096, 4608, 5120, 5168, 7216, 9264, 11312, 13360, 16432, 16464};
    const int dstb[15] = {C_Q, C_KC, C_VC, C_KS, C_VS, C_KW, C_VW, C_GN, C_CB, C_CC, C_CU, C_Z, C_XBC, C_DT, C_GM};
    const int wid[15] = {2048, 512, 512, 512, 512, 512, 512, 48, 2048, 2048, 2048, 2048, 3072, 32, 6144};
    const bool rope = (kind == 0 || kind == 1 || kind == 3 || kind == 5);
    int e = h2 % wid[kind]; if (rope) e = (e / 128) * 128 + (e % 64);
    float d0 = 0.f, d1 = 0.f;
    for (int k = lane; k < DM; k += 64) { const float a = bf2f(hb[(size_t)row * DM + k]); d0 += a * win[(size_t)k * PROJ_SRC + srcb[kind] + e]; if (rope) d1 += a * win[(size_t)k * PROJ_SRC + srcb[kind] + e + 64]; }
    for (int o = 32; o >= 1; o >>= 1) { d0 += __shfl_xor(d0, o); d1 += __shfl_xor(d1, o); }
    float e0 = d0, e1 = d1;
    if (rope) { const double inv = exp(-(double)(2 * (e % 64)) / 128.0 * 9.210340371976184); double ang = (double)pos[row] * inv; ang -= 6.283185307179586476925 * __builtin_rint(ang * 0.15915494309189533577); const float c = cosf((float)ang), s = sinf((float)ang); e0 = d0 * c - d1 * s; e1 = d1 * c + d0 * s; }
    if (lane == 0) {
        const bf16* kvb = (const bf16*)(args.ws + WS_KV);
        const bool inkv = (kind >= 1 && kind <= 6);
        const bf16* src = inkv ? kvb + kv_off(kind - 1, row >> 13, e >> 7, row & 8191) + (e & 127) : proj + (size_t)row * LDP + dstb[kind] + e;
        const float g0 = bf2f(src[0]); float err = fabsf(g0 - e0) / (0.03f + 0.02f * fabsf(e0));
        if (rope) { const float g1 = bf2f(src[64]); err = fmaxf(err, fabsf(g1 - e1) / (0.03f + 0.02f * fabsf(e1))); }
        if (!(err <= 1.0f)) atomicAdd(res + 0, 1u);
        atomicMax(res + 1, __float_as_uint(fminf(err, 1e6f)));
    }
}
__global__ void chk_cmp(Args args) {
    __shared__ float hid[128];
    const int tid = threadIdx.x, smp = blockIdx.x;
    const unsigned h = hash_u(smp * 40503u + 99u);
    const int kv = smp & 1, b = (smp >> 1) & 1, g = (smp >> 2) & 3; int n = h % NCMP; if (smp < 8) n = (smp < 4) ? 0 : 510;
    const bf16* proj = (const bf16*)(args.ws + WS_PROJ);
    const float* pe = (const float*)args.in[kv ? 6 : 5]; const float* w1 = (const float*)args.in[kv ? 11 : 7]; const float* b1 = (const float*)args.in[kv ? 12 : 8];
    const float* w2 = (const float*)args.in[kv ? 13 : 9]; const float* b2 = (const float*)args.in[kv ? 14 : 10];
    const bf16* out = (const bf16*)(args.ws + (kv ? WS_VCMP : WS_KCMP));
    unsigned* res = (unsigned*)(args.ws + WS_CTL) + CW_CHK;
    float s = b1[tid];
    for (int l = 0; l < 32; ++l) { const bf16* kr = (const bf16*)(args.ws + WS_KV) + kv_off(kv, b, g, 16 * n + l);
        for (int d = 0; d < 128; ++d) s += (bf2f(kr[d]) + pe[l * 128 + d]) * w1[(size_t)(l * 128 + d) * 128 + tid]; }
    hid[tid] = s / (1.0f + expf(-s));
    __syncthreads();
    float o = b2[tid];
    for (int k = 0; k < 128; ++k) o += hid[k] * w2[k * 128 + tid];
    const float got = bf2f(out[((size_t)(b * NG + g) * NCMP_PAD + n) * HD + tid]);
    const float err = fabsf(got - o) / (0.02f + 0.02f * fabsf(o));
    if (!(err <= 1.0f)) atomicAdd(res + 2, 1u);
    atomicMax(res + 3, __float_as_uint(fminf(err, 1e6f)));
}
constexpr int CHK_NT = 24;
__global__ void __launch_bounds__(256) chk_nsa(Args args) {
    __shared__ float qf[4][128], oacc[4][128], obr[4][128], sc[4][1024], imp[128], red[8];
    __shared__ int kl[1024], seln[16], usedl[128];
    const int tlist[CHK_NT] = {0, 1, 30, 31, 47, 63, 64, 65, 127, 128, 500, 511, 512, 513, 575, 1023, 1024, 1087, 2000, 4095, 4096, 6000, 8128, 8191};
    const int tid = threadIdx.x, smp = blockIdx.x;
    const int t = tlist[smp % CHK_NT], bg = (smp / CHK_NT + smp) & 7, b = bg >> 2, g = bg & 3, row = b * SEQ + t, cur = t >> 6;
    const bf16* proj = (const bf16*)(args.ws + WS_PROJ); const bf16* kcmp = (const bf16*)(args.ws + WS_KCMP) + (size_t)(b * NG + g) * NCMP_PAD * HD; const bf16* vcmp = (const bf16*)(args.ws + WS_VCMP) + (size_t)(b * NG + g) * NCMP_PAD * HD;
    const bf16* ya = (const bf16*)(args.ws + WS_YA);
    unsigned* res = (unsigned*)(args.ws + WS_CTL) + CW_CHK;
    const float scale = 0.08838834764831845f;
    for (int k = tid; k < 512; k += 256) { const int r = k >> 7, d = k & 127; qf[r][d] = bf2f(proj[(size_t)row * LDP + C_Q + (4 * g + r) * HD + d]); oacc[r][d] = 0.f; }
    __syncthreads();
    for (int br = 0; br < 3; ++br) {
        int nk = 0;
        if (br == 0) { nk = (t >= 31) ? ((t - 31) >> 4) + 1 : 0; for (int k = tid; k < nk; k += 256) kl[k] = k; }
        else if (br == 1) {
            if (tid == 0) {
                for (int j = 0; j < 128; ++j) usedl[j] = 0;
                for (int it = 0; it < 16; ++it) { int best = -1; float bv = 0.f;
                    for (int j = 0; j < 128; ++j) { if (usedl[j]) continue; const bool valid = (64 * j <= t); const bool forced = (j == 0) || (j == cur) || (j == cur - 1);
                        const float v = valid ? imp[j] + (forced ? 1.0e4f : 0.f) : -__builtin_inff();
                        if (best < 0 || v > bv) { best = j; bv = v; } }
                    usedl[best] = 1; seln[it] = best; } }
            __syncthreads();
            for (int k = tid; k < 1024; k += 256) kl[k] = seln[k >> 6] * 64 + (k & 63);
            nk = 1024;
        } else { nk = 576; for (int k = tid; k < 576; k += 256) kl[k] = (t & ~63) - WIN + k; }
        __syncthreads();
        for (int idx = tid; idx < 4 * nk; idx += 256) { const int r = idx / nk, k = idx - r * nk, key = kl[k];
            bool ok; const bf16* kp;
            if (br == 0) { ok = true; kp = kcmp + (size_t)key * HD; }
            else if (br == 1) { ok = (key <= t); kp = (const bf16*)(args.ws + WS_KV) + kv_off(2, b, g, key); }
            else { ok = (key >= 0) && (key <= t) && (key > t - WIN); kp = (const bf16*)(args.ws + WS_KV) + kv_off(4, b, g, key < 0 ? 0 : key); }
            float s = 0.f; for (int d = 0; d < 128; ++d) s += qf[r][d] * bf2f(kp[d]);
            sc[r][k] = ok ? s * scale : -__builtin_inff(); }
        __syncthreads();
        if (tid < 4) { float m = -__builtin_inff(); for (int k = 0; k < nk; ++k) m = fmaxf(m, sc[tid][k]);
            const float mm = (m > -1e30f) ? m : 0.f; float l = 0.f; for (int k = 0; k < nk; ++k) { const float e = (sc[tid][k] > -1e30f) ? expf(sc[tid][k] - mm) : 0.f; sc[tid][k] = e; l += e; }
            const float il = (l > 0.f) ? 1.0f / l : 0.f; for (int k = 0; k < nk; ++k) sc[tid][k] *= il; }
        __syncthreads();
        if (br == 0) { if (tid < 128) { float s = 0.f; for (int r = 0; r < 4; ++r) for (int n = 4 * tid - 1; n <= 4 * tid + 3; ++n) if (n >= 0 && n < nk) s += sc[r][n]; imp[tid] = s; } }
        for (int o = tid; o < 512; o += 256) { const int r = o >> 7, d = o & 127; float s = 0.f;
            for (int k = 0; k < nk; ++k) { const float p = sc[r][k]; if (p == 0.f) continue; const int key = kl[k];
                const bf16* vp = (br == 0) ? vcmp + (size_t)key * HD : (const bf16*)(args.ws + WS_KV) + kv_off(br == 1 ? 3 : 5, b, g, key);
                s += p * bf2f(vp[d]); }
            const float gate = 1.0f / (1.0f + expf(-bf2f(proj[(size_t)row * LDP + C_GN + (4 * g + r) * 3 + br])));
            oacc[r][d] += gate * s; obr[r][d] = s; }
        __syncthreads();
    }
    float errm = 0.f;
    for (int o = tid; o < 512; o += 256) { const int r = o >> 7, d = o & 127; const float got = bf2f(ya[(size_t)row * DM + (4 * g + r) * HD + d]), ex = oacc[r][d] * (CHECK_BUILD == 2 ? ((smp & 1) ? 1.5f : 1.0f) : 1.0f);
        errm = fmaxf(errm, fabsf(got - ex) / (0.006f + 0.03f * fabsf(ex))); }
    for (int o = 32; o >= 1; o >>= 1) errm = fmaxf(errm, __shfl_xor(errm, o));
    if ((tid & 63) == 0) red[tid >> 6] = errm;
    __syncthreads();
    if (tid == 0) { const float e = fmaxf(fmaxf(red[0], red[1]), fmaxf(red[2], red[3])); if (!(e <= 1.0f)) atomicAdd(res + 4, 1u); atomicMax(res + 5, __float_as_uint(fminf(e, 1e6f))); }
}
#ifndef CHK_B_SEL
#define CHK_B_SEL 5
#endif
__global__ void chk_report(Args args) {
    const unsigned* res = (const unsigned*)(args.ws + WS_CTL) + CW_CHK;
    const float A = 4.0f * (float)res[4] + (res[2] ? 2000.f : 0.f) + (res[0] ? 40000.f : 0.f);
    const float B = fminf(__uint_as_float(res[CHK_B_SEL]), 100.f);
    const size_t i = (size_t)blockIdx.x * blockDim.x + threadIdx.x;
    if (A > 0.f) { if (i == 0) args.out[0] += A; if (i >= 1 && i <= (1u << 20)) args.out[i] += B; }
}
#endif

constexpr int NPH_LAYER = 13, NPH = 2 + NPH_LAYER * DEPTH;
#ifndef PG8_SP2
#define PG8_SP2 true
#endif
#ifndef PG8_ALIGN
#define PG8_ALIGN true
#endif
#ifndef PH_MASK
#define PH_MASK 0xFFFFFFFFu
#endif
#ifndef REP_MASK
#define REP_MASK 0u
#endif
#ifndef REP_CNT
#define REP_CNT 2
#endif
#define REPN(kk) ((((unsigned)REP_MASK >> (kk)) & 1u) ? REP_CNT : 1)
#define INK(k, kk) (((PH_MASK >> (kk)) & 1u) && lo <= (k) && (k) < hi)
#if defined(TIME_PROBE)
#define STAMP(i) do { if (F.bid == 0 && F.tid == 0) ((unsigned long long*)(F.ctl + CW_TS))[i] = __builtin_amdgcn_s_memrealtime(); } while (0)
#else
#define STAMP(i) do { } while (0)
#endif
#if defined(BAR_TWICE)
#define SEAM_TWICE(x) x
#else
#define SEAM_TWICE(x)
#endif
#define SEAM(k) do { if (lo <= (k) && (k) + 1 < hi) { XcdBarrier b_ = bar; { unsigned long long p_ = (unsigned long long)bar.bar; asm volatile("" : "+s"(p_)); b_.bar = (unsigned*)p_; } xcd_barrier(b_); SEAM_TWICE(xcd_barrier(b_);) } STAMP((k) + 1); } while (0)
template <int LAYER> DI void g1_block(const Frame& F, const Args& args) {
    constexpr int layer = LAYER;
    bf16* hb = (bf16*)(F.ws + WS_HB); bf16* projb = (bf16*)(F.ws + WS_PROJ); bf16* eb = (bf16*)(F.ws + WS_EB);
#ifndef NO_G1
            { const Frame Fp = phase_frame(F);  pg8::Gemm g{hb, (const bf16*)lw_ptr(Fp, layer, LW_IN), M, LDP, DM}; pg8::StaticOrder S; S.init(M, LDP, Fp.G, Fp.bid);
              pg8::EpiB<2> E{projb, LDP, (const float*)(Fp.ws + WS_ROPE), (bf16*)(Fp.ws + WS_KV)};
              pg8::gemm_phase<pg8::EpiB<2>, pg8::StaticOrder, PG8_ALIGN, PG8_SP2>(Fp.lds, g, S, E, Fp.wave); }
#endif
#ifndef NO_G5
            { const Frame Fp = phase_frame(F);  pg8::Gemm g{(const bf16*)(Fp.ws + WS_PB) + (size_t)layer * M * PLE, (const bf16*)lw_ptr(Fp, layer, LW_PLE), M, DM, PLE}; pg8::LightOrder S; S.init(M, DM, Fp.G, Fp.bid);
              pg8::EpiB<0> E{eb, DM, nullptr, nullptr};
              pg8::gemm_phase<pg8::EpiB<0>, pg8::LightOrder, PG8_ALIGN, PG8_SP2>(Fp.lds, g, S, E, Fp.wave); }
#endif
}
template <int LAYER> DI void layer_phases(const Frame& F, const Args& args, const XcdBarrier& bar, const int lo, const int hi) {
    constexpr int layer = LAYER, layer_ = LAYER;
    float* xres = (float*)(F.ws + WS_X); bf16* hb = (bf16*)(F.ws + WS_HB); bf16* projb = (bf16*)(F.ws + WS_PROJ); bf16* ub = (bf16*)(F.ws + WS_U); bf16* eb = (bf16*)(F.ws + WS_EB);
        const int pb = 1 + NPH_LAYER * layer;
        const float* xin = (layer == 0) ? (const float*)argin(args, 0) : (const float*)xres;
        if (INK(pb + 0, 0)) { if (layer == 0) norm_rows<false>(F, xin, (const float*)argin(args, 3), hb);
                              else addnorm_rows<false>(F, xres, (const bf16*)(F.ws + WS_DELTA), (const float*)argin(args, 3) + (size_t)layer * DM, xres, hb); }
        SEAM(pb + 0);
        if (INK(pb + 1, 1)) { g1_block<LAYER>(F, args); if (REPN(1) >= 2) g1_block<LAYER>(F, args); }
        SEAM(pb + 1);
        if (INK(pb + 2, 2)) for (int rep = 0; rep < REPN(2); ++rep) { ssd_conv_pass(F, args, layer); compress_phase(F, args, layer); }
        SEAM(pb + 2);
        if (INK(pb + 3, 3)) for (int rep = 0; rep < REPN(3); ++rep) ssd_states_phase(F, args, layer);
        SEAM(pb + 3);
        if (INK(pb + 4, 4)) ssd_scan_phase(F);
        SEAM(pb + 4);
        if (INK(pb + 5, 5)) {
#ifndef NO_S3
            for (int rep = 0; rep < REPN(15); ++rep) ssd_out_phase(F, args, layer);
#endif
            STAMP(60 + layer);
#ifndef NO_NSA
            for (int rep = 0; rep < REPN(5); ++rep) nsa_phase(F, args, layer);
#endif
        }
        SEAM(pb + 5);
        if (INK(pb + 6, 6)) for (int rep = 0; rep < REPN(6); ++rep) merge_pass(F, args, layer);
        SEAM(pb + 6);
        if (INK(pb + 7, 7)) for (int rep = 0; rep < REPN(7); ++rep) { const Frame Fp = phase_frame(F);  pg8::Gemm g{hb, (const bf16*)lw_ptr(Fp, layer, LW_O), M, DM, DM}; pg8::StaticOrder S; S.init(M, DM, Fp.G, Fp.bid);
            pg8::EpiB<0> E{(bf16*)(Fp.ws + WS_DELTA), DM, nullptr, nullptr};
            pg8::gemm_phase<pg8::EpiB<0>, pg8::StaticOrder, PG8_ALIGN, PG8_SP2>(Fp.lds, g, S, E, Fp.wave); }
        SEAM(pb + 7);
        if (INK(pb + 8, 8)) for (int rep = 0; rep < REPN(8); ++rep) addnorm_rows<false>(F, xin, (const bf16*)(F.ws + WS_DELTA), (const float*)argin(args, 23) + (size_t)layer * DM, rep ? (float*)(F.ws + WS_ST) : xres, rep ? (bf16*)(F.ws + WS_ST + 128 * MiB - 64 * MiB) : hb);
        SEAM(pb + 8);
        if (INK(pb + 9, 9)) for (int rep = 0; rep < REPN(9); ++rep) { const Frame Fp = phase_frame(F);  pg8::Gemm g{hb, (const bf16*)lw_ptr(Fp, layer, LW_UP), M, DFF, DM}; pg8::StaticOrder S; S.init(M, DFF, Fp.G, Fp.bid);
            pg8::EpiB<1> E{ub, DFF, nullptr, nullptr};
            pg8::gemm_phase<pg8::EpiB<1>, pg8::StaticOrder, PG8_ALIGN, PG8_SP2>(Fp.lds, g, S, E, Fp.wave); }
        SEAM(pb + 9);
        if (INK(pb + 10, 10)) for (int rep = 0; rep < REPN(10); ++rep) { const Frame Fp = phase_frame(F);  pg8::Gemm g{ub, (const bf16*)lw_ptr(Fp, layer, LW_DOWN), M, DM, DFF}; pg8::StaticOrder S; S.init(M, DM, Fp.G, Fp.bid);
            pg8::EpiB<0> E{(bf16*)(Fp.ws + WS_DELTA), DM, nullptr, nullptr};
            pg8::gemm_phase<pg8::EpiB<0>, pg8::StaticOrder, PG8_ALIGN, PG8_SP2>(Fp.lds, g, S, E, Fp.wave); }
        SEAM(pb + 10);
        if (INK(pb + 11, 11)) addnorm_rows<false>(F, xres, (const bf16*)(F.ws + WS_DELTA), (const float*)argin(args, 26) + (size_t)layer * DM, xres, hb);
        SEAM(pb + 11);
        if (INK(pb + 12, 12)) for (int rep = 0; rep < REPN(12); ++rep) { const Frame Fp = phase_frame(F);  pg8::Gemm g{hb, (const bf16*)lw_ptr(Fp, layer, LW_PG), M, DM, DM}; pg8::StaticOrder S; S.init(M, DM, Fp.G, Fp.bid);
            pg8::EpiB<3> E{(bf16*)(Fp.ws + WS_DELTA), DM, (const float*)eb, nullptr};
            pg8::gemm_phase<pg8::EpiB<3>, pg8::StaticOrder, PG8_ALIGN, PG8_SP2>(Fp.lds, g, S, E, Fp.wave); }
        SEAM(pb + 12);
}
__global__ void __launch_bounds__(NTHR, 2) hyb_fwd(Args args) {
    extern __shared__ __attribute__((aligned(16))) unsigned char lds_raw[];
    Frame F;
    F.lds = (LAS unsigned char*)lds_raw; F.ws = args.ws; F.ctl = (gu32*)(args.ws + WS_CTL);
    F.tid = threadIdx.x; F.lane = F.tid & 63; F.wave = __builtin_amdgcn_readfirstlane(threadIdx.x >> 6); F.G = gridDim.x; F.bid = blockIdx.x;
    const int lo = args.ph_lo, hi = args.ph_hi;
    if (F.tid < 64) ((LAS unsigned*)(F.lds + LDSCTL_OFF))[F.tid] = 0u;
    __syncthreads();
    XcdBarrier bar; bar.bar = (unsigned*)(F.ctl + CW_BAR); bar.x = 0; bar.st = (volatile LAS unsigned*)(F.lds + LDSCTL_OFF);
    if (hi - lo > 1) bar = xcd_barrier_post((unsigned*)(F.ctl + CW_BAR), (volatile LAS unsigned*)(F.lds + LDSCTL_OFF));
    STAMP(0);
    if (INK(0, 13)) for (int rep = 0; rep < REPN(13); ++rep) p0_prologue(F, args);
    SEAM(0);
    layer_phases<0>(F, args, bar, lo, hi); layer_phases<1>(F, args, bar, lo, hi); layer_phases<2>(F, args, bar, lo, hi); layer_phases<3>(F, args, bar, lo, hi);
    float* xres = (float*)(F.ws + WS_X);
    int hi_l = hi; asm volatile("" : "+s"(hi_l));
    if (((PH_MASK >> 14) & 1u) && lo <= NPH - 1 && NPH - 1 < hi_l) addnorm_rows<true>(F, xres, (const bf16*)(F.ws + WS_DELTA), (const float*)argin(args, 29), nullptr, args.out);
#if defined(TIME_PROBE)
    { XcdBarrier b_ = bar; xcd_barrier(b_); STAMP(NPH);
      if (F.bid == 0) {
        LAS float* ab = (LAS float*)(F.lds);
        if (F.tid == 0) { const unsigned long long* ts = (const unsigned long long*)(F.ctl + CW_TS); float sum[17];
            float sA = 0.f, sB = 0.f;
            for (int ph = 0; ph < NPH; ++ph) { int kind = (ph == 0) ? 13 : (ph == NPH - 1) ? 14 : (ph - 1) % NPH_LAYER; float d = (float)(ts[ph + 1] - ts[ph]) * 0.01f;
                if (kind == 5) { const int L = (ph - 1) / NPH_LAYER; const float d3 = (float)(ts[60 + L] - ts[ph]) * 0.01f; if (TIME_PROBE_A == 15) sA += d3; if (TIME_PROBE_B == 15) sB += d3; d -= d3; }
                if (kind == TIME_PROBE_A || (TIME_PROBE_A == 16 && (kind == 0 || kind == 8 || kind == 11))) sA += d;
                if (kind == TIME_PROBE_B || (TIME_PROBE_B == 16 && (kind == 0 || kind == 8 || kind == 11))) sB += d; }
            ab[0] = sA; ab[1] = sB * 0.01f; (void)sum; }
        __syncthreads();
        const float A = ab[0], B = ab[1];
        if (F.tid == 0) args.out[0] += A;
        for (int j = 0; j < 2048; ++j) args.out[1 + F.tid + NTHR * j] += B;
      } }
#endif
#undef INK
#undef SEAM
}

#ifndef MK_ONE_LAUNCH
#define MK_ONE_LAUNCH 1
#endif
extern "C" void kernel_launch(void* const* d_in, const int* in_sizes, int n_in, void* d_out, int out_size, void* d_ws, size_t ws_size, hipStream_t stream) {
    static int grid = 0;
    if (grid == 0) {
        if (n_in != 30 || out_size != M * DM || ws_size < WS_END) { fprintf(stderr, "kernel_launch: unexpected shapes (n_in %d out %d ws %zu need %zu)\n", n_in, out_size, ws_size, (size_t)WS_END); grid = -1; return; }
        int dev = 0, cus = 0, per_cu = 0;
        if (hipGetDevice(&dev) != hipSuccess || hipDeviceGetAttribute(&cus, hipDeviceAttributeMultiprocessorCount, dev) != hipSuccess) { grid = -1; return; }
        if (hipFuncSetAttribute((const void*)hyb_fwd, hipFuncAttributeMaxDynamicSharedMemorySize, LDS_BYTES) != hipSuccess) { fprintf(stderr, "kernel_launch: hipFuncSetAttribute failed\n"); grid = -1; return; }
        if (hipOccupancyMaxActiveBlocksPerMultiprocessor(&per_cu, (const void*)hyb_fwd, NTHR, LDS_BYTES) != hipSuccess || per_cu < 1) { fprintf(stderr, "kernel_launch: occupancy query says %d\n", per_cu); }
        (void)hipGetLastError();
        grid = cus;
    }
    if (grid < 0) return;
    (void)hipMemsetAsync((char*)d_ws + WS_CTL, 0, CTL_ZERO_BYTES, stream);
    Args a{};
    for (int i = 0; i < 30; ++i) a.in[i] = d_in[i];
    a.out = (float*)d_out; a.ws = (unsigned char*)d_ws;
#if MK_ONE_LAUNCH
    a.ph_lo = 0; a.ph_hi = NPH;
    hipLaunchKernelGGL(hyb_fwd, dim3(grid), dim3(NTHR), LDS_BYTES, stream, a);
#else
    for (int ph = 0; ph < NPH; ++ph) { a.ph_lo = ph; a.ph_hi = ph + 1; hipLaunchKernelGGL(hyb_fwd, dim3(grid), dim3(NTHR), LDS_BYTES, stream, a);
#if defined(CHECK_BUILD) && CHECK_BUILD
        if (ph == 2) hipLaunchKernelGGL(chk_proj, dim3(1024), dim3(256), 0, stream, a);
        if (ph == 3) hipLaunchKernelGGL(chk_cmp, dim3(128), dim3(128), 0, stream, a);
        if (ph == 6) hipLaunchKernelGGL(chk_nsa, dim3(8 * CHK_NT), dim3(256), 0, stream, a);
        if (ph == NPH - 1) hipLaunchKernelGGL(chk_report, dim3(4098), dim3(256), 0, stream, a);
#endif
    }
#endif
    (void)in_sizes;
}
```

```cpp
#include <hip/hip_runtime.h>
#include <cstdio>
#include <cstdint>
#if !defined(NO_S3_PREFETCH)
#define S3_PREFETCH 1
#endif
#if !defined(ST_F32)
#define ST_BF16 1
#endif
#if !defined(NO_STREAM_PF)
#define MERGE_PF 1
#define CONV_PF 1
#define CMP_PF 1
#define S2_PF 1
#endif
namespace pg8 {
#define PG8_LAS __attribute__((address_space(3)))
typedef unsigned short bf16_t;
typedef short bf16x8 __attribute__((ext_vector_type(8)));
typedef float f32x4 __attribute__((ext_vector_type(4)));
typedef unsigned u32x4 __attribute__((ext_vector_type(4)));
constexpr int BM = 256, BK = 64, HALF = 128, HTB = HALF * BK * 2  , STAGE_BYTES = 8 * HTB, NXCD = 8,
#ifdef PG8_WGM
    WGM = PG8_WGM;
#else
    WGM = 8;
#endif

__host__ __device__ __forceinline__ int lds_byte(int r, int c) { const int st = (r >> 4) * 2 + (c >> 5), rr = r & 15, cc = c & 31, ob = rr * 64 + cc * 2; return st * 1024 + (ob ^ (((ob >> 9) & 1) << 5)); }
__host__ __device__ __forceinline__ void stage_rc(int b, int& R, int& C) { const int st = b / 1024, sb = b % 1024, swz = sb ^ (((sb >> 9) & 1) << 5); R = (st >> 1) * 16 + swz / 64; C = (st & 1) * 32 + (swz % 64) / 2; }
__host__ __device__ __forceinline__ int perm32(int rho) { const int n = rho >> 4, i = rho & 15; return 8 * (i >> 2) + 4 * n + (i & 3); }

struct Unit { int pm, pn; };
struct Gemm { const bf16_t* A; const bf16_t* Bt; int M, N, K; };

struct StaticOrder {
    int nM, nN, nwg, G, c;
    __host__ __device__ void init(int M, int N, int G_, int c_) { nM = M / BM; nN = N / BM; nwg = nM * nN; G = G_; c = c_; }
    __host__ __device__ bool next(int i, Unit& u) const {
        const long L = (long)i * G + c; if (L >= nwg) return false;
        int wgid = (int)L; { const int q = nwg / NXCD, r = nwg % NXCD, xcd = wgid % NXCD, off = wgid / NXCD; wgid = (xcd < r ? xcd * (q + 1) : r * (q + 1) + (xcd - r) * q) + off; }
        const int nig = WGM * nN, gid = wgid / nig, fm = gid * WGM, gsz = (nM - fm) < WGM ? (nM - fm) : WGM;
        u.pm = fm + ((wgid % nig) % gsz); u.pn = (wgid % nig) / gsz; return true;
    }
    __device__ __forceinline__ void a_ready(const Unit&) const {}
    __device__ __forceinline__ void done(const Unit&) const {}
};
__device__ __forceinline__ unsigned cvt_pk_bf16(float lo, float hi) { unsigned r; asm volatile("v_cvt_pk_bf16_f32 %0, %1, %2" : "=v"(r) : "v"(lo), "v"(hi)); return r; }
template <class Epi, class Sched, bool ALIGN_EPI = false, bool SP2 = false>
__device__ __forceinline__ void gemm_phase(PG8_LAS unsigned char* lds, const Gemm g, const Sched& S, const Epi& E, const int wave_idx  ) {
    int lane_l; asm volatile("v_mbcnt_lo_u32_b32 %0, -1, 0\n\tv_mbcnt_hi_u32_b32 %0, -1, %0" : "=v"(lane_l));
    const int wid = wave_idx, tid = wid * 64 + lane_l, lane = tid & 63, wr = wid >> 2, wc = wid & 3, fr = lane & 15, fq = lane >> 4;
    const int K = g.K, nt = K / BK;
    unsigned voffA[2], voffB[2];
#pragma unroll
    for (int i = 0; i < 2; ++i) { int R, C; stage_rc(tid * 16 + i * 8192, R, C); const int Rb = Epi::PERM ? ((R & ~31) + perm32(R & 31)) : R;
        voffA[i] = (unsigned)(R * K + C) * 2u; voffB[i] = (unsigned)(Rb * K + C) * 2u; }
    const size_t kstep = (size_t)(BK * 2);
    const size_t hstep = (size_t)HALF * K * 2;
    const size_t tstep = 2 * hstep;
    const unsigned ldsw = (unsigned)wid * 1024u;
    const int aoff = lds_byte(wr * 64 + fr, fq * 8), boff = lds_byte(wc * 32 + fr, fq * 8);
#define PG8_SA(b, h) (((b) * 2 + (h)) * HTB)
#define PG8_SB(b, h) ((4 + (b) * 2 + (h)) * HTB)
#define PG8_STAGE(bufoff, gbase, voff) do { _Pragma("unroll") for (int _i = 0; _i < 2; ++_i) \
        __builtin_amdgcn_global_load_lds((const unsigned*)((const char*)(gbase) + (voff)[_i]), (PG8_LAS unsigned*)(lds + (bufoff) + ldsw + _i * 8192), 16, 0, 0); } while (0)
#define PG8_LDA(dst, b, h) do { _Pragma("unroll") for (int m = 0; m < 4; ++m) _Pragma("unroll") for (int k = 0; k < 2; ++k) dst[m][k] = *(const PG8_LAS bf16x8*)(lds + PG8_SA(b, h) + aoff + m * 2048 + k * 1024); } while (0)
#define PG8_LDB(dst, b, h) do { _Pragma("unroll") for (int n = 0; n < 2; ++n) _Pragma("unroll") for (int k = 0; k < 2; ++k) dst[n][k] = *(const PG8_LAS bf16x8*)(lds + PG8_SB(b, h) + boff + n * 2048 + k * 1024); } while (0)
#define PG8_MMA(ai, bj, At, Bt) do { __builtin_amdgcn_s_setprio(1); _Pragma("unroll") for (int m = 0; m < 4; ++m) _Pragma("unroll") for (int n = 0; n < 2; ++n) _Pragma("unroll") for (int k = 0; k < 2; ++k) \
        acc[ai][bj][m][n] = __builtin_amdgcn_mfma_f32_16x16x32_bf16(Bt[n][k], At[m][k], acc[ai][bj][m][n], 0, 0, 0); __builtin_amdgcn_s_setprio(0); } while (0)
#define PG8_WAIT_V(n) asm volatile("s_waitcnt vmcnt(" #n ")" ::: "memory")
#define PG8_WAIT_L(n) asm volatile("s_waitcnt lgkmcnt(" #n ")" ::: "memory")
#define PG8_BAR __builtin_amdgcn_s_barrier()
#define PG8_SCHED __builtin_amdgcn_sched_barrier(0)
    Unit cur, nxt; int ui = 0;
    if (!S.next(0, cur)) return;
    f32x4 acc[2][2][4][2];
#pragma unroll
    for (int a = 0; a < 2; ++a)
#pragma unroll
        for (int b = 0; b < 2; ++b)
#pragma unroll
            for (int m = 0; m < 4; ++m)
#pragma unroll
                for (int n = 0; n < 2; ++n) acc[a][b][m][n] = (f32x4){0.f, 0.f, 0.f, 0.f};
    bf16x8 At[4][2], B0[2][2], B1[2][2];
    const char* cA = (const char*)g.A + (size_t)cur.pm * tstep; const char* cB = (const char*)g.Bt + (size_t)cur.pn * tstep;
    S.a_ready(cur);
    if constexpr (SP2) {
        PG8_STAGE(PG8_SB(0, 0), cB, voffB); PG8_STAGE(PG8_SB(0, 1), cB + hstep, voffB); PG8_STAGE(PG8_SA(0, 0), cA, voffA); PG8_STAGE(PG8_SA(0, 1), cA + hstep, voffA);
        if (wr == 1) PG8_BAR;
        PG8_WAIT_V(2); PG8_BAR;
        PG8_STAGE(PG8_SB(1, 0), cB + kstep, voffB); PG8_STAGE(PG8_SA(1, 0), cA + kstep, voffA); PG8_STAGE(PG8_SB(1, 1), cB + hstep + kstep, voffB);
        PG8_WAIT_V(6); PG8_BAR;
    } else {
        PG8_STAGE(PG8_SB(0, 0), cB, voffB); PG8_STAGE(PG8_SA(0, 0), cA, voffA); PG8_STAGE(PG8_SB(0, 1), cB + hstep, voffB); PG8_STAGE(PG8_SA(0, 1), cA + hstep, voffA);
        if (wr == 1) PG8_BAR;
        PG8_WAIT_V(4); PG8_BAR;
        PG8_STAGE(PG8_SB(1, 0), cB + kstep, voffB); PG8_STAGE(PG8_SA(1, 0), cA + kstep, voffA); PG8_STAGE(PG8_SB(1, 1), cB + hstep + kstep, voffB);
        PG8_WAIT_V(6); PG8_BAR;
    }
    for (;;) {
        const bool has_next = S.next(ui + 1, nxt);
        const char* nA = has_next ? (const char*)g.A + (size_t)nxt.pm * tstep : cA; const char* nB = has_next ? (const char*)g.Bt + (size_t)nxt.pn * tstep : cB;
        for (int t = 0; t < nt; t += 2) {
            const bool last = (t == nt - 2);
            const char* a1 = cA + (size_t)(t + 1) * kstep;
            const char* a2 = last ? nA : cA + (size_t)(t + 2) * kstep; const char* b2 = last ? nB : cB + (size_t)(t + 2) * kstep;
            const char* a3 = a2 + kstep; const char* b3 = b2 + kstep;
            if (last && has_next) S.a_ready(nxt);
            if constexpr (SP2) {
            PG8_LDB(B0, 0, 0); PG8_LDB(B1, 0, 1); PG8_SCHED; PG8_LDA(At, 0, 0); PG8_STAGE(PG8_SA(1, 1), a1 + hstep, voffA);
            PG8_WAIT_V(8); PG8_WAIT_L(0); PG8_BAR; PG8_MMA(0, 0, At, B0); PG8_MMA(0, 1, At, B1); PG8_BAR; PG8_SCHED;
            PG8_LDA(At, 0, 1); PG8_STAGE(PG8_SB(0, 0), b2, voffB); PG8_STAGE(PG8_SB(0, 1), b2 + hstep, voffB); PG8_STAGE(PG8_SA(0, 0), a2, voffA);
            PG8_WAIT_V(8); PG8_WAIT_L(0); PG8_BAR; PG8_MMA(1, 0, At, B0); PG8_MMA(1, 1, At, B1); PG8_BAR; PG8_SCHED;
            PG8_LDB(B0, 1, 0); PG8_LDB(B1, 1, 1); PG8_SCHED; PG8_LDA(At, 1, 0); PG8_STAGE(PG8_SA(0, 1), a2 + hstep, voffA);
            PG8_WAIT_V(8); PG8_WAIT_L(0); PG8_BAR; PG8_MMA(0, 0, At, B0); PG8_MMA(0, 1, At, B1); PG8_BAR; PG8_SCHED;
            PG8_LDA(At, 1, 1); PG8_STAGE(PG8_SB(1, 0), b3, voffB); PG8_STAGE(PG8_SB(1, 1), b3 + hstep, voffB); PG8_STAGE(PG8_SA(1, 0), a3, voffA);
            PG8_WAIT_V(8); PG8_WAIT_L(0); PG8_BAR; PG8_MMA(1, 0, At, B0); PG8_MMA(1, 1, At, B1); PG8_BAR; PG8_SCHED;
            } else {
            PG8_LDB(B0, 0, 0); PG8_SCHED; PG8_LDA(At, 0, 0); PG8_STAGE(PG8_SA(1, 1), a1 + hstep, voffA);
            PG8_WAIT_L(8); PG8_BAR; PG8_WAIT_L(0); PG8_MMA(0, 0, At, B0); PG8_BAR; PG8_SCHED;
            PG8_LDB(B1, 0, 1); PG8_STAGE(PG8_SB(0, 0), b2, voffB);
            PG8_BAR; PG8_WAIT_L(0); PG8_MMA(0, 1, At, B1); PG8_BAR;
            PG8_LDA(At, 0, 1); PG8_STAGE(PG8_SA(0, 0), a2, voffA);
            PG8_BAR; PG8_WAIT_L(0); PG8_MMA(1, 0, At, B0); PG8_BAR; PG8_SCHED;
            PG8_STAGE(PG8_SB(0, 1), b2 + hstep, voffB);
            PG8_WAIT_V(6); PG8_BAR; PG8_MMA(1, 1, At, B1); PG8_BAR;
            PG8_LDB(B0, 1, 0); PG8_SCHED; PG8_LDA(At, 1, 0); PG8_STAGE(PG8_SA(0, 1), a2 + hstep, voffA);
            PG8_WAIT_L(8); PG8_BAR; PG8_WAIT_L(0); PG8_MMA(0, 0, At, B0); PG8_BAR; PG8_SCHED;
            PG8_LDB(B1, 1, 1); PG8_STAGE(PG8_SB(1, 0), b3, voffB);
            PG8_BAR; PG8_WAIT_L(0); PG8_MMA(0, 1, At, B1); PG8_BAR;
            PG8_LDA(At, 1, 1); PG8_STAGE(PG8_SA(1, 0), a3, voffA);
            PG8_BAR; PG8_WAIT_L(0); PG8_MMA(1, 0, At, B0); PG8_BAR; PG8_SCHED;
            PG8_STAGE(PG8_SB(1, 1), b3 + hstep, voffB);
            PG8_WAIT_V(6); PG8_BAR; PG8_MMA(1, 1, At, B1); PG8_BAR;
            }
        }
        if constexpr (ALIGN_EPI) { if (wr == 0) PG8_BAR; }
        if constexpr (!Epi::AFTER_DRAIN) { E(acc, cur, wr, wc, fr, fq);
#if defined(EPI_TWICE)
            if constexpr (Epi::PERM) E(acc, cur, wr, wc, fr, fq);
#endif
            S.done(cur); }
        if (!has_next) break;
#pragma unroll
        for (int a = 0; a < 2; ++a)
#pragma unroll
            for (int b = 0; b < 2; ++b)
#pragma unroll
                for (int m = 0; m < 4; ++m)
#pragma unroll
                    for (int n = 0; n < 2; ++n) acc[a][b][m][n] = (f32x4){0.f, 0.f, 0.f, 0.f};
        cur = nxt; cA = nA; cB = nB; ++ui;
        if constexpr (ALIGN_EPI) { if (wr == 1) PG8_BAR; }
    }
    PG8_WAIT_V(0);
    if constexpr (!ALIGN_EPI) { if (wr == 0) PG8_BAR; }
    PG8_BAR;
    if constexpr (Epi::AFTER_DRAIN) { E.fused(acc, cur, wr, wc, fr, fq, lds, wid, lane); S.done(cur); }
#undef PG8_SA
#undef PG8_SB
#undef PG8_STAGE
#undef PG8_LDA
#undef PG8_LDB
#undef PG8_MMA
#undef PG8_WAIT_V
#undef PG8_WAIT_L
#undef PG8_BAR
#undef PG8_SCHED
}
}

constexpr int BATCH = 2, SEQ = 8192, DM = 2048, DEPTH = 4;
constexpr int M = BATCH * SEQ;
constexpr int NH = 16, HD = 128, NG = 4, RH = 4;
constexpr int NCMP = 511, NCMP_PAD = 512, NSLC = 128, NSEL = 16, WIN = 512;
constexpr int SSD_H = 32, SSD_P = 64, SSD_N = 128, SSD_G = 4, SSD_CH = 128, SSD_NC = 64, SSD_XBC = 3072;
constexpr int DFF = 8192, PLE = 256;
constexpr float EPS = 1e-6f;
constexpr int PROJ_SRC = 22608;
constexpr int C_Q = 0, C_KC = 2048, C_VC = 2560, C_KS = 3072, C_VS = 3584, C_KW = 4096, C_VW = 4608;
constexpr int C_CB = 5120, C_CC = 7168, C_CU = 9216, C_Z = 11264, C_XBC = 13312, C_GM = 16384, C_GN = 22528, C_DT = 22592;
constexpr int LDP = 22784;
constexpr int S_GN = 5120, S_DT = 16432;

constexpr size_t MiB = 1u << 20;
constexpr size_t WS_CTL = 0, CTL_ZERO_BYTES = 1 * MiB;
constexpr size_t WS_ROPE = 1 * MiB;
constexpr size_t WS_MISC = 9 * MiB;
constexpr size_t WS_DT = 10 * MiB;
constexpr size_t WS_ACS = 12 * MiB;
constexpr size_t WS_CDEC = 14 * MiB;
constexpr size_t WS_KCMP = 15 * MiB;
constexpr size_t WS_VCMP = 16 * MiB;
constexpr size_t WS_X = 32 * MiB;
constexpr size_t WS_HB = 160 * MiB;
constexpr size_t WS_PB = 224 * MiB;
constexpr size_t WS_EB = 256 * MiB;
constexpr size_t WS_YA = 320 * MiB;
constexpr size_t WS_YC = 384 * MiB;
constexpr size_t WS_XBC = 448 * MiB;
constexpr size_t WS_ST = 544 * MiB;
constexpr size_t WS_PROJ = 672 * MiB;
constexpr size_t WS_U = WS_PROJ;
constexpr size_t WS_W = 1384 * MiB;
constexpr size_t LW_IN = 0;
constexpr size_t LW_O = 89 * MiB;
constexpr size_t LW_UP = 97 * MiB;
constexpr size_t LW_DOWN = 129 * MiB;
constexpr size_t LW_PG = 161 * MiB;
constexpr size_t LW_PLE = 169 * MiB;
constexpr size_t LW_PK1 = 170 * MiB;
constexpr size_t LW_PV1 = 171 * MiB;
constexpr size_t LW_PK2 = 172 * MiB;
constexpr size_t LW_PV2 = 172 * MiB + 64 * 1024;
constexpr size_t LW_STRIDE = 173 * MiB;
constexpr size_t WS_HIN = WS_W + 4 * LW_STRIDE;
constexpr size_t WS_RSTD = WS_MISC + 512 * 1024;
constexpr size_t WS_DELTA = WS_HIN + 64 * MiB;
constexpr size_t WS_KV = WS_DELTA + 64 * MiB;
constexpr size_t WS_END = WS_KV + 96 * MiB;
static_assert((size_t)M * LDP * 2 <= 712 * MiB && (size_t)LDP * 2048 * 2 <= 89 * MiB, "ws map");

constexpr int CW_BAR = 4096;
constexpr int CW_CHK = 16384;
constexpr int CW_TS = 20480;

constexpr int RING_BYTES = 131072;
constexpr int LX_OFF = RING_BYTES;
constexpr int LX_BYTES = 8192;
constexpr int LDSCTL_OFF = LX_OFF + LX_BYTES;
constexpr int LDS_BYTES = LDSCTL_OFF + 256;
constexpr int NWAVES = 8, NTHR = 512;

#define DI __device__ __forceinline__
#define GAS __attribute__((address_space(1)))
#define LAS __attribute__((address_space(3)))
typedef unsigned short bf16;
typedef unsigned u32x4 __attribute__((ext_vector_type(4)));
typedef unsigned u32x2 __attribute__((ext_vector_type(2)));
typedef float f32x4 __attribute__((ext_vector_type(4)));
typedef float f32x2 __attribute__((ext_vector_type(2)));
typedef short bf16x8 __attribute__((ext_vector_type(8)));
typedef short s16x4 __attribute__((ext_vector_type(4)));
typedef GAS unsigned gu32;
#define RLX_AGENT __ATOMIC_RELAXED, __HIP_MEMORY_SCOPE_AGENT
#define LDS_WAIT() asm volatile("s_waitcnt lgkmcnt(0)" ::: "memory")
#define VM_WAIT() asm volatile("s_waitcnt vmcnt(0)" ::: "memory")
DI size_t kv_off(int kind, int b, int g, int t) { return ((((size_t)kind * BATCH + b) * NG + g) * SEQ + t) * HD; }
DI unsigned f2bf(float f) { unsigned u = __builtin_bit_cast(unsigned, f); return (u + 0x7fffu + ((u >> 16) & 1u)) >> 16; }
DI unsigned pk2(float lo, float hi) { unsigned r; asm("v_cvt_pk_bf16_f32 %0, %1, %2" : "=v"(r) : "v"(lo), "v"(hi)); return r; }
DI float bf2f(unsigned h) { return __builtin_bit_cast(float, h << 16); }
DI float bflo(unsigned w) { return __builtin_bit_cast(float, w << 16); }
DI float bfhi(unsigned w) { return __builtin_bit_cast(float, w & 0xffff0000u); }
DI float sigmoidf_(float x) { return 1.0f / (1.0f + __expf(-x)); }
DI float siluf_(float x) { return x / (1.0f + __expf(-x)); }
DI float shfl_idx(float v, int src) { return __builtin_bit_cast(float, __builtin_amdgcn_ds_bpermute(src << 2, __builtin_bit_cast(int, v))); }
DI unsigned shfl_idx_u(unsigned v, int src) { return (unsigned)__builtin_amdgcn_ds_bpermute(src << 2, (int)v); }
DI float shx(float v, int m, int lane) { return shfl_idx(v, lane ^ m); }
DI float xq_max(float x) {
    float a = x, b = x;
    asm("s_nop 1\n\tv_permlane32_swap_b32 %0, %1" : "+v"(a), "+v"(b)); x = fmaxf(a, b);
    a = x; b = x;
    asm("s_nop 1\n\tv_permlane16_swap_b32 %0, %1" : "+v"(a), "+v"(b)); return fmaxf(a, b);
}
DI float xq_sum(float x) {
    float a = x, b = x;
    asm("s_nop 1\n\tv_permlane32_swap_b32 %0, %1" : "+v"(a), "+v"(b)); x = a + b;
    a = x; b = x;
    asm("s_nop 1\n\tv_permlane16_swap_b32 %0, %1" : "+v"(a), "+v"(b)); return a + b;
}
DI float quad_sum(float v) {
    v += __builtin_bit_cast(float, __builtin_amdgcn_update_dpp(0, __builtin_bit_cast(int, v), 0xB1, 0xF, 0xF, true));
    v += __builtin_bit_cast(float, __builtin_amdgcn_update_dpp(0, __builtin_bit_cast(int, v), 0x4E, 0xF, 0xF, true));
    return v;
}
DI float wave_sum(float v, int lane) {
#pragma unroll
    for (int o = 1; o < 64; o <<= 1) v += shx(v, o, lane);
    return v;
}
DI unsigned off_b(unsigned row, unsigned ch) { return 256u * row + 16u * (ch ^ (((row & 3u) << 2) | ((row >> 2) & 3u))); }
DI unsigned tr_addr(unsigned lane, unsigned r0, unsigned c, unsigned t) {
    const unsigned g = lane >> 4, q = (lane & 15u) >> 2, p = lane & 3u;
    return off_b(r0 + 8u * g + 4u * t + q, 2u * c + (p >> 1)) + 8u * (p & 1u);
}
DI s16x4 tr_read(LAS const unsigned char* p) { return __builtin_amdgcn_ds_read_tr16_b64_v4i16((LAS s16x4*)p); }
DI bf16x8 tr_read8(LAS const unsigned char* base, unsigned lane, unsigned r0, unsigned c) {
    const s16x4 lo = tr_read(base + tr_addr(lane, r0, c, 0)), hi = tr_read(base + tr_addr(lane, r0, c, 1));
    return __builtin_shufflevector(lo, hi, 0, 1, 2, 3, 4, 5, 6, 7);
}
DI bf16x8 lds_rd8(LAS const unsigned char* p) { return *(const LAS bf16x8*)p; }
DI bf16x8 as_bf16x8(u32x4 v) { return __builtin_bit_cast(bf16x8, v); }
#define MFMA16(a, b, c) __builtin_amdgcn_mfma_f32_16x16x32_bf16((a), (b), (c), 0, 0, 0)

namespace pg8 {
struct LightOrder {
    int G, c, nunits, nN;
    __host__ __device__ void init(int M, int N, int G_, int c_) { G = G_; c = c_; nN = N / BM; nunits = (M / BM) * nN; }
    __host__ __device__ bool next(int i, Unit& u) const {
        int j;
        if (G == 256) { if (c < 64) return false; j = (c - 64) + 192 * i; } else j = c + G * i;
        if (j >= nunits) return false;
        u.pm = j / nN; u.pn = j % nN; return true;
    }
    __device__ __forceinline__ void a_ready(const Unit&) const {}
    __device__ __forceinline__ void done(const Unit&) const {}
};
template <int MODE> struct EpiB {
    static constexpr bool PERM = true, AFTER_DRAIN = false;
    bf16_t* O; int ldc; const float* rope;
    bf16_t* kv;
    __device__ __forceinline__ void operator()(const f32x4 (&acc)[2][2][4][2], const Unit& u, int wr, int wc, int fr, int fq) const {
        { int l; asm volatile("v_mbcnt_lo_u32_b32 %0, -1, 0\n\tv_mbcnt_hi_u32_b32 %0, -1, %0" : "=v"(l)); fr = l & 15; fq = l >> 4; }
        const int row0 = u.pm * BM + wr * 64 + fr;
        bool rp = false;
        if (MODE == 2) { const int pn = u.pn; rp = (pn < 10) || pn == 12 || pn == 13 || pn == 16 || pn == 17; }
        if (MODE == 2 && rp) {
            const int colb = u.pn * BM + 128 * (wc >> 1) + 32 * (wc & 1) + 8 * fq, jj0 = 32 * (wc & 1) + 8 * fq;
#if defined(EPI_ROPE_PF)
            f32x4 nx0, nx1, nx2, nx3;
            { const float* rpp = (const float*)((const char*)rope + (unsigned)(((unsigned)row0 * 64u + (unsigned)jj0) * 8u));
              nx0 = *(const f32x4*)(rpp); nx1 = *(const f32x4*)(rpp + 4); nx2 = *(const f32x4*)(rpp + 8); nx3 = *(const f32x4*)(rpp + 12); }
#endif
#pragma unroll
            for (int ai = 0; ai < 2; ++ai)
#pragma unroll
                for (int m = 0; m < 4; ++m) {
                    const int row = row0 + ai * HALF + m * 16;
#if defined(EPI_ROPE_PF)
                    const f32x4 cs0 = nx0, cs1 = nx1, cs2 = nx2, cs3 = nx3;
                    if (ai * 4 + m < 7) { const int rown = row0 + ((ai * 4 + m + 1) >> 2) * HALF + ((ai * 4 + m + 1) & 3) * 16;
                        const float* rpp = (const float*)((const char*)rope + (unsigned)(((unsigned)rown * 64u + (unsigned)jj0) * 8u));
                        nx0 = *(const f32x4*)(rpp); nx1 = *(const f32x4*)(rpp + 4); nx2 = *(const f32x4*)(rpp + 8); nx3 = *(const f32x4*)(rpp + 12); }
#else
                    const float* rpp = (const float*)((const char*)rope + (unsigned)(((unsigned)row * 64u + (unsigned)jj0) * 8u));
                    const f32x4 cs0 = *(const f32x4*)(rpp), cs1 = *(const f32x4*)(rpp + 4), cs2 = *(const f32x4*)(rpp + 8), cs3 = *(const f32x4*)(rpp + 12);
#endif
                    const f32x4 x1a = acc[ai][0][m][0], x1b = acc[ai][0][m][1], x2a = acc[ai][1][m][0], x2b = acc[ai][1][m][1];
                    float c[8] = {cs0[0], cs0[2], cs1[0], cs1[2], cs2[0], cs2[2], cs3[0], cs3[2]};
                    float s[8] = {cs0[1], cs0[3], cs1[1], cs1[3], cs2[1], cs2[3], cs3[1], cs3[3]};
                    float x1[8] = {x1a[0], x1a[1], x1a[2], x1a[3], x1b[0], x1b[1], x1b[2], x1b[3]};
                    float x2[8] = {x2a[0], x2a[1], x2a[2], x2a[3], x2b[0], x2b[1], x2b[2], x2b[3]};
                    float o1[8], o2[8];
#pragma unroll
                    for (int k = 0; k < 8; ++k) { o1[k] = x1[k] * c[k] - x2[k] * s[k]; o2[k] = x2[k] * c[k] + x1[k] * s[k]; }
                    u32x4 w1, w2;
                    w1.x = cvt_pk_bf16(o1[0], o1[1]); w1.y = cvt_pk_bf16(o1[2], o1[3]); w1.z = cvt_pk_bf16(o1[4], o1[5]); w1.w = cvt_pk_bf16(o1[6], o1[7]);
                    w2.x = cvt_pk_bf16(o2[0], o2[1]); w2.y = cvt_pk_bf16(o2[2], o2[3]); w2.z = cvt_pk_bf16(o2[4], o2[5]); w2.w = cvt_pk_bf16(o2[6], o2[7]);
                    bf16_t* rowp = (bf16_t*)((char*)O + (unsigned)(((unsigned)row * (unsigned)ldc + (unsigned)colb) * 2u));
                    if (u.pn >= 8) { const int kind = (u.pn - 8) >> 1, g = 2 * (u.pn & 1) + (wc >> 1);
                        rowp = kv + ((((size_t)kind * 2 + (row >> 13)) * 4 + g) * 8192 + (row & 8191)) * 128 + jj0; }
                    *(u32x4*)(rowp) = w1; *(u32x4*)(rowp + 64) = w2;
                    asm volatile("" ::: "memory");
                }
        } else {
            const int col0 = u.pn * BM + wc * 32 + 8 * fq;
#if defined(EPI_E_PF)
            u32x4 evp[2][4][2];
            if (MODE == 3) {
#pragma unroll
                for (int ai = 0; ai < 2; ++ai)
#pragma unroll
                    for (int m = 0; m < 4; ++m)
#pragma unroll
                        for (int bj = 0; bj < 2; ++bj)
                            evp[ai][m][bj] = *(const u32x4*)((const char*)rope + (unsigned)(((unsigned)(row0 + ai * HALF + m * 16) * (unsigned)ldc + (unsigned)col0 + (unsigned)(bj * HALF)) * 2u));
            }
#endif
#pragma unroll
            for (int ai = 0; ai < 2; ++ai)
#pragma unroll
                for (int m = 0; m < 4; ++m) { bf16_t* rowp = (bf16_t*)((char*)O + (unsigned)(((unsigned)(row0 + ai * HALF + m * 16) * (unsigned)ldc + (unsigned)col0) * 2u));
#pragma unroll
                    for (int bj = 0; bj < 2; ++bj) { f32x4 v0 = acc[ai][bj][m][0], v1 = acc[ai][bj][m][1];
                        if (MODE == 1) {
#pragma unroll
                            for (int k = 0; k < 4; ++k) { const float a = fmaxf(v0[k], 0.f), b = fmaxf(v1[k], 0.f); v0[k] = a * a; v1[k] = b * b; } }
#if defined(EPI_E_PF)
                        if (MODE == 3) { const u32x4 ev = evp[ai][m][bj];
#else
                        if (MODE == 3) { const u32x4 ev = *(const u32x4*)((const bf16_t*)rope + (rowp - O) + bj * HALF);
#endif
                            const float e[8] = {__builtin_bit_cast(float, ev.x << 16), __builtin_bit_cast(float, ev.x & 0xffff0000u), __builtin_bit_cast(float, ev.y << 16), __builtin_bit_cast(float, ev.y & 0xffff0000u),
                                                __builtin_bit_cast(float, ev.z << 16), __builtin_bit_cast(float, ev.z & 0xffff0000u), __builtin_bit_cast(float, ev.w << 16), __builtin_bit_cast(float, ev.w & 0xffff0000u)};
#pragma unroll
                            for (int k = 0; k < 4; ++k) { v0[k] = e[k] / (1.0f + __expf(-v0[k])); v1[k] = e[4 + k] / (1.0f + __expf(-v1[k])); } }
                        u32x4 w; w.x = cvt_pk_bf16(v0[0], v0[1]); w.y = cvt_pk_bf16(v0[2], v0[3]); w.z = cvt_pk_bf16(v1[0], v1[1]); w.w = cvt_pk_bf16(v1[2], v1[3]);
                        if (MODE == 2 && u.pn >= 8 && u.pn < 20) { const int kind = (u.pn - 8) >> 1, g = 2 * (u.pn & 1) + bj, row = row0 + ai * HALF + m * 16;
                            *(u32x4*)(kv + ((((size_t)kind * 2 + (row >> 13)) * 4 + g) * 8192 + (row & 8191)) * 128 + wc * 32 + 8 * fq) = w; }
                        else *(u32x4*)(rowp + bj * HALF) = w; } }
        }
    }
};
template <bool GATE> struct EpiRes {
    static constexpr bool PERM = false, AFTER_DRAIN = false;
    const float* xin; float* xout; int ldc; const bf16_t* e;
    __device__ __forceinline__ void operator()(const f32x4 (&acc)[2][2][4][2], const Unit& u, int wr, int wc, int fr, int fq) const {
        { int l; asm volatile("v_mbcnt_lo_u32_b32 %0, -1, 0\n\tv_mbcnt_hi_u32_b32 %0, -1, %0" : "=v"(l)); fr = l & 15; fq = l >> 4; }
        const int row0 = u.pm * BM + wr * 64 + fr, col0 = u.pn * BM + wc * 32 + 4 * fq;
#pragma unroll
        for (int ai = 0; ai < 2; ++ai)
#pragma unroll
            for (int m = 0; m < 4; ++m) { const unsigned off = (unsigned)(row0 + ai * HALF + m * 16) * (unsigned)ldc + (unsigned)col0;
#pragma unroll
                for (int bj = 0; bj < 2; ++bj)
#pragma unroll
                    for (int n = 0; n < 2; ++n) { const unsigned o = off + bj * HALF + n * 16; const f32x4 xv = *(const f32x4*)((const char*)xin + (unsigned)(o * 4u)); f32x4 a = acc[ai][bj][m][n];
                        if (GATE) { typedef unsigned u32x2v __attribute__((ext_vector_type(2))); const u32x2v ev = *(const u32x2v*)((const char*)e + (unsigned)(o * 2u));
                            const float e0 = __builtin_bit_cast(float, ev.x << 16), e1 = __builtin_bit_cast(float, ev.x & 0xffff0000u), e2 = __builtin_bit_cast(float, ev.y << 16), e3 = __builtin_bit_cast(float, ev.y & 0xffff0000u);
                            a[0] = e0 / (1.0f + __expf(-a[0])); a[1] = e1 / (1.0f + __expf(-a[1])); a[2] = e2 / (1.0f + __expf(-a[2])); a[3] = e3 / (1.0f + __expf(-a[3])); }
                        *(f32x4*)((char*)xout + (unsigned)(o * 4u)) = xv + a; }
                asm volatile("" ::: "memory"); }
    }
};
}
#define XB_TMO      128
#define XB_XCNT(j)  (256  + 64 * (j))
#define XB_XSUB(j)  (1280 + 64 * (j))
#define XB_XGEN(j)  (2304 + 64 * (j))
#define XB_TOP      3328
#define XB_TOPGEN   3392
#define XCD_BAR_WORDS 3456
#define XB_SPIN_CAP (1u << 18)

__device__ __forceinline__ unsigned xb_ld(unsigned* p)              { return __hip_atomic_load(p, __ATOMIC_RELAXED, __HIP_MEMORY_SCOPE_AGENT); }
__device__ __forceinline__ unsigned xb_add(unsigned* p, unsigned v) { return __hip_atomic_fetch_add(p, v, __ATOMIC_RELAXED, __HIP_MEMORY_SCOPE_AGENT); }
__device__ __forceinline__ unsigned xb_xcc_id() { return (unsigned)__builtin_amdgcn_s_getreg((3 << 11) | 20) & 0xFu; }
#define XB_SPIN(cond, bar) do { unsigned _sp = 0; while (cond) { __builtin_amdgcn_s_sleep(1); \
    if ((++_sp & 255u) == 0u) { if (xb_ld(&(bar)[XB_TMO])) break; if (_sp > XB_SPIN_CAP) { atomicAdd(&(bar)[XB_TMO], 1u); break; } } } } while (0)

struct XcdBarrier {
    unsigned* bar; unsigned x;
    volatile LAS unsigned* st;
};

__device__ __forceinline__ XcdBarrier xcd_barrier_post(unsigned* bar, volatile LAS unsigned* st) {
    XcdBarrier b; b.bar = bar; b.x = xb_xcc_id(); b.st = st;
    if (threadIdx.x == 0) (void)xb_add(&bar[XB_XCNT(b.x)], 1u);
    return b;
}
__device__ __forceinline__ void xcd_barrier_complete(unsigned* bar, unsigned x, unsigned& nloc, unsigned& nx) {
    const unsigned G = gridDim.x * gridDim.y * gridDim.z;
    unsigned sum, cnt, mine, sp = 0u;
    for (;;) {
        sum = 0u; cnt = 0u; mine = 0u;
#pragma unroll
        for (unsigned j = 0; j < 16; ++j) { const unsigned c = xb_ld(&bar[XB_XCNT(j)]); sum += c; cnt += (c > 0u) ? 1u : 0u; mine = (j == x) ? c : mine; }
        if (sum == G) break;
        __builtin_amdgcn_s_sleep(1);
        if ((++sp & 255u) == 0u) { if (xb_ld(&bar[XB_TMO])) break; if (sp > XB_SPIN_CAP) { atomicAdd(&bar[XB_TMO], 1u); break; } }
    }
    nloc = mine > 0u ? mine : 1u; nx = cnt > 0u ? cnt : 1u;
}

__device__ __forceinline__ void xcd_barrier(const XcdBarrier& b) {
    asm volatile("s_waitcnt vmcnt(0)" ::: "memory");
    __syncthreads();
    if (threadIdx.x == 0) {
        unsigned* bar = b.bar;
        __builtin_amdgcn_s_waitcnt(0);
        unsigned nloc = b.st[0], nx = b.st[1];
        if (nloc == 0u) { xcd_barrier_complete(bar, b.x, nloc, nx); b.st[0] = nloc; b.st[1] = nx; }
        const unsigned old = xb_add(&bar[XB_XSUB(b.x)], 1u);
        const unsigned gen = old / nloc;
        if (old + 1u == (gen + 1u) * nloc) {
            __builtin_amdgcn_fence(__ATOMIC_RELEASE, "agent");
            asm volatile("s_waitcnt vmcnt(0)" ::: "memory");
            const unsigned og = xb_add(&bar[XB_TOP], 1u);
            const unsigned tg = og / nx;
            if (og + 1u == (tg + 1u) * nx) xb_add(&bar[XB_TOPGEN], 1u);
            else XB_SPIN(xb_ld(&bar[XB_TOPGEN]) == tg, bar);
            __builtin_amdgcn_fence(__ATOMIC_ACQUIRE, "agent");
            xb_add(&bar[XB_XGEN(b.x)], 1u);
            asm volatile("s_waitcnt vmcnt(0)" ::: "memory");
        } else {
            XB_SPIN(xb_ld(&bar[XB_XGEN(b.x)]) == gen, bar);
            __builtin_amdgcn_fence(__ATOMIC_ACQUIRE, "agent");
            asm volatile("s_waitcnt vmcnt(0)" ::: "memory");
        }
    }
    __syncthreads();
}

struct Args { const void* in[30]; float* out; unsigned char* ws; int ph_lo, ph_hi; };
struct Frame {
    LAS unsigned char* lds;
    gu32* ctl;
    unsigned char* ws;
    int tid, lane, wave, G, bid;
};
DI const void* argin(const Args&, int k) {
    typedef const void* const __attribute__((address_space(4)))* kptr_t;
    kptr_t p = (kptr_t)__builtin_amdgcn_kernarg_segment_ptr(); asm volatile("" : "+s"(p));
    return (const void*)p[k]; }
DI int launder_s(int x) { asm volatile("" : "+s"(x)); return x; }
DI Frame phase_frame(const Frame& F0) { Frame F = F0;
    int l; asm volatile("v_mbcnt_lo_u32_b32 %0, -1, 0\n\tv_mbcnt_hi_u32_b32 %0, -1, %0" : "=v"(l));
    F.wave = launder_s(F0.wave); F.bid = launder_s(F0.bid); F.G = launder_s(F0.G);
    F.lane = l; F.tid = F.wave * 64 + l;
    { unsigned long long wsb = (unsigned long long)F0.ws; asm volatile("" : "+s"(wsb)); F.ws = (unsigned char*)wsb; }
    { unsigned ll = (unsigned)(size_t)F0.lds; asm volatile("" : "+s"(ll)); F.lds = (LAS unsigned char*)(size_t)ll; }
    return F; }
DI unsigned char* lw_ptr(const Frame& F, int layer, size_t off) { return F.ws + WS_W + (size_t)layer * LW_STRIDE + off; }

template <bool FRAGMAJOR = false>
DI void transpose_item(const float* W, int K, int Nsrc, int nsrc0, bf16* WT, int dst_row0, int k0, LAS float* scr, int lane) {
#pragma unroll 8
    for (int i = 0; i < 32; ++i) { const int kk = 2 * i + (lane >> 5); scr[kk * 33 + (lane & 31)] = W[(size_t)(k0 + kk) * Nsrc + nsrc0 + (lane & 31)]; }
    LDS_WAIT(); asm volatile("" ::: "memory");
    const int c = lane & 7;
#pragma unroll
    for (int j = 0; j < 4; ++j) { const int n = (lane >> 3) + 8 * j; const LAS float* s = scr + (8 * c) * 33 + n;
        u32x4 o; o.x = pk2(s[0 * 33], s[1 * 33]); o.y = pk2(s[2 * 33], s[3 * 33]); o.z = pk2(s[4 * 33], s[5 * 33]); o.w = pk2(s[6 * 33], s[7 * 33]);
        if (FRAGMAJOR) { const int hid = dst_row0 + n, kk = k0 + 8 * c;
            *(u32x4*)(WT + ((size_t)((hid >> 4) * (K >> 5) + (kk >> 5)) * 64 + (((kk >> 3) & 3) * 16 + (hid & 15))) * 8) = o; }
        else *(u32x4*)(WT + (size_t)(dst_row0 + n) * K + k0 + 8 * c) = o; }
    LDS_WAIT(); asm volatile("" ::: "memory");
}
DI int proj_src_col(int d) {
    if (d < 5120) {
        const int pn = d >> 8; const bool rp = (pn < 10) || pn == 12 || pn == 13 || pn == 16 || pn == 17;
        if (!rp) return d;
        const int c = d & 255, bj = c >> 7, wc = (c >> 5) & 3;
        return (pn << 8) + 128 * (wc >> 1) + 64 * bj + 32 * (wc & 1);
    }
    if (d < 16384) return d + 48;
    if (d < 22528) return d + 80;
    if (d < 22592) return S_GN + (d - 22528);
    if (d < 22624) return S_DT + (d - 22592);
    return 0;
}
constexpr int TI_IN = 32 * 712, TI_O = 32 * 64, TI_UP = 32 * 256, TI_DOWN = 128 * 64, TI_PG = 32 * 64, TI_PLE = 4 * 64, TI_P1 = 64 * 4, TI_P2 = 2 * 4;
constexpr int TI_LAYER = TI_IN + TI_O + TI_UP + TI_DOWN + TI_PG + TI_PLE + 2 * TI_P1 + 2 * TI_P2;

DI void p0_prologue(const Frame& F0, const Args& A) {
    const Frame F = phase_frame(F0);
    LAS float* scr = (LAS float*)(F.lds + F.wave * 16384);
    const int gw = F.bid * NWAVES + F.wave, NGW = F.G * NWAVES;
    for (int it = gw; it < DEPTH * TI_LAYER; it += NGW) {
        const int layer = it / TI_LAYER; int r = it - layer * TI_LAYER;
        if (r < TI_IN) { const int kb = r / 712, nb = r - kb * 712;
            transpose_item((const float*)argin(A, 4) + (size_t)layer * DM * PROJ_SRC, DM, PROJ_SRC, proj_src_col(nb * 32), (bf16*)lw_ptr(F, layer, LW_IN), nb * 32, kb * 64, scr, F.lane); continue; } r -= TI_IN;
        if (r < TI_O) { const int kb = r / 64, nb = r % 64;
            transpose_item((const float*)argin(A, 22) + (size_t)layer * DM * DM, DM, DM, nb * 32, (bf16*)lw_ptr(F, layer, LW_O), nb * 32, kb * 64, scr, F.lane); continue; } r -= TI_O;
        if (r < TI_UP) { const int kb = r / 256, nb = r % 256;
            transpose_item((const float*)argin(A, 24) + (size_t)layer * DM * DFF, DM, DFF, nb * 32, (bf16*)lw_ptr(F, layer, LW_UP), nb * 32, kb * 64, scr, F.lane); continue; } r -= TI_UP;
        if (r < TI_DOWN) { const int kb = r / 64, nb = r % 64;
            transpose_item((const float*)argin(A, 25) + (size_t)layer * DFF * DM, DFF, DM, nb * 32, (bf16*)lw_ptr(F, layer, LW_DOWN), nb * 32, kb * 64, scr, F.lane); continue; } r -= TI_DOWN;
        if (r < TI_PG) { const int kb = r / 64, nb = r % 64;
            transpose_item((const float*)argin(A, 28) + (size_t)layer * DM * DM, DM, DM, nb * 32, (bf16*)lw_ptr(F, layer, LW_PG), nb * 32, kb * 64, scr, F.lane); continue; } r -= TI_PG;
        if (r < TI_PLE) { const int kb = r / 64, nb = r % 64;
            transpose_item((const float*)argin(A, 27) + (size_t)layer * PLE * DM, PLE, DM, nb * 32, (bf16*)lw_ptr(F, layer, LW_PLE), nb * 32, kb * 64, scr, F.lane); continue; } r -= TI_PLE;
        if (r < TI_P1) { const int kb = r / 4, nb = r % 4;
            transpose_item<true>((const float*)argin(A, 7) + (size_t)layer * 4096 * 128, 4096, 128, nb * 32, (bf16*)lw_ptr(F, layer, LW_PK1), nb * 32, kb * 64, scr, F.lane); continue; } r -= TI_P1;
        if (r < TI_P1) { const int kb = r / 4, nb = r % 4;
            transpose_item<true>((const float*)argin(A, 11) + (size_t)layer * 4096 * 128, 4096, 128, nb * 32, (bf16*)lw_ptr(F, layer, LW_PV1), nb * 32, kb * 64, scr, F.lane); continue; } r -= TI_P1;
        if (r < TI_P2) { const int kb = r / 4, nb = r % 4;
            transpose_item((const float*)argin(A, 9) + (size_t)layer * 128 * 128, 128, 128, nb * 32, (bf16*)lw_ptr(F, layer, LW_PK2), nb * 32, kb * 64, scr, F.lane); continue; } r -= TI_P2;
        { const int kb = r / 4, nb = r % 4;
            transpose_item((const float*)argin(A, 13) + (size_t)layer * 128 * 128, 128, 128, nb * 32, (bf16*)lw_ptr(F, layer, LW_PV2), nb * 32, kb * 64, scr, F.lane); }
    }
    const size_t gt = (size_t)F.bid * NTHR + F.tid, NGT = (size_t)F.G * NTHR;
    { const float* p = (const float*)argin(A, 1); bf16* pb = (bf16*)(F.ws + WS_PB);
      for (size_t i = gt; i < (size_t)DEPTH * M * PLE / 8; i += NGT) { const f32x4 a = *(const f32x4*)(p + i * 8), b = *(const f32x4*)(p + i * 8 + 4);
          u32x4 o; o.x = pk2(a[0], a[1]); o.y = pk2(a[2], a[3]); o.z = pk2(b[0], b[1]); o.w = pk2(b[2], b[3]); *(u32x4*)(pb + i * 8) = o; } }
    { const int* pos = (const int*)argin(A, 2); float* rope = (float*)(F.ws + WS_ROPE);
      for (size_t i = gt; i < (size_t)M * 64; i += NGT) { const int row = (int)(i >> 6), jj = (int)(i & 63);
          const float inv = 1.0f / powf(10000.0f, (float)(2 * jj) * (1.0f / 128.0f));
          const float ang = (float)pos[row] * inv;
          double a = (double)ang; a -= 6.283185307179586476925 * __builtin_rint(a * 0.15915494309189533577);
          const float ar = (float)a;
          rope[i * 2] = cosf(ar); rope[i * 2 + 1] = sinf(ar); } }
    { float* part = (float*)(F.ws + WS_MISC);
      for (size_t i = gt; i < (size_t)DEPTH * 2 * 8 * 128; i += NGT) { const int hid = (int)(i & 127), c = (int)(i >> 7) & 7, kv = (int)(i >> 10) & 1, layer = (int)(i >> 11);
          const float* pe = (const float*)(kv ? A.in[6] : A.in[5]) + (size_t)layer * 4096 + c * 512;
          const float* w1 = (const float*)(kv ? A.in[11] : A.in[7]) + (size_t)layer * 4096 * 128 + (size_t)c * 512 * 128 + hid;
          float s = 0.f;
#pragma unroll 8
          for (int kk = 0; kk < 512; ++kk) s += pe[kk] * w1[(size_t)kk * 128];
          part[i] = s; } }
}

template <bool OUTF32> DI void norm_rows(const Frame& F0, const float* x, const float* g, void* outp) {
    const Frame F = phase_frame(F0);
    const int gw = F.bid * NWAVES + F.wave, NGW = F.G * NWAVES;
    for (int m = gw; m < M; m += NGW) {
        const f32x4* xr = (const f32x4*)(x + (size_t)m * DM) + F.lane;
        f32x4 v[8]; float s = 0.f;
#pragma unroll
        for (int j = 0; j < 8; ++j) { v[j] = xr[64 * j]; s += (v[j][0] * v[j][0] + v[j][1] * v[j][1]) + (v[j][2] * v[j][2] + v[j][3] * v[j][3]); }
        const float rstd = 1.0f / sqrtf(wave_sum(s, F.lane) * (1.0f / DM) + EPS);
#pragma unroll
        for (int j = 0; j < 8; ++j) { const f32x4 gv = ((const f32x4*)g)[F.lane + 64 * j]; const f32x4 o = v[j] * rstd * gv;
            if (OUTF32) ((f32x4*)((float*)outp + (size_t)m * DM))[F.lane + 64 * j] = o;
            else { u32x2 w; w.x = pk2(o[0], o[1]); w.y = pk2(o[2], o[3]); ((u32x2*)((bf16*)outp + (size_t)m * DM))[F.lane + 64 * j] = w; } }
    }
}
template <bool OUTF32> DI void addnorm_rows(const Frame& F0, const float* xin, const bf16* delta, const float* g, float* xout, void* outp) {
    const Frame F = phase_frame(F0);
    const int gw = F.bid * NWAVES + F.wave, NGW = F.G * NWAVES;
    for (int m = gw; m < M; m += NGW) {
        const f32x4* xr = (const f32x4*)(xin + (size_t)m * DM) + F.lane; const u32x2* dr = (const u32x2*)(delta + (size_t)m * DM) + F.lane;
        f32x4 v[8]; u32x2 d[8]; float s = 0.f;
#pragma unroll
        for (int j = 0; j < 8; ++j) { v[j] = xr[64 * j]; d[j] = dr[64 * j]; }
#pragma unroll
        for (int j = 0; j < 8; ++j) { v[j][0] += bflo(d[j].x); v[j][1] += bfhi(d[j].x); v[j][2] += bflo(d[j].y); v[j][3] += bfhi(d[j].y);
            s += (v[j][0] * v[j][0] + v[j][1] * v[j][1]) + (v[j][2] * v[j][2] + v[j][3] * v[j][3]);
            if (!OUTF32) ((f32x4*)(xout + (size_t)m * DM))[F.lane + 64 * j] = v[j]; }
        const float rstd = 1.0f / sqrtf(wave_sum(s, F.lane) * (1.0f / DM) + EPS);
#pragma unroll
        for (int j = 0; j < 8; ++j) { const f32x4 gv = ((const f32x4*)g)[F.lane + 64 * j]; const f32x4 o = v[j] * rstd * gv;
            if (OUTF32) ((f32x4*)((float*)outp + (size_t)m * DM))[F.lane + 64 * j] = o;
            else { u32x2 w; w.x = pk2(o[0], o[1]); w.y = pk2(o[2], o[3]); ((u32x2*)((bf16*)outp + (size_t)m * DM))[F.lane + 64 * j] = w; } }
    }
}
DI void unpack8(u32x4 w, float (&f)[8]) { f[0] = bflo(w.x); f[1] = bfhi(w.x); f[2] = bflo(w.y); f[3] = bfhi(w.y); f[4] = bflo(w.z); f[5] = bfhi(w.z); f[6] = bflo(w.w); f[7] = bfhi(w.w); }
DI u32x4 pack8f(const float (&f)[8]) { u32x4 o; o.x = pk2(f[0], f[1]); o.y = pk2(f[2], f[3]); o.z = pk2(f[4], f[5]); o.w = pk2(f[6], f[7]); return o; }

DI void ssd_conv_pass(const Frame& F0, const Args& A, int layer) {
    const Frame F = phase_frame(F0);
    const bf16* proj = (const bf16*)(F.ws + WS_PROJ); bf16* xbc = (bf16*)(F.ws + WS_XBC);
    const float* cw = (const float*)argin(A, 16) + (size_t)layer * 4 * SSD_XBC; const float* cb = (const float*)argin(A, 17) + (size_t)layer * SSD_XBC;
    const int gt = F.bid * NTHR + F.tid, NGT = F.G * NTHR;
    for (int task = gt; task < 512 * 384; task += NGT) {
        const int run = task / 384, cg = task - run * 384, ch = cg * 8, row0 = run * 32;
        float w[4][8], bs[8], xm3[8], xm2[8], xm1[8];
#pragma unroll
        for (int j = 0; j < 4; ++j) { const f32x4 a = *(const f32x4*)(cw + j * SSD_XBC + ch), b = *(const f32x4*)(cw + j * SSD_XBC + ch + 4);
            w[j][0] = a[0]; w[j][1] = a[1]; w[j][2] = a[2]; w[j][3] = a[3]; w[j][4] = b[0]; w[j][5] = b[1]; w[j][6] = b[2]; w[j][7] = b[3]; }
        { const f32x4 a = *(const f32x4*)(cb + ch), b = *(const f32x4*)(cb + ch + 4); bs[0] = a[0]; bs[1] = a[1]; bs[2] = a[2]; bs[3] = a[3]; bs[4] = b[0]; bs[5] = b[1]; bs[6] = b[2]; bs[7] = b[3]; }
        if ((row0 & (SEQ - 1)) != 0) {
            unpack8(*(const u32x4*)(proj + (size_t)(row0 - 3) * LDP + C_XBC + ch), xm3);
            unpack8(*(const u32x4*)(proj + (size_t)(row0 - 2) * LDP + C_XBC + ch), xm2);
            unpack8(*(const u32x4*)(proj + (size_t)(row0 - 1) * LDP + C_XBC + ch), xm1);
        } else {
#pragma unroll
            for (int k = 0; k < 8; ++k) { xm3[k] = 0.f; xm2[k] = 0.f; xm1[k] = 0.f; }
        }
#if defined(CONV_PF)
        const char* pj = (const char*)proj + (size_t)C_XBC * 2 + (size_t)ch * 2;
        auto ld8 = [&](u32x4 (&d)[8], int r) {
#pragma unroll
            for (int q = 0; q < 8; ++q) d[q] = *(const u32x4*)(pj + (unsigned)((row0 + r + q) * LDP) * 2u); };
        auto do8 = [&](const u32x4 (&d)[8], int r) {
#pragma unroll
            for (int q = 0; q < 8; ++q) { float cur[8], y[8]; unpack8(d[q], cur);
#pragma unroll
                for (int k = 0; k < 8; ++k) { const float v = w[0][k] * xm3[k] + w[1][k] * xm2[k] + w[2][k] * xm1[k] + w[3][k] * cur[k] + bs[k]; y[k] = siluf_(v); xm3[k] = xm2[k]; xm2[k] = xm1[k]; xm1[k] = cur[k]; }
                *(u32x4*)(xbc + (size_t)(row0 + r + q) * SSD_XBC + ch) = pack8f(y); } };
        u32x4 PA[8], PB[8];
        ld8(PA, 0);
#pragma unroll 1
        for (int r = 0; r < 32; r += 16) {
            ld8(PB, r + 8); do8(PA, r);
            if (r + 16 < 32) ld8(PA, r + 16);
            do8(PB, r + 8);
        }
#else
#pragma unroll 4
        for (int r = 0; r < 32; ++r) {
            float cur[8], y[8]; unpack8(*(const u32x4*)(proj + (size_t)(row0 + r) * LDP + C_XBC + ch), cur);
#pragma unroll
            for (int k = 0; k < 8; ++k) { const float v = w[0][k] * xm3[k] + w[1][k] * xm2[k] + w[2][k] * xm1[k] + w[3][k] * cur[k] + bs[k]; y[k] = siluf_(v); xm3[k] = xm2[k]; xm2[k] = xm1[k]; xm1[k] = cur[k]; }
            *(u32x4*)(xbc + (size_t)(row0 + r) * SSD_XBC + ch) = pack8f(y);
        }
#endif
    }
    const float* dtb = (const float*)argin(A, 18) + layer * SSD_H; float* dt = (float*)(F.ws + WS_DT);
    for (int i = gt; i < M * SSD_H; i += NGT) { const int row = i >> 5, h = i & 31;
        const float x = bf2f(proj[(size_t)row * LDP + C_DT + h]) + dtb[h];
        dt[i] = fmaxf(x, 0.f) + log1pf(__expf(-fabsf(x))); }
}

DI void merge_pass(const Frame& F0, const Args& A, int layer) {
    const Frame F = phase_frame(F0);
    const bf16* proj = (const bf16*)(F.ws + WS_PROJ); const bf16* ya = (const bf16*)(F.ws + WS_YA); const bf16* yc = (const bf16*)(F.ws + WS_YC); bf16* hb = (bf16*)(F.ws + WS_HB);
    const float* sw = (const float*)argin(A, 15) + (size_t)layer * 3 * DM; const float* ngp = (const float*)argin(A, 21) + (size_t)layer * DM; const float* rstdp = (const float*)(F.ws + WS_RSTD);
    const int gt = F.bid * NTHR + F.tid, NGT = F.G * NTHR;
    for (int task = gt; task < 512 * 256; task += NGT) {
        const int run = task >> 8, cg = task & 255, ch = cg * 8, row0 = run * 32;
        float w[3][8], pm2[8], pm1[8], ng8[8];
        { const f32x4 a = *(const f32x4*)(ngp + ch), b = *(const f32x4*)(ngp + ch + 4); ng8[0] = a[0]; ng8[1] = a[1]; ng8[2] = a[2]; ng8[3] = a[3]; ng8[4] = b[0]; ng8[5] = b[1]; ng8[6] = b[2]; ng8[7] = b[3]; }
#pragma unroll
        for (int j = 0; j < 3; ++j) { const f32x4 a = *(const f32x4*)(sw + j * DM + ch), b = *(const f32x4*)(sw + j * DM + ch + 4);
            w[j][0] = a[0]; w[j][1] = a[1]; w[j][2] = a[2]; w[j][3] = a[3]; w[j][4] = b[0]; w[j][5] = b[1]; w[j][6] = b[2]; w[j][7] = b[3]; }
        if ((row0 & (SEQ - 1)) != 0) {
            float c1[8], u1[8];
            unpack8(*(const u32x4*)(proj + (size_t)(row0 - 2) * LDP + C_CC + ch), c1); unpack8(*(const u32x4*)(proj + (size_t)(row0 - 2) * LDP + C_CU + ch), u1);
#pragma unroll
            for (int k = 0; k < 8; ++k) pm2[k] = c1[k] * u1[k];
            unpack8(*(const u32x4*)(proj + (size_t)(row0 - 1) * LDP + C_CC + ch), c1); unpack8(*(const u32x4*)(proj + (size_t)(row0 - 1) * LDP + C_CU + ch), u1);
#pragma unroll
            for (int k = 0; k < 8; ++k) pm1[k] = c1[k] * u1[k];
        } else {
#pragma unroll
            for (int k = 0; k < 8; ++k) { pm2[k] = 0.f; pm1[k] = 0.f; }
        }
#if defined(MERGE_PF)
        struct MR { u32x4 cc, cu, cb, g0, g1, g2, a, c; float rs; };
        auto ldrow = [&](MR& d, int r) { const unsigned pro = (unsigned)((row0 + r) * LDP + ch) * 2u, yro = (unsigned)((row0 + r) * DM + ch) * 2u;
            const char* pj = (const char*)proj;
            d.cc = *(const u32x4*)(pj + pro + C_CC * 2); d.cu = *(const u32x4*)(pj + pro + C_CU * 2); d.cb = *(const u32x4*)(pj + pro + C_CB * 2);
            d.g0 = *(const u32x4*)(pj + pro + C_GM * 2); d.g1 = *(const u32x4*)(pj + pro + (C_GM + DM) * 2); d.g2 = *(const u32x4*)(pj + pro + (C_GM + 2 * DM) * 2);
            d.a = *(const u32x4*)((const char*)ya + yro); d.c = *(const u32x4*)((const char*)yc + yro); d.rs = rstdp[(unsigned)((row0 + r) * SSD_G + (ch >> 9))]; };
        auto dorow = [&](const MR& d, int r) { const size_t yr = (size_t)(row0 + r) * DM + ch;
            float cc[8], cu[8], cbv[8], g0[8], g1[8], g2[8], a[8], c[8], o[8];
            unpack8(d.cc, cc); unpack8(d.cu, cu); unpack8(d.cb, cbv); unpack8(d.g0, g0); unpack8(d.g1, g1); unpack8(d.g2, g2); unpack8(d.a, a); unpack8(d.c, c);
#pragma unroll
            for (int k = 0; k < 8; ++k) { const float pc = cc[k] * cu[k]; const float cv = w[0][k] * pm2[k] + w[1][k] * pm1[k] + w[2][k] * pc; pm2[k] = pm1[k]; pm1[k] = pc;
                o[k] = sigmoidf_(g0[k]) * a[k] + sigmoidf_(g1[k]) * (cbv[k] * cv) + sigmoidf_(g2[k]) * (c[k] * d.rs * ng8[k]); }
            *(u32x4*)(hb + yr) = pack8f(o); };
#if MERGE_PF == 3
        MR A0, A1, A2;
        ldrow(A0, 0); ldrow(A1, 1);
#pragma unroll 1
        for (int r = 0; r < 30; r += 3) {
            ldrow(A2, r + 2); dorow(A0, r);
            ldrow(A0, r + 3); dorow(A1, r + 1);
            ldrow(A1, r + 4); dorow(A2, r + 2);
        }
        dorow(A0, 30); dorow(A1, 31);
#else
        MR A0, B0;
        ldrow(A0, 0);
#pragma unroll 1
        for (int r = 0; r < 32; r += 2) {
            ldrow(B0, r + 1); dorow(A0, r);
            if (r + 2 < 32) ldrow(A0, r + 2);
            dorow(B0, r + 1);
        }
#endif
#else
#if !defined(MERGE_UNROLL)
#define MERGE_UNROLL 2
#endif
#pragma unroll MERGE_UNROLL
        for (int r = 0; r < 32; ++r) {
            const size_t pr = (size_t)(row0 + r) * LDP + ch, yr = (size_t)(row0 + r) * DM + ch;
            float cc[8], cu[8], cbv[8], g0[8], g1[8], g2[8], a[8], c[8], o[8];
            unpack8(*(const u32x4*)(proj + pr + C_CC), cc); unpack8(*(const u32x4*)(proj + pr + C_CU), cu); unpack8(*(const u32x4*)(proj + pr + C_CB), cbv);
            unpack8(*(const u32x4*)(proj + pr + C_GM), g0); unpack8(*(const u32x4*)(proj + pr + C_GM + DM), g1); unpack8(*(const u32x4*)(proj + pr + C_GM + 2 * DM), g2);
            unpack8(*(const u32x4*)(ya + yr), a); unpack8(*(const u32x4*)(yc + yr), c);
            const float rs = rstdp[(size_t)(row0 + r) * SSD_G + (ch >> 9)];
#pragma unroll
            for (int k = 0; k < 8; ++k) { const float pc = cc[k] * cu[k]; const float cv = w[0][k] * pm2[k] + w[1][k] * pm1[k] + w[2][k] * pc; pm2[k] = pm1[k]; pm1[k] = pc;
                o[k] = sigmoidf_(g0[k]) * a[k] + sigmoidf_(g1[k]) * (cbv[k] * cv) + sigmoidf_(g2[k]) * (c[k] * rs * ng8[k]); }
            *(u32x4*)(hb + yr) = pack8f(o);
        }
#endif
    }
}

DI void compress_phase(const Frame& F0, const Args& A, int layer) {
    const Frame F = phase_frame(F0);
    const bf16* proj = (const bf16*)(F.ws + WS_PROJ);
    LAS unsigned char* slab = F.lds;
    LAS unsigned char* hidl = F.lds + 73728;
    LAS float* b1s = (LAS float*)(F.lds + 81920);
    const int lane = F.lane, w = F.wave, i = lane & 15, qd = lane >> 4;
    const float* part = (const float*)(F.ws + WS_MISC);
    for (int u = F.bid; u < 512; u += F.G) {
        const int kv = u >> 8, b = (u >> 7) & 1, g = (u >> 5) & 3, nb = u & 31, n0 = nb * 16, tok0 = n0 * 16;
        const bf16* src = (const bf16*)(F.ws + WS_KV) + kv_off(kv, b, g, 0);
        for (int id = F.tid; id < 272 * 16; id += NTHR) { const int row = id >> 4, ch = id & 15, t = tok0 + row;
            u32x4 v = {0u, 0u, 0u, 0u}; if (t < SEQ) v = *(const u32x4*)(src + (size_t)t * HD + ch * 8);
            *(LAS u32x4*)(slab + off_b(row, ch)) = v; }
        if (F.tid < 128) { float s = ((const float*)argin(A, kv ? 12 : 8))[layer * 128 + F.tid];
#pragma unroll
            for (int c = 0; c < 8; ++c) s += part[(((size_t)layer * 2 + kv) * 8 + c) * 128 + F.tid];
            b1s[F.tid] = s; }
        __syncthreads();
        const bf16* w1t = (const bf16*)lw_ptr(F, layer, kv ? LW_PV1 : LW_PK1) + ((size_t)w * 128 * 64 + lane) * 8;
        f32x4 acc = {0.f, 0.f, 0.f, 0.f};
#if defined(SSD_IGLP)
        __builtin_amdgcn_iglp_opt(0);
#endif
#if defined(CMP_PF)
        {
            bf16x8 ba[16], bc[16];
#pragma unroll
            for (int k = 0; k < 16; ++k) ba[k] = *(const bf16x8*)(w1t + 512 * k);
#pragma unroll 1
            for (int k0 = 0; k0 < 128; k0 += 32) {
#pragma unroll
                for (int k = 0; k < 16; ++k) bc[k] = *(const bf16x8*)(w1t + 512 * (k0 + 16 + k));
#pragma unroll
                for (int k = 0; k < 16; ++k) { const int ks = k0 + k; acc = MFMA16(lds_rd8(slab + off_b(16 * i + (ks >> 2), 4 * (ks & 3) + qd)), ba[k], acc); }
                if (k0 + 32 < 128) {
#pragma unroll
                    for (int k = 0; k < 16; ++k) ba[k] = *(const bf16x8*)(w1t + 512 * (k0 + 32 + k)); }
#pragma unroll
                for (int k = 0; k < 16; ++k) { const int ks = k0 + 16 + k; acc = MFMA16(lds_rd8(slab + off_b(16 * i + (ks >> 2), 4 * (ks & 3) + qd)), bc[k], acc); }
            }
        }
#else
        for (int k0 = 0; k0 < 128; k0 += 32) {
            bf16x8 bb[32];
#pragma unroll
            for (int k = 0; k < 32; ++k) bb[k] = *(const bf16x8*)(w1t + 512 * (k0 + k));
#pragma unroll
            for (int k = 0; k < 32; ++k) { const int ks = k0 + k;
                acc = MFMA16(lds_rd8(slab + off_b(16 * i + (ks >> 2), 4 * (ks & 3) + qd)), bb[k], acc); }
        }
#endif
        { const float bv = b1s[16 * w + i];
#pragma unroll
          for (int j = 0; j < 4; ++j) *(LAS bf16*)(hidl + (4 * qd + j) * 272 + (16 * w + i) * 2) = (bf16)f2bf(siluf_(acc[j] + bv)); }
        __syncthreads();
        const bf16* w2t = (const bf16*)lw_ptr(F, layer, kv ? LW_PV2 : LW_PK2) + (size_t)(16 * w + i) * 128 + 8 * qd;
        f32x4 acc2 = {0.f, 0.f, 0.f, 0.f};
#pragma unroll
        for (int s = 0; s < 4; ++s) {
            const bf16x8 a = lds_rd8(hidl + i * 272 + 64 * s + 16 * qd);
            const bf16x8 bb = *(const bf16x8*)(w2t + 32 * s);
            acc2 = MFMA16(a, bb, acc2);
        }
        const float b2 = ((const float*)argin(A, kv ? 14 : 10))[layer * 128 + 16 * w + i];
        bf16* dst = (bf16*)(F.ws + (kv ? WS_VCMP : WS_KCMP)) + ((size_t)(b * NG + g) * NCMP_PAD + n0) * HD + 16 * w + i;
#pragma unroll
        for (int j = 0; j < 4; ++j) dst[(size_t)(4 * qd + j) * HD] = (bf16)f2bf(acc2[j] + b2);
        __syncthreads();
    }
}

DI unsigned pk2_sw(float a, float b) {
    unsigned ua = __builtin_bit_cast(unsigned, a), ub = __builtin_bit_cast(unsigned, b);
    ua += 0x7FFFu + ((ua >> 16) & 1u); ub += 0x7FFFu + ((ub >> 16) & 1u);
    return (ua >> 16) | (ub & 0xFFFF0000u);
}
DI void ssd_states_phase(const Frame& F0, const Args& A, int layer) {
    const Frame F = phase_frame(F0);
    const bf16* xbc = (const bf16*)(F.ws + WS_XBC); const float* dt = (const float*)(F.ws + WS_DT);
    float* acs = (float*)(F.ws + WS_ACS); float* cdec = (float*)(F.ws + WS_CDEC); float* st = (float*)(F.ws + WS_ST);
    LAS unsigned char* Bt = F.lds; LAS unsigned char* Xt = F.lds + 32768; LAS float* sc = (LAS float*)(F.lds + 65536);
    const float* alog = (const float*)argin(A, 19) + layer * SSD_H;
    const int lane = F.lane, w = F.wave, i = lane & 15, qd = lane >> 4;
    for (int u = F.bid; u < 512; u += F.G) {
        const int b = u >> 8, c = (u >> 2) & 63, g = u & 3, row0 = b * SEQ + c * SSD_CH;
        {
            const int hh = g * 8 + w; const float a = -__expf(alog[hh]);
            const float dt0 = dt[(size_t)(row0 + 2 * lane) * SSD_H + hh], dt1 = dt[(size_t)(row0 + 2 * lane + 1) * SSD_H + hh];
            const float d0 = dt0 * a, d1 = dt1 * a, pair = d0 + d1; float s = pair;
#pragma unroll
            for (int o = 1; o < 64; o <<= 1) { const float t = shfl_idx(s, lane - o); if (lane >= o) s += t; }
            const float a0 = (s - pair) + d0, a1 = s, total = __builtin_bit_cast(float, __builtin_amdgcn_readlane(__builtin_bit_cast(int, s), 63));
            acs[(size_t)(row0 + 2 * lane) * SSD_H + hh] = a0; acs[(size_t)(row0 + 2 * lane + 1) * SSD_H + hh] = a1;
            sc[w * 128 + 2 * lane] = dt0 * __expf(total - a0); sc[w * 128 + 2 * lane + 1] = dt1 * __expf(total - a1);
            if (lane == 0) cdec[(size_t)(b * SSD_NC + c) * SSD_H + hh] = __expf(total);
        }
#if defined(S1_PRELOAD)
        u32x4 xr[4][4];
#pragma unroll
        for (int hp = 0; hp < 4; ++hp)
#pragma unroll
            for (int j = 0; j < 4; ++j) { const int id = F.tid + NTHR * j, row = id >> 4, ch = id & 15;
                xr[hp][j] = *(const u32x4*)(xbc + (size_t)(row0 + row) * SSD_XBC + g * 512 + hp * 128 + ch * 8); }
#pragma unroll
        for (int j = 0; j < 4; ++j) { const int id = F.tid + NTHR * j, row = id >> 4, ch = id & 15;
            *(LAS u32x4*)(Bt + off_b(row, ch)) = *(const u32x4*)(xbc + (size_t)(row0 + row) * SSD_XBC + 2048 + g * 128 + ch * 8); }
        __syncthreads();
        bf16x8 bfr[4];
#pragma unroll
        for (int ks = 0; ks < 4; ++ks) bfr[ks] = tr_read8(Bt, lane, 32 * ks, w);
#pragma unroll
        for (int hp = 0; hp < 4; ++hp) {
            LAS unsigned char* Xb = Xt + (hp & 1) * 32768 + ((hp & 1) ? 4096 : 0);
#pragma unroll
            for (int j = 0; j < 4; ++j) { const int id = F.tid + NTHR * j, row = id >> 4, ch = id & 15;
                float x[8]; unpack8(xr[hp][j], x);
                const float f = sc[(hp * 2 + (ch >> 3)) * 128 + row];
#pragma unroll
                for (int k = 0; k < 8; ++k) x[k] *= f;
                *(LAS u32x4*)(Xb + off_b(row, ch)) = pack8f(x); }
            __syncthreads();
#pragma unroll
            for (int h2 = 0; h2 < 2; ++h2) {
                const int head = g * 8 + hp * 2 + h2;
                float* dst = st + ((size_t)((b * SSD_NC + c) * SSD_H + head) * SSD_N + 16 * w + i) * SSD_P + 4 * qd;
#pragma unroll
                for (int pt = 0; pt < 4; ++pt) {
                    f32x4 acc = {0.f, 0.f, 0.f, 0.f};
#pragma unroll
                    for (int ks = 0; ks < 4; ++ks) acc = MFMA16(tr_read8(Xb, lane, 32 * ks, h2 * 4 + pt), bfr[ks], acc);
#if defined(ST_BF16)
                    { u32x2 o_; o_.x = pk2_sw(acc[0], acc[1]); o_.y = pk2_sw(acc[2], acc[3]); *(u32x2*)((bf16*)st + (size_t)(dst - st) + 16 * pt) = o_; }
#else
                    *(f32x4*)(dst + 16 * pt) = acc;
#endif
                }
            }
        }
#else
        for (int id = F.tid; id < 128 * 16; id += NTHR) { const int row = id >> 4, ch = id & 15;
            *(LAS u32x4*)(Bt + off_b(row, ch)) = *(const u32x4*)(xbc + (size_t)(row0 + row) * SSD_XBC + 2048 + g * 128 + ch * 8); }
        bf16x8 bfr[4];
        for (int hp = 0; hp < 4; ++hp) {
            __syncthreads();
            for (int id = F.tid; id < 128 * 16; id += NTHR) { const int row = id >> 4, ch = id & 15;
                float x[8]; unpack8(*(const u32x4*)(xbc + (size_t)(row0 + row) * SSD_XBC + g * 512 + hp * 128 + ch * 8), x);
                const float f = sc[(hp * 2 + (ch >> 3)) * 128 + row];
#pragma unroll
                for (int k = 0; k < 8; ++k) x[k] *= f;
                *(LAS u32x4*)(Xt + off_b(row, ch)) = pack8f(x); }
            __syncthreads();
            if (hp == 0) {
#pragma unroll
                for (int ks = 0; ks < 4; ++ks) bfr[ks] = tr_read8(Bt, lane, 32 * ks, w);
            }
#pragma unroll
            for (int h2 = 0; h2 < 2; ++h2) {
                const int head = g * 8 + hp * 2 + h2;
                float* dst = st + ((size_t)((b * SSD_NC + c) * SSD_H + head) * SSD_N + 16 * w + i) * SSD_P + 4 * qd;
#pragma unroll
                for (int pt = 0; pt < 4; ++pt) {
                    f32x4 acc = {0.f, 0.f, 0.f, 0.f};
#pragma unroll
                    for (int ks = 0; ks < 4; ++ks) acc = MFMA16(tr_read8(Xt, lane, 32 * ks, h2 * 4 + pt), bfr[ks], acc);
#if defined(ST_BF16)
                    { u32x2 o_; o_.x = pk2_sw(acc[0], acc[1]); o_.y = pk2_sw(acc[2], acc[3]); *(u32x2*)((bf16*)st + (size_t)(dst - st) + 16 * pt) = o_; }
#else
                    *(f32x4*)(dst + 16 * pt) = acc;
#endif
                }
            }
        }
#endif
        __syncthreads();
    }
}
DI void ssd_scan_phase(const Frame& F0) {
    const Frame F = phase_frame(F0);
    const f32x4* st = (const f32x4*)(F.ws + WS_ST); u32x2* hin = (u32x2*)(F.ws + WS_HIN); const float* cdec = (const float*)(F.ws + WS_CDEC);
    const int gt = F.bid * NTHR + F.tid, NGT = F.G * NTHR;
    for (int v = gt; v < BATCH * SSD_H * 2048; v += NGT) {
        const int b = v >> 16, h = (v >> 11) & 31, e = v & 2047;
        const size_t o0 = ((size_t)(b * SSD_NC) * SSD_H + h) * 2048 + e;
        const float* dc = cdec + (size_t)(b * SSD_NC) * SSD_H + h;
        f32x4 hs = {0.f, 0.f, 0.f, 0.f};
#if defined(S2_PF) && defined(ST_BF16)
        {
#pragma unroll 1
            for (int c0 = 0; c0 < SSD_NC; c0 += 32) {
                u32x2 raw[32]; float dd[32];
#pragma unroll
                for (int k = 0; k < 32; ++k) { raw[k] = ((const u32x2*)st)[o0 + (size_t)(c0 + k) * 65536]; dd[k] = dc[(c0 + k) * SSD_H]; }
#pragma unroll
                for (int k = 0; k < 32; ++k) { u32x2 o; o.x = pk2(hs[0], hs[1]); o.y = pk2(hs[2], hs[3]); hin[o0 + (size_t)(c0 + k) * 65536] = o;
                    const f32x4 sv = {bflo(raw[k].x), bfhi(raw[k].x), bflo(raw[k].y), bfhi(raw[k].y)}; hs = hs * dd[k] + sv; }
            }
        }
#else
        for (int c0 = 0; c0 < SSD_NC; c0 += 8) {
            f32x4 s[8]; float d[8];
#pragma unroll
#if defined(ST_BF16)
            for (int k = 0; k < 8; ++k) { const u32x2 t_ = ((const u32x2*)st)[o0 + (size_t)(c0 + k) * 65536]; s[k][0] = bflo(t_.x); s[k][1] = bfhi(t_.x); s[k][2] = bflo(t_.y); s[k][3] = bfhi(t_.y); d[k] = dc[(c0 + k) * SSD_H]; }
#else
            for (int k = 0; k < 8; ++k) { s[k] = st[o0 + (size_t)(c0 + k) * 65536]; d[k] = dc[(c0 + k) * SSD_H]; }
#endif
#pragma unroll
            for (int k = 0; k < 8; ++k) { u32x2 o; o.x = pk2(hs[0], hs[1]); o.y = pk2(hs[2], hs[3]); hin[o0 + (size_t)(c0 + k) * 65536] = o; hs = hs * d[k] + s[k]; }
        }
#endif
    }
}
DI void ssd_out_phase(const Frame& F0, const Args& A, int layer) {
    const Frame F = phase_frame(F0);
    const bf16* xbc = (const bf16*)(F.ws + WS_XBC); const bf16* proj = (const bf16*)(F.ws + WS_PROJ);
    const float* dt = (const float*)(F.ws + WS_DT); const float* acs = (const float*)(F.ws + WS_ACS); const bf16* hin = (const bf16*)(F.ws + WS_HIN);
    bf16* yc = (bf16*)(F.ws + WS_YC); float* rstdp = (float*)(F.ws + WS_RSTD);
    LAS unsigned char* Bt = F.lds; LAS unsigned char* Ct = F.lds + 32768; LAS unsigned char* Xt = F.lds + 65536; LAS unsigned char* Ht = F.lds + 98304;
    LAS float* acsl = (LAS float*)(F.lds + LX_OFF);
    const float* dsk = (const float*)argin(A, 20) + layer * SSD_H;
    const int lane = F.lane, w = F.wave, i = lane & 15, qd = lane >> 4;
    for (int u = F.bid; u < 512; u += F.G) {
        const int b = u >> 8, c = (u >> 2) & 63, g = u & 3, row0 = b * SEQ + c * SSD_CH;
        for (int id = F.tid; id < 128 * 16; id += NTHR) { const int row = id >> 4, ch = id & 15; const bf16* src = xbc + (size_t)(row0 + row) * SSD_XBC + 2048 + g * 128 + ch * 8;
            *(LAS u32x4*)(Bt + off_b(row, ch)) = *(const u32x4*)(src); *(LAS u32x4*)(Ct + off_b(row, ch)) = *(const u32x4*)(src + 512); }
        __syncthreads();
        bf16x8 cfr[4];
#pragma unroll
        for (int ks = 0; ks < 4; ++ks) cfr[ks] = lds_rd8(Ct + off_b(16 * w + i, 4 * ks + qd));
        f32x4 cb[4][2];
#pragma unroll
        for (int k = 0; k < 4; ++k)
#pragma unroll
            for (int T = 0; T < 2; ++T) { f32x4 acc = {0.f, 0.f, 0.f, 0.f};
#pragma unroll
                for (int ks = 0; ks < 4; ++ks) acc = MFMA16(lds_rd8(Bt + off_b(32 * k + 8 * (i >> 2) + (i & 3) + 4 * T, 4 * ks + qd)), cfr[ks], acc);
                cb[k][T] = acc; }
        const int lrow = 16 * w + i, row = row0 + lrow;
        float ssq = 0.f;
#if defined(S3_PREFETCH)
        u32x4 px[4], ph[4]; float pd[4], pa = 0.f;
#define S3_PF_LOAD(HP) do { \
            if (F.tid < 256) { const int h2_ = F.tid >> 7, l_ = F.tid & 127; pa = acs[(size_t)(row0 + l_) * SSD_H + g * 8 + (HP) * 2 + h2_]; } \
            _Pragma("unroll") for (int j_ = 0; j_ < 4; ++j_) { const int id_ = F.tid + NTHR * j_, r_ = id_ >> 4, ch_ = id_ & 15, head_ = g * 8 + (HP) * 2 + (ch_ >> 3); \
                px[j_] = *(const u32x4*)(xbc + (size_t)(row0 + r_) * SSD_XBC + g * 512 + (HP) * 128 + ch_ * 8); pd[j_] = dt[(size_t)(row0 + r_) * SSD_H + head_]; \
                ph[j_] = *(const u32x4*)(hin + ((size_t)((b * SSD_NC + c) * SSD_H + head_) * SSD_N + r_) * SSD_P + (ch_ & 7) * 8); } } while (0)
        S3_PF_LOAD(0);
#endif
        for (int hp = 0; hp < 4; ++hp) {
            __syncthreads();
#if defined(S3_PREFETCH)
            if (F.tid < 256) acsl[F.tid] = pa;
#pragma unroll
            for (int j = 0; j < 4; ++j) { const int id = F.tid + NTHR * j, r = id >> 4, ch = id & 15;
                float x[8]; unpack8(px[j], x);
#pragma unroll
                for (int k = 0; k < 8; ++k) x[k] *= pd[j];
                *(LAS u32x4*)(Xt + off_b(r, ch)) = pack8f(x); *(LAS u32x4*)(Ht + off_b(r, ch)) = ph[j]; }
            __syncthreads();
            u32x2 xva[4], zva[4];
#pragma unroll
            for (int pt = 0; pt < 4; ++pt) { const int chn = (g * 8 + hp * 2) * SSD_P + 16 * pt + 4 * qd;
                xva[pt] = *(const u32x2*)(xbc + (size_t)row * SSD_XBC + chn); zva[pt] = *(const u32x2*)(proj + (size_t)row * LDP + C_Z + chn); }
            __builtin_amdgcn_sched_barrier(0);
            if (hp < 3) S3_PF_LOAD(hp + 1);
            __builtin_amdgcn_sched_barrier(0);
#else
            if (F.tid < 256) { const int h2 = F.tid >> 7, l = F.tid & 127; acsl[F.tid] = acs[(size_t)(row0 + l) * SSD_H + g * 8 + hp * 2 + h2]; }
            for (int id = F.tid; id < 128 * 16; id += NTHR) { const int r = id >> 4, ch = id & 15, head = g * 8 + hp * 2 + (ch >> 3);
                float x[8]; unpack8(*(const u32x4*)(xbc + (size_t)(row0 + r) * SSD_XBC + g * 512 + hp * 128 + ch * 8), x);
                const float f = dt[(size_t)(row0 + r) * SSD_H + head];
#pragma unroll
                for (int k = 0; k < 8; ++k) x[k] *= f;
                *(LAS u32x4*)(Xt + off_b(r, ch)) = pack8f(x);
                *(LAS u32x4*)(Ht + off_b(r, ch)) = *(const u32x4*)(hin + ((size_t)((b * SSD_NC + c) * SSD_H + head) * SSD_N + r) * SSD_P + (ch & 7) * 8); }
            __syncthreads();
#endif
#if defined(S3_PREFETCH)
#pragma unroll 1
#else
#pragma unroll
#endif
            for (int h2 = 0; h2 < 2; ++h2) {
                const int head = g * 8 + hp * 2 + h2;
#if defined(SSD_IGLP)
                __builtin_amdgcn_iglp_opt(0);
#endif
                const float al = acsl[h2 * 128 + lrow], ea = __expf(al), dsv = dsk[head];
#if defined(S3_PREFETCH)
                if (h2 == 1) {
#pragma unroll
                    for (int pt = 0; pt < 4; ++pt) { const int chn = head * SSD_P + 16 * pt + 4 * qd;
                        xva[pt] = *(const u32x2*)(xbc + (size_t)row * SSD_XBC + chn); zva[pt] = *(const u32x2*)(proj + (size_t)row * LDP + C_Z + chn); } }
#else
                u32x2 xv4[4], zv4[4];
#pragma unroll
                for (int pt = 0; pt < 4; ++pt) { const int chn = head * SSD_P + 16 * pt + 4 * qd;
                    xv4[pt] = *(const u32x2*)(xbc + (size_t)row * SSD_XBC + chn); zv4[pt] = *(const u32x2*)(proj + (size_t)row * LDP + C_Z + chn); }
#endif
                bf16x8 mfr[4];
#pragma unroll
                for (int k = 0; k < 4; ++k) {
                    const f32x4 a0 = *(const LAS f32x4*)(acsl + h2 * 128 + 32 * k + 8 * qd), a1 = *(const LAS f32x4*)(acsl + h2 * 128 + 32 * k + 8 * qd + 4);
                    float mv[8];
#pragma unroll
                    for (int j = 0; j < 4; ++j) { const int s0 = 32 * k + 8 * qd + j, s1 = s0 + 4;
                        mv[j] = (s0 <= lrow) ? cb[k][0][j] * __expf(al - a0[j]) : 0.f;
                        mv[4 + j] = (s1 <= lrow) ? cb[k][1][j] * __expf(al - a1[j]) : 0.f; }
                    mfr[k] = as_bf16x8(pack8f(mv));
                }
#pragma unroll
                for (int pt = 0; pt < 4; ++pt) {
                    f32x4 yd = {0.f, 0.f, 0.f, 0.f}, yo = {0.f, 0.f, 0.f, 0.f};
#pragma unroll
                    for (int k = 0; k < 4; ++k) yd = MFMA16(tr_read8(Xt, lane, 32 * k, h2 * 4 + pt), mfr[k], yd);
#pragma unroll
                    for (int ks = 0; ks < 4; ++ks) yo = MFMA16(tr_read8(Ht, lane, 32 * ks, h2 * 4 + pt), cfr[ks], yo);
                    const int chn = head * SSD_P + 16 * pt + 4 * qd;
#if defined(S3_PREFETCH)
                    const u32x2 xv = xva[pt], zv = zva[pt];
#else
                    const u32x2 xv = xv4[pt], zv = zv4[pt];
#endif
                    const float xs[4] = {bflo(xv.x), bfhi(xv.x), bflo(xv.y), bfhi(xv.y)}, zz[4] = {bflo(zv.x), bfhi(zv.x), bflo(zv.y), bfhi(zv.y)};
                    float gy[4];
#pragma unroll
                    for (int j = 0; j < 4; ++j) { const float y = yd[j] + ea * yo[j] + dsv * xs[j]; gy[j] = y * siluf_(zz[j]); ssq += gy[j] * gy[j]; }
                    u32x2 o; o.x = pk2(gy[0], gy[1]); o.y = pk2(gy[2], gy[3]);
                    *(u32x2*)(yc + (size_t)row * DM + chn) = o;
                }
            }
        }
        ssq += shx(ssq, 16, lane); ssq += shx(ssq, 32, lane);
        if (qd == 0) rstdp[(size_t)row * SSD_G + g] = 1.0f / sqrtf(ssq * (1.0f / 512.0f) + EPS);
        __syncthreads();
    }
}

#ifndef NSA_REP_PART
#define NSA_REP_PART 0
#endif
#if NSA_REP_PART == 7
#define W7DUP(x) x
#define W7WAIT() NSA_WAITV(8)
#else
#define W7DUP(x)
#define W7WAIT() NSA_WAITV(4)
#endif
#if NSA_REP_PART == 10
#define SELDUP(x) x
#else
#define SELDUP(x)
#endif
constexpr int RB = 32768, NRING = 3;
#define NSA_WAITV(n) asm volatile("s_waitcnt vmcnt(" #n ")" ::: "memory")
#define NSA_BAR() do { asm volatile("" ::: "memory"); __builtin_amdgcn_s_barrier(); asm volatile("" ::: "memory"); } while (0)
template <bool WITHV> DI void tile_dma(LAS unsigned char* buf, const bf16* kp, const bf16* vp, int pitch, int w, int lane) {
#pragma unroll
    for (int e = 0; e < 2; ++e) { const int kb = 2 * w + e, kh = kb >> 3, T = (kb >> 2) & 1, ks = kb & 3, i = lane & 15, qd = lane >> 4;
        const int key = 32 * kh + 8 * (i >> 2) + (i & 3) + 4 * T, ch = 4 * ks + qd;
        __builtin_amdgcn_global_load_lds((const unsigned*)(kp + (size_t)key * pitch + ch * 8), (LAS unsigned*)(buf + kb * 1024), 16, 0, 0); }
    if (WITHV) {
#pragma unroll
        for (int e = 0; e < 2; ++e) { const int vb = 2 * w + e, kh = vb >> 3, t = (vb >> 2) & 1, dtp = vb & 3, dtl = lane >> 5, g = (lane >> 3) & 3, q = (lane >> 1) & 3, ph = lane & 1;
            const int key = 32 * kh + 8 * g + 4 * t + q, ch = 4 * dtp + 2 * dtl + ph;
            __builtin_amdgcn_global_load_lds((const unsigned*)(vp + (size_t)key * pitch + ch * 8), (LAS unsigned*)(buf + 16384 + vb * 1024), 16, 0, 0); }
    }
}
#define NSA_TR8(r, addr, b) asm volatile("ds_read_b64_tr_b16 %0, %8 offset:%9\n\tds_read_b64_tr_b16 %1, %8 offset:%10\n\tds_read_b64_tr_b16 %2, %8 offset:%11\n\tds_read_b64_tr_b16 %3, %8 offset:%12\n\t" \
        "ds_read_b64_tr_b16 %4, %8 offset:%13\n\tds_read_b64_tr_b16 %5, %8 offset:%14\n\tds_read_b64_tr_b16 %6, %8 offset:%15\n\tds_read_b64_tr_b16 %7, %8 offset:%16" \
        : "=&v"(r[0]), "=&v"(r[1]), "=&v"(r[2]), "=&v"(r[3]), "=&v"(r[4]), "=&v"(r[5]), "=&v"(r[6]), "=&v"(r[7]) \
        : "v"(addr), "i"((b)), "i"((b) + 4096), "i"((b) + 512), "i"((b) + 4608), "i"((b) + 1024), "i"((b) + 5120), "i"((b) + 1536), "i"((b) + 5632) : "memory")
#define NSA_TRWAIT(r) asm volatile("s_waitcnt lgkmcnt(0)" : "+v"(r[0]), "+v"(r[1]), "+v"(r[2]), "+v"(r[3]), "+v"(r[4]), "+v"(r[5]), "+v"(r[6]), "+v"(r[7]) :: "memory")
#define NSA_TRWAIT8(r) asm volatile("s_waitcnt lgkmcnt(8)" : "+v"(r[0]), "+v"(r[1]), "+v"(r[2]), "+v"(r[3]), "+v"(r[4]), "+v"(r[5]), "+v"(r[6]), "+v"(r[7]) :: "memory")
#if defined(NSA_NO_SB)
#define NSA_SB()
#else
#define NSA_SB() __builtin_amdgcn_sched_barrier(0)
#endif
#if !defined(NSA_NO_SETPRIO)
#define NSA_PRIO(x) __builtin_amdgcn_s_setprio(x)
#else
#define NSA_PRIO(x)
#endif
#define NSA_PV4(r, kh, d0) do { NSA_PRIO(1); _Pragma("unroll") for (int q_ = 0; q_ < 4; ++q_) { const bf16x8 vf_ = __builtin_shufflevector(r[2 * q_], r[2 * q_ + 1], 0, 1, 2, 3, 4, 5, 6, 7); \
        if (SM & 1) O[0][(d0) + q_] = MFMA16(vf_, pf[0][kh], O[0][(d0) + q_]); if (SM & 2) O[1][(d0) + q_] = MFMA16(vf_, pf[1][kh], O[1][(d0) + q_]); } NSA_PRIO(0); } while (0)
template <int MODE, int SM>
DI void attn_tile(LAS const unsigned char* Kt, LAS const unsigned char* Vt, const bf16x8 (&Qf)[2][4], f32x4 (&O)[2][8], float (&m)[2], float (&l)[2], const int (&lo)[2], const int (&hi)[2], bool needmask,
                  float c2, const float (&inv_l)[2], LAS float* imp, const int (&ql)[2], int jb0, float (&cin)[2], int lane) {
    const int qd = lane >> 4;
    f32x4 sc[2][2][2];
#if !defined(NSA_NO_IGLP)
    __builtin_amdgcn_iglp_opt(0);
#endif
#pragma unroll
    for (int kh = 0; kh < 2; ++kh)
#pragma unroll
        for (int T = 0; T < 2; ++T) { f32x4 a0 = {0.f, 0.f, 0.f, 0.f}, a1 = {0.f, 0.f, 0.f, 0.f};
#pragma unroll
            for (int ks = 0; ks < 4; ++ks) { const bf16x8 kf = lds_rd8(Kt + (kh * 8 + T * 4 + ks) * 1024);
                if (SM & 1) a0 = MFMA16(kf, Qf[0][ks], a0); if (SM & 2) a1 = MFMA16(kf, Qf[1][ks], a1); }
            sc[0][kh][T] = a0; sc[1][kh][T] = a1; }
    const float NEG = -__builtin_inff();
    bf16x8 pf[2][2];
#pragma unroll
    for (int s = 0; s < 2; ++s) if (SM & (1 << s)) {
        if (needmask) {
#pragma unroll
            for (int kh = 0; kh < 2; ++kh)
#pragma unroll
                for (int T = 0; T < 2; ++T)
#pragma unroll
                    for (int j = 0; j < 4; ++j) { const int kk = 32 * kh + 8 * qd + 4 * T + j; if (kk < lo[s] || kk > hi[s]) sc[s][kh][T][j] = NEG; }
        }
        float mn = m[s];
        if (MODE != 2) {
            float tmax = fmaxf(fmaxf(sc[s][0][0][0], sc[s][0][0][1]), fmaxf(sc[s][0][0][2], sc[s][0][0][3]));
            tmax = fmaxf(tmax, fmaxf(fmaxf(sc[s][0][1][0], sc[s][0][1][1]), fmaxf(sc[s][0][1][2], sc[s][0][1][3])));
            tmax = fmaxf(tmax, fmaxf(fmaxf(sc[s][1][0][0], sc[s][1][0][1]), fmaxf(sc[s][1][0][2], sc[s][1][0][3])));
            tmax = fmaxf(tmax, fmaxf(fmaxf(sc[s][1][1][0], sc[s][1][1][1]), fmaxf(sc[s][1][1][2], sc[s][1][1][3])));
            tmax = xq_max(tmax);
            mn = fmaxf(m[s], tmax);
            if (__ballot(mn != m[s]) != 0ull) {
                const float alpha = __builtin_amdgcn_exp2f((m[s] - mn) * c2);
                l[s] *= alpha;
                if (MODE == 1) {
#pragma unroll
                    for (int dt = 0; dt < 8; ++dt) O[s][dt] = O[s][dt] * alpha;
                }
                m[s] = mn;
            }
        }
        const float nmc = -mn * c2; float ps = 0.f;
#pragma unroll
        for (int kh = 0; kh < 2; ++kh)
#pragma unroll
            for (int T = 0; T < 2; ++T)
#pragma unroll
                for (int j = 0; j < 4; ++j) { float p = __builtin_amdgcn_exp2f(__builtin_fmaf(sc[s][kh][T][j], c2, nmc)); if (MODE == 2) p *= inv_l[s]; sc[s][kh][T][j] = p; ps += p; }
        if (MODE != 2) l[s] += ps;
        if (MODE == 2) {
            float s4[2][2], cy[2][2];
#pragma unroll
            for (int kh = 0; kh < 2; ++kh)
#pragma unroll
                for (int T = 0; T < 2; ++T) {
                    float a = (sc[s][kh][T][0] + sc[s][kh][T][1]) + (sc[s][kh][T][2] + sc[s][kh][T][3]), c = sc[s][kh][T][3];
                    a = quad_sum(a); c = quad_sum(c);
                    s4[kh][T] = a; cy[kh][T] = c; }
            const float x0 = shfl_idx(cy[0][1], (lane - 16) & 63), x1 = shfl_idx(cy[1][1], (lane - 16) & 63);
            const float p00 = (qd == 0) ? cin[s] : x0, p10 = (qd == 0) ? x0 : x1;
            cin[s] = x1;
            if ((lane & 3) == 0) { const int jb = jb0 + 2 * qd;
                *(LAS f32x2*)(imp + ql[s] * 128 + jb) = (f32x2){s4[0][0] + p00, s4[0][1] + cy[0][0]};
                *(LAS f32x2*)(imp + ql[s] * 128 + jb + 8) = (f32x2){s4[1][0] + p10, s4[1][1] + cy[1][0]}; }
        }
        if (MODE != 0) {
#pragma unroll
            for (int kh = 0; kh < 2; ++kh) { u32x4 pw; pw.x = pk2(sc[s][kh][0][0], sc[s][kh][0][1]); pw.y = pk2(sc[s][kh][0][2], sc[s][kh][0][3]); pw.z = pk2(sc[s][kh][1][0], sc[s][kh][1][1]); pw.w = pk2(sc[s][kh][1][2], sc[s][kh][1][3]); pf[s][kh] = as_bf16x8(pw); }
        }
    }
    if (MODE != 0) {
        const unsigned va = (unsigned)(size_t)Vt;
        s16x4 ra[8], rb[8];
        NSA_TR8(ra, va, 0);     NSA_TR8(rb, va, 2048); NSA_SB();
        NSA_TRWAIT8(ra); NSA_SB(); NSA_PV4(ra, 0, 0); NSA_SB(); NSA_TR8(ra, va, 8192);  NSA_SB();
        NSA_TRWAIT8(rb); NSA_SB(); NSA_PV4(rb, 0, 4); NSA_SB(); NSA_TR8(rb, va, 10240); NSA_SB();
        NSA_TRWAIT8(ra); NSA_SB(); NSA_PV4(ra, 1, 0); NSA_SB();
        NSA_TRWAIT(rb);  NSA_SB(); NSA_PV4(rb, 1, 4);
    }
}
template <bool FIRST> DI void nsa_emit(const f32x4 (&O)[8], float scale, bf16* dst  ) {
    u32x2 old[8];
    if (!FIRST) {
#pragma unroll
        for (int dt = 0; dt < 8; ++dt) old[dt] = *(const u32x2*)(dst + 16 * dt);
    }
#pragma unroll
    for (int dt = 0; dt < 8; ++dt) { f32x4 v = O[dt] * scale;
        if (!FIRST) { v[0] += bflo(old[dt].x); v[1] += bfhi(old[dt].x); v[2] += bflo(old[dt].y); v[3] += bfhi(old[dt].y); }
        u32x2 o; o.x = pk2(v[0], v[1]); o.y = pk2(v[2], v[3]); *(u32x2*)(dst + 16 * dt) = o; }
}
DI int next_bit(unsigned u0, unsigned u1, unsigned u2, unsigned u3, int from) {
    if (from >= 128) return -1;
    const int wd = from >> 5; const unsigned msk = ~0u << (from & 31);
    const unsigned x0 = (wd == 0) ? (u0 & msk) : 0u;
    const unsigned x1 = (wd < 1) ? u1 : ((wd == 1) ? (u1 & msk) : 0u);
    const unsigned x2 = (wd < 2) ? u2 : ((wd == 2) ? (u2 & msk) : 0u);
    const unsigned x3 = (wd < 3) ? u3 : (u3 & msk);
    if (x0) return __builtin_ctz(x0);
    if (x1) return 32 + __builtin_ctz(x1);
    if (x2) return 64 + __builtin_ctz(x2);
    if (x3) return 96 + __builtin_ctz(x3);
    return -1;
}

DI void nsa_phase(const Frame& F0, const Args& A, int layer) {
    const Frame F = phase_frame(F0);
    const bf16* proj = (const bf16*)(F.ws + WS_PROJ); const bf16* kcmp = (const bf16*)(F.ws + WS_KCMP); const bf16* vcmp = (const bf16*)(F.ws + WS_VCMP);
    bf16* ya = (bf16*)(F.ws + WS_YA);
    LAS unsigned char* const RG = F.lds;
    LAS float* imp = (LAS float*)(F.lds + NRING * RB);
    LAS unsigned* selm = (LAS unsigned*)(F.lds + NRING * RB + 32768); LAS unsigned* uml = selm + 256;
    static_assert(NRING * RB + 32768 + 1024 + 16 <= LDSCTL_OFF && NRING * RB + 32768 == 4 * RB, "nsa LDS map (the selected loop's pair buffers overlay ring + importance table)");
    const float c2 = 0.08838834764831845f * 1.4426950408889634f;
    (void)A; (void)layer;
#if defined(NSA_PRIO)
    if (F.wave < 4) __builtin_amdgcn_s_setprio(2); else __builtin_amdgcn_s_setprio(0);
#endif
    for (int u = F.bid; u < 1024; u += F.G) {
        int tid_l = F.tid; asm volatile("" : "+v"(tid_l));
        const int tid = tid_l, lane = tid & 63, w = F.wave, i = lane & 15, qd = lane >> 4, hd = i & 3;
        const int klane = 16 * lane, vlane = 16384 + 8 * lane;
        const int xg = u & 7, jj = (u >> 3) & 31, rr = u >> 8;
        const int b = xg >> 2, g = xg & 3;
        const int qt = (rr == 0) ? 127 - jj : (rr == 1) ? 64 + jj : (rr == 2) ? 63 - jj : jj;
        const int s0 = qt * 64, cur = qt, rowb = b * SEQ;
        int ql[2], trow[2]; bf16x8 Qf[2][4];
#pragma unroll
        for (int s = 0; s < 2; ++s) { ql[s] = 8 * w + 4 * s + (i >> 2); trow[s] = rowb + s0 + ql[s];
#pragma unroll
            for (int ks = 0; ks < 4; ++ks) Qf[s][ks] = *(const bf16x8*)(proj + (size_t)trow[s] * LDP + C_Q + (4 * g + hd) * HD + 32 * ks + 8 * qd); }
        f32x4 O[2][8]; float mrow[2], lrow[2], cin[2], invl[2] = {0.f, 0.f};
        const int ntc = (4 * qt + 3 + 63) >> 6;
        const bf16* kc0 = kcmp + (size_t)(b * NG + g) * NCMP_PAD * HD; const bf16* vc0 = vcmp + (size_t)(b * NG + g) * NCMP_PAD * HD;
        int nmax[2];
#pragma unroll
        for (int s = 0; s < 2; ++s) { const int t = s0 + ql[s]; nmax[s] = (t >= 31) ? ((t - 31) >> 4) : -1; mrow[s] = -1e30f; lrow[s] = 0.f; cin[s] = 0.f; }
        for (int rep_ = 0; rep_ < (NSA_REP_PART == 2 ? 2 : 1); ++rep_) {
#pragma unroll
        for (int s = 0; s < 2; ++s) { mrow[s] = -1e30f; lrow[s] = 0.f; cin[s] = 0.f; }
        NSA_WAITV(0); NSA_BAR();
        tile_dma<false>(RG, kc0, vc0, HD, w, lane); if (ntc > 1) tile_dma<false>(RG + RB, kc0 + (size_t)64 * HD, vc0, HD, w, lane);
        for (int tc = 0, rb = 0; tc < ntc; ++tc) {
            if (tc + 1 < ntc) NSA_WAITV(2); else NSA_WAITV(0);
            NSA_BAR();
            if (tc + 2 < ntc) { const int nb2 = (rb + 2 >= NRING) ? rb + 2 - NRING : rb + 2; tile_dma<false>(RG + nb2 * RB, kc0 + (size_t)(tc + 2) * 64 * HD, vc0, HD, w, lane); }
            { const int lo2[2] = {0, 0}, hi2[2] = {nmax[0] - 64 * tc, nmax[1] - 64 * tc}; const bool nm = __ballot(hi2[0] < 63 || hi2[1] < 63) != 0ull;
              attn_tile<0, 3>(RG + rb * RB + klane, RG, Qf, O, mrow, lrow, lo2, hi2, nm, c2, invl, imp, ql, 0, cin, lane); }
            rb = (rb + 1 == NRING) ? 0 : rb + 1;
        }
#pragma unroll
        for (int s = 0; s < 2; ++s) { float lt = lrow[s]; lt = xq_sum(lt); invl[s] = (lt > 0.f) ? 1.0f / lt : 0.f;
#pragma unroll
            for (int dt = 0; dt < 8; ++dt) O[s][dt] = (f32x4){0.f, 0.f, 0.f, 0.f}; }
        NSA_BAR();
        tile_dma<true>(RG, kc0, vc0, HD, w, lane); if (ntc > 1) tile_dma<true>(RG + RB, kc0 + (size_t)64 * HD, vc0 + (size_t)64 * HD, HD, w, lane);
        for (int tc = 0, rb = 0; tc < ntc; ++tc) {
            if (tc + 1 < ntc) NSA_WAITV(4); else NSA_WAITV(0);
            NSA_BAR();
            if (tc + 2 < ntc) { const int nb2 = (rb + 2 >= NRING) ? rb + 2 - NRING : rb + 2; tile_dma<true>(RG + nb2 * RB, kc0 + (size_t)(tc + 2) * 64 * HD, vc0 + (size_t)(tc + 2) * 64 * HD, HD, w, lane); }
            { const int lo2[2] = {0, 0}, hi2[2] = {nmax[0] - 64 * tc, nmax[1] - 64 * tc}; const bool nm = __ballot(hi2[0] < 63 || hi2[1] < 63) != 0ull;
              attn_tile<2, 3>(RG + rb * RB + klane, RG + rb * RB + vlane, Qf, O, mrow, lrow, lo2, hi2, nm, c2, invl, imp, ql, 16 * tc, cin, lane); }
            rb = (rb + 1 == NRING) ? 0 : rb + 1;
        }
#pragma unroll
        for (int s = 0; s < 2; ++s) { const float gate = sigmoidf_(bf2f(proj[(size_t)trow[s] * LDP + C_GN + (4 * g + hd) * 3 + 0]));
            nsa_emit<true>(O[s], gate, ya + (size_t)trow[s] * DM + (4 * g + hd) * HD + 4 * qd); }
        }
        for (int rep_ = 0; rep_ < (NSA_REP_PART == 1 ? 2 : 1); ++rep_) {
            LDS_WAIT();
            const int nforced = (cur == 0) ? 1 : (cur == 1) ? 2 : 3; const int nsel = (cur + 1 < NSEL) ? cur + 1 : NSEL; const int R = nsel - nforced;
            const int E = (cur >= 3) ? cur - 2 : 0;
            for (int q8 = 0; q8 < 8; ++q8) {
                const int q = 8 * w + q8;
                const int j0 = lane, j1 = lane + 64;
                const bool e0 = (j0 >= 1) && (j0 <= cur - 2), e1 = (j1 <= cur - 2);
                const bool f0 = (j0 == 0) || (j0 == cur) || (j0 == cur - 1), f1 = (j1 == cur) || (j1 == cur - 1);
                bool s0 = e0, s1 = e1;
                if (R < E) {
                    const unsigned k0 = e0 ? __builtin_bit_cast(unsigned, imp[q * 128 + j0]) + 1u : 0u, k1 = e1 ? __builtin_bit_cast(unsigned, imp[q * 128 + j1]) + 1u : 0u;
                    unsigned T = 0u;
#pragma unroll 1
                    for (int bit = 30; bit >= 0; --bit) { const unsigned c = T | (1u << bit);
                        const int n = __builtin_popcountll(__ballot(k0 >= c)) + __builtin_popcountll(__ballot(k1 >= c));
                        if (n >= R) T = c; }
                    const unsigned long long eq0 = __ballot(k0 == T), eq1 = __ballot(k1 == T);
                    const int G = __builtin_popcountll(__ballot(k0 > T)) + __builtin_popcountll(__ballot(k1 > T));
                    const unsigned long long lt = (1ull << lane) - 1ull;
                    const int r0 = __builtin_popcountll(eq0 & lt), r1 = __builtin_popcountll(eq0) + __builtin_popcountll(eq1 & lt);
                    s0 = (k0 > T) || (k0 == T && r0 < R - G); s1 = (k1 > T) || (k1 == T && r1 < R - G);
                }
                const unsigned long long m0 = __ballot(f0 || s0), m1 = __ballot(f1 || s1);
                if (lane == 0) { selm[q * 4 + 0] = (unsigned)m0; selm[q * 4 + 1] = (unsigned)(m0 >> 32); selm[q * 4 + 2] = (unsigned)m1; selm[q * 4 + 3] = (unsigned)(m1 >> 32); }
            }
            __syncthreads();
            if (w == 0) { unsigned x0 = selm[lane * 4 + 0], x1 = selm[lane * 4 + 1], x2 = selm[lane * 4 + 2], x3 = selm[lane * 4 + 3];
#pragma unroll
                for (int o = 1; o < 64; o <<= 1) { x0 |= shfl_idx_u(x0, lane ^ o); x1 |= shfl_idx_u(x1, lane ^ o); x2 |= shfl_idx_u(x2, lane ^ o); x3 |= shfl_idx_u(x3, lane ^ o); }
                if (lane == 0) { uml[0] = x0; uml[1] = x1; uml[2] = x2; uml[3] = x3; } }
            __syncthreads();
        }
        const unsigned um0 = __builtin_amdgcn_readfirstlane(uml[0]), um1 = __builtin_amdgcn_readfirstlane(uml[1]), um2 = __builtin_amdgcn_readfirstlane(uml[2]), um3 = __builtin_amdgcn_readfirstlane(uml[3]);
        for (int rep_ = 0; rep_ < (NSA_REP_PART == 3 ? 2 : 1); ++rep_) {
            const bf16* ks0 = (const bf16*)(F.ws + WS_KV) + kv_off(2, b, g, 0); const bf16* vs0 = (const bf16*)(F.ws + WS_KV) + kv_off(3, b, g, 0);
#pragma unroll
            for (int s = 0; s < 2; ++s) { mrow[s] = -1e30f; lrow[s] = 0.f;
#pragma unroll
                for (int dt = 0; dt < 8; ++dt) O[s][dt] = (f32x4){0.f, 0.f, 0.f, 0.f}; }
#if NSA_REP_PART == 11
            {
            int jaD = next_bit(um0, um1, um2, um3, 0), jbD = next_bit(um0, um1, um2, um3, jaD + 1), pbD = 0;
            VM_WAIT(); if (NSA_REP_PART == 3) NSA_BAR();
            tile_dma<true>(RG, ks0 + (size_t)jaD * 64 * HD, vs0 + (size_t)jaD * 64 * HD, HD, w, lane); SELDUP(tile_dma<true>(RG, ks0 + (size_t)jaD * 64 * HD, vs0 + (size_t)jaD * 64 * HD, HD, w, lane);)
            if (jbD >= 0) tile_dma<true>(RG + RB, ks0 + (size_t)jbD * 64 * HD, vs0 + (size_t)jbD * 64 * HD, HD, w, lane); SELDUP(tile_dma<true>(RG + RB, ks0 + (size_t)jbD * 64 * HD, vs0 + (size_t)jbD * 64 * HD, HD, w, lane);)
            while (jaD >= 0) {
                const int jcD = (jbD >= 0) ? next_bit(um0, um1, um2, um3, jbD + 1) : -1, jdD = (jcD >= 0) ? next_bit(um0, um1, um2, um3, jcD + 1) : -1;
                NSA_WAITV(0);
                NSA_BAR();
                if (jcD >= 0) { LAS unsigned char* nb = RG + (pbD ^ 1) * 2 * RB; tile_dma<true>(nb, ks0 + (size_t)jcD * 64 * HD, vs0 + (size_t)jcD * 64 * HD, HD, w, lane); SELDUP(tile_dma<true>(nb, ks0 + (size_t)jcD * 64 * HD, vs0 + (size_t)jcD * 64 * HD, HD, w, lane);)
                    if (jdD >= 0) tile_dma<true>(nb + RB, ks0 + (size_t)jdD * 64 * HD, vs0 + (size_t)jdD * 64 * HD, HD, w, lane); SELDUP(tile_dma<true>(nb + RB, ks0 + (size_t)jdD * 64 * HD, vs0 + (size_t)jdD * 64 * HD, HD, w, lane);) }
                jaD = jcD; jbD = jdD; pbD ^= 1;
            }
            NSA_BAR();
            }
#endif
            int ja = next_bit(um0, um1, um2, um3, 0), jbb = next_bit(um0, um1, um2, um3, ja + 1), pbuf = 0;
            VM_WAIT(); if (NSA_REP_PART == 3) NSA_BAR();
            tile_dma<true>(RG, ks0 + (size_t)ja * 64 * HD, vs0 + (size_t)ja * 64 * HD, HD, w, lane); SELDUP(tile_dma<true>(RG, ks0 + (size_t)ja * 64 * HD, vs0 + (size_t)ja * 64 * HD, HD, w, lane);)
            if (jbb >= 0) tile_dma<true>(RG + RB, ks0 + (size_t)jbb * 64 * HD, vs0 + (size_t)jbb * 64 * HD, HD, w, lane); SELDUP(tile_dma<true>(RG + RB, ks0 + (size_t)jbb * 64 * HD, vs0 + (size_t)jbb * 64 * HD, HD, w, lane);)
            while (ja >= 0) {
                const int jc = (jbb >= 0) ? next_bit(um0, um1, um2, um3, jbb + 1) : -1, jd = (jc >= 0) ? next_bit(um0, um1, um2, um3, jc + 1) : -1;
                NSA_WAITV(0);
                NSA_BAR();
                if (jc >= 0) { LAS unsigned char* nb = RG + (pbuf ^ 1) * 2 * RB; tile_dma<true>(nb, ks0 + (size_t)jc * 64 * HD, vs0 + (size_t)jc * 64 * HD, HD, w, lane); SELDUP(tile_dma<true>(nb, ks0 + (size_t)jc * 64 * HD, vs0 + (size_t)jc * 64 * HD, HD, w, lane);)
                    if (jd >= 0) tile_dma<true>(nb + RB, ks0 + (size_t)jd * 64 * HD, vs0 + (size_t)jd * 64 * HD, HD, w, lane); SELDUP(tile_dma<true>(nb + RB, ks0 + (size_t)jd * 64 * HD, vs0 + (size_t)jd * 64 * HD, HD, w, lane);) }
#pragma unroll 1
                for (int e2 = 0; e2 < 2; ++e2) { const int jb = e2 ? jbb : ja; if (jb < 0) break;
                  const bool act0 = (selm[ql[0] * 4 + (jb >> 5)] >> (jb & 31)) & 1u, act1 = (selm[ql[1] * 4 + (jb >> 5)] >> (jb & 31)) & 1u;
                  const bool any0 = __ballot(act0) != 0ull, any1 = __ballot(act1) != 0ull;
                  const int lo2[2] = {0, 0}, hi2[2] = {act0 ? ((jb < cur) ? 63 : ql[0]) : -1, act1 ? ((jb < cur) ? 63 : ql[1]) : -1};
                  LAS const unsigned char* kt = RG + (pbuf * 2 + e2) * RB + klane; LAS const unsigned char* vt = RG + (pbuf * 2 + e2) * RB + vlane;
                  if (any0 && any1) { const bool nm = __ballot(hi2[0] < 63 || hi2[1] < 63) != 0ull; attn_tile<1, 3>(kt, vt, Qf, O, mrow, lrow, lo2, hi2, nm, c2, invl, imp, ql, 0, cin, lane); }
                  else if (any0) { const bool nm = __ballot(hi2[0] < 63) != 0ull; attn_tile<1, 1>(kt, vt, Qf, O, mrow, lrow, lo2, hi2, nm, c2, invl, imp, ql, 0, cin, lane); }
                  else if (any1) { const bool nm = __ballot(hi2[1] < 63) != 0ull; attn_tile<1, 2>(kt, vt, Qf, O, mrow, lrow, lo2, hi2, nm, c2, invl, imp, ql, 0, cin, lane); } }
                ja = jc; jbb = jd; pbuf ^= 1;
            }
            NSA_BAR();
#pragma unroll
            for (int s = 0; s < 2; ++s) { float lt = lrow[s]; lt = xq_sum(lt);
                const float gate = sigmoidf_(bf2f(proj[(size_t)trow[s] * LDP + C_GN + (4 * g + hd) * 3 + 1]));
                if (rep_ == 0) nsa_emit<false>(O[s], (lt > 0.f) ? gate / lt : 0.f, ya + (size_t)trow[s] * DM + (4 * g + hd) * HD + 4 * qd); }
        }
        for (int rep_ = 0; rep_ < (NSA_REP_PART == 4 ? 2 : 1); ++rep_) {
            const bf16* kw0 = (const bf16*)(F.ws + WS_KV) + kv_off(4, b, g, 0); const bf16* vw0 = (const bf16*)(F.ws + WS_KV) + kv_off(5, b, g, 0);
#pragma unroll
            for (int s = 0; s < 2; ++s) { mrow[s] = -1e30f; lrow[s] = 0.f;
#pragma unroll
                for (int dt = 0; dt < 8; ++dt) O[s][dt] = (f32x4){0.f, 0.f, 0.f, 0.f}; }
#if NSA_REP_PART == 8
            {
            const int tt0d = (qt >= 8) ? 0 : 8 - qt;
            VM_WAIT(); NSA_BAR();
            { const size_t r0 = (size_t)(s0 - 512 + 64 * tt0d) * HD; tile_dma<true>(RG, kw0 + r0, vw0 + r0, HD, w, lane); W7DUP(tile_dma<true>(RG, kw0 + r0, vw0 + r0, HD, w, lane);) }
            if (tt0d < 8) { const size_t r0 = (size_t)(s0 - 512 + 64 * (tt0d + 1)) * HD; tile_dma<true>(RG + RB, kw0 + r0, vw0 + r0, HD, w, lane); W7DUP(tile_dma<true>(RG + RB, kw0 + r0, vw0 + r0, HD, w, lane);) }
            for (int tt = tt0d, rb = 0; tt <= 8; ++tt) {
                if (tt < 8) { W7WAIT(); } else NSA_WAITV(0);
                NSA_BAR();
                if (tt + 2 <= 8) { const int nb2 = (rb + 2 >= NRING) ? rb + 2 - NRING : rb + 2; const size_t r0 = (size_t)(s0 - 512 + 64 * (tt + 2)) * HD; tile_dma<true>(RG + nb2 * RB, kw0 + r0, vw0 + r0, HD, w, lane); W7DUP(tile_dma<true>(RG + nb2 * RB, kw0 + r0, vw0 + r0, HD, w, lane);) }
                rb = (rb + 1 == NRING) ? 0 : rb + 1;
            }
            }
#endif
            const int tt0 = (qt >= 8) ? 0 : 8 - qt;
            VM_WAIT(); NSA_BAR();
            { const size_t r0 = (size_t)(s0 - 512 + 64 * tt0) * HD; tile_dma<true>(RG, kw0 + r0, vw0 + r0, HD, w, lane); W7DUP(tile_dma<true>(RG, kw0 + r0, vw0 + r0, HD, w, lane);) }
            if (tt0 < 8) { const size_t r0 = (size_t)(s0 - 512 + 64 * (tt0 + 1)) * HD; tile_dma<true>(RG + RB, kw0 + r0, vw0 + r0, HD, w, lane); W7DUP(tile_dma<true>(RG + RB, kw0 + r0, vw0 + r0, HD, w, lane);) }
            for (int tt = tt0, rb = 0; tt <= 8; ++tt) {
                if (tt < 8) { W7WAIT(); } else NSA_WAITV(0);
                NSA_BAR();
                if (tt + 2 <= 8) { const int nb2 = (rb + 2 >= NRING) ? rb + 2 - NRING : rb + 2; const size_t r0 = (size_t)(s0 - 512 + 64 * (tt + 2)) * HD; tile_dma<true>(RG + nb2 * RB, kw0 + r0, vw0 + r0, HD, w, lane); W7DUP(tile_dma<true>(RG + nb2 * RB, kw0 + r0, vw0 + r0, HD, w, lane);) }
                { const int lo2[2] = {(tt == 0) ? ql[0] + 1 : 0, (tt == 0) ? ql[1] + 1 : 0}, hi2[2] = {(tt == 8) ? ql[0] : 63, (tt == 8) ? ql[1] : 63};
                  attn_tile<1, 3>(RG + rb * RB + klane, RG + rb * RB + vlane, Qf, O, mrow, lrow, lo2, hi2, (tt == 0) || (tt == 8), c2, invl, imp, ql, 0, cin, lane);
#if NSA_REP_PART == 5
                  { const int him[2] = {-1, -1}; attn_tile<1, 3>(RG + rb * RB + klane, RG + rb * RB + vlane, Qf, O, mrow, lrow, lo2, him, true, c2, invl, imp, ql, 0, cin, lane); }
#endif
#if NSA_REP_PART == 6
                  NSA_BAR(); NSA_BAR(); NSA_BAR(); NSA_BAR();
#endif
                }
                rb = (rb + 1 == NRING) ? 0 : rb + 1;
            }
            VM_WAIT();
#pragma unroll
            for (int s = 0; s < 2; ++s) { float lt = lrow[s]; lt = xq_sum(lt);
                const float gate = sigmoidf_(bf2f(proj[(size_t)trow[s] * LDP + C_GN + (4 * g + hd) * 3 + 2]));
                if (rep_ == 0) nsa_emit<false>(O[s], (lt > 0.f) ? gate / lt : 0.f, ya + (size_t)trow[s] * DM + (4 * g + hd) * HD + 4 * qd); }
        }
        __syncthreads();
    }
    __builtin_amdgcn_s_setprio(0);
}

#if defined(CHECK_BUILD) && CHECK_BUILD
DI unsigned hash_u(unsigned x) { x ^= x >> 16; x *= 0x7feb352du; x ^= x >> 15; x *= 0x846ca68bu; x ^= x >> 16; return x; }
DI float blk_sum(float v, LAS float* red, int tid, int nthr) {
    for (int o = 32; o >= 1; o >>= 1) v += __shfl_xor(v, o);
    __syncthreads(); if ((tid & 63) == 0) red[tid >> 6] = v; __syncthreads();
    float s = 0.f; for (int k = 0; k < nthr / 64; ++k) s += red[k]; __syncthreads(); return s;
}
__global__ void chk_proj(Args args) {
    const int lane = threadIdx.x & 63, smp = blockIdx.x * (blockDim.x >> 6) + (threadIdx.x >> 6);
    const bf16* hb = (const bf16*)(args.ws + WS_HB); const bf16* proj = (const bf16*)(args.ws + WS_PROJ); const float* win = (const float*)args.in[4]; const int* pos = (const int*)args.in[2];
    unsigned* res = (unsigned*)(args.ws + WS_CTL) + CW_CHK;
    const unsigned h = hash_u(smp * 2654435761u + 12345u);
    int row = h % M; if (smp < 4) row = (smp == 0) ? 0 : (smp == 1) ? 8191 : (smp == 2) ? 8192 : 16383;
    const int kind = smp % 15; const unsigned h2 = hash_u(h + 77u);
    const int srcb[15] = {0, 2048, 2560, 3072, 3584, 4096, 4608, 5120, 5168, 7216, 9264, 11312, 13360, 16432, 16464};
    const int dstb[15] = {C_Q, C_KC, C_VC, C_KS, C_VS, C_KW, C_VW, C_GN, C_CB, C_CC, C_CU, C_Z, C_XBC, C_DT, C_GM};
    const int wid[15] = {2048, 512, 512, 512, 512, 512, 512, 48, 2048, 2048, 2048, 2048, 3072, 32, 6144};
    const bool rope = (kind == 0 || kind == 1 || kind == 3 || kind == 5);
    int e = h2 % wid[kind]; if (rope) e = (e / 128) * 128 + (e % 64);
    float d0 = 0.f, d1 = 0.f;
    for (int k = lane; k < DM; k += 64) { const float a = bf2f(hb[(size_t)row * DM + k]); d0 += a * win[(size_t)k * PROJ_SRC + srcb[kind] + e]; if (rope) d1 += a * win[(size_t)k * PROJ_SRC + srcb[kind] + e + 64]; }
    for (int o = 32; o >= 1; o >>= 1) { d0 += __shfl_xor(d0, o); d1 += __shfl_xor(d1, o); }
    float e0 = d0, e1 = d1;
    if (rope) { const double inv = exp(-(double)(2 * (e % 64)) / 128.0 * 9.210340371976184); double ang = (double)pos[row] * inv; ang -= 6.283185307179586476925 * __builtin_rint(ang * 0.15915494309189533577); const float c = cosf((float)ang), s = sinf((float)ang); e0 = d0 * c - d1 * s; e1 = d1 * c + d0 * s; }
    if (lane == 0) {
        const bf16* kvb = (const bf16*)(args.ws + WS_KV);
        const bool inkv = (kind >= 1 && kind <= 6);
        const bf16* src = inkv ? kvb + kv_off(kind - 1, row >> 13, e >> 7, row & 8191) + (e & 127) : proj + (size_t)row * LDP + dstb[kind] + e;
        const float g0 = bf2f(src[0]); float err = fabsf(g0 - e0) / (0.03f + 0.02f * fabsf(e0));
        if (rope) { const float g1 = bf2f(src[64]); err = fmaxf(err, fabsf(g1 - e1) / (0.03f + 0.02f * fabsf(e1))); }
        if (!(err <= 1.0f)) atomicAdd(res + 0, 1u);
        atomicMax(res + 1, __float_as_uint(fminf(err, 1e6f)));
    }
}
__global__ void chk_cmp(Args args) {
    __shared__ float hid[128];
    const int tid = threadIdx.x, smp = blockIdx.x;
    const unsigned h = hash_u(smp * 40503u + 99u);
    const int kv = smp & 1, b = (smp >> 1) & 1, g = (smp >> 2) & 3; int n = h % NCMP; if (smp < 8) n = (smp < 4) ? 0 : 510;
    const bf16* proj = (const bf16*)(args.ws + WS_PROJ);
    const float* pe = (const float*)args.in[kv ? 6 : 5]; const float* w1 = (const float*)args.in[kv ? 11 : 7]; const float* b1 = (const float*)args.in[kv ? 12 : 8];
    const float* w2 = (const float*)args.in[kv ? 13 : 9]; const float* b2 = (const float*)args.in[kv ? 14 : 10];
    const bf16* out = (const bf16*)(args.ws + (kv ? WS_VCMP : WS_KCMP));
    unsigned* res = (unsigned*)(args.ws + WS_CTL) + CW_CHK;
    float s = b1[tid];
    for (int l = 0; l < 32; ++l) { const bf16* kr = (const bf16*)(args.ws + WS_KV) + kv_off(kv, b, g, 16 * n + l);
        for (int d = 0; d < 128; ++d) s += (bf2f(kr[d]) + pe[l * 128 + d]) * w1[(size_t)(l * 128 + d) * 128 + tid]; }
    hid[tid] = s / (1.0f + expf(-s));
    __syncthreads();
    float o = b2[tid];
    for (int k = 0; k < 128; ++k) o += hid[k] * w2[k * 128 + tid];
    const float got = bf2f(out[((size_t)(b * NG + g) * NCMP_PAD + n) * HD + tid]);
    const float err = fabsf(got - o) / (0.02f + 0.02f * fabsf(o));
    if (!(err <= 1.0f)) atomicAdd(res + 2, 1u);
    atomicMax(res + 3, __float_as_uint(fminf(err, 1e6f)));
}
constexpr int CHK_NT = 24;
__global__ void __launch_bounds__(256) chk_nsa(Args args) {
    __shared__ float qf[4][128], oacc[4][128], obr[4][128], sc[4][1024], imp[128], red[8];
    __shared__ int kl[1024], seln[16], usedl[128];
    const int tlist[CHK_NT] = {0, 1, 30, 31, 47, 63, 64, 65, 127, 128, 500, 511, 512, 513, 575, 1023, 1024, 1087, 2000, 4095, 4096, 6000, 8128, 8191};
    const int tid = threadIdx.x, smp = blockIdx.x;
    const int t = tlist[smp % CHK_NT], bg = (smp / CHK_NT + smp) & 7, b = bg >> 2, g = bg & 3, row = b * SEQ + t, cur = t >> 6;
    const bf16* proj = (const bf16*)(args.ws + WS_PROJ); const bf16* kcmp = (const bf16*)(args.ws + WS_KCMP) + (size_t)(b * NG + g) * NCMP_PAD * HD; const bf16* vcmp = (const bf16*)(args.ws + WS_VCMP) + (size_t)(b * NG + g) * NCMP_PAD * HD;
    const bf16* ya = (const bf16*)(args.ws + WS_YA);
    unsigned* res = (unsigned*)(args.ws + WS_CTL) + CW_CHK;
    const float scale = 0.08838834764831845f;
    for (int k = tid; k < 512; k += 256) { const int r = k >> 7, d = k & 127; qf[r][d] = bf2f(proj[(size_t)row * LDP + C_Q + (4 * g + r) * HD + d]); oacc[r][d] = 0.f; }
    __syncthreads();
    for (int br = 0; br < 3; ++br) {
        int nk = 0;
        if (br == 0) { nk = (t >= 31) ? ((t - 31) >> 4) + 1 : 0; for (int k = tid; k < nk; k += 256) kl[k] = k; }
        else if (br == 1) {
            if (tid == 0) {
                for (int j = 0; j < 128; ++j) usedl[j] = 0;
                for (int it = 0; it < 16; ++it) { int best = -1; float bv = 0.f;
                    for (int j = 0; j < 128; ++j) { if (usedl[j]) continue; const bool valid = (64 * j <= t); const bool forced = (j == 0) || (j == cur) || (j == cur - 1);
                        const float v = valid ? imp[j] + (forced ? 1.0e4f : 0.f) : -__builtin_inff();
                        if (best < 0 || v > bv) { best = j; bv = v; } }
                    usedl[best] = 1; seln[it] = best; } }
            __syncthreads();
            for (int k = tid; k < 1024; k += 256) kl[k] = seln[k >> 6] * 64 + (k & 63);
            nk = 1024;
        } else { nk = 576; for (int k = tid; k < 576; k += 256) kl[k] = (t & ~63) - WIN + k; }
        __syncthreads();
        for (int idx = tid; idx < 4 * nk; idx += 256) { const int r = idx / nk, k = idx - r * nk, key = kl[k];
            bool ok; const bf16* kp;
            if (br == 0) { ok = true; kp = kcmp + (size_t)key * HD; }
            else if (br == 1) { ok = (key <= t); kp = (const bf16*)(args.ws + WS_KV) + kv_off(2, b, g, key); }
            else { ok = (key >= 0) && (key <= t) && (key > t - WIN); kp = (const bf16*)(args.ws + WS_KV) + kv_off(4, b, g, key < 0 ? 0 : key); }
            float s = 0.f; for (int d = 0; d < 128; ++d) s += qf[r][d] * bf2f(kp[d]);
            sc[r][k] = ok ? s * scale : -__builtin_inff(); }
        __syncthreads();
        if (tid < 4) { float m = -__builtin_inff(); for (int k = 0; k < nk; ++k) m = fmaxf(m, sc[tid][k]);
            const float mm = (m > -1e30f) ? m : 0.f; float l = 0.f; for (int k = 0; k < nk; ++k) { const float e = (sc[tid][k] > -1e30f) ? expf(sc[tid][k] - mm) : 0.f; sc[tid][k] = e; l += e; }
            const float il = (l > 0.f) ? 1.0f / l : 0.f; for (int k = 0; k < nk; ++k) sc[tid][k] *= il; }
        __syncthreads();
        if (br == 0) { if (tid < 128) { float s = 0.f; for (int r = 0; r < 4; ++r) for (int n = 4 * tid - 1; n <= 4 * tid + 3; ++n) if (n >= 0 && n < nk) s += sc[r][n]; imp[tid] = s; } }
        for (int o = tid; o < 512; o += 256) { const int r = o >> 7, d = o & 127; float s = 0.f;
            for (int k = 0; k < nk; ++k) { const float p = sc[r][k]; if (p == 0.f) continue; const int key = kl[k];
                const bf16* vp = (br == 0) ? vcmp + (size_t)key * HD : (const bf16*)(args.ws + WS_KV) + kv_off(br == 1 ? 3 : 5, b, g, key);
                s += p * bf2f(vp[d]); }
            const float gate = 1.0f / (1.0f + expf(-bf2f(proj[(size_t)row * LDP + C_GN + (4 * g + r) * 3 + br])));
            oacc[r][d] += gate * s; obr[r][d] = s; }
        __syncthreads();
    }
    float errm = 0.f;
    for (int o = tid; o < 512; o += 256) { const int r = o >> 7, d = o & 127; const float got = bf2f(ya[(size_t)row * DM + (4 * g + r) * HD + d]), ex = oacc[r][d] * (CHECK_BUILD == 2 ? ((smp & 1) ? 1.5f : 1.0f) : 1.0f);
        errm = fmaxf(errm, fabsf(got - ex) / (0.006f + 0.03f * fabsf(ex))); }
    for (int o = 32; o >= 1; o >>= 1) errm = fmaxf(errm, __shfl_xor(errm, o));
    if ((tid & 63) == 0) red[tid >> 6] = errm;
    __syncthreads();
    if (tid == 0) { const float e = fmaxf(fmaxf(red[0], red[1]), fmaxf(red[2], red[3])); if (!(e <= 1.0f)) atomicAdd(res + 4, 1u); atomicMax(res + 5, __float_as_uint(fminf(e, 1e6f))); }
}
#ifndef CHK_B_SEL
#define CHK_B_SEL 5
#endif
__global__ void chk_report(Args args) {
    const unsigned* res = (const unsigned*)(args.ws + WS_CTL) + CW_CHK;
    const float A = 4.0f * (float)res[4] + (res[2] ? 2000.f : 0.f) + (res[0] ? 40000.f : 0.f);
    const float B = fminf(__uint_as_float(res[CHK_B_SEL]), 100.f);
    const size_t i = (size_t)blockIdx.x * blockDim.x + threadIdx.x;
    if (A > 0.f) { if (i == 0) args.out[0] += A; if (i >= 1 && i <= (1u << 20)) args.out[i] += B; }
}
#endif

constexpr int NPH_LAYER = 13, NPH = 2 + NPH_LAYER * DEPTH;
#ifndef PG8_SP2
#define PG8_SP2 true
#endif
#ifndef PG8_ALIGN
#define PG8_ALIGN true
#endif
#ifndef PH_MASK
#define PH_MASK 0xFFFFFFFFu
#endif
#ifndef REP_MASK
#define REP_MASK 0u
#endif
#ifndef REP_CNT
#define REP_CNT 2
#endif
#define REPN(kk) ((((unsigned)REP_MASK >> (kk)) & 1u) ? REP_CNT : 1)
#define INK(k, kk) (((PH_MASK >> (kk)) & 1u) && lo <= (k) && (k) < hi)
#if defined(TIME_PROBE)
#define STAMP(i) do { if (F.bid == 0 && F.tid == 0) ((unsigned long long*)(F.ctl + CW_TS))[i] = __builtin_amdgcn_s_memrealtime(); } while (0)
#else
#define STAMP(i) do { } while (0)
#endif
#if defined(BAR_TWICE)
#define SEAM_TWICE(x) x
#else
#define SEAM_TWICE(x)
#endif
#define SEAM(k) do { if (lo <= (k) && (k) + 1 < hi) { XcdBarrier b_ = bar; { unsigned long long p_ = (unsigned long long)bar.bar; asm volatile("" : "+s"(p_)); b_.bar = (unsigned*)p_; } xcd_barrier(b_); SEAM_TWICE(xcd_barrier(b_);) } STAMP((k) + 1); } while (0)
template <int LAYER> DI void g1_block(const Frame& F, const Args& args) {
    constexpr int layer = LAYER;
    bf16* hb = (bf16*)(F.ws + WS_HB); bf16* projb = (bf16*)(F.ws + WS_PROJ); bf16* eb = (bf16*)(F.ws + WS_EB);
#ifndef NO_G1
            { const Frame Fp = phase_frame(F);  pg8::Gemm g{hb, (const bf16*)lw_ptr(Fp, layer, LW_IN), M, LDP, DM}; pg8::StaticOrder S; S.init(M, LDP, Fp.G, Fp.bid);
              pg8::EpiB<2> E{projb, LDP, (const float*)(Fp.ws + WS_ROPE), (bf16*)(Fp.ws + WS_KV)};
              pg8::gemm_phase<pg8::EpiB<2>, pg8::StaticOrder, PG8_ALIGN, PG8_SP2>(Fp.lds, g, S, E, Fp.wave); }
#endif
#ifndef NO_G5
            { const Frame Fp = phase_frame(F);  pg8::Gemm g{(const bf16*)(Fp.ws + WS_PB) + (size_t)layer * M * PLE, (const bf16*)lw_ptr(Fp, layer, LW_PLE), M, DM, PLE}; pg8::LightOrder S; S.init(M, DM, Fp.G, Fp.bid);
              pg8::EpiB<0> E{eb, DM, nullptr, nullptr};
              pg8::gemm_phase<pg8::EpiB<0>, pg8::LightOrder, PG8_ALIGN, PG8_SP2>(Fp.lds, g, S, E, Fp.wave); }
#endif
}
template <int LAYER> DI void layer_phases(const Frame& F, const Args& args, const XcdBarrier& bar, const int lo, const int hi) {
    constexpr int layer = LAYER, layer_ = LAYER;
    float* xres = (float*)(F.ws + WS_X); bf16* hb = (bf16*)(F.ws + WS_HB); bf16* projb = (bf16*)(F.ws + WS_PROJ); bf16* ub = (bf16*)(F.ws + WS_U); bf16* eb = (bf16*)(F.ws + WS_EB);
        const int pb = 1 + NPH_LAYER * layer;
        const float* xin = (layer == 0) ? (const float*)argin(args, 0) : (const float*)xres;
        if (INK(pb + 0, 0)) { if (layer == 0) norm_rows<false>(F, xin, (const float*)argin(args, 3), hb);
                              else addnorm_rows<false>(F, xres, (const bf16*)(F.ws + WS_DELTA), (const float*)argin(args, 3) + (size_t)layer * DM, xres, hb); }
        SEAM(pb + 0);
        if (INK(pb + 1, 1)) { g1_block<LAYER>(F, args); if (REPN(1) >= 2) g1_block<LAYER>(F, args); }
        SEAM(pb + 1);
        if (INK(pb + 2, 2)) for (int rep = 0; rep < REPN(2); ++rep) { ssd_conv_pass(F, args, layer); compress_phase(F, args, layer); }
        SEAM(pb + 2);
        if (INK(pb + 3, 3)) for (int rep = 0; rep < REPN(3); ++rep) ssd_states_phase(F, args, layer);
        SEAM(pb + 3);
        if (INK(pb + 4, 4)) for (int rep = 0; rep < REPN(4); ++rep) ssd_scan_phase(F);
        SEAM(pb + 4);
        if (INK(pb + 5, 5)) {
#ifndef NO_S3
            for (int rep = 0; rep < REPN(15); ++rep) ssd_out_phase(F, args, layer);
#endif
            STAMP(60 + layer);
#ifndef NO_NSA
            for (int rep = 0; rep < REPN(5); ++rep) nsa_phase(F, args, layer);
#endif
        }
        SEAM(pb + 5);
        if (INK(pb + 6, 6)) for (int rep = 0; rep < REPN(6); ++rep) merge_pass(F, args, layer);
        SEAM(pb + 6);
        if (INK(pb + 7, 7)) for (int rep = 0; rep < REPN(7); ++rep) { const Frame Fp = phase_frame(F);  pg8::Gemm g{hb, (const bf16*)lw_ptr(Fp, layer, LW_O), M, DM, DM}; pg8::StaticOrder S; S.init(M, DM, Fp.G, Fp.bid);
            pg8::EpiB<0> E{(bf16*)(Fp.ws + WS_DELTA), DM, nullptr, nullptr};
            pg8::gemm_phase<pg8::EpiB<0>, pg8::StaticOrder, PG8_ALIGN, PG8_SP2>(Fp.lds, g, S, E, Fp.wave); }
        SEAM(pb + 7);
        if (INK(pb + 8, 8)) for (int rep = 0; rep < REPN(8); ++rep) addnorm_rows<false>(F, xin, (const bf16*)(F.ws + WS_DELTA), (const float*)argin(args, 23) + (size_t)layer * DM, rep ? (float*)(F.ws + WS_ST) : xres, rep ? (bf16*)(F.ws + WS_ST + 128 * MiB - 64 * MiB) : hb);
        SEAM(pb + 8);
        if (INK(pb + 9, 9)) for (int rep = 0; rep < REPN(9); ++rep) { const Frame Fp = phase_frame(F);  pg8::Gemm g{hb, (const bf16*)lw_ptr(Fp, layer, LW_UP), M, DFF, DM}; pg8::StaticOrder S; S.init(M, DFF, Fp.G, Fp.bid);
            pg8::EpiB<1> E{ub, DFF, nullptr, nullptr};
            pg8::gemm_phase<pg8::EpiB<1>, pg8::StaticOrder, PG8_ALIGN, PG8_SP2>(Fp.lds, g, S, E, Fp.wave); }
        SEAM(pb + 9);
        if (INK(pb + 10, 10)) for (int rep = 0; rep < REPN(10); ++rep) { const Frame Fp = phase_frame(F);  pg8::Gemm g{ub, (const bf16*)lw_ptr(Fp, layer, LW_DOWN), M, DM, DFF}; pg8::StaticOrder S; S.init(M, DM, Fp.G, Fp.bid);
            pg8::EpiB<0> E{(bf16*)(Fp.ws + WS_DELTA), DM, nullptr, nullptr};
            pg8::gemm_phase<pg8::EpiB<0>, pg8::StaticOrder, PG8_ALIGN, PG8_SP2>(Fp.lds, g, S, E, Fp.wave); }
        SEAM(pb + 10);
        if (INK(pb + 11, 11)) addnorm_rows<false>(F, xres, (const bf16*)(F.ws + WS_DELTA), (const float*)argin(args, 26) + (size_t)layer * DM, xres, hb);
        SEAM(pb + 11);
        if (INK(pb + 12, 12)) for (int rep = 0; rep < REPN(12); ++rep) { const Frame Fp = phase_frame(F);  pg8::Gemm g{hb, (const bf16*)lw_ptr(Fp, layer, LW_PG), M, DM, DM}; pg8::StaticOrder S; S.init(M, DM, Fp.G, Fp.bid);
            pg8::EpiB<3> E{(bf16*)(Fp.ws + WS_DELTA), DM, (const float*)eb, nullptr};
            pg8::gemm_phase<pg8::EpiB<3>, pg8::StaticOrder, PG8_ALIGN, PG8_SP2>(Fp.lds, g, S, E, Fp.wave); }
        SEAM(pb + 12);
}
__global__ void __launch_bounds__(NTHR, 2) hyb_fwd(Args args) {
    extern __shared__ __attribute__((aligned(16))) unsigned char lds_raw[];
    Frame F;
    F.lds = (LAS unsigned char*)lds_raw; F.ws = args.ws; F.ctl = (gu32*)(args.ws + WS_CTL);
    F.tid = threadIdx.x; F.lane = F.tid & 63; F.wave = __builtin_amdgcn_readfirstlane(threadIdx.x >> 6); F.G = gridDim.x; F.bid = blockIdx.x;
    const int lo = args.ph_lo, hi = args.ph_hi;
    if (F.tid < 64) ((LAS unsigned*)(F.lds + LDSCTL_OFF))[F.tid] = 0u;
    __syncthreads();
    XcdBarrier bar; bar.bar = (unsigned*)(F.ctl + CW_BAR); bar.x = 0; bar.st = (volatile LAS unsigned*)(F.lds + LDSCTL_OFF);
    if (hi - lo > 1) bar = xcd_barrier_post((unsigned*)(F.ctl + CW_BAR), (volatile LAS unsigned*)(F.lds + LDSCTL_OFF));
    STAMP(0);
    if (INK(0, 13)) for (int rep = 0; rep < REPN(13); ++rep) p0_prologue(F, args);
    SEAM(0);
    layer_phases<0>(F, args, bar, lo, hi); layer_phases<1>(F, args, bar, lo, hi); layer_phases<2>(F, args, bar, lo, hi); layer_phases<3>(F, args, bar, lo, hi);
    float* xres = (float*)(F.ws + WS_X);
    int hi_l = hi; asm volatile("" : "+s"(hi_l));
    if (((PH_MASK >> 14) & 1u) && lo <= NPH - 1 && NPH - 1 < hi_l) addnorm_rows<true>(F, xres, (const bf16*)(F.ws + WS_DELTA), (const float*)argin(args, 29), nullptr, args.out);
#if defined(TIME_PROBE)
    { XcdBarrier b_ = bar; xcd_barrier(b_); STAMP(NPH);
      if (F.bid == 0) {
        LAS float* ab = (LAS float*)(F.lds);
        if (F.tid == 0) { const unsigned long long* ts = (const unsigned long long*)(F.ctl + CW_TS); float sum[17];
            float sA = 0.f, sB = 0.f;
            for (int ph = 0; ph < NPH; ++ph) { int kind = (ph == 0) ? 13 : (ph == NPH - 1) ? 14 : (ph - 1) % NPH_LAYER; float d = (float)(ts[ph + 1] - ts[ph]) * 0.01f;
                if (kind == 5) { const int L = (ph - 1) / NPH_LAYER; const float d3 = (float)(ts[60 + L] - ts[ph]) * 0.01f; if (TIME_PROBE_A == 15) sA += d3; if (TIME_PROBE_B == 15) sB += d3; d -= d3; }
                if (kind == TIME_PROBE_A || (TIME_PROBE_A == 16 && (kind == 0 || kind == 8 || kind == 11))) sA += d;
                if (kind == TIME_PROBE_B || (TIME_PROBE_B == 16 && (kind == 0 || kind == 8 || kind == 11))) sB += d; }
            ab[0] = sA; ab[1] = sB * 0.01f; (void)sum; }
        __syncthreads();
        const float A = ab[0], B = ab[1];
        if (F.tid == 0) args.out[0] += A;
        for (int j = 0; j < 2048; ++j) args.out[1 + F.tid + NTHR * j] += B;
      } }
#endif
#undef INK
#undef SEAM
}

#ifndef MK_ONE_LAUNCH
#define MK_ONE_LAUNCH 1
#endif
extern "C" void kernel_launch(void* const* d_in, const int* in_sizes, int n_in, void* d_out, int out_size, void* d_ws, size_t ws_size, hipStream_t stream) {
    static int grid = 0;
    if (grid == 0) {
        if (n_in != 30 || out_size != M * DM || ws_size < WS_END) { fprintf(stderr, "kernel_launch: unexpected shapes (n_in %d out %d ws %zu need %zu)\n", n_in, out_size, ws_size, (size_t)WS_END); grid = -1; return; }
        int dev = 0, cus = 0, per_cu = 0;
        if (hipGetDevice(&dev) != hipSuccess || hipDeviceGetAttribute(&cus, hipDeviceAttributeMultiprocessorCount, dev) != hipSuccess) { grid = -1; return; }
        if (hipFuncSetAttribute((const void*)hyb_fwd, hipFuncAttributeMaxDynamicSharedMemorySize, LDS_BYTES) != hipSuccess) { fprintf(stderr, "kernel_launch: hipFuncSetAttribute failed\n"); grid = -1; return; }
        if (hipOccupancyMaxActiveBlocksPerMultiprocessor(&per_cu, (const void*)hyb_fwd, NTHR, LDS_BYTES) != hipSuccess || per_cu < 1) { fprintf(stderr, "kernel_launch: occupancy query says %d\n", per_cu); }
        (void)hipGetLastError();
        grid = cus;
    }
    if (grid < 0) return;
    (void)hipMemsetAsync((char*)d_ws + WS_CTL, 0, CTL_ZERO_BYTES, stream);
    Args a{};
    for (int i = 0; i < 30; ++i) a.in[i] = d_in[i];
    a.out = (float*)d_out; a.ws = (unsigned char*)d_ws;
#if MK_ONE_LAUNCH
    a.ph_lo = 0; a.ph_hi = NPH;
    hipLaunchKernelGGL(hyb_fwd, dim3(grid), dim3(NTHR), LDS_BYTES, stream, a);
#else
    for (int ph = 0; ph < NPH; ++ph) { a.ph_lo = ph; a.ph_hi = ph + 1; hipLaunchKernelGGL(hyb_fwd, dim3(grid), dim3(NTHR), LDS_BYTES, stream, a);
#if defined(CHECK_BUILD) && CHECK_BUILD
        if (ph == 2) hipLaunchKernelGGL(chk_proj, dim3(1024), dim3(256), 0, stream, a);
        if (ph == 3) hipLaunchKernelGGL(chk_cmp, dim3(128), dim3(128), 0, stream, a);
        if (ph == 6) hipLaunchKernelGGL(chk_nsa, dim3(8 * CHK_NT), dim3(256), 0, stream, a);
        if (ph == NPH - 1) hipLaunchKernelGGL(chk_report, dim3(4098), dim3(256), 0, stream, a);
#endif
    }
#endif
    (void)in_sizes;
}
```

```cpp
#include <hip/hip_runtime.h>
#include <cstdio>
#include <cstdint>
#if !defined(NO_S3_PREFETCH)
#define S3_PREFETCH 1
#endif
#if !defined(ST_F32)
#define ST_BF16 1
#endif
#if !defined(NO_STREAM_PF)
#define MERGE_PF 1
#define CONV_PF 1
#define CMP_PF 1
#define S2_PF 1
#define ADDNORM_PF 1
#endif
namespace pg8 {
#define PG8_LAS __attribute__((address_space(3)))
typedef unsigned short bf16_t;
typedef short bf16x8 __attribute__((ext_vector_type(8)));
typedef float f32x4 __attribute__((ext_vector_type(4)));
typedef unsigned u32x4 __attribute__((ext_vector_type(4)));
constexpr int BM = 256, BK = 64, HALF = 128, HTB = HALF * BK * 2  , STAGE_BYTES = 8 * HTB, NXCD = 8,
#ifdef PG8_WGM
    WGM = PG8_WGM;
#else
    WGM = 8;
#endif

__host__ __device__ __forceinline__ int lds_byte(int r, int c) { const int st = (r >> 4) * 2 + (c >> 5), rr = r & 15, cc = c & 31, ob = rr * 64 + cc * 2; return st * 1024 + (ob ^ (((ob >> 9) & 1) << 5)); }
__host__ __device__ __forceinline__ void stage_rc(int b, int& R, int& C) { const int st = b / 1024, sb = b % 1024, swz = sb ^ (((sb >> 9) & 1) << 5); R = (st >> 1) * 16 + swz / 64; C = (st & 1) * 32 + (swz % 64) / 2; }
__host__ __device__ __forceinline__ int perm32(int rho) { const int n = rho >> 4, i = rho & 15; return 8 * (i >> 2) + 4 * n + (i & 3); }

struct Unit { int pm, pn; };
struct Gemm { const bf16_t* A; const bf16_t* Bt; int M, N, K; };

struct StaticOrder {
    int nM, nN, nwg, G, c;
    __host__ __device__ void init(int M, int N, int G_, int c_) { nM = M / BM; nN = N / BM; nwg = nM * nN; G = G_; c = c_; }
    __host__ __device__ bool next(int i, Unit& u) const {
        const long L = (long)i * G + c; if (L >= nwg) return false;
        int wgid = (int)L; { const int q = nwg / NXCD, r = nwg % NXCD, xcd = wgid % NXCD, off = wgid / NXCD; wgid = (xcd < r ? xcd * (q + 1) : r * (q + 1) + (xcd - r) * q) + off; }
        const int nig = WGM * nN, gid = wgid / nig, fm = gid * WGM, gsz = (nM - fm) < WGM ? (nM - fm) : WGM;
        u.pm = fm + ((wgid % nig) % gsz); u.pn = (wgid % nig) / gsz; return true;
    }
    __device__ __forceinline__ void a_ready(const Unit&) const {}
    __device__ __forceinline__ void done(const Unit&) const {}
};
__device__ __forceinline__ unsigned cvt_pk_bf16(float lo, float hi) { unsigned r; asm volatile("v_cvt_pk_bf16_f32 %0, %1, %2" : "=v"(r) : "v"(lo), "v"(hi)); return r; }
template <class Epi, class Sched, bool ALIGN_EPI = false, bool SP2 = false>
__device__ __forceinline__ void gemm_phase(PG8_LAS unsigned char* lds, const Gemm g, const Sched& S, const Epi& E, const int wave_idx  ) {
    int lane_l; asm volatile("v_mbcnt_lo_u32_b32 %0, -1, 0\n\tv_mbcnt_hi_u32_b32 %0, -1, %0" : "=v"(lane_l));
    const int wid = wave_idx, tid = wid * 64 + lane_l, lane = tid & 63, wr = wid >> 2, wc = wid & 3, fr = lane & 15, fq = lane >> 4;
    const int K = g.K, nt = K / BK;
    unsigned voffA[2], voffB[2];
#pragma unroll
    for (int i = 0; i < 2; ++i) { int R, C; stage_rc(tid * 16 + i * 8192, R, C); const int Rb = Epi::PERM ? ((R & ~31) + perm32(R & 31)) : R;
        voffA[i] = (unsigned)(R * K + C) * 2u; voffB[i] = (unsigned)(Rb * K + C) * 2u; }
    const size_t kstep = (size_t)(BK * 2);
    const size_t hstep = (size_t)HALF * K * 2;
    const size_t tstep = 2 * hstep;
    const unsigned ldsw = (unsigned)wid * 1024u;
    const int aoff = lds_byte(wr * 64 + fr, fq * 8), boff = lds_byte(wc * 32 + fr, fq * 8);
#define PG8_SA(b, h) (((b) * 2 + (h)) * HTB)
#define PG8_SB(b, h) ((4 + (b) * 2 + (h)) * HTB)
#define PG8_STAGE(bufoff, gbase, voff) do { _Pragma("unroll") for (int _i = 0; _i < 2; ++_i) \
        __builtin_amdgcn_global_load_lds((const unsigned*)((const char*)(gbase) + (voff)[_i]), (PG8_LAS unsigned*)(lds + (bufoff) + ldsw + _i * 8192), 16, 0, 0); } while (0)
#define PG8_LDA(dst, b, h) do { _Pragma("unroll") for (int m = 0; m < 4; ++m) _Pragma("unroll") for (int k = 0; k < 2; ++k) dst[m][k] = *(const PG8_LAS bf16x8*)(lds + PG8_SA(b, h) + aoff + m * 2048 + k * 1024); } while (0)
#define PG8_LDB(dst, b, h) do { _Pragma("unroll") for (int n = 0; n < 2; ++n) _Pragma("unroll") for (int k = 0; k < 2; ++k) dst[n][k] = *(const PG8_LAS bf16x8*)(lds + PG8_SB(b, h) + boff + n * 2048 + k * 1024); } while (0)
#define PG8_MMA(ai, bj, At, Bt) do { __builtin_amdgcn_s_setprio(1); _Pragma("unroll") for (int m = 0; m < 4; ++m) _Pragma("unroll") for (int n = 0; n < 2; ++n) _Pragma("unroll") for (int k = 0; k < 2; ++k) \
        acc[ai][bj][m][n] = __builtin_amdgcn_mfma_f32_16x16x32_bf16(Bt[n][k], At[m][k], acc[ai][bj][m][n], 0, 0, 0); __builtin_amdgcn_s_setprio(0); } while (0)
#define PG8_WAIT_V(n) asm volatile("s_waitcnt vmcnt(" #n ")" ::: "memory")
#define PG8_WAIT_L(n) asm volatile("s_waitcnt lgkmcnt(" #n ")" ::: "memory")
#define PG8_BAR __builtin_amdgcn_s_barrier()
#define PG8_SCHED __builtin_amdgcn_sched_barrier(0)
    Unit cur, nxt; int ui = 0;
    if (!S.next(0, cur)) return;
    f32x4 acc[2][2][4][2];
#pragma unroll
    for (int a = 0; a < 2; ++a)
#pragma unroll
        for (int b = 0; b < 2; ++b)
#pragma unroll
            for (int m = 0; m < 4; ++m)
#pragma unroll
                for (int n = 0; n < 2; ++n) acc[a][b][m][n] = (f32x4){0.f, 0.f, 0.f, 0.f};
    bf16x8 At[4][2], B0[2][2], B1[2][2];
    const char* cA = (const char*)g.A + (size_t)cur.pm * tstep; const char* cB = (const char*)g.Bt + (size_t)cur.pn * tstep;
    S.a_ready(cur);
    if constexpr (SP2) {
        PG8_STAGE(PG8_SB(0, 0), cB, voffB); PG8_STAGE(PG8_SB(0, 1), cB + hstep, voffB); PG8_STAGE(PG8_SA(0, 0), cA, voffA); PG8_STAGE(PG8_SA(0, 1), cA + hstep, voffA);
        if (wr == 1) PG8_BAR;
        PG8_WAIT_V(2); PG8_BAR;
        PG8_STAGE(PG8_SB(1, 0), cB + kstep, voffB); PG8_STAGE(PG8_SA(1, 0), cA + kstep, voffA); PG8_STAGE(PG8_SB(1, 1), cB + hstep + kstep, voffB);
        PG8_WAIT_V(6); PG8_BAR;
    } else {
        PG8_STAGE(PG8_SB(0, 0), cB, voffB); PG8_STAGE(PG8_SA(0, 0), cA, voffA); PG8_STAGE(PG8_SB(0, 1), cB + hstep, voffB); PG8_STAGE(PG8_SA(0, 1), cA + hstep, voffA);
        if (wr == 1) PG8_BAR;
        PG8_WAIT_V(4); PG8_BAR;
        PG8_STAGE(PG8_SB(1, 0), cB + kstep, voffB); PG8_STAGE(PG8_SA(1, 0), cA + kstep, voffA); PG8_STAGE(PG8_SB(1, 1), cB + hstep + kstep, voffB);
        PG8_WAIT_V(6); PG8_BAR;
    }
    for (;;) {
        const bool has_next = S.next(ui + 1, nxt);
        const char* nA = has_next ? (const char*)g.A + (size_t)nxt.pm * tstep : cA; const char* nB = has_next ? (const char*)g.Bt + (size_t)nxt.pn * tstep : cB;
        for (int t = 0; t < nt; t += 2) {
            const bool last = (t == nt - 2);
            const char* a1 = cA + (size_t)(t + 1) * kstep;
            const char* a2 = last ? nA : cA + (size_t)(t + 2) * kstep; const char* b2 = last ? nB : cB + (size_t)(t + 2) * kstep;
            const char* a3 = a2 + kstep; const char* b3 = b2 + kstep;
            if (last && has_next) S.a_ready(nxt);
            if constexpr (SP2) {
            PG8_LDB(B0, 0, 0); PG8_LDB(B1, 0, 1); PG8_SCHED; PG8_LDA(At, 0, 0); PG8_STAGE(PG8_SA(1, 1), a1 + hstep, voffA);
            PG8_WAIT_V(8); PG8_WAIT_L(0); PG8_BAR; PG8_MMA(0, 0, At, B0); PG8_MMA(0, 1, At, B1); PG8_BAR; PG8_SCHED;
            PG8_LDA(At, 0, 1); PG8_STAGE(PG8_SB(0, 0), b2, voffB); PG8_STAGE(PG8_SB(0, 1), b2 + hstep, voffB); PG8_STAGE(PG8_SA(0, 0), a2, voffA);
            PG8_WAIT_V(8); PG8_WAIT_L(0); PG8_BAR; PG8_MMA(1, 0, At, B0); PG8_MMA(1, 1, At, B1); PG8_BAR; PG8_SCHED;
            PG8_LDB(B0, 1, 0); PG8_LDB(B1, 1, 1); PG8_SCHED; PG8_LDA(At, 1, 0); PG8_STAGE(PG8_SA(0, 1), a2 + hstep, voffA);
            PG8_WAIT_V(8); PG8_WAIT_L(0); PG8_BAR; PG8_MMA(0, 0, At, B0); PG8_MMA(0, 1, At, B1); PG8_BAR; PG8_SCHED;
            PG8_LDA(At, 1, 1); PG8_STAGE(PG8_SB(1, 0), b3, voffB); PG8_STAGE(PG8_SB(1, 1), b3 + hstep, voffB); PG8_STAGE(PG8_SA(1, 0), a3, voffA);
            PG8_WAIT_V(8); PG8_WAIT_L(0); PG8_BAR; PG8_MMA(1, 0, At, B0); PG8_MMA(1, 1, At, B1); PG8_BAR; PG8_SCHED;
            } else {
            PG8_LDB(B0, 0, 0); PG8_SCHED; PG8_LDA(At, 0, 0); PG8_STAGE(PG8_SA(1, 1), a1 + hstep, voffA);
            PG8_WAIT_L(8); PG8_BAR; PG8_WAIT_L(0); PG8_MMA(0, 0, At, B0); PG8_BAR; PG8_SCHED;
            PG8_LDB(B1, 0, 1); PG8_STAGE(PG8_SB(0, 0), b2, voffB);
            PG8_BAR; PG8_WAIT_L(0); PG8_MMA(0, 1, At, B1); PG8_BAR;
            PG8_LDA(At, 0, 1); PG8_STAGE(PG8_SA(0, 0), a2, voffA);
            PG8_BAR; PG8_WAIT_L(0); PG8_MMA(1, 0, At, B0); PG8_BAR; PG8_SCHED;
            PG8_STAGE(PG8_SB(0, 1), b2 + hstep, voffB);
            PG8_WAIT_V(6); PG8_BAR; PG8_MMA(1, 1, At, B1); PG8_BAR;
            PG8_LDB(B0, 1, 0); PG8_SCHED; PG8_LDA(At, 1, 0); PG8_STAGE(PG8_SA(0, 1), a2 + hstep, voffA);
            PG8_WAIT_L(8); PG8_BAR; PG8_WAIT_L(0); PG8_MMA(0, 0, At, B0); PG8_BAR; PG8_SCHED;
            PG8_LDB(B1, 1, 1); PG8_STAGE(PG8_SB(1, 0), b3, voffB);
            PG8_BAR; PG8_WAIT_L(0); PG8_MMA(0, 1, At, B1); PG8_BAR;
            PG8_LDA(At, 1, 1); PG8_STAGE(PG8_SA(1, 0), a3, voffA);
            PG8_BAR; PG8_WAIT_L(0); PG8_MMA(1, 0, At, B0); PG8_BAR; PG8_SCHED;
            PG8_STAGE(PG8_SB(1, 1), b3 + hstep, voffB);
            PG8_WAIT_V(6); PG8_BAR; PG8_MMA(1, 1, At, B1); PG8_BAR;
            }
        }
        if constexpr (ALIGN_EPI) { if (wr == 0) PG8_BAR; }
        if constexpr (!Epi::AFTER_DRAIN) { E(acc, cur, wr, wc, fr, fq);
#if defined(EPI_TWICE)
            if constexpr (Epi::PERM) E(acc, cur, wr, wc, fr, fq);
#endif
            S.done(cur); }
        if (!has_next) break;
#pragma unroll
        for (int a = 0; a < 2; ++a)
#pragma unroll
            for (int b = 0; b < 2; ++b)
#pragma unroll
                for (int m = 0; m < 4; ++m)
#pragma unroll
                    for (int n = 0; n < 2; ++n) acc[a][b][m][n] = (f32x4){0.f, 0.f, 0.f, 0.f};
        cur = nxt; cA = nA; cB = nB; ++ui;
        if constexpr (ALIGN_EPI) { if (wr == 1) PG8_BAR; }
    }
    PG8_WAIT_V(0);
    if constexpr (!ALIGN_EPI) { if (wr == 0) PG8_BAR; }
    PG8_BAR;
    if constexpr (Epi::AFTER_DRAIN) { E.fused(acc, cur, wr, wc, fr, fq, lds, wid, lane); S.done(cur); }
#undef PG8_SA
#undef PG8_SB
#undef PG8_STAGE
#undef PG8_LDA
#undef PG8_LDB
#undef PG8_MMA
#undef PG8_WAIT_V
#undef PG8_WAIT_L
#undef PG8_BAR
#undef PG8_SCHED
}
}

constexpr int BATCH = 2, SEQ = 8192, DM = 2048, DEPTH = 4;
constexpr int M = BATCH * SEQ;
constexpr int NH = 16, HD = 128, NG = 4, RH = 4;
constexpr int NCMP = 511, NCMP_PAD = 512, NSLC = 128, NSEL = 16, WIN = 512;
constexpr int SSD_H = 32, SSD_P = 64, SSD_N = 128, SSD_G = 4, SSD_CH = 128, SSD_NC = 64, SSD_XBC = 3072;
constexpr int DFF = 8192, PLE = 256;
constexpr float EPS = 1e-6f;
constexpr int PROJ_SRC = 22608;
constexpr int C_Q = 0, C_KC = 2048, C_VC = 2560, C_KS = 3072, C_VS = 3584, C_KW = 4096, C_VW = 4608;
constexpr int C_CB = 5120, C_CC = 7168, C_CU = 9216, C_Z = 11264, C_XBC = 13312, C_GM = 16384, C_GN = 22528, C_DT = 22592;
constexpr int LDP = 22784;
constexpr int S_GN = 5120, S_DT = 16432;

constexpr size_t MiB = 1u << 20;
constexpr size_t WS_CTL = 0, CTL_ZERO_BYTES = 1 * MiB;
constexpr size_t WS_ROPE = 1 * MiB;
constexpr size_t WS_MISC = 9 * MiB;
constexpr size_t WS_DT = 10 * MiB;
constexpr size_t WS_ACS = 12 * MiB;
constexpr size_t WS_CDEC = 14 * MiB;
constexpr size_t WS_KCMP = 15 * MiB;
constexpr size_t WS_VCMP = 16 * MiB;
constexpr size_t WS_X = 32 * MiB;
constexpr size_t WS_HB = 160 * MiB;
constexpr size_t WS_PB = 224 * MiB;
constexpr size_t WS_EB = 256 * MiB;
constexpr size_t WS_YA = 320 * MiB;
constexpr size_t WS_YC = 384 * MiB;
constexpr size_t WS_XBC = 448 * MiB;
#if !defined(PCH)
#define PCH 8
#endif
constexpr size_t WS_ST = 544 * MiB;
constexpr size_t WS_PROJ = 672 * MiB;
constexpr size_t WS_U = WS_PROJ;
constexpr size_t WS_W = 1384 * MiB;
constexpr size_t LW_IN = 0;
constexpr size_t LW_O = 89 * MiB;
constexpr size_t LW_UP = 97 * MiB;
constexpr size_t LW_DOWN = 129 * MiB;
constexpr size_t LW_PG = 161 * MiB;
constexpr size_t LW_PLE = 169 * MiB;
constexpr size_t LW_PK1 = 170 * MiB;
constexpr size_t LW_PV1 = 171 * MiB;
constexpr size_t LW_PK2 = 172 * MiB;
constexpr size_t LW_PV2 = 172 * MiB + 64 * 1024;
constexpr size_t LW_STRIDE = 173 * MiB;
constexpr size_t WS_HIN = WS_W + 4 * LW_STRIDE;
constexpr size_t WS_RSTD = WS_MISC + 512 * 1024;
constexpr size_t WS_DELTA = WS_HIN + 64 * MiB;
constexpr size_t WS_KV = WS_DELTA + 64 * MiB;
constexpr size_t WS_END = WS_KV + 96 * MiB;
static_assert((size_t)M * LDP * 2 <= 712 * MiB && (size_t)LDP * 2048 * 2 <= 89 * MiB, "ws map");

constexpr int CW_BAR = 4096;
constexpr int CW_CHK = 16384;
constexpr int CW_TS = 20480;

constexpr int RING_BYTES = 131072;
constexpr int LX_OFF = RING_BYTES;
constexpr int LX_BYTES = 8192;
constexpr int LDSCTL_OFF = LX_OFF + LX_BYTES;
constexpr int LDS_BYTES = LDSCTL_OFF + 256;
constexpr int NWAVES = 8, NTHR = 512;

#define DI __device__ __forceinline__
#define GAS __attribute__((address_space(1)))
#define LAS __attribute__((address_space(3)))
typedef unsigned short bf16;
typedef unsigned u32x4 __attribute__((ext_vector_type(4)));
typedef unsigned u32x2 __attribute__((ext_vector_type(2)));
typedef float f32x4 __attribute__((ext_vector_type(4)));
typedef float f32x2 __attribute__((ext_vector_type(2)));
typedef short bf16x8 __attribute__((ext_vector_type(8)));
typedef short s16x4 __attribute__((ext_vector_type(4)));
typedef GAS unsigned gu32;
#define RLX_AGENT __ATOMIC_RELAXED, __HIP_MEMORY_SCOPE_AGENT
#define LDS_WAIT() asm volatile("s_waitcnt lgkmcnt(0)" ::: "memory")
#define VM_WAIT() asm volatile("s_waitcnt vmcnt(0)" ::: "memory")
DI size_t kv_off(int kind, int b, int g, int t) { return ((((size_t)kind * BATCH + b) * NG + g) * SEQ + t) * HD; }
DI unsigned f2bf(float f) { unsigned u = __builtin_bit_cast(unsigned, f); return (u + 0x7fffu + ((u >> 16) & 1u)) >> 16; }
DI unsigned pk2(float lo, float hi) { unsigned r; asm("v_cvt_pk_bf16_f32 %0, %1, %2" : "=v"(r) : "v"(lo), "v"(hi)); return r; }
DI float bf2f(unsigned h) { return __builtin_bit_cast(float, h << 16); }
DI float bflo(unsigned w) { return __builtin_bit_cast(float, w << 16); }
DI float bfhi(unsigned w) { return __builtin_bit_cast(float, w & 0xffff0000u); }
DI float sigmoidf_(float x) { return 1.0f / (1.0f + __expf(-x)); }
DI float siluf_(float x) { return x / (1.0f + __expf(-x)); }
DI float shfl_idx(float v, int src) { return __builtin_bit_cast(float, __builtin_amdgcn_ds_bpermute(src << 2, __builtin_bit_cast(int, v))); }
DI unsigned shfl_idx_u(unsigned v, int src) { return (unsigned)__builtin_amdgcn_ds_bpermute(src << 2, (int)v); }
DI float shx(float v, int m, int lane) { return shfl_idx(v, lane ^ m); }
DI float xq_max(float x) {
    float a = x, b = x;
    asm("s_nop 1\n\tv_permlane32_swap_b32 %0, %1" : "+v"(a), "+v"(b)); x = fmaxf(a, b);
    a = x; b = x;
    asm("s_nop 1\n\tv_permlane16_swap_b32 %0, %1" : "+v"(a), "+v"(b)); return fmaxf(a, b);
}
DI float xq_sum(float x) {
    float a = x, b = x;
    asm("s_nop 1\n\tv_permlane32_swap_b32 %0, %1" : "+v"(a), "+v"(b)); x = a + b;
    a = x; b = x;
    asm("s_nop 1\n\tv_permlane16_swap_b32 %0, %1" : "+v"(a), "+v"(b)); return a + b;
}
DI float quad_sum(float v) {
    v += __builtin_bit_cast(float, __builtin_amdgcn_update_dpp(0, __builtin_bit_cast(int, v), 0xB1, 0xF, 0xF, true));
    v += __builtin_bit_cast(float, __builtin_amdgcn_update_dpp(0, __builtin_bit_cast(int, v), 0x4E, 0xF, 0xF, true));
    return v;
}
DI float wave_sum(float v, int lane) {
#pragma unroll
    for (int o = 1; o < 64; o <<= 1) v += shx(v, o, lane);
    return v;
}
DI unsigned off_b(unsigned row, unsigned ch) { return 256u * row + 16u * (ch ^ (((row & 3u) << 2) | ((row >> 2) & 3u))); }
DI unsigned tr_addr(unsigned lane, unsigned r0, unsigned c, unsigned t) {
    const unsigned g = lane >> 4, q = (lane & 15u) >> 2, p = lane & 3u;
    return off_b(r0 + 8u * g + 4u * t + q, 2u * c + (p >> 1)) + 8u * (p & 1u);
}
DI s16x4 tr_read(LAS const unsigned char* p) { return __builtin_amdgcn_ds_read_tr16_b64_v4i16((LAS s16x4*)p); }
DI bf16x8 tr_read8(LAS const unsigned char* base, unsigned lane, unsigned r0, unsigned c) {
    const s16x4 lo = tr_read(base + tr_addr(lane, r0, c, 0)), hi = tr_read(base + tr_addr(lane, r0, c, 1));
    return __builtin_shufflevector(lo, hi, 0, 1, 2, 3, 4, 5, 6, 7);
}
DI bf16x8 lds_rd8(LAS const unsigned char* p) { return *(const LAS bf16x8*)p; }
DI bf16x8 as_bf16x8(u32x4 v) { return __builtin_bit_cast(bf16x8, v); }
#define MFMA16(a, b, c) __builtin_amdgcn_mfma_f32_16x16x32_bf16((a), (b), (c), 0, 0, 0)

namespace pg8 {
struct LightOrder {
    int G, c, nunits, nN;
    __host__ __device__ void init(int M, int N, int G_, int c_) { G = G_; c = c_; nN = N / BM; nunits = (M / BM) * nN; }
    __host__ __device__ bool next(int i, Unit& u) const {
        int j;
        if (G == 256) { if (c < 64) return false; j = (c - 64) + 192 * i; } else j = c + G * i;
        if (j >= nunits) return false;
        u.pm = j / nN; u.pn = j % nN; return true;
    }
    __device__ __forceinline__ void a_ready(const Unit&) const {}
    __device__ __forceinline__ void done(const Unit&) const {}
};
template <int MODE> struct EpiB {
    static constexpr bool PERM = true, AFTER_DRAIN = false;
    bf16_t* O; int ldc; const float* rope;
    bf16_t* kv;
    __device__ __forceinline__ void operator()(const f32x4 (&acc)[2][2][4][2], const Unit& u, int wr, int wc, int fr, int fq) const {
        { int l; asm volatile("v_mbcnt_lo_u32_b32 %0, -1, 0\n\tv_mbcnt_hi_u32_b32 %0, -1, %0" : "=v"(l)); fr = l & 15; fq = l >> 4; }
        const int row0 = u.pm * BM + wr * 64 + fr;
        bool rp = false;
        if (MODE == 2) { const int pn = u.pn; rp = (pn < 10) || pn == 12 || pn == 13 || pn == 16 || pn == 17; }
        if (MODE == 2 && rp) {
            const int colb = u.pn * BM + 128 * (wc >> 1) + 32 * (wc & 1) + 8 * fq, jj0 = 32 * (wc & 1) + 8 * fq;
#if defined(EPI_ROPE_PF)
            f32x4 nx0, nx1, nx2, nx3;
            { const float* rpp = (const float*)((const char*)rope + (unsigned)(((unsigned)row0 * 64u + (unsigned)jj0) * 8u));
              nx0 = *(const f32x4*)(rpp); nx1 = *(const f32x4*)(rpp + 4); nx2 = *(const f32x4*)(rpp + 8); nx3 = *(const f32x4*)(rpp + 12); }
#endif
#pragma unroll
            for (int ai = 0; ai < 2; ++ai)
#pragma unroll
                for (int m = 0; m < 4; ++m) {
                    const int row = row0 + ai * HALF + m * 16;
#if defined(EPI_ROPE_PF)
                    const f32x4 cs0 = nx0, cs1 = nx1, cs2 = nx2, cs3 = nx3;
                    if (ai * 4 + m < 7) { const int rown = row0 + ((ai * 4 + m + 1) >> 2) * HALF + ((ai * 4 + m + 1) & 3) * 16;
                        const float* rpp = (const float*)((const char*)rope + (unsigned)(((unsigned)rown * 64u + (unsigned)jj0) * 8u));
                        nx0 = *(const f32x4*)(rpp); nx1 = *(const f32x4*)(rpp + 4); nx2 = *(const f32x4*)(rpp + 8); nx3 = *(const f32x4*)(rpp + 12); }
#else
                    const float* rpp = (const float*)((const char*)rope + (unsigned)(((unsigned)row * 64u + (unsigned)jj0) * 8u));
                    const f32x4 cs0 = *(const f32x4*)(rpp), cs1 = *(const f32x4*)(rpp + 4), cs2 = *(const f32x4*)(rpp + 8), cs3 = *(const f32x4*)(rpp + 12);
#endif
                    const f32x4 x1a = acc[ai][0][m][0], x1b = acc[ai][0][m][1], x2a = acc[ai][1][m][0], x2b = acc[ai][1][m][1];
                    float c[8] = {cs0[0], cs0[2], cs1[0], cs1[2], cs2[0], cs2[2], cs3[0], cs3[2]};
                    float s[8] = {cs0[1], cs0[3], cs1[1], cs1[3], cs2[1], cs2[3], cs3[1], cs3[3]};
                    float x1[8] = {x1a[0], x1a[1], x1a[2], x1a[3], x1b[0], x1b[1], x1b[2], x1b[3]};
                    float x2[8] = {x2a[0], x2a[1], x2a[2], x2a[3], x2b[0], x2b[1], x2b[2], x2b[3]};
                    float o1[8], o2[8];
#pragma unroll
                    for (int k = 0; k < 8; ++k) { o1[k] = x1[k] * c[k] - x2[k] * s[k]; o2[k] = x2[k] * c[k] + x1[k] * s[k]; }
                    u32x4 w1, w2;
                    w1.x = cvt_pk_bf16(o1[0], o1[1]); w1.y = cvt_pk_bf16(o1[2], o1[3]); w1.z = cvt_pk_bf16(o1[4], o1[5]); w1.w = cvt_pk_bf16(o1[6], o1[7]);
                    w2.x = cvt_pk_bf16(o2[0], o2[1]); w2.y = cvt_pk_bf16(o2[2], o2[3]); w2.z = cvt_pk_bf16(o2[4], o2[5]); w2.w = cvt_pk_bf16(o2[6], o2[7]);
                    bf16_t* rowp = (bf16_t*)((char*)O + (unsigned)(((unsigned)row * (unsigned)ldc + (unsigned)colb) * 2u));
                    if (u.pn >= 8) { const int kind = (u.pn - 8) >> 1, g = 2 * (u.pn & 1) + (wc >> 1);
                        rowp = kv + ((((size_t)kind * 2 + (row >> 13)) * 4 + g) * 8192 + (row & 8191)) * 128 + jj0; }
                    *(u32x4*)(rowp) = w1; *(u32x4*)(rowp + 64) = w2;
                    asm volatile("" ::: "memory");
                }
        } else {
            const int col0 = u.pn * BM + wc * 32 + 8 * fq;
#if defined(EPI_E_PF)
            u32x4 evp[2][4][2];
            if (MODE == 3) {
#pragma unroll
                for (int ai = 0; ai < 2; ++ai)
#pragma unroll
                    for (int m = 0; m < 4; ++m)
#pragma unroll
                        for (int bj = 0; bj < 2; ++bj)
                            evp[ai][m][bj] = *(const u32x4*)((const char*)rope + (unsigned)(((unsigned)(row0 + ai * HALF + m * 16) * (unsigned)ldc + (unsigned)col0 + (unsigned)(bj * HALF)) * 2u));
            }
#endif
#pragma unroll
            for (int ai = 0; ai < 2; ++ai)
#pragma unroll
                for (int m = 0; m < 4; ++m) { bf16_t* rowp = (bf16_t*)((char*)O + (unsigned)(((unsigned)(row0 + ai * HALF + m * 16) * (unsigned)ldc + (unsigned)col0) * 2u));
#pragma unroll
                    for (int bj = 0; bj < 2; ++bj) { f32x4 v0 = acc[ai][bj][m][0], v1 = acc[ai][bj][m][1];
                        if (MODE == 1) {
#pragma unroll
                            for (int k = 0; k < 4; ++k) { const float a = fmaxf(v0[k], 0.f), b = fmaxf(v1[k], 0.f); v0[k] = a * a; v1[k] = b * b; } }
#if defined(EPI_E_PF)
                        if (MODE == 3) { const u32x4 ev = evp[ai][m][bj];
#else
                        if (MODE == 3) { const u32x4 ev = *(const u32x4*)((const bf16_t*)rope + (rowp - O) + bj * HALF);
#endif
                            const float e[8] = {__builtin_bit_cast(float, ev.x << 16), __builtin_bit_cast(float, ev.x & 0xffff0000u), __builtin_bit_cast(float, ev.y << 16), __builtin_bit_cast(float, ev.y & 0xffff0000u),
                                                __builtin_bit_cast(float, ev.z << 16), __builtin_bit_cast(float, ev.z & 0xffff0000u), __builtin_bit_cast(float, ev.w << 16), __builtin_bit_cast(float, ev.w & 0xffff0000u)};
#pragma unroll
                            for (int k = 0; k < 4; ++k) { v0[k] = e[k] / (1.0f + __expf(-v0[k])); v1[k] = e[4 + k] / (1.0f + __expf(-v1[k])); } }
                        u32x4 w; w.x = cvt_pk_bf16(v0[0], v0[1]); w.y = cvt_pk_bf16(v0[2], v0[3]); w.z = cvt_pk_bf16(v1[0], v1[1]); w.w = cvt_pk_bf16(v1[2], v1[3]);
                        if (MODE == 2 && u.pn >= 8 && u.pn < 20) { const int kind = (u.pn - 8) >> 1, g = 2 * (u.pn & 1) + bj, row = row0 + ai * HALF + m * 16;
                            *(u32x4*)(kv + ((((size_t)kind * 2 + (row >> 13)) * 4 + g) * 8192 + (row & 8191)) * 128 + wc * 32 + 8 * fq) = w; }
                        else *(u32x4*)(rowp + bj * HALF) = w; } }
        }
    }
};
template <bool GATE> struct EpiRes {
    static constexpr bool PERM = false, AFTER_DRAIN = false;
    const float* xin; float* xout; int ldc; const bf16_t* e;
    __device__ __forceinline__ void operator()(const f32x4 (&acc)[2][2][4][2], const Unit& u, int wr, int wc, int fr, int fq) const {
        { int l; asm volatile("v_mbcnt_lo_u32_b32 %0, -1, 0\n\tv_mbcnt_hi_u32_b32 %0, -1, %0" : "=v"(l)); fr = l & 15; fq = l >> 4; }
        const int row0 = u.pm * BM + wr * 64 + fr, col0 = u.pn * BM + wc * 32 + 4 * fq;
#pragma unroll
        for (int ai = 0; ai < 2; ++ai)
#pragma unroll
            for (int m = 0; m < 4; ++m) { const unsigned off = (unsigned)(row0 + ai * HALF + m * 16) * (unsigned)ldc + (unsigned)col0;
#pragma unroll
                for (int bj = 0; bj < 2; ++bj)
#pragma unroll
                    for (int n = 0; n < 2; ++n) { const unsigned o = off + bj * HALF + n * 16; const f32x4 xv = *(const f32x4*)((const char*)xin + (unsigned)(o * 4u)); f32x4 a = acc[ai][bj][m][n];
                        if (GATE) { typedef unsigned u32x2v __attribute__((ext_vector_type(2))); const u32x2v ev = *(const u32x2v*)((const char*)e + (unsigned)(o * 2u));
                            const float e0 = __builtin_bit_cast(float, ev.x << 16), e1 = __builtin_bit_cast(float, ev.x & 0xffff0000u), e2 = __builtin_bit_cast(float, ev.y << 16), e3 = __builtin_bit_cast(float, ev.y & 0xffff0000u);
                            a[0] = e0 / (1.0f + __expf(-a[0])); a[1] = e1 / (1.0f + __expf(-a[1])); a[2] = e2 / (1.0f + __expf(-a[2])); a[3] = e3 / (1.0f + __expf(-a[3])); }
                        *(f32x4*)((char*)xout + (unsigned)(o * 4u)) = xv + a; }
                asm volatile("" ::: "memory"); }
    }
};
}
#define XB_TMO      128
#define XB_XCNT(j)  (256  + 64 * (j))
#define XB_XSUB(j)  (1280 + 64 * (j))
#define XB_XGEN(j)  (2304 + 64 * (j))
#define XB_TOP      3328
#define XB_TOPGEN   3392
#define XCD_BAR_WORDS 3456
#define XB_SPIN_CAP (1u << 18)

__device__ __forceinline__ unsigned xb_ld(unsigned* p)              { return __hip_atomic_load(p, __ATOMIC_RELAXED, __HIP_MEMORY_SCOPE_AGENT); }
__device__ __forceinline__ unsigned xb_add(unsigned* p, unsigned v) { return __hip_atomic_fetch_add(p, v, __ATOMIC_RELAXED, __HIP_MEMORY_SCOPE_AGENT); }
__device__ __forceinline__ unsigned xb_xcc_id() { return (unsigned)__builtin_amdgcn_s_getreg((3 << 11) | 20) & 0xFu; }
#define XB_SPIN(cond, bar) do { unsigned _sp = 0; while (cond) { __builtin_amdgcn_s_sleep(1); \
    if ((++_sp & 255u) == 0u) { if (xb_ld(&(bar)[XB_TMO])) break; if (_sp > XB_SPIN_CAP) { atomicAdd(&(bar)[XB_TMO], 1u); break; } } } } while (0)

struct XcdBarrier {
    unsigned* bar; unsigned x;
    volatile LAS unsigned* st;
};

__device__ __forceinline__ XcdBarrier xcd_barrier_post(unsigned* bar, volatile LAS unsigned* st) {
    XcdBarrier b; b.bar = bar; b.x = xb_xcc_id(); b.st = st;
    if (threadIdx.x == 0) (void)xb_add(&bar[XB_XCNT(b.x)], 1u);
    return b;
}
__device__ __forceinline__ void xcd_barrier_complete(unsigned* bar, unsigned x, unsigned& nloc, unsigned& nx) {
    const unsigned G = gridDim.x * gridDim.y * gridDim.z;
    unsigned sum, cnt, mine, sp = 0u;
    for (;;) {
        sum = 0u; cnt = 0u; mine = 0u;
#pragma unroll
        for (unsigned j = 0; j < 16; ++j) { const unsigned c = xb_ld(&bar[XB_XCNT(j)]); sum += c; cnt += (c > 0u) ? 1u : 0u; mine = (j == x) ? c : mine; }
        if (sum == G) break;
        __builtin_amdgcn_s_sleep(1);
        if ((++sp & 255u) == 0u) { if (xb_ld(&bar[XB_TMO])) break; if (sp > XB_SPIN_CAP) { atomicAdd(&bar[XB_TMO], 1u); break; } }
    }
    nloc = mine > 0u ? mine : 1u; nx = cnt > 0u ? cnt : 1u;
}

__device__ __forceinline__ void xcd_barrier(const XcdBarrier& b) {
    asm volatile("s_waitcnt vmcnt(0)" ::: "memory");
    __syncthreads();
    if (threadIdx.x == 0) {
        unsigned* bar = b.bar;
        __builtin_amdgcn_s_waitcnt(0);
        unsigned nloc = b.st[0], nx = b.st[1];
        if (nloc == 0u) { xcd_barrier_complete(bar, b.x, nloc, nx); b.st[0] = nloc; b.st[1] = nx; }
        const unsigned old = xb_add(&bar[XB_XSUB(b.x)], 1u);
        const unsigned gen = old / nloc;
        if (old + 1u == (gen + 1u) * nloc) {
            __builtin_amdgcn_fence(__ATOMIC_RELEASE, "agent");
            asm volatile("s_waitcnt vmcnt(0)" ::: "memory");
            const unsigned og = xb_add(&bar[XB_TOP], 1u);
            const unsigned tg = og / nx;
            if (og + 1u == (tg + 1u) * nx) xb_add(&bar[XB_TOPGEN], 1u);
            else XB_SPIN(xb_ld(&bar[XB_TOPGEN]) == tg, bar);
            __builtin_amdgcn_fence(__ATOMIC_ACQUIRE, "agent");
            xb_add(&bar[XB_XGEN(b.x)], 1u);
            asm volatile("s_waitcnt vmcnt(0)" ::: "memory");
        } else {
            XB_SPIN(xb_ld(&bar[XB_XGEN(b.x)]) == gen, bar);
            __builtin_amdgcn_fence(__ATOMIC_ACQUIRE, "agent");
            asm volatile("s_waitcnt vmcnt(0)" ::: "memory");
        }
    }
    __syncthreads();
}

struct Args { const void* in[30]; float* out; unsigned char* ws; int ph_lo, ph_hi; };
struct Frame {
    LAS unsigned char* lds;
    gu32* ctl;
    unsigned char* ws;
    int tid, lane, wave, G, bid;
};
DI const void* argin(const Args&, int k) {
    typedef const void* const __attribute__((address_space(4)))* kptr_t;
    kptr_t p = (kptr_t)__builtin_amdgcn_kernarg_segment_ptr(); asm volatile("" : "+s"(p));
    return (const void*)p[k]; }
DI int launder_s(int x) { asm volatile("" : "+s"(x)); return x; }
DI Frame phase_frame(const Frame& F0) { Frame F = F0;
    int l; asm volatile("v_mbcnt_lo_u32_b32 %0, -1, 0\n\tv_mbcnt_hi_u32_b32 %0, -1, %0" : "=v"(l));
    F.wave = launder_s(F0.wave); F.bid = launder_s(F0.bid); F.G = launder_s(F0.G);
    F.lane = l; F.tid = F.wave * 64 + l;
    { unsigned long long wsb = (unsigned long long)F0.ws; asm volatile("" : "+s"(wsb)); F.ws = (unsigned char*)wsb; }
    { unsigned ll = (unsigned)(size_t)F0.lds; asm volatile("" : "+s"(ll)); F.lds = (LAS unsigned char*)(size_t)ll; }
    return F; }
DI unsigned char* lw_ptr(const Frame& F, int layer, size_t off) { return F.ws + WS_W + (size_t)layer * LW_STRIDE + off; }

template <bool FRAGMAJOR = false>
DI void transpose_item(const float* W, int K, int Nsrc, int nsrc0, bf16* WT, int dst_row0, int k0, LAS float* scr, int lane) {
#pragma unroll 8
    for (int i = 0; i < 32; ++i) { const int kk = 2 * i + (lane >> 5); scr[kk * 33 + (lane & 31)] = W[(size_t)(k0 + kk) * Nsrc + nsrc0 + (lane & 31)]; }
    LDS_WAIT(); asm volatile("" ::: "memory");
    const int c = lane & 7;
#pragma unroll
    for (int j = 0; j < 4; ++j) { const int n = (lane >> 3) + 8 * j; const LAS float* s = scr + (8 * c) * 33 + n;
        u32x4 o; o.x = pk2(s[0 * 33], s[1 * 33]); o.y = pk2(s[2 * 33], s[3 * 33]); o.z = pk2(s[4 * 33], s[5 * 33]); o.w = pk2(s[6 * 33], s[7 * 33]);
        if (FRAGMAJOR) { const int hid = dst_row0 + n, kk = k0 + 8 * c;
            *(u32x4*)(WT + ((size_t)((hid >> 4) * (K >> 5) + (kk >> 5)) * 64 + (((kk >> 3) & 3) * 16 + (hid & 15))) * 8) = o; }
        else *(u32x4*)(WT + (size_t)(dst_row0 + n) * K + k0 + 8 * c) = o; }
    LDS_WAIT(); asm volatile("" ::: "memory");
}
DI int proj_src_col(int d) {
    if (d < 5120) {
        const int pn = d >> 8; const bool rp = (pn < 10) || pn == 12 || pn == 13 || pn == 16 || pn == 17;
        if (!rp) return d;
        const int c = d & 255, bj = c >> 7, wc = (c >> 5) & 3;
        return (pn << 8) + 128 * (wc >> 1) + 64 * bj + 32 * (wc & 1);
    }
    if (d < 16384) return d + 48;
    if (d < 22528) return d + 80;
    if (d < 22592) return S_GN + (d - 22528);
    if (d < 22624) return S_DT + (d - 22592);
    return 0;
}
constexpr int TI_IN = 32 * 712, TI_O = 32 * 64, TI_UP = 32 * 256, TI_DOWN = 128 * 64, TI_PG = 32 * 64, TI_PLE = 4 * 64, TI_P1 = 64 * 4, TI_P2 = 2 * 4;
constexpr int TI_LAYER = TI_IN + TI_O + TI_UP + TI_DOWN + TI_PG + TI_PLE + 2 * TI_P1 + 2 * TI_P2;

struct TItem { const float* src; bf16* WT; int Nsrc, K, drow, k0, frag; };
DI void ti_decode(const Frame& F, const Args& A, int it, TItem& t) {
    const int layer = it / TI_LAYER; int r = it - layer * TI_LAYER; int ai, lw, K, Nsrc, nbn, frag = 0; size_t lstride;
    if (r < TI_IN) { ai = 4; lw = LW_IN; K = DM; Nsrc = PROJ_SRC; nbn = 712; lstride = (size_t)DM * PROJ_SRC; }
    else if ((r -= TI_IN) < TI_O) { ai = 22; lw = LW_O; K = DM; Nsrc = DM; nbn = 64; lstride = (size_t)DM * DM; }
    else if ((r -= TI_O) < TI_UP) { ai = 24; lw = LW_UP; K = DM; Nsrc = DFF; nbn = 256; lstride = (size_t)DM * DFF; }
    else if ((r -= TI_UP) < TI_DOWN) { ai = 25; lw = LW_DOWN; K = DFF; Nsrc = DM; nbn = 64; lstride = (size_t)DFF * DM; }
    else if ((r -= TI_DOWN) < TI_PG) { ai = 28; lw = LW_PG; K = DM; Nsrc = DM; nbn = 64; lstride = (size_t)DM * DM; }
    else if ((r -= TI_PG) < TI_PLE) { ai = 27; lw = LW_PLE; K = PLE; Nsrc = DM; nbn = 64; lstride = (size_t)PLE * DM; }
    else if ((r -= TI_PLE) < TI_P1) { ai = 7; lw = LW_PK1; K = 4096; Nsrc = 128; nbn = 4; lstride = (size_t)4096 * 128; frag = 1; }
    else if ((r -= TI_P1) < TI_P1) { ai = 11; lw = LW_PV1; K = 4096; Nsrc = 128; nbn = 4; lstride = (size_t)4096 * 128; frag = 1; }
    else if ((r -= TI_P1) < TI_P2) { ai = 9; lw = LW_PK2; K = 128; Nsrc = 128; nbn = 4; lstride = (size_t)128 * 128; }
    else { r -= TI_P2; ai = 13; lw = LW_PV2; K = 128; Nsrc = 128; nbn = 4; lstride = (size_t)128 * 128; }
    int kb = r / nbn, nb = r - kb * nbn;
#if defined(TI_BLK)
    if (K >= 256) {
        const int r8 = r & 7, rq = r >> 3, hn = nbn >> 1, skb = rq / hn, snb = rq - skb * hn; nb = 2 * snb + (r8 & 1); kb = 4 * skb + (r8 >> 1); }
#endif
    const int scol = (ai == 4) ? proj_src_col(nb * 32) : nb * 32;
    t.src = (const float*)argin(A, ai) + (size_t)layer * lstride + (size_t)(kb * 64) * Nsrc + scol;
    t.WT = (bf16*)lw_ptr(F, layer, lw); t.Nsrc = Nsrc; t.K = K; t.drow = nb * 32; t.k0 = kb * 64; t.frag = frag;
}
DI void ti_load(const TItem& t, int lane, float (&v)[32]) {
#pragma unroll
    for (int i = 0; i < 32; ++i) { const int kk = 2 * i + (lane >> 5); v[i] = t.src[(size_t)kk * t.Nsrc + (lane & 31)]; }
}
DI void ti_store(const TItem& t, const float (&v)[32], LAS float* scr, int lane) {
#pragma unroll
    for (int i = 0; i < 32; ++i) { const int kk = 2 * i + (lane >> 5); scr[kk * 33 + (lane & 31)] = v[i]; }
    LDS_WAIT(); asm volatile("" ::: "memory");
    const int c = lane & 7;
#pragma unroll
    for (int j = 0; j < 4; ++j) { const int n = (lane >> 3) + 8 * j; const LAS float* s = scr + (8 * c) * 33 + n;
        u32x4 o; o.x = pk2(s[0 * 33], s[1 * 33]); o.y = pk2(s[2 * 33], s[3 * 33]); o.z = pk2(s[4 * 33], s[5 * 33]); o.w = pk2(s[6 * 33], s[7 * 33]);
        if (t.frag) { const int hid = t.drow + n, kk = t.k0 + 8 * c;
            *(u32x4*)(t.WT + ((size_t)((hid >> 4) * (t.K >> 5) + (kk >> 5)) * 64 + (((kk >> 3) & 3) * 16 + (hid & 15))) * 8) = o; }
        else *(u32x4*)(t.WT + (size_t)(t.drow + n) * t.K + t.k0 + 8 * c) = o; }
    LDS_WAIT(); asm volatile("" ::: "memory");
}
DI void p0_prologue(const Frame& F0, const Args& A) {
    const Frame F = phase_frame(F0);
    LAS float* scr = (LAS float*)(F.lds + F.wave * 16384);
    const int gw = F.bid * NWAVES + F.wave, NGW = F.G * NWAVES;
#if defined(TI_PIPE)
    { int it = gw; TItem d0, d1; float va[32], vb[32];
      if (it < DEPTH * TI_LAYER) { ti_decode(F, A, it, d0); ti_load(d0, F.lane, va); }
      while (it < DEPTH * TI_LAYER) {
          const int itn = it + NGW; const bool more = itn < DEPTH * TI_LAYER;
#if TI_PIPE == 2
          ti_store(d0, va, scr, F.lane);
          if (more) { ti_decode(F, A, itn, d1); ti_load(d1, F.lane, vb); }
#else
          if (more) { ti_decode(F, A, itn, d1); ti_load(d1, F.lane, vb); }
          ti_store(d0, va, scr, F.lane);
#endif
          if (more) { d0 = d1;
#pragma unroll
              for (int q = 0; q < 32; ++q) va[q] = vb[q]; }
          it = itn; } }
#else
    for (int it = gw; it < DEPTH * TI_LAYER; it += NGW) {
        const int layer = it / TI_LAYER; int r = it - layer * TI_LAYER;
        if (r < TI_IN) { const int kb = r / 712, nb = r - kb * 712;
            transpose_item((const float*)argin(A, 4) + (size_t)layer * DM * PROJ_SRC, DM, PROJ_SRC, proj_src_col(nb * 32), (bf16*)lw_ptr(F, layer, LW_IN), nb * 32, kb * 64, scr, F.lane); continue; } r -= TI_IN;
        if (r < TI_O) { const int kb = r / 64, nb = r % 64;
            transpose_item((const float*)argin(A, 22) + (size_t)layer * DM * DM, DM, DM, nb * 32, (bf16*)lw_ptr(F, layer, LW_O), nb * 32, kb * 64, scr, F.lane); continue; } r -= TI_O;
        if (r < TI_UP) { const int kb = r / 256, nb = r % 256;
            transpose_item((const float*)argin(A, 24) + (size_t)layer * DM * DFF, DM, DFF, nb * 32, (bf16*)lw_ptr(F, layer, LW_UP), nb * 32, kb * 64, scr, F.lane); continue; } r -= TI_UP;
        if (r < TI_DOWN) { const int kb = r / 64, nb = r % 64;
            transpose_item((const float*)argin(A, 25) + (size_t)layer * DFF * DM, DFF, DM, nb * 32, (bf16*)lw_ptr(F, layer, LW_DOWN), nb * 32, kb * 64, scr, F.lane); continue; } r -= TI_DOWN;
        if (r < TI_PG) { const int kb = r / 64, nb = r % 64;
            transpose_item((const float*)argin(A, 28) + (size_t)layer * DM * DM, DM, DM, nb * 32, (bf16*)lw_ptr(F, layer, LW_PG), nb * 32, kb * 64, scr, F.lane); continue; } r -= TI_PG;
        if (r < TI_PLE) { const int kb = r / 64, nb = r % 64;
            transpose_item((const float*)argin(A, 27) + (size_t)layer * PLE * DM, PLE, DM, nb * 32, (bf16*)lw_ptr(F, layer, LW_PLE), nb * 32, kb * 64, scr, F.lane); continue; } r -= TI_PLE;
        if (r < TI_P1) { const int kb = r / 4, nb = r % 4;
            transpose_item<true>((const float*)argin(A, 7) + (size_t)layer * 4096 * 128, 4096, 128, nb * 32, (bf16*)lw_ptr(F, layer, LW_PK1), nb * 32, kb * 64, scr, F.lane); continue; } r -= TI_P1;
        if (r < TI_P1) { const int kb = r / 4, nb = r % 4;
            transpose_item<true>((const float*)argin(A, 11) + (size_t)layer * 4096 * 128, 4096, 128, nb * 32, (bf16*)lw_ptr(F, layer, LW_PV1), nb * 32, kb * 64, scr, F.lane); continue; } r -= TI_P1;
        if (r < TI_P2) { const int kb = r / 4, nb = r % 4;
            transpose_item((const float*)argin(A, 9) + (size_t)layer * 128 * 128, 128, 128, nb * 32, (bf16*)lw_ptr(F, layer, LW_PK2), nb * 32, kb * 64, scr, F.lane); continue; } r -= TI_P2;
        { const int kb = r / 4, nb = r % 4;
            transpose_item((const float*)argin(A, 13) + (size_t)layer * 128 * 128, 128, 128, nb * 32, (bf16*)lw_ptr(F, layer, LW_PV2), nb * 32, kb * 64, scr, F.lane); }
    }
#endif
    const size_t gt = (size_t)F.bid * NTHR + F.tid, NGT = (size_t)F.G * NTHR;
    { const float* p = (const float*)argin(A, 1); bf16* pb = (bf16*)(F.ws + WS_PB);
      for (size_t i = gt; i < (size_t)DEPTH * M * PLE / 8; i += NGT) { const f32x4 a = *(const f32x4*)(p + i * 8), b = *(const f32x4*)(p + i * 8 + 4);
          u32x4 o; o.x = pk2(a[0], a[1]); o.y = pk2(a[2], a[3]); o.z = pk2(b[0], b[1]); o.w = pk2(b[2], b[3]); *(u32x4*)(pb + i * 8) = o; } }
    { const int* pos = (const int*)argin(A, 2); float* rope = (float*)(F.ws + WS_ROPE);
      for (size_t i = gt; i < (size_t)M * 64; i += NGT) { const int row = (int)(i >> 6), jj = (int)(i & 63);
          const float inv = 1.0f / powf(10000.0f, (float)(2 * jj) * (1.0f / 128.0f));
          const float ang = (float)pos[row] * inv;
          double a = (double)ang; a -= 6.283185307179586476925 * __builtin_rint(a * 0.15915494309189533577);
          const float ar = (float)a;
          rope[i * 2] = cosf(ar); rope[i * 2 + 1] = sinf(ar); } }
    { float* part = (float*)(F.ws + WS_MISC);
      for (size_t i = gt; i < (size_t)DEPTH * 2 * PCH * 128; i += NGT) { const int hid = (int)(i & 127), c = (int)(i >> 7) % PCH, kv = (int)((i >> 7) / PCH) & 1, layer = (int)((i >> 7) / (2 * PCH));
          const float* pe = (const float*)(kv ? A.in[6] : A.in[5]) + (size_t)layer * 4096 + c * (4096 / PCH);
          const float* w1 = (const float*)(kv ? A.in[11] : A.in[7]) + (size_t)layer * 4096 * 128 + (size_t)c * (4096 / PCH) * 128 + hid;
          float s = 0.f;
#pragma unroll 8
          for (int kk = 0; kk < 4096 / PCH; ++kk) s += pe[kk] * w1[(size_t)kk * 128];
          part[i] = s; } }
}

template <bool OUTF32> DI void norm_rows(const Frame& F0, const float* x, const float* g, void* outp) {
    const Frame F = phase_frame(F0);
    const int gw = F.bid * NWAVES + F.wave, NGW = F.G * NWAVES;
    for (int m = gw; m < M; m += NGW) {
        const f32x4* xr = (const f32x4*)(x + (size_t)m * DM) + F.lane;
        f32x4 v[8]; float s = 0.f;
#pragma unroll
        for (int j = 0; j < 8; ++j) { v[j] = xr[64 * j]; s += (v[j][0] * v[j][0] + v[j][1] * v[j][1]) + (v[j][2] * v[j][2] + v[j][3] * v[j][3]); }
        const float rstd = 1.0f / sqrtf(wave_sum(s, F.lane) * (1.0f / DM) + EPS);
#pragma unroll
        for (int j = 0; j < 8; ++j) { const f32x4 gv = ((const f32x4*)g)[F.lane + 64 * j]; const f32x4 o = v[j] * rstd * gv;
            if (OUTF32) ((f32x4*)((float*)outp + (size_t)m * DM))[F.lane + 64 * j] = o;
            else { u32x2 w; w.x = pk2(o[0], o[1]); w.y = pk2(o[2], o[3]); ((u32x2*)((bf16*)outp + (size_t)m * DM))[F.lane + 64 * j] = w; } }
    }
}
template <bool OUTF32> DI void addnorm_rows(const Frame& F0, const float* xin, const bf16* delta, const float* g, float* xout, void* outp) {
    const Frame F = phase_frame(F0);
    const int gw = F.bid * NWAVES + F.wave, NGW = F.G * NWAVES;
#if defined(ADDNORM_PF)
    {
        f32x4 gv[8];
#pragma unroll
        for (int j = 0; j < 8; ++j) gv[j] = ((const f32x4*)g)[F.lane + 64 * j];
        f32x4 v[8], nv[8]; u32x2 d[8], nd[8];
        int m = gw;
        if (m < M) {
#pragma unroll
            for (int j = 0; j < 8; ++j) { v[j] = ((const f32x4*)(xin + (size_t)m * DM))[F.lane + 64 * j]; d[j] = ((const u32x2*)(delta + (size_t)m * DM))[F.lane + 64 * j]; } }
        while (m < M) {
            const int mn = m + NGW;
            if (mn < M) {
#pragma unroll
                for (int j = 0; j < 8; ++j) { nv[j] = ((const f32x4*)(xin + (size_t)mn * DM))[F.lane + 64 * j]; nd[j] = ((const u32x2*)(delta + (size_t)mn * DM))[F.lane + 64 * j]; } }
            float s = 0.f;
#pragma unroll
            for (int j = 0; j < 8; ++j) { v[j][0] += bflo(d[j].x); v[j][1] += bfhi(d[j].x); v[j][2] += bflo(d[j].y); v[j][3] += bfhi(d[j].y);
                s += (v[j][0] * v[j][0] + v[j][1] * v[j][1]) + (v[j][2] * v[j][2] + v[j][3] * v[j][3]);
                if (!OUTF32) ((f32x4*)(xout + (size_t)m * DM))[F.lane + 64 * j] = v[j]; }
            const float rstd = 1.0f / sqrtf(wave_sum(s, F.lane) * (1.0f / DM) + EPS);
#pragma unroll
            for (int j = 0; j < 8; ++j) { const f32x4 o = v[j] * rstd * gv[j];
                if (OUTF32) ((f32x4*)((float*)outp + (size_t)m * DM))[F.lane + 64 * j] = o;
                else { u32x2 w; w.x = pk2(o[0], o[1]); w.y = pk2(o[2], o[3]); ((u32x2*)((bf16*)outp + (size_t)m * DM))[F.lane + 64 * j] = w; } }
            if (mn < M) {
#pragma unroll
                for (int j = 0; j < 8; ++j) { v[j] = nv[j]; d[j] = nd[j]; } }
            m = mn;
        }
    }
#else
    for (int m = gw; m < M; m += NGW) {
        const f32x4* xr = (const f32x4*)(xin + (size_t)m * DM) + F.lane; const u32x2* dr = (const u32x2*)(delta + (size_t)m * DM) + F.lane;
        f32x4 v[8]; u32x2 d[8]; float s = 0.f;
#pragma unroll
        for (int j = 0; j < 8; ++j) { v[j] = xr[64 * j]; d[j] = dr[64 * j]; }
#pragma unroll
        for (int j = 0; j < 8; ++j) { v[j][0] += bflo(d[j].x); v[j][1] += bfhi(d[j].x); v[j][2] += bflo(d[j].y); v[j][3] += bfhi(d[j].y);
            s += (v[j][0] * v[j][0] + v[j][1] * v[j][1]) + (v[j][2] * v[j][2] + v[j][3] * v[j][3]);
            if (!OUTF32) ((f32x4*)(xout + (size_t)m * DM))[F.lane + 64 * j] = v[j]; }
        const float rstd = 1.0f / sqrtf(wave_sum(s, F.lane) * (1.0f / DM) + EPS);
#pragma unroll
        for (int j = 0; j < 8; ++j) { const f32x4 gv = ((const f32x4*)g)[F.lane + 64 * j]; const f32x4 o = v[j] * rstd * gv;
            if (OUTF32) ((f32x4*)((float*)outp + (size_t)m * DM))[F.lane + 64 * j] = o;
            else { u32x2 w; w.x = pk2(o[0], o[1]); w.y = pk2(o[2], o[3]); ((u32x2*)((bf16*)outp + (size_t)m * DM))[F.lane + 64 * j] = w; } }
    }
#endif
}
DI void unpack8(u32x4 w, float (&f)[8]) { f[0] = bflo(w.x); f[1] = bfhi(w.x); f[2] = bflo(w.y); f[3] = bfhi(w.y); f[4] = bflo(w.z); f[5] = bfhi(w.z); f[6] = bflo(w.w); f[7] = bfhi(w.w); }
DI u32x4 pack8f(const float (&f)[8]) { u32x4 o; o.x = pk2(f[0], f[1]); o.y = pk2(f[2], f[3]); o.z = pk2(f[4], f[5]); o.w = pk2(f[6], f[7]); return o; }

DI void ssd_conv_pass(const Frame& F0, const Args& A, int layer) {
    const Frame F = phase_frame(F0);
    const bf16* proj = (const bf16*)(F.ws + WS_PROJ); bf16* xbc = (bf16*)(F.ws + WS_XBC);
    const float* cw = (const float*)argin(A, 16) + (size_t)layer * 4 * SSD_XBC; const float* cb = (const float*)argin(A, 17) + (size_t)layer * SSD_XBC;
    const int gt = F.bid * NTHR + F.tid, NGT = F.G * NTHR;
    for (int task = gt; task < 512 * 384; task += NGT) {
        const int run = task / 384, cg = task - run * 384, ch = cg * 8, row0 = run * 32;
        float w[4][8], bs[8], xm3[8], xm2[8], xm1[8];
#pragma unroll
        for (int j = 0; j < 4; ++j) { const f32x4 a = *(const f32x4*)(cw + j * SSD_XBC + ch), b = *(const f32x4*)(cw + j * SSD_XBC + ch + 4);
            w[j][0] = a[0]; w[j][1] = a[1]; w[j][2] = a[2]; w[j][3] = a[3]; w[j][4] = b[0]; w[j][5] = b[1]; w[j][6] = b[2]; w[j][7] = b[3]; }
        { const f32x4 a = *(const f32x4*)(cb + ch), b = *(const f32x4*)(cb + ch + 4); bs[0] = a[0]; bs[1] = a[1]; bs[2] = a[2]; bs[3] = a[3]; bs[4] = b[0]; bs[5] = b[1]; bs[6] = b[2]; bs[7] = b[3]; }
        if ((row0 & (SEQ - 1)) != 0) {
            unpack8(*(const u32x4*)(proj + (size_t)(row0 - 3) * LDP + C_XBC + ch), xm3);
            unpack8(*(const u32x4*)(proj + (size_t)(row0 - 2) * LDP + C_XBC + ch), xm2);
            unpack8(*(const u32x4*)(proj + (size_t)(row0 - 1) * LDP + C_XBC + ch), xm1);
        } else {
#pragma unroll
            for (int k = 0; k < 8; ++k) { xm3[k] = 0.f; xm2[k] = 0.f; xm1[k] = 0.f; }
        }
#if defined(CONV_PF)
        const char* pj = (const char*)proj + (size_t)C_XBC * 2 + (size_t)ch * 2;
        auto ld8 = [&](u32x4 (&d)[8], int r) {
#pragma unroll
            for (int q = 0; q < 8; ++q) d[q] = *(const u32x4*)(pj + (unsigned)((row0 + r + q) * LDP) * 2u); };
        auto do8 = [&](const u32x4 (&d)[8], int r) {
#pragma unroll
            for (int q = 0; q < 8; ++q) { float cur[8], y[8]; unpack8(d[q], cur);
#pragma unroll
                for (int k = 0; k < 8; ++k) { const float v = w[0][k] * xm3[k] + w[1][k] * xm2[k] + w[2][k] * xm1[k] + w[3][k] * cur[k] + bs[k]; y[k] = siluf_(v); xm3[k] = xm2[k]; xm2[k] = xm1[k]; xm1[k] = cur[k]; }
                *(u32x4*)(xbc + (size_t)(row0 + r + q) * SSD_XBC + ch) = pack8f(y); } };
        u32x4 PA[8], PB[8];
        ld8(PA, 0);
#pragma unroll 1
        for (int r = 0; r < 32; r += 16) {
            ld8(PB, r + 8); do8(PA, r);
            if (r + 16 < 32) ld8(PA, r + 16);
            do8(PB, r + 8);
        }
#else
#pragma unroll 4
        for (int r = 0; r < 32; ++r) {
            float cur[8], y[8]; unpack8(*(const u32x4*)(proj + (size_t)(row0 + r) * LDP + C_XBC + ch), cur);
#pragma unroll
            for (int k = 0; k < 8; ++k) { const float v = w[0][k] * xm3[k] + w[1][k] * xm2[k] + w[2][k] * xm1[k] + w[3][k] * cur[k] + bs[k]; y[k] = siluf_(v); xm3[k] = xm2[k]; xm2[k] = xm1[k]; xm1[k] = cur[k]; }
            *(u32x4*)(xbc + (size_t)(row0 + r) * SSD_XBC + ch) = pack8f(y);
        }
#endif
    }
    const float* dtb = (const float*)argin(A, 18) + layer * SSD_H; float* dt = (float*)(F.ws + WS_DT);
    for (int i = gt; i < M * SSD_H; i += NGT) { const int row = i >> 5, h = i & 31;
        const float x = bf2f(proj[(size_t)row * LDP + C_DT + h]) + dtb[h];
        dt[i] = fmaxf(x, 0.f) + log1pf(__expf(-fabsf(x))); }
}

DI void merge_pass(const Frame& F0, const Args& A, int layer) {
    const Frame F = phase_frame(F0);
    const bf16* proj = (const bf16*)(F.ws + WS_PROJ); const bf16* ya = (const bf16*)(F.ws + WS_YA); const bf16* yc = (const bf16*)(F.ws + WS_YC); bf16* hb = (bf16*)(F.ws + WS_HB);
    const float* sw = (const float*)argin(A, 15) + (size_t)layer * 3 * DM; const float* ngp = (const float*)argin(A, 21) + (size_t)layer * DM; const float* rstdp = (const float*)(F.ws + WS_RSTD);
    const int gt = F.bid * NTHR + F.tid, NGT = F.G * NTHR;
    for (int task = gt; task < 512 * 256; task += NGT) {
        const int run = task >> 8, cg = task & 255, ch = cg * 8, row0 = run * 32;
        float w[3][8], pm2[8], pm1[8], ng8[8];
        { const f32x4 a = *(const f32x4*)(ngp + ch), b = *(const f32x4*)(ngp + ch + 4); ng8[0] = a[0]; ng8[1] = a[1]; ng8[2] = a[2]; ng8[3] = a[3]; ng8[4] = b[0]; ng8[5] = b[1]; ng8[6] = b[2]; ng8[7] = b[3]; }
#pragma unroll
        for (int j = 0; j < 3; ++j) { const f32x4 a = *(const f32x4*)(sw + j * DM + ch), b = *(const f32x4*)(sw + j * DM + ch + 4);
            w[j][0] = a[0]; w[j][1] = a[1]; w[j][2] = a[2]; w[j][3] = a[3]; w[j][4] = b[0]; w[j][5] = b[1]; w[j][6] = b[2]; w[j][7] = b[3]; }
        if ((row0 & (SEQ - 1)) != 0) {
            float c1[8], u1[8];
            unpack8(*(const u32x4*)(proj + (size_t)(row0 - 2) * LDP + C_CC + ch), c1); unpack8(*(const u32x4*)(proj + (size_t)(row0 - 2) * LDP + C_CU + ch), u1);
#pragma unroll
            for (int k = 0; k < 8; ++k) pm2[k] = c1[k] * u1[k];
            unpack8(*(const u32x4*)(proj + (size_t)(row0 - 1) * LDP + C_CC + ch), c1); unpack8(*(const u32x4*)(proj + (size_t)(row0 - 1) * LDP + C_CU + ch), u1);
#pragma unroll
            for (int k = 0; k < 8; ++k) pm1[k] = c1[k] * u1[k];
        } else {
#pragma unroll
            for (int k = 0; k < 8; ++k) { pm2[k] = 0.f; pm1[k] = 0.f; }
        }
#if defined(MERGE_PF)
        struct MR { u32x4 cc, cu, cb, g0, g1, g2, a, c; float rs; };
        auto ldrow = [&](MR& d, int r) { const unsigned pro = (unsigned)((row0 + r) * LDP + ch) * 2u, yro = (unsigned)((row0 + r) * DM + ch) * 2u;
            const char* pj = (const char*)proj;
            d.cc = *(const u32x4*)(pj + pro + C_CC * 2); d.cu = *(const u32x4*)(pj + pro + C_CU * 2); d.cb = *(const u32x4*)(pj + pro + C_CB * 2);
            d.g0 = *(const u32x4*)(pj + pro + C_GM * 2); d.g1 = *(const u32x4*)(pj + pro + (C_GM + DM) * 2); d.g2 = *(const u32x4*)(pj + pro + (C_GM + 2 * DM) * 2);
            d.a = *(const u32x4*)((const char*)ya + yro); d.c = *(const u32x4*)((const char*)yc + yro); d.rs = rstdp[(unsigned)((row0 + r) * SSD_G + (ch >> 9))]; };
        auto dorow = [&](const MR& d, int r) { const size_t yr = (size_t)(row0 + r) * DM + ch;
            float cc[8], cu[8], cbv[8], g0[8], g1[8], g2[8], a[8], c[8], o[8];
            unpack8(d.cc, cc); unpack8(d.cu, cu); unpack8(d.cb, cbv); unpack8(d.g0, g0); unpack8(d.g1, g1); unpack8(d.g2, g2); unpack8(d.a, a); unpack8(d.c, c);
#pragma unroll
            for (int k = 0; k < 8; ++k) { const float pc = cc[k] * cu[k]; const float cv = w[0][k] * pm2[k] + w[1][k] * pm1[k] + w[2][k] * pc; pm2[k] = pm1[k]; pm1[k] = pc;
                o[k] = sigmoidf_(g0[k]) * a[k] + sigmoidf_(g1[k]) * (cbv[k] * cv) + sigmoidf_(g2[k]) * (c[k] * d.rs * ng8[k]); }
            *(u32x4*)(hb + yr) = pack8f(o); };
#if MERGE_PF == 3
        MR A0, A1, A2;
        ldrow(A0, 0); ldrow(A1, 1);
#pragma unroll 1
        for (int r = 0; r < 30; r += 3) {
            ldrow(A2, r + 2); dorow(A0, r);
            ldrow(A0, r + 3); dorow(A1, r + 1);
            ldrow(A1, r + 4); dorow(A2, r + 2);
        }
        dorow(A0, 30); dorow(A1, 31);
#else
        MR A0, B0;
        ldrow(A0, 0);
#pragma unroll 1
        for (int r = 0; r < 32; r += 2) {
            ldrow(B0, r + 1); dorow(A0, r);
            if (r + 2 < 32) ldrow(A0, r + 2);
            dorow(B0, r + 1);
        }
#endif
#else
#if !defined(MERGE_UNROLL)
#define MERGE_UNROLL 2
#endif
#pragma unroll MERGE_UNROLL
        for (int r = 0; r < 32; ++r) {
            const size_t pr = (size_t)(row0 + r) * LDP + ch, yr = (size_t)(row0 + r) * DM + ch;
            float cc[8], cu[8], cbv[8], g0[8], g1[8], g2[8], a[8], c[8], o[8];
            unpack8(*(const u32x4*)(proj + pr + C_CC), cc); unpack8(*(const u32x4*)(proj + pr + C_CU), cu); unpack8(*(const u32x4*)(proj + pr + C_CB), cbv);
            unpack8(*(const u32x4*)(proj + pr + C_GM), g0); unpack8(*(const u32x4*)(proj + pr + C_GM + DM), g1); unpack8(*(const u32x4*)(proj + pr + C_GM + 2 * DM), g2);
            unpack8(*(const u32x4*)(ya + yr), a); unpack8(*(const u32x4*)(yc + yr), c);
            const float rs = rstdp[(size_t)(row0 + r) * SSD_G + (ch >> 9)];
#pragma unroll
            for (int k = 0; k < 8; ++k) { const float pc = cc[k] * cu[k]; const float cv = w[0][k] * pm2[k] + w[1][k] * pm1[k] + w[2][k] * pc; pm2[k] = pm1[k]; pm1[k] = pc;
                o[k] = sigmoidf_(g0[k]) * a[k] + sigmoidf_(g1[k]) * (cbv[k] * cv) + sigmoidf_(g2[k]) * (c[k] * rs * ng8[k]); }
            *(u32x4*)(hb + yr) = pack8f(o);
        }
#endif
    }
}

DI void compress_phase(const Frame& F0, const Args& A, int layer) {
    const Frame F = phase_frame(F0);
    const bf16* proj = (const bf16*)(F.ws + WS_PROJ);
    LAS unsigned char* slab = F.lds;
    LAS unsigned char* hidl = F.lds + 73728;
    LAS float* b1s = (LAS float*)(F.lds + 81920);
    const int lane = F.lane, w = F.wave, i = lane & 15, qd = lane >> 4;
    const float* part = (const float*)(F.ws + WS_MISC);
    for (int u = F.bid; u < 512; u += F.G) {
        const int kv = u >> 8, b = (u >> 7) & 1, g = (u >> 5) & 3, nb = u & 31, n0 = nb * 16, tok0 = n0 * 16;
        const bf16* src = (const bf16*)(F.ws + WS_KV) + kv_off(kv, b, g, 0);
        for (int id = F.tid; id < 272 * 16; id += NTHR) { const int row = id >> 4, ch = id & 15, t = tok0 + row;
            u32x4 v = {0u, 0u, 0u, 0u}; if (t < SEQ) v = *(const u32x4*)(src + (size_t)t * HD + ch * 8);
            *(LAS u32x4*)(slab + off_b(row, ch)) = v; }
        if (F.tid < 128) { float s = ((const float*)argin(A, kv ? 12 : 8))[layer * 128 + F.tid];
#pragma unroll
            for (int c = 0; c < PCH; ++c) s += part[(((size_t)layer * 2 + kv) * PCH + c) * 128 + F.tid];
            b1s[F.tid] = s; }
        __syncthreads();
        const bf16* w1t = (const bf16*)lw_ptr(F, layer, kv ? LW_PV1 : LW_PK1) + ((size_t)w * 128 * 64 + lane) * 8;
        f32x4 acc = {0.f, 0.f, 0.f, 0.f};
#if defined(SSD_IGLP)
        __builtin_amdgcn_iglp_opt(0);
#endif
#if defined(CMP_PF)
        {
            bf16x8 ba[16], bc[16];
#pragma unroll
            for (int k = 0; k < 16; ++k) ba[k] = *(const bf16x8*)(w1t + 512 * k);
#pragma unroll 1
            for (int k0 = 0; k0 < 128; k0 += 32) {
#pragma unroll
                for (int k = 0; k < 16; ++k) bc[k] = *(const bf16x8*)(w1t + 512 * (k0 + 16 + k));
#pragma unroll
                for (int k = 0; k < 16; ++k) { const int ks = k0 + k; acc = MFMA16(lds_rd8(slab + off_b(16 * i + (ks >> 2), 4 * (ks & 3) + qd)), ba[k], acc); }
                if (k0 + 32 < 128) {
#pragma unroll
                    for (int k = 0; k < 16; ++k) ba[k] = *(const bf16x8*)(w1t + 512 * (k0 + 32 + k)); }
#pragma unroll
                for (int k = 0; k < 16; ++k) { const int ks = k0 + 16 + k; acc = MFMA16(lds_rd8(slab + off_b(16 * i + (ks >> 2), 4 * (ks & 3) + qd)), bc[k], acc); }
            }
        }
#else
        for (int k0 = 0; k0 < 128; k0 += 32) {
            bf16x8 bb[32];
#pragma unroll
            for (int k = 0; k < 32; ++k) bb[k] = *(const bf16x8*)(w1t + 512 * (k0 + k));
#pragma unroll
            for (int k = 0; k < 32; ++k) { const int ks = k0 + k;
                acc = MFMA16(lds_rd8(slab + off_b(16 * i + (ks >> 2), 4 * (ks & 3) + qd)), bb[k], acc); }
        }
#endif
        { const float bv = b1s[16 * w + i];
#pragma unroll
          for (int j = 0; j < 4; ++j) *(LAS bf16*)(hidl + (4 * qd + j) * 272 + (16 * w + i) * 2) = (bf16)f2bf(siluf_(acc[j] + bv)); }
        __syncthreads();
        const bf16* w2t = (const bf16*)lw_ptr(F, layer, kv ? LW_PV2 : LW_PK2) + (size_t)(16 * w + i) * 128 + 8 * qd;
        f32x4 acc2 = {0.f, 0.f, 0.f, 0.f};
#pragma unroll
        for (int s = 0; s < 4; ++s) {
            const bf16x8 a = lds_rd8(hidl + i * 272 + 64 * s + 16 * qd);
            const bf16x8 bb = *(const bf16x8*)(w2t + 32 * s);
            acc2 = MFMA16(a, bb, acc2);
        }
        const float b2 = ((const float*)argin(A, kv ? 14 : 10))[layer * 128 + 16 * w + i];
        bf16* dst = (bf16*)(F.ws + (kv ? WS_VCMP : WS_KCMP)) + ((size_t)(b * NG + g) * NCMP_PAD + n0) * HD + 16 * w + i;
#pragma unroll
        for (int j = 0; j < 4; ++j) dst[(size_t)(4 * qd + j) * HD] = (bf16)f2bf(acc2[j] + b2);
        __syncthreads();
    }
}

DI unsigned pk2_sw(float a, float b) {
    unsigned ua = __builtin_bit_cast(unsigned, a), ub = __builtin_bit_cast(unsigned, b);
    ua += 0x7FFFu + ((ua >> 16) & 1u); ub += 0x7FFFu + ((ub >> 16) & 1u);
    return (ua >> 16) | (ub & 0xFFFF0000u);
}
DI void ssd_states_phase(const Frame& F0, const Args& A, int layer) {
    const Frame F = phase_frame(F0);
    const bf16* xbc = (const bf16*)(F.ws + WS_XBC); const float* dt = (const float*)(F.ws + WS_DT);
    float* acs = (float*)(F.ws + WS_ACS); float* cdec = (float*)(F.ws + WS_CDEC); float* st = (float*)(F.ws + WS_ST);
    LAS unsigned char* Bt = F.lds; LAS unsigned char* Xt = F.lds + 32768; LAS float* sc = (LAS float*)(F.lds + 65536);
    const float* alog = (const float*)argin(A, 19) + layer * SSD_H;
    const int lane = F.lane, w = F.wave, i = lane & 15, qd = lane >> 4;
    for (int u = F.bid; u < 512; u += F.G) {
        const int b = u >> 8, c = (u >> 2) & 63, g = u & 3, row0 = b * SEQ + c * SSD_CH;
        {
            const int hh = g * 8 + w; const float a = -__expf(alog[hh]);
            const float dt0 = dt[(size_t)(row0 + 2 * lane) * SSD_H + hh], dt1 = dt[(size_t)(row0 + 2 * lane + 1) * SSD_H + hh];
            const float d0 = dt0 * a, d1 = dt1 * a, pair = d0 + d1; float s = pair;
#pragma unroll
            for (int o = 1; o < 64; o <<= 1) { const float t = shfl_idx(s, lane - o); if (lane >= o) s += t; }
            const float a0 = (s - pair) + d0, a1 = s, total = __builtin_bit_cast(float, __builtin_amdgcn_readlane(__builtin_bit_cast(int, s), 63));
            acs[(size_t)(row0 + 2 * lane) * SSD_H + hh] = a0; acs[(size_t)(row0 + 2 * lane + 1) * SSD_H + hh] = a1;
            sc[w * 128 + 2 * lane] = dt0 * __expf(total - a0); sc[w * 128 + 2 * lane + 1] = dt1 * __expf(total - a1);
            if (lane == 0) cdec[(size_t)(b * SSD_NC + c) * SSD_H + hh] = __expf(total);
        }
#if defined(S1_PRELOAD)
        u32x4 xr[4][4];
#pragma unroll
        for (int hp = 0; hp < 4; ++hp)
#pragma unroll
            for (int j = 0; j < 4; ++j) { const int id = F.tid + NTHR * j, row = id >> 4, ch = id & 15;
                xr[hp][j] = *(const u32x4*)(xbc + (size_t)(row0 + row) * SSD_XBC + g * 512 + hp * 128 + ch * 8); }
#pragma unroll
        for (int j = 0; j < 4; ++j) { const int id = F.tid + NTHR * j, row = id >> 4, ch = id & 15;
            *(LAS u32x4*)(Bt + off_b(row, ch)) = *(const u32x4*)(xbc + (size_t)(row0 + row) * SSD_XBC + 2048 + g * 128 + ch * 8); }
        __syncthreads();
        bf16x8 bfr[4];
#pragma unroll
        for (int ks = 0; ks < 4; ++ks) bfr[ks] = tr_read8(Bt, lane, 32 * ks, w);
#pragma unroll
        for (int hp = 0; hp < 4; ++hp) {
            LAS unsigned char* Xb = Xt + (hp & 1) * 32768 + ((hp & 1) ? 4096 : 0);
#pragma unroll
            for (int j = 0; j < 4; ++j) { const int id = F.tid + NTHR * j, row = id >> 4, ch = id & 15;
                float x[8]; unpack8(xr[hp][j], x);
                const float f = sc[(hp * 2 + (ch >> 3)) * 128 + row];
#pragma unroll
                for (int k = 0; k < 8; ++k) x[k] *= f;
                *(LAS u32x4*)(Xb + off_b(row, ch)) = pack8f(x); }
            __syncthreads();
#pragma unroll
            for (int h2 = 0; h2 < 2; ++h2) {
                const int head = g * 8 + hp * 2 + h2;
                float* dst = st + ((size_t)((b * SSD_NC + c) * SSD_H + head) * SSD_N + 16 * w + i) * SSD_P + 4 * qd;
#pragma unroll
                for (int pt = 0; pt < 4; ++pt) {
                    f32x4 acc = {0.f, 0.f, 0.f, 0.f};
#pragma unroll
                    for (int ks = 0; ks < 4; ++ks) acc = MFMA16(tr_read8(Xb, lane, 32 * ks, h2 * 4 + pt), bfr[ks], acc);
#if defined(ST_BF16)
                    { u32x2 o_; o_.x = pk2_sw(acc[0], acc[1]); o_.y = pk2_sw(acc[2], acc[3]); *(u32x2*)((bf16*)st + (size_t)(dst - st) + 16 * pt) = o_; }
#else
                    *(f32x4*)(dst + 16 * pt) = acc;
#endif
                }
            }
        }
#else
        for (int id = F.tid; id < 128 * 16; id += NTHR) { const int row = id >> 4, ch = id & 15;
            *(LAS u32x4*)(Bt + off_b(row, ch)) = *(const u32x4*)(xbc + (size_t)(row0 + row) * SSD_XBC + 2048 + g * 128 + ch * 8); }
        bf16x8 bfr[4];
        for (int hp = 0; hp < 4; ++hp) {
            __syncthreads();
            for (int id = F.tid; id < 128 * 16; id += NTHR) { const int row = id >> 4, ch = id & 15;
                float x[8]; unpack8(*(const u32x4*)(xbc + (size_t)(row0 + row) * SSD_XBC + g * 512 + hp * 128 + ch * 8), x);
                const float f = sc[(hp * 2 + (ch >> 3)) * 128 + row];
#pragma unroll
                for (int k = 0; k < 8; ++k) x[k] *= f;
                *(LAS u32x4*)(Xt + off_b(row, ch)) = pack8f(x); }
            __syncthreads();
            if (hp == 0) {
#pragma unroll
                for (int ks = 0; ks < 4; ++ks) bfr[ks] = tr_read8(Bt, lane, 32 * ks, w);
            }
#pragma unroll
            for (int h2 = 0; h2 < 2; ++h2) {
                const int head = g * 8 + hp * 2 + h2;
                float* dst = st + ((size_t)((b * SSD_NC + c) * SSD_H + head) * SSD_N + 16 * w + i) * SSD_P + 4 * qd;
#pragma unroll
                for (int pt = 0; pt < 4; ++pt) {
                    f32x4 acc = {0.f, 0.f, 0.f, 0.f};
#pragma unroll
                    for (int ks = 0; ks < 4; ++ks) acc = MFMA16(tr_read8(Xt, lane, 32 * ks, h2 * 4 + pt), bfr[ks], acc);
#if defined(ST_BF16)
                    { u32x2 o_; o_.x = pk2_sw(acc[0], acc[1]); o_.y = pk2_sw(acc[2], acc[3]); *(u32x2*)((bf16*)st + (size_t)(dst - st) + 16 * pt) = o_; }
#else
                    *(f32x4*)(dst + 16 * pt) = acc;
#endif
                }
            }
        }
#endif
        __syncthreads();
    }
}
DI void ssd_scan_phase(const Frame& F0) {
    const Frame F = phase_frame(F0);
    const f32x4* st = (const f32x4*)(F.ws + WS_ST); u32x2* hin = (u32x2*)(F.ws + WS_HIN); const float* cdec = (const float*)(F.ws + WS_CDEC);
    const int gt = F.bid * NTHR + F.tid, NGT = F.G * NTHR;
    for (int v = gt; v < BATCH * SSD_H * 2048; v += NGT) {
        const int b = v >> 16, h = (v >> 11) & 31, e = v & 2047;
        const size_t o0 = ((size_t)(b * SSD_NC) * SSD_H + h) * 2048 + e;
        const float* dc = cdec + (size_t)(b * SSD_NC) * SSD_H + h;
        f32x4 hs = {0.f, 0.f, 0.f, 0.f};
#if defined(S2_PF) && defined(ST_BF16)
        {
#pragma unroll 1
            for (int c0 = 0; c0 < SSD_NC; c0 += 32) {
                u32x2 raw[32]; float dd[32];
#pragma unroll
                for (int k = 0; k < 32; ++k) { raw[k] = ((const u32x2*)st)[o0 + (size_t)(c0 + k) * 65536]; dd[k] = dc[(c0 + k) * SSD_H]; }
#pragma unroll
                for (int k = 0; k < 32; ++k) { u32x2 o; o.x = pk2(hs[0], hs[1]); o.y = pk2(hs[2], hs[3]); hin[o0 + (size_t)(c0 + k) * 65536] = o;
                    const f32x4 sv = {bflo(raw[k].x), bfhi(raw[k].x), bflo(raw[k].y), bfhi(raw[k].y)}; hs = hs * dd[k] + sv; }
            }
        }
#else
        for (int c0 = 0; c0 < SSD_NC; c0 += 8) {
            f32x4 s[8]; float d[8];
#pragma unroll
#if defined(ST_BF16)
            for (int k = 0; k < 8; ++k) { const u32x2 t_ = ((const u32x2*)st)[o0 + (size_t)(c0 + k) * 65536]; s[k][0] = bflo(t_.x); s[k][1] = bfhi(t_.x); s[k][2] = bflo(t_.y); s[k][3] = bfhi(t_.y); d[k] = dc[(c0 + k) * SSD_H]; }
#else
            for (int k = 0; k < 8; ++k) { s[k] = st[o0 + (size_t)(c0 + k) * 65536]; d[k] = dc[(c0 + k) * SSD_H]; }
#endif
#pragma unroll
            for (int k = 0; k < 8; ++k) { u32x2 o; o.x = pk2(hs[0], hs[1]); o.y = pk2(hs[2], hs[3]); hin[o0 + (size_t)(c0 + k) * 65536] = o; hs = hs * d[k] + s[k]; }
        }
#endif
    }
}
DI void ssd_out_phase(const Frame& F0, const Args& A, int layer) {
    const Frame F = phase_frame(F0);
    const bf16* xbc = (const bf16*)(F.ws + WS_XBC); const bf16* proj = (const bf16*)(F.ws + WS_PROJ);
    const float* dt = (const float*)(F.ws + WS_DT); const float* acs = (const float*)(F.ws + WS_ACS); const bf16* hin = (const bf16*)(F.ws + WS_HIN);
    bf16* yc = (bf16*)(F.ws + WS_YC); float* rstdp = (float*)(F.ws + WS_RSTD);
    LAS unsigned char* Bt = F.lds; LAS unsigned char* Ct = F.lds + 32768; LAS unsigned char* Xt = F.lds + 65536; LAS unsigned char* Ht = F.lds + 98304;
    LAS float* acsl = (LAS float*)(F.lds + LX_OFF);
    const float* dsk = (const float*)argin(A, 20) + layer * SSD_H;
    const int lane = F.lane, w = F.wave, i = lane & 15, qd = lane >> 4;
    for (int u = F.bid; u < 512; u += F.G) {
        const int b = u >> 8, c = (u >> 2) & 63, g = u & 3, row0 = b * SEQ + c * SSD_CH;
        for (int id = F.tid; id < 128 * 16; id += NTHR) { const int row = id >> 4, ch = id & 15; const bf16* src = xbc + (size_t)(row0 + row) * SSD_XBC + 2048 + g * 128 + ch * 8;
            *(LAS u32x4*)(Bt + off_b(row, ch)) = *(const u32x4*)(src); *(LAS u32x4*)(Ct + off_b(row, ch)) = *(const u32x4*)(src + 512); }
        __syncthreads();
        bf16x8 cfr[4];
#pragma unroll
        for (int ks = 0; ks < 4; ++ks) cfr[ks] = lds_rd8(Ct + off_b(16 * w + i, 4 * ks + qd));
        f32x4 cb[4][2];
#pragma unroll
        for (int k = 0; k < 4; ++k)
#pragma unroll
            for (int T = 0; T < 2; ++T) { f32x4 acc = {0.f, 0.f, 0.f, 0.f};
#pragma unroll
                for (int ks = 0; ks < 4; ++ks) acc = MFMA16(lds_rd8(Bt + off_b(32 * k + 8 * (i >> 2) + (i & 3) + 4 * T, 4 * ks + qd)), cfr[ks], acc);
                cb[k][T] = acc; }
        const int lrow = 16 * w + i, row = row0 + lrow;
        float ssq = 0.f;
#if defined(S3_PREFETCH)
        u32x4 px[4], ph[4]; float pd[4], pa = 0.f;
#define S3_PF_LOAD(HP) do { \
            if (F.tid < 256) { const int h2_ = F.tid >> 7, l_ = F.tid & 127; pa = acs[(size_t)(row0 + l_) * SSD_H + g * 8 + (HP) * 2 + h2_]; } \
            _Pragma("unroll") for (int j_ = 0; j_ < 4; ++j_) { const int id_ = F.tid + NTHR * j_, r_ = id_ >> 4, ch_ = id_ & 15, head_ = g * 8 + (HP) * 2 + (ch_ >> 3); \
                px[j_] = *(const u32x4*)(xbc + (size_t)(row0 + r_) * SSD_XBC + g * 512 + (HP) * 128 + ch_ * 8); pd[j_] = dt[(size_t)(row0 + r_) * SSD_H + head_]; \
                ph[j_] = *(const u32x4*)(hin + ((size_t)((b * SSD_NC + c) * SSD_H + head_) * SSD_N + r_) * SSD_P + (ch_ & 7) * 8); } } while (0)
        S3_PF_LOAD(0);
#endif
        for (int hp = 0; hp < 4; ++hp) {
            __syncthreads();
#if defined(S3_PREFETCH)
            if (F.tid < 256) acsl[F.tid] = pa;
#pragma unroll
            for (int j = 0; j < 4; ++j) { const int id = F.tid + NTHR * j, r = id >> 4, ch = id & 15;
                float x[8]; unpack8(px[j], x);
#pragma unroll
                for (int k = 0; k < 8; ++k) x[k] *= pd[j];
                *(LAS u32x4*)(Xt + off_b(r, ch)) = pack8f(x); *(LAS u32x4*)(Ht + off_b(r, ch)) = ph[j]; }
            __syncthreads();
            u32x2 xva[4], zva[4];
#pragma unroll
            for (int pt = 0; pt < 4; ++pt) { const int chn = (g * 8 + hp * 2) * SSD_P + 16 * pt + 4 * qd;
                xva[pt] = *(const u32x2*)(xbc + (size_t)row * SSD_XBC + chn); zva[pt] = *(const u32x2*)(proj + (size_t)row * LDP + C_Z + chn); }
            __builtin_amdgcn_sched_barrier(0);
            if (hp < 3) S3_PF_LOAD(hp + 1);
            __builtin_amdgcn_sched_barrier(0);
#else
            if (F.tid < 256) { const int h2 = F.tid >> 7, l = F.tid & 127; acsl[F.tid] = acs[(size_t)(row0 + l) * SSD_H + g * 8 + hp * 2 + h2]; }
            for (int id = F.tid; id < 128 * 16; id += NTHR) { const int r = id >> 4, ch = id & 15, head = g * 8 + hp * 2 + (ch >> 3);
                float x[8]; unpack8(*(const u32x4*)(xbc + (size_t)(row0 + r) * SSD_XBC + g * 512 + hp * 128 + ch * 8), x);
                const float f = dt[(size_t)(row0 + r) * SSD_H + head];
#pragma unroll
                for (int k = 0; k < 8; ++k) x[k] *= f;
                *(LAS u32x4*)(Xt + off_b(r, ch)) = pack8f(x);
                *(LAS u32x4*)(Ht + off_b(r, ch)) = *(const u32x4*)(hin + ((size_t)((b * SSD_NC + c) * SSD_H + head) * SSD_N + r) * SSD_P + (ch & 7) * 8); }
            __syncthreads();
#endif
#if defined(S3_PREFETCH)
#pragma unroll 1
#else
#pragma unroll
#endif
            for (int h2 = 0; h2 < 2; ++h2) {
                const int head = g * 8 + hp * 2 + h2;
#if defined(SSD_IGLP)
                __builtin_amdgcn_iglp_opt(0);
#endif
                const float al = acsl[h2 * 128 + lrow], ea = __expf(al), dsv = dsk[head];
#if defined(S3_PREFETCH)
                if (h2 == 1) {
#pragma unroll
                    for (int pt = 0; pt < 4; ++pt) { const int chn = head * SSD_P + 16 * pt + 4 * qd;
                        xva[pt] = *(const u32x2*)(xbc + (size_t)row * SSD_XBC + chn); zva[pt] = *(const u32x2*)(proj + (size_t)row * LDP + C_Z + chn); } }
#else
                u32x2 xv4[4], zv4[4];
#pragma unroll
                for (int pt = 0; pt < 4; ++pt) { const int chn = head * SSD_P + 16 * pt + 4 * qd;
                    xv4[pt] = *(const u32x2*)(xbc + (size_t)row * SSD_XBC + chn); zv4[pt] = *(const u32x2*)(proj + (size_t)row * LDP + C_Z + chn); }
#endif
                bf16x8 mfr[4];
#pragma unroll
                for (int k = 0; k < 4; ++k) {
                    const f32x4 a0 = *(const LAS f32x4*)(acsl + h2 * 128 + 32 * k + 8 * qd), a1 = *(const LAS f32x4*)(acsl + h2 * 128 + 32 * k + 8 * qd + 4);
                    float mv[8];
#pragma unroll
                    for (int j = 0; j < 4; ++j) { const int s0 = 32 * k + 8 * qd + j, s1 = s0 + 4;
                        mv[j] = (s0 <= lrow) ? cb[k][0][j] * __expf(al - a0[j]) : 0.f;
                        mv[4 + j] = (s1 <= lrow) ? cb[k][1][j] * __expf(al - a1[j]) : 0.f; }
                    mfr[k] = as_bf16x8(pack8f(mv));
                }
#pragma unroll
                for (int pt = 0; pt < 4; ++pt) {
                    f32x4 yd = {0.f, 0.f, 0.f, 0.f}, yo = {0.f, 0.f, 0.f, 0.f};
#pragma unroll
                    for (int k = 0; k < 4; ++k) yd = MFMA16(tr_read8(Xt, lane, 32 * k, h2 * 4 + pt), mfr[k], yd);
#pragma unroll
                    for (int ks = 0; ks < 4; ++ks) yo = MFMA16(tr_read8(Ht, lane, 32 * ks, h2 * 4 + pt), cfr[ks], yo);
                    const int chn = head * SSD_P + 16 * pt + 4 * qd;
#if defined(S3_PREFETCH)
                    const u32x2 xv = xva[pt], zv = zva[pt];
#else
                    const u32x2 xv = xv4[pt], zv = zv4[pt];
#endif
                    const float xs[4] = {bflo(xv.x), bfhi(xv.x), bflo(xv.y), bfhi(xv.y)}, zz[4] = {bflo(zv.x), bfhi(zv.x), bflo(zv.y), bfhi(zv.y)};
                    float gy[4];
#pragma unroll
                    for (int j = 0; j < 4; ++j) { const float y = yd[j] + ea * yo[j] + dsv * xs[j]; gy[j] = y * siluf_(zz[j]); ssq += gy[j] * gy[j]; }
                    u32x2 o; o.x = pk2(gy[0], gy[1]); o.y = pk2(gy[2], gy[3]);
                    *(u32x2*)(yc + (size_t)row * DM + chn) = o;
                }
            }
        }
        ssq += shx(ssq, 16, lane); ssq += shx(ssq, 32, lane);
        if (qd == 0) rstdp[(size_t)row * SSD_G + g] = 1.0f / sqrtf(ssq * (1.0f / 512.0f) + EPS);
        __syncthreads();
    }
}

#ifndef NSA_REP_PART
#define NSA_REP_PART 0
#endif
#if NSA_REP_PART == 7
#define W7DUP(x) x
#define W7WAIT() NSA_WAITV(8)
#else
#define W7DUP(x)
#define W7WAIT() NSA_WAITV(4)
#endif
#if NSA_REP_PART == 10
#define SELDUP(x) x
#else
#define SELDUP(x)
#endif
constexpr int RB = 32768, NRING = 3;
#define NSA_WAITV(n) asm volatile("s_waitcnt vmcnt(" #n ")" ::: "memory")
#define NSA_BAR() do { asm volatile("" ::: "memory"); __builtin_amdgcn_s_barrier(); asm volatile("" ::: "memory"); } while (0)
template <bool WITHV> DI void tile_dma(LAS unsigned char* buf, const bf16* kp, const bf16* vp, int pitch, int w, int lane) {
#pragma unroll
    for (int e = 0; e < 2; ++e) { const int kb = 2 * w + e, kh = kb >> 3, T = (kb >> 2) & 1, ks = kb & 3, i = lane & 15, qd = lane >> 4;
        const int key = 32 * kh + 8 * (i >> 2) + (i & 3) + 4 * T, ch = 4 * ks + qd;
        __builtin_amdgcn_global_load_lds((const unsigned*)(kp + (size_t)key * pitch + ch * 8), (LAS unsigned*)(buf + kb * 1024), 16, 0, 0); }
    if (WITHV) {
#pragma unroll
        for (int e = 0; e < 2; ++e) { const int vb = 2 * w + e, kh = vb >> 3, t = (vb >> 2) & 1, dtp = vb & 3, dtl = lane >> 5, g = (lane >> 3) & 3, q = (lane >> 1) & 3, ph = lane & 1;
            const int key = 32 * kh + 8 * g + 4 * t + q, ch = 4 * dtp + 2 * dtl + ph;
            __builtin_amdgcn_global_load_lds((const unsigned*)(vp + (size_t)key * pitch + ch * 8), (LAS unsigned*)(buf + 16384 + vb * 1024), 16, 0, 0); }
    }
}
#define NSA_TR8(r, addr, b) asm volatile("ds_read_b64_tr_b16 %0, %8 offset:%9\n\tds_read_b64_tr_b16 %1, %8 offset:%10\n\tds_read_b64_tr_b16 %2, %8 offset:%11\n\tds_read_b64_tr_b16 %3, %8 offset:%12\n\t" \
        "ds_read_b64_tr_b16 %4, %8 offset:%13\n\tds_read_b64_tr_b16 %5, %8 offset:%14\n\tds_read_b64_tr_b16 %6, %8 offset:%15\n\tds_read_b64_tr_b16 %7, %8 offset:%16" \
        : "=&v"(r[0]), "=&v"(r[1]), "=&v"(r[2]), "=&v"(r[3]), "=&v"(r[4]), "=&v"(r[5]), "=&v"(r[6]), "=&v"(r[7]) \
        : "v"(addr), "i"((b)), "i"((b) + 4096), "i"((b) + 512), "i"((b) + 4608), "i"((b) + 1024), "i"((b) + 5120), "i"((b) + 1536), "i"((b) + 5632) : "memory")
#define NSA_TRWAIT(r) asm volatile("s_waitcnt lgkmcnt(0)" : "+v"(r[0]), "+v"(r[1]), "+v"(r[2]), "+v"(r[3]), "+v"(r[4]), "+v"(r[5]), "+v"(r[6]), "+v"(r[7]) :: "memory")
#define NSA_TRWAIT8(r) asm volatile("s_waitcnt lgkmcnt(8)" : "+v"(r[0]), "+v"(r[1]), "+v"(r[2]), "+v"(r[3]), "+v"(r[4]), "+v"(r[5]), "+v"(r[6]), "+v"(r[7]) :: "memory")
#if defined(NSA_NO_SB)
#define NSA_SB()
#else
#define NSA_SB() __builtin_amdgcn_sched_barrier(0)
#endif
#if !defined(NSA_NO_SETPRIO)
#define NSA_PRIO(x) __builtin_amdgcn_s_setprio(x)
#else
#define NSA_PRIO(x)
#endif
#define NSA_PV4(r, kh, d0) do { NSA_PRIO(1); _Pragma("unroll") for (int q_ = 0; q_ < 4; ++q_) { const bf16x8 vf_ = __builtin_shufflevector(r[2 * q_], r[2 * q_ + 1], 0, 1, 2, 3, 4, 5, 6, 7); \
        if (SM & 1) O[0][(d0) + q_] = MFMA16(vf_, pf[0][kh], O[0][(d0) + q_]); if (SM & 2) O[1][(d0) + q_] = MFMA16(vf_, pf[1][kh], O[1][(d0) + q_]); } NSA_PRIO(0); } while (0)
template <int MODE, int SM>
DI void attn_tile(LAS const unsigned char* Kt, LAS const unsigned char* Vt, const bf16x8 (&Qf)[2][4], f32x4 (&O)[2][8], float (&m)[2], float (&l)[2], const int (&lo)[2], const int (&hi)[2], bool needmask,
                  float c2, const float (&inv_l)[2], LAS float* imp, const int (&ql)[2], int jb0, float (&cin)[2], int lane) {
    const int qd = lane >> 4;
    f32x4 sc[2][2][2];
#if !defined(NSA_NO_IGLP)
    __builtin_amdgcn_iglp_opt(0);
#endif
#pragma unroll
    for (int kh = 0; kh < 2; ++kh)
#pragma unroll
        for (int T = 0; T < 2; ++T) { f32x4 a0 = {0.f, 0.f, 0.f, 0.f}, a1 = {0.f, 0.f, 0.f, 0.f};
#pragma unroll
            for (int ks = 0; ks < 4; ++ks) { const bf16x8 kf = lds_rd8(Kt + (kh * 8 + T * 4 + ks) * 1024);
                if (SM & 1) a0 = MFMA16(kf, Qf[0][ks], a0); if (SM & 2) a1 = MFMA16(kf, Qf[1][ks], a1); }
            sc[0][kh][T] = a0; sc[1][kh][T] = a1; }
    const float NEG = -__builtin_inff();
    bf16x8 pf[2][2];
#pragma unroll
    for (int s = 0; s < 2; ++s) if (SM & (1 << s)) {
        if (needmask) {
#pragma unroll
            for (int kh = 0; kh < 2; ++kh)
#pragma unroll
                for (int T = 0; T < 2; ++T)
#pragma unroll
                    for (int j = 0; j < 4; ++j) { const int kk = 32 * kh + 8 * qd + 4 * T + j; if (kk < lo[s] || kk > hi[s]) sc[s][kh][T][j] = NEG; }
        }
        float mn = m[s];
        if (MODE != 2) {
            float tmax = fmaxf(fmaxf(sc[s][0][0][0], sc[s][0][0][1]), fmaxf(sc[s][0][0][2], sc[s][0][0][3]));
            tmax = fmaxf(tmax, fmaxf(fmaxf(sc[s][0][1][0], sc[s][0][1][1]), fmaxf(sc[s][0][1][2], sc[s][0][1][3])));
            tmax = fmaxf(tmax, fmaxf(fmaxf(sc[s][1][0][0], sc[s][1][0][1]), fmaxf(sc[s][1][0][2], sc[s][1][0][3])));
            tmax = fmaxf(tmax, fmaxf(fmaxf(sc[s][1][1][0], sc[s][1][1][1]), fmaxf(sc[s][1][1][2], sc[s][1][1][3])));
            tmax = xq_max(tmax);
            mn = fmaxf(m[s], tmax);
            if (__ballot(mn != m[s]) != 0ull) {
                const float alpha = __builtin_amdgcn_exp2f((m[s] - mn) * c2);
                l[s] *= alpha;
                if (MODE == 1) {
#pragma unroll
                    for (int dt = 0; dt < 8; ++dt) O[s][dt] = O[s][dt] * alpha;
                }
                m[s] = mn;
            }
        }
        const float nmc = -mn * c2; float ps = 0.f;
#pragma unroll
        for (int kh = 0; kh < 2; ++kh)
#pragma unroll
            for (int T = 0; T < 2; ++T)
#pragma unroll
                for (int j = 0; j < 4; ++j) { float p = __builtin_amdgcn_exp2f(__builtin_fmaf(sc[s][kh][T][j], c2, nmc)); if (MODE == 2) p *= inv_l[s]; sc[s][kh][T][j] = p; ps += p; }
        if (MODE != 2) l[s] += ps;
        if (MODE == 2) {
            float s4[2][2], cy[2][2];
#pragma unroll
            for (int kh = 0; kh < 2; ++kh)
#pragma unroll
                for (int T = 0; T < 2; ++T) {
                    float a = (sc[s][kh][T][0] + sc[s][kh][T][1]) + (sc[s][kh][T][2] + sc[s][kh][T][3]), c = sc[s][kh][T][3];
                    a = quad_sum(a); c = quad_sum(c);
                    s4[kh][T] = a; cy[kh][T] = c; }
            const float x0 = shfl_idx(cy[0][1], (lane - 16) & 63), x1 = shfl_idx(cy[1][1], (lane - 16) & 63);
            const float p00 = (qd == 0) ? cin[s] : x0, p10 = (qd == 0) ? x0 : x1;
            cin[s] = x1;
            if ((lane & 3) == 0) { const int jb = jb0 + 2 * qd;
                *(LAS f32x2*)(imp + ql[s] * 128 + jb) = (f32x2){s4[0][0] + p00, s4[0][1] + cy[0][0]};
                *(LAS f32x2*)(imp + ql[s] * 128 + jb + 8) = (f32x2){s4[1][0] + p10, s4[1][1] + cy[1][0]}; }
        }
        if (MODE != 0) {
#pragma unroll
            for (int kh = 0; kh < 2; ++kh) { u32x4 pw; pw.x = pk2(sc[s][kh][0][0], sc[s][kh][0][1]); pw.y = pk2(sc[s][kh][0][2], sc[s][kh][0][3]); pw.z = pk2(sc[s][kh][1][0], sc[s][kh][1][1]); pw.w = pk2(sc[s][kh][1][2], sc[s][kh][1][3]); pf[s][kh] = as_bf16x8(pw); }
        }
    }
    if (MODE != 0) {
        const unsigned va = (unsigned)(size_t)Vt;
        s16x4 ra[8], rb[8];
        NSA_TR8(ra, va, 0);     NSA_TR8(rb, va, 2048); NSA_SB();
        NSA_TRWAIT8(ra); NSA_SB(); NSA_PV4(ra, 0, 0); NSA_SB(); NSA_TR8(ra, va, 8192);  NSA_SB();
        NSA_TRWAIT8(rb); NSA_SB(); NSA_PV4(rb, 0, 4); NSA_SB(); NSA_TR8(rb, va, 10240); NSA_SB();
        NSA_TRWAIT8(ra); NSA_SB(); NSA_PV4(ra, 1, 0); NSA_SB();
        NSA_TRWAIT(rb);  NSA_SB(); NSA_PV4(rb, 1, 4);
    }
}
template <bool FIRST> DI void nsa_emit(const f32x4 (&O)[8], float scale, bf16* dst  ) {
    u32x2 old[8];
    if (!FIRST) {
#pragma unroll
        for (int dt = 0; dt < 8; ++dt) old[dt] = *(const u32x2*)(dst + 16 * dt);
    }
#pragma unroll
    for (int dt = 0; dt < 8; ++dt) { f32x4 v = O[dt] * scale;
        if (!FIRST) { v[0] += bflo(old[dt].x); v[1] += bfhi(old[dt].x); v[2] += bflo(old[dt].y); v[3] += bfhi(old[dt].y); }
        u32x2 o; o.x = pk2(v[0], v[1]); o.y = pk2(v[2], v[3]); *(u32x2*)(dst + 16 * dt) = o; }
}
DI int next_bit(unsigned u0, unsigned u1, unsigned u2, unsigned u3, int from) {
    if (from >= 128) return -1;
    const int wd = from >> 5; const unsigned msk = ~0u << (from & 31);
    const unsigned x0 = (wd == 0) ? (u0 & msk) : 0u;
    const unsigned x1 = (wd < 1) ? u1 : ((wd == 1) ? (u1 & msk) : 0u);
    const unsigned x2 = (wd < 2) ? u2 : ((wd == 2) ? (u2 & msk) : 0u);
    const unsigned x3 = (wd < 3) ? u3 : (u3 & msk);
    if (x0) return __builtin_ctz(x0);
    if (x1) return 32 + __builtin_ctz(x1);
    if (x2) return 64 + __builtin_ctz(x2);
    if (x3) return 96 + __builtin_ctz(x3);
    return -1;
}

DI void nsa_phase(const Frame& F0, const Args& A, int layer) {
    const Frame F = phase_frame(F0);
    const bf16* proj = (const bf16*)(F.ws + WS_PROJ); const bf16* kcmp = (const bf16*)(F.ws + WS_KCMP); const bf16* vcmp = (const bf16*)(F.ws + WS_VCMP);
    bf16* ya = (bf16*)(F.ws + WS_YA);
    LAS unsigned char* const RG = F.lds;
    LAS float* imp = (LAS float*)(F.lds + NRING * RB);
    LAS unsigned* selm = (LAS unsigned*)(F.lds + NRING * RB + 32768); LAS unsigned* uml = selm + 256;
    static_assert(NRING * RB + 32768 + 1024 + 16 <= LDSCTL_OFF && NRING * RB + 32768 == 4 * RB, "nsa LDS map (the selected loop's pair buffers overlay ring + importance table)");
    const float c2 = 0.08838834764831845f * 1.4426950408889634f;
    (void)A; (void)layer;
#if defined(NSA_PRIO)
    if (F.wave < 4) __builtin_amdgcn_s_setprio(2); else __builtin_amdgcn_s_setprio(0);
#endif
    for (int u = F.bid; u < 1024; u += F.G) {
        int tid_l = F.tid; asm volatile("" : "+v"(tid_l));
        const int tid = tid_l, lane = tid & 63, w = F.wave, i = lane & 15, qd = lane >> 4, hd = i & 3;
        const int klane = 16 * lane, vlane = 16384 + 8 * lane;
        const int xg = u & 7, jj = (u >> 3) & 31, rr = u >> 8;
        const int b = xg >> 2, g = xg & 3;
        const int qt = (rr == 0) ? 127 - jj : (rr == 1) ? 64 + jj : (rr == 2) ? 63 - jj : jj;
        const int s0 = qt * 64, cur = qt, rowb = b * SEQ;
        int ql[2], trow[2]; bf16x8 Qf[2][4];
#pragma unroll
        for (int s = 0; s < 2; ++s) { ql[s] = 8 * w + 4 * s + (i >> 2); trow[s] = rowb + s0 + ql[s];
#pragma unroll
            for (int ks = 0; ks < 4; ++ks) Qf[s][ks] = *(const bf16x8*)(proj + (size_t)trow[s] * LDP + C_Q + (4 * g + hd) * HD + 32 * ks + 8 * qd); }
        f32x4 O[2][8]; float mrow[2], lrow[2], cin[2], invl[2] = {0.f, 0.f};
        const int ntc = (4 * qt + 3 + 63) >> 6;
        const bf16* kc0 = kcmp + (size_t)(b * NG + g) * NCMP_PAD * HD; const bf16* vc0 = vcmp + (size_t)(b * NG + g) * NCMP_PAD * HD;
        int nmax[2];
#pragma unroll
        for (int s = 0; s < 2; ++s) { const int t = s0 + ql[s]; nmax[s] = (t >= 31) ? ((t - 31) >> 4) : -1; mrow[s] = -1e30f; lrow[s] = 0.f; cin[s] = 0.f; }
        for (int rep_ = 0; rep_ < (NSA_REP_PART == 2 ? 2 : 1); ++rep_) {
#pragma unroll
        for (int s = 0; s < 2; ++s) { mrow[s] = -1e30f; lrow[s] = 0.f; cin[s] = 0.f; }
        NSA_WAITV(0); NSA_BAR();
        tile_dma<false>(RG, kc0, vc0, HD, w, lane); if (ntc > 1) tile_dma<false>(RG + RB, kc0 + (size_t)64 * HD, vc0, HD, w, lane);
        for (int tc = 0, rb = 0; tc < ntc; ++tc) {
            if (tc + 1 < ntc) NSA_WAITV(2); else NSA_WAITV(0);
            NSA_BAR();
            if (tc + 2 < ntc) { const int nb2 = (rb + 2 >= NRING) ? rb + 2 - NRING : rb + 2; tile_dma<false>(RG + nb2 * RB, kc0 + (size_t)(tc + 2) * 64 * HD, vc0, HD, w, lane); }
            { const int lo2[2] = {0, 0}, hi2[2] = {nmax[0] - 64 * tc, nmax[1] - 64 * tc}; const bool nm = __ballot(hi2[0] < 63 || hi2[1] < 63) != 0ull;
              attn_tile<0, 3>(RG + rb * RB + klane, RG, Qf, O, mrow, lrow, lo2, hi2, nm, c2, invl, imp, ql, 0, cin, lane); }
            rb = (rb + 1 == NRING) ? 0 : rb + 1;
        }
#pragma unroll
        for (int s = 0; s < 2; ++s) { float lt = lrow[s]; lt = xq_sum(lt); invl[s] = (lt > 0.f) ? 1.0f / lt : 0.f;
#pragma unroll
            for (int dt = 0; dt < 8; ++dt) O[s][dt] = (f32x4){0.f, 0.f, 0.f, 0.f}; }
        NSA_BAR();
        tile_dma<true>(RG, kc0, vc0, HD, w, lane); if (ntc > 1) tile_dma<true>(RG + RB, kc0 + (size_t)64 * HD, vc0 + (size_t)64 * HD, HD, w, lane);
        for (int tc = 0, rb = 0; tc < ntc; ++tc) {
            if (tc + 1 < ntc) NSA_WAITV(4); else NSA_WAITV(0);
            NSA_BAR();
            if (tc + 2 < ntc) { const int nb2 = (rb + 2 >= NRING) ? rb + 2 - NRING : rb + 2; tile_dma<true>(RG + nb2 * RB, kc0 + (size_t)(tc + 2) * 64 * HD, vc0 + (size_t)(tc + 2) * 64 * HD, HD, w, lane); }
            { const int lo2[2] = {0, 0}, hi2[2] = {nmax[0] - 64 * tc, nmax[1] - 64 * tc}; const bool nm = __ballot(hi2[0] < 63 || hi2[1] < 63) != 0ull;
              attn_tile<2, 3>(RG + rb * RB + klane, RG + rb * RB + vlane, Qf, O, mrow, lrow, lo2, hi2, nm, c2, invl, imp, ql, 16 * tc, cin, lane); }
            rb = (rb + 1 == NRING) ? 0 : rb + 1;
        }
#pragma unroll
        for (int s = 0; s < 2; ++s) { const float gate = sigmoidf_(bf2f(proj[(size_t)trow[s] * LDP + C_GN + (4 * g + hd) * 3 + 0]));
            nsa_emit<true>(O[s], gate, ya + (size_t)trow[s] * DM + (4 * g + hd) * HD + 4 * qd); }
        }
        for (int rep_ = 0; rep_ < (NSA_REP_PART == 1 ? 2 : 1); ++rep_) {
            LDS_WAIT();
            const int nforced = (cur == 0) ? 1 : (cur == 1) ? 2 : 3; const int nsel = (cur + 1 < NSEL) ? cur + 1 : NSEL; const int R = nsel - nforced;
            const int E = (cur >= 3) ? cur - 2 : 0;
            for (int q8 = 0; q8 < 8; ++q8) {
                const int q = 8 * w + q8;
                const int j0 = lane, j1 = lane + 64;
                const bool e0 = (j0 >= 1) && (j0 <= cur - 2), e1 = (j1 <= cur - 2);
                const bool f0 = (j0 == 0) || (j0 == cur) || (j0 == cur - 1), f1 = (j1 == cur) || (j1 == cur - 1);
                bool s0 = e0, s1 = e1;
                if (R < E) {
                    const unsigned k0 = e0 ? __builtin_bit_cast(unsigned, imp[q * 128 + j0]) + 1u : 0u, k1 = e1 ? __builtin_bit_cast(unsigned, imp[q * 128 + j1]) + 1u : 0u;
                    unsigned T = 0u;
#pragma unroll 1
                    for (int bit = 30; bit >= 0; --bit) { const unsigned c = T | (1u << bit);
                        const int n = __builtin_popcountll(__ballot(k0 >= c)) + __builtin_popcountll(__ballot(k1 >= c));
                        if (n >= R) T = c; }
                    const unsigned long long eq0 = __ballot(k0 == T), eq1 = __ballot(k1 == T);
                    const int G = __builtin_popcountll(__ballot(k0 > T)) + __builtin_popcountll(__ballot(k1 > T));
                    const unsigned long long lt = (1ull << lane) - 1ull;
                    const int r0 = __builtin_popcountll(eq0 & lt), r1 = __builtin_popcountll(eq0) + __builtin_popcountll(eq1 & lt);
                    s0 = (k0 > T) || (k0 == T && r0 < R - G); s1 = (k1 > T) || (k1 == T && r1 < R - G);
                }
                const unsigned long long m0 = __ballot(f0 || s0), m1 = __ballot(f1 || s1);
                if (lane == 0) { selm[q * 4 + 0] = (unsigned)m0; selm[q * 4 + 1] = (unsigned)(m0 >> 32); selm[q * 4 + 2] = (unsigned)m1; selm[q * 4 + 3] = (unsigned)(m1 >> 32); }
            }
            __syncthreads();
            if (w == 0) { unsigned x0 = selm[lane * 4 + 0], x1 = selm[lane * 4 + 1], x2 = selm[lane * 4 + 2], x3 = selm[lane * 4 + 3];
#pragma unroll
                for (int o = 1; o < 64; o <<= 1) { x0 |= shfl_idx_u(x0, lane ^ o); x1 |= shfl_idx_u(x1, lane ^ o); x2 |= shfl_idx_u(x2, lane ^ o); x3 |= shfl_idx_u(x3, lane ^ o); }
                if (lane == 0) { uml[0] = x0; uml[1] = x1; uml[2] = x2; uml[3] = x3; } }
            __syncthreads();
        }
        const unsigned um0 = __builtin_amdgcn_readfirstlane(uml[0]), um1 = __builtin_amdgcn_readfirstlane(uml[1]), um2 = __builtin_amdgcn_readfirstlane(uml[2]), um3 = __builtin_amdgcn_readfirstlane(uml[3]);
        for (int rep_ = 0; rep_ < (NSA_REP_PART == 3 ? 2 : 1); ++rep_) {
            const bf16* ks0 = (const bf16*)(F.ws + WS_KV) + kv_off(2, b, g, 0); const bf16* vs0 = (const bf16*)(F.ws + WS_KV) + kv_off(3, b, g, 0);
#pragma unroll
            for (int s = 0; s < 2; ++s) { mrow[s] = -1e30f; lrow[s] = 0.f;
#pragma unroll
                for (int dt = 0; dt < 8; ++dt) O[s][dt] = (f32x4){0.f, 0.f, 0.f, 0.f}; }
#if NSA_REP_PART == 11
            {
            int jaD = next_bit(um0, um1, um2, um3, 0), jbD = next_bit(um0, um1, um2, um3, jaD + 1), pbD = 0;
            VM_WAIT(); if (NSA_REP_PART == 3) NSA_BAR();
            tile_dma<true>(RG, ks0 + (size_t)jaD * 64 * HD, vs0 + (size_t)jaD * 64 * HD, HD, w, lane); SELDUP(tile_dma<true>(RG, ks0 + (size_t)jaD * 64 * HD, vs0 + (size_t)jaD * 64 * HD, HD, w, lane);)
            if (jbD >= 0) tile_dma<true>(RG + RB, ks0 + (size_t)jbD * 64 * HD, vs0 + (size_t)jbD * 64 * HD, HD, w, lane); SELDUP(tile_dma<true>(RG + RB, ks0 + (size_t)jbD * 64 * HD, vs0 + (size_t)jbD * 64 * HD, HD, w, lane);)
            while (jaD >= 0) {
                const int jcD = (jbD >= 0) ? next_bit(um0, um1, um2, um3, jbD + 1) : -1, jdD = (jcD >= 0) ? next_bit(um0, um1, um2, um3, jcD + 1) : -1;
                NSA_WAITV(0);
                NSA_BAR();
                if (jcD >= 0) { LAS unsigned char* nb = RG + (pbD ^ 1) * 2 * RB; tile_dma<true>(nb, ks0 + (size_t)jcD * 64 * HD, vs0 + (size_t)jcD * 64 * HD, HD, w, lane); SELDUP(tile_dma<true>(nb, ks0 + (size_t)jcD * 64 * HD, vs0 + (size_t)jcD * 64 * HD, HD, w, lane);)
                    if (jdD >= 0) tile_dma<true>(nb + RB, ks0 + (size_t)jdD * 64 * HD, vs0 + (size_t)jdD * 64 * HD, HD, w, lane); SELDUP(tile_dma<true>(nb + RB, ks0 + (size_t)jdD * 64 * HD, vs0 + (size_t)jdD * 64 * HD, HD, w, lane);) }
                jaD = jcD; jbD = jdD; pbD ^= 1;
            }
            NSA_BAR();
            }
#endif
            int ja = next_bit(um0, um1, um2, um3, 0), jbb = next_bit(um0, um1, um2, um3, ja + 1), pbuf = 0;
            VM_WAIT(); if (NSA_REP_PART == 3) NSA_BAR();
            tile_dma<true>(RG, ks0 + (size_t)ja * 64 * HD, vs0 + (size_t)ja * 64 * HD, HD, w, lane); SELDUP(tile_dma<true>(RG, ks0 + (size_t)ja * 64 * HD, vs0 + (size_t)ja * 64 * HD, HD, w, lane);)
            if (jbb >= 0) tile_dma<true>(RG + RB, ks0 + (size_t)jbb * 64 * HD, vs0 + (size_t)jbb * 64 * HD, HD, w, lane); SELDUP(tile_dma<true>(RG + RB, ks0 + (size_t)jbb * 64 * HD, vs0 + (size_t)jbb * 64 * HD, HD, w, lane);)
            while (ja >= 0) {
                const int jc = (jbb >= 0) ? next_bit(um0, um1, um2, um3, jbb + 1) : -1, jd = (jc >= 0) ? next_bit(um0, um1, um2, um3, jc + 1) : -1;
                NSA_WAITV(0);
                NSA_BAR();
                if (jc >= 0) { LAS unsigned char* nb = RG + (pbuf ^ 1) * 2 * RB; tile_dma<true>(nb, ks0 + (size_t)jc * 64 * HD, vs0 + (size_t)jc * 64 * HD, HD, w, lane); SELDUP(tile_dma<true>(nb, ks0 + (size_t)jc * 64 * HD, vs0 + (size_t)jc * 64 * HD, HD, w, lane);)
                    if (jd >= 0) tile_dma<true>(nb + RB, ks0 + (size_t)jd * 64 * HD, vs0 + (size_t)jd * 64 * HD, HD, w, lane); SELDUP(tile_dma<true>(nb + RB, ks0 + (size_t)jd * 64 * HD, vs0 + (size_t)jd * 64 * HD, HD, w, lane);) }
#pragma unroll 1
                for (int e2 = 0; e2 < 2; ++e2) { const int jb = e2 ? jbb : ja; if (jb < 0) break;
                  const bool act0 = (selm[ql[0] * 4 + (jb >> 5)] >> (jb & 31)) & 1u, act1 = (selm[ql[1] * 4 + (jb >> 5)] >> (jb & 31)) & 1u;
                  const bool any0 = __ballot(act0) != 0ull, any1 = __ballot(act1) != 0ull;
                  const int lo2[2] = {0, 0}, hi2[2] = {act0 ? ((jb < cur) ? 63 : ql[0]) : -1, act1 ? ((jb < cur) ? 63 : ql[1]) : -1};
                  LAS const unsigned char* kt = RG + (pbuf * 2 + e2) * RB + klane; LAS const unsigned char* vt = RG + (pbuf * 2 + e2) * RB + vlane;
                  if (any0 && any1) { const bool nm = __ballot(hi2[0] < 63 || hi2[1] < 63) != 0ull; attn_tile<1, 3>(kt, vt, Qf, O, mrow, lrow, lo2, hi2, nm, c2, invl, imp, ql, 0, cin, lane); }
                  else if (any0) { const bool nm = __ballot(hi2[0] < 63) != 0ull; attn_tile<1, 1>(kt, vt, Qf, O, mrow, lrow, lo2, hi2, nm, c2, invl, imp, ql, 0, cin, lane); }
                  else if (any1) { const bool nm = __ballot(hi2[1] < 63) != 0ull; attn_tile<1, 2>(kt, vt, Qf, O, mrow, lrow, lo2, hi2, nm, c2, invl, imp, ql, 0, cin, lane); } }
                ja = jc; jbb = jd; pbuf ^= 1;
            }
            NSA_BAR();
#pragma unroll
            for (int s = 0; s < 2; ++s) { float lt = lrow[s]; lt = xq_sum(lt);
                const float gate = sigmoidf_(bf2f(proj[(size_t)trow[s] * LDP + C_GN + (4 * g + hd) * 3 + 1]));
                if (rep_ == 0) nsa_emit<false>(O[s], (lt > 0.f) ? gate / lt : 0.f, ya + (size_t)trow[s] * DM + (4 * g + hd) * HD + 4 * qd); }
        }
        for (int rep_ = 0; rep_ < (NSA_REP_PART == 4 ? 2 : 1); ++rep_) {
            const bf16* kw0 = (const bf16*)(F.ws + WS_KV) + kv_off(4, b, g, 0); const bf16* vw0 = (const bf16*)(F.ws + WS_KV) + kv_off(5, b, g, 0);
#pragma unroll
            for (int s = 0; s < 2; ++s) { mrow[s] = -1e30f; lrow[s] = 0.f;
#pragma unroll
                for (int dt = 0; dt < 8; ++dt) O[s][dt] = (f32x4){0.f, 0.f, 0.f, 0.f}; }
#if NSA_REP_PART == 8
            {
            const int tt0d = (qt >= 8) ? 0 : 8 - qt;
            VM_WAIT(); NSA_BAR();
            { const size_t r0 = (size_t)(s0 - 512 + 64 * tt0d) * HD; tile_dma<true>(RG, kw0 + r0, vw0 + r0, HD, w, lane); W7DUP(tile_dma<true>(RG, kw0 + r0, vw0 + r0, HD, w, lane);) }
            if (tt0d < 8) { const size_t r0 = (size_t)(s0 - 512 + 64 * (tt0d + 1)) * HD; tile_dma<true>(RG + RB, kw0 + r0, vw0 + r0, HD, w, lane); W7DUP(tile_dma<true>(RG + RB, kw0 + r0, vw0 + r0, HD, w, lane);) }
            for (int tt = tt0d, rb = 0; tt <= 8; ++tt) {
                if (tt < 8) { W7WAIT(); } else NSA_WAITV(0);
                NSA_BAR();
                if (tt + 2 <= 8) { const int nb2 = (rb + 2 >= NRING) ? rb + 2 - NRING : rb + 2; const size_t r0 = (size_t)(s0 - 512 + 64 * (tt + 2)) * HD; tile_dma<true>(RG + nb2 * RB, kw0 + r0, vw0 + r0, HD, w, lane); W7DUP(tile_dma<true>(RG + nb2 * RB, kw0 + r0, vw0 + r0, HD, w, lane);) }
                rb = (rb + 1 == NRING) ? 0 : rb + 1;
            }
            }
#endif
            const int tt0 = (qt >= 8) ? 0 : 8 - qt;
            VM_WAIT(); NSA_BAR();
            { const size_t r0 = (size_t)(s0 - 512 + 64 * tt0) * HD; tile_dma<true>(RG, kw0 + r0, vw0 + r0, HD, w, lane); W7DUP(tile_dma<true>(RG, kw0 + r0, vw0 + r0, HD, w, lane);) }
            if (tt0 < 8) { const size_t r0 = (size_t)(s0 - 512 + 64 * (tt0 + 1)) * HD; tile_dma<true>(RG + RB, kw0 + r0, vw0 + r0, HD, w, lane); W7DUP(tile_dma<true>(RG + RB, kw0 + r0, vw0 + r0, HD, w, lane);) }
            for (int tt = tt0, rb = 0; tt <= 8; ++tt) {
                if (tt < 8) { W7WAIT(); } else NSA_WAITV(0);
                NSA_BAR();
                if (tt + 2 <= 8) { const int nb2 = (rb + 2 >= NRING) ? rb + 2 - NRING : rb + 2; const size_t r0 = (size_t)(s0 - 512 + 64 * (tt + 2)) * HD; tile_dma<true>(RG + nb2 * RB, kw0 + r0, vw0 + r0, HD, w, lane); W7DUP(tile_dma<true>(RG + nb2 * RB, kw0 + r0, vw0 + r0, HD, w, lane);) }
                { const int lo2[2] = {(tt == 0) ? ql[0] + 1 : 0, (tt == 0) ? ql[1] + 1 : 0}, hi2[2] = {(tt == 8) ? ql[0] : 63, (tt == 8) ? ql[1] : 63};
                  attn_tile<1, 3>(RG + rb * RB + klane, RG + rb * RB + vlane, Qf, O, mrow, lrow, lo2, hi2, (tt == 0) || (tt == 8), c2, invl, imp, ql, 0, cin, lane);
#if NSA_REP_PART == 5
                  { const int him[2] = {-1, -1}; attn_tile<1, 3>(RG + rb * RB + klane, RG + rb * RB + vlane, Qf, O, mrow, lrow, lo2, him, true, c2, invl, imp, ql, 0, cin, lane); }
#endif
#if NSA_REP_PART == 6
                  NSA_BAR(); NSA_BAR(); NSA_BAR(); NSA_BAR();
#endif
                }
                rb = (rb + 1 == NRING) ? 0 : rb + 1;
            }
            VM_WAIT();
#pragma unroll
            for (int s = 0; s < 2; ++s) { float lt = lrow[s]; lt = xq_sum(lt);
                const float gate = sigmoidf_(bf2f(proj[(size_t)trow[s] * LDP + C_GN + (4 * g + hd) * 3 + 2]));
                if (rep_ == 0) nsa_emit<false>(O[s], (lt > 0.f) ? gate / lt : 0.f, ya + (size_t)trow[s] * DM + (4 * g + hd) * HD + 4 * qd); }
        }
        __syncthreads();
    }
    __builtin_amdgcn_s_setprio(0);
}

#if defined(CHECK_BUILD) && CHECK_BUILD
DI unsigned hash_u(unsigned x) { x ^= x >> 16; x *= 0x7feb352du; x ^= x >> 15; x *= 0x846ca68bu; x ^= x >> 16; return x; }
DI float blk_sum(float v, LAS float* red, int tid, int nthr) {
    for (int o = 32; o >= 1; o >>= 1) v += __shfl_xor(v, o);
    __syncthreads(); if ((tid & 63) == 0) red[tid >> 6] = v; __syncthreads();
    float s = 0.f; for (int k = 0; k < nthr / 64; ++k) s += red[k]; __syncthreads(); return s;
}
__global__ void chk_proj(Args args) {
    const int lane = threadIdx.x & 63, smp = blockIdx.x * (blockDim.x >> 6) + (threadIdx.x >> 6);
    const bf16* hb = (const bf16*)(args.ws + WS_HB); const bf16* proj = (const bf16*)(args.ws + WS_PROJ); const float* win = (const float*)args.in[4]; const int* pos = (const int*)args.in[2];
    unsigned* res = (unsigned*)(args.ws + WS_CTL) + CW_CHK;
    const unsigned h = hash_u(smp * 2654435761u + 12345u);
    int row = h % M; if (smp < 4) row = (smp == 0) ? 0 : (smp == 1) ? 8191 : (smp == 2) ? 8192 : 16383;
    const int kind = smp % 15; const unsigned h2 = hash_u(h + 77u);
    const int srcb[15] = {0, 2048, 2560, 3072, 3584, 4096, 4608, 5120, 5168, 7216, 9264, 11312, 13360, 16432, 16464};
    const int dstb[15] = {C_Q, C_KC, C_VC, C_KS, C_VS, C_KW, C_VW, C_GN, C_CB, C_CC, C_CU, C_Z, C_XBC, C_DT, C_GM};
    const int wid[15] = {2048, 512, 512, 512, 512, 512, 512, 48, 2048, 2048, 2048, 2048, 3072, 32, 6144};
    const bool rope = (kind == 0 || kind == 1 || kind == 3 || kind == 5);
    int e = h2 % wid[kind]; if (rope) e = (e / 128) * 128 + (e % 64);
    float d0 = 0.f, d1 = 0.f;
    for (int k = lane; k < DM; k += 64) { const float a = bf2f(hb[(size_t)row * DM + k]); d0 += a * win[(size_t)k * PROJ_SRC + srcb[kind] + e]; if (rope) d1 += a * win[(size_t)k * PROJ_SRC + srcb[kind] + e + 64]; }
    for (int o = 32; o >= 1; o >>= 1) { d0 += __shfl_xor(d0, o); d1 += __shfl_xor(d1, o); }
    float e0 = d0, e1 = d1;
    if (rope) { const double inv = exp(-(double)(2 * (e % 64)) / 128.0 * 9.210340371976184); double ang = (double)pos[row] * inv; ang -= 6.283185307179586476925 * __builtin_rint(ang * 0.15915494309189533577); const float c = cosf((float)ang), s = sinf((float)ang); e0 = d0 * c - d1 * s; e1 = d1 * c + d0 * s; }
    if (lane == 0) {
        const bf16* kvb = (const bf16*)(args.ws + WS_KV);
        const bool inkv = (kind >= 1 && kind <= 6);
        const bf16* src = inkv ? kvb + kv_off(kind - 1, row >> 13, e >> 7, row & 8191) + (e & 127) : proj + (size_t)row * LDP + dstb[kind] + e;
        const float g0 = bf2f(src[0]); float err = fabsf(g0 - e0) / (0.03f + 0.02f * fabsf(e0));
        if (rope) { const float g1 = bf2f(src[64]); err = fmaxf(err, fabsf(g1 - e1) / (0.03f + 0.02f * fabsf(e1))); }
        if (!(err <= 1.0f)) atomicAdd(res + 0, 1u);
        atomicMax(res + 1, __float_as_uint(fminf(err, 1e6f)));
    }
}
__global__ void chk_cmp(Args args) {
    __shared__ float hid[128];
    const int tid = threadIdx.x, smp = blockIdx.x;
    const unsigned h = hash_u(smp * 40503u + 99u);
    const int kv = smp & 1, b = (smp >> 1) & 1, g = (smp >> 2) & 3; int n = h % NCMP; if (smp < 8) n = (smp < 4) ? 0 : 510;
    const bf16* proj = (const bf16*)(args.ws + WS_PROJ);
    const float* pe = (const float*)args.in[kv ? 6 : 5]; const float* w1 = (const float*)args.in[kv ? 11 : 7]; const float* b1 = (const float*)args.in[kv ? 12 : 8];
    const float* w2 = (const float*)args.in[kv ? 13 : 9]; const float* b2 = (const float*)args.in[kv ? 14 : 10];
    const bf16* out = (const bf16*)(args.ws + (kv ? WS_VCMP : WS_KCMP));
    unsigned* res = (unsigned*)(args.ws + WS_CTL) + CW_CHK;
    float s = b1[tid];
    for (int l = 0; l < 32; ++l) { const bf16* kr = (const bf16*)(args.ws + WS_KV) + kv_off(kv, b, g, 16 * n + l);
        for (int d = 0; d < 128; ++d) s += (bf2f(kr[d]) + pe[l * 128 + d]) * w1[(size_t)(l * 128 + d) * 128 + tid]; }
    hid[tid] = s / (1.0f + expf(-s));
    __syncthreads();
    float o = b2[tid];
    for (int k = 0; k < 128; ++k) o += hid[k] * w2[k * 128 + tid];
    const float got = bf2f(out[((size_t)(b * NG + g) * NCMP_PAD + n) * HD + tid]);
    const float err = fabsf(got - o) / (0.02f + 0.02f * fabsf(o));
    if (!(err <= 1.0f)) atomicAdd(res + 2, 1u);
    atomicMax(res + 3, __float_as_uint(fminf(err, 1e6f)));
}
constexpr int CHK_NT = 24;
__global__ void __launch_bounds__(256) chk_nsa(Args args) {
    __shared__ float qf[4][128], oacc[4][128], obr[4][128], sc[4][1024], imp[128], red[8];
    __shared__ int kl[1024], seln[16], usedl[128];
    const int tlist[CHK_NT] = {0, 1, 30, 31, 47, 63, 64, 65, 127, 128, 500, 511, 512, 513, 575, 1023, 1024, 1087, 2000, 4095, 4096, 6000, 8128, 8191};
    const int tid = threadIdx.x, smp = blockIdx.x;
    const int t = tlist[smp % CHK_NT], bg = (smp / CHK_NT + smp) & 7, b = bg >> 2, g = bg & 3, row = b * SEQ + t, cur = t >> 6;
    const bf16* proj = (const bf16*)(args.ws + WS_PROJ); const bf16* kcmp = (const bf16*)(args.ws + WS_KCMP) + (size_t)(b * NG + g) * NCMP_PAD * HD; const bf16* vcmp = (const bf16*)(args.ws + WS_VCMP) + (size_t)(b * NG + g) * NCMP_PAD * HD;
    const bf16* ya = (const bf16*)(args.ws + WS_YA);
    unsigned* res = (unsigned*)(args.ws + WS_CTL) + CW_CHK;
    const float scale = 0.08838834764831845f;
    for (int k = tid; k < 512; k += 256) { const int r = k >> 7, d = k & 127; qf[r][d] = bf2f(proj[(size_t)row * LDP + C_Q + (4 * g + r) * HD + d]); oacc[r][d] = 0.f; }
    __syncthreads();
    for (int br = 0; br < 3; ++br) {
        int nk = 0;
        if (br == 0) { nk = (t >= 31) ? ((t - 31) >> 4) + 1 : 0; for (int k = tid; k < nk; k += 256) kl[k] = k; }
        else if (br == 1) {
            if (tid == 0) {
                for (int j = 0; j < 128; ++j) usedl[j] = 0;
                for (int it = 0; it < 16; ++it) { int best = -1; float bv = 0.f;
                    for (int j = 0; j < 128; ++j) { if (usedl[j]) continue; const bool valid = (64 * j <= t); const bool forced = (j == 0) || (j == cur) || (j == cur - 1);
                        const float v = valid ? imp[j] + (forced ? 1.0e4f : 0.f) : -__builtin_inff();
                        if (best < 0 || v > bv) { best = j; bv = v; } }
                    usedl[best] = 1; seln[it] = best; } }
            __syncthreads();
            for (int k = tid; k < 1024; k += 256) kl[k] = seln[k >> 6] * 64 + (k & 63);
            nk = 1024;
        } else { nk = 576; for (int k = tid; k < 576; k += 256) kl[k] = (t & ~63) - WIN + k; }
        __syncthreads();
        for (int idx = tid; idx < 4 * nk; idx += 256) { const int r = idx / nk, k = idx - r * nk, key = kl[k];
            bool ok; const bf16* kp;
            if (br == 0) { ok = true; kp = kcmp + (size_t)key * HD; }
            else if (br == 1) { ok = (key <= t); kp = (const bf16*)(args.ws + WS_KV) + kv_off(2, b, g, key); }
            else { ok = (key >= 0) && (key <= t) && (key > t - WIN); kp = (const bf16*)(args.ws + WS_KV) + kv_off(4, b, g, key < 0 ? 0 : key); }
            float s = 0.f; for (int d = 0; d < 128; ++d) s += qf[r][d] * bf2f(kp[d]);
            sc[r][k] = ok ? s * scale : -__builtin_inff(); }
        __syncthreads();
        if (tid < 4) { float m = -__builtin_inff(); for (int k = 0; k < nk; ++k) m = fmaxf(m, sc[tid][k]);
            const float mm = (m > -1e30f) ? m : 0.f; float l = 0.f; for (int k = 0; k < nk; ++k) { const float e = (sc[tid][k] > -1e30f) ? expf(sc[tid][k] - mm) : 0.f; sc[tid][k] = e; l += e; }
            const float il = (l > 0.f) ? 1.0f / l : 0.f; for (int k = 0; k < nk; ++k) sc[tid][k] *= il; }
        __syncthreads();
        if (br == 0) { if (tid < 128) { float s = 0.f; for (int r = 0; r < 4; ++r) for (int n = 4 * tid - 1; n <= 4 * tid + 3; ++n) if (n >= 0 && n < nk) s += sc[r][n]; imp[tid] = s; } }
        for (int o = tid; o < 512; o += 256) { const int r = o >> 7, d = o & 127; float s = 0.f;
            for (int k = 0; k < nk; ++k) { const float p = sc[r][k]; if (p == 0.f) continue; const int key = kl[k];
                const bf16* vp = (br == 0) ? vcmp + (size_t)key * HD : (const bf16*)(args.ws + WS_KV) + kv_off(br == 1 ? 3 : 5, b, g, key);
                s += p * bf2f(vp[d]); }
            const float gate = 1.0f / (1.0f + expf(-bf2f(proj[(size_t)row * LDP + C_GN + (4 * g + r) * 3 + br])));
            oacc[r][d] += gate * s; obr[r][d] = s; }
        __syncthreads();
    }
    float errm = 0.f;
    for (int o = tid; o < 512; o += 256) { const int r = o >> 7, d = o & 127; const float got = bf2f(ya[(size_t)row * DM + (4 * g + r) * HD + d]), ex = oacc[r][d] * (CHECK_BUILD == 2 ? ((smp & 1) ? 1.5f : 1.0f) : 1.0f);
        errm = fmaxf(errm, fabsf(got - ex) / (0.006f + 0.03f * fabsf(ex))); }
    for (int o = 32; o >= 1; o >>= 1) errm = fmaxf(errm, __shfl_xor(errm, o));
    if ((tid & 63) == 0) red[tid >> 6] = errm;
    __syncthreads();
    if (tid == 0) { const float e = fmaxf(fmaxf(red[0], red[1]), fmaxf(red[2], red[3])); if (!(e <= 1.0f)) atomicAdd(res + 4, 1u); atomicMax(res + 5, __float_as_uint(fminf(e, 1e6f))); }
}
#ifndef CHK_B_SEL
#define CHK_B_SEL 5
#endif
__global__ void chk_report(Args args) {
    const unsigned* res = (const unsigned*)(args.ws + WS_CTL) + CW_CHK;
    const float A = 4.0f * (float)res[4] + (res[2] ? 2000.f : 0.f) + (res[0] ? 40000.f : 0.f);
    const float B = fminf(__uint_as_float(res[CHK_B_SEL]), 100.f);
    const size_t i = (size_t)blockIdx.x * blockDim.x + threadIdx.x;
    if (A > 0.f) { if (i == 0) args.out[0] += A; if (i >= 1 && i <= (1u << 20)) args.out[i] += B; }
}
#endif

constexpr int NPH_LAYER = 13, NPH = 2 + NPH_LAYER * DEPTH;
#ifndef PG8_SP2
#define PG8_SP2 true
#endif
#ifndef PG8_ALIGN
#define PG8_ALIGN true
#endif
#ifndef PH_MASK
#define PH_MASK 0xFFFFFFFFu
#endif
#ifndef REP_MASK
#define REP_MASK 0u
#endif
#ifndef REP_CNT
#define REP_CNT 2
#endif
#define REPN(kk) ((((unsigned)REP_MASK >> (kk)) & 1u) ? REP_CNT : 1)
#define INK(k, kk) (((PH_MASK >> (kk)) & 1u) && lo <= (k) && (k) < hi)
#if defined(TIME_PROBE)
#define STAMP(i) do { if (F.bid == 0 && F.tid == 0) ((unsigned long long*)(F.ctl + CW_TS))[i] = __builtin_amdgcn_s_memrealtime(); } while (0)
#else
#define STAMP(i) do { } while (0)
#endif
#if defined(BAR_TWICE)
#define SEAM_TWICE(x) x
#else
#define SEAM_TWICE(x)
#endif
#define SEAM(k) do { if (lo <= (k) && (k) + 1 < hi) { XcdBarrier b_ = bar; { unsigned long long p_ = (unsigned long long)bar.bar; asm volatile("" : "+s"(p_)); b_.bar = (unsigned*)p_; } xcd_barrier(b_); SEAM_TWICE(xcd_barrier(b_);) } STAMP((k) + 1); } while (0)
template <int LAYER> DI void g1_block(const Frame& F, const Args& args) {
    constexpr int layer = LAYER;
    bf16* hb = (bf16*)(F.ws + WS_HB); bf16* projb = (bf16*)(F.ws + WS_PROJ); bf16* eb = (bf16*)(F.ws + WS_EB);
#ifndef NO_G1
            { const Frame Fp = phase_frame(F);  pg8::Gemm g{hb, (const bf16*)lw_ptr(Fp, layer, LW_IN), M, LDP, DM}; pg8::StaticOrder S; S.init(M, LDP, Fp.G, Fp.bid);
              pg8::EpiB<2> E{projb, LDP, (const float*)(Fp.ws + WS_ROPE), (bf16*)(Fp.ws + WS_KV)};
              pg8::gemm_phase<pg8::EpiB<2>, pg8::StaticOrder, PG8_ALIGN, PG8_SP2>(Fp.lds, g, S, E, Fp.wave); }
#endif
#ifndef NO_G5
            { const Frame Fp = phase_frame(F);  pg8::Gemm g{(const bf16*)(Fp.ws + WS_PB) + (size_t)layer * M * PLE, (const bf16*)lw_ptr(Fp, layer, LW_PLE), M, DM, PLE}; pg8::LightOrder S; S.init(M, DM, Fp.G, Fp.bid);
              pg8::EpiB<0> E{eb, DM, nullptr, nullptr};
              pg8::gemm_phase<pg8::EpiB<0>, pg8::LightOrder, PG8_ALIGN, PG8_SP2>(Fp.lds, g, S, E, Fp.wave); }
#endif
}
template <int LAYER> DI void layer_phases(const Frame& F, const Args& args, const XcdBarrier& bar, const int lo, const int hi) {
    constexpr int layer = LAYER, layer_ = LAYER;
    float* xres = (float*)(F.ws + WS_X); bf16* hb = (bf16*)(F.ws + WS_HB); bf16* projb = (bf16*)(F.ws + WS_PROJ); bf16* ub = (bf16*)(F.ws + WS_U); bf16* eb = (bf16*)(F.ws + WS_EB);
        const int pb = 1 + NPH_LAYER * layer;
        const float* xin = (layer == 0) ? (const float*)argin(args, 0) : (const float*)xres;
        if (INK(pb + 0, 0)) { if (layer == 0) norm_rows<false>(F, xin, (const float*)argin(args, 3), hb);
                              else addnorm_rows<false>(F, xres, (const bf16*)(F.ws + WS_DELTA), (const float*)argin(args, 3) + (size_t)layer * DM, xres, hb); }
        SEAM(pb + 0);
        if (INK(pb + 1, 1)) { g1_block<LAYER>(F, args); if (REPN(1) >= 2) g1_block<LAYER>(F, args); }
        SEAM(pb + 1);
        if (INK(pb + 2, 2)) for (int rep = 0; rep < REPN(2); ++rep) { ssd_conv_pass(F, args, layer); compress_phase(F, args, layer); }
        SEAM(pb + 2);
        if (INK(pb + 3, 3)) for (int rep = 0; rep < REPN(3); ++rep) ssd_states_phase(F, args, layer);
        SEAM(pb + 3);
        if (INK(pb + 4, 4)) for (int rep = 0; rep < REPN(4); ++rep) ssd_scan_phase(F);
        SEAM(pb + 4);
        if (INK(pb + 5, 5)) {
#ifndef NO_S3
            for (int rep = 0; rep < REPN(15); ++rep) ssd_out_phase(F, args, layer);
#endif
            STAMP(60 + layer);
#ifndef NO_NSA
            for (int rep = 0; rep < REPN(5); ++rep) nsa_phase(F, args, layer);
#endif
        }
        SEAM(pb + 5);
        if (INK(pb + 6, 6)) for (int rep = 0; rep < REPN(6); ++rep) merge_pass(F, args, layer);
        SEAM(pb + 6);
        if (INK(pb + 7, 7)) for (int rep = 0; rep < REPN(7); ++rep) { const Frame Fp = phase_frame(F);  pg8::Gemm g{hb, (const bf16*)lw_ptr(Fp, layer, LW_O), M, DM, DM}; pg8::StaticOrder S; S.init(M, DM, Fp.G, Fp.bid);
            pg8::EpiB<0> E{(bf16*)(Fp.ws + WS_DELTA), DM, nullptr, nullptr};
            pg8::gemm_phase<pg8::EpiB<0>, pg8::StaticOrder, PG8_ALIGN, PG8_SP2>(Fp.lds, g, S, E, Fp.wave); }
        SEAM(pb + 7);
        if (INK(pb + 8, 8)) for (int rep = 0; rep < REPN(8); ++rep) addnorm_rows<false>(F, xin, (const bf16*)(F.ws + WS_DELTA), (const float*)argin(args, 23) + (size_t)layer * DM, rep ? (float*)(F.ws + WS_ST) : xres, rep ? (bf16*)(F.ws + WS_ST + 128 * MiB - 64 * MiB) : hb);
        SEAM(pb + 8);
        if (INK(pb + 9, 9)) for (int rep = 0; rep < REPN(9); ++rep) { const Frame Fp = phase_frame(F);  pg8::Gemm g{hb, (const bf16*)lw_ptr(Fp, layer, LW_UP), M, DFF, DM}; pg8::StaticOrder S; S.init(M, DFF, Fp.G, Fp.bid);
            pg8::EpiB<1> E{ub, DFF, nullptr, nullptr};
            pg8::gemm_phase<pg8::EpiB<1>, pg8::StaticOrder, PG8_ALIGN, PG8_SP2>(Fp.lds, g, S, E, Fp.wave); }
        SEAM(pb + 9);
        if (INK(pb + 10, 10)) for (int rep = 0; rep < REPN(10); ++rep) { const Frame Fp = phase_frame(F);  pg8::Gemm g{ub, (const bf16*)lw_ptr(Fp, layer, LW_DOWN), M, DM, DFF}; pg8::StaticOrder S; S.init(M, DM, Fp.G, Fp.bid);
            pg8::EpiB<0> E{(bf16*)(Fp.ws + WS_DELTA), DM, nullptr, nullptr};
            pg8::gemm_phase<pg8::EpiB<0>, pg8::StaticOrder, PG8_ALIGN, PG8_SP2>(Fp.lds, g, S, E, Fp.wave); }
        SEAM(pb + 10);
        if (INK(pb + 11, 11)) addnorm_rows<false>(F, xres, (const bf16*)(F.ws + WS_DELTA), (const float*)argin(args, 26) + (size_t)layer * DM, xres, hb);
        SEAM(pb + 11);
        if (INK(pb + 12, 12)) for (int rep = 0; rep < REPN(12); ++rep) { const Frame Fp = phase_frame(F);  pg8::Gemm g{hb, (const bf16*)lw_ptr(Fp, layer, LW_PG), M, DM, DM}; pg8::StaticOrder S; S.init(M, DM, Fp.G, Fp.bid);
            pg8::EpiB<3> E{(bf16*)(Fp.ws + WS_DELTA), DM, (const float*)eb, nullptr};
            pg8::gemm_phase<pg8::EpiB<3>, pg8::StaticOrder, PG8_ALIGN, PG8_SP2>(Fp.lds, g, S, E, Fp.wave); }
        SEAM(pb + 12);
}
__global__ void __launch_bounds__(NTHR, 2) hyb_fwd(Args args) {
    extern __shared__ __attribute__((aligned(16))) unsigned char lds_raw[];
    Frame F;
    F.lds = (LAS unsigned char*)lds_raw; F.ws = args.ws; F.ctl = (gu32*)(args.ws + WS_CTL);
    F.tid = threadIdx.x; F.lane = F.tid & 63; F.wave = __builtin_amdgcn_readfirstlane(threadIdx.x >> 6); F.G = gridDim.x; F.bid = blockIdx.x;
    const int lo = args.ph_lo, hi = args.ph_hi;
    if (F.tid < 64) ((LAS unsigned*)(F.lds + LDSCTL_OFF))[F.tid] = 0u;
    __syncthreads();
    XcdBarrier bar; bar.bar = (unsigned*)(F.ctl + CW_BAR); bar.x = 0; bar.st = (volatile LAS unsigned*)(F.lds + LDSCTL_OFF);
    if (hi - lo > 1) bar = xcd_barrier_post((unsigned*)(F.ctl + CW_BAR), (volatile LAS unsigned*)(F.lds + LDSCTL_OFF));
    STAMP(0);
    if (INK(0, 13)) for (int rep = 0; rep < REPN(13); ++rep) p0_prologue(F, args);
    SEAM(0);
    layer_phases<0>(F, args, bar, lo, hi); layer_phases<1>(F, args, bar, lo, hi); layer_phases<2>(F, args, bar, lo, hi); layer_phases<3>(F, args, bar, lo, hi);
    float* xres = (float*)(F.ws + WS_X);
    int hi_l = hi; asm volatile("" : "+s"(hi_l));
    if (((PH_MASK >> 14) & 1u) && lo <= NPH - 1 && NPH - 1 < hi_l) addnorm_rows<true>(F, xres, (const bf16*)(F.ws + WS_DELTA), (const float*)argin(args, 29), nullptr, args.out);
#if defined(TIME_PROBE)
    { XcdBarrier b_ = bar; xcd_barrier(b_); STAMP(NPH);
      if (F.bid == 0) {
        LAS float* ab = (LAS float*)(F.lds);
        if (F.tid == 0) { const unsigned long long* ts = (const unsigned long long*)(F.ctl + CW_TS); float sum[17];
            float sA = 0.f, sB = 0.f;
            for (int ph = 0; ph < NPH; ++ph) { int kind = (ph == 0) ? 13 : (ph == NPH - 1) ? 14 : (ph - 1) % NPH_LAYER; float d = (float)(ts[ph + 1] - ts[ph]) * 0.01f;
                if (kind == 5) { const int L = (ph - 1) / NPH_LAYER; const float d3 = (float)(ts[60 + L] - ts[ph]) * 0.01f; if (TIME_PROBE_A == 15) sA += d3; if (TIME_PROBE_B == 15) sB += d3; d -= d3; }
                if (kind == TIME_PROBE_A || (TIME_PROBE_A == 16 && (kind == 0 || kind == 8 || kind == 11))) sA += d;
                if (kind == TIME_PROBE_B || (TIME_PROBE_B == 16 && (kind == 0 || kind == 8 || kind == 11))) sB += d; }
            ab[0] = sA; ab[1] = sB * 0.01f; (void)sum; }
        __syncthreads();
        const float A = ab[0], B = ab[1];
        if (F.tid == 0) args.out[0] += A;
        for (int j = 0; j < 2048; ++j) args.out[1 + F.tid + NTHR * j] += B;
      } }
#endif
#undef INK
#undef SEAM
}

#ifndef MK_ONE_LAUNCH
#define MK_ONE_LAUNCH 1
#endif
extern "C" void kernel_launch(void* const* d_in, const int* in_sizes, int n_in, void* d_out, int out_size, void* d_ws, size_t ws_size, hipStream_t stream) {
    static int grid = 0;
    if (grid == 0) {
        if (n_in != 30 || out_size != M * DM || ws_size < WS_END) { fprintf(stderr, "kernel_launch: unexpected shapes (n_in %d out %d ws %zu need %zu)\n", n_in, out_size, ws_size, (size_t)WS_END); grid = -1; return; }
        int dev = 0, cus = 0, per_cu = 0;
        if (hipGetDevice(&dev) != hipSuccess || hipDeviceGetAttribute(&cus, hipDeviceAttributeMultiprocessorCount, dev) != hipSuccess) { grid = -1; return; }
        if (hipFuncSetAttribute((const void*)hyb_fwd, hipFuncAttributeMaxDynamicSharedMemorySize, LDS_BYTES) != hipSuccess) { fprintf(stderr, "kernel_launch: hipFuncSetAttribute failed\n"); grid = -1; return; }
        if (hipOccupancyMaxActiveBlocksPerMultiprocessor(&per_cu, (const void*)hyb_fwd, NTHR, LDS_BYTES) != hipSuccess || per_cu < 1) { fprintf(stderr, "kernel_launch: occupancy query says %d\n", per_cu); }
        (void)hipGetLastError();
        grid = cus;
    }
    if (grid < 0) return;
    (void)hipMemsetAsync((char*)d_ws + WS_CTL, 0, CTL_ZERO_BYTES, stream);
    Args a{};
    for (int i = 0; i < 30; ++i) a.in[i] = d_in[i];
    a.out = (float*)d_out; a.ws = (unsigned char*)d_ws;
#if MK_ONE_LAUNCH
    a.ph_lo = 0; a.ph_hi = NPH;
    hipLaunchKernelGGL(hyb_fwd, dim3(grid), dim3(NTHR), LDS_BYTES, stream, a);
#else
    for (int ph = 0; ph < NPH; ++ph) { a.ph_lo = ph; a.ph_hi = ph + 1; hipLaunchKernelGGL(hyb_fwd, dim3(grid), dim3(NTHR), LDS_BYTES, stream, a);
#if defined(CHECK_BUILD) && CHECK_BUILD
        if (ph == 2) hipLaunchKernelGGL(chk_proj, dim3(1024), dim3(256), 0, stream, a);
        if (ph == 3) hipLaunchKernelGGL(chk_cmp, dim3(128), dim3(128), 0, stream, a);
        if (ph == 6) hipLaunchKernelGGL(chk_nsa, dim3(8 * CHK_NT), dim3(256), 0, stream, a);
        if (ph == NPH - 1) hipLaunchKernelGGL(chk_report, dim3(4098), dim3(256), 0, stream, a);
#endif
    }
#endif
    (void)in_sizes;
}
```

```cpp
#include <hip/hip_runtime.h>
#include <cstdio>
#include <cstdint>
#if !defined(NO_S3_PREFETCH)
#define S3_PREFETCH 1
#endif
#if !defined(ST_F32)
#define ST_BF16 1
#endif
#if !defined(NO_STREAM_PF)
#define MERGE_PF 1
#define CONV_PF 1
#define CMP_PF 1
#define S2_PF 1
#define ADDNORM_PF 1
#if !defined(MERGE_NT)
#define MERGE_NT 1
#endif
#endif
namespace pg8 {
#define PG8_LAS __attribute__((address_space(3)))
typedef unsigned short bf16_t;
typedef short bf16x8 __attribute__((ext_vector_type(8)));
typedef float f32x4 __attribute__((ext_vector_type(4)));
typedef unsigned u32x4 __attribute__((ext_vector_type(4)));
constexpr int BM = 256, BK = 64, HALF = 128, HTB = HALF * BK * 2  , STAGE_BYTES = 8 * HTB, NXCD = 8,
#ifdef PG8_WGM
    WGM = PG8_WGM;
#else
    WGM = 8;
#endif

__host__ __device__ __forceinline__ int lds_byte(int r, int c) { const int st = (r >> 4) * 2 + (c >> 5), rr = r & 15, cc = c & 31, ob = rr * 64 + cc * 2; return st * 1024 + (ob ^ (((ob >> 9) & 1) << 5)); }
__host__ __device__ __forceinline__ void stage_rc(int b, int& R, int& C) { const int st = b / 1024, sb = b % 1024, swz = sb ^ (((sb >> 9) & 1) << 5); R = (st >> 1) * 16 + swz / 64; C = (st & 1) * 32 + (swz % 64) / 2; }
__host__ __device__ __forceinline__ int perm32(int rho) { const int n = rho >> 4, i = rho & 15; return 8 * (i >> 2) + 4 * n + (i & 3); }

struct Unit { int pm, pn; };
struct Gemm { const bf16_t* A; const bf16_t* Bt; int M, N, K; };

struct StaticOrder {
    int nM, nN, nwg, G, c;
    __host__ __device__ void init(int M, int N, int G_, int c_) { nM = M / BM; nN = N / BM; nwg = nM * nN; G = G_; c = c_; }
    __host__ __device__ bool next(int i, Unit& u) const {
        const long L = (long)i * G + c; if (L >= nwg) return false;
        int wgid = (int)L; { const int q = nwg / NXCD, r = nwg % NXCD, xcd = wgid % NXCD, off = wgid / NXCD; wgid = (xcd < r ? xcd * (q + 1) : r * (q + 1) + (xcd - r) * q) + off; }
        const int nig = WGM * nN, gid = wgid / nig, fm = gid * WGM, gsz = (nM - fm) < WGM ? (nM - fm) : WGM;
        u.pm = fm + ((wgid % nig) % gsz); u.pn = (wgid % nig) / gsz; return true;
    }
    __device__ __forceinline__ void a_ready(const Unit&) const {}
    __device__ __forceinline__ void done(const Unit&) const {}
};
__device__ __forceinline__ unsigned cvt_pk_bf16(float lo, float hi) { unsigned r; asm volatile("v_cvt_pk_bf16_f32 %0, %1, %2" : "=v"(r) : "v"(lo), "v"(hi)); return r; }
template <class Epi, class Sched, bool ALIGN_EPI = false, bool SP2 = false>
__device__ __forceinline__ void gemm_phase(PG8_LAS unsigned char* lds, const Gemm g, const Sched& S, const Epi& E, const int wave_idx  ) {
    int lane_l; asm volatile("v_mbcnt_lo_u32_b32 %0, -1, 0\n\tv_mbcnt_hi_u32_b32 %0, -1, %0" : "=v"(lane_l));
    const int wid = wave_idx, tid = wid * 64 + lane_l, lane = tid & 63, wr = wid >> 2, wc = wid & 3, fr = lane & 15, fq = lane >> 4;
    const int K = g.K, nt = K / BK;
    unsigned voffA[2], voffB[2];
#pragma unroll
    for (int i = 0; i < 2; ++i) { int R, C; stage_rc(tid * 16 + i * 8192, R, C); const int Rb = Epi::PERM ? ((R & ~31) + perm32(R & 31)) : R;
        voffA[i] = (unsigned)(R * K + C) * 2u; voffB[i] = (unsigned)(Rb * K + C) * 2u; }
    const size_t kstep = (size_t)(BK * 2);
    const size_t hstep = (size_t)HALF * K * 2;
    const size_t tstep = 2 * hstep;
    const unsigned ldsw = (unsigned)wid * 1024u;
    const int aoff = lds_byte(wr * 64 + fr, fq * 8), boff = lds_byte(wc * 32 + fr, fq * 8);
#define PG8_SA(b, h) (((b) * 2 + (h)) * HTB)
#define PG8_SB(b, h) ((4 + (b) * 2 + (h)) * HTB)
#define PG8_STAGE(bufoff, gbase, voff) do { _Pragma("unroll") for (int _i = 0; _i < 2; ++_i) \
        __builtin_amdgcn_global_load_lds((const unsigned*)((const char*)(gbase) + (voff)[_i]), (PG8_LAS unsigned*)(lds + (bufoff) + ldsw + _i * 8192), 16, 0, 0); } while (0)
#define PG8_LDA(dst, b, h) do { _Pragma("unroll") for (int m = 0; m < 4; ++m) _Pragma("unroll") for (int k = 0; k < 2; ++k) dst[m][k] = *(const PG8_LAS bf16x8*)(lds + PG8_SA(b, h) + aoff + m * 2048 + k * 1024); } while (0)
#define PG8_LDB(dst, b, h) do { _Pragma("unroll") for (int n = 0; n < 2; ++n) _Pragma("unroll") for (int k = 0; k < 2; ++k) dst[n][k] = *(const PG8_LAS bf16x8*)(lds + PG8_SB(b, h) + boff + n * 2048 + k * 1024); } while (0)
#define PG8_MMA(ai, bj, At, Bt) do { __builtin_amdgcn_s_setprio(1); _Pragma("unroll") for (int m = 0; m < 4; ++m) _Pragma("unroll") for (int n = 0; n < 2; ++n) _Pragma("unroll") for (int k = 0; k < 2; ++k) \
        acc[ai][bj][m][n] = __builtin_amdgcn_mfma_f32_16x16x32_bf16(Bt[n][k], At[m][k], acc[ai][bj][m][n], 0, 0, 0); __builtin_amdgcn_s_setprio(0); } while (0)
#define PG8_WAIT_V(n) asm volatile("s_waitcnt vmcnt(" #n ")" ::: "memory")
#define PG8_WAIT_L(n) asm volatile("s_waitcnt lgkmcnt(" #n ")" ::: "memory")
#define PG8_BAR __builtin_amdgcn_s_barrier()
#define PG8_SCHED __builtin_amdgcn_sched_barrier(0)
    Unit cur, nxt; int ui = 0;
    if (!S.next(0, cur)) return;
    f32x4 acc[2][2][4][2];
#pragma unroll
    for (int a = 0; a < 2; ++a)
#pragma unroll
        for (int b = 0; b < 2; ++b)
#pragma unroll
            for (int m = 0; m < 4; ++m)
#pragma unroll
                for (int n = 0; n < 2; ++n) acc[a][b][m][n] = (f32x4){0.f, 0.f, 0.f, 0.f};
    bf16x8 At[4][2], B0[2][2], B1[2][2];
    const char* cA = (const char*)g.A + (size_t)cur.pm * tstep; const char* cB = (const char*)g.Bt + (size_t)cur.pn * tstep;
    S.a_ready(cur);
    if constexpr (SP2) {
        PG8_STAGE(PG8_SB(0, 0), cB, voffB); PG8_STAGE(PG8_SB(0, 1), cB + hstep, voffB); PG8_STAGE(PG8_SA(0, 0), cA, voffA); PG8_STAGE(PG8_SA(0, 1), cA + hstep, voffA);
        if (wr == 1) PG8_BAR;
        PG8_WAIT_V(2); PG8_BAR;
        PG8_STAGE(PG8_SB(1, 0), cB + kstep, voffB); PG8_STAGE(PG8_SA(1, 0), cA + kstep, voffA); PG8_STAGE(PG8_SB(1, 1), cB + hstep + kstep, voffB);
        PG8_WAIT_V(6); PG8_BAR;
    } else {
        PG8_STAGE(PG8_SB(0, 0), cB, voffB); PG8_STAGE(PG8_SA(0, 0), cA, voffA); PG8_STAGE(PG8_SB(0, 1), cB + hstep, voffB); PG8_STAGE(PG8_SA(0, 1), cA + hstep, voffA);
        if (wr == 1) PG8_BAR;
        PG8_WAIT_V(4); PG8_BAR;
        PG8_STAGE(PG8_SB(1, 0), cB + kstep, voffB); PG8_STAGE(PG8_SA(1, 0), cA + kstep, voffA); PG8_STAGE(PG8_SB(1, 1), cB + hstep + kstep, voffB);
        PG8_WAIT_V(6); PG8_BAR;
    }
    for (;;) {
        const bool has_next = S.next(ui + 1, nxt);
        const char* nA = has_next ? (const char*)g.A + (size_t)nxt.pm * tstep : cA; const char* nB = has_next ? (const char*)g.Bt + (size_t)nxt.pn * tstep : cB;
        for (int t = 0; t < nt; t += 2) {
            const bool last = (t == nt - 2);
            const char* a1 = cA + (size_t)(t + 1) * kstep;
            const char* a2 = last ? nA : cA + (size_t)(t + 2) * kstep; const char* b2 = last ? nB : cB + (size_t)(t + 2) * kstep;
            const char* a3 = a2 + kstep; const char* b3 = b2 + kstep;
            if (last && has_next) S.a_ready(nxt);
            if constexpr (SP2) {
            PG8_LDB(B0, 0, 0); PG8_LDB(B1, 0, 1); PG8_SCHED; PG8_LDA(At, 0, 0); PG8_STAGE(PG8_SA(1, 1), a1 + hstep, voffA);
            PG8_WAIT_V(8); PG8_WAIT_L(0); PG8_BAR; PG8_MMA(0, 0, At, B0); PG8_MMA(0, 1, At, B1); PG8_BAR; PG8_SCHED;
            PG8_LDA(At, 0, 1); PG8_STAGE(PG8_SB(0, 0), b2, voffB); PG8_STAGE(PG8_SB(0, 1), b2 + hstep, voffB); PG8_STAGE(PG8_SA(0, 0), a2, voffA);
            PG8_WAIT_V(8); PG8_WAIT_L(0); PG8_BAR; PG8_MMA(1, 0, At, B0); PG8_MMA(1, 1, At, B1); PG8_BAR; PG8_SCHED;
            PG8_LDB(B0, 1, 0); PG8_LDB(B1, 1, 1); PG8_SCHED; PG8_LDA(At, 1, 0); PG8_STAGE(PG8_SA(0, 1), a2 + hstep, voffA);
            PG8_WAIT_V(8); PG8_WAIT_L(0); PG8_BAR; PG8_MMA(0, 0, At, B0); PG8_MMA(0, 1, At, B1); PG8_BAR; PG8_SCHED;
            PG8_LDA(At, 1, 1); PG8_STAGE(PG8_SB(1, 0), b3, voffB); PG8_STAGE(PG8_SB(1, 1), b3 + hstep, voffB); PG8_STAGE(PG8_SA(1, 0), a3, voffA);
            PG8_WAIT_V(8); PG8_WAIT_L(0); PG8_BAR; PG8_MMA(1, 0, At, B0); PG8_MMA(1, 1, At, B1); PG8_BAR; PG8_SCHED;
            } else {
            PG8_LDB(B0, 0, 0); PG8_SCHED; PG8_LDA(At, 0, 0); PG8_STAGE(PG8_SA(1, 1), a1 + hstep, voffA);
            PG8_WAIT_L(8); PG8_BAR; PG8_WAIT_L(0); PG8_MMA(0, 0, At, B0); PG8_BAR; PG8_SCHED;
            PG8_LDB(B1, 0, 1); PG8_STAGE(PG8_SB(0, 0), b2, voffB);
            PG8_BAR; PG8_WAIT_L(0); PG8_MMA(0, 1, At, B1); PG8_BAR;
            PG8_LDA(At, 0, 1); PG8_STAGE(PG8_SA(0, 0), a2, voffA);
            PG8_BAR; PG8_WAIT_L(0); PG8_MMA(1, 0, At, B0); PG8_BAR; PG8_SCHED;
            PG8_STAGE(PG8_SB(0, 1), b2 + hstep, voffB);
            PG8_WAIT_V(6); PG8_BAR; PG8_MMA(1, 1, At, B1); PG8_BAR;
            PG8_LDB(B0, 1, 0); PG8_SCHED; PG8_LDA(At, 1, 0); PG8_STAGE(PG8_SA(0, 1), a2 + hstep, voffA);
            PG8_WAIT_L(8); PG8_BAR; PG8_WAIT_L(0); PG8_MMA(0, 0, At, B0); PG8_BAR; PG8_SCHED;
            PG8_LDB(B1, 1, 1); PG8_STAGE(PG8_SB(1, 0), b3, voffB);
            PG8_BAR; PG8_WAIT_L(0); PG8_MMA(0, 1, At, B1); PG8_BAR;
            PG8_LDA(At, 1, 1); PG8_STAGE(PG8_SA(1, 0), a3, voffA);
            PG8_BAR; PG8_WAIT_L(0); PG8_MMA(1, 0, At, B0); PG8_BAR; PG8_SCHED;
            PG8_STAGE(PG8_SB(1, 1), b3 + hstep, voffB);
            PG8_WAIT_V(6); PG8_BAR; PG8_MMA(1, 1, At, B1); PG8_BAR;
            }
        }
        if constexpr (ALIGN_EPI) { if (wr == 0) PG8_BAR; }
        if constexpr (!Epi::AFTER_DRAIN) { E(acc, cur, wr, wc, fr, fq);
#if defined(EPI_TWICE)
            if constexpr (Epi::PERM) E(acc, cur, wr, wc, fr, fq);
#endif
            S.done(cur); }
        if (!has_next) break;
#pragma unroll
        for (int a = 0; a < 2; ++a)
#pragma unroll
            for (int b = 0; b < 2; ++b)
#pragma unroll
                for (int m = 0; m < 4; ++m)
#pragma unroll
                    for (int n = 0; n < 2; ++n) acc[a][b][m][n] = (f32x4){0.f, 0.f, 0.f, 0.f};
        cur = nxt; cA = nA; cB = nB; ++ui;
        if constexpr (ALIGN_EPI) { if (wr == 1) PG8_BAR; }
    }
    PG8_WAIT_V(0);
    if constexpr (!ALIGN_EPI) { if (wr == 0) PG8_BAR; }
    PG8_BAR;
    if constexpr (Epi::AFTER_DRAIN) { E.fused(acc, cur, wr, wc, fr, fq, lds, wid, lane); S.done(cur); }
#undef PG8_SA
#undef PG8_SB
#undef PG8_STAGE
#undef PG8_LDA
#undef PG8_LDB
#undef PG8_MMA
#undef PG8_WAIT_V
#undef PG8_WAIT_L
#undef PG8_BAR
#undef PG8_SCHED
}
}

constexpr int BATCH = 2, SEQ = 8192, DM = 2048, DEPTH = 4;
constexpr int M = BATCH * SEQ;
constexpr int NH = 16, HD = 128, NG = 4, RH = 4;
constexpr int NCMP = 511, NCMP_PAD = 512, NSLC = 128, NSEL = 16, WIN = 512;
constexpr int SSD_H = 32, SSD_P = 64, SSD_N = 128, SSD_G = 4, SSD_CH = 128, SSD_NC = 64, SSD_XBC = 3072;
constexpr int DFF = 8192, PLE = 256;
constexpr float EPS = 1e-6f;
constexpr int PROJ_SRC = 22608;
constexpr int C_Q = 0, C_KC = 2048, C_VC = 2560, C_KS = 3072, C_VS = 3584, C_KW = 4096, C_VW = 4608;
constexpr int C_CB = 5120, C_CC = 7168, C_CU = 9216, C_Z = 11264, C_XBC = 13312, C_GM = 16384, C_GN = 22528, C_DT = 22592;
constexpr int LDP = 22784;
constexpr int S_GN = 5120, S_DT = 16432;

constexpr size_t MiB = 1u << 20;
constexpr size_t WS_CTL = 0, CTL_ZERO_BYTES = 1 * MiB;
constexpr size_t WS_ROPE = 1 * MiB;
constexpr size_t WS_MISC = 9 * MiB;
constexpr size_t WS_DT = 10 * MiB;
constexpr size_t WS_ACS = 12 * MiB;
constexpr size_t WS_CDEC = 14 * MiB;
constexpr size_t WS_KCMP = 15 * MiB;
constexpr size_t WS_VCMP = 16 * MiB;
constexpr size_t WS_X = 32 * MiB;
constexpr size_t WS_HB = 160 * MiB;
constexpr size_t WS_PB = 224 * MiB;
constexpr size_t WS_EB = 256 * MiB;
constexpr size_t WS_YA = 320 * MiB;
constexpr size_t WS_YC = 384 * MiB;
constexpr size_t WS_XBC = 448 * MiB;
#if !defined(PCH)
#define PCH 8
#endif
constexpr size_t WS_ST = 544 * MiB;
constexpr size_t WS_PROJ = 672 * MiB;
constexpr size_t WS_U = WS_PROJ;
constexpr size_t WS_W = 1384 * MiB;
constexpr size_t LW_IN = 0;
constexpr size_t LW_O = 89 * MiB;
constexpr size_t LW_UP = 97 * MiB;
constexpr size_t LW_DOWN = 129 * MiB;
constexpr size_t LW_PG = 161 * MiB;
constexpr size_t LW_PLE = 169 * MiB;
constexpr size_t LW_PK1 = 170 * MiB;
constexpr size_t LW_PV1 = 171 * MiB;
constexpr size_t LW_PK2 = 172 * MiB;
constexpr size_t LW_PV2 = 172 * MiB + 64 * 1024;
constexpr size_t LW_STRIDE = 173 * MiB;
constexpr size_t WS_HIN = WS_W + 4 * LW_STRIDE;
constexpr size_t WS_RSTD = WS_MISC + 512 * 1024;
constexpr size_t WS_DELTA = WS_HIN + 64 * MiB;
constexpr size_t WS_KV = WS_DELTA + 64 * MiB;
constexpr size_t WS_END = WS_KV + 96 * MiB;
static_assert((size_t)M * LDP * 2 <= 712 * MiB && (size_t)LDP * 2048 * 2 <= 89 * MiB, "ws map");

constexpr int CW_BAR = 4096;
constexpr int CW_CHK = 16384;
constexpr int CW_TS = 20480;

constexpr int RING_BYTES = 131072;
constexpr int LX_OFF = RING_BYTES;
constexpr int LX_BYTES = 8192;
constexpr int LDSCTL_OFF = LX_OFF + LX_BYTES;
constexpr int LDS_BYTES = LDSCTL_OFF + 256;
constexpr int NWAVES = 8, NTHR = 512;

#define DI __device__ __forceinline__
#define GAS __attribute__((address_space(1)))
#define LAS __attribute__((address_space(3)))
typedef unsigned short bf16;
typedef unsigned u32x4 __attribute__((ext_vector_type(4)));
typedef unsigned u32x2 __attribute__((ext_vector_type(2)));
typedef float f32x4 __attribute__((ext_vector_type(4)));
typedef float f32x2 __attribute__((ext_vector_type(2)));
typedef short bf16x8 __attribute__((ext_vector_type(8)));
typedef short s16x4 __attribute__((ext_vector_type(4)));
typedef GAS unsigned gu32;
#define RLX_AGENT __ATOMIC_RELAXED, __HIP_MEMORY_SCOPE_AGENT
#define LDS_WAIT() asm volatile("s_waitcnt lgkmcnt(0)" ::: "memory")
#define VM_WAIT() asm volatile("s_waitcnt vmcnt(0)" ::: "memory")
DI size_t kv_off(int kind, int b, int g, int t) { return ((((size_t)kind * BATCH + b) * NG + g) * SEQ + t) * HD; }
DI unsigned f2bf(float f) { unsigned u = __builtin_bit_cast(unsigned, f); return (u + 0x7fffu + ((u >> 16) & 1u)) >> 16; }
DI unsigned pk2(float lo, float hi) { unsigned r; asm("v_cvt_pk_bf16_f32 %0, %1, %2" : "=v"(r) : "v"(lo), "v"(hi)); return r; }
DI float bf2f(unsigned h) { return __builtin_bit_cast(float, h << 16); }
DI float bflo(unsigned w) { return __builtin_bit_cast(float, w << 16); }
DI float bfhi(unsigned w) { return __builtin_bit_cast(float, w & 0xffff0000u); }
DI float sigmoidf_(float x) { return 1.0f / (1.0f + __expf(-x)); }
DI float siluf_(float x) { return x / (1.0f + __expf(-x)); }
DI float shfl_idx(float v, int src) { return __builtin_bit_cast(float, __builtin_amdgcn_ds_bpermute(src << 2, __builtin_bit_cast(int, v))); }
DI unsigned shfl_idx_u(unsigned v, int src) { return (unsigned)__builtin_amdgcn_ds_bpermute(src << 2, (int)v); }
DI float shx(float v, int m, int lane) { return shfl_idx(v, lane ^ m); }
DI float xq_max(float x) {
    float a = x, b = x;
    asm("s_nop 1\n\tv_permlane32_swap_b32 %0, %1" : "+v"(a), "+v"(b)); x = fmaxf(a, b);
    a = x; b = x;
    asm("s_nop 1\n\tv_permlane16_swap_b32 %0, %1" : "+v"(a), "+v"(b)); return fmaxf(a, b);
}
DI float xq_sum(float x) {
    float a = x, b = x;
    asm("s_nop 1\n\tv_permlane32_swap_b32 %0, %1" : "+v"(a), "+v"(b)); x = a + b;
    a = x; b = x;
    asm("s_nop 1\n\tv_permlane16_swap_b32 %0, %1" : "+v"(a), "+v"(b)); return a + b;
}
DI float quad_sum(float v) {
    v += __builtin_bit_cast(float, __builtin_amdgcn_update_dpp(0, __builtin_bit_cast(int, v), 0xB1, 0xF, 0xF, true));
    v += __builtin_bit_cast(float, __builtin_amdgcn_update_dpp(0, __builtin_bit_cast(int, v), 0x4E, 0xF, 0xF, true));
    return v;
}
DI float wave_sum(float v, int lane) {
#pragma unroll
    for (int o = 1; o < 64; o <<= 1) v += shx(v, o, lane);
    return v;
}
DI unsigned off_b(unsigned row, unsigned ch) { return 256u * row + 16u * (ch ^ (((row & 3u) << 2) | ((row >> 2) & 3u))); }
DI unsigned tr_addr(unsigned lane, unsigned r0, unsigned c, unsigned t) {
    const unsigned g = lane >> 4, q = (lane & 15u) >> 2, p = lane & 3u;
    return off_b(r0 + 8u * g + 4u * t + q, 2u * c + (p >> 1)) + 8u * (p & 1u);
}
DI s16x4 tr_read(LAS const unsigned char* p) { return __builtin_amdgcn_ds_read_tr16_b64_v4i16((LAS s16x4*)p); }
DI bf16x8 tr_read8(LAS const unsigned char* base, unsigned lane, unsigned r0, unsigned c) {
    const s16x4 lo = tr_read(base + tr_addr(lane, r0, c, 0)), hi = tr_read(base + tr_addr(lane, r0, c, 1));
    return __builtin_shufflevector(lo, hi, 0, 1, 2, 3, 4, 5, 6, 7);
}
DI bf16x8 lds_rd8(LAS const unsigned char* p) { return *(const LAS bf16x8*)p; }
DI bf16x8 as_bf16x8(u32x4 v) { return __builtin_bit_cast(bf16x8, v); }
#define MFMA16(a, b, c) __builtin_amdgcn_mfma_f32_16x16x32_bf16((a), (b), (c), 0, 0, 0)

namespace pg8 {
struct LightOrder {
    int G, c, nunits, nN;
    __host__ __device__ void init(int M, int N, int G_, int c_) { G = G_; c = c_; nN = N / BM; nunits = (M / BM) * nN; }
    __host__ __device__ bool next(int i, Unit& u) const {
        int j;
        if (G == 256) { if (c < 64) return false; j = (c - 64) + 192 * i; } else j = c + G * i;
        if (j >= nunits) return false;
        u.pm = j / nN; u.pn = j % nN; return true;
    }
    __device__ __forceinline__ void a_ready(const Unit&) const {}
    __device__ __forceinline__ void done(const Unit&) const {}
};
template <int MODE> struct EpiB {
    static constexpr bool PERM = true, AFTER_DRAIN = false;
    bf16_t* O; int ldc; const float* rope;
    bf16_t* kv;
    __device__ __forceinline__ void operator()(const f32x4 (&acc)[2][2][4][2], const Unit& u, int wr, int wc, int fr, int fq) const {
        { int l; asm volatile("v_mbcnt_lo_u32_b32 %0, -1, 0\n\tv_mbcnt_hi_u32_b32 %0, -1, %0" : "=v"(l)); fr = l & 15; fq = l >> 4; }
        const int row0 = u.pm * BM + wr * 64 + fr;
        bool rp = false;
        if (MODE == 2) { const int pn = u.pn; rp = (pn < 10) || pn == 12 || pn == 13 || pn == 16 || pn == 17; }
        if (MODE == 2 && rp) {
            const int colb = u.pn * BM + 128 * (wc >> 1) + 32 * (wc & 1) + 8 * fq, jj0 = 32 * (wc & 1) + 8 * fq;
#if defined(EPI_ROPE_PF)
            f32x4 nx0, nx1, nx2, nx3;
            { const float* rpp = (const float*)((const char*)rope + (unsigned)(((unsigned)row0 * 64u + (unsigned)jj0) * 8u));
              nx0 = *(const f32x4*)(rpp); nx1 = *(const f32x4*)(rpp + 4); nx2 = *(const f32x4*)(rpp + 8); nx3 = *(const f32x4*)(rpp + 12); }
#endif
#pragma unroll
            for (int ai = 0; ai < 2; ++ai)
#pragma unroll
                for (int m = 0; m < 4; ++m) {
                    const int row = row0 + ai * HALF + m * 16;
#if defined(EPI_ROPE_PF)
                    const f32x4 cs0 = nx0, cs1 = nx1, cs2 = nx2, cs3 = nx3;
                    if (ai * 4 + m < 7) { const int rown = row0 + ((ai * 4 + m + 1) >> 2) * HALF + ((ai * 4 + m + 1) & 3) * 16;
                        const float* rpp = (const float*)((const char*)rope + (unsigned)(((unsigned)rown * 64u + (unsigned)jj0) * 8u));
                        nx0 = *(const f32x4*)(rpp); nx1 = *(const f32x4*)(rpp + 4); nx2 = *(const f32x4*)(rpp + 8); nx3 = *(const f32x4*)(rpp + 12); }
#else
                    const float* rpp = (const float*)((const char*)rope + (unsigned)(((unsigned)row * 64u + (unsigned)jj0) * 8u));
                    const f32x4 cs0 = *(const f32x4*)(rpp), cs1 = *(const f32x4*)(rpp + 4), cs2 = *(const f32x4*)(rpp + 8), cs3 = *(const f32x4*)(rpp + 12);
#endif
                    const f32x4 x1a = acc[ai][0][m][0], x1b = acc[ai][0][m][1], x2a = acc[ai][1][m][0], x2b = acc[ai][1][m][1];
                    float c[8] = {cs0[0], cs0[2], cs1[0], cs1[2], cs2[0], cs2[2], cs3[0], cs3[2]};
                    float s[8] = {cs0[1], cs0[3], cs1[1], cs1[3], cs2[1], cs2[3], cs3[1], cs3[3]};
                    float x1[8] = {x1a[0], x1a[1], x1a[2], x1a[3], x1b[0], x1b[1], x1b[2], x1b[3]};
                    float x2[8] = {x2a[0], x2a[1], x2a[2], x2a[3], x2b[0], x2b[1], x2b[2], x2b[3]};
                    float o1[8], o2[8];
#pragma unroll
                    for (int k = 0; k < 8; ++k) { o1[k] = x1[k] * c[k] - x2[k] * s[k]; o2[k] = x2[k] * c[k] + x1[k] * s[k]; }
                    u32x4 w1, w2;
                    w1.x = cvt_pk_bf16(o1[0], o1[1]); w1.y = cvt_pk_bf16(o1[2], o1[3]); w1.z = cvt_pk_bf16(o1[4], o1[5]); w1.w = cvt_pk_bf16(o1[6], o1[7]);
                    w2.x = cvt_pk_bf16(o2[0], o2[1]); w2.y = cvt_pk_bf16(o2[2], o2[3]); w2.z = cvt_pk_bf16(o2[4], o2[5]); w2.w = cvt_pk_bf16(o2[6], o2[7]);
                    bf16_t* rowp = (bf16_t*)((char*)O + (unsigned)(((unsigned)row * (unsigned)ldc + (unsigned)colb) * 2u));
                    if (u.pn >= 8) { const int kind = (u.pn - 8) >> 1, g = 2 * (u.pn & 1) + (wc >> 1);
                        rowp = kv + ((((size_t)kind * 2 + (row >> 13)) * 4 + g) * 8192 + (row & 8191)) * 128 + jj0; }
#if defined(EPI_NT)
                    __builtin_nontemporal_store(w1, (u32x4*)(rowp)); __builtin_nontemporal_store(w2, (u32x4*)(rowp + 64));
#else
                    *(u32x4*)(rowp) = w1; *(u32x4*)(rowp + 64) = w2;
#endif
                    asm volatile("" ::: "memory");
                }
        } else {
            const int col0 = u.pn * BM + wc * 32 + 8 * fq;
#if defined(EPI_E_PF)
            u32x4 evp[2][4][2];
            if (MODE == 3) {
#pragma unroll
                for (int ai = 0; ai < 2; ++ai)
#pragma unroll
                    for (int m = 0; m < 4; ++m)
#pragma unroll
                        for (int bj = 0; bj < 2; ++bj)
                            evp[ai][m][bj] = *(const u32x4*)((const char*)rope + (unsigned)(((unsigned)(row0 + ai * HALF + m * 16) * (unsigned)ldc + (unsigned)col0 + (unsigned)(bj * HALF)) * 2u));
            }
#endif
#pragma unroll
            for (int ai = 0; ai < 2; ++ai)
#pragma unroll
                for (int m = 0; m < 4; ++m) { bf16_t* rowp = (bf16_t*)((char*)O + (unsigned)(((unsigned)(row0 + ai * HALF + m * 16) * (unsigned)ldc + (unsigned)col0) * 2u));
#pragma unroll
                    for (int bj = 0; bj < 2; ++bj) { f32x4 v0 = acc[ai][bj][m][0], v1 = acc[ai][bj][m][1];
                        if (MODE == 1) {
#pragma unroll
                            for (int k = 0; k < 4; ++k) { const float a = fmaxf(v0[k], 0.f), b = fmaxf(v1[k], 0.f); v0[k] = a * a; v1[k] = b * b; } }
#if defined(EPI_E_PF)
                        if (MODE == 3) { const u32x4 ev = evp[ai][m][bj];
#else
                        if (MODE == 3) { const u32x4 ev = *(const u32x4*)((const bf16_t*)rope + (rowp - O) + bj * HALF);
#endif
                            const float e[8] = {__builtin_bit_cast(float, ev.x << 16), __builtin_bit_cast(float, ev.x & 0xffff0000u), __builtin_bit_cast(float, ev.y << 16), __builtin_bit_cast(float, ev.y & 0xffff0000u),
                                                __builtin_bit_cast(float, ev.z << 16), __builtin_bit_cast(float, ev.z & 0xffff0000u), __builtin_bit_cast(float, ev.w << 16), __builtin_bit_cast(float, ev.w & 0xffff0000u)};
#pragma unroll
                            for (int k = 0; k < 4; ++k) { v0[k] = e[k] / (1.0f + __expf(-v0[k])); v1[k] = e[4 + k] / (1.0f + __expf(-v1[k])); } }
                        u32x4 w; w.x = cvt_pk_bf16(v0[0], v0[1]); w.y = cvt_pk_bf16(v0[2], v0[3]); w.z = cvt_pk_bf16(v1[0], v1[1]); w.w = cvt_pk_bf16(v1[2], v1[3]);
                        if (MODE == 2 && u.pn >= 8 && u.pn < 20) { const int kind = (u.pn - 8) >> 1, g = 2 * (u.pn & 1) + bj, row = row0 + ai * HALF + m * 16;
#if defined(EPI_NT)
                            __builtin_nontemporal_store(w, (u32x4*)(kv + ((((size_t)kind * 2 + (row >> 13)) * 4 + g) * 8192 + (row & 8191)) * 128 + wc * 32 + 8 * fq)); }
                        else if (MODE == 2) __builtin_nontemporal_store(w, (u32x4*)(rowp + bj * HALF));
                        else *(u32x4*)(rowp + bj * HALF) = w; } }
#else
                            *(u32x4*)(kv + ((((size_t)kind * 2 + (row >> 13)) * 4 + g) * 8192 + (row & 8191)) * 128 + wc * 32 + 8 * fq) = w; }
                        else *(u32x4*)(rowp + bj * HALF) = w; } }
#endif
        }
    }
};
template <bool GATE> struct EpiRes {
    static constexpr bool PERM = false, AFTER_DRAIN = false;
    const float* xin; float* xout; int ldc; const bf16_t* e;
    __device__ __forceinline__ void operator()(const f32x4 (&acc)[2][2][4][2], const Unit& u, int wr, int wc, int fr, int fq) const {
        { int l; asm volatile("v_mbcnt_lo_u32_b32 %0, -1, 0\n\tv_mbcnt_hi_u32_b32 %0, -1, %0" : "=v"(l)); fr = l & 15; fq = l >> 4; }
        const int row0 = u.pm * BM + wr * 64 + fr, col0 = u.pn * BM + wc * 32 + 4 * fq;
#pragma unroll
        for (int ai = 0; ai < 2; ++ai)
#pragma unroll
            for (int m = 0; m < 4; ++m) { const unsigned off = (unsigned)(row0 + ai * HALF + m * 16) * (unsigned)ldc + (unsigned)col0;
#pragma unroll
                for (int bj = 0; bj < 2; ++bj)
#pragma unroll
                    for (int n = 0; n < 2; ++n) { const unsigned o = off + bj * HALF + n * 16; const f32x4 xv = *(const f32x4*)((const char*)xin + (unsigned)(o * 4u)); f32x4 a = acc[ai][bj][m][n];
                        if (GATE) { typedef unsigned u32x2v __attribute__((ext_vector_type(2))); const u32x2v ev = *(const u32x2v*)((const char*)e + (unsigned)(o * 2u));
                            const float e0 = __builtin_bit_cast(float, ev.x << 16), e1 = __builtin_bit_cast(float, ev.x & 0xffff0000u), e2 = __builtin_bit_cast(float, ev.y << 16), e3 = __builtin_bit_cast(float, ev.y & 0xffff0000u);
                            a[0] = e0 / (1.0f + __expf(-a[0])); a[1] = e1 / (1.0f + __expf(-a[1])); a[2] = e2 / (1.0f + __expf(-a[2])); a[3] = e3 / (1.0f + __expf(-a[3])); }
                        *(f32x4*)((char*)xout + (unsigned)(o * 4u)) = xv + a; }
                asm volatile("" ::: "memory"); }
    }
};
}
#define XB_TMO      128
#define XB_XCNT(j)  (256  + 64 * (j))
#define XB_XSUB(j)  (1280 + 64 * (j))
#define XB_XGEN(j)  (2304 + 64 * (j))
#define XB_TOP      3328
#define XB_TOPGEN   3392
#define XCD_BAR_WORDS 3456
#define XB_SPIN_CAP (1u << 18)

__device__ __forceinline__ unsigned xb_ld(unsigned* p)              { return __hip_atomic_load(p, __ATOMIC_RELAXED, __HIP_MEMORY_SCOPE_AGENT); }
__device__ __forceinline__ unsigned xb_add(unsigned* p, unsigned v) { return __hip_atomic_fetch_add(p, v, __ATOMIC_RELAXED, __HIP_MEMORY_SCOPE_AGENT); }
__device__ __forceinline__ unsigned xb_xcc_id() { return (unsigned)__builtin_amdgcn_s_getreg((3 << 11) | 20) & 0xFu; }
#define XB_SPIN(cond, bar) do { unsigned _sp = 0; while (cond) { __builtin_amdgcn_s_sleep(1); \
    if ((++_sp & 255u) == 0u) { if (xb_ld(&(bar)[XB_TMO])) break; if (_sp > XB_SPIN_CAP) { atomicAdd(&(bar)[XB_TMO], 1u); break; } } } } while (0)

struct XcdBarrier {
    unsigned* bar; unsigned x;
    volatile LAS unsigned* st;
};

__device__ __forceinline__ XcdBarrier xcd_barrier_post(unsigned* bar, volatile LAS unsigned* st) {
    XcdBarrier b; b.bar = bar; b.x = xb_xcc_id(); b.st = st;
    if (threadIdx.x == 0) (void)xb_add(&bar[XB_XCNT(b.x)], 1u);
    return b;
}
__device__ __forceinline__ void xcd_barrier_complete(unsigned* bar, unsigned x, unsigned& nloc, unsigned& nx) {
    const unsigned G = gridDim.x * gridDim.y * gridDim.z;
    unsigned sum, cnt, mine, sp = 0u;
    for (;;) {
        sum = 0u; cnt = 0u; mine = 0u;
#pragma unroll
        for (unsigned j = 0; j < 16; ++j) { const unsigned c = xb_ld(&bar[XB_XCNT(j)]); sum += c; cnt += (c > 0u) ? 1u : 0u; mine = (j == x) ? c : mine; }
        if (sum == G) break;
        __builtin_amdgcn_s_sleep(1);
        if ((++sp & 255u) == 0u) { if (xb_ld(&bar[XB_TMO])) break; if (sp > XB_SPIN_CAP) { atomicAdd(&bar[XB_TMO], 1u); break; } }
    }
    nloc = mine > 0u ? mine : 1u; nx = cnt > 0u ? cnt : 1u;
}

__device__ __forceinline__ void xcd_barrier(const XcdBarrier& b) {
    asm volatile("s_waitcnt vmcnt(0)" ::: "memory");
    __syncthreads();
    if (threadIdx.x == 0) {
        unsigned* bar = b.bar;
        __builtin_amdgcn_s_waitcnt(0);
        unsigned nloc = b.st[0], nx = b.st[1];
        if (nloc == 0u) { xcd_barrier_complete(bar, b.x, nloc, nx); b.st[0] = nloc; b.st[1] = nx; }
        const unsigned old = xb_add(&bar[XB_XSUB(b.x)], 1u);
        const unsigned gen = old / nloc;
        if (old + 1u == (gen + 1u) * nloc) {
            __builtin_amdgcn_fence(__ATOMIC_RELEASE, "agent");
            asm volatile("s_waitcnt vmcnt(0)" ::: "memory");
            const unsigned og = xb_add(&bar[XB_TOP], 1u);
            const unsigned tg = og / nx;
            if (og + 1u == (tg + 1u) * nx) xb_add(&bar[XB_TOPGEN], 1u);
            else XB_SPIN(xb_ld(&bar[XB_TOPGEN]) == tg, bar);
            __builtin_amdgcn_fence(__ATOMIC_ACQUIRE, "agent");
            xb_add(&bar[XB_XGEN(b.x)], 1u);
            asm volatile("s_waitcnt vmcnt(0)" ::: "memory");
        } else {
            XB_SPIN(xb_ld(&bar[XB_XGEN(b.x)]) == gen, bar);
            __builtin_amdgcn_fence(__ATOMIC_ACQUIRE, "agent");
            asm volatile("s_waitcnt vmcnt(0)" ::: "memory");
        }
    }
    __syncthreads();
}

struct Args { const void* in[30]; float* out; unsigned char* ws; int ph_lo, ph_hi; };
struct Frame {
    LAS unsigned char* lds;
    gu32* ctl;
    unsigned char* ws;
    int tid, lane, wave, G, bid;
};
DI const void* argin(const Args&, int k) {
    typedef const void* const __attribute__((address_space(4)))* kptr_t;
    kptr_t p = (kptr_t)__builtin_amdgcn_kernarg_segment_ptr(); asm volatile("" : "+s"(p));
    return (const void*)p[k]; }
DI int launder_s(int x) { asm volatile("" : "+s"(x)); return x; }
DI Frame phase_frame(const Frame& F0) { Frame F = F0;
    int l; asm volatile("v_mbcnt_lo_u32_b32 %0, -1, 0\n\tv_mbcnt_hi_u32_b32 %0, -1, %0" : "=v"(l));
    F.wave = launder_s(F0.wave); F.bid = launder_s(F0.bid); F.G = launder_s(F0.G);
    F.lane = l; F.tid = F.wave * 64 + l;
    { unsigned long long wsb = (unsigned long long)F0.ws; asm volatile("" : "+s"(wsb)); F.ws = (unsigned char*)wsb; }
    { unsigned ll = (unsigned)(size_t)F0.lds; asm volatile("" : "+s"(ll)); F.lds = (LAS unsigned char*)(size_t)ll; }
    return F; }
DI unsigned char* lw_ptr(const Frame& F, int layer, size_t off) { return F.ws + WS_W + (size_t)layer * LW_STRIDE + off; }

template <bool FRAGMAJOR = false>
DI void transpose_item(const float* W, int K, int Nsrc, int nsrc0, bf16* WT, int dst_row0, int k0, LAS float* scr, int lane) {
#pragma unroll 8
#if defined(TR_NT)
    for (int i = 0; i < 32; ++i) { const int kk = 2 * i + (lane >> 5); scr[kk * 33 + (lane & 31)] = __builtin_nontemporal_load(W + (size_t)(k0 + kk) * Nsrc + nsrc0 + (lane & 31)); }
#else
    for (int i = 0; i < 32; ++i) { const int kk = 2 * i + (lane >> 5); scr[kk * 33 + (lane & 31)] = W[(size_t)(k0 + kk) * Nsrc + nsrc0 + (lane & 31)]; }
#endif
    LDS_WAIT(); asm volatile("" ::: "memory");
    const int c = lane & 7;
#pragma unroll
    for (int j = 0; j < 4; ++j) { const int n = (lane >> 3) + 8 * j; const LAS float* s = scr + (8 * c) * 33 + n;
        u32x4 o; o.x = pk2(s[0 * 33], s[1 * 33]); o.y = pk2(s[2 * 33], s[3 * 33]); o.z = pk2(s[4 * 33], s[5 * 33]); o.w = pk2(s[6 * 33], s[7 * 33]);
        if (FRAGMAJOR) { const int hid = dst_row0 + n, kk = k0 + 8 * c;
            *(u32x4*)(WT + ((size_t)((hid >> 4) * (K >> 5) + (kk >> 5)) * 64 + (((kk >> 3) & 3) * 16 + (hid & 15))) * 8) = o; }
#if defined(TR_NTS)
        else __builtin_nontemporal_store(o, (u32x4*)(WT + (size_t)(dst_row0 + n) * K + k0 + 8 * c)); }
#else
        else *(u32x4*)(WT + (size_t)(dst_row0 + n) * K + k0 + 8 * c) = o; }
#endif
    LDS_WAIT(); asm volatile("" ::: "memory");
}
DI int proj_src_col(int d) {
    if (d < 5120) {
        const int pn = d >> 8; const bool rp = (pn < 10) || pn == 12 || pn == 13 || pn == 16 || pn == 17;
        if (!rp) return d;
        const int c = d & 255, bj = c >> 7, wc = (c >> 5) & 3;
        return (pn << 8) + 128 * (wc >> 1) + 64 * bj + 32 * (wc & 1);
    }
    if (d < 16384) return d + 48;
    if (d < 22528) return d + 80;
    if (d < 22592) return S_GN + (d - 22528);
    if (d < 22624) return S_DT + (d - 22592);
    return 0;
}
constexpr int TI_IN = 32 * 712, TI_O = 32 * 64, TI_UP = 32 * 256, TI_DOWN = 128 * 64, TI_PG = 32 * 64, TI_PLE = 4 * 64, TI_P1 = 64 * 4, TI_P2 = 2 * 4;
constexpr int TI_LAYER = TI_IN + TI_O + TI_UP + TI_DOWN + TI_PG + TI_PLE + 2 * TI_P1 + 2 * TI_P2;

struct TItem { const float* src; bf16* WT; int Nsrc, K, drow, k0, frag; };
DI void ti_decode(const Frame& F, const Args& A, int it, TItem& t) {
    const int layer = it / TI_LAYER; int r = it - layer * TI_LAYER; int ai, lw, K, Nsrc, nbn, frag = 0; size_t lstride;
    if (r < TI_IN) { ai = 4; lw = LW_IN; K = DM; Nsrc = PROJ_SRC; nbn = 712; lstride = (size_t)DM * PROJ_SRC; }
    else if ((r -= TI_IN) < TI_O) { ai = 22; lw = LW_O; K = DM; Nsrc = DM; nbn = 64; lstride = (size_t)DM * DM; }
    else if ((r -= TI_O) < TI_UP) { ai = 24; lw = LW_UP; K = DM; Nsrc = DFF; nbn = 256; lstride = (size_t)DM * DFF; }
    else if ((r -= TI_UP) < TI_DOWN) { ai = 25; lw = LW_DOWN; K = DFF; Nsrc = DM; nbn = 64; lstride = (size_t)DFF * DM; }
    else if ((r -= TI_DOWN) < TI_PG) { ai = 28; lw = LW_PG; K = DM; Nsrc = DM; nbn = 64; lstride = (size_t)DM * DM; }
    else if ((r -= TI_PG) < TI_PLE) { ai = 27; lw = LW_PLE; K = PLE; Nsrc = DM; nbn = 64; lstride = (size_t)PLE * DM; }
    else if ((r -= TI_PLE) < TI_P1) { ai = 7; lw = LW_PK1; K = 4096; Nsrc = 128; nbn = 4; lstride = (size_t)4096 * 128; frag = 1; }
    else if ((r -= TI_P1) < TI_P1) { ai = 11; lw = LW_PV1; K = 4096; Nsrc = 128; nbn = 4; lstride = (size_t)4096 * 128; frag = 1; }
    else if ((r -= TI_P1) < TI_P2) { ai = 9; lw = LW_PK2; K = 128; Nsrc = 128; nbn = 4; lstride = (size_t)128 * 128; }
    else { r -= TI_P2; ai = 13; lw = LW_PV2; K = 128; Nsrc = 128; nbn = 4; lstride = (size_t)128 * 128; }
    int kb = r / nbn, nb = r - kb * nbn;
#if defined(TI_BLK)
    if (K >= 256) {
        const int r8 = r & 7, rq = r >> 3, hn = nbn >> 1, skb = rq / hn, snb = rq - skb * hn; nb = 2 * snb + (r8 & 1); kb = 4 * skb + (r8 >> 1); }
#endif
    const int scol = (ai == 4) ? proj_src_col(nb * 32) : nb * 32;
    t.src = (const float*)argin(A, ai) + (size_t)layer * lstride + (size_t)(kb * 64) * Nsrc + scol;
    t.WT = (bf16*)lw_ptr(F, layer, lw); t.Nsrc = Nsrc; t.K = K; t.drow = nb * 32; t.k0 = kb * 64; t.frag = frag;
}
DI void ti_load(const TItem& t, int lane, float (&v)[32]) {
#pragma unroll
    for (int i = 0; i < 32; ++i) { const int kk = 2 * i + (lane >> 5); v[i] = t.src[(size_t)kk * t.Nsrc + (lane & 31)]; }
}
DI void ti_store(const TItem& t, const float (&v)[32], LAS float* scr, int lane) {
#pragma unroll
    for (int i = 0; i < 32; ++i) { const int kk = 2 * i + (lane >> 5); scr[kk * 33 + (lane & 31)] = v[i]; }
    LDS_WAIT(); asm volatile("" ::: "memory");
    const int c = lane & 7;
#pragma unroll
    for (int j = 0; j < 4; ++j) { const int n = (lane >> 3) + 8 * j; const LAS float* s = scr + (8 * c) * 33 + n;
        u32x4 o; o.x = pk2(s[0 * 33], s[1 * 33]); o.y = pk2(s[2 * 33], s[3 * 33]); o.z = pk2(s[4 * 33], s[5 * 33]); o.w = pk2(s[6 * 33], s[7 * 33]);
        if (t.frag) { const int hid = t.drow + n, kk = t.k0 + 8 * c;
            *(u32x4*)(t.WT + ((size_t)((hid >> 4) * (t.K >> 5) + (kk >> 5)) * 64 + (((kk >> 3) & 3) * 16 + (hid & 15))) * 8) = o; }
        else *(u32x4*)(t.WT + (size_t)(t.drow + n) * t.K + t.k0 + 8 * c) = o; }
    LDS_WAIT(); asm volatile("" ::: "memory");
}
DI void p0_prologue(const Frame& F0, const Args& A) {
    const Frame F = phase_frame(F0);
    LAS float* scr = (LAS float*)(F.lds + F.wave * 16384);
    const int gw = F.bid * NWAVES + F.wave, NGW = F.G * NWAVES;
#if defined(TI_PIPE)
    { int it = gw; TItem d0, d1; float va[32], vb[32];
      if (it < DEPTH * TI_LAYER) { ti_decode(F, A, it, d0); ti_load(d0, F.lane, va); }
      while (it < DEPTH * TI_LAYER) {
          const int itn = it + NGW; const bool more = itn < DEPTH * TI_LAYER;
#if TI_PIPE == 2
          ti_store(d0, va, scr, F.lane);
          if (more) { ti_decode(F, A, itn, d1); ti_load(d1, F.lane, vb); }
#else
          if (more) { ti_decode(F, A, itn, d1); ti_load(d1, F.lane, vb); }
          ti_store(d0, va, scr, F.lane);
#endif
          if (more) { d0 = d1;
#pragma unroll
              for (int q = 0; q < 32; ++q) va[q] = vb[q]; }
          it = itn; } }
#else
    for (int it = gw; it < DEPTH * TI_LAYER; it += NGW) {
        const int layer = it / TI_LAYER; int r = it - layer * TI_LAYER;
        if (r < TI_IN) { const int kb = r / 712, nb = r - kb * 712;
            transpose_item((const float*)argin(A, 4) + (size_t)layer * DM * PROJ_SRC, DM, PROJ_SRC, proj_src_col(nb * 32), (bf16*)lw_ptr(F, layer, LW_IN), nb * 32, kb * 64, scr, F.lane); continue; } r -= TI_IN;
        if (r < TI_O) { const int kb = r / 64, nb = r % 64;
            transpose_item((const float*)argin(A, 22) + (size_t)layer * DM * DM, DM, DM, nb * 32, (bf16*)lw_ptr(F, layer, LW_O), nb * 32, kb * 64, scr, F.lane); continue; } r -= TI_O;
        if (r < TI_UP) { const int kb = r / 256, nb = r % 256;
            transpose_item((const float*)argin(A, 24) + (size_t)layer * DM * DFF, DM, DFF, nb * 32, (bf16*)lw_ptr(F, layer, LW_UP), nb * 32, kb * 64, scr, F.lane); continue; } r -= TI_UP;
        if (r < TI_DOWN) { const int kb = r / 64, nb = r % 64;
            transpose_item((const float*)argin(A, 25) + (size_t)layer * DFF * DM, DFF, DM, nb * 32, (bf16*)lw_ptr(F, layer, LW_DOWN), nb * 32, kb * 64, scr, F.lane); continue; } r -= TI_DOWN;
        if (r < TI_PG) { const int kb = r / 64, nb = r % 64;
            transpose_item((const float*)argin(A, 28) + (size_t)layer * DM * DM, DM, DM, nb * 32, (bf16*)lw_ptr(F, layer, LW_PG), nb * 32, kb * 64, scr, F.lane); continue; } r -= TI_PG;
        if (r < TI_PLE) { const int kb = r / 64, nb = r % 64;
            transpose_item((const float*)argin(A, 27) + (size_t)layer * PLE * DM, PLE, DM, nb * 32, (bf16*)lw_ptr(F, layer, LW_PLE), nb * 32, kb * 64, scr, F.lane); continue; } r -= TI_PLE;
        if (r < TI_P1) { const int kb = r / 4, nb = r % 4;
            transpose_item<true>((const float*)argin(A, 7) + (size_t)layer * 4096 * 128, 4096, 128, nb * 32, (bf16*)lw_ptr(F, layer, LW_PK1), nb * 32, kb * 64, scr, F.lane); continue; } r -= TI_P1;
        if (r < TI_P1) { const int kb = r / 4, nb = r % 4;
            transpose_item<true>((const float*)argin(A, 11) + (size_t)layer * 4096 * 128, 4096, 128, nb * 32, (bf16*)lw_ptr(F, layer, LW_PV1), nb * 32, kb * 64, scr, F.lane); continue; } r -= TI_P1;
        if (r < TI_P2) { const int kb = r / 4, nb = r % 4;
            transpose_item((const float*)argin(A, 9) + (size_t)layer * 128 * 128, 128, 128, nb * 32, (bf16*)lw_ptr(F, layer, LW_PK2), nb * 32, kb * 64, scr, F.lane); continue; } r -= TI_P2;
        { const int kb = r / 4, nb = r % 4;
            transpose_item((const float*)argin(A, 13) + (size_t)layer * 128 * 128, 128, 128, nb * 32, (bf16*)lw_ptr(F, layer, LW_PV2), nb * 32, kb * 64, scr, F.lane); }
    }
#endif
    const size_t gt = (size_t)F.bid * NTHR + F.tid, NGT = (size_t)F.G * NTHR;
    { const float* p = (const float*)argin(A, 1); bf16* pb = (bf16*)(F.ws + WS_PB);
      for (size_t i = gt; i < (size_t)DEPTH * M * PLE / 8; i += NGT) { const f32x4 a = *(const f32x4*)(p + i * 8), b = *(const f32x4*)(p + i * 8 + 4);
          u32x4 o; o.x = pk2(a[0], a[1]); o.y = pk2(a[2], a[3]); o.z = pk2(b[0], b[1]); o.w = pk2(b[2], b[3]); *(u32x4*)(pb + i * 8) = o; } }
    { const int* pos = (const int*)argin(A, 2); float* rope = (float*)(F.ws + WS_ROPE);
      for (size_t i = gt; i < (size_t)M * 64; i += NGT) { const int row = (int)(i >> 6), jj = (int)(i & 63);
          const float inv = 1.0f / powf(10000.0f, (float)(2 * jj) * (1.0f / 128.0f));
          const float ang = (float)pos[row] * inv;
          double a = (double)ang; a -= 6.283185307179586476925 * __builtin_rint(a * 0.15915494309189533577);
          const float ar = (float)a;
          rope[i * 2] = cosf(ar); rope[i * 2 + 1] = sinf(ar); } }
    { float* part = (float*)(F.ws + WS_MISC);
      for (size_t i = gt; i < (size_t)DEPTH * 2 * PCH * 128; i += NGT) { const int hid = (int)(i & 127), c = (int)(i >> 7) % PCH, kv = (int)((i >> 7) / PCH) & 1, layer = (int)((i >> 7) / (2 * PCH));
          const float* pe = (const float*)(kv ? A.in[6] : A.in[5]) + (size_t)layer * 4096 + c * (4096 / PCH);
          const float* w1 = (const float*)(kv ? A.in[11] : A.in[7]) + (size_t)layer * 4096 * 128 + (size_t)c * (4096 / PCH) * 128 + hid;
          float s = 0.f;
#pragma unroll 8
          for (int kk = 0; kk < 4096 / PCH; ++kk) s += pe[kk] * w1[(size_t)kk * 128];
          part[i] = s; } }
}

template <bool OUTF32> DI void norm_rows(const Frame& F0, const float* x, const float* g, void* outp) {
    const Frame F = phase_frame(F0);
    const int gw = F.bid * NWAVES + F.wave, NGW = F.G * NWAVES;
    for (int m = gw; m < M; m += NGW) {
        const f32x4* xr = (const f32x4*)(x + (size_t)m * DM) + F.lane;
        f32x4 v[8]; float s = 0.f;
#pragma unroll
        for (int j = 0; j < 8; ++j) { v[j] = xr[64 * j]; s += (v[j][0] * v[j][0] + v[j][1] * v[j][1]) + (v[j][2] * v[j][2] + v[j][3] * v[j][3]); }
        const float rstd = 1.0f / sqrtf(wave_sum(s, F.lane) * (1.0f / DM) + EPS);
#pragma unroll
        for (int j = 0; j < 8; ++j) { const f32x4 gv = ((const f32x4*)g)[F.lane + 64 * j]; const f32x4 o = v[j] * rstd * gv;
            if (OUTF32) ((f32x4*)((float*)outp + (size_t)m * DM))[F.lane + 64 * j] = o;
            else { u32x2 w; w.x = pk2(o[0], o[1]); w.y = pk2(o[2], o[3]); ((u32x2*)((bf16*)outp + (size_t)m * DM))[F.lane + 64 * j] = w; } }
    }
}
#if defined(ADDNORM_NT)
#define AN_LD(p_) __builtin_nontemporal_load(p_)
#if ADDNORM_NT >= 2
#define AN_ST(p_, v_) __builtin_nontemporal_store((v_), (p_))
#else
#define AN_ST(p_, v_) (*(p_) = (v_))
#endif
#else
#define AN_LD(p_) (*(p_))
#define AN_ST(p_, v_) (*(p_) = (v_))
#endif
template <bool OUTF32> DI void addnorm_rows(const Frame& F0, const float* xin, const bf16* delta, const float* g, float* xout, void* outp) {
    const Frame F = phase_frame(F0);
    const int gw = F.bid * NWAVES + F.wave, NGW = F.G * NWAVES;
#if defined(ADDNORM_PF)
    {
        f32x4 gv[8];
#pragma unroll
        for (int j = 0; j < 8; ++j) gv[j] = ((const f32x4*)g)[F.lane + 64 * j];
        f32x4 v[8], nv[8]; u32x2 d[8], nd[8];
        int m = gw;
        if (m < M) {
#pragma unroll
            for (int j = 0; j < 8; ++j) { v[j] = AN_LD(((const f32x4*)(xin + (size_t)m * DM)) + F.lane + 64 * j); d[j] = AN_LD(((const u32x2*)(delta + (size_t)m * DM)) + F.lane + 64 * j); } }
        while (m < M) {
            const int mn = m + NGW;
            if (mn < M) {
#pragma unroll
                for (int j = 0; j < 8; ++j) { nv[j] = AN_LD(((const f32x4*)(xin + (size_t)mn * DM)) + F.lane + 64 * j); nd[j] = AN_LD(((const u32x2*)(delta + (size_t)mn * DM)) + F.lane + 64 * j); } }
            float s = 0.f;
#pragma unroll
            for (int j = 0; j < 8; ++j) { v[j][0] += bflo(d[j].x); v[j][1] += bfhi(d[j].x); v[j][2] += bflo(d[j].y); v[j][3] += bfhi(d[j].y);
                s += (v[j][0] * v[j][0] + v[j][1] * v[j][1]) + (v[j][2] * v[j][2] + v[j][3] * v[j][3]);
                if (!OUTF32) AN_ST(((f32x4*)(xout + (size_t)m * DM)) + F.lane + 64 * j, v[j]); }
            const float rstd = 1.0f / sqrtf(wave_sum(s, F.lane) * (1.0f / DM) + EPS);
#pragma unroll
            for (int j = 0; j < 8; ++j) { const f32x4 o = v[j] * rstd * gv[j];
                if (OUTF32) ((f32x4*)((float*)outp + (size_t)m * DM))[F.lane + 64 * j] = o;
                else { u32x2 w; w.x = pk2(o[0], o[1]); w.y = pk2(o[2], o[3]); ((u32x2*)((bf16*)outp + (size_t)m * DM))[F.lane + 64 * j] = w; } }
            if (mn < M) {
#pragma unroll
                for (int j = 0; j < 8; ++j) { v[j] = nv[j]; d[j] = nd[j]; } }
            m = mn;
        }
    }
#else
    for (int m = gw; m < M; m += NGW) {
        const f32x4* xr = (const f32x4*)(xin + (size_t)m * DM) + F.lane; const u32x2* dr = (const u32x2*)(delta + (size_t)m * DM) + F.lane;
        f32x4 v[8]; u32x2 d[8]; float s = 0.f;
#pragma unroll
        for (int j = 0; j < 8; ++j) { v[j] = xr[64 * j]; d[j] = dr[64 * j]; }
#pragma unroll
        for (int j = 0; j < 8; ++j) { v[j][0] += bflo(d[j].x); v[j][1] += bfhi(d[j].x); v[j][2] += bflo(d[j].y); v[j][3] += bfhi(d[j].y);
            s += (v[j][0] * v[j][0] + v[j][1] * v[j][1]) + (v[j][2] * v[j][2] + v[j][3] * v[j][3]);
            if (!OUTF32) ((f32x4*)(xout + (size_t)m * DM))[F.lane + 64 * j] = v[j]; }
        const float rstd = 1.0f / sqrtf(wave_sum(s, F.lane) * (1.0f / DM) + EPS);
#pragma unroll
        for (int j = 0; j < 8; ++j) { const f32x4 gv = ((const f32x4*)g)[F.lane + 64 * j]; const f32x4 o = v[j] * rstd * gv;
            if (OUTF32) ((f32x4*)((float*)outp + (size_t)m * DM))[F.lane + 64 * j] = o;
            else { u32x2 w; w.x = pk2(o[0], o[1]); w.y = pk2(o[2], o[3]); ((u32x2*)((bf16*)outp + (size_t)m * DM))[F.lane + 64 * j] = w; } }
    }
#endif
}
DI void unpack8(u32x4 w, float (&f)[8]) { f[0] = bflo(w.x); f[1] = bfhi(w.x); f[2] = bflo(w.y); f[3] = bfhi(w.y); f[4] = bflo(w.z); f[5] = bfhi(w.z); f[6] = bflo(w.w); f[7] = bfhi(w.w); }
DI u32x4 pack8f(const float (&f)[8]) { u32x4 o; o.x = pk2(f[0], f[1]); o.y = pk2(f[2], f[3]); o.z = pk2(f[4], f[5]); o.w = pk2(f[6], f[7]); return o; }

DI void ssd_conv_pass(const Frame& F0, const Args& A, int layer) {
    const Frame F = phase_frame(F0);
    const bf16* proj = (const bf16*)(F.ws + WS_PROJ); bf16* xbc = (bf16*)(F.ws + WS_XBC);
    const float* cw = (const float*)argin(A, 16) + (size_t)layer * 4 * SSD_XBC; const float* cb = (const float*)argin(A, 17) + (size_t)layer * SSD_XBC;
    const int gt = F.bid * NTHR + F.tid, NGT = F.G * NTHR;
    for (int task = gt; task < 512 * 384; task += NGT) {
        const int run = task / 384, cg = task - run * 384, ch = cg * 8, row0 = run * 32;
        float w[4][8], bs[8], xm3[8], xm2[8], xm1[8];
#pragma unroll
        for (int j = 0; j < 4; ++j) { const f32x4 a = *(const f32x4*)(cw + j * SSD_XBC + ch), b = *(const f32x4*)(cw + j * SSD_XBC + ch + 4);
            w[j][0] = a[0]; w[j][1] = a[1]; w[j][2] = a[2]; w[j][3] = a[3]; w[j][4] = b[0]; w[j][5] = b[1]; w[j][6] = b[2]; w[j][7] = b[3]; }
        { const f32x4 a = *(const f32x4*)(cb + ch), b = *(const f32x4*)(cb + ch + 4); bs[0] = a[0]; bs[1] = a[1]; bs[2] = a[2]; bs[3] = a[3]; bs[4] = b[0]; bs[5] = b[1]; bs[6] = b[2]; bs[7] = b[3]; }
        if ((row0 & (SEQ - 1)) != 0) {
            unpack8(*(const u32x4*)(proj + (size_t)(row0 - 3) * LDP + C_XBC + ch), xm3);
            unpack8(*(const u32x4*)(proj + (size_t)(row0 - 2) * LDP + C_XBC + ch), xm2);
            unpack8(*(const u32x4*)(proj + (size_t)(row0 - 1) * LDP + C_XBC + ch), xm1);
        } else {
#pragma unroll
            for (int k = 0; k < 8; ++k) { xm3[k] = 0.f; xm2[k] = 0.f; xm1[k] = 0.f; }
        }
#if defined(CONV_PF)
        const char* pj = (const char*)proj + (size_t)C_XBC * 2 + (size_t)ch * 2;
        auto ld8 = [&](u32x4 (&d)[8], int r) {
#pragma unroll
#if defined(CONV_NT)
            for (int q = 0; q < 8; ++q) d[q] = __builtin_nontemporal_load((const u32x4*)(pj + (unsigned)((row0 + r + q) * LDP) * 2u)); };
#else
            for (int q = 0; q < 8; ++q) d[q] = *(const u32x4*)(pj + (unsigned)((row0 + r + q) * LDP) * 2u); };
#endif
        auto do8 = [&](const u32x4 (&d)[8], int r) {
#pragma unroll
            for (int q = 0; q < 8; ++q) { float cur[8], y[8]; unpack8(d[q], cur);
#pragma unroll
                for (int k = 0; k < 8; ++k) { const float v = w[0][k] * xm3[k] + w[1][k] * xm2[k] + w[2][k] * xm1[k] + w[3][k] * cur[k] + bs[k]; y[k] = siluf_(v); xm3[k] = xm2[k]; xm2[k] = xm1[k]; xm1[k] = cur[k]; }
                *(u32x4*)(xbc + (size_t)(row0 + r + q) * SSD_XBC + ch) = pack8f(y); } };
        u32x4 PA[8], PB[8];
        ld8(PA, 0);
#pragma unroll 1
        for (int r = 0; r < 32; r += 16) {
            ld8(PB, r + 8); do8(PA, r);
            if (r + 16 < 32) ld8(PA, r + 16);
            do8(PB, r + 8);
        }
#else
#pragma unroll 4
        for (int r = 0; r < 32; ++r) {
            float cur[8], y[8]; unpack8(*(const u32x4*)(proj + (size_t)(row0 + r) * LDP + C_XBC + ch), cur);
#pragma unroll
            for (int k = 0; k < 8; ++k) { const float v = w[0][k] * xm3[k] + w[1][k] * xm2[k] + w[2][k] * xm1[k] + w[3][k] * cur[k] + bs[k]; y[k] = siluf_(v); xm3[k] = xm2[k]; xm2[k] = xm1[k]; xm1[k] = cur[k]; }
            *(u32x4*)(xbc + (size_t)(row0 + r) * SSD_XBC + ch) = pack8f(y);
        }
#endif
    }
    const float* dtb = (const float*)argin(A, 18) + layer * SSD_H; float* dt = (float*)(F.ws + WS_DT);
    for (int i = gt; i < M * SSD_H; i += NGT) { const int row = i >> 5, h = i & 31;
        const float x = bf2f(proj[(size_t)row * LDP + C_DT + h]) + dtb[h];
        dt[i] = fmaxf(x, 0.f) + log1pf(__expf(-fabsf(x))); }
}

DI void merge_pass(const Frame& F0, const Args& A, int layer) {
    const Frame F = phase_frame(F0);
    const bf16* proj = (const bf16*)(F.ws + WS_PROJ); const bf16* ya = (const bf16*)(F.ws + WS_YA); const bf16* yc = (const bf16*)(F.ws + WS_YC); bf16* hb = (bf16*)(F.ws + WS_HB);
    const float* sw = (const float*)argin(A, 15) + (size_t)layer * 3 * DM; const float* ngp = (const float*)argin(A, 21) + (size_t)layer * DM; const float* rstdp = (const float*)(F.ws + WS_RSTD);
    const int gt = F.bid * NTHR + F.tid, NGT = F.G * NTHR;
    for (int task = gt; task < 512 * 256; task += NGT) {
        const int run = task >> 8, cg = task & 255, ch = cg * 8, row0 = run * 32;
        float w[3][8], pm2[8], pm1[8], ng8[8];
        { const f32x4 a = *(const f32x4*)(ngp + ch), b = *(const f32x4*)(ngp + ch + 4); ng8[0] = a[0]; ng8[1] = a[1]; ng8[2] = a[2]; ng8[3] = a[3]; ng8[4] = b[0]; ng8[5] = b[1]; ng8[6] = b[2]; ng8[7] = b[3]; }
#pragma unroll
        for (int j = 0; j < 3; ++j) { const f32x4 a = *(const f32x4*)(sw + j * DM + ch), b = *(const f32x4*)(sw + j * DM + ch + 4);
            w[j][0] = a[0]; w[j][1] = a[1]; w[j][2] = a[2]; w[j][3] = a[3]; w[j][4] = b[0]; w[j][5] = b[1]; w[j][6] = b[2]; w[j][7] = b[3]; }
        if ((row0 & (SEQ - 1)) != 0) {
            float c1[8], u1[8];
            unpack8(*(const u32x4*)(proj + (size_t)(row0 - 2) * LDP + C_CC + ch), c1); unpack8(*(const u32x4*)(proj + (size_t)(row0 - 2) * LDP + C_CU + ch), u1);
#pragma unroll
            for (int k = 0; k < 8; ++k) pm2[k] = c1[k] * u1[k];
            unpack8(*(const u32x4*)(proj + (size_t)(row0 - 1) * LDP + C_CC + ch), c1); unpack8(*(const u32x4*)(proj + (size_t)(row0 - 1) * LDP + C_CU + ch), u1);
#pragma unroll
            for (int k = 0; k < 8; ++k) pm1[k] = c1[k] * u1[k];
        } else {
#pragma unroll
            for (int k = 0; k < 8; ++k) { pm2[k] = 0.f; pm1[k] = 0.f; }
        }
#if defined(MERGE_PF)
        struct MR { u32x4 cc, cu, cb, g0, g1, g2, a, c; float rs; };
        auto ldrow = [&](MR& d, int r) { const unsigned pro = (unsigned)((row0 + r) * LDP + ch) * 2u, yro = (unsigned)((row0 + r) * DM + ch) * 2u;
            const char* pj = (const char*)proj;
#if defined(MERGE_NT)
#define MG_LD(p_) __builtin_nontemporal_load((const u32x4*)(p_))
#else
#define MG_LD(p_) (*(const u32x4*)(p_))
#endif
            d.cc = MG_LD(pj + pro + C_CC * 2); d.cu = MG_LD(pj + pro + C_CU * 2); d.cb = MG_LD(pj + pro + C_CB * 2);
            d.g0 = MG_LD(pj + pro + C_GM * 2); d.g1 = MG_LD(pj + pro + (C_GM + DM) * 2); d.g2 = MG_LD(pj + pro + (C_GM + 2 * DM) * 2);
#if MERGE_NT == 2
            d.a = *(const u32x4*)((const char*)ya + yro); d.c = *(const u32x4*)((const char*)yc + yro);
#else
            d.a = MG_LD((const char*)ya + yro); d.c = MG_LD((const char*)yc + yro);
#endif
            d.rs = rstdp[(unsigned)((row0 + r) * SSD_G + (ch >> 9))]; };
        auto dorow = [&](const MR& d, int r) { const size_t yr = (size_t)(row0 + r) * DM + ch;
            float cc[8], cu[8], cbv[8], g0[8], g1[8], g2[8], a[8], c[8], o[8];
            unpack8(d.cc, cc); unpack8(d.cu, cu); unpack8(d.cb, cbv); unpack8(d.g0, g0); unpack8(d.g1, g1); unpack8(d.g2, g2); unpack8(d.a, a); unpack8(d.c, c);
#pragma unroll
            for (int k = 0; k < 8; ++k) { const float pc = cc[k] * cu[k]; const float cv = w[0][k] * pm2[k] + w[1][k] * pm1[k] + w[2][k] * pc; pm2[k] = pm1[k]; pm1[k] = pc;
                o[k] = sigmoidf_(g0[k]) * a[k] + sigmoidf_(g1[k]) * (cbv[k] * cv) + sigmoidf_(g2[k]) * (c[k] * d.rs * ng8[k]); }
            *(u32x4*)(hb + yr) = pack8f(o); };
#if MERGE_PF == 3
        MR A0, A1, A2;
        ldrow(A0, 0); ldrow(A1, 1);
#pragma unroll 1
        for (int r = 0; r < 30; r += 3) {
            ldrow(A2, r + 2); dorow(A0, r);
            ldrow(A0, r + 3); dorow(A1, r + 1);
            ldrow(A1, r + 4); dorow(A2, r + 2);
        }
        dorow(A0, 30); dorow(A1, 31);
#else
        MR A0, B0;
        ldrow(A0, 0);
#pragma unroll 1
        for (int r = 0; r < 32; r += 2) {
            ldrow(B0, r + 1); dorow(A0, r);
            if (r + 2 < 32) ldrow(A0, r + 2);
            dorow(B0, r + 1);
        }
#endif
#else
#if !defined(MERGE_UNROLL)
#define MERGE_UNROLL 2
#endif
#pragma unroll MERGE_UNROLL
        for (int r = 0; r < 32; ++r) {
            const size_t pr = (size_t)(row0 + r) * LDP + ch, yr = (size_t)(row0 + r) * DM + ch;
            float cc[8], cu[8], cbv[8], g0[8], g1[8], g2[8], a[8], c[8], o[8];
            unpack8(*(const u32x4*)(proj + pr + C_CC), cc); unpack8(*(const u32x4*)(proj + pr + C_CU), cu); unpack8(*(const u32x4*)(proj + pr + C_CB), cbv);
            unpack8(*(const u32x4*)(proj + pr + C_GM), g0); unpack8(*(const u32x4*)(proj + pr + C_GM + DM), g1); unpack8(*(const u32x4*)(proj + pr + C_GM + 2 * DM), g2);
            unpack8(*(const u32x4*)(ya + yr), a); unpack8(*(const u32x4*)(yc + yr), c);
            const float rs = rstdp[(size_t)(row0 + r) * SSD_G + (ch >> 9)];
#pragma unroll
            for (int k = 0; k < 8; ++k) { const float pc = cc[k] * cu[k]; const float cv = w[0][k] * pm2[k] + w[1][k] * pm1[k] + w[2][k] * pc; pm2[k] = pm1[k]; pm1[k] = pc;
                o[k] = sigmoidf_(g0[k]) * a[k] + sigmoidf_(g1[k]) * (cbv[k] * cv) + sigmoidf_(g2[k]) * (c[k] * rs * ng8[k]); }
            *(u32x4*)(hb + yr) = pack8f(o);
        }
#endif
    }
}

DI void compress_phase(const Frame& F0, const Args& A, int layer) {
    const Frame F = phase_frame(F0);
    const bf16* proj = (const bf16*)(F.ws + WS_PROJ);
    LAS unsigned char* slab = F.lds;
    LAS unsigned char* hidl = F.lds + 73728;
    LAS float* b1s = (LAS float*)(F.lds + 81920);
    const int lane = F.lane, w = F.wave, i = lane & 15, qd = lane >> 4;
    const float* part = (const float*)(F.ws + WS_MISC);
    for (int u = F.bid; u < 512; u += F.G) {
        const int kv = u >> 8, b = (u >> 7) & 1, g = (u >> 5) & 3, nb = u & 31, n0 = nb * 16, tok0 = n0 * 16;
        const bf16* src = (const bf16*)(F.ws + WS_KV) + kv_off(kv, b, g, 0);
        for (int id = F.tid; id < 272 * 16; id += NTHR) { const int row = id >> 4, ch = id & 15, t = tok0 + row;
            u32x4 v = {0u, 0u, 0u, 0u}; if (t < SEQ) v = __builtin_nontemporal_load((const u32x4*)(src + (size_t)t * HD + ch * 8));
            *(LAS u32x4*)(slab + off_b(row, ch)) = v; }
        if (F.tid < 128) { float s = ((const float*)argin(A, kv ? 12 : 8))[layer * 128 + F.tid];
#pragma unroll
            for (int c = 0; c < PCH; ++c) s += part[(((size_t)layer * 2 + kv) * PCH + c) * 128 + F.tid];
            b1s[F.tid] = s; }
        __syncthreads();
#if defined(CMP_W2_HOIST)
        bf16x8 w2f[4]; { const bf16* w2p = (const bf16*)lw_ptr(F, layer, kv ? LW_PV2 : LW_PK2) + (size_t)(16 * w + i) * 128 + 8 * qd;
#pragma unroll
          for (int s_ = 0; s_ < 4; ++s_) w2f[s_] = *(const bf16x8*)(w2p + 32 * s_); }
        const float b2h = ((const float*)argin(A, kv ? 14 : 10))[layer * 128 + 16 * w + i];
#endif
        const bf16* w1t = (const bf16*)lw_ptr(F, layer, kv ? LW_PV1 : LW_PK1) + ((size_t)w * 128 * 64 + lane) * 8;
        f32x4 acc = {0.f, 0.f, 0.f, 0.f};
#if defined(SSD_IGLP)
        __builtin_amdgcn_iglp_opt(0);
#endif
#if defined(CMP_PF)
        {
            bf16x8 ba[16], bc[16];
#pragma unroll
            for (int k = 0; k < 16; ++k) ba[k] = *(const bf16x8*)(w1t + 512 * k);
#pragma unroll 1
            for (int k0 = 0; k0 < 128; k0 += 32) {
#pragma unroll
                for (int k = 0; k < 16; ++k) bc[k] = *(const bf16x8*)(w1t + 512 * (k0 + 16 + k));
#pragma unroll
                for (int k = 0; k < 16; ++k) { const int ks = k0 + k; acc = MFMA16(lds_rd8(slab + off_b(16 * i + (ks >> 2), 4 * (ks & 3) + qd)), ba[k], acc); }
                if (k0 + 32 < 128) {
#pragma unroll
                    for (int k = 0; k < 16; ++k) ba[k] = *(const bf16x8*)(w1t + 512 * (k0 + 32 + k)); }
#pragma unroll
                for (int k = 0; k < 16; ++k) { const int ks = k0 + 16 + k; acc = MFMA16(lds_rd8(slab + off_b(16 * i + (ks >> 2), 4 * (ks & 3) + qd)), bc[k], acc); }
            }
        }
#else
        for (int k0 = 0; k0 < 128; k0 += 32) {
            bf16x8 bb[32];
#pragma unroll
            for (int k = 0; k < 32; ++k) bb[k] = *(const bf16x8*)(w1t + 512 * (k0 + k));
#pragma unroll
            for (int k = 0; k < 32; ++k) { const int ks = k0 + k;
                acc = MFMA16(lds_rd8(slab + off_b(16 * i + (ks >> 2), 4 * (ks & 3) + qd)), bb[k], acc); }
        }
#endif
        { const float bv = b1s[16 * w + i];
#pragma unroll
          for (int j = 0; j < 4; ++j) *(LAS bf16*)(hidl + (4 * qd + j) * 272 + (16 * w + i) * 2) = (bf16)f2bf(siluf_(acc[j] + bv)); }
        __syncthreads();
        const bf16* w2t = (const bf16*)lw_ptr(F, layer, kv ? LW_PV2 : LW_PK2) + (size_t)(16 * w + i) * 128 + 8 * qd;
        f32x4 acc2 = {0.f, 0.f, 0.f, 0.f};
#pragma unroll
        for (int s = 0; s < 4; ++s) {
            const bf16x8 a = lds_rd8(hidl + i * 272 + 64 * s + 16 * qd);
#if defined(CMP_W2_HOIST)
            const bf16x8 bb = w2f[s];
#else
            const bf16x8 bb = *(const bf16x8*)(w2t + 32 * s);
#endif
            acc2 = MFMA16(a, bb, acc2);
        }
#if defined(CMP_W2_HOIST)
        const float b2 = b2h;
#else
        const float b2 = ((const float*)argin(A, kv ? 14 : 10))[layer * 128 + 16 * w + i];
#endif
        bf16* dst = (bf16*)(F.ws + (kv ? WS_VCMP : WS_KCMP)) + ((size_t)(b * NG + g) * NCMP_PAD + n0) * HD + 16 * w + i;
#pragma unroll
        for (int j = 0; j < 4; ++j) dst[(size_t)(4 * qd + j) * HD] = (bf16)f2bf(acc2[j] + b2);
        __syncthreads();
    }
}

DI unsigned pk2_sw(float a, float b) {
    unsigned ua = __builtin_bit_cast(unsigned, a), ub = __builtin_bit_cast(unsigned, b);
    ua += 0x7FFFu + ((ua >> 16) & 1u); ub += 0x7FFFu + ((ub >> 16) & 1u);
    return (ua >> 16) | (ub & 0xFFFF0000u);
}
DI void ssd_states_phase(const Frame& F0, const Args& A, int layer) {
    const Frame F = phase_frame(F0);
    const bf16* xbc = (const bf16*)(F.ws + WS_XBC); const float* dt = (const float*)(F.ws + WS_DT);
    float* acs = (float*)(F.ws + WS_ACS); float* cdec = (float*)(F.ws + WS_CDEC); float* st = (float*)(F.ws + WS_ST);
    LAS unsigned char* Bt = F.lds; LAS unsigned char* Xt = F.lds + 32768; LAS float* sc = (LAS float*)(F.lds + 65536);
    const float* alog = (const float*)argin(A, 19) + layer * SSD_H;
    const int lane = F.lane, w = F.wave, i = lane & 15, qd = lane >> 4;
    for (int u = F.bid; u < 512; u += F.G) {
        const int b = u >> 8, c = (u >> 2) & 63, g = u & 3, row0 = b * SEQ + c * SSD_CH;
        {
            const int hh = g * 8 + w; const float a = -__expf(alog[hh]);
            const float dt0 = dt[(size_t)(row0 + 2 * lane) * SSD_H + hh], dt1 = dt[(size_t)(row0 + 2 * lane + 1) * SSD_H + hh];
            const float d0 = dt0 * a, d1 = dt1 * a, pair = d0 + d1; float s = pair;
#pragma unroll
            for (int o = 1; o < 64; o <<= 1) { const float t = shfl_idx(s, lane - o); if (lane >= o) s += t; }
            const float a0 = (s - pair) + d0, a1 = s, total = __builtin_bit_cast(float, __builtin_amdgcn_readlane(__builtin_bit_cast(int, s), 63));
            acs[(size_t)(row0 + 2 * lane) * SSD_H + hh] = a0; acs[(size_t)(row0 + 2 * lane + 1) * SSD_H + hh] = a1;
            sc[w * 128 + 2 * lane] = dt0 * __expf(total - a0); sc[w * 128 + 2 * lane + 1] = dt1 * __expf(total - a1);
            if (lane == 0) cdec[(size_t)(b * SSD_NC + c) * SSD_H + hh] = __expf(total);
        }
#if defined(S1_PRELOAD)
        u32x4 xr[4][4];
#pragma unroll
        for (int hp = 0; hp < 4; ++hp)
#pragma unroll
            for (int j = 0; j < 4; ++j) { const int id = F.tid + NTHR * j, row = id >> 4, ch = id & 15;
                xr[hp][j] = *(const u32x4*)(xbc + (size_t)(row0 + row) * SSD_XBC + g * 512 + hp * 128 + ch * 8); }
#pragma unroll
        for (int j = 0; j < 4; ++j) { const int id = F.tid + NTHR * j, row = id >> 4, ch = id & 15;
            *(LAS u32x4*)(Bt + off_b(row, ch)) = *(const u32x4*)(xbc + (size_t)(row0 + row) * SSD_XBC + 2048 + g * 128 + ch * 8); }
        __syncthreads();
        bf16x8 bfr[4];
#pragma unroll
        for (int ks = 0; ks < 4; ++ks) bfr[ks] = tr_read8(Bt, lane, 32 * ks, w);
#pragma unroll
        for (int hp = 0; hp < 4; ++hp) {
            LAS unsigned char* Xb = Xt + (hp & 1) * 32768 + ((hp & 1) ? 4096 : 0);
#pragma unroll
            for (int j = 0; j < 4; ++j) { const int id = F.tid + NTHR * j, row = id >> 4, ch = id & 15;
                float x[8]; unpack8(xr[hp][j], x);
                const float f = sc[(hp * 2 + (ch >> 3)) * 128 + row];
#pragma unroll
                for (int k = 0; k < 8; ++k) x[k] *= f;
                *(LAS u32x4*)(Xb + off_b(row, ch)) = pack8f(x); }
            __syncthreads();
#pragma unroll
            for (int h2 = 0; h2 < 2; ++h2) {
                const int head = g * 8 + hp * 2 + h2;
                float* dst = st + ((size_t)((b * SSD_NC + c) * SSD_H + head) * SSD_N + 16 * w + i) * SSD_P + 4 * qd;
#pragma unroll
                for (int pt = 0; pt < 4; ++pt) {
                    f32x4 acc = {0.f, 0.f, 0.f, 0.f};
#pragma unroll
                    for (int ks = 0; ks < 4; ++ks) acc = MFMA16(tr_read8(Xb, lane, 32 * ks, h2 * 4 + pt), bfr[ks], acc);
#if defined(ST_BF16)
                    { u32x2 o_; o_.x = pk2_sw(acc[0], acc[1]); o_.y = pk2_sw(acc[2], acc[3]); *(u32x2*)((bf16*)st + (size_t)(dst - st) + 16 * pt) = o_; }
#else
                    *(f32x4*)(dst + 16 * pt) = acc;
#endif
                }
            }
        }
#else
        for (int id = F.tid; id < 128 * 16; id += NTHR) { const int row = id >> 4, ch = id & 15;
            *(LAS u32x4*)(Bt + off_b(row, ch)) = *(const u32x4*)(xbc + (size_t)(row0 + row) * SSD_XBC + 2048 + g * 128 + ch * 8); }
        bf16x8 bfr[4];
        for (int hp = 0; hp < 4; ++hp) {
            __syncthreads();
            for (int id = F.tid; id < 128 * 16; id += NTHR) { const int row = id >> 4, ch = id & 15;
                float x[8]; unpack8(*(const u32x4*)(xbc + (size_t)(row0 + row) * SSD_XBC + g * 512 + hp * 128 + ch * 8), x);
                const float f = sc[(hp * 2 + (ch >> 3)) * 128 + row];
#pragma unroll
                for (int k = 0; k < 8; ++k) x[k] *= f;
                *(LAS u32x4*)(Xt + off_b(row, ch)) = pack8f(x); }
            __syncthreads();
            if (hp == 0) {
#pragma unroll
                for (int ks = 0; ks < 4; ++ks) bfr[ks] = tr_read8(Bt, lane, 32 * ks, w);
            }
#pragma unroll
            for (int h2 = 0; h2 < 2; ++h2) {
                const int head = g * 8 + hp * 2 + h2;
                float* dst = st + ((size_t)((b * SSD_NC + c) * SSD_H + head) * SSD_N + 16 * w + i) * SSD_P + 4 * qd;
#pragma unroll
                for (int pt = 0; pt < 4; ++pt) {
                    f32x4 acc = {0.f, 0.f, 0.f, 0.f};
#pragma unroll
                    for (int ks = 0; ks < 4; ++ks) acc = MFMA16(tr_read8(Xt, lane, 32 * ks, h2 * 4 + pt), bfr[ks], acc);
#if defined(ST_BF16)
                    { u32x2 o_; o_.x = pk2_sw(acc[0], acc[1]); o_.y = pk2_sw(acc[2], acc[3]); *(u32x2*)((bf16*)st + (size_t)(dst - st) + 16 * pt) = o_; }
#else
                    *(f32x4*)(dst + 16 * pt) = acc;
#endif
                }
            }
        }
#endif
        __syncthreads();
    }
}
DI void ssd_scan_phase(const Frame& F0) {
    const Frame F = phase_frame(F0);
    const f32x4* st = (const f32x4*)(F.ws + WS_ST); u32x2* hin = (u32x2*)(F.ws + WS_HIN); const float* cdec = (const float*)(F.ws + WS_CDEC);
    const int gt = F.bid * NTHR + F.tid, NGT = F.G * NTHR;
    for (int v = gt; v < BATCH * SSD_H * 2048; v += NGT) {
        const int b = v >> 16, h = (v >> 11) & 31, e = v & 2047;
        const size_t o0 = ((size_t)(b * SSD_NC) * SSD_H + h) * 2048 + e;
        const float* dc = cdec + (size_t)(b * SSD_NC) * SSD_H + h;
        f32x4 hs = {0.f, 0.f, 0.f, 0.f};
#if defined(S2_PF) && defined(ST_BF16)
        {
#pragma unroll 1
            for (int c0 = 0; c0 < SSD_NC; c0 += 32) {
                u32x2 raw[32]; float dd[32];
#pragma unroll
                for (int k = 0; k < 32; ++k) { raw[k] = __builtin_nontemporal_load(((const u32x2*)st) + o0 + (size_t)(c0 + k) * 65536); dd[k] = dc[(c0 + k) * SSD_H]; }
#pragma unroll
                for (int k = 0; k < 32; ++k) { u32x2 o; o.x = pk2(hs[0], hs[1]); o.y = pk2(hs[2], hs[3]); hin[o0 + (size_t)(c0 + k) * 65536] = o;
                    const f32x4 sv = {bflo(raw[k].x), bfhi(raw[k].x), bflo(raw[k].y), bfhi(raw[k].y)}; hs = hs * dd[k] + sv; }
            }
        }
#else
        for (int c0 = 0; c0 < SSD_NC; c0 += 8) {
            f32x4 s[8]; float d[8];
#pragma unroll
#if defined(ST_BF16)
            for (int k = 0; k < 8; ++k) { const u32x2 t_ = ((const u32x2*)st)[o0 + (size_t)(c0 + k) * 65536]; s[k][0] = bflo(t_.x); s[k][1] = bfhi(t_.x); s[k][2] = bflo(t_.y); s[k][3] = bfhi(t_.y); d[k] = dc[(c0 + k) * SSD_H]; }
#else
            for (int k = 0; k < 8; ++k) { s[k] = st[o0 + (size_t)(c0 + k) * 65536]; d[k] = dc[(c0 + k) * SSD_H]; }
#endif
#pragma unroll
            for (int k = 0; k < 8; ++k) { u32x2 o; o.x = pk2(hs[0], hs[1]); o.y = pk2(hs[2], hs[3]); hin[o0 + (size_t)(c0 + k) * 65536] = o; hs = hs * d[k] + s[k]; }
        }
#endif
    }
}
DI void ssd_out_phase(const Frame& F0, const Args& A, int layer) {
    const Frame F = phase_frame(F0);
    const bf16* xbc = (const bf16*)(F.ws + WS_XBC); const bf16* proj = (const bf16*)(F.ws + WS_PROJ);
    const float* dt = (const float*)(F.ws + WS_DT); const float* acs = (const float*)(F.ws + WS_ACS); const bf16* hin = (const bf16*)(F.ws + WS_HIN);
    bf16* yc = (bf16*)(F.ws + WS_YC); float* rstdp = (float*)(F.ws + WS_RSTD);
    LAS unsigned char* Bt = F.lds; LAS unsigned char* Ct = F.lds + 32768; LAS unsigned char* Xt = F.lds + 65536; LAS unsigned char* Ht = F.lds + 98304;
    LAS float* acsl = (LAS float*)(F.lds + LX_OFF);
    const float* dsk = (const float*)argin(A, 20) + layer * SSD_H;
    const int lane = F.lane, w = F.wave, i = lane & 15, qd = lane >> 4;
    for (int u = F.bid; u < 512; u += F.G) {
        const int b = u >> 8, c = (u >> 2) & 63, g = u & 3, row0 = b * SEQ + c * SSD_CH;
        for (int id = F.tid; id < 128 * 16; id += NTHR) { const int row = id >> 4, ch = id & 15; const bf16* src = xbc + (size_t)(row0 + row) * SSD_XBC + 2048 + g * 128 + ch * 8;
            *(LAS u32x4*)(Bt + off_b(row, ch)) = *(const u32x4*)(src); *(LAS u32x4*)(Ct + off_b(row, ch)) = *(const u32x4*)(src + 512); }
        __syncthreads();
        bf16x8 cfr[4];
#pragma unroll
        for (int ks = 0; ks < 4; ++ks) cfr[ks] = lds_rd8(Ct + off_b(16 * w + i, 4 * ks + qd));
        f32x4 cb[4][2];
#pragma unroll
        for (int k = 0; k < 4; ++k)
#pragma unroll
            for (int T = 0; T < 2; ++T) { f32x4 acc = {0.f, 0.f, 0.f, 0.f};
#pragma unroll
                for (int ks = 0; ks < 4; ++ks) acc = MFMA16(lds_rd8(Bt + off_b(32 * k + 8 * (i >> 2) + (i & 3) + 4 * T, 4 * ks + qd)), cfr[ks], acc);
                cb[k][T] = acc; }
        const int lrow = 16 * w + i, row = row0 + lrow;
        float ssq = 0.f;
#if defined(S3_PREFETCH)
#if defined(S3_NT)
#define S3_LD(p_) __builtin_nontemporal_load(p_)
#else
#define S3_LD(p_) (*(p_))
#endif
        u32x4 px[4], ph[4]; float pd[4], pa = 0.f;
#define S3_PF_LOAD(HP) do { \
            if (F.tid < 256) { const int h2_ = F.tid >> 7, l_ = F.tid & 127; pa = acs[(size_t)(row0 + l_) * SSD_H + g * 8 + (HP) * 2 + h2_]; } \
            _Pragma("unroll") for (int j_ = 0; j_ < 4; ++j_) { const int id_ = F.tid + NTHR * j_, r_ = id_ >> 4, ch_ = id_ & 15, head_ = g * 8 + (HP) * 2 + (ch_ >> 3); \
                px[j_] = S3_LD((const u32x4*)(xbc + (size_t)(row0 + r_) * SSD_XBC + g * 512 + (HP) * 128 + ch_ * 8)); pd[j_] = dt[(size_t)(row0 + r_) * SSD_H + head_]; \
                ph[j_] = S3_LD((const u32x4*)(hin + ((size_t)((b * SSD_NC + c) * SSD_H + head_) * SSD_N + r_) * SSD_P + (ch_ & 7) * 8)); } } while (0)
        S3_PF_LOAD(0);
#endif
        for (int hp = 0; hp < 4; ++hp) {
            __syncthreads();
#if defined(S3_PREFETCH)
            if (F.tid < 256) acsl[F.tid] = pa;
#pragma unroll
            for (int j = 0; j < 4; ++j) { const int id = F.tid + NTHR * j, r = id >> 4, ch = id & 15;
                float x[8]; unpack8(px[j], x);
#pragma unroll
                for (int k = 0; k < 8; ++k) x[k] *= pd[j];
                *(LAS u32x4*)(Xt + off_b(r, ch)) = pack8f(x); *(LAS u32x4*)(Ht + off_b(r, ch)) = ph[j]; }
            __syncthreads();
            u32x2 xva[4], zva[4];
#pragma unroll
            for (int pt = 0; pt < 4; ++pt) { const int chn = (g * 8 + hp * 2) * SSD_P + 16 * pt + 4 * qd;
                xva[pt] = *(const u32x2*)(xbc + (size_t)row * SSD_XBC + chn); zva[pt] = S3_LD((const u32x2*)(proj + (size_t)row * LDP + C_Z + chn)); }
            __builtin_amdgcn_sched_barrier(0);
            if (hp < 3) S3_PF_LOAD(hp + 1);
            __builtin_amdgcn_sched_barrier(0);
#else
            if (F.tid < 256) { const int h2 = F.tid >> 7, l = F.tid & 127; acsl[F.tid] = acs[(size_t)(row0 + l) * SSD_H + g * 8 + hp * 2 + h2]; }
            for (int id = F.tid; id < 128 * 16; id += NTHR) { const int r = id >> 4, ch = id & 15, head = g * 8 + hp * 2 + (ch >> 3);
                float x[8]; unpack8(*(const u32x4*)(xbc + (size_t)(row0 + r) * SSD_XBC + g * 512 + hp * 128 + ch * 8), x);
                const float f = dt[(size_t)(row0 + r) * SSD_H + head];
#pragma unroll
                for (int k = 0; k < 8; ++k) x[k] *= f;
                *(LAS u32x4*)(Xt + off_b(r, ch)) = pack8f(x);
                *(LAS u32x4*)(Ht + off_b(r, ch)) = *(const u32x4*)(hin + ((size_t)((b * SSD_NC + c) * SSD_H + head) * SSD_N + r) * SSD_P + (ch & 7) * 8); }
            __syncthreads();
#endif
#if defined(S3_PREFETCH)
#pragma unroll 1
#else
#pragma unroll
#endif
            for (int h2 = 0; h2 < 2; ++h2) {
                const int head = g * 8 + hp * 2 + h2;
#if defined(SSD_IGLP)
                __builtin_amdgcn_iglp_opt(0);
#endif
                const float al = acsl[h2 * 128 + lrow], ea = __expf(al), dsv = dsk[head];
#if defined(S3_PREFETCH)
                if (h2 == 1) {
#pragma unroll
                    for (int pt = 0; pt < 4; ++pt) { const int chn = head * SSD_P + 16 * pt + 4 * qd;
                        xva[pt] = *(const u32x2*)(xbc + (size_t)row * SSD_XBC + chn); zva[pt] = S3_LD((const u32x2*)(proj + (size_t)row * LDP + C_Z + chn)); } }
#else
                u32x2 xv4[4], zv4[4];
#pragma unroll
                for (int pt = 0; pt < 4; ++pt) { const int chn = head * SSD_P + 16 * pt + 4 * qd;
                    xv4[pt] = *(const u32x2*)(xbc + (size_t)row * SSD_XBC + chn); zv4[pt] = *(const u32x2*)(proj + (size_t)row * LDP + C_Z + chn); }
#endif
                bf16x8 mfr[4];
#pragma unroll
                for (int k = 0; k < 4; ++k) {
                    const f32x4 a0 = *(const LAS f32x4*)(acsl + h2 * 128 + 32 * k + 8 * qd), a1 = *(const LAS f32x4*)(acsl + h2 * 128 + 32 * k + 8 * qd + 4);
                    float mv[8];
#pragma unroll
                    for (int j = 0; j < 4; ++j) { const int s0 = 32 * k + 8 * qd + j, s1 = s0 + 4;
                        mv[j] = (s0 <= lrow) ? cb[k][0][j] * __expf(al - a0[j]) : 0.f;
                        mv[4 + j] = (s1 <= lrow) ? cb[k][1][j] * __expf(al - a1[j]) : 0.f; }
                    mfr[k] = as_bf16x8(pack8f(mv));
                }
#pragma unroll
                for (int pt = 0; pt < 4; ++pt) {
                    f32x4 yd = {0.f, 0.f, 0.f, 0.f}, yo = {0.f, 0.f, 0.f, 0.f};
#pragma unroll
                    for (int k = 0; k < 4; ++k) yd = MFMA16(tr_read8(Xt, lane, 32 * k, h2 * 4 + pt), mfr[k], yd);
#pragma unroll
                    for (int ks = 0; ks < 4; ++ks) yo = MFMA16(tr_read8(Ht, lane, 32 * ks, h2 * 4 + pt), cfr[ks], yo);
                    const int chn = head * SSD_P + 16 * pt + 4 * qd;
#if defined(S3_PREFETCH)
                    const u32x2 xv = xva[pt], zv = zva[pt];
#else
                    const u32x2 xv = xv4[pt], zv = zv4[pt];
#endif
                    const float xs[4] = {bflo(xv.x), bfhi(xv.x), bflo(xv.y), bfhi(xv.y)}, zz[4] = {bflo(zv.x), bfhi(zv.x), bflo(zv.y), bfhi(zv.y)};
                    float gy[4];
#pragma unroll
                    for (int j = 0; j < 4; ++j) { const float y = yd[j] + ea * yo[j] + dsv * xs[j]; gy[j] = y * siluf_(zz[j]); ssq += gy[j] * gy[j]; }
                    u32x2 o; o.x = pk2(gy[0], gy[1]); o.y = pk2(gy[2], gy[3]);
#if defined(S3_NT)
                    __builtin_nontemporal_store(o, (u32x2*)(yc + (size_t)row * DM + chn));
#else
                    *(u32x2*)(yc + (size_t)row * DM + chn) = o;
#endif
                }
            }
        }
        ssq += shx(ssq, 16, lane); ssq += shx(ssq, 32, lane);
        if (qd == 0) rstdp[(size_t)row * SSD_G + g] = 1.0f / sqrtf(ssq * (1.0f / 512.0f) + EPS);
        __syncthreads();
    }
}

#ifndef NSA_REP_PART
#define NSA_REP_PART 0
#endif
#if NSA_REP_PART == 7
#define W7DUP(x) x
#define W7WAIT() NSA_WAITV(8)
#else
#define W7DUP(x)
#define W7WAIT() NSA_WAITV(4)
#endif
#if NSA_REP_PART == 10
#define SELDUP(x) x
#else
#define SELDUP(x)
#endif
constexpr int RB = 32768, NRING = 3;
#define NSA_WAITV(n) asm volatile("s_waitcnt vmcnt(" #n ")" ::: "memory")
#define NSA_BAR() do { asm volatile("" ::: "memory"); __builtin_amdgcn_s_barrier(); asm volatile("" ::: "memory"); } while (0)
template <bool WITHV> DI void tile_dma(LAS unsigned char* buf, const bf16* kp, const bf16* vp, int pitch, int w, int lane) {
#pragma unroll
    for (int e = 0; e < 2; ++e) { const int kb = 2 * w + e, kh = kb >> 3, T = (kb >> 2) & 1, ks = kb & 3, i = lane & 15, qd = lane >> 4;
        const int key = 32 * kh + 8 * (i >> 2) + (i & 3) + 4 * T, ch = 4 * ks + qd;
        __builtin_amdgcn_global_load_lds((const unsigned*)(kp + (size_t)key * pitch + ch * 8), (LAS unsigned*)(buf + kb * 1024), 16, 0, 0); }
    if (WITHV) {
#pragma unroll
        for (int e = 0; e < 2; ++e) { const int vb = 2 * w + e, kh = vb >> 3, t = (vb >> 2) & 1, dtp = vb & 3, dtl = lane >> 5, g = (lane >> 3) & 3, q = (lane >> 1) & 3, ph = lane & 1;
            const int key = 32 * kh + 8 * g + 4 * t + q, ch = 4 * dtp + 2 * dtl + ph;
            __builtin_amdgcn_global_load_lds((const unsigned*)(vp + (size_t)key * pitch + ch * 8), (LAS unsigned*)(buf + 16384 + vb * 1024), 16, 0, 0); }
    }
}
#define NSA_TR8(r, addr, b) asm volatile("ds_read_b64_tr_b16 %0, %8 offset:%9\n\tds_read_b64_tr_b16 %1, %8 offset:%10\n\tds_read_b64_tr_b16 %2, %8 offset:%11\n\tds_read_b64_tr_b16 %3, %8 offset:%12\n\t" \
        "ds_read_b64_tr_b16 %4, %8 offset:%13\n\tds_read_b64_tr_b16 %5, %8 offset:%14\n\tds_read_b64_tr_b16 %6, %8 offset:%15\n\tds_read_b64_tr_b16 %7, %8 offset:%16" \
        : "=&v"(r[0]), "=&v"(r[1]), "=&v"(r[2]), "=&v"(r[3]), "=&v"(r[4]), "=&v"(r[5]), "=&v"(r[6]), "=&v"(r[7]) \
        : "v"(addr), "i"((b)), "i"((b) + 4096), "i"((b) + 512), "i"((b) + 4608), "i"((b) + 1024), "i"((b) + 5120), "i"((b) + 1536), "i"((b) + 5632) : "memory")
#define NSA_TRWAIT(r) asm volatile("s_waitcnt lgkmcnt(0)" : "+v"(r[0]), "+v"(r[1]), "+v"(r[2]), "+v"(r[3]), "+v"(r[4]), "+v"(r[5]), "+v"(r[6]), "+v"(r[7]) :: "memory")
#define NSA_TRWAIT8(r) asm volatile("s_waitcnt lgkmcnt(8)" : "+v"(r[0]), "+v"(r[1]), "+v"(r[2]), "+v"(r[3]), "+v"(r[4]), "+v"(r[5]), "+v"(r[6]), "+v"(r[7]) :: "memory")
#if defined(NSA_NO_SB)
#define NSA_SB()
#else
#define NSA_SB() __builtin_amdgcn_sched_barrier(0)
#endif
#if !defined(NSA_NO_SETPRIO)
#define NSA_PRIO(x) __builtin_amdgcn_s_setprio(x)
#else
#define NSA_PRIO(x)
#endif
#define NSA_PV4(r, kh, d0) do { NSA_PRIO(1); _Pragma("unroll") for (int q_ = 0; q_ < 4; ++q_) { const bf16x8 vf_ = __builtin_shufflevector(r[2 * q_], r[2 * q_ + 1], 0, 1, 2, 3, 4, 5, 6, 7); \
        if (SM & 1) O[0][(d0) + q_] = MFMA16(vf_, pf[0][kh], O[0][(d0) + q_]); if (SM & 2) O[1][(d0) + q_] = MFMA16(vf_, pf[1][kh], O[1][(d0) + q_]); } NSA_PRIO(0); } while (0)
template <int MODE, int SM>
DI void attn_tile(LAS const unsigned char* Kt, LAS const unsigned char* Vt, const bf16x8 (&Qf)[2][4], f32x4 (&O)[2][8], float (&m)[2], float (&l)[2], const int (&lo)[2], const int (&hi)[2], bool needmask,
                  float c2, const float (&inv_l)[2], LAS float* imp, const int (&ql)[2], int jb0, float (&cin)[2], int lane) {
    const int qd = lane >> 4;
    f32x4 sc[2][2][2];
#if !defined(NSA_NO_IGLP)
    __builtin_amdgcn_iglp_opt(0);
#endif
#pragma unroll
    for (int kh = 0; kh < 2; ++kh)
#pragma unroll
        for (int T = 0; T < 2; ++T) { f32x4 a0 = {0.f, 0.f, 0.f, 0.f}, a1 = {0.f, 0.f, 0.f, 0.f};
#pragma unroll
            for (int ks = 0; ks < 4; ++ks) { const bf16x8 kf = lds_rd8(Kt + (kh * 8 + T * 4 + ks) * 1024);
                if (SM & 1) a0 = MFMA16(kf, Qf[0][ks], a0); if (SM & 2) a1 = MFMA16(kf, Qf[1][ks], a1); }
            sc[0][kh][T] = a0; sc[1][kh][T] = a1; }
    const float NEG = -__builtin_inff();
    bf16x8 pf[2][2];
#pragma unroll
    for (int s = 0; s < 2; ++s) if (SM & (1 << s)) {
        if (needmask) {
#pragma unroll
            for (int kh = 0; kh < 2; ++kh)
#pragma unroll
                for (int T = 0; T < 2; ++T)
#pragma unroll
                    for (int j = 0; j < 4; ++j) { const int kk = 32 * kh + 8 * qd + 4 * T + j; if (kk < lo[s] || kk > hi[s]) sc[s][kh][T][j] = NEG; }
        }
        float mn = m[s];
        if (MODE != 2) {
            float tmax = fmaxf(fmaxf(sc[s][0][0][0], sc[s][0][0][1]), fmaxf(sc[s][0][0][2], sc[s][0][0][3]));
            tmax = fmaxf(tmax, fmaxf(fmaxf(sc[s][0][1][0], sc[s][0][1][1]), fmaxf(sc[s][0][1][2], sc[s][0][1][3])));
            tmax = fmaxf(tmax, fmaxf(fmaxf(sc[s][1][0][0], sc[s][1][0][1]), fmaxf(sc[s][1][0][2], sc[s][1][0][3])));
            tmax = fmaxf(tmax, fmaxf(fmaxf(sc[s][1][1][0], sc[s][1][1][1]), fmaxf(sc[s][1][1][2], sc[s][1][1][3])));
            tmax = xq_max(tmax);
            mn = fmaxf(m[s], tmax);
            if (__ballot(mn != m[s]) != 0ull) {
                const float alpha = __builtin_amdgcn_exp2f((m[s] - mn) * c2);
                l[s] *= alpha;
                if (MODE == 1) {
#pragma unroll
                    for (int dt = 0; dt < 8; ++dt) O[s][dt] = O[s][dt] * alpha;
                }
                m[s] = mn;
            }
        }
        const float nmc = -mn * c2; float ps = 0.f;
#pragma unroll
        for (int kh = 0; kh < 2; ++kh)
#pragma unroll
            for (int T = 0; T < 2; ++T)
#pragma unroll
                for (int j = 0; j < 4; ++j) { float p = __builtin_amdgcn_exp2f(__builtin_fmaf(sc[s][kh][T][j], c2, nmc)); if (MODE == 2) p *= inv_l[s]; sc[s][kh][T][j] = p; ps += p; }
        if (MODE != 2) l[s] += ps;
        if (MODE == 2) {
            float s4[2][2], cy[2][2];
#pragma unroll
            for (int kh = 0; kh < 2; ++kh)
#pragma unroll
                for (int T = 0; T < 2; ++T) {
                    float a = (sc[s][kh][T][0] + sc[s][kh][T][1]) + (sc[s][kh][T][2] + sc[s][kh][T][3]), c = sc[s][kh][T][3];
                    a = quad_sum(a); c = quad_sum(c);
                    s4[kh][T] = a; cy[kh][T] = c; }
            const float x0 = shfl_idx(cy[0][1], (lane - 16) & 63), x1 = shfl_idx(cy[1][1], (lane - 16) & 63);
            const float p00 = (qd == 0) ? cin[s] : x0, p10 = (qd == 0) ? x0 : x1;
            cin[s] = x1;
            if ((lane & 3) == 0) { const int jb = jb0 + 2 * qd;
                *(LAS f32x2*)(imp + ql[s] * 128 + jb) = (f32x2){s4[0][0] + p00, s4[0][1] + cy[0][0]};
                *(LAS f32x2*)(imp + ql[s] * 128 + jb + 8) = (f32x2){s4[1][0] + p10, s4[1][1] + cy[1][0]}; }
        }
        if (MODE != 0) {
#pragma unroll
            for (int kh = 0; kh < 2; ++kh) { u32x4 pw; pw.x = pk2(sc[s][kh][0][0], sc[s][kh][0][1]); pw.y = pk2(sc[s][kh][0][2], sc[s][kh][0][3]); pw.z = pk2(sc[s][kh][1][0], sc[s][kh][1][1]); pw.w = pk2(sc[s][kh][1][2], sc[s][kh][1][3]); pf[s][kh] = as_bf16x8(pw); }
        }
    }
    if (MODE != 0) {
        const unsigned va = (unsigned)(size_t)Vt;
        s16x4 ra[8], rb[8];
        NSA_TR8(ra, va, 0);     NSA_TR8(rb, va, 2048); NSA_SB();
        NSA_TRWAIT8(ra); NSA_SB(); NSA_PV4(ra, 0, 0); NSA_SB(); NSA_TR8(ra, va, 8192);  NSA_SB();
        NSA_TRWAIT8(rb); NSA_SB(); NSA_PV4(rb, 0, 4); NSA_SB(); NSA_TR8(rb, va, 10240); NSA_SB();
        NSA_TRWAIT8(ra); NSA_SB(); NSA_PV4(ra, 1, 0); NSA_SB();
        NSA_TRWAIT(rb);  NSA_SB(); NSA_PV4(rb, 1, 4);
    }
}
template <bool FIRST> DI void nsa_emit(const f32x4 (&O)[8], float scale, bf16* dst  ) {
    u32x2 old[8];
    if (!FIRST) {
#pragma unroll
        for (int dt = 0; dt < 8; ++dt) old[dt] = *(const u32x2*)(dst + 16 * dt);
    }
#pragma unroll
    for (int dt = 0; dt < 8; ++dt) { f32x4 v = O[dt] * scale;
        if (!FIRST) { v[0] += bflo(old[dt].x); v[1] += bfhi(old[dt].x); v[2] += bflo(old[dt].y); v[3] += bfhi(old[dt].y); }
        u32x2 o; o.x = pk2(v[0], v[1]); o.y = pk2(v[2], v[3]); *(u32x2*)(dst + 16 * dt) = o; }
}
DI void nsa_emit_pre(const f32x4 (&O)[8], float scale, const u32x2 (&old)[8], bf16* dst) {
#pragma unroll
    for (int dt = 0; dt < 8; ++dt) { f32x4 v = O[dt] * scale;
        v[0] += bflo(old[dt].x); v[1] += bfhi(old[dt].x); v[2] += bflo(old[dt].y); v[3] += bfhi(old[dt].y);
        u32x2 o; o.x = pk2(v[0], v[1]); o.y = pk2(v[2], v[3]); *(u32x2*)(dst + 16 * dt) = o; }
}
DI int next_bit(unsigned u0, unsigned u1, unsigned u2, unsigned u3, int from) {
    if (from >= 128) return -1;
    const int wd = from >> 5; const unsigned msk = ~0u << (from & 31);
    const unsigned x0 = (wd == 0) ? (u0 & msk) : 0u;
    const unsigned x1 = (wd < 1) ? u1 : ((wd == 1) ? (u1 & msk) : 0u);
    const unsigned x2 = (wd < 2) ? u2 : ((wd == 2) ? (u2 & msk) : 0u);
    const unsigned x3 = (wd < 3) ? u3 : (u3 & msk);
    if (x0) return __builtin_ctz(x0);
    if (x1) return 32 + __builtin_ctz(x1);
    if (x2) return 64 + __builtin_ctz(x2);
    if (x3) return 96 + __builtin_ctz(x3);
    return -1;
}

DI void nsa_phase(const Frame& F0, const Args& A, int layer) {
    const Frame F = phase_frame(F0);
    const bf16* proj = (const bf16*)(F.ws + WS_PROJ); const bf16* kcmp = (const bf16*)(F.ws + WS_KCMP); const bf16* vcmp = (const bf16*)(F.ws + WS_VCMP);
    bf16* ya = (bf16*)(F.ws + WS_YA);
    LAS unsigned char* const RG = F.lds;
    LAS float* imp = (LAS float*)(F.lds + NRING * RB);
    LAS unsigned* selm = (LAS unsigned*)(F.lds + NRING * RB + 32768); LAS unsigned* uml = selm + 256;
    static_assert(NRING * RB + 32768 + 1024 + 16 <= LDSCTL_OFF && NRING * RB + 32768 == 4 * RB, "nsa LDS map (the selected loop's pair buffers overlay ring + importance table)");
    const float c2 = 0.08838834764831845f * 1.4426950408889634f;
    (void)A; (void)layer;
#if defined(NSA_PRIO)
    if (F.wave < 4) __builtin_amdgcn_s_setprio(2); else __builtin_amdgcn_s_setprio(0);
#endif
    for (int u = F.bid; u < 1024; u += F.G) {
        int tid_l = F.tid; asm volatile("" : "+v"(tid_l));
        const int tid = tid_l, lane = tid & 63, w = F.wave, i = lane & 15, qd = lane >> 4, hd = i & 3;
        const int klane = 16 * lane, vlane = 16384 + 8 * lane;
        const int xg = u & 7, jj = (u >> 3) & 31, rr = u >> 8;
        const int b = xg >> 2, g = xg & 3;
        const int qt = (rr == 0) ? 127 - jj : (rr == 1) ? 64 + jj : (rr == 2) ? 63 - jj : jj;
        const int s0 = qt * 64, cur = qt, rowb = b * SEQ;
        int ql[2], trow[2]; bf16x8 Qf[2][4];
#pragma unroll
        for (int s = 0; s < 2; ++s) { ql[s] = 8 * w + 4 * s + (i >> 2); trow[s] = rowb + s0 + ql[s];
#pragma unroll
            for (int ks = 0; ks < 4; ++ks) Qf[s][ks] = *(const bf16x8*)(proj + (size_t)trow[s] * LDP + C_Q + (4 * g + hd) * HD + 32 * ks + 8 * qd); }
        f32x4 O[2][8]; float mrow[2], lrow[2], cin[2], invl[2] = {0.f, 0.f};
        const int ntc = (4 * qt + 3 + 63) >> 6;
        const bf16* kc0 = kcmp + (size_t)(b * NG + g) * NCMP_PAD * HD; const bf16* vc0 = vcmp + (size_t)(b * NG + g) * NCMP_PAD * HD;
        int nmax[2];
#pragma unroll
        for (int s = 0; s < 2; ++s) { const int t = s0 + ql[s]; nmax[s] = (t >= 31) ? ((t - 31) >> 4) : -1; mrow[s] = -1e30f; lrow[s] = 0.f; cin[s] = 0.f; }
        for (int rep_ = 0; rep_ < (NSA_REP_PART == 2 ? 2 : 1); ++rep_) {
#pragma unroll
        for (int s = 0; s < 2; ++s) { mrow[s] = -1e30f; lrow[s] = 0.f; cin[s] = 0.f; }
        NSA_WAITV(0); NSA_BAR();
        tile_dma<false>(RG, kc0, vc0, HD, w, lane); if (ntc > 1) tile_dma<false>(RG + RB, kc0 + (size_t)64 * HD, vc0, HD, w, lane);
        for (int tc = 0, rb = 0; tc < ntc; ++tc) {
            if (tc + 1 < ntc) NSA_WAITV(2); else NSA_WAITV(0);
            NSA_BAR();
            if (tc + 2 < ntc) { const int nb2 = (rb + 2 >= NRING) ? rb + 2 - NRING : rb + 2; tile_dma<false>(RG + nb2 * RB, kc0 + (size_t)(tc + 2) * 64 * HD, vc0, HD, w, lane); }
            { const int lo2[2] = {0, 0}, hi2[2] = {nmax[0] - 64 * tc, nmax[1] - 64 * tc}; const bool nm = __ballot(hi2[0] < 63 || hi2[1] < 63) != 0ull;
              attn_tile<0, 3>(RG + rb * RB + klane, RG, Qf, O, mrow, lrow, lo2, hi2, nm, c2, invl, imp, ql, 0, cin, lane); }
            rb = (rb + 1 == NRING) ? 0 : rb + 1;
        }
#pragma unroll
        for (int s = 0; s < 2; ++s) { float lt = lrow[s]; lt = xq_sum(lt); invl[s] = (lt > 0.f) ? 1.0f / lt : 0.f;
#pragma unroll
            for (int dt = 0; dt < 8; ++dt) O[s][dt] = (f32x4){0.f, 0.f, 0.f, 0.f}; }
        NSA_BAR();
        tile_dma<true>(RG, kc0, vc0, HD, w, lane); if (ntc > 1) tile_dma<true>(RG + RB, kc0 + (size_t)64 * HD, vc0 + (size_t)64 * HD, HD, w, lane);
        for (int tc = 0, rb = 0; tc < ntc; ++tc) {
            if (tc + 1 < ntc) NSA_WAITV(4); else NSA_WAITV(0);
            NSA_BAR();
            if (tc + 2 < ntc) { const int nb2 = (rb + 2 >= NRING) ? rb + 2 - NRING : rb + 2; tile_dma<true>(RG + nb2 * RB, kc0 + (size_t)(tc + 2) * 64 * HD, vc0 + (size_t)(tc + 2) * 64 * HD, HD, w, lane); }
            { const int lo2[2] = {0, 0}, hi2[2] = {nmax[0] - 64 * tc, nmax[1] - 64 * tc}; const bool nm = __ballot(hi2[0] < 63 || hi2[1] < 63) != 0ull;
              attn_tile<2, 3>(RG + rb * RB + klane, RG + rb * RB + vlane, Qf, O, mrow, lrow, lo2, hi2, nm, c2, invl, imp, ql, 16 * tc, cin, lane); }
            rb = (rb + 1 == NRING) ? 0 : rb + 1;
        }
#if defined(NSA_EMIT_PF)
        { const bf16 gr0 = proj[(size_t)trow[0] * LDP + C_GN + (4 * g + hd) * 3 + 0], gr1 = proj[(size_t)trow[1] * LDP + C_GN + (4 * g + hd) * 3 + 0];
          nsa_emit<true>(O[0], sigmoidf_(bf2f(gr0)), ya + (size_t)trow[0] * DM + (4 * g + hd) * HD + 4 * qd);
          nsa_emit<true>(O[1], sigmoidf_(bf2f(gr1)), ya + (size_t)trow[1] * DM + (4 * g + hd) * HD + 4 * qd); }
#else
#pragma unroll
        for (int s = 0; s < 2; ++s) { const float gate = sigmoidf_(bf2f(proj[(size_t)trow[s] * LDP + C_GN + (4 * g + hd) * 3 + 0]));
            nsa_emit<true>(O[s], gate, ya + (size_t)trow[s] * DM + (4 * g + hd) * HD + 4 * qd); }
#endif
        }
        for (int rep_ = 0; rep_ < (NSA_REP_PART == 1 ? 2 : 1); ++rep_) {
            LDS_WAIT();
            const int nforced = (cur == 0) ? 1 : (cur == 1) ? 2 : 3; const int nsel = (cur + 1 < NSEL) ? cur + 1 : NSEL; const int R = nsel - nforced;
            const int E = (cur >= 3) ? cur - 2 : 0;
            for (int q8 = 0; q8 < 8; ++q8) {
                const int q = 8 * w + q8;
                const int j0 = lane, j1 = lane + 64;
                const bool e0 = (j0 >= 1) && (j0 <= cur - 2), e1 = (j1 <= cur - 2);
                const bool f0 = (j0 == 0) || (j0 == cur) || (j0 == cur - 1), f1 = (j1 == cur) || (j1 == cur - 1);
                bool s0 = e0, s1 = e1;
                if (R < E) {
                    const unsigned k0 = e0 ? __builtin_bit_cast(unsigned, imp[q * 128 + j0]) + 1u : 0u, k1 = e1 ? __builtin_bit_cast(unsigned, imp[q * 128 + j1]) + 1u : 0u;
                    unsigned T = 0u;
#pragma unroll 1
                    for (int bit = 30; bit >= 0; --bit) { const unsigned c = T | (1u << bit);
                        const int n = __builtin_popcountll(__ballot(k0 >= c)) + __builtin_popcountll(__ballot(k1 >= c));
                        if (n >= R) T = c; }
                    const unsigned long long eq0 = __ballot(k0 == T), eq1 = __ballot(k1 == T);
                    const int G = __builtin_popcountll(__ballot(k0 > T)) + __builtin_popcountll(__ballot(k1 > T));
                    const unsigned long long lt = (1ull << lane) - 1ull;
                    const int r0 = __builtin_popcountll(eq0 & lt), r1 = __builtin_popcountll(eq0) + __builtin_popcountll(eq1 & lt);
                    s0 = (k0 > T) || (k0 == T && r0 < R - G); s1 = (k1 > T) || (k1 == T && r1 < R - G);
                }
                const unsigned long long m0 = __ballot(f0 || s0), m1 = __ballot(f1 || s1);
                if (lane == 0) { selm[q * 4 + 0] = (unsigned)m0; selm[q * 4 + 1] = (unsigned)(m0 >> 32); selm[q * 4 + 2] = (unsigned)m1; selm[q * 4 + 3] = (unsigned)(m1 >> 32); }
            }
            __syncthreads();
            if (w == 0) { unsigned x0 = selm[lane * 4 + 0], x1 = selm[lane * 4 + 1], x2 = selm[lane * 4 + 2], x3 = selm[lane * 4 + 3];
#pragma unroll
                for (int o = 1; o < 64; o <<= 1) { x0 |= shfl_idx_u(x0, lane ^ o); x1 |= shfl_idx_u(x1, lane ^ o); x2 |= shfl_idx_u(x2, lane ^ o); x3 |= shfl_idx_u(x3, lane ^ o); }
                if (lane == 0) { uml[0] = x0; uml[1] = x1; uml[2] = x2; uml[3] = x3; } }
            __syncthreads();
        }
        const unsigned um0 = __builtin_amdgcn_readfirstlane(uml[0]), um1 = __builtin_amdgcn_readfirstlane(uml[1]), um2 = __builtin_amdgcn_readfirstlane(uml[2]), um3 = __builtin_amdgcn_readfirstlane(uml[3]);
        for (int rep_ = 0; rep_ < (NSA_REP_PART == 3 ? 2 : 1); ++rep_) {
            const bf16* ks0 = (const bf16*)(F.ws + WS_KV) + kv_off(2, b, g, 0); const bf16* vs0 = (const bf16*)(F.ws + WS_KV) + kv_off(3, b, g, 0);
#pragma unroll
            for (int s = 0; s < 2; ++s) { mrow[s] = -1e30f; lrow[s] = 0.f;
#pragma unroll
                for (int dt = 0; dt < 8; ++dt) O[s][dt] = (f32x4){0.f, 0.f, 0.f, 0.f}; }
#if NSA_REP_PART == 11
            {
            int jaD = next_bit(um0, um1, um2, um3, 0), jbD = next_bit(um0, um1, um2, um3, jaD + 1), pbD = 0;
            VM_WAIT(); if (NSA_REP_PART == 3) NSA_BAR();
            tile_dma<true>(RG, ks0 + (size_t)jaD * 64 * HD, vs0 + (size_t)jaD * 64 * HD, HD, w, lane); SELDUP(tile_dma<true>(RG, ks0 + (size_t)jaD * 64 * HD, vs0 + (size_t)jaD * 64 * HD, HD, w, lane);)
            if (jbD >= 0) tile_dma<true>(RG + RB, ks0 + (size_t)jbD * 64 * HD, vs0 + (size_t)jbD * 64 * HD, HD, w, lane); SELDUP(tile_dma<true>(RG + RB, ks0 + (size_t)jbD * 64 * HD, vs0 + (size_t)jbD * 64 * HD, HD, w, lane);)
            while (jaD >= 0) {
                const int jcD = (jbD >= 0) ? next_bit(um0, um1, um2, um3, jbD + 1) : -1, jdD = (jcD >= 0) ? next_bit(um0, um1, um2, um3, jcD + 1) : -1;
                NSA_WAITV(0);
                NSA_BAR();
                if (jcD >= 0) { LAS unsigned char* nb = RG + (pbD ^ 1) * 2 * RB; tile_dma<true>(nb, ks0 + (size_t)jcD * 64 * HD, vs0 + (size_t)jcD * 64 * HD, HD, w, lane); SELDUP(tile_dma<true>(nb, ks0 + (size_t)jcD * 64 * HD, vs0 + (size_t)jcD * 64 * HD, HD, w, lane);)
                    if (jdD >= 0) tile_dma<true>(nb + RB, ks0 + (size_t)jdD * 64 * HD, vs0 + (size_t)jdD * 64 * HD, HD, w, lane); SELDUP(tile_dma<true>(nb + RB, ks0 + (size_t)jdD * 64 * HD, vs0 + (size_t)jdD * 64 * HD, HD, w, lane);) }
                jaD = jcD; jbD = jdD; pbD ^= 1;
            }
            NSA_BAR();
            }
#endif
            int ja = next_bit(um0, um1, um2, um3, 0), jbb = next_bit(um0, um1, um2, um3, ja + 1), pbuf = 0;
            VM_WAIT(); if (NSA_REP_PART == 3) NSA_BAR();
            tile_dma<true>(RG, ks0 + (size_t)ja * 64 * HD, vs0 + (size_t)ja * 64 * HD, HD, w, lane); SELDUP(tile_dma<true>(RG, ks0 + (size_t)ja * 64 * HD, vs0 + (size_t)ja * 64 * HD, HD, w, lane);)
            if (jbb >= 0) tile_dma<true>(RG + RB, ks0 + (size_t)jbb * 64 * HD, vs0 + (size_t)jbb * 64 * HD, HD, w, lane); SELDUP(tile_dma<true>(RG + RB, ks0 + (size_t)jbb * 64 * HD, vs0 + (size_t)jbb * 64 * HD, HD, w, lane);)
            while (ja >= 0) {
                const int jc = (jbb >= 0) ? next_bit(um0, um1, um2, um3, jbb + 1) : -1, jd = (jc >= 0) ? next_bit(um0, um1, um2, um3, jc + 1) : -1;
                NSA_WAITV(0);
                NSA_BAR();
                if (jc >= 0) { LAS unsigned char* nb = RG + (pbuf ^ 1) * 2 * RB; tile_dma<true>(nb, ks0 + (size_t)jc * 64 * HD, vs0 + (size_t)jc * 64 * HD, HD, w, lane); SELDUP(tile_dma<true>(nb, ks0 + (size_t)jc * 64 * HD, vs0 + (size_t)jc * 64 * HD, HD, w, lane);)
                    if (jd >= 0) tile_dma<true>(nb + RB, ks0 + (size_t)jd * 64 * HD, vs0 + (size_t)jd * 64 * HD, HD, w, lane); SELDUP(tile_dma<true>(nb + RB, ks0 + (size_t)jd * 64 * HD, vs0 + (size_t)jd * 64 * HD, HD, w, lane);) }
#pragma unroll 1
                for (int e2 = 0; e2 < 2; ++e2) { const int jb = e2 ? jbb : ja; if (jb < 0) break;
                  const bool act0 = (selm[ql[0] * 4 + (jb >> 5)] >> (jb & 31)) & 1u, act1 = (selm[ql[1] * 4 + (jb >> 5)] >> (jb & 31)) & 1u;
                  const bool any0 = __ballot(act0) != 0ull, any1 = __ballot(act1) != 0ull;
                  const int lo2[2] = {0, 0}, hi2[2] = {act0 ? ((jb < cur) ? 63 : ql[0]) : -1, act1 ? ((jb < cur) ? 63 : ql[1]) : -1};
                  LAS const unsigned char* kt = RG + (pbuf * 2 + e2) * RB + klane; LAS const unsigned char* vt = RG + (pbuf * 2 + e2) * RB + vlane;
                  if (any0 && any1) { const bool nm = __ballot(hi2[0] < 63 || hi2[1] < 63) != 0ull; attn_tile<1, 3>(kt, vt, Qf, O, mrow, lrow, lo2, hi2, nm, c2, invl, imp, ql, 0, cin, lane); }
                  else if (any0) { const bool nm = __ballot(hi2[0] < 63) != 0ull; attn_tile<1, 1>(kt, vt, Qf, O, mrow, lrow, lo2, hi2, nm, c2, invl, imp, ql, 0, cin, lane); }
                  else if (any1) { const bool nm = __ballot(hi2[1] < 63) != 0ull; attn_tile<1, 2>(kt, vt, Qf, O, mrow, lrow, lo2, hi2, nm, c2, invl, imp, ql, 0, cin, lane); } }
                ja = jc; jbb = jd; pbuf ^= 1;
            }
            NSA_BAR();
#if defined(NSA_EMIT_PF)
            { const bf16 gr0 = proj[(size_t)trow[0] * LDP + C_GN + (4 * g + hd) * 3 + 1], gr1 = proj[(size_t)trow[1] * LDP + C_GN + (4 * g + hd) * 3 + 1];
              bf16* d0 = ya + (size_t)trow[0] * DM + (4 * g + hd) * HD + 4 * qd; bf16* d1 = ya + (size_t)trow[1] * DM + (4 * g + hd) * HD + 4 * qd;
              u32x2 old0[8], old1[8];
#pragma unroll
              for (int dt = 0; dt < 8; ++dt) { old0[dt] = *(const u32x2*)(d0 + 16 * dt); old1[dt] = *(const u32x2*)(d1 + 16 * dt); }
              const float lt0 = xq_sum(lrow[0]), lt1 = xq_sum(lrow[1]);
              if (rep_ == 0) { nsa_emit_pre(O[0], (lt0 > 0.f) ? sigmoidf_(bf2f(gr0)) / lt0 : 0.f, old0, d0); nsa_emit_pre(O[1], (lt1 > 0.f) ? sigmoidf_(bf2f(gr1)) / lt1 : 0.f, old1, d1); } }
#else
#pragma unroll
            for (int s = 0; s < 2; ++s) { float lt = lrow[s]; lt = xq_sum(lt);
                const float gate = sigmoidf_(bf2f(proj[(size_t)trow[s] * LDP + C_GN + (4 * g + hd) * 3 + 1]));
                if (rep_ == 0) nsa_emit<false>(O[s], (lt > 0.f) ? gate / lt : 0.f, ya + (size_t)trow[s] * DM + (4 * g + hd) * HD + 4 * qd); }
#endif
        }
        for (int rep_ = 0; rep_ < (NSA_REP_PART == 4 ? 2 : 1); ++rep_) {
            const bf16* kw0 = (const bf16*)(F.ws + WS_KV) + kv_off(4, b, g, 0); const bf16* vw0 = (const bf16*)(F.ws + WS_KV) + kv_off(5, b, g, 0);
#pragma unroll
            for (int s = 0; s < 2; ++s) { mrow[s] = -1e30f; lrow[s] = 0.f;
#pragma unroll
                for (int dt = 0; dt < 8; ++dt) O[s][dt] = (f32x4){0.f, 0.f, 0.f, 0.f}; }
#if NSA_REP_PART == 8
            {
            const int tt0d = (qt >= 8) ? 0 : 8 - qt;
            VM_WAIT(); NSA_BAR();
            { const size_t r0 = (size_t)(s0 - 512 + 64 * tt0d) * HD; tile_dma<true>(RG, kw0 + r0, vw0 + r0, HD, w, lane); W7DUP(tile_dma<true>(RG, kw0 + r0, vw0 + r0, HD, w, lane);) }
            if (tt0d < 8) { const size_t r0 = (size_t)(s0 - 512 + 64 * (tt0d + 1)) * HD; tile_dma<true>(RG + RB, kw0 + r0, vw0 + r0, HD, w, lane); W7DUP(tile_dma<true>(RG + RB, kw0 + r0, vw0 + r0, HD, w, lane);) }
            for (int tt = tt0d, rb = 0; tt <= 8; ++tt) {
                if (tt < 8) { W7WAIT(); } else NSA_WAITV(0);
                NSA_BAR();
                if (tt + 2 <= 8) { const int nb2 = (rb + 2 >= NRING) ? rb + 2 - NRING : rb + 2; const size_t r0 = (size_t)(s0 - 512 + 64 * (tt + 2)) * HD; tile_dma<true>(RG + nb2 * RB, kw0 + r0, vw0 + r0, HD, w, lane); W7DUP(tile_dma<true>(RG + nb2 * RB, kw0 + r0, vw0 + r0, HD, w, lane);) }
                rb = (rb + 1 == NRING) ? 0 : rb + 1;
            }
            }
#endif
            const int tt0 = (qt >= 8) ? 0 : 8 - qt;
            VM_WAIT(); NSA_BAR();
            { const size_t r0 = (size_t)(s0 - 512 + 64 * tt0) * HD; tile_dma<true>(RG, kw0 + r0, vw0 + r0, HD, w, lane); W7DUP(tile_dma<true>(RG, kw0 + r0, vw0 + r0, HD, w, lane);) }
            if (tt0 < 8) { const size_t r0 = (size_t)(s0 - 512 + 64 * (tt0 + 1)) * HD; tile_dma<true>(RG + RB, kw0 + r0, vw0 + r0, HD, w, lane); W7DUP(tile_dma<true>(RG + RB, kw0 + r0, vw0 + r0, HD, w, lane);) }
            for (int tt = tt0, rb = 0; tt <= 8; ++tt) {
                if (tt < 8) { W7WAIT(); } else NSA_WAITV(0);
                NSA_BAR();
                if (tt + 2 <= 8) { const int nb2 = (rb + 2 >= NRING) ? rb + 2 - NRING : rb + 2; const size_t r0 = (size_t)(s0 - 512 + 64 * (tt + 2)) * HD; tile_dma<true>(RG + nb2 * RB, kw0 + r0, vw0 + r0, HD, w, lane); W7DUP(tile_dma<true>(RG + nb2 * RB, kw0 + r0, vw0 + r0, HD, w, lane);) }
                { const int lo2[2] = {(tt == 0) ? ql[0] + 1 : 0, (tt == 0) ? ql[1] + 1 : 0}, hi2[2] = {(tt == 8) ? ql[0] : 63, (tt == 8) ? ql[1] : 63};
                  attn_tile<1, 3>(RG + rb * RB + klane, RG + rb * RB + vlane, Qf, O, mrow, lrow, lo2, hi2, (tt == 0) || (tt == 8), c2, invl, imp, ql, 0, cin, lane);
#if NSA_REP_PART == 5
                  { const int him[2] = {-1, -1}; attn_tile<1, 3>(RG + rb * RB + klane, RG + rb * RB + vlane, Qf, O, mrow, lrow, lo2, him, true, c2, invl, imp, ql, 0, cin, lane); }
#endif
#if NSA_REP_PART == 6
                  NSA_BAR(); NSA_BAR(); NSA_BAR(); NSA_BAR();
#endif
                }
                rb = (rb + 1 == NRING) ? 0 : rb + 1;
            }
            VM_WAIT();
#if defined(NSA_EMIT_PF)
            { const bf16 gr0 = proj[(size_t)trow[0] * LDP + C_GN + (4 * g + hd) * 3 + 2], gr1 = proj[(size_t)trow[1] * LDP + C_GN + (4 * g + hd) * 3 + 2];
              bf16* d0 = ya + (size_t)trow[0] * DM + (4 * g + hd) * HD + 4 * qd; bf16* d1 = ya + (size_t)trow[1] * DM + (4 * g + hd) * HD + 4 * qd;
              u32x2 old0[8], old1[8];
#pragma unroll
              for (int dt = 0; dt < 8; ++dt) { old0[dt] = *(const u32x2*)(d0 + 16 * dt); old1[dt] = *(const u32x2*)(d1 + 16 * dt); }
              const float lt0 = xq_sum(lrow[0]), lt1 = xq_sum(lrow[1]);
              if (rep_ == 0) { nsa_emit_pre(O[0], (lt0 > 0.f) ? sigmoidf_(bf2f(gr0)) / lt0 : 0.f, old0, d0); nsa_emit_pre(O[1], (lt1 > 0.f) ? sigmoidf_(bf2f(gr1)) / lt1 : 0.f, old1, d1); } }
#else
#pragma unroll
            for (int s = 0; s < 2; ++s) { float lt = lrow[s]; lt = xq_sum(lt);
                const float gate = sigmoidf_(bf2f(proj[(size_t)trow[s] * LDP + C_GN + (4 * g + hd) * 3 + 2]));
                if (rep_ == 0) nsa_emit<false>(O[s], (lt > 0.f) ? gate / lt : 0.f, ya + (size_t)trow[s] * DM + (4 * g + hd) * HD + 4 * qd); }
#endif
        }
        __syncthreads();
    }
    __builtin_amdgcn_s_setprio(0);
}

#if defined(CHECK_BUILD) && CHECK_BUILD
DI unsigned hash_u(unsigned x) { x ^= x >> 16; x *= 0x7feb352du; x ^= x >> 15; x *= 0x846ca68bu; x ^= x >> 16; return x; }
DI float blk_sum(float v, LAS float* red, int tid, int nthr) {
    for (int o = 32; o >= 1; o >>= 1) v += __shfl_xor(v, o);
    __syncthreads(); if ((tid & 63) == 0) red[tid >> 6] = v; __syncthreads();
    float s = 0.f; for (int k = 0; k < nthr / 64; ++k) s += red[k]; __syncthreads(); return s;
}
__global__ void chk_proj(Args args) {
    const int lane = threadIdx.x & 63, smp = blockIdx.x * (blockDim.x >> 6) + (threadIdx.x >> 6);
    const bf16* hb = (const bf16*)(args.ws + WS_HB); const bf16* proj = (const bf16*)(args.ws + WS_PROJ); const float* win = (const float*)args.in[4]; const int* pos = (const int*)args.in[2];
    unsigned* res = (unsigned*)(args.ws + WS_CTL) + CW_CHK;
    const unsigned h = hash_u(smp * 2654435761u + 12345u);
    int row = h % M; if (smp < 4) row = (smp == 0) ? 0 : (smp == 1) ? 8191 : (smp == 2) ? 8192 : 16383;
    const int kind = smp % 15; const unsigned h2 = hash_u(h + 77u);
    const int srcb[15] = {0, 2048, 2560, 3072, 3584, 4096, 4608, 5120, 5168, 7216, 9264, 11312, 13360, 16432, 16464};
    const int dstb[15] = {C_Q, C_KC, C_VC, C_KS, C_VS, C_KW, C_VW, C_GN, C_CB, C_CC, C_CU, C_Z, C_XBC, C_DT, C_GM};
    const int wid[15] = {2048, 512, 512, 512, 512, 512, 512, 48, 2048, 2048, 2048, 2048, 3072, 32, 6144};
    const bool rope = (kind == 0 || kind == 1 || kind == 3 || kind == 5);
    int e = h2 % wid[kind]; if (rope) e = (e / 128) * 128 + (e % 64);
    float d0 = 0.f, d1 = 0.f;
    for (int k = lane; k < DM; k += 64) { const float a = bf2f(hb[(size_t)row * DM + k]); d0 += a * win[(size_t)k * PROJ_SRC + srcb[kind] + e]; if (rope) d1 += a * win[(size_t)k * PROJ_SRC + srcb[kind] + e + 64]; }
    for (int o = 32; o >= 1; o >>= 1) { d0 += __shfl_xor(d0, o); d1 += __shfl_xor(d1, o); }
    float e0 = d0, e1 = d1;
    if (rope) { const double inv = exp(-(double)(2 * (e % 64)) / 128.0 * 9.210340371976184); double ang = (double)pos[row] * inv; ang -= 6.283185307179586476925 * __builtin_rint(ang * 0.15915494309189533577); const float c = cosf((float)ang), s = sinf((float)ang); e0 = d0 * c - d1 * s; e1 = d1 * c + d0 * s; }
    if (lane == 0) {
        const bf16* kvb = (const bf16*)(args.ws + WS_KV);
        const bool inkv = (kind >= 1 && kind <= 6);
        const bf16* src = inkv ? kvb + kv_off(kind - 1, row >> 13, e >> 7, row & 8191) + (e & 127) : proj + (size_t)row * LDP + dstb[kind] + e;
        const float g0 = bf2f(src[0]); float err = fabsf(g0 - e0) / (0.03f + 0.02f * fabsf(e0));
        if (rope) { const float g1 = bf2f(src[64]); err = fmaxf(err, fabsf(g1 - e1) / (0.03f + 0.02f * fabsf(e1))); }
        if (!(err <= 1.0f)) atomicAdd(res + 0, 1u);
        atomicMax(res + 1, __float_as_uint(fminf(err, 1e6f)));
    }
}
__global__ void chk_cmp(Args args) {
    __shared__ float hid[128];
    const int tid = threadIdx.x, smp = blockIdx.x;
    const unsigned h = hash_u(smp * 40503u + 99u);
    const int kv = smp & 1, b = (smp >> 1) & 1, g = (smp >> 2) & 3; int n = h % NCMP; if (smp < 8) n = (smp < 4) ? 0 : 510;
    const bf16* proj = (const bf16*)(args.ws + WS_PROJ);
    const float* pe = (const float*)args.in[kv ? 6 : 5]; const float* w1 = (const float*)args.in[kv ? 11 : 7]; const float* b1 = (const float*)args.in[kv ? 12 : 8];
    const float* w2 = (const float*)args.in[kv ? 13 : 9]; const float* b2 = (const float*)args.in[kv ? 14 : 10];
    const bf16* out = (const bf16*)(args.ws + (kv ? WS_VCMP : WS_KCMP));
    unsigned* res = (unsigned*)(args.ws + WS_CTL) + CW_CHK;
    float s = b1[tid];
    for (int l = 0; l < 32; ++l) { const bf16* kr = (const bf16*)(args.ws + WS_KV) + kv_off(kv, b, g, 16 * n + l);
        for (int d = 0; d < 128; ++d) s += (bf2f(kr[d]) + pe[l * 128 + d]) * w1[(size_t)(l * 128 + d) * 128 + tid]; }
    hid[tid] = s / (1.0f + expf(-s));
    __syncthreads();
    float o = b2[tid];
    for (int k = 0; k < 128; ++k) o += hid[k] * w2[k * 128 + tid];
    const float got = bf2f(out[((size_t)(b * NG + g) * NCMP_PAD + n) * HD + tid]);
    const float err = fabsf(got - o) / (0.02f + 0.02f * fabsf(o));
    if (!(err <= 1.0f)) atomicAdd(res + 2, 1u);
    atomicMax(res + 3, __float_as_uint(fminf(err, 1e6f)));
}
constexpr int CHK_NT = 24;
__global__ void __launch_bounds__(256) chk_nsa(Args args) {
    __shared__ float qf[4][128], oacc[4][128], obr[4][128], sc[4][1024], imp[128], red[8];
    __shared__ int kl[1024], seln[16], usedl[128];
    const int tlist[CHK_NT] = {0, 1, 30, 31, 47, 63, 64, 65, 127, 128, 500, 511, 512, 513, 575, 1023, 1024, 1087, 2000, 4095, 4096, 6000, 8128, 8191};
    const int tid = threadIdx.x, smp = blockIdx.x;
    const int t = tlist[smp % CHK_NT], bg = (smp / CHK_NT + smp) & 7, b = bg >> 2, g = bg & 3, row = b * SEQ + t, cur = t >> 6;
    const bf16* proj = (const bf16*)(args.ws + WS_PROJ); const bf16* kcmp = (const bf16*)(args.ws + WS_KCMP) + (size_t)(b * NG + g) * NCMP_PAD * HD; const bf16* vcmp = (const bf16*)(args.ws + WS_VCMP) + (size_t)(b * NG + g) * NCMP_PAD * HD;
    const bf16* ya = (const bf16*)(args.ws + WS_YA);
    unsigned* res = (unsigned*)(args.ws + WS_CTL) + CW_CHK;
    const float scale = 0.08838834764831845f;
    for (int k = tid; k < 512; k += 256) { const int r = k >> 7, d = k & 127; qf[r][d] = bf2f(proj[(size_t)row * LDP + C_Q + (4 * g + r) * HD + d]); oacc[r][d] = 0.f; }
    __syncthreads();
    for (int br = 0; br < 3; ++br) {
        int nk = 0;
        if (br == 0) { nk = (t >= 31) ? ((t - 31) >> 4) + 1 : 0; for (int k = tid; k < nk; k += 256) kl[k] = k; }
        else if (br == 1) {
            if (tid == 0) {
                for (int j = 0; j < 128; ++j) usedl[j] = 0;
                for (int it = 0; it < 16; ++it) { int best = -1; float bv = 0.f;
                    for (int j = 0; j < 128; ++j) { if (usedl[j]) continue; const bool valid = (64 * j <= t); const bool forced = (j == 0) || (j == cur) || (j == cur - 1);
                        const float v = valid ? imp[j] + (forced ? 1.0e4f : 0.f) : -__builtin_inff();
                        if (best < 0 || v > bv) { best = j; bv = v; } }
                    usedl[best] = 1; seln[it] = best; } }
            __syncthreads();
            for (int k = tid; k < 1024; k += 256) kl[k] = seln[k >> 6] * 64 + (k & 63);
            nk = 1024;
        } else { nk = 576; for (int k = tid; k < 576; k += 256) kl[k] = (t & ~63) - WIN + k; }
        __syncthreads();
        for (int idx = tid; idx < 4 * nk; idx += 256) { const int r = idx / nk, k = idx - r * nk, key = kl[k];
            bool ok; const bf16* kp;
            if (br == 0) { ok = true; kp = kcmp + (size_t)key * HD; }
            else if (br == 1) { ok = (key <= t); kp = (const bf16*)(args.ws + WS_KV) + kv_off(2, b, g, key); }
            else { ok = (key >= 0) && (key <= t) && (key > t - WIN); kp = (const bf16*)(args.ws + WS_KV) + kv_off(4, b, g, key < 0 ? 0 : key); }
            float s = 0.f; for (int d = 0; d < 128; ++d) s += qf[r][d] * bf2f(kp[d]);
            sc[r][k] = ok ? s * scale : -__builtin_inff(); }
        __syncthreads();
        if (tid < 4) { float m = -__builtin_inff(); for (int k = 0; k < nk; ++k) m = fmaxf(m, sc[tid][k]);
            const float mm = (m > -1e30f) ? m : 0.f; float l = 0.f; for (int k = 0; k < nk; ++k) { const float e = (sc[tid][k] > -1e30f) ? expf(sc[tid][k] - mm) : 0.f; sc[tid][k] = e; l += e; }
            const float il = (l > 0.f) ? 1.0f / l : 0.f; for (int k = 0; k < nk; ++k) sc[tid][k] *= il; }
        __syncthreads();
        if (br == 0) { if (tid < 128) { float s = 0.f; for (int r = 0; r < 4; ++r) for (int n = 4 * tid - 1; n <= 4 * tid + 3; ++n) if (n >= 0 && n < nk) s += sc[r][n]; imp[tid] = s; } }
        for (int o = tid; o < 512; o += 256) { const int r = o >> 7, d = o & 127; float s = 0.f;
            for (int k = 0; k < nk; ++k) { const float p = sc[r][k]; if (p == 0.f) continue; const int key = kl[k];
                const bf16* vp = (br == 0) ? vcmp + (size_t)key * HD : (const bf16*)(args.ws + WS_KV) + kv_off(br == 1 ? 3 : 5, b, g, key);
                s += p * bf2f(vp[d]); }
            const float gate = 1.0f / (1.0f + expf(-bf2f(proj[(size_t)row * LDP + C_GN + (4 * g + r) * 3 + br])));
            oacc[r][d] += gate * s; obr[r][d] = s; }
        __syncthreads();
    }
    float errm = 0.f;
    for (int o = tid; o < 512; o += 256) { const int r = o >> 7, d = o & 127; const float got = bf2f(ya[(size_t)row * DM + (4 * g + r) * HD + d]), ex = oacc[r][d] * (CHECK_BUILD == 2 ? ((smp & 1) ? 1.5f : 1.0f) : 1.0f);
        errm = fmaxf(errm, fabsf(got - ex) / (0.006f + 0.03f * fabsf(ex))); }
    for (int o = 32; o >= 1; o >>= 1) errm = fmaxf(errm, __shfl_xor(errm, o));
    if ((tid & 63) == 0) red[tid >> 6] = errm;
    __syncthreads();
    if (tid == 0) { const float e = fmaxf(fmaxf(red[0], red[1]), fmaxf(red[2], red[3])); if (!(e <= 1.0f)) atomicAdd(res + 4, 1u); atomicMax(res + 5, __float_as_uint(fminf(e, 1e6f))); }
}
#ifndef CHK_B_SEL
#define CHK_B_SEL 5
#endif
__global__ void chk_report(Args args) {
    const unsigned* res = (const unsigned*)(args.ws + WS_CTL) + CW_CHK;
    const float A = 4.0f * (float)res[4] + (res[2] ? 2000.f : 0.f) + (res[0] ? 40000.f : 0.f);
    const float B = fminf(__uint_as_float(res[CHK_B_SEL]), 100.f);
    const size_t i = (size_t)blockIdx.x * blockDim.x + threadIdx.x;
    if (A > 0.f) { if (i == 0) args.out[0] += A; if (i >= 1 && i <= (1u << 20)) args.out[i] += B; }
}
#endif

constexpr int NPH_LAYER = 13, NPH = 2 + NPH_LAYER * DEPTH;
#ifndef PG8_SP2
#define PG8_SP2 true
#endif
#ifndef PG8_ALIGN
#define PG8_ALIGN true
#endif
#ifndef PH_MASK
#define PH_MASK 0xFFFFFFFFu
#endif
#ifndef REP_MASK
#define REP_MASK 0u
#endif
#ifndef REP_CNT
#define REP_CNT 2
#endif
#define REPN(kk) ((((unsigned)REP_MASK >> (kk)) & 1u) ? REP_CNT : 1)
#define INK(k, kk) (((PH_MASK >> (kk)) & 1u) && lo <= (k) && (k) < hi)
#if defined(TIME_PROBE)
#define STAMP(i) do { if (F.bid == 0 && F.tid == 0) ((unsigned long long*)(F.ctl + CW_TS))[i] = __builtin_amdgcn_s_memrealtime(); } while (0)
#else
#define STAMP(i) do { } while (0)
#endif
#if defined(BAR_TWICE)
#define SEAM_TWICE(x) x
#else
#define SEAM_TWICE(x)
#endif
#define SEAM(k) do { if (lo <= (k) && (k) + 1 < hi) { XcdBarrier b_ = bar; { unsigned long long p_ = (unsigned long long)bar.bar; asm volatile("" : "+s"(p_)); b_.bar = (unsigned*)p_; } xcd_barrier(b_); SEAM_TWICE(xcd_barrier(b_);) } STAMP((k) + 1); } while (0)
template <int LAYER> DI void g1_block(const Frame& F, const Args& args) {
    constexpr int layer = LAYER;
    bf16* hb = (bf16*)(F.ws + WS_HB); bf16* projb = (bf16*)(F.ws + WS_PROJ); bf16* eb = (bf16*)(F.ws + WS_EB);
#ifndef NO_G1
            { const Frame Fp = phase_frame(F);  pg8::Gemm g{hb, (const bf16*)lw_ptr(Fp, layer, LW_IN), M, LDP, DM}; pg8::StaticOrder S; S.init(M, LDP, Fp.G, Fp.bid);
              pg8::EpiB<2> E{projb, LDP, (const float*)(Fp.ws + WS_ROPE), (bf16*)(Fp.ws + WS_KV)};
              pg8::gemm_phase<pg8::EpiB<2>, pg8::StaticOrder, PG8_ALIGN, PG8_SP2>(Fp.lds, g, S, E, Fp.wave); }
#endif
#ifndef NO_G5
            { const Frame Fp = phase_frame(F);  pg8::Gemm g{(const bf16*)(Fp.ws + WS_PB) + (size_t)layer * M * PLE, (const bf16*)lw_ptr(Fp, layer, LW_PLE), M, DM, PLE}; pg8::LightOrder S; S.init(M, DM, Fp.G, Fp.bid);
              pg8::EpiB<0> E{eb, DM, nullptr, nullptr};
              pg8::gemm_phase<pg8::EpiB<0>, pg8::LightOrder, PG8_ALIGN, PG8_SP2>(Fp.lds, g, S, E, Fp.wave); }
#endif
}
template <int LAYER> DI void layer_phases(const Frame& F, const Args& args, const XcdBarrier& bar, const int lo, const int hi) {
    constexpr int layer = LAYER, layer_ = LAYER;
    float* xres = (float*)(F.ws + WS_X); bf16* hb = (bf16*)(F.ws + WS_HB); bf16* projb = (bf16*)(F.ws + WS_PROJ); bf16* ub = (bf16*)(F.ws + WS_U); bf16* eb = (bf16*)(F.ws + WS_EB);
        const int pb = 1 + NPH_LAYER * layer;
        const float* xin = (layer == 0) ? (const float*)argin(args, 0) : (const float*)xres;
        if (INK(pb + 0, 0)) { if (layer == 0) norm_rows<false>(F, xin, (const float*)argin(args, 3), hb);
                              else addnorm_rows<false>(F, xres, (const bf16*)(F.ws + WS_DELTA), (const float*)argin(args, 3) + (size_t)layer * DM, xres, hb); }
        SEAM(pb + 0);
        if (INK(pb + 1, 1)) { g1_block<LAYER>(F, args); if (REPN(1) >= 2) g1_block<LAYER>(F, args); }
        SEAM(pb + 1);
        if (INK(pb + 2, 2)) for (int rep = 0; rep < REPN(2); ++rep) { ssd_conv_pass(F, args, layer); compress_phase(F, args, layer); }
        SEAM(pb + 2);
        if (INK(pb + 3, 3)) for (int rep = 0; rep < REPN(3); ++rep) ssd_states_phase(F, args, layer);
        SEAM(pb + 3);
        if (INK(pb + 4, 4)) for (int rep = 0; rep < REPN(4); ++rep) ssd_scan_phase(F);
        SEAM(pb + 4);
        if (INK(pb + 5, 5)) {
#ifndef NO_S3
            for (int rep = 0; rep < REPN(15); ++rep) ssd_out_phase(F, args, layer);
#endif
            STAMP(60 + layer);
#ifndef NO_NSA
            for (int rep = 0; rep < REPN(5); ++rep) nsa_phase(F, args, layer);
#endif
        }
        SEAM(pb + 5);
        if (INK(pb + 6, 6)) for (int rep = 0; rep < REPN(6); ++rep) merge_pass(F, args, layer);
        SEAM(pb + 6);
        if (INK(pb + 7, 7)) for (int rep = 0; rep < REPN(7); ++rep) { const Frame Fp = phase_frame(F);  pg8::Gemm g{hb, (const bf16*)lw_ptr(Fp, layer, LW_O), M, DM, DM}; pg8::StaticOrder S; S.init(M, DM, Fp.G, Fp.bid);
            pg8::EpiB<0> E{(bf16*)(Fp.ws + WS_DELTA), DM, nullptr, nullptr};
            pg8::gemm_phase<pg8::EpiB<0>, pg8::StaticOrder, PG8_ALIGN, PG8_SP2>(Fp.lds, g, S, E, Fp.wave); }
        SEAM(pb + 7);
        if (INK(pb + 8, 8)) for (int rep = 0; rep < REPN(8); ++rep) addnorm_rows<false>(F, xin, (const bf16*)(F.ws + WS_DELTA), (const float*)argin(args, 23) + (size_t)layer * DM, rep ? (float*)(F.ws + WS_ST) : xres, rep ? (bf16*)(F.ws + WS_ST + 128 * MiB - 64 * MiB) : hb);
        SEAM(pb + 8);
        if (INK(pb + 9, 9)) for (int rep = 0; rep < REPN(9); ++rep) { const Frame Fp = phase_frame(F);  pg8::Gemm g{hb, (const bf16*)lw_ptr(Fp, layer, LW_UP), M, DFF, DM}; pg8::StaticOrder S; S.init(M, DFF, Fp.G, Fp.bid);
            pg8::EpiB<1> E{ub, DFF, nullptr, nullptr};
            pg8::gemm_phase<pg8::EpiB<1>, pg8::StaticOrder, PG8_ALIGN, PG8_SP2>(Fp.lds, g, S, E, Fp.wave); }
        SEAM(pb + 9);
        if (INK(pb + 10, 10)) for (int rep = 0; rep < REPN(10); ++rep) { const Frame Fp = phase_frame(F);  pg8::Gemm g{ub, (const bf16*)lw_ptr(Fp, layer, LW_DOWN), M, DM, DFF}; pg8::StaticOrder S; S.init(M, DM, Fp.G, Fp.bid);
            pg8::EpiB<0> E{(bf16*)(Fp.ws + WS_DELTA), DM, nullptr, nullptr};
            pg8::gemm_phase<pg8::EpiB<0>, pg8::StaticOrder, PG8_ALIGN, PG8_SP2>(Fp.lds, g, S, E, Fp.wave); }
        SEAM(pb + 10);
        if (INK(pb + 11, 11)) addnorm_rows<false>(F, xres, (const bf16*)(F.ws + WS_DELTA), (const float*)argin(args, 26) + (size_t)layer * DM, xres, hb);
        SEAM(pb + 11);
        if (INK(pb + 12, 12)) for (int rep = 0; rep < REPN(12); ++rep) { const Frame Fp = phase_frame(F);  pg8::Gemm g{hb, (const bf16*)lw_ptr(Fp, layer, LW_PG), M, DM, DM}; pg8::StaticOrder S; S.init(M, DM, Fp.G, Fp.bid);
            pg8::EpiB<3> E{(bf16*)(Fp.ws + WS_DELTA), DM, (const float*)eb, nullptr};
            pg8::gemm_phase<pg8::EpiB<3>, pg8::StaticOrder, PG8_ALIGN, PG8_SP2>(Fp.lds, g, S, E, Fp.wave); }
        SEAM(pb + 12);
}
__global__ void __launch_bounds__(NTHR, 2) hyb_fwd(Args args) {
    extern __shared__ __attribute__((aligned(16))) unsigned char lds_raw[];
    Frame F;
    F.lds = (LAS unsigned char*)lds_raw; F.ws = args.ws; F.ctl = (gu32*)(args.ws + WS_CTL);
    F.tid = threadIdx.x; F.lane = F.tid & 63; F.wave = __builtin_amdgcn_readfirstlane(threadIdx.x >> 6); F.G = gridDim.x; F.bid = blockIdx.x;
    const int lo = args.ph_lo, hi = args.ph_hi;
    if (F.tid < 64) ((LAS unsigned*)(F.lds + LDSCTL_OFF))[F.tid] = 0u;
    __syncthreads();
    XcdBarrier bar; bar.bar = (unsigned*)(F.ctl + CW_BAR); bar.x = 0; bar.st = (volatile LAS unsigned*)(F.lds + LDSCTL_OFF);
    if (hi - lo > 1) bar = xcd_barrier_post((unsigned*)(F.ctl + CW_BAR), (volatile LAS unsigned*)(F.lds + LDSCTL_OFF));
    STAMP(0);
    if (INK(0, 13)) for (int rep = 0; rep < REPN(13); ++rep) p0_prologue(F, args);
    SEAM(0);
    layer_phases<0>(F, args, bar, lo, hi); layer_phases<1>(F, args, bar, lo, hi); layer_phases<2>(F, args, bar, lo, hi); layer_phases<3>(F, args, bar, lo, hi);
    float* xres = (float*)(F.ws + WS_X);
    int hi_l = hi; asm volatile("" : "+s"(hi_l));
    if (((PH_MASK >> 14) & 1u) && lo <= NPH - 1 && NPH - 1 < hi_l) addnorm_rows<true>(F, xres, (const bf16*)(F.ws + WS_DELTA), (const float*)argin(args, 29), nullptr, args.out);
#if defined(TIME_PROBE)
    { XcdBarrier b_ = bar; xcd_barrier(b_); STAMP(NPH);
      if (F.bid == 0) {
        LAS float* ab = (LAS float*)(F.lds);
        if (F.tid == 0) { const unsigned long long* ts = (const unsigned long long*)(F.ctl + CW_TS); float sum[17];
            float sA = 0.f, sB = 0.f;
            for (int ph = 0; ph < NPH; ++ph) { int kind = (ph == 0) ? 13 : (ph == NPH - 1) ? 14 : (ph - 1) % NPH_LAYER; float d = (float)(ts[ph + 1] - ts[ph]) * 0.01f;
                if (kind == 5) { const int L = (ph - 1) / NPH_LAYER; const float d3 = (float)(ts[60 + L] - ts[ph]) * 0.01f; if (TIME_PROBE_A == 15) sA += d3; if (TIME_PROBE_B == 15) sB += d3; d -= d3; }
                if (kind == TIME_PROBE_A || (TIME_PROBE_A == 16 && (kind == 0 || kind == 8 || kind == 11))) sA += d;
                if (kind == TIME_PROBE_B || (TIME_PROBE_B == 16 && (kind == 0 || kind == 8 || kind == 11))) sB += d; }
            ab[0] = sA; ab[1] = sB * 0.01f; (void)sum; }
        __syncthreads();
        const float A = ab[0], B = ab[1];
        if (F.tid == 0) args.out[0] += A;
        for (int j = 0; j < 2048; ++j) args.out[1 + F.tid + NTHR * j] += B;
      } }
#endif
#undef INK
#undef SEAM
}

#ifndef MK_ONE_LAUNCH
#define MK_ONE_LAUNCH 1
#endif
extern "C" void kernel_launch(void* const* d_in, const int* in_sizes, int n_in, void* d_out, int out_size, void* d_ws, size_t ws_size, hipStream_t stream) {
    static int grid = 0;
    if (grid == 0) {
        if (n_in != 30 || out_size != M * DM || ws_size < WS_END) { fprintf(stderr, "kernel_launch: unexpected shapes (n_in %d out %d ws %zu need %zu)\n", n_in, out_size, ws_size, (size_t)WS_END); grid = -1; return; }
        int dev = 0, cus = 0, per_cu = 0;
        if (hipGetDevice(&dev) != hipSuccess || hipDeviceGetAttribute(&cus, hipDeviceAttributeMultiprocessorCount, dev) != hipSuccess) { grid = -1; return; }
        if (hipFuncSetAttribute((const void*)hyb_fwd, hipFuncAttributeMaxDynamicSharedMemorySize, LDS_BYTES) != hipSuccess) { fprintf(stderr, "kernel_launch: hipFuncSetAttribute failed\n"); grid = -1; return; }
        if (hipOccupancyMaxActiveBlocksPerMultiprocessor(&per_cu, (const void*)hyb_fwd, NTHR, LDS_BYTES) != hipSuccess || per_cu < 1) { fprintf(stderr, "kernel_launch: occupancy query says %d\n", per_cu); }
        (void)hipGetLastError();
        grid = cus;
    }
    if (grid < 0) return;
    (void)hipMemsetAsync((char*)d_ws + WS_CTL, 0, CTL_ZERO_BYTES, stream);
    Args a{};
    for (int i = 0; i < 30; ++i) a.in[i] = d_in[i];
    a.out = (float*)d_out; a.ws = (unsigned char*)d_ws;
#if MK_ONE_LAUNCH
    a.ph_lo = 0; a.ph_hi = NPH;
    hipLaunchKernelGGL(hyb_fwd, dim3(grid), dim3(NTHR), LDS_BYTES, stream, a);
#else
    for (int ph = 0; ph < NPH; ++ph) { a.ph_lo = ph; a.ph_hi = ph + 1; hipLaunchKernelGGL(hyb_fwd, dim3(grid), dim3(NTHR), LDS_BYTES, stream, a);
#if defined(CHECK_BUILD) && CHECK_BUILD
        if (ph == 2) hipLaunchKernelGGL(chk_proj, dim3(1024), dim3(256), 0, stream, a);
        if (ph == 3) hipLaunchKernelGGL(chk_cmp, dim3(128), dim3(128), 0, stream, a);
        if (ph == 6) hipLaunchKernelGGL(chk_nsa, dim3(8 * CHK_NT), dim3(256), 0, stream, a);
        if (ph == NPH - 1) hipLaunchKernelGGL(chk_report, dim3(4098), dim3(256), 0, stream, a);
#endif
    }
#endif
    (void)in_sizes;
}
```
